# Optimizing an MI355X kernel written in HIP

```python
import math
import jax, jax.numpy as jnp
from jax import lax
import numpy as np

D_MODEL = 1024
BATCH = 1
SEQ = 16384
DEPTH = 2

CTX_LEN = 256
GRID_W = 64
EPS = 1e-6
ROPE_THETA = 10000.0
Q_BLOCK = 128

GLA_HEADS = 4
GLA_DK = 64
GLA_DV = 128
GLA_GATE_RANK = 16
GLA_TAU = 16.0
GLA_CHUNK = 64
GLA_QK = GLA_HEADS * GLA_DK
GLA_VW = GLA_HEADS * GLA_DV

MLA_HEADS = 4
MLA_Q_LORA = 256
MLA_KV_LORA = 128
MLA_NOPE = 128
MLA_ROPE = 64
MLA_V = 128
MLA_VW = MLA_HEADS * MLA_V

MIX_WIDTH = GLA_VW + MLA_VW
AB_SIZES = (GLA_QK, GLA_QK, GLA_VW, GLA_VW, GLA_GATE_RANK, GLA_GATE_RANK, MLA_Q_LORA, MLA_KV_LORA, MLA_ROPE)
IN_AB = GLA_QK + GLA_QK + GLA_VW + GLA_VW + GLA_GATE_RANK + GLA_GATE_RANK + MLA_Q_LORA + MLA_KV_LORA + MLA_ROPE

NA_HEADS = 16
NA_DH = D_MODEL // NA_HEADS
NA_KH_MAX = 8
NA_KW = 16

N_EXPERTS = 32
TOP_K = 4
D_FF_EXPERT = D_MODEL
SWIGLU_LIMIT = 7.0
SWIGLU_ALPHA = 1.702
MOE_BLOCK = 128

N_EVEN = (DEPTH + 1) // 2
N_ODD = DEPTH // 2

kernel_name = "hybrid_gla_mla_natten_moe_dit"


def rmsnorm(x, g):
    xf = x.astype(jnp.float32)
    y = xf * lax.rsqrt(jnp.mean(xf * xf, axis=-1, keepdims=True) + EPS)
    return (y * g.astype(jnp.float32)).astype(x.dtype)


def axial_rope(n_tok, rot_dim, dtype):
    t = jnp.arange(n_tok)
    row = (t // GRID_W).astype(jnp.float32)
    col = (t % GRID_W).astype(jnp.float32)
    n_freq = rot_dim // 4
    inv = ROPE_THETA ** (-jnp.arange(n_freq, dtype=jnp.float32) / n_freq)
    ang = jnp.concatenate([row[:, None] * inv, col[:, None] * inv], axis=-1)
    return jnp.cos(ang).astype(dtype), jnp.sin(ang).astype(dtype)


def apply_rope(x, cos, sin):
    x1, x2 = jnp.split(x, 2, axis=-1)
    return jnp.concatenate([x1 * cos - x2 * sin, x1 * sin + x2 * cos], axis=-1)


def dense_attention_blocks(q, k, v, scale):
    B, S, H, dq = q.shape
    nb = S // Q_BLOCK
    qb = jnp.moveaxis(q.reshape(B, nb, Q_BLOCK, H, dq), 1, 0)

    def one(qi):
        s = jnp.einsum('bqhd,bkhd->bhqk', qi, k).astype(jnp.float32) * scale
        p = jax.nn.softmax(s, axis=-1).astype(v.dtype)
        return jnp.einsum('bhqk,bkhv->bqhv', p, v)

    o = lax.map(one, qb)
    return jnp.moveaxis(o, 0, 1).reshape(B, S, H, v.shape[-1])


def gla_scan(q, k, v, log_a, s0):
    B, T, H, DK = q.shape
    DV = v.shape[-1]
    nc = T // GLA_CHUNK

    def to_chunks(a):
        return jnp.moveaxis(a.astype(jnp.float32).reshape(B, nc, GLA_CHUNK, H, a.shape[-1]), 1, 0)

    causal = jnp.tril(jnp.ones((GLA_CHUNK, GLA_CHUNK), dtype=bool))

    def step(s, inp):
        qc, kc, vc, gc = inp
        b = jnp.cumsum(gc, axis=1)
        diff = b[:, :, None] - b[:, None, :]
        decay = jnp.exp(jnp.where(causal[None, :, :, None, None], diff, -jnp.inf))
        a = jnp.sum(qc[:, :, None] * kc[:, None] * decay, axis=-1)
        o_intra = jnp.einsum('btsh,bshv->bthv', a, vc)
        o_inter = jnp.einsum('bthd,bhdv->bthv', qc * jnp.exp(b), s)
        b_last = b[:, -1]
        k_dec = kc * jnp.exp(b_last[:, None] - b)
        s_new = jnp.exp(b_last)[..., None] * s + jnp.einsum('bshd,bshv->bhdv', k_dec, vc)
        return s_new, o_intra + o_inter

    s_fin, o = lax.scan(step, s0, (to_chunks(q), to_chunks(k), to_chunks(v), to_chunks(log_a)))
    o = jnp.moveaxis(o, 0, 1).reshape(B, T, H, DV)
    return o.astype(v.dtype), s_fin


def mixer_gla_mla(h_l, h_c, in_w, wa_f, ba_f, wa_b, ba_b, onorm, qnorm, wuq, kvnorm, wukv, out_w, cos, sin, need_ctx):
    split_pts = np.cumsum(AB_SIZES)[:-1].tolist()

    def project(h, rotary):
        B, T, _ = h.shape
        q, k, v, r, a_f, a_b, cq, ckv, kr = jnp.split(h @ in_w, split_pts, axis=-1)
        q = q.reshape(B, T, GLA_HEADS, GLA_DK) * (GLA_DK ** -0.5)
        k = k.reshape(B, T, GLA_HEADS, GLA_DK)
        v = v.reshape(B, T, GLA_HEADS, GLA_DV)
        la_f = jax.nn.log_sigmoid((a_f @ wa_f + ba_f).astype(jnp.float32)).reshape(B, T, GLA_HEADS, GLA_DK) / GLA_TAU
        la_b = jax.nn.log_sigmoid((a_b @ wa_b + ba_b).astype(jnp.float32)).reshape(B, T, GLA_HEADS, GLA_DK) / GLA_TAU
        qm = (rmsnorm(cq, qnorm) @ wuq).reshape(B, T, MLA_HEADS, MLA_NOPE + MLA_ROPE)
        kvm = (rmsnorm(ckv, kvnorm) @ wukv).reshape(B, T, MLA_HEADS, MLA_NOPE + MLA_V)
        q_nope, q_rope = jnp.split(qm, [MLA_NOPE], axis=-1)
        k_nope, vm = jnp.split(kvm, [MLA_NOPE], axis=-1)
        if rotary:
            q_rope = apply_rope(q_rope, cos[:, None, :], sin[:, None, :])
            kr = apply_rope(kr, cos, sin)
        qm = jnp.concatenate([q_nope, q_rope], axis=-1)
        km = jnp.concatenate([k_nope, jnp.broadcast_to(kr[:, :, None, :], (B, T, MLA_HEADS, MLA_ROPE))], axis=-1)
        return (q, k, v, la_f, la_b, r), (qm, km, vm)

    (q_l, k_l, v_l, fl, bl, r_l), (qm_l, km_l, vm_l) = project(h_l, True)
    (q_c, k_c, v_c, fc, bc, r_c), (qm_c, km_c, vm_c) = project(h_c, False)
    B, S, _ = h_l.shape
    flip = lambda a: a[:, ::-1]
    s0 = jnp.zeros((q_l.shape[0], GLA_HEADS, GLA_DK, GLA_DV), jnp.float32)
    o_cf, s_cf = gla_scan(q_c, k_c, v_c, fc, s0)
    o_cb, s_cb = gla_scan(flip(q_c), flip(k_c), flip(v_c), flip(bc), s0)
    o_lf, _ = gla_scan(q_l, k_l, v_l, fl, s_cf)
    o_lb, _ = gla_scan(flip(q_l), flip(k_l), flip(v_l), flip(bl), s_cb)

    def gla_out(o, r):
        return rmsnorm(o, onorm).reshape(o.shape[0], o.shape[1], GLA_VW) * jax.nn.silu(r)

    scale = (MLA_NOPE + MLA_ROPE) ** -0.5
    k_all = jnp.concatenate([km_c, km_l], axis=1)
    v_all = jnp.concatenate([vm_c, vm_l], axis=1)
    o_mla_l = dense_attention_blocks(qm_l, k_all, v_all, scale)
    y_l = jnp.concatenate([gla_out(o_lf + flip(o_lb), r_l), o_mla_l.reshape(B, S, MLA_VW)], axis=-1) @ out_w
    if not need_ctx:
        return y_l, None
    o_mla_c = dense_attention_blocks(qm_c, km_c, vm_c, scale)
    y_c = jnp.concatenate([gla_out(o_cf + flip(o_cb), r_c), o_mla_c.reshape(B, CTX_LEN, MLA_VW)], axis=-1) @ out_w
    return y_l, y_c


def neighbourhood_attention(q, k, v, k_ctx, v_ctx, rpb):
    B, S, H, dh = q.shape
    rows = S // GRID_W
    kh = min(NA_KH_MAX, rows)
    kw = NA_KW
    scale = dh ** -0.5
    qg = q.reshape(B, rows, GRID_W, H, dh)
    kg = k.reshape(B, rows, GRID_W, H, dh)
    vg = v.reshape(B, rows, GRID_W, H, dh)
    col = jnp.arange(GRID_W)
    c0 = jnp.clip(col - kw // 2, 0, GRID_W - kw)
    col_idx = c0[:, None] + jnp.arange(kw)[None, :]
    col_bias_idx = col_idx - col[:, None] + NA_KW - 1
    rpb_f = rpb.astype(jnp.float32)

    def one_row(r):
        r0 = jnp.clip(r - kh // 2, 0, rows - kh)
        q_r = lax.dynamic_index_in_dim(qg, r, axis=1, keepdims=False)
        k_rows = lax.dynamic_slice_in_dim(kg, r0, kh, axis=1)
        v_rows = lax.dynamic_slice_in_dim(vg, r0, kh, axis=1)
        k_nb = k_rows[:, :, col_idx]
        v_nb = v_rows[:, :, col_idx]
        s_nb = jnp.einsum('bqhd,bkqwhd->bhqkw', q_r, k_nb).astype(jnp.float32) * scale
        row_bias_idx = r0 + jnp.arange(kh) - r + NA_KH_MAX - 1
        bias = jnp.transpose(rpb_f[:, row_bias_idx][:, :, col_bias_idx], (0, 2, 1, 3))
        s_nb = (s_nb + bias[None]).reshape(B, H, GRID_W, kh * kw)
        s_ctx = jnp.einsum('bqhd,bkhd->bhqk', q_r, k_ctx).astype(jnp.float32) * scale
        p = jax.nn.softmax(jnp.concatenate([s_nb, s_ctx], axis=-1), axis=-1).astype(v.dtype)
        p_nb = p[..., :kh * kw].reshape(B, H, GRID_W, kh, kw)
        p_ctx = p[..., kh * kw:]
        return (jnp.einsum('bhqkw,bkqwhd->bqhd', p_nb, v_nb)
                + jnp.einsum('bhqk,bkhd->bqhd', p_ctx, v_ctx))

    o = lax.map(one_row, jnp.arange(rows))
    return jnp.moveaxis(o, 0, 1).reshape(B, S, H, dh)


def mixer_na(h_l, h_c, qkv_w, rpb, out_w, need_ctx):
    def proj(h):
        B, T, _ = h.shape
        p = (h @ qkv_w).reshape(B, T, 3, NA_HEADS, NA_DH)
        return p[:, :, 0], p[:, :, 1], p[:, :, 2]

    q_l, k_l, v_l = proj(h_l)
    q_c, k_c, v_c = proj(h_c)
    B, S, _ = h_l.shape
    y_l = neighbourhood_attention(q_l, k_l, v_l, k_c, v_c, rpb).reshape(B, S, D_MODEL) @ out_w
    if not need_ctx:
        return y_l, None
    y_c = dense_attention_blocks(q_c, k_c, v_c, NA_DH ** -0.5).reshape(B, CTX_LEN, D_MODEL) @ out_w
    return y_l, y_c


def moe_ffn(h, router_w, router_b, w1, b1, w2, b2):
    T, D = h.shape
    logits = (h @ router_w + router_b).astype(jnp.float32)
    top_val, top_idx = lax.top_k(logits, TOP_K)
    gates = jax.nn.softmax(top_val, axis=-1)
    n_assign = T * TOP_K
    flat_e = top_idx.reshape(-1)
    flat_tok = jnp.arange(n_assign, dtype=jnp.int32) // TOP_K
    order = jnp.argsort(flat_e)
    e_sorted = flat_e[order]
    counts = jnp.bincount(flat_e, length=N_EXPERTS)
    padded = ((counts + MOE_BLOCK - 1) // MOE_BLOCK) * MOE_BLOCK
    pad_end = jnp.cumsum(padded)
    pad_start = pad_end - padded
    start = jnp.cumsum(counts) - counts
    slot = pad_start[e_sorted] + jnp.arange(n_assign) - start[e_sorted]
    n_blocks = -(-n_assign // MOE_BLOCK) + N_EXPERTS
    n_slots = n_blocks * MOE_BLOCK
    slot_tok = jnp.full((n_slots,), T, jnp.int32).at[slot].set(flat_tok[order])
    slot_gate = jnp.zeros((n_slots,), jnp.float32).at[slot].set(gates.reshape(-1)[order])
    block_e = jnp.minimum(jnp.searchsorted(pad_end, jnp.arange(n_blocks) * MOE_BLOCK, side='right'), N_EXPERTS - 1)
    h_pad = jnp.concatenate([h, jnp.zeros((1, D), h.dtype)], axis=0)
    xb = h_pad[slot_tok].reshape(n_blocks, MOE_BLOCK, D)

    def expert_block(args):
        x_blk, e = args
        u = x_blk @ w1[e] + b1[e]
        glu = jnp.minimum(u[:, ::2], SWIGLU_LIMIT)
        lin = jnp.clip(u[:, 1::2], -SWIGLU_LIMIT, SWIGLU_LIMIT)
        act = glu * jax.nn.sigmoid(SWIGLU_ALPHA * glu) * (lin + 1)
        return act @ w2[e] + b2[e]

    yb = lax.map(expert_block, (xb, block_e)).reshape(n_slots, D)
    y = jnp.zeros((T + 1, D), h.dtype).at[slot_tok].add(yb * slot_gate[:, None].astype(h.dtype))
    return y[:T]


def setup_inputs(seed: int = 0) -> dict:
    key = jax.random.key(seed)
    ks = iter(jax.random.split(key, 40))
    f32 = jnp.float32

    def nrm(shape, fan_in, mult=1.0):
        return jax.random.normal(next(ks), shape, f32) * (mult * fan_in ** -0.5)

    def gain(shape):
        return 1.0 + 0.05 * jax.random.normal(next(ks), shape, f32)

    def small(shape, s=0.02):
        return s * jax.random.normal(next(ks), shape, f32)

    D = D_MODEL
    F = D_FF_EXPERT
    return {
        "x": jax.random.normal(next(ks), (BATCH, SEQ, D), f32),
        "c": jax.random.normal(next(ks), (BATCH, D), f32),
        "ctx": jax.random.normal(next(ks), (BATCH, CTX_LEN, D), f32),
        "c_ctx": jax.random.normal(next(ks), (D,), f32),
        "ada_w": nrm((DEPTH, D, 6 * D), D, 0.2),
        "ada_b": small((DEPTH, 6 * D)),
        "norm_g": gain((DEPTH, 4, D)),
        "router_w": nrm((DEPTH, D, N_EXPERTS), D),
        "router_b": small((DEPTH, N_EXPERTS), 0.01),
        "moe_w1": nrm((DEPTH, N_EXPERTS, D, 2 * F), D),
        "moe_b1": small((DEPTH, N_EXPERTS, 2 * F)),
        "moe_w2": nrm((DEPTH, N_EXPERTS, F, D), F),
        "moe_b2": small((DEPTH, N_EXPERTS, D)),
        "ab_in_w": nrm((N_EVEN, D, IN_AB), D),
        "gla_wa_f": nrm((N_EVEN, GLA_GATE_RANK, GLA_QK), GLA_GATE_RANK),
        "gla_ba_f": small((N_EVEN, GLA_QK), 0.1),
        "gla_wa_b": nrm((N_EVEN, GLA_GATE_RANK, GLA_QK), GLA_GATE_RANK),
        "gla_ba_b": small((N_EVEN, GLA_QK), 0.1),
        "gla_onorm": gain((N_EVEN, GLA_DV)),
        "mla_qnorm": gain((N_EVEN, MLA_Q_LORA)),
        "mla_wuq": nrm((N_EVEN, MLA_Q_LORA, MLA_HEADS * (MLA_NOPE + MLA_ROPE)), MLA_Q_LORA),
        "mla_kvnorm": gain((N_EVEN, MLA_KV_LORA)),
        "mla_wukv": nrm((N_EVEN, MLA_KV_LORA, MLA_HEADS * (MLA_NOPE + MLA_V)), MLA_KV_LORA),
        "ab_out_w": nrm((N_EVEN, MIX_WIDTH, D), MIX_WIDTH),
        "na_qkv_w": nrm((N_ODD, D, 3 * D), D),
        "na_rpb": small((N_ODD, NA_HEADS, 2 * NA_KH_MAX - 1, 2 * NA_KW - 1), 0.1),
        "na_out_w": nrm((N_ODD, D, D), D),
    }


def reference(x, c, ctx, c_ctx, ada_w, ada_b, norm_g, router_w, router_b, moe_w1, moe_b1, moe_w2, moe_b2,
              ab_in_w, gla_wa_f, gla_ba_f, gla_wa_b, gla_ba_b, gla_onorm, mla_qnorm, mla_wuq, mla_kvnorm, mla_wukv,
              ab_out_w, na_qkv_w, na_rpb, na_out_w):
    B, S, D = x.shape
    cos, sin = axial_rope(S, MLA_ROPE, x.dtype)
    silu_c = jax.nn.silu(c)
    silu_cc = jax.nn.silu(c_ctx)[None]
    xc = ctx
    for l in range(DEPTH):
        last = l == DEPTH - 1
        sh1_l, sc1_l, g1_l, sh2_l, sc2_l, g2_l = jnp.split((silu_c @ ada_w[l] + ada_b[l])[:, None, :], 6, axis=-1)
        sh1_c, sc1_c, g1_c, sh2_c, sc2_c, g2_c = jnp.split((silu_cc @ ada_w[l] + ada_b[l])[:, None, :], 6, axis=-1)
        h_l = rmsnorm(x, norm_g[l, 0]) * (1 + sc1_l) + sh1_l
        h_c = rmsnorm(xc, norm_g[l, 0]) * (1 + sc1_c) + sh1_c
        i = l // 2
        if l % 2 == 0:
            o_l, o_c = mixer_gla_mla(h_l, h_c, ab_in_w[i], gla_wa_f[i], gla_ba_f[i], gla_wa_b[i], gla_ba_b[i],
                                     gla_onorm[i], mla_qnorm[i], mla_wuq[i], mla_kvnorm[i], mla_wukv[i],
                                     ab_out_w[i], cos, sin, not last)
        else:
            o_l, o_c = mixer_na(h_l, h_c, na_qkv_w[i], na_rpb[i], na_out_w[i], not last)
        x = x + rmsnorm(o_l, norm_g[l, 1]) * g1_l
        h_l = rmsnorm(x, norm_g[l, 2]) * (1 + sc2_l) + sh2_l
        if not last:
            xc = xc + rmsnorm(o_c, norm_g[l, 1]) * g1_c
            h_c = rmsnorm(xc, norm_g[l, 2]) * (1 + sc2_c) + sh2_c
            tokens = jnp.concatenate([h_c.reshape(-1, D), h_l.reshape(-1, D)], axis=0)
            y = moe_ffn(tokens, router_w[l], router_b[l], moe_w1[l], moe_b1[l], moe_w2[l], moe_b2[l])
            y_c = y[:B * CTX_LEN].reshape(B, CTX_LEN, D)
            y_l = y[B * CTX_LEN:].reshape(B, S, D)
            xc = xc + rmsnorm(y_c, norm_g[l, 3]) * g2_c
        else:
            y_l = moe_ffn(h_l.reshape(-1, D), router_w[l], router_b[l], moe_w1[l], moe_b1[l], moe_w2[l],
                          moe_b2[l]).reshape(B, S, D)
        x = x + rmsnorm(y_l, norm_g[l, 3]) * g2_l
    return x
```

```cpp
#include <hip/hip_runtime.h>
#include <hip/hip_cooperative_groups.h>
#include <cstdio>
#include <cstdint>
namespace cg = cooperative_groups;

#ifndef PROBE_REPEAT
#define PROBE_REPEAT -1
#endif
#ifndef MK_LAUNCHES
#define MK_LAUNCHES 1
#endif

typedef unsigned short bf16_t;
typedef short bf16x8 __attribute__((ext_vector_type(8)));
typedef short s16x4 __attribute__((ext_vector_type(4)));
typedef float f32x4 __attribute__((ext_vector_type(4)));
typedef float f32x16 __attribute__((ext_vector_type(16)));
typedef unsigned u32x4 __attribute__((ext_vector_type(4)));
typedef unsigned u32x2 __attribute__((ext_vector_type(2)));

constexpr int SEQ = 16384, CTXN = 256, NTOK = SEQ + CTXN, DM = 1024;
constexpr int NEXP = 32, FF = 1024;
constexpr int PW = 2048;
constexpr int PC_Q = 0, PC_K = 256, PC_V = 512, PC_R = 1024, PC_AF = 1536, PC_AB = 1552, PC_CQ = 1568, PC_CKV = 1824, PC_KR = 1952;
constexpr int NCH = NTOK / 64;
constexpr int NTH = 512;
constexpr float EPSN = 1e-6f;
constexpr float LOG2E = 1.4426950408889634f;

constexpr size_t al256(size_t x) { return (x + 255) / 256 * 256; }
constexpr size_t WS_BAR   = 0;
constexpr size_t WS_CNT   = WS_BAR + 16384;
constexpr size_t WS_MOD   = WS_CNT + 1024;
constexpr size_t WS_ROPE  = WS_MOD + al256((size_t)2 * 2 * 6144 * 4);
constexpr size_t WS_RWT   = WS_ROPE + al256((size_t)(256 + 256 + 64 + 64) * 16 * 4);
constexpr size_t WS_WIN   = WS_RWT + al256((size_t)2 * 32 * 1024 * 4);
constexpr size_t WS_WUQ   = WS_WIN + (size_t)2048 * 1024 * 2;
constexpr size_t WS_WUKV  = WS_WUQ + (size_t)768 * 256 * 2;
constexpr size_t WS_WOUT0 = WS_WUKV + (size_t)1024 * 128 * 2;
constexpr size_t WS_WQKV  = WS_WOUT0 + (size_t)1024 * 1024 * 2;
constexpr size_t WS_WNAO  = WS_WQKV + (size_t)3072 * 1024 * 2;
constexpr size_t WS_W1T   = WS_WNAO + (size_t)1024 * 1024 * 2;
constexpr size_t WS_W2T   = WS_W1T + (size_t)2 * 32 * 2048 * 1024 * 2;
constexpr size_t WS_HB    = WS_W2T + (size_t)2 * 32 * 1024 * 1024 * 2;
constexpr size_t WS_P     = WS_HB + (size_t)NTOK * 1024 * 2;
constexpr size_t WS_QM    = WS_P + (size_t)NTOK * 3072 * 2;
constexpr size_t WS_KM    = WS_QM + (size_t)NTOK * 768 * 2;
constexpr size_t WS_VM    = WS_KM + (size_t)NTOK * 768 * 2;
constexpr size_t WS_U     = WS_VM + (size_t)NTOK * 512 * 2;
constexpr size_t WS_SIN   = WS_U + (size_t)2 * NCH * 4 * 128 * 64 * 2;
constexpr size_t WS_DEC   = WS_SIN + (size_t)2 * NCH * 4 * 128 * 64 * 2;
constexpr size_t WS_MIX   = WS_DEC + al256((size_t)2 * NCH * 4 * 64 * 4);
constexpr size_t WS_OB    = WS_MIX + (size_t)NTOK * 1024 * 2;
constexpr size_t WS_X1    = WS_OB + (size_t)NTOK * 1024 * 2;
constexpr size_t WS_X2    = WS_X1 + (size_t)NTOK * 1024 * 4;
constexpr size_t WS_TOPE  = WS_X2 + (size_t)NTOK * 1024 * 4;
constexpr size_t WS_TOPP  = WS_TOPE + al256((size_t)NTOK * 4 * 4);
constexpr size_t WS_GATE  = WS_TOPP + al256((size_t)NTOK * 4 * 4);
constexpr size_t WS_LIST  = WS_GATE + al256((size_t)NTOK * 4 * 4);
constexpr size_t WS_ACT   = WS_LIST + al256((size_t)32 * NTOK * 4);
constexpr size_t WS_YB    = WS_ACT + (size_t)(NTOK * 4 + 256) * 1024 * 2;
constexpr size_t WS_END   = WS_YB + (size_t)(NTOK * 4) * 1024 * 2;

constexpr int LDS_BYTES = 160 * 1024;
extern __shared__ __attribute__((aligned(16))) char smem[];

struct Params {
    const float *x, *c, *ctx, *c_ctx, *ada_w, *ada_b, *norm_g, *router_w, *router_b, *moe_w1, *moe_b1, *moe_w2, *moe_b2;
    const float *ab_in_w, *gla_wa_f, *gla_ba_f, *gla_wa_b, *gla_ba_b, *gla_onorm, *mla_qnorm, *mla_wuq, *mla_kvnorm, *mla_wukv;
    const float *ab_out_w, *na_qkv_w, *na_rpb, *na_out_w;
    float* out; char* ws;
    int pad0, pad1;
};

__device__ __forceinline__ float bf2f(bf16_t h) { return __uint_as_float(((unsigned)h) << 16); }
__device__ __forceinline__ bf16_t f2bf(float f) { unsigned u = __float_as_uint(f); u += 0x7FFFu + ((u >> 16) & 1u); return (bf16_t)(u >> 16); }
__device__ __forceinline__ unsigned cvtpk(float lo, float hi) { unsigned r; asm volatile("v_cvt_pk_bf16_f32 %0, %1, %2" : "=v"(r) : "v"(lo), "v"(hi)); return r; }
__device__ __forceinline__ float wave_sum(float v) {
#pragma unroll
    for (int o = 32; o >= 1; o >>= 1) v += __shfl_xor(v, o);
    return v;
}
__device__ __forceinline__ int crow(int r, int hi) { return (r & 3) + 8 * (r >> 2) + 4 * hi; }
__device__ __forceinline__ float silu_f(float x) { return x / (1.f + __expf(-x)); }
#define SBAR() __builtin_amdgcn_sched_barrier(0)
__device__ __forceinline__ int tid_opaque() { int t = threadIdx.x; asm volatile("" : "+v"(t)); return t; }

struct ConvJob { const float* src; bf16_t* dst; const float* gain; int K, Nsrc, kt, nt, mode; };
__device__ __forceinline__ void conv_load(const ConvJob& jb, float4 (&v)[8]) {
    const int tid = threadIdx.x, n4 = tid & 31, kr = tid >> 5, n = jb.nt * 128 + n4 * 4;
    const float* q = jb.src + (size_t)(jb.kt * 128 + kr) * jb.Nsrc + n;
#pragma unroll
    for (int i = 0; i < 8; ++i) { if (n < jb.Nsrc) v[i] = *(const float4*)(q + (size_t)(16 * i) * jb.Nsrc); else v[i] = make_float4(0.f, 0.f, 0.f, 0.f); }
}
__device__ __forceinline__ void conv_to_lds(const ConvJob& jb, const float4 (&v)[8]) {
    bf16_t* T = (bf16_t*)smem;
    const int tid = threadIdx.x, n4 = tid & 31, kr = tid >> 5;
#pragma unroll
    for (int i = 0; i < 8; ++i) {
        const int k = kr + 16 * i;
        float4 w = v[i];
        if (jb.mode == 1) { const float g = jb.gain[jb.kt * 128 + k]; w.x *= g; w.y *= g; w.z *= g; w.w *= g; }
        u32x2 pk; pk.x = cvtpk(w.x, w.y); pk.y = cvtpk(w.z, w.w);
        *(u32x2*)(T + k * 132 + n4 * 4) = pk;
    }
}
__device__ __forceinline__ void conv_readout(const ConvJob& jb) {
    const bf16_t* T = (const bf16_t*)smem;
    const int tid = threadIdx.x, k0 = jb.kt * 128;
#pragma unroll
    for (int i = 0; i < 4; ++i) {
        const int cc = tid + 512 * i, nn = cc >> 4, kc = cc & 15;
        int col = nn, drow = jb.nt * 128 + nn;
        if (jb.mode == 2) { const int f = jb.nt * 64 + (nn & 63); col = 2 * (nn & 63) + (nn >> 6); drow = (f >> 7) * 256 + (f & 127) + (nn >> 6) * 128; }
        unsigned short e[8];
#pragma unroll
        for (int j = 0; j < 8; ++j) e[j] = T[(kc * 8 + j) * 132 + col];
        u32x4 o; o.x = e[0] | ((unsigned)e[1] << 16); o.y = e[2] | ((unsigned)e[3] << 16); o.z = e[4] | ((unsigned)e[5] << 16); o.w = e[6] | ((unsigned)e[7] << 16);
        *(u32x4*)(jb.dst + (size_t)drow * jb.K + k0 + kc * 8) = o;
    }
}

__device__ __forceinline__ void adaln_job(const Params& p, int job) {
    const int l = job / 24, cb = (job % 24) * 256, tid = threadIdx.x;
    float* sv = (float*)smem;
    for (int i = tid; i < 2048; i += NTH) { const int k = i & 1023; const float xx = (i < 1024) ? p.c[k] : p.c_ctx[k]; sv[i] = silu_f(xx); }
    __syncthreads();
    const int col4 = tid & 63, kq = tid >> 6;
    float4 a0 = make_float4(0, 0, 0, 0), a1 = make_float4(0, 0, 0, 0);
    const float* w = p.ada_w + ((size_t)l * 1024 + kq * 128) * 6144 + cb + col4 * 4;
#pragma unroll 8
    for (int k = 0; k < 128; ++k) {
        const float4 wv = *(const float4*)(w + (size_t)k * 6144);
        const float s0 = sv[kq * 128 + k], s1 = sv[1024 + kq * 128 + k];
        a0.x += s0 * wv.x; a0.y += s0 * wv.y; a0.z += s0 * wv.z; a0.w += s0 * wv.w;
        a1.x += s1 * wv.x; a1.y += s1 * wv.y; a1.z += s1 * wv.z; a1.w += s1 * wv.w;
    }
    float* red = sv + 2048;
    *(float4*)(red + (kq * 2 + 0) * 256 + col4 * 4) = a0;
    *(float4*)(red + (kq * 2 + 1) * 256 + col4 * 4) = a1;
    __syncthreads();
    {
        const int s = tid >> 8, col = tid & 255;
        float acc = p.ada_b[l * 6144 + cb + col];
#pragma unroll
        for (int q = 0; q < 8; ++q) acc += red[(q * 2 + s) * 256 + col];
        ((float*)(p.ws + WS_MOD))[(l * 2 + s) * 6144 + cb + col] = acc;
    }
    __syncthreads();
}

__device__ __forceinline__ void tables_job(const Params& p) {
    float* rope = (float*)(p.ws + WS_ROPE);
    const int tid = threadIdx.x;
    for (int i = tid; i < (256 + 64) * 16; i += NTH) {
        const bool isrow = i < 256 * 16;
        const int idx = isrow ? i : i - 256 * 16, pos = idx >> 4, j = idx & 15;
        const float inv = exp2f(-(float)j * (13.287712379549449f / 16.f));
        const float ang = (float)pos * inv;
        float rev = ang * 0.15915494309189535f; rev -= rintf(rev);
        const float cs = __builtin_amdgcn_cosf(rev), sn = __builtin_amdgcn_sinf(rev);
        if (isrow) { rope[idx] = cs; rope[256 * 16 + idx] = sn; }
        else { rope[512 * 16 + idx] = cs; rope[512 * 16 + 64 * 16 + idx] = sn; }
    }
    if (tid < 64) ((int*)(p.ws + WS_CNT))[tid] = 0;
}
__device__ __forceinline__ void rwt_job(const Params& p, int l) {
    float* dst = (float*)(p.ws + WS_RWT) + (size_t)l * 32 * 1024;
    const float* src = p.router_w + (size_t)l * 1024 * 32;
    for (int i = threadIdx.x; i < 32 * 1024; i += NTH) { const int cch = i >> 5, e = i & 31; dst[e * 1024 + cch] = src[i]; }
}

constexpr int J_IN = 8 * 16, J_UQ = 2 * 6, J_UKV = 1 * 8, J_OUT0 = 64, J_QKV = 8 * 24, J_NAO = 64, J_W1 = 64 * 128, J_W2 = 64 * 64;
constexpr int J_TOTAL = J_IN + J_UQ + J_UKV + J_OUT0 + J_QKV + J_NAO + J_W1 + J_W2;
__device__ __forceinline__ ConvJob conv_decode(const Params& p, int j) {
    ConvJob jb; jb.gain = nullptr; jb.mode = 0;
    int t = j;
    if (t < J_W1) { const int m = t >> 7, q = t & 127; jb.src = p.moe_w1 + (size_t)m * 1024 * 2048; jb.dst = (bf16_t*)(p.ws + WS_W1T) + (size_t)m * 2048 * 1024; jb.K = 1024; jb.Nsrc = 2048; jb.kt = q >> 4; jb.nt = q & 15; jb.mode = 2; return jb; } t -= J_W1;
    if (t < J_W2) { const int m = t >> 6, q = t & 63; jb.src = p.moe_w2 + (size_t)m * 1024 * 1024; jb.dst = (bf16_t*)(p.ws + WS_W2T) + (size_t)m * 1024 * 1024; jb.K = 1024; jb.Nsrc = 1024; jb.kt = q >> 3; jb.nt = q & 7; return jb; } t -= J_W2;
    if (t < J_IN) { jb.src = p.ab_in_w; jb.dst = (bf16_t*)(p.ws + WS_WIN); jb.K = 1024; jb.Nsrc = 2016; jb.kt = t / 16; jb.nt = t % 16; return jb; } t -= J_IN;
    if (t < J_UQ) { jb.src = p.mla_wuq; jb.dst = (bf16_t*)(p.ws + WS_WUQ); jb.K = 256; jb.Nsrc = 768; jb.kt = t / 6; jb.nt = t % 6; jb.mode = 1; jb.gain = p.mla_qnorm; return jb; } t -= J_UQ;
    if (t < J_UKV) { jb.src = p.mla_wukv; jb.dst = (bf16_t*)(p.ws + WS_WUKV); jb.K = 128; jb.Nsrc = 1024; jb.kt = 0; jb.nt = t; jb.mode = 1; jb.gain = p.mla_kvnorm; return jb; } t -= J_UKV;
    if (t < J_OUT0) { jb.src = p.ab_out_w; jb.dst = (bf16_t*)(p.ws + WS_WOUT0); jb.K = 1024; jb.Nsrc = 1024; jb.kt = t / 8; jb.nt = t % 8; return jb; } t -= J_OUT0;
    if (t < J_QKV) { jb.src = p.na_qkv_w; jb.dst = (bf16_t*)(p.ws + WS_WQKV); jb.K = 1024; jb.Nsrc = 3072; jb.kt = t / 24; jb.nt = t % 24; return jb; } t -= J_QKV;
    jb.src = p.na_out_w; jb.dst = (bf16_t*)(p.ws + WS_WNAO); jb.K = 1024; jb.Nsrc = 1024; jb.kt = t / 8; jb.nt = t % 8; return jb;
}

__device__ __forceinline__ void phase_prologue(const Params& p) {
    const int G = gridDim.x, b = blockIdx.x;
    for (int j = b; j < 51; j += G) {
        if (j < 48) adaln_job(p, j);
        else if (j == 48) tables_job(p);
        else rwt_job(p, j - 49);
    }
    __syncthreads();
    int j = b;
    if (j >= J_TOTAL) return;
    ConvJob cur = conv_decode(p, j);
    float4 v[8];
    conv_load(cur, v);
    for (;;) {
        conv_to_lds(cur, v);
        __syncthreads();
        const int jn = j + G;
        ConvJob nxt = cur;
        if (jn < J_TOTAL) { nxt = conv_decode(p, jn); conv_load(nxt, v); }
        conv_readout(cur);
        __syncthreads();
        if (jn >= J_TOTAL) break;
        cur = nxt; j = jn;
    }
}

namespace gm {
constexpr int BK = 64, HT = 128 * 64;
__device__ __forceinline__ int lds_byte(int r, int c) { const int st = (r >> 4) * 2 + (c >> 5), rr = r & 15, cc = c & 31, ob = rr * 64 + cc * 2; return st * 1024 + (ob ^ (((ob >> 9) & 1) << 5)); }
__device__ __forceinline__ void stage_rc(int b, int& R, int& C) { const int st = b / 1024, sb = b % 1024, swz = sb ^ (((sb >> 9) & 1) << 5); R = (st >> 1) * 16 + swz / 64; C = (st & 1) * 32 + (swz % 64) / 2; }

template <class Epi>
__device__ __forceinline__ void gemm_tile(const bf16_t* __restrict__ A, const int (&aoff)[2][2], const bf16_t* __restrict__ Bt, const int (&boff)[2], int nk, Epi& epi) {
    bf16_t* shm = (bf16_t*)smem;
    const int tid = tid_opaque(), wid = tid >> 6, lane = tid & 63, wr = wid >> 1, wc = wid & 1, fr = lane & 15, fq = lane >> 4;
    f32x4 acc[4][4];
#pragma unroll
    for (int m = 0; m < 4; ++m)
#pragma unroll
        for (int n = 0; n < 4; ++n) acc[m][n] = (f32x4){0.f, 0.f, 0.f, 0.f};
#define GM_STAGE(buf, kt) do { \
        _Pragma("unroll") for (int _i = 0; _i < 2; ++_i) { \
            __builtin_amdgcn_global_load_lds((const unsigned*)(A + aoff[0][_i] + (kt) * BK), (unsigned*)((char*)(shm + ((buf) * 3 + 0) * HT) + tid * 16 + _i * 8192), 16, 0, 0); \
            __builtin_amdgcn_global_load_lds((const unsigned*)(A + aoff[1][_i] + (kt) * BK), (unsigned*)((char*)(shm + ((buf) * 3 + 1) * HT) + tid * 16 + _i * 8192), 16, 0, 0); \
            __builtin_amdgcn_global_load_lds((const unsigned*)(Bt + boff[_i] + (kt) * BK), (unsigned*)((char*)(shm + ((buf) * 3 + 2) * HT) + tid * 16 + _i * 8192), 16, 0, 0); } } while (0)
    GM_STAGE(0, 0);
    for (int kt = 0; kt < nk; ++kt) {
        __syncthreads();
        const int buf = kt & 1;
        if (kt + 1 < nk) GM_STAGE(buf ^ 1, kt + 1);
        const char* Ab = (const char*)(shm + (buf * 3 + (wr >> 1)) * HT);
        const char* Bb = (const char*)(shm + (buf * 3 + 2) * HT);
#pragma unroll
        for (int k = 0; k < 2; ++k) {
            bf16x8 Bf[4], Af[4];
#pragma unroll
            for (int n = 0; n < 4; ++n) Bf[n] = *(const bf16x8*)(Bb + lds_byte(wc * 64 + n * 16 + fr, k * 32 + fq * 8));
#pragma unroll
            for (int m = 0; m < 4; ++m) Af[m] = *(const bf16x8*)(Ab + lds_byte((wr & 1) * 64 + m * 16 + fr, k * 32 + fq * 8));
#pragma unroll
            for (int m = 0; m < 4; ++m)
#pragma unroll
                for (int n = 0; n < 4; ++n) acc[m][n] = __builtin_amdgcn_mfma_f32_16x16x32_bf16(Af[m], Bf[n], acc[m][n], 0, 0, 0);
        }
    }
#undef GM_STAGE
    float* stg = (float*)smem;
    __syncthreads();
    {
        float* wb = stg + (wr * 64 + fq * 4) * 132 + wc * 64 + fr;
#pragma unroll
        for (int m = 0; m < 4; ++m)
#pragma unroll
            for (int n = 0; n < 4; ++n)
#pragma unroll
                for (int j = 0; j < 4; ++j) wb[(m * 16 + j) * 132 + n * 16] = acc[m][n][j];
    }
    __syncthreads();
    if (Epi::MOE1) {
        const int fch = tid & 7, rg = tid >> 3;
        for (int ps = 0; ps < 4; ++ps) {
            const int row = ps * 64 + rg;
            const float* q = stg + row * 132 + (fch >> 1) * 32 + (fch & 1) * 8;
            float g[8], l[8];
            *(f32x4*)&g[0] = *(const f32x4*)q; *(f32x4*)&g[4] = *(const f32x4*)(q + 4);
            *(f32x4*)&l[0] = *(const f32x4*)(q + 16); *(f32x4*)&l[4] = *(const f32x4*)(q + 20);
            epi.pair(row, fch * 8, g, l);
        }
    } else {
        const int ch = tid & 15, rg = tid >> 4;
        for (int ps = 0; ps < 8; ++ps) {
            const int row = ps * 32 + rg;
            const float* q = stg + row * 132 + ch * 8;
            float v[8];
            *(f32x4*)&v[0] = *(const f32x4*)q; *(f32x4*)&v[4] = *(const f32x4*)(q + 4);
            epi.row8(row, ch * 8, v);
        }
    }
    __syncthreads();
}
__device__ __forceinline__ void make_off(int (&off)[2][2], int row0, int ld) {
#pragma unroll
    for (int h = 0; h < 2; ++h)
#pragma unroll
        for (int i = 0; i < 2; ++i) { int R, C; stage_rc(tid_opaque() * 16 + i * 8192, R, C); off[h][i] = (row0 + h * 128 + R) * ld + C; }
}
__device__ __forceinline__ void make_off1(int (&off)[2], int row0, int ld) {
#pragma unroll
    for (int i = 0; i < 2; ++i) { int R, C; stage_rc(tid_opaque() * 16 + i * 8192, R, C); off[i] = (row0 + R) * ld + C; }
}
}

namespace pg8 {
#define PG8_LAS __attribute__((address_space(3)))
constexpr int BM = 256, BK = 64, HALF = 128, HTB = HALF * BK * 2, STAGE_BYTES = 8 * HTB, NXCD = 8, WGM = 8;
__device__ __forceinline__ int lds_byte(int r, int c) { const int st = (r >> 4) * 2 + (c >> 5), rr = r & 15, cc = c & 31, ob = rr * 64 + cc * 2; return st * 1024 + (ob ^ (((ob >> 9) & 1) << 5)); }
__device__ __forceinline__ void stage_rc(int b, int& R, int& C) { const int st = b / 1024, sb = b % 1024, swz = sb ^ (((sb >> 9) & 1) << 5); R = (st >> 1) * 16 + swz / 64; C = (st & 1) * 32 + (swz % 64) / 2; }
__device__ __forceinline__ int perm32(int rho) { const int n = rho >> 4, i = rho & 15; return 8 * (i >> 2) + 4 * n + (i & 3); }
struct Unit { int pm, pn, e, nvalid, slot0; };

template <class Epi, class Sched, bool GATHER>
__device__ __forceinline__ void gemm_phase(PG8_LAS unsigned char* lds, const Sched& S, const Epi& E, int K, int lda, int ldb) {
    const int tid = tid_opaque(), wid = __builtin_amdgcn_readfirstlane(tid >> 6), lane = tid & 63, wr = wid >> 2, wc = wid & 3, fr = lane & 15, fq = lane >> 4;
    const int nt = K / BK;
    unsigned voffA[2], voffB[2]; int gR[2], gC[2];
#pragma unroll
    for (int i = 0; i < 2; ++i) { int R, C; stage_rc(tid * 16 + i * 8192, R, C); const int Rb = Epi::PERM ? ((R & ~31) + perm32(R & 31)) : R;
        voffA[i] = (unsigned)(R * lda + C) * 2u; voffB[i] = (unsigned)(Rb * ldb + C) * 2u; gR[i] = R; gC[i] = C * 2; }
    const size_t kstep = (size_t)(BK * 2);
    const size_t hstepA = (size_t)HALF * lda * 2, hstepB = (size_t)HALF * ldb * 2;
    const unsigned ldsw = (unsigned)wid * 1024u;
    const int aoff = lds_byte(wr * 64 + fr, fq * 8), boff = lds_byte(wc * 32 + fr, fq * 8);
    unsigned gA[2][2] = {{0u, 0u}, {0u, 0u}};
#define PG8_SA(b, h) (((b) * 2 + (h)) * HTB)
#define PG8_SB(b, h) ((4 + (b) * 2 + (h)) * HTB)
#define PG8_STAGE(bufoff, gbase, voff) do { _Pragma("unroll") for (int _i = 0; _i < 2; ++_i) \
        __builtin_amdgcn_global_load_lds((const unsigned*)((const char*)(gbase) + (voff)[_i]), (PG8_LAS unsigned*)(lds + (bufoff) + ldsw + _i * 8192), 16, 0, 0); } while (0)
#define PG8_STAGE_A(bufoff, base, h) do { if constexpr (GATHER) PG8_STAGE(bufoff, base, gA[h]); else PG8_STAGE(bufoff, (base) + (h) * hstepA, voffA); } while (0)
#define PG8_LDA(dst, b, h) do { _Pragma("unroll") for (int m = 0; m < 4; ++m) _Pragma("unroll") for (int k = 0; k < 2; ++k) dst[m][k] = *(const PG8_LAS bf16x8*)(lds + PG8_SA(b, h) + aoff + m * 2048 + k * 1024); } while (0)
#define PG8_LDB(dst, b, h) do { _Pragma("unroll") for (int n = 0; n < 2; ++n) _Pragma("unroll") for (int k = 0; k < 2; ++k) dst[n][k] = *(const PG8_LAS bf16x8*)(lds + PG8_SB(b, h) + boff + n * 2048 + k * 1024); } while (0)
#define PG8_MMA(ai, bj, At, Bt) do { __builtin_amdgcn_s_setprio(1); _Pragma("unroll") for (int m = 0; m < 4; ++m) _Pragma("unroll") for (int n = 0; n < 2; ++n) _Pragma("unroll") for (int k = 0; k < 2; ++k) \
        acc[ai][bj][m][n] = __builtin_amdgcn_mfma_f32_16x16x32_bf16(Bt[n][k], At[m][k], acc[ai][bj][m][n], 0, 0, 0); __builtin_amdgcn_s_setprio(0); } while (0)
#define PG8_WAIT_V(n) asm volatile("s_waitcnt vmcnt(" #n ")" ::: "memory")
#define PG8_WAIT_L(n) asm volatile("s_waitcnt lgkmcnt(" #n ")" ::: "memory")
#define PG8_BAR __builtin_amdgcn_s_barrier()
#define PG8_SCHED __builtin_amdgcn_sched_barrier(0)
#define PG8_GLOAD(ui_) do { const PG8_LAS int* _gl = S.glist(ui_); _Pragma("unroll") for (int _h = 0; _h < 2; ++_h) _Pragma("unroll") for (int _i = 0; _i < 2; ++_i) \
        gA[_h][_i] = ((unsigned)_gl[_h * 128 + gR[_i]] << 11) + (unsigned)gC[_i]; } while (0)
    Unit cur, nxt; int ui = 0;
    if (!S.next(0, cur)) return;
    f32x4 acc[2][2][4][2];
#pragma unroll
    for (int a = 0; a < 2; ++a)
#pragma unroll
        for (int b = 0; b < 2; ++b)
#pragma unroll
            for (int m = 0; m < 4; ++m)
#pragma unroll
                for (int n = 0; n < 2; ++n) acc[a][b][m][n] = (f32x4){0.f, 0.f, 0.f, 0.f};
    bf16x8 At[4][2], B0[2][2], B1[2][2];
    const char* cA = S.a_base(cur); const char* cB = S.b_base(cur);
    if constexpr (GATHER) PG8_GLOAD(0);
    PG8_STAGE(PG8_SB(0, 0), cB, voffB); PG8_STAGE_A(PG8_SA(0, 0), cA, 0); PG8_STAGE(PG8_SB(0, 1), cB + hstepB, voffB); PG8_STAGE_A(PG8_SA(0, 1), cA, 1);
    if (wr == 1) PG8_BAR;
    PG8_WAIT_V(4); PG8_BAR;
    PG8_STAGE(PG8_SB(1, 0), cB + kstep, voffB); PG8_STAGE_A(PG8_SA(1, 0), cA + kstep, 0); PG8_STAGE(PG8_SB(1, 1), cB + hstepB + kstep, voffB);
    PG8_WAIT_V(6); PG8_BAR;
    for (;;) {
        const bool has_next = S.next(ui + 1, nxt);
        const char* nA = has_next ? S.a_base(nxt) : cA; const char* nB = has_next ? S.b_base(nxt) : cB;
        for (int t = 0; t < nt; t += 2) {
            const bool last = (t == nt - 2);
            const char* a1 = cA + (size_t)(t + 1) * kstep;
            const char* a2 = last ? nA : cA + (size_t)(t + 2) * kstep; const char* b2 = last ? nB : cB + (size_t)(t + 2) * kstep;
            const char* a3 = a2 + kstep; const char* b3 = b2 + kstep;
            PG8_LDB(B0, 0, 0); PG8_SCHED; PG8_LDA(At, 0, 0); PG8_STAGE_A(PG8_SA(1, 1), a1, 1);
            PG8_WAIT_L(8); PG8_BAR; PG8_WAIT_L(0); PG8_MMA(0, 0, At, B0); PG8_BAR; PG8_SCHED;
            if constexpr (GATHER) { if (last && has_next) PG8_GLOAD(ui + 1); }
            PG8_LDB(B1, 0, 1); PG8_STAGE(PG8_SB(0, 0), b2, voffB);
            PG8_BAR; PG8_WAIT_L(0); PG8_MMA(0, 1, At, B1); PG8_BAR;
            PG8_LDA(At, 0, 1); PG8_STAGE_A(PG8_SA(0, 0), a2, 0);
            PG8_BAR; PG8_WAIT_L(0); PG8_MMA(1, 0, At, B0); PG8_BAR; PG8_SCHED;
            PG8_STAGE(PG8_SB(0, 1), b2 + hstepB, voffB);
            PG8_WAIT_V(6); PG8_BAR; PG8_MMA(1, 1, At, B1); PG8_BAR;
            PG8_LDB(B0, 1, 0); PG8_SCHED; PG8_LDA(At, 1, 0); PG8_STAGE_A(PG8_SA(0, 1), a2, 1);
            PG8_WAIT_L(8); PG8_BAR; PG8_WAIT_L(0); PG8_MMA(0, 0, At, B0); PG8_BAR; PG8_SCHED;
            PG8_LDB(B1, 1, 1); PG8_STAGE(PG8_SB(1, 0), b3, voffB);
            PG8_BAR; PG8_WAIT_L(0); PG8_MMA(0, 1, At, B1); PG8_BAR;
            PG8_LDA(At, 1, 1); PG8_STAGE_A(PG8_SA(1, 0), a3, 0);
            PG8_BAR; PG8_WAIT_L(0); PG8_MMA(1, 0, At, B0); PG8_BAR; PG8_SCHED;
            PG8_STAGE(PG8_SB(1, 1), b3 + hstepB, voffB);
            PG8_WAIT_V(6); PG8_BAR; PG8_MMA(1, 1, At, B1); PG8_BAR;
        }
        E(acc, cur, wr, wc, fr, fq);
        if (!has_next) break;
#pragma unroll
        for (int a = 0; a < 2; ++a)
#pragma unroll
            for (int b = 0; b < 2; ++b)
#pragma unroll
                for (int m = 0; m < 4; ++m)
#pragma unroll
                    for (int n = 0; n < 2; ++n) acc[a][b][m][n] = (f32x4){0.f, 0.f, 0.f, 0.f};
        cur = nxt; cA = nA; cB = nB; ++ui;
    }
    PG8_WAIT_V(0);
    if (wr == 0) PG8_BAR;
    PG8_BAR;
#undef PG8_SA
#undef PG8_SB
#undef PG8_STAGE
#undef PG8_STAGE_A
#undef PG8_LDA
#undef PG8_LDB
#undef PG8_MMA
#undef PG8_WAIT_V
#undef PG8_WAIT_L
#undef PG8_BAR
#undef PG8_SCHED
#undef PG8_GLOAD
}

struct PlainOrder {
    const char* A; const char* Bt; int lda, ldb, nM, nN, nwg, G, c;
    __device__ void init(const bf16_t* A_, int lda_, const bf16_t* Bt_, int ldb_, int nM_, int nN_) { A = (const char*)A_; Bt = (const char*)Bt_; lda = lda_; ldb = ldb_; nM = nM_; nN = nN_; nwg = nM * nN; G = gridDim.x; c = blockIdx.x; }
    __device__ __forceinline__ bool next(int i, Unit& u) const {
        const long L = (long)i * G + c; if (L >= nwg) return false;
        int wgid = (int)L; { const int q = nwg / NXCD, r = nwg % NXCD, xcd = wgid % NXCD, off = wgid / NXCD; wgid = (xcd < r ? xcd * (q + 1) : r * (q + 1) + (xcd - r) * q) + off; }
        const int nig = WGM * nN, gid = wgid / nig, fm = gid * WGM, gsz = (nM - fm) < WGM ? (nM - fm) : WGM;
        u.pm = fm + ((wgid % nig) % gsz); u.pn = (wgid % nig) / gsz; u.e = 0; u.nvalid = 256; u.slot0 = 0; return true;
    }
    __device__ __forceinline__ const char* a_base(const Unit& u) const { return A + (size_t)u.pm * 256 * lda * 2; }
    __device__ __forceinline__ const char* b_base(const Unit& u) const { return Bt + (size_t)u.pn * 256 * ldb * 2; }
    __device__ __forceinline__ const PG8_LAS int* glist(int) const { return nullptr; }
};
struct MoeOrder {
    const char* A; const char* W; const PG8_LAS int* tab; const PG8_LAS int* gl; int wrows, nunits;
    __device__ __forceinline__ bool next(int i, Unit& u) const {
        if (i >= nunits) return false;
        const PG8_LAS int* t = tab + i * 8;
        u.pm = t[0]; u.pn = t[1]; u.e = t[2]; u.nvalid = t[3]; u.slot0 = t[4]; return true;
    }
    __device__ __forceinline__ const char* a_base(const Unit& u) const { return A + (size_t)u.slot0 * 2048; }
    __device__ __forceinline__ const char* b_base(const Unit& u) const { return W + ((size_t)u.e * wrows + (size_t)u.pn * 256) * 2048; }
    __device__ __forceinline__ const PG8_LAS int* glist(int i) const { return gl + i * 256; }
};
constexpr int MOE_UNITS_MAX = 16;
__device__ __forceinline__ int moe_build_units(PG8_LAS int* tab, const int* cnt, const int* off, const int* toff, int nN) {
    const int G = gridDim.x, c = blockIdx.x, x = c & 7, j = c >> 3, per = (G >> 3) / nN, nMt = toff[32];
    const int i = threadIdx.x;
    if (i < MOE_UNITS_MAX) {
        const int pn = j % nN, mt = (i * 8 + x) * per + j / nN;
        int e = 0, valid = (mt < nMt && j < per * nN) ? 1 : 0;
        if (valid) { while (toff[e + 1] <= mt) ++e; }
        const int m = mt - toff[e];
        tab[i * 8 + 0] = mt; tab[i * 8 + 1] = pn; tab[i * 8 + 2] = e; tab[i * 8 + 3] = cnt[e] - m * 256; tab[i * 8 + 4] = off[e] + m * 256; tab[i * 8 + 5] = valid;
    }
    __syncthreads();
    int n = 0;
    while (n < MOE_UNITS_MAX && tab[n * 8 + 5]) ++n;
    return n;
}
struct MoeOrderG : MoeOrder { __device__ __forceinline__ const char* a_base(const Unit&) const { return A; } };

__device__ __forceinline__ u32x4 pk8(const f32x4& a, const f32x4& b) { return (u32x4){cvtpk(a[0], a[1]), cvtpk(a[2], a[3]), cvtpk(b[0], b[1]), cvtpk(b[2], b[3])}; }
struct EpiStore {
    static constexpr bool PERM = true;
    bf16_t* C; int ldc; const float* rs;
    __device__ __forceinline__ void operator()(const f32x4 (&acc)[2][2][4][2], const Unit& u, int wr, int wc, int fr, int fq) const {
        bf16_t* base = C + ((size_t)u.pm * 256 + wr * 64 + fr) * ldc + u.pn * 256 + wc * 32 + 8 * fq;
#pragma unroll
        for (int ai = 0; ai < 2; ++ai)
#pragma unroll
            for (int m = 0; m < 4; ++m) { bf16_t* rowp = base + (size_t)(ai * HALF + m * 16) * ldc; const float s = rs ? rs[ai * HALF + wr * 64 + m * 16 + fr] : 1.f;
#pragma unroll
                for (int bj = 0; bj < 2; ++bj) *(u32x4*)(rowp + bj * HALF) = pk8(acc[ai][bj][m][0] * s, acc[ai][bj][m][1] * s); }
    }
};
struct EpiAct {
    static constexpr bool PERM = true;
    bf16_t* Act; const float* b1all;
    __device__ __forceinline__ void operator()(const f32x4 (&acc)[2][2][4][2], const Unit& u, int wr, int wc, int fr, int fq) const {
        const int f0 = u.pn * 128 + wc * 32 + 8 * fq;
        const float* bb = b1all + (size_t)u.e * 2048 + 2 * f0;
        f32x4 bv[4];
#pragma unroll
        for (int q = 0; q < 4; ++q) bv[q] = *(const f32x4*)(bb + 4 * q);
        bf16_t* base = Act + ((size_t)u.slot0 + wr * 64 + fr) * 1024 + f0;
#pragma unroll
        for (int ai = 0; ai < 2; ++ai)
#pragma unroll
            for (int m = 0; m < 4; ++m) {
                const int r = ai * HALF + wr * 64 + m * 16 + fr;
                float a[8];
#pragma unroll
                for (int n = 0; n < 2; ++n)
#pragma unroll
                    for (int j = 0; j < 4; ++j) { const int f = 4 * n + j;
                        float glu = acc[ai][0][m][n][j] + bv[f >> 1][(f & 1) * 2], lin = acc[ai][1][m][n][j] + bv[f >> 1][(f & 1) * 2 + 1];
                        glu = fminf(glu, 7.f); lin = fminf(fmaxf(lin, -7.f), 7.f);
                        a[f] = glu * __builtin_amdgcn_rcpf(1.f + __builtin_amdgcn_exp2f(-1.702f * LOG2E * glu)) * (lin + 1.f); }
                if (r < u.nvalid) *(u32x4*)(base + (size_t)(ai * HALF + m * 16) * 1024) = (u32x4){cvtpk(a[0], a[1]), cvtpk(a[2], a[3]), cvtpk(a[4], a[5]), cvtpk(a[6], a[7])};
            }
    }
};
struct EpiBias {
    static constexpr bool PERM = true;
    bf16_t* Y; const float* b2all;
    __device__ __forceinline__ void operator()(const f32x4 (&acc)[2][2][4][2], const Unit& u, int wr, int wc, int fr, int fq) const {
        const int c0 = u.pn * 256 + wc * 32 + 8 * fq;
        const float* bb = b2all + (size_t)u.e * 1024 + c0;
        f32x4 bv[2][2];
#pragma unroll
        for (int bj = 0; bj < 2; ++bj)
#pragma unroll
            for (int n = 0; n < 2; ++n) bv[bj][n] = *(const f32x4*)(bb + bj * HALF + 4 * n);
        bf16_t* base = Y + ((size_t)u.slot0 + wr * 64 + fr) * 1024 + c0;
#pragma unroll
        for (int ai = 0; ai < 2; ++ai)
#pragma unroll
            for (int m = 0; m < 4; ++m) { const int r = ai * HALF + wr * 64 + m * 16 + fr;
                if (r < u.nvalid) {
#pragma unroll
                    for (int bj = 0; bj < 2; ++bj) *(u32x4*)(base + (size_t)(ai * HALF + m * 16) * 1024 + bj * HALF) = pk8(acc[ai][bj][m][0] + bv[bj][0], acc[ai][bj][m][1] + bv[bj][1]); } }
    }
};
}

__device__ __forceinline__ u32x4 pack8(const float (&v)[8]) { return (u32x4){cvtpk(v[0], v[1]), cvtpk(v[2], v[3]), cvtpk(v[4], v[5]), cvtpk(v[6], v[7])}; }
struct EpiPlain {
    static constexpr bool MOE1 = false;
    bf16_t* C; int ldc;
    __device__ __forceinline__ void row8(int r, int c, const float (&v)[8]) const { *(u32x4*)(C + (size_t)r * ldc + c) = pack8(v); }
    __device__ __forceinline__ void pair(int, int, const float (&)[8], const float (&)[8]) const {}
};
struct EpiRowScale {
    static constexpr bool MOE1 = false;
    bf16_t* C; int ldc; const float* rs;
    __device__ __forceinline__ void row8(int r, int c, const float (&v)[8]) const { const float s = rs[r]; float w[8];
#pragma unroll
        for (int i = 0; i < 8; ++i) w[i] = v[i] * s;
        *(u32x4*)(C + (size_t)r * ldc + c) = pack8(w); }
    __device__ __forceinline__ void pair(int, int, const float (&)[8], const float (&)[8]) const {}
};
__device__ __forceinline__ void phase_gemm_plain(const bf16_t* A, int lda, const bf16_t* Bt, int K, bf16_t* C, int ldc, int nM, int nN) {
    const int G = gridDim.x;
    for (int u = blockIdx.x; u < nM * nN; u += G) {
        const int pm = u / nN, pn = u % nN;
        int aoff[2][2], boff[2];
        gm::make_off(aoff, pm * 256, lda); gm::make_off1(boff, pn * 128, K);
        EpiPlain epi{C + (size_t)pm * 256 * ldc + pn * 128, ldc};
        gm::gemm_tile(A, aoff, Bt, boff, K / 64, epi);
    }
}

struct Row16 { float4 v[4]; };
__device__ __forceinline__ Row16 ld_row_f32(const float* p, int lane) { Row16 r;
#pragma unroll
    for (int i = 0; i < 4; ++i) r.v[i] = *(const float4*)(p + lane * 4 + 256 * i);
    return r; }
__device__ __forceinline__ Row16 ld_row_bf16(const bf16_t* p, int lane) { Row16 r;
#pragma unroll
    for (int i = 0; i < 4; ++i) { const u32x2 w = *(const u32x2*)(p + lane * 4 + 256 * i);
        r.v[i] = make_float4(__uint_as_float(w.x << 16), __uint_as_float(w.x & 0xFFFF0000u), __uint_as_float(w.y << 16), __uint_as_float(w.y & 0xFFFF0000u)); }
    return r; }
__device__ __forceinline__ void st_row_f32(float* p, int lane, const Row16& r) {
#pragma unroll
    for (int i = 0; i < 4; ++i) *(float4*)(p + lane * 4 + 256 * i) = r.v[i]; }
__device__ __forceinline__ void st_row_bf16(bf16_t* p, int lane, const Row16& r) {
#pragma unroll
    for (int i = 0; i < 4; ++i) { u32x2 w; w.x = cvtpk(r.v[i].x, r.v[i].y); w.y = cvtpk(r.v[i].z, r.v[i].w); *(u32x2*)(p + lane * 4 + 256 * i) = w; } }
__device__ __forceinline__ float row_rstd(const Row16& r) {
    float s = 0.f;
#pragma unroll
    for (int i = 0; i < 4; ++i) s += r.v[i].x * r.v[i].x + r.v[i].y * r.v[i].y + r.v[i].z * r.v[i].z + r.v[i].w * r.v[i].w;
    s = wave_sum(s);
    return rsqrtf(s * (1.f / 1024.f) + EPSN);
}
__device__ __forceinline__ Row16 norm_mod(const Row16& x, float rstd, const float* g, const float* sc, const float* sh, int lane) {
    Row16 h;
#pragma unroll
    for (int i = 0; i < 4; ++i) {
        const int c = lane * 4 + 256 * i;
        const float4 gv = *(const float4*)(g + c), scv = *(const float4*)(sc + c), shv = *(const float4*)(sh + c);
        h.v[i].x = x.v[i].x * rstd * gv.x * (1.f + scv.x) + shv.x; h.v[i].y = x.v[i].y * rstd * gv.y * (1.f + scv.y) + shv.y;
        h.v[i].z = x.v[i].z * rstd * gv.z * (1.f + scv.z) + shv.z; h.v[i].w = x.v[i].w * rstd * gv.w * (1.f + scv.w) + shv.w;
    }
    return h;
}
__device__ __forceinline__ Row16 resid_add(const Row16& x, const Row16& y, float rstd, const float* g, const float* gate, int lane) {
    Row16 o;
#pragma unroll
    for (int i = 0; i < 4; ++i) {
        const int c = lane * 4 + 256 * i;
        const float4 gv = *(const float4*)(g + c), ga = *(const float4*)(gate + c);
        o.v[i].x = x.v[i].x + y.v[i].x * rstd * gv.x * ga.x; o.v[i].y = x.v[i].y + y.v[i].y * rstd * gv.y * ga.y;
        o.v[i].z = x.v[i].z + y.v[i].z * rstd * gv.z * ga.z; o.v[i].w = x.v[i].w + y.v[i].w * rstd * gv.w * ga.w;
    }
    return o;
}
__device__ __forceinline__ const float* mod_ptr(const Params& p, int l, int r) { return (const float*)(p.ws + WS_MOD) + (size_t)(l * 2 + (r < CTXN ? 1 : 0)) * 6144; }
__device__ __forceinline__ const float* src_row(const Params& p, int r) { return r < CTXN ? p.ctx + (size_t)r * 1024 : p.x + (size_t)(r - CTXN) * 1024; }

struct ModAB { float4 a[4], b[4]; };
struct ModG { float4 g[4]; };
__device__ __forceinline__ ModAB load_ab(const float* g, const float* sc, const float* sh, int lane) { ModAB m;
#pragma unroll
    for (int i = 0; i < 4; ++i) { const int c = lane * 4 + 256 * i; const float4 gv = *(const float4*)(g + c), sv = *(const float4*)(sc + c); m.b[i] = *(const float4*)(sh + c);
        m.a[i] = make_float4(gv.x * (1.f + sv.x), gv.y * (1.f + sv.y), gv.z * (1.f + sv.z), gv.w * (1.f + sv.w)); }
    return m; }
__device__ __forceinline__ ModG load_g(const float* g, const float* gate, int lane) { ModG m;
#pragma unroll
    for (int i = 0; i < 4; ++i) { const int c = lane * 4 + 256 * i; const float4 gv = *(const float4*)(g + c), ga = *(const float4*)(gate + c); m.g[i] = make_float4(gv.x * ga.x, gv.y * ga.y, gv.z * ga.z, gv.w * ga.w); }
    return m; }
__device__ __forceinline__ Row16 apply_ab(const Row16& x, float rstd, const ModAB& m) { Row16 h;
#pragma unroll
    for (int i = 0; i < 4; ++i) h.v[i] = make_float4(x.v[i].x * rstd * m.a[i].x + m.b[i].x, x.v[i].y * rstd * m.a[i].y + m.b[i].y, x.v[i].z * rstd * m.a[i].z + m.b[i].z, x.v[i].w * rstd * m.a[i].w + m.b[i].w);
    return h; }
__device__ __forceinline__ Row16 apply_g(const Row16& x, const Row16& y, float rstd, const ModG& m) { Row16 o;
#pragma unroll
    for (int i = 0; i < 4; ++i) o.v[i] = make_float4(x.v[i].x + y.v[i].x * rstd * m.g[i].x, x.v[i].y + y.v[i].y * rstd * m.g[i].y, x.v[i].z + y.v[i].z * rstd * m.g[i].z, x.v[i].w + y.v[i].w * rstd * m.g[i].w);
    return o; }
struct RowB8 { u32x2 v[4]; };
__device__ __forceinline__ RowB8 ld_rowb(const bf16_t* p, int lane) { RowB8 r;
#pragma unroll
    for (int i = 0; i < 4; ++i) r.v[i] = *(const u32x2*)(p + lane * 4 + 256 * i);
    return r; }
__device__ __forceinline__ Row16 cvt_rowb(const RowB8& b) { Row16 r;
#pragma unroll
    for (int i = 0; i < 4; ++i) r.v[i] = make_float4(__uint_as_float(b.v[i].x << 16), __uint_as_float(b.v[i].x & 0xFFFF0000u), __uint_as_float(b.v[i].y << 16), __uint_as_float(b.v[i].y & 0xFFFF0000u));
    return r; }

__device__ __forceinline__ void phase_norm1_l0(const Params& p) {
    const int lane = threadIdx.x & 63, wave = threadIdx.x >> 6, G = gridDim.x, step = G * 8;
    bf16_t* HB = (bf16_t*)(p.ws + WS_HB);
    int r = blockIdx.x * 8 + wave;
    if (r >= NTOK) return;
    int cur_s = (r < CTXN) ? 1 : 0;
    const float* mod = mod_ptr(p, 0, r);
    ModAB m = load_ab(p.norm_g, mod + 1024, mod, lane);
    Row16 x = ld_row_f32(src_row(p, r), lane);
    for (; r < NTOK; r += step) {
        const int rn = r + step;
        Row16 xn = x;
        if (rn < NTOK) xn = ld_row_f32(src_row(p, rn), lane);
        const int s_ = (r < CTXN) ? 1 : 0;
        if (s_ != cur_s) { cur_s = s_; const float* md = mod_ptr(p, 0, r); m = load_ab(p.norm_g, md + 1024, md, lane); }
        const float rstd = row_rstd(x);
        st_row_bf16(HB + (size_t)r * 1024, lane, apply_ab(x, rstd, m));
        x = xn;
    }
}

__device__ __forceinline__ void phase_mid(const Params& p, int l) {
    const int tid = tid_opaque(), lane = tid & 63, wave = tid >> 6, G = gridDim.x;
    float* wT = (float*)smem;
    int* lcnt = (int*)(smem + 139264);
    int* lbase = lcnt + 32;
    int* sel = lbase + 32;
    {
        const float4* src = (const float4*)((const float*)(p.ws + WS_RWT) + (size_t)l * 32 * 1024);
        for (int i = tid; i < 32 * 1024 / 4; i += NTH) ((float4*)wT)[i] = src[i];
        if (tid < 32) lcnt[tid] = 0;
    }
    __syncthreads();
    const int r_begin = (l == 0) ? 0 : CTXN;
    bf16_t* HB = (bf16_t*)(p.ws + WS_HB); const bf16_t* OB = (const bf16_t*)(p.ws + WS_OB);
    float* X1 = (float*)(p.ws + WS_X1); const float* X2 = (const float*)(p.ws + WS_X2);
    const float* ng = p.norm_g + (size_t)l * 4 * 1024;
    const float* rb = p.router_b + l * 32;
    float* GATE = (float*)(p.ws + WS_GATE);
    int it = 0;
    int r = r_begin + blockIdx.x * 8 + wave;
    const int step = G * 8;
    int cur_s = -1; ModG mg; ModAB mab;
    Row16 xin; RowB8 ob;
    if (r < NTOK) { xin = (l == 0) ? ld_row_f32(src_row(p, r), lane) : ld_row_f32(X2 + (size_t)r * 1024, lane); ob = ld_rowb(OB + (size_t)r * 1024, lane); }
    for (; r < NTOK; r += step, ++it) {
        const int rn = r + step;
        Row16 xin_n = xin; RowB8 ob_n = ob;
        if (rn < NTOK) { xin_n = (l == 0) ? ld_row_f32(src_row(p, rn), lane) : ld_row_f32(X2 + (size_t)rn * 1024, lane); ob_n = ld_rowb(OB + (size_t)rn * 1024, lane); }
        const int s_ = (r < CTXN) ? 1 : 0;
        if (s_ != cur_s) { cur_s = s_; const float* mod = mod_ptr(p, l, r); mg = load_g(ng + 1024, mod + 2048, lane); mab = load_ab(ng + 2048, mod + 4096, mod + 3072, lane); }
        const Row16 o = cvt_rowb(ob);
        const float rso = row_rstd(o);
        const Row16 x1 = apply_g(xin, o, rso, mg);
        st_row_f32(X1 + (size_t)r * 1024, lane, x1);
        const float rs1 = row_rstd(x1);
        const Row16 h = apply_ab(x1, rs1, mab);
        st_row_bf16(HB + (size_t)r * 1024, lane, h);
        xin = xin_n; ob = ob_n;
        float part[32];
        {
            const float* wl = wT + lane * 4;
            float4 wa[4], wb[4];
#pragma unroll
            for (int i = 0; i < 4; ++i) wa[i] = *(const float4*)(wl + 256 * i);
#pragma unroll
            for (int e = 0; e < 32; e += 2) {
#pragma unroll
                for (int i = 0; i < 4; ++i) wb[i] = *(const float4*)(wl + (e + 1) * 1024 + 256 * i);
                { float a = 0.f;
#pragma unroll
                  for (int i = 0; i < 4; ++i) a += h.v[i].x * wa[i].x + h.v[i].y * wa[i].y + h.v[i].z * wa[i].z + h.v[i].w * wa[i].w;
                  part[e] = a; }
                if (e + 2 < 32) {
#pragma unroll
                    for (int i = 0; i < 4; ++i) wa[i] = *(const float4*)(wl + (e + 2) * 1024 + 256 * i);
                }
                { float a = 0.f;
#pragma unroll
                  for (int i = 0; i < 4; ++i) a += h.v[i].x * wb[i].x + h.v[i].y * wb[i].y + h.v[i].z * wb[i].z + h.v[i].w * wb[i].w;
                  part[e + 1] = a; }
            }
        }
#define TR_STEP(NV, BIT) _Pragma("unroll") for (int i = 0; i < (NV) / 2; ++i) { const float lo = part[i], hi_ = part[i + (NV) / 2]; const bool up = (lane & (BIT)) != 0; \
            const float send = up ? lo : hi_, keep = up ? hi_ : lo; part[i] = keep + __shfl_xor(send, (BIT)); }
        TR_STEP(32, 32) TR_STEP(16, 16) TR_STEP(8, 8) TR_STEP(4, 4) TR_STEP(2, 2)
#undef TR_STEP
        float logit = part[0] + __shfl_xor(part[0], 1);
        const int myexp = lane >> 1;
        logit += rb[myexp];
        float val = (lane & 1) ? -3.0e38f : logit;
        float tv[4]; int ti[4];
#pragma unroll
        for (int k = 0; k < 4; ++k) {
            float bv = val; int bi = myexp;
#pragma unroll
            for (int off = 32; off >= 1; off >>= 1) { const float ov = __shfl_xor(bv, off); const int oi = __shfl_xor(bi, off); if (ov > bv || (ov == bv && oi < bi)) { bv = ov; bi = oi; } }
            tv[k] = bv; ti[k] = bi;
            if (myexp == bi) val = -3.0e38f;
        }
        const float e1 = __expf(tv[1] - tv[0]), e2 = __expf(tv[2] - tv[0]), e3 = __expf(tv[3] - tv[0]);
        const float inv = 1.f / (1.f + e1 + e2 + e3);
        if (lane < 4) {
            const int k = lane;
            const int e = (k == 0) ? ti[0] : (k == 1) ? ti[1] : (k == 2) ? ti[2] : ti[3];
            const float gk = ((k == 0) ? 1.f : (k == 1) ? e1 : (k == 2) ? e2 : e3) * inv;
            GATE[(size_t)r * 4 + k] = gk;
            const int lp = atomicAdd(&lcnt[e], 1);
            sel[(it * 8 + wave) * 4 + k] = e | (lp << 8);
        }
    }
    __syncthreads();
    int* CNT = (int*)(p.ws + WS_CNT) + l * 32;
    if (tid < 32) lbase[tid] = atomicAdd(&CNT[tid], lcnt[tid]);
    __syncthreads();
    {
        int* TOPE = (int*)(p.ws + WS_TOPE); int* TOPP = (int*)(p.ws + WS_TOPP); int* LIST = (int*)(p.ws + WS_LIST);
        for (int q = tid; q < 80 * 4; q += NTH) {
            const int slot = q >> 2, k = q & 3, itq = slot >> 3, wv = slot & 7;
            const int r = r_begin + blockIdx.x * 8 + wv + itq * G * 8;
            if (r < NTOK) {
                const int s = sel[q], e = s & 255, lp = s >> 8, pos = lbase[e] + lp;
                TOPE[(size_t)r * 4 + k] = e; TOPP[(size_t)r * 4 + k] = pos; LIST[(size_t)e * NTOK + pos] = r;
            }
        }
    }
    __syncthreads();
}

struct MoeLds { int* cnt; int* off; int* toff; };
__device__ __forceinline__ MoeLds moe_setup(const Params& p, int l, char* base) {
    MoeLds m; m.cnt = (int*)base; m.off = m.cnt + 32; m.toff = m.off + 33;
    const int tid = tid_opaque();
    if (tid < 64) {
        const int e = tid & 31;
        const int cval = ((const int*)(p.ws + WS_CNT))[l * 32 + e];
        const int tiles = (cval + 255) >> 8;
        int pc = cval, pt = tiles;
#pragma unroll
        for (int o = 1; o < 32; o <<= 1) { const int a = __shfl_up(pc, o, 32), b = __shfl_up(pt, o, 32); if (e >= o) { pc += a; pt += b; } }
        if (tid < 32) { m.cnt[e] = cval; m.off[e + 1] = pc; m.toff[e + 1] = pt; if (e == 0) { m.off[0] = 0; m.toff[0] = 0; } }
    }
    __syncthreads();
    return m;
}

__device__ __forceinline__ void phase_end(const Params& p, int l) {
    const int tid = tid_opaque(), lane = tid & 63, wave = tid >> 6, G = gridDim.x;
    MoeLds ml = moe_setup(p, l, smem);
    const int r_begin = (l == 0) ? 0 : CTXN;
    const bf16_t* YB = (const bf16_t*)(p.ws + WS_YB);
    const float* X1 = (const float*)(p.ws + WS_X1); float* X2 = (float*)(p.ws + WS_X2);
    bf16_t* HB = (bf16_t*)(p.ws + WS_HB);
    const int* TOPE = (const int*)(p.ws + WS_TOPE); const int* TOPP = (const int*)(p.ws + WS_TOPP); const float* GATE = (const float*)(p.ws + WS_GATE);
    const float* ng = p.norm_g + (size_t)l * 4 * 1024;
    int cur_s = -1; ModG mg; ModAB mab;
    int r = r_begin + blockIdx.x * 8 + wave;
    int4 en = make_int4(0, 0, 0, 0), pn = make_int4(0, 0, 0, 0); float4 gn = make_float4(0.f, 0.f, 0.f, 0.f);
    const int step = G * 8;
    if (r < NTOK) { en = *(const int4*)(TOPE + (size_t)r * 4); pn = *(const int4*)(TOPP + (size_t)r * 4); gn = *(const float4*)(GATE + (size_t)r * 4); }
    RowB8 t4n[4]; Row16 x1n; float4 gcur = gn;
    if (r < NTOK) {
        t4n[0] = ld_rowb(YB + (size_t)(ml.off[en.x] + pn.x) * 1024, lane); t4n[1] = ld_rowb(YB + (size_t)(ml.off[en.y] + pn.y) * 1024, lane);
        t4n[2] = ld_rowb(YB + (size_t)(ml.off[en.z] + pn.z) * 1024, lane); t4n[3] = ld_rowb(YB + (size_t)(ml.off[en.w] + pn.w) * 1024, lane);
        x1n = ld_row_f32(X1 + (size_t)r * 1024, lane);
        if (r + step < NTOK) { en = *(const int4*)(TOPE + (size_t)(r + step) * 4); pn = *(const int4*)(TOPP + (size_t)(r + step) * 4); gn = *(const float4*)(GATE + (size_t)(r + step) * 4); }
    }
    for (; r < NTOK; r += step) {
        RowB8 t4[4]; t4[0] = t4n[0]; t4[1] = t4n[1]; t4[2] = t4n[2]; t4[3] = t4n[3];
        const Row16 x1 = x1n;
        const float g4[4] = {gcur.x, gcur.y, gcur.z, gcur.w};
        const int rn = r + step;
        if (rn < NTOK) {
            t4n[0] = ld_rowb(YB + (size_t)(ml.off[en.x] + pn.x) * 1024, lane); t4n[1] = ld_rowb(YB + (size_t)(ml.off[en.y] + pn.y) * 1024, lane);
            t4n[2] = ld_rowb(YB + (size_t)(ml.off[en.z] + pn.z) * 1024, lane); t4n[3] = ld_rowb(YB + (size_t)(ml.off[en.w] + pn.w) * 1024, lane);
            x1n = ld_row_f32(X1 + (size_t)rn * 1024, lane);
            gcur = gn;
            if (rn + step < NTOK) { en = *(const int4*)(TOPE + (size_t)(rn + step) * 4); pn = *(const int4*)(TOPP + (size_t)(rn + step) * 4); gn = *(const float4*)(GATE + (size_t)(rn + step) * 4); }
        }
        const int s_ = (r < CTXN) ? 1 : 0;
        if (s_ != cur_s) { cur_s = s_; const float* mod = mod_ptr(p, l, r); mg = load_g(ng + 3072, mod + 5120, lane);
            if (l == 0) { const float* mod1 = mod_ptr(p, 1, r); mab = load_ab(p.norm_g + (size_t)4 * 1024, mod1 + 1024, mod1, lane); } }
        Row16 y;
#pragma unroll
        for (int i = 0; i < 4; ++i) y.v[i] = make_float4(0.f, 0.f, 0.f, 0.f);
#pragma unroll
        for (int k = 0; k < 4; ++k) { const Row16 t = cvt_rowb(t4[k]); const float gk = g4[k];
#pragma unroll
            for (int i = 0; i < 4; ++i) { y.v[i].x += gk * t.v[i].x; y.v[i].y += gk * t.v[i].y; y.v[i].z += gk * t.v[i].z; y.v[i].w += gk * t.v[i].w; } }
        const float rsy = row_rstd(y);
        const Row16 x2 = apply_g(x1, y, rsy, mg);
        if (l == 0) {
            st_row_f32(X2 + (size_t)r * 1024, lane, x2);
            const float rs2 = row_rstd(x2);
            st_row_bf16(HB + (size_t)r * 1024, lane, apply_ab(x2, rs2, mab));
        } else {
            st_row_f32(p.out + (size_t)(r - CTXN) * 1024, lane, x2);
        }
    }
    __syncthreads();
}

__device__ __forceinline__ void phase_gemm_pg8(const bf16_t* A, int lda, const bf16_t* Bt, int K, bf16_t* C, int ldc, int nM, int nN) {
    pg8::PlainOrder S; S.init(A, lda, Bt, K, nM, nN);
    pg8::EpiStore E{C, ldc, nullptr};
    pg8::gemm_phase<pg8::EpiStore, pg8::PlainOrder, false>((PG8_LAS unsigned char*)smem, S, E, K, lda, K);
    __syncthreads();
}
constexpr int MOE_GL_OFF = 131072, MOE_ML_OFF = 143360, MOE_TAB_OFF = 143872, MOE_GL_MAX = 12;
__device__ __forceinline__ void phase_moe1(const Params& p, int l) {
    MoeLds ml = moe_setup(p, l, smem + MOE_ML_OFF);
    const int tid = tid_opaque();
    PG8_LAS int* gl = (PG8_LAS int*)(smem + MOE_GL_OFF);
    PG8_LAS int* tab = (PG8_LAS int*)(smem + MOE_TAB_OFF);
    pg8::MoeOrderG S;
    S.A = (const char*)(p.ws + WS_HB); S.W = (const char*)(p.ws + WS_W1T) + (size_t)l * 32 * 2048 * 2048;
    S.tab = tab; S.gl = gl; S.wrows = 2048;
    S.nunits = pg8::moe_build_units(tab, ml.cnt, ml.off, ml.toff, 8);
    if (S.nunits > MOE_GL_MAX) S.nunits = MOE_GL_MAX;
    const int* LIST = (const int*)(p.ws + WS_LIST);
    for (int i = 0; i < S.nunits; ++i) {
        const int e = tab[i * 8 + 2], mt = tab[i * 8 + 0], nvalid = tab[i * 8 + 3], m = mt - ml.toff[e];
        if (tid < 256) gl[i * 256 + tid] = (tid < nvalid) ? LIST[(size_t)e * NTOK + m * 256 + tid] : 0;
    }
    __syncthreads();
    pg8::EpiAct E{(bf16_t*)(p.ws + WS_ACT), p.moe_b1 + (size_t)l * 32 * 2048};
    pg8::gemm_phase<pg8::EpiAct, pg8::MoeOrderG, true>((PG8_LAS unsigned char*)smem, S, E, 1024, 1024, 1024);
    __syncthreads();
}
__device__ __forceinline__ void phase_moe2(const Params& p, int l) {
    MoeLds ml = moe_setup(p, l, smem + MOE_ML_OFF);
    PG8_LAS int* tab = (PG8_LAS int*)(smem + MOE_TAB_OFF);
    pg8::MoeOrder S;
    S.A = (const char*)(p.ws + WS_ACT); S.W = (const char*)(p.ws + WS_W2T) + (size_t)l * 32 * 1024 * 2048;
    S.tab = tab; S.gl = nullptr; S.wrows = 1024;
    S.nunits = pg8::moe_build_units(tab, ml.cnt, ml.off, ml.toff, 4);
    pg8::EpiBias E{(bf16_t*)(p.ws + WS_YB), p.moe_b2 + (size_t)l * 32 * 1024};
    pg8::gemm_phase<pg8::EpiBias, pg8::MoeOrder, false>((PG8_LAS unsigned char*)smem, S, E, 1024, 1024, 1024);
    __syncthreads();
}

__device__ __forceinline__ void gla_local_units(const Params& p);
__device__ __forceinline__ void rope8(const float* rope, int t, int j0, const u32x4& a, const u32x4& b, u32x4& oa, u32x4& ob);
__device__ __forceinline__ void rowstat(const bf16_t* A, int lda, int K, float* rs) {
    const int tid = tid_opaque(), r = tid >> 1, hf = tid & 1, half = K / 2;
    const bf16_t* q = A + (size_t)r * lda + hf * half;
    float s = 0.f;
    for (int i = 0; i < half; i += 8) { const u32x4 w = *(const u32x4*)(q + i);
#pragma unroll
        for (int j = 0; j < 4; ++j) { const float a = __uint_as_float(w[j] << 16), b = __uint_as_float(w[j] & 0xFFFF0000u); s += a * a + b * b; } }
    s += __shfl_xor(s, 1);
    if (hf == 0) rs[r] = rsqrtf(s / (float)K + EPSN);
    __syncthreads();
}
__device__ __forceinline__ void phase_mla_up(const Params& p) {
    const int G = gridDim.x, tid = threadIdx.x;
    const bf16_t* P = (const bf16_t*)(p.ws + WS_P);
    float* rs = (float*)(smem + 139264);
    const int nM = NTOK / 256;
    {
        pg8::PlainOrder S; S.init(P + PC_CQ, PW, (const bf16_t*)(p.ws + WS_WUQ), 256, nM, 3);
        pg8::Unit u;
        if (S.next(0, u)) rowstat(P + (size_t)u.pm * 256 * PW + PC_CQ, PW, 256, rs);
        pg8::EpiStore E{(bf16_t*)(p.ws + WS_QM), 768, rs};
        pg8::gemm_phase<pg8::EpiStore, pg8::PlainOrder, false>((PG8_LAS unsigned char*)smem, S, E, 256, PW, 256);
        __syncthreads();
    }
    for (int v = (blockIdx.x + G - 195) % G; v < nM * 8; v += G) {
        int aoff[2][2], boff[2];
        const int pm = v >> 3, pn = v & 7, h = pn >> 1;
        rowstat(P + (size_t)pm * 256 * PW + PC_CKV, PW, 128, rs);
        gm::make_off(aoff, pm * 256, PW); gm::make_off1(boff, pn * 128, 128);
        bf16_t* dst = (pn & 1) ? (bf16_t*)(p.ws + WS_VM) + (size_t)pm * 256 * 512 + h * 128 : (bf16_t*)(p.ws + WS_KM) + (size_t)pm * 256 * 768 + h * 192;
        EpiRowScale epi{dst, (pn & 1) ? 512 : 768, rs};
        gm::gemm_tile(P + PC_CKV, aoff, (const bf16_t*)(p.ws + WS_WUKV), boff, 2, epi);
    }
    const float* rope = (const float*)(p.ws + WS_ROPE);
    bf16_t* KM = (bf16_t*)(p.ws + WS_KM);
    for (int i = blockIdx.x * NTH + tid; i < NTOK * 4; i += G * NTH) {
        const int r = i >> 2, j0 = (i & 3) * 8;
        const u32x4 a = *(const u32x4*)(P + (size_t)r * PW + PC_KR + j0), b = *(const u32x4*)(P + (size_t)r * PW + PC_KR + 32 + j0);
        u32x4 oa = a, ob = b;
        if (r >= CTXN) rope8(rope, r - CTXN, j0, a, b, oa, ob);
#pragma unroll
        for (int h = 0; h < 4; ++h) { *(u32x4*)(KM + (size_t)r * 768 + h * 192 + 128 + j0) = oa; *(u32x4*)(KM + (size_t)r * 768 + h * 192 + 160 + j0) = ob; }
    }
    __syncthreads();
    gla_local_units(p);
}

struct GlaB { float b[16]; float total; };
__device__ __forceinline__ GlaB gla_decay(const Params& p, int gc, int h, float* scr  ) {
    const int tid = threadIdx.x, lane = tid & 63, wave = tid >> 6, dir = wave & 1, tq = wave >> 1;
    const bf16_t* P = (const bf16_t*)(p.ws + WS_P);
    float* af = scr;
    float* wa = scr + 2048;
    float* ba = scr + 4096;
    float* tot = scr + 4224;
#pragma unroll
    for (int i = 0; i < 4; ++i) {
        const int idx = tid + 512 * i, dd = idx >> 10, t = (idx >> 4) & 63, j = idx & 15;
        af[idx] = bf2f(P[(size_t)(gc * 64 + t) * PW + PC_AF + dd * 16 + j]);
        const int jj = (idx >> 6) & 15, d = idx & 63;
        wa[idx] = (dd == 0 ? p.gla_wa_f : p.gla_wa_b)[jj * 256 + h * 64 + d];
    }
    if (tid < 128) ba[tid] = ((tid >> 6) == 0 ? p.gla_ba_f : p.gla_ba_b)[h * 64 + (tid & 63)];
    __syncthreads();
    float w[16];
#pragma unroll
    for (int j = 0; j < 16; ++j) w[j] = wa[(dir * 16 + j) * 64 + lane];
    const float bias = ba[dir * 64 + lane];
    GlaB r;
#pragma unroll
    for (int i = 0; i < 16; ++i) {
        const int t = tq * 16 + i;
        float z = bias;
#pragma unroll
        for (int j = 0; j < 16; ++j) z += af[(dir * 64 + t) * 16 + j] * w[j];
        const float g = (fminf(z, 0.f) - __logf(1.f + __expf(-fabsf(z)))) * (1.f / 16.f);
        r.b[i] = g;
    }
    if (dir == 0) {
#pragma unroll
        for (int i = 1; i < 16; ++i) r.b[i] += r.b[i - 1];
        tot[(dir * 4 + tq) * 64 + lane] = r.b[15];
    } else {
#pragma unroll
        for (int i = 14; i >= 0; --i) r.b[i] += r.b[i + 1];
        tot[(dir * 4 + tq) * 64 + lane] = r.b[0];
    }
    __syncthreads();
    float offs = 0.f, total = 0.f;
#pragma unroll
    for (int q = 0; q < 4; ++q) { const float tv = tot[(dir * 4 + q) * 64 + lane]; total += tv; if (dir == 0 ? (q < tq) : (q > tq)) offs += tv; }
#pragma unroll
    for (int i = 0; i < 16; ++i) r.b[i] += offs;
    r.total = total;
    return r;
}

__device__ __forceinline__ void gla_stage_vt(const bf16_t* P, int gc, int h, bf16_t* VT) {
    const int tid = threadIdx.x, v = tid & 127, sq = tid >> 7;
    unsigned pk[8];
#pragma unroll
    for (int i = 0; i < 8; ++i) {
        const bf16_t a = P[(size_t)(gc * 64 + sq * 16 + 2 * i) * PW + PC_V + h * 128 + v], b = P[(size_t)(gc * 64 + sq * 16 + 2 * i + 1) * PW + PC_V + h * 128 + v];
        pk[i] = a | ((unsigned)b << 16);
    }
    *(u32x4*)(VT + v * 72 + sq * 16) = (u32x4){pk[0], pk[1], pk[2], pk[3]};
    *(u32x4*)(VT + v * 72 + sq * 16 + 8) = (u32x4){pk[4], pk[5], pk[6], pk[7]};
}

struct GlaPreL { u32x4 kc, vc[2], ac; float4 wac; float bac; };
__device__ __forceinline__ void gla_prefetch_local(const Params& p, int gc, int h, GlaPreL& g) {
    const int tid = threadIdx.x;
    const bf16_t* P = (const bf16_t*)(p.ws + WS_P);
    g.kc = *(const u32x4*)(P + (size_t)(gc * 64 + (tid >> 3)) * PW + PC_K + h * 64 + (tid & 7) * 8);
#pragma unroll
    for (int i = 0; i < 2; ++i) { const int idx = tid + 512 * i; g.vc[i] = *(const u32x4*)(P + (size_t)(gc * 64 + (idx >> 4)) * PW + PC_V + h * 128 + (idx & 15) * 8); }
    g.ac = *(const u32x4*)(P + (size_t)(gc * 64 + ((tid & 255) >> 2)) * PW + PC_AF + (tid & 3) * 8);
    { const int dd = tid >> 8, jj = (tid >> 4) & 15, d4 = tid & 15; g.wac = *(const float4*)((dd == 0 ? p.gla_wa_f : p.gla_wa_b) + jj * 256 + h * 64 + d4 * 4); }
    g.bac = ((tid >> 6) & 1 ? p.gla_ba_b : p.gla_ba_f)[h * 64 + (tid & 63)];
}
template <int OFF> __device__ __forceinline__ s16x4 glal_tr(int vb) { s16x4 r; asm volatile("ds_read_b64_tr_b16 %0, %1 offset:%2" : "=&v"(r) : "v"(vb), "i"(OFF) : "memory"); return r; }
__device__ __forceinline__ void gla_local_units(const Params& p) {
    const int tid = threadIdx.x, lane = tid & 63, wave = tid >> 6, r32 = lane & 31, hi = lane >> 5, G = gridDim.x;
    bf16_t* kdT = (bf16_t*)smem;
    bf16_t* Kraw = kdT + 2 * 64 * 72;
    char* Vraw = smem + 27648;
    float* af = (float*)(smem + 49152);
    float* wa = af + 2048; float* ba = wa + 2048; float* tot = ba + 128;
    bf16_t* U = (bf16_t*)(p.ws + WS_U); float* DEC = (float*)(p.ws + WS_DEC);
    int u = blockIdx.x;
    if (u >= NCH * 4) return;
    GlaPreL g;
    gla_prefetch_local(p, u >> 2, u & 3, g);
    const int dir = wave & 1, tq = wave >> 1;
    for (; u < NCH * 4; u += G) {
        const int gc = u >> 2, h = u & 3;
        *(u32x4*)(Kraw + (tid >> 3) * 72 + (tid & 7) * 8) = g.kc;
#pragma unroll
        for (int i = 0; i < 2; ++i) { const int idx = tid + 512 * i; *(u32x4*)(Vraw + (idx >> 4) * 320 + (idx & 15) * 16) = g.vc[i]; }
        if (tid < 256) { const int t = tid >> 2, ch = tid & 3, dd = ch >> 1, j0 = (ch & 1) * 8; float* q = af + dd * 1024 + t * 16 + j0;
#pragma unroll
            for (int e = 0; e < 4; ++e) { q[2 * e] = __uint_as_float(g.ac[e] << 16); q[2 * e + 1] = __uint_as_float(g.ac[e] & 0xFFFF0000u); } }
        { const int dd = tid >> 8, jj = (tid >> 4) & 15, d4 = tid & 15; *(float4*)(wa + (dd * 16 + jj) * 64 + d4 * 4) = g.wac; }
        if (tid < 128) ba[tid] = g.bac;
        __syncthreads();
        const int un = u + G;
        if (un < NCH * 4) gla_prefetch_local(p, un >> 2, un & 3, g);
        float bb[16]; float total = 0.f;
        {
            float w[16];
#pragma unroll
            for (int j = 0; j < 16; ++j) w[j] = wa[(dir * 16 + j) * 64 + lane];
            const float bias = ba[dir * 64 + lane];
#pragma unroll
            for (int i = 0; i < 16; ++i) {
                const int t = tq * 16 + i;
                float z = bias;
#pragma unroll
                for (int j = 0; j < 16; ++j) z += af[(dir * 64 + t) * 16 + j] * w[j];
                bb[i] = (fminf(z, 0.f) - __logf(1.f + __expf(-fabsf(z)))) * (1.f / 16.f);
            }
            if (dir == 0) {
#pragma unroll
                for (int i = 1; i < 16; ++i) bb[i] += bb[i - 1];
                tot[(dir * 4 + tq) * 64 + lane] = bb[15];
            } else {
#pragma unroll
                for (int i = 14; i >= 0; --i) bb[i] += bb[i + 1];
                tot[(dir * 4 + tq) * 64 + lane] = bb[0];
            }
        }
        __syncthreads();
        {
            float offs = 0.f;
#pragma unroll
            for (int q = 0; q < 4; ++q) { const float tv = tot[(dir * 4 + q) * 64 + lane]; total += tv; if (dir == 0 ? (q < tq) : (q > tq)) offs += tv; }
#pragma unroll
            for (int i = 0; i < 16; ++i) bb[i] += offs;
        }
        {
            unsigned pk[8];
#pragma unroll
            for (int i = 0; i < 8; ++i) {
                const int s0 = tq * 16 + 2 * i;
                const float k0 = bf2f(Kraw[s0 * 72 + lane]), k1 = bf2f(Kraw[(s0 + 1) * 72 + lane]);
                pk[i] = cvtpk(k0 * __expf(total - bb[2 * i]), k1 * __expf(total - bb[2 * i + 1]));
            }
            *(u32x4*)(kdT + (dir * 64 + lane) * 72 + tq * 16) = (u32x4){pk[0], pk[1], pk[2], pk[3]};
            *(u32x4*)(kdT + (dir * 64 + lane) * 72 + tq * 16 + 8) = (u32x4){pk[4], pk[5], pk[6], pk[7]};
            if (tq == 0) DEC[((size_t)(dir * NCH + gc) * 4 + h) * 64 + lane] = __expf(total);
        }
        __syncthreads();
        {
            const int mdir = wave >> 2, vbk = wave & 3;
            const int vb = (int)(uintptr_t)Vraw + (8 * hi + ((lane & 15) >> 2)) * 320 + (vbk * 32 + 16 * ((lane >> 4) & 1) + 4 * (lane & 3)) * 2;
            f32x16 a0 = {}, a1 = {};
#define GLAL_STEP(KS) do { const s16x4 l_ = glal_tr<(KS) * 5120>(vb), h_ = glal_tr<(KS) * 5120 + 1280>(vb); \
            const bf16x8 b0 = *(const bf16x8*)(kdT + (mdir * 64 + r32) * 72 + (KS) * 16 + hi * 8); \
            const bf16x8 b1 = *(const bf16x8*)(kdT + (mdir * 64 + 32 + r32) * 72 + (KS) * 16 + hi * 8); \
            asm volatile("s_waitcnt lgkmcnt(0)" ::: "memory"); SBAR(); \
            const bf16x8 a_ = (bf16x8){l_[0], l_[1], l_[2], l_[3], h_[0], h_[1], h_[2], h_[3]}; \
            a0 = __builtin_amdgcn_mfma_f32_32x32x16_bf16(a_, b0, a0, 0, 0, 0); a1 = __builtin_amdgcn_mfma_f32_32x32x16_bf16(a_, b1, a1, 0, 0, 0); } while (0)
            GLAL_STEP(0); GLAL_STEP(1); GLAL_STEP(2); GLAL_STEP(3);
#undef GLAL_STEP
            bf16_t* Uo = U + ((size_t)(mdir * NCH + gc) * 4 + h) * 8192;
#pragma unroll
            for (int r = 0; r < 16; ++r) { const int v = vbk * 32 + crow(r, hi); Uo[v * 64 + r32] = f2bf(a0[r]); Uo[v * 64 + 32 + r32] = f2bf(a1[r]); }
        }
        __syncthreads();
    }
}
__device__ __forceinline__ void rope8(const float* rope, int t, int j0, const u32x4& a, const u32x4& b, u32x4& oa, u32x4& ob) {
    const int row = t >> 6, col = t & 63;
    const float* cs = (j0 < 16) ? rope + row * 16 + j0 : rope + 512 * 16 + col * 16 + (j0 - 16);
    const float* sn = (j0 < 16) ? rope + 256 * 16 + row * 16 + j0 : rope + 512 * 16 + 64 * 16 + col * 16 + (j0 - 16);
    const f32x4 c0 = *(const f32x4*)cs, c1 = *(const f32x4*)(cs + 4), s0 = *(const f32x4*)sn, s1 = *(const f32x4*)(sn + 4);
#pragma unroll
    for (int e = 0; e < 4; ++e) {
        const float x1l = __uint_as_float(a[e] << 16), x1h = __uint_as_float(a[e] & 0xFFFF0000u), x2l = __uint_as_float(b[e] << 16), x2h = __uint_as_float(b[e] & 0xFFFF0000u);
        const float cl = (e < 2) ? c0[2 * e] : c1[2 * e - 4], ch = (e < 2) ? c0[2 * e + 1] : c1[2 * e - 3], sl = (e < 2) ? s0[2 * e] : s1[2 * e - 4], sh = (e < 2) ? s0[2 * e + 1] : s1[2 * e - 3];
        oa[e] = cvtpk(x1l * cl - x2l * sl, x1h * ch - x2h * sh);
        ob[e] = cvtpk(x1l * sl + x2l * cl, x1h * sh + x2h * ch);
    }
}
__device__ __forceinline__ void qrope_pass(const Params& p, int b0, int nb) {
    const int tid = threadIdx.x;
    const float* rope = (const float*)(p.ws + WS_ROPE);
    bf16_t* QM = (bf16_t*)(p.ws + WS_QM);
    for (int i = (blockIdx.x - b0) * NTH + tid; i < SEQ * 16; i += nb * NTH) {
        const int t = i >> 4, hh = (i >> 2) & 3, j0 = (i & 3) * 8;
        bf16_t* q = QM + (size_t)(CTXN + t) * 768 + hh * 192 + 128 + j0;
        const u32x4 a = *(const u32x4*)q, b = *(const u32x4*)(q + 32);
        u32x4 oa, ob; rope8(rope, t, j0, a, b, oa, ob);
        *(u32x4*)q = oa; *(u32x4*)(q + 32) = ob;
    }
}

__device__ __forceinline__ int gla_order(int dir, int step) { return dir == 0 ? step : (step < 4 ? 3 - step : NCH - 1 - (step - 4)); }
__device__ __forceinline__ void phase_gla_scan(const Params& p) {
    const int gid = blockIdx.x * NTH + threadIdx.x;
    if (gid >= 2 * 4 * 8192) { qrope_pass(p, 128, (int)gridDim.x - 128); return; }
    const int dir = gid >> 15, h = (gid >> 13) & 3, e = gid & 8191, d = e & 63;
    const bf16_t* U = (const bf16_t*)(p.ws + WS_U); bf16_t* S = (bf16_t*)(p.ws + WS_SIN); const float* DEC = (const float*)(p.ws + WS_DEC);
    float s = 0.f;
#pragma unroll 1
    for (int s0 = 0; s0 < NCH; s0 += 52) {
        float uu[52], dc[52];
#pragma unroll
        for (int i = 0; i < 52; ++i) { const size_t o = ((size_t)(dir * NCH + gla_order(dir, s0 + i)) * 4 + h); uu[i] = bf2f(U[o * 8192 + e]); dc[i] = DEC[o * 64 + d]; }
#pragma unroll
        for (int i = 0; i < 52; ++i) { const size_t o = ((size_t)(dir * NCH + gla_order(dir, s0 + i)) * 4 + h); S[o * 8192 + e] = f2bf(s); s = dc[i] * s + uu[i]; }
    }
}

__device__ __forceinline__ void gla_out_unit(const Params& p, int gc, int h) {
    const int tid = threadIdx.x, lane = tid & 63, wave = tid >> 6, r32 = lane & 31, hi = lane >> 5;
    const bf16_t* P = (const bf16_t*)(p.ws + WS_P);
    bf16_t* qe = (bf16_t*)smem;
    bf16_t* ke = qe + 2 * 64 * 72;
    bf16_t* Am = ke + 2 * 64 * 72;
    bf16_t* VT = Am + 2 * 64 * 72;
    bf16_t* ST = VT + 128 * 72;
    float* scr = (float*)(smem + 110592);
    float* ob = (float*)(ke);
    const GlaB gb = gla_decay(p, gc, h, scr);
    {
        const int dir = wave & 1, tq = wave >> 1;
#pragma unroll
        for (int i = 0; i < 16; ++i) {
            const int t = tq * 16 + i;
            const float qv = bf2f(P[(size_t)(gc * 64 + t) * PW + PC_Q + h * 64 + lane]) * 0.125f, kv = bf2f(P[(size_t)(gc * 64 + t) * PW + PC_K + h * 64 + lane]);
            qe[(dir * 64 + t) * 72 + lane] = f2bf(qv * __expf(gb.b[i]));
            ke[(dir * 64 + t) * 72 + lane] = f2bf(kv * __expf(-gb.b[i]));
        }
    }
    gla_stage_vt(P, gc, h, VT);
    {
        const bf16_t* S = (const bf16_t*)(p.ws + WS_SIN);
#pragma unroll
        for (int i = 0; i < 4; ++i) {
            const int cc = tid + 512 * i, dir = cc >> 10, v = (cc >> 3) & 127, ch = cc & 7;
            *(u32x4*)(ST + (dir * 128 + v) * 72 + ch * 8) = *(const u32x4*)(S + ((size_t)(dir * NCH + gc) * 4 + h) * 8192 + v * 64 + ch * 8);
        }
    }
    __syncthreads();
    {
        const int dir = wave >> 2, tb = (wave >> 1) & 1, sb = wave & 1;
        f32x16 acc = {};
#pragma unroll
        for (int ks = 0; ks < 4; ++ks) {
            const bf16x8 a = *(const bf16x8*)(qe + (dir * 64 + tb * 32 + r32) * 72 + ks * 16 + hi * 8);
            const bf16x8 b = *(const bf16x8*)(ke + (dir * 64 + sb * 32 + r32) * 72 + ks * 16 + hi * 8);
            acc = __builtin_amdgcn_mfma_f32_32x32x16_bf16(a, b, acc, 0, 0, 0);
        }
        const int s = sb * 32 + r32;
#pragma unroll
        for (int r = 0; r < 16; ++r) { const int t = tb * 32 + crow(r, hi); const bool keep = (dir == 0) ? (s <= t) : (s >= t); Am[(dir * 64 + t) * 72 + s] = f2bf(keep ? acc[r] : 0.f); }
    }
    __syncthreads();
    f32x16 o = {};
    const int tb = wave >> 2, vb = wave & 3;
#pragma unroll
    for (int dir = 0; dir < 2; ++dir)
#pragma unroll
        for (int ks = 0; ks < 4; ++ks) {
            const bf16x8 a1 = *(const bf16x8*)(Am + (dir * 64 + tb * 32 + r32) * 72 + ks * 16 + hi * 8);
            const bf16x8 b1 = *(const bf16x8*)(VT + (vb * 32 + r32) * 72 + ks * 16 + hi * 8);
            o = __builtin_amdgcn_mfma_f32_32x32x16_bf16(a1, b1, o, 0, 0, 0);
            const bf16x8 a2 = *(const bf16x8*)(qe + (dir * 64 + tb * 32 + r32) * 72 + ks * 16 + hi * 8);
            const bf16x8 b2 = *(const bf16x8*)(ST + (dir * 128 + vb * 32 + r32) * 72 + ks * 16 + hi * 8);
            o = __builtin_amdgcn_mfma_f32_32x32x16_bf16(a2, b2, o, 0, 0, 0);
        }
    __syncthreads();
#pragma unroll
    for (int r = 0; r < 16; ++r) ob[(tb * 32 + crow(r, hi)) * 132 + vb * 32 + r32] = o[r];
    __syncthreads();
    {
        const int t = tid >> 3, v0 = (tid & 7) * 16;
        float vals[16]; float ss = 0.f;
#pragma unroll
        for (int i = 0; i < 16; ++i) { vals[i] = ob[t * 132 + v0 + i]; ss += vals[i] * vals[i]; }
        ss += __shfl_xor(ss, 1); ss += __shfl_xor(ss, 2); ss += __shfl_xor(ss, 4);
        const float rstd = rsqrtf(ss * (1.f / 128.f) + EPSN);
        const size_t row = (size_t)gc * 64 + t;
        unsigned pk[8];
#pragma unroll
        for (int i = 0; i < 8; ++i) {
            const float r0 = bf2f(P[row * PW + PC_R + h * 128 + v0 + 2 * i]), r1 = bf2f(P[row * PW + PC_R + h * 128 + v0 + 2 * i + 1]);
            pk[i] = cvtpk(vals[2 * i] * rstd * p.gla_onorm[v0 + 2 * i] * silu_f(r0), vals[2 * i + 1] * rstd * p.gla_onorm[v0 + 2 * i + 1] * silu_f(r1));
        }
        bf16_t* M = (bf16_t*)(p.ws + WS_MIX) + row * 1024 + h * 128 + v0;
        *(u32x4*)M = (u32x4){pk[0], pk[1], pk[2], pk[3]}; *(u32x4*)(M + 8) = (u32x4){pk[4], pk[5], pk[6], pk[7]};
    }
    __syncthreads();
}


struct GlaPre { u32x4 qc, kc, vc[2], ac, sc[4]; float4 wac; float bac; };
__device__ __forceinline__ void gla_prefetch(const Params& p, int gc, int h, GlaPre& g, u32x4 (&rc)[2]) {
    const int tid = threadIdx.x;
    const bf16_t* P = (const bf16_t*)(p.ws + WS_P);
    const bf16_t* rowp = P + (size_t)(gc * 64 + (tid >> 3)) * PW;
    g.qc = *(const u32x4*)(rowp + PC_Q + h * 64 + (tid & 7) * 8);
    g.kc = *(const u32x4*)(rowp + PC_K + h * 64 + (tid & 7) * 8);
#pragma unroll
    for (int i = 0; i < 2; ++i) { const int idx = tid + 512 * i; g.vc[i] = *(const u32x4*)(P + (size_t)(gc * 64 + (idx >> 4)) * PW + PC_V + h * 128 + (idx & 15) * 8); }
#pragma unroll
    for (int i = 0; i < 2; ++i) rc[i] = *(const u32x4*)(rowp + PC_R + h * 128 + (tid & 7) * 16 + 8 * i);
    g.ac = *(const u32x4*)(P + (size_t)(gc * 64 + ((tid & 255) >> 2)) * PW + PC_AF + (tid & 3) * 8);
    const bf16_t* S = (const bf16_t*)(p.ws + WS_SIN);
#pragma unroll
    for (int i = 0; i < 4; ++i) { const int cc = tid + 512 * i, dir = cc >> 10; g.sc[i] = *(const u32x4*)(S + ((size_t)(dir * NCH + gc) * 4 + h) * 8192 + (cc & 1023) * 8); }
    { const int dd = tid >> 8, jj = (tid >> 4) & 15, d4 = tid & 15; g.wac = *(const float4*)((dd == 0 ? p.gla_wa_f : p.gla_wa_b) + jj * 256 + h * 64 + d4 * 4); }
    g.bac = ((tid >> 6) & 1 ? p.gla_ba_b : p.gla_ba_f)[h * 64 + (tid & 63)];
}
template <int OFF> __device__ __forceinline__ s16x4 gla_tr(int vb) { s16x4 r; asm volatile("ds_read_b64_tr_b16 %0, %1 offset:%2" : "=&v"(r) : "v"(vb), "i"(OFF) : "memory"); return r; }
__device__ __forceinline__ void phase_gla_out(const Params& p) {
    const int tid = threadIdx.x, lane = tid & 63, wave = tid >> 6, r32 = lane & 31, hi = lane >> 5, G = gridDim.x;
    bf16_t* qe = (bf16_t*)smem;
    bf16_t* ke = qe + 2 * 64 * 72;
    bf16_t* Am = ke + 2 * 64 * 72;
    bf16_t* Qraw = Am; bf16_t* Kraw = Am + 64 * 72;
    char* Vraw = smem + 55296;
    bf16_t* ST = (bf16_t*)(smem + 75776);
    float* af = (float*)(smem + 112640);
    float* wa = af + 2048;
    float* ba = wa + 2048;
    float* tot = ba + 128;
    float* ob = (float*)ke;
    int u = blockIdx.x;
    if (u >= NCH * 4) return;
    const int nt_t = tid >> 3, nt_v0 = (tid & 7) * 16;
    float on[16];
#pragma unroll
    for (int i = 0; i < 16; ++i) on[i] = p.gla_onorm[nt_v0 + i];
    GlaPre g; u32x4 rc[2], rcn[2];
    gla_prefetch(p, u >> 2, u & 3, g, rc);
    const int dir = wave & 1, tq = wave >> 1;
    for (; u < NCH * 4; u += G) {
        const int gc = u >> 2, h = u & 3;
        *(u32x4*)(Qraw + (tid >> 3) * 72 + (tid & 7) * 8) = g.qc;
        *(u32x4*)(Kraw + (tid >> 3) * 72 + (tid & 7) * 8) = g.kc;
#pragma unroll
        for (int i = 0; i < 2; ++i) { const int idx = tid + 512 * i; *(u32x4*)(Vraw + (idx >> 4) * 320 + (idx & 15) * 16) = g.vc[i]; }
#pragma unroll
        for (int i = 0; i < 4; ++i) { const int cc = tid + 512 * i; *(u32x4*)(ST + ((cc >> 10) * 128 + ((cc >> 3) & 127)) * 72 + (cc & 7) * 8) = g.sc[i]; }
        if (tid < 256) { const int t = tid >> 2, ch = tid & 3, dd = ch >> 1, j0 = (ch & 1) * 8; float* q = af + dd * 1024 + t * 16 + j0;
#pragma unroll
            for (int e = 0; e < 4; ++e) { q[2 * e] = __uint_as_float(g.ac[e] << 16); q[2 * e + 1] = __uint_as_float(g.ac[e] & 0xFFFF0000u); } }
        { const int dd = tid >> 8, jj = (tid >> 4) & 15, d4 = tid & 15; *(float4*)(wa + (dd * 16 + jj) * 64 + d4 * 4) = g.wac; }
        if (tid < 128) ba[tid] = g.bac;
        __syncthreads();
        const int un = u + G;
        if (un < NCH * 4) gla_prefetch(p, un >> 2, un & 3, g, rcn);
        float bb[16]; float total;
        {
            float w[16];
#pragma unroll
            for (int j = 0; j < 16; ++j) w[j] = wa[(dir * 16 + j) * 64 + lane];
            const float bias = ba[dir * 64 + lane];
#pragma unroll
            for (int i = 0; i < 16; ++i) {
                const int t = tq * 16 + i;
                float z = bias;
#pragma unroll
                for (int j = 0; j < 16; ++j) z += af[(dir * 64 + t) * 16 + j] * w[j];
                bb[i] = (fminf(z, 0.f) - __logf(1.f + __expf(-fabsf(z)))) * (1.f / 16.f);
            }
            if (dir == 0) {
#pragma unroll
                for (int i = 1; i < 16; ++i) bb[i] += bb[i - 1];
                tot[(dir * 4 + tq) * 64 + lane] = bb[15];
            } else {
#pragma unroll
                for (int i = 14; i >= 0; --i) bb[i] += bb[i + 1];
                tot[(dir * 4 + tq) * 64 + lane] = bb[0];
            }
        }
        __syncthreads();
        {
            float offs = 0.f; total = 0.f;
#pragma unroll
            for (int q = 0; q < 4; ++q) { const float tv = tot[(dir * 4 + q) * 64 + lane]; total += tv; if (dir == 0 ? (q < tq) : (q > tq)) offs += tv; }
#pragma unroll
            for (int i = 0; i < 16; ++i) bb[i] += offs;
        }
#pragma unroll
        for (int i = 0; i < 16; ++i) {
            const int t = tq * 16 + i;
            const float qv = bf2f(Qraw[t * 72 + lane]) * 0.125f, kv = bf2f(Kraw[t * 72 + lane]);
            qe[(dir * 64 + t) * 72 + lane] = f2bf(qv * __expf(bb[i]));
            ke[(dir * 64 + t) * 72 + lane] = f2bf(kv * __expf(-bb[i]));
        }
        __syncthreads();
        {
            const int mdir = wave >> 2, tb = (wave >> 1) & 1, sb = wave & 1;
            f32x16 acc = {};
#pragma unroll
            for (int ks = 0; ks < 4; ++ks) {
                const bf16x8 a = *(const bf16x8*)(qe + (mdir * 64 + tb * 32 + r32) * 72 + ks * 16 + hi * 8);
                const bf16x8 b = *(const bf16x8*)(ke + (mdir * 64 + sb * 32 + r32) * 72 + ks * 16 + hi * 8);
                acc = __builtin_amdgcn_mfma_f32_32x32x16_bf16(a, b, acc, 0, 0, 0);
            }
            const int sI = sb * 32 + r32;
#pragma unroll
            for (int r = 0; r < 16; ++r) { const int t = tb * 32 + crow(r, hi); const bool keep = (mdir == 0) ? (sI <= t) : (sI >= t); Am[(mdir * 64 + t) * 72 + sI] = f2bf(keep ? acc[r] : 0.f); }
        }
        __syncthreads();
        f32x16 o = {};
        const int tb = wave >> 2, vbk = wave & 3;
        {
            const int vb = (int)(uintptr_t)Vraw + (8 * hi + ((lane & 15) >> 2)) * 320 + (vbk * 32 + 16 * ((lane >> 4) & 1) + 4 * (lane & 3)) * 2;
#define GLA_PV(KS, DIRN) do { const s16x4 l_ = gla_tr<(KS) * 5120>(vb), h_ = gla_tr<(KS) * 5120 + 1280>(vb); \
            const bf16x8 a1 = *(const bf16x8*)(Am + ((DIRN) * 64 + tb * 32 + r32) * 72 + (KS) * 16 + hi * 8); \
            const bf16x8 a2 = *(const bf16x8*)(qe + ((DIRN) * 64 + tb * 32 + r32) * 72 + (KS) * 16 + hi * 8); \
            const bf16x8 b2 = *(const bf16x8*)(ST + ((DIRN) * 128 + vbk * 32 + r32) * 72 + (KS) * 16 + hi * 8); \
            asm volatile("s_waitcnt lgkmcnt(0)" ::: "memory"); SBAR(); \
            o = __builtin_amdgcn_mfma_f32_32x32x16_bf16(a1, (bf16x8){l_[0], l_[1], l_[2], l_[3], h_[0], h_[1], h_[2], h_[3]}, o, 0, 0, 0); \
            o = __builtin_amdgcn_mfma_f32_32x32x16_bf16(a2, b2, o, 0, 0, 0); } while (0)
            GLA_PV(0, 0); GLA_PV(1, 0); GLA_PV(2, 0); GLA_PV(3, 0); GLA_PV(0, 1); GLA_PV(1, 1); GLA_PV(2, 1); GLA_PV(3, 1);
#undef GLA_PV
        }
        __syncthreads();
#pragma unroll
        for (int r = 0; r < 16; ++r) ob[(tb * 32 + crow(r, hi)) * 132 + vbk * 32 + r32] = o[r];
        __syncthreads();
        {
            float vals[16]; float ss = 0.f;
#pragma unroll
            for (int i = 0; i < 4; ++i) { const f32x4 x = *(const f32x4*)(ob + nt_t * 132 + nt_v0 + 4 * i); vals[4 * i] = x[0]; vals[4 * i + 1] = x[1]; vals[4 * i + 2] = x[2]; vals[4 * i + 3] = x[3]; }
#pragma unroll
            for (int i = 0; i < 16; ++i) ss += vals[i] * vals[i];
            ss += __shfl_xor(ss, 1); ss += __shfl_xor(ss, 2); ss += __shfl_xor(ss, 4);
            const float rstd = rsqrtf(ss * (1.f / 128.f) + EPSN);
            unsigned pk[8];
#pragma unroll
            for (int i = 0; i < 8; ++i) {
                const unsigned w = rc[i >> 2][i & 3];
                const float r0 = __uint_as_float(w << 16), r1 = __uint_as_float(w & 0xFFFF0000u);
                const float s0 = r0 * __builtin_amdgcn_rcpf(1.f + __expf(-r0)), s1 = r1 * __builtin_amdgcn_rcpf(1.f + __expf(-r1));
                pk[i] = cvtpk(vals[2 * i] * rstd * on[2 * i] * s0, vals[2 * i + 1] * rstd * on[2 * i + 1] * s1);
            }
            bf16_t* M = (bf16_t*)(p.ws + WS_MIX) + ((size_t)gc * 64 + nt_t) * 1024 + h * 128 + nt_v0;
            *(u32x4*)M = (u32x4){pk[0], pk[1], pk[2], pk[3]}; *(u32x4*)(M + 8) = (u32x4){pk[4], pk[5], pk[6], pk[7]};
        }
        rc[0] = rcn[0]; rc[1] = rcn[1];
        __syncthreads();
    }
}

namespace mla {
constexpr int KVBLK = 64, QBLK = 32;
#ifndef MLA_QREG
#define MLA_QREG 12
#endif
constexpr int QREG = MLA_QREG;
constexpr float SCALE = 0.07216878364870322f;
constexpr float THR = 8.f;
constexpr int LDQ = 768, LDK = 768, LDV = 512, LDO = 1024;
constexpr int SHM_V = KVBLK * 128 * 2, SHM_K = KVBLK * 400;
#define MKSWZ(row, colB) ((row) * 400 + (colB))
__device__ __forceinline__ void partialSM(f32x16& p0, f32x16& p1, float& m_reg, float& mn, float& alpha) {
    constexpr float C = SCALE * LOG2E;
    float pmax = p0[0];
#pragma unroll
    for (int r = 1; r < 16; ++r) pmax = fmaxf(pmax, p0[r]);
#pragma unroll
    for (int r = 0; r < 16; ++r) pmax = fmaxf(pmax, p1[r]);
    { auto rr = __builtin_amdgcn_permlane32_swap(__float_as_uint(pmax), __float_as_uint(pmax), false, false);
      pmax = fmaxf(__uint_as_float(rr[0]), __uint_as_float(rr[1])); }
    if (__builtin_expect(__all(pmax - m_reg <= THR / SCALE), 1)) { mn = m_reg; alpha = 1.f; }
    else { mn = fmaxf(m_reg, pmax); alpha = __builtin_amdgcn_exp2f((m_reg - mn) * C); m_reg = mn; }
    const float mnC = -mn * C;
#pragma unroll
    for (int r = 0; r < 16; ++r) p0[r] = fmaf(p0[r], C, mnC);
#pragma unroll
    for (int r = 0; r < 16; ++r) p1[r] = fmaf(p1[r], C, mnC);
#pragma unroll
    for (int r = 0; r < 16; ++r) p0[r] = __builtin_amdgcn_exp2f(p0[r]);
}
__device__ __forceinline__ void finishSM(f32x16& p0, f32x16& p1, float alpha, float& l_reg, bf16x8& pa0, bf16x8& pa1, bf16x8& pa2, bf16x8& pa3) {
#pragma unroll
    for (int r = 0; r < 16; ++r) p1[r] = __builtin_amdgcn_exp2f(p1[r]);
    float ps = 0;
#pragma unroll
    for (int r = 0; r < 16; ++r) ps += p0[r];
#pragma unroll
    for (int r = 0; r < 16; ++r) ps += p1[r];
    { auto rr = __builtin_amdgcn_permlane32_swap(__float_as_uint(ps), __float_as_uint(ps), false, false);
      ps = __uint_as_float(rr[0]) + __uint_as_float(rr[1]); }
    l_reg = l_reg * alpha + ps;
#define PK4(P, BASE, OUT) do { unsigned a0 = cvtpk(P[BASE + 0], P[BASE + 1]), a1 = cvtpk(P[BASE + 2], P[BASE + 3]);   \
    unsigned b0 = cvtpk(P[BASE + 4], P[BASE + 5]), b1 = cvtpk(P[BASE + 6], P[BASE + 7]);                              \
    auto r0 = __builtin_amdgcn_permlane32_swap(a0, b0, false, false); auto r1 = __builtin_amdgcn_permlane32_swap(a1, b1, false, false); \
    u32x4 w = {r0[0], r1[0], r0[1], r1[1]}; OUT = *reinterpret_cast<bf16x8*>(&w); } while (0)
    PK4(p0, 0, pa0); PK4(p0, 8, pa1); PK4(p1, 0, pa2); PK4(p1, 8, pa3);
}
__device__ __forceinline__ void qkt(f32x16& p0, f32x16& p1, const char* Ks, const bf16x8* qr, const char* qlds, int r32, int hi) {
    p0 = f32x16{}; p1 = f32x16{};
#pragma unroll
    for (int d0 = 0; d0 < 12; ++d0) { const int cb = (d0 * 16 + hi * 8) * 2;
        const bf16x8 b0 = *reinterpret_cast<const bf16x8*>(Ks + MKSWZ(r32, cb));
        const bf16x8 b1 = *reinterpret_cast<const bf16x8*>(Ks + MKSWZ(32 + r32, cb));
        const bf16x8 qv = (d0 < QREG) ? qr[d0 < QREG ? d0 : 0] : *reinterpret_cast<const bf16x8*>(qlds + (d0 - QREG) * 1024);
        p0 = __builtin_amdgcn_mfma_f32_32x32x16_bf16(b0, qv, p0, 0, 0, 0);
        p1 = __builtin_amdgcn_mfma_f32_32x32x16_bf16(b1, qv, p1, 0, 0, 0); }
}
__device__ __forceinline__ int v_st(int k, int c) { const int kk = (k & ~0xC) | ((k & 4) << 1) | ((k & 8) >> 1); return ((kk >> 3) * 4 + (c >> 5)) * 512 + ((kk & 7) * 32 + (c & 31)) * 2; }
__device__ __forceinline__ int v_rd_base(int lane) { return ((lane & 3) << 3) | (((lane >> 2) & 3) << 6) | (((lane >> 4) & 1) << 5) | (((lane >> 5) & 1) << 8); }
constexpr int v_rd_off(int d0, int ks, int half) { return d0 * 512 + ks * 4096 + half * 2048; }
template <int OFF> __device__ __forceinline__ s16x4 tr_read(int vb) {
    s16x4 r; asm volatile("ds_read_b64_tr_b16 %0, %1 offset:%2" : "=&v"(r) : "v"(vb), "i"(OFF) : "memory"); return r;
}
template <int D0> __device__ __forceinline__ void pv_one(f32x16& od, int vb, bf16x8 pa0, bf16x8 pa1, bf16x8 pa2, bf16x8 pa3) {
#define PKV(L, H) (bf16x8){L[0], L[1], L[2], L[3], H[0], H[1], H[2], H[3]}
    {
    const s16x4 l0 = tr_read<v_rd_off(D0, 0, 0)>(vb), h0 = tr_read<v_rd_off(D0, 0, 1)>(vb), l1 = tr_read<v_rd_off(D0, 1, 0)>(vb), h1 = tr_read<v_rd_off(D0, 1, 1)>(vb);
    asm volatile("s_waitcnt lgkmcnt(0)" ::: "memory"); SBAR();
    od = __builtin_amdgcn_mfma_f32_32x32x16_bf16(pa0, PKV(l0, h0), od, 0, 0, 0);
    od = __builtin_amdgcn_mfma_f32_32x32x16_bf16(pa1, PKV(l1, h1), od, 0, 0, 0);
    }
    {
    const s16x4 l2 = tr_read<v_rd_off(D0, 2, 0)>(vb), h2 = tr_read<v_rd_off(D0, 2, 1)>(vb), l3 = tr_read<v_rd_off(D0, 3, 0)>(vb), h3 = tr_read<v_rd_off(D0, 3, 1)>(vb);
    asm volatile("s_waitcnt lgkmcnt(0)" ::: "memory"); SBAR();
    od = __builtin_amdgcn_mfma_f32_32x32x16_bf16(pa2, PKV(l2, h2), od, 0, 0, 0);
    od = __builtin_amdgcn_mfma_f32_32x32x16_bf16(pa3, PKV(l3, h3), od, 0, 0, 0);
    }
#undef PKV
}
__device__ __forceinline__ void pv_d0(f32x16* o, int vb, bf16x8 pa0, bf16x8 pa1, bf16x8 pa2, bf16x8 pa3) {
    pv_one<0>(o[0], vb, pa0, pa1, pa2, pa3); pv_one<1>(o[1], vb, pa0, pa1, pa2, pa3); pv_one<2>(o[2], vb, pa0, pa1, pa2, pa3); pv_one<3>(o[3], vb, pa0, pa1, pa2, pa3);
}
__device__ __forceinline__ void attn_body(const bf16_t* __restrict__ Qb, const bf16_t* __restrict__ Kh, const bf16_t* __restrict__ Vh, bf16_t* __restrict__ Ob, int seq) {
    char* lds = smem;
    const int tid = threadIdx.x, wid = tid >> 6, lane = tid & 63, r32 = lane & 31, hi = lane >> 5;
    char* V_lds = lds; char* K_lds = lds + 2 * SHM_V;
    float* ws = (float*)(lds + 2 * SHM_V + 2 * SHM_K) + wid * 64; float* li_l = ws; float* al_l = ws + 32;
    float m_reg = -1e30f, l_reg = 0; f32x16 o[4] = {}; bf16x8 qr[QREG];
    const bf16_t* Qw = Qb + (long)(wid * QBLK + r32) * LDQ + hi * 8;
#pragma unroll
    for (int d0 = 0; d0 < QREG; ++d0) qr[d0] = *reinterpret_cast<const bf16x8*>(Qw + d0 * 16);
    char* qlds = lds + 2 * SHM_V + 2 * SHM_K + 2048 + wid * ((12 - QREG) * 1024) + lane * 16;
#pragma unroll
    for (int d0 = 0; d0 < 12 - QREG; ++d0) *reinterpret_cast<bf16x8*>(qlds + d0 * 1024) = *reinterpret_cast<const bf16x8*>(Qw + (QREG + d0) * 16);
    const int sr = tid >> 4, sc = (tid & 15) * 8, vst0 = v_st(sr, sc), vst1 = v_st(32 + sr, sc);
    int kgo[3], kso[3];
#pragma unroll
    for (int i = 0; i < 3; ++i) { const int id = tid + 512 * i, kr_ = id / 24, kc_ = (id % 24) * 8; kgo[i] = kr_ * LDK + kc_; kso[i] = MKSWZ(kr_, kc_ * 2); }
    const int vb0 = (int)(uintptr_t)V_lds + v_rd_base(lane);
    struct { bf16x8 vs0, vs1, ks0, ks1, ks2; } st_;
#define SLOAD(k0) do { st_.vs0 = *(const bf16x8*)(&Vh[(long)((k0) + sr) * LDV + sc]); st_.vs1 = *(const bf16x8*)(&Vh[(long)((k0) + 32 + sr) * LDV + sc]); \
    st_.ks0 = *(const bf16x8*)(&Kh[(long)(k0) * LDK + kgo[0]]); st_.ks1 = *(const bf16x8*)(&Kh[(long)(k0) * LDK + kgo[1]]); \
    st_.ks2 = *(const bf16x8*)(&Kh[(long)(k0) * LDK + kgo[2]]); } while (0)
#define SWRITE(b) do { *(bf16x8*)(V_lds + (b) * SHM_V + vst0) = st_.vs0; *(bf16x8*)(V_lds + (b) * SHM_V + vst1) = st_.vs1; \
    *(bf16x8*)(K_lds + (b) * SHM_K + kso[0]) = st_.ks0; *(bf16x8*)(K_lds + (b) * SHM_K + kso[1]) = st_.ks1; \
    *(bf16x8*)(K_lds + (b) * SHM_K + kso[2]) = st_.ks2; } while (0)
#define RESC(a) do { if (__any((a) < 1.f)) { if (hi == 0) al_l[r32] = (a); asm volatile("s_waitcnt lgkmcnt(0)" ::: "memory"); \
    _Pragma("unroll") for (int d = 0; d < 4; ++d) _Pragma("unroll") for (int r = 0; r < 16; ++r) o[d][r] *= al_l[crow(r, hi)]; } } while (0)
    f32x16 pA0, pA1, pB0, pB1; float mnA, mnB, alA, alB; bf16x8 pa0, pa1, pa2, pa3; const int NT = seq / KVBLK;
    SLOAD(0); SWRITE(0); __syncthreads();
    qkt(pA0, pA1, K_lds, qr, qlds, r32, hi); partialSM(pA0, pA1, m_reg, mnA, alA);
    SLOAD(KVBLK); SWRITE(1); __syncthreads();
    for (int j = 1; j + 1 < NT; j += 2) {
        SBAR(); qkt(pB0, pB1, K_lds + SHM_K, qr, qlds, r32, hi);
        finishSM(pA0, pA1, alA, l_reg, pa0, pa1, pa2, pa3); SBAR();
        SLOAD((j + 1) * KVBLK); SBAR();
        pv_d0(o, vb0, pa0, pa1, pa2, pa3); partialSM(pB0, pB1, m_reg, mnB, alB);
        __syncthreads(); SWRITE(0);
        RESC(alB); __syncthreads();
        SBAR(); qkt(pA0, pA1, K_lds, qr, qlds, r32, hi);
        finishSM(pB0, pB1, alB, l_reg, pa0, pa1, pa2, pa3); SBAR();
        SLOAD((j + 2) * KVBLK); SBAR();
        pv_d0(o, vb0 + SHM_V, pa0, pa1, pa2, pa3); partialSM(pA0, pA1, m_reg, mnA, alA);
        __syncthreads(); SWRITE(1);
        RESC(alA); __syncthreads();
    }
    SBAR(); qkt(pB0, pB1, K_lds + SHM_K, qr, qlds, r32, hi);
    finishSM(pA0, pA1, alA, l_reg, pa0, pa1, pa2, pa3); SBAR();
    pv_d0(o, vb0, pa0, pa1, pa2, pa3); partialSM(pB0, pB1, m_reg, mnB, alB);
    __syncthreads(); RESC(alB);
    finishSM(pB0, pB1, alB, l_reg, pa0, pa1, pa2, pa3); SBAR();
    pv_d0(o, vb0 + SHM_V, pa0, pa1, pa2, pa3);
    if (hi == 0) li_l[r32] = l_reg; asm volatile("s_waitcnt lgkmcnt(0)" ::: "memory");
    float rli[16];
#pragma unroll
    for (int r = 0; r < 16; ++r) rli[r] = __builtin_amdgcn_rcpf(li_l[crow(r, hi)]);
    bf16_t* Ow = Ob + (long)(wid * QBLK) * LDO;
#pragma unroll
    for (int r = 0; r < 16; ++r) { const int orow = crow(r, hi);
#pragma unroll
        for (int d0 = 0; d0 < 4; ++d0) Ow[(long)orow * LDO + d0 * 32 + r32] = f2bf(o[d0][r] * rli[r]); }
    __syncthreads();
#undef SLOAD
#undef SWRITE
#undef RESC
}
}

__device__ __forceinline__ void phase_mix0(const Params& p) {
    const int G = gridDim.x;
    phase_gla_out(p);
    __syncthreads();
    const bf16_t* QM = (const bf16_t*)(p.ws + WS_QM); const bf16_t* KM = (const bf16_t*)(p.ws + WS_KM); const bf16_t* VM = (const bf16_t*)(p.ws + WS_VM);
    bf16_t* MIX = (bf16_t*)(p.ws + WS_MIX);
    for (int u = blockIdx.x; u < 260; u += G) {
        const bool lat = u < 256;
        const int h = lat ? (u & 3) : (u - 256);
        const size_t q0 = lat ? (size_t)CTXN + (size_t)(u >> 2) * 256 : 0;
        mla::attn_body(QM + q0 * 768 + h * 192, KM + h * 192, VM + h * 128, MIX + q0 * 1024 + 512 + h * 128, lat ? NTOK : CTXN);
    }
}

template <int OFF> __device__ __forceinline__ s16x4 na_tr(int vb) { s16x4 r; asm volatile("ds_read_b64_tr_b16 %0, %1 offset:%2" : "=&v"(r) : "v"(vb), "i"(OFF) : "memory"); return r; }
template <int KS> __device__ __forceinline__ void na_pv(f32x16& o0, f32x16& o1, int vb, bf16x8 pa) {
    const s16x4 a0 = na_tr<KS * 5120>(vb), a1 = na_tr<KS * 5120 + 1280>(vb), b0 = na_tr<KS * 5120 + 64>(vb), b1 = na_tr<KS * 5120 + 1280 + 64>(vb);
    asm volatile("s_waitcnt lgkmcnt(0)" ::: "memory"); SBAR();
    o0 = __builtin_amdgcn_mfma_f32_32x32x16_bf16(pa, (bf16x8){a0[0], a0[1], a0[2], a0[3], a1[0], a1[1], a1[2], a1[3]}, o0, 0, 0, 0);
    o1 = __builtin_amdgcn_mfma_f32_32x32x16_bf16(pa, (bf16x8){b0[0], b0[1], b0[2], b0[3], b1[0], b1[1], b1[2], b1[3]}, o1, 0, 0, 0);
}
template <int MODE> __device__ __forceinline__ void na_softmax(f32x16& p0, f32x16& p1, float& m_reg, float& l_reg, float& alpha, const float* brow, int c0, int hi) {
    constexpr float C = 0.125f * LOG2E;
#define NA_L0(q) (MODE != 2 || (q) >= 12)
#define NA_L1(q) (MODE != 1 || (q) < 4)
    if (MODE == 0) {
#pragma unroll
        for (int q = 0; q < 16; ++q) { p0[q] *= C; p1[q] *= C; }
    } else {
        float bv0[16], bv1[16];
#pragma unroll
        for (int q = 0; q < 16; ++q) { const int kc0 = crow(q, hi); if (NA_L0(q)) bv0[q] = brow[kc0]; if (NA_L1(q)) bv1[q] = brow[32 + kc0]; }
#pragma unroll
        for (int q = 0; q < 16; ++q) { if (NA_L0(q)) asm volatile("" : "+v"(bv0[q])); if (NA_L1(q)) asm volatile("" : "+v"(bv1[q])); }
#pragma unroll
        for (int q = 0; q < 16; ++q) {
            const int kc0 = crow(q, hi), kc1 = 32 + kc0;
            if (NA_L0(q)) { const float t = fmaf(p0[q], C, bv0[q]); p0[q] = ((unsigned)(kc0 - c0) < 16u) ? t : -1e30f; }
            if (NA_L1(q)) { const float t = fmaf(p1[q], C, bv1[q]); p1[q] = ((unsigned)(kc1 - c0) < 16u) ? t : -1e30f; }
        }
    }
    float pmax = -1e30f;
#pragma unroll
    for (int q = 0; q < 16; ++q) { if (NA_L0(q)) pmax = fmaxf(pmax, p0[q]); if (NA_L1(q)) pmax = fmaxf(pmax, p1[q]); }
    { auto rr = __builtin_amdgcn_permlane32_swap(__float_as_uint(pmax), __float_as_uint(pmax), false, false);
      pmax = fmaxf(__uint_as_float(rr[0]), __uint_as_float(rr[1])); }
    const float mn = fmaxf(m_reg, pmax);
    alpha = __builtin_amdgcn_exp2f(m_reg - mn);
    m_reg = mn;
    float ps = 0.f;
#pragma unroll
    for (int q = 0; q < 16; ++q) {
        if (NA_L0(q)) { p0[q] = __builtin_amdgcn_exp2f(p0[q] - mn); ps += p0[q]; } else p0[q] = 0.f;
        if (NA_L1(q)) { p1[q] = __builtin_amdgcn_exp2f(p1[q] - mn); ps += p1[q]; } else p1[q] = 0.f;
    }
    { auto rr = __builtin_amdgcn_permlane32_swap(__float_as_uint(ps), __float_as_uint(ps), false, false);
      ps = __uint_as_float(rr[0]) + __uint_as_float(rr[1]); }
    l_reg = l_reg * alpha + ps;
#undef NA_L0
#undef NA_L1
}
__device__ __forceinline__ void phase_na(const Params& p) {
    const int tid = threadIdx.x, lane = tid & 63, wave = tid >> 6, r32 = lane & 31, hi = lane >> 5, G = gridDim.x;
    const bf16_t* QKV = (const bf16_t*)(p.ws + WS_P);
    bf16_t* MIX = (bf16_t*)(p.ws + WS_MIX);
    constexpr int KB = 64 * 72 * 2, VB = 64 * 160 * 2;
    char* Kl = smem;
    char* Vl = smem + 2 * KB;
    float* xch = (float*)(smem + 2 * KB + 2 * VB) + wave * 64;
    float* rpbL = (float*)(smem + 2 * KB + 2 * VB + 8 * 64 * 4);
    constexpr float C = 0.125f * LOG2E;
    const int skey = tid >> 3, sch = tid & 7;
    const int vb0 = (int)(uintptr_t)Vl + (8 * hi + ((lane & 15) >> 2)) * 320 + (16 * ((lane >> 4) & 1) + 4 * (lane & 3)) * 2;
    for (int u = blockIdx.x; u < 64 * 16; u += G) {
        const int rg = u >> 4, h = u & 15;
        const int r = rg * 4 + (wave >> 1), qb = wave & 1;
        const int r0w = min(max(r - 4, 0), 248);
        const int kr_lo = min(max(rg * 4 - 4, 0), 248), kr_hi = min(max(rg * 4 + 3 - 4, 0), 248) + 7, nwin = kr_hi - kr_lo + 1, ntile = nwin + 4;
        for (int i = tid; i < 15 * 31; i += NTH) rpbL[i] = p.na_rpb[(size_t)h * 15 * 31 + i] * LOG2E;
        const int c = qb * 32 + r32, c0 = min(max(c - 8, 0), 48);
        const size_t qrow = (size_t)CTXN + (size_t)r * 64 + c;
        bf16x8 qr[4];
#pragma unroll
        for (int ks = 0; ks < 4; ++ks) qr[ks] = *(const bf16x8*)(QKV + qrow * 3072 + h * 64 + ks * 16 + hi * 8);
        float m_reg = -1e30f, l_reg = 0.f; f32x16 o0 = {}, o1 = {};
        u32x4 skA, svA, skB, svB;
#define NA_LOAD(ti_, SK, SV) do { const size_t key0_ = ((ti_) >= nwin) ? (size_t)((ti_) - nwin) * 64 : (size_t)CTXN + (size_t)(kr_lo + (ti_)) * 64; \
            const bf16_t* src_ = QKV + (key0_ + skey) * 3072 + h * 64 + sch * 8; SK = *(const u32x4*)(src_ + 1024); SV = *(const u32x4*)(src_ + 2048); } while (0)
#define NA_WRITE(b_, SK, SV) do { *(u32x4*)(Kl + (b_) * KB + skey * 144 + sch * 16) = SK; *(u32x4*)(Vl + (b_) * VB + skey * 320 + sch * 16) = SV; } while (0)
        NA_LOAD(0, skA, svA); NA_WRITE(0, skA, svA);
        NA_LOAD(1, skA, svA);
        __syncthreads();
        for (int ti = 0; ti < ntile; ++ti) {
            const int b = ti & 1;
            if (ti + 2 < ntile) { if (b == 0) NA_LOAD(ti + 2, skB, svB); else NA_LOAD(ti + 2, skA, svA); }
            const bool isctx = ti >= nwin;
            const int kr = kr_lo + ti;
            const bool need = isctx || (kr >= r0w && kr <= r0w + 7);
            if (need) {
                const bf16_t* Ks = (const bf16_t*)(Kl + b * KB);
                f32x16 p0 = {}, p1 = {};
#pragma unroll
                for (int ks = 0; ks < 4; ++ks) {
                    const bf16x8 a0 = *(const bf16x8*)(Ks + r32 * 72 + ks * 16 + hi * 8), a1 = *(const bf16x8*)(Ks + (32 + r32) * 72 + ks * 16 + hi * 8);
                    p0 = __builtin_amdgcn_mfma_f32_32x32x16_bf16(a0, qr[ks], p0, 0, 0, 0);
                    p1 = __builtin_amdgcn_mfma_f32_32x32x16_bf16(a1, qr[ks], p1, 0, 0, 0);
                }
                float alpha;
                const float* brow = rpbL + (kr - r + 7) * 31 + 15 - c;
                if (isctx) na_softmax<0>(p0, p1, m_reg, l_reg, alpha, brow, c0, hi);
                else if (qb == 0) na_softmax<1>(p0, p1, m_reg, l_reg, alpha, brow, c0, hi);
                else na_softmax<2>(p0, p1, m_reg, l_reg, alpha, brow, c0, hi);
                bf16x8 pa0, pa1, pa2, pa3;
                PK4(p0, 0, pa0); PK4(p0, 8, pa1); PK4(p1, 0, pa2); PK4(p1, 8, pa3);
                if (__any(alpha < 1.f)) {
                    if (hi == 0) xch[r32] = alpha;
                    asm volatile("s_waitcnt lgkmcnt(0)" ::: "memory");
#pragma unroll
                    for (int q = 0; q < 16; ++q) { const float a = xch[crow(q, hi)]; o0[q] *= a; o1[q] *= a; }
                }
                const int vb = vb0 + b * VB;
                na_pv<0>(o0, o1, vb, pa0); na_pv<1>(o0, o1, vb, pa1); na_pv<2>(o0, o1, vb, pa2); na_pv<3>(o0, o1, vb, pa3);
            }
            if (ti + 1 < ntile) { if (b == 0) NA_WRITE(1, skA, svA); else NA_WRITE(0, skB, svB); }
            __syncthreads();
        }
#undef NA_LOAD
#undef NA_WRITE
        if (hi == 0) xch[32 + r32] = l_reg;
        asm volatile("s_waitcnt lgkmcnt(0)" ::: "memory");
        const size_t orow0 = (size_t)CTXN + (size_t)r * 64 + qb * 32;
#pragma unroll
        for (int q = 0; q < 16; ++q) {
            const int qi = crow(q, hi); const float il = __builtin_amdgcn_rcpf(xch[32 + qi]);
            bf16_t* dst = MIX + (orow0 + qi) * 1024 + h * 64;
            dst[r32] = f2bf(o0[q] * il); dst[32 + r32] = f2bf(o1[q] * il);
        }
        __syncthreads();
    }
}
#undef PK4

#define XB_TMO      128
#define XB_XCNT(j)  (256  + 64 * (j))
#define XB_XSUB(j)  (1280 + 64 * (j))
#define XB_XGEN(j)  (2304 + 64 * (j))
#define XB_TOP      3328
#define XB_TOPGEN   3392
#define XCD_BAR_WORDS 3456
#define XB_SPIN_CAP (1u << 22)
#define LAS __attribute__((address_space(3)))
__device__ __forceinline__ unsigned xb_ld(unsigned* p)              { return __hip_atomic_load(p, __ATOMIC_RELAXED, __HIP_MEMORY_SCOPE_AGENT); }
__device__ __forceinline__ unsigned xb_add(unsigned* p, unsigned v) { return __hip_atomic_fetch_add(p, v, __ATOMIC_RELAXED, __HIP_MEMORY_SCOPE_AGENT); }
__device__ __forceinline__ unsigned xb_xcc_id() { return (unsigned)__builtin_amdgcn_s_getreg((3 << 11) | 20) & 0xFu; }
#define XB_SPIN(cond, bar) do { unsigned _sp = 0; while (cond) { __builtin_amdgcn_s_sleep(1); \
    if ((++_sp & 255u) == 0u) { if (xb_ld(&(bar)[XB_TMO])) break; if (_sp > XB_SPIN_CAP) { atomicAdd(&(bar)[XB_TMO], 1u); break; } } } } while (0)
struct XcdBarrier { unsigned* bar; unsigned x; volatile LAS unsigned* st; };
__device__ __forceinline__ XcdBarrier xcd_barrier_post(unsigned* bar, volatile LAS unsigned* st) {
    XcdBarrier b; b.bar = bar; b.x = xb_xcc_id(); b.st = st;
    if (threadIdx.x == 0) (void)xb_add(&bar[XB_XCNT(b.x)], 1u);
    return b;
}
__device__ __forceinline__ void xcd_barrier_complete(unsigned* bar, unsigned x, unsigned& nloc, unsigned& nx) {
    const unsigned G = gridDim.x * gridDim.y * gridDim.z;
    unsigned sum, cnt, mine, sp = 0u;
    for (;;) {
        sum = 0u; cnt = 0u; mine = 0u;
#pragma unroll
        for (unsigned j = 0; j < 16; ++j) { const unsigned c = xb_ld(&bar[XB_XCNT(j)]); sum += c; cnt += (c > 0u) ? 1u : 0u; mine = (j == x) ? c : mine; }
        if (sum == G) break;
        __builtin_amdgcn_s_sleep(1);
        if ((++sp & 255u) == 0u) { if (xb_ld(&bar[XB_TMO])) break; if (sp > XB_SPIN_CAP) { atomicAdd(&bar[XB_TMO], 1u); break; } }
    }
    nloc = mine > 0u ? mine : 1u; nx = cnt > 0u ? cnt : 1u;
}
__device__ __forceinline__ void xcd_barrier(const XcdBarrier& b) {
    asm volatile("s_waitcnt vmcnt(0)" ::: "memory");
    __syncthreads();
    if (threadIdx.x == 0) {
        unsigned* bar = b.bar;
        __builtin_amdgcn_s_waitcnt(0);
        unsigned nloc = b.st[0], nx = b.st[1];
        if (nloc == 0u) { xcd_barrier_complete(bar, b.x, nloc, nx); b.st[0] = nloc; b.st[1] = nx; }
        const unsigned old = xb_add(&bar[XB_XSUB(b.x)], 1u);
        const unsigned gen = old / nloc;
        if (old + 1u == (gen + 1u) * nloc) {
            __builtin_amdgcn_fence(__ATOMIC_RELEASE, "agent");
            asm volatile("s_waitcnt vmcnt(0)" ::: "memory");
            const unsigned og = xb_add(&bar[XB_TOP], 1u);
            const unsigned tg = og / nx;
            if (og + 1u == (tg + 1u) * nx) xb_add(&bar[XB_TOPGEN], 1u);
            else XB_SPIN(xb_ld(&bar[XB_TOPGEN]) == tg, bar);
            __builtin_amdgcn_fence(__ATOMIC_ACQUIRE, "agent");
            xb_add(&bar[XB_XGEN(b.x)], 1u);
            asm volatile("s_waitcnt vmcnt(0)" ::: "memory");
        } else {
            XB_SPIN(xb_ld(&bar[XB_XGEN(b.x)]) == gen, bar);
            __builtin_amdgcn_fence(__ATOMIC_ACQUIRE, "agent");
            asm volatile("s_waitcnt vmcnt(0)" ::: "memory");
        }
    }
    __syncthreads();
}

__device__ __forceinline__ void run_phase(const Params& p, int ph) {
#ifdef ONLY_PHASE
    if (ph != ONLY_PHASE) return;
    ph = ONLY_PHASE;
#endif
    const bf16_t* HB = (const bf16_t*)(p.ws + WS_HB);
    switch (ph) {
    case 0: phase_prologue(p); break;
    case 1: phase_norm1_l0(p); break;
    case 2: phase_gemm_pg8(HB, 1024, (const bf16_t*)(p.ws + WS_WIN), 1024, (bf16_t*)(p.ws + WS_P), PW, NTOK / 256, 8); break;
    case 3: phase_mla_up(p); break;
    case 4: break;
    case 5: phase_gla_scan(p); break;
    case 6: phase_mix0(p); break;
    case 7: phase_gemm_pg8((const bf16_t*)(p.ws + WS_MIX), 1024, (const bf16_t*)(p.ws + WS_WOUT0), 1024, (bf16_t*)(p.ws + WS_OB), 1024, NTOK / 256, 4); break;
    case 8: phase_mid(p, 0); break;
    case 9: phase_moe1(p, 0); break;
    case 10: phase_moe2(p, 0); break;
    case 11: phase_end(p, 0); break;
    case 12: phase_gemm_pg8(HB, 1024, (const bf16_t*)(p.ws + WS_WQKV), 1024, (bf16_t*)(p.ws + WS_P), 3072, NTOK / 256, 12); break;
    case 13: phase_na(p); break;
    case 14: phase_gemm_pg8((const bf16_t*)(p.ws + WS_MIX) + (size_t)CTXN * 1024, 1024, (const bf16_t*)(p.ws + WS_WNAO), 1024, (bf16_t*)(p.ws + WS_OB) + (size_t)CTXN * 1024, 1024, SEQ / 256, 4); break;
    case 15: phase_mid(p, 1); break;
    case 16: phase_moe1(p, 1); break;
    case 17: phase_moe2(p, 1); break;
    case 18: phase_end(p, 1); break;
    default: break;
    }
}
constexpr int N_PHASES = 19;

#if MK_LAUNCHES == 1
__global__ void __launch_bounds__(512) mega_kernel(Params p) {
    cg::grid_group grid = cg::this_grid();
    volatile LAS unsigned* xst = (volatile LAS unsigned*)(smem + LDS_BYTES - 16);
    if (threadIdx.x == 0) { xst[0] = 0u; xst[1] = 0u; xst[2] = 0u; xst[3] = 0u; }
    __syncthreads();
    XcdBarrier xb = xcd_barrier_post((unsigned*)(p.ws + WS_BAR), xst);
    run_phase(p, 0); xcd_barrier(xb);
    if (p.pad0 == 0x7fffffff) grid.sync();
    if (PROBE_REPEAT == 100) { run_phase(p, 0); xcd_barrier(xb); }
    if (PROBE_REPEAT == 61) { phase_gla_out(p); xcd_barrier(xb); }
#define PH_(n) run_phase(p, n); xcd_barrier(xb); if ((n) == PROBE_REPEAT) { run_phase(p, n); xcd_barrier(xb); }
    PH_(1) PH_(2) PH_(3) PH_(5) PH_(6) PH_(7) PH_(8) PH_(9) PH_(10) PH_(11) PH_(12) PH_(13) PH_(14) PH_(15) PH_(16) PH_(17)
    run_phase(p, 18);
#undef PH_
}
#else
template <int PH> __global__ void __launch_bounds__(512) phase_kernel(Params p) { run_phase(p, PH); }
typedef void (*phase_fn)(Params);
template <int PH> static bool launch_phase(const Params& p, int grid, hipStream_t stream, bool setattr) {
    if (setattr && hipFuncSetAttribute((const void*)phase_kernel<PH>, hipFuncAttributeMaxDynamicSharedMemorySize, LDS_BYTES) != hipSuccess) return false;
    hipLaunchKernelGGL(phase_kernel<PH>, dim3(grid), dim3(NTH), LDS_BYTES, stream, p);
    return true;
}
#endif

extern "C" void kernel_launch(void* const* d_in, const int* in_sizes, int n_in, void* d_out, int out_size, void* d_ws, size_t ws_size, hipStream_t stream) {
    static int grid_blocks = 0;
    bool first = false;
    if (!grid_blocks) {
        if (ws_size < WS_END) { fprintf(stderr, "kernel_launch: workspace too small: %zu < %zu\n", ws_size, (size_t)WS_END); return; }
        int dev = 0, cus = 0;
        (void)hipGetDevice(&dev);
        (void)hipDeviceGetAttribute(&cus, hipDeviceAttributeMultiprocessorCount, dev);
#if MK_LAUNCHES == 1
        if (hipFuncSetAttribute((const void*)mega_kernel, hipFuncAttributeMaxDynamicSharedMemorySize, LDS_BYTES) != hipSuccess) { fprintf(stderr, "kernel_launch: LDS attribute failed\n"); return; }
        int per_cu = 0;
        (void)hipOccupancyMaxActiveBlocksPerMultiprocessor(&per_cu, (const void*)mega_kernel, NTH, LDS_BYTES);
        if (per_cu < 1) { fprintf(stderr, "kernel_launch: occupancy query returned %d\n", per_cu); return; }
#endif
        grid_blocks = cus;
        first = true;
    }
    Params p{};
    const float* const* in = (const float* const*)d_in;
    p.x = in[0]; p.c = in[1]; p.ctx = in[2]; p.c_ctx = in[3]; p.ada_w = in[4]; p.ada_b = in[5]; p.norm_g = in[6]; p.router_w = in[7]; p.router_b = in[8];
    p.moe_w1 = in[9]; p.moe_b1 = in[10]; p.moe_w2 = in[11]; p.moe_b2 = in[12]; p.ab_in_w = in[13]; p.gla_wa_f = in[14]; p.gla_ba_f = in[15]; p.gla_wa_b = in[16]; p.gla_ba_b = in[17];
    p.gla_onorm = in[18]; p.mla_qnorm = in[19]; p.mla_wuq = in[20]; p.mla_kvnorm = in[21]; p.mla_wukv = in[22]; p.ab_out_w = in[23]; p.na_qkv_w = in[24]; p.na_rpb = in[25]; p.na_out_w = in[26];
    p.out = (float*)d_out; p.ws = (char*)d_ws;
#if MK_LAUNCHES == 1
    (void)hipMemsetAsync((char*)d_ws + WS_BAR, 0, 16384, stream);
    void* args[] = {&p};
    hipError_t e = hipLaunchCooperativeKernel((const void*)mega_kernel, dim3(grid_blocks), dim3(NTH), args, LDS_BYTES, stream);
    if (e != hipSuccess) fprintf(stderr, "cooperative launch failed: %s (grid %d)\n", hipGetErrorString(e), grid_blocks);
#else
    const int g = grid_blocks;
    launch_phase<0>(p, g, stream, first); launch_phase<1>(p, g, stream, first); launch_phase<2>(p, g, stream, first); launch_phase<3>(p, g, stream, first);
    launch_phase<4>(p, g, stream, first); launch_phase<5>(p, g, stream, first); launch_phase<6>(p, g, stream, first); launch_phase<7>(p, g, stream, first);
    launch_phase<8>(p, g, stream, first); launch_phase<9>(p, g, stream, first); launch_phase<10>(p, g, stream, first); launch_phase<11>(p, g, stream, first);
    launch_phase<12>(p, g, stream, first); launch_phase<13>(p, g, stream, first); launch_phase<14>(p, g, stream, first); launch_phase<15>(p, g, stream, first);
    launch_phase<16>(p, g, stream, first); launch_phase<17>(p, g, stream, first); launch_phase<18>(p, g, stream, first);
#endif
}
```

```cpp
#include <hip/hip_runtime.h>
#include <hip/hip_cooperative_groups.h>
#include <cstdio>
#include <cstdint>
namespace cg = cooperative_groups;

#ifndef PROBE_REPEAT
#define PROBE_REPEAT -1
#endif
#ifndef MK_LAUNCHES
#define MK_LAUNCHES 1
#endif

typedef unsigned short bf16_t;
typedef short bf16x8 __attribute__((ext_vector_type(8)));
typedef short s16x4 __attribute__((ext_vector_type(4)));
typedef float f32x4 __attribute__((ext_vector_type(4)));
typedef float f32x16 __attribute__((ext_vector_type(16)));
typedef unsigned u32x4 __attribute__((ext_vector_type(4)));
typedef unsigned u32x2 __attribute__((ext_vector_type(2)));

constexpr int SEQ = 16384, CTXN = 256, NTOK = SEQ + CTXN, DM = 1024;
constexpr int NEXP = 32, FF = 1024;
constexpr int PW = 2048;
constexpr int PC_Q = 0, PC_K = 256, PC_V = 512, PC_R = 1024, PC_AF = 1536, PC_AB = 1552, PC_CQ = 1568, PC_CKV = 1824, PC_KR = 1952;
constexpr int NCH = NTOK / 64;
constexpr int NTH = 512;
constexpr float EPSN = 1e-6f;
constexpr float LOG2E = 1.4426950408889634f;

constexpr size_t al256(size_t x) { return (x + 255) / 256 * 256; }
constexpr size_t WS_BAR   = 0;
constexpr size_t WS_CNT   = WS_BAR + 16384;
constexpr size_t WS_MOD   = WS_CNT + 1024;
constexpr size_t WS_ROPE  = WS_MOD + al256((size_t)2 * 2 * 6144 * 4);
constexpr size_t WS_RWT   = WS_ROPE + al256((size_t)(256 + 256 + 64 + 64) * 16 * 4);
constexpr size_t WS_WIN   = WS_RWT + al256((size_t)2 * 32 * 1024 * 4);
constexpr size_t WS_WUQ   = WS_WIN + (size_t)2048 * 1024 * 2;
constexpr size_t WS_WUKV  = WS_WUQ + (size_t)768 * 256 * 2;
constexpr size_t WS_WOUT0 = WS_WUKV + (size_t)1024 * 128 * 2;
constexpr size_t WS_WQKV  = WS_WOUT0 + (size_t)1024 * 1024 * 2;
constexpr size_t WS_WNAO  = WS_WQKV + (size_t)3072 * 1024 * 2;
constexpr size_t WS_W1T   = WS_WNAO + (size_t)1024 * 1024 * 2;
constexpr size_t WS_W2T   = WS_W1T + (size_t)2 * 32 * 2048 * 1024 * 2;
constexpr size_t WS_HB    = WS_W2T + (size_t)2 * 32 * 1024 * 1024 * 2;
constexpr size_t WS_P     = WS_HB + (size_t)NTOK * 1024 * 2;
constexpr size_t WS_QM    = WS_P + (size_t)NTOK * 3072 * 2;
constexpr size_t WS_KM    = WS_QM + (size_t)NTOK * 768 * 2;
constexpr size_t WS_VM    = WS_KM + (size_t)NTOK * 768 * 2;
constexpr size_t WS_U     = WS_VM + (size_t)NTOK * 512 * 2;
constexpr size_t WS_SIN   = WS_U + (size_t)2 * NCH * 4 * 128 * 64 * 2;
constexpr size_t WS_DEC   = WS_SIN + (size_t)2 * NCH * 4 * 128 * 64 * 2;
constexpr size_t WS_MIX   = WS_DEC + al256((size_t)2 * NCH * 4 * 64 * 4);
constexpr size_t WS_OB    = WS_MIX + (size_t)NTOK * 1024 * 2;
constexpr size_t WS_X1    = WS_OB + (size_t)NTOK * 1024 * 2;
constexpr size_t WS_X2    = WS_X1 + (size_t)NTOK * 1024 * 4;
constexpr size_t WS_TOPE  = WS_X2 + (size_t)NTOK * 1024 * 4;
constexpr size_t WS_TOPP  = WS_TOPE + al256((size_t)NTOK * 4 * 4);
constexpr size_t WS_GATE  = WS_TOPP + al256((size_t)NTOK * 4 * 4);
constexpr size_t WS_LIST  = WS_GATE + al256((size_t)NTOK * 4 * 4);
constexpr size_t WS_ACT   = WS_LIST + al256((size_t)32 * NTOK * 4);
constexpr size_t WS_YB    = WS_ACT + (size_t)(NTOK * 4 + 256) * 1024 * 2;
constexpr size_t WS_END   = WS_YB + (size_t)(NTOK * 4) * 1024 * 2;

constexpr int LDS_BYTES = 160 * 1024;
extern __shared__ __attribute__((aligned(16))) char smem[];

struct Params {
    const float *x, *c, *ctx, *c_ctx, *ada_w, *ada_b, *norm_g, *router_w, *router_b, *moe_w1, *moe_b1, *moe_w2, *moe_b2;
    const float *ab_in_w, *gla_wa_f, *gla_ba_f, *gla_wa_b, *gla_ba_b, *gla_onorm, *mla_qnorm, *mla_wuq, *mla_kvnorm, *mla_wukv;
    const float *ab_out_w, *na_qkv_w, *na_rpb, *na_out_w;
    float* out; char* ws;
    int pad0, pad1;
};

__device__ __forceinline__ float bf2f(bf16_t h) { return __uint_as_float(((unsigned)h) << 16); }
__device__ __forceinline__ bf16_t f2bf(float f) { unsigned u = __float_as_uint(f); u += 0x7FFFu + ((u >> 16) & 1u); return (bf16_t)(u >> 16); }
__device__ __forceinline__ unsigned cvtpk(float lo, float hi) { unsigned r; asm volatile("v_cvt_pk_bf16_f32 %0, %1, %2" : "=v"(r) : "v"(lo), "v"(hi)); return r; }
__device__ __forceinline__ float wave_sum(float v) {
#pragma unroll
    for (int o = 32; o >= 1; o >>= 1) v += __shfl_xor(v, o);
    return v;
}
__device__ __forceinline__ int crow(int r, int hi) { return (r & 3) + 8 * (r >> 2) + 4 * hi; }
__device__ __forceinline__ float silu_f(float x) { return x / (1.f + __expf(-x)); }
#define SBAR() __builtin_amdgcn_sched_barrier(0)
__device__ __forceinline__ int tid_opaque() { int t = threadIdx.x; asm volatile("" : "+v"(t)); return t; }

struct ConvJob { const float* src; bf16_t* dst; const float* gain; int K, Nsrc, kt, nt, mode; };
__device__ __forceinline__ void conv_load(const ConvJob& jb, float4 (&v)[16]) {
    const int tid = threadIdx.x, n4 = tid & 63, kr = tid >> 6, n = jb.nt * 256 + n4 * 4;
    const float* q = jb.src + (size_t)(jb.kt * 128 + kr) * jb.Nsrc + n;
#pragma unroll
    for (int i = 0; i < 16; ++i) { if (n < jb.Nsrc) v[i] = *(const float4*)(q + (size_t)(8 * i) * jb.Nsrc); else v[i] = make_float4(0.f, 0.f, 0.f, 0.f); }
}
__device__ __forceinline__ void conv_to_lds(const ConvJob& jb, const float4 (&v)[16]) {
    bf16_t* T = (bf16_t*)smem;
    const int tid = threadIdx.x, n4 = tid & 63, kr = tid >> 6;
#pragma unroll
    for (int i = 0; i < 16; ++i) {
        const int k = kr + 8 * i;
        float4 w = v[i];
        if (jb.mode == 1) { const float g = jb.gain[jb.kt * 128 + k]; w.x *= g; w.y *= g; w.z *= g; w.w *= g; }
        u32x2 pk; pk.x = cvtpk(w.x, w.y); pk.y = cvtpk(w.z, w.w);
        *(u32x2*)(T + k * 260 + n4 * 4) = pk;
    }
}
__device__ __forceinline__ void conv_readout(const ConvJob& jb) {
    const bf16_t* T = (const bf16_t*)smem;
    const int tid = threadIdx.x, k0 = jb.kt * 128;
#pragma unroll
    for (int i = 0; i < 8; ++i) {
        const int cc = tid + 512 * i, nn = cc >> 4, kc = cc & 15;
        const int col = (jb.mode == 2) ? (2 * (nn & 127) + (nn >> 7)) : nn;
        unsigned short e[8];
#pragma unroll
        for (int j = 0; j < 8; ++j) e[j] = T[(kc * 8 + j) * 260 + col];
        u32x4 o; o.x = e[0] | ((unsigned)e[1] << 16); o.y = e[2] | ((unsigned)e[3] << 16); o.z = e[4] | ((unsigned)e[5] << 16); o.w = e[6] | ((unsigned)e[7] << 16);
        *(u32x4*)(jb.dst + (size_t)(jb.nt * 256 + nn) * jb.K + k0 + kc * 8) = o;
    }
}

__device__ __forceinline__ void adaln_job(const Params& p, int job) {
    const int l = job / 24, cb = (job % 24) * 256, tid = threadIdx.x;
    float* sv = (float*)smem;
    for (int i = tid; i < 2048; i += NTH) { const int k = i & 1023; const float xx = (i < 1024) ? p.c[k] : p.c_ctx[k]; sv[i] = silu_f(xx); }
    __syncthreads();
    const int col4 = tid & 63, kq = tid >> 6;
    float4 a0 = make_float4(0, 0, 0, 0), a1 = make_float4(0, 0, 0, 0);
    const float* w = p.ada_w + ((size_t)l * 1024 + kq * 128) * 6144 + cb + col4 * 4;
#pragma unroll 8
    for (int k = 0; k < 128; ++k) {
        const float4 wv = *(const float4*)(w + (size_t)k * 6144);
        const float s0 = sv[kq * 128 + k], s1 = sv[1024 + kq * 128 + k];
        a0.x += s0 * wv.x; a0.y += s0 * wv.y; a0.z += s0 * wv.z; a0.w += s0 * wv.w;
        a1.x += s1 * wv.x; a1.y += s1 * wv.y; a1.z += s1 * wv.z; a1.w += s1 * wv.w;
    }
    float* red = sv + 2048;
    *(float4*)(red + (kq * 2 + 0) * 256 + col4 * 4) = a0;
    *(float4*)(red + (kq * 2 + 1) * 256 + col4 * 4) = a1;
    __syncthreads();
    {
        const int s = tid >> 8, col = tid & 255;
        float acc = p.ada_b[l * 6144 + cb + col];
#pragma unroll
        for (int q = 0; q < 8; ++q) acc += red[(q * 2 + s) * 256 + col];
        ((float*)(p.ws + WS_MOD))[(l * 2 + s) * 6144 + cb + col] = acc;
    }
    __syncthreads();
}

__device__ __forceinline__ void tables_job(const Params& p) {
    float* rope = (float*)(p.ws + WS_ROPE);
    const int tid = threadIdx.x;
    for (int i = tid; i < (256 + 64) * 16; i += NTH) {
        const bool isrow = i < 256 * 16;
        const int idx = isrow ? i : i - 256 * 16, pos = idx >> 4, j = idx & 15;
        const float inv = exp2f(-(float)j * (13.287712379549449f / 16.f));
        const float ang = (float)pos * inv;
        float rev = ang * 0.15915494309189535f; rev -= rintf(rev);
        const float cs = __builtin_amdgcn_cosf(rev), sn = __builtin_amdgcn_sinf(rev);
        if (isrow) { rope[idx] = cs; rope[256 * 16 + idx] = sn; }
        else { rope[512 * 16 + idx] = cs; rope[512 * 16 + 64 * 16 + idx] = sn; }
    }
    if (tid < 64) ((int*)(p.ws + WS_CNT))[tid] = 0;
}
__device__ __forceinline__ void rwt_job(const Params& p, int l) {
    float* dst = (float*)(p.ws + WS_RWT) + (size_t)l * 32 * 1024;
    const float* src = p.router_w + (size_t)l * 1024 * 32;
    for (int i = threadIdx.x; i < 32 * 1024; i += NTH) { const int cch = i >> 5, e = i & 31; dst[e * 1024 + cch] = src[i]; }
}

constexpr int J_IN = 8 * 8, J_UQ = 2 * 3, J_UKV = 1 * 4, J_OUT0 = 32, J_QKV = 8 * 12, J_NAO = 32, J_W1 = 64 * 64, J_W2 = 64 * 32;
constexpr int J_TOTAL = J_IN + J_UQ + J_UKV + J_OUT0 + J_QKV + J_NAO + J_W1 + J_W2;
__device__ __forceinline__ ConvJob conv_decode(const Params& p, int j) {
    ConvJob jb; jb.gain = nullptr; jb.mode = 0;
    int t = j;
    if (t < J_W1) { const int m = t >> 6, q = t & 63; jb.src = p.moe_w1 + (size_t)m * 1024 * 2048; jb.dst = (bf16_t*)(p.ws + WS_W1T) + (size_t)m * 2048 * 1024; jb.K = 1024; jb.Nsrc = 2048; jb.kt = q >> 3; jb.nt = q & 7; jb.mode = 2; return jb; } t -= J_W1;
    if (t < J_W2) { const int m = t >> 5, q = t & 31; jb.src = p.moe_w2 + (size_t)m * 1024 * 1024; jb.dst = (bf16_t*)(p.ws + WS_W2T) + (size_t)m * 1024 * 1024; jb.K = 1024; jb.Nsrc = 1024; jb.kt = q >> 2; jb.nt = q & 3; return jb; } t -= J_W2;
    if (t < J_IN) { jb.src = p.ab_in_w; jb.dst = (bf16_t*)(p.ws + WS_WIN); jb.K = 1024; jb.Nsrc = 2016; jb.kt = t / 8; jb.nt = t % 8; return jb; } t -= J_IN;
    if (t < J_UQ) { jb.src = p.mla_wuq; jb.dst = (bf16_t*)(p.ws + WS_WUQ); jb.K = 256; jb.Nsrc = 768; jb.kt = t / 3; jb.nt = t % 3; jb.mode = 1; jb.gain = p.mla_qnorm; return jb; } t -= J_UQ;
    if (t < J_UKV) { jb.src = p.mla_wukv; jb.dst = (bf16_t*)(p.ws + WS_WUKV); jb.K = 128; jb.Nsrc = 1024; jb.kt = 0; jb.nt = t; jb.mode = 1; jb.gain = p.mla_kvnorm; return jb; } t -= J_UKV;
    if (t < J_OUT0) { jb.src = p.ab_out_w; jb.dst = (bf16_t*)(p.ws + WS_WOUT0); jb.K = 1024; jb.Nsrc = 1024; jb.kt = t / 4; jb.nt = t % 4; return jb; } t -= J_OUT0;
    if (t < J_QKV) { jb.src = p.na_qkv_w; jb.dst = (bf16_t*)(p.ws + WS_WQKV); jb.K = 1024; jb.Nsrc = 3072; jb.kt = t / 12; jb.nt = t % 12; return jb; } t -= J_QKV;
    jb.src = p.na_out_w; jb.dst = (bf16_t*)(p.ws + WS_WNAO); jb.K = 1024; jb.Nsrc = 1024; jb.kt = t / 4; jb.nt = t % 4; return jb;
}

__device__ __forceinline__ void phase_prologue(const Params& p) {
    const int G = gridDim.x, b = blockIdx.x;
    for (int j = b; j < 51; j += G) {
        if (j < 48) adaln_job(p, j);
        else if (j == 48) tables_job(p);
        else rwt_job(p, j - 49);
    }
    __syncthreads();
    int j = b;
    if (j >= J_TOTAL) return;
    ConvJob cur = conv_decode(p, j);
    float4 v[16];
    conv_load(cur, v);
    for (;;) {
        conv_to_lds(cur, v);
        __syncthreads();
        const int jn = j + G;
        ConvJob nxt = cur;
        if (jn < J_TOTAL) { nxt = conv_decode(p, jn); conv_load(nxt, v); }
        conv_readout(cur);
        __syncthreads();
        if (jn >= J_TOTAL) break;
        cur = nxt; j = jn;
    }
}

namespace gm {
constexpr int BK = 64, HT = 128 * 64;
__device__ __forceinline__ int lds_byte(int r, int c) { const int st = (r >> 4) * 2 + (c >> 5), rr = r & 15, cc = c & 31, ob = rr * 64 + cc * 2; return st * 1024 + (ob ^ (((ob >> 9) & 1) << 5)); }
__device__ __forceinline__ void stage_rc(int b, int& R, int& C) { const int st = b / 1024, sb = b % 1024, swz = sb ^ (((sb >> 9) & 1) << 5); R = (st >> 1) * 16 + swz / 64; C = (st & 1) * 32 + (swz % 64) / 2; }

template <class Epi>
__device__ __forceinline__ void gemm_tile(const bf16_t* __restrict__ A, const int (&aoff)[2][2], const bf16_t* __restrict__ Bt, const int (&boff)[2], int nk, Epi& epi) {
    bf16_t* shm = (bf16_t*)smem;
    const int tid = tid_opaque(), wid = tid >> 6, lane = tid & 63, wr = wid >> 1, wc = wid & 1, fr = lane & 15, fq = lane >> 4;
    f32x4 acc[4][4];
#pragma unroll
    for (int m = 0; m < 4; ++m)
#pragma unroll
        for (int n = 0; n < 4; ++n) acc[m][n] = (f32x4){0.f, 0.f, 0.f, 0.f};
#define GM_STAGE(buf, kt) do { \
        _Pragma("unroll") for (int _i = 0; _i < 2; ++_i) { \
            __builtin_amdgcn_global_load_lds((const unsigned*)(A + aoff[0][_i] + (kt) * BK), (unsigned*)((char*)(shm + ((buf) * 3 + 0) * HT) + tid * 16 + _i * 8192), 16, 0, 0); \
            __builtin_amdgcn_global_load_lds((const unsigned*)(A + aoff[1][_i] + (kt) * BK), (unsigned*)((char*)(shm + ((buf) * 3 + 1) * HT) + tid * 16 + _i * 8192), 16, 0, 0); \
            __builtin_amdgcn_global_load_lds((const unsigned*)(Bt + boff[_i] + (kt) * BK), (unsigned*)((char*)(shm + ((buf) * 3 + 2) * HT) + tid * 16 + _i * 8192), 16, 0, 0); } } while (0)
    GM_STAGE(0, 0);
    for (int kt = 0; kt < nk; ++kt) {
        __syncthreads();
        const int buf = kt & 1;
        if (kt + 1 < nk) GM_STAGE(buf ^ 1, kt + 1);
        const char* Ab = (const char*)(shm + (buf * 3 + (wr >> 1)) * HT);
        const char* Bb = (const char*)(shm + (buf * 3 + 2) * HT);
#pragma unroll
        for (int k = 0; k < 2; ++k) {
            bf16x8 Bf[4], Af[4];
#pragma unroll
            for (int n = 0; n < 4; ++n) Bf[n] = *(const bf16x8*)(Bb + lds_byte(wc * 64 + n * 16 + fr, k * 32 + fq * 8));
#pragma unroll
            for (int m = 0; m < 4; ++m) Af[m] = *(const bf16x8*)(Ab + lds_byte((wr & 1) * 64 + m * 16 + fr, k * 32 + fq * 8));
#pragma unroll
            for (int m = 0; m < 4; ++m)
#pragma unroll
                for (int n = 0; n < 4; ++n) acc[m][n] = __builtin_amdgcn_mfma_f32_16x16x32_bf16(Af[m], Bf[n], acc[m][n], 0, 0, 0);
        }
    }
#undef GM_STAGE
    float* stg = (float*)smem;
    __syncthreads();
    {
        float* wb = stg + (wr * 64 + fq * 4) * 132 + wc * 64 + fr;
#pragma unroll
        for (int m = 0; m < 4; ++m)
#pragma unroll
            for (int n = 0; n < 4; ++n)
#pragma unroll
                for (int j = 0; j < 4; ++j) wb[(m * 16 + j) * 132 + n * 16] = acc[m][n][j];
    }
    __syncthreads();
    if (Epi::MOE1) {
        const int fch = tid & 7, rg = tid >> 3;
        for (int ps = 0; ps < 4; ++ps) {
            const int row = ps * 64 + rg;
            const float* q = stg + row * 132 + (fch >> 1) * 32 + (fch & 1) * 8;
            float g[8], l[8];
            *(f32x4*)&g[0] = *(const f32x4*)q; *(f32x4*)&g[4] = *(const f32x4*)(q + 4);
            *(f32x4*)&l[0] = *(const f32x4*)(q + 16); *(f32x4*)&l[4] = *(const f32x4*)(q + 20);
            epi.pair(row, fch * 8, g, l);
        }
    } else {
        const int ch = tid & 15, rg = tid >> 4;
        for (int ps = 0; ps < 8; ++ps) {
            const int row = ps * 32 + rg;
            const float* q = stg + row * 132 + ch * 8;
            float v[8];
            *(f32x4*)&v[0] = *(const f32x4*)q; *(f32x4*)&v[4] = *(const f32x4*)(q + 4);
            epi.row8(row, ch * 8, v);
        }
    }
    __syncthreads();
}
__device__ __forceinline__ void make_off(int (&off)[2][2], int row0, int ld) {
#pragma unroll
    for (int h = 0; h < 2; ++h)
#pragma unroll
        for (int i = 0; i < 2; ++i) { int R, C; stage_rc(tid_opaque() * 16 + i * 8192, R, C); off[h][i] = (row0 + h * 128 + R) * ld + C; }
}
__device__ __forceinline__ void make_off1(int (&off)[2], int row0, int ld) {
#pragma unroll
    for (int i = 0; i < 2; ++i) { int R, C; stage_rc(tid_opaque() * 16 + i * 8192, R, C); off[i] = (row0 + R) * ld + C; }
}
}

namespace pg8 {
#define PG8_LAS __attribute__((address_space(3)))
constexpr int BM = 256, BK = 64, HALF = 128, HTB = HALF * BK * 2, STAGE_BYTES = 8 * HTB, NXCD = 8, WGM = 8;
__device__ __forceinline__ int lds_byte(int r, int c) { const int st = (r >> 4) * 2 + (c >> 5), rr = r & 15, cc = c & 31, ob = rr * 64 + cc * 2; return st * 1024 + (ob ^ (((ob >> 9) & 1) << 5)); }
__device__ __forceinline__ void stage_rc(int b, int& R, int& C) { const int st = b / 1024, sb = b % 1024, swz = sb ^ (((sb >> 9) & 1) << 5); R = (st >> 1) * 16 + swz / 64; C = (st & 1) * 32 + (swz % 64) / 2; }
__device__ __forceinline__ int perm32(int rho) { const int n = rho >> 4, i = rho & 15; return 8 * (i >> 2) + 4 * n + (i & 3); }
struct Unit { int pm, pn, e, nvalid, slot0; };

template <class Epi, class Sched, bool GATHER>
__device__ __forceinline__ void gemm_phase(PG8_LAS unsigned char* lds, const Sched& S, const Epi& E, int K, int lda, int ldb) {
    const int tid = tid_opaque(), wid = __builtin_amdgcn_readfirstlane(tid >> 6), lane = tid & 63, wr = wid >> 2, wc = wid & 3, fr = lane & 15, fq = lane >> 4;
    const int nt = K / BK;
    unsigned voffA[2], voffB[2]; int gR[2], gC[2];
#pragma unroll
    for (int i = 0; i < 2; ++i) { int R, C; stage_rc(tid * 16 + i * 8192, R, C); const int Rb = Epi::PERM ? ((R & ~31) + perm32(R & 31)) : R;
        voffA[i] = (unsigned)(R * lda + C) * 2u; voffB[i] = (unsigned)(Rb * ldb + C) * 2u; gR[i] = R; gC[i] = C * 2; }
    const size_t kstep = (size_t)(BK * 2);
    const size_t hstepA = (size_t)HALF * lda * 2, hstepB = (size_t)HALF * ldb * 2;
    const unsigned ldsw = (unsigned)wid * 1024u;
    const int aoff = lds_byte(wr * 64 + fr, fq * 8), boff = lds_byte(wc * 32 + fr, fq * 8);
    unsigned gA[2][2] = {{0u, 0u}, {0u, 0u}};
#define PG8_SA(b, h) (((b) * 2 + (h)) * HTB)
#define PG8_SB(b, h) ((4 + (b) * 2 + (h)) * HTB)
#define PG8_STAGE(bufoff, gbase, voff) do { _Pragma("unroll") for (int _i = 0; _i < 2; ++_i) \
        __builtin_amdgcn_global_load_lds((const unsigned*)((const char*)(gbase) + (voff)[_i]), (PG8_LAS unsigned*)(lds + (bufoff) + ldsw + _i * 8192), 16, 0, 0); } while (0)
#define PG8_STAGE_A(bufoff, base, h) do { if constexpr (GATHER) PG8_STAGE(bufoff, base, gA[h]); else PG8_STAGE(bufoff, (base) + (h) * hstepA, voffA); } while (0)
#define PG8_LDA(dst, b, h) do { _Pragma("unroll") for (int m = 0; m < 4; ++m) _Pragma("unroll") for (int k = 0; k < 2; ++k) dst[m][k] = *(const PG8_LAS bf16x8*)(lds + PG8_SA(b, h) + aoff + m * 2048 + k * 1024); } while (0)
#define PG8_LDB(dst, b, h) do { _Pragma("unroll") for (int n = 0; n < 2; ++n) _Pragma("unroll") for (int k = 0; k < 2; ++k) dst[n][k] = *(const PG8_LAS bf16x8*)(lds + PG8_SB(b, h) + boff + n * 2048 + k * 1024); } while (0)
#define PG8_MMA(ai, bj, At, Bt) do { __builtin_amdgcn_s_setprio(1); _Pragma("unroll") for (int m = 0; m < 4; ++m) _Pragma("unroll") for (int n = 0; n < 2; ++n) _Pragma("unroll") for (int k = 0; k < 2; ++k) \
        acc[ai][bj][m][n] = __builtin_amdgcn_mfma_f32_16x16x32_bf16(Bt[n][k], At[m][k], acc[ai][bj][m][n], 0, 0, 0); __builtin_amdgcn_s_setprio(0); } while (0)
#define PG8_WAIT_V(n) asm volatile("s_waitcnt vmcnt(" #n ")" ::: "memory")
#define PG8_WAIT_L(n) asm volatile("s_waitcnt lgkmcnt(" #n ")" ::: "memory")
#define PG8_BAR __builtin_amdgcn_s_barrier()
#define PG8_SCHED __builtin_amdgcn_sched_barrier(0)
#define PG8_GLOAD(ui_) do { const PG8_LAS int* _gl = S.glist(ui_); _Pragma("unroll") for (int _h = 0; _h < 2; ++_h) _Pragma("unroll") for (int _i = 0; _i < 2; ++_i) \
        gA[_h][_i] = ((unsigned)_gl[_h * 128 + gR[_i]] << 11) + (unsigned)gC[_i]; } while (0)
    Unit cur, nxt; int ui = 0;
    if (!S.next(0, cur)) return;
    f32x4 acc[2][2][4][2];
#pragma unroll
    for (int a = 0; a < 2; ++a)
#pragma unroll
        for (int b = 0; b < 2; ++b)
#pragma unroll
            for (int m = 0; m < 4; ++m)
#pragma unroll
                for (int n = 0; n < 2; ++n) acc[a][b][m][n] = (f32x4){0.f, 0.f, 0.f, 0.f};
    bf16x8 At[4][2], B0[2][2], B1[2][2];
    const char* cA = S.a_base(cur); const char* cB = S.b_base(cur);
    if constexpr (GATHER) PG8_GLOAD(0);
    PG8_STAGE(PG8_SB(0, 0), cB, voffB); PG8_STAGE_A(PG8_SA(0, 0), cA, 0); PG8_STAGE(PG8_SB(0, 1), cB + hstepB, voffB); PG8_STAGE_A(PG8_SA(0, 1), cA, 1);
    if (wr == 1) PG8_BAR;
    PG8_WAIT_V(4); PG8_BAR;
    PG8_STAGE(PG8_SB(1, 0), cB + kstep, voffB); PG8_STAGE_A(PG8_SA(1, 0), cA + kstep, 0); PG8_STAGE(PG8_SB(1, 1), cB + hstepB + kstep, voffB);
    PG8_WAIT_V(6); PG8_BAR;
    for (;;) {
        const bool has_next = S.next(ui + 1, nxt);
        const char* nA = has_next ? S.a_base(nxt) : cA; const char* nB = has_next ? S.b_base(nxt) : cB;
        for (int t = 0; t < nt; t += 2) {
            const bool last = (t == nt - 2);
            const char* a1 = cA + (size_t)(t + 1) * kstep;
            const char* a2 = last ? nA : cA + (size_t)(t + 2) * kstep; const char* b2 = last ? nB : cB + (size_t)(t + 2) * kstep;
            const char* a3 = a2 + kstep; const char* b3 = b2 + kstep;
            PG8_LDB(B0, 0, 0); PG8_SCHED; PG8_LDA(At, 0, 0); PG8_STAGE_A(PG8_SA(1, 1), a1, 1);
            PG8_WAIT_L(8); PG8_BAR; PG8_WAIT_L(0); PG8_MMA(0, 0, At, B0); PG8_BAR; PG8_SCHED;
            if constexpr (GATHER) { if (last && has_next) PG8_GLOAD(ui + 1); }
            PG8_LDB(B1, 0, 1); PG8_STAGE(PG8_SB(0, 0), b2, voffB);
            PG8_BAR; PG8_WAIT_L(0); PG8_MMA(0, 1, At, B1); PG8_BAR;
            PG8_LDA(At, 0, 1); PG8_STAGE_A(PG8_SA(0, 0), a2, 0);
            PG8_BAR; PG8_WAIT_L(0); PG8_MMA(1, 0, At, B0); PG8_BAR; PG8_SCHED;
            PG8_STAGE(PG8_SB(0, 1), b2 + hstepB, voffB);
            PG8_WAIT_V(6); PG8_BAR; PG8_MMA(1, 1, At, B1); PG8_BAR;
            PG8_LDB(B0, 1, 0); PG8_SCHED; PG8_LDA(At, 1, 0); PG8_STAGE_A(PG8_SA(0, 1), a2, 1);
            PG8_WAIT_L(8); PG8_BAR; PG8_WAIT_L(0); PG8_MMA(0, 0, At, B0); PG8_BAR; PG8_SCHED;
            PG8_LDB(B1, 1, 1); PG8_STAGE(PG8_SB(1, 0), b3, voffB);
            PG8_BAR; PG8_WAIT_L(0); PG8_MMA(0, 1, At, B1); PG8_BAR;
            PG8_LDA(At, 1, 1); PG8_STAGE_A(PG8_SA(1, 0), a3, 0);
            PG8_BAR; PG8_WAIT_L(0); PG8_MMA(1, 0, At, B0); PG8_BAR; PG8_SCHED;
            PG8_STAGE(PG8_SB(1, 1), b3 + hstepB, voffB);
            PG8_WAIT_V(6); PG8_BAR; PG8_MMA(1, 1, At, B1); PG8_BAR;
        }
        E(acc, cur, wr, wc, fr, fq);
        if (!has_next) break;
#pragma unroll
        for (int a = 0; a < 2; ++a)
#pragma unroll
            for (int b = 0; b < 2; ++b)
#pragma unroll
                for (int m = 0; m < 4; ++m)
#pragma unroll
                    for (int n = 0; n < 2; ++n) acc[a][b][m][n] = (f32x4){0.f, 0.f, 0.f, 0.f};
        cur = nxt; cA = nA; cB = nB; ++ui;
    }
    PG8_WAIT_V(0);
    if (wr == 0) PG8_BAR;
    PG8_BAR;
#undef PG8_SA
#undef PG8_SB
#undef PG8_STAGE
#undef PG8_STAGE_A
#undef PG8_LDA
#undef PG8_LDB
#undef PG8_MMA
#undef PG8_WAIT_V
#undef PG8_WAIT_L
#undef PG8_BAR
#undef PG8_SCHED
#undef PG8_GLOAD
}

struct PlainOrder {
    const char* A; const char* Bt; int lda, ldb, nM, nN, nwg, G, c;
    __device__ void init(const bf16_t* A_, int lda_, const bf16_t* Bt_, int ldb_, int nM_, int nN_) { A = (const char*)A_; Bt = (const char*)Bt_; lda = lda_; ldb = ldb_; nM = nM_; nN = nN_; nwg = nM * nN; G = gridDim.x; c = blockIdx.x; }
    __device__ __forceinline__ bool next(int i, Unit& u) const {
        const long L = (long)i * G + c; if (L >= nwg) return false;
        int wgid = (int)L; { const int q = nwg / NXCD, r = nwg % NXCD, xcd = wgid % NXCD, off = wgid / NXCD; wgid = (xcd < r ? xcd * (q + 1) : r * (q + 1) + (xcd - r) * q) + off; }
        const int nig = WGM * nN, gid = wgid / nig, fm = gid * WGM, gsz = (nM - fm) < WGM ? (nM - fm) : WGM;
        u.pm = fm + ((wgid % nig) % gsz); u.pn = (wgid % nig) / gsz; u.e = 0; u.nvalid = 256; u.slot0 = 0; return true;
    }
    __device__ __forceinline__ const char* a_base(const Unit& u) const { return A + (size_t)u.pm * 256 * lda * 2; }
    __device__ __forceinline__ const char* b_base(const Unit& u) const { return Bt + (size_t)u.pn * 256 * ldb * 2; }
    __device__ __forceinline__ const PG8_LAS int* glist(int) const { return nullptr; }
};
struct MoeOrder {
    const char* A; const char* W; const PG8_LAS int* tab; const PG8_LAS int* gl; int wrows, nunits;
    __device__ __forceinline__ bool next(int i, Unit& u) const {
        if (i >= nunits) return false;
        const PG8_LAS int* t = tab + i * 8;
        u.pm = t[0]; u.pn = t[1]; u.e = t[2]; u.nvalid = t[3]; u.slot0 = t[4]; return true;
    }
    __device__ __forceinline__ const char* a_base(const Unit& u) const { return A + (size_t)u.slot0 * 2048; }
    __device__ __forceinline__ const char* b_base(const Unit& u) const { return W + ((size_t)u.e * wrows + (size_t)u.pn * 256) * 2048; }
    __device__ __forceinline__ const PG8_LAS int* glist(int i) const { return gl + i * 256; }
};
constexpr int MOE_UNITS_MAX = 16;
__device__ __forceinline__ int moe_build_units(PG8_LAS int* tab, const int* cnt, const int* off, const int* toff, int nN) {
    const int G = gridDim.x, c = blockIdx.x, x = c & 7, j = c >> 3, per = (G >> 3) / nN, nMt = toff[32];
    const int i = threadIdx.x;
    if (i < MOE_UNITS_MAX) {
        const int pn = j % nN, mt = (i * 8 + x) * per + j / nN;
        int e = 0, valid = (mt < nMt && j < per * nN) ? 1 : 0;
        if (valid) { while (toff[e + 1] <= mt) ++e; }
        const int m = mt - toff[e];
        tab[i * 8 + 0] = mt; tab[i * 8 + 1] = pn; tab[i * 8 + 2] = e; tab[i * 8 + 3] = cnt[e] - m * 256; tab[i * 8 + 4] = off[e] + m * 256; tab[i * 8 + 5] = valid;
    }
    __syncthreads();
    int n = 0;
    while (n < MOE_UNITS_MAX && tab[n * 8 + 5]) ++n;
    return n;
}
struct MoeOrderG : MoeOrder { __device__ __forceinline__ const char* a_base(const Unit&) const { return A; } };

__device__ __forceinline__ u32x4 pk8(const f32x4& a, const f32x4& b) { return (u32x4){cvtpk(a[0], a[1]), cvtpk(a[2], a[3]), cvtpk(b[0], b[1]), cvtpk(b[2], b[3])}; }
struct EpiStore {
    static constexpr bool PERM = true;
    bf16_t* C; int ldc; const float* rs;
    __device__ __forceinline__ void operator()(const f32x4 (&acc)[2][2][4][2], const Unit& u, int wr, int wc, int fr, int fq) const {
        bf16_t* base = C + ((size_t)u.pm * 256 + wr * 64 + fr) * ldc + u.pn * 256 + wc * 32 + 8 * fq;
#pragma unroll
        for (int ai = 0; ai < 2; ++ai)
#pragma unroll
            for (int m = 0; m < 4; ++m) { bf16_t* rowp = base + (size_t)(ai * HALF + m * 16) * ldc; const float s = rs ? rs[ai * HALF + wr * 64 + m * 16 + fr] : 1.f;
#pragma unroll
                for (int bj = 0; bj < 2; ++bj) *(u32x4*)(rowp + bj * HALF) = pk8(acc[ai][bj][m][0] * s, acc[ai][bj][m][1] * s); }
    }
};
struct EpiAct {
    static constexpr bool PERM = true;
    bf16_t* Act; const float* b1all;
    __device__ __forceinline__ void operator()(const f32x4 (&acc)[2][2][4][2], const Unit& u, int wr, int wc, int fr, int fq) const {
        const int f0 = u.pn * 128 + wc * 32 + 8 * fq;
        const float* bb = b1all + (size_t)u.e * 2048 + 2 * f0;
        f32x4 bv[4];
#pragma unroll
        for (int q = 0; q < 4; ++q) bv[q] = *(const f32x4*)(bb + 4 * q);
        bf16_t* base = Act + ((size_t)u.slot0 + wr * 64 + fr) * 1024 + f0;
#pragma unroll
        for (int ai = 0; ai < 2; ++ai)
#pragma unroll
            for (int m = 0; m < 4; ++m) {
                const int r = ai * HALF + wr * 64 + m * 16 + fr;
                float a[8];
#pragma unroll
                for (int n = 0; n < 2; ++n)
#pragma unroll
                    for (int j = 0; j < 4; ++j) { const int f = 4 * n + j;
                        float glu = acc[ai][0][m][n][j] + bv[f >> 1][(f & 1) * 2], lin = acc[ai][1][m][n][j] + bv[f >> 1][(f & 1) * 2 + 1];
                        glu = fminf(glu, 7.f); lin = fminf(fmaxf(lin, -7.f), 7.f);
                        a[f] = glu * __builtin_amdgcn_rcpf(1.f + __builtin_amdgcn_exp2f(-1.702f * LOG2E * glu)) * (lin + 1.f); }
                if (r < u.nvalid) *(u32x4*)(base + (size_t)(ai * HALF + m * 16) * 1024) = (u32x4){cvtpk(a[0], a[1]), cvtpk(a[2], a[3]), cvtpk(a[4], a[5]), cvtpk(a[6], a[7])};
            }
    }
};
struct EpiBias {
    static constexpr bool PERM = true;
    bf16_t* Y; const float* b2all;
    __device__ __forceinline__ void operator()(const f32x4 (&acc)[2][2][4][2], const Unit& u, int wr, int wc, int fr, int fq) const {
        const int c0 = u.pn * 256 + wc * 32 + 8 * fq;
        const float* bb = b2all + (size_t)u.e * 1024 + c0;
        f32x4 bv[2][2];
#pragma unroll
        for (int bj = 0; bj < 2; ++bj)
#pragma unroll
            for (int n = 0; n < 2; ++n) bv[bj][n] = *(const f32x4*)(bb + bj * HALF + 4 * n);
        bf16_t* base = Y + ((size_t)u.slot0 + wr * 64 + fr) * 1024 + c0;
#pragma unroll
        for (int ai = 0; ai < 2; ++ai)
#pragma unroll
            for (int m = 0; m < 4; ++m) { const int r = ai * HALF + wr * 64 + m * 16 + fr;
                if (r < u.nvalid) {
#pragma unroll
                    for (int bj = 0; bj < 2; ++bj) *(u32x4*)(base + (size_t)(ai * HALF + m * 16) * 1024 + bj * HALF) = pk8(acc[ai][bj][m][0] + bv[bj][0], acc[ai][bj][m][1] + bv[bj][1]); } }
    }
};
}

__device__ __forceinline__ u32x4 pack8(const float (&v)[8]) { return (u32x4){cvtpk(v[0], v[1]), cvtpk(v[2], v[3]), cvtpk(v[4], v[5]), cvtpk(v[6], v[7])}; }
struct EpiPlain {
    static constexpr bool MOE1 = false;
    bf16_t* C; int ldc;
    __device__ __forceinline__ void row8(int r, int c, const float (&v)[8]) const { *(u32x4*)(C + (size_t)r * ldc + c) = pack8(v); }
    __device__ __forceinline__ void pair(int, int, const float (&)[8], const float (&)[8]) const {}
};
struct EpiRowScale {
    static constexpr bool MOE1 = false;
    bf16_t* C; int ldc; const float* rs;
    __device__ __forceinline__ void row8(int r, int c, const float (&v)[8]) const { const float s = rs[r]; float w[8];
#pragma unroll
        for (int i = 0; i < 8; ++i) w[i] = v[i] * s;
        *(u32x4*)(C + (size_t)r * ldc + c) = pack8(w); }
    __device__ __forceinline__ void pair(int, int, const float (&)[8], const float (&)[8]) const {}
};
__device__ __forceinline__ void phase_gemm_plain(const bf16_t* A, int lda, const bf16_t* Bt, int K, bf16_t* C, int ldc, int nM, int nN) {
    const int G = gridDim.x;
    for (int u = blockIdx.x; u < nM * nN; u += G) {
        const int pm = u / nN, pn = u % nN;
        int aoff[2][2], boff[2];
        gm::make_off(aoff, pm * 256, lda); gm::make_off1(boff, pn * 128, K);
        EpiPlain epi{C + (size_t)pm * 256 * ldc + pn * 128, ldc};
        gm::gemm_tile(A, aoff, Bt, boff, K / 64, epi);
    }
}

struct Row16 { float4 v[4]; };
__device__ __forceinline__ Row16 ld_row_f32(const float* p, int lane) { Row16 r;
#pragma unroll
    for (int i = 0; i < 4; ++i) r.v[i] = *(const float4*)(p + lane * 4 + 256 * i);
    return r; }
__device__ __forceinline__ Row16 ld_row_bf16(const bf16_t* p, int lane) { Row16 r;
#pragma unroll
    for (int i = 0; i < 4; ++i) { const u32x2 w = *(const u32x2*)(p + lane * 4 + 256 * i);
        r.v[i] = make_float4(__uint_as_float(w.x << 16), __uint_as_float(w.x & 0xFFFF0000u), __uint_as_float(w.y << 16), __uint_as_float(w.y & 0xFFFF0000u)); }
    return r; }
__device__ __forceinline__ void st_row_f32(float* p, int lane, const Row16& r) {
#pragma unroll
    for (int i = 0; i < 4; ++i) *(float4*)(p + lane * 4 + 256 * i) = r.v[i]; }
__device__ __forceinline__ void st_row_bf16(bf16_t* p, int lane, const Row16& r) {
#pragma unroll
    for (int i = 0; i < 4; ++i) { u32x2 w; w.x = cvtpk(r.v[i].x, r.v[i].y); w.y = cvtpk(r.v[i].z, r.v[i].w); *(u32x2*)(p + lane * 4 + 256 * i) = w; } }
__device__ __forceinline__ float row_rstd(const Row16& r) {
    float s = 0.f;
#pragma unroll
    for (int i = 0; i < 4; ++i) s += r.v[i].x * r.v[i].x + r.v[i].y * r.v[i].y + r.v[i].z * r.v[i].z + r.v[i].w * r.v[i].w;
    s = wave_sum(s);
    return rsqrtf(s * (1.f / 1024.f) + EPSN);
}
__device__ __forceinline__ Row16 norm_mod(const Row16& x, float rstd, const float* g, const float* sc, const float* sh, int lane) {
    Row16 h;
#pragma unroll
    for (int i = 0; i < 4; ++i) {
        const int c = lane * 4 + 256 * i;
        const float4 gv = *(const float4*)(g + c), scv = *(const float4*)(sc + c), shv = *(const float4*)(sh + c);
        h.v[i].x = x.v[i].x * rstd * gv.x * (1.f + scv.x) + shv.x; h.v[i].y = x.v[i].y * rstd * gv.y * (1.f + scv.y) + shv.y;
        h.v[i].z = x.v[i].z * rstd * gv.z * (1.f + scv.z) + shv.z; h.v[i].w = x.v[i].w * rstd * gv.w * (1.f + scv.w) + shv.w;
    }
    return h;
}
__device__ __forceinline__ Row16 resid_add(const Row16& x, const Row16& y, float rstd, const float* g, const float* gate, int lane) {
    Row16 o;
#pragma unroll
    for (int i = 0; i < 4; ++i) {
        const int c = lane * 4 + 256 * i;
        const float4 gv = *(const float4*)(g + c), ga = *(const float4*)(gate + c);
        o.v[i].x = x.v[i].x + y.v[i].x * rstd * gv.x * ga.x; o.v[i].y = x.v[i].y + y.v[i].y * rstd * gv.y * ga.y;
        o.v[i].z = x.v[i].z + y.v[i].z * rstd * gv.z * ga.z; o.v[i].w = x.v[i].w + y.v[i].w * rstd * gv.w * ga.w;
    }
    return o;
}
__device__ __forceinline__ const float* mod_ptr(const Params& p, int l, int r) { return (const float*)(p.ws + WS_MOD) + (size_t)(l * 2 + (r < CTXN ? 1 : 0)) * 6144; }
__device__ __forceinline__ const float* src_row(const Params& p, int r) { return r < CTXN ? p.ctx + (size_t)r * 1024 : p.x + (size_t)(r - CTXN) * 1024; }

struct ModAB { float4 a[4], b[4]; };
struct ModG { float4 g[4]; };
__device__ __forceinline__ ModAB load_ab(const float* g, const float* sc, const float* sh, int lane) { ModAB m;
#pragma unroll
    for (int i = 0; i < 4; ++i) { const int c = lane * 4 + 256 * i; const float4 gv = *(const float4*)(g + c), sv = *(const float4*)(sc + c); m.b[i] = *(const float4*)(sh + c);
        m.a[i] = make_float4(gv.x * (1.f + sv.x), gv.y * (1.f + sv.y), gv.z * (1.f + sv.z), gv.w * (1.f + sv.w)); }
    return m; }
__device__ __forceinline__ ModG load_g(const float* g, const float* gate, int lane) { ModG m;
#pragma unroll
    for (int i = 0; i < 4; ++i) { const int c = lane * 4 + 256 * i; const float4 gv = *(const float4*)(g + c), ga = *(const float4*)(gate + c); m.g[i] = make_float4(gv.x * ga.x, gv.y * ga.y, gv.z * ga.z, gv.w * ga.w); }
    return m; }
__device__ __forceinline__ Row16 apply_ab(const Row16& x, float rstd, const ModAB& m) { Row16 h;
#pragma unroll
    for (int i = 0; i < 4; ++i) h.v[i] = make_float4(x.v[i].x * rstd * m.a[i].x + m.b[i].x, x.v[i].y * rstd * m.a[i].y + m.b[i].y, x.v[i].z * rstd * m.a[i].z + m.b[i].z, x.v[i].w * rstd * m.a[i].w + m.b[i].w);
    return h; }
__device__ __forceinline__ Row16 apply_g(const Row16& x, const Row16& y, float rstd, const ModG& m) { Row16 o;
#pragma unroll
    for (int i = 0; i < 4; ++i) o.v[i] = make_float4(x.v[i].x + y.v[i].x * rstd * m.g[i].x, x.v[i].y + y.v[i].y * rstd * m.g[i].y, x.v[i].z + y.v[i].z * rstd * m.g[i].z, x.v[i].w + y.v[i].w * rstd * m.g[i].w);
    return o; }
struct RowB8 { u32x2 v[4]; };
__device__ __forceinline__ RowB8 ld_rowb(const bf16_t* p, int lane) { RowB8 r;
#pragma unroll
    for (int i = 0; i < 4; ++i) r.v[i] = *(const u32x2*)(p + lane * 4 + 256 * i);
    return r; }
__device__ __forceinline__ Row16 cvt_rowb(const RowB8& b) { Row16 r;
#pragma unroll
    for (int i = 0; i < 4; ++i) r.v[i] = make_float4(__uint_as_float(b.v[i].x << 16), __uint_as_float(b.v[i].x & 0xFFFF0000u), __uint_as_float(b.v[i].y << 16), __uint_as_float(b.v[i].y & 0xFFFF0000u));
    return r; }

__device__ __forceinline__ void phase_norm1_l0(const Params& p) {
    const int lane = threadIdx.x & 63, wave = threadIdx.x >> 6, G = gridDim.x, step = G * 8;
    bf16_t* HB = (bf16_t*)(p.ws + WS_HB);
    int r = blockIdx.x * 8 + wave;
    if (r >= NTOK) return;
    int cur_s = (r < CTXN) ? 1 : 0;
    const float* mod = mod_ptr(p, 0, r);
    ModAB m = load_ab(p.norm_g, mod + 1024, mod, lane);
    Row16 x = ld_row_f32(src_row(p, r), lane);
    for (; r < NTOK; r += step) {
        const int rn = r + step;
        Row16 xn = x;
        if (rn < NTOK) xn = ld_row_f32(src_row(p, rn), lane);
        const int s_ = (r < CTXN) ? 1 : 0;
        if (s_ != cur_s) { cur_s = s_; const float* md = mod_ptr(p, 0, r); m = load_ab(p.norm_g, md + 1024, md, lane); }
        const float rstd = row_rstd(x);
        st_row_bf16(HB + (size_t)r * 1024, lane, apply_ab(x, rstd, m));
        x = xn;
    }
}

__device__ __forceinline__ void phase_mid(const Params& p, int l) {
    const int tid = tid_opaque(), lane = tid & 63, wave = tid >> 6, G = gridDim.x;
    float* wT = (float*)smem;
    int* lcnt = (int*)(smem + 139264);
    int* lbase = lcnt + 32;
    int* sel = lbase + 32;
    {
        const float4* src = (const float4*)((const float*)(p.ws + WS_RWT) + (size_t)l * 32 * 1024);
        for (int i = tid; i < 32 * 1024 / 4; i += NTH) ((float4*)wT)[i] = src[i];
        if (tid < 32) lcnt[tid] = 0;
    }
    __syncthreads();
    const int r_begin = (l == 0) ? 0 : CTXN;
    bf16_t* HB = (bf16_t*)(p.ws + WS_HB); const bf16_t* OB = (const bf16_t*)(p.ws + WS_OB);
    float* X1 = (float*)(p.ws + WS_X1); const float* X2 = (const float*)(p.ws + WS_X2);
    const float* ng = p.norm_g + (size_t)l * 4 * 1024;
    const float* rb = p.router_b + l * 32;
    float* GATE = (float*)(p.ws + WS_GATE);
    int it = 0;
    int r = r_begin + blockIdx.x * 8 + wave;
    const int step = G * 8;
    int cur_s = -1; ModG mg; ModAB mab;
    Row16 xin; RowB8 ob;
    if (r < NTOK) { xin = (l == 0) ? ld_row_f32(src_row(p, r), lane) : ld_row_f32(X2 + (size_t)r * 1024, lane); ob = ld_rowb(OB + (size_t)r * 1024, lane); }
    for (; r < NTOK; r += step, ++it) {
        const int rn = r + step;
        Row16 xin_n = xin; RowB8 ob_n = ob;
        if (rn < NTOK) { xin_n = (l == 0) ? ld_row_f32(src_row(p, rn), lane) : ld_row_f32(X2 + (size_t)rn * 1024, lane); ob_n = ld_rowb(OB + (size_t)rn * 1024, lane); }
        const int s_ = (r < CTXN) ? 1 : 0;
        if (s_ != cur_s) { cur_s = s_; const float* mod = mod_ptr(p, l, r); mg = load_g(ng + 1024, mod + 2048, lane); mab = load_ab(ng + 2048, mod + 4096, mod + 3072, lane); }
        const Row16 o = cvt_rowb(ob);
        const float rso = row_rstd(o);
        const Row16 x1 = apply_g(xin, o, rso, mg);
        st_row_f32(X1 + (size_t)r * 1024, lane, x1);
        const float rs1 = row_rstd(x1);
        const Row16 h = apply_ab(x1, rs1, mab);
        st_row_bf16(HB + (size_t)r * 1024, lane, h);
        xin = xin_n; ob = ob_n;
        float part[32];
        {
            const float* wl = wT + lane * 4;
            float4 wa[4], wb[4];
#pragma unroll
            for (int i = 0; i < 4; ++i) wa[i] = *(const float4*)(wl + 256 * i);
#pragma unroll
            for (int e = 0; e < 32; e += 2) {
#pragma unroll
                for (int i = 0; i < 4; ++i) wb[i] = *(const float4*)(wl + (e + 1) * 1024 + 256 * i);
                { float a = 0.f;
#pragma unroll
                  for (int i = 0; i < 4; ++i) a += h.v[i].x * wa[i].x + h.v[i].y * wa[i].y + h.v[i].z * wa[i].z + h.v[i].w * wa[i].w;
                  part[e] = a; }
                if (e + 2 < 32) {
#pragma unroll
                    for (int i = 0; i < 4; ++i) wa[i] = *(const float4*)(wl + (e + 2) * 1024 + 256 * i);
                }
                { float a = 0.f;
#pragma unroll
                  for (int i = 0; i < 4; ++i) a += h.v[i].x * wb[i].x + h.v[i].y * wb[i].y + h.v[i].z * wb[i].z + h.v[i].w * wb[i].w;
                  part[e + 1] = a; }
            }
        }
#define TR_STEP(NV, BIT) _Pragma("unroll") for (int i = 0; i < (NV) / 2; ++i) { const float lo = part[i], hi_ = part[i + (NV) / 2]; const bool up = (lane & (BIT)) != 0; \
            const float send = up ? lo : hi_, keep = up ? hi_ : lo; part[i] = keep + __shfl_xor(send, (BIT)); }
        TR_STEP(32, 32) TR_STEP(16, 16) TR_STEP(8, 8) TR_STEP(4, 4) TR_STEP(2, 2)
#undef TR_STEP
        float logit = part[0] + __shfl_xor(part[0], 1);
        const int myexp = lane >> 1;
        logit += rb[myexp];
        float val = (lane & 1) ? -3.0e38f : logit;
        float tv[4]; int ti[4];
#pragma unroll
        for (int k = 0; k < 4; ++k) {
            float bv = val; int bi = myexp;
#pragma unroll
            for (int off = 32; off >= 1; off >>= 1) { const float ov = __shfl_xor(bv, off); const int oi = __shfl_xor(bi, off); if (ov > bv || (ov == bv && oi < bi)) { bv = ov; bi = oi; } }
            tv[k] = bv; ti[k] = bi;
            if (myexp == bi) val = -3.0e38f;
        }
        const float e1 = __expf(tv[1] - tv[0]), e2 = __expf(tv[2] - tv[0]), e3 = __expf(tv[3] - tv[0]);
        const float inv = 1.f / (1.f + e1 + e2 + e3);
        if (lane < 4) {
            const int k = lane;
            const int e = (k == 0) ? ti[0] : (k == 1) ? ti[1] : (k == 2) ? ti[2] : ti[3];
            const float gk = ((k == 0) ? 1.f : (k == 1) ? e1 : (k == 2) ? e2 : e3) * inv;
            GATE[(size_t)r * 4 + k] = gk;
            const int lp = atomicAdd(&lcnt[e], 1);
            sel[(it * 8 + wave) * 4 + k] = e | (lp << 8);
        }
    }
    __syncthreads();
    int* CNT = (int*)(p.ws + WS_CNT) + l * 32;
    if (tid < 32) lbase[tid] = atomicAdd(&CNT[tid], lcnt[tid]);
    __syncthreads();
    {
        int* TOPE = (int*)(p.ws + WS_TOPE); int* TOPP = (int*)(p.ws + WS_TOPP); int* LIST = (int*)(p.ws + WS_LIST);
        for (int q = tid; q < 80 * 4; q += NTH) {
            const int slot = q >> 2, k = q & 3, itq = slot >> 3, wv = slot & 7;
            const int r = r_begin + blockIdx.x * 8 + wv + itq * G * 8;
            if (r < NTOK) {
                const int s = sel[q], e = s & 255, lp = s >> 8, pos = lbase[e] + lp;
                TOPE[(size_t)r * 4 + k] = e; TOPP[(size_t)r * 4 + k] = pos; LIST[(size_t)e * NTOK + pos] = r;
            }
        }
    }
    __syncthreads();
}

struct MoeLds { int* cnt; int* off; int* toff; };
__device__ __forceinline__ MoeLds moe_setup(const Params& p, int l, char* base) {
    MoeLds m; m.cnt = (int*)base; m.off = m.cnt + 32; m.toff = m.off + 33;
    const int tid = tid_opaque();
    if (tid < 64) {
        const int e = tid & 31;
        const int cval = ((const int*)(p.ws + WS_CNT))[l * 32 + e];
        const int tiles = (cval + 255) >> 8;
        int pc = cval, pt = tiles;
#pragma unroll
        for (int o = 1; o < 32; o <<= 1) { const int a = __shfl_up(pc, o, 32), b = __shfl_up(pt, o, 32); if (e >= o) { pc += a; pt += b; } }
        if (tid < 32) { m.cnt[e] = cval; m.off[e + 1] = pc; m.toff[e + 1] = pt; if (e == 0) { m.off[0] = 0; m.toff[0] = 0; } }
    }
    __syncthreads();
    return m;
}

__device__ __forceinline__ void phase_end(const Params& p, int l) {
    const int tid = tid_opaque(), lane = tid & 63, wave = tid >> 6, G = gridDim.x;
    MoeLds ml = moe_setup(p, l, smem);
    const int r_begin = (l == 0) ? 0 : CTXN;
    const bf16_t* YB = (const bf16_t*)(p.ws + WS_YB);
    const float* X1 = (const float*)(p.ws + WS_X1); float* X2 = (float*)(p.ws + WS_X2);
    bf16_t* HB = (bf16_t*)(p.ws + WS_HB);
    const int* TOPE = (const int*)(p.ws + WS_TOPE); const int* TOPP = (const int*)(p.ws + WS_TOPP); const float* GATE = (const float*)(p.ws + WS_GATE);
    const float* ng = p.norm_g + (size_t)l * 4 * 1024;
    int cur_s = -1; ModG mg; ModAB mab;
    int r = r_begin + blockIdx.x * 8 + wave;
    int4 en = make_int4(0, 0, 0, 0), pn = make_int4(0, 0, 0, 0); float4 gn = make_float4(0.f, 0.f, 0.f, 0.f);
    const int step = G * 8;
    if (r < NTOK) { en = *(const int4*)(TOPE + (size_t)r * 4); pn = *(const int4*)(TOPP + (size_t)r * 4); gn = *(const float4*)(GATE + (size_t)r * 4); }
    RowB8 t4n[4]; Row16 x1n; float4 gcur = gn;
    if (r < NTOK) {
        t4n[0] = ld_rowb(YB + (size_t)(ml.off[en.x] + pn.x) * 1024, lane); t4n[1] = ld_rowb(YB + (size_t)(ml.off[en.y] + pn.y) * 1024, lane);
        t4n[2] = ld_rowb(YB + (size_t)(ml.off[en.z] + pn.z) * 1024, lane); t4n[3] = ld_rowb(YB + (size_t)(ml.off[en.w] + pn.w) * 1024, lane);
        x1n = ld_row_f32(X1 + (size_t)r * 1024, lane);
        if (r + step < NTOK) { en = *(const int4*)(TOPE + (size_t)(r + step) * 4); pn = *(const int4*)(TOPP + (size_t)(r + step) * 4); gn = *(const float4*)(GATE + (size_t)(r + step) * 4); }
    }
    for (; r < NTOK; r += step) {
        RowB8 t4[4]; t4[0] = t4n[0]; t4[1] = t4n[1]; t4[2] = t4n[2]; t4[3] = t4n[3];
        const Row16 x1 = x1n;
        const float g4[4] = {gcur.x, gcur.y, gcur.z, gcur.w};
        const int rn = r + step;
        if (rn < NTOK) {
            t4n[0] = ld_rowb(YB + (size_t)(ml.off[en.x] + pn.x) * 1024, lane); t4n[1] = ld_rowb(YB + (size_t)(ml.off[en.y] + pn.y) * 1024, lane);
            t4n[2] = ld_rowb(YB + (size_t)(ml.off[en.z] + pn.z) * 1024, lane); t4n[3] = ld_rowb(YB + (size_t)(ml.off[en.w] + pn.w) * 1024, lane);
            x1n = ld_row_f32(X1 + (size_t)rn * 1024, lane);
            gcur = gn;
            if (rn + step < NTOK) { en = *(const int4*)(TOPE + (size_t)(rn + step) * 4); pn = *(const int4*)(TOPP + (size_t)(rn + step) * 4); gn = *(const float4*)(GATE + (size_t)(rn + step) * 4); }
        }
        const int s_ = (r < CTXN) ? 1 : 0;
        if (s_ != cur_s) { cur_s = s_; const float* mod = mod_ptr(p, l, r); mg = load_g(ng + 3072, mod + 5120, lane);
            if (l == 0) { const float* mod1 = mod_ptr(p, 1, r); mab = load_ab(p.norm_g + (size_t)4 * 1024, mod1 + 1024, mod1, lane); } }
        Row16 y;
#pragma unroll
        for (int i = 0; i < 4; ++i) y.v[i] = make_float4(0.f, 0.f, 0.f, 0.f);
#pragma unroll
        for (int k = 0; k < 4; ++k) { const Row16 t = cvt_rowb(t4[k]); const float gk = g4[k];
#pragma unroll
            for (int i = 0; i < 4; ++i) { y.v[i].x += gk * t.v[i].x; y.v[i].y += gk * t.v[i].y; y.v[i].z += gk * t.v[i].z; y.v[i].w += gk * t.v[i].w; } }
        const float rsy = row_rstd(y);
        const Row16 x2 = apply_g(x1, y, rsy, mg);
        if (l == 0) {
            st_row_f32(X2 + (size_t)r * 1024, lane, x2);
            const float rs2 = row_rstd(x2);
            st_row_bf16(HB + (size_t)r * 1024, lane, apply_ab(x2, rs2, mab));
        } else {
            st_row_f32(p.out + (size_t)(r - CTXN) * 1024, lane, x2);
        }
    }
    __syncthreads();
}

__device__ __forceinline__ void phase_gemm_pg8(const bf16_t* A, int lda, const bf16_t* Bt, int K, bf16_t* C, int ldc, int nM, int nN) {
    pg8::PlainOrder S; S.init(A, lda, Bt, K, nM, nN);
    pg8::EpiStore E{C, ldc, nullptr};
    pg8::gemm_phase<pg8::EpiStore, pg8::PlainOrder, false>((PG8_LAS unsigned char*)smem, S, E, K, lda, K);
    __syncthreads();
}
constexpr int MOE_GL_OFF = 131072, MOE_ML_OFF = 143360, MOE_TAB_OFF = 143872, MOE_GL_MAX = 12;
__device__ __forceinline__ void phase_moe1(const Params& p, int l) {
    MoeLds ml = moe_setup(p, l, smem + MOE_ML_OFF);
    const int tid = tid_opaque();
    PG8_LAS int* gl = (PG8_LAS int*)(smem + MOE_GL_OFF);
    PG8_LAS int* tab = (PG8_LAS int*)(smem + MOE_TAB_OFF);
    pg8::MoeOrderG S;
    S.A = (const char*)(p.ws + WS_HB); S.W = (const char*)(p.ws + WS_W1T) + (size_t)l * 32 * 2048 * 2048;
    S.tab = tab; S.gl = gl; S.wrows = 2048;
    S.nunits = pg8::moe_build_units(tab, ml.cnt, ml.off, ml.toff, 8);
    if (S.nunits > MOE_GL_MAX) S.nunits = MOE_GL_MAX;
    const int* LIST = (const int*)(p.ws + WS_LIST);
    for (int i = 0; i < S.nunits; ++i) {
        const int e = tab[i * 8 + 2], mt = tab[i * 8 + 0], nvalid = tab[i * 8 + 3], m = mt - ml.toff[e];
        if (tid < 256) gl[i * 256 + tid] = (tid < nvalid) ? LIST[(size_t)e * NTOK + m * 256 + tid] : 0;
    }
    __syncthreads();
    pg8::EpiAct E{(bf16_t*)(p.ws + WS_ACT), p.moe_b1 + (size_t)l * 32 * 2048};
    pg8::gemm_phase<pg8::EpiAct, pg8::MoeOrderG, true>((PG8_LAS unsigned char*)smem, S, E, 1024, 1024, 1024);
    __syncthreads();
}
__device__ __forceinline__ void phase_moe2(const Params& p, int l) {
    MoeLds ml = moe_setup(p, l, smem + MOE_ML_OFF);
    PG8_LAS int* tab = (PG8_LAS int*)(smem + MOE_TAB_OFF);
    pg8::MoeOrder S;
    S.A = (const char*)(p.ws + WS_ACT); S.W = (const char*)(p.ws + WS_W2T) + (size_t)l * 32 * 1024 * 2048;
    S.tab = tab; S.gl = nullptr; S.wrows = 1024;
    S.nunits = pg8::moe_build_units(tab, ml.cnt, ml.off, ml.toff, 4);
    pg8::EpiBias E{(bf16_t*)(p.ws + WS_YB), p.moe_b2 + (size_t)l * 32 * 1024};
    pg8::gemm_phase<pg8::EpiBias, pg8::MoeOrder, false>((PG8_LAS unsigned char*)smem, S, E, 1024, 1024, 1024);
    __syncthreads();
}

__device__ __forceinline__ void gla_local_units(const Params& p);
__device__ __forceinline__ void rope8(const float* rope, int t, int j0, const u32x4& a, const u32x4& b, u32x4& oa, u32x4& ob);
__device__ __forceinline__ void rowstat(const bf16_t* A, int lda, int K, float* rs) {
    const int tid = tid_opaque(), r = tid >> 1, hf = tid & 1, half = K / 2;
    const bf16_t* q = A + (size_t)r * lda + hf * half;
    float s = 0.f;
    for (int i = 0; i < half; i += 8) { const u32x4 w = *(const u32x4*)(q + i);
#pragma unroll
        for (int j = 0; j < 4; ++j) { const float a = __uint_as_float(w[j] << 16), b = __uint_as_float(w[j] & 0xFFFF0000u); s += a * a + b * b; } }
    s += __shfl_xor(s, 1);
    if (hf == 0) rs[r] = rsqrtf(s / (float)K + EPSN);
    __syncthreads();
}
__device__ __forceinline__ void phase_mla_up(const Params& p) {
    const int G = gridDim.x, tid = threadIdx.x;
    const bf16_t* P = (const bf16_t*)(p.ws + WS_P);
    float* rs = (float*)(smem + 139264);
    const int nM = NTOK / 256;
    {
        pg8::PlainOrder S; S.init(P + PC_CQ, PW, (const bf16_t*)(p.ws + WS_WUQ), 256, nM, 3);
        pg8::Unit u;
        if (S.next(0, u)) rowstat(P + (size_t)u.pm * 256 * PW + PC_CQ, PW, 256, rs);
        pg8::EpiStore E{(bf16_t*)(p.ws + WS_QM), 768, rs};
        pg8::gemm_phase<pg8::EpiStore, pg8::PlainOrder, false>((PG8_LAS unsigned char*)smem, S, E, 256, PW, 256);
        __syncthreads();
    }
    for (int v = (blockIdx.x + G - 195) % G; v < nM * 8; v += G) {
        int aoff[2][2], boff[2];
        const int pm = v >> 3, pn = v & 7, h = pn >> 1;
        rowstat(P + (size_t)pm * 256 * PW + PC_CKV, PW, 128, rs);
        gm::make_off(aoff, pm * 256, PW); gm::make_off1(boff, pn * 128, 128);
        bf16_t* dst = (pn & 1) ? (bf16_t*)(p.ws + WS_VM) + (size_t)pm * 256 * 512 + h * 128 : (bf16_t*)(p.ws + WS_KM) + (size_t)pm * 256 * 768 + h * 192;
        EpiRowScale epi{dst, (pn & 1) ? 512 : 768, rs};
        gm::gemm_tile(P + PC_CKV, aoff, (const bf16_t*)(p.ws + WS_WUKV), boff, 2, epi);
    }
    const float* rope = (const float*)(p.ws + WS_ROPE);
    bf16_t* KM = (bf16_t*)(p.ws + WS_KM);
    for (int i = blockIdx.x * NTH + tid; i < NTOK * 4; i += G * NTH) {
        const int r = i >> 2, j0 = (i & 3) * 8;
        const u32x4 a = *(const u32x4*)(P + (size_t)r * PW + PC_KR + j0), b = *(const u32x4*)(P + (size_t)r * PW + PC_KR + 32 + j0);
        u32x4 oa = a, ob = b;
        if (r >= CTXN) rope8(rope, r - CTXN, j0, a, b, oa, ob);
#pragma unroll
        for (int h = 0; h < 4; ++h) { *(u32x4*)(KM + (size_t)r * 768 + h * 192 + 128 + j0) = oa; *(u32x4*)(KM + (size_t)r * 768 + h * 192 + 160 + j0) = ob; }
    }
    __syncthreads();
    gla_local_units(p);
}

struct GlaB { float b[16]; float total; };
__device__ __forceinline__ GlaB gla_decay(const Params& p, int gc, int h, float* scr  ) {
    const int tid = threadIdx.x, lane = tid & 63, wave = tid >> 6, dir = wave & 1, tq = wave >> 1;
    const bf16_t* P = (const bf16_t*)(p.ws + WS_P);
    float* af = scr;
    float* wa = scr + 2048;
    float* ba = scr + 4096;
    float* tot = scr + 4224;
#pragma unroll
    for (int i = 0; i < 4; ++i) {
        const int idx = tid + 512 * i, dd = idx >> 10, t = (idx >> 4) & 63, j = idx & 15;
        af[idx] = bf2f(P[(size_t)(gc * 64 + t) * PW + PC_AF + dd * 16 + j]);
        const int jj = (idx >> 6) & 15, d = idx & 63;
        wa[idx] = (dd == 0 ? p.gla_wa_f : p.gla_wa_b)[jj * 256 + h * 64 + d];
    }
    if (tid < 128) ba[tid] = ((tid >> 6) == 0 ? p.gla_ba_f : p.gla_ba_b)[h * 64 + (tid & 63)];
    __syncthreads();
    float w[16];
#pragma unroll
    for (int j = 0; j < 16; ++j) w[j] = wa[(dir * 16 + j) * 64 + lane];
    const float bias = ba[dir * 64 + lane];
    GlaB r;
#pragma unroll
    for (int i = 0; i < 16; ++i) {
        const int t = tq * 16 + i;
        float z = bias;
#pragma unroll
        for (int j = 0; j < 16; ++j) z += af[(dir * 64 + t) * 16 + j] * w[j];
        const float g = (fminf(z, 0.f) - __logf(1.f + __expf(-fabsf(z)))) * (1.f / 16.f);
        r.b[i] = g;
    }
    if (dir == 0) {
#pragma unroll
        for (int i = 1; i < 16; ++i) r.b[i] += r.b[i - 1];
        tot[(dir * 4 + tq) * 64 + lane] = r.b[15];
    } else {
#pragma unroll
        for (int i = 14; i >= 0; --i) r.b[i] += r.b[i + 1];
        tot[(dir * 4 + tq) * 64 + lane] = r.b[0];
    }
    __syncthreads();
    float offs = 0.f, total = 0.f;
#pragma unroll
    for (int q = 0; q < 4; ++q) { const float tv = tot[(dir * 4 + q) * 64 + lane]; total += tv; if (dir == 0 ? (q < tq) : (q > tq)) offs += tv; }
#pragma unroll
    for (int i = 0; i < 16; ++i) r.b[i] += offs;
    r.total = total;
    return r;
}

__device__ __forceinline__ void gla_stage_vt(const bf16_t* P, int gc, int h, bf16_t* VT) {
    const int tid = threadIdx.x, v = tid & 127, sq = tid >> 7;
    unsigned pk[8];
#pragma unroll
    for (int i = 0; i < 8; ++i) {
        const bf16_t a = P[(size_t)(gc * 64 + sq * 16 + 2 * i) * PW + PC_V + h * 128 + v], b = P[(size_t)(gc * 64 + sq * 16 + 2 * i + 1) * PW + PC_V + h * 128 + v];
        pk[i] = a | ((unsigned)b << 16);
    }
    *(u32x4*)(VT + v * 72 + sq * 16) = (u32x4){pk[0], pk[1], pk[2], pk[3]};
    *(u32x4*)(VT + v * 72 + sq * 16 + 8) = (u32x4){pk[4], pk[5], pk[6], pk[7]};
}

struct GlaPreL { u32x4 kc, vc[2], ac; float4 wac; float bac; };
__device__ __forceinline__ void gla_prefetch_local(const Params& p, int gc, int h, GlaPreL& g) {
    const int tid = threadIdx.x;
    const bf16_t* P = (const bf16_t*)(p.ws + WS_P);
    g.kc = *(const u32x4*)(P + (size_t)(gc * 64 + (tid >> 3)) * PW + PC_K + h * 64 + (tid & 7) * 8);
#pragma unroll
    for (int i = 0; i < 2; ++i) { const int idx = tid + 512 * i; g.vc[i] = *(const u32x4*)(P + (size_t)(gc * 64 + (idx >> 4)) * PW + PC_V + h * 128 + (idx & 15) * 8); }
    g.ac = *(const u32x4*)(P + (size_t)(gc * 64 + ((tid & 255) >> 2)) * PW + PC_AF + (tid & 3) * 8);
    { const int dd = tid >> 8, jj = (tid >> 4) & 15, d4 = tid & 15; g.wac = *(const float4*)((dd == 0 ? p.gla_wa_f : p.gla_wa_b) + jj * 256 + h * 64 + d4 * 4); }
    g.bac = ((tid >> 6) & 1 ? p.gla_ba_b : p.gla_ba_f)[h * 64 + (tid & 63)];
}
template <int OFF> __device__ __forceinline__ s16x4 glal_tr(int vb) { s16x4 r; asm volatile("ds_read_b64_tr_b16 %0, %1 offset:%2" : "=&v"(r) : "v"(vb), "i"(OFF) : "memory"); return r; }
__device__ __forceinline__ void gla_local_units(const Params& p) {
    const int tid = threadIdx.x, lane = tid & 63, wave = tid >> 6, r32 = lane & 31, hi = lane >> 5, G = gridDim.x;
    bf16_t* kdT = (bf16_t*)smem;
    bf16_t* Kraw = kdT + 2 * 64 * 72;
    char* Vraw = smem + 27648;
    float* af = (float*)(smem + 49152);
    float* wa = af + 2048; float* ba = wa + 2048; float* tot = ba + 128;
    bf16_t* U = (bf16_t*)(p.ws + WS_U); float* DEC = (float*)(p.ws + WS_DEC);
    int u = blockIdx.x;
    if (u >= NCH * 4) return;
    GlaPreL g;
    gla_prefetch_local(p, u >> 2, u & 3, g);
    const int dir = wave & 1, tq = wave >> 1;
    for (; u < NCH * 4; u += G) {
        const int gc = u >> 2, h = u & 3;
        *(u32x4*)(Kraw + (tid >> 3) * 72 + (tid & 7) * 8) = g.kc;
#pragma unroll
        for (int i = 0; i < 2; ++i) { const int idx = tid + 512 * i; *(u32x4*)(Vraw + (idx >> 4) * 320 + (idx & 15) * 16) = g.vc[i]; }
        if (tid < 256) { const int t = tid >> 2, ch = tid & 3, dd = ch >> 1, j0 = (ch & 1) * 8; float* q = af + dd * 1024 + t * 16 + j0;
#pragma unroll
            for (int e = 0; e < 4; ++e) { q[2 * e] = __uint_as_float(g.ac[e] << 16); q[2 * e + 1] = __uint_as_float(g.ac[e] & 0xFFFF0000u); } }
        { const int dd = tid >> 8, jj = (tid >> 4) & 15, d4 = tid & 15; *(float4*)(wa + (dd * 16 + jj) * 64 + d4 * 4) = g.wac; }
        if (tid < 128) ba[tid] = g.bac;
        __syncthreads();
        const int un = u + G;
        if (un < NCH * 4) gla_prefetch_local(p, un >> 2, un & 3, g);
        float bb[16]; float total = 0.f;
        {
            float w[16];
#pragma unroll
            for (int j = 0; j < 16; ++j) w[j] = wa[(dir * 16 + j) * 64 + lane];
            const float bias = ba[dir * 64 + lane];
#pragma unroll
            for (int i = 0; i < 16; ++i) {
                const int t = tq * 16 + i;
                float z = bias;
#pragma unroll
                for (int j = 0; j < 16; ++j) z += af[(dir * 64 + t) * 16 + j] * w[j];
                bb[i] = (fminf(z, 0.f) - __logf(1.f + __expf(-fabsf(z)))) * (1.f / 16.f);
            }
            if (dir == 0) {
#pragma unroll
                for (int i = 1; i < 16; ++i) bb[i] += bb[i - 1];
                tot[(dir * 4 + tq) * 64 + lane] = bb[15];
            } else {
#pragma unroll
                for (int i = 14; i >= 0; --i) bb[i] += bb[i + 1];
                tot[(dir * 4 + tq) * 64 + lane] = bb[0];
            }
        }
        __syncthreads();
        {
            float offs = 0.f;
#pragma unroll
            for (int q = 0; q < 4; ++q) { const float tv = tot[(dir * 4 + q) * 64 + lane]; total += tv; if (dir == 0 ? (q < tq) : (q > tq)) offs += tv; }
#pragma unroll
            for (int i = 0; i < 16; ++i) bb[i] += offs;
        }
        {
            unsigned pk[8];
#pragma unroll
            for (int i = 0; i < 8; ++i) {
                const int s0 = tq * 16 + 2 * i;
                const float k0 = bf2f(Kraw[s0 * 72 + lane]), k1 = bf2f(Kraw[(s0 + 1) * 72 + lane]);
                pk[i] = cvtpk(k0 * __expf(total - bb[2 * i]), k1 * __expf(total - bb[2 * i + 1]));
            }
            *(u32x4*)(kdT + (dir * 64 + lane) * 72 + tq * 16) = (u32x4){pk[0], pk[1], pk[2], pk[3]};
            *(u32x4*)(kdT + (dir * 64 + lane) * 72 + tq * 16 + 8) = (u32x4){pk[4], pk[5], pk[6], pk[7]};
            if (tq == 0) DEC[((size_t)(dir * NCH + gc) * 4 + h) * 64 + lane] = __expf(total);
        }
        __syncthreads();
        {
            const int mdir = wave >> 2, vbk = wave & 3;
            const int vb = (int)(uintptr_t)Vraw + (8 * hi + ((lane & 15) >> 2)) * 320 + (vbk * 32 + 16 * ((lane >> 4) & 1) + 4 * (lane & 3)) * 2;
            f32x16 a0 = {}, a1 = {};
#define GLAL_STEP(KS) do { const s16x4 l_ = glal_tr<(KS) * 5120>(vb), h_ = glal_tr<(KS) * 5120 + 1280>(vb); \
            const bf16x8 b0 = *(const bf16x8*)(kdT + (mdir * 64 + r32) * 72 + (KS) * 16 + hi * 8); \
            const bf16x8 b1 = *(const bf16x8*)(kdT + (mdir * 64 + 32 + r32) * 72 + (KS) * 16 + hi * 8); \
            asm volatile("s_waitcnt lgkmcnt(0)" ::: "memory"); SBAR(); \
            const bf16x8 a_ = (bf16x8){l_[0], l_[1], l_[2], l_[3], h_[0], h_[1], h_[2], h_[3]}; \
            a0 = __builtin_amdgcn_mfma_f32_32x32x16_bf16(a_, b0, a0, 0, 0, 0); a1 = __builtin_amdgcn_mfma_f32_32x32x16_bf16(a_, b1, a1, 0, 0, 0); } while (0)
            GLAL_STEP(0); GLAL_STEP(1); GLAL_STEP(2); GLAL_STEP(3);
#undef GLAL_STEP
            bf16_t* Uo = U + ((size_t)(mdir * NCH + gc) * 4 + h) * 8192;
#pragma unroll
            for (int r = 0; r < 16; ++r) { const int v = vbk * 32 + crow(r, hi); Uo[v * 64 + r32] = f2bf(a0[r]); Uo[v * 64 + 32 + r32] = f2bf(a1[r]); }
        }
        __syncthreads();
    }
}
__device__ __forceinline__ void rope8(const float* rope, int t, int j0, const u32x4& a, const u32x4& b, u32x4& oa, u32x4& ob) {
    const int row = t >> 6, col = t & 63;
    const float* cs = (j0 < 16) ? rope + row * 16 + j0 : rope + 512 * 16 + col * 16 + (j0 - 16);
    const float* sn = (j0 < 16) ? rope + 256 * 16 + row * 16 + j0 : rope + 512 * 16 + 64 * 16 + col * 16 + (j0 - 16);
    const f32x4 c0 = *(const f32x4*)cs, c1 = *(const f32x4*)(cs + 4), s0 = *(const f32x4*)sn, s1 = *(const f32x4*)(sn + 4);
#pragma unroll
    for (int e = 0; e < 4; ++e) {
        const float x1l = __uint_as_float(a[e] << 16), x1h = __uint_as_float(a[e] & 0xFFFF0000u), x2l = __uint_as_float(b[e] << 16), x2h = __uint_as_float(b[e] & 0xFFFF0000u);
        const float cl = (e < 2) ? c0[2 * e] : c1[2 * e - 4], ch = (e < 2) ? c0[2 * e + 1] : c1[2 * e - 3], sl = (e < 2) ? s0[2 * e] : s1[2 * e - 4], sh = (e < 2) ? s0[2 * e + 1] : s1[2 * e - 3];
        oa[e] = cvtpk(x1l * cl - x2l * sl, x1h * ch - x2h * sh);
        ob[e] = cvtpk(x1l * sl + x2l * cl, x1h * sh + x2h * ch);
    }
}
__device__ __forceinline__ void qrope_pass(const Params& p, int b0, int nb) {
    const int tid = threadIdx.x;
    const float* rope = (const float*)(p.ws + WS_ROPE);
    bf16_t* QM = (bf16_t*)(p.ws + WS_QM);
    for (int i = (blockIdx.x - b0) * NTH + tid; i < SEQ * 16; i += nb * NTH) {
        const int t = i >> 4, hh = (i >> 2) & 3, j0 = (i & 3) * 8;
        bf16_t* q = QM + (size_t)(CTXN + t) * 768 + hh * 192 + 128 + j0;
        const u32x4 a = *(const u32x4*)q, b = *(const u32x4*)(q + 32);
        u32x4 oa, ob; rope8(rope, t, j0, a, b, oa, ob);
        *(u32x4*)q = oa; *(u32x4*)(q + 32) = ob;
    }
}

__device__ __forceinline__ int gla_order(int dir, int step) { return dir == 0 ? step : (step < 4 ? 3 - step : NCH - 1 - (step - 4)); }
__device__ __forceinline__ void phase_gla_scan(const Params& p) {
    const int gid = blockIdx.x * NTH + threadIdx.x;
    if (gid >= 2 * 4 * 8192) { qrope_pass(p, 128, (int)gridDim.x - 128); return; }
    const int dir = gid >> 15, h = (gid >> 13) & 3, e = gid & 8191, d = e & 63;
    const bf16_t* U = (const bf16_t*)(p.ws + WS_U); bf16_t* S = (bf16_t*)(p.ws + WS_SIN); const float* DEC = (const float*)(p.ws + WS_DEC);
    float s = 0.f;
#pragma unroll 1
    for (int s0 = 0; s0 < NCH; s0 += 52) {
        float uu[52], dc[52];
#pragma unroll
        for (int i = 0; i < 52; ++i) { const size_t o = ((size_t)(dir * NCH + gla_order(dir, s0 + i)) * 4 + h); uu[i] = bf2f(U[o * 8192 + e]); dc[i] = DEC[o * 64 + d]; }
#pragma unroll
        for (int i = 0; i < 52; ++i) { const size_t o = ((size_t)(dir * NCH + gla_order(dir, s0 + i)) * 4 + h); S[o * 8192 + e] = f2bf(s); s = dc[i] * s + uu[i]; }
    }
}

__device__ __forceinline__ void gla_out_unit(const Params& p, int gc, int h) {
    const int tid = threadIdx.x, lane = tid & 63, wave = tid >> 6, r32 = lane & 31, hi = lane >> 5;
    const bf16_t* P = (const bf16_t*)(p.ws + WS_P);
    bf16_t* qe = (bf16_t*)smem;
    bf16_t* ke = qe + 2 * 64 * 72;
    bf16_t* Am = ke + 2 * 64 * 72;
    bf16_t* VT = Am + 2 * 64 * 72;
    bf16_t* ST = VT + 128 * 72;
    float* scr = (float*)(smem + 110592);
    float* ob = (float*)(ke);
    const GlaB gb = gla_decay(p, gc, h, scr);
    {
        const int dir = wave & 1, tq = wave >> 1;
#pragma unroll
        for (int i = 0; i < 16; ++i) {
            const int t = tq * 16 + i;
            const float qv = bf2f(P[(size_t)(gc * 64 + t) * PW + PC_Q + h * 64 + lane]) * 0.125f, kv = bf2f(P[(size_t)(gc * 64 + t) * PW + PC_K + h * 64 + lane]);
            qe[(dir * 64 + t) * 72 + lane] = f2bf(qv * __expf(gb.b[i]));
            ke[(dir * 64 + t) * 72 + lane] = f2bf(kv * __expf(-gb.b[i]));
        }
    }
    gla_stage_vt(P, gc, h, VT);
    {
        const bf16_t* S = (const bf16_t*)(p.ws + WS_SIN);
#pragma unroll
        for (int i = 0; i < 4; ++i) {
            const int cc = tid + 512 * i, dir = cc >> 10, v = (cc >> 3) & 127, ch = cc & 7;
            *(u32x4*)(ST + (dir * 128 + v) * 72 + ch * 8) = *(const u32x4*)(S + ((size_t)(dir * NCH + gc) * 4 + h) * 8192 + v * 64 + ch * 8);
        }
    }
    __syncthreads();
    {
        const int dir = wave >> 2, tb = (wave >> 1) & 1, sb = wave & 1;
        f32x16 acc = {};
#pragma unroll
        for (int ks = 0; ks < 4; ++ks) {
            const bf16x8 a = *(const bf16x8*)(qe + (dir * 64 + tb * 32 + r32) * 72 + ks * 16 + hi * 8);
            const bf16x8 b = *(const bf16x8*)(ke + (dir * 64 + sb * 32 + r32) * 72 + ks * 16 + hi * 8);
            acc = __builtin_amdgcn_mfma_f32_32x32x16_bf16(a, b, acc, 0, 0, 0);
        }
        const int s = sb * 32 + r32;
#pragma unroll
        for (int r = 0; r < 16; ++r) { const int t = tb * 32 + crow(r, hi); const bool keep = (dir == 0) ? (s <= t) : (s >= t); Am[(dir * 64 + t) * 72 + s] = f2bf(keep ? acc[r] : 0.f); }
    }
    __syncthreads();
    f32x16 o = {};
    const int tb = wave >> 2, vb = wave & 3;
#pragma unroll
    for (int dir = 0; dir < 2; ++dir)
#pragma unroll
        for (int ks = 0; ks < 4; ++ks) {
            const bf16x8 a1 = *(const bf16x8*)(Am + (dir * 64 + tb * 32 + r32) * 72 + ks * 16 + hi * 8);
            const bf16x8 b1 = *(const bf16x8*)(VT + (vb * 32 + r32) * 72 + ks * 16 + hi * 8);
            o = __builtin_amdgcn_mfma_f32_32x32x16_bf16(a1, b1, o, 0, 0, 0);
            const bf16x8 a2 = *(const bf16x8*)(qe + (dir * 64 + tb * 32 + r32) * 72 + ks * 16 + hi * 8);
            const bf16x8 b2 = *(const bf16x8*)(ST + (dir * 128 + vb * 32 + r32) * 72 + ks * 16 + hi * 8);
            o = __builtin_amdgcn_mfma_f32_32x32x16_bf16(a2, b2, o, 0, 0, 0);
        }
    __syncthreads();
#pragma unroll
    for (int r = 0; r < 16; ++r) ob[(tb * 32 + crow(r, hi)) * 132 + vb * 32 + r32] = o[r];
    __syncthreads();
    {
        const int t = tid >> 3, v0 = (tid & 7) * 16;
        float vals[16]; float ss = 0.f;
#pragma unroll
        for (int i = 0; i < 16; ++i) { vals[i] = ob[t * 132 + v0 + i]; ss += vals[i] * vals[i]; }
        ss += __shfl_xor(ss, 1); ss += __shfl_xor(ss, 2); ss += __shfl_xor(ss, 4);
        const float rstd = rsqrtf(ss * (1.f / 128.f) + EPSN);
        const size_t row = (size_t)gc * 64 + t;
        unsigned pk[8];
#pragma unroll
        for (int i = 0; i < 8; ++i) {
            const float r0 = bf2f(P[row * PW + PC_R + h * 128 + v0 + 2 * i]), r1 = bf2f(P[row * PW + PC_R + h * 128 + v0 + 2 * i + 1]);
            pk[i] = cvtpk(vals[2 * i] * rstd * p.gla_onorm[v0 + 2 * i] * silu_f(r0), vals[2 * i + 1] * rstd * p.gla_onorm[v0 + 2 * i + 1] * silu_f(r1));
        }
        bf16_t* M = (bf16_t*)(p.ws + WS_MIX) + row * 1024 + h * 128 + v0;
        *(u32x4*)M = (u32x4){pk[0], pk[1], pk[2], pk[3]}; *(u32x4*)(M + 8) = (u32x4){pk[4], pk[5], pk[6], pk[7]};
    }
    __syncthreads();
}


struct GlaPre { u32x4 qc, kc, vc[2], ac, sc[4]; float4 wac; float bac; };
__device__ __forceinline__ void gla_prefetch(const Params& p, int gc, int h, GlaPre& g, u32x4 (&rc)[2]) {
    const int tid = threadIdx.x;
    const bf16_t* P = (const bf16_t*)(p.ws + WS_P);
    const bf16_t* rowp = P + (size_t)(gc * 64 + (tid >> 3)) * PW;
    g.qc = *(const u32x4*)(rowp + PC_Q + h * 64 + (tid & 7) * 8);
    g.kc = *(const u32x4*)(rowp + PC_K + h * 64 + (tid & 7) * 8);
#pragma unroll
    for (int i = 0; i < 2; ++i) { const int idx = tid + 512 * i; g.vc[i] = *(const u32x4*)(P + (size_t)(gc * 64 + (idx >> 4)) * PW + PC_V + h * 128 + (idx & 15) * 8); }
#pragma unroll
    for (int i = 0; i < 2; ++i) rc[i] = *(const u32x4*)(rowp + PC_R + h * 128 + (tid & 7) * 16 + 8 * i);
    g.ac = *(const u32x4*)(P + (size_t)(gc * 64 + ((tid & 255) >> 2)) * PW + PC_AF + (tid & 3) * 8);
    const bf16_t* S = (const bf16_t*)(p.ws + WS_SIN);
#pragma unroll
    for (int i = 0; i < 4; ++i) { const int cc = tid + 512 * i, dir = cc >> 10; g.sc[i] = *(const u32x4*)(S + ((size_t)(dir * NCH + gc) * 4 + h) * 8192 + (cc & 1023) * 8); }
    { const int dd = tid >> 8, jj = (tid >> 4) & 15, d4 = tid & 15; g.wac = *(const float4*)((dd == 0 ? p.gla_wa_f : p.gla_wa_b) + jj * 256 + h * 64 + d4 * 4); }
    g.bac = ((tid >> 6) & 1 ? p.gla_ba_b : p.gla_ba_f)[h * 64 + (tid & 63)];
}
template <int OFF> __device__ __forceinline__ s16x4 gla_tr(int vb) { s16x4 r; asm volatile("ds_read_b64_tr_b16 %0, %1 offset:%2" : "=&v"(r) : "v"(vb), "i"(OFF) : "memory"); return r; }
__device__ __forceinline__ void phase_gla_out(const Params& p) {
    const int tid = threadIdx.x, lane = tid & 63, wave = tid >> 6, r32 = lane & 31, hi = lane >> 5, G = gridDim.x;
    bf16_t* qe = (bf16_t*)smem;
    bf16_t* ke = qe + 2 * 64 * 72;
    bf16_t* Am = ke + 2 * 64 * 72;
    bf16_t* Qraw = Am; bf16_t* Kraw = Am + 64 * 72;
    char* Vraw = smem + 55296;
    bf16_t* ST = (bf16_t*)(smem + 75776);
    float* af = (float*)(smem + 112640);
    float* wa = af + 2048;
    float* ba = wa + 2048;
    float* tot = ba + 128;
    float* ob = (float*)ke;
    int u = blockIdx.x;
    if (u >= NCH * 4) return;
    const int nt_t = tid >> 3, nt_v0 = (tid & 7) * 16;
    float on[16];
#pragma unroll
    for (int i = 0; i < 16; ++i) on[i] = p.gla_onorm[nt_v0 + i];
    GlaPre g; u32x4 rc[2], rcn[2];
    gla_prefetch(p, u >> 2, u & 3, g, rc);
    const int dir = wave & 1, tq = wave >> 1;
    for (; u < NCH * 4; u += G) {
        const int gc = u >> 2, h = u & 3;
        *(u32x4*)(Qraw + (tid >> 3) * 72 + (tid & 7) * 8) = g.qc;
        *(u32x4*)(Kraw + (tid >> 3) * 72 + (tid & 7) * 8) = g.kc;
#pragma unroll
        for (int i = 0; i < 2; ++i) { const int idx = tid + 512 * i; *(u32x4*)(Vraw + (idx >> 4) * 320 + (idx & 15) * 16) = g.vc[i]; }
#pragma unroll
        for (int i = 0; i < 4; ++i) { const int cc = tid + 512 * i; *(u32x4*)(ST + ((cc >> 10) * 128 + ((cc >> 3) & 127)) * 72 + (cc & 7) * 8) = g.sc[i]; }
        if (tid < 256) { const int t = tid >> 2, ch = tid & 3, dd = ch >> 1, j0 = (ch & 1) * 8; float* q = af + dd * 1024 + t * 16 + j0;
#pragma unroll
            for (int e = 0; e < 4; ++e) { q[2 * e] = __uint_as_float(g.ac[e] << 16); q[2 * e + 1] = __uint_as_float(g.ac[e] & 0xFFFF0000u); } }
        { const int dd = tid >> 8, jj = (tid >> 4) & 15, d4 = tid & 15; *(float4*)(wa + (dd * 16 + jj) * 64 + d4 * 4) = g.wac; }
        if (tid < 128) ba[tid] = g.bac;
        __syncthreads();
        const int un = u + G;
        if (un < NCH * 4) gla_prefetch(p, un >> 2, un & 3, g, rcn);
        float bb[16]; float total;
        {
            float w[16];
#pragma unroll
            for (int j = 0; j < 16; ++j) w[j] = wa[(dir * 16 + j) * 64 + lane];
            const float bias = ba[dir * 64 + lane];
#pragma unroll
            for (int i = 0; i < 16; ++i) {
                const int t = tq * 16 + i;
                float z = bias;
#pragma unroll
                for (int j = 0; j < 16; ++j) z += af[(dir * 64 + t) * 16 + j] * w[j];
                bb[i] = (fminf(z, 0.f) - __logf(1.f + __expf(-fabsf(z)))) * (1.f / 16.f);
            }
            if (dir == 0) {
#pragma unroll
                for (int i = 1; i < 16; ++i) bb[i] += bb[i - 1];
                tot[(dir * 4 + tq) * 64 + lane] = bb[15];
            } else {
#pragma unroll
                for (int i = 14; i >= 0; --i) bb[i] += bb[i + 1];
                tot[(dir * 4 + tq) * 64 + lane] = bb[0];
            }
        }
        __syncthreads();
        {
            float offs = 0.f; total = 0.f;
#pragma unroll
            for (int q = 0; q < 4; ++q) { const float tv = tot[(dir * 4 + q) * 64 + lane]; total += tv; if (dir == 0 ? (q < tq) : (q > tq)) offs += tv; }
#pragma unroll
            for (int i = 0; i < 16; ++i) bb[i] += offs;
        }
#pragma unroll
        for (int i = 0; i < 16; ++i) {
            const int t = tq * 16 + i;
            const float qv = bf2f(Qraw[t * 72 + lane]) * 0.125f, kv = bf2f(Kraw[t * 72 + lane]);
            qe[(dir * 64 + t) * 72 + lane] = f2bf(qv * __expf(bb[i]));
            ke[(dir * 64 + t) * 72 + lane] = f2bf(kv * __expf(-bb[i]));
        }
        __syncthreads();
        {
            const int mdir = wave >> 2, tb = (wave >> 1) & 1, sb = wave & 1;
            f32x16 acc = {};
#pragma unroll
            for (int ks = 0; ks < 4; ++ks) {
                const bf16x8 a = *(const bf16x8*)(qe + (mdir * 64 + tb * 32 + r32) * 72 + ks * 16 + hi * 8);
                const bf16x8 b = *(const bf16x8*)(ke + (mdir * 64 + sb * 32 + r32) * 72 + ks * 16 + hi * 8);
                acc = __builtin_amdgcn_mfma_f32_32x32x16_bf16(a, b, acc, 0, 0, 0);
            }
            const int sI = sb * 32 + r32;
#pragma unroll
            for (int r = 0; r < 16; ++r) { const int t = tb * 32 + crow(r, hi); const bool keep = (mdir == 0) ? (sI <= t) : (sI >= t); Am[(mdir * 64 + t) * 72 + sI] = f2bf(keep ? acc[r] : 0.f); }
        }
        __syncthreads();
        f32x16 o = {};
        const int tb = wave >> 2, vbk = wave & 3;
        {
            const int vb = (int)(uintptr_t)Vraw + (8 * hi + ((lane & 15) >> 2)) * 320 + (vbk * 32 + 16 * ((lane >> 4) & 1) + 4 * (lane & 3)) * 2;
#define GLA_PV(KS, DIRN) do { const s16x4 l_ = gla_tr<(KS) * 5120>(vb), h_ = gla_tr<(KS) * 5120 + 1280>(vb); \
            const bf16x8 a1 = *(const bf16x8*)(Am + ((DIRN) * 64 + tb * 32 + r32) * 72 + (KS) * 16 + hi * 8); \
            const bf16x8 a2 = *(const bf16x8*)(qe + ((DIRN) * 64 + tb * 32 + r32) * 72 + (KS) * 16 + hi * 8); \
            const bf16x8 b2 = *(const bf16x8*)(ST + ((DIRN) * 128 + vbk * 32 + r32) * 72 + (KS) * 16 + hi * 8); \
            asm volatile("s_waitcnt lgkmcnt(0)" ::: "memory"); SBAR(); \
            o = __builtin_amdgcn_mfma_f32_32x32x16_bf16(a1, (bf16x8){l_[0], l_[1], l_[2], l_[3], h_[0], h_[1], h_[2], h_[3]}, o, 0, 0, 0); \
            o = __builtin_amdgcn_mfma_f32_32x32x16_bf16(a2, b2, o, 0, 0, 0); } while (0)
            GLA_PV(0, 0); GLA_PV(1, 0); GLA_PV(2, 0); GLA_PV(3, 0); GLA_PV(0, 1); GLA_PV(1, 1); GLA_PV(2, 1); GLA_PV(3, 1);
#undef GLA_PV
        }
        __syncthreads();
#pragma unroll
        for (int r = 0; r < 16; ++r) ob[(tb * 32 + crow(r, hi)) * 132 + vbk * 32 + r32] = o[r];
        __syncthreads();
        {
            float vals[16]; float ss = 0.f;
#pragma unroll
            for (int i = 0; i < 4; ++i) { const f32x4 x = *(const f32x4*)(ob + nt_t * 132 + nt_v0 + 4 * i); vals[4 * i] = x[0]; vals[4 * i + 1] = x[1]; vals[4 * i + 2] = x[2]; vals[4 * i + 3] = x[3]; }
#pragma unroll
            for (int i = 0; i < 16; ++i) ss += vals[i] * vals[i];
            ss += __shfl_xor(ss, 1); ss += __shfl_xor(ss, 2); ss += __shfl_xor(ss, 4);
            const float rstd = rsqrtf(ss * (1.f / 128.f) + EPSN);
            unsigned pk[8];
#pragma unroll
            for (int i = 0; i < 8; ++i) {
                const unsigned w = rc[i >> 2][i & 3];
                const float r0 = __uint_as_float(w << 16), r1 = __uint_as_float(w & 0xFFFF0000u);
                const float s0 = r0 * __builtin_amdgcn_rcpf(1.f + __expf(-r0)), s1 = r1 * __builtin_amdgcn_rcpf(1.f + __expf(-r1));
                pk[i] = cvtpk(vals[2 * i] * rstd * on[2 * i] * s0, vals[2 * i + 1] * rstd * on[2 * i + 1] * s1);
            }
            bf16_t* M = (bf16_t*)(p.ws + WS_MIX) + ((size_t)gc * 64 + nt_t) * 1024 + h * 128 + nt_v0;
            *(u32x4*)M = (u32x4){pk[0], pk[1], pk[2], pk[3]}; *(u32x4*)(M + 8) = (u32x4){pk[4], pk[5], pk[6], pk[7]};
        }
        rc[0] = rcn[0]; rc[1] = rcn[1];
        __syncthreads();
    }
}

namespace mla {
constexpr int KVBLK = 64, QBLK = 32;
#ifndef MLA_QREG
#define MLA_QREG 12
#endif
constexpr int QREG = MLA_QREG;
constexpr float SCALE = 0.07216878364870322f;
constexpr float THR = 8.f;
constexpr int LDQ = 768, LDK = 768, LDV = 512, LDO = 1024;
constexpr int SHM_V = KVBLK * 128 * 2, SHM_K = KVBLK * 400;
#define MKSWZ(row, colB) ((row) * 400 + (colB))
__device__ __forceinline__ void partialSM(f32x16& p0, f32x16& p1, float& m_reg, float& mn, float& alpha) {
    constexpr float C = SCALE * LOG2E;
    float pmax = p0[0];
#pragma unroll
    for (int r = 1; r < 16; ++r) pmax = fmaxf(pmax, p0[r]);
#pragma unroll
    for (int r = 0; r < 16; ++r) pmax = fmaxf(pmax, p1[r]);
    { auto rr = __builtin_amdgcn_permlane32_swap(__float_as_uint(pmax), __float_as_uint(pmax), false, false);
      pmax = fmaxf(__uint_as_float(rr[0]), __uint_as_float(rr[1])); }
    if (__builtin_expect(__all(pmax - m_reg <= THR / SCALE), 1)) { mn = m_reg; alpha = 1.f; }
    else { mn = fmaxf(m_reg, pmax); alpha = __builtin_amdgcn_exp2f((m_reg - mn) * C); m_reg = mn; }
    const float mnC = -mn * C;
#pragma unroll
    for (int r = 0; r < 16; ++r) p0[r] = fmaf(p0[r], C, mnC);
#pragma unroll
    for (int r = 0; r < 16; ++r) p1[r] = fmaf(p1[r], C, mnC);
#pragma unroll
    for (int r = 0; r < 16; ++r) p0[r] = __builtin_amdgcn_exp2f(p0[r]);
}
__device__ __forceinline__ void finishSM(f32x16& p0, f32x16& p1, float alpha, float& l_reg, bf16x8& pa0, bf16x8& pa1, bf16x8& pa2, bf16x8& pa3) {
#pragma unroll
    for (int r = 0; r < 16; ++r) p1[r] = __builtin_amdgcn_exp2f(p1[r]);
    float ps = 0;
#pragma unroll
    for (int r = 0; r < 16; ++r) ps += p0[r];
#pragma unroll
    for (int r = 0; r < 16; ++r) ps += p1[r];
    { auto rr = __builtin_amdgcn_permlane32_swap(__float_as_uint(ps), __float_as_uint(ps), false, false);
      ps = __uint_as_float(rr[0]) + __uint_as_float(rr[1]); }
    l_reg = l_reg * alpha + ps;
#define PK4(P, BASE, OUT) do { unsigned a0 = cvtpk(P[BASE + 0], P[BASE + 1]), a1 = cvtpk(P[BASE + 2], P[BASE + 3]);   \
    unsigned b0 = cvtpk(P[BASE + 4], P[BASE + 5]), b1 = cvtpk(P[BASE + 6], P[BASE + 7]);                              \
    auto r0 = __builtin_amdgcn_permlane32_swap(a0, b0, false, false); auto r1 = __builtin_amdgcn_permlane32_swap(a1, b1, false, false); \
    u32x4 w = {r0[0], r1[0], r0[1], r1[1]}; OUT = *reinterpret_cast<bf16x8*>(&w); } while (0)
    PK4(p0, 0, pa0); PK4(p0, 8, pa1); PK4(p1, 0, pa2); PK4(p1, 8, pa3);
}
__device__ __forceinline__ void qkt(f32x16& p0, f32x16& p1, const char* Ks, const bf16x8* qr, const char* qlds, int r32, int hi) {
    p0 = f32x16{}; p1 = f32x16{};
#pragma unroll
    for (int d0 = 0; d0 < 12; ++d0) { const int cb = (d0 * 16 + hi * 8) * 2;
        const bf16x8 b0 = *reinterpret_cast<const bf16x8*>(Ks + MKSWZ(r32, cb));
        const bf16x8 b1 = *reinterpret_cast<const bf16x8*>(Ks + MKSWZ(32 + r32, cb));
        const bf16x8 qv = (d0 < QREG) ? qr[d0 < QREG ? d0 : 0] : *reinterpret_cast<const bf16x8*>(qlds + (d0 - QREG) * 1024);
        p0 = __builtin_amdgcn_mfma_f32_32x32x16_bf16(b0, qv, p0, 0, 0, 0);
        p1 = __builtin_amdgcn_mfma_f32_32x32x16_bf16(b1, qv, p1, 0, 0, 0); }
}
__device__ __forceinline__ int v_st(int k, int c) { const int kk = (k & ~0xC) | ((k & 4) << 1) | ((k & 8) >> 1); return ((kk >> 3) * 4 + (c >> 5)) * 512 + ((kk & 7) * 32 + (c & 31)) * 2; }
__device__ __forceinline__ int v_rd_base(int lane) { return ((lane & 3) << 3) | (((lane >> 2) & 3) << 6) | (((lane >> 4) & 1) << 5) | (((lane >> 5) & 1) << 8); }
constexpr int v_rd_off(int d0, int ks, int half) { return d0 * 512 + ks * 4096 + half * 2048; }
template <int OFF> __device__ __forceinline__ s16x4 tr_read(int vb) {
    s16x4 r; asm volatile("ds_read_b64_tr_b16 %0, %1 offset:%2" : "=&v"(r) : "v"(vb), "i"(OFF) : "memory"); return r;
}
template <int D0> __device__ __forceinline__ void pv_one(f32x16& od, int vb, bf16x8 pa0, bf16x8 pa1, bf16x8 pa2, bf16x8 pa3) {
#define PKV(L, H) (bf16x8){L[0], L[1], L[2], L[3], H[0], H[1], H[2], H[3]}
    {
    const s16x4 l0 = tr_read<v_rd_off(D0, 0, 0)>(vb), h0 = tr_read<v_rd_off(D0, 0, 1)>(vb), l1 = tr_read<v_rd_off(D0, 1, 0)>(vb), h1 = tr_read<v_rd_off(D0, 1, 1)>(vb);
    asm volatile("s_waitcnt lgkmcnt(0)" ::: "memory"); SBAR();
    od = __builtin_amdgcn_mfma_f32_32x32x16_bf16(pa0, PKV(l0, h0), od, 0, 0, 0);
    od = __builtin_amdgcn_mfma_f32_32x32x16_bf16(pa1, PKV(l1, h1), od, 0, 0, 0);
    }
    {
    const s16x4 l2 = tr_read<v_rd_off(D0, 2, 0)>(vb), h2 = tr_read<v_rd_off(D0, 2, 1)>(vb), l3 = tr_read<v_rd_off(D0, 3, 0)>(vb), h3 = tr_read<v_rd_off(D0, 3, 1)>(vb);
    asm volatile("s_waitcnt lgkmcnt(0)" ::: "memory"); SBAR();
    od = __builtin_amdgcn_mfma_f32_32x32x16_bf16(pa2, PKV(l2, h2), od, 0, 0, 0);
    od = __builtin_amdgcn_mfma_f32_32x32x16_bf16(pa3, PKV(l3, h3), od, 0, 0, 0);
    }
#undef PKV
}
__device__ __forceinline__ void pv_d0(f32x16* o, int vb, bf16x8 pa0, bf16x8 pa1, bf16x8 pa2, bf16x8 pa3) {
    pv_one<0>(o[0], vb, pa0, pa1, pa2, pa3); pv_one<1>(o[1], vb, pa0, pa1, pa2, pa3); pv_one<2>(o[2], vb, pa0, pa1, pa2, pa3); pv_one<3>(o[3], vb, pa0, pa1, pa2, pa3);
}
__device__ __forceinline__ void attn_body(const bf16_t* __restrict__ Qb, const bf16_t* __restrict__ Kh, const bf16_t* __restrict__ Vh, bf16_t* __restrict__ Ob, int seq) {
    char* lds = smem;
    const int tid = threadIdx.x, wid = tid >> 6, lane = tid & 63, r32 = lane & 31, hi = lane >> 5;
    char* V_lds = lds; char* K_lds = lds + 2 * SHM_V;
    float* ws = (float*)(lds + 2 * SHM_V + 2 * SHM_K) + wid * 64; float* li_l = ws; float* al_l = ws + 32;
    float m_reg = -1e30f, l_reg = 0; f32x16 o[4] = {}; bf16x8 qr[QREG];
    const bf16_t* Qw = Qb + (long)(wid * QBLK + r32) * LDQ + hi * 8;
#pragma unroll
    for (int d0 = 0; d0 < QREG; ++d0) qr[d0] = *reinterpret_cast<const bf16x8*>(Qw + d0 * 16);
    char* qlds = lds + 2 * SHM_V + 2 * SHM_K + 2048 + wid * ((12 - QREG) * 1024) + lane * 16;
#pragma unroll
    for (int d0 = 0; d0 < 12 - QREG; ++d0) *reinterpret_cast<bf16x8*>(qlds + d0 * 1024) = *reinterpret_cast<const bf16x8*>(Qw + (QREG + d0) * 16);
    const int sr = tid >> 4, sc = (tid & 15) * 8, vst0 = v_st(sr, sc), vst1 = v_st(32 + sr, sc);
    int kgo[3], kso[3];
#pragma unroll
    for (int i = 0; i < 3; ++i) { const int id = tid + 512 * i, kr_ = id / 24, kc_ = (id % 24) * 8; kgo[i] = kr_ * LDK + kc_; kso[i] = MKSWZ(kr_, kc_ * 2); }
    const int vb0 = (int)(uintptr_t)V_lds + v_rd_base(lane);
    struct { bf16x8 vs0, vs1, ks0, ks1, ks2; } st_;
#define SLOAD(k0) do { st_.vs0 = *(const bf16x8*)(&Vh[(long)((k0) + sr) * LDV + sc]); st_.vs1 = *(const bf16x8*)(&Vh[(long)((k0) + 32 + sr) * LDV + sc]); \
    st_.ks0 = *(const bf16x8*)(&Kh[(long)(k0) * LDK + kgo[0]]); st_.ks1 = *(const bf16x8*)(&Kh[(long)(k0) * LDK + kgo[1]]); \
    st_.ks2 = *(const bf16x8*)(&Kh[(long)(k0) * LDK + kgo[2]]); } while (0)
#define SWRITE(b) do { *(bf16x8*)(V_lds + (b) * SHM_V + vst0) = st_.vs0; *(bf16x8*)(V_lds + (b) * SHM_V + vst1) = st_.vs1; \
    *(bf16x8*)(K_lds + (b) * SHM_K + kso[0]) = st_.ks0; *(bf16x8*)(K_lds + (b) * SHM_K + kso[1]) = st_.ks1; \
    *(bf16x8*)(K_lds + (b) * SHM_K + kso[2]) = st_.ks2; } while (0)
#define RESC(a) do { if (__any((a) < 1.f)) { if (hi == 0) al_l[r32] = (a); asm volatile("s_waitcnt lgkmcnt(0)" ::: "memory"); \
    _Pragma("unroll") for (int d = 0; d < 4; ++d) _Pragma("unroll") for (int r = 0; r < 16; ++r) o[d][r] *= al_l[crow(r, hi)]; } } while (0)
    f32x16 pA0, pA1, pB0, pB1; float mnA, mnB, alA, alB; bf16x8 pa0, pa1, pa2, pa3; const int NT = seq / KVBLK;
    SLOAD(0); SWRITE(0); __syncthreads();
    qkt(pA0, pA1, K_lds, qr, qlds, r32, hi); partialSM(pA0, pA1, m_reg, mnA, alA);
    SLOAD(KVBLK); SWRITE(1); __syncthreads();
    for (int j = 1; j + 1 < NT; j += 2) {
        SBAR(); qkt(pB0, pB1, K_lds + SHM_K, qr, qlds, r32, hi);
        finishSM(pA0, pA1, alA, l_reg, pa0, pa1, pa2, pa3); SBAR();
        SLOAD((j + 1) * KVBLK); SBAR();
        pv_d0(o, vb0, pa0, pa1, pa2, pa3); partialSM(pB0, pB1, m_reg, mnB, alB);
        __syncthreads(); SWRITE(0);
        RESC(alB); __syncthreads();
        SBAR(); qkt(pA0, pA1, K_lds, qr, qlds, r32, hi);
        finishSM(pB0, pB1, alB, l_reg, pa0, pa1, pa2, pa3); SBAR();
        SLOAD((j + 2) * KVBLK); SBAR();
        pv_d0(o, vb0 + SHM_V, pa0, pa1, pa2, pa3); partialSM(pA0, pA1, m_reg, mnA, alA);
        __syncthreads(); SWRITE(1);
        RESC(alA); __syncthreads();
    }
    SBAR(); qkt(pB0, pB1, K_lds + SHM_K, qr, qlds, r32, hi);
    finishSM(pA0, pA1, alA, l_reg, pa0, pa1, pa2, pa3); SBAR();
    pv_d0(o, vb0, pa0, pa1, pa2, pa3); partialSM(pB0, pB1, m_reg, mnB, alB);
    __syncthreads(); RESC(alB);
    finishSM(pB0, pB1, alB, l_reg, pa0, pa1, pa2, pa3); SBAR();
    pv_d0(o, vb0 + SHM_V, pa0, pa1, pa2, pa3);
    if (hi == 0) li_l[r32] = l_reg; asm volatile("s_waitcnt lgkmcnt(0)" ::: "memory");
    float rli[16];
#pragma unroll
    for (int r = 0; r < 16; ++r) rli[r] = __builtin_amdgcn_rcpf(li_l[crow(r, hi)]);
    bf16_t* Ow = Ob + (long)(wid * QBLK) * LDO;
#pragma unroll
    for (int r = 0; r < 16; ++r) { const int orow = crow(r, hi);
#pragma unroll
        for (int d0 = 0; d0 < 4; ++d0) Ow[(long)orow * LDO + d0 * 32 + r32] = f2bf(o[d0][r] * rli[r]); }
    __syncthreads();
#undef SLOAD
#undef SWRITE
#undef RESC
}
}

__device__ __forceinline__ void phase_mix0(const Params& p) {
    const int G = gridDim.x;
    phase_gla_out(p);
    __syncthreads();
    const bf16_t* QM = (const bf16_t*)(p.ws + WS_QM); const bf16_t* KM = (const bf16_t*)(p.ws + WS_KM); const bf16_t* VM = (const bf16_t*)(p.ws + WS_VM);
    bf16_t* MIX = (bf16_t*)(p.ws + WS_MIX);
    for (int u = blockIdx.x; u < 260; u += G) {
        const bool lat = u < 256;
        const int h = lat ? (u & 3) : (u - 256);
        const size_t q0 = lat ? (size_t)CTXN + (size_t)(u >> 2) * 256 : 0;
        mla::attn_body(QM + q0 * 768 + h * 192, KM + h * 192, VM + h * 128, MIX + q0 * 1024 + 512 + h * 128, lat ? NTOK : CTXN);
    }
}

template <int OFF> __device__ __forceinline__ s16x4 na_tr(int vb) { s16x4 r; asm volatile("ds_read_b64_tr_b16 %0, %1 offset:%2" : "=&v"(r) : "v"(vb), "i"(OFF) : "memory"); return r; }
template <int KS> __device__ __forceinline__ void na_pv(f32x16& o0, f32x16& o1, int vb, bf16x8 pa) {
    const s16x4 a0 = na_tr<KS * 5120>(vb), a1 = na_tr<KS * 5120 + 1280>(vb), b0 = na_tr<KS * 5120 + 64>(vb), b1 = na_tr<KS * 5120 + 1280 + 64>(vb);
    asm volatile("s_waitcnt lgkmcnt(0)" ::: "memory"); SBAR();
    o0 = __builtin_amdgcn_mfma_f32_32x32x16_bf16(pa, (bf16x8){a0[0], a0[1], a0[2], a0[3], a1[0], a1[1], a1[2], a1[3]}, o0, 0, 0, 0);
    o1 = __builtin_amdgcn_mfma_f32_32x32x16_bf16(pa, (bf16x8){b0[0], b0[1], b0[2], b0[3], b1[0], b1[1], b1[2], b1[3]}, o1, 0, 0, 0);
}
template <int MODE> __device__ __forceinline__ void na_softmax(f32x16& p0, f32x16& p1, float& m_reg, float& l_reg, float& alpha, const float* brow, int c0, int hi) {
    constexpr float C = 0.125f * LOG2E;
#define NA_L0(q) (MODE != 2 || (q) >= 12)
#define NA_L1(q) (MODE != 1 || (q) < 4)
    if (MODE == 0) {
#pragma unroll
        for (int q = 0; q < 16; ++q) { p0[q] *= C; p1[q] *= C; }
    } else {
        float bv0[16], bv1[16];
#pragma unroll
        for (int q = 0; q < 16; ++q) { const int kc0 = crow(q, hi); if (NA_L0(q)) bv0[q] = brow[kc0]; if (NA_L1(q)) bv1[q] = brow[32 + kc0]; }
#pragma unroll
        for (int q = 0; q < 16; ++q) { if (NA_L0(q)) asm volatile("" : "+v"(bv0[q])); if (NA_L1(q)) asm volatile("" : "+v"(bv1[q])); }
#pragma unroll
        for (int q = 0; q < 16; ++q) {
            const int kc0 = crow(q, hi), kc1 = 32 + kc0;
            if (NA_L0(q)) { const float t = fmaf(p0[q], C, bv0[q]); p0[q] = ((unsigned)(kc0 - c0) < 16u) ? t : -1e30f; }
            if (NA_L1(q)) { const float t = fmaf(p1[q], C, bv1[q]); p1[q] = ((unsigned)(kc1 - c0) < 16u) ? t : -1e30f; }
        }
    }
    float pmax = -1e30f;
#pragma unroll
    for (int q = 0; q < 16; ++q) { if (NA_L0(q)) pmax = fmaxf(pmax, p0[q]); if (NA_L1(q)) pmax = fmaxf(pmax, p1[q]); }
    { auto rr = __builtin_amdgcn_permlane32_swap(__float_as_uint(pmax), __float_as_uint(pmax), false, false);
      pmax = fmaxf(__uint_as_float(rr[0]), __uint_as_float(rr[1])); }
    const float mn = fmaxf(m_reg, pmax);
    alpha = __builtin_amdgcn_exp2f(m_reg - mn);
    m_reg = mn;
    float ps = 0.f;
#pragma unroll
    for (int q = 0; q < 16; ++q) {
        if (NA_L0(q)) { p0[q] = __builtin_amdgcn_exp2f(p0[q] - mn); ps += p0[q]; } else p0[q] = 0.f;
        if (NA_L1(q)) { p1[q] = __builtin_amdgcn_exp2f(p1[q] - mn); ps += p1[q]; } else p1[q] = 0.f;
    }
    { auto rr = __builtin_amdgcn_permlane32_swap(__float_as_uint(ps), __float_as_uint(ps), false, false);
      ps = __uint_as_float(rr[0]) + __uint_as_float(rr[1]); }
    l_reg = l_reg * alpha + ps;
#undef NA_L0
#undef NA_L1
}
__device__ __forceinline__ void phase_na(const Params& p) {
    const int tid = threadIdx.x, lane = tid & 63, wave = tid >> 6, r32 = lane & 31, hi = lane >> 5, G = gridDim.x;
    const bf16_t* QKV = (const bf16_t*)(p.ws + WS_P);
    bf16_t* MIX = (bf16_t*)(p.ws + WS_MIX);
    constexpr int KB = 64 * 72 * 2, VB = 64 * 160 * 2;
    char* Kl = smem;
    char* Vl = smem + 2 * KB;
    float* xch = (float*)(smem + 2 * KB + 2 * VB) + wave * 64;
    float* rpbL = (float*)(smem + 2 * KB + 2 * VB + 8 * 64 * 4);
    constexpr float C = 0.125f * LOG2E;
    const int skey = tid >> 3, sch = tid & 7;
    const int vb0 = (int)(uintptr_t)Vl + (8 * hi + ((lane & 15) >> 2)) * 320 + (16 * ((lane >> 4) & 1) + 4 * (lane & 3)) * 2;
    for (int u = blockIdx.x; u < 64 * 16; u += G) {
        const int rg = u >> 4, h = u & 15;
        const int r = rg * 4 + (wave >> 1), qb = wave & 1;
        const int r0w = min(max(r - 4, 0), 248);
        const int kr_lo = min(max(rg * 4 - 4, 0), 248), kr_hi = min(max(rg * 4 + 3 - 4, 0), 248) + 7, nwin = kr_hi - kr_lo + 1, ntile = nwin + 4;
        for (int i = tid; i < 15 * 31; i += NTH) rpbL[i] = p.na_rpb[(size_t)h * 15 * 31 + i] * LOG2E;
        const int c = qb * 32 + r32, c0 = min(max(c - 8, 0), 48);
        const size_t qrow = (size_t)CTXN + (size_t)r * 64 + c;
        bf16x8 qr[4];
#pragma unroll
        for (int ks = 0; ks < 4; ++ks) qr[ks] = *(const bf16x8*)(QKV + qrow * 3072 + h * 64 + ks * 16 + hi * 8);
        float m_reg = -1e30f, l_reg = 0.f; f32x16 o0 = {}, o1 = {};
        u32x4 skA, svA, skB, svB;
#define NA_LOAD(ti_, SK, SV) do { const size_t key0_ = ((ti_) >= nwin) ? (size_t)((ti_) - nwin) * 64 : (size_t)CTXN + (size_t)(kr_lo + (ti_)) * 64; \
            const bf16_t* src_ = QKV + (key0_ + skey) * 3072 + h * 64 + sch * 8; SK = *(const u32x4*)(src_ + 1024); SV = *(const u32x4*)(src_ + 2048); } while (0)
#define NA_WRITE(b_, SK, SV) do { *(u32x4*)(Kl + (b_) * KB + skey * 144 + sch * 16) = SK; *(u32x4*)(Vl + (b_) * VB + skey * 320 + sch * 16) = SV; } while (0)
        NA_LOAD(0, skA, svA); NA_WRITE(0, skA, svA);
        NA_LOAD(1, skA, svA);
        __syncthreads();
        for (int ti = 0; ti < ntile; ++ti) {
            const int b = ti & 1;
            if (ti + 2 < ntile) { if (b == 0) NA_LOAD(ti + 2, skB, svB); else NA_LOAD(ti + 2, skA, svA); }
            const bool isctx = ti >= nwin;
            const int kr = kr_lo + ti;
            const bool need = isctx || (kr >= r0w && kr <= r0w + 7);
            if (need) {
                const bf16_t* Ks = (const bf16_t*)(Kl + b * KB);
                f32x16 p0 = {}, p1 = {};
#pragma unroll
                for (int ks = 0; ks < 4; ++ks) {
                    const bf16x8 a0 = *(const bf16x8*)(Ks + r32 * 72 + ks * 16 + hi * 8), a1 = *(const bf16x8*)(Ks + (32 + r32) * 72 + ks * 16 + hi * 8);
                    p0 = __builtin_amdgcn_mfma_f32_32x32x16_bf16(a0, qr[ks], p0, 0, 0, 0);
                    p1 = __builtin_amdgcn_mfma_f32_32x32x16_bf16(a1, qr[ks], p1, 0, 0, 0);
                }
                float alpha;
                const float* brow = rpbL + (kr - r + 7) * 31 + 15 - c;
                if (isctx) na_softmax<0>(p0, p1, m_reg, l_reg, alpha, brow, c0, hi);
                else if (qb == 0) na_softmax<1>(p0, p1, m_reg, l_reg, alpha, brow, c0, hi);
                else na_softmax<2>(p0, p1, m_reg, l_reg, alpha, brow, c0, hi);
                bf16x8 pa0, pa1, pa2, pa3;
                PK4(p0, 0, pa0); PK4(p0, 8, pa1); PK4(p1, 0, pa2); PK4(p1, 8, pa3);
                if (__any(alpha < 1.f)) {
                    if (hi == 0) xch[r32] = alpha;
                    asm volatile("s_waitcnt lgkmcnt(0)" ::: "memory");
#pragma unroll
                    for (int q = 0; q < 16; ++q) { const float a = xch[crow(q, hi)]; o0[q] *= a; o1[q] *= a; }
                }
                const int vb = vb0 + b * VB;
                na_pv<0>(o0, o1, vb, pa0); na_pv<1>(o0, o1, vb, pa1); na_pv<2>(o0, o1, vb, pa2); na_pv<3>(o0, o1, vb, pa3);
            }
            if (ti + 1 < ntile) { if (b == 0) NA_WRITE(1, skA, svA); else NA_WRITE(0, skB, svB); }
            __syncthreads();
        }
#undef NA_LOAD
#undef NA_WRITE
        if (hi == 0) xch[32 + r32] = l_reg;
        asm volatile("s_waitcnt lgkmcnt(0)" ::: "memory");
        const size_t orow0 = (size_t)CTXN + (size_t)r * 64 + qb * 32;
#pragma unroll
        for (int q = 0; q < 16; ++q) {
            const int qi = crow(q, hi); const float il = __builtin_amdgcn_rcpf(xch[32 + qi]);
            bf16_t* dst = MIX + (orow0 + qi) * 1024 + h * 64;
            dst[r32] = f2bf(o0[q] * il); dst[32 + r32] = f2bf(o1[q] * il);
        }
        __syncthreads();
    }
}
#undef PK4

#define XB_TMO      128
#define XB_XCNT(j)  (256  + 64 * (j))
#define XB_XSUB(j)  (1280 + 64 * (j))
#define XB_XGEN(j)  (2304 + 64 * (j))
#define XB_TOP      3328
#define XB_TOPGEN   3392
#define XCD_BAR_WORDS 3456
#define XB_SPIN_CAP (1u << 22)
#define LAS __attribute__((address_space(3)))
__device__ __forceinline__ unsigned xb_ld(unsigned* p)              { return __hip_atomic_load(p, __ATOMIC_RELAXED, __HIP_MEMORY_SCOPE_AGENT); }
__device__ __forceinline__ unsigned xb_add(unsigned* p, unsigned v) { return __hip_atomic_fetch_add(p, v, __ATOMIC_RELAXED, __HIP_MEMORY_SCOPE_AGENT); }
__device__ __forceinline__ unsigned xb_xcc_id() { return (unsigned)__builtin_amdgcn_s_getreg((3 << 11) | 20) & 0xFu; }
#define XB_SPIN(cond, bar) do { unsigned _sp = 0; while (cond) { __builtin_amdgcn_s_sleep(1); \
    if ((++_sp & 255u) == 0u) { if (xb_ld(&(bar)[XB_TMO])) break; if (_sp > XB_SPIN_CAP) { atomicAdd(&(bar)[XB_TMO], 1u); break; } } } } while (0)
struct XcdBarrier { unsigned* bar; unsigned x; volatile LAS unsigned* st; };
__device__ __forceinline__ XcdBarrier xcd_barrier_post(unsigned* bar, volatile LAS unsigned* st) {
    XcdBarrier b; b.bar = bar; b.x = xb_xcc_id(); b.st = st;
    if (threadIdx.x == 0) (void)xb_add(&bar[XB_XCNT(b.x)], 1u);
    return b;
}
__device__ __forceinline__ void xcd_barrier_complete(unsigned* bar, unsigned x, unsigned& nloc, unsigned& nx) {
    const unsigned G = gridDim.x * gridDim.y * gridDim.z;
    unsigned sum, cnt, mine, sp = 0u;
    for (;;) {
        sum = 0u; cnt = 0u; mine = 0u;
#pragma unroll
        for (unsigned j = 0; j < 16; ++j) { const unsigned c = xb_ld(&bar[XB_XCNT(j)]); sum += c; cnt += (c > 0u) ? 1u : 0u; mine = (j == x) ? c : mine; }
        if (sum == G) break;
        __builtin_amdgcn_s_sleep(1);
        if ((++sp & 255u) == 0u) { if (xb_ld(&bar[XB_TMO])) break; if (sp > XB_SPIN_CAP) { atomicAdd(&bar[XB_TMO], 1u); break; } }
    }
    nloc = mine > 0u ? mine : 1u; nx = cnt > 0u ? cnt : 1u;
}
__device__ __forceinline__ void xcd_barrier(const XcdBarrier& b) {
    asm volatile("s_waitcnt vmcnt(0)" ::: "memory");
    __syncthreads();
    if (threadIdx.x == 0) {
        unsigned* bar = b.bar;
        __builtin_amdgcn_s_waitcnt(0);
        unsigned nloc = b.st[0], nx = b.st[1];
        if (nloc == 0u) { xcd_barrier_complete(bar, b.x, nloc, nx); b.st[0] = nloc; b.st[1] = nx; }
        const unsigned old = xb_add(&bar[XB_XSUB(b.x)], 1u);
        const unsigned gen = old / nloc;
        if (old + 1u == (gen + 1u) * nloc) {
            __builtin_amdgcn_fence(__ATOMIC_RELEASE, "agent");
            asm volatile("s_waitcnt vmcnt(0)" ::: "memory");
            const unsigned og = xb_add(&bar[XB_TOP], 1u);
            const unsigned tg = og / nx;
            if (og + 1u == (tg + 1u) * nx) xb_add(&bar[XB_TOPGEN], 1u);
            else XB_SPIN(xb_ld(&bar[XB_TOPGEN]) == tg, bar);
            __builtin_amdgcn_fence(__ATOMIC_ACQUIRE, "agent");
            xb_add(&bar[XB_XGEN(b.x)], 1u);
            asm volatile("s_waitcnt vmcnt(0)" ::: "memory");
        } else {
            XB_SPIN(xb_ld(&bar[XB_XGEN(b.x)]) == gen, bar);
            __builtin_amdgcn_fence(__ATOMIC_ACQUIRE, "agent");
            asm volatile("s_waitcnt vmcnt(0)" ::: "memory");
        }
    }
    __syncthreads();
}

__device__ __forceinline__ void run_phase(const Params& p, int ph) {
#ifdef ONLY_PHASE
    if (ph != ONLY_PHASE) return;
    ph = ONLY_PHASE;
#endif
    const bf16_t* HB = (const bf16_t*)(p.ws + WS_HB);
    switch (ph) {
    case 0: phase_prologue(p); break;
    case 1: phase_norm1_l0(p); break;
    case 2: phase_gemm_pg8(HB, 1024, (const bf16_t*)(p.ws + WS_WIN), 1024, (bf16_t*)(p.ws + WS_P), PW, NTOK / 256, 8); break;
    case 3: phase_mla_up(p); break;
    case 4: break;
    case 5: phase_gla_scan(p); break;
    case 6: phase_mix0(p); break;
    case 7: phase_gemm_pg8((const bf16_t*)(p.ws + WS_MIX), 1024, (const bf16_t*)(p.ws + WS_WOUT0), 1024, (bf16_t*)(p.ws + WS_OB), 1024, NTOK / 256, 4); break;
    case 8: phase_mid(p, 0); break;
    case 9: phase_moe1(p, 0); break;
    case 10: phase_moe2(p, 0); break;
    case 11: phase_end(p, 0); break;
    case 12: phase_gemm_pg8(HB, 1024, (const bf16_t*)(p.ws + WS_WQKV), 1024, (bf16_t*)(p.ws + WS_P), 3072, NTOK / 256, 12); break;
    case 13: phase_na(p); break;
    case 14: phase_gemm_pg8((const bf16_t*)(p.ws + WS_MIX) + (size_t)CTXN * 1024, 1024, (const bf16_t*)(p.ws + WS_WNAO), 1024, (bf16_t*)(p.ws + WS_OB) + (size_t)CTXN * 1024, 1024, SEQ / 256, 4); break;
    case 15: phase_mid(p, 1); break;
    case 16: phase_moe1(p, 1); break;
    case 17: phase_moe2(p, 1); break;
    case 18: phase_end(p, 1); break;
    default: break;
    }
}
constexpr int N_PHASES = 19;

#if MK_LAUNCHES == 1
__global__ void __launch_bounds__(512) mega_kernel(Params p) {
    cg::grid_group grid = cg::this_grid();
    volatile LAS unsigned* xst = (volatile LAS unsigned*)(smem + LDS_BYTES - 16);
    if (threadIdx.x == 0) { xst[0] = 0u; xst[1] = 0u; xst[2] = 0u; xst[3] = 0u; }
    __syncthreads();
    XcdBarrier xb = xcd_barrier_post((unsigned*)(p.ws + WS_BAR), xst);
    run_phase(p, 0); xcd_barrier(xb);
    if (p.pad0 == 0x7fffffff) grid.sync();
    if (PROBE_REPEAT == 100) { run_phase(p, 0); xcd_barrier(xb); }
    if (PROBE_REPEAT == 61) { phase_gla_out(p); xcd_barrier(xb); }
#define PH_(n) run_phase(p, n); xcd_barrier(xb); if ((n) == PROBE_REPEAT) { run_phase(p, n); xcd_barrier(xb); }
    PH_(1) PH_(2) PH_(3) PH_(5) PH_(6) PH_(7) PH_(8) PH_(9) PH_(10) PH_(11) PH_(12) PH_(13) PH_(14) PH_(15) PH_(16) PH_(17)
    run_phase(p, 18);
#undef PH_
}
#else
template <int PH> __global__ void __launch_bounds__(512) phase_kernel(Params p) { run_phase(p, PH); }
typedef void (*phase_fn)(Params);
template <int PH> static bool launch_phase(const Params& p, int grid, hipStream_t stream, bool setattr) {
    if (setattr && hipFuncSetAttribute((const void*)phase_kernel<PH>, hipFuncAttributeMaxDynamicSharedMemorySize, LDS_BYTES) != hipSuccess) return false;
    hipLaunchKernelGGL(phase_kernel<PH>, dim3(grid), dim3(NTH), LDS_BYTES, stream, p);
    return true;
}
#endif

extern "C" void kernel_launch(void* const* d_in, const int* in_sizes, int n_in, void* d_out, int out_size, void* d_ws, size_t ws_size, hipStream_t stream) {
    static int grid_blocks = 0;
    bool first = false;
    if (!grid_blocks) {
        if (ws_size < WS_END) { fprintf(stderr, "kernel_launch: workspace too small: %zu < %zu\n", ws_size, (size_t)WS_END); return; }
        int dev = 0, cus = 0;
        (void)hipGetDevice(&dev);
        (void)hipDeviceGetAttribute(&cus, hipDeviceAttributeMultiprocessorCount, dev);
#if MK_LAUNCHES == 1
        if (hipFuncSetAttribute((const void*)mega_kernel, hipFuncAttributeMaxDynamicSharedMemorySize, LDS_BYTES) != hipSuccess) { fprintf(stderr, "kernel_launch: LDS attribute failed\n"); return; }
        int per_cu = 0;
        (void)hipOccupancyMaxActiveBlocksPerMultiprocessor(&per_cu, (const void*)mega_kernel, NTH, LDS_BYTES);
        if (per_cu < 1) { fprintf(stderr, "kernel_launch: occupancy query returned %d\n", per_cu); return; }
#endif
        grid_blocks = cus;
        first = true;
    }
    Params p{};
    const float* const* in = (const float* const*)d_in;
    p.x = in[0]; p.c = in[1]; p.ctx = in[2]; p.c_ctx = in[3]; p.ada_w = in[4]; p.ada_b = in[5]; p.norm_g = in[6]; p.router_w = in[7]; p.router_b = in[8];
    p.moe_w1 = in[9]; p.moe_b1 = in[10]; p.moe_w2 = in[11]; p.moe_b2 = in[12]; p.ab_in_w = in[13]; p.gla_wa_f = in[14]; p.gla_ba_f = in[15]; p.gla_wa_b = in[16]; p.gla_ba_b = in[17];
    p.gla_onorm = in[18]; p.mla_qnorm = in[19]; p.mla_wuq = in[20]; p.mla_kvnorm = in[21]; p.mla_wukv = in[22]; p.ab_out_w = in[23]; p.na_qkv_w = in[24]; p.na_rpb = in[25]; p.na_out_w = in[26];
    p.out = (float*)d_out; p.ws = (char*)d_ws;
#if MK_LAUNCHES == 1
    (void)hipMemsetAsync((char*)d_ws + WS_BAR, 0, 16384, stream);
    void* args[] = {&p};
    hipError_t e = hipLaunchCooperativeKernel((const void*)mega_kernel, dim3(grid_blocks), dim3(NTH), args, LDS_BYTES, stream);
    if (e != hipSuccess) fprintf(stderr, "cooperative launch failed: %s (grid %d)\n", hipGetErrorString(e), grid_blocks);
#else
    const int g = grid_blocks;
    launch_phase<0>(p, g, stream, first); launch_phase<1>(p, g, stream, first); launch_phase<2>(p, g, stream, first); launch_phase<3>(p, g, stream, first);
    launch_phase<4>(p, g, stream, first); launch_phase<5>(p, g, stream, first); launch_phase<6>(p, g, stream, first); launch_phase<7>(p, g, stream, first);
    launch_phase<8>(p, g, stream, first); launch_phase<9>(p, g, stream, first); launch_phase<10>(p, g, stream, first); launch_phase<11>(p, g, stream, first);
    launch_phase<12>(p, g, stream, first); launch_phase<13>(p, g, stream, first); launch_phase<14>(p, g, stream, first); launch_phase<15>(p, g, stream, first);
    launch_phase<16>(p, g, stream, first); launch_phase<17>(p, g, stream, first); launch_phase<18>(p, g, stream, first);
#endif
}
```

```cpp
#include <hip/hip_runtime.h>
#include <hip/hip_cooperative_groups.h>
#include <cstdio>
#include <cstdint>
namespace cg = cooperative_groups;

#ifndef PROBE_REPEAT
#define PROBE_REPEAT -1
#endif
#ifndef MK_LAUNCHES
#define MK_LAUNCHES 1
#endif

typedef unsigned short bf16_t;
typedef short bf16x8 __attribute__((ext_vector_type(8)));
typedef short s16x4 __attribute__((ext_vector_type(4)));
typedef float f32x4 __attribute__((ext_vector_type(4)));
typedef float f32x16 __attribute__((ext_vector_type(16)));
typedef unsigned u32x4 __attribute__((ext_vector_type(4)));
typedef unsigned u32x2 __attribute__((ext_vector_type(2)));

constexpr int SEQ = 16384, CTXN = 256, NTOK = SEQ + CTXN, DM = 1024;
constexpr int NEXP = 32, FF = 1024;
constexpr int PW = 2048;
constexpr int PC_Q = 0, PC_K = 256, PC_V = 512, PC_R = 1024, PC_AF = 1536, PC_AB = 1552, PC_CQ = 1568, PC_CKV = 1824, PC_KR = 1952;
constexpr int NCH = NTOK / 64;
constexpr int NTH = 512;
constexpr float EPSN = 1e-6f;
constexpr float LOG2E = 1.4426950408889634f;

constexpr size_t al256(size_t x) { return (x + 255) / 256 * 256; }
constexpr size_t WS_BAR   = 0;
constexpr size_t WS_CNT   = WS_BAR + 16384;
constexpr size_t WS_MOD   = WS_CNT + 1024;
constexpr size_t WS_ROPE  = WS_MOD + al256((size_t)2 * 2 * 6144 * 4);
constexpr size_t WS_RWT   = WS_ROPE + al256((size_t)(256 + 256 + 64 + 64) * 16 * 4);
constexpr size_t WS_WIN   = WS_RWT + al256((size_t)2 * 32 * 1024 * 4);
constexpr size_t WS_WUQ   = WS_WIN + (size_t)2048 * 1024 * 2;
constexpr size_t WS_WUKV  = WS_WUQ + (size_t)768 * 256 * 2;
constexpr size_t WS_WOUT0 = WS_WUKV + (size_t)1024 * 128 * 2;
constexpr size_t WS_WQKV  = WS_WOUT0 + (size_t)1024 * 1024 * 2;
constexpr size_t WS_WNAO  = WS_WQKV + (size_t)3072 * 1024 * 2;
constexpr size_t WS_W1T   = WS_WNAO + (size_t)1024 * 1024 * 2;
constexpr size_t WS_W2T   = WS_W1T + (size_t)2 * 32 * 2048 * 1024 * 2;
constexpr size_t WS_HB    = WS_W2T + (size_t)2 * 32 * 1024 * 1024 * 2;
constexpr size_t WS_P     = WS_HB + (size_t)NTOK * 1024 * 2;
constexpr size_t WS_QM    = WS_P + (size_t)NTOK * 3072 * 2;
constexpr size_t WS_KM    = WS_QM + (size_t)NTOK * 768 * 2;
constexpr size_t WS_VM    = WS_KM + (size_t)NTOK * 768 * 2;
constexpr size_t WS_U     = WS_VM + (size_t)NTOK * 512 * 2;
constexpr size_t WS_SIN   = WS_U + (size_t)2 * NCH * 4 * 128 * 64 * 2;
constexpr size_t WS_DEC   = WS_SIN + (size_t)2 * NCH * 4 * 128 * 64 * 2;
constexpr size_t WS_MIX   = WS_DEC + al256((size_t)2 * NCH * 4 * 64 * 4);
constexpr size_t WS_OB    = WS_MIX + (size_t)NTOK * 1024 * 2;
constexpr size_t WS_X1    = WS_OB + (size_t)NTOK * 1024 * 2;
constexpr size_t WS_X2    = WS_X1 + (size_t)NTOK * 1024 * 4;
constexpr size_t WS_TOPE  = WS_X2 + (size_t)NTOK * 1024 * 4;
constexpr size_t WS_TOPP  = WS_TOPE + al256((size_t)NTOK * 4 * 4);
constexpr size_t WS_GATE  = WS_TOPP + al256((size_t)NTOK * 4 * 4);
constexpr size_t WS_LIST  = WS_GATE + al256((size_t)NTOK * 4 * 4);
constexpr size_t WS_ACT   = WS_LIST + al256((size_t)32 * NTOK * 4);
constexpr size_t WS_YB    = WS_ACT + (size_t)(NTOK * 4 + 256) * 1024 * 2;
constexpr size_t WS_END   = WS_YB + (size_t)(NTOK * 4) * 1024 * 2;

constexpr int LDS_BYTES = 160 * 1024;
extern __shared__ __attribute__((aligned(16))) char smem[];

struct Params {
    const float *x, *c, *ctx, *c_ctx, *ada_w, *ada_b, *norm_g, *router_w, *router_b, *moe_w1, *moe_b1, *moe_w2, *moe_b2;
    const float *ab_in_w, *gla_wa_f, *gla_ba_f, *gla_wa_b, *gla_ba_b, *gla_onorm, *mla_qnorm, *mla_wuq, *mla_kvnorm, *mla_wukv;
    const float *ab_out_w, *na_qkv_w, *na_rpb, *na_out_w;
    float* out; char* ws;
    int pad0, pad1;
};

__device__ __forceinline__ float bf2f(bf16_t h) { return __uint_as_float(((unsigned)h) << 16); }
__device__ __forceinline__ bf16_t f2bf(float f) { unsigned u = __float_as_uint(f); u += 0x7FFFu + ((u >> 16) & 1u); return (bf16_t)(u >> 16); }
__device__ __forceinline__ unsigned cvtpk(float lo, float hi) { unsigned r; asm volatile("v_cvt_pk_bf16_f32 %0, %1, %2" : "=v"(r) : "v"(lo), "v"(hi)); return r; }
__device__ __forceinline__ float wave_sum(float v) {
#pragma unroll
    for (int o = 32; o >= 1; o >>= 1) v += __shfl_xor(v, o);
    return v;
}
__device__ __forceinline__ int crow(int r, int hi) { return (r & 3) + 8 * (r >> 2) + 4 * hi; }
__device__ __forceinline__ float silu_f(float x) { return x / (1.f + __expf(-x)); }
#define SBAR() __builtin_amdgcn_sched_barrier(0)
__device__ __forceinline__ int tid_opaque() { int t = threadIdx.x; asm volatile("" : "+v"(t)); return t; }

struct ConvJob { const float* src; bf16_t* dst; const float* gain; int K, Nsrc, kt, nt, mode; };
__device__ __forceinline__ void conv_load(const ConvJob& jb, float4 (&v)[16]) {
    const int tid = threadIdx.x, n4 = tid & 63, kr = tid >> 6, n = jb.nt * 256 + n4 * 4;
    const float* q = jb.src + (size_t)(jb.kt * 128 + kr) * jb.Nsrc + n;
#pragma unroll
    for (int i = 0; i < 16; ++i) { if (n < jb.Nsrc) { const f32x4 t = __builtin_nontemporal_load((const f32x4*)(q + (size_t)(8 * i) * jb.Nsrc)); v[i] = make_float4(t[0], t[1], t[2], t[3]); } else v[i] = make_float4(0.f, 0.f, 0.f, 0.f); }
}
__device__ __forceinline__ void conv_to_lds(const ConvJob& jb, const float4 (&v)[16]) {
    bf16_t* T = (bf16_t*)smem;
    const int tid = threadIdx.x, n4 = tid & 63, kr = tid >> 6;
#pragma unroll
    for (int i = 0; i < 16; ++i) {
        const int k = kr + 8 * i;
        float4 w = v[i];
        if (jb.mode == 1) { const float g = jb.gain[jb.kt * 128 + k]; w.x *= g; w.y *= g; w.z *= g; w.w *= g; }
        u32x2 pk; pk.x = cvtpk(w.x, w.y); pk.y = cvtpk(w.z, w.w);
        *(u32x2*)(T + k * 260 + n4 * 4) = pk;
    }
}
__device__ __forceinline__ void conv_readout(const ConvJob& jb) {
    const bf16_t* T = (const bf16_t*)smem;
    const int tid = threadIdx.x, k0 = jb.kt * 128;
#pragma unroll
    for (int i = 0; i < 8; ++i) {
        const int cc = tid + 512 * i, nn = cc >> 4, kc = cc & 15;
        const int col = (jb.mode == 2) ? (2 * (nn & 127) + (nn >> 7)) : nn;
        unsigned short e[8];
#pragma unroll
        for (int j = 0; j < 8; ++j) e[j] = T[(kc * 8 + j) * 260 + col];
        u32x4 o; o.x = e[0] | ((unsigned)e[1] << 16); o.y = e[2] | ((unsigned)e[3] << 16); o.z = e[4] | ((unsigned)e[5] << 16); o.w = e[6] | ((unsigned)e[7] << 16);
        *(u32x4*)(jb.dst + (size_t)(jb.nt * 256 + nn) * jb.K + k0 + kc * 8) = o;
    }
}

__device__ __forceinline__ void adaln_job(const Params& p, int job) {
    const int l = job / 24, cb = (job % 24) * 256, tid = threadIdx.x;
    float* sv = (float*)smem;
    for (int i = tid; i < 2048; i += NTH) { const int k = i & 1023; const float xx = (i < 1024) ? p.c[k] : p.c_ctx[k]; sv[i] = silu_f(xx); }
    __syncthreads();
    const int col4 = tid & 63, kq = tid >> 6;
    float4 a0 = make_float4(0, 0, 0, 0), a1 = make_float4(0, 0, 0, 0);
    const float* w = p.ada_w + ((size_t)l * 1024 + kq * 128) * 6144 + cb + col4 * 4;
#pragma unroll 8
    for (int k = 0; k < 128; ++k) {
        const float4 wv = *(const float4*)(w + (size_t)k * 6144);
        const float s0 = sv[kq * 128 + k], s1 = sv[1024 + kq * 128 + k];
        a0.x += s0 * wv.x; a0.y += s0 * wv.y; a0.z += s0 * wv.z; a0.w += s0 * wv.w;
        a1.x += s1 * wv.x; a1.y += s1 * wv.y; a1.z += s1 * wv.z; a1.w += s1 * wv.w;
    }
    float* red = sv + 2048;
    *(float4*)(red + (kq * 2 + 0) * 256 + col4 * 4) = a0;
    *(float4*)(red + (kq * 2 + 1) * 256 + col4 * 4) = a1;
    __syncthreads();
    {
        const int s = tid >> 8, col = tid & 255;
        float acc = p.ada_b[l * 6144 + cb + col];
#pragma unroll
        for (int q = 0; q < 8; ++q) acc += red[(q * 2 + s) * 256 + col];
        ((float*)(p.ws + WS_MOD))[(l * 2 + s) * 6144 + cb + col] = acc;
    }
    __syncthreads();
}

__device__ __forceinline__ void tables_job(const Params& p) {
    float* rope = (float*)(p.ws + WS_ROPE);
    const int tid = threadIdx.x;
    for (int i = tid; i < (256 + 64) * 16; i += NTH) {
        const bool isrow = i < 256 * 16;
        const int idx = isrow ? i : i - 256 * 16, pos = idx >> 4, j = idx & 15;
        const float inv = exp2f(-(float)j * (13.287712379549449f / 16.f));
        const float ang = (float)pos * inv;
        float rev = ang * 0.15915494309189535f; rev -= rintf(rev);
        const float cs = __builtin_amdgcn_cosf(rev), sn = __builtin_amdgcn_sinf(rev);
        if (isrow) { rope[idx] = cs; rope[256 * 16 + idx] = sn; }
        else { rope[512 * 16 + idx] = cs; rope[512 * 16 + 64 * 16 + idx] = sn; }
    }
    if (tid < 64) ((int*)(p.ws + WS_CNT))[tid] = 0;
}
__device__ __forceinline__ void rwt_job(const Params& p, int l) {
    float* dst = (float*)(p.ws + WS_RWT) + (size_t)l * 32 * 1024;
    const float* src = p.router_w + (size_t)l * 1024 * 32;
    for (int i = threadIdx.x; i < 32 * 1024; i += NTH) { const int cch = i >> 5, e = i & 31; dst[e * 1024 + cch] = src[i]; }
}

constexpr int J_IN = 8 * 8, J_UQ = 2 * 3, J_UKV = 1 * 4, J_OUT0 = 32, J_QKV = 8 * 12, J_NAO = 32, J_W1 = 64 * 64, J_W2 = 64 * 32;
constexpr int J_TOTAL = J_IN + J_UQ + J_UKV + J_OUT0 + J_QKV + J_NAO + J_W1 + J_W2;
__device__ __forceinline__ ConvJob conv_decode(const Params& p, int j) {
    ConvJob jb; jb.gain = nullptr; jb.mode = 0;
    int t = j;
    if (t < J_W1) { const int m = t >> 6, q = t & 63; jb.src = p.moe_w1 + (size_t)m * 1024 * 2048; jb.dst = (bf16_t*)(p.ws + WS_W1T) + (size_t)m * 2048 * 1024; jb.K = 1024; jb.Nsrc = 2048; jb.kt = q >> 3; jb.nt = q & 7; jb.mode = 2; return jb; } t -= J_W1;
    if (t < J_W2) { const int m = t >> 5, q = t & 31; jb.src = p.moe_w2 + (size_t)m * 1024 * 1024; jb.dst = (bf16_t*)(p.ws + WS_W2T) + (size_t)m * 1024 * 1024; jb.K = 1024; jb.Nsrc = 1024; jb.kt = q >> 2; jb.nt = q & 3; return jb; } t -= J_W2;
    if (t < J_IN) { jb.src = p.ab_in_w; jb.dst = (bf16_t*)(p.ws + WS_WIN); jb.K = 1024; jb.Nsrc = 2016; jb.kt = t / 8; jb.nt = t % 8; return jb; } t -= J_IN;
    if (t < J_UQ) { jb.src = p.mla_wuq; jb.dst = (bf16_t*)(p.ws + WS_WUQ); jb.K = 256; jb.Nsrc = 768; jb.kt = t / 3; jb.nt = t % 3; jb.mode = 1; jb.gain = p.mla_qnorm; return jb; } t -= J_UQ;
    if (t < J_UKV) { jb.src = p.mla_wukv; jb.dst = (bf16_t*)(p.ws + WS_WUKV); jb.K = 128; jb.Nsrc = 1024; jb.kt = 0; jb.nt = t; jb.mode = 1; jb.gain = p.mla_kvnorm; return jb; } t -= J_UKV;
    if (t < J_OUT0) { jb.src = p.ab_out_w; jb.dst = (bf16_t*)(p.ws + WS_WOUT0); jb.K = 1024; jb.Nsrc = 1024; jb.kt = t / 4; jb.nt = t % 4; return jb; } t -= J_OUT0;
    if (t < J_QKV) { jb.src = p.na_qkv_w; jb.dst = (bf16_t*)(p.ws + WS_WQKV); jb.K = 1024; jb.Nsrc = 3072; jb.kt = t / 12; jb.nt = t % 12; return jb; } t -= J_QKV;
    jb.src = p.na_out_w; jb.dst = (bf16_t*)(p.ws + WS_WNAO); jb.K = 1024; jb.Nsrc = 1024; jb.kt = t / 4; jb.nt = t % 4; return jb;
}

__device__ __forceinline__ void phase_prologue(const Params& p) {
    const int G = gridDim.x, b = blockIdx.x;
    for (int j = b; j < 51; j += G) {
        if (j < 48) adaln_job(p, j);
        else if (j == 48) tables_job(p);
        else rwt_job(p, j - 49);
    }
    __syncthreads();
    int j = b;
    if (j >= J_TOTAL) return;
    ConvJob cur = conv_decode(p, j);
    float4 v[16];
    conv_load(cur, v);
    for (;;) {
        conv_to_lds(cur, v);
        __syncthreads();
        const int jn = j + G;
        ConvJob nxt = cur;
        if (jn < J_TOTAL) { nxt = conv_decode(p, jn); conv_load(nxt, v); }
        conv_readout(cur);
        __syncthreads();
        if (jn >= J_TOTAL) break;
        cur = nxt; j = jn;
    }
}

namespace gm {
constexpr int BK = 64, HT = 128 * 64;
__device__ __forceinline__ int lds_byte(int r, int c) { const int st = (r >> 4) * 2 + (c >> 5), rr = r & 15, cc = c & 31, ob = rr * 64 + cc * 2; return st * 1024 + (ob ^ (((ob >> 9) & 1) << 5)); }
__device__ __forceinline__ void stage_rc(int b, int& R, int& C) { const int st = b / 1024, sb = b % 1024, swz = sb ^ (((sb >> 9) & 1) << 5); R = (st >> 1) * 16 + swz / 64; C = (st & 1) * 32 + (swz % 64) / 2; }

template <class Epi>
__device__ __forceinline__ void gemm_tile(const bf16_t* __restrict__ A, const int (&aoff)[2][2], const bf16_t* __restrict__ Bt, const int (&boff)[2], int nk, Epi& epi) {
    bf16_t* shm = (bf16_t*)smem;
    const int tid = tid_opaque(), wid = tid >> 6, lane = tid & 63, wr = wid >> 1, wc = wid & 1, fr = lane & 15, fq = lane >> 4;
    f32x4 acc[4][4];
#pragma unroll
    for (int m = 0; m < 4; ++m)
#pragma unroll
        for (int n = 0; n < 4; ++n) acc[m][n] = (f32x4){0.f, 0.f, 0.f, 0.f};
#define GM_STAGE(buf, kt) do { \
        _Pragma("unroll") for (int _i = 0; _i < 2; ++_i) { \
            __builtin_amdgcn_global_load_lds((const unsigned*)(A + aoff[0][_i] + (kt) * BK), (unsigned*)((char*)(shm + ((buf) * 3 + 0) * HT) + tid * 16 + _i * 8192), 16, 0, 0); \
            __builtin_amdgcn_global_load_lds((const unsigned*)(A + aoff[1][_i] + (kt) * BK), (unsigned*)((char*)(shm + ((buf) * 3 + 1) * HT) + tid * 16 + _i * 8192), 16, 0, 0); \
            __builtin_amdgcn_global_load_lds((const unsigned*)(Bt + boff[_i] + (kt) * BK), (unsigned*)((char*)(shm + ((buf) * 3 + 2) * HT) + tid * 16 + _i * 8192), 16, 0, 0); } } while (0)
    GM_STAGE(0, 0);
    for (int kt = 0; kt < nk; ++kt) {
        __syncthreads();
        const int buf = kt & 1;
        if (kt + 1 < nk) GM_STAGE(buf ^ 1, kt + 1);
        const char* Ab = (const char*)(shm + (buf * 3 + (wr >> 1)) * HT);
        const char* Bb = (const char*)(shm + (buf * 3 + 2) * HT);
#pragma unroll
        for (int k = 0; k < 2; ++k) {
            bf16x8 Bf[4], Af[4];
#pragma unroll
            for (int n = 0; n < 4; ++n) Bf[n] = *(const bf16x8*)(Bb + lds_byte(wc * 64 + n * 16 + fr, k * 32 + fq * 8));
#pragma unroll
            for (int m = 0; m < 4; ++m) Af[m] = *(const bf16x8*)(Ab + lds_byte((wr & 1) * 64 + m * 16 + fr, k * 32 + fq * 8));
#pragma unroll
            for (int m = 0; m < 4; ++m)
#pragma unroll
                for (int n = 0; n < 4; ++n) acc[m][n] = __builtin_amdgcn_mfma_f32_16x16x32_bf16(Af[m], Bf[n], acc[m][n], 0, 0, 0);
        }
    }
#undef GM_STAGE
    float* stg = (float*)smem;
    __syncthreads();
    {
        float* wb = stg + (wr * 64 + fq * 4) * 132 + wc * 64 + fr;
#pragma unroll
        for (int m = 0; m < 4; ++m)
#pragma unroll
            for (int n = 0; n < 4; ++n)
#pragma unroll
                for (int j = 0; j < 4; ++j) wb[(m * 16 + j) * 132 + n * 16] = acc[m][n][j];
    }
    __syncthreads();
    if (Epi::MOE1) {
        const int fch = tid & 7, rg = tid >> 3;
        for (int ps = 0; ps < 4; ++ps) {
            const int row = ps * 64 + rg;
            const float* q = stg + row * 132 + (fch >> 1) * 32 + (fch & 1) * 8;
            float g[8], l[8];
            *(f32x4*)&g[0] = *(const f32x4*)q; *(f32x4*)&g[4] = *(const f32x4*)(q + 4);
            *(f32x4*)&l[0] = *(const f32x4*)(q + 16); *(f32x4*)&l[4] = *(const f32x4*)(q + 20);
            epi.pair(row, fch * 8, g, l);
        }
    } else {
        const int ch = tid & 15, rg = tid >> 4;
        for (int ps = 0; ps < 8; ++ps) {
            const int row = ps * 32 + rg;
            const float* q = stg + row * 132 + ch * 8;
            float v[8];
            *(f32x4*)&v[0] = *(const f32x4*)q; *(f32x4*)&v[4] = *(const f32x4*)(q + 4);
            epi.row8(row, ch * 8, v);
        }
    }
    __syncthreads();
}
__device__ __forceinline__ void make_off(int (&off)[2][2], int row0, int ld) {
#pragma unroll
    for (int h = 0; h < 2; ++h)
#pragma unroll
        for (int i = 0; i < 2; ++i) { int R, C; stage_rc(tid_opaque() * 16 + i * 8192, R, C); off[h][i] = (row0 + h * 128 + R) * ld + C; }
}
__device__ __forceinline__ void make_off1(int (&off)[2], int row0, int ld) {
#pragma unroll
    for (int i = 0; i < 2; ++i) { int R, C; stage_rc(tid_opaque() * 16 + i * 8192, R, C); off[i] = (row0 + R) * ld + C; }
}
}

namespace pg8 {
#define PG8_LAS __attribute__((address_space(3)))
constexpr int BM = 256, BK = 64, HALF = 128, HTB = HALF * BK * 2, STAGE_BYTES = 8 * HTB, NXCD = 8, WGM = 8;
__device__ __forceinline__ int lds_byte(int r, int c) { const int st = (r >> 4) * 2 + (c >> 5), rr = r & 15, cc = c & 31, ob = rr * 64 + cc * 2; return st * 1024 + (ob ^ (((ob >> 9) & 1) << 5)); }
__device__ __forceinline__ void stage_rc(int b, int& R, int& C) { const int st = b / 1024, sb = b % 1024, swz = sb ^ (((sb >> 9) & 1) << 5); R = (st >> 1) * 16 + swz / 64; C = (st & 1) * 32 + (swz % 64) / 2; }
__device__ __forceinline__ int perm32(int rho) { const int n = rho >> 4, i = rho & 15; return 8 * (i >> 2) + 4 * n + (i & 3); }
struct Unit { int pm, pn, e, nvalid, slot0; };

template <class Epi, class Sched, bool GATHER>
__device__ __forceinline__ void gemm_phase(PG8_LAS unsigned char* lds, const Sched& S, const Epi& E, int K, int lda, int ldb) {
    const int tid = tid_opaque(), wid = __builtin_amdgcn_readfirstlane(tid >> 6), lane = tid & 63, wr = wid >> 2, wc = wid & 3, fr = lane & 15, fq = lane >> 4;
    const int nt = K / BK;
    unsigned voffA[2], voffB[2]; int gR[2], gC[2];
#pragma unroll
    for (int i = 0; i < 2; ++i) { int R, C; stage_rc(tid * 16 + i * 8192, R, C); const int Rb = Epi::PERM ? ((R & ~31) + perm32(R & 31)) : R;
        voffA[i] = (unsigned)(R * lda + C) * 2u; voffB[i] = (unsigned)(Rb * ldb + C) * 2u; gR[i] = R; gC[i] = C * 2; }
    const size_t kstep = (size_t)(BK * 2);
    const size_t hstepA = (size_t)HALF * lda * 2, hstepB = (size_t)HALF * ldb * 2;
    const unsigned ldsw = (unsigned)wid * 1024u;
    const int aoff = lds_byte(wr * 64 + fr, fq * 8), boff = lds_byte(wc * 32 + fr, fq * 8);
    unsigned gA[2][2] = {{0u, 0u}, {0u, 0u}};
#define PG8_SA(b, h) (((b) * 2 + (h)) * HTB)
#define PG8_SB(b, h) ((4 + (b) * 2 + (h)) * HTB)
#define PG8_STAGE(bufoff, gbase, voff) do { _Pragma("unroll") for (int _i = 0; _i < 2; ++_i) \
        __builtin_amdgcn_global_load_lds((const unsigned*)((const char*)(gbase) + (voff)[_i]), (PG8_LAS unsigned*)(lds + (bufoff) + ldsw + _i * 8192), 16, 0, 0); } while (0)
#define PG8_STAGE_A(bufoff, base, h) do { if constexpr (GATHER) PG8_STAGE(bufoff, base, gA[h]); else PG8_STAGE(bufoff, (base) + (h) * hstepA, voffA); } while (0)
#define PG8_LDA(dst, b, h) do { _Pragma("unroll") for (int m = 0; m < 4; ++m) _Pragma("unroll") for (int k = 0; k < 2; ++k) dst[m][k] = *(const PG8_LAS bf16x8*)(lds + PG8_SA(b, h) + aoff + m * 2048 + k * 1024); } while (0)
#define PG8_LDB(dst, b, h) do { _Pragma("unroll") for (int n = 0; n < 2; ++n) _Pragma("unroll") for (int k = 0; k < 2; ++k) dst[n][k] = *(const PG8_LAS bf16x8*)(lds + PG8_SB(b, h) + boff + n * 2048 + k * 1024); } while (0)
#define PG8_MMA(ai, bj, At, Bt) do { __builtin_amdgcn_s_setprio(1); _Pragma("unroll") for (int m = 0; m < 4; ++m) _Pragma("unroll") for (int n = 0; n < 2; ++n) _Pragma("unroll") for (int k = 0; k < 2; ++k) \
        acc[ai][bj][m][n] = __builtin_amdgcn_mfma_f32_16x16x32_bf16(Bt[n][k], At[m][k], acc[ai][bj][m][n], 0, 0, 0); __builtin_amdgcn_s_setprio(0); } while (0)
#define PG8_WAIT_V(n) asm volatile("s_waitcnt vmcnt(" #n ")" ::: "memory")
#define PG8_WAIT_L(n) asm volatile("s_waitcnt lgkmcnt(" #n ")" ::: "memory")
#define PG8_BAR __builtin_amdgcn_s_barrier()
#define PG8_SCHED __builtin_amdgcn_sched_barrier(0)
#define PG8_GLOAD(ui_) do { const PG8_LAS int* _gl = S.glist(ui_); _Pragma("unroll") for (int _h = 0; _h < 2; ++_h) _Pragma("unroll") for (int _i = 0; _i < 2; ++_i) \
        gA[_h][_i] = ((unsigned)_gl[_h * 128 + gR[_i]] << 11) + (unsigned)gC[_i]; } while (0)
    Unit cur, nxt; int ui = 0;
    if (!S.next(0, cur)) return;
    f32x4 acc[2][2][4][2];
#pragma unroll
    for (int a = 0; a < 2; ++a)
#pragma unroll
        for (int b = 0; b < 2; ++b)
#pragma unroll
            for (int m = 0; m < 4; ++m)
#pragma unroll
                for (int n = 0; n < 2; ++n) acc[a][b][m][n] = (f32x4){0.f, 0.f, 0.f, 0.f};
    bf16x8 At[4][2], B0[2][2], B1[2][2];
    const char* cA = S.a_base(cur); const char* cB = S.b_base(cur);
    if constexpr (GATHER) PG8_GLOAD(0);
    PG8_STAGE(PG8_SB(0, 0), cB, voffB); PG8_STAGE_A(PG8_SA(0, 0), cA, 0); PG8_STAGE(PG8_SB(0, 1), cB + hstepB, voffB); PG8_STAGE_A(PG8_SA(0, 1), cA, 1);
    if (wr == 1) PG8_BAR;
    PG8_WAIT_V(4); PG8_BAR;
    PG8_STAGE(PG8_SB(1, 0), cB + kstep, voffB); PG8_STAGE_A(PG8_SA(1, 0), cA + kstep, 0); PG8_STAGE(PG8_SB(1, 1), cB + hstepB + kstep, voffB);
    PG8_WAIT_V(6); PG8_BAR;
    for (;;) {
        const bool has_next = S.next(ui + 1, nxt);
        const char* nA = has_next ? S.a_base(nxt) : cA; const char* nB = has_next ? S.b_base(nxt) : cB;
        for (int t = 0; t < nt; t += 2) {
            const bool last = (t == nt - 2);
            const char* a1 = cA + (size_t)(t + 1) * kstep;
            const char* a2 = last ? nA : cA + (size_t)(t + 2) * kstep; const char* b2 = last ? nB : cB + (size_t)(t + 2) * kstep;
            const char* a3 = a2 + kstep; const char* b3 = b2 + kstep;
            PG8_LDB(B0, 0, 0); PG8_SCHED; PG8_LDA(At, 0, 0); PG8_STAGE_A(PG8_SA(1, 1), a1, 1);
            PG8_WAIT_L(8); PG8_BAR; PG8_WAIT_L(0); PG8_MMA(0, 0, At, B0); PG8_BAR; PG8_SCHED;
            if constexpr (GATHER) { if (last && has_next) PG8_GLOAD(ui + 1); }
            PG8_LDB(B1, 0, 1); PG8_STAGE(PG8_SB(0, 0), b2, voffB);
            PG8_BAR; PG8_WAIT_L(0); PG8_MMA(0, 1, At, B1); PG8_BAR;
            PG8_LDA(At, 0, 1); PG8_STAGE_A(PG8_SA(0, 0), a2, 0);
            PG8_BAR; PG8_WAIT_L(0); PG8_MMA(1, 0, At, B0); PG8_BAR; PG8_SCHED;
            PG8_STAGE(PG8_SB(0, 1), b2 + hstepB, voffB);
            PG8_WAIT_V(6); PG8_BAR; PG8_MMA(1, 1, At, B1); PG8_BAR;
            PG8_LDB(B0, 1, 0); PG8_SCHED; PG8_LDA(At, 1, 0); PG8_STAGE_A(PG8_SA(0, 1), a2, 1);
            PG8_WAIT_L(8); PG8_BAR; PG8_WAIT_L(0); PG8_MMA(0, 0, At, B0); PG8_BAR; PG8_SCHED;
            PG8_LDB(B1, 1, 1); PG8_STAGE(PG8_SB(1, 0), b3, voffB);
            PG8_BAR; PG8_WAIT_L(0); PG8_MMA(0, 1, At, B1); PG8_BAR;
            PG8_LDA(At, 1, 1); PG8_STAGE_A(PG8_SA(1, 0), a3, 0);
            PG8_BAR; PG8_WAIT_L(0); PG8_MMA(1, 0, At, B0); PG8_BAR; PG8_SCHED;
            PG8_STAGE(PG8_SB(1, 1), b3 + hstepB, voffB);
            PG8_WAIT_V(6); PG8_BAR; PG8_MMA(1, 1, At, B1); PG8_BAR;
        }
        E(acc, cur, wr, wc, fr, fq);
        if (!has_next) break;
#pragma unroll
        for (int a = 0; a < 2; ++a)
#pragma unroll
            for (int b = 0; b < 2; ++b)
#pragma unroll
                for (int m = 0; m < 4; ++m)
#pragma unroll
                    for (int n = 0; n < 2; ++n) acc[a][b][m][n] = (f32x4){0.f, 0.f, 0.f, 0.f};
        cur = nxt; cA = nA; cB = nB; ++ui;
    }
    PG8_WAIT_V(0);
    if (wr == 0) PG8_BAR;
    PG8_BAR;
#undef PG8_SA
#undef PG8_SB
#undef PG8_STAGE
#undef PG8_STAGE_A
#undef PG8_LDA
#undef PG8_LDB
#undef PG8_MMA
#undef PG8_WAIT_V
#undef PG8_WAIT_L
#undef PG8_BAR
#undef PG8_SCHED
#undef PG8_GLOAD
}

struct PlainOrder {
    const char* A; const char* Bt; int lda, ldb, nM, nN, nwg, G, c;
    __device__ void init(const bf16_t* A_, int lda_, const bf16_t* Bt_, int ldb_, int nM_, int nN_) { A = (const char*)A_; Bt = (const char*)Bt_; lda = lda_; ldb = ldb_; nM = nM_; nN = nN_; nwg = nM * nN; G = gridDim.x; c = blockIdx.x; }
    __device__ __forceinline__ bool next(int i, Unit& u) const {
        const long L = (long)i * G + c; if (L >= nwg) return false;
        int wgid = (int)L; { const int q = nwg / NXCD, r = nwg % NXCD, xcd = wgid % NXCD, off = wgid / NXCD; wgid = (xcd < r ? xcd * (q + 1) : r * (q + 1) + (xcd - r) * q) + off; }
        const int nig = WGM * nN, gid = wgid / nig, fm = gid * WGM, gsz = (nM - fm) < WGM ? (nM - fm) : WGM;
        u.pm = fm + ((wgid % nig) % gsz); u.pn = (wgid % nig) / gsz; u.e = 0; u.nvalid = 256; u.slot0 = 0; return true;
    }
    __device__ __forceinline__ const char* a_base(const Unit& u) const { return A + (size_t)u.pm * 256 * lda * 2; }
    __device__ __forceinline__ const char* b_base(const Unit& u) const { return Bt + (size_t)u.pn * 256 * ldb * 2; }
    __device__ __forceinline__ const PG8_LAS int* glist(int) const { return nullptr; }
};
struct MoeOrder {
    const char* A; const char* W; const PG8_LAS int* tab; const PG8_LAS int* gl; int wrows, nunits;
    __device__ __forceinline__ bool next(int i, Unit& u) const {
        if (i >= nunits) return false;
        const PG8_LAS int* t = tab + i * 8;
        u.pm = t[0]; u.pn = t[1]; u.e = t[2]; u.nvalid = t[3]; u.slot0 = t[4]; return true;
    }
    __device__ __forceinline__ const char* a_base(const Unit& u) const { return A + (size_t)u.slot0 * 2048; }
    __device__ __forceinline__ const char* b_base(const Unit& u) const { return W + ((size_t)u.e * wrows + (size_t)u.pn * 256) * 2048; }
    __device__ __forceinline__ const PG8_LAS int* glist(int i) const { return gl + i * 256; }
};
constexpr int MOE_UNITS_MAX = 16;
__device__ __forceinline__ int moe_build_units(PG8_LAS int* tab, const int* cnt, const int* off, const int* toff, int nN) {
    const int G = gridDim.x, c = blockIdx.x, x = c & 7, j = c >> 3, per = (G >> 3) / nN, nMt = toff[32];
    const int i = threadIdx.x;
    if (i < MOE_UNITS_MAX) {
        const int pn = j % nN, mt = (i * 8 + x) * per + j / nN;
        int e = 0, valid = (mt < nMt && j < per * nN) ? 1 : 0;
        if (valid) { while (toff[e + 1] <= mt) ++e; }
        const int m = mt - toff[e];
        tab[i * 8 + 0] = mt; tab[i * 8 + 1] = pn; tab[i * 8 + 2] = e; tab[i * 8 + 3] = cnt[e] - m * 256; tab[i * 8 + 4] = off[e] + m * 256; tab[i * 8 + 5] = valid;
    }
    __syncthreads();
    int n = 0;
    while (n < MOE_UNITS_MAX && tab[n * 8 + 5]) ++n;
    return n;
}
struct MoeOrderG : MoeOrder { __device__ __forceinline__ const char* a_base(const Unit&) const { return A; } };

__device__ __forceinline__ u32x4 pk8(const f32x4& a, const f32x4& b) { return (u32x4){cvtpk(a[0], a[1]), cvtpk(a[2], a[3]), cvtpk(b[0], b[1]), cvtpk(b[2], b[3])}; }
struct EpiStore {
    static constexpr bool PERM = true;
    bf16_t* C; int ldc; const float* rs;
    __device__ __forceinline__ void operator()(const f32x4 (&acc)[2][2][4][2], const Unit& u, int wr, int wc, int fr, int fq) const {
        bf16_t* base = C + ((size_t)u.pm * 256 + wr * 64 + fr) * ldc + u.pn * 256 + wc * 32 + 8 * fq;
#pragma unroll
        for (int ai = 0; ai < 2; ++ai)
#pragma unroll
            for (int m = 0; m < 4; ++m) { bf16_t* rowp = base + (size_t)(ai * HALF + m * 16) * ldc; const float s = rs ? rs[ai * HALF + wr * 64 + m * 16 + fr] : 1.f;
#pragma unroll
                for (int bj = 0; bj < 2; ++bj) *(u32x4*)(rowp + bj * HALF) = pk8(acc[ai][bj][m][0] * s, acc[ai][bj][m][1] * s); }
    }
};
struct EpiAct {
    static constexpr bool PERM = true;
    bf16_t* Act; const float* b1all;
    __device__ __forceinline__ void operator()(const f32x4 (&acc)[2][2][4][2], const Unit& u, int wr, int wc, int fr, int fq) const {
        const int f0 = u.pn * 128 + wc * 32 + 8 * fq;
        const float* bb = b1all + (size_t)u.e * 2048 + 2 * f0;
        f32x4 bv[4];
#pragma unroll
        for (int q = 0; q < 4; ++q) bv[q] = *(const f32x4*)(bb + 4 * q);
        bf16_t* base = Act + ((size_t)u.slot0 + wr * 64 + fr) * 1024 + f0;
#pragma unroll
        for (int ai = 0; ai < 2; ++ai)
#pragma unroll
            for (int m = 0; m < 4; ++m) {
                const int r = ai * HALF + wr * 64 + m * 16 + fr;
                float a[8];
#pragma unroll
                for (int n = 0; n < 2; ++n)
#pragma unroll
                    for (int j = 0; j < 4; ++j) { const int f = 4 * n + j;
                        float glu = acc[ai][0][m][n][j] + bv[f >> 1][(f & 1) * 2], lin = acc[ai][1][m][n][j] + bv[f >> 1][(f & 1) * 2 + 1];
                        glu = fminf(glu, 7.f); lin = fminf(fmaxf(lin, -7.f), 7.f);
                        a[f] = glu * __builtin_amdgcn_rcpf(1.f + __builtin_amdgcn_exp2f(-1.702f * LOG2E * glu)) * (lin + 1.f); }
                if (r < u.nvalid) *(u32x4*)(base + (size_t)(ai * HALF + m * 16) * 1024) = (u32x4){cvtpk(a[0], a[1]), cvtpk(a[2], a[3]), cvtpk(a[4], a[5]), cvtpk(a[6], a[7])};
            }
    }
};
struct EpiBias {
    static constexpr bool PERM = true;
    bf16_t* Y; const float* b2all;
    __device__ __forceinline__ void operator()(const f32x4 (&acc)[2][2][4][2], const Unit& u, int wr, int wc, int fr, int fq) const {
        const int c0 = u.pn * 256 + wc * 32 + 8 * fq;
        const float* bb = b2all + (size_t)u.e * 1024 + c0;
        f32x4 bv[2][2];
#pragma unroll
        for (int bj = 0; bj < 2; ++bj)
#pragma unroll
            for (int n = 0; n < 2; ++n) bv[bj][n] = *(const f32x4*)(bb + bj * HALF + 4 * n);
        bf16_t* base = Y + ((size_t)u.slot0 + wr * 64 + fr) * 1024 + c0;
#pragma unroll
        for (int ai = 0; ai < 2; ++ai)
#pragma unroll
            for (int m = 0; m < 4; ++m) { const int r = ai * HALF + wr * 64 + m * 16 + fr;
                if (r < u.nvalid) {
#pragma unroll
                    for (int bj = 0; bj < 2; ++bj) *(u32x4*)(base + (size_t)(ai * HALF + m * 16) * 1024 + bj * HALF) = pk8(acc[ai][bj][m][0] + bv[bj][0], acc[ai][bj][m][1] + bv[bj][1]); } }
    }
};
}

__device__ __forceinline__ u32x4 pack8(const float (&v)[8]) { return (u32x4){cvtpk(v[0], v[1]), cvtpk(v[2], v[3]), cvtpk(v[4], v[5]), cvtpk(v[6], v[7])}; }
struct EpiPlain {
    static constexpr bool MOE1 = false;
    bf16_t* C; int ldc;
    __device__ __forceinline__ void row8(int r, int c, const float (&v)[8]) const { *(u32x4*)(C + (size_t)r * ldc + c) = pack8(v); }
    __device__ __forceinline__ void pair(int, int, const float (&)[8], const float (&)[8]) const {}
};
struct EpiRowScale {
    static constexpr bool MOE1 = false;
    bf16_t* C; int ldc; const float* rs;
    __device__ __forceinline__ void row8(int r, int c, const float (&v)[8]) const { const float s = rs[r]; float w[8];
#pragma unroll
        for (int i = 0; i < 8; ++i) w[i] = v[i] * s;
        *(u32x4*)(C + (size_t)r * ldc + c) = pack8(w); }
    __device__ __forceinline__ void pair(int, int, const float (&)[8], const float (&)[8]) const {}
};
__device__ __forceinline__ void phase_gemm_plain(const bf16_t* A, int lda, const bf16_t* Bt, int K, bf16_t* C, int ldc, int nM, int nN) {
    const int G = gridDim.x;
    for (int u = blockIdx.x; u < nM * nN; u += G) {
        const int pm = u / nN, pn = u % nN;
        int aoff[2][2], boff[2];
        gm::make_off(aoff, pm * 256, lda); gm::make_off1(boff, pn * 128, K);
        EpiPlain epi{C + (size_t)pm * 256 * ldc + pn * 128, ldc};
        gm::gemm_tile(A, aoff, Bt, boff, K / 64, epi);
    }
}

struct Row16 { float4 v[4]; };
__device__ __forceinline__ Row16 ld_row_f32(const float* p, int lane) { Row16 r;
#pragma unroll
    for (int i = 0; i < 4; ++i) r.v[i] = *(const float4*)(p + lane * 4 + 256 * i);
    return r; }
__device__ __forceinline__ Row16 ld_row_bf16(const bf16_t* p, int lane) { Row16 r;
#pragma unroll
    for (int i = 0; i < 4; ++i) { const u32x2 w = *(const u32x2*)(p + lane * 4 + 256 * i);
        r.v[i] = make_float4(__uint_as_float(w.x << 16), __uint_as_float(w.x & 0xFFFF0000u), __uint_as_float(w.y << 16), __uint_as_float(w.y & 0xFFFF0000u)); }
    return r; }
__device__ __forceinline__ void st_row_f32(float* p, int lane, const Row16& r) {
#pragma unroll
    for (int i = 0; i < 4; ++i) *(float4*)(p + lane * 4 + 256 * i) = r.v[i]; }
__device__ __forceinline__ void st_row_bf16(bf16_t* p, int lane, const Row16& r) {
#pragma unroll
    for (int i = 0; i < 4; ++i) { u32x2 w; w.x = cvtpk(r.v[i].x, r.v[i].y); w.y = cvtpk(r.v[i].z, r.v[i].w); *(u32x2*)(p + lane * 4 + 256 * i) = w; } }
__device__ __forceinline__ float row_rstd(const Row16& r) {
    float s = 0.f;
#pragma unroll
    for (int i = 0; i < 4; ++i) s += r.v[i].x * r.v[i].x + r.v[i].y * r.v[i].y + r.v[i].z * r.v[i].z + r.v[i].w * r.v[i].w;
    s = wave_sum(s);
    return rsqrtf(s * (1.f / 1024.f) + EPSN);
}
__device__ __forceinline__ Row16 norm_mod(const Row16& x, float rstd, const float* g, const float* sc, const float* sh, int lane) {
    Row16 h;
#pragma unroll
    for (int i = 0; i < 4; ++i) {
        const int c = lane * 4 + 256 * i;
        const float4 gv = *(const float4*)(g + c), scv = *(const float4*)(sc + c), shv = *(const float4*)(sh + c);
        h.v[i].x = x.v[i].x * rstd * gv.x * (1.f + scv.x) + shv.x; h.v[i].y = x.v[i].y * rstd * gv.y * (1.f + scv.y) + shv.y;
        h.v[i].z = x.v[i].z * rstd * gv.z * (1.f + scv.z) + shv.z; h.v[i].w = x.v[i].w * rstd * gv.w * (1.f + scv.w) + shv.w;
    }
    return h;
}
__device__ __forceinline__ Row16 resid_add(const Row16& x, const Row16& y, float rstd, const float* g, const float* gate, int lane) {
    Row16 o;
#pragma unroll
    for (int i = 0; i < 4; ++i) {
        const int c = lane * 4 + 256 * i;
        const float4 gv = *(const float4*)(g + c), ga = *(const float4*)(gate + c);
        o.v[i].x = x.v[i].x + y.v[i].x * rstd * gv.x * ga.x; o.v[i].y = x.v[i].y + y.v[i].y * rstd * gv.y * ga.y;
        o.v[i].z = x.v[i].z + y.v[i].z * rstd * gv.z * ga.z; o.v[i].w = x.v[i].w + y.v[i].w * rstd * gv.w * ga.w;
    }
    return o;
}
__device__ __forceinline__ const float* mod_ptr(const Params& p, int l, int r) { return (const float*)(p.ws + WS_MOD) + (size_t)(l * 2 + (r < CTXN ? 1 : 0)) * 6144; }
__device__ __forceinline__ const float* src_row(const Params& p, int r) { return r < CTXN ? p.ctx + (size_t)r * 1024 : p.x + (size_t)(r - CTXN) * 1024; }

struct ModAB { float4 a[4], b[4]; };
struct ModG { float4 g[4]; };
__device__ __forceinline__ ModAB load_ab(const float* g, const float* sc, const float* sh, int lane) { ModAB m;
#pragma unroll
    for (int i = 0; i < 4; ++i) { const int c = lane * 4 + 256 * i; const float4 gv = *(const float4*)(g + c), sv = *(const float4*)(sc + c); m.b[i] = *(const float4*)(sh + c);
        m.a[i] = make_float4(gv.x * (1.f + sv.x), gv.y * (1.f + sv.y), gv.z * (1.f + sv.z), gv.w * (1.f + sv.w)); }
    return m; }
__device__ __forceinline__ ModG load_g(const float* g, const float* gate, int lane) { ModG m;
#pragma unroll
    for (int i = 0; i < 4; ++i) { const int c = lane * 4 + 256 * i; const float4 gv = *(const float4*)(g + c), ga = *(const float4*)(gate + c); m.g[i] = make_float4(gv.x * ga.x, gv.y * ga.y, gv.z * ga.z, gv.w * ga.w); }
    return m; }
__device__ __forceinline__ Row16 apply_ab(const Row16& x, float rstd, const ModAB& m) { Row16 h;
#pragma unroll
    for (int i = 0; i < 4; ++i) h.v[i] = make_float4(x.v[i].x * rstd * m.a[i].x + m.b[i].x, x.v[i].y * rstd * m.a[i].y + m.b[i].y, x.v[i].z * rstd * m.a[i].z + m.b[i].z, x.v[i].w * rstd * m.a[i].w + m.b[i].w);
    return h; }
__device__ __forceinline__ Row16 apply_g(const Row16& x, const Row16& y, float rstd, const ModG& m) { Row16 o;
#pragma unroll
    for (int i = 0; i < 4; ++i) o.v[i] = make_float4(x.v[i].x + y.v[i].x * rstd * m.g[i].x, x.v[i].y + y.v[i].y * rstd * m.g[i].y, x.v[i].z + y.v[i].z * rstd * m.g[i].z, x.v[i].w + y.v[i].w * rstd * m.g[i].w);
    return o; }
struct RowB8 { u32x2 v[4]; };
__device__ __forceinline__ RowB8 ld_rowb(const bf16_t* p, int lane) { RowB8 r;
#pragma unroll
    for (int i = 0; i < 4; ++i) r.v[i] = *(const u32x2*)(p + lane * 4 + 256 * i);
    return r; }
__device__ __forceinline__ Row16 cvt_rowb(const RowB8& b) { Row16 r;
#pragma unroll
    for (int i = 0; i < 4; ++i) r.v[i] = make_float4(__uint_as_float(b.v[i].x << 16), __uint_as_float(b.v[i].x & 0xFFFF0000u), __uint_as_float(b.v[i].y << 16), __uint_as_float(b.v[i].y & 0xFFFF0000u));
    return r; }

__device__ __forceinline__ void phase_norm1_l0(const Params& p) {
    const int lane = threadIdx.x & 63, wave = threadIdx.x >> 6, G = gridDim.x, step = G * 8;
    bf16_t* HB = (bf16_t*)(p.ws + WS_HB);
    int r = blockIdx.x * 8 + wave;
    if (r >= NTOK) return;
    int cur_s = (r < CTXN) ? 1 : 0;
    const float* mod = mod_ptr(p, 0, r);
    ModAB m = load_ab(p.norm_g, mod + 1024, mod, lane);
    Row16 x = ld_row_f32(src_row(p, r), lane);
    for (; r < NTOK; r += step) {
        const int rn = r + step;
        Row16 xn = x;
        if (rn < NTOK) xn = ld_row_f32(src_row(p, rn), lane);
        const int s_ = (r < CTXN) ? 1 : 0;
        if (s_ != cur_s) { cur_s = s_; const float* md = mod_ptr(p, 0, r); m = load_ab(p.norm_g, md + 1024, md, lane); }
        const float rstd = row_rstd(x);
        st_row_bf16(HB + (size_t)r * 1024, lane, apply_ab(x, rstd, m));
        x = xn;
    }
}

__device__ __forceinline__ void phase_mid(const Params& p, int l) {
    const int tid = tid_opaque(), lane = tid & 63, wave = tid >> 6, G = gridDim.x;
    float* wT = (float*)smem;
    int* lcnt = (int*)(smem + 139264);
    int* lbase = lcnt + 32;
    int* sel = lbase + 32;
    {
        const float4* src = (const float4*)((const float*)(p.ws + WS_RWT) + (size_t)l * 32 * 1024);
        for (int i = tid; i < 32 * 1024 / 4; i += NTH) ((float4*)wT)[i] = src[i];
        if (tid < 32) lcnt[tid] = 0;
    }
    __syncthreads();
    const int r_begin = (l == 0) ? 0 : CTXN;
    bf16_t* HB = (bf16_t*)(p.ws + WS_HB); const bf16_t* OB = (const bf16_t*)(p.ws + WS_OB);
    float* X1 = (float*)(p.ws + WS_X1); const float* X2 = (const float*)(p.ws + WS_X2);
    const float* ng = p.norm_g + (size_t)l * 4 * 1024;
    const float* rb = p.router_b + l * 32;
    float* GATE = (float*)(p.ws + WS_GATE);
    int it = 0;
    int r = r_begin + blockIdx.x * 8 + wave;
    const int step = G * 8;
    int cur_s = -1; ModG mg; ModAB mab;
    Row16 xin; RowB8 ob;
    if (r < NTOK) { xin = (l == 0) ? ld_row_f32(src_row(p, r), lane) : ld_row_f32(X2 + (size_t)r * 1024, lane); ob = ld_rowb(OB + (size_t)r * 1024, lane); }
    for (; r < NTOK; r += step, ++it) {
        const int rn = r + step;
        Row16 xin_n = xin; RowB8 ob_n = ob;
        if (rn < NTOK) { xin_n = (l == 0) ? ld_row_f32(src_row(p, rn), lane) : ld_row_f32(X2 + (size_t)rn * 1024, lane); ob_n = ld_rowb(OB + (size_t)rn * 1024, lane); }
        const int s_ = (r < CTXN) ? 1 : 0;
        if (s_ != cur_s) { cur_s = s_; const float* mod = mod_ptr(p, l, r); mg = load_g(ng + 1024, mod + 2048, lane); mab = load_ab(ng + 2048, mod + 4096, mod + 3072, lane); }
        const Row16 o = cvt_rowb(ob);
        const float rso = row_rstd(o);
        const Row16 x1 = apply_g(xin, o, rso, mg);
        st_row_f32(X1 + (size_t)r * 1024, lane, x1);
        const float rs1 = row_rstd(x1);
        const Row16 h = apply_ab(x1, rs1, mab);
        st_row_bf16(HB + (size_t)r * 1024, lane, h);
        xin = xin_n; ob = ob_n;
        float part[32];
        {
            const float* wl = wT + lane * 4;
            float4 wa[4], wb[4];
#pragma unroll
            for (int i = 0; i < 4; ++i) wa[i] = *(const float4*)(wl + 256 * i);
#pragma unroll
            for (int e = 0; e < 32; e += 2) {
#pragma unroll
                for (int i = 0; i < 4; ++i) wb[i] = *(const float4*)(wl + (e + 1) * 1024 + 256 * i);
                { float a = 0.f;
#pragma unroll
                  for (int i = 0; i < 4; ++i) a += h.v[i].x * wa[i].x + h.v[i].y * wa[i].y + h.v[i].z * wa[i].z + h.v[i].w * wa[i].w;
                  part[e] = a; }
                if (e + 2 < 32) {
#pragma unroll
                    for (int i = 0; i < 4; ++i) wa[i] = *(const float4*)(wl + (e + 2) * 1024 + 256 * i);
                }
                { float a = 0.f;
#pragma unroll
                  for (int i = 0; i < 4; ++i) a += h.v[i].x * wb[i].x + h.v[i].y * wb[i].y + h.v[i].z * wb[i].z + h.v[i].w * wb[i].w;
                  part[e + 1] = a; }
            }
        }
#define TR_STEP(NV, BIT) _Pragma("unroll") for (int i = 0; i < (NV) / 2; ++i) { const float lo = part[i], hi_ = part[i + (NV) / 2]; const bool up = (lane & (BIT)) != 0; \
            const float send = up ? lo : hi_, keep = up ? hi_ : lo; part[i] = keep + __shfl_xor(send, (BIT)); }
        TR_STEP(32, 32) TR_STEP(16, 16) TR_STEP(8, 8) TR_STEP(4, 4) TR_STEP(2, 2)
#undef TR_STEP
        float logit = part[0] + __shfl_xor(part[0], 1);
        const int myexp = lane >> 1;
        logit += rb[myexp];
        float val = (lane & 1) ? -3.0e38f : logit;
        float tv[4]; int ti[4];
#pragma unroll
        for (int k = 0; k < 4; ++k) {
            float bv = val; int bi = myexp;
#pragma unroll
            for (int off = 32; off >= 1; off >>= 1) { const float ov = __shfl_xor(bv, off); const int oi = __shfl_xor(bi, off); if (ov > bv || (ov == bv && oi < bi)) { bv = ov; bi = oi; } }
            tv[k] = bv; ti[k] = bi;
            if (myexp == bi) val = -3.0e38f;
        }
        const float e1 = __expf(tv[1] - tv[0]), e2 = __expf(tv[2] - tv[0]), e3 = __expf(tv[3] - tv[0]);
        const float inv = 1.f / (1.f + e1 + e2 + e3);
        if (lane < 4) {
            const int k = lane;
            const int e = (k == 0) ? ti[0] : (k == 1) ? ti[1] : (k == 2) ? ti[2] : ti[3];
            const float gk = ((k == 0) ? 1.f : (k == 1) ? e1 : (k == 2) ? e2 : e3) * inv;
            GATE[(size_t)r * 4 + k] = gk;
            const int lp = atomicAdd(&lcnt[e], 1);
            sel[(it * 8 + wave) * 4 + k] = e | (lp << 8);
        }
    }
    __syncthreads();
    int* CNT = (int*)(p.ws + WS_CNT) + l * 32;
    if (tid < 32) lbase[tid] = atomicAdd(&CNT[tid], lcnt[tid]);
    __syncthreads();
    {
        int* TOPE = (int*)(p.ws + WS_TOPE); int* TOPP = (int*)(p.ws + WS_TOPP); int* LIST = (int*)(p.ws + WS_LIST);
        for (int q = tid; q < 80 * 4; q += NTH) {
            const int slot = q >> 2, k = q & 3, itq = slot >> 3, wv = slot & 7;
            const int r = r_begin + blockIdx.x * 8 + wv + itq * G * 8;
            if (r < NTOK) {
                const int s = sel[q], e = s & 255, lp = s >> 8, pos = lbase[e] + lp;
                TOPE[(size_t)r * 4 + k] = e; TOPP[(size_t)r * 4 + k] = pos; LIST[(size_t)e * NTOK + pos] = r;
            }
        }
    }
    __syncthreads();
}

struct MoeLds { int* cnt; int* off; int* toff; };
__device__ __forceinline__ MoeLds moe_setup(const Params& p, int l, char* base) {
    MoeLds m; m.cnt = (int*)base; m.off = m.cnt + 32; m.toff = m.off + 33;
    const int tid = tid_opaque();
    if (tid < 64) {
        const int e = tid & 31;
        const int cval = ((const int*)(p.ws + WS_CNT))[l * 32 + e];
        const int tiles = (cval + 255) >> 8;
        int pc = cval, pt = tiles;
#pragma unroll
        for (int o = 1; o < 32; o <<= 1) { const int a = __shfl_up(pc, o, 32), b = __shfl_up(pt, o, 32); if (e >= o) { pc += a; pt += b; } }
        if (tid < 32) { m.cnt[e] = cval; m.off[e + 1] = pc; m.toff[e + 1] = pt; if (e == 0) { m.off[0] = 0; m.toff[0] = 0; } }
    }
    __syncthreads();
    return m;
}

__device__ __forceinline__ void phase_end(const Params& p, int l) {
    const int tid = tid_opaque(), lane = tid & 63, wave = tid >> 6, G = gridDim.x;
    MoeLds ml = moe_setup(p, l, smem);
    const int r_begin = (l == 0) ? 0 : CTXN;
    const bf16_t* YB = (const bf16_t*)(p.ws + WS_YB);
    const float* X1 = (const float*)(p.ws + WS_X1); float* X2 = (float*)(p.ws + WS_X2);
    bf16_t* HB = (bf16_t*)(p.ws + WS_HB);
    const int* TOPE = (const int*)(p.ws + WS_TOPE); const int* TOPP = (const int*)(p.ws + WS_TOPP); const float* GATE = (const float*)(p.ws + WS_GATE);
    const float* ng = p.norm_g + (size_t)l * 4 * 1024;
    int cur_s = -1; ModG mg; ModAB mab;
    int r = r_begin + blockIdx.x * 8 + wave;
    int4 en = make_int4(0, 0, 0, 0), pn = make_int4(0, 0, 0, 0); float4 gn = make_float4(0.f, 0.f, 0.f, 0.f);
    const int step = G * 8;
    if (r < NTOK) { en = *(const int4*)(TOPE + (size_t)r * 4); pn = *(const int4*)(TOPP + (size_t)r * 4); gn = *(const float4*)(GATE + (size_t)r * 4); }
    RowB8 t4n[4]; Row16 x1n; float4 gcur = gn;
    if (r < NTOK) {
        t4n[0] = ld_rowb(YB + (size_t)(ml.off[en.x] + pn.x) * 1024, lane); t4n[1] = ld_rowb(YB + (size_t)(ml.off[en.y] + pn.y) * 1024, lane);
        t4n[2] = ld_rowb(YB + (size_t)(ml.off[en.z] + pn.z) * 1024, lane); t4n[3] = ld_rowb(YB + (size_t)(ml.off[en.w] + pn.w) * 1024, lane);
        x1n = ld_row_f32(X1 + (size_t)r * 1024, lane);
        if (r + step < NTOK) { en = *(const int4*)(TOPE + (size_t)(r + step) * 4); pn = *(const int4*)(TOPP + (size_t)(r + step) * 4); gn = *(const float4*)(GATE + (size_t)(r + step) * 4); }
    }
    for (; r < NTOK; r += step) {
        RowB8 t4[4]; t4[0] = t4n[0]; t4[1] = t4n[1]; t4[2] = t4n[2]; t4[3] = t4n[3];
        const Row16 x1 = x1n;
        const float g4[4] = {gcur.x, gcur.y, gcur.z, gcur.w};
        const int rn = r + step;
        if (rn < NTOK) {
            t4n[0] = ld_rowb(YB + (size_t)(ml.off[en.x] + pn.x) * 1024, lane); t4n[1] = ld_rowb(YB + (size_t)(ml.off[en.y] + pn.y) * 1024, lane);
            t4n[2] = ld_rowb(YB + (size_t)(ml.off[en.z] + pn.z) * 1024, lane); t4n[3] = ld_rowb(YB + (size_t)(ml.off[en.w] + pn.w) * 1024, lane);
            x1n = ld_row_f32(X1 + (size_t)rn * 1024, lane);
            gcur = gn;
            if (rn + step < NTOK) { en = *(const int4*)(TOPE + (size_t)(rn + step) * 4); pn = *(const int4*)(TOPP + (size_t)(rn + step) * 4); gn = *(const float4*)(GATE + (size_t)(rn + step) * 4); }
        }
        const int s_ = (r < CTXN) ? 1 : 0;
        if (s_ != cur_s) { cur_s = s_; const float* mod = mod_ptr(p, l, r); mg = load_g(ng + 3072, mod + 5120, lane);
            if (l == 0) { const float* mod1 = mod_ptr(p, 1, r); mab = load_ab(p.norm_g + (size_t)4 * 1024, mod1 + 1024, mod1, lane); } }
        Row16 y;
#pragma unroll
        for (int i = 0; i < 4; ++i) y.v[i] = make_float4(0.f, 0.f, 0.f, 0.f);
#pragma unroll
        for (int k = 0; k < 4; ++k) { const Row16 t = cvt_rowb(t4[k]); const float gk = g4[k];
#pragma unroll
            for (int i = 0; i < 4; ++i) { y.v[i].x += gk * t.v[i].x; y.v[i].y += gk * t.v[i].y; y.v[i].z += gk * t.v[i].z; y.v[i].w += gk * t.v[i].w; } }
        const float rsy = row_rstd(y);
        const Row16 x2 = apply_g(x1, y, rsy, mg);
        if (l == 0) {
            st_row_f32(X2 + (size_t)r * 1024, lane, x2);
            const float rs2 = row_rstd(x2);
            st_row_bf16(HB + (size_t)r * 1024, lane, apply_ab(x2, rs2, mab));
        } else {
            st_row_f32(p.out + (size_t)(r - CTXN) * 1024, lane, x2);
        }
    }
    __syncthreads();
}

__device__ __forceinline__ void phase_gemm_pg8(const bf16_t* A, int lda, const bf16_t* Bt, int K, bf16_t* C, int ldc, int nM, int nN) {
    pg8::PlainOrder S; S.init(A, lda, Bt, K, nM, nN);
    pg8::EpiStore E{C, ldc, nullptr};
    pg8::gemm_phase<pg8::EpiStore, pg8::PlainOrder, false>((PG8_LAS unsigned char*)smem, S, E, K, lda, K);
    __syncthreads();
}
constexpr int MOE_GL_OFF = 131072, MOE_ML_OFF = 143360, MOE_TAB_OFF = 143872, MOE_GL_MAX = 12;
__device__ __forceinline__ void phase_moe1(const Params& p, int l) {
    MoeLds ml = moe_setup(p, l, smem + MOE_ML_OFF);
    const int tid = tid_opaque();
    PG8_LAS int* gl = (PG8_LAS int*)(smem + MOE_GL_OFF);
    PG8_LAS int* tab = (PG8_LAS int*)(smem + MOE_TAB_OFF);
    pg8::MoeOrderG S;
    S.A = (const char*)(p.ws + WS_HB); S.W = (const char*)(p.ws + WS_W1T) + (size_t)l * 32 * 2048 * 2048;
    S.tab = tab; S.gl = gl; S.wrows = 2048;
    S.nunits = pg8::moe_build_units(tab, ml.cnt, ml.off, ml.toff, 8);
    if (S.nunits > MOE_GL_MAX) S.nunits = MOE_GL_MAX;
    const int* LIST = (const int*)(p.ws + WS_LIST);
    for (int i = 0; i < S.nunits; ++i) {
        const int e = tab[i * 8 + 2], mt = tab[i * 8 + 0], nvalid = tab[i * 8 + 3], m = mt - ml.toff[e];
        if (tid < 256) gl[i * 256 + tid] = (tid < nvalid) ? LIST[(size_t)e * NTOK + m * 256 + tid] : 0;
    }
    __syncthreads();
    pg8::EpiAct E{(bf16_t*)(p.ws + WS_ACT), p.moe_b1 + (size_t)l * 32 * 2048};
    pg8::gemm_phase<pg8::EpiAct, pg8::MoeOrderG, true>((PG8_LAS unsigned char*)smem, S, E, 1024, 1024, 1024);
    __syncthreads();
}
__device__ __forceinline__ void phase_moe2(const Params& p, int l) {
    MoeLds ml = moe_setup(p, l, smem + MOE_ML_OFF);
    PG8_LAS int* tab = (PG8_LAS int*)(smem + MOE_TAB_OFF);
    pg8::MoeOrder S;
    S.A = (const char*)(p.ws + WS_ACT); S.W = (const char*)(p.ws + WS_W2T) + (size_t)l * 32 * 1024 * 2048;
    S.tab = tab; S.gl = nullptr; S.wrows = 1024;
    S.nunits = pg8::moe_build_units(tab, ml.cnt, ml.off, ml.toff, 4);
    pg8::EpiBias E{(bf16_t*)(p.ws + WS_YB), p.moe_b2 + (size_t)l * 32 * 1024};
    pg8::gemm_phase<pg8::EpiBias, pg8::MoeOrder, false>((PG8_LAS unsigned char*)smem, S, E, 1024, 1024, 1024);
    __syncthreads();
}

__device__ __forceinline__ void gla_local_units(const Params& p);
__device__ __forceinline__ void rope8(const float* rope, int t, int j0, const u32x4& a, const u32x4& b, u32x4& oa, u32x4& ob);
__device__ __forceinline__ void rowstat(const bf16_t* A, int lda, int K, float* rs) {
    const int tid = tid_opaque(), r = tid >> 1, hf = tid & 1, half = K / 2;
    const bf16_t* q = A + (size_t)r * lda + hf * half;
    float s = 0.f;
    for (int i = 0; i < half; i += 8) { const u32x4 w = *(const u32x4*)(q + i);
#pragma unroll
        for (int j = 0; j < 4; ++j) { const float a = __uint_as_float(w[j] << 16), b = __uint_as_float(w[j] & 0xFFFF0000u); s += a * a + b * b; } }
    s += __shfl_xor(s, 1);
    if (hf == 0) rs[r] = rsqrtf(s / (float)K + EPSN);
    __syncthreads();
}
__device__ __forceinline__ void phase_mla_up(const Params& p) {
    const int G = gridDim.x, tid = threadIdx.x;
    const bf16_t* P = (const bf16_t*)(p.ws + WS_P);
    float* rs = (float*)(smem + 139264);
    const int nM = NTOK / 256;
    {
        pg8::PlainOrder S; S.init(P + PC_CQ, PW, (const bf16_t*)(p.ws + WS_WUQ), 256, nM, 3);
        pg8::Unit u;
        if (S.next(0, u)) rowstat(P + (size_t)u.pm * 256 * PW + PC_CQ, PW, 256, rs);
        pg8::EpiStore E{(bf16_t*)(p.ws + WS_QM), 768, rs};
        pg8::gemm_phase<pg8::EpiStore, pg8::PlainOrder, false>((PG8_LAS unsigned char*)smem, S, E, 256, PW, 256);
        __syncthreads();
    }
    for (int v = (blockIdx.x + G - 195) % G; v < nM * 8; v += G) {
        int aoff[2][2], boff[2];
        const int pm = v >> 3, pn = v & 7, h = pn >> 1;
        rowstat(P + (size_t)pm * 256 * PW + PC_CKV, PW, 128, rs);
        gm::make_off(aoff, pm * 256, PW); gm::make_off1(boff, pn * 128, 128);
        bf16_t* dst = (pn & 1) ? (bf16_t*)(p.ws + WS_VM) + (size_t)pm * 256 * 512 + h * 128 : (bf16_t*)(p.ws + WS_KM) + (size_t)pm * 256 * 768 + h * 192;
        EpiRowScale epi{dst, (pn & 1) ? 512 : 768, rs};
        gm::gemm_tile(P + PC_CKV, aoff, (const bf16_t*)(p.ws + WS_WUKV), boff, 2, epi);
    }
    const float* rope = (const float*)(p.ws + WS_ROPE);
    bf16_t* KM = (bf16_t*)(p.ws + WS_KM);
    for (int i = blockIdx.x * NTH + tid; i < NTOK * 4; i += G * NTH) {
        const int r = i >> 2, j0 = (i & 3) * 8;
        const u32x4 a = *(const u32x4*)(P + (size_t)r * PW + PC_KR + j0), b = *(const u32x4*)(P + (size_t)r * PW + PC_KR + 32 + j0);
        u32x4 oa = a, ob = b;
        if (r >= CTXN) rope8(rope, r - CTXN, j0, a, b, oa, ob);
#pragma unroll
        for (int h = 0; h < 4; ++h) { *(u32x4*)(KM + (size_t)r * 768 + h * 192 + 128 + j0) = oa; *(u32x4*)(KM + (size_t)r * 768 + h * 192 + 160 + j0) = ob; }
    }
    __syncthreads();
    gla_local_units(p);
}

struct GlaB { float b[16]; float total; };
__device__ __forceinline__ GlaB gla_decay(const Params& p, int gc, int h, float* scr  ) {
    const int tid = threadIdx.x, lane = tid & 63, wave = tid >> 6, dir = wave & 1, tq = wave >> 1;
    const bf16_t* P = (const bf16_t*)(p.ws + WS_P);
    float* af = scr;
    float* wa = scr + 2048;
    float* ba = scr + 4096;
    float* tot = scr + 4224;
#pragma unroll
    for (int i = 0; i < 4; ++i) {
        const int idx = tid + 512 * i, dd = idx >> 10, t = (idx >> 4) & 63, j = idx & 15;
        af[idx] = bf2f(P[(size_t)(gc * 64 + t) * PW + PC_AF + dd * 16 + j]);
        const int jj = (idx >> 6) & 15, d = idx & 63;
        wa[idx] = (dd == 0 ? p.gla_wa_f : p.gla_wa_b)[jj * 256 + h * 64 + d];
    }
    if (tid < 128) ba[tid] = ((tid >> 6) == 0 ? p.gla_ba_f : p.gla_ba_b)[h * 64 + (tid & 63)];
    __syncthreads();
    float w[16];
#pragma unroll
    for (int j = 0; j < 16; ++j) w[j] = wa[(dir * 16 + j) * 64 + lane];
    const float bias = ba[dir * 64 + lane];
    GlaB r;
#pragma unroll
    for (int i = 0; i < 16; ++i) {
        const int t = tq * 16 + i;
        float z = bias;
#pragma unroll
        for (int j = 0; j < 16; ++j) z += af[(dir * 64 + t) * 16 + j] * w[j];
        const float g = (fminf(z, 0.f) - __logf(1.f + __expf(-fabsf(z)))) * (1.f / 16.f);
        r.b[i] = g;
    }
    if (dir == 0) {
#pragma unroll
        for (int i = 1; i < 16; ++i) r.b[i] += r.b[i - 1];
        tot[(dir * 4 + tq) * 64 + lane] = r.b[15];
    } else {
#pragma unroll
        for (int i = 14; i >= 0; --i) r.b[i] += r.b[i + 1];
        tot[(dir * 4 + tq) * 64 + lane] = r.b[0];
    }
    __syncthreads();
    float offs = 0.f, total = 0.f;
#pragma unroll
    for (int q = 0; q < 4; ++q) { const float tv = tot[(dir * 4 + q) * 64 + lane]; total += tv; if (dir == 0 ? (q < tq) : (q > tq)) offs += tv; }
#pragma unroll
    for (int i = 0; i < 16; ++i) r.b[i] += offs;
    r.total = total;
    return r;
}

__device__ __forceinline__ void gla_stage_vt(const bf16_t* P, int gc, int h, bf16_t* VT) {
    const int tid = threadIdx.x, v = tid & 127, sq = tid >> 7;
    unsigned pk[8];
#pragma unroll
    for (int i = 0; i < 8; ++i) {
        const bf16_t a = P[(size_t)(gc * 64 + sq * 16 + 2 * i) * PW + PC_V + h * 128 + v], b = P[(size_t)(gc * 64 + sq * 16 + 2 * i + 1) * PW + PC_V + h * 128 + v];
        pk[i] = a | ((unsigned)b << 16);
    }
    *(u32x4*)(VT + v * 72 + sq * 16) = (u32x4){pk[0], pk[1], pk[2], pk[3]};
    *(u32x4*)(VT + v * 72 + sq * 16 + 8) = (u32x4){pk[4], pk[5], pk[6], pk[7]};
}

struct GlaPreL { u32x4 kc, vc[2], ac; float4 wac; float bac; };
__device__ __forceinline__ void gla_prefetch_local(const Params& p, int gc, int h, GlaPreL& g) {
    const int tid = threadIdx.x;
    const bf16_t* P = (const bf16_t*)(p.ws + WS_P);
    g.kc = *(const u32x4*)(P + (size_t)(gc * 64 + (tid >> 3)) * PW + PC_K + h * 64 + (tid & 7) * 8);
#pragma unroll
    for (int i = 0; i < 2; ++i) { const int idx = tid + 512 * i; g.vc[i] = *(const u32x4*)(P + (size_t)(gc * 64 + (idx >> 4)) * PW + PC_V + h * 128 + (idx & 15) * 8); }
    g.ac = *(const u32x4*)(P + (size_t)(gc * 64 + ((tid & 255) >> 2)) * PW + PC_AF + (tid & 3) * 8);
    { const int dd = tid >> 8, jj = (tid >> 4) & 15, d4 = tid & 15; g.wac = *(const float4*)((dd == 0 ? p.gla_wa_f : p.gla_wa_b) + jj * 256 + h * 64 + d4 * 4); }
    g.bac = ((tid >> 6) & 1 ? p.gla_ba_b : p.gla_ba_f)[h * 64 + (tid & 63)];
}
template <int OFF> __device__ __forceinline__ s16x4 glal_tr(int vb) { s16x4 r; asm volatile("ds_read_b64_tr_b16 %0, %1 offset:%2" : "=&v"(r) : "v"(vb), "i"(OFF) : "memory"); return r; }
__device__ __forceinline__ void gla_local_units(const Params& p) {
    const int tid = threadIdx.x, lane = tid & 63, wave = tid >> 6, r32 = lane & 31, hi = lane >> 5, G = gridDim.x;
    bf16_t* kdT = (bf16_t*)smem;
    bf16_t* Kraw = kdT + 2 * 64 * 72;
    char* Vraw = smem + 27648;
    float* af = (float*)(smem + 49152);
    float* wa = af + 2048; float* ba = wa + 2048; float* tot = ba + 128;
    bf16_t* U = (bf16_t*)(p.ws + WS_U); float* DEC = (float*)(p.ws + WS_DEC);
    int u = blockIdx.x;
    if (u >= NCH * 4) return;
    GlaPreL g;
    gla_prefetch_local(p, u >> 2, u & 3, g);
    const int dir = wave & 1, tq = wave >> 1;
    for (; u < NCH * 4; u += G) {
        const int gc = u >> 2, h = u & 3;
        *(u32x4*)(Kraw + (tid >> 3) * 72 + (tid & 7) * 8) = g.kc;
#pragma unroll
        for (int i = 0; i < 2; ++i) { const int idx = tid + 512 * i; *(u32x4*)(Vraw + (idx >> 4) * 320 + (idx & 15) * 16) = g.vc[i]; }
        if (tid < 256) { const int t = tid >> 2, ch = tid & 3, dd = ch >> 1, j0 = (ch & 1) * 8; float* q = af + dd * 1024 + t * 16 + j0;
#pragma unroll
            for (int e = 0; e < 4; ++e) { q[2 * e] = __uint_as_float(g.ac[e] << 16); q[2 * e + 1] = __uint_as_float(g.ac[e] & 0xFFFF0000u); } }
        { const int dd = tid >> 8, jj = (tid >> 4) & 15, d4 = tid & 15; *(float4*)(wa + (dd * 16 + jj) * 64 + d4 * 4) = g.wac; }
        if (tid < 128) ba[tid] = g.bac;
        __syncthreads();
        const int un = u + G;
        if (un < NCH * 4) gla_prefetch_local(p, un >> 2, un & 3, g);
        float bb[16]; float total = 0.f;
        {
            float w[16];
#pragma unroll
            for (int j = 0; j < 16; ++j) w[j] = wa[(dir * 16 + j) * 64 + lane];
            const float bias = ba[dir * 64 + lane];
#pragma unroll
            for (int i = 0; i < 16; ++i) {
                const int t = tq * 16 + i;
                float z = bias;
#pragma unroll
                for (int j = 0; j < 16; ++j) z += af[(dir * 64 + t) * 16 + j] * w[j];
                bb[i] = (fminf(z, 0.f) - __logf(1.f + __expf(-fabsf(z)))) * (1.f / 16.f);
            }
            if (dir == 0) {
#pragma unroll
                for (int i = 1; i < 16; ++i) bb[i] += bb[i - 1];
                tot[(dir * 4 + tq) * 64 + lane] = bb[15];
            } else {
#pragma unroll
                for (int i = 14; i >= 0; --i) bb[i] += bb[i + 1];
                tot[(dir * 4 + tq) * 64 + lane] = bb[0];
            }
        }
        __syncthreads();
        {
            float offs = 0.f;
#pragma unroll
            for (int q = 0; q < 4; ++q) { const float tv = tot[(dir * 4 + q) * 64 + lane]; total += tv; if (dir == 0 ? (q < tq) : (q > tq)) offs += tv; }
#pragma unroll
            for (int i = 0; i < 16; ++i) bb[i] += offs;
        }
        {
            unsigned pk[8];
#pragma unroll
            for (int i = 0; i < 8; ++i) {
                const int s0 = tq * 16 + 2 * i;
                const float k0 = bf2f(Kraw[s0 * 72 + lane]), k1 = bf2f(Kraw[(s0 + 1) * 72 + lane]);
                pk[i] = cvtpk(k0 * __expf(total - bb[2 * i]), k1 * __expf(total - bb[2 * i + 1]));
            }
            *(u32x4*)(kdT + (dir * 64 + lane) * 72 + tq * 16) = (u32x4){pk[0], pk[1], pk[2], pk[3]};
            *(u32x4*)(kdT + (dir * 64 + lane) * 72 + tq * 16 + 8) = (u32x4){pk[4], pk[5], pk[6], pk[7]};
            if (tq == 0) DEC[((size_t)(dir * NCH + gc) * 4 + h) * 64 + lane] = __expf(total);
        }
        __syncthreads();
        {
            const int mdir = wave >> 2, vbk = wave & 3;
            const int vb = (int)(uintptr_t)Vraw + (8 * hi + ((lane & 15) >> 2)) * 320 + (vbk * 32 + 16 * ((lane >> 4) & 1) + 4 * (lane & 3)) * 2;
            f32x16 a0 = {}, a1 = {};
#define GLAL_STEP(KS) do { const s16x4 l_ = glal_tr<(KS) * 5120>(vb), h_ = glal_tr<(KS) * 5120 + 1280>(vb); \
            const bf16x8 b0 = *(const bf16x8*)(kdT + (mdir * 64 + r32) * 72 + (KS) * 16 + hi * 8); \
            const bf16x8 b1 = *(const bf16x8*)(kdT + (mdir * 64 + 32 + r32) * 72 + (KS) * 16 + hi * 8); \
            asm volatile("s_waitcnt lgkmcnt(0)" ::: "memory"); SBAR(); \
            const bf16x8 a_ = (bf16x8){l_[0], l_[1], l_[2], l_[3], h_[0], h_[1], h_[2], h_[3]}; \
            a0 = __builtin_amdgcn_mfma_f32_32x32x16_bf16(a_, b0, a0, 0, 0, 0); a1 = __builtin_amdgcn_mfma_f32_32x32x16_bf16(a_, b1, a1, 0, 0, 0); } while (0)
            GLAL_STEP(0); GLAL_STEP(1); GLAL_STEP(2); GLAL_STEP(3);
#undef GLAL_STEP
            bf16_t* Uo = U + ((size_t)(mdir * NCH + gc) * 4 + h) * 8192;
#pragma unroll
            for (int r = 0; r < 16; ++r) { const int v = vbk * 32 + crow(r, hi); Uo[v * 64 + r32] = f2bf(a0[r]); Uo[v * 64 + 32 + r32] = f2bf(a1[r]); }
        }
        __syncthreads();
    }
}
__device__ __forceinline__ void rope8(const float* rope, int t, int j0, const u32x4& a, const u32x4& b, u32x4& oa, u32x4& ob) {
    const int row = t >> 6, col = t & 63;
    const float* cs = (j0 < 16) ? rope + row * 16 + j0 : rope + 512 * 16 + col * 16 + (j0 - 16);
    const float* sn = (j0 < 16) ? rope + 256 * 16 + row * 16 + j0 : rope + 512 * 16 + 64 * 16 + col * 16 + (j0 - 16);
    const f32x4 c0 = *(const f32x4*)cs, c1 = *(const f32x4*)(cs + 4), s0 = *(const f32x4*)sn, s1 = *(const f32x4*)(sn + 4);
#pragma unroll
    for (int e = 0; e < 4; ++e) {
        const float x1l = __uint_as_float(a[e] << 16), x1h = __uint_as_float(a[e] & 0xFFFF0000u), x2l = __uint_as_float(b[e] << 16), x2h = __uint_as_float(b[e] & 0xFFFF0000u);
        const float cl = (e < 2) ? c0[2 * e] : c1[2 * e - 4], ch = (e < 2) ? c0[2 * e + 1] : c1[2 * e - 3], sl = (e < 2) ? s0[2 * e] : s1[2 * e - 4], sh = (e < 2) ? s0[2 * e + 1] : s1[2 * e - 3];
        oa[e] = cvtpk(x1l * cl - x2l * sl, x1h * ch - x2h * sh);
        ob[e] = cvtpk(x1l * sl + x2l * cl, x1h * sh + x2h * ch);
    }
}
__device__ __forceinline__ void qrope_pass(const Params& p, int b0, int nb) {
    const int tid = threadIdx.x;
    const float* rope = (const float*)(p.ws + WS_ROPE);
    bf16_t* QM = (bf16_t*)(p.ws + WS_QM);
    for (int i = (blockIdx.x - b0) * NTH + tid; i < SEQ * 16; i += nb * NTH) {
        const int t = i >> 4, hh = (i >> 2) & 3, j0 = (i & 3) * 8;
        bf16_t* q = QM + (size_t)(CTXN + t) * 768 + hh * 192 + 128 + j0;
        const u32x4 a = *(const u32x4*)q, b = *(const u32x4*)(q + 32);
        u32x4 oa, ob; rope8(rope, t, j0, a, b, oa, ob);
        *(u32x4*)q = oa; *(u32x4*)(q + 32) = ob;
    }
}

__device__ __forceinline__ int gla_order(int dir, int step) { return dir == 0 ? step : (step < 4 ? 3 - step : NCH - 1 - (step - 4)); }
__device__ __forceinline__ void phase_gla_scan(const Params& p) {
    const int gid = blockIdx.x * NTH + threadIdx.x;
    if (gid >= 2 * 4 * 8192) { qrope_pass(p, 128, (int)gridDim.x - 128); return; }
    const int dir = gid >> 15, h = (gid >> 13) & 3, e = gid & 8191, d = e & 63;
    const bf16_t* U = (const bf16_t*)(p.ws + WS_U); bf16_t* S = (bf16_t*)(p.ws + WS_SIN); const float* DEC = (const float*)(p.ws + WS_DEC);
    float s = 0.f;
#pragma unroll 1
    for (int s0 = 0; s0 < NCH; s0 += 52) {
        float uu[52], dc[52];
#pragma unroll
        for (int i = 0; i < 52; ++i) { const size_t o = ((size_t)(dir * NCH + gla_order(dir, s0 + i)) * 4 + h); uu[i] = bf2f(U[o * 8192 + e]); dc[i] = DEC[o * 64 + d]; }
#pragma unroll
        for (int i = 0; i < 52; ++i) { const size_t o = ((size_t)(dir * NCH + gla_order(dir, s0 + i)) * 4 + h); S[o * 8192 + e] = f2bf(s); s = dc[i] * s + uu[i]; }
    }
}

__device__ __forceinline__ void gla_out_unit(const Params& p, int gc, int h) {
    const int tid = threadIdx.x, lane = tid & 63, wave = tid >> 6, r32 = lane & 31, hi = lane >> 5;
    const bf16_t* P = (const bf16_t*)(p.ws + WS_P);
    bf16_t* qe = (bf16_t*)smem;
    bf16_t* ke = qe + 2 * 64 * 72;
    bf16_t* Am = ke + 2 * 64 * 72;
    bf16_t* VT = Am + 2 * 64 * 72;
    bf16_t* ST = VT + 128 * 72;
    float* scr = (float*)(smem + 110592);
    float* ob = (float*)(ke);
    const GlaB gb = gla_decay(p, gc, h, scr);
    {
        const int dir = wave & 1, tq = wave >> 1;
#pragma unroll
        for (int i = 0; i < 16; ++i) {
            const int t = tq * 16 + i;
            const float qv = bf2f(P[(size_t)(gc * 64 + t) * PW + PC_Q + h * 64 + lane]) * 0.125f, kv = bf2f(P[(size_t)(gc * 64 + t) * PW + PC_K + h * 64 + lane]);
            qe[(dir * 64 + t) * 72 + lane] = f2bf(qv * __expf(gb.b[i]));
            ke[(dir * 64 + t) * 72 + lane] = f2bf(kv * __expf(-gb.b[i]));
        }
    }
    gla_stage_vt(P, gc, h, VT);
    {
        const bf16_t* S = (const bf16_t*)(p.ws + WS_SIN);
#pragma unroll
        for (int i = 0; i < 4; ++i) {
            const int cc = tid + 512 * i, dir = cc >> 10, v = (cc >> 3) & 127, ch = cc & 7;
            *(u32x4*)(ST + (dir * 128 + v) * 72 + ch * 8) = *(const u32x4*)(S + ((size_t)(dir * NCH + gc) * 4 + h) * 8192 + v * 64 + ch * 8);
        }
    }
    __syncthreads();
    {
        const int dir = wave >> 2, tb = (wave >> 1) & 1, sb = wave & 1;
        f32x16 acc = {};
#pragma unroll
        for (int ks = 0; ks < 4; ++ks) {
            const bf16x8 a = *(const bf16x8*)(qe + (dir * 64 + tb * 32 + r32) * 72 + ks * 16 + hi * 8);
            const bf16x8 b = *(const bf16x8*)(ke + (dir * 64 + sb * 32 + r32) * 72 + ks * 16 + hi * 8);
            acc = __builtin_amdgcn_mfma_f32_32x32x16_bf16(a, b, acc, 0, 0, 0);
        }
        const int s = sb * 32 + r32;
#pragma unroll
        for (int r = 0; r < 16; ++r) { const int t = tb * 32 + crow(r, hi); const bool keep = (dir == 0) ? (s <= t) : (s >= t); Am[(dir * 64 + t) * 72 + s] = f2bf(keep ? acc[r] : 0.f); }
    }
    __syncthreads();
    f32x16 o = {};
    const int tb = wave >> 2, vb = wave & 3;
#pragma unroll
    for (int dir = 0; dir < 2; ++dir)
#pragma unroll
        for (int ks = 0; ks < 4; ++ks) {
            const bf16x8 a1 = *(const bf16x8*)(Am + (dir * 64 + tb * 32 + r32) * 72 + ks * 16 + hi * 8);
            const bf16x8 b1 = *(const bf16x8*)(VT + (vb * 32 + r32) * 72 + ks * 16 + hi * 8);
            o = __builtin_amdgcn_mfma_f32_32x32x16_bf16(a1, b1, o, 0, 0, 0);
            const bf16x8 a2 = *(const bf16x8*)(qe + (dir * 64 + tb * 32 + r32) * 72 + ks * 16 + hi * 8);
            const bf16x8 b2 = *(const bf16x8*)(ST + (dir * 128 + vb * 32 + r32) * 72 + ks * 16 + hi * 8);
            o = __builtin_amdgcn_mfma_f32_32x32x16_bf16(a2, b2, o, 0, 0, 0);
        }
    __syncthreads();
#pragma unroll
    for (int r = 0; r < 16; ++r) ob[(tb * 32 + crow(r, hi)) * 132 + vb * 32 + r32] = o[r];
    __syncthreads();
    {
        const int t = tid >> 3, v0 = (tid & 7) * 16;
        float vals[16]; float ss = 0.f;
#pragma unroll
        for (int i = 0; i < 16; ++i) { vals[i] = ob[t * 132 + v0 + i]; ss += vals[i] * vals[i]; }
        ss += __shfl_xor(ss, 1); ss += __shfl_xor(ss, 2); ss += __shfl_xor(ss, 4);
        const float rstd = rsqrtf(ss * (1.f / 128.f) + EPSN);
        const size_t row = (size_t)gc * 64 + t;
        unsigned pk[8];
#pragma unroll
        for (int i = 0; i < 8; ++i) {
            const float r0 = bf2f(P[row * PW + PC_R + h * 128 + v0 + 2 * i]), r1 = bf2f(P[row * PW + PC_R + h * 128 + v0 + 2 * i + 1]);
            pk[i] = cvtpk(vals[2 * i] * rstd * p.gla_onorm[v0 + 2 * i] * silu_f(r0), vals[2 * i + 1] * rstd * p.gla_onorm[v0 + 2 * i + 1] * silu_f(r1));
        }
        bf16_t* M = (bf16_t*)(p.ws + WS_MIX) + row * 1024 + h * 128 + v0;
        *(u32x4*)M = (u32x4){pk[0], pk[1], pk[2], pk[3]}; *(u32x4*)(M + 8) = (u32x4){pk[4], pk[5], pk[6], pk[7]};
    }
    __syncthreads();
}


struct GlaPre { u32x4 qc, kc, vc[2], ac, sc[4]; float4 wac; float bac; };
__device__ __forceinline__ void gla_prefetch(const Params& p, int gc, int h, GlaPre& g, u32x4 (&rc)[2]) {
    const int tid = threadIdx.x;
    const bf16_t* P = (const bf16_t*)(p.ws + WS_P);
    const bf16_t* rowp = P + (size_t)(gc * 64 + (tid >> 3)) * PW;
    g.qc = *(const u32x4*)(rowp + PC_Q + h * 64 + (tid & 7) * 8);
    g.kc = *(const u32x4*)(rowp + PC_K + h * 64 + (tid & 7) * 8);
#pragma unroll
    for (int i = 0; i < 2; ++i) { const int idx = tid + 512 * i; g.vc[i] = *(const u32x4*)(P + (size_t)(gc * 64 + (idx >> 4)) * PW + PC_V + h * 128 + (idx & 15) * 8); }
#pragma unroll
    for (int i = 0; i < 2; ++i) rc[i] = *(const u32x4*)(rowp + PC_R + h * 128 + (tid & 7) * 16 + 8 * i);
    g.ac = *(const u32x4*)(P + (size_t)(gc * 64 + ((tid & 255) >> 2)) * PW + PC_AF + (tid & 3) * 8);
    const bf16_t* S = (const bf16_t*)(p.ws + WS_SIN);
#pragma unroll
    for (int i = 0; i < 4; ++i) { const int cc = tid + 512 * i, dir = cc >> 10; g.sc[i] = *(const u32x4*)(S + ((size_t)(dir * NCH + gc) * 4 + h) * 8192 + (cc & 1023) * 8); }
    { const int dd = tid >> 8, jj = (tid >> 4) & 15, d4 = tid & 15; g.wac = *(const float4*)((dd == 0 ? p.gla_wa_f : p.gla_wa_b) + jj * 256 + h * 64 + d4 * 4); }
    g.bac = ((tid >> 6) & 1 ? p.gla_ba_b : p.gla_ba_f)[h * 64 + (tid & 63)];
}
template <int OFF> __device__ __forceinline__ s16x4 gla_tr(int vb) { s16x4 r; asm volatile("ds_read_b64_tr_b16 %0, %1 offset:%2" : "=&v"(r) : "v"(vb), "i"(OFF) : "memory"); return r; }
__device__ __forceinline__ void phase_gla_out(const Params& p) {
    const int tid = threadIdx.x, lane = tid & 63, wave = tid >> 6, r32 = lane & 31, hi = lane >> 5, G = gridDim.x;
    bf16_t* qe = (bf16_t*)smem;
    bf16_t* ke = qe + 2 * 64 * 72;
    bf16_t* Am = ke + 2 * 64 * 72;
    bf16_t* Qraw = Am; bf16_t* Kraw = Am + 64 * 72;
    char* Vraw = smem + 55296;
    bf16_t* ST = (bf16_t*)(smem + 75776);
    float* af = (float*)(smem + 112640);
    float* wa = af + 2048;
    float* ba = wa + 2048;
    float* tot = ba + 128;
    float* ob = (float*)ke;
    int u = blockIdx.x;
    if (u >= NCH * 4) return;
    const int nt_t = tid >> 3, nt_v0 = (tid & 7) * 16;
    float on[16];
#pragma unroll
    for (int i = 0; i < 16; ++i) on[i] = p.gla_onorm[nt_v0 + i];
    GlaPre g; u32x4 rc[2], rcn[2];
    gla_prefetch(p, u >> 2, u & 3, g, rc);
    const int dir = wave & 1, tq = wave >> 1;
    for (; u < NCH * 4; u += G) {
        const int gc = u >> 2, h = u & 3;
        *(u32x4*)(Qraw + (tid >> 3) * 72 + (tid & 7) * 8) = g.qc;
        *(u32x4*)(Kraw + (tid >> 3) * 72 + (tid & 7) * 8) = g.kc;
#pragma unroll
        for (int i = 0; i < 2; ++i) { const int idx = tid + 512 * i; *(u32x4*)(Vraw + (idx >> 4) * 320 + (idx & 15) * 16) = g.vc[i]; }
#pragma unroll
        for (int i = 0; i < 4; ++i) { const int cc = tid + 512 * i; *(u32x4*)(ST + ((cc >> 10) * 128 + ((cc >> 3) & 127)) * 72 + (cc & 7) * 8) = g.sc[i]; }
        if (tid < 256) { const int t = tid >> 2, ch = tid & 3, dd = ch >> 1, j0 = (ch & 1) * 8; float* q = af + dd * 1024 + t * 16 + j0;
#pragma unroll
            for (int e = 0; e < 4; ++e) { q[2 * e] = __uint_as_float(g.ac[e] << 16); q[2 * e + 1] = __uint_as_float(g.ac[e] & 0xFFFF0000u); } }
        { const int dd = tid >> 8, jj = (tid >> 4) & 15, d4 = tid & 15; *(float4*)(wa + (dd * 16 + jj) * 64 + d4 * 4) = g.wac; }
        if (tid < 128) ba[tid] = g.bac;
        __syncthreads();
        const int un = u + G;
        if (un < NCH * 4) gla_prefetch(p, un >> 2, un & 3, g, rcn);
        float bb[16]; float total;
        {
            float w[16];
#pragma unroll
            for (int j = 0; j < 16; ++j) w[j] = wa[(dir * 16 + j) * 64 + lane];
            const float bias = ba[dir * 64 + lane];
#pragma unroll
            for (int i = 0; i < 16; ++i) {
                const int t = tq * 16 + i;
                float z = bias;
#pragma unroll
                for (int j = 0; j < 16; ++j) z += af[(dir * 64 + t) * 16 + j] * w[j];
                bb[i] = (fminf(z, 0.f) - __logf(1.f + __expf(-fabsf(z)))) * (1.f / 16.f);
            }
            if (dir == 0) {
#pragma unroll
                for (int i = 1; i < 16; ++i) bb[i] += bb[i - 1];
                tot[(dir * 4 + tq) * 64 + lane] = bb[15];
            } else {
#pragma unroll
                for (int i = 14; i >= 0; --i) bb[i] += bb[i + 1];
                tot[(dir * 4 + tq) * 64 + lane] = bb[0];
            }
        }
        __syncthreads();
        {
            float offs = 0.f; total = 0.f;
#pragma unroll
            for (int q = 0; q < 4; ++q) { const float tv = tot[(dir * 4 + q) * 64 + lane]; total += tv; if (dir == 0 ? (q < tq) : (q > tq)) offs += tv; }
#pragma unroll
            for (int i = 0; i < 16; ++i) bb[i] += offs;
        }
#pragma unroll
        for (int i = 0; i < 16; ++i) {
            const int t = tq * 16 + i;
            const float qv = bf2f(Qraw[t * 72 + lane]) * 0.125f, kv = bf2f(Kraw[t * 72 + lane]);
            qe[(dir * 64 + t) * 72 + lane] = f2bf(qv * __expf(bb[i]));
            ke[(dir * 64 + t) * 72 + lane] = f2bf(kv * __expf(-bb[i]));
        }
        __syncthreads();
        {
            const int mdir = wave >> 2, tb = (wave >> 1) & 1, sb = wave & 1;
            f32x16 acc = {};
#pragma unroll
            for (int ks = 0; ks < 4; ++ks) {
                const bf16x8 a = *(const bf16x8*)(qe + (mdir * 64 + tb * 32 + r32) * 72 + ks * 16 + hi * 8);
                const bf16x8 b = *(const bf16x8*)(ke + (mdir * 64 + sb * 32 + r32) * 72 + ks * 16 + hi * 8);
                acc = __builtin_amdgcn_mfma_f32_32x32x16_bf16(a, b, acc, 0, 0, 0);
            }
            const int sI = sb * 32 + r32;
#pragma unroll
            for (int r = 0; r < 16; ++r) { const int t = tb * 32 + crow(r, hi); const bool keep = (mdir == 0) ? (sI <= t) : (sI >= t); Am[(mdir * 64 + t) * 72 + sI] = f2bf(keep ? acc[r] : 0.f); }
        }
        __syncthreads();
        f32x16 o = {};
        const int tb = wave >> 2, vbk = wave & 3;
        {
            const int vb = (int)(uintptr_t)Vraw + (8 * hi + ((lane & 15) >> 2)) * 320 + (vbk * 32 + 16 * ((lane >> 4) & 1) + 4 * (lane & 3)) * 2;
#define GLA_PV(KS, DIRN) do { const s16x4 l_ = gla_tr<(KS) * 5120>(vb), h_ = gla_tr<(KS) * 5120 + 1280>(vb); \
            const bf16x8 a1 = *(const bf16x8*)(Am + ((DIRN) * 64 + tb * 32 + r32) * 72 + (KS) * 16 + hi * 8); \
            const bf16x8 a2 = *(const bf16x8*)(qe + ((DIRN) * 64 + tb * 32 + r32) * 72 + (KS) * 16 + hi * 8); \
            const bf16x8 b2 = *(const bf16x8*)(ST + ((DIRN) * 128 + vbk * 32 + r32) * 72 + (KS) * 16 + hi * 8); \
            asm volatile("s_waitcnt lgkmcnt(0)" ::: "memory"); SBAR(); \
            o = __builtin_amdgcn_mfma_f32_32x32x16_bf16(a1, (bf16x8){l_[0], l_[1], l_[2], l_[3], h_[0], h_[1], h_[2], h_[3]}, o, 0, 0, 0); \
            o = __builtin_amdgcn_mfma_f32_32x32x16_bf16(a2, b2, o, 0, 0, 0); } while (0)
            GLA_PV(0, 0); GLA_PV(1, 0); GLA_PV(2, 0); GLA_PV(3, 0); GLA_PV(0, 1); GLA_PV(1, 1); GLA_PV(2, 1); GLA_PV(3, 1);
#undef GLA_PV
        }
        __syncthreads();
#pragma unroll
        for (int r = 0; r < 16; ++r) ob[(tb * 32 + crow(r, hi)) * 132 + vbk * 32 + r32] = o[r];
        __syncthreads();
        {
            float vals[16]; float ss = 0.f;
#pragma unroll
            for (int i = 0; i < 4; ++i) { const f32x4 x = *(const f32x4*)(ob + nt_t * 132 + nt_v0 + 4 * i); vals[4 * i] = x[0]; vals[4 * i + 1] = x[1]; vals[4 * i + 2] = x[2]; vals[4 * i + 3] = x[3]; }
#pragma unroll
            for (int i = 0; i < 16; ++i) ss += vals[i] * vals[i];
            ss += __shfl_xor(ss, 1); ss += __shfl_xor(ss, 2); ss += __shfl_xor(ss, 4);
            const float rstd = rsqrtf(ss * (1.f / 128.f) + EPSN);
            unsigned pk[8];
#pragma unroll
            for (int i = 0; i < 8; ++i) {
                const unsigned w = rc[i >> 2][i & 3];
                const float r0 = __uint_as_float(w << 16), r1 = __uint_as_float(w & 0xFFFF0000u);
                const float s0 = r0 * __builtin_amdgcn_rcpf(1.f + __expf(-r0)), s1 = r1 * __builtin_amdgcn_rcpf(1.f + __expf(-r1));
                pk[i] = cvtpk(vals[2 * i] * rstd * on[2 * i] * s0, vals[2 * i + 1] * rstd * on[2 * i + 1] * s1);
            }
            bf16_t* M = (bf16_t*)(p.ws + WS_MIX) + ((size_t)gc * 64 + nt_t) * 1024 + h * 128 + nt_v0;
            *(u32x4*)M = (u32x4){pk[0], pk[1], pk[2], pk[3]}; *(u32x4*)(M + 8) = (u32x4){pk[4], pk[5], pk[6], pk[7]};
        }
        rc[0] = rcn[0]; rc[1] = rcn[1];
        __syncthreads();
    }
}

namespace mla {
constexpr int KVBLK = 64, QBLK = 32;
#ifndef MLA_QREG
#define MLA_QREG 12
#endif
constexpr int QREG = MLA_QREG;
constexpr float SCALE = 0.07216878364870322f;
constexpr float THR = 8.f;
constexpr int LDQ = 768, LDK = 768, LDV = 512, LDO = 1024;
constexpr int SHM_V = KVBLK * 128 * 2, SHM_K = KVBLK * 400;
#define MKSWZ(row, colB) ((row) * 400 + (colB))
__device__ __forceinline__ void partialSM(f32x16& p0, f32x16& p1, float& m_reg, float& mn, float& alpha) {
    constexpr float C = SCALE * LOG2E;
    float pmax = p0[0];
#pragma unroll
    for (int r = 1; r < 16; ++r) pmax = fmaxf(pmax, p0[r]);
#pragma unroll
    for (int r = 0; r < 16; ++r) pmax = fmaxf(pmax, p1[r]);
    { auto rr = __builtin_amdgcn_permlane32_swap(__float_as_uint(pmax), __float_as_uint(pmax), false, false);
      pmax = fmaxf(__uint_as_float(rr[0]), __uint_as_float(rr[1])); }
    if (__builtin_expect(__all(pmax - m_reg <= THR / SCALE), 1)) { mn = m_reg; alpha = 1.f; }
    else { mn = fmaxf(m_reg, pmax); alpha = __builtin_amdgcn_exp2f((m_reg - mn) * C); m_reg = mn; }
    const float mnC = -mn * C;
#pragma unroll
    for (int r = 0; r < 16; ++r) p0[r] = fmaf(p0[r], C, mnC);
#pragma unroll
    for (int r = 0; r < 16; ++r) p1[r] = fmaf(p1[r], C, mnC);
#pragma unroll
    for (int r = 0; r < 16; ++r) p0[r] = __builtin_amdgcn_exp2f(p0[r]);
}
__device__ __forceinline__ void finishSM(f32x16& p0, f32x16& p1, float alpha, float& l_reg, bf16x8& pa0, bf16x8& pa1, bf16x8& pa2, bf16x8& pa3) {
#pragma unroll
    for (int r = 0; r < 16; ++r) p1[r] = __builtin_amdgcn_exp2f(p1[r]);
    float ps = 0;
#pragma unroll
    for (int r = 0; r < 16; ++r) ps += p0[r];
#pragma unroll
    for (int r = 0; r < 16; ++r) ps += p1[r];
    { auto rr = __builtin_amdgcn_permlane32_swap(__float_as_uint(ps), __float_as_uint(ps), false, false);
      ps = __uint_as_float(rr[0]) + __uint_as_float(rr[1]); }
    l_reg = l_reg * alpha + ps;
#define PK4(P, BASE, OUT) do { unsigned a0 = cvtpk(P[BASE + 0], P[BASE + 1]), a1 = cvtpk(P[BASE + 2], P[BASE + 3]);   \
    unsigned b0 = cvtpk(P[BASE + 4], P[BASE + 5]), b1 = cvtpk(P[BASE + 6], P[BASE + 7]);                              \
    auto r0 = __builtin_amdgcn_permlane32_swap(a0, b0, false, false); auto r1 = __builtin_amdgcn_permlane32_swap(a1, b1, false, false); \
    u32x4 w = {r0[0], r1[0], r0[1], r1[1]}; OUT = *reinterpret_cast<bf16x8*>(&w); } while (0)
    PK4(p0, 0, pa0); PK4(p0, 8, pa1); PK4(p1, 0, pa2); PK4(p1, 8, pa3);
}
__device__ __forceinline__ void qkt(f32x16& p0, f32x16& p1, const char* Ks, const bf16x8* qr, const char* qlds, int r32, int hi) {
    p0 = f32x16{}; p1 = f32x16{};
#pragma unroll
    for (int d0 = 0; d0 < 12; ++d0) { const int cb = (d0 * 16 + hi * 8) * 2;
        const bf16x8 b0 = *reinterpret_cast<const bf16x8*>(Ks + MKSWZ(r32, cb));
        const bf16x8 b1 = *reinterpret_cast<const bf16x8*>(Ks + MKSWZ(32 + r32, cb));
        const bf16x8 qv = (d0 < QREG) ? qr[d0 < QREG ? d0 : 0] : *reinterpret_cast<const bf16x8*>(qlds + (d0 - QREG) * 1024);
        p0 = __builtin_amdgcn_mfma_f32_32x32x16_bf16(b0, qv, p0, 0, 0, 0);
        p1 = __builtin_amdgcn_mfma_f32_32x32x16_bf16(b1, qv, p1, 0, 0, 0); }
}
__device__ __forceinline__ int v_st(int k, int c) { const int kk = (k & ~0xC) | ((k & 4) << 1) | ((k & 8) >> 1); return ((kk >> 3) * 4 + (c >> 5)) * 512 + ((kk & 7) * 32 + (c & 31)) * 2; }
__device__ __forceinline__ int v_rd_base(int lane) { return ((lane & 3) << 3) | (((lane >> 2) & 3) << 6) | (((lane >> 4) & 1) << 5) | (((lane >> 5) & 1) << 8); }
constexpr int v_rd_off(int d0, int ks, int half) { return d0 * 512 + ks * 4096 + half * 2048; }
template <int OFF> __device__ __forceinline__ s16x4 tr_read(int vb) {
    s16x4 r; asm volatile("ds_read_b64_tr_b16 %0, %1 offset:%2" : "=&v"(r) : "v"(vb), "i"(OFF) : "memory"); return r;
}
template <int D0> __device__ __forceinline__ void pv_one(f32x16& od, int vb, bf16x8 pa0, bf16x8 pa1, bf16x8 pa2, bf16x8 pa3) {
#define PKV(L, H) (bf16x8){L[0], L[1], L[2], L[3], H[0], H[1], H[2], H[3]}
    {
    const s16x4 l0 = tr_read<v_rd_off(D0, 0, 0)>(vb), h0 = tr_read<v_rd_off(D0, 0, 1)>(vb), l1 = tr_read<v_rd_off(D0, 1, 0)>(vb), h1 = tr_read<v_rd_off(D0, 1, 1)>(vb);
    asm volatile("s_waitcnt lgkmcnt(0)" ::: "memory"); SBAR();
    od = __builtin_amdgcn_mfma_f32_32x32x16_bf16(pa0, PKV(l0, h0), od, 0, 0, 0);
    od = __builtin_amdgcn_mfma_f32_32x32x16_bf16(pa1, PKV(l1, h1), od, 0, 0, 0);
    }
    {
    const s16x4 l2 = tr_read<v_rd_off(D0, 2, 0)>(vb), h2 = tr_read<v_rd_off(D0, 2, 1)>(vb), l3 = tr_read<v_rd_off(D0, 3, 0)>(vb), h3 = tr_read<v_rd_off(D0, 3, 1)>(vb);
    asm volatile("s_waitcnt lgkmcnt(0)" ::: "memory"); SBAR();
    od = __builtin_amdgcn_mfma_f32_32x32x16_bf16(pa2, PKV(l2, h2), od, 0, 0, 0);
    od = __builtin_amdgcn_mfma_f32_32x32x16_bf16(pa3, PKV(l3, h3), od, 0, 0, 0);
    }
#undef PKV
}
__device__ __forceinline__ void pv_d0(f32x16* o, int vb, bf16x8 pa0, bf16x8 pa1, bf16x8 pa2, bf16x8 pa3) {
    pv_one<0>(o[0], vb, pa0, pa1, pa2, pa3); pv_one<1>(o[1], vb, pa0, pa1, pa2, pa3); pv_one<2>(o[2], vb, pa0, pa1, pa2, pa3); pv_one<3>(o[3], vb, pa0, pa1, pa2, pa3);
}
__device__ __forceinline__ void attn_body(const bf16_t* __restrict__ Qb, const bf16_t* __restrict__ Kh, const bf16_t* __restrict__ Vh, bf16_t* __restrict__ Ob, int seq) {
    char* lds = smem;
    const int tid = threadIdx.x, wid = tid >> 6, lane = tid & 63, r32 = lane & 31, hi = lane >> 5;
    char* V_lds = lds; char* K_lds = lds + 2 * SHM_V;
    float* ws = (float*)(lds + 2 * SHM_V + 2 * SHM_K) + wid * 64; float* li_l = ws; float* al_l = ws + 32;
    float m_reg = -1e30f, l_reg = 0; f32x16 o[4] = {}; bf16x8 qr[QREG];
    const bf16_t* Qw = Qb + (long)(wid * QBLK + r32) * LDQ + hi * 8;
#pragma unroll
    for (int d0 = 0; d0 < QREG; ++d0) qr[d0] = *reinterpret_cast<const bf16x8*>(Qw + d0 * 16);
    char* qlds = lds + 2 * SHM_V + 2 * SHM_K + 2048 + wid * ((12 - QREG) * 1024) + lane * 16;
#pragma unroll
    for (int d0 = 0; d0 < 12 - QREG; ++d0) *reinterpret_cast<bf16x8*>(qlds + d0 * 1024) = *reinterpret_cast<const bf16x8*>(Qw + (QREG + d0) * 16);
    const int sr = tid >> 4, sc = (tid & 15) * 8, vst0 = v_st(sr, sc), vst1 = v_st(32 + sr, sc);
    int kgo[3], kso[3];
#pragma unroll
    for (int i = 0; i < 3; ++i) { const int id = tid + 512 * i, kr_ = id / 24, kc_ = (id % 24) * 8; kgo[i] = kr_ * LDK + kc_; kso[i] = MKSWZ(kr_, kc_ * 2); }
    const int vb0 = (int)(uintptr_t)V_lds + v_rd_base(lane);
    struct { bf16x8 vs0, vs1, ks0, ks1, ks2; } st_;
#define SLOAD(k0) do { st_.vs0 = *(const bf16x8*)(&Vh[(long)((k0) + sr) * LDV + sc]); st_.vs1 = *(const bf16x8*)(&Vh[(long)((k0) + 32 + sr) * LDV + sc]); \
    st_.ks0 = *(const bf16x8*)(&Kh[(long)(k0) * LDK + kgo[0]]); st_.ks1 = *(const bf16x8*)(&Kh[(long)(k0) * LDK + kgo[1]]); \
    st_.ks2 = *(const bf16x8*)(&Kh[(long)(k0) * LDK + kgo[2]]); } while (0)
#define SWRITE(b) do { *(bf16x8*)(V_lds + (b) * SHM_V + vst0) = st_.vs0; *(bf16x8*)(V_lds + (b) * SHM_V + vst1) = st_.vs1; \
    *(bf16x8*)(K_lds + (b) * SHM_K + kso[0]) = st_.ks0; *(bf16x8*)(K_lds + (b) * SHM_K + kso[1]) = st_.ks1; \
    *(bf16x8*)(K_lds + (b) * SHM_K + kso[2]) = st_.ks2; } while (0)
#define RESC(a) do { if (__any((a) < 1.f)) { if (hi == 0) al_l[r32] = (a); asm volatile("s_waitcnt lgkmcnt(0)" ::: "memory"); \
    _Pragma("unroll") for (int d = 0; d < 4; ++d) _Pragma("unroll") for (int r = 0; r < 16; ++r) o[d][r] *= al_l[crow(r, hi)]; } } while (0)
    f32x16 pA0, pA1, pB0, pB1; float mnA, mnB, alA, alB; bf16x8 pa0, pa1, pa2, pa3; const int NT = seq / KVBLK;
    SLOAD(0); SWRITE(0); __syncthreads();
    qkt(pA0, pA1, K_lds, qr, qlds, r32, hi); partialSM(pA0, pA1, m_reg, mnA, alA);
    SLOAD(KVBLK); SWRITE(1); __syncthreads();
    for (int j = 1; j + 1 < NT; j += 2) {
        SBAR(); qkt(pB0, pB1, K_lds + SHM_K, qr, qlds, r32, hi);
        finishSM(pA0, pA1, alA, l_reg, pa0, pa1, pa2, pa3); SBAR();
        SLOAD((j + 1) * KVBLK); SBAR();
        pv_d0(o, vb0, pa0, pa1, pa2, pa3); partialSM(pB0, pB1, m_reg, mnB, alB);
        __syncthreads(); SWRITE(0);
        RESC(alB); __syncthreads();
        SBAR(); qkt(pA0, pA1, K_lds, qr, qlds, r32, hi);
        finishSM(pB0, pB1, alB, l_reg, pa0, pa1, pa2, pa3); SBAR();
        SLOAD((j + 2) * KVBLK); SBAR();
        pv_d0(o, vb0 + SHM_V, pa0, pa1, pa2, pa3); partialSM(pA0, pA1, m_reg, mnA, alA);
        __syncthreads(); SWRITE(1);
        RESC(alA); __syncthreads();
    }
    SBAR(); qkt(pB0, pB1, K_lds + SHM_K, qr, qlds, r32, hi);
    finishSM(pA0, pA1, alA, l_reg, pa0, pa1, pa2, pa3); SBAR();
    pv_d0(o, vb0, pa0, pa1, pa2, pa3); partialSM(pB0, pB1, m_reg, mnB, alB);
    __syncthreads(); RESC(alB);
    finishSM(pB0, pB1, alB, l_reg, pa0, pa1, pa2, pa3); SBAR();
    pv_d0(o, vb0 + SHM_V, pa0, pa1, pa2, pa3);
    if (hi == 0) li_l[r32] = l_reg; asm volatile("s_waitcnt lgkmcnt(0)" ::: "memory");
    float rli[16];
#pragma unroll
    for (int r = 0; r < 16; ++r) rli[r] = __builtin_amdgcn_rcpf(li_l[crow(r, hi)]);
    bf16_t* Ow = Ob + (long)(wid * QBLK) * LDO;
#pragma unroll
    for (int r = 0; r < 16; ++r) { const int orow = crow(r, hi);
#pragma unroll
        for (int d0 = 0; d0 < 4; ++d0) Ow[(long)orow * LDO + d0 * 32 + r32] = f2bf(o[d0][r] * rli[r]); }
    __syncthreads();
#undef SLOAD
#undef SWRITE
#undef RESC
}
}

__device__ __forceinline__ void phase_mix0(const Params& p) {
    const int G = gridDim.x;
    phase_gla_out(p);
    __syncthreads();
    const bf16_t* QM = (const bf16_t*)(p.ws + WS_QM); const bf16_t* KM = (const bf16_t*)(p.ws + WS_KM); const bf16_t* VM = (const bf16_t*)(p.ws + WS_VM);
    bf16_t* MIX = (bf16_t*)(p.ws + WS_MIX);
    for (int u = blockIdx.x; u < 260; u += G) {
        const bool lat = u < 256;
        const int h = lat ? (u & 3) : (u - 256);
        const size_t q0 = lat ? (size_t)CTXN + (size_t)(u >> 2) * 256 : 0;
        mla::attn_body(QM + q0 * 768 + h * 192, KM + h * 192, VM + h * 128, MIX + q0 * 1024 + 512 + h * 128, lat ? NTOK : CTXN);
    }
}

template <int OFF> __device__ __forceinline__ s16x4 na_tr(int vb) { s16x4 r; asm volatile("ds_read_b64_tr_b16 %0, %1 offset:%2" : "=&v"(r) : "v"(vb), "i"(OFF) : "memory"); return r; }
template <int KS> __device__ __forceinline__ void na_pv(f32x16& o0, f32x16& o1, int vb, bf16x8 pa) {
    const s16x4 a0 = na_tr<KS * 5120>(vb), a1 = na_tr<KS * 5120 + 1280>(vb), b0 = na_tr<KS * 5120 + 64>(vb), b1 = na_tr<KS * 5120 + 1280 + 64>(vb);
    asm volatile("s_waitcnt lgkmcnt(0)" ::: "memory"); SBAR();
    o0 = __builtin_amdgcn_mfma_f32_32x32x16_bf16(pa, (bf16x8){a0[0], a0[1], a0[2], a0[3], a1[0], a1[1], a1[2], a1[3]}, o0, 0, 0, 0);
    o1 = __builtin_amdgcn_mfma_f32_32x32x16_bf16(pa, (bf16x8){b0[0], b0[1], b0[2], b0[3], b1[0], b1[1], b1[2], b1[3]}, o1, 0, 0, 0);
}
template <int MODE> __device__ __forceinline__ void na_softmax(f32x16& p0, f32x16& p1, float& m_reg, float& l_reg, float& alpha, const float* brow, int c0, int hi) {
    constexpr float C = 0.125f * LOG2E;
#define NA_L0(q) (MODE != 2 || (q) >= 12)
#define NA_L1(q) (MODE != 1 || (q) < 4)
    if (MODE == 0) {
#pragma unroll
        for (int q = 0; q < 16; ++q) { p0[q] *= C; p1[q] *= C; }
    } else {
        float bv0[16], bv1[16];
#pragma unroll
        for (int q = 0; q < 16; ++q) { const int kc0 = crow(q, hi); if (NA_L0(q)) bv0[q] = brow[kc0]; if (NA_L1(q)) bv1[q] = brow[32 + kc0]; }
#pragma unroll
        for (int q = 0; q < 16; ++q) { if (NA_L0(q)) asm volatile("" : "+v"(bv0[q])); if (NA_L1(q)) asm volatile("" : "+v"(bv1[q])); }
#pragma unroll
        for (int q = 0; q < 16; ++q) {
            const int kc0 = crow(q, hi), kc1 = 32 + kc0;
            if (NA_L0(q)) { const float t = fmaf(p0[q], C, bv0[q]); p0[q] = ((unsigned)(kc0 - c0) < 16u) ? t : -1e30f; }
            if (NA_L1(q)) { const float t = fmaf(p1[q], C, bv1[q]); p1[q] = ((unsigned)(kc1 - c0) < 16u) ? t : -1e30f; }
        }
    }
    float pmax = -1e30f;
#pragma unroll
    for (int q = 0; q < 16; ++q) { if (NA_L0(q)) pmax = fmaxf(pmax, p0[q]); if (NA_L1(q)) pmax = fmaxf(pmax, p1[q]); }
    { auto rr = __builtin_amdgcn_permlane32_swap(__float_as_uint(pmax), __float_as_uint(pmax), false, false);
      pmax = fmaxf(__uint_as_float(rr[0]), __uint_as_float(rr[1])); }
    const float mn = fmaxf(m_reg, pmax);
    alpha = __builtin_amdgcn_exp2f(m_reg - mn);
    m_reg = mn;
    float ps = 0.f;
#pragma unroll
    for (int q = 0; q < 16; ++q) {
        if (NA_L0(q)) { p0[q] = __builtin_amdgcn_exp2f(p0[q] - mn); ps += p0[q]; } else p0[q] = 0.f;
        if (NA_L1(q)) { p1[q] = __builtin_amdgcn_exp2f(p1[q] - mn); ps += p1[q]; } else p1[q] = 0.f;
    }
    { auto rr = __builtin_amdgcn_permlane32_swap(__float_as_uint(ps), __float_as_uint(ps), false, false);
      ps = __uint_as_float(rr[0]) + __uint_as_float(rr[1]); }
    l_reg = l_reg * alpha + ps;
#undef NA_L0
#undef NA_L1
}
__device__ __forceinline__ void phase_na(const Params& p) {
    const int tid = threadIdx.x, lane = tid & 63, wave = tid >> 6, r32 = lane & 31, hi = lane >> 5, G = gridDim.x;
    const bf16_t* QKV = (const bf16_t*)(p.ws + WS_P);
    bf16_t* MIX = (bf16_t*)(p.ws + WS_MIX);
    constexpr int KB = 64 * 72 * 2, VB = 64 * 160 * 2;
    char* Kl = smem;
    char* Vl = smem + 2 * KB;
    float* xch = (float*)(smem + 2 * KB + 2 * VB) + wave * 64;
    float* rpbL = (float*)(smem + 2 * KB + 2 * VB + 8 * 64 * 4);
    constexpr float C = 0.125f * LOG2E;
    const int skey = tid >> 3, sch = tid & 7;
    const int vb0 = (int)(uintptr_t)Vl + (8 * hi + ((lane & 15) >> 2)) * 320 + (16 * ((lane >> 4) & 1) + 4 * (lane & 3)) * 2;
    for (int u = blockIdx.x; u < 64 * 16; u += G) {
        const int rg = u >> 4, h = u & 15;
        const int r = rg * 4 + (wave >> 1), qb = wave & 1;
        const int r0w = min(max(r - 4, 0), 248);
        const int kr_lo = min(max(rg * 4 - 4, 0), 248), kr_hi = min(max(rg * 4 + 3 - 4, 0), 248) + 7, nwin = kr_hi - kr_lo + 1, ntile = nwin + 4;
        for (int i = tid; i < 15 * 31; i += NTH) rpbL[i] = p.na_rpb[(size_t)h * 15 * 31 + i] * LOG2E;
        const int c = qb * 32 + r32, c0 = min(max(c - 8, 0), 48);
        const size_t qrow = (size_t)CTXN + (size_t)r * 64 + c;
        bf16x8 qr[4];
#pragma unroll
        for (int ks = 0; ks < 4; ++ks) qr[ks] = *(const bf16x8*)(QKV + qrow * 3072 + h * 64 + ks * 16 + hi * 8);
        float m_reg = -1e30f, l_reg = 0.f; f32x16 o0 = {}, o1 = {};
        u32x4 skA, svA, skB, svB;
#define NA_LOAD(ti_, SK, SV) do { const size_t key0_ = ((ti_) >= nwin) ? (size_t)((ti_) - nwin) * 64 : (size_t)CTXN + (size_t)(kr_lo + (ti_)) * 64; \
            const bf16_t* src_ = QKV + (key0_ + skey) * 3072 + h * 64 + sch * 8; SK = *(const u32x4*)(src_ + 1024); SV = *(const u32x4*)(src_ + 2048); } while (0)
#define NA_WRITE(b_, SK, SV) do { *(u32x4*)(Kl + (b_) * KB + skey * 144 + sch * 16) = SK; *(u32x4*)(Vl + (b_) * VB + skey * 320 + sch * 16) = SV; } while (0)
        NA_LOAD(0, skA, svA); NA_WRITE(0, skA, svA);
        NA_LOAD(1, skA, svA);
        __syncthreads();
        for (int ti = 0; ti < ntile; ++ti) {
            const int b = ti & 1;
            if (ti + 2 < ntile) { if (b == 0) NA_LOAD(ti + 2, skB, svB); else NA_LOAD(ti + 2, skA, svA); }
            const bool isctx = ti >= nwin;
            const int kr = kr_lo + ti;
            const bool need = isctx || (kr >= r0w && kr <= r0w + 7);
            if (need) {
                const bf16_t* Ks = (const bf16_t*)(Kl + b * KB);
                f32x16 p0 = {}, p1 = {};
#pragma unroll
                for (int ks = 0; ks < 4; ++ks) {
                    const bf16x8 a0 = *(const bf16x8*)(Ks + r32 * 72 + ks * 16 + hi * 8), a1 = *(const bf16x8*)(Ks + (32 + r32) * 72 + ks * 16 + hi * 8);
                    p0 = __builtin_amdgcn_mfma_f32_32x32x16_bf16(a0, qr[ks], p0, 0, 0, 0);
                    p1 = __builtin_amdgcn_mfma_f32_32x32x16_bf16(a1, qr[ks], p1, 0, 0, 0);
                }
                float alpha;
                const float* brow = rpbL + (kr - r + 7) * 31 + 15 - c;
                if (isctx) na_softmax<0>(p0, p1, m_reg, l_reg, alpha, brow, c0, hi);
                else if (qb == 0) na_softmax<1>(p0, p1, m_reg, l_reg, alpha, brow, c0, hi);
                else na_softmax<2>(p0, p1, m_reg, l_reg, alpha, brow, c0, hi);
                bf16x8 pa0, pa1, pa2, pa3;
                PK4(p0, 0, pa0); PK4(p0, 8, pa1); PK4(p1, 0, pa2); PK4(p1, 8, pa3);
                if (__any(alpha < 1.f)) {
                    if (hi == 0) xch[r32] = alpha;
                    asm volatile("s_waitcnt lgkmcnt(0)" ::: "memory");
#pragma unroll
                    for (int q = 0; q < 16; ++q) { const float a = xch[crow(q, hi)]; o0[q] *= a; o1[q] *= a; }
                }
                const int vb = vb0 + b * VB;
                na_pv<0>(o0, o1, vb, pa0); na_pv<1>(o0, o1, vb, pa1); na_pv<2>(o0, o1, vb, pa2); na_pv<3>(o0, o1, vb, pa3);
            }
            if (ti + 1 < ntile) { if (b == 0) NA_WRITE(1, skA, svA); else NA_WRITE(0, skB, svB); }
            __syncthreads();
        }
#undef NA_LOAD
#undef NA_WRITE
        if (hi == 0) xch[32 + r32] = l_reg;
        asm volatile("s_waitcnt lgkmcnt(0)" ::: "memory");
        const size_t orow0 = (size_t)CTXN + (size_t)r * 64 + qb * 32;
#pragma unroll
        for (int q = 0; q < 16; ++q) {
            const int qi = crow(q, hi); const float il = __builtin_amdgcn_rcpf(xch[32 + qi]);
            bf16_t* dst = MIX + (orow0 + qi) * 1024 + h * 64;
            dst[r32] = f2bf(o0[q] * il); dst[32 + r32] = f2bf(o1[q] * il);
        }
        __syncthreads();
    }
}
#undef PK4

#define XB_TMO      128
#define XB_XCNT(j)  (256  + 64 * (j))
#define XB_XSUB(j)  (1280 + 64 * (j))
#define XB_XGEN(j)  (2304 + 64 * (j))
#define XB_TOP      3328
#define XB_TOPGEN   3392
#define XCD_BAR_WORDS 3456
#define XB_SPIN_CAP (1u << 22)
#define LAS __attribute__((address_space(3)))
__device__ __forceinline__ unsigned xb_ld(unsigned* p)              { return __hip_atomic_load(p, __ATOMIC_RELAXED, __HIP_MEMORY_SCOPE_AGENT); }
__device__ __forceinline__ unsigned xb_add(unsigned* p, unsigned v) { return __hip_atomic_fetch_add(p, v, __ATOMIC_RELAXED, __HIP_MEMORY_SCOPE_AGENT); }
__device__ __forceinline__ unsigned xb_xcc_id() { return (unsigned)__builtin_amdgcn_s_getreg((3 << 11) | 20) & 0xFu; }
#define XB_SPIN(cond, bar) do { unsigned _sp = 0; while (cond) { __builtin_amdgcn_s_sleep(1); \
    if ((++_sp & 255u) == 0u) { if (xb_ld(&(bar)[XB_TMO])) break; if (_sp > XB_SPIN_CAP) { atomicAdd(&(bar)[XB_TMO], 1u); break; } } } } while (0)
struct XcdBarrier { unsigned* bar; unsigned x; volatile LAS unsigned* st; };
__device__ __forceinline__ XcdBarrier xcd_barrier_post(unsigned* bar, volatile LAS unsigned* st) {
    XcdBarrier b; b.bar = bar; b.x = xb_xcc_id(); b.st = st;
    if (threadIdx.x == 0) (void)xb_add(&bar[XB_XCNT(b.x)], 1u);
    return b;
}
__device__ __forceinline__ void xcd_barrier_complete(unsigned* bar, unsigned x, unsigned& nloc, unsigned& nx) {
    const unsigned G = gridDim.x * gridDim.y * gridDim.z;
    unsigned sum, cnt, mine, sp = 0u;
    for (;;) {
        sum = 0u; cnt = 0u; mine = 0u;
#pragma unroll
        for (unsigned j = 0; j < 16; ++j) { const unsigned c = xb_ld(&bar[XB_XCNT(j)]); sum += c; cnt += (c > 0u) ? 1u : 0u; mine = (j == x) ? c : mine; }
        if (sum == G) break;
        __builtin_amdgcn_s_sleep(1);
        if ((++sp & 255u) == 0u) { if (xb_ld(&bar[XB_TMO])) break; if (sp > XB_SPIN_CAP) { atomicAdd(&bar[XB_TMO], 1u); break; } }
    }
    nloc = mine > 0u ? mine : 1u; nx = cnt > 0u ? cnt : 1u;
}
__device__ __forceinline__ void xcd_barrier(const XcdBarrier& b) {
    asm volatile("s_waitcnt vmcnt(0)" ::: "memory");
    __syncthreads();
    if (threadIdx.x == 0) {
        unsigned* bar = b.bar;
        __builtin_amdgcn_s_waitcnt(0);
        unsigned nloc = b.st[0], nx = b.st[1];
        if (nloc == 0u) { xcd_barrier_complete(bar, b.x, nloc, nx); b.st[0] = nloc; b.st[1] = nx; }
        const unsigned old = xb_add(&bar[XB_XSUB(b.x)], 1u);
        const unsigned gen = old / nloc;
        if (old + 1u == (gen + 1u) * nloc) {
            __builtin_amdgcn_fence(__ATOMIC_RELEASE, "agent");
            asm volatile("s_waitcnt vmcnt(0)" ::: "memory");
            const unsigned og = xb_add(&bar[XB_TOP], 1u);
            const unsigned tg = og / nx;
            if (og + 1u == (tg + 1u) * nx) xb_add(&bar[XB_TOPGEN], 1u);
            else XB_SPIN(xb_ld(&bar[XB_TOPGEN]) == tg, bar);
            __builtin_amdgcn_fence(__ATOMIC_ACQUIRE, "agent");
            xb_add(&bar[XB_XGEN(b.x)], 1u);
            asm volatile("s_waitcnt vmcnt(0)" ::: "memory");
        } else {
            XB_SPIN(xb_ld(&bar[XB_XGEN(b.x)]) == gen, bar);
            __builtin_amdgcn_fence(__ATOMIC_ACQUIRE, "agent");
            asm volatile("s_waitcnt vmcnt(0)" ::: "memory");
        }
    }
    __syncthreads();
}

__device__ __forceinline__ void run_phase(const Params& p, int ph) {
#ifdef ONLY_PHASE
    if (ph != ONLY_PHASE) return;
    ph = ONLY_PHASE;
#endif
    const bf16_t* HB = (const bf16_t*)(p.ws + WS_HB);
    switch (ph) {
    case 0: phase_prologue(p); break;
    case 1: phase_norm1_l0(p); break;
    case 2: phase_gemm_pg8(HB, 1024, (const bf16_t*)(p.ws + WS_WIN), 1024, (bf16_t*)(p.ws + WS_P), PW, NTOK / 256, 8); break;
    case 3: phase_mla_up(p); break;
    case 4: break;
    case 5: phase_gla_scan(p); break;
    case 6: phase_mix0(p); break;
    case 7: phase_gemm_pg8((const bf16_t*)(p.ws + WS_MIX), 1024, (const bf16_t*)(p.ws + WS_WOUT0), 1024, (bf16_t*)(p.ws + WS_OB), 1024, NTOK / 256, 4); break;
    case 8: phase_mid(p, 0); break;
    case 9: phase_moe1(p, 0); break;
    case 10: phase_moe2(p, 0); break;
    case 11: phase_end(p, 0); break;
    case 12: phase_gemm_pg8(HB, 1024, (const bf16_t*)(p.ws + WS_WQKV), 1024, (bf16_t*)(p.ws + WS_P), 3072, NTOK / 256, 12); break;
    case 13: phase_na(p); break;
    case 14: phase_gemm_pg8((const bf16_t*)(p.ws + WS_MIX) + (size_t)CTXN * 1024, 1024, (const bf16_t*)(p.ws + WS_WNAO), 1024, (bf16_t*)(p.ws + WS_OB) + (size_t)CTXN * 1024, 1024, SEQ / 256, 4); break;
    case 15: phase_mid(p, 1); break;
    case 16: phase_moe1(p, 1); break;
    case 17: phase_moe2(p, 1); break;
    case 18: phase_end(p, 1); break;
    default: break;
    }
}
constexpr int N_PHASES = 19;

#if MK_LAUNCHES == 1
__global__ void __launch_bounds__(512) mega_kernel(Params p) {
    cg::grid_group grid = cg::this_grid();
    volatile LAS unsigned* xst = (volatile LAS unsigned*)(smem + LDS_BYTES - 16);
    if (threadIdx.x == 0) { xst[0] = 0u; xst[1] = 0u; xst[2] = 0u; xst[3] = 0u; }
    __syncthreads();
    XcdBarrier xb = xcd_barrier_post((unsigned*)(p.ws + WS_BAR), xst);
    run_phase(p, 0); xcd_barrier(xb);
    if (p.pad0 == 0x7fffffff) grid.sync();
    if (PROBE_REPEAT == 100) { run_phase(p, 0); xcd_barrier(xb); }
    if (PROBE_REPEAT == 61) { phase_gla_out(p); xcd_barrier(xb); }
#define PH_(n) run_phase(p, n); xcd_barrier(xb); if ((n) == PROBE_REPEAT) { run_phase(p, n); xcd_barrier(xb); }
    PH_(1) PH_(2) PH_(3) PH_(5) PH_(6) PH_(7) PH_(8) PH_(9) PH_(10) PH_(11) PH_(12) PH_(13) PH_(14) PH_(15) PH_(16) PH_(17)
    run_phase(p, 18);
#undef PH_
}
#else
template <int PH> __global__ void __launch_bounds__(512) phase_kernel(Params p) { run_phase(p, PH); }
typedef void (*phase_fn)(Params);
template <int PH> static bool launch_phase(const Params& p, int grid, hipStream_t stream, bool setattr) {
    if (setattr && hipFuncSetAttribute((const void*)phase_kernel<PH>, hipFuncAttributeMaxDynamicSharedMemorySize, LDS_BYTES) != hipSuccess) return false;
    hipLaunchKernelGGL(phase_kernel<PH>, dim3(grid), dim3(NTH), LDS_BYTES, stream, p);
    return true;
}
#endif

extern "C" void kernel_launch(void* const* d_in, const int* in_sizes, int n_in, void* d_out, int out_size, void* d_ws, size_t ws_size, hipStream_t stream) {
    static int grid_blocks = 0;
    bool first = false;
    if (!grid_blocks) {
        if (ws_size < WS_END) { fprintf(stderr, "kernel_launch: workspace too small: %zu < %zu\n", ws_size, (size_t)WS_END); return; }
        int dev = 0, cus = 0;
        (void)hipGetDevice(&dev);
        (void)hipDeviceGetAttribute(&cus, hipDeviceAttributeMultiprocessorCount, dev);
#if MK_LAUNCHES == 1
        if (hipFuncSetAttribute((const void*)mega_kernel, hipFuncAttributeMaxDynamicSharedMemorySize, LDS_BYTES) != hipSuccess) { fprintf(stderr, "kernel_launch: LDS attribute failed\n"); return; }
        int per_cu = 0;
        (void)hipOccupancyMaxActiveBlocksPerMultiprocessor(&per_cu, (const void*)mega_kernel, NTH, LDS_BYTES);
        if (per_cu < 1) { fprintf(stderr, "kernel_launch: occupancy query returned %d\n", per_cu); return; }
#endif
        grid_blocks = cus;
        first = true;
    }
    Params p{};
    const float* const* in = (const float* const*)d_in;
    p.x = in[0]; p.c = in[1]; p.ctx = in[2]; p.c_ctx = in[3]; p.ada_w = in[4]; p.ada_b = in[5]; p.norm_g = in[6]; p.router_w = in[7]; p.router_b = in[8];
    p.moe_w1 = in[9]; p.moe_b1 = in[10]; p.moe_w2 = in[11]; p.moe_b2 = in[12]; p.ab_in_w = in[13]; p.gla_wa_f = in[14]; p.gla_ba_f = in[15]; p.gla_wa_b = in[16]; p.gla_ba_b = in[17];
    p.gla_onorm = in[18]; p.mla_qnorm = in[19]; p.mla_wuq = in[20]; p.mla_kvnorm = in[21]; p.mla_wukv = in[22]; p.ab_out_w = in[23]; p.na_qkv_w = in[24]; p.na_rpb = in[25]; p.na_out_w = in[26];
    p.out = (float*)d_out; p.ws = (char*)d_ws;
#if MK_LAUNCHES == 1
    (void)hipMemsetAsync((char*)d_ws + WS_BAR, 0, 16384, stream);
    void* args[] = {&p};
    hipError_t e = hipLaunchCooperativeKernel((const void*)mega_kernel, dim3(grid_blocks), dim3(NTH), args, LDS_BYTES, stream);
    if (e != hipSuccess) fprintf(stderr, "cooperative launch failed: %s (grid %d)\n", hipGetErrorString(e), grid_blocks);
#else
    const int g = grid_blocks;
    launch_phase<0>(p, g, stream, first); launch_phase<1>(p, g, stream, first); launch_phase<2>(p, g, stream, first); launch_phase<3>(p, g, stream, first);
    launch_phase<4>(p, g, stream, first); launch_phase<5>(p, g, stream, first); launch_phase<6>(p, g, stream, first); launch_phase<7>(p, g, stream, first);
    launch_phase<8>(p, g, stream, first); launch_phase<9>(p, g, stream, first); launch_phase<10>(p, g, stream, first); launch_phase<11>(p, g, stream, first);
    launch_phase<12>(p, g, stream, first); launch_phase<13>(p, g, stream, first); launch_phase<14>(p, g, stream, first); launch_phase<15>(p, g, stream, first);
    launch_phase<16>(p, g, stream, first); launch_phase<17>(p, g, stream, first); launch_phase<18>(p, g, stream, first);
#endif
}
```

```cpp
#include <hip/hip_runtime.h>
#include <hip/hip_cooperative_groups.h>
#include <cstdio>
#include <cstdint>
namespace cg = cooperative_groups;

#ifndef PROBE_REPEAT
#define PROBE_REPEAT -1
#endif
#ifndef MK_LAUNCHES
#define MK_LAUNCHES 1
#endif

typedef unsigned short bf16_t;
typedef short bf16x8 __attribute__((ext_vector_type(8)));
typedef short s16x4 __attribute__((ext_vector_type(4)));
typedef float f32x4 __attribute__((ext_vector_type(4)));
typedef float f32x16 __attribute__((ext_vector_type(16)));
typedef unsigned u32x4 __attribute__((ext_vector_type(4)));
typedef unsigned u32x2 __attribute__((ext_vector_type(2)));

constexpr int SEQ = 16384, CTXN = 256, NTOK = SEQ + CTXN, DM = 1024;
constexpr int NEXP = 32, FF = 1024;
constexpr int PW = 2048;
constexpr int PC_Q = 0, PC_K = 256, PC_V = 512, PC_R = 1024, PC_AF = 1536, PC_AB = 1552, PC_CQ = 1568, PC_CKV = 1824, PC_KR = 1952;
constexpr int NCH = NTOK / 64;
constexpr int NTH = 512;
constexpr float EPSN = 1e-6f;
constexpr float LOG2E = 1.4426950408889634f;

constexpr size_t al256(size_t x) { return (x + 255) / 256 * 256; }
constexpr size_t WS_BAR   = 0;
constexpr size_t WS_CNT   = WS_BAR + 16384;
constexpr size_t WS_MOD   = WS_CNT + 1024;
constexpr size_t WS_ROPE  = WS_MOD + al256((size_t)2 * 2 * 6144 * 4);
constexpr size_t WS_RWT   = WS_ROPE + al256((size_t)(256 + 256 + 64 + 64) * 16 * 4);
constexpr size_t WS_WIN   = WS_RWT + al256((size_t)2 * 32 * 1024 * 4);
constexpr size_t WS_WUQ   = WS_WIN + (size_t)2048 * 1024 * 2;
constexpr size_t WS_WUKV  = WS_WUQ + (size_t)768 * 256 * 2;
constexpr size_t WS_WOUT0 = WS_WUKV + (size_t)1024 * 128 * 2;
constexpr size_t WS_WQKV  = WS_WOUT0 + (size_t)1024 * 1024 * 2;
constexpr size_t WS_WNAO  = WS_WQKV + (size_t)3072 * 1024 * 2;
constexpr size_t WS_W1T   = WS_WNAO + (size_t)1024 * 1024 * 2;
constexpr size_t WS_W2T   = WS_W1T + (size_t)2 * 32 * 2048 * 1024 * 2;
constexpr size_t WS_HB    = WS_W2T + (size_t)2 * 32 * 1024 * 1024 * 2;
constexpr size_t WS_P     = WS_HB + (size_t)NTOK * 1024 * 2;
constexpr size_t WS_QM    = WS_P + (size_t)NTOK * 3072 * 2;
constexpr size_t WS_KM    = WS_QM + (size_t)NTOK * 768 * 2;
constexpr size_t WS_VM    = WS_KM + (size_t)NTOK * 768 * 2;
constexpr size_t WS_U     = WS_VM + (size_t)NTOK * 512 * 2;
constexpr size_t WS_SIN   = WS_U + (size_t)2 * NCH * 4 * 128 * 64 * 2;
constexpr size_t WS_DEC   = WS_SIN + (size_t)2 * NCH * 4 * 128 * 64 * 2;
constexpr size_t WS_MIX   = WS_DEC + al256((size_t)2 * NCH * 4 * 64 * 4);
constexpr size_t WS_OB    = WS_MIX + (size_t)NTOK * 1024 * 2;
constexpr size_t WS_X1    = WS_OB + (size_t)NTOK * 1024 * 2;
constexpr size_t WS_X2    = WS_X1 + (size_t)NTOK * 1024 * 4;
constexpr size_t WS_TOPE  = WS_X2 + (size_t)NTOK * 1024 * 4;
constexpr size_t WS_TOPP  = WS_TOPE + al256((size_t)NTOK * 4 * 4);
constexpr size_t WS_GATE  = WS_TOPP + al256((size_t)NTOK * 4 * 4);
constexpr size_t WS_LIST  = WS_GATE + al256((size_t)NTOK * 4 * 4);
constexpr size_t WS_ACT   = WS_LIST + al256((size_t)32 * NTOK * 4);
constexpr size_t WS_YB    = WS_ACT + (size_t)(NTOK * 4 + 256) * 1024 * 2;
constexpr size_t WS_END   = WS_YB + (size_t)(NTOK * 4) * 1024 * 2;

constexpr int LDS_BYTES = 160 * 1024;
extern __shared__ __attribute__((aligned(16))) char smem[];

struct Params {
    const float *x, *c, *ctx, *c_ctx, *ada_w, *ada_b, *norm_g, *router_w, *router_b, *moe_w1, *moe_b1, *moe_w2, *moe_b2;
    const float *ab_in_w, *gla_wa_f, *gla_ba_f, *gla_wa_b, *gla_ba_b, *gla_onorm, *mla_qnorm, *mla_wuq, *mla_kvnorm, *mla_wukv;
    const float *ab_out_w, *na_qkv_w, *na_rpb, *na_out_w;
    float* out; char* ws;
    int pad0, pad1;
};

__device__ __forceinline__ float bf2f(bf16_t h) { return __uint_as_float(((unsigned)h) << 16); }
__device__ __forceinline__ bf16_t f2bf(float f) { unsigned u = __float_as_uint(f); u += 0x7FFFu + ((u >> 16) & 1u); return (bf16_t)(u >> 16); }
__device__ __forceinline__ unsigned cvtpk(float lo, float hi) { unsigned r; asm volatile("v_cvt_pk_bf16_f32 %0, %1, %2" : "=v"(r) : "v"(lo), "v"(hi)); return r; }
__device__ __forceinline__ float wave_sum(float v) {
#pragma unroll
    for (int o = 32; o >= 1; o >>= 1) v += __shfl_xor(v, o);
    return v;
}
__device__ __forceinline__ int crow(int r, int hi) { return (r & 3) + 8 * (r >> 2) + 4 * hi; }
__device__ __forceinline__ float silu_f(float x) { return x / (1.f + __expf(-x)); }
#define SBAR() __builtin_amdgcn_sched_barrier(0)
__device__ __forceinline__ int tid_opaque() { int t = threadIdx.x; asm volatile("" : "+v"(t)); return t; }

struct ConvJob { const float* src; bf16_t* dst; const float* gain; int K, Nsrc, kt, nt, mode; };
__device__ __forceinline__ void conv_load(const ConvJob& jb, float4 (&v)[16]) {
    const int tid = threadIdx.x, n4 = tid & 63, kr = tid >> 6, n = jb.nt * 256 + n4 * 4;
    const float* q = jb.src + (size_t)(jb.kt * 128 + kr) * jb.Nsrc + n;
#pragma unroll
    for (int i = 0; i < 16; ++i) { if (n < jb.Nsrc) { const f32x4 t = __builtin_nontemporal_load((const f32x4*)(q + (size_t)(8 * i) * jb.Nsrc)); v[i] = make_float4(t[0], t[1], t[2], t[3]); } else v[i] = make_float4(0.f, 0.f, 0.f, 0.f); }
}
__device__ __forceinline__ void conv_to_lds(const ConvJob& jb, const float4 (&v)[16]) {
    bf16_t* T = (bf16_t*)smem;
    const int tid = threadIdx.x, n4 = tid & 63, kr = tid >> 6;
#pragma unroll
    for (int i = 0; i < 16; ++i) {
        const int k = kr + 8 * i;
        float4 w = v[i];
        if (jb.mode == 1) { const float g = jb.gain[jb.kt * 128 + k]; w.x *= g; w.y *= g; w.z *= g; w.w *= g; }
        u32x2 pk; pk.x = cvtpk(w.x, w.y); pk.y = cvtpk(w.z, w.w);
        *(u32x2*)(T + k * 260 + n4 * 4) = pk;
    }
}
__device__ __forceinline__ void conv_readout(const ConvJob& jb) {
    const bf16_t* T = (const bf16_t*)smem;
    const int tid = threadIdx.x, k0 = jb.kt * 128;
#pragma unroll
    for (int i = 0; i < 8; ++i) {
        const int cc = tid + 512 * i, nn = cc >> 4, kc = cc & 15;
        const int col = (jb.mode == 2) ? (2 * (nn & 127) + (nn >> 7)) : nn;
        unsigned short e[8];
#pragma unroll
        for (int j = 0; j < 8; ++j) e[j] = T[(kc * 8 + j) * 260 + col];
        u32x4 o; o.x = e[0] | ((unsigned)e[1] << 16); o.y = e[2] | ((unsigned)e[3] << 16); o.z = e[4] | ((unsigned)e[5] << 16); o.w = e[6] | ((unsigned)e[7] << 16);
        __builtin_nontemporal_store(o, (u32x4*)(jb.dst + (size_t)(jb.nt * 256 + nn) * jb.K + k0 + kc * 8));
    }
}

__device__ __forceinline__ void adaln_job(const Params& p, int job) {
    const int l = job / 24, cb = (job % 24) * 256, tid = threadIdx.x;
    float* sv = (float*)smem;
    for (int i = tid; i < 2048; i += NTH) { const int k = i & 1023; const float xx = (i < 1024) ? p.c[k] : p.c_ctx[k]; sv[i] = silu_f(xx); }
    __syncthreads();
    const int col4 = tid & 63, kq = tid >> 6;
    float4 a0 = make_float4(0, 0, 0, 0), a1 = make_float4(0, 0, 0, 0);
    const float* w = p.ada_w + ((size_t)l * 1024 + kq * 128) * 6144 + cb + col4 * 4;
#pragma unroll 8
    for (int k = 0; k < 128; ++k) {
        const float4 wv = *(const float4*)(w + (size_t)k * 6144);
        const float s0 = sv[kq * 128 + k], s1 = sv[1024 + kq * 128 + k];
        a0.x += s0 * wv.x; a0.y += s0 * wv.y; a0.z += s0 * wv.z; a0.w += s0 * wv.w;
        a1.x += s1 * wv.x; a1.y += s1 * wv.y; a1.z += s1 * wv.z; a1.w += s1 * wv.w;
    }
    float* red = sv + 2048;
    *(float4*)(red + (kq * 2 + 0) * 256 + col4 * 4) = a0;
    *(float4*)(red + (kq * 2 + 1) * 256 + col4 * 4) = a1;
    __syncthreads();
    {
        const int s = tid >> 8, col = tid & 255;
        float acc = p.ada_b[l * 6144 + cb + col];
#pragma unroll
        for (int q = 0; q < 8; ++q) acc += red[(q * 2 + s) * 256 + col];
        ((float*)(p.ws + WS_MOD))[(l * 2 + s) * 6144 + cb + col] = acc;
    }
    __syncthreads();
}

__device__ __forceinline__ void tables_job(const Params& p) {
    float* rope = (float*)(p.ws + WS_ROPE);
    const int tid = threadIdx.x;
    for (int i = tid; i < (256 + 64) * 16; i += NTH) {
        const bool isrow = i < 256 * 16;
        const int idx = isrow ? i : i - 256 * 16, pos = idx >> 4, j = idx & 15;
        const float inv = exp2f(-(float)j * (13.287712379549449f / 16.f));
        const float ang = (float)pos * inv;
        float rev = ang * 0.15915494309189535f; rev -= rintf(rev);
        const float cs = __builtin_amdgcn_cosf(rev), sn = __builtin_amdgcn_sinf(rev);
        if (isrow) { rope[idx] = cs; rope[256 * 16 + idx] = sn; }
        else { rope[512 * 16 + idx] = cs; rope[512 * 16 + 64 * 16 + idx] = sn; }
    }
    if (tid < 64) ((int*)(p.ws + WS_CNT))[tid] = 0;
}
__device__ __forceinline__ void rwt_job(const Params& p, int l) {
    float* dst = (float*)(p.ws + WS_RWT) + (size_t)l * 32 * 1024;
    const float* src = p.router_w + (size_t)l * 1024 * 32;
    for (int i = threadIdx.x; i < 32 * 1024; i += NTH) { const int cch = i >> 5, e = i & 31; dst[e * 1024 + cch] = src[i]; }
}

constexpr int J_IN = 8 * 8, J_UQ = 2 * 3, J_UKV = 1 * 4, J_OUT0 = 32, J_QKV = 8 * 12, J_NAO = 32, J_W1 = 64 * 64, J_W2 = 64 * 32;
constexpr int J_TOTAL = J_IN + J_UQ + J_UKV + J_OUT0 + J_QKV + J_NAO + J_W1 + J_W2;
__device__ __forceinline__ ConvJob conv_decode(const Params& p, int j) {
    ConvJob jb; jb.gain = nullptr; jb.mode = 0;
    int t = j;
    if (t < J_W1) { const int m = t >> 6, q = t & 63; jb.src = p.moe_w1 + (size_t)m * 1024 * 2048; jb.dst = (bf16_t*)(p.ws + WS_W1T) + (size_t)m * 2048 * 1024; jb.K = 1024; jb.Nsrc = 2048; jb.kt = q >> 3; jb.nt = q & 7; jb.mode = 2; return jb; } t -= J_W1;
    if (t < J_W2) { const int m = t >> 5, q = t & 31; jb.src = p.moe_w2 + (size_t)m * 1024 * 1024; jb.dst = (bf16_t*)(p.ws + WS_W2T) + (size_t)m * 1024 * 1024; jb.K = 1024; jb.Nsrc = 1024; jb.kt = q >> 2; jb.nt = q & 3; return jb; } t -= J_W2;
    if (t < J_IN) { jb.src = p.ab_in_w; jb.dst = (bf16_t*)(p.ws + WS_WIN); jb.K = 1024; jb.Nsrc = 2016; jb.kt = t / 8; jb.nt = t % 8; return jb; } t -= J_IN;
    if (t < J_UQ) { jb.src = p.mla_wuq; jb.dst = (bf16_t*)(p.ws + WS_WUQ); jb.K = 256; jb.Nsrc = 768; jb.kt = t / 3; jb.nt = t % 3; jb.mode = 1; jb.gain = p.mla_qnorm; return jb; } t -= J_UQ;
    if (t < J_UKV) { jb.src = p.mla_wukv; jb.dst = (bf16_t*)(p.ws + WS_WUKV); jb.K = 128; jb.Nsrc = 1024; jb.kt = 0; jb.nt = t; jb.mode = 1; jb.gain = p.mla_kvnorm; return jb; } t -= J_UKV;
    if (t < J_OUT0) { jb.src = p.ab_out_w; jb.dst = (bf16_t*)(p.ws + WS_WOUT0); jb.K = 1024; jb.Nsrc = 1024; jb.kt = t / 4; jb.nt = t % 4; return jb; } t -= J_OUT0;
    if (t < J_QKV) { jb.src = p.na_qkv_w; jb.dst = (bf16_t*)(p.ws + WS_WQKV); jb.K = 1024; jb.Nsrc = 3072; jb.kt = t / 12; jb.nt = t % 12; return jb; } t -= J_QKV;
    jb.src = p.na_out_w; jb.dst = (bf16_t*)(p.ws + WS_WNAO); jb.K = 1024; jb.Nsrc = 1024; jb.kt = t / 4; jb.nt = t % 4; return jb;
}

__device__ __forceinline__ void phase_prologue(const Params& p) {
    const int G = gridDim.x, b = blockIdx.x;
    for (int j = b; j < 51; j += G) {
        if (j < 48) adaln_job(p, j);
        else if (j == 48) tables_job(p);
        else rwt_job(p, j - 49);
    }
    __syncthreads();
    int j = b;
    if (j >= J_TOTAL) return;
    ConvJob cur = conv_decode(p, j);
    float4 v[16];
    conv_load(cur, v);
    for (;;) {
        conv_to_lds(cur, v);
        __syncthreads();
        const int jn = j + G;
        ConvJob nxt = cur;
        if (jn < J_TOTAL) { nxt = conv_decode(p, jn); conv_load(nxt, v); }
        conv_readout(cur);
        __syncthreads();
        if (jn >= J_TOTAL) break;
        cur = nxt; j = jn;
    }
}

namespace gm {
constexpr int BK = 64, HT = 128 * 64;
__device__ __forceinline__ int lds_byte(int r, int c) { const int st = (r >> 4) * 2 + (c >> 5), rr = r & 15, cc = c & 31, ob = rr * 64 + cc * 2; return st * 1024 + (ob ^ (((ob >> 9) & 1) << 5)); }
__device__ __forceinline__ void stage_rc(int b, int& R, int& C) { const int st = b / 1024, sb = b % 1024, swz = sb ^ (((sb >> 9) & 1) << 5); R = (st >> 1) * 16 + swz / 64; C = (st & 1) * 32 + (swz % 64) / 2; }

template <class Epi>
__device__ __forceinline__ void gemm_tile(const bf16_t* __restrict__ A, const int (&aoff)[2][2], const bf16_t* __restrict__ Bt, const int (&boff)[2], int nk, Epi& epi) {
    bf16_t* shm = (bf16_t*)smem;
    const int tid = tid_opaque(), wid = tid >> 6, lane = tid & 63, wr = wid >> 1, wc = wid & 1, fr = lane & 15, fq = lane >> 4;
    f32x4 acc[4][4];
#pragma unroll
    for (int m = 0; m < 4; ++m)
#pragma unroll
        for (int n = 0; n < 4; ++n) acc[m][n] = (f32x4){0.f, 0.f, 0.f, 0.f};
#define GM_STAGE(buf, kt) do { \
        _Pragma("unroll") for (int _i = 0; _i < 2; ++_i) { \
            __builtin_amdgcn_global_load_lds((const unsigned*)(A + aoff[0][_i] + (kt) * BK), (unsigned*)((char*)(shm + ((buf) * 3 + 0) * HT) + tid * 16 + _i * 8192), 16, 0, 0); \
            __builtin_amdgcn_global_load_lds((const unsigned*)(A + aoff[1][_i] + (kt) * BK), (unsigned*)((char*)(shm + ((buf) * 3 + 1) * HT) + tid * 16 + _i * 8192), 16, 0, 0); \
            __builtin_amdgcn_global_load_lds((const unsigned*)(Bt + boff[_i] + (kt) * BK), (unsigned*)((char*)(shm + ((buf) * 3 + 2) * HT) + tid * 16 + _i * 8192), 16, 0, 0); } } while (0)
    GM_STAGE(0, 0);
    for (int kt = 0; kt < nk; ++kt) {
        __syncthreads();
        const int buf = kt & 1;
        if (kt + 1 < nk) GM_STAGE(buf ^ 1, kt + 1);
        const char* Ab = (const char*)(shm + (buf * 3 + (wr >> 1)) * HT);
        const char* Bb = (const char*)(shm + (buf * 3 + 2) * HT);
#pragma unroll
        for (int k = 0; k < 2; ++k) {
            bf16x8 Bf[4], Af[4];
#pragma unroll
            for (int n = 0; n < 4; ++n) Bf[n] = *(const bf16x8*)(Bb + lds_byte(wc * 64 + n * 16 + fr, k * 32 + fq * 8));
#pragma unroll
            for (int m = 0; m < 4; ++m) Af[m] = *(const bf16x8*)(Ab + lds_byte((wr & 1) * 64 + m * 16 + fr, k * 32 + fq * 8));
#pragma unroll
            for (int m = 0; m < 4; ++m)
#pragma unroll
                for (int n = 0; n < 4; ++n) acc[m][n] = __builtin_amdgcn_mfma_f32_16x16x32_bf16(Af[m], Bf[n], acc[m][n], 0, 0, 0);
        }
    }
#undef GM_STAGE
    float* stg = (float*)smem;
    __syncthreads();
    {
        float* wb = stg + (wr * 64 + fq * 4) * 132 + wc * 64 + fr;
#pragma unroll
        for (int m = 0; m < 4; ++m)
#pragma unroll
            for (int n = 0; n < 4; ++n)
#pragma unroll
                for (int j = 0; j < 4; ++j) wb[(m * 16 + j) * 132 + n * 16] = acc[m][n][j];
    }
    __syncthreads();
    if (Epi::MOE1) {
        const int fch = tid & 7, rg = tid >> 3;
        for (int ps = 0; ps < 4; ++ps) {
            const int row = ps * 64 + rg;
            const float* q = stg + row * 132 + (fch >> 1) * 32 + (fch & 1) * 8;
            float g[8], l[8];
            *(f32x4*)&g[0] = *(const f32x4*)q; *(f32x4*)&g[4] = *(const f32x4*)(q + 4);
            *(f32x4*)&l[0] = *(const f32x4*)(q + 16); *(f32x4*)&l[4] = *(const f32x4*)(q + 20);
            epi.pair(row, fch * 8, g, l);
        }
    } else {
        const int ch = tid & 15, rg = tid >> 4;
        for (int ps = 0; ps < 8; ++ps) {
            const int row = ps * 32 + rg;
            const float* q = stg + row * 132 + ch * 8;
            float v[8];
            *(f32x4*)&v[0] = *(const f32x4*)q; *(f32x4*)&v[4] = *(const f32x4*)(q + 4);
            epi.row8(row, ch * 8, v);
        }
    }
    __syncthreads();
}
__device__ __forceinline__ void make_off(int (&off)[2][2], int row0, int ld) {
#pragma unroll
    for (int h = 0; h < 2; ++h)
#pragma unroll
        for (int i = 0; i < 2; ++i) { int R, C; stage_rc(tid_opaque() * 16 + i * 8192, R, C); off[h][i] = (row0 + h * 128 + R) * ld + C; }
}
__device__ __forceinline__ void make_off1(int (&off)[2], int row0, int ld) {
#pragma unroll
    for (int i = 0; i < 2; ++i) { int R, C; stage_rc(tid_opaque() * 16 + i * 8192, R, C); off[i] = (row0 + R) * ld + C; }
}
}

namespace pg8 {
#define PG8_LAS __attribute__((address_space(3)))
constexpr int BM = 256, BK = 64, HALF = 128, HTB = HALF * BK * 2, STAGE_BYTES = 8 * HTB, NXCD = 8, WGM = 8;
__device__ __forceinline__ int lds_byte(int r, int c) { const int st = (r >> 4) * 2 + (c >> 5), rr = r & 15, cc = c & 31, ob = rr * 64 + cc * 2; return st * 1024 + (ob ^ (((ob >> 9) & 1) << 5)); }
__device__ __forceinline__ void stage_rc(int b, int& R, int& C) { const int st = b / 1024, sb = b % 1024, swz = sb ^ (((sb >> 9) & 1) << 5); R = (st >> 1) * 16 + swz / 64; C = (st & 1) * 32 + (swz % 64) / 2; }
__device__ __forceinline__ int perm32(int rho) { const int n = rho >> 4, i = rho & 15; return 8 * (i >> 2) + 4 * n + (i & 3); }
struct Unit { int pm, pn, e, nvalid, slot0; };

template <class Epi, class Sched, bool GATHER>
__device__ __forceinline__ void gemm_phase(PG8_LAS unsigned char* lds, const Sched& S, const Epi& E, int K, int lda, int ldb) {
    const int tid = tid_opaque(), wid = __builtin_amdgcn_readfirstlane(tid >> 6), lane = tid & 63, wr = wid >> 2, wc = wid & 3, fr = lane & 15, fq = lane >> 4;
    const int nt = K / BK;
    unsigned voffA[2], voffB[2]; int gR[2], gC[2];
#pragma unroll
    for (int i = 0; i < 2; ++i) { int R, C; stage_rc(tid * 16 + i * 8192, R, C); const int Rb = Epi::PERM ? ((R & ~31) + perm32(R & 31)) : R;
        voffA[i] = (unsigned)(R * lda + C) * 2u; voffB[i] = (unsigned)(Rb * ldb + C) * 2u; gR[i] = R; gC[i] = C * 2; }
    const size_t kstep = (size_t)(BK * 2);
    const size_t hstepA = (size_t)HALF * lda * 2, hstepB = (size_t)HALF * ldb * 2;
    const unsigned ldsw = (unsigned)wid * 1024u;
    const int aoff = lds_byte(wr * 64 + fr, fq * 8), boff = lds_byte(wc * 32 + fr, fq * 8);
    unsigned gA[2][2] = {{0u, 0u}, {0u, 0u}};
#define PG8_SA(b, h) (((b) * 2 + (h)) * HTB)
#define PG8_SB(b, h) ((4 + (b) * 2 + (h)) * HTB)
#define PG8_STAGE(bufoff, gbase, voff) do { _Pragma("unroll") for (int _i = 0; _i < 2; ++_i) \
        __builtin_amdgcn_global_load_lds((const unsigned*)((const char*)(gbase) + (voff)[_i]), (PG8_LAS unsigned*)(lds + (bufoff) + ldsw + _i * 8192), 16, 0, 0); } while (0)
#define PG8_STAGE_A(bufoff, base, h) do { if constexpr (GATHER) PG8_STAGE(bufoff, base, gA[h]); else PG8_STAGE(bufoff, (base) + (h) * hstepA, voffA); } while (0)
#define PG8_LDA(dst, b, h) do { _Pragma("unroll") for (int m = 0; m < 4; ++m) _Pragma("unroll") for (int k = 0; k < 2; ++k) dst[m][k] = *(const PG8_LAS bf16x8*)(lds + PG8_SA(b, h) + aoff + m * 2048 + k * 1024); } while (0)
#define PG8_LDB(dst, b, h) do { _Pragma("unroll") for (int n = 0; n < 2; ++n) _Pragma("unroll") for (int k = 0; k < 2; ++k) dst[n][k] = *(const PG8_LAS bf16x8*)(lds + PG8_SB(b, h) + boff + n * 2048 + k * 1024); } while (0)
#define PG8_MMA(ai, bj, At, Bt) do { __builtin_amdgcn_s_setprio(1); _Pragma("unroll") for (int m = 0; m < 4; ++m) _Pragma("unroll") for (int n = 0; n < 2; ++n) _Pragma("unroll") for (int k = 0; k < 2; ++k) \
        acc[ai][bj][m][n] = __builtin_amdgcn_mfma_f32_16x16x32_bf16(Bt[n][k], At[m][k], acc[ai][bj][m][n], 0, 0, 0); __builtin_amdgcn_s_setprio(0); } while (0)
#define PG8_WAIT_V(n) asm volatile("s_waitcnt vmcnt(" #n ")" ::: "memory")
#define PG8_WAIT_L(n) asm volatile("s_waitcnt lgkmcnt(" #n ")" ::: "memory")
#define PG8_BAR __builtin_amdgcn_s_barrier()
#define PG8_SCHED __builtin_amdgcn_sched_barrier(0)
#define PG8_GLOAD(ui_) do { const PG8_LAS int* _gl = S.glist(ui_); _Pragma("unroll") for (int _h = 0; _h < 2; ++_h) _Pragma("unroll") for (int _i = 0; _i < 2; ++_i) \
        gA[_h][_i] = ((unsigned)_gl[_h * 128 + gR[_i]] << 11) + (unsigned)gC[_i]; } while (0)
    Unit cur, nxt; int ui = 0;
    if (!S.next(0, cur)) return;
    f32x4 acc[2][2][4][2];
#pragma unroll
    for (int a = 0; a < 2; ++a)
#pragma unroll
        for (int b = 0; b < 2; ++b)
#pragma unroll
            for (int m = 0; m < 4; ++m)
#pragma unroll
                for (int n = 0; n < 2; ++n) acc[a][b][m][n] = (f32x4){0.f, 0.f, 0.f, 0.f};
    bf16x8 At[4][2], B0[2][2], B1[2][2];
    const char* cA = S.a_base(cur); const char* cB = S.b_base(cur);
    if constexpr (GATHER) PG8_GLOAD(0);
    PG8_STAGE(PG8_SB(0, 0), cB, voffB); PG8_STAGE_A(PG8_SA(0, 0), cA, 0); PG8_STAGE(PG8_SB(0, 1), cB + hstepB, voffB); PG8_STAGE_A(PG8_SA(0, 1), cA, 1);
    if (wr == 1) PG8_BAR;
    PG8_WAIT_V(4); PG8_BAR;
    PG8_STAGE(PG8_SB(1, 0), cB + kstep, voffB); PG8_STAGE_A(PG8_SA(1, 0), cA + kstep, 0); PG8_STAGE(PG8_SB(1, 1), cB + hstepB + kstep, voffB);
    PG8_WAIT_V(6); PG8_BAR;
    for (;;) {
        const bool has_next = S.next(ui + 1, nxt);
        const char* nA = has_next ? S.a_base(nxt) : cA; const char* nB = has_next ? S.b_base(nxt) : cB;
        for (int t = 0; t < nt; t += 2) {
            const bool last = (t == nt - 2);
            const char* a1 = cA + (size_t)(t + 1) * kstep;
            const char* a2 = last ? nA : cA + (size_t)(t + 2) * kstep; const char* b2 = last ? nB : cB + (size_t)(t + 2) * kstep;
            const char* a3 = a2 + kstep; const char* b3 = b2 + kstep;
            PG8_LDB(B0, 0, 0); PG8_SCHED; PG8_LDA(At, 0, 0); PG8_STAGE_A(PG8_SA(1, 1), a1, 1);
            PG8_WAIT_L(8); PG8_BAR; PG8_WAIT_L(0); PG8_MMA(0, 0, At, B0); PG8_BAR; PG8_SCHED;
            if constexpr (GATHER) { if (last && has_next) PG8_GLOAD(ui + 1); }
            PG8_LDB(B1, 0, 1); PG8_STAGE(PG8_SB(0, 0), b2, voffB);
            PG8_BAR; PG8_WAIT_L(0); PG8_MMA(0, 1, At, B1); PG8_BAR;
            PG8_LDA(At, 0, 1); PG8_STAGE_A(PG8_SA(0, 0), a2, 0);
            PG8_BAR; PG8_WAIT_L(0); PG8_MMA(1, 0, At, B0); PG8_BAR; PG8_SCHED;
            PG8_STAGE(PG8_SB(0, 1), b2 + hstepB, voffB);
            PG8_WAIT_V(6); PG8_BAR; PG8_MMA(1, 1, At, B1); PG8_BAR;
            PG8_LDB(B0, 1, 0); PG8_SCHED; PG8_LDA(At, 1, 0); PG8_STAGE_A(PG8_SA(0, 1), a2, 1);
            PG8_WAIT_L(8); PG8_BAR; PG8_WAIT_L(0); PG8_MMA(0, 0, At, B0); PG8_BAR; PG8_SCHED;
            PG8_LDB(B1, 1, 1); PG8_STAGE(PG8_SB(1, 0), b3, voffB);
            PG8_BAR; PG8_WAIT_L(0); PG8_MMA(0, 1, At, B1); PG8_BAR;
            PG8_LDA(At, 1, 1); PG8_STAGE_A(PG8_SA(1, 0), a3, 0);
            PG8_BAR; PG8_WAIT_L(0); PG8_MMA(1, 0, At, B0); PG8_BAR; PG8_SCHED;
            PG8_STAGE(PG8_SB(1, 1), b3 + hstepB, voffB);
            PG8_WAIT_V(6); PG8_BAR; PG8_MMA(1, 1, At, B1); PG8_BAR;
        }
        E(acc, cur, wr, wc, fr, fq);
        if (!has_next) break;
#pragma unroll
        for (int a = 0; a < 2; ++a)
#pragma unroll
            for (int b = 0; b < 2; ++b)
#pragma unroll
                for (int m = 0; m < 4; ++m)
#pragma unroll
                    for (int n = 0; n < 2; ++n) acc[a][b][m][n] = (f32x4){0.f, 0.f, 0.f, 0.f};
        cur = nxt; cA = nA; cB = nB; ++ui;
    }
    PG8_WAIT_V(0);
    if (wr == 0) PG8_BAR;
    PG8_BAR;
#undef PG8_SA
#undef PG8_SB
#undef PG8_STAGE
#undef PG8_STAGE_A
#undef PG8_LDA
#undef PG8_LDB
#undef PG8_MMA
#undef PG8_WAIT_V
#undef PG8_WAIT_L
#undef PG8_BAR
#undef PG8_SCHED
#undef PG8_GLOAD
}

struct PlainOrder {
    const char* A; const char* Bt; int lda, ldb, nM, nN, nwg, G, c;
    __device__ void init(const bf16_t* A_, int lda_, const bf16_t* Bt_, int ldb_, int nM_, int nN_) { A = (const char*)A_; Bt = (const char*)Bt_; lda = lda_; ldb = ldb_; nM = nM_; nN = nN_; nwg = nM * nN; G = gridDim.x; c = blockIdx.x; }
    __device__ __forceinline__ bool next(int i, Unit& u) const {
        const long L = (long)i * G + c; if (L >= nwg) return false;
        int wgid = (int)L; { const int q = nwg / NXCD, r = nwg % NXCD, xcd = wgid % NXCD, off = wgid / NXCD; wgid = (xcd < r ? xcd * (q + 1) : r * (q + 1) + (xcd - r) * q) + off; }
        const int nig = WGM * nN, gid = wgid / nig, fm = gid * WGM, gsz = (nM - fm) < WGM ? (nM - fm) : WGM;
        u.pm = fm + ((wgid % nig) % gsz); u.pn = (wgid % nig) / gsz; u.e = 0; u.nvalid = 256; u.slot0 = 0; return true;
    }
    __device__ __forceinline__ const char* a_base(const Unit& u) const { return A + (size_t)u.pm * 256 * lda * 2; }
    __device__ __forceinline__ const char* b_base(const Unit& u) const { return Bt + (size_t)u.pn * 256 * ldb * 2; }
    __device__ __forceinline__ const PG8_LAS int* glist(int) const { return nullptr; }
};
struct MoeOrder {
    const char* A; const char* W; const PG8_LAS int* tab; const PG8_LAS int* gl; int wrows, nunits;
    __device__ __forceinline__ bool next(int i, Unit& u) const {
        if (i >= nunits) return false;
        const PG8_LAS int* t = tab + i * 8;
        u.pm = t[0]; u.pn = t[1]; u.e = t[2]; u.nvalid = t[3]; u.slot0 = t[4]; return true;
    }
    __device__ __forceinline__ const char* a_base(const Unit& u) const { return A + (size_t)u.slot0 * 2048; }
    __device__ __forceinline__ const char* b_base(const Unit& u) const { return W + ((size_t)u.e * wrows + (size_t)u.pn * 256) * 2048; }
    __device__ __forceinline__ const PG8_LAS int* glist(int i) const { return gl + i * 256; }
};
constexpr int MOE_UNITS_MAX = 16;
__device__ __forceinline__ int moe_build_units(PG8_LAS int* tab, const int* cnt, const int* off, const int* toff, int nN) {
    const int G = gridDim.x, c = blockIdx.x, x = c & 7, j = c >> 3, per = (G >> 3) / nN, nMt = toff[32];
    const int i = threadIdx.x;
    if (i < MOE_UNITS_MAX) {
        const int pn = j % nN, mt = (i * 8 + x) * per + j / nN;
        int e = 0, valid = (mt < nMt && j < per * nN) ? 1 : 0;
        if (valid) { while (toff[e + 1] <= mt) ++e; }
        const int m = mt - toff[e];
        tab[i * 8 + 0] = mt; tab[i * 8 + 1] = pn; tab[i * 8 + 2] = e; tab[i * 8 + 3] = cnt[e] - m * 256; tab[i * 8 + 4] = off[e] + m * 256; tab[i * 8 + 5] = valid;
    }
    __syncthreads();
    int n = 0;
    while (n < MOE_UNITS_MAX && tab[n * 8 + 5]) ++n;
    return n;
}
struct MoeOrderG : MoeOrder { __device__ __forceinline__ const char* a_base(const Unit&) const { return A; } };

__device__ __forceinline__ u32x4 pk8(const f32x4& a, const f32x4& b) { return (u32x4){cvtpk(a[0], a[1]), cvtpk(a[2], a[3]), cvtpk(b[0], b[1]), cvtpk(b[2], b[3])}; }
struct EpiStore {
    static constexpr bool PERM = true;
    bf16_t* C; int ldc; const float* rs;
    __device__ __forceinline__ void operator()(const f32x4 (&acc)[2][2][4][2], const Unit& u, int wr, int wc, int fr, int fq) const {
        bf16_t* base = C + ((size_t)u.pm * 256 + wr * 64 + fr) * ldc + u.pn * 256 + wc * 32 + 8 * fq;
#pragma unroll
        for (int ai = 0; ai < 2; ++ai)
#pragma unroll
            for (int m = 0; m < 4; ++m) { bf16_t* rowp = base + (size_t)(ai * HALF + m * 16) * ldc; const float s = rs ? rs[ai * HALF + wr * 64 + m * 16 + fr] : 1.f;
#pragma unroll
                for (int bj = 0; bj < 2; ++bj) *(u32x4*)(rowp + bj * HALF) = pk8(acc[ai][bj][m][0] * s, acc[ai][bj][m][1] * s); }
    }
};
struct EpiAct {
    static constexpr bool PERM = true;
    bf16_t* Act; const float* b1all;
    __device__ __forceinline__ void operator()(const f32x4 (&acc)[2][2][4][2], const Unit& u, int wr, int wc, int fr, int fq) const {
        const int f0 = u.pn * 128 + wc * 32 + 8 * fq;
        const float* bb = b1all + (size_t)u.e * 2048 + 2 * f0;
        f32x4 bv[4];
#pragma unroll
        for (int q = 0; q < 4; ++q) bv[q] = *(const f32x4*)(bb + 4 * q);
        bf16_t* base = Act + ((size_t)u.slot0 + wr * 64 + fr) * 1024 + f0;
#pragma unroll
        for (int ai = 0; ai < 2; ++ai)
#pragma unroll
            for (int m = 0; m < 4; ++m) {
                const int r = ai * HALF + wr * 64 + m * 16 + fr;
                float a[8];
#pragma unroll
                for (int n = 0; n < 2; ++n)
#pragma unroll
                    for (int j = 0; j < 4; ++j) { const int f = 4 * n + j;
                        float glu = acc[ai][0][m][n][j] + bv[f >> 1][(f & 1) * 2], lin = acc[ai][1][m][n][j] + bv[f >> 1][(f & 1) * 2 + 1];
                        glu = fminf(glu, 7.f); lin = fminf(fmaxf(lin, -7.f), 7.f);
                        a[f] = glu * __builtin_amdgcn_rcpf(1.f + __builtin_amdgcn_exp2f(-1.702f * LOG2E * glu)) * (lin + 1.f); }
                if (r < u.nvalid) *(u32x4*)(base + (size_t)(ai * HALF + m * 16) * 1024) = (u32x4){cvtpk(a[0], a[1]), cvtpk(a[2], a[3]), cvtpk(a[4], a[5]), cvtpk(a[6], a[7])};
            }
    }
};
struct EpiBias {
    static constexpr bool PERM = true;
    bf16_t* Y; const float* b2all;
    __device__ __forceinline__ void operator()(const f32x4 (&acc)[2][2][4][2], const Unit& u, int wr, int wc, int fr, int fq) const {
        const int c0 = u.pn * 256 + wc * 32 + 8 * fq;
        const float* bb = b2all + (size_t)u.e * 1024 + c0;
        f32x4 bv[2][2];
#pragma unroll
        for (int bj = 0; bj < 2; ++bj)
#pragma unroll
            for (int n = 0; n < 2; ++n) bv[bj][n] = *(const f32x4*)(bb + bj * HALF + 4 * n);
        bf16_t* base = Y + ((size_t)u.slot0 + wr * 64 + fr) * 1024 + c0;
#pragma unroll
        for (int ai = 0; ai < 2; ++ai)
#pragma unroll
            for (int m = 0; m < 4; ++m) { const int r = ai * HALF + wr * 64 + m * 16 + fr;
                if (r < u.nvalid) {
#pragma unroll
                    for (int bj = 0; bj < 2; ++bj) *(u32x4*)(base + (size_t)(ai * HALF + m * 16) * 1024 + bj * HALF) = pk8(acc[ai][bj][m][0] + bv[bj][0], acc[ai][bj][m][1] + bv[bj][1]); } }
    }
};
}

__device__ __forceinline__ u32x4 pack8(const float (&v)[8]) { return (u32x4){cvtpk(v[0], v[1]), cvtpk(v[2], v[3]), cvtpk(v[4], v[5]), cvtpk(v[6], v[7])}; }
struct EpiPlain {
    static constexpr bool MOE1 = false;
    bf16_t* C; int ldc;
    __device__ __forceinline__ void row8(int r, int c, const float (&v)[8]) const { *(u32x4*)(C + (size_t)r * ldc + c) = pack8(v); }
    __device__ __forceinline__ void pair(int, int, const float (&)[8], const float (&)[8]) const {}
};
struct EpiRowScale {
    static constexpr bool MOE1 = false;
    bf16_t* C; int ldc; const float* rs;
    __device__ __forceinline__ void row8(int r, int c, const float (&v)[8]) const { const float s = rs[r]; float w[8];
#pragma unroll
        for (int i = 0; i < 8; ++i) w[i] = v[i] * s;
        *(u32x4*)(C + (size_t)r * ldc + c) = pack8(w); }
    __device__ __forceinline__ void pair(int, int, const float (&)[8], const float (&)[8]) const {}
};
__device__ __forceinline__ void phase_gemm_plain(const bf16_t* A, int lda, const bf16_t* Bt, int K, bf16_t* C, int ldc, int nM, int nN) {
    const int G = gridDim.x;
    for (int u = blockIdx.x; u < nM * nN; u += G) {
        const int pm = u / nN, pn = u % nN;
        int aoff[2][2], boff[2];
        gm::make_off(aoff, pm * 256, lda); gm::make_off1(boff, pn * 128, K);
        EpiPlain epi{C + (size_t)pm * 256 * ldc + pn * 128, ldc};
        gm::gemm_tile(A, aoff, Bt, boff, K / 64, epi);
    }
}

struct Row16 { float4 v[4]; };
__device__ __forceinline__ Row16 ld_row_f32(const float* p, int lane) { Row16 r;
#pragma unroll
    for (int i = 0; i < 4; ++i) r.v[i] = *(const float4*)(p + lane * 4 + 256 * i);
    return r; }
__device__ __forceinline__ Row16 ld_row_bf16(const bf16_t* p, int lane) { Row16 r;
#pragma unroll
    for (int i = 0; i < 4; ++i) { const u32x2 w = *(const u32x2*)(p + lane * 4 + 256 * i);
        r.v[i] = make_float4(__uint_as_float(w.x << 16), __uint_as_float(w.x & 0xFFFF0000u), __uint_as_float(w.y << 16), __uint_as_float(w.y & 0xFFFF0000u)); }
    return r; }
__device__ __forceinline__ void st_row_f32(float* p, int lane, const Row16& r) {
#pragma unroll
    for (int i = 0; i < 4; ++i) *(float4*)(p + lane * 4 + 256 * i) = r.v[i]; }
__device__ __forceinline__ void st_row_bf16(bf16_t* p, int lane, const Row16& r) {
#pragma unroll
    for (int i = 0; i < 4; ++i) { u32x2 w; w.x = cvtpk(r.v[i].x, r.v[i].y); w.y = cvtpk(r.v[i].z, r.v[i].w); *(u32x2*)(p + lane * 4 + 256 * i) = w; } }
__device__ __forceinline__ float row_rstd(const Row16& r) {
    float s = 0.f;
#pragma unroll
    for (int i = 0; i < 4; ++i) s += r.v[i].x * r.v[i].x + r.v[i].y * r.v[i].y + r.v[i].z * r.v[i].z + r.v[i].w * r.v[i].w;
    s = wave_sum(s);
    return rsqrtf(s * (1.f / 1024.f) + EPSN);
}
__device__ __forceinline__ Row16 norm_mod(const Row16& x, float rstd, const float* g, const float* sc, const float* sh, int lane) {
    Row16 h;
#pragma unroll
    for (int i = 0; i < 4; ++i) {
        const int c = lane * 4 + 256 * i;
        const float4 gv = *(const float4*)(g + c), scv = *(const float4*)(sc + c), shv = *(const float4*)(sh + c);
        h.v[i].x = x.v[i].x * rstd * gv.x * (1.f + scv.x) + shv.x; h.v[i].y = x.v[i].y * rstd * gv.y * (1.f + scv.y) + shv.y;
        h.v[i].z = x.v[i].z * rstd * gv.z * (1.f + scv.z) + shv.z; h.v[i].w = x.v[i].w * rstd * gv.w * (1.f + scv.w) + shv.w;
    }
    return h;
}
__device__ __forceinline__ Row16 resid_add(const Row16& x, const Row16& y, float rstd, const float* g, const float* gate, int lane) {
    Row16 o;
#pragma unroll
    for (int i = 0; i < 4; ++i) {
        const int c = lane * 4 + 256 * i;
        const float4 gv = *(const float4*)(g + c), ga = *(const float4*)(gate + c);
        o.v[i].x = x.v[i].x + y.v[i].x * rstd * gv.x * ga.x; o.v[i].y = x.v[i].y + y.v[i].y * rstd * gv.y * ga.y;
        o.v[i].z = x.v[i].z + y.v[i].z * rstd * gv.z * ga.z; o.v[i].w = x.v[i].w + y.v[i].w * rstd * gv.w * ga.w;
    }
    return o;
}
__device__ __forceinline__ const float* mod_ptr(const Params& p, int l, int r) { return (const float*)(p.ws + WS_MOD) + (size_t)(l * 2 + (r < CTXN ? 1 : 0)) * 6144; }
__device__ __forceinline__ const float* src_row(const Params& p, int r) { return r < CTXN ? p.ctx + (size_t)r * 1024 : p.x + (size_t)(r - CTXN) * 1024; }

struct ModAB { float4 a[4], b[4]; };
struct ModG { float4 g[4]; };
__device__ __forceinline__ ModAB load_ab(const float* g, const float* sc, const float* sh, int lane) { ModAB m;
#pragma unroll
    for (int i = 0; i < 4; ++i) { const int c = lane * 4 + 256 * i; const float4 gv = *(const float4*)(g + c), sv = *(const float4*)(sc + c); m.b[i] = *(const float4*)(sh + c);
        m.a[i] = make_float4(gv.x * (1.f + sv.x), gv.y * (1.f + sv.y), gv.z * (1.f + sv.z), gv.w * (1.f + sv.w)); }
    return m; }
__device__ __forceinline__ ModG load_g(const float* g, const float* gate, int lane) { ModG m;
#pragma unroll
    for (int i = 0; i < 4; ++i) { const int c = lane * 4 + 256 * i; const float4 gv = *(const float4*)(g + c), ga = *(const float4*)(gate + c); m.g[i] = make_float4(gv.x * ga.x, gv.y * ga.y, gv.z * ga.z, gv.w * ga.w); }
    return m; }
__device__ __forceinline__ Row16 apply_ab(const Row16& x, float rstd, const ModAB& m) { Row16 h;
#pragma unroll
    for (int i = 0; i < 4; ++i) h.v[i] = make_float4(x.v[i].x * rstd * m.a[i].x + m.b[i].x, x.v[i].y * rstd * m.a[i].y + m.b[i].y, x.v[i].z * rstd * m.a[i].z + m.b[i].z, x.v[i].w * rstd * m.a[i].w + m.b[i].w);
    return h; }
__device__ __forceinline__ Row16 apply_g(const Row16& x, const Row16& y, float rstd, const ModG& m) { Row16 o;
#pragma unroll
    for (int i = 0; i < 4; ++i) o.v[i] = make_float4(x.v[i].x + y.v[i].x * rstd * m.g[i].x, x.v[i].y + y.v[i].y * rstd * m.g[i].y, x.v[i].z + y.v[i].z * rstd * m.g[i].z, x.v[i].w + y.v[i].w * rstd * m.g[i].w);
    return o; }
struct RowB8 { u32x2 v[4]; };
__device__ __forceinline__ RowB8 ld_rowb(const bf16_t* p, int lane) { RowB8 r;
#pragma unroll
    for (int i = 0; i < 4; ++i) r.v[i] = *(const u32x2*)(p + lane * 4 + 256 * i);
    return r; }
__device__ __forceinline__ Row16 cvt_rowb(const RowB8& b) { Row16 r;
#pragma unroll
    for (int i = 0; i < 4; ++i) r.v[i] = make_float4(__uint_as_float(b.v[i].x << 16), __uint_as_float(b.v[i].x & 0xFFFF0000u), __uint_as_float(b.v[i].y << 16), __uint_as_float(b.v[i].y & 0xFFFF0000u));
    return r; }

__device__ __forceinline__ void phase_norm1_l0(const Params& p) {
    const int lane = threadIdx.x & 63, wave = threadIdx.x >> 6, G = gridDim.x, step = G * 8;
    bf16_t* HB = (bf16_t*)(p.ws + WS_HB);
    int r = blockIdx.x * 8 + wave;
    if (r >= NTOK) return;
    int cur_s = (r < CTXN) ? 1 : 0;
    const float* mod = mod_ptr(p, 0, r);
    ModAB m = load_ab(p.norm_g, mod + 1024, mod, lane);
    Row16 x = ld_row_f32(src_row(p, r), lane);
    for (; r < NTOK; r += step) {
        const int rn = r + step;
        Row16 xn = x;
        if (rn < NTOK) xn = ld_row_f32(src_row(p, rn), lane);
        const int s_ = (r < CTXN) ? 1 : 0;
        if (s_ != cur_s) { cur_s = s_; const float* md = mod_ptr(p, 0, r); m = load_ab(p.norm_g, md + 1024, md, lane); }
        const float rstd = row_rstd(x);
        st_row_bf16(HB + (size_t)r * 1024, lane, apply_ab(x, rstd, m));
        x = xn;
    }
}

__device__ __forceinline__ void phase_mid(const Params& p, int l) {
    const int tid = tid_opaque(), lane = tid & 63, wave = tid >> 6, G = gridDim.x;
    float* wT = (float*)smem;
    int* lcnt = (int*)(smem + 139264);
    int* lbase = lcnt + 32;
    int* sel = lbase + 32;
    {
        const float4* src = (const float4*)((const float*)(p.ws + WS_RWT) + (size_t)l * 32 * 1024);
        for (int i = tid; i < 32 * 1024 / 4; i += NTH) ((float4*)wT)[i] = src[i];
        if (tid < 32) lcnt[tid] = 0;
    }
    __syncthreads();
    const int r_begin = (l == 0) ? 0 : CTXN;
    bf16_t* HB = (bf16_t*)(p.ws + WS_HB); const bf16_t* OB = (const bf16_t*)(p.ws + WS_OB);
    float* X1 = (float*)(p.ws + WS_X1); const float* X2 = (const float*)(p.ws + WS_X2);
    const float* ng = p.norm_g + (size_t)l * 4 * 1024;
    const float* rb = p.router_b + l * 32;
    float* GATE = (float*)(p.ws + WS_GATE);
    int it = 0;
    int r = r_begin + blockIdx.x * 8 + wave;
    const int step = G * 8;
    int cur_s = -1; ModG mg; ModAB mab;
    Row16 xin; RowB8 ob;
    if (r < NTOK) { xin = (l == 0) ? ld_row_f32(src_row(p, r), lane) : ld_row_f32(X2 + (size_t)r * 1024, lane); ob = ld_rowb(OB + (size_t)r * 1024, lane); }
    for (; r < NTOK; r += step, ++it) {
        const int rn = r + step;
        Row16 xin_n = xin; RowB8 ob_n = ob;
        if (rn < NTOK) { xin_n = (l == 0) ? ld_row_f32(src_row(p, rn), lane) : ld_row_f32(X2 + (size_t)rn * 1024, lane); ob_n = ld_rowb(OB + (size_t)rn * 1024, lane); }
        const int s_ = (r < CTXN) ? 1 : 0;
        if (s_ != cur_s) { cur_s = s_; const float* mod = mod_ptr(p, l, r); mg = load_g(ng + 1024, mod + 2048, lane); mab = load_ab(ng + 2048, mod + 4096, mod + 3072, lane); }
        const Row16 o = cvt_rowb(ob);
        const float rso = row_rstd(o);
        const Row16 x1 = apply_g(xin, o, rso, mg);
        st_row_f32(X1 + (size_t)r * 1024, lane, x1);
        const float rs1 = row_rstd(x1);
        const Row16 h = apply_ab(x1, rs1, mab);
        st_row_bf16(HB + (size_t)r * 1024, lane, h);
        xin = xin_n; ob = ob_n;
        float part[32];
        {
            const float* wl = wT + lane * 4;
            float4 wa[4], wb[4];
#pragma unroll
            for (int i = 0; i < 4; ++i) wa[i] = *(const float4*)(wl + 256 * i);
#pragma unroll
            for (int e = 0; e < 32; e += 2) {
#pragma unroll
                for (int i = 0; i < 4; ++i) wb[i] = *(const float4*)(wl + (e + 1) * 1024 + 256 * i);
                { float a = 0.f;
#pragma unroll
                  for (int i = 0; i < 4; ++i) a += h.v[i].x * wa[i].x + h.v[i].y * wa[i].y + h.v[i].z * wa[i].z + h.v[i].w * wa[i].w;
                  part[e] = a; }
                if (e + 2 < 32) {
#pragma unroll
                    for (int i = 0; i < 4; ++i) wa[i] = *(const float4*)(wl + (e + 2) * 1024 + 256 * i);
                }
                { float a = 0.f;
#pragma unroll
                  for (int i = 0; i < 4; ++i) a += h.v[i].x * wb[i].x + h.v[i].y * wb[i].y + h.v[i].z * wb[i].z + h.v[i].w * wb[i].w;
                  part[e + 1] = a; }
            }
        }
#define TR_STEP(NV, BIT) _Pragma("unroll") for (int i = 0; i < (NV) / 2; ++i) { const float lo = part[i], hi_ = part[i + (NV) / 2]; const bool up = (lane & (BIT)) != 0; \
            const float send = up ? lo : hi_, keep = up ? hi_ : lo; part[i] = keep + __shfl_xor(send, (BIT)); }
        TR_STEP(32, 32) TR_STEP(16, 16) TR_STEP(8, 8) TR_STEP(4, 4) TR_STEP(2, 2)
#undef TR_STEP
        float logit = part[0] + __shfl_xor(part[0], 1);
        const int myexp = lane >> 1;
        logit += rb[myexp];
        float val = (lane & 1) ? -3.0e38f : logit;
        float tv[4]; int ti[4];
#pragma unroll
        for (int k = 0; k < 4; ++k) {
            float bv = val; int bi = myexp;
#pragma unroll
            for (int off = 32; off >= 1; off >>= 1) { const float ov = __shfl_xor(bv, off); const int oi = __shfl_xor(bi, off); if (ov > bv || (ov == bv && oi < bi)) { bv = ov; bi = oi; } }
            tv[k] = bv; ti[k] = bi;
            if (myexp == bi) val = -3.0e38f;
        }
        const float e1 = __expf(tv[1] - tv[0]), e2 = __expf(tv[2] - tv[0]), e3 = __expf(tv[3] - tv[0]);
        const float inv = 1.f / (1.f + e1 + e2 + e3);
        if (lane < 4) {
            const int k = lane;
            const int e = (k == 0) ? ti[0] : (k == 1) ? ti[1] : (k == 2) ? ti[2] : ti[3];
            const float gk = ((k == 0) ? 1.f : (k == 1) ? e1 : (k == 2) ? e2 : e3) * inv;
            GATE[(size_t)r * 4 + k] = gk;
            const int lp = atomicAdd(&lcnt[e], 1);
            sel[(it * 8 + wave) * 4 + k] = e | (lp << 8);
        }
    }
    __syncthreads();
    int* CNT = (int*)(p.ws + WS_CNT) + l * 32;
    if (tid < 32) lbase[tid] = atomicAdd(&CNT[tid], lcnt[tid]);
    __syncthreads();
    {
        int* TOPE = (int*)(p.ws + WS_TOPE); int* TOPP = (int*)(p.ws + WS_TOPP); int* LIST = (int*)(p.ws + WS_LIST);
        for (int q = tid; q < 80 * 4; q += NTH) {
            const int slot = q >> 2, k = q & 3, itq = slot >> 3, wv = slot & 7;
            const int r = r_begin + blockIdx.x * 8 + wv + itq * G * 8;
            if (r < NTOK) {
                const int s = sel[q], e = s & 255, lp = s >> 8, pos = lbase[e] + lp;
                TOPE[(size_t)r * 4 + k] = e; TOPP[(size_t)r * 4 + k] = pos; LIST[(size_t)e * NTOK + pos] = r;
            }
        }
    }
    __syncthreads();
}

struct MoeLds { int* cnt; int* off; int* toff; };
__device__ __forceinline__ MoeLds moe_setup(const Params& p, int l, char* base) {
    MoeLds m; m.cnt = (int*)base; m.off = m.cnt + 32; m.toff = m.off + 33;
    const int tid = tid_opaque();
    if (tid < 64) {
        const int e = tid & 31;
        const int cval = ((const int*)(p.ws + WS_CNT))[l * 32 + e];
        const int tiles = (cval + 255) >> 8;
        int pc = cval, pt = tiles;
#pragma unroll
        for (int o = 1; o < 32; o <<= 1) { const int a = __shfl_up(pc, o, 32), b = __shfl_up(pt, o, 32); if (e >= o) { pc += a; pt += b; } }
        if (tid < 32) { m.cnt[e] = cval; m.off[e + 1] = pc; m.toff[e + 1] = pt; if (e == 0) { m.off[0] = 0; m.toff[0] = 0; } }
    }
    __syncthreads();
    return m;
}

__device__ __forceinline__ void phase_end(const Params& p, int l) {
    const int tid = tid_opaque(), lane = tid & 63, wave = tid >> 6, G = gridDim.x;
    MoeLds ml = moe_setup(p, l, smem);
    const int r_begin = (l == 0) ? 0 : CTXN;
    const bf16_t* YB = (const bf16_t*)(p.ws + WS_YB);
    const float* X1 = (const float*)(p.ws + WS_X1); float* X2 = (float*)(p.ws + WS_X2);
    bf16_t* HB = (bf16_t*)(p.ws + WS_HB);
    const int* TOPE = (const int*)(p.ws + WS_TOPE); const int* TOPP = (const int*)(p.ws + WS_TOPP); const float* GATE = (const float*)(p.ws + WS_GATE);
    const float* ng = p.norm_g + (size_t)l * 4 * 1024;
    int cur_s = -1; ModG mg; ModAB mab;
    int r = r_begin + blockIdx.x * 8 + wave;
    int4 en = make_int4(0, 0, 0, 0), pn = make_int4(0, 0, 0, 0); float4 gn = make_float4(0.f, 0.f, 0.f, 0.f);
    const int step = G * 8;
    if (r < NTOK) { en = *(const int4*)(TOPE + (size_t)r * 4); pn = *(const int4*)(TOPP + (size_t)r * 4); gn = *(const float4*)(GATE + (size_t)r * 4); }
    RowB8 t4n[4]; Row16 x1n; float4 gcur = gn;
    if (r < NTOK) {
        t4n[0] = ld_rowb(YB + (size_t)(ml.off[en.x] + pn.x) * 1024, lane); t4n[1] = ld_rowb(YB + (size_t)(ml.off[en.y] + pn.y) * 1024, lane);
        t4n[2] = ld_rowb(YB + (size_t)(ml.off[en.z] + pn.z) * 1024, lane); t4n[3] = ld_rowb(YB + (size_t)(ml.off[en.w] + pn.w) * 1024, lane);
        x1n = ld_row_f32(X1 + (size_t)r * 1024, lane);
        if (r + step < NTOK) { en = *(const int4*)(TOPE + (size_t)(r + step) * 4); pn = *(const int4*)(TOPP + (size_t)(r + step) * 4); gn = *(const float4*)(GATE + (size_t)(r + step) * 4); }
    }
    for (; r < NTOK; r += step) {
        RowB8 t4[4]; t4[0] = t4n[0]; t4[1] = t4n[1]; t4[2] = t4n[2]; t4[3] = t4n[3];
        const Row16 x1 = x1n;
        const float g4[4] = {gcur.x, gcur.y, gcur.z, gcur.w};
        const int rn = r + step;
        if (rn < NTOK) {
            t4n[0] = ld_rowb(YB + (size_t)(ml.off[en.x] + pn.x) * 1024, lane); t4n[1] = ld_rowb(YB + (size_t)(ml.off[en.y] + pn.y) * 1024, lane);
            t4n[2] = ld_rowb(YB + (size_t)(ml.off[en.z] + pn.z) * 1024, lane); t4n[3] = ld_rowb(YB + (size_t)(ml.off[en.w] + pn.w) * 1024, lane);
            x1n = ld_row_f32(X1 + (size_t)rn * 1024, lane);
            gcur = gn;
            if (rn + step < NTOK) { en = *(const int4*)(TOPE + (size_t)(rn + step) * 4); pn = *(const int4*)(TOPP + (size_t)(rn + step) * 4); gn = *(const float4*)(GATE + (size_t)(rn + step) * 4); }
        }
        const int s_ = (r < CTXN) ? 1 : 0;
        if (s_ != cur_s) { cur_s = s_; const float* mod = mod_ptr(p, l, r); mg = load_g(ng + 3072, mod + 5120, lane);
            if (l == 0) { const float* mod1 = mod_ptr(p, 1, r); mab = load_ab(p.norm_g + (size_t)4 * 1024, mod1 + 1024, mod1, lane); } }
        Row16 y;
#pragma unroll
        for (int i = 0; i < 4; ++i) y.v[i] = make_float4(0.f, 0.f, 0.f, 0.f);
#pragma unroll
        for (int k = 0; k < 4; ++k) { const Row16 t = cvt_rowb(t4[k]); const float gk = g4[k];
#pragma unroll
            for (int i = 0; i < 4; ++i) { y.v[i].x += gk * t.v[i].x; y.v[i].y += gk * t.v[i].y; y.v[i].z += gk * t.v[i].z; y.v[i].w += gk * t.v[i].w; } }
        const float rsy = row_rstd(y);
        const Row16 x2 = apply_g(x1, y, rsy, mg);
        if (l == 0) {
            st_row_f32(X2 + (size_t)r * 1024, lane, x2);
            const float rs2 = row_rstd(x2);
            st_row_bf16(HB + (size_t)r * 1024, lane, apply_ab(x2, rs2, mab));
        } else {
            st_row_f32(p.out + (size_t)(r - CTXN) * 1024, lane, x2);
        }
    }
    __syncthreads();
}

__device__ __forceinline__ void phase_gemm_pg8(const bf16_t* A, int lda, const bf16_t* Bt, int K, bf16_t* C, int ldc, int nM, int nN) {
    pg8::PlainOrder S; S.init(A, lda, Bt, K, nM, nN);
    pg8::EpiStore E{C, ldc, nullptr};
    pg8::gemm_phase<pg8::EpiStore, pg8::PlainOrder, false>((PG8_LAS unsigned char*)smem, S, E, K, lda, K);
    __syncthreads();
}
constexpr int MOE_GL_OFF = 131072, MOE_ML_OFF = 143360, MOE_TAB_OFF = 143872, MOE_GL_MAX = 12;
__device__ __forceinline__ void phase_moe1(const Params& p, int l) {
    MoeLds ml = moe_setup(p, l, smem + MOE_ML_OFF);
    const int tid = tid_opaque();
    PG8_LAS int* gl = (PG8_LAS int*)(smem + MOE_GL_OFF);
    PG8_LAS int* tab = (PG8_LAS int*)(smem + MOE_TAB_OFF);
    pg8::MoeOrderG S;
    S.A = (const char*)(p.ws + WS_HB); S.W = (const char*)(p.ws + WS_W1T) + (size_t)l * 32 * 2048 * 2048;
    S.tab = tab; S.gl = gl; S.wrows = 2048;
    S.nunits = pg8::moe_build_units(tab, ml.cnt, ml.off, ml.toff, 8);
    if (S.nunits > MOE_GL_MAX) S.nunits = MOE_GL_MAX;
    const int* LIST = (const int*)(p.ws + WS_LIST);
    for (int i = 0; i < S.nunits; ++i) {
        const int e = tab[i * 8 + 2], mt = tab[i * 8 + 0], nvalid = tab[i * 8 + 3], m = mt - ml.toff[e];
        if (tid < 256) gl[i * 256 + tid] = (tid < nvalid) ? LIST[(size_t)e * NTOK + m * 256 + tid] : 0;
    }
    __syncthreads();
    pg8::EpiAct E{(bf16_t*)(p.ws + WS_ACT), p.moe_b1 + (size_t)l * 32 * 2048};
    pg8::gemm_phase<pg8::EpiAct, pg8::MoeOrderG, true>((PG8_LAS unsigned char*)smem, S, E, 1024, 1024, 1024);
    __syncthreads();
}
__device__ __forceinline__ void phase_moe2(const Params& p, int l) {
    MoeLds ml = moe_setup(p, l, smem + MOE_ML_OFF);
    PG8_LAS int* tab = (PG8_LAS int*)(smem + MOE_TAB_OFF);
    pg8::MoeOrder S;
    S.A = (const char*)(p.ws + WS_ACT); S.W = (const char*)(p.ws + WS_W2T) + (size_t)l * 32 * 1024 * 2048;
    S.tab = tab; S.gl = nullptr; S.wrows = 1024;
    S.nunits = pg8::moe_build_units(tab, ml.cnt, ml.off, ml.toff, 4);
    pg8::EpiBias E{(bf16_t*)(p.ws + WS_YB), p.moe_b2 + (size_t)l * 32 * 1024};
    pg8::gemm_phase<pg8::EpiBias, pg8::MoeOrder, false>((PG8_LAS unsigned char*)smem, S, E, 1024, 1024, 1024);
    __syncthreads();
}

__device__ __forceinline__ void gla_local_units(const Params& p);
__device__ __forceinline__ void rope8(const float* rope, int t, int j0, const u32x4& a, const u32x4& b, u32x4& oa, u32x4& ob);
__device__ __forceinline__ void rowstat(const bf16_t* A, int lda, int K, float* rs) {
    const int tid = tid_opaque(), r = tid >> 1, hf = tid & 1, half = K / 2;
    const bf16_t* q = A + (size_t)r * lda + hf * half;
    float s = 0.f;
    for (int i = 0; i < half; i += 8) { const u32x4 w = *(const u32x4*)(q + i);
#pragma unroll
        for (int j = 0; j < 4; ++j) { const float a = __uint_as_float(w[j] << 16), b = __uint_as_float(w[j] & 0xFFFF0000u); s += a * a + b * b; } }
    s += __shfl_xor(s, 1);
    if (hf == 0) rs[r] = rsqrtf(s / (float)K + EPSN);
    __syncthreads();
}
__device__ __forceinline__ void phase_mla_up(const Params& p) {
    const int G = gridDim.x, tid = threadIdx.x;
    const bf16_t* P = (const bf16_t*)(p.ws + WS_P);
    float* rs = (float*)(smem + 139264);
    const int nM = NTOK / 256;
    {
        pg8::PlainOrder S; S.init(P + PC_CQ, PW, (const bf16_t*)(p.ws + WS_WUQ), 256, nM, 3);
        pg8::Unit u;
        if (S.next(0, u)) rowstat(P + (size_t)u.pm * 256 * PW + PC_CQ, PW, 256, rs);
        pg8::EpiStore E{(bf16_t*)(p.ws + WS_QM), 768, rs};
        pg8::gemm_phase<pg8::EpiStore, pg8::PlainOrder, false>((PG8_LAS unsigned char*)smem, S, E, 256, PW, 256);
        __syncthreads();
    }
    for (int v = (blockIdx.x + G - 195) % G; v < nM * 8; v += G) {
        int aoff[2][2], boff[2];
        const int pm = v >> 3, pn = v & 7, h = pn >> 1;
        rowstat(P + (size_t)pm * 256 * PW + PC_CKV, PW, 128, rs);
        gm::make_off(aoff, pm * 256, PW); gm::make_off1(boff, pn * 128, 128);
        bf16_t* dst = (pn & 1) ? (bf16_t*)(p.ws + WS_VM) + (size_t)pm * 256 * 512 + h * 128 : (bf16_t*)(p.ws + WS_KM) + (size_t)pm * 256 * 768 + h * 192;
        EpiRowScale epi{dst, (pn & 1) ? 512 : 768, rs};
        gm::gemm_tile(P + PC_CKV, aoff, (const bf16_t*)(p.ws + WS_WUKV), boff, 2, epi);
    }
    const float* rope = (const float*)(p.ws + WS_ROPE);
    bf16_t* KM = (bf16_t*)(p.ws + WS_KM);
    for (int i = blockIdx.x * NTH + tid; i < NTOK * 4; i += G * NTH) {
        const int r = i >> 2, j0 = (i & 3) * 8;
        const u32x4 a = *(const u32x4*)(P + (size_t)r * PW + PC_KR + j0), b = *(const u32x4*)(P + (size_t)r * PW + PC_KR + 32 + j0);
        u32x4 oa = a, ob = b;
        if (r >= CTXN) rope8(rope, r - CTXN, j0, a, b, oa, ob);
#pragma unroll
        for (int h = 0; h < 4; ++h) { *(u32x4*)(KM + (size_t)r * 768 + h * 192 + 128 + j0) = oa; *(u32x4*)(KM + (size_t)r * 768 + h * 192 + 160 + j0) = ob; }
    }
    __syncthreads();
    gla_local_units(p);
}

struct GlaB { float b[16]; float total; };
__device__ __forceinline__ GlaB gla_decay(const Params& p, int gc, int h, float* scr  ) {
    const int tid = threadIdx.x, lane = tid & 63, wave = tid >> 6, dir = wave & 1, tq = wave >> 1;
    const bf16_t* P = (const bf16_t*)(p.ws + WS_P);
    float* af = scr;
    float* wa = scr + 2048;
    float* ba = scr + 4096;
    float* tot = scr + 4224;
#pragma unroll
    for (int i = 0; i < 4; ++i) {
        const int idx = tid + 512 * i, dd = idx >> 10, t = (idx >> 4) & 63, j = idx & 15;
        af[idx] = bf2f(P[(size_t)(gc * 64 + t) * PW + PC_AF + dd * 16 + j]);
        const int jj = (idx >> 6) & 15, d = idx & 63;
        wa[idx] = (dd == 0 ? p.gla_wa_f : p.gla_wa_b)[jj * 256 + h * 64 + d];
    }
    if (tid < 128) ba[tid] = ((tid >> 6) == 0 ? p.gla_ba_f : p.gla_ba_b)[h * 64 + (tid & 63)];
    __syncthreads();
    float w[16];
#pragma unroll
    for (int j = 0; j < 16; ++j) w[j] = wa[(dir * 16 + j) * 64 + lane];
    const float bias = ba[dir * 64 + lane];
    GlaB r;
#pragma unroll
    for (int i = 0; i < 16; ++i) {
        const int t = tq * 16 + i;
        float z = bias;
#pragma unroll
        for (int j = 0; j < 16; ++j) z += af[(dir * 64 + t) * 16 + j] * w[j];
        const float g = (fminf(z, 0.f) - __logf(1.f + __expf(-fabsf(z)))) * (1.f / 16.f);
        r.b[i] = g;
    }
    if (dir == 0) {
#pragma unroll
        for (int i = 1; i < 16; ++i) r.b[i] += r.b[i - 1];
        tot[(dir * 4 + tq) * 64 + lane] = r.b[15];
    } else {
#pragma unroll
        for (int i = 14; i >= 0; --i) r.b[i] += r.b[i + 1];
        tot[(dir * 4 + tq) * 64 + lane] = r.b[0];
    }
    __syncthreads();
    float offs = 0.f, total = 0.f;
#pragma unroll
    for (int q = 0; q < 4; ++q) { const float tv = tot[(dir * 4 + q) * 64 + lane]; total += tv; if (dir == 0 ? (q < tq) : (q > tq)) offs += tv; }
#pragma unroll
    for (int i = 0; i < 16; ++i) r.b[i] += offs;
    r.total = total;
    return r;
}

__device__ __forceinline__ void gla_stage_vt(const bf16_t* P, int gc, int h, bf16_t* VT) {
    const int tid = threadIdx.x, v = tid & 127, sq = tid >> 7;
    unsigned pk[8];
#pragma unroll
    for (int i = 0; i < 8; ++i) {
        const bf16_t a = P[(size_t)(gc * 64 + sq * 16 + 2 * i) * PW + PC_V + h * 128 + v], b = P[(size_t)(gc * 64 + sq * 16 + 2 * i + 1) * PW + PC_V + h * 128 + v];
        pk[i] = a | ((unsigned)b << 16);
    }
    *(u32x4*)(VT + v * 72 + sq * 16) = (u32x4){pk[0], pk[1], pk[2], pk[3]};
    *(u32x4*)(VT + v * 72 + sq * 16 + 8) = (u32x4){pk[4], pk[5], pk[6], pk[7]};
}

struct GlaPreL { u32x4 kc, vc[2], ac; float4 wac; float bac; };
__device__ __forceinline__ void gla_prefetch_local(const Params& p, int gc, int h, GlaPreL& g) {
    const int tid = threadIdx.x;
    const bf16_t* P = (const bf16_t*)(p.ws + WS_P);
    g.kc = *(const u32x4*)(P + (size_t)(gc * 64 + (tid >> 3)) * PW + PC_K + h * 64 + (tid & 7) * 8);
#pragma unroll
    for (int i = 0; i < 2; ++i) { const int idx = tid + 512 * i; g.vc[i] = *(const u32x4*)(P + (size_t)(gc * 64 + (idx >> 4)) * PW + PC_V + h * 128 + (idx & 15) * 8); }
    g.ac = *(const u32x4*)(P + (size_t)(gc * 64 + ((tid & 255) >> 2)) * PW + PC_AF + (tid & 3) * 8);
    { const int dd = tid >> 8, jj = (tid >> 4) & 15, d4 = tid & 15; g.wac = *(const float4*)((dd == 0 ? p.gla_wa_f : p.gla_wa_b) + jj * 256 + h * 64 + d4 * 4); }
    g.bac = ((tid >> 6) & 1 ? p.gla_ba_b : p.gla_ba_f)[h * 64 + (tid & 63)];
}
template <int OFF> __device__ __forceinline__ s16x4 glal_tr(int vb) { s16x4 r; asm volatile("ds_read_b64_tr_b16 %0, %1 offset:%2" : "=&v"(r) : "v"(vb), "i"(OFF) : "memory"); return r; }
__device__ __forceinline__ void gla_local_units(const Params& p) {
    const int tid = threadIdx.x, lane = tid & 63, wave = tid >> 6, r32 = lane & 31, hi = lane >> 5, G = gridDim.x;
    bf16_t* kdT = (bf16_t*)smem;
    bf16_t* Kraw = kdT + 2 * 64 * 72;
    char* Vraw = smem + 27648;
    float* af = (float*)(smem + 49152);
    float* wa = af + 2048; float* ba = wa + 2048; float* tot = ba + 128;
    bf16_t* U = (bf16_t*)(p.ws + WS_U); float* DEC = (float*)(p.ws + WS_DEC);
    int u = blockIdx.x;
    if (u >= NCH * 4) return;
    GlaPreL g;
    gla_prefetch_local(p, u >> 2, u & 3, g);
    const int dir = wave & 1, tq = wave >> 1;
    for (; u < NCH * 4; u += G) {
        const int gc = u >> 2, h = u & 3;
        *(u32x4*)(Kraw + (tid >> 3) * 72 + (tid & 7) * 8) = g.kc;
#pragma unroll
        for (int i = 0; i < 2; ++i) { const int idx = tid + 512 * i; *(u32x4*)(Vraw + (idx >> 4) * 320 + (idx & 15) * 16) = g.vc[i]; }
        if (tid < 256) { const int t = tid >> 2, ch = tid & 3, dd = ch >> 1, j0 = (ch & 1) * 8; float* q = af + dd * 1024 + t * 16 + j0;
#pragma unroll
            for (int e = 0; e < 4; ++e) { q[2 * e] = __uint_as_float(g.ac[e] << 16); q[2 * e + 1] = __uint_as_float(g.ac[e] & 0xFFFF0000u); } }
        { const int dd = tid >> 8, jj = (tid >> 4) & 15, d4 = tid & 15; *(float4*)(wa + (dd * 16 + jj) * 64 + d4 * 4) = g.wac; }
        if (tid < 128) ba[tid] = g.bac;
        __syncthreads();
        const int un = u + G;
        if (un < NCH * 4) gla_prefetch_local(p, un >> 2, un & 3, g);
        float bb[16]; float total = 0.f;
        {
            float w[16];
#pragma unroll
            for (int j = 0; j < 16; ++j) w[j] = wa[(dir * 16 + j) * 64 + lane];
            const float bias = ba[dir * 64 + lane];
#pragma unroll
            for (int i = 0; i < 16; ++i) {
                const int t = tq * 16 + i;
                float z = bias;
#pragma unroll
                for (int j = 0; j < 16; ++j) z += af[(dir * 64 + t) * 16 + j] * w[j];
                bb[i] = (fminf(z, 0.f) - __logf(1.f + __expf(-fabsf(z)))) * (1.f / 16.f);
            }
            if (dir == 0) {
#pragma unroll
                for (int i = 1; i < 16; ++i) bb[i] += bb[i - 1];
                tot[(dir * 4 + tq) * 64 + lane] = bb[15];
            } else {
#pragma unroll
                for (int i = 14; i >= 0; --i) bb[i] += bb[i + 1];
                tot[(dir * 4 + tq) * 64 + lane] = bb[0];
            }
        }
        __syncthreads();
        {
            float offs = 0.f;
#pragma unroll
            for (int q = 0; q < 4; ++q) { const float tv = tot[(dir * 4 + q) * 64 + lane]; total += tv; if (dir == 0 ? (q < tq) : (q > tq)) offs += tv; }
#pragma unroll
            for (int i = 0; i < 16; ++i) bb[i] += offs;
        }
        {
            unsigned pk[8];
#pragma unroll
            for (int i = 0; i < 8; ++i) {
                const int s0 = tq * 16 + 2 * i;
                const float k0 = bf2f(Kraw[s0 * 72 + lane]), k1 = bf2f(Kraw[(s0 + 1) * 72 + lane]);
                pk[i] = cvtpk(k0 * __expf(total - bb[2 * i]), k1 * __expf(total - bb[2 * i + 1]));
            }
            *(u32x4*)(kdT + (dir * 64 + lane) * 72 + tq * 16) = (u32x4){pk[0], pk[1], pk[2], pk[3]};
            *(u32x4*)(kdT + (dir * 64 + lane) * 72 + tq * 16 + 8) = (u32x4){pk[4], pk[5], pk[6], pk[7]};
            if (tq == 0) DEC[((size_t)(dir * NCH + gc) * 4 + h) * 64 + lane] = __expf(total);
        }
        __syncthreads();
        {
            const int mdir = wave >> 2, vbk = wave & 3;
            const int vb = (int)(uintptr_t)Vraw + (8 * hi + ((lane & 15) >> 2)) * 320 + (vbk * 32 + 16 * ((lane >> 4) & 1) + 4 * (lane & 3)) * 2;
            f32x16 a0 = {}, a1 = {};
#define GLAL_STEP(KS) do { const s16x4 l_ = glal_tr<(KS) * 5120>(vb), h_ = glal_tr<(KS) * 5120 + 1280>(vb); \
            const bf16x8 b0 = *(const bf16x8*)(kdT + (mdir * 64 + r32) * 72 + (KS) * 16 + hi * 8); \
            const bf16x8 b1 = *(const bf16x8*)(kdT + (mdir * 64 + 32 + r32) * 72 + (KS) * 16 + hi * 8); \
            asm volatile("s_waitcnt lgkmcnt(0)" ::: "memory"); SBAR(); \
            const bf16x8 a_ = (bf16x8){l_[0], l_[1], l_[2], l_[3], h_[0], h_[1], h_[2], h_[3]}; \
            a0 = __builtin_amdgcn_mfma_f32_32x32x16_bf16(a_, b0, a0, 0, 0, 0); a1 = __builtin_amdgcn_mfma_f32_32x32x16_bf16(a_, b1, a1, 0, 0, 0); } while (0)
            GLAL_STEP(0); GLAL_STEP(1); GLAL_STEP(2); GLAL_STEP(3);
#undef GLAL_STEP
            bf16_t* Uo = U + ((size_t)(mdir * NCH + gc) * 4 + h) * 8192;
#pragma unroll
            for (int r = 0; r < 16; ++r) { const int v = vbk * 32 + crow(r, hi); Uo[v * 64 + r32] = f2bf(a0[r]); Uo[v * 64 + 32 + r32] = f2bf(a1[r]); }
        }
        __syncthreads();
    }
}
__device__ __forceinline__ void rope8(const float* rope, int t, int j0, const u32x4& a, const u32x4& b, u32x4& oa, u32x4& ob) {
    const int row = t >> 6, col = t & 63;
    const float* cs = (j0 < 16) ? rope + row * 16 + j0 : rope + 512 * 16 + col * 16 + (j0 - 16);
    const float* sn = (j0 < 16) ? rope + 256 * 16 + row * 16 + j0 : rope + 512 * 16 + 64 * 16 + col * 16 + (j0 - 16);
    const f32x4 c0 = *(const f32x4*)cs, c1 = *(const f32x4*)(cs + 4), s0 = *(const f32x4*)sn, s1 = *(const f32x4*)(sn + 4);
#pragma unroll
    for (int e = 0; e < 4; ++e) {
        const float x1l = __uint_as_float(a[e] << 16), x1h = __uint_as_float(a[e] & 0xFFFF0000u), x2l = __uint_as_float(b[e] << 16), x2h = __uint_as_float(b[e] & 0xFFFF0000u);
        const float cl = (e < 2) ? c0[2 * e] : c1[2 * e - 4], ch = (e < 2) ? c0[2 * e + 1] : c1[2 * e - 3], sl = (e < 2) ? s0[2 * e] : s1[2 * e - 4], sh = (e < 2) ? s0[2 * e + 1] : s1[2 * e - 3];
        oa[e] = cvtpk(x1l * cl - x2l * sl, x1h * ch - x2h * sh);
        ob[e] = cvtpk(x1l * sl + x2l * cl, x1h * sh + x2h * ch);
    }
}
__device__ __forceinline__ void qrope_pass(const Params& p, int b0, int nb) {
    const int tid = threadIdx.x;
    const float* rope = (const float*)(p.ws + WS_ROPE);
    bf16_t* QM = (bf16_t*)(p.ws + WS_QM);
    for (int i = (blockIdx.x - b0) * NTH + tid; i < SEQ * 16; i += nb * NTH) {
        const int t = i >> 4, hh = (i >> 2) & 3, j0 = (i & 3) * 8;
        bf16_t* q = QM + (size_t)(CTXN + t) * 768 + hh * 192 + 128 + j0;
        const u32x4 a = *(const u32x4*)q, b = *(const u32x4*)(q + 32);
        u32x4 oa, ob; rope8(rope, t, j0, a, b, oa, ob);
        *(u32x4*)q = oa; *(u32x4*)(q + 32) = ob;
    }
}

__device__ __forceinline__ int gla_order(int dir, int step) { return dir == 0 ? step : (step < 4 ? 3 - step : NCH - 1 - (step - 4)); }
__device__ __forceinline__ void phase_gla_scan(const Params& p) {
    const int gid = blockIdx.x * NTH + threadIdx.x;
    if (gid >= 2 * 4 * 8192) { qrope_pass(p, 128, (int)gridDim.x - 128); return; }
    const int dir = gid >> 15, h = (gid >> 13) & 3, e = gid & 8191, d = e & 63;
    const bf16_t* U = (const bf16_t*)(p.ws + WS_U); bf16_t* S = (bf16_t*)(p.ws + WS_SIN); const float* DEC = (const float*)(p.ws + WS_DEC);
    float s = 0.f;
#pragma unroll 1
    for (int s0 = 0; s0 < NCH; s0 += 52) {
        float uu[52], dc[52];
#pragma unroll
        for (int i = 0; i < 52; ++i) { const size_t o = ((size_t)(dir * NCH + gla_order(dir, s0 + i)) * 4 + h); uu[i] = bf2f(U[o * 8192 + e]); dc[i] = DEC[o * 64 + d]; }
#pragma unroll
        for (int i = 0; i < 52; ++i) { const size_t o = ((size_t)(dir * NCH + gla_order(dir, s0 + i)) * 4 + h); S[o * 8192 + e] = f2bf(s); s = dc[i] * s + uu[i]; }
    }
}

__device__ __forceinline__ void gla_out_unit(const Params& p, int gc, int h) {
    const int tid = threadIdx.x, lane = tid & 63, wave = tid >> 6, r32 = lane & 31, hi = lane >> 5;
    const bf16_t* P = (const bf16_t*)(p.ws + WS_P);
    bf16_t* qe = (bf16_t*)smem;
    bf16_t* ke = qe + 2 * 64 * 72;
    bf16_t* Am = ke + 2 * 64 * 72;
    bf16_t* VT = Am + 2 * 64 * 72;
    bf16_t* ST = VT + 128 * 72;
    float* scr = (float*)(smem + 110592);
    float* ob = (float*)(ke);
    const GlaB gb = gla_decay(p, gc, h, scr);
    {
        const int dir = wave & 1, tq = wave >> 1;
#pragma unroll
        for (int i = 0; i < 16; ++i) {
            const int t = tq * 16 + i;
            const float qv = bf2f(P[(size_t)(gc * 64 + t) * PW + PC_Q + h * 64 + lane]) * 0.125f, kv = bf2f(P[(size_t)(gc * 64 + t) * PW + PC_K + h * 64 + lane]);
            qe[(dir * 64 + t) * 72 + lane] = f2bf(qv * __expf(gb.b[i]));
            ke[(dir * 64 + t) * 72 + lane] = f2bf(kv * __expf(-gb.b[i]));
        }
    }
    gla_stage_vt(P, gc, h, VT);
    {
        const bf16_t* S = (const bf16_t*)(p.ws + WS_SIN);
#pragma unroll
        for (int i = 0; i < 4; ++i) {
            const int cc = tid + 512 * i, dir = cc >> 10, v = (cc >> 3) & 127, ch = cc & 7;
            *(u32x4*)(ST + (dir * 128 + v) * 72 + ch * 8) = *(const u32x4*)(S + ((size_t)(dir * NCH + gc) * 4 + h) * 8192 + v * 64 + ch * 8);
        }
    }
    __syncthreads();
    {
        const int dir = wave >> 2, tb = (wave >> 1) & 1, sb = wave & 1;
        f32x16 acc = {};
#pragma unroll
        for (int ks = 0; ks < 4; ++ks) {
            const bf16x8 a = *(const bf16x8*)(qe + (dir * 64 + tb * 32 + r32) * 72 + ks * 16 + hi * 8);
            const bf16x8 b = *(const bf16x8*)(ke + (dir * 64 + sb * 32 + r32) * 72 + ks * 16 + hi * 8);
            acc = __builtin_amdgcn_mfma_f32_32x32x16_bf16(a, b, acc, 0, 0, 0);
        }
        const int s = sb * 32 + r32;
#pragma unroll
        for (int r = 0; r < 16; ++r) { const int t = tb * 32 + crow(r, hi); const bool keep = (dir == 0) ? (s <= t) : (s >= t); Am[(dir * 64 + t) * 72 + s] = f2bf(keep ? acc[r] : 0.f); }
    }
    __syncthreads();
    f32x16 o = {};
    const int tb = wave >> 2, vb = wave & 3;
#pragma unroll
    for (int dir = 0; dir < 2; ++dir)
#pragma unroll
        for (int ks = 0; ks < 4; ++ks) {
            const bf16x8 a1 = *(const bf16x8*)(Am + (dir * 64 + tb * 32 + r32) * 72 + ks * 16 + hi * 8);
            const bf16x8 b1 = *(const bf16x8*)(VT + (vb * 32 + r32) * 72 + ks * 16 + hi * 8);
            o = __builtin_amdgcn_mfma_f32_32x32x16_bf16(a1, b1, o, 0, 0, 0);
            const bf16x8 a2 = *(const bf16x8*)(qe + (dir * 64 + tb * 32 + r32) * 72 + ks * 16 + hi * 8);
            const bf16x8 b2 = *(const bf16x8*)(ST + (dir * 128 + vb * 32 + r32) * 72 + ks * 16 + hi * 8);
            o = __builtin_amdgcn_mfma_f32_32x32x16_bf16(a2, b2, o, 0, 0, 0);
        }
    __syncthreads();
#pragma unroll
    for (int r = 0; r < 16; ++r) ob[(tb * 32 + crow(r, hi)) * 132 + vb * 32 + r32] = o[r];
    __syncthreads();
    {
        const int t = tid >> 3, v0 = (tid & 7) * 16;
        float vals[16]; float ss = 0.f;
#pragma unroll
        for (int i = 0; i < 16; ++i) { vals[i] = ob[t * 132 + v0 + i]; ss += vals[i] * vals[i]; }
        ss += __shfl_xor(ss, 1); ss += __shfl_xor(ss, 2); ss += __shfl_xor(ss, 4);
        const float rstd = rsqrtf(ss * (1.f / 128.f) + EPSN);
        const size_t row = (size_t)gc * 64 + t;
        unsigned pk[8];
#pragma unroll
        for (int i = 0; i < 8; ++i) {
            const float r0 = bf2f(P[row * PW + PC_R + h * 128 + v0 + 2 * i]), r1 = bf2f(P[row * PW + PC_R + h * 128 + v0 + 2 * i + 1]);
            pk[i] = cvtpk(vals[2 * i] * rstd * p.gla_onorm[v0 + 2 * i] * silu_f(r0), vals[2 * i + 1] * rstd * p.gla_onorm[v0 + 2 * i + 1] * silu_f(r1));
        }
        bf16_t* M = (bf16_t*)(p.ws + WS_MIX) + row * 1024 + h * 128 + v0;
        *(u32x4*)M = (u32x4){pk[0], pk[1], pk[2], pk[3]}; *(u32x4*)(M + 8) = (u32x4){pk[4], pk[5], pk[6], pk[7]};
    }
    __syncthreads();
}


struct GlaPre { u32x4 qc, kc, vc[2], ac, sc[4]; float4 wac; float bac; };
__device__ __forceinline__ void gla_prefetch(const Params& p, int gc, int h, GlaPre& g, u32x4 (&rc)[2]) {
    const int tid = threadIdx.x;
    const bf16_t* P = (const bf16_t*)(p.ws + WS_P);
    const bf16_t* rowp = P + (size_t)(gc * 64 + (tid >> 3)) * PW;
    g.qc = *(const u32x4*)(rowp + PC_Q + h * 64 + (tid & 7) * 8);
    g.kc = *(const u32x4*)(rowp + PC_K + h * 64 + (tid & 7) * 8);
#pragma unroll
    for (int i = 0; i < 2; ++i) { const int idx = tid + 512 * i; g.vc[i] = *(const u32x4*)(P + (size_t)(gc * 64 + (idx >> 4)) * PW + PC_V + h * 128 + (idx & 15) * 8); }
#pragma unroll
    for (int i = 0; i < 2; ++i) rc[i] = *(const u32x4*)(rowp + PC_R + h * 128 + (tid & 7) * 16 + 8 * i);
    g.ac = *(const u32x4*)(P + (size_t)(gc * 64 + ((tid & 255) >> 2)) * PW + PC_AF + (tid & 3) * 8);
    const bf16_t* S = (const bf16_t*)(p.ws + WS_SIN);
#pragma unroll
    for (int i = 0; i < 4; ++i) { const int cc = tid + 512 * i, dir = cc >> 10; g.sc[i] = *(const u32x4*)(S + ((size_t)(dir * NCH + gc) * 4 + h) * 8192 + (cc & 1023) * 8); }
    { const int dd = tid >> 8, jj = (tid >> 4) & 15, d4 = tid & 15; g.wac = *(const float4*)((dd == 0 ? p.gla_wa_f : p.gla_wa_b) + jj * 256 + h * 64 + d4 * 4); }
    g.bac = ((tid >> 6) & 1 ? p.gla_ba_b : p.gla_ba_f)[h * 64 + (tid & 63)];
}
template <int OFF> __device__ __forceinline__ s16x4 gla_tr(int vb) { s16x4 r; asm volatile("ds_read_b64_tr_b16 %0, %1 offset:%2" : "=&v"(r) : "v"(vb), "i"(OFF) : "memory"); return r; }
__device__ __forceinline__ void phase_gla_out(const Params& p) {
    const int tid = threadIdx.x, lane = tid & 63, wave = tid >> 6, r32 = lane & 31, hi = lane >> 5, G = gridDim.x;
    bf16_t* qe = (bf16_t*)smem;
    bf16_t* ke = qe + 2 * 64 * 72;
    bf16_t* Am = ke + 2 * 64 * 72;
    bf16_t* Qraw = Am; bf16_t* Kraw = Am + 64 * 72;
    char* Vraw = smem + 55296;
    bf16_t* ST = (bf16_t*)(smem + 75776);
    float* af = (float*)(smem + 112640);
    float* wa = af + 2048;
    float* ba = wa + 2048;
    float* tot = ba + 128;
    float* ob = (float*)ke;
    int u = blockIdx.x;
    if (u >= NCH * 4) return;
    const int nt_t = tid >> 3, nt_v0 = (tid & 7) * 16;
    float on[16];
#pragma unroll
    for (int i = 0; i < 16; ++i) on[i] = p.gla_onorm[nt_v0 + i];
    GlaPre g; u32x4 rc[2], rcn[2];
    gla_prefetch(p, u >> 2, u & 3, g, rc);
    const int dir = wave & 1, tq = wave >> 1;
    for (; u < NCH * 4; u += G) {
        const int gc = u >> 2, h = u & 3;
        *(u32x4*)(Qraw + (tid >> 3) * 72 + (tid & 7) * 8) = g.qc;
        *(u32x4*)(Kraw + (tid >> 3) * 72 + (tid & 7) * 8) = g.kc;
#pragma unroll
        for (int i = 0; i < 2; ++i) { const int idx = tid + 512 * i; *(u32x4*)(Vraw + (idx >> 4) * 320 + (idx & 15) * 16) = g.vc[i]; }
#pragma unroll
        for (int i = 0; i < 4; ++i) { const int cc = tid + 512 * i; *(u32x4*)(ST + ((cc >> 10) * 128 + ((cc >> 3) & 127)) * 72 + (cc & 7) * 8) = g.sc[i]; }
        if (tid < 256) { const int t = tid >> 2, ch = tid & 3, dd = ch >> 1, j0 = (ch & 1) * 8; float* q = af + dd * 1024 + t * 16 + j0;
#pragma unroll
            for (int e = 0; e < 4; ++e) { q[2 * e] = __uint_as_float(g.ac[e] << 16); q[2 * e + 1] = __uint_as_float(g.ac[e] & 0xFFFF0000u); } }
        { const int dd = tid >> 8, jj = (tid >> 4) & 15, d4 = tid & 15; *(float4*)(wa + (dd * 16 + jj) * 64 + d4 * 4) = g.wac; }
        if (tid < 128) ba[tid] = g.bac;
        __syncthreads();
        const int un = u + G;
        if (un < NCH * 4) gla_prefetch(p, un >> 2, un & 3, g, rcn);
        float bb[16]; float total;
        {
            float w[16];
#pragma unroll
            for (int j = 0; j < 16; ++j) w[j] = wa[(dir * 16 + j) * 64 + lane];
            const float bias = ba[dir * 64 + lane];
#pragma unroll
            for (int i = 0; i < 16; ++i) {
                const int t = tq * 16 + i;
                float z = bias;
#pragma unroll
                for (int j = 0; j < 16; ++j) z += af[(dir * 64 + t) * 16 + j] * w[j];
                bb[i] = (fminf(z, 0.f) - __logf(1.f + __expf(-fabsf(z)))) * (1.f / 16.f);
            }
            if (dir == 0) {
#pragma unroll
                for (int i = 1; i < 16; ++i) bb[i] += bb[i - 1];
                tot[(dir * 4 + tq) * 64 + lane] = bb[15];
            } else {
#pragma unroll
                for (int i = 14; i >= 0; --i) bb[i] += bb[i + 1];
                tot[(dir * 4 + tq) * 64 + lane] = bb[0];
            }
        }
        __syncthreads();
        {
            float offs = 0.f; total = 0.f;
#pragma unroll
            for (int q = 0; q < 4; ++q) { const float tv = tot[(dir * 4 + q) * 64 + lane]; total += tv; if (dir == 0 ? (q < tq) : (q > tq)) offs += tv; }
#pragma unroll
            for (int i = 0; i < 16; ++i) bb[i] += offs;
        }
#pragma unroll
        for (int i = 0; i < 16; ++i) {
            const int t = tq * 16 + i;
            const float qv = bf2f(Qraw[t * 72 + lane]) * 0.125f, kv = bf2f(Kraw[t * 72 + lane]);
            qe[(dir * 64 + t) * 72 + lane] = f2bf(qv * __expf(bb[i]));
            ke[(dir * 64 + t) * 72 + lane] = f2bf(kv * __expf(-bb[i]));
        }
        __syncthreads();
        {
            const int mdir = wave >> 2, tb = (wave >> 1) & 1, sb = wave & 1;
            f32x16 acc = {};
#pragma unroll
            for (int ks = 0; ks < 4; ++ks) {
                const bf16x8 a = *(const bf16x8*)(qe + (mdir * 64 + tb * 32 + r32) * 72 + ks * 16 + hi * 8);
                const bf16x8 b = *(const bf16x8*)(ke + (mdir * 64 + sb * 32 + r32) * 72 + ks * 16 + hi * 8);
                acc = __builtin_amdgcn_mfma_f32_32x32x16_bf16(a, b, acc, 0, 0, 0);
            }
            const int sI = sb * 32 + r32;
#pragma unroll
            for (int r = 0; r < 16; ++r) { const int t = tb * 32 + crow(r, hi); const bool keep = (mdir == 0) ? (sI <= t) : (sI >= t); Am[(mdir * 64 + t) * 72 + sI] = f2bf(keep ? acc[r] : 0.f); }
        }
        __syncthreads();
        f32x16 o = {};
        const int tb = wave >> 2, vbk = wave & 3;
        {
            const int vb = (int)(uintptr_t)Vraw + (8 * hi + ((lane & 15) >> 2)) * 320 + (vbk * 32 + 16 * ((lane >> 4) & 1) + 4 * (lane & 3)) * 2;
#define GLA_PV(KS, DIRN) do { const s16x4 l_ = gla_tr<(KS) * 5120>(vb), h_ = gla_tr<(KS) * 5120 + 1280>(vb); \
            const bf16x8 a1 = *(const bf16x8*)(Am + ((DIRN) * 64 + tb * 32 + r32) * 72 + (KS) * 16 + hi * 8); \
            const bf16x8 a2 = *(const bf16x8*)(qe + ((DIRN) * 64 + tb * 32 + r32) * 72 + (KS) * 16 + hi * 8); \
            const bf16x8 b2 = *(const bf16x8*)(ST + ((DIRN) * 128 + vbk * 32 + r32) * 72 + (KS) * 16 + hi * 8); \
            asm volatile("s_waitcnt lgkmcnt(0)" ::: "memory"); SBAR(); \
            o = __builtin_amdgcn_mfma_f32_32x32x16_bf16(a1, (bf16x8){l_[0], l_[1], l_[2], l_[3], h_[0], h_[1], h_[2], h_[3]}, o, 0, 0, 0); \
            o = __builtin_amdgcn_mfma_f32_32x32x16_bf16(a2, b2, o, 0, 0, 0); } while (0)
            GLA_PV(0, 0); GLA_PV(1, 0); GLA_PV(2, 0); GLA_PV(3, 0); GLA_PV(0, 1); GLA_PV(1, 1); GLA_PV(2, 1); GLA_PV(3, 1);
#undef GLA_PV
        }
        __syncthreads();
#pragma unroll
        for (int r = 0; r < 16; ++r) ob[(tb * 32 + crow(r, hi)) * 132 + vbk * 32 + r32] = o[r];
        __syncthreads();
        {
            float vals[16]; float ss = 0.f;
#pragma unroll
            for (int i = 0; i < 4; ++i) { const f32x4 x = *(const f32x4*)(ob + nt_t * 132 + nt_v0 + 4 * i); vals[4 * i] = x[0]; vals[4 * i + 1] = x[1]; vals[4 * i + 2] = x[2]; vals[4 * i + 3] = x[3]; }
#pragma unroll
            for (int i = 0; i < 16; ++i) ss += vals[i] * vals[i];
            ss += __shfl_xor(ss, 1); ss += __shfl_xor(ss, 2); ss += __shfl_xor(ss, 4);
            const float rstd = rsqrtf(ss * (1.f / 128.f) + EPSN);
            unsigned pk[8];
#pragma unroll
            for (int i = 0; i < 8; ++i) {
                const unsigned w = rc[i >> 2][i & 3];
                const float r0 = __uint_as_float(w << 16), r1 = __uint_as_float(w & 0xFFFF0000u);
                const float s0 = r0 * __builtin_amdgcn_rcpf(1.f + __expf(-r0)), s1 = r1 * __builtin_amdgcn_rcpf(1.f + __expf(-r1));
                pk[i] = cvtpk(vals[2 * i] * rstd * on[2 * i] * s0, vals[2 * i + 1] * rstd * on[2 * i + 1] * s1);
            }
            bf16_t* M = (bf16_t*)(p.ws + WS_MIX) + ((size_t)gc * 64 + nt_t) * 1024 + h * 128 + nt_v0;
            *(u32x4*)M = (u32x4){pk[0], pk[1], pk[2], pk[3]}; *(u32x4*)(M + 8) = (u32x4){pk[4], pk[5], pk[6], pk[7]};
        }
        rc[0] = rcn[0]; rc[1] = rcn[1];
        __syncthreads();
    }
}

namespace mla {
constexpr int KVBLK = 64, QBLK = 32;
#ifndef MLA_QREG
#define MLA_QREG 12
#endif
constexpr int QREG = MLA_QREG;
constexpr float SCALE = 0.07216878364870322f;
constexpr float THR = 8.f;
constexpr int LDQ = 768, LDK = 768, LDV = 512, LDO = 1024;
constexpr int SHM_V = KVBLK * 128 * 2, SHM_K = KVBLK * 400;
#define MKSWZ(row, colB) ((row) * 400 + (colB))
__device__ __forceinline__ void partialSM(f32x16& p0, f32x16& p1, float& m_reg, float& mn, float& alpha) {
    constexpr float C = SCALE * LOG2E;
    float pmax = p0[0];
#pragma unroll
    for (int r = 1; r < 16; ++r) pmax = fmaxf(pmax, p0[r]);
#pragma unroll
    for (int r = 0; r < 16; ++r) pmax = fmaxf(pmax, p1[r]);
    { auto rr = __builtin_amdgcn_permlane32_swap(__float_as_uint(pmax), __float_as_uint(pmax), false, false);
      pmax = fmaxf(__uint_as_float(rr[0]), __uint_as_float(rr[1])); }
    if (__builtin_expect(__all(pmax - m_reg <= THR / SCALE), 1)) { mn = m_reg; alpha = 1.f; }
    else { mn = fmaxf(m_reg, pmax); alpha = __builtin_amdgcn_exp2f((m_reg - mn) * C); m_reg = mn; }
    const float mnC = -mn * C;
#pragma unroll
    for (int r = 0; r < 16; ++r) p0[r] = fmaf(p0[r], C, mnC);
#pragma unroll
    for (int r = 0; r < 16; ++r) p1[r] = fmaf(p1[r], C, mnC);
#pragma unroll
    for (int r = 0; r < 16; ++r) p0[r] = __builtin_amdgcn_exp2f(p0[r]);
}
__device__ __forceinline__ void finishSM(f32x16& p0, f32x16& p1, float alpha, float& l_reg, bf16x8& pa0, bf16x8& pa1, bf16x8& pa2, bf16x8& pa3) {
#pragma unroll
    for (int r = 0; r < 16; ++r) p1[r] = __builtin_amdgcn_exp2f(p1[r]);
    float ps = 0;
#pragma unroll
    for (int r = 0; r < 16; ++r) ps += p0[r];
#pragma unroll
    for (int r = 0; r < 16; ++r) ps += p1[r];
    { auto rr = __builtin_amdgcn_permlane32_swap(__float_as_uint(ps), __float_as_uint(ps), false, false);
      ps = __uint_as_float(rr[0]) + __uint_as_float(rr[1]); }
    l_reg = l_reg * alpha + ps;
#define PK4(P, BASE, OUT) do { unsigned a0 = cvtpk(P[BASE + 0], P[BASE + 1]), a1 = cvtpk(P[BASE + 2], P[BASE + 3]);   \
    unsigned b0 = cvtpk(P[BASE + 4], P[BASE + 5]), b1 = cvtpk(P[BASE + 6], P[BASE + 7]);                              \
    auto r0 = __builtin_amdgcn_permlane32_swap(a0, b0, false, false); auto r1 = __builtin_amdgcn_permlane32_swap(a1, b1, false, false); \
    u32x4 w = {r0[0], r1[0], r0[1], r1[1]}; OUT = *reinterpret_cast<bf16x8*>(&w); } while (0)
    PK4(p0, 0, pa0); PK4(p0, 8, pa1); PK4(p1, 0, pa2); PK4(p1, 8, pa3);
}
__device__ __forceinline__ void qkt(f32x16& p0, f32x16& p1, const char* Ks, const bf16x8* qr, const char* qlds, int r32, int hi) {
    p0 = f32x16{}; p1 = f32x16{};
#pragma unroll
    for (int d0 = 0; d0 < 12; ++d0) { const int cb = (d0 * 16 + hi * 8) * 2;
        const bf16x8 b0 = *reinterpret_cast<const bf16x8*>(Ks + MKSWZ(r32, cb));
        const bf16x8 b1 = *reinterpret_cast<const bf16x8*>(Ks + MKSWZ(32 + r32, cb));
        const bf16x8 qv = (d0 < QREG) ? qr[d0 < QREG ? d0 : 0] : *reinterpret_cast<const bf16x8*>(qlds + (d0 - QREG) * 1024);
        p0 = __builtin_amdgcn_mfma_f32_32x32x16_bf16(b0, qv, p0, 0, 0, 0);
        p1 = __builtin_amdgcn_mfma_f32_32x32x16_bf16(b1, qv, p1, 0, 0, 0); }
}
__device__ __forceinline__ int v_st(int k, int c) { const int kk = (k & ~0xC) | ((k & 4) << 1) | ((k & 8) >> 1); return ((kk >> 3) * 4 + (c >> 5)) * 512 + ((kk & 7) * 32 + (c & 31)) * 2; }
__device__ __forceinline__ int v_rd_base(int lane) { return ((lane & 3) << 3) | (((lane >> 2) & 3) << 6) | (((lane >> 4) & 1) << 5) | (((lane >> 5) & 1) << 8); }
constexpr int v_rd_off(int d0, int ks, int half) { return d0 * 512 + ks * 4096 + half * 2048; }
template <int OFF> __device__ __forceinline__ s16x4 tr_read(int vb) {
    s16x4 r; asm volatile("ds_read_b64_tr_b16 %0, %1 offset:%2" : "=&v"(r) : "v"(vb), "i"(OFF) : "memory"); return r;
}
template <int D0> __device__ __forceinline__ void pv_one(f32x16& od, int vb, bf16x8 pa0, bf16x8 pa1, bf16x8 pa2, bf16x8 pa3) {
#define PKV(L, H) (bf16x8){L[0], L[1], L[2], L[3], H[0], H[1], H[2], H[3]}
    {
    const s16x4 l0 = tr_read<v_rd_off(D0, 0, 0)>(vb), h0 = tr_read<v_rd_off(D0, 0, 1)>(vb), l1 = tr_read<v_rd_off(D0, 1, 0)>(vb), h1 = tr_read<v_rd_off(D0, 1, 1)>(vb);
    asm volatile("s_waitcnt lgkmcnt(0)" ::: "memory"); SBAR();
    od = __builtin_amdgcn_mfma_f32_32x32x16_bf16(pa0, PKV(l0, h0), od, 0, 0, 0);
    od = __builtin_amdgcn_mfma_f32_32x32x16_bf16(pa1, PKV(l1, h1), od, 0, 0, 0);
    }
    {
    const s16x4 l2 = tr_read<v_rd_off(D0, 2, 0)>(vb), h2 = tr_read<v_rd_off(D0, 2, 1)>(vb), l3 = tr_read<v_rd_off(D0, 3, 0)>(vb), h3 = tr_read<v_rd_off(D0, 3, 1)>(vb);
    asm volatile("s_waitcnt lgkmcnt(0)" ::: "memory"); SBAR();
    od = __builtin_amdgcn_mfma_f32_32x32x16_bf16(pa2, PKV(l2, h2), od, 0, 0, 0);
    od = __builtin_amdgcn_mfma_f32_32x32x16_bf16(pa3, PKV(l3, h3), od, 0, 0, 0);
    }
#undef PKV
}
__device__ __forceinline__ void pv_d0(f32x16* o, int vb, bf16x8 pa0, bf16x8 pa1, bf16x8 pa2, bf16x8 pa3) {
    pv_one<0>(o[0], vb, pa0, pa1, pa2, pa3); pv_one<1>(o[1], vb, pa0, pa1, pa2, pa3); pv_one<2>(o[2], vb, pa0, pa1, pa2, pa3); pv_one<3>(o[3], vb, pa0, pa1, pa2, pa3);
}
__device__ __forceinline__ void attn_body(const bf16_t* __restrict__ Qb, const bf16_t* __restrict__ Kh, const bf16_t* __restrict__ Vh, bf16_t* __restrict__ Ob, int seq) {
    char* lds = smem;
    const int tid = threadIdx.x, wid = tid >> 6, lane = tid & 63, r32 = lane & 31, hi = lane >> 5;
    char* V_lds = lds; char* K_lds = lds + 2 * SHM_V;
    float* ws = (float*)(lds + 2 * SHM_V + 2 * SHM_K) + wid * 64; float* li_l = ws; float* al_l = ws + 32;
    float m_reg = -1e30f, l_reg = 0; f32x16 o[4] = {}; bf16x8 qr[QREG];
    const bf16_t* Qw = Qb + (long)(wid * QBLK + r32) * LDQ + hi * 8;
#pragma unroll
    for (int d0 = 0; d0 < QREG; ++d0) qr[d0] = *reinterpret_cast<const bf16x8*>(Qw + d0 * 16);
    char* qlds = lds + 2 * SHM_V + 2 * SHM_K + 2048 + wid * ((12 - QREG) * 1024) + lane * 16;
#pragma unroll
    for (int d0 = 0; d0 < 12 - QREG; ++d0) *reinterpret_cast<bf16x8*>(qlds + d0 * 1024) = *reinterpret_cast<const bf16x8*>(Qw + (QREG + d0) * 16);
    const int sr = tid >> 4, sc = (tid & 15) * 8, vst0 = v_st(sr, sc), vst1 = v_st(32 + sr, sc);
    int kgo[3], kso[3];
#pragma unroll
    for (int i = 0; i < 3; ++i) { const int id = tid + 512 * i, kr_ = id / 24, kc_ = (id % 24) * 8; kgo[i] = kr_ * LDK + kc_; kso[i] = MKSWZ(kr_, kc_ * 2); }
    const int vb0 = (int)(uintptr_t)V_lds + v_rd_base(lane);
    struct { bf16x8 vs0, vs1, ks0, ks1, ks2; } st_;
#define SLOAD(k0) do { st_.vs0 = *(const bf16x8*)(&Vh[(long)((k0) + sr) * LDV + sc]); st_.vs1 = *(const bf16x8*)(&Vh[(long)((k0) + 32 + sr) * LDV + sc]); \
    st_.ks0 = *(const bf16x8*)(&Kh[(long)(k0) * LDK + kgo[0]]); st_.ks1 = *(const bf16x8*)(&Kh[(long)(k0) * LDK + kgo[1]]); \
    st_.ks2 = *(const bf16x8*)(&Kh[(long)(k0) * LDK + kgo[2]]); } while (0)
#define SWRITE(b) do { *(bf16x8*)(V_lds + (b) * SHM_V + vst0) = st_.vs0; *(bf16x8*)(V_lds + (b) * SHM_V + vst1) = st_.vs1; \
    *(bf16x8*)(K_lds + (b) * SHM_K + kso[0]) = st_.ks0; *(bf16x8*)(K_lds + (b) * SHM_K + kso[1]) = st_.ks1; \
    *(bf16x8*)(K_lds + (b) * SHM_K + kso[2]) = st_.ks2; } while (0)
#define RESC(a) do { if (__any((a) < 1.f)) { if (hi == 0) al_l[r32] = (a); asm volatile("s_waitcnt lgkmcnt(0)" ::: "memory"); \
    _Pragma("unroll") for (int d = 0; d < 4; ++d) _Pragma("unroll") for (int r = 0; r < 16; ++r) o[d][r] *= al_l[crow(r, hi)]; } } while (0)
    f32x16 pA0, pA1, pB0, pB1; float mnA, mnB, alA, alB; bf16x8 pa0, pa1, pa2, pa3; const int NT = seq / KVBLK;
    SLOAD(0); SWRITE(0); __syncthreads();
    qkt(pA0, pA1, K_lds, qr, qlds, r32, hi); partialSM(pA0, pA1, m_reg, mnA, alA);
    SLOAD(KVBLK); SWRITE(1); __syncthreads();
    for (int j = 1; j + 1 < NT; j += 2) {
        SBAR(); qkt(pB0, pB1, K_lds + SHM_K, qr, qlds, r32, hi);
        finishSM(pA0, pA1, alA, l_reg, pa0, pa1, pa2, pa3); SBAR();
        SLOAD((j + 1) * KVBLK); SBAR();
        pv_d0(o, vb0, pa0, pa1, pa2, pa3); partialSM(pB0, pB1, m_reg, mnB, alB);
        __syncthreads(); SWRITE(0);
        RESC(alB); __syncthreads();
        SBAR(); qkt(pA0, pA1, K_lds, qr, qlds, r32, hi);
        finishSM(pB0, pB1, alB, l_reg, pa0, pa1, pa2, pa3); SBAR();
        SLOAD((j + 2) * KVBLK); SBAR();
        pv_d0(o, vb0 + SHM_V, pa0, pa1, pa2, pa3); partialSM(pA0, pA1, m_reg, mnA, alA);
        __syncthreads(); SWRITE(1);
        RESC(alA); __syncthreads();
    }
    SBAR(); qkt(pB0, pB1, K_lds + SHM_K, qr, qlds, r32, hi);
    finishSM(pA0, pA1, alA, l_reg, pa0, pa1, pa2, pa3); SBAR();
    pv_d0(o, vb0, pa0, pa1, pa2, pa3); partialSM(pB0, pB1, m_reg, mnB, alB);
    __syncthreads(); RESC(alB);
    finishSM(pB0, pB1, alB, l_reg, pa0, pa1, pa2, pa3); SBAR();
    pv_d0(o, vb0 + SHM_V, pa0, pa1, pa2, pa3);
    if (hi == 0) li_l[r32] = l_reg; asm volatile("s_waitcnt lgkmcnt(0)" ::: "memory");
    float rli[16];
#pragma unroll
    for (int r = 0; r < 16; ++r) rli[r] = __builtin_amdgcn_rcpf(li_l[crow(r, hi)]);
    bf16_t* Ow = Ob + (long)(wid * QBLK) * LDO;
#pragma unroll
    for (int r = 0; r < 16; ++r) { const int orow = crow(r, hi);
#pragma unroll
        for (int d0 = 0; d0 < 4; ++d0) Ow[(long)orow * LDO + d0 * 32 + r32] = f2bf(o[d0][r] * rli[r]); }
    __syncthreads();
#undef SLOAD
#undef SWRITE
#undef RESC
}
}

__device__ __forceinline__ void phase_mix0(const Params& p) {
    const int G = gridDim.x;
    phase_gla_out(p);
    __syncthreads();
    const bf16_t* QM = (const bf16_t*)(p.ws + WS_QM); const bf16_t* KM = (const bf16_t*)(p.ws + WS_KM); const bf16_t* VM = (const bf16_t*)(p.ws + WS_VM);
    bf16_t* MIX = (bf16_t*)(p.ws + WS_MIX);
    for (int u = blockIdx.x; u < 260; u += G) {
        const bool lat = u < 256;
        const int h = lat ? (u & 3) : (u - 256);
        const size_t q0 = lat ? (size_t)CTXN + (size_t)(u >> 2) * 256 : 0;
        mla::attn_body(QM + q0 * 768 + h * 192, KM + h * 192, VM + h * 128, MIX + q0 * 1024 + 512 + h * 128, lat ? NTOK : CTXN);
    }
}

template <int OFF> __device__ __forceinline__ s16x4 na_tr(int vb) { s16x4 r; asm volatile("ds_read_b64_tr_b16 %0, %1 offset:%2" : "=&v"(r) : "v"(vb), "i"(OFF) : "memory"); return r; }
template <int KS> __device__ __forceinline__ void na_pv(f32x16& o0, f32x16& o1, int vb, bf16x8 pa) {
    const s16x4 a0 = na_tr<KS * 5120>(vb), a1 = na_tr<KS * 5120 + 1280>(vb), b0 = na_tr<KS * 5120 + 64>(vb), b1 = na_tr<KS * 5120 + 1280 + 64>(vb);
    asm volatile("s_waitcnt lgkmcnt(0)" ::: "memory"); SBAR();
    o0 = __builtin_amdgcn_mfma_f32_32x32x16_bf16(pa, (bf16x8){a0[0], a0[1], a0[2], a0[3], a1[0], a1[1], a1[2], a1[3]}, o0, 0, 0, 0);
    o1 = __builtin_amdgcn_mfma_f32_32x32x16_bf16(pa, (bf16x8){b0[0], b0[1], b0[2], b0[3], b1[0], b1[1], b1[2], b1[3]}, o1, 0, 0, 0);
}
template <int MODE> __device__ __forceinline__ void na_softmax(f32x16& p0, f32x16& p1, float& m_reg, float& l_reg, float& alpha, const float* brow, int c0, int hi) {
    constexpr float C = 0.125f * LOG2E;
#define NA_L0(q) (MODE != 2 || (q) >= 12)
#define NA_L1(q) (MODE != 1 || (q) < 4)
    if (MODE == 0) {
#pragma unroll
        for (int q = 0; q < 16; ++q) { p0[q] *= C; p1[q] *= C; }
    } else {
        float bv0[16], bv1[16];
#pragma unroll
        for (int q = 0; q < 16; ++q) { const int kc0 = crow(q, hi); if (NA_L0(q)) bv0[q] = brow[kc0]; if (NA_L1(q)) bv1[q] = brow[32 + kc0]; }
#pragma unroll
        for (int q = 0; q < 16; ++q) { if (NA_L0(q)) asm volatile("" : "+v"(bv0[q])); if (NA_L1(q)) asm volatile("" : "+v"(bv1[q])); }
#pragma unroll
        for (int q = 0; q < 16; ++q) {
            const int kc0 = crow(q, hi), kc1 = 32 + kc0;
            if (NA_L0(q)) { const float t = fmaf(p0[q], C, bv0[q]); p0[q] = ((unsigned)(kc0 - c0) < 16u) ? t : -1e30f; }
            if (NA_L1(q)) { const float t = fmaf(p1[q], C, bv1[q]); p1[q] = ((unsigned)(kc1 - c0) < 16u) ? t : -1e30f; }
        }
    }
    float pmax = -1e30f;
#pragma unroll
    for (int q = 0; q < 16; ++q) { if (NA_L0(q)) pmax = fmaxf(pmax, p0[q]); if (NA_L1(q)) pmax = fmaxf(pmax, p1[q]); }
    { auto rr = __builtin_amdgcn_permlane32_swap(__float_as_uint(pmax), __float_as_uint(pmax), false, false);
      pmax = fmaxf(__uint_as_float(rr[0]), __uint_as_float(rr[1])); }
    const float mn = fmaxf(m_reg, pmax);
    alpha = __builtin_amdgcn_exp2f(m_reg - mn);
    m_reg = mn;
    float ps = 0.f;
#pragma unroll
    for (int q = 0; q < 16; ++q) {
        if (NA_L0(q)) { p0[q] = __builtin_amdgcn_exp2f(p0[q] - mn); ps += p0[q]; } else p0[q] = 0.f;
        if (NA_L1(q)) { p1[q] = __builtin_amdgcn_exp2f(p1[q] - mn); ps += p1[q]; } else p1[q] = 0.f;
    }
    { auto rr = __builtin_amdgcn_permlane32_swap(__float_as_uint(ps), __float_as_uint(ps), false, false);
      ps = __uint_as_float(rr[0]) + __uint_as_float(rr[1]); }
    l_reg = l_reg * alpha + ps;
#undef NA_L0
#undef NA_L1
}
__device__ __forceinline__ void phase_na(const Params& p) {
    const int tid = threadIdx.x, lane = tid & 63, wave = tid >> 6, r32 = lane & 31, hi = lane >> 5, G = gridDim.x;
    const bf16_t* QKV = (const bf16_t*)(p.ws + WS_P);
    bf16_t* MIX = (bf16_t*)(p.ws + WS_MIX);
    constexpr int KB = 64 * 72 * 2, VB = 64 * 160 * 2;
    char* Kl = smem;
    char* Vl = smem + 2 * KB;
    float* xch = (float*)(smem + 2 * KB + 2 * VB) + wave * 64;
    float* rpbL = (float*)(smem + 2 * KB + 2 * VB + 8 * 64 * 4);
    constexpr float C = 0.125f * LOG2E;
    const int skey = tid >> 3, sch = tid & 7;
    const int vb0 = (int)(uintptr_t)Vl + (8 * hi + ((lane & 15) >> 2)) * 320 + (16 * ((lane >> 4) & 1) + 4 * (lane & 3)) * 2;
    for (int u = blockIdx.x; u < 64 * 16; u += G) {
        const int rg = u >> 4, h = u & 15;
        const int r = rg * 4 + (wave >> 1), qb = wave & 1;
        const int r0w = min(max(r - 4, 0), 248);
        const int kr_lo = min(max(rg * 4 - 4, 0), 248), kr_hi = min(max(rg * 4 + 3 - 4, 0), 248) + 7, nwin = kr_hi - kr_lo + 1, ntile = nwin + 4;
        for (int i = tid; i < 15 * 31; i += NTH) rpbL[i] = p.na_rpb[(size_t)h * 15 * 31 + i] * LOG2E;
        const int c = qb * 32 + r32, c0 = min(max(c - 8, 0), 48);
        const size_t qrow = (size_t)CTXN + (size_t)r * 64 + c;
        bf16x8 qr[4];
#pragma unroll
        for (int ks = 0; ks < 4; ++ks) qr[ks] = *(const bf16x8*)(QKV + qrow * 3072 + h * 64 + ks * 16 + hi * 8);
        float m_reg = -1e30f, l_reg = 0.f; f32x16 o0 = {}, o1 = {};
        u32x4 skA, svA, skB, svB;
#define NA_LOAD(ti_, SK, SV) do { const size_t key0_ = ((ti_) >= nwin) ? (size_t)((ti_) - nwin) * 64 : (size_t)CTXN + (size_t)(kr_lo + (ti_)) * 64; \
            const bf16_t* src_ = QKV + (key0_ + skey) * 3072 + h * 64 + sch * 8; SK = *(const u32x4*)(src_ + 1024); SV = *(const u32x4*)(src_ + 2048); } while (0)
#define NA_WRITE(b_, SK, SV) do { *(u32x4*)(Kl + (b_) * KB + skey * 144 + sch * 16) = SK; *(u32x4*)(Vl + (b_) * VB + skey * 320 + sch * 16) = SV; } while (0)
        NA_LOAD(0, skA, svA); NA_WRITE(0, skA, svA);
        NA_LOAD(1, skA, svA);
        __syncthreads();
        for (int ti = 0; ti < ntile; ++ti) {
            const int b = ti & 1;
            if (ti + 2 < ntile) { if (b == 0) NA_LOAD(ti + 2, skB, svB); else NA_LOAD(ti + 2, skA, svA); }
            const bool isctx = ti >= nwin;
            const int kr = kr_lo + ti;
            const bool need = isctx || (kr >= r0w && kr <= r0w + 7);
            if (need) {
                const bf16_t* Ks = (const bf16_t*)(Kl + b * KB);
                f32x16 p0 = {}, p1 = {};
#pragma unroll
                for (int ks = 0; ks < 4; ++ks) {
                    const bf16x8 a0 = *(const bf16x8*)(Ks + r32 * 72 + ks * 16 + hi * 8), a1 = *(const bf16x8*)(Ks + (32 + r32) * 72 + ks * 16 + hi * 8);
                    p0 = __builtin_amdgcn_mfma_f32_32x32x16_bf16(a0, qr[ks], p0, 0, 0, 0);
                    p1 = __builtin_amdgcn_mfma_f32_32x32x16_bf16(a1, qr[ks], p1, 0, 0, 0);
                }
                float alpha;
                const float* brow = rpbL + (kr - r + 7) * 31 + 15 - c;
                if (isctx) na_softmax<0>(p0, p1, m_reg, l_reg, alpha, brow, c0, hi);
                else if (qb == 0) na_softmax<1>(p0, p1, m_reg, l_reg, alpha, brow, c0, hi);
                else na_softmax<2>(p0, p1, m_reg, l_reg, alpha, brow, c0, hi);
                bf16x8 pa0, pa1, pa2, pa3;
                PK4(p0, 0, pa0); PK4(p0, 8, pa1); PK4(p1, 0, pa2); PK4(p1, 8, pa3);
                if (__any(alpha < 1.f)) {
                    if (hi == 0) xch[r32] = alpha;
                    asm volatile("s_waitcnt lgkmcnt(0)" ::: "memory");
#pragma unroll
                    for (int q = 0; q < 16; ++q) { const float a = xch[crow(q, hi)]; o0[q] *= a; o1[q] *= a; }
                }
                const int vb = vb0 + b * VB;
                na_pv<0>(o0, o1, vb, pa0); na_pv<1>(o0, o1, vb, pa1); na_pv<2>(o0, o1, vb, pa2); na_pv<3>(o0, o1, vb, pa3);
            }
            if (ti + 1 < ntile) { if (b == 0) NA_WRITE(1, skA, svA); else NA_WRITE(0, skB, svB); }
            __syncthreads();
        }
#undef NA_LOAD
#undef NA_WRITE
        if (hi == 0) xch[32 + r32] = l_reg;
        asm volatile("s_waitcnt lgkmcnt(0)" ::: "memory");
        const size_t orow0 = (size_t)CTXN + (size_t)r * 64 + qb * 32;
#pragma unroll
        for (int q = 0; q < 16; ++q) {
            const int qi = crow(q, hi); const float il = __builtin_amdgcn_rcpf(xch[32 + qi]);
            bf16_t* dst = MIX + (orow0 + qi) * 1024 + h * 64;
            dst[r32] = f2bf(o0[q] * il); dst[32 + r32] = f2bf(o1[q] * il);
        }
        __syncthreads();
    }
}
#undef PK4

#define XB_TMO      128
#define XB_XCNT(j)  (256  + 64 * (j))
#define XB_XSUB(j)  (1280 + 64 * (j))
#define XB_XGEN(j)  (2304 + 64 * (j))
#define XB_TOP      3328
#define XB_TOPGEN   3392
#define XCD_BAR_WORDS 3456
#define XB_SPIN_CAP (1u << 22)
#define LAS __attribute__((address_space(3)))
__device__ __forceinline__ unsigned xb_ld(unsigned* p)              { return __hip_atomic_load(p, __ATOMIC_RELAXED, __HIP_MEMORY_SCOPE_AGENT); }
__device__ __forceinline__ unsigned xb_add(unsigned* p, unsigned v) { return __hip_atomic_fetch_add(p, v, __ATOMIC_RELAXED, __HIP_MEMORY_SCOPE_AGENT); }
__device__ __forceinline__ unsigned xb_xcc_id() { return (unsigned)__builtin_amdgcn_s_getreg((3 << 11) | 20) & 0xFu; }
#define XB_SPIN(cond, bar) do { unsigned _sp = 0; while (cond) { __builtin_amdgcn_s_sleep(1); \
    if ((++_sp & 255u) == 0u) { if (xb_ld(&(bar)[XB_TMO])) break; if (_sp > XB_SPIN_CAP) { atomicAdd(&(bar)[XB_TMO], 1u); break; } } } } while (0)
struct XcdBarrier { unsigned* bar; unsigned x; volatile LAS unsigned* st; };
__device__ __forceinline__ XcdBarrier xcd_barrier_post(unsigned* bar, volatile LAS unsigned* st) {
    XcdBarrier b; b.bar = bar; b.x = xb_xcc_id(); b.st = st;
    if (threadIdx.x == 0) (void)xb_add(&bar[XB_XCNT(b.x)], 1u);
    return b;
}
__device__ __forceinline__ void xcd_barrier_complete(unsigned* bar, unsigned x, unsigned& nloc, unsigned& nx) {
    const unsigned G = gridDim.x * gridDim.y * gridDim.z;
    unsigned sum, cnt, mine, sp = 0u;
    for (;;) {
        sum = 0u; cnt = 0u; mine = 0u;
#pragma unroll
        for (unsigned j = 0; j < 16; ++j) { const unsigned c = xb_ld(&bar[XB_XCNT(j)]); sum += c; cnt += (c > 0u) ? 1u : 0u; mine = (j == x) ? c : mine; }
        if (sum == G) break;
        __builtin_amdgcn_s_sleep(1);
        if ((++sp & 255u) == 0u) { if (xb_ld(&bar[XB_TMO])) break; if (sp > XB_SPIN_CAP) { atomicAdd(&bar[XB_TMO], 1u); break; } }
    }
    nloc = mine > 0u ? mine : 1u; nx = cnt > 0u ? cnt : 1u;
}
__device__ __forceinline__ void xcd_barrier(const XcdBarrier& b) {
    asm volatile("s_waitcnt vmcnt(0)" ::: "memory");
    __syncthreads();
    if (threadIdx.x == 0) {
        unsigned* bar = b.bar;
        __builtin_amdgcn_s_waitcnt(0);
        unsigned nloc = b.st[0], nx = b.st[1];
        if (nloc == 0u) { xcd_barrier_complete(bar, b.x, nloc, nx); b.st[0] = nloc; b.st[1] = nx; }
        const unsigned old = xb_add(&bar[XB_XSUB(b.x)], 1u);
        const unsigned gen = old / nloc;
        if (old + 1u == (gen + 1u) * nloc) {
            __builtin_amdgcn_fence(__ATOMIC_RELEASE, "agent");
            asm volatile("s_waitcnt vmcnt(0)" ::: "memory");
            const unsigned og = xb_add(&bar[XB_TOP], 1u);
            const unsigned tg = og / nx;
            if (og + 1u == (tg + 1u) * nx) xb_add(&bar[XB_TOPGEN], 1u);
            else XB_SPIN(xb_ld(&bar[XB_TOPGEN]) == tg, bar);
            __builtin_amdgcn_fence(__ATOMIC_ACQUIRE, "agent");
            xb_add(&bar[XB_XGEN(b.x)], 1u);
            asm volatile("s_waitcnt vmcnt(0)" ::: "memory");
        } else {
            XB_SPIN(xb_ld(&bar[XB_XGEN(b.x)]) == gen, bar);
            __builtin_amdgcn_fence(__ATOMIC_ACQUIRE, "agent");
            asm volatile("s_waitcnt vmcnt(0)" ::: "memory");
        }
    }
    __syncthreads();
}

__device__ __forceinline__ void run_phase(const Params& p, int ph) {
#ifdef ONLY_PHASE
    if (ph != ONLY_PHASE) return;
    ph = ONLY_PHASE;
#endif
    const bf16_t* HB = (const bf16_t*)(p.ws + WS_HB);
    switch (ph) {
    case 0: phase_prologue(p); break;
    case 1: phase_norm1_l0(p); break;
    case 2: phase_gemm_pg8(HB, 1024, (const bf16_t*)(p.ws + WS_WIN), 1024, (bf16_t*)(p.ws + WS_P), PW, NTOK / 256, 8); break;
    case 3: phase_mla_up(p); break;
    case 4: break;
    case 5: phase_gla_scan(p); break;
    case 6: phase_mix0(p); break;
    case 7: phase_gemm_pg8((const bf16_t*)(p.ws + WS_MIX), 1024, (const bf16_t*)(p.ws + WS_WOUT0), 1024, (bf16_t*)(p.ws + WS_OB), 1024, NTOK / 256, 4); break;
    case 8: phase_mid(p, 0); break;
    case 9: phase_moe1(p, 0); break;
    case 10: phase_moe2(p, 0); break;
    case 11: phase_end(p, 0); break;
    case 12: phase_gemm_pg8(HB, 1024, (const bf16_t*)(p.ws + WS_WQKV), 1024, (bf16_t*)(p.ws + WS_P), 3072, NTOK / 256, 12); break;
    case 13: phase_na(p); break;
    case 14: phase_gemm_pg8((const bf16_t*)(p.ws + WS_MIX) + (size_t)CTXN * 1024, 1024, (const bf16_t*)(p.ws + WS_WNAO), 1024, (bf16_t*)(p.ws + WS_OB) + (size_t)CTXN * 1024, 1024, SEQ / 256, 4); break;
    case 15: phase_mid(p, 1); break;
    case 16: phase_moe1(p, 1); break;
    case 17: phase_moe2(p, 1); break;
    case 18: phase_end(p, 1); break;
    default: break;
    }
}
constexpr int N_PHASES = 19;

#if MK_LAUNCHES == 1
__global__ void __launch_bounds__(512) mega_kernel(Params p) {
    cg::grid_group grid = cg::this_grid();
    volatile LAS unsigned* xst = (volatile LAS unsigned*)(smem + LDS_BYTES - 16);
    if (threadIdx.x == 0) { xst[0] = 0u; xst[1] = 0u; xst[2] = 0u; xst[3] = 0u; }
    __syncthreads();
    XcdBarrier xb = xcd_barrier_post((unsigned*)(p.ws + WS_BAR), xst);
    run_phase(p, 0); xcd_barrier(xb);
    if (p.pad0 == 0x7fffffff) grid.sync();
    if (PROBE_REPEAT == 100) { run_phase(p, 0); xcd_barrier(xb); }
    if (PROBE_REPEAT == 61) { phase_gla_out(p); xcd_barrier(xb); }
#define PH_(n) run_phase(p, n); xcd_barrier(xb); if ((n) == PROBE_REPEAT) { run_phase(p, n); xcd_barrier(xb); }
    PH_(1) PH_(2) PH_(3) PH_(5) PH_(6) PH_(7) PH_(8) PH_(9) PH_(10) PH_(11) PH_(12) PH_(13) PH_(14) PH_(15) PH_(16) PH_(17)
    run_phase(p, 18);
#undef PH_
}
#else
template <int PH> __global__ void __launch_bounds__(512) phase_kernel(Params p) { run_phase(p, PH); }
typedef void (*phase_fn)(Params);
template <int PH> static bool launch_phase(const Params& p, int grid, hipStream_t stream, bool setattr) {
    if (setattr && hipFuncSetAttribute((const void*)phase_kernel<PH>, hipFuncAttributeMaxDynamicSharedMemorySize, LDS_BYTES) != hipSuccess) return false;
    hipLaunchKernelGGL(phase_kernel<PH>, dim3(grid), dim3(NTH), LDS_BYTES, stream, p);
    return true;
}
#endif

extern "C" void kernel_launch(void* const* d_in, const int* in_sizes, int n_in, void* d_out, int out_size, void* d_ws, size_t ws_size, hipStream_t stream) {
    static int grid_blocks = 0;
    bool first = false;
    if (!grid_blocks) {
        if (ws_size < WS_END) { fprintf(stderr, "kernel_launch: workspace too small: %zu < %zu\n", ws_size, (size_t)WS_END); return; }
        int dev = 0, cus = 0;
        (void)hipGetDevice(&dev);
        (void)hipDeviceGetAttribute(&cus, hipDeviceAttributeMultiprocessorCount, dev);
#if MK_LAUNCHES == 1
        if (hipFuncSetAttribute((const void*)mega_kernel, hipFuncAttributeMaxDynamicSharedMemorySize, LDS_BYTES) != hipSuccess) { fprintf(stderr, "kernel_launch: LDS attribute failed\n"); return; }
        int per_cu = 0;
        (void)hipOccupancyMaxActiveBlocksPerMultiprocessor(&per_cu, (const void*)mega_kernel, NTH, LDS_BYTES);
        if (per_cu < 1) { fprintf(stderr, "kernel_launch: occupancy query returned %d\n", per_cu); return; }
#endif
        grid_blocks = cus;
        first = true;
    }
    Params p{};
    const float* const* in = (const float* const*)d_in;
    p.x = in[0]; p.c = in[1]; p.ctx = in[2]; p.c_ctx = in[3]; p.ada_w = in[4]; p.ada_b = in[5]; p.norm_g = in[6]; p.router_w = in[7]; p.router_b = in[8];
    p.moe_w1 = in[9]; p.moe_b1 = in[10]; p.moe_w2 = in[11]; p.moe_b2 = in[12]; p.ab_in_w = in[13]; p.gla_wa_f = in[14]; p.gla_ba_f = in[15]; p.gla_wa_b = in[16]; p.gla_ba_b = in[17];
    p.gla_onorm = in[18]; p.mla_qnorm = in[19]; p.mla_wuq = in[20]; p.mla_kvnorm = in[21]; p.mla_wukv = in[22]; p.ab_out_w = in[23]; p.na_qkv_w = in[24]; p.na_rpb = in[25]; p.na_out_w = in[26];
    p.out = (float*)d_out; p.ws = (char*)d_ws;
#if MK_LAUNCHES == 1
    (void)hipMemsetAsync((char*)d_ws + WS_BAR, 0, 16384, stream);
    void* args[] = {&p};
    hipError_t e = hipLaunchCooperativeKernel((const void*)mega_kernel, dim3(grid_blocks), dim3(NTH), args, LDS_BYTES, stream);
    if (e != hipSuccess) fprintf(stderr, "cooperative launch failed: %s (grid %d)\n", hipGetErrorString(e), grid_blocks);
#else
    const int g = grid_blocks;
    launch_phase<0>(p, g, stream, first); launch_phase<1>(p, g, stream, first); launch_phase<2>(p, g, stream, first); launch_phase<3>(p, g, stream, first);
    launch_phase<4>(p, g, stream, first); launch_phase<5>(p, g, stream, first); launch_phase<6>(p, g, stream, first); launch_phase<7>(p, g, stream, first);
    launch_phase<8>(p, g, stream, first); launch_phase<9>(p, g, stream, first); launch_phase<10>(p, g, stream, first); launch_phase<11>(p, g, stream, first);
    launch_phase<12>(p, g, stream, first); launch_phase<13>(p, g, stream, first); launch_phase<14>(p, g, stream, first); launch_phase<15>(p, g, stream, first);
    launch_phase<16>(p, g, stream, first); launch_phase<17>(p, g, stream, first); launch_phase<18>(p, g, stream, first);
#endif
}
```

```cpp
#include <hip/hip_runtime.h>
#include <hip/hip_cooperative_groups.h>
#include <cstdio>
#include <cstdint>
namespace cg = cooperative_groups;

#ifndef PROBE_REPEAT
#define PROBE_REPEAT -1
#endif
#ifndef MK_LAUNCHES
#define MK_LAUNCHES 1
#endif

typedef unsigned short bf16_t;
typedef short bf16x8 __attribute__((ext_vector_type(8)));
typedef short s16x4 __attribute__((ext_vector_type(4)));
typedef float f32x4 __attribute__((ext_vector_type(4)));
typedef float f32x16 __attribute__((ext_vector_type(16)));
typedef unsigned u32x4 __attribute__((ext_vector_type(4)));
typedef int i32x4 __attribute__((ext_vector_type(4)));
typedef unsigned u32x2 __attribute__((ext_vector_type(2)));

constexpr int SEQ = 16384, CTXN = 256, NTOK = SEQ + CTXN, DM = 1024;
constexpr int NEXP = 32, FF = 1024;
constexpr int PW = 2048;
constexpr int PC_Q = 0, PC_K = 256, PC_V = 512, PC_R = 1024, PC_AF = 1536, PC_AB = 1552, PC_CQ = 1568, PC_CKV = 1824, PC_KR = 1952;
constexpr int NCH = NTOK / 64;
constexpr int NTH = 512;
constexpr float EPSN = 1e-6f;
constexpr float LOG2E = 1.4426950408889634f;

constexpr size_t al256(size_t x) { return (x + 255) / 256 * 256; }
constexpr size_t WS_BAR   = 0;
constexpr size_t WS_CNT   = WS_BAR + 16384;
constexpr size_t WS_MOD   = WS_CNT + 1024;
constexpr size_t WS_ROPE  = WS_MOD + al256((size_t)2 * 2 * 6144 * 4);
constexpr size_t WS_RWT   = WS_ROPE + al256((size_t)(256 + 256 + 64 + 64) * 16 * 4);
constexpr size_t WS_WIN   = WS_RWT + al256((size_t)2 * 32 * 1024 * 4);
constexpr size_t WS_WUQ   = WS_WIN + (size_t)2048 * 1024 * 2;
constexpr size_t WS_WUKV  = WS_WUQ + (size_t)768 * 256 * 2;
constexpr size_t WS_WOUT0 = WS_WUKV + (size_t)1024 * 128 * 2;
constexpr size_t WS_WQKV  = WS_WOUT0 + (size_t)1024 * 1024 * 2;
constexpr size_t WS_WNAO  = WS_WQKV + (size_t)3072 * 1024 * 2;
constexpr size_t WS_W1T   = WS_WNAO + (size_t)1024 * 1024 * 2;
constexpr size_t WS_W2T   = WS_W1T + (size_t)2 * 32 * 2048 * 1024 * 2;
constexpr size_t WS_HB    = WS_W2T + (size_t)2 * 32 * 1024 * 1024 * 2;
constexpr size_t WS_P     = WS_HB + (size_t)NTOK * 1024 * 2;
constexpr size_t WS_QM    = WS_P + (size_t)NTOK * 3072 * 2;
constexpr size_t WS_KM    = WS_QM + (size_t)NTOK * 768 * 2;
constexpr size_t WS_VM    = WS_KM + (size_t)NTOK * 768 * 2;
constexpr size_t WS_U     = WS_VM + (size_t)NTOK * 512 * 2;
constexpr size_t WS_SIN   = WS_U + (size_t)2 * NCH * 4 * 128 * 64 * 2;
constexpr size_t WS_DEC   = WS_SIN + (size_t)2 * NCH * 4 * 128 * 64 * 2;
constexpr size_t WS_MIX   = WS_DEC + al256((size_t)2 * NCH * 4 * 64 * 4);
constexpr size_t WS_OB    = WS_MIX + (size_t)NTOK * 1024 * 2;
constexpr size_t WS_X1    = WS_OB + (size_t)NTOK * 1024 * 2;
constexpr size_t WS_X2    = WS_X1 + (size_t)NTOK * 1024 * 4;
constexpr size_t WS_TOPE  = WS_X2 + (size_t)NTOK * 1024 * 4;
constexpr size_t WS_TOPP  = WS_TOPE + al256((size_t)NTOK * 4 * 4);
constexpr size_t WS_GATE  = WS_TOPP + al256((size_t)NTOK * 4 * 4);
constexpr size_t WS_LIST  = WS_GATE + al256((size_t)NTOK * 4 * 4);
constexpr size_t WS_ACT   = WS_LIST + al256((size_t)32 * NTOK * 4);
constexpr size_t WS_YB    = WS_ACT + (size_t)(NTOK * 4 + 256) * 1024 * 2;
constexpr size_t WS_END   = WS_YB + (size_t)(NTOK * 4) * 1024 * 2;

constexpr int LDS_BYTES = 160 * 1024;
extern __shared__ __attribute__((aligned(16))) char smem[];

struct Params {
    const float *x, *c, *ctx, *c_ctx, *ada_w, *ada_b, *norm_g, *router_w, *router_b, *moe_w1, *moe_b1, *moe_w2, *moe_b2;
    const float *ab_in_w, *gla_wa_f, *gla_ba_f, *gla_wa_b, *gla_ba_b, *gla_onorm, *mla_qnorm, *mla_wuq, *mla_kvnorm, *mla_wukv;
    const float *ab_out_w, *na_qkv_w, *na_rpb, *na_out_w;
    float* out; char* ws;
    int pad0, pad1;
};
typedef const __attribute__((address_space(4))) Params& PRef;
typedef const __attribute__((address_space(4))) Params* KPtr;
__device__ __forceinline__ KPtr kparams() { KPtr k = (KPtr)__builtin_amdgcn_kernarg_segment_ptr(); asm volatile("" : "+s"(k)); return k; }

__device__ __forceinline__ float bf2f(bf16_t h) { return __uint_as_float(((unsigned)h) << 16); }
__device__ __forceinline__ bf16_t f2bf(float f) { unsigned u = __float_as_uint(f); u += 0x7FFFu + ((u >> 16) & 1u); return (bf16_t)(u >> 16); }
__device__ __forceinline__ unsigned cvtpk(float lo, float hi) { unsigned r; asm volatile("v_cvt_pk_bf16_f32 %0, %1, %2" : "=v"(r) : "v"(lo), "v"(hi)); return r; }
__device__ __forceinline__ float wave_sum(float v) {
#pragma unroll
    for (int o = 32; o >= 1; o >>= 1) v += __shfl_xor(v, o);
    return v;
}
__device__ __forceinline__ int crow(int r, int hi) { return (r & 3) + 8 * (r >> 2) + 4 * hi; }
__device__ __forceinline__ float silu_f(float x) { return x / (1.f + __expf(-x)); }
#define SBAR() __builtin_amdgcn_sched_barrier(0)
__device__ __forceinline__ unsigned pk4_fp8(float a, float b, float c, float d) {
    a = __builtin_amdgcn_fmed3f(a, -448.f, 448.f); b = __builtin_amdgcn_fmed3f(b, -448.f, 448.f); c = __builtin_amdgcn_fmed3f(c, -448.f, 448.f); d = __builtin_amdgcn_fmed3f(d, -448.f, 448.f);
    int r = __builtin_amdgcn_cvt_pk_fp8_f32(a, b, 0, false); r = __builtin_amdgcn_cvt_pk_fp8_f32(c, d, r, true); return (unsigned)r; }
__device__ __forceinline__ int tid_opaque() { int t = threadIdx.x; asm volatile("" : "+v"(t)); return t; }

struct ConvJob { const float* src; bf16_t* dst; const float* gain; int K, Nsrc, kt, nt, mode, f8; };
constexpr int CONV8_RS = 264;
constexpr float W8_SCALE = 64.f;
__device__ __forceinline__ void conv_load(const ConvJob& jb, float4 (&v)[16]) {
    const int tid = threadIdx.x, n4 = tid & 63, kr = tid >> 6, n = jb.nt * 256 + n4 * 4;
    const float* q = jb.src + (size_t)(jb.kt * 128 + kr) * jb.Nsrc + n;
#pragma unroll
    for (int i = 0; i < 16; ++i) { if (n < jb.Nsrc) { const f32x4 t = __builtin_nontemporal_load((const f32x4*)(q + (size_t)(8 * i) * jb.Nsrc)); v[i] = make_float4(t[0], t[1], t[2], t[3]); } else v[i] = make_float4(0.f, 0.f, 0.f, 0.f); }
}
__device__ __forceinline__ void conv_to_lds(const ConvJob& jb, const float4 (&v)[16]) {
    bf16_t* T = (bf16_t*)smem;
    const int tid = threadIdx.x, n4 = tid & 63, kr = tid >> 6;
#pragma unroll
    for (int i = 0; i < 16; ++i) {
        const int k = kr + 8 * i;
        float4 w = v[i];
        if (jb.mode == 1) { const float g = jb.gain[jb.kt * 128 + k]; w.x *= g; w.y *= g; w.z *= g; w.w *= g; }
        if (jb.f8) { *(unsigned*)((char*)smem + k * CONV8_RS + n4 * 4) = pk4_fp8(w.x * W8_SCALE, w.y * W8_SCALE, w.z * W8_SCALE, w.w * W8_SCALE); continue; }
        u32x2 pk; pk.x = cvtpk(w.x, w.y); pk.y = cvtpk(w.z, w.w);
        *(u32x2*)(T + k * 260 + n4 * 4) = pk;
    }
}
__device__ __forceinline__ void conv_readout(const ConvJob& jb) {
    const bf16_t* T = (const bf16_t*)smem;
    const int tid = threadIdx.x, k0 = jb.kt * 128;
    if (jb.f8) {
        const unsigned char* T8 = (const unsigned char*)smem;
#pragma unroll
        for (int i = 0; i < 4; ++i) {
            const int cc = tid + 512 * i, nn = cc >> 3, kc = cc & 7;
            const int col = (jb.mode == 2) ? (2 * (nn & 127) + (nn >> 7)) : nn;
            unsigned e[16];
#pragma unroll
            for (int j = 0; j < 16; ++j) e[j] = T8[(kc * 16 + j) * CONV8_RS + col];
            u32x4 o;
#pragma unroll
            for (int q = 0; q < 4; ++q) o[q] = e[4 * q] | (e[4 * q + 1] << 8) | (e[4 * q + 2] << 16) | (e[4 * q + 3] << 24);
            __builtin_nontemporal_store(o, (u32x4*)((char*)jb.dst + (size_t)(jb.nt * 256 + nn) * jb.K + k0 + kc * 16));
        }
        return;
    }
#pragma unroll
    for (int i = 0; i < 8; ++i) {
        const int cc = tid + 512 * i, nn = cc >> 4, kc = cc & 15;
        const int col = (jb.mode == 2) ? (2 * (nn & 127) + (nn >> 7)) : nn;
        unsigned short e[8];
#pragma unroll
        for (int j = 0; j < 8; ++j) e[j] = T[(kc * 8 + j) * 260 + col];
        u32x4 o; o.x = e[0] | ((unsigned)e[1] << 16); o.y = e[2] | ((unsigned)e[3] << 16); o.z = e[4] | ((unsigned)e[5] << 16); o.w = e[6] | ((unsigned)e[7] << 16);
        __builtin_nontemporal_store(o, (u32x4*)(jb.dst + (size_t)(jb.nt * 256 + nn) * jb.K + k0 + kc * 8));
    }
}

__device__ __forceinline__ void adaln_job(PRef p, int job) {
    const int l = job / 24, cb = (job % 24) * 256, tid = threadIdx.x;
    float* sv = (float*)smem;
    for (int i = tid; i < 2048; i += NTH) { const int k = i & 1023; const float xx = (i < 1024) ? p.c[k] : p.c_ctx[k]; sv[i] = silu_f(xx); }
    __syncthreads();
    const int col4 = tid & 63, kq = tid >> 6;
    float4 a0 = make_float4(0, 0, 0, 0), a1 = make_float4(0, 0, 0, 0);
    const float* w = p.ada_w + ((size_t)l * 1024 + kq * 128) * 6144 + cb + col4 * 4;
#pragma unroll 8
    for (int k = 0; k < 128; ++k) {
        const float4 wv = *(const float4*)(w + (size_t)k * 6144);
        const float s0 = sv[kq * 128 + k], s1 = sv[1024 + kq * 128 + k];
        a0.x += s0 * wv.x; a0.y += s0 * wv.y; a0.z += s0 * wv.z; a0.w += s0 * wv.w;
        a1.x += s1 * wv.x; a1.y += s1 * wv.y; a1.z += s1 * wv.z; a1.w += s1 * wv.w;
    }
    float* red = sv + 2048;
    *(float4*)(red + (kq * 2 + 0) * 256 + col4 * 4) = a0;
    *(float4*)(red + (kq * 2 + 1) * 256 + col4 * 4) = a1;
    __syncthreads();
    {
        const int s = tid >> 8, col = tid & 255;
        float acc = p.ada_b[l * 6144 + cb + col];
#pragma unroll
        for (int q = 0; q < 8; ++q) acc += red[(q * 2 + s) * 256 + col];
        ((float*)(p.ws + WS_MOD))[(l * 2 + s) * 6144 + cb + col] = acc;
    }
    __syncthreads();
}

__device__ __forceinline__ void tables_job(PRef p) {
    float* rope = (float*)(p.ws + WS_ROPE);
    const int tid = threadIdx.x;
    for (int i = tid; i < (256 + 64) * 16; i += NTH) {
        const bool isrow = i < 256 * 16;
        const int idx = isrow ? i : i - 256 * 16, pos = idx >> 4, j = idx & 15;
        const float inv = exp2f(-(float)j * (13.287712379549449f / 16.f));
        const float ang = (float)pos * inv;
        float rev = ang * 0.15915494309189535f; rev -= rintf(rev);
        const float cs = __builtin_amdgcn_cosf(rev), sn = __builtin_amdgcn_sinf(rev);
        if (isrow) { rope[idx] = cs; rope[256 * 16 + idx] = sn; }
        else { rope[512 * 16 + idx] = cs; rope[512 * 16 + 64 * 16 + idx] = sn; }
    }
    if (tid < 64) ((int*)(p.ws + WS_CNT))[tid] = 0;
}
__device__ __forceinline__ void rwt_job(PRef p, int l) {
    float* dst = (float*)(p.ws + WS_RWT) + (size_t)l * 32 * 1024;
    const float* src = p.router_w + (size_t)l * 1024 * 32;
    for (int i = threadIdx.x; i < 32 * 1024; i += NTH) { const int cch = i >> 5, e = i & 31; dst[e * 1024 + cch] = src[i]; }
}

constexpr int J_IN = 8 * 8, J_UQ = 2 * 3, J_UKV = 1 * 4, J_OUT0 = 32, J_QKV = 8 * 12, J_NAO = 32, J_W1 = 64 * 64, J_W2 = 64 * 32;
constexpr int J_TOTAL = J_IN + J_UQ + J_UKV + J_OUT0 + J_QKV + J_NAO + J_W1 + J_W2;
__device__ __forceinline__ ConvJob conv_decode(PRef p, int j) {
    ConvJob jb; jb.gain = nullptr; jb.mode = 0; jb.f8 = 0;
    int t = j;
    if (t < J_W1) { const int m = t >> 6, q = t & 63; jb.src = p.moe_w1 + (size_t)m * 1024 * 2048; jb.dst = (bf16_t*)(p.ws + WS_W1T + (size_t)m * 2048 * 1024); jb.K = 1024; jb.Nsrc = 2048; jb.kt = q >> 3; jb.nt = q & 7; jb.mode = 2; jb.f8 = 1; return jb; } t -= J_W1;
    if (t < J_W2) { const int m = t >> 5, q = t & 31; jb.src = p.moe_w2 + (size_t)m * 1024 * 1024; jb.dst = (bf16_t*)(p.ws + WS_W2T + (size_t)m * 1024 * 1024); jb.K = 1024; jb.Nsrc = 1024; jb.kt = q >> 2; jb.nt = q & 3; jb.f8 = 1; return jb; } t -= J_W2;
    if (t < J_IN) { jb.src = p.ab_in_w; jb.dst = (bf16_t*)(p.ws + WS_WIN); jb.K = 1024; jb.Nsrc = 2016; jb.kt = t / 8; jb.nt = t % 8; return jb; } t -= J_IN;
    if (t < J_UQ) { jb.src = p.mla_wuq; jb.dst = (bf16_t*)(p.ws + WS_WUQ); jb.K = 256; jb.Nsrc = 768; jb.kt = t / 3; jb.nt = t % 3; jb.mode = 1; jb.gain = p.mla_qnorm; return jb; } t -= J_UQ;
    if (t < J_UKV) { jb.src = p.mla_wukv; jb.dst = (bf16_t*)(p.ws + WS_WUKV); jb.K = 128; jb.Nsrc = 1024; jb.kt = 0; jb.nt = t; jb.mode = 1; jb.gain = p.mla_kvnorm; return jb; } t -= J_UKV;
    if (t < J_OUT0) { jb.src = p.ab_out_w; jb.dst = (bf16_t*)(p.ws + WS_WOUT0); jb.K = 1024; jb.Nsrc = 1024; jb.kt = t / 4; jb.nt = t % 4; return jb; } t -= J_OUT0;
    if (t < J_QKV) { jb.src = p.na_qkv_w; jb.dst = (bf16_t*)(p.ws + WS_WQKV); jb.K = 1024; jb.Nsrc = 3072; jb.kt = t / 12; jb.nt = t % 12; return jb; } t -= J_QKV;
    jb.src = p.na_out_w; jb.dst = (bf16_t*)(p.ws + WS_WNAO); jb.K = 1024; jb.Nsrc = 1024; jb.kt = t / 4; jb.nt = t % 4; return jb;
}

__device__ __forceinline__ void phase_prologue(PRef p) {
    const int G = gridDim.x, b = blockIdx.x;
    for (int j = b; j < 51; j += G) {
        if (j < 48) adaln_job(p, j);
        else if (j == 48) tables_job(p);
        else rwt_job(p, j - 49);
    }
    __syncthreads();
    int j = b;
    if (j >= J_TOTAL) return;
    ConvJob cur = conv_decode(p, j);
    float4 v[16];
    conv_load(cur, v);
    for (;;) {
        conv_to_lds(cur, v);
        __syncthreads();
        const int jn = j + G;
        ConvJob nxt = cur;
        if (jn < J_TOTAL) { nxt = conv_decode(p, jn); conv_load(nxt, v); }
        conv_readout(cur);
        __syncthreads();
        if (jn >= J_TOTAL) break;
        cur = nxt; j = jn;
    }
}

namespace gm {
constexpr int BK = 64, HT = 128 * 64;
__device__ __forceinline__ int lds_byte(int r, int c) { const int st = (r >> 4) * 2 + (c >> 5), rr = r & 15, cc = c & 31, ob = rr * 64 + cc * 2; return st * 1024 + (ob ^ (((ob >> 9) & 1) << 5)); }
__device__ __forceinline__ void stage_rc(int b, int& R, int& C) { const int st = b / 1024, sb = b % 1024, swz = sb ^ (((sb >> 9) & 1) << 5); R = (st >> 1) * 16 + swz / 64; C = (st & 1) * 32 + (swz % 64) / 2; }

template <class Epi>
__device__ __forceinline__ void gemm_tile(const bf16_t* __restrict__ A, const int (&aoff)[2][2], const bf16_t* __restrict__ Bt, const int (&boff)[2], int nk, Epi& epi) {
    bf16_t* shm = (bf16_t*)smem;
    const int tid = tid_opaque(), wid = tid >> 6, lane = tid & 63, wr = wid >> 1, wc = wid & 1, fr = lane & 15, fq = lane >> 4;
    f32x4 acc[4][4];
#pragma unroll
    for (int m = 0; m < 4; ++m)
#pragma unroll
        for (int n = 0; n < 4; ++n) acc[m][n] = (f32x4){0.f, 0.f, 0.f, 0.f};
#define GM_STAGE(buf, kt) do { \
        _Pragma("unroll") for (int _i = 0; _i < 2; ++_i) { \
            __builtin_amdgcn_global_load_lds((const unsigned*)(A + aoff[0][_i] + (kt) * BK), (unsigned*)((char*)(shm + ((buf) * 3 + 0) * HT) + tid * 16 + _i * 8192), 16, 0, 0); \
            __builtin_amdgcn_global_load_lds((const unsigned*)(A + aoff[1][_i] + (kt) * BK), (unsigned*)((char*)(shm + ((buf) * 3 + 1) * HT) + tid * 16 + _i * 8192), 16, 0, 0); \
            __builtin_amdgcn_global_load_lds((const unsigned*)(Bt + boff[_i] + (kt) * BK), (unsigned*)((char*)(shm + ((buf) * 3 + 2) * HT) + tid * 16 + _i * 8192), 16, 0, 0); } } while (0)
    GM_STAGE(0, 0);
    for (int kt = 0; kt < nk; ++kt) {
        __syncthreads();
        const int buf = kt & 1;
        if (kt + 1 < nk) GM_STAGE(buf ^ 1, kt + 1);
        const char* Ab = (const char*)(shm + (buf * 3 + (wr >> 1)) * HT);
        const char* Bb = (const char*)(shm + (buf * 3 + 2) * HT);
#pragma unroll
        for (int k = 0; k < 2; ++k) {
            bf16x8 Bf[4], Af[4];
#pragma unroll
            for (int n = 0; n < 4; ++n) Bf[n] = *(const bf16x8*)(Bb + lds_byte(wc * 64 + n * 16 + fr, k * 32 + fq * 8));
#pragma unroll
            for (int m = 0; m < 4; ++m) Af[m] = *(const bf16x8*)(Ab + lds_byte((wr & 1) * 64 + m * 16 + fr, k * 32 + fq * 8));
#pragma unroll
            for (int m = 0; m < 4; ++m)
#pragma unroll
                for (int n = 0; n < 4; ++n) acc[m][n] = __builtin_amdgcn_mfma_f32_16x16x32_bf16(Af[m], Bf[n], acc[m][n], 0, 0, 0);
        }
    }
#undef GM_STAGE
    float* stg = (float*)smem;
    __syncthreads();
    {
        float* wb = stg + (wr * 64 + fq * 4) * 132 + wc * 64 + fr;
#pragma unroll
        for (int m = 0; m < 4; ++m)
#pragma unroll
            for (int n = 0; n < 4; ++n)
#pragma unroll
                for (int j = 0; j < 4; ++j) wb[(m * 16 + j) * 132 + n * 16] = acc[m][n][j];
    }
    __syncthreads();
    if (Epi::MOE1) {
        const int fch = tid & 7, rg = tid >> 3;
        for (int ps = 0; ps < 4; ++ps) {
            const int row = ps * 64 + rg;
            const float* q = stg + row * 132 + (fch >> 1) * 32 + (fch & 1) * 8;
            float g[8], l[8];
            *(f32x4*)&g[0] = *(const f32x4*)q; *(f32x4*)&g[4] = *(const f32x4*)(q + 4);
            *(f32x4*)&l[0] = *(const f32x4*)(q + 16); *(f32x4*)&l[4] = *(const f32x4*)(q + 20);
            epi.pair(row, fch * 8, g, l);
        }
    } else {
        const int ch = tid & 15, rg = tid >> 4;
        for (int ps = 0; ps < 8; ++ps) {
            const int row = ps * 32 + rg;
            const float* q = stg + row * 132 + ch * 8;
            float v[8];
            *(f32x4*)&v[0] = *(const f32x4*)q; *(f32x4*)&v[4] = *(const f32x4*)(q + 4);
            epi.row8(row, ch * 8, v);
        }
    }
    __syncthreads();
}
__device__ __forceinline__ void make_off(int (&off)[2][2], int row0, int ld) {
#pragma unroll
    for (int h = 0; h < 2; ++h)
#pragma unroll
        for (int i = 0; i < 2; ++i) { int R, C; stage_rc(tid_opaque() * 16 + i * 8192, R, C); off[h][i] = (row0 + h * 128 + R) * ld + C; }
}
__device__ __forceinline__ void make_off1(int (&off)[2], int row0, int ld) {
#pragma unroll
    for (int i = 0; i < 2; ++i) { int R, C; stage_rc(tid_opaque() * 16 + i * 8192, R, C); off[i] = (row0 + R) * ld + C; }
}
}

namespace pg8 {
#define PG8_LAS __attribute__((address_space(3)))
constexpr int BM = 256, BK = 64, HALF = 128, HTB = HALF * BK * 2, STAGE_BYTES = 8 * HTB, NXCD = 8, WGM = 8;
__device__ __forceinline__ int lds_byte(int r, int c) { const int st = (r >> 4) * 2 + (c >> 5), rr = r & 15, cc = c & 31, ob = rr * 64 + cc * 2; return st * 1024 + (ob ^ (((ob >> 9) & 1) << 5)); }
__device__ __forceinline__ void stage_rc(int b, int& R, int& C) { const int st = b / 1024, sb = b % 1024, swz = sb ^ (((sb >> 9) & 1) << 5); R = (st >> 1) * 16 + swz / 64; C = (st & 1) * 32 + (swz % 64) / 2; }
__device__ __forceinline__ int perm32(int rho) { const int n = rho >> 4, i = rho & 15; return 8 * (i >> 2) + 4 * n + (i & 3); }
struct Unit { int pm, pn, e, nvalid, slot0; };

template <class Epi, class Sched, bool GATHER, bool F8 = false>
__device__ __forceinline__ void gemm_phase(PG8_LAS unsigned char* lds, const Sched& S, const Epi& E, int K, int lda, int ldb, int scA = 0x7F7F7F7F, int scB = 0x7F7F7F7F) {
    const int tid = tid_opaque(), wid = __builtin_amdgcn_readfirstlane(tid >> 6), lane = tid & 63, wr = wid >> 2, wc = wid & 3, fr = lane & 15, fq = lane >> 4;
    const int nt = K / BK;
    unsigned voffA[2], voffB[2]; int gR[2], gC[2];
#pragma unroll
    for (int i = 0; i < 2; ++i) { int R, C; stage_rc(tid * 16 + i * 8192, R, C); const int Rb = Epi::PERM ? ((R & ~31) + perm32(R & 31)) : R;
        voffA[i] = (unsigned)(R * lda + C) * 2u; voffB[i] = (unsigned)(Rb * ldb + C) * 2u; gR[i] = R; gC[i] = C * 2; }
    const size_t kstep = (size_t)(BK * 2);
    const size_t hstepA = (size_t)HALF * lda * 2, hstepB = (size_t)HALF * ldb * 2;
    const unsigned ldsw = (unsigned)wid * 1024u;
    const int aoff = lds_byte(wr * 64 + fr, fq * 8), boff = lds_byte(wc * 32 + fr, fq * 8);
    unsigned gA[2][2] = {{0u, 0u}, {0u, 0u}};
#define PG8_SA(b, h) (((b) * 2 + (h)) * HTB)
#define PG8_SB(b, h) ((4 + (b) * 2 + (h)) * HTB)
#define PG8_STAGE(bufoff, gbase, voff) do { _Pragma("unroll") for (int _i = 0; _i < 2; ++_i) \
        __builtin_amdgcn_global_load_lds((const unsigned*)((const char*)(gbase) + (voff)[_i]), (PG8_LAS unsigned*)(lds + (bufoff) + ldsw + _i * 8192), 16, 0, 0); } while (0)
#define PG8_STAGE_A(bufoff, base, h) do { if constexpr (GATHER) PG8_STAGE(bufoff, base, gA[h]); else PG8_STAGE(bufoff, (base) + (h) * hstepA, voffA); } while (0)
#define PG8_LDA(dst, b, h) do { _Pragma("unroll") for (int m = 0; m < 4; ++m) _Pragma("unroll") for (int k = 0; k < 2; ++k) dst[m][k] = *(const PG8_LAS bf16x8*)(lds + PG8_SA(b, h) + aoff + m * 2048 + k * 1024); } while (0)
#define PG8_LDB(dst, b, h) do { _Pragma("unroll") for (int n = 0; n < 2; ++n) _Pragma("unroll") for (int k = 0; k < 2; ++k) dst[n][k] = *(const PG8_LAS bf16x8*)(lds + PG8_SB(b, h) + boff + n * 2048 + k * 1024); } while (0)
#define PG8_MMA(ai, bj, At, Bt) do { __builtin_amdgcn_s_setprio(1); _Pragma("unroll") for (int m = 0; m < 4; ++m) _Pragma("unroll") for (int n = 0; n < 2; ++n) { \
        if constexpr (F8) { const i32x4 _b0 = __builtin_bit_cast(i32x4, Bt[n][0]), _b1 = __builtin_bit_cast(i32x4, Bt[n][1]), _a0 = __builtin_bit_cast(i32x4, At[m][0]), _a1 = __builtin_bit_cast(i32x4, At[m][1]); \
            acc[ai][bj][m][n] = __builtin_amdgcn_mfma_scale_f32_16x16x128_f8f6f4(__builtin_shufflevector(_b0, _b1, 0, 1, 2, 3, 4, 5, 6, 7), __builtin_shufflevector(_a0, _a1, 0, 1, 2, 3, 4, 5, 6, 7), acc[ai][bj][m][n], 0, 0, 0, scB, 0, scA); } \
        else { _Pragma("unroll") for (int k = 0; k < 2; ++k) acc[ai][bj][m][n] = __builtin_amdgcn_mfma_f32_16x16x32_bf16(Bt[n][k], At[m][k], acc[ai][bj][m][n], 0, 0, 0); } } __builtin_amdgcn_s_setprio(0); } while (0)
#define PG8_WAIT_V(n) asm volatile("s_waitcnt vmcnt(" #n ")" ::: "memory")
#define PG8_WAIT_L(n) asm volatile("s_waitcnt lgkmcnt(" #n ")" ::: "memory")
#define PG8_BAR __builtin_amdgcn_s_barrier()
#define PG8_SCHED __builtin_amdgcn_sched_barrier(0)
#define PG8_GLOAD(ui_) do { const PG8_LAS int* _gl = S.glist(ui_); _Pragma("unroll") for (int _h = 0; _h < 2; ++_h) _Pragma("unroll") for (int _i = 0; _i < 2; ++_i) \
        gA[_h][_i] = ((unsigned)_gl[_h * 128 + gR[_i]] << (F8 ? 10 : 11)) + (unsigned)gC[_i]; } while (0)
    Unit cur, nxt; int ui = 0;
    if (!S.next(0, cur)) return;
    f32x4 acc[2][2][4][2];
#pragma unroll
    for (int a = 0; a < 2; ++a)
#pragma unroll
        for (int b = 0; b < 2; ++b)
#pragma unroll
            for (int m = 0; m < 4; ++m)
#pragma unroll
                for (int n = 0; n < 2; ++n) acc[a][b][m][n] = (f32x4){0.f, 0.f, 0.f, 0.f};
    bf16x8 At[4][2], B0[2][2], B1[2][2];
    const char* cA = S.a_base(cur); const char* cB = S.b_base(cur);
    if constexpr (GATHER) PG8_GLOAD(0);
    PG8_STAGE(PG8_SB(0, 0), cB, voffB); PG8_STAGE_A(PG8_SA(0, 0), cA, 0); PG8_STAGE(PG8_SB(0, 1), cB + hstepB, voffB); PG8_STAGE_A(PG8_SA(0, 1), cA, 1);
    if (wr == 1) PG8_BAR;
    PG8_WAIT_V(4); PG8_BAR;
    PG8_STAGE(PG8_SB(1, 0), cB + kstep, voffB); PG8_STAGE_A(PG8_SA(1, 0), cA + kstep, 0); PG8_STAGE(PG8_SB(1, 1), cB + hstepB + kstep, voffB);
    PG8_WAIT_V(6); PG8_BAR;
    for (;;) {
        const bool has_next = S.next(ui + 1, nxt);
        const char* nA = has_next ? S.a_base(nxt) : cA; const char* nB = has_next ? S.b_base(nxt) : cB;
#pragma unroll 1
        for (int t = 0; t < nt; t += 2) {
            const bool last = (t == nt - 2);
            const char* a1 = cA + (size_t)(t + 1) * kstep;
            const char* a2 = last ? nA : cA + (size_t)(t + 2) * kstep; const char* b2 = last ? nB : cB + (size_t)(t + 2) * kstep;
            const char* a3 = a2 + kstep; const char* b3 = b2 + kstep;
            PG8_LDB(B0, 0, 0); PG8_SCHED; PG8_LDA(At, 0, 0); PG8_STAGE_A(PG8_SA(1, 1), a1, 1);
            PG8_WAIT_L(8); PG8_BAR; PG8_WAIT_L(0); PG8_MMA(0, 0, At, B0); PG8_BAR; PG8_SCHED;
            if constexpr (GATHER) { if (last && has_next) PG8_GLOAD(ui + 1); }
            PG8_LDB(B1, 0, 1); PG8_STAGE(PG8_SB(0, 0), b2, voffB);
            PG8_BAR; PG8_WAIT_L(0); PG8_MMA(0, 1, At, B1); PG8_BAR;
            PG8_LDA(At, 0, 1); PG8_STAGE_A(PG8_SA(0, 0), a2, 0);
            PG8_BAR; PG8_WAIT_L(0); PG8_MMA(1, 0, At, B0); PG8_BAR; PG8_SCHED;
            PG8_STAGE(PG8_SB(0, 1), b2 + hstepB, voffB);
            PG8_WAIT_V(6); PG8_BAR; PG8_MMA(1, 1, At, B1); PG8_BAR;
            PG8_LDB(B0, 1, 0); PG8_SCHED; PG8_LDA(At, 1, 0); PG8_STAGE_A(PG8_SA(0, 1), a2, 1);
            PG8_WAIT_L(8); PG8_BAR; PG8_WAIT_L(0); PG8_MMA(0, 0, At, B0); PG8_BAR; PG8_SCHED;
            PG8_LDB(B1, 1, 1); PG8_STAGE(PG8_SB(1, 0), b3, voffB);
            PG8_BAR; PG8_WAIT_L(0); PG8_MMA(0, 1, At, B1); PG8_BAR;
            PG8_LDA(At, 1, 1); PG8_STAGE_A(PG8_SA(1, 0), a3, 0);
            PG8_BAR; PG8_WAIT_L(0); PG8_MMA(1, 0, At, B0); PG8_BAR; PG8_SCHED;
            PG8_STAGE(PG8_SB(1, 1), b3 + hstepB, voffB);
            PG8_WAIT_V(6); PG8_BAR; PG8_MMA(1, 1, At, B1); PG8_BAR;
        }
        { int fr_e = fr, fq_e = fq; asm volatile("" : "+v"(fr_e), "+v"(fq_e));
          E(acc, cur, wr, wc, fr_e, fq_e); }
        if (!has_next) break;
#pragma unroll
        for (int a = 0; a < 2; ++a)
#pragma unroll
            for (int b = 0; b < 2; ++b)
#pragma unroll
                for (int m = 0; m < 4; ++m)
#pragma unroll
                    for (int n = 0; n < 2; ++n) acc[a][b][m][n] = (f32x4){0.f, 0.f, 0.f, 0.f};
        cur = nxt; cA = nA; cB = nB; ++ui;
    }
    PG8_WAIT_V(0);
    if (wr == 0) PG8_BAR;
    PG8_BAR;
#undef PG8_SA
#undef PG8_SB
#undef PG8_STAGE
#undef PG8_STAGE_A
#undef PG8_LDA
#undef PG8_LDB
#undef PG8_MMA
#undef PG8_WAIT_V
#undef PG8_WAIT_L
#undef PG8_BAR
#undef PG8_SCHED
#undef PG8_GLOAD
}

struct PlainOrder {
    const char* A; const char* Bt; int lda, ldb, nM, nN, nwg, G, c;
    __device__ void init(const bf16_t* A_, int lda_, const bf16_t* Bt_, int ldb_, int nM_, int nN_) { A = (const char*)A_; Bt = (const char*)Bt_; lda = lda_; ldb = ldb_; nM = nM_; nN = nN_; nwg = nM * nN; G = gridDim.x; c = blockIdx.x; }
    __device__ __forceinline__ bool next(int i, Unit& u) const {
        const long L = (long)i * G + c; if (L >= nwg) return false;
        int wgid = (int)L; { const int q = nwg / NXCD, r = nwg % NXCD, xcd = wgid % NXCD, off = wgid / NXCD; wgid = (xcd < r ? xcd * (q + 1) : r * (q + 1) + (xcd - r) * q) + off; }
        const int nig = WGM * nN, gid = wgid / nig, fm = gid * WGM, gsz = (nM - fm) < WGM ? (nM - fm) : WGM;
        u.pm = fm + ((wgid % nig) % gsz); u.pn = (wgid % nig) / gsz; u.e = 0; u.nvalid = 256; u.slot0 = 0; return true;
    }
    __device__ __forceinline__ const char* a_base(const Unit& u) const { return A + (size_t)u.pm * 256 * lda * 2; }
    __device__ __forceinline__ const char* b_base(const Unit& u) const { return Bt + (size_t)u.pn * 256 * ldb * 2; }
    __device__ __forceinline__ const PG8_LAS int* glist(int) const { return nullptr; }
};
struct MoeOrder {
    const char* A; const char* W; const PG8_LAS int* tab; const PG8_LAS int* gl; int wrows, nunits;
    __device__ __forceinline__ bool next(int i, Unit& u) const {
        if (i >= nunits) return false;
        const PG8_LAS int* t = tab + i * 8;
        u.pm = t[0]; u.pn = t[1]; u.e = t[2]; u.nvalid = t[3]; u.slot0 = t[4]; return true;
    }
    __device__ __forceinline__ const char* a_base(const Unit& u) const { return A + (size_t)u.slot0 * 1024; }
    __device__ __forceinline__ const char* b_base(const Unit& u) const { return W + ((size_t)u.e * wrows + (size_t)u.pn * 256) * 1024; }
    __device__ __forceinline__ const PG8_LAS int* glist(int i) const { return gl + i * 256; }
};
constexpr int MOE_UNITS_MAX = 16;
__device__ __forceinline__ int moe_build_units(PG8_LAS int* tab, const int* cnt, const int* off, const int* toff, int nN) {
    const int G = gridDim.x, c = blockIdx.x, x = c & 7, j = c >> 3, per = (G >> 3) / nN, nMt = toff[32];
    const int i = threadIdx.x;
    if (i < MOE_UNITS_MAX) {
        const int pn = j % nN, mt = (i * 8 + x) * per + j / nN;
        int e = 0, valid = (mt < nMt && j < per * nN) ? 1 : 0;
        if (valid) { while (toff[e + 1] <= mt) ++e; }
        const int m = mt - toff[e];
        tab[i * 8 + 0] = mt; tab[i * 8 + 1] = pn; tab[i * 8 + 2] = e; tab[i * 8 + 3] = cnt[e] - m * 256; tab[i * 8 + 4] = off[e] + m * 256; tab[i * 8 + 5] = valid;
    }
    __syncthreads();
    int n = 0;
    while (n < MOE_UNITS_MAX && tab[n * 8 + 5]) ++n;
    return n;
}
struct MoeOrderG : MoeOrder { __device__ __forceinline__ const char* a_base(const Unit&) const { return A; } };

__device__ __forceinline__ u32x4 pk8(const f32x4& a, const f32x4& b) { return (u32x4){cvtpk(a[0], a[1]), cvtpk(a[2], a[3]), cvtpk(b[0], b[1]), cvtpk(b[2], b[3])}; }
struct EpiStore {
    static constexpr bool PERM = true;
    bf16_t* C; int ldc; const float* rs;
    __device__ __forceinline__ void operator()(const f32x4 (&acc)[2][2][4][2], const Unit& u, int wr, int wc, int fr, int fq) const {
        bf16_t* base = C + ((size_t)u.pm * 256 + wr * 64 + fr) * ldc + u.pn * 256 + wc * 32 + 8 * fq;
#pragma unroll
        for (int ai = 0; ai < 2; ++ai)
#pragma unroll
            for (int m = 0; m < 4; ++m) { bf16_t* rowp = base + (size_t)(ai * HALF + m * 16) * ldc; const float s = rs ? rs[ai * HALF + wr * 64 + m * 16 + fr] : 1.f;
#pragma unroll
                for (int bj = 0; bj < 2; ++bj) *(u32x4*)(rowp + bj * HALF) = pk8(acc[ai][bj][m][0] * s, acc[ai][bj][m][1] * s); }
    }
};
constexpr float ACT8_SCALE = 4.f;
struct EpiAct {
    static constexpr bool PERM = true;
    unsigned char* Act; const float* b1all;
    __device__ __forceinline__ void operator()(const f32x4 (&acc)[2][2][4][2], const Unit& u, int wr, int wc, int fr, int fq) const {
        const int f0 = u.pn * 128 + wc * 32 + 8 * fq;
        const float* bb = b1all + (size_t)u.e * 2048 + 2 * f0;
        f32x4 bv[4];
#pragma unroll
        for (int q = 0; q < 4; ++q) bv[q] = *(const f32x4*)(bb + 4 * q);
        unsigned char* base = Act + ((size_t)u.slot0 + wr * 64 + fr) * 1024 + f0;
#pragma unroll
        for (int ai = 0; ai < 2; ++ai)
#pragma unroll
            for (int m = 0; m < 4; ++m) {
                const int r = ai * HALF + wr * 64 + m * 16 + fr;
                float a[8];
#pragma unroll
                for (int n = 0; n < 2; ++n)
#pragma unroll
                    for (int j = 0; j < 4; ++j) { const int f = 4 * n + j;
                        float glu = acc[ai][0][m][n][j] + bv[f >> 1][(f & 1) * 2], lin = acc[ai][1][m][n][j] + bv[f >> 1][(f & 1) * 2 + 1];
                        glu = fminf(glu, 7.f); lin = fminf(fmaxf(lin, -7.f), 7.f);
                        a[f] = glu * __builtin_amdgcn_rcpf(1.f + __builtin_amdgcn_exp2f(-1.702f * LOG2E * glu)) * (lin * ACT8_SCALE + ACT8_SCALE); }
                if (r < u.nvalid) *(u32x2*)(base + (size_t)(ai * HALF + m * 16) * 1024) = (u32x2){pk4_fp8(a[0], a[1], a[2], a[3]), pk4_fp8(a[4], a[5], a[6], a[7])};
            }
    }
};
struct EpiBias {
    static constexpr bool PERM = true;
    bf16_t* Y; const float* b2all;
    __device__ __forceinline__ void operator()(const f32x4 (&acc)[2][2][4][2], const Unit& u, int wr, int wc, int fr, int fq) const {
        const int c0 = u.pn * 256 + wc * 32 + 8 * fq;
        const float* bb = b2all + (size_t)u.e * 1024 + c0;
        f32x4 bv[2][2];
#pragma unroll
        for (int bj = 0; bj < 2; ++bj)
#pragma unroll
            for (int n = 0; n < 2; ++n) bv[bj][n] = *(const f32x4*)(bb + bj * HALF + 4 * n);
        bf16_t* base = Y + ((size_t)u.slot0 + wr * 64 + fr) * 1024 + c0;
#pragma unroll
        for (int ai = 0; ai < 2; ++ai)
#pragma unroll
            for (int m = 0; m < 4; ++m) { const int r = ai * HALF + wr * 64 + m * 16 + fr;
                if (r < u.nvalid) {
#pragma unroll
                    for (int bj = 0; bj < 2; ++bj) *(u32x4*)(base + (size_t)(ai * HALF + m * 16) * 1024 + bj * HALF) = pk8(acc[ai][bj][m][0] + bv[bj][0], acc[ai][bj][m][1] + bv[bj][1]); } }
    }
};
}

__device__ __forceinline__ u32x4 pack8(const float (&v)[8]) { return (u32x4){cvtpk(v[0], v[1]), cvtpk(v[2], v[3]), cvtpk(v[4], v[5]), cvtpk(v[6], v[7])}; }
struct EpiPlain {
    static constexpr bool MOE1 = false;
    bf16_t* C; int ldc;
    __device__ __forceinline__ void row8(int r, int c, const float (&v)[8]) const { *(u32x4*)(C + (size_t)r * ldc + c) = pack8(v); }
    __device__ __forceinline__ void pair(int, int, const float (&)[8], const float (&)[8]) const {}
};
struct EpiRowScale {
    static constexpr bool MOE1 = false;
    bf16_t* C; int ldc; const float* rs;
    __device__ __forceinline__ void row8(int r, int c, const float (&v)[8]) const { const float s = rs[r]; float w[8];
#pragma unroll
        for (int i = 0; i < 8; ++i) w[i] = v[i] * s;
        *(u32x4*)(C + (size_t)r * ldc + c) = pack8(w); }
    __device__ __forceinline__ void pair(int, int, const float (&)[8], const float (&)[8]) const {}
};
__device__ __forceinline__ void phase_gemm_plain(const bf16_t* A, int lda, const bf16_t* Bt, int K, bf16_t* C, int ldc, int nM, int nN) {
    const int G = gridDim.x;
    for (int u = blockIdx.x; u < nM * nN; u += G) {
        const int pm = u / nN, pn = u % nN;
        int aoff[2][2], boff[2];
        gm::make_off(aoff, pm * 256, lda); gm::make_off1(boff, pn * 128, K);
        EpiPlain epi{C + (size_t)pm * 256 * ldc + pn * 128, ldc};
        gm::gemm_tile(A, aoff, Bt, boff, K / 64, epi);
    }
}

struct Row16 { float4 v[4]; };
__device__ __forceinline__ Row16 ld_row_f32(const float* p, int lane) { Row16 r;
#pragma unroll
    for (int i = 0; i < 4; ++i) r.v[i] = *(const float4*)(p + lane * 4 + 256 * i);
    return r; }
__device__ __forceinline__ Row16 ld_row_bf16(const bf16_t* p, int lane) { Row16 r;
#pragma unroll
    for (int i = 0; i < 4; ++i) { const u32x2 w = *(const u32x2*)(p + lane * 4 + 256 * i);
        r.v[i] = make_float4(__uint_as_float(w.x << 16), __uint_as_float(w.x & 0xFFFF0000u), __uint_as_float(w.y << 16), __uint_as_float(w.y & 0xFFFF0000u)); }
    return r; }
__device__ __forceinline__ void st_row_f32(float* p, int lane, const Row16& r) {
#pragma unroll
    for (int i = 0; i < 4; ++i) *(float4*)(p + lane * 4 + 256 * i) = r.v[i]; }
__device__ __forceinline__ void st_row_bf16(bf16_t* p, int lane, const Row16& r) {
#pragma unroll
    for (int i = 0; i < 4; ++i) { u32x2 w; w.x = cvtpk(r.v[i].x, r.v[i].y); w.y = cvtpk(r.v[i].z, r.v[i].w); *(u32x2*)(p + lane * 4 + 256 * i) = w; } }
__device__ __forceinline__ void st_row_fp8(unsigned char* p, int lane, const Row16& r) {
#pragma unroll
    for (int i = 0; i < 4; ++i) *(unsigned*)(p + lane * 4 + 256 * i) = pk4_fp8(r.v[i].x, r.v[i].y, r.v[i].z, r.v[i].w); }
__device__ __forceinline__ float row_rstd(const Row16& r) {
    float s = 0.f;
#pragma unroll
    for (int i = 0; i < 4; ++i) s += r.v[i].x * r.v[i].x + r.v[i].y * r.v[i].y + r.v[i].z * r.v[i].z + r.v[i].w * r.v[i].w;
    s = wave_sum(s);
    return rsqrtf(s * (1.f / 1024.f) + EPSN);
}
__device__ __forceinline__ Row16 norm_mod(const Row16& x, float rstd, const float* g, const float* sc, const float* sh, int lane) {
    Row16 h;
#pragma unroll
    for (int i = 0; i < 4; ++i) {
        const int c = lane * 4 + 256 * i;
        const float4 gv = *(const float4*)(g + c), scv = *(const float4*)(sc + c), shv = *(const float4*)(sh + c);
        h.v[i].x = x.v[i].x * rstd * gv.x * (1.f + scv.x) + shv.x; h.v[i].y = x.v[i].y * rstd * gv.y * (1.f + scv.y) + shv.y;
        h.v[i].z = x.v[i].z * rstd * gv.z * (1.f + scv.z) + shv.z; h.v[i].w = x.v[i].w * rstd * gv.w * (1.f + scv.w) + shv.w;
    }
    return h;
}
__device__ __forceinline__ Row16 resid_add(const Row16& x, const Row16& y, float rstd, const float* g, const float* gate, int lane) {
    Row16 o;
#pragma unroll
    for (int i = 0; i < 4; ++i) {
        const int c = lane * 4 + 256 * i;
        const float4 gv = *(const float4*)(g + c), ga = *(const float4*)(gate + c);
        o.v[i].x = x.v[i].x + y.v[i].x * rstd * gv.x * ga.x; o.v[i].y = x.v[i].y + y.v[i].y * rstd * gv.y * ga.y;
        o.v[i].z = x.v[i].z + y.v[i].z * rstd * gv.z * ga.z; o.v[i].w = x.v[i].w + y.v[i].w * rstd * gv.w * ga.w;
    }
    return o;
}
__device__ __forceinline__ const float* mod_ptr(PRef p, int l, int r) { return (const float*)(p.ws + WS_MOD) + (size_t)(l * 2 + (r < CTXN ? 1 : 0)) * 6144; }
__device__ __forceinline__ const float* src_row(PRef p, int r) { return r < CTXN ? p.ctx + (size_t)r * 1024 : p.x + (size_t)(r - CTXN) * 1024; }

struct ModAB { float4 a[4], b[4]; };
struct ModG { float4 g[4]; };
__device__ __forceinline__ ModAB load_ab(const float* g, const float* sc, const float* sh, int lane) { ModAB m;
#pragma unroll
    for (int i = 0; i < 4; ++i) { const int c = lane * 4 + 256 * i; const float4 gv = *(const float4*)(g + c), sv = *(const float4*)(sc + c); m.b[i] = *(const float4*)(sh + c);
        m.a[i] = make_float4(gv.x * (1.f + sv.x), gv.y * (1.f + sv.y), gv.z * (1.f + sv.z), gv.w * (1.f + sv.w)); }
    return m; }
__device__ __forceinline__ ModG load_g(const float* g, const float* gate, int lane) { ModG m;
#pragma unroll
    for (int i = 0; i < 4; ++i) { const int c = lane * 4 + 256 * i; const float4 gv = *(const float4*)(g + c), ga = *(const float4*)(gate + c); m.g[i] = make_float4(gv.x * ga.x, gv.y * ga.y, gv.z * ga.z, gv.w * ga.w); }
    return m; }
__device__ __forceinline__ Row16 apply_ab(const Row16& x, float rstd, const ModAB& m) { Row16 h;
#pragma unroll
    for (int i = 0; i < 4; ++i) h.v[i] = make_float4(x.v[i].x * rstd * m.a[i].x + m.b[i].x, x.v[i].y * rstd * m.a[i].y + m.b[i].y, x.v[i].z * rstd * m.a[i].z + m.b[i].z, x.v[i].w * rstd * m.a[i].w + m.b[i].w);
    return h; }
__device__ __forceinline__ Row16 apply_g(const Row16& x, const Row16& y, float rstd, const ModG& m) { Row16 o;
#pragma unroll
    for (int i = 0; i < 4; ++i) o.v[i] = make_float4(x.v[i].x + y.v[i].x * rstd * m.g[i].x, x.v[i].y + y.v[i].y * rstd * m.g[i].y, x.v[i].z + y.v[i].z * rstd * m.g[i].z, x.v[i].w + y.v[i].w * rstd * m.g[i].w);
    return o; }
struct RowB8 { u32x2 v[4]; };
__device__ __forceinline__ RowB8 ld_rowb(const bf16_t* p, int lane) { RowB8 r;
#pragma unroll
    for (int i = 0; i < 4; ++i) r.v[i] = *(const u32x2*)(p + lane * 4 + 256 * i);
    return r; }
__device__ __forceinline__ Row16 cvt_rowb(const RowB8& b) { Row16 r;
#pragma unroll
    for (int i = 0; i < 4; ++i) r.v[i] = make_float4(__uint_as_float(b.v[i].x << 16), __uint_as_float(b.v[i].x & 0xFFFF0000u), __uint_as_float(b.v[i].y << 16), __uint_as_float(b.v[i].y & 0xFFFF0000u));
    return r; }

__device__ __forceinline__ void phase_norm1_l0(PRef p) {
    const int lane = threadIdx.x & 63, wave = threadIdx.x >> 6, G = gridDim.x, step = G * 8;
    bf16_t* HB = (bf16_t*)(p.ws + WS_HB);
    int r = blockIdx.x * 8 + wave;
    if (r >= NTOK) return;
    int cur_s = (r < CTXN) ? 1 : 0;
    const float* mod = mod_ptr(p, 0, r);
    ModAB m = load_ab(p.norm_g, mod + 1024, mod, lane);
    Row16 x = ld_row_f32(src_row(p, r), lane);
    for (; r < NTOK; r += step) {
        const int rn = r + step;
        Row16 xn = x;
        if (rn < NTOK) xn = ld_row_f32(src_row(p, rn), lane);
        const int s_ = (r < CTXN) ? 1 : 0;
        if (s_ != cur_s) { cur_s = s_; const float* md = mod_ptr(p, 0, r); m = load_ab(p.norm_g, md + 1024, md, lane); }
        const float rstd = row_rstd(x);
        st_row_bf16(HB + (size_t)r * 1024, lane, apply_ab(x, rstd, m));
        x = xn;
    }
}

__device__ __forceinline__ void phase_mid(PRef p, int l) {
    const int tid = tid_opaque(), lane = tid & 63, wave = tid >> 6, G = gridDim.x;
    float* wT = (float*)smem;
    int* lcnt = (int*)(smem + 139264);
    int* lbase = lcnt + 32;
    int* sel = lbase + 32;
    {
        const float4* src = (const float4*)((const float*)(p.ws + WS_RWT) + (size_t)l * 32 * 1024);
        for (int i = tid; i < 32 * 1024 / 4; i += NTH) ((float4*)wT)[i] = src[i];
        if (tid < 32) lcnt[tid] = 0;
    }
    __syncthreads();
    const int r_begin = (l == 0) ? 0 : CTXN;
    bf16_t* HB = (bf16_t*)(p.ws + WS_HB); const bf16_t* OB = (const bf16_t*)(p.ws + WS_OB);
    float* X1 = (float*)(p.ws + WS_X1); const float* X2 = (const float*)(p.ws + WS_X2);
    const float* ng = p.norm_g + (size_t)l * 4 * 1024;
    const float* rb = p.router_b + l * 32;
    float* GATE = (float*)(p.ws + WS_GATE);
    int it = 0;
    int r = r_begin + blockIdx.x * 8 + wave;
    const int step = G * 8;
    int cur_s = -1; ModG mg; ModAB mab;
    Row16 xin; RowB8 ob;
    if (r < NTOK) { xin = (l == 0) ? ld_row_f32(src_row(p, r), lane) : ld_row_f32(X2 + (size_t)r * 1024, lane); ob = ld_rowb(OB + (size_t)r * 1024, lane); }
    for (; r < NTOK; r += step, ++it) {
        const int rn = r + step;
        Row16 xin_n = xin; RowB8 ob_n = ob;
        if (rn < NTOK) { xin_n = (l == 0) ? ld_row_f32(src_row(p, rn), lane) : ld_row_f32(X2 + (size_t)rn * 1024, lane); ob_n = ld_rowb(OB + (size_t)rn * 1024, lane); }
        const int s_ = (r < CTXN) ? 1 : 0;
        if (s_ != cur_s) { cur_s = s_; const float* mod = mod_ptr(p, l, r); mg = load_g(ng + 1024, mod + 2048, lane); mab = load_ab(ng + 2048, mod + 4096, mod + 3072, lane); }
        const Row16 o = cvt_rowb(ob);
        const float rso = row_rstd(o);
        const Row16 x1 = apply_g(xin, o, rso, mg);
        st_row_f32(X1 + (size_t)r * 1024, lane, x1);
        const float rs1 = row_rstd(x1);
        const Row16 h = apply_ab(x1, rs1, mab);
        xin = xin_n; ob = ob_n;
        float part[32];
        {
            const float* wl = wT + lane * 4;
            float4 wa[4], wb[4];
#pragma unroll
            for (int i = 0; i < 4; ++i) wa[i] = *(const float4*)(wl + 256 * i);
#pragma unroll
            for (int e = 0; e < 32; e += 2) {
#pragma unroll
                for (int i = 0; i < 4; ++i) wb[i] = *(const float4*)(wl + (e + 1) * 1024 + 256 * i);
                { float a = 0.f;
#pragma unroll
                  for (int i = 0; i < 4; ++i) a += h.v[i].x * wa[i].x + h.v[i].y * wa[i].y + h.v[i].z * wa[i].z + h.v[i].w * wa[i].w;
                  part[e] = a; }
                if (e + 2 < 32) {
#pragma unroll
                    for (int i = 0; i < 4; ++i) wa[i] = *(const float4*)(wl + (e + 2) * 1024 + 256 * i);
                }
                { float a = 0.f;
#pragma unroll
                  for (int i = 0; i < 4; ++i) a += h.v[i].x * wb[i].x + h.v[i].y * wb[i].y + h.v[i].z * wb[i].z + h.v[i].w * wb[i].w;
                  part[e + 1] = a; }
            }
        }
        st_row_fp8((unsigned char*)HB + (size_t)r * 1024, lane, h);
#define TR_STEP(NV, BIT) _Pragma("unroll") for (int i = 0; i < (NV) / 2; ++i) { const float lo = part[i], hi_ = part[i + (NV) / 2]; const bool up = (lane & (BIT)) != 0; \
            const float send = up ? lo : hi_, keep = up ? hi_ : lo; part[i] = keep + __shfl_xor(send, (BIT)); }
        TR_STEP(32, 32) TR_STEP(16, 16) TR_STEP(8, 8) TR_STEP(4, 4) TR_STEP(2, 2)
#undef TR_STEP
        float logit = part[0] + __shfl_xor(part[0], 1);
        const int myexp = lane >> 1;
        logit += rb[myexp];
        float val = (lane & 1) ? -3.0e38f : logit;
        float tv[4]; int ti[4];
#pragma unroll
        for (int k = 0; k < 4; ++k) {
            float bv = val; int bi = myexp;
#pragma unroll
            for (int off = 32; off >= 1; off >>= 1) { const float ov = __shfl_xor(bv, off); const int oi = __shfl_xor(bi, off); if (ov > bv || (ov == bv && oi < bi)) { bv = ov; bi = oi; } }
            tv[k] = bv; ti[k] = bi;
            if (myexp == bi) val = -3.0e38f;
        }
        const float e1 = __expf(tv[1] - tv[0]), e2 = __expf(tv[2] - tv[0]), e3 = __expf(tv[3] - tv[0]);
        const float inv = 1.f / (1.f + e1 + e2 + e3);
        if (lane < 4) {
            const int k = lane;
            const int e = (k == 0) ? ti[0] : (k == 1) ? ti[1] : (k == 2) ? ti[2] : ti[3];
            const float gk = ((k == 0) ? 1.f : (k == 1) ? e1 : (k == 2) ? e2 : e3) * inv;
            GATE[(size_t)r * 4 + k] = gk;
            const int lp = atomicAdd(&lcnt[e], 1);
            sel[(it * 8 + wave) * 4 + k] = e | (lp << 8);
        }
    }
    __syncthreads();
    int* CNT = (int*)(p.ws + WS_CNT) + l * 32;
    if (tid < 32) lbase[tid] = atomicAdd(&CNT[tid], lcnt[tid]);
    __syncthreads();
    {
        int* TOPE = (int*)(p.ws + WS_TOPE); int* TOPP = (int*)(p.ws + WS_TOPP); int* LIST = (int*)(p.ws + WS_LIST);
        for (int q = tid; q < 80 * 4; q += NTH) {
            const int slot = q >> 2, k = q & 3, itq = slot >> 3, wv = slot & 7;
            const int r = r_begin + blockIdx.x * 8 + wv + itq * G * 8;
            if (r < NTOK) {
                const int s = sel[q], e = s & 255, lp = s >> 8, pos = lbase[e] + lp;
                TOPE[(size_t)r * 4 + k] = e; TOPP[(size_t)r * 4 + k] = pos; LIST[(size_t)e * NTOK + pos] = r;
            }
        }
    }
    __syncthreads();
}

struct MoeLds { int* cnt; int* off; int* toff; };
__device__ __forceinline__ MoeLds moe_setup(PRef p, int l, char* base) {
    MoeLds m; m.cnt = (int*)base; m.off = m.cnt + 32; m.toff = m.off + 33;
    const int tid = tid_opaque();
    if (tid < 64) {
        const int e = tid & 31;
        const int cval = ((const int*)(p.ws + WS_CNT))[l * 32 + e];
        const int tiles = (cval + 255) >> 8;
        int pc = cval, pt = tiles;
#pragma unroll
        for (int o = 1; o < 32; o <<= 1) { const int a = __shfl_up(pc, o, 32), b = __shfl_up(pt, o, 32); if (e >= o) { pc += a; pt += b; } }
        if (tid < 32) { m.cnt[e] = cval; m.off[e + 1] = pc; m.toff[e + 1] = pt; if (e == 0) { m.off[0] = 0; m.toff[0] = 0; } }
    }
    __syncthreads();
    return m;
}

__device__ __forceinline__ void phase_end(PRef p, int l) {
    const int tid = tid_opaque(), lane = tid & 63, wave = tid >> 6, G = gridDim.x;
    MoeLds ml = moe_setup(p, l, smem);
    const int r_begin = (l == 0) ? 0 : CTXN;
    const bf16_t* YB = (const bf16_t*)(p.ws + WS_YB);
    const float* X1 = (const float*)(p.ws + WS_X1); float* X2 = (float*)(p.ws + WS_X2);
    bf16_t* HB = (bf16_t*)(p.ws + WS_HB);
    const int* TOPE = (const int*)(p.ws + WS_TOPE); const int* TOPP = (const int*)(p.ws + WS_TOPP); const float* GATE = (const float*)(p.ws + WS_GATE);
    const float* ng = p.norm_g + (size_t)l * 4 * 1024;
    int cur_s = -1; ModG mg; ModAB mab;
    int r = r_begin + blockIdx.x * 8 + wave;
    int4 en = make_int4(0, 0, 0, 0), pn = make_int4(0, 0, 0, 0); float4 gn = make_float4(0.f, 0.f, 0.f, 0.f);
    const int step = G * 8;
    if (r < NTOK) { en = *(const int4*)(TOPE + (size_t)r * 4); pn = *(const int4*)(TOPP + (size_t)r * 4); gn = *(const float4*)(GATE + (size_t)r * 4); }
    RowB8 t4n[4]; Row16 x1n; float4 gcur = gn;
    if (r < NTOK) {
        t4n[0] = ld_rowb(YB + (size_t)(ml.off[en.x] + pn.x) * 1024, lane); t4n[1] = ld_rowb(YB + (size_t)(ml.off[en.y] + pn.y) * 1024, lane);
        t4n[2] = ld_rowb(YB + (size_t)(ml.off[en.z] + pn.z) * 1024, lane); t4n[3] = ld_rowb(YB + (size_t)(ml.off[en.w] + pn.w) * 1024, lane);
        x1n = ld_row_f32(X1 + (size_t)r * 1024, lane);
        if (r + step < NTOK) { en = *(const int4*)(TOPE + (size_t)(r + step) * 4); pn = *(const int4*)(TOPP + (size_t)(r + step) * 4); gn = *(const float4*)(GATE + (size_t)(r + step) * 4); }
    }
    for (; r < NTOK; r += step) {
        RowB8 t4[4]; t4[0] = t4n[0]; t4[1] = t4n[1]; t4[2] = t4n[2]; t4[3] = t4n[3];
        const Row16 x1 = x1n;
        const float g4[4] = {gcur.x, gcur.y, gcur.z, gcur.w};
        const int rn = r + step;
        if (rn < NTOK) {
            t4n[0] = ld_rowb(YB + (size_t)(ml.off[en.x] + pn.x) * 1024, lane); t4n[1] = ld_rowb(YB + (size_t)(ml.off[en.y] + pn.y) * 1024, lane);
            t4n[2] = ld_rowb(YB + (size_t)(ml.off[en.z] + pn.z) * 1024, lane); t4n[3] = ld_rowb(YB + (size_t)(ml.off[en.w] + pn.w) * 1024, lane);
            x1n = ld_row_f32(X1 + (size_t)rn * 1024, lane);
            gcur = gn;
            if (rn + step < NTOK) { en = *(const int4*)(TOPE + (size_t)(rn + step) * 4); pn = *(const int4*)(TOPP + (size_t)(rn + step) * 4); gn = *(const float4*)(GATE + (size_t)(rn + step) * 4); }
        }
        const int s_ = (r < CTXN) ? 1 : 0;
        if (s_ != cur_s) { cur_s = s_; const float* mod = mod_ptr(p, l, r); mg = load_g(ng + 3072, mod + 5120, lane);
            if (l == 0) { const float* mod1 = mod_ptr(p, 1, r); mab = load_ab(p.norm_g + (size_t)4 * 1024, mod1 + 1024, mod1, lane); } }
        Row16 y;
#pragma unroll
        for (int i = 0; i < 4; ++i) y.v[i] = make_float4(0.f, 0.f, 0.f, 0.f);
#pragma unroll
        for (int k = 0; k < 4; ++k) { const Row16 t = cvt_rowb(t4[k]); const float gk = g4[k];
#pragma unroll
            for (int i = 0; i < 4; ++i) { y.v[i].x += gk * t.v[i].x; y.v[i].y += gk * t.v[i].y; y.v[i].z += gk * t.v[i].z; y.v[i].w += gk * t.v[i].w; } }
        const float rsy = row_rstd(y);
        const Row16 x2 = apply_g(x1, y, rsy, mg);
        if (l == 0) {
            st_row_f32(X2 + (size_t)r * 1024, lane, x2);
            const float rs2 = row_rstd(x2);
            st_row_bf16(HB + (size_t)r * 1024, lane, apply_ab(x2, rs2, mab));
        } else {
            st_row_f32(p.out + (size_t)(r - CTXN) * 1024, lane, x2);
        }
    }
    __syncthreads();
}

__device__ __forceinline__ void phase_gemm_pg8(const bf16_t* A, int lda, const bf16_t* Bt, int K, bf16_t* C, int ldc, int nM, int nN) {
    pg8::PlainOrder S; S.init(A, lda, Bt, K, nM, nN);
    pg8::EpiStore E{C, ldc, nullptr};
    pg8::gemm_phase<pg8::EpiStore, pg8::PlainOrder, false>((PG8_LAS unsigned char*)smem, S, E, K, lda, K);
    __syncthreads();
}
constexpr int MOE_GL_OFF = 131072, MOE_ML_OFF = 143360, MOE_TAB_OFF = 143872, MOE_GL_MAX = 12;
__device__ __forceinline__ void phase_moe1(PRef p, int l) {
    MoeLds ml = moe_setup(p, l, smem + MOE_ML_OFF);
    const int tid = tid_opaque();
    PG8_LAS int* gl = (PG8_LAS int*)(smem + MOE_GL_OFF);
    PG8_LAS int* tab = (PG8_LAS int*)(smem + MOE_TAB_OFF);
    pg8::MoeOrderG S;
    S.A = (const char*)(p.ws + WS_HB); S.W = (const char*)(p.ws + WS_W1T) + (size_t)l * 32 * 2048 * 1024;
    S.tab = tab; S.gl = gl; S.wrows = 2048;
    S.nunits = pg8::moe_build_units(tab, ml.cnt, ml.off, ml.toff, 8);
    if (S.nunits > MOE_GL_MAX) S.nunits = MOE_GL_MAX;
    const int* LIST = (const int*)(p.ws + WS_LIST);
    for (int i = 0; i < S.nunits; ++i) {
        const int e = tab[i * 8 + 2], mt = tab[i * 8 + 0], nvalid = tab[i * 8 + 3], m = mt - ml.toff[e];
        if (tid < 256) gl[i * 256 + tid] = (tid < nvalid) ? LIST[(size_t)e * NTOK + m * 256 + tid] : 0;
    }
    __syncthreads();
    pg8::EpiAct E{(unsigned char*)(p.ws + WS_ACT), p.moe_b1 + (size_t)l * 32 * 2048};
    pg8::gemm_phase<pg8::EpiAct, pg8::MoeOrderG, true, true>((PG8_LAS unsigned char*)smem, S, E, 512, 512, 512, 0x7F7F7F7F, 0x79797979);
    __syncthreads();
}
__device__ __forceinline__ void phase_moe2(PRef p, int l) {
    MoeLds ml = moe_setup(p, l, smem + MOE_ML_OFF);
    PG8_LAS int* tab = (PG8_LAS int*)(smem + MOE_TAB_OFF);
    PG8_LAS int* gl = (PG8_LAS int*)(smem + MOE_GL_OFF);
    pg8::MoeOrderG S;
    S.A = (const char*)(p.ws + WS_ACT); S.W = (const char*)(p.ws + WS_W2T) + (size_t)l * 32 * 1024 * 1024;
    S.tab = tab; S.gl = gl; S.wrows = 1024;
    S.nunits = pg8::moe_build_units(tab, ml.cnt, ml.off, ml.toff, 4);
    if (S.nunits > MOE_GL_MAX) S.nunits = MOE_GL_MAX;
    { const int tid = tid_opaque();
      for (int i = 0; i < S.nunits; ++i) if (tid < 256) gl[i * 256 + tid] = tab[i * 8 + 4] + tid;
      __syncthreads(); }
    pg8::EpiBias E{(bf16_t*)(p.ws + WS_YB), p.moe_b2 + (size_t)l * 32 * 1024};
    pg8::gemm_phase<pg8::EpiBias, pg8::MoeOrderG, true, true>((PG8_LAS unsigned char*)smem, S, E, 512, 512, 512, 0x7D7D7D7D, 0x79797979);
    __syncthreads();
}

__device__ __forceinline__ void gla_local_units(PRef p);
__device__ __forceinline__ void rope8(const float* rope, int t, int j0, const u32x4& a, const u32x4& b, u32x4& oa, u32x4& ob);
__device__ __forceinline__ void rowstat(const bf16_t* A, int lda, int K, float* rs) {
    const int tid = tid_opaque(), r = tid >> 1, hf = tid & 1, half = K / 2;
    const bf16_t* q = A + (size_t)r * lda + hf * half;
    float s = 0.f;
    for (int i = 0; i < half; i += 8) { const u32x4 w = *(const u32x4*)(q + i);
#pragma unroll
        for (int j = 0; j < 4; ++j) { const float a = __uint_as_float(w[j] << 16), b = __uint_as_float(w[j] & 0xFFFF0000u); s += a * a + b * b; } }
    s += __shfl_xor(s, 1);
    if (hf == 0) rs[r] = rsqrtf(s / (float)K + EPSN);
    __syncthreads();
}
__device__ __forceinline__ void phase_mla_up(PRef p) {
    const int G = gridDim.x, tid = threadIdx.x;
    const bf16_t* P = (const bf16_t*)(p.ws + WS_P);
    float* rs = (float*)(smem + 139264);
    const int nM = NTOK / 256;
    {
        pg8::PlainOrder S; S.init(P + PC_CQ, PW, (const bf16_t*)(p.ws + WS_WUQ), 256, nM, 3);
        pg8::Unit u;
        if (S.next(0, u)) rowstat(P + (size_t)u.pm * 256 * PW + PC_CQ, PW, 256, rs);
        pg8::EpiStore E{(bf16_t*)(p.ws + WS_QM), 768, rs};
        pg8::gemm_phase<pg8::EpiStore, pg8::PlainOrder, false>((PG8_LAS unsigned char*)smem, S, E, 256, PW, 256);
        __syncthreads();
    }
    for (int v = (blockIdx.x + G - 195) % G; v < nM * 8; v += G) {
        int aoff[2][2], boff[2];
        const int pm = v >> 3, pn = v & 7, h = pn >> 1;
        rowstat(P + (size_t)pm * 256 * PW + PC_CKV, PW, 128, rs);
        gm::make_off(aoff, pm * 256, PW); gm::make_off1(boff, pn * 128, 128);
        bf16_t* dst = (pn & 1) ? (bf16_t*)(p.ws + WS_VM) + (size_t)pm * 256 * 512 + h * 128 : (bf16_t*)(p.ws + WS_KM) + (size_t)pm * 256 * 768 + h * 192;
        EpiRowScale epi{dst, (pn & 1) ? 512 : 768, rs};
        gm::gemm_tile(P + PC_CKV, aoff, (const bf16_t*)(p.ws + WS_WUKV), boff, 2, epi);
    }
    const float* rope = (const float*)(p.ws + WS_ROPE);
    bf16_t* KM = (bf16_t*)(p.ws + WS_KM);
    for (int i = blockIdx.x * NTH + tid; i < NTOK * 4; i += G * NTH) {
        const int r = i >> 2, j0 = (i & 3) * 8;
        const u32x4 a = *(const u32x4*)(P + (size_t)r * PW + PC_KR + j0), b = *(const u32x4*)(P + (size_t)r * PW + PC_KR + 32 + j0);
        u32x4 oa = a, ob = b;
        if (r >= CTXN) rope8(rope, r - CTXN, j0, a, b, oa, ob);
#pragma unroll
        for (int h = 0; h < 4; ++h) { *(u32x4*)(KM + (size_t)r * 768 + h * 192 + 128 + j0) = oa; *(u32x4*)(KM + (size_t)r * 768 + h * 192 + 160 + j0) = ob; }
    }
    __syncthreads();
    gla_local_units(p);
}

struct GlaB { float b[16]; float total; };
__device__ __forceinline__ GlaB gla_decay(PRef p, int gc, int h, float* scr  ) {
    const int tid = threadIdx.x, lane = tid & 63, wave = tid >> 6, dir = wave & 1, tq = wave >> 1;
    const bf16_t* P = (const bf16_t*)(p.ws + WS_P);
    float* af = scr;
    float* wa = scr + 2048;
    float* ba = scr + 4096;
    float* tot = scr + 4224;
#pragma unroll
    for (int i = 0; i < 4; ++i) {
        const int idx = tid + 512 * i, dd = idx >> 10, t = (idx >> 4) & 63, j = idx & 15;
        af[idx] = bf2f(P[(size_t)(gc * 64 + t) * PW + PC_AF + dd * 16 + j]);
        const int jj = (idx >> 6) & 15, d = idx & 63;
        wa[idx] = (dd == 0 ? p.gla_wa_f : p.gla_wa_b)[jj * 256 + h * 64 + d];
    }
    if (tid < 128) ba[tid] = ((tid >> 6) == 0 ? p.gla_ba_f : p.gla_ba_b)[h * 64 + (tid & 63)];
    __syncthreads();
    float w[16];
#pragma unroll
    for (int j = 0; j < 16; ++j) w[j] = wa[(dir * 16 + j) * 64 + lane];
    const float bias = ba[dir * 64 + lane];
    GlaB r;
#pragma unroll
    for (int i = 0; i < 16; ++i) {
        const int t = tq * 16 + i;
        float z = bias;
#pragma unroll
        for (int j = 0; j < 16; ++j) z += af[(dir * 64 + t) * 16 + j] * w[j];
        const float g = (fminf(z, 0.f) - __logf(1.f + __expf(-fabsf(z)))) * (1.f / 16.f);
        r.b[i] = g;
    }
    if (dir == 0) {
#pragma unroll
        for (int i = 1; i < 16; ++i) r.b[i] += r.b[i - 1];
        tot[(dir * 4 + tq) * 64 + lane] = r.b[15];
    } else {
#pragma unroll
        for (int i = 14; i >= 0; --i) r.b[i] += r.b[i + 1];
        tot[(dir * 4 + tq) * 64 + lane] = r.b[0];
    }
    __syncthreads();
    float offs = 0.f, total = 0.f;
#pragma unroll
    for (int q = 0; q < 4; ++q) { const float tv = tot[(dir * 4 + q) * 64 + lane]; total += tv; if (dir == 0 ? (q < tq) : (q > tq)) offs += tv; }
#pragma unroll
    for (int i = 0; i < 16; ++i) r.b[i] += offs;
    r.total = total;
    return r;
}

__device__ __forceinline__ void gla_stage_vt(const bf16_t* P, int gc, int h, bf16_t* VT) {
    const int tid = threadIdx.x, v = tid & 127, sq = tid >> 7;
    unsigned pk[8];
#pragma unroll
    for (int i = 0; i < 8; ++i) {
        const bf16_t a = P[(size_t)(gc * 64 + sq * 16 + 2 * i) * PW + PC_V + h * 128 + v], b = P[(size_t)(gc * 64 + sq * 16 + 2 * i + 1) * PW + PC_V + h * 128 + v];
        pk[i] = a | ((unsigned)b << 16);
    }
    *(u32x4*)(VT + v * 72 + sq * 16) = (u32x4){pk[0], pk[1], pk[2], pk[3]};
    *(u32x4*)(VT + v * 72 + sq * 16 + 8) = (u32x4){pk[4], pk[5], pk[6], pk[7]};
}

struct GlaPreL { u32x4 kc, vc[2], ac; float4 wac; float bac; };
__device__ __forceinline__ void gla_prefetch_local(PRef p, int gc, int h, GlaPreL& g) {
    const int tid = threadIdx.x;
    const bf16_t* P = (const bf16_t*)(p.ws + WS_P);
    g.kc = *(const u32x4*)(P + (size_t)(gc * 64 + (tid >> 3)) * PW + PC_K + h * 64 + (tid & 7) * 8);
#pragma unroll
    for (int i = 0; i < 2; ++i) { const int idx = tid + 512 * i; g.vc[i] = *(const u32x4*)(P + (size_t)(gc * 64 + (idx >> 4)) * PW + PC_V + h * 128 + (idx & 15) * 8); }
    g.ac = *(const u32x4*)(P + (size_t)(gc * 64 + ((tid & 255) >> 2)) * PW + PC_AF + (tid & 3) * 8);
    { const int dd = tid >> 8, jj = (tid >> 4) & 15, d4 = tid & 15; g.wac = *(const float4*)((dd == 0 ? p.gla_wa_f : p.gla_wa_b) + jj * 256 + h * 64 + d4 * 4); }
    g.bac = ((tid >> 6) & 1 ? p.gla_ba_b : p.gla_ba_f)[h * 64 + (tid & 63)];
}
template <int OFF> __device__ __forceinline__ s16x4 glal_tr(int vb) { s16x4 r; asm volatile("ds_read_b64_tr_b16 %0, %1 offset:%2" : "=&v"(r) : "v"(vb), "i"(OFF) : "memory"); return r; }
__device__ __forceinline__ void gla_local_units(PRef p) {
    const int tid = threadIdx.x, lane = tid & 63, wave = tid >> 6, r32 = lane & 31, hi = lane >> 5, G = gridDim.x;
    bf16_t* kdT = (bf16_t*)smem;
    bf16_t* Kraw = kdT + 2 * 64 * 72;
    char* Vraw = smem + 27648;
    float* af = (float*)(smem + 49152);
    float* wa = af + 2048; float* ba = wa + 2048; float* tot = ba + 128;
    bf16_t* U = (bf16_t*)(p.ws + WS_U); float* DEC = (float*)(p.ws + WS_DEC);
    int u = blockIdx.x;
    if (u >= NCH * 4) return;
    GlaPreL g;
    gla_prefetch_local(p, u >> 2, u & 3, g);
    const int dir = wave & 1, tq = wave >> 1;
    for (; u < NCH * 4; u += G) {
        const int gc = u >> 2, h = u & 3;
        *(u32x4*)(Kraw + (tid >> 3) * 72 + (tid & 7) * 8) = g.kc;
#pragma unroll
        for (int i = 0; i < 2; ++i) { const int idx = tid + 512 * i; *(u32x4*)(Vraw + (idx >> 4) * 320 + (idx & 15) * 16) = g.vc[i]; }
        if (tid < 256) { const int t = tid >> 2, ch = tid & 3, dd = ch >> 1, j0 = (ch & 1) * 8; float* q = af + dd * 1024 + t * 16 + j0;
#pragma unroll
            for (int e = 0; e < 4; ++e) { q[2 * e] = __uint_as_float(g.ac[e] << 16); q[2 * e + 1] = __uint_as_float(g.ac[e] & 0xFFFF0000u); } }
        { const int dd = tid >> 8, jj = (tid >> 4) & 15, d4 = tid & 15; *(float4*)(wa + (dd * 16 + jj) * 64 + d4 * 4) = g.wac; }
        if (tid < 128) ba[tid] = g.bac;
        __syncthreads();
        const int un = u + G;
        if (un < NCH * 4) gla_prefetch_local(p, un >> 2, un & 3, g);
        float bb[16]; float total = 0.f;
        {
            float w[16];
#pragma unroll
            for (int j = 0; j < 16; ++j) w[j] = wa[(dir * 16 + j) * 64 + lane];
            const float bias = ba[dir * 64 + lane];
#pragma unroll
            for (int i = 0; i < 16; ++i) {
                const int t = tq * 16 + i;
                float z = bias;
#pragma unroll
                for (int j = 0; j < 16; ++j) z += af[(dir * 64 + t) * 16 + j] * w[j];
                bb[i] = (fminf(z, 0.f) - __logf(1.f + __expf(-fabsf(z)))) * (1.f / 16.f);
            }
            if (dir == 0) {
#pragma unroll
                for (int i = 1; i < 16; ++i) bb[i] += bb[i - 1];
                tot[(dir * 4 + tq) * 64 + lane] = bb[15];
            } else {
#pragma unroll
                for (int i = 14; i >= 0; --i) bb[i] += bb[i + 1];
                tot[(dir * 4 + tq) * 64 + lane] = bb[0];
            }
        }
        __syncthreads();
        {
            float offs = 0.f;
#pragma unroll
            for (int q = 0; q < 4; ++q) { const float tv = tot[(dir * 4 + q) * 64 + lane]; total += tv; if (dir == 0 ? (q < tq) : (q > tq)) offs += tv; }
#pragma unroll
            for (int i = 0; i < 16; ++i) bb[i] += offs;
        }
        {
            unsigned pk[8];
#pragma unroll
            for (int i = 0; i < 8; ++i) {
                const int s0 = tq * 16 + 2 * i;
                const float k0 = bf2f(Kraw[s0 * 72 + lane]), k1 = bf2f(Kraw[(s0 + 1) * 72 + lane]);
                pk[i] = cvtpk(k0 * __expf(total - bb[2 * i]), k1 * __expf(total - bb[2 * i + 1]));
            }
            *(u32x4*)(kdT + (dir * 64 + lane) * 72 + tq * 16) = (u32x4){pk[0], pk[1], pk[2], pk[3]};
            *(u32x4*)(kdT + (dir * 64 + lane) * 72 + tq * 16 + 8) = (u32x4){pk[4], pk[5], pk[6], pk[7]};
            if (tq == 0) DEC[((size_t)(dir * NCH + gc) * 4 + h) * 64 + lane] = __expf(total);
        }
        __syncthreads();
        {
            const int mdir = wave >> 2, vbk = wave & 3;
            const int vb = (int)(uintptr_t)Vraw + (8 * hi + ((lane & 15) >> 2)) * 320 + (vbk * 32 + 16 * ((lane >> 4) & 1) + 4 * (lane & 3)) * 2;
            f32x16 a0 = {}, a1 = {};
#define GLAL_STEP(KS) do { const s16x4 l_ = glal_tr<(KS) * 5120>(vb), h_ = glal_tr<(KS) * 5120 + 1280>(vb); \
            const bf16x8 b0 = *(const bf16x8*)(kdT + (mdir * 64 + r32) * 72 + (KS) * 16 + hi * 8); \
            const bf16x8 b1 = *(const bf16x8*)(kdT + (mdir * 64 + 32 + r32) * 72 + (KS) * 16 + hi * 8); \
            asm volatile("s_waitcnt lgkmcnt(0)" ::: "memory"); SBAR(); \
            const bf16x8 a_ = (bf16x8){l_[0], l_[1], l_[2], l_[3], h_[0], h_[1], h_[2], h_[3]}; \
            a0 = __builtin_amdgcn_mfma_f32_32x32x16_bf16(a_, b0, a0, 0, 0, 0); a1 = __builtin_amdgcn_mfma_f32_32x32x16_bf16(a_, b1, a1, 0, 0, 0); } while (0)
            GLAL_STEP(0); GLAL_STEP(1); GLAL_STEP(2); GLAL_STEP(3);
#undef GLAL_STEP
            bf16_t* Uo = U + ((size_t)(mdir * NCH + gc) * 4 + h) * 8192;
#pragma unroll
            for (int r = 0; r < 16; ++r) { const int v = vbk * 32 + crow(r, hi); Uo[v * 64 + r32] = f2bf(a0[r]); Uo[v * 64 + 32 + r32] = f2bf(a1[r]); }
        }
        __syncthreads();
    }
}
__device__ __forceinline__ void rope8(const float* rope, int t, int j0, const u32x4& a, const u32x4& b, u32x4& oa, u32x4& ob) {
    const int row = t >> 6, col = t & 63;
    const float* cs = (j0 < 16) ? rope + row * 16 + j0 : rope + 512 * 16 + col * 16 + (j0 - 16);
    const float* sn = (j0 < 16) ? rope + 256 * 16 + row * 16 + j0 : rope + 512 * 16 + 64 * 16 + col * 16 + (j0 - 16);
    const f32x4 c0 = *(const f32x4*)cs, c1 = *(const f32x4*)(cs + 4), s0 = *(const f32x4*)sn, s1 = *(const f32x4*)(sn + 4);
#pragma unroll
    for (int e = 0; e < 4; ++e) {
        const float x1l = __uint_as_float(a[e] << 16), x1h = __uint_as_float(a[e] & 0xFFFF0000u), x2l = __uint_as_float(b[e] << 16), x2h = __uint_as_float(b[e] & 0xFFFF0000u);
        const float cl = (e < 2) ? c0[2 * e] : c1[2 * e - 4], ch = (e < 2) ? c0[2 * e + 1] : c1[2 * e - 3], sl = (e < 2) ? s0[2 * e] : s1[2 * e - 4], sh = (e < 2) ? s0[2 * e + 1] : s1[2 * e - 3];
        oa[e] = cvtpk(x1l * cl - x2l * sl, x1h * ch - x2h * sh);
        ob[e] = cvtpk(x1l * sl + x2l * cl, x1h * sh + x2h * ch);
    }
}
__device__ __forceinline__ void qrope_pass(PRef p, int b0, int nb) {
    const int tid = threadIdx.x;
    const float* rope = (const float*)(p.ws + WS_ROPE);
    bf16_t* QM = (bf16_t*)(p.ws + WS_QM);
    for (int i = (blockIdx.x - b0) * NTH + tid; i < SEQ * 16; i += nb * NTH) {
        const int t = i >> 4, hh = (i >> 2) & 3, j0 = (i & 3) * 8;
        bf16_t* q = QM + (size_t)(CTXN + t) * 768 + hh * 192 + 128 + j0;
        const u32x4 a = *(const u32x4*)q, b = *(const u32x4*)(q + 32);
        u32x4 oa, ob; rope8(rope, t, j0, a, b, oa, ob);
        *(u32x4*)q = oa; *(u32x4*)(q + 32) = ob;
    }
}

__device__ __forceinline__ int gla_order(int dir, int step) { return dir == 0 ? step : (step < 4 ? 3 - step : NCH - 1 - (step - 4)); }
__device__ __forceinline__ void phase_gla_scan(PRef p) {
    const int gid = blockIdx.x * NTH + threadIdx.x;
    if (gid >= 2 * 4 * 8192) { qrope_pass(p, 128, (int)gridDim.x - 128); return; }
    const int dir = gid >> 15, h = (gid >> 13) & 3, e = gid & 8191, d = e & 63;
    const bf16_t* U = (const bf16_t*)(p.ws + WS_U); bf16_t* S = (bf16_t*)(p.ws + WS_SIN); const float* DEC = (const float*)(p.ws + WS_DEC);
    float s = 0.f;
#pragma unroll 1
    for (int s0 = 0; s0 < NCH; s0 += 52) {
        float uu[52], dc[52];
#pragma unroll
        for (int i = 0; i < 52; ++i) { const size_t o = ((size_t)(dir * NCH + gla_order(dir, s0 + i)) * 4 + h); uu[i] = bf2f(U[o * 8192 + e]); dc[i] = DEC[o * 64 + d]; }
#pragma unroll
        for (int i = 0; i < 52; ++i) { const size_t o = ((size_t)(dir * NCH + gla_order(dir, s0 + i)) * 4 + h); S[o * 8192 + e] = f2bf(s); s = dc[i] * s + uu[i]; }
    }
}

__device__ __forceinline__ void gla_out_unit(PRef p, int gc, int h) {
    const int tid = threadIdx.x, lane = tid & 63, wave = tid >> 6, r32 = lane & 31, hi = lane >> 5;
    const bf16_t* P = (const bf16_t*)(p.ws + WS_P);
    bf16_t* qe = (bf16_t*)smem;
    bf16_t* ke = qe + 2 * 64 * 72;
    bf16_t* Am = ke + 2 * 64 * 72;
    bf16_t* VT = Am + 2 * 64 * 72;
    bf16_t* ST = VT + 128 * 72;
    float* scr = (float*)(smem + 110592);
    float* ob = (float*)(ke);
    const GlaB gb = gla_decay(p, gc, h, scr);
    {
        const int dir = wave & 1, tq = wave >> 1;
#pragma unroll
        for (int i = 0; i < 16; ++i) {
            const int t = tq * 16 + i;
            const float qv = bf2f(P[(size_t)(gc * 64 + t) * PW + PC_Q + h * 64 + lane]) * 0.125f, kv = bf2f(P[(size_t)(gc * 64 + t) * PW + PC_K + h * 64 + lane]);
            qe[(dir * 64 + t) * 72 + lane] = f2bf(qv * __expf(gb.b[i]));
            ke[(dir * 64 + t) * 72 + lane] = f2bf(kv * __expf(-gb.b[i]));
        }
    }
    gla_stage_vt(P, gc, h, VT);
    {
        const bf16_t* S = (const bf16_t*)(p.ws + WS_SIN);
#pragma unroll
        for (int i = 0; i < 4; ++i) {
            const int cc = tid + 512 * i, dir = cc >> 10, v = (cc >> 3) & 127, ch = cc & 7;
            *(u32x4*)(ST + (dir * 128 + v) * 72 + ch * 8) = *(const u32x4*)(S + ((size_t)(dir * NCH + gc) * 4 + h) * 8192 + v * 64 + ch * 8);
        }
    }
    __syncthreads();
    {
        const int dir = wave >> 2, tb = (wave >> 1) & 1, sb = wave & 1;
        f32x16 acc = {};
#pragma unroll
        for (int ks = 0; ks < 4; ++ks) {
            const bf16x8 a = *(const bf16x8*)(qe + (dir * 64 + tb * 32 + r32) * 72 + ks * 16 + hi * 8);
            const bf16x8 b = *(const bf16x8*)(ke + (dir * 64 + sb * 32 + r32) * 72 + ks * 16 + hi * 8);
            acc = __builtin_amdgcn_mfma_f32_32x32x16_bf16(a, b, acc, 0, 0, 0);
        }
        const int s = sb * 32 + r32;
#pragma unroll
        for (int r = 0; r < 16; ++r) { const int t = tb * 32 + crow(r, hi); const bool keep = (dir == 0) ? (s <= t) : (s >= t); Am[(dir * 64 + t) * 72 + s] = f2bf(keep ? acc[r] : 0.f); }
    }
    __syncthreads();
    f32x16 o = {};
    const int tb = wave >> 2, vb = wave & 3;
#pragma unroll
    for (int dir = 0; dir < 2; ++dir)
#pragma unroll
        for (int ks = 0; ks < 4; ++ks) {
            const bf16x8 a1 = *(const bf16x8*)(Am + (dir * 64 + tb * 32 + r32) * 72 + ks * 16 + hi * 8);
            const bf16x8 b1 = *(const bf16x8*)(VT + (vb * 32 + r32) * 72 + ks * 16 + hi * 8);
            o = __builtin_amdgcn_mfma_f32_32x32x16_bf16(a1, b1, o, 0, 0, 0);
            const bf16x8 a2 = *(const bf16x8*)(qe + (dir * 64 + tb * 32 + r32) * 72 + ks * 16 + hi * 8);
            const bf16x8 b2 = *(const bf16x8*)(ST + (dir * 128 + vb * 32 + r32) * 72 + ks * 16 + hi * 8);
            o = __builtin_amdgcn_mfma_f32_32x32x16_bf16(a2, b2, o, 0, 0, 0);
        }
    __syncthreads();
#pragma unroll
    for (int r = 0; r < 16; ++r) ob[(tb * 32 + crow(r, hi)) * 132 + vb * 32 + r32] = o[r];
    __syncthreads();
    {
        const int t = tid >> 3, v0 = (tid & 7) * 16;
        float vals[16]; float ss = 0.f;
#pragma unroll
        for (int i = 0; i < 16; ++i) { vals[i] = ob[t * 132 + v0 + i]; ss += vals[i] * vals[i]; }
        ss += __shfl_xor(ss, 1); ss += __shfl_xor(ss, 2); ss += __shfl_xor(ss, 4);
        const float rstd = rsqrtf(ss * (1.f / 128.f) + EPSN);
        const size_t row = (size_t)gc * 64 + t;
        unsigned pk[8];
#pragma unroll
        for (int i = 0; i < 8; ++i) {
            const float r0 = bf2f(P[row * PW + PC_R + h * 128 + v0 + 2 * i]), r1 = bf2f(P[row * PW + PC_R + h * 128 + v0 + 2 * i + 1]);
            pk[i] = cvtpk(vals[2 * i] * rstd * p.gla_onorm[v0 + 2 * i] * silu_f(r0), vals[2 * i + 1] * rstd * p.gla_onorm[v0 + 2 * i + 1] * silu_f(r1));
        }
        bf16_t* M = (bf16_t*)(p.ws + WS_MIX) + row * 1024 + h * 128 + v0;
        *(u32x4*)M = (u32x4){pk[0], pk[1], pk[2], pk[3]}; *(u32x4*)(M + 8) = (u32x4){pk[4], pk[5], pk[6], pk[7]};
    }
    __syncthreads();
}


struct GlaPre { u32x4 qc, kc, vc[2], ac, sc[4]; float4 wac; float bac; };
__device__ __forceinline__ void gla_prefetch(PRef p, int gc, int h, GlaPre& g, u32x4 (&rc)[2]) {
    const int tid = threadIdx.x;
    const bf16_t* P = (const bf16_t*)(p.ws + WS_P);
    const bf16_t* rowp = P + (size_t)(gc * 64 + (tid >> 3)) * PW;
    g.qc = *(const u32x4*)(rowp + PC_Q + h * 64 + (tid & 7) * 8);
    g.kc = *(const u32x4*)(rowp + PC_K + h * 64 + (tid & 7) * 8);
#pragma unroll
    for (int i = 0; i < 2; ++i) { const int idx = tid + 512 * i; g.vc[i] = *(const u32x4*)(P + (size_t)(gc * 64 + (idx >> 4)) * PW + PC_V + h * 128 + (idx & 15) * 8); }
#pragma unroll
    for (int i = 0; i < 2; ++i) rc[i] = *(const u32x4*)(rowp + PC_R + h * 128 + (tid & 7) * 16 + 8 * i);
    g.ac = *(const u32x4*)(P + (size_t)(gc * 64 + ((tid & 255) >> 2)) * PW + PC_AF + (tid & 3) * 8);
    const bf16_t* S = (const bf16_t*)(p.ws + WS_SIN);
#pragma unroll
    for (int i = 0; i < 4; ++i) { const int cc = tid + 512 * i, dir = cc >> 10; g.sc[i] = *(const u32x4*)(S + ((size_t)(dir * NCH + gc) * 4 + h) * 8192 + (cc & 1023) * 8); }
    { const int dd = tid >> 8, jj = (tid >> 4) & 15, d4 = tid & 15; g.wac = *(const float4*)((dd == 0 ? p.gla_wa_f : p.gla_wa_b) + jj * 256 + h * 64 + d4 * 4); }
    g.bac = ((tid >> 6) & 1 ? p.gla_ba_b : p.gla_ba_f)[h * 64 + (tid & 63)];
}
template <int OFF> __device__ __forceinline__ s16x4 gla_tr(int vb) { s16x4 r; asm volatile("ds_read_b64_tr_b16 %0, %1 offset:%2" : "=&v"(r) : "v"(vb), "i"(OFF) : "memory"); return r; }
__device__ __forceinline__ void phase_gla_out(PRef p) {
    const int tid = threadIdx.x, lane = tid & 63, wave = tid >> 6, r32 = lane & 31, hi = lane >> 5, G = gridDim.x;
    bf16_t* qe = (bf16_t*)smem;
    bf16_t* ke = qe + 2 * 64 * 72;
    bf16_t* Am = ke + 2 * 64 * 72;
    bf16_t* Qraw = Am; bf16_t* Kraw = Am + 64 * 72;
    char* Vraw = smem + 55296;
    bf16_t* ST = (bf16_t*)(smem + 75776);
    float* af = (float*)(smem + 112640);
    float* wa = af + 2048;
    float* ba = wa + 2048;
    float* tot = ba + 128;
    float* ob = (float*)ke;
    int u = blockIdx.x;
    if (u >= NCH * 4) return;
    const int nt_t = tid >> 3, nt_v0 = (tid & 7) * 16;
    float on[16];
#pragma unroll
    for (int i = 0; i < 16; ++i) on[i] = p.gla_onorm[nt_v0 + i];
    GlaPre g; u32x4 rc[2], rcn[2];
    gla_prefetch(p, u >> 2, u & 3, g, rc);
    const int dir = wave & 1, tq = wave >> 1;
    for (; u < NCH * 4; u += G) {
        const int gc = u >> 2, h = u & 3;
        *(u32x4*)(Qraw + (tid >> 3) * 72 + (tid & 7) * 8) = g.qc;
        *(u32x4*)(Kraw + (tid >> 3) * 72 + (tid & 7) * 8) = g.kc;
#pragma unroll
        for (int i = 0; i < 2; ++i) { const int idx = tid + 512 * i; *(u32x4*)(Vraw + (idx >> 4) * 320 + (idx & 15) * 16) = g.vc[i]; }
#pragma unroll
        for (int i = 0; i < 4; ++i) { const int cc = tid + 512 * i; *(u32x4*)(ST + ((cc >> 10) * 128 + ((cc >> 3) & 127)) * 72 + (cc & 7) * 8) = g.sc[i]; }
        if (tid < 256) { const int t = tid >> 2, ch = tid & 3, dd = ch >> 1, j0 = (ch & 1) * 8; float* q = af + dd * 1024 + t * 16 + j0;
#pragma unroll
            for (int e = 0; e < 4; ++e) { q[2 * e] = __uint_as_float(g.ac[e] << 16); q[2 * e + 1] = __uint_as_float(g.ac[e] & 0xFFFF0000u); } }
        { const int dd = tid >> 8, jj = (tid >> 4) & 15, d4 = tid & 15; *(float4*)(wa + (dd * 16 + jj) * 64 + d4 * 4) = g.wac; }
        if (tid < 128) ba[tid] = g.bac;
        __syncthreads();
        const int un = u + G;
        if (un < NCH * 4) gla_prefetch(p, un >> 2, un & 3, g, rcn);
        float bb[16]; float total;
        {
            float w[16];
#pragma unroll
            for (int j = 0; j < 16; ++j) w[j] = wa[(dir * 16 + j) * 64 + lane];
            const float bias = ba[dir * 64 + lane];
#pragma unroll
            for (int i = 0; i < 16; ++i) {
                const int t = tq * 16 + i;
                float z = bias;
#pragma unroll
                for (int j = 0; j < 16; ++j) z += af[(dir * 64 + t) * 16 + j] * w[j];
                bb[i] = (fminf(z, 0.f) - __logf(1.f + __expf(-fabsf(z)))) * (1.f / 16.f);
            }
            if (dir == 0) {
#pragma unroll
                for (int i = 1; i < 16; ++i) bb[i] += bb[i - 1];
                tot[(dir * 4 + tq) * 64 + lane] = bb[15];
            } else {
#pragma unroll
                for (int i = 14; i >= 0; --i) bb[i] += bb[i + 1];
                tot[(dir * 4 + tq) * 64 + lane] = bb[0];
            }
        }
        __syncthreads();
        {
            float offs = 0.f; total = 0.f;
#pragma unroll
            for (int q = 0; q < 4; ++q) { const float tv = tot[(dir * 4 + q) * 64 + lane]; total += tv; if (dir == 0 ? (q < tq) : (q > tq)) offs += tv; }
#pragma unroll
            for (int i = 0; i < 16; ++i) bb[i] += offs;
        }
#pragma unroll
        for (int i = 0; i < 16; ++i) {
            const int t = tq * 16 + i;
            const float qv = bf2f(Qraw[t * 72 + lane]) * 0.125f, kv = bf2f(Kraw[t * 72 + lane]);
            qe[(dir * 64 + t) * 72 + lane] = f2bf(qv * __expf(bb[i]));
            ke[(dir * 64 + t) * 72 + lane] = f2bf(kv * __expf(-bb[i]));
        }
        __syncthreads();
        {
            const int mdir = wave >> 2, tb = (wave >> 1) & 1, sb = wave & 1;
            f32x16 acc = {};
#pragma unroll
            for (int ks = 0; ks < 4; ++ks) {
                const bf16x8 a = *(const bf16x8*)(qe + (mdir * 64 + tb * 32 + r32) * 72 + ks * 16 + hi * 8);
                const bf16x8 b = *(const bf16x8*)(ke + (mdir * 64 + sb * 32 + r32) * 72 + ks * 16 + hi * 8);
                acc = __builtin_amdgcn_mfma_f32_32x32x16_bf16(a, b, acc, 0, 0, 0);
            }
            const int sI = sb * 32 + r32;
#pragma unroll
            for (int r = 0; r < 16; ++r) { const int t = tb * 32 + crow(r, hi); const bool keep = (mdir == 0) ? (sI <= t) : (sI >= t); Am[(mdir * 64 + t) * 72 + sI] = f2bf(keep ? acc[r] : 0.f); }
        }
        __syncthreads();
        f32x16 o = {};
        const int tb = wave >> 2, vbk = wave & 3;
        {
            const int vb = (int)(uintptr_t)Vraw + (8 * hi + ((lane & 15) >> 2)) * 320 + (vbk * 32 + 16 * ((lane >> 4) & 1) + 4 * (lane & 3)) * 2;
#define GLA_PV(KS, DIRN) do { const s16x4 l_ = gla_tr<(KS) * 5120>(vb), h_ = gla_tr<(KS) * 5120 + 1280>(vb); \
            const bf16x8 a1 = *(const bf16x8*)(Am + ((DIRN) * 64 + tb * 32 + r32) * 72 + (KS) * 16 + hi * 8); \
            const bf16x8 a2 = *(const bf16x8*)(qe + ((DIRN) * 64 + tb * 32 + r32) * 72 + (KS) * 16 + hi * 8); \
            const bf16x8 b2 = *(const bf16x8*)(ST + ((DIRN) * 128 + vbk * 32 + r32) * 72 + (KS) * 16 + hi * 8); \
            asm volatile("s_waitcnt lgkmcnt(0)" ::: "memory"); SBAR(); \
            o = __builtin_amdgcn_mfma_f32_32x32x16_bf16(a1, (bf16x8){l_[0], l_[1], l_[2], l_[3], h_[0], h_[1], h_[2], h_[3]}, o, 0, 0, 0); \
            o = __builtin_amdgcn_mfma_f32_32x32x16_bf16(a2, b2, o, 0, 0, 0); } while (0)
            GLA_PV(0, 0); GLA_PV(1, 0); GLA_PV(2, 0); GLA_PV(3, 0); GLA_PV(0, 1); GLA_PV(1, 1); GLA_PV(2, 1); GLA_PV(3, 1);
#undef GLA_PV
        }
        __syncthreads();
#pragma unroll
        for (int r = 0; r < 16; ++r) ob[(tb * 32 + crow(r, hi)) * 132 + vbk * 32 + r32] = o[r];
        __syncthreads();
        {
            float vals[16]; float ss = 0.f;
#pragma unroll
            for (int i = 0; i < 4; ++i) { const f32x4 x = *(const f32x4*)(ob + nt_t * 132 + nt_v0 + 4 * i); vals[4 * i] = x[0]; vals[4 * i + 1] = x[1]; vals[4 * i + 2] = x[2]; vals[4 * i + 3] = x[3]; }
#pragma unroll
            for (int i = 0; i < 16; ++i) ss += vals[i] * vals[i];
            ss += __shfl_xor(ss, 1); ss += __shfl_xor(ss, 2); ss += __shfl_xor(ss, 4);
            const float rstd = rsqrtf(ss * (1.f / 128.f) + EPSN);
            unsigned pk[8];
#pragma unroll
            for (int i = 0; i < 8; ++i) {
                const unsigned w = rc[i >> 2][i & 3];
                const float r0 = __uint_as_float(w << 16), r1 = __uint_as_float(w & 0xFFFF0000u);
                const float s0 = r0 * __builtin_amdgcn_rcpf(1.f + __expf(-r0)), s1 = r1 * __builtin_amdgcn_rcpf(1.f + __expf(-r1));
                pk[i] = cvtpk(vals[2 * i] * rstd * on[2 * i] * s0, vals[2 * i + 1] * rstd * on[2 * i + 1] * s1);
            }
            bf16_t* M = (bf16_t*)(p.ws + WS_MIX) + ((size_t)gc * 64 + nt_t) * 1024 + h * 128 + nt_v0;
            *(u32x4*)M = (u32x4){pk[0], pk[1], pk[2], pk[3]}; *(u32x4*)(M + 8) = (u32x4){pk[4], pk[5], pk[6], pk[7]};
        }
        rc[0] = rcn[0]; rc[1] = rcn[1];
        __syncthreads();
    }
}

namespace mla {
constexpr int KVBLK = 64, QBLK = 32;
#ifndef MLA_QREG
#define MLA_QREG 12
#endif
constexpr int QREG = MLA_QREG;
constexpr float SCALE = 0.07216878364870322f;
constexpr float THR = 8.f;
constexpr int LDQ = 768, LDK = 768, LDV = 512, LDO = 1024;
constexpr int SHM_V = KVBLK * 128 * 2, SHM_K = KVBLK * 400;
#define MKSWZ(row, colB) ((row) * 400 + (colB))
__device__ __forceinline__ void partialSM(f32x16& p0, f32x16& p1, float& m_reg, float& mn, float& alpha) {
    constexpr float C = SCALE * LOG2E;
    float pmax = p0[0];
#pragma unroll
    for (int r = 1; r < 16; ++r) pmax = fmaxf(pmax, p0[r]);
#pragma unroll
    for (int r = 0; r < 16; ++r) pmax = fmaxf(pmax, p1[r]);
    { auto rr = __builtin_amdgcn_permlane32_swap(__float_as_uint(pmax), __float_as_uint(pmax), false, false);
      pmax = fmaxf(__uint_as_float(rr[0]), __uint_as_float(rr[1])); }
    if (__builtin_expect(__all(pmax - m_reg <= THR / SCALE), 1)) { mn = m_reg; alpha = 1.f; }
    else { mn = fmaxf(m_reg, pmax); alpha = __builtin_amdgcn_exp2f((m_reg - mn) * C); m_reg = mn; }
    const float mnC = -mn * C;
#pragma unroll
    for (int r = 0; r < 16; ++r) p0[r] = fmaf(p0[r], C, mnC);
#pragma unroll
    for (int r = 0; r < 16; ++r) p1[r] = fmaf(p1[r], C, mnC);
#pragma unroll
    for (int r = 0; r < 16; ++r) p0[r] = __builtin_amdgcn_exp2f(p0[r]);
}
__device__ __forceinline__ void finishSM(f32x16& p0, f32x16& p1, float alpha, float& l_reg, bf16x8& pa0, bf16x8& pa1, bf16x8& pa2, bf16x8& pa3) {
#pragma unroll
    for (int r = 0; r < 16; ++r) p1[r] = __builtin_amdgcn_exp2f(p1[r]);
    float ps = 0;
#pragma unroll
    for (int r = 0; r < 16; ++r) ps += p0[r];
#pragma unroll
    for (int r = 0; r < 16; ++r) ps += p1[r];
    { auto rr = __builtin_amdgcn_permlane32_swap(__float_as_uint(ps), __float_as_uint(ps), false, false);
      ps = __uint_as_float(rr[0]) + __uint_as_float(rr[1]); }
    l_reg = l_reg * alpha + ps;
#define PK4(P, BASE, OUT) do { unsigned a0 = cvtpk(P[BASE + 0], P[BASE + 1]), a1 = cvtpk(P[BASE + 2], P[BASE + 3]);   \
    unsigned b0 = cvtpk(P[BASE + 4], P[BASE + 5]), b1 = cvtpk(P[BASE + 6], P[BASE + 7]);                              \
    auto r0 = __builtin_amdgcn_permlane32_swap(a0, b0, false, false); auto r1 = __builtin_amdgcn_permlane32_swap(a1, b1, false, false); \
    u32x4 w = {r0[0], r1[0], r0[1], r1[1]}; OUT = *reinterpret_cast<bf16x8*>(&w); } while (0)
    PK4(p0, 0, pa0); PK4(p0, 8, pa1); PK4(p1, 0, pa2); PK4(p1, 8, pa3);
}
__device__ __forceinline__ void qkt(f32x16& p0, f32x16& p1, const char* Ks, const bf16x8* qr, const char* qlds, int r32, int hi) {
    p0 = f32x16{}; p1 = f32x16{};
#pragma unroll
    for (int d0 = 0; d0 < 12; ++d0) { const int cb = (d0 * 16 + hi * 8) * 2;
        const bf16x8 b0 = *reinterpret_cast<const bf16x8*>(Ks + MKSWZ(r32, cb));
        const bf16x8 b1 = *reinterpret_cast<const bf16x8*>(Ks + MKSWZ(32 + r32, cb));
        const bf16x8 qv = (d0 < QREG) ? qr[d0 < QREG ? d0 : 0] : *reinterpret_cast<const bf16x8*>(qlds + (d0 - QREG) * 1024);
        p0 = __builtin_amdgcn_mfma_f32_32x32x16_bf16(b0, qv, p0, 0, 0, 0);
        p1 = __builtin_amdgcn_mfma_f32_32x32x16_bf16(b1, qv, p1, 0, 0, 0); }
}
__device__ __forceinline__ int v_st(int k, int c) { const int kk = (k & ~0xC) | ((k & 4) << 1) | ((k & 8) >> 1); return ((kk >> 3) * 4 + (c >> 5)) * 512 + ((kk & 7) * 32 + (c & 31)) * 2; }
__device__ __forceinline__ int v_rd_base(int lane) { return ((lane & 3) << 3) | (((lane >> 2) & 3) << 6) | (((lane >> 4) & 1) << 5) | (((lane >> 5) & 1) << 8); }
constexpr int v_rd_off(int d0, int ks, int half) { return d0 * 512 + ks * 4096 + half * 2048; }
template <int OFF> __device__ __forceinline__ s16x4 tr_read(int vb) {
    s16x4 r; asm volatile("ds_read_b64_tr_b16 %0, %1 offset:%2" : "=&v"(r) : "v"(vb), "i"(OFF) : "memory"); return r;
}
template <int D0> __device__ __forceinline__ void pv_one(f32x16& od, int vb, bf16x8 pa0, bf16x8 pa1, bf16x8 pa2, bf16x8 pa3) {
#define PKV(L, H) (bf16x8){L[0], L[1], L[2], L[3], H[0], H[1], H[2], H[3]}
    {
    const s16x4 l0 = tr_read<v_rd_off(D0, 0, 0)>(vb), h0 = tr_read<v_rd_off(D0, 0, 1)>(vb), l1 = tr_read<v_rd_off(D0, 1, 0)>(vb), h1 = tr_read<v_rd_off(D0, 1, 1)>(vb);
    asm volatile("s_waitcnt lgkmcnt(0)" ::: "memory"); SBAR();
    od = __builtin_amdgcn_mfma_f32_32x32x16_bf16(pa0, PKV(l0, h0), od, 0, 0, 0);
    od = __builtin_amdgcn_mfma_f32_32x32x16_bf16(pa1, PKV(l1, h1), od, 0, 0, 0);
    }
    {
    const s16x4 l2 = tr_read<v_rd_off(D0, 2, 0)>(vb), h2 = tr_read<v_rd_off(D0, 2, 1)>(vb), l3 = tr_read<v_rd_off(D0, 3, 0)>(vb), h3 = tr_read<v_rd_off(D0, 3, 1)>(vb);
    asm volatile("s_waitcnt lgkmcnt(0)" ::: "memory"); SBAR();
    od = __builtin_amdgcn_mfma_f32_32x32x16_bf16(pa2, PKV(l2, h2), od, 0, 0, 0);
    od = __builtin_amdgcn_mfma_f32_32x32x16_bf16(pa3, PKV(l3, h3), od, 0, 0, 0);
    }
#undef PKV
}
__device__ __forceinline__ void pv_d0(f32x16* o, int vb, bf16x8 pa0, bf16x8 pa1, bf16x8 pa2, bf16x8 pa3) {
    pv_one<0>(o[0], vb, pa0, pa1, pa2, pa3); pv_one<1>(o[1], vb, pa0, pa1, pa2, pa3); pv_one<2>(o[2], vb, pa0, pa1, pa2, pa3); pv_one<3>(o[3], vb, pa0, pa1, pa2, pa3);
}
__device__ __forceinline__ void attn_body(const bf16_t* __restrict__ Qb, const bf16_t* __restrict__ Kh, const bf16_t* __restrict__ Vh, bf16_t* __restrict__ Ob, int seq) {
    char* lds = smem;
    const int tid = threadIdx.x, wid = tid >> 6, lane = tid & 63, r32 = lane & 31, hi = lane >> 5;
    char* V_lds = lds; char* K_lds = lds + 2 * SHM_V;
    float* ws = (float*)(lds + 2 * SHM_V + 2 * SHM_K) + wid * 64; float* li_l = ws; float* al_l = ws + 32;
    float m_reg = -1e30f, l_reg = 0; f32x16 o[4] = {}; bf16x8 qr[QREG];
    const bf16_t* Qw = Qb + (long)(wid * QBLK + r32) * LDQ + hi * 8;
#pragma unroll
    for (int d0 = 0; d0 < QREG; ++d0) qr[d0] = *reinterpret_cast<const bf16x8*>(Qw + d0 * 16);
    char* qlds = lds + 2 * SHM_V + 2 * SHM_K + 2048 + wid * ((12 - QREG) * 1024) + lane * 16;
#pragma unroll
    for (int d0 = 0; d0 < 12 - QREG; ++d0) *reinterpret_cast<bf16x8*>(qlds + d0 * 1024) = *reinterpret_cast<const bf16x8*>(Qw + (QREG + d0) * 16);
    const int sr = tid >> 4, sc = (tid & 15) * 8, vst0 = v_st(sr, sc), vst1 = v_st(32 + sr, sc);
    int kgo[3], kso[3];
#pragma unroll
    for (int i = 0; i < 3; ++i) { const int id = tid + 512 * i, kr_ = id / 24, kc_ = (id % 24) * 8; kgo[i] = kr_ * LDK + kc_; kso[i] = MKSWZ(kr_, kc_ * 2); }
    const int vb0 = (int)(uintptr_t)V_lds + v_rd_base(lane);
    struct { bf16x8 vs0, vs1, ks0, ks1, ks2; } st_;
#define SLOAD(k0) do { st_.vs0 = *(const bf16x8*)(&Vh[(long)((k0) + sr) * LDV + sc]); st_.vs1 = *(const bf16x8*)(&Vh[(long)((k0) + 32 + sr) * LDV + sc]); \
    st_.ks0 = *(const bf16x8*)(&Kh[(long)(k0) * LDK + kgo[0]]); st_.ks1 = *(const bf16x8*)(&Kh[(long)(k0) * LDK + kgo[1]]); \
    st_.ks2 = *(const bf16x8*)(&Kh[(long)(k0) * LDK + kgo[2]]); } while (0)
#define SWRITE(b) do { *(bf16x8*)(V_lds + (b) * SHM_V + vst0) = st_.vs0; *(bf16x8*)(V_lds + (b) * SHM_V + vst1) = st_.vs1; \
    *(bf16x8*)(K_lds + (b) * SHM_K + kso[0]) = st_.ks0; *(bf16x8*)(K_lds + (b) * SHM_K + kso[1]) = st_.ks1; \
    *(bf16x8*)(K_lds + (b) * SHM_K + kso[2]) = st_.ks2; } while (0)
#define RESC(a) do { if (__any((a) < 1.f)) { if (hi == 0) al_l[r32] = (a); asm volatile("s_waitcnt lgkmcnt(0)" ::: "memory"); \
    _Pragma("unroll") for (int d = 0; d < 4; ++d) _Pragma("unroll") for (int r = 0; r < 16; ++r) o[d][r] *= al_l[crow(r, hi)]; } } while (0)
    f32x16 pA0, pA1, pB0, pB1; float mnA, mnB, alA, alB; bf16x8 pa0, pa1, pa2, pa3; const int NT = seq / KVBLK;
    SLOAD(0); SWRITE(0); __syncthreads();
    qkt(pA0, pA1, K_lds, qr, qlds, r32, hi); partialSM(pA0, pA1, m_reg, mnA, alA);
    SLOAD(KVBLK); SWRITE(1); __syncthreads();
    for (int j = 1; j + 1 < NT; j += 2) {
        SBAR(); qkt(pB0, pB1, K_lds + SHM_K, qr, qlds, r32, hi);
        finishSM(pA0, pA1, alA, l_reg, pa0, pa1, pa2, pa3); SBAR();
        SLOAD((j + 1) * KVBLK); SBAR();
        pv_d0(o, vb0, pa0, pa1, pa2, pa3); partialSM(pB0, pB1, m_reg, mnB, alB);
        __syncthreads(); SWRITE(0);
        RESC(alB); __syncthreads();
        SBAR(); qkt(pA0, pA1, K_lds, qr, qlds, r32, hi);
        finishSM(pB0, pB1, alB, l_reg, pa0, pa1, pa2, pa3); SBAR();
        SLOAD((j + 2) * KVBLK); SBAR();
        pv_d0(o, vb0 + SHM_V, pa0, pa1, pa2, pa3); partialSM(pA0, pA1, m_reg, mnA, alA);
        __syncthreads(); SWRITE(1);
        RESC(alA); __syncthreads();
    }
    SBAR(); qkt(pB0, pB1, K_lds + SHM_K, qr, qlds, r32, hi);
    finishSM(pA0, pA1, alA, l_reg, pa0, pa1, pa2, pa3); SBAR();
    pv_d0(o, vb0, pa0, pa1, pa2, pa3); partialSM(pB0, pB1, m_reg, mnB, alB);
    __syncthreads(); RESC(alB);
    finishSM(pB0, pB1, alB, l_reg, pa0, pa1, pa2, pa3); SBAR();
    pv_d0(o, vb0 + SHM_V, pa0, pa1, pa2, pa3);
    if (hi == 0) li_l[r32] = l_reg; asm volatile("s_waitcnt lgkmcnt(0)" ::: "memory");
    float rli[16];
#pragma unroll
    for (int r = 0; r < 16; ++r) rli[r] = __builtin_amdgcn_rcpf(li_l[crow(r, hi)]);
    bf16_t* Ow = Ob + (long)(wid * QBLK) * LDO;
#pragma unroll
    for (int r = 0; r < 16; ++r) { const int orow = crow(r, hi);
#pragma unroll
        for (int d0 = 0; d0 < 4; ++d0) Ow[(long)orow * LDO + d0 * 32 + r32] = f2bf(o[d0][r] * rli[r]); }
    __syncthreads();
#undef SLOAD
#undef SWRITE
#undef RESC
}
}

__device__ __forceinline__ void phase_mix0(PRef p) {
    const int G = gridDim.x;
    phase_gla_out(p);
    __syncthreads();
    const bf16_t* QM = (const bf16_t*)(p.ws + WS_QM); const bf16_t* KM = (const bf16_t*)(p.ws + WS_KM); const bf16_t* VM = (const bf16_t*)(p.ws + WS_VM);
    bf16_t* MIX = (bf16_t*)(p.ws + WS_MIX);
    for (int u = blockIdx.x; u < 260; u += G) {
        const bool lat = u < 256;
        const int h = lat ? (u & 3) : (u - 256);
        const size_t q0 = lat ? (size_t)CTXN + (size_t)(u >> 2) * 256 : 0;
        mla::attn_body(QM + q0 * 768 + h * 192, KM + h * 192, VM + h * 128, MIX + q0 * 1024 + 512 + h * 128, lat ? NTOK : CTXN);
    }
}

template <int OFF> __device__ __forceinline__ s16x4 na_tr(int vb) { s16x4 r; asm volatile("ds_read_b64_tr_b16 %0, %1 offset:%2" : "=&v"(r) : "v"(vb), "i"(OFF) : "memory"); return r; }
template <int KS> __device__ __forceinline__ void na_pv(f32x16& o0, f32x16& o1, int vb, bf16x8 pa) {
    const s16x4 a0 = na_tr<KS * 5120>(vb), a1 = na_tr<KS * 5120 + 1280>(vb), b0 = na_tr<KS * 5120 + 64>(vb), b1 = na_tr<KS * 5120 + 1280 + 64>(vb);
    asm volatile("s_waitcnt lgkmcnt(0)" ::: "memory"); SBAR();
    o0 = __builtin_amdgcn_mfma_f32_32x32x16_bf16(pa, (bf16x8){a0[0], a0[1], a0[2], a0[3], a1[0], a1[1], a1[2], a1[3]}, o0, 0, 0, 0);
    o1 = __builtin_amdgcn_mfma_f32_32x32x16_bf16(pa, (bf16x8){b0[0], b0[1], b0[2], b0[3], b1[0], b1[1], b1[2], b1[3]}, o1, 0, 0, 0);
}
template <int MODE> __device__ __forceinline__ void na_softmax(f32x16& p0, f32x16& p1, float& m_reg, float& l_reg, float& alpha, const float* brow, int c0, int hi) {
    constexpr float C = 0.125f * LOG2E;
#define NA_L0(q) (MODE != 2 || (q) >= 12)
#define NA_L1(q) (MODE != 1 || (q) < 4)
    if (MODE == 0) {
#pragma unroll
        for (int q = 0; q < 16; ++q) { p0[q] *= C; p1[q] *= C; }
    } else {
        float bv0[16], bv1[16];
#pragma unroll
        for (int q = 0; q < 16; ++q) { const int kc0 = crow(q, hi); if (NA_L0(q)) bv0[q] = brow[kc0]; if (NA_L1(q)) bv1[q] = brow[32 + kc0]; }
#pragma unroll
        for (int q = 0; q < 16; ++q) { if (NA_L0(q)) asm volatile("" : "+v"(bv0[q])); if (NA_L1(q)) asm volatile("" : "+v"(bv1[q])); }
#pragma unroll
        for (int q = 0; q < 16; ++q) {
            const int kc0 = crow(q, hi), kc1 = 32 + kc0;
            if (NA_L0(q)) { const float t = fmaf(p0[q], C, bv0[q]); p0[q] = ((unsigned)(kc0 - c0) < 16u) ? t : -1e30f; }
            if (NA_L1(q)) { const float t = fmaf(p1[q], C, bv1[q]); p1[q] = ((unsigned)(kc1 - c0) < 16u) ? t : -1e30f; }
        }
    }
    float pmax = -1e30f;
#pragma unroll
    for (int q = 0; q < 16; ++q) { if (NA_L0(q)) pmax = fmaxf(pmax, p0[q]); if (NA_L1(q)) pmax = fmaxf(pmax, p1[q]); }
    { auto rr = __builtin_amdgcn_permlane32_swap(__float_as_uint(pmax), __float_as_uint(pmax), false, false);
      pmax = fmaxf(__uint_as_float(rr[0]), __uint_as_float(rr[1])); }
    const float mn = fmaxf(m_reg, pmax);
    alpha = __builtin_amdgcn_exp2f(m_reg - mn);
    m_reg = mn;
    float ps = 0.f;
#pragma unroll
    for (int q = 0; q < 16; ++q) {
        if (NA_L0(q)) { p0[q] = __builtin_amdgcn_exp2f(p0[q] - mn); ps += p0[q]; } else p0[q] = 0.f;
        if (NA_L1(q)) { p1[q] = __builtin_amdgcn_exp2f(p1[q] - mn); ps += p1[q]; } else p1[q] = 0.f;
    }
    { auto rr = __builtin_amdgcn_permlane32_swap(__float_as_uint(ps), __float_as_uint(ps), false, false);
      ps = __uint_as_float(rr[0]) + __uint_as_float(rr[1]); }
    l_reg = l_reg * alpha + ps;
#undef NA_L0
#undef NA_L1
}
__device__ __forceinline__ void phase_na(PRef p) {
    const int tid = threadIdx.x, lane = tid & 63, wave = tid >> 6, r32 = lane & 31, hi = lane >> 5, G = gridDim.x;
    const bf16_t* QKV = (const bf16_t*)(p.ws + WS_P);
    bf16_t* MIX = (bf16_t*)(p.ws + WS_MIX);
    constexpr int KB = 64 * 72 * 2, VB = 64 * 160 * 2;
    char* Kl = smem;
    char* Vl = smem + 2 * KB;
    float* xch = (float*)(smem + 2 * KB + 2 * VB) + wave * 64;
    float* rpbL = (float*)(smem + 2 * KB + 2 * VB + 8 * 64 * 4);
    constexpr float C = 0.125f * LOG2E;
    const int skey = tid >> 3, sch = tid & 7;
    const int vb0 = (int)(uintptr_t)Vl + (8 * hi + ((lane & 15) >> 2)) * 320 + (16 * ((lane >> 4) & 1) + 4 * (lane & 3)) * 2;
    for (int u = blockIdx.x; u < 64 * 16; u += G) {
        const int rg = u >> 4, h = u & 15;
        const int r = rg * 4 + (wave >> 1), qb = wave & 1;
        const int r0w = min(max(r - 4, 0), 248);
        const int kr_lo = min(max(rg * 4 - 4, 0), 248), kr_hi = min(max(rg * 4 + 3 - 4, 0), 248) + 7, nwin = kr_hi - kr_lo + 1, ntile = nwin + 4;
        for (int i = tid; i < 15 * 31; i += NTH) rpbL[i] = p.na_rpb[(size_t)h * 15 * 31 + i] * LOG2E;
        const int c = qb * 32 + r32, c0 = min(max(c - 8, 0), 48);
        const size_t qrow = (size_t)CTXN + (size_t)r * 64 + c;
        bf16x8 qr[4];
#pragma unroll
        for (int ks = 0; ks < 4; ++ks) qr[ks] = *(const bf16x8*)(QKV + qrow * 3072 + h * 64 + ks * 16 + hi * 8);
        float m_reg = -1e30f, l_reg = 0.f; f32x16 o0 = {}, o1 = {};
        u32x4 skA, svA, skB, svB;
#define NA_LOAD(ti_, SK, SV) do { const size_t key0_ = ((ti_) >= nwin) ? (size_t)((ti_) - nwin) * 64 : (size_t)CTXN + (size_t)(kr_lo + (ti_)) * 64; \
            const bf16_t* src_ = QKV + (key0_ + skey) * 3072 + h * 64 + sch * 8; SK = *(const u32x4*)(src_ + 1024); SV = *(const u32x4*)(src_ + 2048); } while (0)
#define NA_WRITE(b_, SK, SV) do { *(u32x4*)(Kl + (b_) * KB + skey * 144 + sch * 16) = SK; *(u32x4*)(Vl + (b_) * VB + skey * 320 + sch * 16) = SV; } while (0)
        NA_LOAD(0, skA, svA); NA_WRITE(0, skA, svA);
        NA_LOAD(1, skA, svA);
        __syncthreads();
        for (int ti = 0; ti < ntile; ++ti) {
            const int b = ti & 1;
            if (ti + 2 < ntile) { if (b == 0) NA_LOAD(ti + 2, skB, svB); else NA_LOAD(ti + 2, skA, svA); }
            const bool isctx = ti >= nwin;
            const int kr = kr_lo + ti;
            const bool need = isctx || (kr >= r0w && kr <= r0w + 7);
            if (need) {
                const bf16_t* Ks = (const bf16_t*)(Kl + b * KB);
                f32x16 p0 = {}, p1 = {};
#pragma unroll
                for (int ks = 0; ks < 4; ++ks) {
                    const bf16x8 a0 = *(const bf16x8*)(Ks + r32 * 72 + ks * 16 + hi * 8), a1 = *(const bf16x8*)(Ks + (32 + r32) * 72 + ks * 16 + hi * 8);
                    p0 = __builtin_amdgcn_mfma_f32_32x32x16_bf16(a0, qr[ks], p0, 0, 0, 0);
                    p1 = __builtin_amdgcn_mfma_f32_32x32x16_bf16(a1, qr[ks], p1, 0, 0, 0);
                }
                float alpha;
                const float* brow = rpbL + (kr - r + 7) * 31 + 15 - c;
                if (isctx) na_softmax<0>(p0, p1, m_reg, l_reg, alpha, brow, c0, hi);
                else if (qb == 0) na_softmax<1>(p0, p1, m_reg, l_reg, alpha, brow, c0, hi);
                else na_softmax<2>(p0, p1, m_reg, l_reg, alpha, brow, c0, hi);
                bf16x8 pa0, pa1, pa2, pa3;
                PK4(p0, 0, pa0); PK4(p0, 8, pa1); PK4(p1, 0, pa2); PK4(p1, 8, pa3);
                if (__any(alpha < 1.f)) {
                    if (hi == 0) xch[r32] = alpha;
                    asm volatile("s_waitcnt lgkmcnt(0)" ::: "memory");
#pragma unroll
                    for (int q = 0; q < 16; ++q) { const float a = xch[crow(q, hi)]; o0[q] *= a; o1[q] *= a; }
                }
                const int vb = vb0 + b * VB;
                na_pv<0>(o0, o1, vb, pa0); na_pv<1>(o0, o1, vb, pa1); na_pv<2>(o0, o1, vb, pa2); na_pv<3>(o0, o1, vb, pa3);
            }
            if (ti + 1 < ntile) { if (b == 0) NA_WRITE(1, skA, svA); else NA_WRITE(0, skB, svB); }
            __syncthreads();
        }
#undef NA_LOAD
#undef NA_WRITE
        if (hi == 0) xch[32 + r32] = l_reg;
        asm volatile("s_waitcnt lgkmcnt(0)" ::: "memory");
        const size_t orow0 = (size_t)CTXN + (size_t)r * 64 + qb * 32;
#pragma unroll
        for (int q = 0; q < 16; ++q) {
            const int qi = crow(q, hi); const float il = __builtin_amdgcn_rcpf(xch[32 + qi]);
            bf16_t* dst = MIX + (orow0 + qi) * 1024 + h * 64;
            dst[r32] = f2bf(o0[q] * il); dst[32 + r32] = f2bf(o1[q] * il);
        }
        __syncthreads();
    }
}
#undef PK4

#define XB_TMO      128
#define XB_XCNT(j)  (256  + 64 * (j))
#define XB_XSUB(j)  (1280 + 64 * (j))
#define XB_XGEN(j)  (2304 + 64 * (j))
#define XB_TOP      3328
#define XB_TOPGEN   3392
#define XCD_BAR_WORDS 3456
#define XB_SPIN_CAP (1u << 22)
#define LAS __attribute__((address_space(3)))
__device__ __forceinline__ unsigned xb_ld(unsigned* p)              { return __hip_atomic_load(p, __ATOMIC_RELAXED, __HIP_MEMORY_SCOPE_AGENT); }
__device__ __forceinline__ unsigned xb_add(unsigned* p, unsigned v) { return __hip_atomic_fetch_add(p, v, __ATOMIC_RELAXED, __HIP_MEMORY_SCOPE_AGENT); }
__device__ __forceinline__ unsigned xb_xcc_id() { return (unsigned)__builtin_amdgcn_s_getreg((3 << 11) | 20) & 0xFu; }
#define XB_SPIN(cond, bar) do { unsigned _sp = 0; while (cond) { __builtin_amdgcn_s_sleep(1); \
    if ((++_sp & 255u) == 0u) { if (xb_ld(&(bar)[XB_TMO])) break; if (_sp > XB_SPIN_CAP) { atomicAdd(&(bar)[XB_TMO], 1u); break; } } } } while (0)
struct XcdBarrier { unsigned* bar; unsigned x; volatile LAS unsigned* st; };
__device__ __forceinline__ XcdBarrier xcd_barrier_post(unsigned* bar, volatile LAS unsigned* st) {
    XcdBarrier b; b.bar = bar; b.x = xb_xcc_id(); b.st = st;
    if (threadIdx.x == 0) (void)xb_add(&bar[XB_XCNT(b.x)], 1u);
    return b;
}
__device__ __forceinline__ void xcd_barrier_complete(unsigned* bar, unsigned x, unsigned& nloc, unsigned& nx) {
    const unsigned G = gridDim.x * gridDim.y * gridDim.z;
    unsigned sum, cnt, mine, sp = 0u;
    for (;;) {
        sum = 0u; cnt = 0u; mine = 0u;
#pragma unroll
        for (unsigned j = 0; j < 16; ++j) { const unsigned c = xb_ld(&bar[XB_XCNT(j)]); sum += c; cnt += (c > 0u) ? 1u : 0u; mine = (j == x) ? c : mine; }
        if (sum == G) break;
        __builtin_amdgcn_s_sleep(1);
        if ((++sp & 255u) == 0u) { if (xb_ld(&bar[XB_TMO])) break; if (sp > XB_SPIN_CAP) { atomicAdd(&bar[XB_TMO], 1u); break; } }
    }
    nloc = mine > 0u ? mine : 1u; nx = cnt > 0u ? cnt : 1u;
}
__device__ __forceinline__ void xcd_barrier(const XcdBarrier& b) {
    asm volatile("s_waitcnt vmcnt(0)" ::: "memory");
    __syncthreads();
    if (threadIdx.x == 0) {
        unsigned* bar = b.bar;
        __builtin_amdgcn_s_waitcnt(0);
        unsigned nloc = b.st[0], nx = b.st[1];
        if (nloc == 0u) { xcd_barrier_complete(bar, b.x, nloc, nx); b.st[0] = nloc; b.st[1] = nx; }
        const unsigned old = xb_add(&bar[XB_XSUB(b.x)], 1u);
        const unsigned gen = old / nloc;
        if (old + 1u == (gen + 1u) * nloc) {
            __builtin_amdgcn_fence(__ATOMIC_RELEASE, "agent");
            asm volatile("s_waitcnt vmcnt(0)" ::: "memory");
            const unsigned og = xb_add(&bar[XB_TOP], 1u);
            const unsigned tg = og / nx;
            if (og + 1u == (tg + 1u) * nx) xb_add(&bar[XB_TOPGEN], 1u);
            else XB_SPIN(xb_ld(&bar[XB_TOPGEN]) == tg, bar);
            __builtin_amdgcn_fence(__ATOMIC_ACQUIRE, "agent");
            xb_add(&bar[XB_XGEN(b.x)], 1u);
            asm volatile("s_waitcnt vmcnt(0)" ::: "memory");
        } else {
            XB_SPIN(xb_ld(&bar[XB_XGEN(b.x)]) == gen, bar);
            __builtin_amdgcn_fence(__ATOMIC_ACQUIRE, "agent");
            asm volatile("s_waitcnt vmcnt(0)" ::: "memory");
        }
    }
    __syncthreads();
}

__device__ __forceinline__ void run_phase(PRef p, int ph) {
#ifdef ONLY_PHASE
    if (ph != ONLY_PHASE) return;
    ph = ONLY_PHASE;
#endif
    const bf16_t* HB = (const bf16_t*)(p.ws + WS_HB);
    switch (ph) {
    case 0: phase_prologue(p); break;
    case 1: phase_norm1_l0(p); break;
    case 2: phase_gemm_pg8(HB, 1024, (const bf16_t*)(p.ws + WS_WIN), 1024, (bf16_t*)(p.ws + WS_P), PW, NTOK / 256, 8); break;
    case 3: phase_mla_up(p); break;
    case 4: break;
    case 5: phase_gla_scan(p); break;
    case 6: phase_mix0(p); break;
    case 7: phase_gemm_pg8((const bf16_t*)(p.ws + WS_MIX), 1024, (const bf16_t*)(p.ws + WS_WOUT0), 1024, (bf16_t*)(p.ws + WS_OB), 1024, NTOK / 256, 4); break;
    case 8: phase_mid(p, 0); break;
    case 9: phase_moe1(p, 0); break;
    case 10: phase_moe2(p, 0); break;
    case 11: phase_end(p, 0); break;
    case 12: phase_gemm_pg8(HB, 1024, (const bf16_t*)(p.ws + WS_WQKV), 1024, (bf16_t*)(p.ws + WS_P), 3072, NTOK / 256, 12); break;
    case 13: phase_na(p); break;
    case 14: phase_gemm_pg8((const bf16_t*)(p.ws + WS_MIX) + (size_t)CTXN * 1024, 1024, (const bf16_t*)(p.ws + WS_WNAO), 1024, (bf16_t*)(p.ws + WS_OB) + (size_t)CTXN * 1024, 1024, SEQ / 256, 4); break;
    case 15: phase_mid(p, 1); break;
    case 16: phase_moe1(p, 1); break;
    case 17: phase_moe2(p, 1); break;
    case 18: phase_end(p, 1); break;
    default: break;
    }
}
constexpr int N_PHASES = 19;

#if MK_LAUNCHES == 1
__global__ void __launch_bounds__(512) mega_kernel(Params p) {
    cg::grid_group grid = cg::this_grid();
    volatile LAS unsigned* xst = (volatile LAS unsigned*)(smem + LDS_BYTES - 16);
    if (threadIdx.x == 0) { xst[0] = 0u; xst[1] = 0u; xst[2] = 0u; xst[3] = 0u; }
    __syncthreads();
    XcdBarrier xb = xcd_barrier_post((unsigned*)(kparams()->ws + WS_BAR), xst);
    run_phase(*kparams(), 0); xcd_barrier(xb);
    if (kparams()->pad0 == 0x7fffffff) grid.sync();
    if (PROBE_REPEAT == 100) { run_phase(*kparams(), 0); xcd_barrier(xb); }
    if (PROBE_REPEAT == 61) { phase_gla_out(*kparams()); xcd_barrier(xb); }
#define PH_(n) run_phase(*kparams(), n); xcd_barrier(xb); if ((n) == PROBE_REPEAT) { run_phase(*kparams(), n); xcd_barrier(xb); }
    PH_(1) PH_(2) PH_(3) PH_(5) PH_(6) PH_(7) PH_(8) PH_(9) PH_(10) PH_(11) PH_(12) PH_(13) PH_(14) PH_(15) PH_(16) PH_(17)
    run_phase(*kparams(), 18);
#undef PH_
}
#else
template <int PH> __global__ void __launch_bounds__(512) phase_kernel(Params p) { run_phase(*kparams(), PH); }
typedef void (*phase_fn)(Params);
template <int PH> static bool launch_phase(PRef p, int grid, hipStream_t stream, bool setattr) {
    if (setattr && hipFuncSetAttribute((const void*)phase_kernel<PH>, hipFuncAttributeMaxDynamicSharedMemorySize, LDS_BYTES) != hipSuccess) return false;
    hipLaunchKernelGGL(phase_kernel<PH>, dim3(grid), dim3(NTH), LDS_BYTES, stream, p);
    return true;
}
#endif

extern "C" void kernel_launch(void* const* d_in, const int* in_sizes, int n_in, void* d_out, int out_size, void* d_ws, size_t ws_size, hipStream_t stream) {
    static int grid_blocks = 0;
    bool first = false;
    if (!grid_blocks) {
        if (ws_size < WS_END) { fprintf(stderr, "kernel_launch: workspace too small: %zu < %zu\n", ws_size, (size_t)WS_END); return; }
        int dev = 0, cus = 0;
        (void)hipGetDevice(&dev);
        (void)hipDeviceGetAttribute(&cus, hipDeviceAttributeMultiprocessorCount, dev);
#if MK_LAUNCHES == 1
        if (hipFuncSetAttribute((const void*)mega_kernel, hipFuncAttributeMaxDynamicSharedMemorySize, LDS_BYTES) != hipSuccess) { fprintf(stderr, "kernel_launch: LDS attribute failed\n"); return; }
        int per_cu = 0;
        (void)hipOccupancyMaxActiveBlocksPerMultiprocessor(&per_cu, (const void*)mega_kernel, NTH, LDS_BYTES);
        if (per_cu < 1) { fprintf(stderr, "kernel_launch: occupancy query returned %d\n", per_cu); return; }
#endif
        grid_blocks = cus;
        first = true;
    }
    Params p{};
    const float* const* in = (const float* const*)d_in;
    p.x = in[0]; p.c = in[1]; p.ctx = in[2]; p.c_ctx = in[3]; p.ada_w = in[4]; p.ada_b = in[5]; p.norm_g = in[6]; p.router_w = in[7]; p.router_b = in[8];
    p.moe_w1 = in[9]; p.moe_b1 = in[10]; p.moe_w2 = in[11]; p.moe_b2 = in[12]; p.ab_in_w = in[13]; p.gla_wa_f = in[14]; p.gla_ba_f = in[15]; p.gla_wa_b = in[16]; p.gla_ba_b = in[17];
    p.gla_onorm = in[18]; p.mla_qnorm = in[19]; p.mla_wuq = in[20]; p.mla_kvnorm = in[21]; p.mla_wukv = in[22]; p.ab_out_w = in[23]; p.na_qkv_w = in[24]; p.na_rpb = in[25]; p.na_out_w = in[26];
    p.out = (float*)d_out; p.ws = (char*)d_ws;
#if MK_LAUNCHES == 1
    (void)hipMemsetAsync((char*)d_ws + WS_BAR, 0, 16384, stream);
    void* args[] = {&p};
    hipError_t e = hipLaunchCooperativeKernel((const void*)mega_kernel, dim3(grid_blocks), dim3(NTH), args, LDS_BYTES, stream);
    if (e != hipSuccess) fprintf(stderr, "cooperative launch failed: %s (grid %d)\n", hipGetErrorString(e), grid_blocks);
#else
    const int g = grid_blocks;
    launch_phase<0>(p, g, stream, first); launch_phase<1>(p, g, stream, first); launch_phase<2>(p, g, stream, first); launch_phase<3>(p, g, stream, first);
    launch_phase<4>(p, g, stream, first); launch_phase<5>(p, g, stream, first); launch_phase<6>(p, g, stream, first); launch_phase<7>(p, g, stream, first);
    launch_phase<8>(p, g, stream, first); launch_phase<9>(p, g, stream, first); launch_phase<10>(p, g, stream, first); launch_phase<11>(p, g, stream, first);
    launch_phase<12>(p, g, stream, first); launch_phase<13>(p, g, stream, first); launch_phase<14>(p, g, stream, first); launch_phase<15>(p, g, stream, first);
    launch_phase<16>(p, g, stream, first); launch_phase<17>(p, g, stream, first); launch_phase<18>(p, g, stream, first);
#endif
}
```

```cpp
#include <hip/hip_runtime.h>
#include <hip/hip_cooperative_groups.h>
#include <cstdio>
#include <cstdint>
namespace cg = cooperative_groups;

#ifndef PROBE_REPEAT
#define PROBE_REPEAT -1
#endif
#ifndef MK_LAUNCHES
#define MK_LAUNCHES 1
#endif

typedef unsigned short bf16_t;
typedef short bf16x8 __attribute__((ext_vector_type(8)));
typedef short s16x4 __attribute__((ext_vector_type(4)));
typedef float f32x4 __attribute__((ext_vector_type(4)));
typedef float f32x16 __attribute__((ext_vector_type(16)));
typedef unsigned u32x4 __attribute__((ext_vector_type(4)));
typedef int i32x4 __attribute__((ext_vector_type(4)));
typedef unsigned u32x2 __attribute__((ext_vector_type(2)));

constexpr int SEQ = 16384, CTXN = 256, NTOK = SEQ + CTXN, DM = 1024;
constexpr int NEXP = 32, FF = 1024;
constexpr int PW = 2048;
constexpr int PC_Q = 0, PC_K = 256, PC_V = 512, PC_R = 1024, PC_AF = 1536, PC_AB = 1552, PC_CQ = 1568, PC_CKV = 1824, PC_KR = 1952;
constexpr int NCH = NTOK / 64;
constexpr int NTH = 512;
constexpr float EPSN = 1e-6f;
constexpr float LOG2E = 1.4426950408889634f;

constexpr size_t al256(size_t x) { return (x + 255) / 256 * 256; }
constexpr size_t WS_BAR   = 0;
constexpr size_t WS_CNT   = WS_BAR + 16384;
constexpr size_t WS_MOD   = WS_CNT + 1024;
constexpr size_t WS_ROPE  = WS_MOD + al256((size_t)2 * 2 * 6144 * 4);
constexpr size_t WS_RWT   = WS_ROPE + al256((size_t)(256 + 256 + 64 + 64) * 16 * 4);
constexpr size_t WS_WIN   = WS_RWT + al256((size_t)2 * 32 * 1024 * 4);
constexpr size_t WS_WUQ   = WS_WIN + (size_t)2048 * 1024 * 2;
constexpr size_t WS_WUKV  = WS_WUQ + (size_t)768 * 256 * 2;
constexpr size_t WS_WOUT0 = WS_WUKV + (size_t)1024 * 128 * 2;
constexpr size_t WS_WQKV  = WS_WOUT0 + (size_t)1024 * 1024 * 2;
constexpr size_t WS_WNAO  = WS_WQKV + (size_t)3072 * 1024 * 2;
constexpr size_t WS_W1T   = WS_WNAO + (size_t)1024 * 1024 * 2;
constexpr size_t WS_W2T   = WS_W1T + (size_t)2 * 32 * 2048 * 1024 * 2;
constexpr size_t WS_Q8    = WS_W1T + (size_t)2 * 32 * 2048 * 1024;
constexpr size_t WS_K8    = WS_Q8 + (size_t)NTOK * 768;
constexpr size_t WS_VT8   = WS_K8 + (size_t)NTOK * 768;
static_assert(WS_VT8 + (size_t)NTOK * 512 <= WS_W2T, "fp8 MLA operands overflow the W1T region");
constexpr size_t WS_HB    = WS_W2T + (size_t)2 * 32 * 1024 * 1024 * 2;
constexpr size_t WS_P     = WS_HB + (size_t)NTOK * 1024 * 2;
constexpr size_t WS_QM    = WS_P + (size_t)NTOK * 3072 * 2;
constexpr size_t WS_KM    = WS_QM + (size_t)NTOK * 768 * 2;
constexpr size_t WS_VM    = WS_KM + (size_t)NTOK * 768 * 2;
constexpr size_t WS_U     = WS_VM + (size_t)NTOK * 512 * 2;
constexpr size_t WS_SIN   = WS_U + (size_t)2 * NCH * 4 * 128 * 64 * 2;
constexpr size_t WS_DEC   = WS_SIN + (size_t)2 * NCH * 4 * 128 * 64 * 2;
constexpr size_t WS_MIX   = WS_DEC + al256((size_t)2 * NCH * 4 * 64 * 4);
constexpr size_t WS_OB    = WS_MIX + (size_t)NTOK * 1024 * 2;
constexpr size_t WS_X1    = WS_OB + (size_t)NTOK * 1024 * 2;
constexpr size_t WS_X2    = WS_X1 + (size_t)NTOK * 1024 * 4;
constexpr size_t WS_TOPE  = WS_X2 + (size_t)NTOK * 1024 * 4;
constexpr size_t WS_TOPP  = WS_TOPE + al256((size_t)NTOK * 4 * 4);
constexpr size_t WS_GATE  = WS_TOPP + al256((size_t)NTOK * 4 * 4);
constexpr size_t WS_LIST  = WS_GATE + al256((size_t)NTOK * 4 * 4);
constexpr size_t WS_ACT   = WS_LIST + al256((size_t)32 * NTOK * 4);
constexpr size_t WS_YB    = WS_ACT + (size_t)(NTOK * 4 + 256) * 1024 * 2;
constexpr size_t WS_END   = WS_YB + (size_t)(NTOK * 4) * 1024 * 2;

constexpr int LDS_BYTES = 160 * 1024;
extern __shared__ __attribute__((aligned(16))) char smem[];

struct Params {
    const float *x, *c, *ctx, *c_ctx, *ada_w, *ada_b, *norm_g, *router_w, *router_b, *moe_w1, *moe_b1, *moe_w2, *moe_b2;
    const float *ab_in_w, *gla_wa_f, *gla_ba_f, *gla_wa_b, *gla_ba_b, *gla_onorm, *mla_qnorm, *mla_wuq, *mla_kvnorm, *mla_wukv;
    const float *ab_out_w, *na_qkv_w, *na_rpb, *na_out_w;
    float* out; char* ws;
    int pad0, pad1;
};
typedef const __attribute__((address_space(4))) Params& PRef;
typedef const __attribute__((address_space(4))) Params* KPtr;
__device__ __forceinline__ KPtr kparams() { KPtr k = (KPtr)__builtin_amdgcn_kernarg_segment_ptr(); asm volatile("" : "+s"(k)); return k; }

__device__ __forceinline__ float bf2f(bf16_t h) { return __uint_as_float(((unsigned)h) << 16); }
__device__ __forceinline__ bf16_t f2bf(float f) { unsigned u = __float_as_uint(f); u += 0x7FFFu + ((u >> 16) & 1u); return (bf16_t)(u >> 16); }
__device__ __forceinline__ unsigned cvtpk(float lo, float hi) { unsigned r; asm volatile("v_cvt_pk_bf16_f32 %0, %1, %2" : "=v"(r) : "v"(lo), "v"(hi)); return r; }
__device__ __forceinline__ float wave_sum(float v) {
#pragma unroll
    for (int o = 32; o >= 1; o >>= 1) v += __shfl_xor(v, o);
    return v;
}
__device__ __forceinline__ int crow(int r, int hi) { return (r & 3) + 8 * (r >> 2) + 4 * hi; }
__device__ __forceinline__ float silu_f(float x) { return x / (1.f + __expf(-x)); }
#define SBAR() __builtin_amdgcn_sched_barrier(0)
__device__ __forceinline__ unsigned pk4_fp8(float a, float b, float c, float d) {
    a = __builtin_amdgcn_fmed3f(a, -448.f, 448.f); b = __builtin_amdgcn_fmed3f(b, -448.f, 448.f); c = __builtin_amdgcn_fmed3f(c, -448.f, 448.f); d = __builtin_amdgcn_fmed3f(d, -448.f, 448.f);
    int r = __builtin_amdgcn_cvt_pk_fp8_f32(a, b, 0, false); r = __builtin_amdgcn_cvt_pk_fp8_f32(c, d, r, true); return (unsigned)r; }
__device__ __forceinline__ int tid_opaque() { int t = threadIdx.x; asm volatile("" : "+v"(t)); return t; }

struct ConvJob { const float* src; bf16_t* dst; const float* gain; int K, Nsrc, kt, nt, mode, f8; };
constexpr int CONV8_RS = 264;
constexpr float W8_SCALE = 64.f;
__device__ __forceinline__ void conv_load(const ConvJob& jb, float4 (&v)[16]) {
    const int tid = threadIdx.x, n4 = tid & 63, kr = tid >> 6, n = jb.nt * 256 + n4 * 4;
    const float* q = jb.src + (size_t)(jb.kt * 128 + kr) * jb.Nsrc + n;
#pragma unroll
    for (int i = 0; i < 16; ++i) { if (n < jb.Nsrc) { const f32x4 t = __builtin_nontemporal_load((const f32x4*)(q + (size_t)(8 * i) * jb.Nsrc)); v[i] = make_float4(t[0], t[1], t[2], t[3]); } else v[i] = make_float4(0.f, 0.f, 0.f, 0.f); }
}
__device__ __forceinline__ void conv_to_lds(const ConvJob& jb, const float4 (&v)[16]) {
    bf16_t* T = (bf16_t*)smem;
    const int tid = threadIdx.x, n4 = tid & 63, kr = tid >> 6;
#pragma unroll
    for (int i = 0; i < 16; ++i) {
        const int k = kr + 8 * i;
        float4 w = v[i];
        if (jb.mode == 1) { const float g = jb.gain[jb.kt * 128 + k]; w.x *= g; w.y *= g; w.z *= g; w.w *= g; }
        if (jb.f8) { *(unsigned*)((char*)smem + k * CONV8_RS + n4 * 4) = pk4_fp8(w.x * W8_SCALE, w.y * W8_SCALE, w.z * W8_SCALE, w.w * W8_SCALE); continue; }
        u32x2 pk; pk.x = cvtpk(w.x, w.y); pk.y = cvtpk(w.z, w.w);
        *(u32x2*)(T + k * 260 + n4 * 4) = pk;
    }
}
__device__ __forceinline__ void conv_readout(const ConvJob& jb) {
    const bf16_t* T = (const bf16_t*)smem;
    const int tid = threadIdx.x, k0 = jb.kt * 128;
    if (jb.f8) {
        const unsigned char* T8 = (const unsigned char*)smem;
#pragma unroll
        for (int i = 0; i < 4; ++i) {
            const int cc = tid + 512 * i, nn = cc >> 3, kc = cc & 7;
            const int col = (jb.mode == 2) ? (2 * (nn & 127) + (nn >> 7)) : nn;
            unsigned e[16];
#pragma unroll
            for (int j = 0; j < 16; ++j) e[j] = T8[(kc * 16 + j) * CONV8_RS + col];
            u32x4 o;
#pragma unroll
            for (int q = 0; q < 4; ++q) o[q] = e[4 * q] | (e[4 * q + 1] << 8) | (e[4 * q + 2] << 16) | (e[4 * q + 3] << 24);
            __builtin_nontemporal_store(o, (u32x4*)((char*)jb.dst + (size_t)(jb.nt * 256 + nn) * jb.K + k0 + kc * 16));
        }
        return;
    }
#pragma unroll
    for (int i = 0; i < 8; ++i) {
        const int cc = tid + 512 * i, nn = cc >> 4, kc = cc & 15;
        const int col = (jb.mode == 2) ? (2 * (nn & 127) + (nn >> 7)) : nn;
        unsigned short e[8];
#pragma unroll
        for (int j = 0; j < 8; ++j) e[j] = T[(kc * 8 + j) * 260 + col];
        u32x4 o; o.x = e[0] | ((unsigned)e[1] << 16); o.y = e[2] | ((unsigned)e[3] << 16); o.z = e[4] | ((unsigned)e[5] << 16); o.w = e[6] | ((unsigned)e[7] << 16);
        __builtin_nontemporal_store(o, (u32x4*)(jb.dst + (size_t)(jb.nt * 256 + nn) * jb.K + k0 + kc * 8));
    }
}

__device__ __forceinline__ void adaln_job(PRef p, int job) {
    const int l = job / 24, cb = (job % 24) * 256, tid = threadIdx.x;
    float* sv = (float*)smem;
    for (int i = tid; i < 2048; i += NTH) { const int k = i & 1023; const float xx = (i < 1024) ? p.c[k] : p.c_ctx[k]; sv[i] = silu_f(xx); }
    __syncthreads();
    const int col4 = tid & 63, kq = tid >> 6;
    float4 a0 = make_float4(0, 0, 0, 0), a1 = make_float4(0, 0, 0, 0);
    const float* w = p.ada_w + ((size_t)l * 1024 + kq * 128) * 6144 + cb + col4 * 4;
#pragma unroll 8
    for (int k = 0; k < 128; ++k) {
        const float4 wv = *(const float4*)(w + (size_t)k * 6144);
        const float s0 = sv[kq * 128 + k], s1 = sv[1024 + kq * 128 + k];
        a0.x += s0 * wv.x; a0.y += s0 * wv.y; a0.z += s0 * wv.z; a0.w += s0 * wv.w;
        a1.x += s1 * wv.x; a1.y += s1 * wv.y; a1.z += s1 * wv.z; a1.w += s1 * wv.w;
    }
    float* red = sv + 2048;
    *(float4*)(red + (kq * 2 + 0) * 256 + col4 * 4) = a0;
    *(float4*)(red + (kq * 2 + 1) * 256 + col4 * 4) = a1;
    __syncthreads();
    {
        const int s = tid >> 8, col = tid & 255;
        float acc = p.ada_b[l * 6144 + cb + col];
#pragma unroll
        for (int q = 0; q < 8; ++q) acc += red[(q * 2 + s) * 256 + col];
        ((float*)(p.ws + WS_MOD))[(l * 2 + s) * 6144 + cb + col] = acc;
    }
    __syncthreads();
}

__device__ __forceinline__ void tables_job(PRef p) {
    float* rope = (float*)(p.ws + WS_ROPE);
    const int tid = threadIdx.x;
    for (int i = tid; i < (256 + 64) * 16; i += NTH) {
        const bool isrow = i < 256 * 16;
        const int idx = isrow ? i : i - 256 * 16, pos = idx >> 4, j = idx & 15;
        const float inv = exp2f(-(float)j * (13.287712379549449f / 16.f));
        const float ang = (float)pos * inv;
        float rev = ang * 0.15915494309189535f; rev -= rintf(rev);
        const float cs = __builtin_amdgcn_cosf(rev), sn = __builtin_amdgcn_sinf(rev);
        if (isrow) { rope[idx] = cs; rope[256 * 16 + idx] = sn; }
        else { rope[512 * 16 + idx] = cs; rope[512 * 16 + 64 * 16 + idx] = sn; }
    }
    if (tid < 64) ((int*)(p.ws + WS_CNT))[tid] = 0;
}
__device__ __forceinline__ void rwt_job(PRef p, int l) {
    float* dst = (float*)(p.ws + WS_RWT) + (size_t)l * 32 * 1024;
    const float* src = p.router_w + (size_t)l * 1024 * 32;
    for (int i = threadIdx.x; i < 32 * 1024; i += NTH) { const int cch = i >> 5, e = i & 31; dst[e * 1024 + cch] = src[i]; }
}

constexpr int J_IN = 8 * 8, J_UQ = 2 * 3, J_UKV = 1 * 4, J_OUT0 = 32, J_QKV = 8 * 12, J_NAO = 32, J_W1 = 64 * 64, J_W2 = 64 * 32;
constexpr int J_TOTAL = J_IN + J_UQ + J_UKV + J_OUT0 + J_QKV + J_NAO + J_W1 + J_W2;
__device__ __forceinline__ ConvJob conv_decode(PRef p, int j) {
    ConvJob jb; jb.gain = nullptr; jb.mode = 0; jb.f8 = 0;
    int t = j;
    if (t < J_W1) { const int m = t >> 6, q = t & 63; jb.src = p.moe_w1 + (size_t)m * 1024 * 2048; jb.dst = (bf16_t*)(p.ws + WS_W1T + (size_t)m * 2048 * 1024); jb.K = 1024; jb.Nsrc = 2048; jb.kt = q >> 3; jb.nt = q & 7; jb.mode = 2; jb.f8 = 1; return jb; } t -= J_W1;
    if (t < J_W2) { const int m = t >> 5, q = t & 31; jb.src = p.moe_w2 + (size_t)m * 1024 * 1024; jb.dst = (bf16_t*)(p.ws + WS_W2T + (size_t)m * 1024 * 1024); jb.K = 1024; jb.Nsrc = 1024; jb.kt = q >> 2; jb.nt = q & 3; jb.f8 = 1; return jb; } t -= J_W2;
    if (t < J_IN) { jb.src = p.ab_in_w; jb.dst = (bf16_t*)(p.ws + WS_WIN); jb.K = 1024; jb.Nsrc = 2016; jb.kt = t / 8; jb.nt = t % 8; return jb; } t -= J_IN;
    if (t < J_UQ) { jb.src = p.mla_wuq; jb.dst = (bf16_t*)(p.ws + WS_WUQ); jb.K = 256; jb.Nsrc = 768; jb.kt = t / 3; jb.nt = t % 3; jb.mode = 1; jb.gain = p.mla_qnorm; return jb; } t -= J_UQ;
    if (t < J_UKV) { jb.src = p.mla_wukv; jb.dst = (bf16_t*)(p.ws + WS_WUKV); jb.K = 128; jb.Nsrc = 1024; jb.kt = 0; jb.nt = t; jb.mode = 1; jb.gain = p.mla_kvnorm; return jb; } t -= J_UKV;
    if (t < J_OUT0) { jb.src = p.ab_out_w; jb.dst = (bf16_t*)(p.ws + WS_WOUT0); jb.K = 1024; jb.Nsrc = 1024; jb.kt = t / 4; jb.nt = t % 4; return jb; } t -= J_OUT0;
    if (t < J_QKV) { jb.src = p.na_qkv_w; jb.dst = (bf16_t*)(p.ws + WS_WQKV); jb.K = 1024; jb.Nsrc = 3072; jb.kt = t / 12; jb.nt = t % 12; return jb; } t -= J_QKV;
    jb.src = p.na_out_w; jb.dst = (bf16_t*)(p.ws + WS_WNAO); jb.K = 1024; jb.Nsrc = 1024; jb.kt = t / 4; jb.nt = t % 4; return jb;
}

__device__ __forceinline__ void phase_prologue(PRef p) {
    const int G = gridDim.x, b = blockIdx.x;
    for (int j = b; j < 51; j += G) {
        if (j < 48) adaln_job(p, j);
        else if (j == 48) tables_job(p);
        else rwt_job(p, j - 49);
    }
    __syncthreads();
    int j = b;
    if (j >= J_TOTAL) return;
    ConvJob cur = conv_decode(p, j);
    float4 v[16];
    conv_load(cur, v);
    for (;;) {
        conv_to_lds(cur, v);
        __syncthreads();
        const int jn = j + G;
        ConvJob nxt = cur;
        if (jn < J_TOTAL) { nxt = conv_decode(p, jn); conv_load(nxt, v); }
        conv_readout(cur);
        __syncthreads();
        if (jn >= J_TOTAL) break;
        cur = nxt; j = jn;
    }
}

namespace gm {
constexpr int BK = 64, HT = 128 * 64;
__device__ __forceinline__ int lds_byte(int r, int c) { const int st = (r >> 4) * 2 + (c >> 5), rr = r & 15, cc = c & 31, ob = rr * 64 + cc * 2; return st * 1024 + (ob ^ (((ob >> 9) & 1) << 5)); }
__device__ __forceinline__ void stage_rc(int b, int& R, int& C) { const int st = b / 1024, sb = b % 1024, swz = sb ^ (((sb >> 9) & 1) << 5); R = (st >> 1) * 16 + swz / 64; C = (st & 1) * 32 + (swz % 64) / 2; }

template <class Epi>
__device__ __forceinline__ void gemm_tile(const bf16_t* __restrict__ A, const int (&aoff)[2][2], const bf16_t* __restrict__ Bt, const int (&boff)[2], int nk, Epi& epi) {
    bf16_t* shm = (bf16_t*)smem;
    const int tid = tid_opaque(), wid = tid >> 6, lane = tid & 63, wr = wid >> 1, wc = wid & 1, fr = lane & 15, fq = lane >> 4;
    f32x4 acc[4][4];
#pragma unroll
    for (int m = 0; m < 4; ++m)
#pragma unroll
        for (int n = 0; n < 4; ++n) acc[m][n] = (f32x4){0.f, 0.f, 0.f, 0.f};
#define GM_STAGE(buf, kt) do { \
        _Pragma("unroll") for (int _i = 0; _i < 2; ++_i) { \
            __builtin_amdgcn_global_load_lds((const unsigned*)(A + aoff[0][_i] + (kt) * BK), (unsigned*)((char*)(shm + ((buf) * 3 + 0) * HT) + tid * 16 + _i * 8192), 16, 0, 0); \
            __builtin_amdgcn_global_load_lds((const unsigned*)(A + aoff[1][_i] + (kt) * BK), (unsigned*)((char*)(shm + ((buf) * 3 + 1) * HT) + tid * 16 + _i * 8192), 16, 0, 0); \
            __builtin_amdgcn_global_load_lds((const unsigned*)(Bt + boff[_i] + (kt) * BK), (unsigned*)((char*)(shm + ((buf) * 3 + 2) * HT) + tid * 16 + _i * 8192), 16, 0, 0); } } while (0)
    GM_STAGE(0, 0);
    for (int kt = 0; kt < nk; ++kt) {
        __syncthreads();
        const int buf = kt & 1;
        if (kt + 1 < nk) GM_STAGE(buf ^ 1, kt + 1);
        const char* Ab = (const char*)(shm + (buf * 3 + (wr >> 1)) * HT);
        const char* Bb = (const char*)(shm + (buf * 3 + 2) * HT);
#pragma unroll
        for (int k = 0; k < 2; ++k) {
            bf16x8 Bf[4], Af[4];
#pragma unroll
            for (int n = 0; n < 4; ++n) Bf[n] = *(const bf16x8*)(Bb + lds_byte(wc * 64 + n * 16 + fr, k * 32 + fq * 8));
#pragma unroll
            for (int m = 0; m < 4; ++m) Af[m] = *(const bf16x8*)(Ab + lds_byte((wr & 1) * 64 + m * 16 + fr, k * 32 + fq * 8));
#pragma unroll
            for (int m = 0; m < 4; ++m)
#pragma unroll
                for (int n = 0; n < 4; ++n) acc[m][n] = __builtin_amdgcn_mfma_f32_16x16x32_bf16(Af[m], Bf[n], acc[m][n], 0, 0, 0);
        }
    }
#undef GM_STAGE
    float* stg = (float*)smem;
    __syncthreads();
    {
        float* wb = stg + (wr * 64 + fq * 4) * 132 + wc * 64 + fr;
#pragma unroll
        for (int m = 0; m < 4; ++m)
#pragma unroll
            for (int n = 0; n < 4; ++n)
#pragma unroll
                for (int j = 0; j < 4; ++j) wb[(m * 16 + j) * 132 + n * 16] = acc[m][n][j];
    }
    __syncthreads();
    if (Epi::MOE1) {
        const int fch = tid & 7, rg = tid >> 3;
        for (int ps = 0; ps < 4; ++ps) {
            const int row = ps * 64 + rg;
            const float* q = stg + row * 132 + (fch >> 1) * 32 + (fch & 1) * 8;
            float g[8], l[8];
            *(f32x4*)&g[0] = *(const f32x4*)q; *(f32x4*)&g[4] = *(const f32x4*)(q + 4);
            *(f32x4*)&l[0] = *(const f32x4*)(q + 16); *(f32x4*)&l[4] = *(const f32x4*)(q + 20);
            epi.pair(row, fch * 8, g, l);
        }
    } else {
        const int ch = tid & 15, rg = tid >> 4;
        for (int ps = 0; ps < 8; ++ps) {
            const int row = ps * 32 + rg;
            const float* q = stg + row * 132 + ch * 8;
            float v[8];
            *(f32x4*)&v[0] = *(const f32x4*)q; *(f32x4*)&v[4] = *(const f32x4*)(q + 4);
            epi.row8(row, ch * 8, v);
        }
    }
    __syncthreads();
}
__device__ __forceinline__ void make_off(int (&off)[2][2], int row0, int ld) {
#pragma unroll
    for (int h = 0; h < 2; ++h)
#pragma unroll
        for (int i = 0; i < 2; ++i) { int R, C; stage_rc(tid_opaque() * 16 + i * 8192, R, C); off[h][i] = (row0 + h * 128 + R) * ld + C; }
}
__device__ __forceinline__ void make_off1(int (&off)[2], int row0, int ld) {
#pragma unroll
    for (int i = 0; i < 2; ++i) { int R, C; stage_rc(tid_opaque() * 16 + i * 8192, R, C); off[i] = (row0 + R) * ld + C; }
}
}

namespace pg8 {
#define PG8_LAS __attribute__((address_space(3)))
constexpr int BM = 256, BK = 64, HALF = 128, HTB = HALF * BK * 2, STAGE_BYTES = 8 * HTB, NXCD = 8, WGM = 8;
__device__ __forceinline__ int lds_byte(int r, int c) { const int st = (r >> 4) * 2 + (c >> 5), rr = r & 15, cc = c & 31, ob = rr * 64 + cc * 2; return st * 1024 + (ob ^ (((ob >> 9) & 1) << 5)); }
__device__ __forceinline__ void stage_rc(int b, int& R, int& C) { const int st = b / 1024, sb = b % 1024, swz = sb ^ (((sb >> 9) & 1) << 5); R = (st >> 1) * 16 + swz / 64; C = (st & 1) * 32 + (swz % 64) / 2; }
__device__ __forceinline__ int perm32(int rho) { const int n = rho >> 4, i = rho & 15; return 8 * (i >> 2) + 4 * n + (i & 3); }
struct Unit { int pm, pn, e, nvalid, slot0; };

template <class Epi, class Sched, bool GATHER, bool F8 = false>
__device__ __forceinline__ void gemm_phase(PG8_LAS unsigned char* lds, const Sched& S, const Epi& E, int K, int lda, int ldb, int scA = 0x7F7F7F7F, int scB = 0x7F7F7F7F) {
    const int tid = tid_opaque(), wid = __builtin_amdgcn_readfirstlane(tid >> 6), lane = tid & 63, wr = wid >> 2, wc = wid & 3, fr = lane & 15, fq = lane >> 4;
    const int nt = K / BK;
    unsigned voffA[2], voffB[2]; int gR[2], gC[2];
#pragma unroll
    for (int i = 0; i < 2; ++i) { int R, C; stage_rc(tid * 16 + i * 8192, R, C); const int Rb = Epi::PERM ? ((R & ~31) + perm32(R & 31)) : R;
        voffA[i] = (unsigned)(R * lda + C) * 2u; voffB[i] = (unsigned)(Rb * ldb + C) * 2u; gR[i] = R; gC[i] = C * 2; }
    const size_t kstep = (size_t)(BK * 2);
    const size_t hstepA = (size_t)HALF * lda * 2, hstepB = (size_t)HALF * ldb * 2;
    const unsigned ldsw = (unsigned)wid * 1024u;
    const int aoff = lds_byte(wr * 64 + fr, fq * 8), boff = lds_byte(wc * 32 + fr, fq * 8);
    unsigned gA[2][2] = {{0u, 0u}, {0u, 0u}};
#define PG8_SA(b, h) (((b) * 2 + (h)) * HTB)
#define PG8_SB(b, h) ((4 + (b) * 2 + (h)) * HTB)
#define PG8_STAGE(bufoff, gbase, voff) do { _Pragma("unroll") for (int _i = 0; _i < 2; ++_i) \
        __builtin_amdgcn_global_load_lds((const unsigned*)((const char*)(gbase) + (voff)[_i]), (PG8_LAS unsigned*)(lds + (bufoff) + ldsw + _i * 8192), 16, 0, 0); } while (0)
#define PG8_STAGE_A(bufoff, base, h) do { if constexpr (GATHER) PG8_STAGE(bufoff, base, gA[h]); else PG8_STAGE(bufoff, (base) + (h) * hstepA, voffA); } while (0)
#define PG8_LDA(dst, b, h) do { _Pragma("unroll") for (int m = 0; m < 4; ++m) _Pragma("unroll") for (int k = 0; k < 2; ++k) dst[m][k] = *(const PG8_LAS bf16x8*)(lds + PG8_SA(b, h) + aoff + m * 2048 + k * 1024); } while (0)
#define PG8_LDB(dst, b, h) do { _Pragma("unroll") for (int n = 0; n < 2; ++n) _Pragma("unroll") for (int k = 0; k < 2; ++k) dst[n][k] = *(const PG8_LAS bf16x8*)(lds + PG8_SB(b, h) + boff + n * 2048 + k * 1024); } while (0)
#define PG8_MMA(ai, bj, At, Bt) do { __builtin_amdgcn_s_setprio(1); _Pragma("unroll") for (int m = 0; m < 4; ++m) _Pragma("unroll") for (int n = 0; n < 2; ++n) { \
        if constexpr (F8) { const i32x4 _b0 = __builtin_bit_cast(i32x4, Bt[n][0]), _b1 = __builtin_bit_cast(i32x4, Bt[n][1]), _a0 = __builtin_bit_cast(i32x4, At[m][0]), _a1 = __builtin_bit_cast(i32x4, At[m][1]); \
            acc[ai][bj][m][n] = __builtin_amdgcn_mfma_scale_f32_16x16x128_f8f6f4(__builtin_shufflevector(_b0, _b1, 0, 1, 2, 3, 4, 5, 6, 7), __builtin_shufflevector(_a0, _a1, 0, 1, 2, 3, 4, 5, 6, 7), acc[ai][bj][m][n], 0, 0, 0, scB, 0, scA); } \
        else { _Pragma("unroll") for (int k = 0; k < 2; ++k) acc[ai][bj][m][n] = __builtin_amdgcn_mfma_f32_16x16x32_bf16(Bt[n][k], At[m][k], acc[ai][bj][m][n], 0, 0, 0); } } __builtin_amdgcn_s_setprio(0); } while (0)
#define PG8_WAIT_V(n) asm volatile("s_waitcnt vmcnt(" #n ")" ::: "memory")
#define PG8_WAIT_L(n) asm volatile("s_waitcnt lgkmcnt(" #n ")" ::: "memory")
#define PG8_BAR __builtin_amdgcn_s_barrier()
#define PG8_SCHED __builtin_amdgcn_sched_barrier(0)
#define PG8_GLOAD(ui_) do { const PG8_LAS int* _gl = S.glist(ui_); _Pragma("unroll") for (int _h = 0; _h < 2; ++_h) _Pragma("unroll") for (int _i = 0; _i < 2; ++_i) \
        gA[_h][_i] = ((unsigned)_gl[_h * 128 + gR[_i]] << (F8 ? 10 : 11)) + (unsigned)gC[_i]; } while (0)
    Unit cur, nxt; int ui = 0;
    if (!S.next(0, cur)) return;
    f32x4 acc[2][2][4][2];
#pragma unroll
    for (int a = 0; a < 2; ++a)
#pragma unroll
        for (int b = 0; b < 2; ++b)
#pragma unroll
            for (int m = 0; m < 4; ++m)
#pragma unroll
                for (int n = 0; n < 2; ++n) acc[a][b][m][n] = (f32x4){0.f, 0.f, 0.f, 0.f};
    bf16x8 At[4][2], B0[2][2], B1[2][2];
    const char* cA = S.a_base(cur); const char* cB = S.b_base(cur);
    if constexpr (GATHER) PG8_GLOAD(0);
    PG8_STAGE(PG8_SB(0, 0), cB, voffB); PG8_STAGE_A(PG8_SA(0, 0), cA, 0); PG8_STAGE(PG8_SB(0, 1), cB + hstepB, voffB); PG8_STAGE_A(PG8_SA(0, 1), cA, 1);
    if (wr == 1) PG8_BAR;
    PG8_WAIT_V(4); PG8_BAR;
    PG8_STAGE(PG8_SB(1, 0), cB + kstep, voffB); PG8_STAGE_A(PG8_SA(1, 0), cA + kstep, 0); PG8_STAGE(PG8_SB(1, 1), cB + hstepB + kstep, voffB);
    PG8_WAIT_V(6); PG8_BAR;
    for (;;) {
        const bool has_next = S.next(ui + 1, nxt);
        const char* nA = has_next ? S.a_base(nxt) : cA; const char* nB = has_next ? S.b_base(nxt) : cB;
#pragma unroll 1
        for (int t = 0; t < nt; t += 2) {
            const bool last = (t == nt - 2);
            const char* a1 = cA + (size_t)(t + 1) * kstep;
            const char* a2 = last ? nA : cA + (size_t)(t + 2) * kstep; const char* b2 = last ? nB : cB + (size_t)(t + 2) * kstep;
            const char* a3 = a2 + kstep; const char* b3 = b2 + kstep;
            PG8_LDB(B0, 0, 0); PG8_SCHED; PG8_LDA(At, 0, 0); PG8_STAGE_A(PG8_SA(1, 1), a1, 1);
            PG8_WAIT_L(8); PG8_BAR; PG8_WAIT_L(0); PG8_MMA(0, 0, At, B0); PG8_BAR; PG8_SCHED;
            if constexpr (GATHER) { if (last && has_next) PG8_GLOAD(ui + 1); }
            PG8_LDB(B1, 0, 1); PG8_STAGE(PG8_SB(0, 0), b2, voffB);
            PG8_BAR; PG8_WAIT_L(0); PG8_MMA(0, 1, At, B1); PG8_BAR;
            PG8_LDA(At, 0, 1); PG8_STAGE_A(PG8_SA(0, 0), a2, 0);
            PG8_BAR; PG8_WAIT_L(0); PG8_MMA(1, 0, At, B0); PG8_BAR; PG8_SCHED;
            PG8_STAGE(PG8_SB(0, 1), b2 + hstepB, voffB);
            PG8_WAIT_V(6); PG8_BAR; PG8_MMA(1, 1, At, B1); PG8_BAR;
            PG8_LDB(B0, 1, 0); PG8_SCHED; PG8_LDA(At, 1, 0); PG8_STAGE_A(PG8_SA(0, 1), a2, 1);
            PG8_WAIT_L(8); PG8_BAR; PG8_WAIT_L(0); PG8_MMA(0, 0, At, B0); PG8_BAR; PG8_SCHED;
            PG8_LDB(B1, 1, 1); PG8_STAGE(PG8_SB(1, 0), b3, voffB);
            PG8_BAR; PG8_WAIT_L(0); PG8_MMA(0, 1, At, B1); PG8_BAR;
            PG8_LDA(At, 1, 1); PG8_STAGE_A(PG8_SA(1, 0), a3, 0);
            PG8_BAR; PG8_WAIT_L(0); PG8_MMA(1, 0, At, B0); PG8_BAR; PG8_SCHED;
            PG8_STAGE(PG8_SB(1, 1), b3 + hstepB, voffB);
            PG8_WAIT_V(6); PG8_BAR; PG8_MMA(1, 1, At, B1); PG8_BAR;
        }
        { int fr_e = fr, fq_e = fq; asm volatile("" : "+v"(fr_e), "+v"(fq_e));
          E(acc, cur, wr, wc, fr_e, fq_e); }
        if (!has_next) break;
#pragma unroll
        for (int a = 0; a < 2; ++a)
#pragma unroll
            for (int b = 0; b < 2; ++b)
#pragma unroll
                for (int m = 0; m < 4; ++m)
#pragma unroll
                    for (int n = 0; n < 2; ++n) acc[a][b][m][n] = (f32x4){0.f, 0.f, 0.f, 0.f};
        cur = nxt; cA = nA; cB = nB; ++ui;
    }
    PG8_WAIT_V(0);
    if (wr == 0) PG8_BAR;
    PG8_BAR;
#undef PG8_SA
#undef PG8_SB
#undef PG8_STAGE
#undef PG8_STAGE_A
#undef PG8_LDA
#undef PG8_LDB
#undef PG8_MMA
#undef PG8_WAIT_V
#undef PG8_WAIT_L
#undef PG8_BAR
#undef PG8_SCHED
#undef PG8_GLOAD
}

struct PlainOrder {
    const char* A; const char* Bt; int lda, ldb, nM, nN, nwg, G, c;
    __device__ void init(const bf16_t* A_, int lda_, const bf16_t* Bt_, int ldb_, int nM_, int nN_) { A = (const char*)A_; Bt = (const char*)Bt_; lda = lda_; ldb = ldb_; nM = nM_; nN = nN_; nwg = nM * nN; G = gridDim.x; c = blockIdx.x; }
    __device__ __forceinline__ bool next(int i, Unit& u) const {
        const long L = (long)i * G + c; if (L >= nwg) return false;
        int wgid = (int)L; { const int q = nwg / NXCD, r = nwg % NXCD, xcd = wgid % NXCD, off = wgid / NXCD; wgid = (xcd < r ? xcd * (q + 1) : r * (q + 1) + (xcd - r) * q) + off; }
        const int nig = WGM * nN, gid = wgid / nig, fm = gid * WGM, gsz = (nM - fm) < WGM ? (nM - fm) : WGM;
        u.pm = fm + ((wgid % nig) % gsz); u.pn = (wgid % nig) / gsz; u.e = 0; u.nvalid = 256; u.slot0 = 0; return true;
    }
    __device__ __forceinline__ const char* a_base(const Unit& u) const { return A + (size_t)u.pm * 256 * lda * 2; }
    __device__ __forceinline__ const char* b_base(const Unit& u) const { return Bt + (size_t)u.pn * 256 * ldb * 2; }
    __device__ __forceinline__ const PG8_LAS int* glist(int) const { return nullptr; }
};
struct MoeOrder {
    const char* A; const char* W; const PG8_LAS int* tab; const PG8_LAS int* gl; int wrows, nunits;
    __device__ __forceinline__ bool next(int i, Unit& u) const {
        if (i >= nunits) return false;
        const PG8_LAS int* t = tab + i * 8;
        u.pm = t[0]; u.pn = t[1]; u.e = t[2]; u.nvalid = t[3]; u.slot0 = t[4]; return true;
    }
    __device__ __forceinline__ const char* a_base(const Unit& u) const { return A + (size_t)u.slot0 * 1024; }
    __device__ __forceinline__ const char* b_base(const Unit& u) const { return W + ((size_t)u.e * wrows + (size_t)u.pn * 256) * 1024; }
    __device__ __forceinline__ const PG8_LAS int* glist(int i) const { return gl + i * 256; }
};
constexpr int MOE_UNITS_MAX = 16;
__device__ __forceinline__ int moe_build_units(PG8_LAS int* tab, const int* cnt, const int* off, const int* toff, int nN) {
    const int G = gridDim.x, c = blockIdx.x, x = c & 7, j = c >> 3, per = (G >> 3) / nN, nMt = toff[32];
    const int i = threadIdx.x;
    if (i < MOE_UNITS_MAX) {
        const int pn = j % nN, mt = (i * 8 + x) * per + j / nN;
        int e = 0, valid = (mt < nMt && j < per * nN) ? 1 : 0;
        if (valid) { while (toff[e + 1] <= mt) ++e; }
        const int m = mt - toff[e];
        tab[i * 8 + 0] = mt; tab[i * 8 + 1] = pn; tab[i * 8 + 2] = e; tab[i * 8 + 3] = cnt[e] - m * 256; tab[i * 8 + 4] = off[e] + m * 256; tab[i * 8 + 5] = valid;
    }
    __syncthreads();
    int n = 0;
    while (n < MOE_UNITS_MAX && tab[n * 8 + 5]) ++n;
    return n;
}
struct MoeOrderG : MoeOrder { __device__ __forceinline__ const char* a_base(const Unit&) const { return A; } };

__device__ __forceinline__ u32x4 pk8(const f32x4& a, const f32x4& b) { return (u32x4){cvtpk(a[0], a[1]), cvtpk(a[2], a[3]), cvtpk(b[0], b[1]), cvtpk(b[2], b[3])}; }
struct EpiStore {
    static constexpr bool PERM = true;
    bf16_t* C; int ldc; const float* rs;
    __device__ __forceinline__ void operator()(const f32x4 (&acc)[2][2][4][2], const Unit& u, int wr, int wc, int fr, int fq) const {
        bf16_t* base = C + ((size_t)u.pm * 256 + wr * 64 + fr) * ldc + u.pn * 256 + wc * 32 + 8 * fq;
#pragma unroll
        for (int ai = 0; ai < 2; ++ai)
#pragma unroll
            for (int m = 0; m < 4; ++m) { bf16_t* rowp = base + (size_t)(ai * HALF + m * 16) * ldc; const float s = rs ? rs[ai * HALF + wr * 64 + m * 16 + fr] : 1.f;
#pragma unroll
                for (int bj = 0; bj < 2; ++bj) *(u32x4*)(rowp + bj * HALF) = pk8(acc[ai][bj][m][0] * s, acc[ai][bj][m][1] * s); }
    }
};
constexpr float ACT8_SCALE = 4.f;
struct EpiAct {
    static constexpr bool PERM = true;
    unsigned char* Act; const float* b1all;
    __device__ __forceinline__ void operator()(const f32x4 (&acc)[2][2][4][2], const Unit& u, int wr, int wc, int fr, int fq) const {
        const int f0 = u.pn * 128 + wc * 32 + 8 * fq;
        const float* bb = b1all + (size_t)u.e * 2048 + 2 * f0;
        f32x4 bv[4];
#pragma unroll
        for (int q = 0; q < 4; ++q) bv[q] = *(const f32x4*)(bb + 4 * q);
        unsigned char* base = Act + ((size_t)u.slot0 + wr * 64 + fr) * 1024 + f0;
#pragma unroll
        for (int ai = 0; ai < 2; ++ai)
#pragma unroll
            for (int m = 0; m < 4; ++m) {
                const int r = ai * HALF + wr * 64 + m * 16 + fr;
                float a[8];
#pragma unroll
                for (int n = 0; n < 2; ++n)
#pragma unroll
                    for (int j = 0; j < 4; ++j) { const int f = 4 * n + j;
                        float glu = acc[ai][0][m][n][j] + bv[f >> 1][(f & 1) * 2], lin = acc[ai][1][m][n][j] + bv[f >> 1][(f & 1) * 2 + 1];
                        glu = fminf(glu, 7.f); lin = fminf(fmaxf(lin, -7.f), 7.f);
                        a[f] = glu * __builtin_amdgcn_rcpf(1.f + __builtin_amdgcn_exp2f(-1.702f * LOG2E * glu)) * (lin * ACT8_SCALE + ACT8_SCALE); }
                if (r < u.nvalid) *(u32x2*)(base + (size_t)(ai * HALF + m * 16) * 1024) = (u32x2){pk4_fp8(a[0], a[1], a[2], a[3]), pk4_fp8(a[4], a[5], a[6], a[7])};
            }
    }
};
struct EpiBias {
    static constexpr bool PERM = true;
    bf16_t* Y; const float* b2all;
    __device__ __forceinline__ void operator()(const f32x4 (&acc)[2][2][4][2], const Unit& u, int wr, int wc, int fr, int fq) const {
        const int c0 = u.pn * 256 + wc * 32 + 8 * fq;
        const float* bb = b2all + (size_t)u.e * 1024 + c0;
        f32x4 bv[2][2];
#pragma unroll
        for (int bj = 0; bj < 2; ++bj)
#pragma unroll
            for (int n = 0; n < 2; ++n) bv[bj][n] = *(const f32x4*)(bb + bj * HALF + 4 * n);
        bf16_t* base = Y + ((size_t)u.slot0 + wr * 64 + fr) * 1024 + c0;
#pragma unroll
        for (int ai = 0; ai < 2; ++ai)
#pragma unroll
            for (int m = 0; m < 4; ++m) { const int r = ai * HALF + wr * 64 + m * 16 + fr;
                if (r < u.nvalid) {
#pragma unroll
                    for (int bj = 0; bj < 2; ++bj) *(u32x4*)(base + (size_t)(ai * HALF + m * 16) * 1024 + bj * HALF) = pk8(acc[ai][bj][m][0] + bv[bj][0], acc[ai][bj][m][1] + bv[bj][1]); } }
    }
};
}

__device__ __forceinline__ u32x4 pack8(const float (&v)[8]) { return (u32x4){cvtpk(v[0], v[1]), cvtpk(v[2], v[3]), cvtpk(v[4], v[5]), cvtpk(v[6], v[7])}; }
struct EpiPlain {
    static constexpr bool MOE1 = false;
    bf16_t* C; int ldc;
    __device__ __forceinline__ void row8(int r, int c, const float (&v)[8]) const { *(u32x4*)(C + (size_t)r * ldc + c) = pack8(v); }
    __device__ __forceinline__ void pair(int, int, const float (&)[8], const float (&)[8]) const {}
};
struct EpiRowScale {
    static constexpr bool MOE1 = false;
    bf16_t* C; int ldc; const float* rs;
    __device__ __forceinline__ void row8(int r, int c, const float (&v)[8]) const { const float s = rs[r]; float w[8];
#pragma unroll
        for (int i = 0; i < 8; ++i) w[i] = v[i] * s;
        *(u32x4*)(C + (size_t)r * ldc + c) = pack8(w); }
    __device__ __forceinline__ void pair(int, int, const float (&)[8], const float (&)[8]) const {}
};
__device__ __forceinline__ void phase_gemm_plain(const bf16_t* A, int lda, const bf16_t* Bt, int K, bf16_t* C, int ldc, int nM, int nN) {
    const int G = gridDim.x;
    for (int u = blockIdx.x; u < nM * nN; u += G) {
        const int pm = u / nN, pn = u % nN;
        int aoff[2][2], boff[2];
        gm::make_off(aoff, pm * 256, lda); gm::make_off1(boff, pn * 128, K);
        EpiPlain epi{C + (size_t)pm * 256 * ldc + pn * 128, ldc};
        gm::gemm_tile(A, aoff, Bt, boff, K / 64, epi);
    }
}

struct Row16 { float4 v[4]; };
__device__ __forceinline__ Row16 ld_row_f32(const float* p, int lane) { Row16 r;
#pragma unroll
    for (int i = 0; i < 4; ++i) r.v[i] = *(const float4*)(p + lane * 4 + 256 * i);
    return r; }
__device__ __forceinline__ Row16 ld_row_bf16(const bf16_t* p, int lane) { Row16 r;
#pragma unroll
    for (int i = 0; i < 4; ++i) { const u32x2 w = *(const u32x2*)(p + lane * 4 + 256 * i);
        r.v[i] = make_float4(__uint_as_float(w.x << 16), __uint_as_float(w.x & 0xFFFF0000u), __uint_as_float(w.y << 16), __uint_as_float(w.y & 0xFFFF0000u)); }
    return r; }
__device__ __forceinline__ void st_row_f32(float* p, int lane, const Row16& r) {
#pragma unroll
    for (int i = 0; i < 4; ++i) *(float4*)(p + lane * 4 + 256 * i) = r.v[i]; }
__device__ __forceinline__ void st_row_bf16(bf16_t* p, int lane, const Row16& r) {
#pragma unroll
    for (int i = 0; i < 4; ++i) { u32x2 w; w.x = cvtpk(r.v[i].x, r.v[i].y); w.y = cvtpk(r.v[i].z, r.v[i].w); *(u32x2*)(p + lane * 4 + 256 * i) = w; } }
__device__ __forceinline__ void st_row_fp8(unsigned char* p, int lane, const Row16& r) {
#pragma unroll
    for (int i = 0; i < 4; ++i) *(unsigned*)(p + lane * 4 + 256 * i) = pk4_fp8(r.v[i].x, r.v[i].y, r.v[i].z, r.v[i].w); }
__device__ __forceinline__ float row_rstd(const Row16& r) {
    float s = 0.f;
#pragma unroll
    for (int i = 0; i < 4; ++i) s += r.v[i].x * r.v[i].x + r.v[i].y * r.v[i].y + r.v[i].z * r.v[i].z + r.v[i].w * r.v[i].w;
    s = wave_sum(s);
    return rsqrtf(s * (1.f / 1024.f) + EPSN);
}
__device__ __forceinline__ Row16 norm_mod(const Row16& x, float rstd, const float* g, const float* sc, const float* sh, int lane) {
    Row16 h;
#pragma unroll
    for (int i = 0; i < 4; ++i) {
        const int c = lane * 4 + 256 * i;
        const float4 gv = *(const float4*)(g + c), scv = *(const float4*)(sc + c), shv = *(const float4*)(sh + c);
        h.v[i].x = x.v[i].x * rstd * gv.x * (1.f + scv.x) + shv.x; h.v[i].y = x.v[i].y * rstd * gv.y * (1.f + scv.y) + shv.y;
        h.v[i].z = x.v[i].z * rstd * gv.z * (1.f + scv.z) + shv.z; h.v[i].w = x.v[i].w * rstd * gv.w * (1.f + scv.w) + shv.w;
    }
    return h;
}
__device__ __forceinline__ Row16 resid_add(const Row16& x, const Row16& y, float rstd, const float* g, const float* gate, int lane) {
    Row16 o;
#pragma unroll
    for (int i = 0; i < 4; ++i) {
        const int c = lane * 4 + 256 * i;
        const float4 gv = *(const float4*)(g + c), ga = *(const float4*)(gate + c);
        o.v[i].x = x.v[i].x + y.v[i].x * rstd * gv.x * ga.x; o.v[i].y = x.v[i].y + y.v[i].y * rstd * gv.y * ga.y;
        o.v[i].z = x.v[i].z + y.v[i].z * rstd * gv.z * ga.z; o.v[i].w = x.v[i].w + y.v[i].w * rstd * gv.w * ga.w;
    }
    return o;
}
__device__ __forceinline__ const float* mod_ptr(PRef p, int l, int r) { return (const float*)(p.ws + WS_MOD) + (size_t)(l * 2 + (r < CTXN ? 1 : 0)) * 6144; }
__device__ __forceinline__ const float* src_row(PRef p, int r) { return r < CTXN ? p.ctx + (size_t)r * 1024 : p.x + (size_t)(r - CTXN) * 1024; }

struct ModAB { float4 a[4], b[4]; };
struct ModG { float4 g[4]; };
__device__ __forceinline__ ModAB load_ab(const float* g, const float* sc, const float* sh, int lane) { ModAB m;
#pragma unroll
    for (int i = 0; i < 4; ++i) { const int c = lane * 4 + 256 * i; const float4 gv = *(const float4*)(g + c), sv = *(const float4*)(sc + c); m.b[i] = *(const float4*)(sh + c);
        m.a[i] = make_float4(gv.x * (1.f + sv.x), gv.y * (1.f + sv.y), gv.z * (1.f + sv.z), gv.w * (1.f + sv.w)); }
    return m; }
__device__ __forceinline__ ModG load_g(const float* g, const float* gate, int lane) { ModG m;
#pragma unroll
    for (int i = 0; i < 4; ++i) { const int c = lane * 4 + 256 * i; const float4 gv = *(const float4*)(g + c), ga = *(const float4*)(gate + c); m.g[i] = make_float4(gv.x * ga.x, gv.y * ga.y, gv.z * ga.z, gv.w * ga.w); }
    return m; }
__device__ __forceinline__ Row16 apply_ab(const Row16& x, float rstd, const ModAB& m) { Row16 h;
#pragma unroll
    for (int i = 0; i < 4; ++i) h.v[i] = make_float4(x.v[i].x * rstd * m.a[i].x + m.b[i].x, x.v[i].y * rstd * m.a[i].y + m.b[i].y, x.v[i].z * rstd * m.a[i].z + m.b[i].z, x.v[i].w * rstd * m.a[i].w + m.b[i].w);
    return h; }
__device__ __forceinline__ Row16 apply_g(const Row16& x, const Row16& y, float rstd, const ModG& m) { Row16 o;
#pragma unroll
    for (int i = 0; i < 4; ++i) o.v[i] = make_float4(x.v[i].x + y.v[i].x * rstd * m.g[i].x, x.v[i].y + y.v[i].y * rstd * m.g[i].y, x.v[i].z + y.v[i].z * rstd * m.g[i].z, x.v[i].w + y.v[i].w * rstd * m.g[i].w);
    return o; }
struct RowB8 { u32x2 v[4]; };
__device__ __forceinline__ RowB8 ld_rowb(const bf16_t* p, int lane) { RowB8 r;
#pragma unroll
    for (int i = 0; i < 4; ++i) r.v[i] = *(const u32x2*)(p + lane * 4 + 256 * i);
    return r; }
__device__ __forceinline__ Row16 cvt_rowb(const RowB8& b) { Row16 r;
#pragma unroll
    for (int i = 0; i < 4; ++i) r.v[i] = make_float4(__uint_as_float(b.v[i].x << 16), __uint_as_float(b.v[i].x & 0xFFFF0000u), __uint_as_float(b.v[i].y << 16), __uint_as_float(b.v[i].y & 0xFFFF0000u));
    return r; }

__device__ __forceinline__ void phase_norm1_l0(PRef p) {
    const int lane = threadIdx.x & 63, wave = threadIdx.x >> 6, G = gridDim.x, step = G * 8;
    bf16_t* HB = (bf16_t*)(p.ws + WS_HB);
    int r = blockIdx.x * 8 + wave;
    if (r >= NTOK) return;
    int cur_s = (r < CTXN) ? 1 : 0;
    const float* mod = mod_ptr(p, 0, r);
    ModAB m = load_ab(p.norm_g, mod + 1024, mod, lane);
    Row16 x = ld_row_f32(src_row(p, r), lane);
    for (; r < NTOK; r += step) {
        const int rn = r + step;
        Row16 xn = x;
        if (rn < NTOK) xn = ld_row_f32(src_row(p, rn), lane);
        const int s_ = (r < CTXN) ? 1 : 0;
        if (s_ != cur_s) { cur_s = s_; const float* md = mod_ptr(p, 0, r); m = load_ab(p.norm_g, md + 1024, md, lane); }
        const float rstd = row_rstd(x);
        st_row_bf16(HB + (size_t)r * 1024, lane, apply_ab(x, rstd, m));
        x = xn;
    }
}

__device__ __forceinline__ void phase_mid(PRef p, int l) {
    const int tid = tid_opaque(), lane = tid & 63, wave = tid >> 6, G = gridDim.x;
    float* wT = (float*)smem;
    int* lcnt = (int*)(smem + 139264);
    int* lbase = lcnt + 32;
    int* sel = lbase + 32;
    {
        const float4* src = (const float4*)((const float*)(p.ws + WS_RWT) + (size_t)l * 32 * 1024);
        for (int i = tid; i < 32 * 1024 / 4; i += NTH) ((float4*)wT)[i] = src[i];
        if (tid < 32) lcnt[tid] = 0;
    }
    __syncthreads();
    const int r_begin = (l == 0) ? 0 : CTXN;
    bf16_t* HB = (bf16_t*)(p.ws + WS_HB); const bf16_t* OB = (const bf16_t*)(p.ws + WS_OB);
    float* X1 = (float*)(p.ws + WS_X1); const float* X2 = (const float*)(p.ws + WS_X2);
    const float* ng = p.norm_g + (size_t)l * 4 * 1024;
    const float* rb = p.router_b + l * 32;
    float* GATE = (float*)(p.ws + WS_GATE);
    int it = 0;
    int r = r_begin + blockIdx.x * 8 + wave;
    const int step = G * 8;
    int cur_s = -1; ModG mg; ModAB mab;
    Row16 xin; RowB8 ob;
    if (r < NTOK) { xin = (l == 0) ? ld_row_f32(src_row(p, r), lane) : ld_row_f32(X2 + (size_t)r * 1024, lane); ob = ld_rowb(OB + (size_t)r * 1024, lane); }
    for (; r < NTOK; r += step, ++it) {
        const int rn = r + step;
        Row16 xin_n = xin; RowB8 ob_n = ob;
        if (rn < NTOK) { xin_n = (l == 0) ? ld_row_f32(src_row(p, rn), lane) : ld_row_f32(X2 + (size_t)rn * 1024, lane); ob_n = ld_rowb(OB + (size_t)rn * 1024, lane); }
        const int s_ = (r < CTXN) ? 1 : 0;
        if (s_ != cur_s) { cur_s = s_; const float* mod = mod_ptr(p, l, r); mg = load_g(ng + 1024, mod + 2048, lane); mab = load_ab(ng + 2048, mod + 4096, mod + 3072, lane); }
        const Row16 o = cvt_rowb(ob);
        const float rso = row_rstd(o);
        const Row16 x1 = apply_g(xin, o, rso, mg);
        st_row_f32(X1 + (size_t)r * 1024, lane, x1);
        const float rs1 = row_rstd(x1);
        const Row16 h = apply_ab(x1, rs1, mab);
        xin = xin_n; ob = ob_n;
        float part[32];
        {
            const float* wl = wT + lane * 4;
            float4 wa[4], wb[4];
#pragma unroll
            for (int i = 0; i < 4; ++i) wa[i] = *(const float4*)(wl + 256 * i);
#pragma unroll
            for (int e = 0; e < 32; e += 2) {
#pragma unroll
                for (int i = 0; i < 4; ++i) wb[i] = *(const float4*)(wl + (e + 1) * 1024 + 256 * i);
                { float a = 0.f;
#pragma unroll
                  for (int i = 0; i < 4; ++i) a += h.v[i].x * wa[i].x + h.v[i].y * wa[i].y + h.v[i].z * wa[i].z + h.v[i].w * wa[i].w;
                  part[e] = a; }
                if (e + 2 < 32) {
#pragma unroll
                    for (int i = 0; i < 4; ++i) wa[i] = *(const float4*)(wl + (e + 2) * 1024 + 256 * i);
                }
                { float a = 0.f;
#pragma unroll
                  for (int i = 0; i < 4; ++i) a += h.v[i].x * wb[i].x + h.v[i].y * wb[i].y + h.v[i].z * wb[i].z + h.v[i].w * wb[i].w;
                  part[e + 1] = a; }
            }
        }
        st_row_fp8((unsigned char*)HB + (size_t)r * 1024, lane, h);
#define TR_STEP(NV, BIT) _Pragma("unroll") for (int i = 0; i < (NV) / 2; ++i) { const float lo = part[i], hi_ = part[i + (NV) / 2]; const bool up = (lane & (BIT)) != 0; \
            const float send = up ? lo : hi_, keep = up ? hi_ : lo; part[i] = keep + __shfl_xor(send, (BIT)); }
        TR_STEP(32, 32) TR_STEP(16, 16) TR_STEP(8, 8) TR_STEP(4, 4) TR_STEP(2, 2)
#undef TR_STEP
        float logit = part[0] + __shfl_xor(part[0], 1);
        const int myexp = lane >> 1;
        logit += rb[myexp];
        float val = (lane & 1) ? -3.0e38f : logit;
        float tv[4]; int ti[4];
#pragma unroll
        for (int k = 0; k < 4; ++k) {
            float bv = val; int bi = myexp;
#pragma unroll
            for (int off = 32; off >= 1; off >>= 1) { const float ov = __shfl_xor(bv, off); const int oi = __shfl_xor(bi, off); if (ov > bv || (ov == bv && oi < bi)) { bv = ov; bi = oi; } }
            tv[k] = bv; ti[k] = bi;
            if (myexp == bi) val = -3.0e38f;
        }
        const float e1 = __expf(tv[1] - tv[0]), e2 = __expf(tv[2] - tv[0]), e3 = __expf(tv[3] - tv[0]);
        const float inv = 1.f / (1.f + e1 + e2 + e3);
        if (lane < 4) {
            const int k = lane;
            const int e = (k == 0) ? ti[0] : (k == 1) ? ti[1] : (k == 2) ? ti[2] : ti[3];
            const float gk = ((k == 0) ? 1.f : (k == 1) ? e1 : (k == 2) ? e2 : e3) * inv;
            GATE[(size_t)r * 4 + k] = gk;
            const int lp = atomicAdd(&lcnt[e], 1);
            sel[(it * 8 + wave) * 4 + k] = e | (lp << 8);
        }
    }
    __syncthreads();
    int* CNT = (int*)(p.ws + WS_CNT) + l * 32;
    if (tid < 32) lbase[tid] = atomicAdd(&CNT[tid], lcnt[tid]);
    __syncthreads();
    {
        int* TOPE = (int*)(p.ws + WS_TOPE); int* TOPP = (int*)(p.ws + WS_TOPP); int* LIST = (int*)(p.ws + WS_LIST);
        for (int q = tid; q < 80 * 4; q += NTH) {
            const int slot = q >> 2, k = q & 3, itq = slot >> 3, wv = slot & 7;
            const int r = r_begin + blockIdx.x * 8 + wv + itq * G * 8;
            if (r < NTOK) {
                const int s = sel[q], e = s & 255, lp = s >> 8, pos = lbase[e] + lp;
                TOPE[(size_t)r * 4 + k] = e; TOPP[(size_t)r * 4 + k] = pos; LIST[(size_t)e * NTOK + pos] = r;
            }
        }
    }
    __syncthreads();
}

struct MoeLds { int* cnt; int* off; int* toff; };
__device__ __forceinline__ MoeLds moe_setup(PRef p, int l, char* base) {
    MoeLds m; m.cnt = (int*)base; m.off = m.cnt + 32; m.toff = m.off + 33;
    const int tid = tid_opaque();
    if (tid < 64) {
        const int e = tid & 31;
        const int cval = ((const int*)(p.ws + WS_CNT))[l * 32 + e];
        const int tiles = (cval + 255) >> 8;
        int pc = cval, pt = tiles;
#pragma unroll
        for (int o = 1; o < 32; o <<= 1) { const int a = __shfl_up(pc, o, 32), b = __shfl_up(pt, o, 32); if (e >= o) { pc += a; pt += b; } }
        if (tid < 32) { m.cnt[e] = cval; m.off[e + 1] = pc; m.toff[e + 1] = pt; if (e == 0) { m.off[0] = 0; m.toff[0] = 0; } }
    }
    __syncthreads();
    return m;
}

__device__ __forceinline__ void phase_end(PRef p, int l) {
    const int tid = tid_opaque(), lane = tid & 63, wave = tid >> 6, G = gridDim.x;
    MoeLds ml = moe_setup(p, l, smem);
    const int r_begin = (l == 0) ? 0 : CTXN;
    const bf16_t* YB = (const bf16_t*)(p.ws + WS_YB);
    const float* X1 = (const float*)(p.ws + WS_X1); float* X2 = (float*)(p.ws + WS_X2);
    bf16_t* HB = (bf16_t*)(p.ws + WS_HB);
    const int* TOPE = (const int*)(p.ws + WS_TOPE); const int* TOPP = (const int*)(p.ws + WS_TOPP); const float* GATE = (const float*)(p.ws + WS_GATE);
    const float* ng = p.norm_g + (size_t)l * 4 * 1024;
    int cur_s = -1; ModG mg; ModAB mab;
    int r = r_begin + blockIdx.x * 8 + wave;
    int4 en = make_int4(0, 0, 0, 0), pn = make_int4(0, 0, 0, 0); float4 gn = make_float4(0.f, 0.f, 0.f, 0.f);
    const int step = G * 8;
    if (r < NTOK) { en = *(const int4*)(TOPE + (size_t)r * 4); pn = *(const int4*)(TOPP + (size_t)r * 4); gn = *(const float4*)(GATE + (size_t)r * 4); }
    RowB8 t4n[4]; Row16 x1n; float4 gcur = gn;
    if (r < NTOK) {
        t4n[0] = ld_rowb(YB + (size_t)(ml.off[en.x] + pn.x) * 1024, lane); t4n[1] = ld_rowb(YB + (size_t)(ml.off[en.y] + pn.y) * 1024, lane);
        t4n[2] = ld_rowb(YB + (size_t)(ml.off[en.z] + pn.z) * 1024, lane); t4n[3] = ld_rowb(YB + (size_t)(ml.off[en.w] + pn.w) * 1024, lane);
        x1n = ld_row_f32(X1 + (size_t)r * 1024, lane);
        if (r + step < NTOK) { en = *(const int4*)(TOPE + (size_t)(r + step) * 4); pn = *(const int4*)(TOPP + (size_t)(r + step) * 4); gn = *(const float4*)(GATE + (size_t)(r + step) * 4); }
    }
    for (; r < NTOK; r += step) {
        RowB8 t4[4]; t4[0] = t4n[0]; t4[1] = t4n[1]; t4[2] = t4n[2]; t4[3] = t4n[3];
        const Row16 x1 = x1n;
        const float g4[4] = {gcur.x, gcur.y, gcur.z, gcur.w};
        const int rn = r + step;
        if (rn < NTOK) {
            t4n[0] = ld_rowb(YB + (size_t)(ml.off[en.x] + pn.x) * 1024, lane); t4n[1] = ld_rowb(YB + (size_t)(ml.off[en.y] + pn.y) * 1024, lane);
            t4n[2] = ld_rowb(YB + (size_t)(ml.off[en.z] + pn.z) * 1024, lane); t4n[3] = ld_rowb(YB + (size_t)(ml.off[en.w] + pn.w) * 1024, lane);
            x1n = ld_row_f32(X1 + (size_t)rn * 1024, lane);
            gcur = gn;
            if (rn + step < NTOK) { en = *(const int4*)(TOPE + (size_t)(rn + step) * 4); pn = *(const int4*)(TOPP + (size_t)(rn + step) * 4); gn = *(const float4*)(GATE + (size_t)(rn + step) * 4); }
        }
        const int s_ = (r < CTXN) ? 1 : 0;
        if (s_ != cur_s) { cur_s = s_; const float* mod = mod_ptr(p, l, r); mg = load_g(ng + 3072, mod + 5120, lane);
            if (l == 0) { const float* mod1 = mod_ptr(p, 1, r); mab = load_ab(p.norm_g + (size_t)4 * 1024, mod1 + 1024, mod1, lane); } }
        Row16 y;
#pragma unroll
        for (int i = 0; i < 4; ++i) y.v[i] = make_float4(0.f, 0.f, 0.f, 0.f);
#pragma unroll
        for (int k = 0; k < 4; ++k) { const Row16 t = cvt_rowb(t4[k]); const float gk = g4[k];
#pragma unroll
            for (int i = 0; i < 4; ++i) { y.v[i].x += gk * t.v[i].x; y.v[i].y += gk * t.v[i].y; y.v[i].z += gk * t.v[i].z; y.v[i].w += gk * t.v[i].w; } }
        const float rsy = row_rstd(y);
        const Row16 x2 = apply_g(x1, y, rsy, mg);
        if (l == 0) {
            st_row_f32(X2 + (size_t)r * 1024, lane, x2);
            const float rs2 = row_rstd(x2);
            st_row_bf16(HB + (size_t)r * 1024, lane, apply_ab(x2, rs2, mab));
        } else {
            st_row_f32(p.out + (size_t)(r - CTXN) * 1024, lane, x2);
        }
    }
    __syncthreads();
}

__device__ __forceinline__ void phase_gemm_pg8(const bf16_t* A, int lda, const bf16_t* Bt, int K, bf16_t* C, int ldc, int nM, int nN) {
    pg8::PlainOrder S; S.init(A, lda, Bt, K, nM, nN);
    pg8::EpiStore E{C, ldc, nullptr};
    pg8::gemm_phase<pg8::EpiStore, pg8::PlainOrder, false>((PG8_LAS unsigned char*)smem, S, E, K, lda, K);
    __syncthreads();
}
constexpr int MOE_GL_OFF = 131072, MOE_ML_OFF = 143360, MOE_TAB_OFF = 143872, MOE_GL_MAX = 12;
__device__ __forceinline__ void phase_moe1(PRef p, int l) {
    MoeLds ml = moe_setup(p, l, smem + MOE_ML_OFF);
    const int tid = tid_opaque();
    PG8_LAS int* gl = (PG8_LAS int*)(smem + MOE_GL_OFF);
    PG8_LAS int* tab = (PG8_LAS int*)(smem + MOE_TAB_OFF);
    pg8::MoeOrderG S;
    S.A = (const char*)(p.ws + WS_HB); S.W = (const char*)(p.ws + WS_W1T) + (size_t)l * 32 * 2048 * 1024;
    S.tab = tab; S.gl = gl; S.wrows = 2048;
    S.nunits = pg8::moe_build_units(tab, ml.cnt, ml.off, ml.toff, 8);
    if (S.nunits > MOE_GL_MAX) S.nunits = MOE_GL_MAX;
    const int* LIST = (const int*)(p.ws + WS_LIST);
    for (int i = 0; i < S.nunits; ++i) {
        const int e = tab[i * 8 + 2], mt = tab[i * 8 + 0], nvalid = tab[i * 8 + 3], m = mt - ml.toff[e];
        if (tid < 256) gl[i * 256 + tid] = (tid < nvalid) ? LIST[(size_t)e * NTOK + m * 256 + tid] : 0;
    }
    __syncthreads();
    pg8::EpiAct E{(unsigned char*)(p.ws + WS_ACT), p.moe_b1 + (size_t)l * 32 * 2048};
    pg8::gemm_phase<pg8::EpiAct, pg8::MoeOrderG, true, true>((PG8_LAS unsigned char*)smem, S, E, 512, 512, 512, 0x7F7F7F7F, 0x79797979);
    __syncthreads();
}
__device__ __forceinline__ void phase_moe2(PRef p, int l) {
    MoeLds ml = moe_setup(p, l, smem + MOE_ML_OFF);
    PG8_LAS int* tab = (PG8_LAS int*)(smem + MOE_TAB_OFF);
    PG8_LAS int* gl = (PG8_LAS int*)(smem + MOE_GL_OFF);
    pg8::MoeOrderG S;
    S.A = (const char*)(p.ws + WS_ACT); S.W = (const char*)(p.ws + WS_W2T) + (size_t)l * 32 * 1024 * 1024;
    S.tab = tab; S.gl = gl; S.wrows = 1024;
    S.nunits = pg8::moe_build_units(tab, ml.cnt, ml.off, ml.toff, 4);
    if (S.nunits > MOE_GL_MAX) S.nunits = MOE_GL_MAX;
    { const int tid = tid_opaque();
      for (int i = 0; i < S.nunits; ++i) if (tid < 256) gl[i * 256 + tid] = tab[i * 8 + 4] + tid;
      __syncthreads(); }
    pg8::EpiBias E{(bf16_t*)(p.ws + WS_YB), p.moe_b2 + (size_t)l * 32 * 1024};
    pg8::gemm_phase<pg8::EpiBias, pg8::MoeOrderG, true, true>((PG8_LAS unsigned char*)smem, S, E, 512, 512, 512, 0x7D7D7D7D, 0x79797979);
    __syncthreads();
}

__device__ __forceinline__ void gla_local_units(PRef p);
__device__ __forceinline__ void rope8(const float* rope, int t, int j0, const u32x4& a, const u32x4& b, u32x4& oa, u32x4& ob);
__device__ __forceinline__ void rowstat(const bf16_t* A, int lda, int K, float* rs) {
    const int tid = tid_opaque(), r = tid >> 1, hf = tid & 1, half = K / 2;
    const bf16_t* q = A + (size_t)r * lda + hf * half;
    float s = 0.f;
    for (int i = 0; i < half; i += 8) { const u32x4 w = *(const u32x4*)(q + i);
#pragma unroll
        for (int j = 0; j < 4; ++j) { const float a = __uint_as_float(w[j] << 16), b = __uint_as_float(w[j] & 0xFFFF0000u); s += a * a + b * b; } }
    s += __shfl_xor(s, 1);
    if (hf == 0) rs[r] = rsqrtf(s / (float)K + EPSN);
    __syncthreads();
}
__device__ __forceinline__ void phase_mla_up(PRef p) {
    const int G = gridDim.x, tid = threadIdx.x;
    const bf16_t* P = (const bf16_t*)(p.ws + WS_P);
    float* rs = (float*)(smem + 139264);
    const int nM = NTOK / 256;
    {
        pg8::PlainOrder S; S.init(P + PC_CQ, PW, (const bf16_t*)(p.ws + WS_WUQ), 256, nM, 3);
        pg8::Unit u;
        if (S.next(0, u)) rowstat(P + (size_t)u.pm * 256 * PW + PC_CQ, PW, 256, rs);
        pg8::EpiStore E{(bf16_t*)(p.ws + WS_QM), 768, rs};
        pg8::gemm_phase<pg8::EpiStore, pg8::PlainOrder, false>((PG8_LAS unsigned char*)smem, S, E, 256, PW, 256);
        __syncthreads();
    }
    for (int v = (blockIdx.x + G - 195) % G; v < nM * 8; v += G) {
        int aoff[2][2], boff[2];
        const int pm = v >> 3, pn = v & 7, h = pn >> 1;
        rowstat(P + (size_t)pm * 256 * PW + PC_CKV, PW, 128, rs);
        gm::make_off(aoff, pm * 256, PW); gm::make_off1(boff, pn * 128, 128);
        bf16_t* dst = (pn & 1) ? (bf16_t*)(p.ws + WS_VM) + (size_t)pm * 256 * 512 + h * 128 : (bf16_t*)(p.ws + WS_KM) + (size_t)pm * 256 * 768 + h * 192;
        EpiRowScale epi{dst, (pn & 1) ? 512 : 768, rs};
        gm::gemm_tile(P + PC_CKV, aoff, (const bf16_t*)(p.ws + WS_WUKV), boff, 2, epi);
    }
    const float* rope = (const float*)(p.ws + WS_ROPE);
    bf16_t* KM = (bf16_t*)(p.ws + WS_KM);
    for (int i = blockIdx.x * NTH + tid; i < NTOK * 4; i += G * NTH) {
        const int r = i >> 2, j0 = (i & 3) * 8;
        const u32x4 a = *(const u32x4*)(P + (size_t)r * PW + PC_KR + j0), b = *(const u32x4*)(P + (size_t)r * PW + PC_KR + 32 + j0);
        u32x4 oa = a, ob = b;
        if (r >= CTXN) rope8(rope, r - CTXN, j0, a, b, oa, ob);
#pragma unroll
        for (int h = 0; h < 4; ++h) { *(u32x4*)(KM + (size_t)r * 768 + h * 192 + 128 + j0) = oa; *(u32x4*)(KM + (size_t)r * 768 + h * 192 + 160 + j0) = ob; }
    }
    __syncthreads();
    gla_local_units(p);
}

struct GlaB { float b[16]; float total; };
__device__ __forceinline__ GlaB gla_decay(PRef p, int gc, int h, float* scr  ) {
    const int tid = threadIdx.x, lane = tid & 63, wave = tid >> 6, dir = wave & 1, tq = wave >> 1;
    const bf16_t* P = (const bf16_t*)(p.ws + WS_P);
    float* af = scr;
    float* wa = scr + 2048;
    float* ba = scr + 4096;
    float* tot = scr + 4224;
#pragma unroll
    for (int i = 0; i < 4; ++i) {
        const int idx = tid + 512 * i, dd = idx >> 10, t = (idx >> 4) & 63, j = idx & 15;
        af[idx] = bf2f(P[(size_t)(gc * 64 + t) * PW + PC_AF + dd * 16 + j]);
        const int jj = (idx >> 6) & 15, d = idx & 63;
        wa[idx] = (dd == 0 ? p.gla_wa_f : p.gla_wa_b)[jj * 256 + h * 64 + d];
    }
    if (tid < 128) ba[tid] = ((tid >> 6) == 0 ? p.gla_ba_f : p.gla_ba_b)[h * 64 + (tid & 63)];
    __syncthreads();
    float w[16];
#pragma unroll
    for (int j = 0; j < 16; ++j) w[j] = wa[(dir * 16 + j) * 64 + lane];
    const float bias = ba[dir * 64 + lane];
    GlaB r;
#pragma unroll
    for (int i = 0; i < 16; ++i) {
        const int t = tq * 16 + i;
        float z = bias;
#pragma unroll
        for (int j = 0; j < 16; ++j) z += af[(dir * 64 + t) * 16 + j] * w[j];
        const float g = (fminf(z, 0.f) - __logf(1.f + __expf(-fabsf(z)))) * (1.f / 16.f);
        r.b[i] = g;
    }
    if (dir == 0) {
#pragma unroll
        for (int i = 1; i < 16; ++i) r.b[i] += r.b[i - 1];
        tot[(dir * 4 + tq) * 64 + lane] = r.b[15];
    } else {
#pragma unroll
        for (int i = 14; i >= 0; --i) r.b[i] += r.b[i + 1];
        tot[(dir * 4 + tq) * 64 + lane] = r.b[0];
    }
    __syncthreads();
    float offs = 0.f, total = 0.f;
#pragma unroll
    for (int q = 0; q < 4; ++q) { const float tv = tot[(dir * 4 + q) * 64 + lane]; total += tv; if (dir == 0 ? (q < tq) : (q > tq)) offs += tv; }
#pragma unroll
    for (int i = 0; i < 16; ++i) r.b[i] += offs;
    r.total = total;
    return r;
}

__device__ __forceinline__ void gla_stage_vt(const bf16_t* P, int gc, int h, bf16_t* VT) {
    const int tid = threadIdx.x, v = tid & 127, sq = tid >> 7;
    unsigned pk[8];
#pragma unroll
    for (int i = 0; i < 8; ++i) {
        const bf16_t a = P[(size_t)(gc * 64 + sq * 16 + 2 * i) * PW + PC_V + h * 128 + v], b = P[(size_t)(gc * 64 + sq * 16 + 2 * i + 1) * PW + PC_V + h * 128 + v];
        pk[i] = a | ((unsigned)b << 16);
    }
    *(u32x4*)(VT + v * 72 + sq * 16) = (u32x4){pk[0], pk[1], pk[2], pk[3]};
    *(u32x4*)(VT + v * 72 + sq * 16 + 8) = (u32x4){pk[4], pk[5], pk[6], pk[7]};
}

struct GlaPreL { u32x4 kc, vc[2], ac; float4 wac; float bac; };
__device__ __forceinline__ void gla_prefetch_local(PRef p, int gc, int h, GlaPreL& g) {
    const int tid = threadIdx.x;
    const bf16_t* P = (const bf16_t*)(p.ws + WS_P);
    g.kc = *(const u32x4*)(P + (size_t)(gc * 64 + (tid >> 3)) * PW + PC_K + h * 64 + (tid & 7) * 8);
#pragma unroll
    for (int i = 0; i < 2; ++i) { const int idx = tid + 512 * i; g.vc[i] = *(const u32x4*)(P + (size_t)(gc * 64 + (idx >> 4)) * PW + PC_V + h * 128 + (idx & 15) * 8); }
    g.ac = *(const u32x4*)(P + (size_t)(gc * 64 + ((tid & 255) >> 2)) * PW + PC_AF + (tid & 3) * 8);
    { const int dd = tid >> 8, jj = (tid >> 4) & 15, d4 = tid & 15; g.wac = *(const float4*)((dd == 0 ? p.gla_wa_f : p.gla_wa_b) + jj * 256 + h * 64 + d4 * 4); }
    g.bac = ((tid >> 6) & 1 ? p.gla_ba_b : p.gla_ba_f)[h * 64 + (tid & 63)];
}
template <int OFF> __device__ __forceinline__ s16x4 glal_tr(int vb) { s16x4 r; asm volatile("ds_read_b64_tr_b16 %0, %1 offset:%2" : "=&v"(r) : "v"(vb), "i"(OFF) : "memory"); return r; }
__device__ __forceinline__ void gla_local_units(PRef p) {
    const int tid = threadIdx.x, lane = tid & 63, wave = tid >> 6, r32 = lane & 31, hi = lane >> 5, G = gridDim.x;
    bf16_t* kdT = (bf16_t*)smem;
    bf16_t* Kraw = kdT + 2 * 64 * 72;
    char* Vraw = smem + 27648;
    float* af = (float*)(smem + 49152);
    float* wa = af + 2048; float* ba = wa + 2048; float* tot = ba + 128;
    bf16_t* U = (bf16_t*)(p.ws + WS_U); float* DEC = (float*)(p.ws + WS_DEC);
    int u = blockIdx.x;
    if (u >= NCH * 4) return;
    GlaPreL g;
    gla_prefetch_local(p, u >> 2, u & 3, g);
    const int dir = wave & 1, tq = wave >> 1;
    for (; u < NCH * 4; u += G) {
        const int gc = u >> 2, h = u & 3;
        *(u32x4*)(Kraw + (tid >> 3) * 72 + (tid & 7) * 8) = g.kc;
#pragma unroll
        for (int i = 0; i < 2; ++i) { const int idx = tid + 512 * i; *(u32x4*)(Vraw + (idx >> 4) * 320 + (idx & 15) * 16) = g.vc[i]; }
        if (tid < 256) { const int t = tid >> 2, ch = tid & 3, dd = ch >> 1, j0 = (ch & 1) * 8; float* q = af + dd * 1024 + t * 16 + j0;
#pragma unroll
            for (int e = 0; e < 4; ++e) { q[2 * e] = __uint_as_float(g.ac[e] << 16); q[2 * e + 1] = __uint_as_float(g.ac[e] & 0xFFFF0000u); } }
        { const int dd = tid >> 8, jj = (tid >> 4) & 15, d4 = tid & 15; *(float4*)(wa + (dd * 16 + jj) * 64 + d4 * 4) = g.wac; }
        if (tid < 128) ba[tid] = g.bac;
        __syncthreads();
        const int un = u + G;
        if (un < NCH * 4) gla_prefetch_local(p, un >> 2, un & 3, g);
        float bb[16]; float total = 0.f;
        {
            float w[16];
#pragma unroll
            for (int j = 0; j < 16; ++j) w[j] = wa[(dir * 16 + j) * 64 + lane];
            const float bias = ba[dir * 64 + lane];
#pragma unroll
            for (int i = 0; i < 16; ++i) {
                const int t = tq * 16 + i;
                float z = bias;
#pragma unroll
                for (int j = 0; j < 16; ++j) z += af[(dir * 64 + t) * 16 + j] * w[j];
                bb[i] = (fminf(z, 0.f) - __logf(1.f + __expf(-fabsf(z)))) * (1.f / 16.f);
            }
            if (dir == 0) {
#pragma unroll
                for (int i = 1; i < 16; ++i) bb[i] += bb[i - 1];
                tot[(dir * 4 + tq) * 64 + lane] = bb[15];
            } else {
#pragma unroll
                for (int i = 14; i >= 0; --i) bb[i] += bb[i + 1];
                tot[(dir * 4 + tq) * 64 + lane] = bb[0];
            }
        }
        __syncthreads();
        {
            float offs = 0.f;
#pragma unroll
            for (int q = 0; q < 4; ++q) { const float tv = tot[(dir * 4 + q) * 64 + lane]; total += tv; if (dir == 0 ? (q < tq) : (q > tq)) offs += tv; }
#pragma unroll
            for (int i = 0; i < 16; ++i) bb[i] += offs;
        }
        {
            unsigned pk[8];
#pragma unroll
            for (int i = 0; i < 8; ++i) {
                const int s0 = tq * 16 + 2 * i;
                const float k0 = bf2f(Kraw[s0 * 72 + lane]), k1 = bf2f(Kraw[(s0 + 1) * 72 + lane]);
                pk[i] = cvtpk(k0 * __expf(total - bb[2 * i]), k1 * __expf(total - bb[2 * i + 1]));
            }
            *(u32x4*)(kdT + (dir * 64 + lane) * 72 + tq * 16) = (u32x4){pk[0], pk[1], pk[2], pk[3]};
            *(u32x4*)(kdT + (dir * 64 + lane) * 72 + tq * 16 + 8) = (u32x4){pk[4], pk[5], pk[6], pk[7]};
            if (tq == 0) DEC[((size_t)(dir * NCH + gc) * 4 + h) * 64 + lane] = __expf(total);
        }
        __syncthreads();
        {
            const int mdir = wave >> 2, vbk = wave & 3;
            const int vb = (int)(uintptr_t)Vraw + (8 * hi + ((lane & 15) >> 2)) * 320 + (vbk * 32 + 16 * ((lane >> 4) & 1) + 4 * (lane & 3)) * 2;
            f32x16 a0 = {}, a1 = {};
#define GLAL_STEP(KS) do { const s16x4 l_ = glal_tr<(KS) * 5120>(vb), h_ = glal_tr<(KS) * 5120 + 1280>(vb); \
            const bf16x8 b0 = *(const bf16x8*)(kdT + (mdir * 64 + r32) * 72 + (KS) * 16 + hi * 8); \
            const bf16x8 b1 = *(const bf16x8*)(kdT + (mdir * 64 + 32 + r32) * 72 + (KS) * 16 + hi * 8); \
            asm volatile("s_waitcnt lgkmcnt(0)" ::: "memory"); SBAR(); \
            const bf16x8 a_ = (bf16x8){l_[0], l_[1], l_[2], l_[3], h_[0], h_[1], h_[2], h_[3]}; \
            a0 = __builtin_amdgcn_mfma_f32_32x32x16_bf16(a_, b0, a0, 0, 0, 0); a1 = __builtin_amdgcn_mfma_f32_32x32x16_bf16(a_, b1, a1, 0, 0, 0); } while (0)
            GLAL_STEP(0); GLAL_STEP(1); GLAL_STEP(2); GLAL_STEP(3);
#undef GLAL_STEP
            bf16_t* Uo = U + ((size_t)(mdir * NCH + gc) * 4 + h) * 8192;
#pragma unroll
            for (int r = 0; r < 16; ++r) { const int v = vbk * 32 + crow(r, hi); Uo[v * 64 + r32] = f2bf(a0[r]); Uo[v * 64 + 32 + r32] = f2bf(a1[r]); }
        }
        __syncthreads();
    }
}
__device__ __forceinline__ void rope8(const float* rope, int t, int j0, const u32x4& a, const u32x4& b, u32x4& oa, u32x4& ob) {
    const int row = t >> 6, col = t & 63;
    const float* cs = (j0 < 16) ? rope + row * 16 + j0 : rope + 512 * 16 + col * 16 + (j0 - 16);
    const float* sn = (j0 < 16) ? rope + 256 * 16 + row * 16 + j0 : rope + 512 * 16 + 64 * 16 + col * 16 + (j0 - 16);
    const f32x4 c0 = *(const f32x4*)cs, c1 = *(const f32x4*)(cs + 4), s0 = *(const f32x4*)sn, s1 = *(const f32x4*)(sn + 4);
#pragma unroll
    for (int e = 0; e < 4; ++e) {
        const float x1l = __uint_as_float(a[e] << 16), x1h = __uint_as_float(a[e] & 0xFFFF0000u), x2l = __uint_as_float(b[e] << 16), x2h = __uint_as_float(b[e] & 0xFFFF0000u);
        const float cl = (e < 2) ? c0[2 * e] : c1[2 * e - 4], ch = (e < 2) ? c0[2 * e + 1] : c1[2 * e - 3], sl = (e < 2) ? s0[2 * e] : s1[2 * e - 4], sh = (e < 2) ? s0[2 * e + 1] : s1[2 * e - 3];
        oa[e] = cvtpk(x1l * cl - x2l * sl, x1h * ch - x2h * sh);
        ob[e] = cvtpk(x1l * sl + x2l * cl, x1h * sh + x2h * ch);
    }
}
__device__ __forceinline__ u32x4 cvt16_fp8(const u32x4& a, const u32x4& b) {
    u32x4 o;
#pragma unroll
    for (int j = 0; j < 2; ++j) {
        o[j] = pk4_fp8(__uint_as_float(a[2 * j] << 16), __uint_as_float(a[2 * j] & 0xFFFF0000u), __uint_as_float(a[2 * j + 1] << 16), __uint_as_float(a[2 * j + 1] & 0xFFFF0000u));
        o[2 + j] = pk4_fp8(__uint_as_float(b[2 * j] << 16), __uint_as_float(b[2 * j] & 0xFFFF0000u), __uint_as_float(b[2 * j + 1] << 16), __uint_as_float(b[2 * j + 1] & 0xFFFF0000u));
    }
    return o;
}
__device__ __forceinline__ u32x2 cvt8_fp8(const u32x4& a) { return (u32x2){pk4_fp8(__uint_as_float(a[0] << 16), __uint_as_float(a[0] & 0xFFFF0000u), __uint_as_float(a[1] << 16), __uint_as_float(a[1] & 0xFFFF0000u)),
                                                                       pk4_fp8(__uint_as_float(a[2] << 16), __uint_as_float(a[2] & 0xFFFF0000u), __uint_as_float(a[3] << 16), __uint_as_float(a[3] & 0xFFFF0000u))}; }
__device__ __forceinline__ void mla_pack_pass(PRef p, int b0, int nb) {
    const int tid = threadIdx.x, gt = (blockIdx.x - b0) * NTH + tid, gn = nb * NTH;
    const float* rope = (const float*)(p.ws + WS_ROPE);
    const bf16_t* QM = (const bf16_t*)(p.ws + WS_QM); const bf16_t* KM = (const bf16_t*)(p.ws + WS_KM); const bf16_t* VM = (const bf16_t*)(p.ws + WS_VM);
    unsigned char* Q8 = (unsigned char*)(p.ws + WS_Q8); unsigned char* K8 = (unsigned char*)(p.ws + WS_K8); unsigned char* VT8 = (unsigned char*)(p.ws + WS_VT8);
    for (int i = gt; i < NTOK * 48; i += gn) {
        const int r = i / 48, q = i % 48, hh = q / 12, c = q % 12;
        const bf16_t* qs = QM + (size_t)r * 768 + hh * 192; const bf16_t* ks = KM + (size_t)r * 768 + hh * 192;
        unsigned char* qd = Q8 + (size_t)r * 768 + hh * 192; unsigned char* kd = K8 + ((size_t)hh * NTOK + r) * 192;
        if (c < 8) {
            *(u32x4*)(qd + c * 16) = cvt16_fp8(*(const u32x4*)(qs + c * 16), *(const u32x4*)(qs + c * 16 + 8));
            *(u32x4*)(kd + c * 16) = cvt16_fp8(*(const u32x4*)(ks + c * 16), *(const u32x4*)(ks + c * 16 + 8));
        } else {
            const int j0 = (c - 8) * 8;
            const u32x4 a = *(const u32x4*)(qs + 128 + j0), b = *(const u32x4*)(qs + 160 + j0);
            u32x4 oa = a, ob = b;
            if (r >= CTXN) rope8(rope, r - CTXN, j0, a, b, oa, ob);
            *(u32x2*)(qd + 128 + j0) = cvt8_fp8(oa); *(u32x2*)(qd + 160 + j0) = cvt8_fp8(ob);
            *(u32x2*)(kd + 128 + j0) = cvt8_fp8(*(const u32x4*)(ks + 128 + j0)); *(u32x2*)(kd + 160 + j0) = cvt8_fp8(*(const u32x4*)(ks + 160 + j0));
        }
    }
    {
        const int lane = tid & 63, g = lane >> 4, dq = lane & 15;
        for (int u = gt >> 6; u < 4 * NCH; u += gn >> 6) {
            const int hh = u / NCH, t = u % NCH;
            const bf16_t* vs = VM + (size_t)(t * 64 + 16 * g) * 512 + hh * 128 + dq * 8;
            u32x4 w[16];
#pragma unroll
            for (int i = 0; i < 16; ++i) w[i] = *(const u32x4*)(vs + (size_t)i * 512);
            unsigned char* dst = VT8 + ((size_t)u * 128 + dq * 8) * 64 + 8 * g;
#pragma unroll
            for (int d = 0; d < 8; ++d) {
                float f[16];
#pragma unroll
                for (int i = 0; i < 16; ++i) f[i] = (d & 1) ? __uint_as_float(w[i][d >> 1] & 0xFFFF0000u) : __uint_as_float(w[i][d >> 1] << 16);
                *(u32x2*)(dst + d * 64) = (u32x2){pk4_fp8(f[0], f[1], f[2], f[3]), pk4_fp8(f[8], f[9], f[10], f[11])};
                *(u32x2*)(dst + d * 64 + 32) = (u32x2){pk4_fp8(f[4], f[5], f[6], f[7]), pk4_fp8(f[12], f[13], f[14], f[15])};
            }
        }
    }
}

__device__ __forceinline__ int gla_order(int dir, int step) { return dir == 0 ? step : (step < 4 ? 3 - step : NCH - 1 - (step - 4)); }
__device__ __forceinline__ void phase_gla_scan(PRef p) {
    const int gid = blockIdx.x * NTH + threadIdx.x;
    if (gid >= 2 * 4 * 8192) { mla_pack_pass(p, 128, (int)gridDim.x - 128); return; }
    const int dir = gid >> 15, h = (gid >> 13) & 3, e = gid & 8191, d = e & 63;
    const bf16_t* U = (const bf16_t*)(p.ws + WS_U); bf16_t* S = (bf16_t*)(p.ws + WS_SIN); const float* DEC = (const float*)(p.ws + WS_DEC);
    float s = 0.f;
#pragma unroll 1
    for (int s0 = 0; s0 < NCH; s0 += 52) {
        float uu[52], dc[52];
#pragma unroll
        for (int i = 0; i < 52; ++i) { const size_t o = ((size_t)(dir * NCH + gla_order(dir, s0 + i)) * 4 + h); uu[i] = bf2f(U[o * 8192 + e]); dc[i] = DEC[o * 64 + d]; }
#pragma unroll
        for (int i = 0; i < 52; ++i) { const size_t o = ((size_t)(dir * NCH + gla_order(dir, s0 + i)) * 4 + h); S[o * 8192 + e] = f2bf(s); s = dc[i] * s + uu[i]; }
    }
}

__device__ __forceinline__ void gla_out_unit(PRef p, int gc, int h) {
    const int tid = threadIdx.x, lane = tid & 63, wave = tid >> 6, r32 = lane & 31, hi = lane >> 5;
    const bf16_t* P = (const bf16_t*)(p.ws + WS_P);
    bf16_t* qe = (bf16_t*)smem;
    bf16_t* ke = qe + 2 * 64 * 72;
    bf16_t* Am = ke + 2 * 64 * 72;
    bf16_t* VT = Am + 2 * 64 * 72;
    bf16_t* ST = VT + 128 * 72;
    float* scr = (float*)(smem + 110592);
    float* ob = (float*)(ke);
    const GlaB gb = gla_decay(p, gc, h, scr);
    {
        const int dir = wave & 1, tq = wave >> 1;
#pragma unroll
        for (int i = 0; i < 16; ++i) {
            const int t = tq * 16 + i;
            const float qv = bf2f(P[(size_t)(gc * 64 + t) * PW + PC_Q + h * 64 + lane]) * 0.125f, kv = bf2f(P[(size_t)(gc * 64 + t) * PW + PC_K + h * 64 + lane]);
            qe[(dir * 64 + t) * 72 + lane] = f2bf(qv * __expf(gb.b[i]));
            ke[(dir * 64 + t) * 72 + lane] = f2bf(kv * __expf(-gb.b[i]));
        }
    }
    gla_stage_vt(P, gc, h, VT);
    {
        const bf16_t* S = (const bf16_t*)(p.ws + WS_SIN);
#pragma unroll
        for (int i = 0; i < 4; ++i) {
            const int cc = tid + 512 * i, dir = cc >> 10, v = (cc >> 3) & 127, ch = cc & 7;
            *(u32x4*)(ST + (dir * 128 + v) * 72 + ch * 8) = *(const u32x4*)(S + ((size_t)(dir * NCH + gc) * 4 + h) * 8192 + v * 64 + ch * 8);
        }
    }
    __syncthreads();
    {
        const int dir = wave >> 2, tb = (wave >> 1) & 1, sb = wave & 1;
        f32x16 acc = {};
#pragma unroll
        for (int ks = 0; ks < 4; ++ks) {
            const bf16x8 a = *(const bf16x8*)(qe + (dir * 64 + tb * 32 + r32) * 72 + ks * 16 + hi * 8);
            const bf16x8 b = *(const bf16x8*)(ke + (dir * 64 + sb * 32 + r32) * 72 + ks * 16 + hi * 8);
            acc = __builtin_amdgcn_mfma_f32_32x32x16_bf16(a, b, acc, 0, 0, 0);
        }
        const int s = sb * 32 + r32;
#pragma unroll
        for (int r = 0; r < 16; ++r) { const int t = tb * 32 + crow(r, hi); const bool keep = (dir == 0) ? (s <= t) : (s >= t); Am[(dir * 64 + t) * 72 + s] = f2bf(keep ? acc[r] : 0.f); }
    }
    __syncthreads();
    f32x16 o = {};
    const int tb = wave >> 2, vb = wave & 3;
#pragma unroll
    for (int dir = 0; dir < 2; ++dir)
#pragma unroll
        for (int ks = 0; ks < 4; ++ks) {
            const bf16x8 a1 = *(const bf16x8*)(Am + (dir * 64 + tb * 32 + r32) * 72 + ks * 16 + hi * 8);
            const bf16x8 b1 = *(const bf16x8*)(VT + (vb * 32 + r32) * 72 + ks * 16 + hi * 8);
            o = __builtin_amdgcn_mfma_f32_32x32x16_bf16(a1, b1, o, 0, 0, 0);
            const bf16x8 a2 = *(const bf16x8*)(qe + (dir * 64 + tb * 32 + r32) * 72 + ks * 16 + hi * 8);
            const bf16x8 b2 = *(const bf16x8*)(ST + (dir * 128 + vb * 32 + r32) * 72 + ks * 16 + hi * 8);
            o = __builtin_amdgcn_mfma_f32_32x32x16_bf16(a2, b2, o, 0, 0, 0);
        }
    __syncthreads();
#pragma unroll
    for (int r = 0; r < 16; ++r) ob[(tb * 32 + crow(r, hi)) * 132 + vb * 32 + r32] = o[r];
    __syncthreads();
    {
        const int t = tid >> 3, v0 = (tid & 7) * 16;
        float vals[16]; float ss = 0.f;
#pragma unroll
        for (int i = 0; i < 16; ++i) { vals[i] = ob[t * 132 + v0 + i]; ss += vals[i] * vals[i]; }
        ss += __shfl_xor(ss, 1); ss += __shfl_xor(ss, 2); ss += __shfl_xor(ss, 4);
        const float rstd = rsqrtf(ss * (1.f / 128.f) + EPSN);
        const size_t row = (size_t)gc * 64 + t;
        unsigned pk[8];
#pragma unroll
        for (int i = 0; i < 8; ++i) {
            const float r0 = bf2f(P[row * PW + PC_R + h * 128 + v0 + 2 * i]), r1 = bf2f(P[row * PW + PC_R + h * 128 + v0 + 2 * i + 1]);
            pk[i] = cvtpk(vals[2 * i] * rstd * p.gla_onorm[v0 + 2 * i] * silu_f(r0), vals[2 * i + 1] * rstd * p.gla_onorm[v0 + 2 * i + 1] * silu_f(r1));
        }
        bf16_t* M = (bf16_t*)(p.ws + WS_MIX) + row * 1024 + h * 128 + v0;
        *(u32x4*)M = (u32x4){pk[0], pk[1], pk[2], pk[3]}; *(u32x4*)(M + 8) = (u32x4){pk[4], pk[5], pk[6], pk[7]};
    }
    __syncthreads();
}


struct GlaPre { u32x4 qc, kc, vc[2], ac, sc[4]; float4 wac; float bac; };
__device__ __forceinline__ void gla_prefetch(PRef p, int gc, int h, GlaPre& g, u32x4 (&rc)[2]) {
    const int tid = threadIdx.x;
    const bf16_t* P = (const bf16_t*)(p.ws + WS_P);
    const bf16_t* rowp = P + (size_t)(gc * 64 + (tid >> 3)) * PW;
    g.qc = *(const u32x4*)(rowp + PC_Q + h * 64 + (tid & 7) * 8);
    g.kc = *(const u32x4*)(rowp + PC_K + h * 64 + (tid & 7) * 8);
#pragma unroll
    for (int i = 0; i < 2; ++i) { const int idx = tid + 512 * i; g.vc[i] = *(const u32x4*)(P + (size_t)(gc * 64 + (idx >> 4)) * PW + PC_V + h * 128 + (idx & 15) * 8); }
#pragma unroll
    for (int i = 0; i < 2; ++i) rc[i] = *(const u32x4*)(rowp + PC_R + h * 128 + (tid & 7) * 16 + 8 * i);
    g.ac = *(const u32x4*)(P + (size_t)(gc * 64 + ((tid & 255) >> 2)) * PW + PC_AF + (tid & 3) * 8);
    const bf16_t* S = (const bf16_t*)(p.ws + WS_SIN);
#pragma unroll
    for (int i = 0; i < 4; ++i) { const int cc = tid + 512 * i, dir = cc >> 10; g.sc[i] = *(const u32x4*)(S + ((size_t)(dir * NCH + gc) * 4 + h) * 8192 + (cc & 1023) * 8); }
    { const int dd = tid >> 8, jj = (tid >> 4) & 15, d4 = tid & 15; g.wac = *(const float4*)((dd == 0 ? p.gla_wa_f : p.gla_wa_b) + jj * 256 + h * 64 + d4 * 4); }
    g.bac = ((tid >> 6) & 1 ? p.gla_ba_b : p.gla_ba_f)[h * 64 + (tid & 63)];
}
template <int OFF> __device__ __forceinline__ s16x4 gla_tr(int vb) { s16x4 r; asm volatile("ds_read_b64_tr_b16 %0, %1 offset:%2" : "=&v"(r) : "v"(vb), "i"(OFF) : "memory"); return r; }
__device__ __forceinline__ void phase_gla_out(PRef p) {
    const int tid = threadIdx.x, lane = tid & 63, wave = tid >> 6, r32 = lane & 31, hi = lane >> 5, G = gridDim.x;
    bf16_t* qe = (bf16_t*)smem;
    bf16_t* ke = qe + 2 * 64 * 72;
    bf16_t* Am = ke + 2 * 64 * 72;
    bf16_t* Qraw = Am; bf16_t* Kraw = Am + 64 * 72;
    char* Vraw = smem + 55296;
    bf16_t* ST = (bf16_t*)(smem + 75776);
    float* af = (float*)(smem + 112640);
    float* wa = af + 2048;
    float* ba = wa + 2048;
    float* tot = ba + 128;
    float* ob = (float*)ke;
    int u = blockIdx.x;
    if (u >= NCH * 4) return;
    const int nt_t = tid >> 3, nt_v0 = (tid & 7) * 16;
    float on[16];
#pragma unroll
    for (int i = 0; i < 16; ++i) on[i] = p.gla_onorm[nt_v0 + i];
    GlaPre g; u32x4 rc[2], rcn[2];
    gla_prefetch(p, u >> 2, u & 3, g, rc);
    const int dir = wave & 1, tq = wave >> 1;
    for (; u < NCH * 4; u += G) {
        const int gc = u >> 2, h = u & 3;
        *(u32x4*)(Qraw + (tid >> 3) * 72 + (tid & 7) * 8) = g.qc;
        *(u32x4*)(Kraw + (tid >> 3) * 72 + (tid & 7) * 8) = g.kc;
#pragma unroll
        for (int i = 0; i < 2; ++i) { const int idx = tid + 512 * i; *(u32x4*)(Vraw + (idx >> 4) * 320 + (idx & 15) * 16) = g.vc[i]; }
#pragma unroll
        for (int i = 0; i < 4; ++i) { const int cc = tid + 512 * i; *(u32x4*)(ST + ((cc >> 10) * 128 + ((cc >> 3) & 127)) * 72 + (cc & 7) * 8) = g.sc[i]; }
        if (tid < 256) { const int t = tid >> 2, ch = tid & 3, dd = ch >> 1, j0 = (ch & 1) * 8; float* q = af + dd * 1024 + t * 16 + j0;
#pragma unroll
            for (int e = 0; e < 4; ++e) { q[2 * e] = __uint_as_float(g.ac[e] << 16); q[2 * e + 1] = __uint_as_float(g.ac[e] & 0xFFFF0000u); } }
        { const int dd = tid >> 8, jj = (tid >> 4) & 15, d4 = tid & 15; *(float4*)(wa + (dd * 16 + jj) * 64 + d4 * 4) = g.wac; }
        if (tid < 128) ba[tid] = g.bac;
        __syncthreads();
        const int un = u + G;
        if (un < NCH * 4) gla_prefetch(p, un >> 2, un & 3, g, rcn);
        float bb[16]; float total;
        {
            float w[16];
#pragma unroll
            for (int j = 0; j < 16; ++j) w[j] = wa[(dir * 16 + j) * 64 + lane];
            const float bias = ba[dir * 64 + lane];
#pragma unroll
            for (int i = 0; i < 16; ++i) {
                const int t = tq * 16 + i;
                float z = bias;
#pragma unroll
                for (int j = 0; j < 16; ++j) z += af[(dir * 64 + t) * 16 + j] * w[j];
                bb[i] = (fminf(z, 0.f) - __logf(1.f + __expf(-fabsf(z)))) * (1.f / 16.f);
            }
            if (dir == 0) {
#pragma unroll
                for (int i = 1; i < 16; ++i) bb[i] += bb[i - 1];
                tot[(dir * 4 + tq) * 64 + lane] = bb[15];
            } else {
#pragma unroll
                for (int i = 14; i >= 0; --i) bb[i] += bb[i + 1];
                tot[(dir * 4 + tq) * 64 + lane] = bb[0];
            }
        }
        __syncthreads();
        {
            float offs = 0.f; total = 0.f;
#pragma unroll
            for (int q = 0; q < 4; ++q) { const float tv = tot[(dir * 4 + q) * 64 + lane]; total += tv; if (dir == 0 ? (q < tq) : (q > tq)) offs += tv; }
#pragma unroll
            for (int i = 0; i < 16; ++i) bb[i] += offs;
        }
#pragma unroll
        for (int i = 0; i < 16; ++i) {
            const int t = tq * 16 + i;
            const float qv = bf2f(Qraw[t * 72 + lane]) * 0.125f, kv = bf2f(Kraw[t * 72 + lane]);
            qe[(dir * 64 + t) * 72 + lane] = f2bf(qv * __expf(bb[i]));
            ke[(dir * 64 + t) * 72 + lane] = f2bf(kv * __expf(-bb[i]));
        }
        __syncthreads();
        {
            const int mdir = wave >> 2, tb = (wave >> 1) & 1, sb = wave & 1;
            f32x16 acc = {};
#pragma unroll
            for (int ks = 0; ks < 4; ++ks) {
                const bf16x8 a = *(const bf16x8*)(qe + (mdir * 64 + tb * 32 + r32) * 72 + ks * 16 + hi * 8);
                const bf16x8 b = *(const bf16x8*)(ke + (mdir * 64 + sb * 32 + r32) * 72 + ks * 16 + hi * 8);
                acc = __builtin_amdgcn_mfma_f32_32x32x16_bf16(a, b, acc, 0, 0, 0);
            }
            const int sI = sb * 32 + r32;
#pragma unroll
            for (int r = 0; r < 16; ++r) { const int t = tb * 32 + crow(r, hi); const bool keep = (mdir == 0) ? (sI <= t) : (sI >= t); Am[(mdir * 64 + t) * 72 + sI] = f2bf(keep ? acc[r] : 0.f); }
        }
        __syncthreads();
        f32x16 o = {};
        const int tb = wave >> 2, vbk = wave & 3;
        {
            const int vb = (int)(uintptr_t)Vraw + (8 * hi + ((lane & 15) >> 2)) * 320 + (vbk * 32 + 16 * ((lane >> 4) & 1) + 4 * (lane & 3)) * 2;
#define GLA_PV(KS, DIRN) do { const s16x4 l_ = gla_tr<(KS) * 5120>(vb), h_ = gla_tr<(KS) * 5120 + 1280>(vb); \
            const bf16x8 a1 = *(const bf16x8*)(Am + ((DIRN) * 64 + tb * 32 + r32) * 72 + (KS) * 16 + hi * 8); \
            const bf16x8 a2 = *(const bf16x8*)(qe + ((DIRN) * 64 + tb * 32 + r32) * 72 + (KS) * 16 + hi * 8); \
            const bf16x8 b2 = *(const bf16x8*)(ST + ((DIRN) * 128 + vbk * 32 + r32) * 72 + (KS) * 16 + hi * 8); \
            asm volatile("s_waitcnt lgkmcnt(0)" ::: "memory"); SBAR(); \
            o = __builtin_amdgcn_mfma_f32_32x32x16_bf16(a1, (bf16x8){l_[0], l_[1], l_[2], l_[3], h_[0], h_[1], h_[2], h_[3]}, o, 0, 0, 0); \
            o = __builtin_amdgcn_mfma_f32_32x32x16_bf16(a2, b2, o, 0, 0, 0); } while (0)
            GLA_PV(0, 0); GLA_PV(1, 0); GLA_PV(2, 0); GLA_PV(3, 0); GLA_PV(0, 1); GLA_PV(1, 1); GLA_PV(2, 1); GLA_PV(3, 1);
#undef GLA_PV
        }
        __syncthreads();
#pragma unroll
        for (int r = 0; r < 16; ++r) ob[(tb * 32 + crow(r, hi)) * 132 + vbk * 32 + r32] = o[r];
        __syncthreads();
        {
            float vals[16]; float ss = 0.f;
#pragma unroll
            for (int i = 0; i < 4; ++i) { const f32x4 x = *(const f32x4*)(ob + nt_t * 132 + nt_v0 + 4 * i); vals[4 * i] = x[0]; vals[4 * i + 1] = x[1]; vals[4 * i + 2] = x[2]; vals[4 * i + 3] = x[3]; }
#pragma unroll
            for (int i = 0; i < 16; ++i) ss += vals[i] * vals[i];
            ss += __shfl_xor(ss, 1); ss += __shfl_xor(ss, 2); ss += __shfl_xor(ss, 4);
            const float rstd = rsqrtf(ss * (1.f / 128.f) + EPSN);
            unsigned pk[8];
#pragma unroll
            for (int i = 0; i < 8; ++i) {
                const unsigned w = rc[i >> 2][i & 3];
                const float r0 = __uint_as_float(w << 16), r1 = __uint_as_float(w & 0xFFFF0000u);
                const float s0 = r0 * __builtin_amdgcn_rcpf(1.f + __expf(-r0)), s1 = r1 * __builtin_amdgcn_rcpf(1.f + __expf(-r1));
                pk[i] = cvtpk(vals[2 * i] * rstd * on[2 * i] * s0, vals[2 * i + 1] * rstd * on[2 * i + 1] * s1);
            }
            bf16_t* M = (bf16_t*)(p.ws + WS_MIX) + ((size_t)gc * 64 + nt_t) * 1024 + h * 128 + nt_v0;
            *(u32x4*)M = (u32x4){pk[0], pk[1], pk[2], pk[3]}; *(u32x4*)(M + 8) = (u32x4){pk[4], pk[5], pk[6], pk[7]};
        }
        rc[0] = rcn[0]; rc[1] = rcn[1];
        __syncthreads();
    }
}

namespace mla {
constexpr int KVBLK = 64, QBLK = 32;
#ifndef MLA_QREG
#define MLA_QREG 12
#endif
constexpr int QREG = MLA_QREG;
constexpr float SCALE = 0.07216878364870322f;
constexpr float THR = 8.f;
constexpr int LDQ = 768, LDK = 768, LDV = 512, LDO = 1024;
constexpr int SHM_V = KVBLK * 128 * 2, SHM_K = KVBLK * 400;
#define MKSWZ(row, colB) ((row) * 400 + (colB))
__device__ __forceinline__ void partialSM(f32x16& p0, f32x16& p1, float& m_reg, float& mn, float& alpha) {
    constexpr float C = SCALE * LOG2E;
    float pmax = p0[0];
#pragma unroll
    for (int r = 1; r < 16; ++r) pmax = fmaxf(pmax, p0[r]);
#pragma unroll
    for (int r = 0; r < 16; ++r) pmax = fmaxf(pmax, p1[r]);
    { auto rr = __builtin_amdgcn_permlane32_swap(__float_as_uint(pmax), __float_as_uint(pmax), false, false);
      pmax = fmaxf(__uint_as_float(rr[0]), __uint_as_float(rr[1])); }
    if (__builtin_expect(__all(pmax - m_reg <= THR / SCALE), 1)) { mn = m_reg; alpha = 1.f; }
    else { mn = fmaxf(m_reg, pmax); alpha = __builtin_amdgcn_exp2f((m_reg - mn) * C); m_reg = mn; }
    const float mnC = -mn * C;
#pragma unroll
    for (int r = 0; r < 16; ++r) p0[r] = fmaf(p0[r], C, mnC);
#pragma unroll
    for (int r = 0; r < 16; ++r) p1[r] = fmaf(p1[r], C, mnC);
#pragma unroll
    for (int r = 0; r < 16; ++r) p0[r] = __builtin_amdgcn_exp2f(p0[r]);
}
__device__ __forceinline__ void finishSM(f32x16& p0, f32x16& p1, float alpha, float& l_reg, bf16x8& pa0, bf16x8& pa1, bf16x8& pa2, bf16x8& pa3) {
#pragma unroll
    for (int r = 0; r < 16; ++r) p1[r] = __builtin_amdgcn_exp2f(p1[r]);
    float ps = 0;
#pragma unroll
    for (int r = 0; r < 16; ++r) ps += p0[r];
#pragma unroll
    for (int r = 0; r < 16; ++r) ps += p1[r];
    { auto rr = __builtin_amdgcn_permlane32_swap(__float_as_uint(ps), __float_as_uint(ps), false, false);
      ps = __uint_as_float(rr[0]) + __uint_as_float(rr[1]); }
    l_reg = l_reg * alpha + ps;
#define PK4(P, BASE, OUT) do { unsigned a0 = cvtpk(P[BASE + 0], P[BASE + 1]), a1 = cvtpk(P[BASE + 2], P[BASE + 3]);   \
    unsigned b0 = cvtpk(P[BASE + 4], P[BASE + 5]), b1 = cvtpk(P[BASE + 6], P[BASE + 7]);                              \
    auto r0 = __builtin_amdgcn_permlane32_swap(a0, b0, false, false); auto r1 = __builtin_amdgcn_permlane32_swap(a1, b1, false, false); \
    u32x4 w = {r0[0], r1[0], r0[1], r1[1]}; OUT = *reinterpret_cast<bf16x8*>(&w); } while (0)
    PK4(p0, 0, pa0); PK4(p0, 8, pa1); PK4(p1, 0, pa2); PK4(p1, 8, pa3);
}
__device__ __forceinline__ void qkt(f32x16& p0, f32x16& p1, const char* Ks, const bf16x8* qr, const char* qlds, int r32, int hi) {
    p0 = f32x16{}; p1 = f32x16{};
#pragma unroll
    for (int d0 = 0; d0 < 12; ++d0) { const int cb = (d0 * 16 + hi * 8) * 2;
        const bf16x8 b0 = *reinterpret_cast<const bf16x8*>(Ks + MKSWZ(r32, cb));
        const bf16x8 b1 = *reinterpret_cast<const bf16x8*>(Ks + MKSWZ(32 + r32, cb));
        const bf16x8 qv = (d0 < QREG) ? qr[d0 < QREG ? d0 : 0] : *reinterpret_cast<const bf16x8*>(qlds + (d0 - QREG) * 1024);
        p0 = __builtin_amdgcn_mfma_f32_32x32x16_bf16(b0, qv, p0, 0, 0, 0);
        p1 = __builtin_amdgcn_mfma_f32_32x32x16_bf16(b1, qv, p1, 0, 0, 0); }
}
__device__ __forceinline__ int v_st(int k, int c) { const int kk = (k & ~0xC) | ((k & 4) << 1) | ((k & 8) >> 1); return ((kk >> 3) * 4 + (c >> 5)) * 512 + ((kk & 7) * 32 + (c & 31)) * 2; }
__device__ __forceinline__ int v_rd_base(int lane) { return ((lane & 3) << 3) | (((lane >> 2) & 3) << 6) | (((lane >> 4) & 1) << 5) | (((lane >> 5) & 1) << 8); }
constexpr int v_rd_off(int d0, int ks, int half) { return d0 * 512 + ks * 4096 + half * 2048; }
template <int OFF> __device__ __forceinline__ s16x4 tr_read(int vb) {
    s16x4 r; asm volatile("ds_read_b64_tr_b16 %0, %1 offset:%2" : "=&v"(r) : "v"(vb), "i"(OFF) : "memory"); return r;
}
template <int D0> __device__ __forceinline__ void pv_one(f32x16& od, int vb, bf16x8 pa0, bf16x8 pa1, bf16x8 pa2, bf16x8 pa3) {
#define PKV(L, H) (bf16x8){L[0], L[1], L[2], L[3], H[0], H[1], H[2], H[3]}
    {
    const s16x4 l0 = tr_read<v_rd_off(D0, 0, 0)>(vb), h0 = tr_read<v_rd_off(D0, 0, 1)>(vb), l1 = tr_read<v_rd_off(D0, 1, 0)>(vb), h1 = tr_read<v_rd_off(D0, 1, 1)>(vb);
    asm volatile("s_waitcnt lgkmcnt(0)" ::: "memory"); SBAR();
    od = __builtin_amdgcn_mfma_f32_32x32x16_bf16(pa0, PKV(l0, h0), od, 0, 0, 0);
    od = __builtin_amdgcn_mfma_f32_32x32x16_bf16(pa1, PKV(l1, h1), od, 0, 0, 0);
    }
    {
    const s16x4 l2 = tr_read<v_rd_off(D0, 2, 0)>(vb), h2 = tr_read<v_rd_off(D0, 2, 1)>(vb), l3 = tr_read<v_rd_off(D0, 3, 0)>(vb), h3 = tr_read<v_rd_off(D0, 3, 1)>(vb);
    asm volatile("s_waitcnt lgkmcnt(0)" ::: "memory"); SBAR();
    od = __builtin_amdgcn_mfma_f32_32x32x16_bf16(pa2, PKV(l2, h2), od, 0, 0, 0);
    od = __builtin_amdgcn_mfma_f32_32x32x16_bf16(pa3, PKV(l3, h3), od, 0, 0, 0);
    }
#undef PKV
}
__device__ __forceinline__ void pv_d0(f32x16* o, int vb, bf16x8 pa0, bf16x8 pa1, bf16x8 pa2, bf16x8 pa3) {
    pv_one<0>(o[0], vb, pa0, pa1, pa2, pa3); pv_one<1>(o[1], vb, pa0, pa1, pa2, pa3); pv_one<2>(o[2], vb, pa0, pa1, pa2, pa3); pv_one<3>(o[3], vb, pa0, pa1, pa2, pa3);
}
__device__ __forceinline__ void attn_body(const bf16_t* __restrict__ Qb, const bf16_t* __restrict__ Kh, const bf16_t* __restrict__ Vh, bf16_t* __restrict__ Ob, int seq) {
    char* lds = smem;
    const int tid = threadIdx.x, wid = tid >> 6, lane = tid & 63, r32 = lane & 31, hi = lane >> 5;
    char* V_lds = lds; char* K_lds = lds + 2 * SHM_V;
    float* ws = (float*)(lds + 2 * SHM_V + 2 * SHM_K) + wid * 64; float* li_l = ws; float* al_l = ws + 32;
    float m_reg = -1e30f, l_reg = 0; f32x16 o[4] = {}; bf16x8 qr[QREG];
    const bf16_t* Qw = Qb + (long)(wid * QBLK + r32) * LDQ + hi * 8;
#pragma unroll
    for (int d0 = 0; d0 < QREG; ++d0) qr[d0] = *reinterpret_cast<const bf16x8*>(Qw + d0 * 16);
    char* qlds = lds + 2 * SHM_V + 2 * SHM_K + 2048 + wid * ((12 - QREG) * 1024) + lane * 16;
#pragma unroll
    for (int d0 = 0; d0 < 12 - QREG; ++d0) *reinterpret_cast<bf16x8*>(qlds + d0 * 1024) = *reinterpret_cast<const bf16x8*>(Qw + (QREG + d0) * 16);
    const int sr = tid >> 4, sc = (tid & 15) * 8, vst0 = v_st(sr, sc), vst1 = v_st(32 + sr, sc);
    int kgo[3], kso[3];
#pragma unroll
    for (int i = 0; i < 3; ++i) { const int id = tid + 512 * i, kr_ = id / 24, kc_ = (id % 24) * 8; kgo[i] = kr_ * LDK + kc_; kso[i] = MKSWZ(kr_, kc_ * 2); }
    const int vb0 = (int)(uintptr_t)V_lds + v_rd_base(lane);
    struct { bf16x8 vs0, vs1, ks0, ks1, ks2; } st_;
#define SLOAD(k0) do { st_.vs0 = *(const bf16x8*)(&Vh[(long)((k0) + sr) * LDV + sc]); st_.vs1 = *(const bf16x8*)(&Vh[(long)((k0) + 32 + sr) * LDV + sc]); \
    st_.ks0 = *(const bf16x8*)(&Kh[(long)(k0) * LDK + kgo[0]]); st_.ks1 = *(const bf16x8*)(&Kh[(long)(k0) * LDK + kgo[1]]); \
    st_.ks2 = *(const bf16x8*)(&Kh[(long)(k0) * LDK + kgo[2]]); } while (0)
#define SWRITE(b) do { *(bf16x8*)(V_lds + (b) * SHM_V + vst0) = st_.vs0; *(bf16x8*)(V_lds + (b) * SHM_V + vst1) = st_.vs1; \
    *(bf16x8*)(K_lds + (b) * SHM_K + kso[0]) = st_.ks0; *(bf16x8*)(K_lds + (b) * SHM_K + kso[1]) = st_.ks1; \
    *(bf16x8*)(K_lds + (b) * SHM_K + kso[2]) = st_.ks2; } while (0)
#define RESC(a) do { if (__any((a) < 1.f)) { if (hi == 0) al_l[r32] = (a); asm volatile("s_waitcnt lgkmcnt(0)" ::: "memory"); \
    _Pragma("unroll") for (int d = 0; d < 4; ++d) _Pragma("unroll") for (int r = 0; r < 16; ++r) o[d][r] *= al_l[crow(r, hi)]; } } while (0)
    f32x16 pA0, pA1, pB0, pB1; float mnA, mnB, alA, alB; bf16x8 pa0, pa1, pa2, pa3; const int NT = seq / KVBLK;
    SLOAD(0); SWRITE(0); __syncthreads();
    qkt(pA0, pA1, K_lds, qr, qlds, r32, hi); partialSM(pA0, pA1, m_reg, mnA, alA);
    SLOAD(KVBLK); SWRITE(1); __syncthreads();
    for (int j = 1; j + 1 < NT; j += 2) {
        SBAR(); qkt(pB0, pB1, K_lds + SHM_K, qr, qlds, r32, hi);
        finishSM(pA0, pA1, alA, l_reg, pa0, pa1, pa2, pa3); SBAR();
        SLOAD((j + 1) * KVBLK); SBAR();
        pv_d0(o, vb0, pa0, pa1, pa2, pa3); partialSM(pB0, pB1, m_reg, mnB, alB);
        __syncthreads(); SWRITE(0);
        RESC(alB); __syncthreads();
        SBAR(); qkt(pA0, pA1, K_lds, qr, qlds, r32, hi);
        finishSM(pB0, pB1, alB, l_reg, pa0, pa1, pa2, pa3); SBAR();
        SLOAD((j + 2) * KVBLK); SBAR();
        pv_d0(o, vb0 + SHM_V, pa0, pa1, pa2, pa3); partialSM(pA0, pA1, m_reg, mnA, alA);
        __syncthreads(); SWRITE(1);
        RESC(alA); __syncthreads();
    }
    SBAR(); qkt(pB0, pB1, K_lds + SHM_K, qr, qlds, r32, hi);
    finishSM(pA0, pA1, alA, l_reg, pa0, pa1, pa2, pa3); SBAR();
    pv_d0(o, vb0, pa0, pa1, pa2, pa3); partialSM(pB0, pB1, m_reg, mnB, alB);
    __syncthreads(); RESC(alB);
    finishSM(pB0, pB1, alB, l_reg, pa0, pa1, pa2, pa3); SBAR();
    pv_d0(o, vb0 + SHM_V, pa0, pa1, pa2, pa3);
    if (hi == 0) li_l[r32] = l_reg; asm volatile("s_waitcnt lgkmcnt(0)" ::: "memory");
    float rli[16];
#pragma unroll
    for (int r = 0; r < 16; ++r) rli[r] = __builtin_amdgcn_rcpf(li_l[crow(r, hi)]);
    bf16_t* Ow = Ob + (long)(wid * QBLK) * LDO;
#pragma unroll
    for (int r = 0; r < 16; ++r) { const int orow = crow(r, hi);
#pragma unroll
        for (int d0 = 0; d0 < 4; ++d0) Ow[(long)orow * LDO + d0 * 32 + r32] = f2bf(o[d0][r] * rli[r]); }
    __syncthreads();
#undef SLOAD
#undef SWRITE
#undef RESC
}
}

namespace mla8 {
typedef int i32x8 __attribute__((ext_vector_type(8)));
constexpr int KVBLK = 64;
constexpr float SCALE = 0.07216878364870322f;
constexpr float THR = 3.f;
constexpr float PBIAS = 4.f;
constexpr int KROW = 208, VROW = 80;
constexpr int SHM_K = KVBLK * KROW, SHM_V = 128 * VROW;
constexpr int ONE = 0x7F7F7F7F;
__device__ __forceinline__ i32x8 ld32(const char* a) { const i32x4 lo = *(const i32x4*)a, hi_ = *(const i32x4*)(a + 16); return __builtin_shufflevector(lo, hi_, 0, 1, 2, 3, 4, 5, 6, 7); }
__device__ __forceinline__ void qkt(f32x16& p0, f32x16& p1, const char* Kw, const i32x8 (&q)[3]) {
    p0 = f32x16{}; p1 = f32x16{};
#pragma unroll
    for (int s_ = 0; s_ < 3; ++s_) {
        const i32x8 a0 = ld32(Kw + s_ * 64), a1 = ld32(Kw + 32 * KROW + s_ * 64);
        p0 = __builtin_amdgcn_mfma_scale_f32_32x32x64_f8f6f4(a0, q[s_], p0, 0, 0, 0, ONE, 0, ONE);
        p1 = __builtin_amdgcn_mfma_scale_f32_32x32x64_f8f6f4(a1, q[s_], p1, 0, 0, 0, ONE, 0, ONE);
    }
}
__device__ __forceinline__ void partialSM(f32x16& p0, f32x16& p1, float& m_reg, float& alpha) {
    constexpr float C = SCALE * LOG2E;
    float pmax = p0[0];
#pragma unroll
    for (int r = 1; r < 16; ++r) pmax = fmaxf(pmax, p0[r]);
#pragma unroll
    for (int r = 0; r < 16; ++r) pmax = fmaxf(pmax, p1[r]);
    { auto rr = __builtin_amdgcn_permlane32_swap(__float_as_uint(pmax), __float_as_uint(pmax), false, false);
      pmax = fmaxf(__uint_as_float(rr[0]), __uint_as_float(rr[1])); }
    float mn;
    if (__builtin_expect(__all(pmax - m_reg <= THR / SCALE), 1)) { mn = m_reg; alpha = 1.f; }
    else { mn = fmaxf(m_reg, pmax); alpha = __builtin_amdgcn_exp2f((m_reg - mn) * C); m_reg = mn; }
    const float mnC = PBIAS - mn * C;
#pragma unroll
    for (int r = 0; r < 16; ++r) p0[r] = fmaf(p0[r], C, mnC);
#pragma unroll
    for (int r = 0; r < 16; ++r) p1[r] = fmaf(p1[r], C, mnC);
#pragma unroll
    for (int r = 0; r < 16; ++r) p0[r] = __builtin_amdgcn_exp2f(p0[r]);
}
__device__ __forceinline__ void finishSM(f32x16& p0, f32x16& p1, float alpha, float& l_reg, i32x8& P8) {
#pragma unroll
    for (int r = 0; r < 16; ++r) p1[r] = __builtin_amdgcn_exp2f(p1[r]);
    float ps = 0;
#pragma unroll
    for (int r = 0; r < 16; ++r) ps += p0[r];
#pragma unroll
    for (int r = 0; r < 16; ++r) ps += p1[r];
    { auto rr = __builtin_amdgcn_permlane32_swap(__float_as_uint(ps), __float_as_uint(ps), false, false);
      ps = __uint_as_float(rr[0]) + __uint_as_float(rr[1]); }
    l_reg = l_reg * alpha + ps;
#pragma unroll
    for (int w = 0; w < 4; ++w) {
        int a = __builtin_amdgcn_cvt_pk_fp8_f32(p0[4 * w], p0[4 * w + 1], 0, false); a = __builtin_amdgcn_cvt_pk_fp8_f32(p0[4 * w + 2], p0[4 * w + 3], a, true); P8[w] = a;
        int b = __builtin_amdgcn_cvt_pk_fp8_f32(p1[4 * w], p1[4 * w + 1], 0, false); b = __builtin_amdgcn_cvt_pk_fp8_f32(p1[4 * w + 2], p1[4 * w + 3], b, true); P8[4 + w] = b;
    }
}
__device__ __forceinline__ void pv(f32x16 (&o)[4], const char* Vw, const i32x8& P8) {
#pragma unroll
    for (int d0 = 0; d0 < 4; ++d0) { const i32x8 av = ld32(Vw + d0 * 32 * VROW); o[d0] = __builtin_amdgcn_mfma_scale_f32_32x32x64_f8f6f4(av, P8, o[d0], 0, 0, 0, ONE, 0, ONE); }
}
__device__ __forceinline__ void attn_body(const unsigned char* __restrict__ Q8w, const unsigned char* __restrict__ K8h, const unsigned char* __restrict__ V8h, bf16_t* __restrict__ Ob, int seq) {
    char* lds = smem;
    const int tid = tid_opaque(), wid = tid >> 6, lane = tid & 63, r32 = lane & 31, hi = lane >> 5;
    char* K_lds = lds; char* V_lds = lds + 2 * SHM_K;
    float m_reg = -1e30f, l_reg = 0; f32x16 o[4] = {};
    i32x8 q[3];
    { const unsigned char* qp = Q8w + (size_t)(wid * 32 + r32) * 768 + hi * 32;
#pragma unroll
      for (int s_ = 0; s_ < 3; ++s_) { const i32x4 lo = *(const i32x4*)(qp + s_ * 64), hi_ = *(const i32x4*)(qp + s_ * 64 + 16); q[s_] = __builtin_shufflevector(lo, hi_, 0, 1, 2, 3, 4, 5, 6, 7); } }
    const int kc0 = tid, kc1 = 512 + (tid & 255);
    const int kso0 = (kc0 / 12) * KROW + (kc0 % 12) * 16, kso1 = (kc1 / 12) * KROW + (kc1 % 12) * 16, vso = (tid >> 2) * VROW + (tid & 3) * 16;
    const bool two = tid < 256;
    const char* Kw = K_lds + r32 * KROW + hi * 32; const char* Vw = V_lds + r32 * VROW + hi * 32;
    struct { u32x4 k0, k1, v; } st_;
#define SLOAD(t_) do { const unsigned char* kt_ = K8h + (size_t)(t_) * (KVBLK * 192); st_.k0 = *(const u32x4*)(kt_ + kc0 * 16); if (two) st_.k1 = *(const u32x4*)(kt_ + kc1 * 16); \
    st_.v = *(const u32x4*)(V8h + (size_t)(t_) * 8192 + tid * 16); } while (0)
#define SWRITE(b) do { *(u32x4*)(K_lds + (b) * SHM_K + kso0) = st_.k0; if (two) *(u32x4*)(K_lds + (b) * SHM_K + kso1) = st_.k1; *(u32x4*)(V_lds + (b) * SHM_V + vso) = st_.v; } while (0)
#define RESC(a) do { if (__any((a) < 1.f)) { _Pragma("unroll") for (int d = 0; d < 4; ++d) _Pragma("unroll") for (int r = 0; r < 16; ++r) o[d][r] *= (a); } } while (0)
    f32x16 pA0, pA1, pB0, pB1; float alA, alB; i32x8 P8; const int NT = seq / KVBLK;
    SLOAD(0); SWRITE(0); __syncthreads();
    qkt(pA0, pA1, Kw, q); partialSM(pA0, pA1, m_reg, alA);
    SLOAD(1); SWRITE(1); __syncthreads();
    for (int j = 1; j + 1 < NT; j += 2) {
        SBAR(); qkt(pB0, pB1, Kw + SHM_K, q);
        finishSM(pA0, pA1, alA, l_reg, P8); SBAR();
        SLOAD(j + 1); SBAR();
        pv(o, Vw, P8); partialSM(pB0, pB1, m_reg, alB);
        __syncthreads(); SWRITE(0);
        RESC(alB); __syncthreads();
        SBAR(); qkt(pA0, pA1, Kw, q);
        finishSM(pB0, pB1, alB, l_reg, P8); SBAR();
        SLOAD(j + 2); SBAR();
        pv(o, Vw + SHM_V, P8); partialSM(pA0, pA1, m_reg, alA);
        __syncthreads(); SWRITE(1);
        RESC(alA); __syncthreads();
    }
    SBAR(); qkt(pB0, pB1, Kw + SHM_K, q);
    finishSM(pA0, pA1, alA, l_reg, P8); SBAR();
    pv(o, Vw, P8); partialSM(pB0, pB1, m_reg, alB);
    RESC(alB);
    finishSM(pB0, pB1, alB, l_reg, P8); SBAR();
    pv(o, Vw + SHM_V, P8);
    const float rl = __builtin_amdgcn_rcpf(l_reg);
    bf16_t* Ow = Ob + (size_t)(wid * 32 + r32) * 1024 + 4 * hi;
#pragma unroll
    for (int d0 = 0; d0 < 4; ++d0)
#pragma unroll
        for (int g = 0; g < 4; ++g)
            *(u32x2*)(Ow + d0 * 32 + 8 * g) = (u32x2){cvtpk(o[d0][4 * g] * rl, o[d0][4 * g + 1] * rl), cvtpk(o[d0][4 * g + 2] * rl, o[d0][4 * g + 3] * rl)};
    __syncthreads();
#undef SLOAD
#undef SWRITE
#undef RESC
}
}

__device__ __forceinline__ void phase_mix0(PRef p) {
    const int G = gridDim.x;
    phase_gla_out(p);
    __syncthreads();
    const unsigned char* Q8 = (const unsigned char*)(p.ws + WS_Q8); const unsigned char* K8 = (const unsigned char*)(p.ws + WS_K8); const unsigned char* VT8 = (const unsigned char*)(p.ws + WS_VT8);
    bf16_t* MIX = (bf16_t*)(p.ws + WS_MIX);
    for (int u = blockIdx.x; u < 260; u += G) {
        const bool lat = u < 256;
        const int h = lat ? (u & 3) : (u - 256);
        const size_t q0 = lat ? (size_t)CTXN + (size_t)(u >> 2) * 256 : 0;
        mla8::attn_body(Q8 + q0 * 768 + h * 192, K8 + (size_t)h * NTOK * 192, VT8 + (size_t)h * NCH * 8192, MIX + q0 * 1024 + 512 + h * 128, lat ? NTOK : CTXN);
    }
}

template <int OFF> __device__ __forceinline__ s16x4 na_tr(int vb) { s16x4 r; asm volatile("ds_read_b64_tr_b16 %0, %1 offset:%2" : "=&v"(r) : "v"(vb), "i"(OFF) : "memory"); return r; }
template <int KS> __device__ __forceinline__ void na_pv(f32x16& o0, f32x16& o1, int vb, bf16x8 pa) {
    const s16x4 a0 = na_tr<KS * 5120>(vb), a1 = na_tr<KS * 5120 + 1280>(vb), b0 = na_tr<KS * 5120 + 64>(vb), b1 = na_tr<KS * 5120 + 1280 + 64>(vb);
    asm volatile("s_waitcnt lgkmcnt(0)" ::: "memory"); SBAR();
    o0 = __builtin_amdgcn_mfma_f32_32x32x16_bf16(pa, (bf16x8){a0[0], a0[1], a0[2], a0[3], a1[0], a1[1], a1[2], a1[3]}, o0, 0, 0, 0);
    o1 = __builtin_amdgcn_mfma_f32_32x32x16_bf16(pa, (bf16x8){b0[0], b0[1], b0[2], b0[3], b1[0], b1[1], b1[2], b1[3]}, o1, 0, 0, 0);
}
template <int MODE> __device__ __forceinline__ void na_softmax(f32x16& p0, f32x16& p1, float& m_reg, float& l_reg, float& alpha, const float* brow, int c0, int hi) {
    constexpr float C = 0.125f * LOG2E;
#define NA_L0(q) (MODE != 2 || (q) >= 12)
#define NA_L1(q) (MODE != 1 || (q) < 4)
    if (MODE == 0) {
#pragma unroll
        for (int q = 0; q < 16; ++q) { p0[q] *= C; p1[q] *= C; }
    } else {
        float bv0[16], bv1[16];
#pragma unroll
        for (int q = 0; q < 16; ++q) { const int kc0 = crow(q, hi); if (NA_L0(q)) bv0[q] = brow[kc0]; if (NA_L1(q)) bv1[q] = brow[32 + kc0]; }
#pragma unroll
        for (int q = 0; q < 16; ++q) { if (NA_L0(q)) asm volatile("" : "+v"(bv0[q])); if (NA_L1(q)) asm volatile("" : "+v"(bv1[q])); }
#pragma unroll
        for (int q = 0; q < 16; ++q) {
            const int kc0 = crow(q, hi), kc1 = 32 + kc0;
            if (NA_L0(q)) { const float t = fmaf(p0[q], C, bv0[q]); p0[q] = ((unsigned)(kc0 - c0) < 16u) ? t : -1e30f; }
            if (NA_L1(q)) { const float t = fmaf(p1[q], C, bv1[q]); p1[q] = ((unsigned)(kc1 - c0) < 16u) ? t : -1e30f; }
        }
    }
    float pmax = -1e30f;
#pragma unroll
    for (int q = 0; q < 16; ++q) { if (NA_L0(q)) pmax = fmaxf(pmax, p0[q]); if (NA_L1(q)) pmax = fmaxf(pmax, p1[q]); }
    { auto rr = __builtin_amdgcn_permlane32_swap(__float_as_uint(pmax), __float_as_uint(pmax), false, false);
      pmax = fmaxf(__uint_as_float(rr[0]), __uint_as_float(rr[1])); }
    const float mn = fmaxf(m_reg, pmax);
    alpha = __builtin_amdgcn_exp2f(m_reg - mn);
    m_reg = mn;
    float ps = 0.f;
#pragma unroll
    for (int q = 0; q < 16; ++q) {
        if (NA_L0(q)) { p0[q] = __builtin_amdgcn_exp2f(p0[q] - mn); ps += p0[q]; } else p0[q] = 0.f;
        if (NA_L1(q)) { p1[q] = __builtin_amdgcn_exp2f(p1[q] - mn); ps += p1[q]; } else p1[q] = 0.f;
    }
    { auto rr = __builtin_amdgcn_permlane32_swap(__float_as_uint(ps), __float_as_uint(ps), false, false);
      ps = __uint_as_float(rr[0]) + __uint_as_float(rr[1]); }
    l_reg = l_reg * alpha + ps;
#undef NA_L0
#undef NA_L1
}
__device__ __forceinline__ void phase_na(PRef p) {
    const int tid = threadIdx.x, lane = tid & 63, wave = tid >> 6, r32 = lane & 31, hi = lane >> 5, G = gridDim.x;
    const bf16_t* QKV = (const bf16_t*)(p.ws + WS_P);
    bf16_t* MIX = (bf16_t*)(p.ws + WS_MIX);
    constexpr int KB = 64 * 72 * 2, VB = 64 * 160 * 2;
    char* Kl = smem;
    char* Vl = smem + 2 * KB;
    float* xch = (float*)(smem + 2 * KB + 2 * VB) + wave * 64;
    float* rpbL = (float*)(smem + 2 * KB + 2 * VB + 8 * 64 * 4);
    constexpr float C = 0.125f * LOG2E;
    const int skey = tid >> 3, sch = tid & 7;
    const int vb0 = (int)(uintptr_t)Vl + (8 * hi + ((lane & 15) >> 2)) * 320 + (16 * ((lane >> 4) & 1) + 4 * (lane & 3)) * 2;
    for (int u = blockIdx.x; u < 64 * 16; u += G) {
        const int rg = u >> 4, h = u & 15;
        const int r = rg * 4 + (wave >> 1), qb = wave & 1;
        const int r0w = min(max(r - 4, 0), 248);
        const int kr_lo = min(max(rg * 4 - 4, 0), 248), kr_hi = min(max(rg * 4 + 3 - 4, 0), 248) + 7, nwin = kr_hi - kr_lo + 1, ntile = nwin + 4;
        for (int i = tid; i < 15 * 31; i += NTH) rpbL[i] = p.na_rpb[(size_t)h * 15 * 31 + i] * LOG2E;
        const int c = qb * 32 + r32, c0 = min(max(c - 8, 0), 48);
        const size_t qrow = (size_t)CTXN + (size_t)r * 64 + c;
        bf16x8 qr[4];
#pragma unroll
        for (int ks = 0; ks < 4; ++ks) qr[ks] = *(const bf16x8*)(QKV + qrow * 3072 + h * 64 + ks * 16 + hi * 8);
        float m_reg = -1e30f, l_reg = 0.f; f32x16 o0 = {}, o1 = {};
        u32x4 skA, svA, skB, svB;
#define NA_LOAD(ti_, SK, SV) do { const size_t key0_ = ((ti_) >= nwin) ? (size_t)((ti_) - nwin) * 64 : (size_t)CTXN + (size_t)(kr_lo + (ti_)) * 64; \
            const bf16_t* src_ = QKV + (key0_ + skey) * 3072 + h * 64 + sch * 8; SK = *(const u32x4*)(src_ + 1024); SV = *(const u32x4*)(src_ + 2048); } while (0)
#define NA_WRITE(b_, SK, SV) do { *(u32x4*)(Kl + (b_) * KB + skey * 144 + sch * 16) = SK; *(u32x4*)(Vl + (b_) * VB + skey * 320 + sch * 16) = SV; } while (0)
        NA_LOAD(0, skA, svA); NA_WRITE(0, skA, svA);
        NA_LOAD(1, skA, svA);
        __syncthreads();
        for (int ti = 0; ti < ntile; ++ti) {
            const int b = ti & 1;
            if (ti + 2 < ntile) { if (b == 0) NA_LOAD(ti + 2, skB, svB); else NA_LOAD(ti + 2, skA, svA); }
            const bool isctx = ti >= nwin;
            const int kr = kr_lo + ti;
            const bool need = isctx || (kr >= r0w && kr <= r0w + 7);
            if (need) {
                const bf16_t* Ks = (const bf16_t*)(Kl + b * KB);
                f32x16 p0 = {}, p1 = {};
#pragma unroll
                for (int ks = 0; ks < 4; ++ks) {
                    const bf16x8 a0 = *(const bf16x8*)(Ks + r32 * 72 + ks * 16 + hi * 8), a1 = *(const bf16x8*)(Ks + (32 + r32) * 72 + ks * 16 + hi * 8);
                    p0 = __builtin_amdgcn_mfma_f32_32x32x16_bf16(a0, qr[ks], p0, 0, 0, 0);
                    p1 = __builtin_amdgcn_mfma_f32_32x32x16_bf16(a1, qr[ks], p1, 0, 0, 0);
                }
                float alpha;
                const float* brow = rpbL + (kr - r + 7) * 31 + 15 - c;
                if (isctx) na_softmax<0>(p0, p1, m_reg, l_reg, alpha, brow, c0, hi);
                else if (qb == 0) na_softmax<1>(p0, p1, m_reg, l_reg, alpha, brow, c0, hi);
                else na_softmax<2>(p0, p1, m_reg, l_reg, alpha, brow, c0, hi);
                bf16x8 pa0, pa1, pa2, pa3;
                PK4(p0, 0, pa0); PK4(p0, 8, pa1); PK4(p1, 0, pa2); PK4(p1, 8, pa3);
                if (__any(alpha < 1.f)) {
                    if (hi == 0) xch[r32] = alpha;
                    asm volatile("s_waitcnt lgkmcnt(0)" ::: "memory");
#pragma unroll
                    for (int q = 0; q < 16; ++q) { const float a = xch[crow(q, hi)]; o0[q] *= a; o1[q] *= a; }
                }
                const int vb = vb0 + b * VB;
                na_pv<0>(o0, o1, vb, pa0); na_pv<1>(o0, o1, vb, pa1); na_pv<2>(o0, o1, vb, pa2); na_pv<3>(o0, o1, vb, pa3);
            }
            if (ti + 1 < ntile) { if (b == 0) NA_WRITE(1, skA, svA); else NA_WRITE(0, skB, svB); }
            __syncthreads();
        }
#undef NA_LOAD
#undef NA_WRITE
        if (hi == 0) xch[32 + r32] = l_reg;
        asm volatile("s_waitcnt lgkmcnt(0)" ::: "memory");
        const size_t orow0 = (size_t)CTXN + (size_t)r * 64 + qb * 32;
#pragma unroll
        for (int q = 0; q < 16; ++q) {
            const int qi = crow(q, hi); const float il = __builtin_amdgcn_rcpf(xch[32 + qi]);
            bf16_t* dst = MIX + (orow0 + qi) * 1024 + h * 64;
            dst[r32] = f2bf(o0[q] * il); dst[32 + r32] = f2bf(o1[q] * il);
        }
        __syncthreads();
    }
}
#undef PK4

#define XB_TMO      128
#define XB_XCNT(j)  (256  + 64 * (j))
#define XB_XSUB(j)  (1280 + 64 * (j))
#define XB_XGEN(j)  (2304 + 64 * (j))
#define XB_TOP      3328
#define XB_TOPGEN   3392
#define XCD_BAR_WORDS 3456
#define XB_SPIN_CAP (1u << 22)
#define LAS __attribute__((address_space(3)))
__device__ __forceinline__ unsigned xb_ld(unsigned* p)              { return __hip_atomic_load(p, __ATOMIC_RELAXED, __HIP_MEMORY_SCOPE_AGENT); }
__device__ __forceinline__ unsigned xb_add(unsigned* p, unsigned v) { return __hip_atomic_fetch_add(p, v, __ATOMIC_RELAXED, __HIP_MEMORY_SCOPE_AGENT); }
__device__ __forceinline__ unsigned xb_xcc_id() { return (unsigned)__builtin_amdgcn_s_getreg((3 << 11) | 20) & 0xFu; }
#define XB_SPIN(cond, bar) do { unsigned _sp = 0; while (cond) { __builtin_amdgcn_s_sleep(1); \
    if ((++_sp & 255u) == 0u) { if (xb_ld(&(bar)[XB_TMO])) break; if (_sp > XB_SPIN_CAP) { atomicAdd(&(bar)[XB_TMO], 1u); break; } } } } while (0)
struct XcdBarrier { unsigned* bar; unsigned x; volatile LAS unsigned* st; };
__device__ __forceinline__ XcdBarrier xcd_barrier_post(unsigned* bar, volatile LAS unsigned* st) {
    XcdBarrier b; b.bar = bar; b.x = xb_xcc_id(); b.st = st;
    if (threadIdx.x == 0) (void)xb_add(&bar[XB_XCNT(b.x)], 1u);
    return b;
}
__device__ __forceinline__ void xcd_barrier_complete(unsigned* bar, unsigned x, unsigned& nloc, unsigned& nx) {
    const unsigned G = gridDim.x * gridDim.y * gridDim.z;
    unsigned sum, cnt, mine, sp = 0u;
    for (;;) {
        sum = 0u; cnt = 0u; mine = 0u;
#pragma unroll
        for (unsigned j = 0; j < 16; ++j) { const unsigned c = xb_ld(&bar[XB_XCNT(j)]); sum += c; cnt += (c > 0u) ? 1u : 0u; mine = (j == x) ? c : mine; }
        if (sum == G) break;
        __builtin_amdgcn_s_sleep(1);
        if ((++sp & 255u) == 0u) { if (xb_ld(&bar[XB_TMO])) break; if (sp > XB_SPIN_CAP) { atomicAdd(&bar[XB_TMO], 1u); break; } }
    }
    nloc = mine > 0u ? mine : 1u; nx = cnt > 0u ? cnt : 1u;
}
__device__ __forceinline__ void xcd_barrier(const XcdBarrier& b) {
    asm volatile("s_waitcnt vmcnt(0)" ::: "memory");
    __syncthreads();
    if (threadIdx.x == 0) {
        unsigned* bar = b.bar;
        __builtin_amdgcn_s_waitcnt(0);
        unsigned nloc = b.st[0], nx = b.st[1];
        if (nloc == 0u) { xcd_barrier_complete(bar, b.x, nloc, nx); b.st[0] = nloc; b.st[1] = nx; }
        const unsigned old = xb_add(&bar[XB_XSUB(b.x)], 1u);
        const unsigned gen = old / nloc;
        if (old + 1u == (gen + 1u) * nloc) {
            __builtin_amdgcn_fence(__ATOMIC_RELEASE, "agent");
            asm volatile("s_waitcnt vmcnt(0)" ::: "memory");
            const unsigned og = xb_add(&bar[XB_TOP], 1u);
            const unsigned tg = og / nx;
            if (og + 1u == (tg + 1u) * nx) xb_add(&bar[XB_TOPGEN], 1u);
            else XB_SPIN(xb_ld(&bar[XB_TOPGEN]) == tg, bar);
            __builtin_amdgcn_fence(__ATOMIC_ACQUIRE, "agent");
            xb_add(&bar[XB_XGEN(b.x)], 1u);
            asm volatile("s_waitcnt vmcnt(0)" ::: "memory");
        } else {
            XB_SPIN(xb_ld(&bar[XB_XGEN(b.x)]) == gen, bar);
            __builtin_amdgcn_fence(__ATOMIC_ACQUIRE, "agent");
            asm volatile("s_waitcnt vmcnt(0)" ::: "memory");
        }
    }
    __syncthreads();
}

__device__ __forceinline__ void run_phase(PRef p, int ph) {
#ifdef ONLY_PHASE
    if (ph != ONLY_PHASE) return;
    ph = ONLY_PHASE;
#endif
    const bf16_t* HB = (const bf16_t*)(p.ws + WS_HB);
    switch (ph) {
    case 0: phase_prologue(p); break;
    case 1: phase_norm1_l0(p); break;
    case 2: phase_gemm_pg8(HB, 1024, (const bf16_t*)(p.ws + WS_WIN), 1024, (bf16_t*)(p.ws + WS_P), PW, NTOK / 256, 8); break;
    case 3: phase_mla_up(p); break;
    case 4: break;
    case 5: phase_gla_scan(p); break;
    case 6: phase_mix0(p); break;
    case 7: phase_gemm_pg8((const bf16_t*)(p.ws + WS_MIX), 1024, (const bf16_t*)(p.ws + WS_WOUT0), 1024, (bf16_t*)(p.ws + WS_OB), 1024, NTOK / 256, 4); break;
    case 8: phase_mid(p, 0); break;
    case 9: phase_moe1(p, 0); break;
    case 10: phase_moe2(p, 0); break;
    case 11: phase_end(p, 0); break;
    case 12: phase_gemm_pg8(HB, 1024, (const bf16_t*)(p.ws + WS_WQKV), 1024, (bf16_t*)(p.ws + WS_P), 3072, NTOK / 256, 12); break;
    case 13: phase_na(p); break;
    case 14: phase_gemm_pg8((const bf16_t*)(p.ws + WS_MIX) + (size_t)CTXN * 1024, 1024, (const bf16_t*)(p.ws + WS_WNAO), 1024, (bf16_t*)(p.ws + WS_OB) + (size_t)CTXN * 1024, 1024, SEQ / 256, 4); break;
    case 15: phase_mid(p, 1); break;
    case 16: phase_moe1(p, 1); break;
    case 17: phase_moe2(p, 1); break;
    case 18: phase_end(p, 1); break;
    default: break;
    }
}
constexpr int N_PHASES = 19;

#if MK_LAUNCHES == 1
__global__ void __launch_bounds__(512) mega_kernel(Params p) {
    cg::grid_group grid = cg::this_grid();
    volatile LAS unsigned* xst = (volatile LAS unsigned*)(smem + LDS_BYTES - 16);
    if (threadIdx.x == 0) { xst[0] = 0u; xst[1] = 0u; xst[2] = 0u; xst[3] = 0u; }
    __syncthreads();
    XcdBarrier xb = xcd_barrier_post((unsigned*)(kparams()->ws + WS_BAR), xst);
    run_phase(*kparams(), 0); xcd_barrier(xb);
    if (kparams()->pad0 == 0x7fffffff) grid.sync();
    if (PROBE_REPEAT == 100) { run_phase(*kparams(), 0); xcd_barrier(xb); }
    if (PROBE_REPEAT == 61) { phase_gla_out(*kparams()); xcd_barrier(xb); }
#define PH_(n) run_phase(*kparams(), n); xcd_barrier(xb); if ((n) == PROBE_REPEAT) { run_phase(*kparams(), n); xcd_barrier(xb); }
    PH_(1) PH_(2) PH_(3) PH_(5) PH_(6) PH_(7) PH_(8) PH_(9) PH_(10) PH_(11) PH_(12) PH_(13) PH_(14) PH_(15) PH_(16) PH_(17)
    run_phase(*kparams(), 18);
#undef PH_
}
#else
template <int PH> __global__ void __launch_bounds__(512) phase_kernel(Params p) { run_phase(*kparams(), PH); }
typedef void (*phase_fn)(Params);
template <int PH> static bool launch_phase(PRef p, int grid, hipStream_t stream, bool setattr) {
    if (setattr && hipFuncSetAttribute((const void*)phase_kernel<PH>, hipFuncAttributeMaxDynamicSharedMemorySize, LDS_BYTES) != hipSuccess) return false;
    hipLaunchKernelGGL(phase_kernel<PH>, dim3(grid), dim3(NTH), LDS_BYTES, stream, p);
    return true;
}
#endif

extern "C" void kernel_launch(void* const* d_in, const int* in_sizes, int n_in, void* d_out, int out_size, void* d_ws, size_t ws_size, hipStream_t stream) {
    static int grid_blocks = 0;
    bool first = false;
    if (!grid_blocks) {
        if (ws_size < WS_END) { fprintf(stderr, "kernel_launch: workspace too small: %zu < %zu\n", ws_size, (size_t)WS_END); return; }
        int dev = 0, cus = 0;
        (void)hipGetDevice(&dev);
        (void)hipDeviceGetAttribute(&cus, hipDeviceAttributeMultiprocessorCount, dev);
#if MK_LAUNCHES == 1
        if (hipFuncSetAttribute((const void*)mega_kernel, hipFuncAttributeMaxDynamicSharedMemorySize, LDS_BYTES) != hipSuccess) { fprintf(stderr, "kernel_launch: LDS attribute failed\n"); return; }
        int per_cu = 0;
        (void)hipOccupancyMaxActiveBlocksPerMultiprocessor(&per_cu, (const void*)mega_kernel, NTH, LDS_BYTES);
        if (per_cu < 1) { fprintf(stderr, "kernel_launch: occupancy query returned %d\n", per_cu); return; }
#endif
        grid_blocks = cus;
        first = true;
    }
    Params p{};
    const float* const* in = (const float* const*)d_in;
    p.x = in[0]; p.c = in[1]; p.ctx = in[2]; p.c_ctx = in[3]; p.ada_w = in[4]; p.ada_b = in[5]; p.norm_g = in[6]; p.router_w = in[7]; p.router_b = in[8];
    p.moe_w1 = in[9]; p.moe_b1 = in[10]; p.moe_w2 = in[11]; p.moe_b2 = in[12]; p.ab_in_w = in[13]; p.gla_wa_f = in[14]; p.gla_ba_f = in[15]; p.gla_wa_b = in[16]; p.gla_ba_b = in[17];
    p.gla_onorm = in[18]; p.mla_qnorm = in[19]; p.mla_wuq = in[20]; p.mla_kvnorm = in[21]; p.mla_wukv = in[22]; p.ab_out_w = in[23]; p.na_qkv_w = in[24]; p.na_rpb = in[25]; p.na_out_w = in[26];
    p.out = (float*)d_out; p.ws = (char*)d_ws;
#if MK_LAUNCHES == 1
    (void)hipMemsetAsync((char*)d_ws + WS_BAR, 0, 16384, stream);
    void* args[] = {&p};
    hipError_t e = hipLaunchCooperativeKernel((const void*)mega_kernel, dim3(grid_blocks), dim3(NTH), args, LDS_BYTES, stream);
    if (e != hipSuccess) fprintf(stderr, "cooperative launch failed: %s (grid %d)\n", hipGetErrorString(e), grid_blocks);
#else
    const int g = grid_blocks;
    launch_phase<0>(p, g, stream, first); launch_phase<1>(p, g, stream, first); launch_phase<2>(p, g, stream, first); launch_phase<3>(p, g, stream, first);
    launch_phase<4>(p, g, stream, first); launch_phase<5>(p, g, stream, first); launch_phase<6>(p, g, stream, first); launch_phase<7>(p, g, stream, first);
    launch_phase<8>(p, g, stream, first); launch_phase<9>(p, g, stream, first); launch_phase<10>(p, g, stream, first); launch_phase<11>(p, g, stream, first);
    launch_phase<12>(p, g, stream, first); launch_phase<13>(p, g, stream, first); launch_phase<14>(p, g, stream, first); launch_phase<15>(p, g, stream, first);
    launch_phase<16>(p, g, stream, first); launch_phase<17>(p, g, stream, first); launch_phase<18>(p, g, stream, first);
#endif
}
```

```cpp
#include <hip/hip_runtime.h>
#include <hip/hip_cooperative_groups.h>
#include <cstdio>
#include <cstdint>
namespace cg = cooperative_groups;

#ifndef PROBE_REPEAT
#define PROBE_REPEAT -1
#endif
#ifndef MK_LAUNCHES
#define MK_LAUNCHES 1
#endif

typedef unsigned short bf16_t;
typedef short bf16x8 __attribute__((ext_vector_type(8)));
typedef short s16x4 __attribute__((ext_vector_type(4)));
typedef float f32x4 __attribute__((ext_vector_type(4)));
typedef float f32x16 __attribute__((ext_vector_type(16)));
typedef unsigned u32x4 __attribute__((ext_vector_type(4)));
typedef int i32x4 __attribute__((ext_vector_type(4)));
typedef unsigned u32x2 __attribute__((ext_vector_type(2)));

constexpr int SEQ = 16384, CTXN = 256, NTOK = SEQ + CTXN, DM = 1024;
constexpr int NEXP = 32, FF = 1024;
constexpr int PW = 2048;
constexpr int PC_Q = 0, PC_K = 256, PC_V = 512, PC_R = 1024, PC_AF = 1536, PC_AB = 1552, PC_CQ = 1568, PC_CKV = 1824, PC_KR = 1952;
constexpr int NCH = NTOK / 64;
constexpr int NTH = 512;
constexpr float EPSN = 1e-6f;
constexpr float LOG2E = 1.4426950408889634f;

constexpr size_t al256(size_t x) { return (x + 255) / 256 * 256; }
constexpr size_t WS_BAR   = 0;
constexpr size_t WS_CNT   = WS_BAR + 16384;
constexpr size_t WS_MOD   = WS_CNT + 1024;
constexpr size_t WS_ROPE  = WS_MOD + al256((size_t)2 * 2 * 6144 * 4);
constexpr size_t WS_RWT   = WS_ROPE + al256((size_t)(256 + 256 + 64 + 64) * 16 * 4);
constexpr size_t WS_WIN   = WS_RWT + al256((size_t)2 * 32 * 1024 * 4);
constexpr size_t WS_WUQ   = WS_WIN + (size_t)2048 * 1024 * 2;
constexpr size_t WS_WUKV  = WS_WUQ + (size_t)768 * 256 * 2;
constexpr size_t WS_WOUT0 = WS_WUKV + (size_t)1024 * 128 * 2;
constexpr size_t WS_WQKV  = WS_WOUT0 + (size_t)1024 * 1024 * 2;
constexpr size_t WS_WNAO  = WS_WQKV + (size_t)3072 * 1024 * 2;
constexpr size_t WS_W1T   = WS_WNAO + (size_t)1024 * 1024 * 2;
constexpr size_t WS_W2T   = WS_W1T + (size_t)2 * 32 * 2048 * 1024 * 2;
constexpr size_t WS_Q8    = WS_W1T + (size_t)2 * 32 * 2048 * 1024;
constexpr size_t WS_K8    = WS_Q8 + (size_t)NTOK * 768;
constexpr size_t WS_VT8   = WS_K8 + (size_t)NTOK * 768;
static_assert(WS_VT8 + (size_t)NTOK * 512 <= WS_W2T, "fp8 MLA operands overflow the W1T region");
constexpr size_t WS_HB    = WS_W2T + (size_t)2 * 32 * 1024 * 1024 * 2;
constexpr size_t WS_P     = WS_HB + (size_t)NTOK * 1024 * 2;
constexpr size_t WS_QM    = WS_P + (size_t)NTOK * 3072 * 2;
constexpr size_t WS_KM    = WS_QM + (size_t)NTOK * 768 * 2;
constexpr size_t WS_VM    = WS_KM + (size_t)NTOK * 768 * 2;
constexpr size_t WS_U     = WS_VM + (size_t)NTOK * 512 * 2;
constexpr size_t WS_SIN   = WS_U + (size_t)2 * NCH * 4 * 128 * 64 * 2;
constexpr size_t WS_DEC   = WS_SIN + (size_t)2 * NCH * 4 * 128 * 64 * 2;
constexpr size_t WS_MIX   = WS_DEC + al256((size_t)2 * NCH * 4 * 64 * 4);
constexpr size_t WS_OB    = WS_MIX + (size_t)NTOK * 1024 * 2;
constexpr size_t WS_X1    = WS_OB + (size_t)NTOK * 1024 * 2;
constexpr size_t WS_X2    = WS_X1 + (size_t)NTOK * 1024 * 4;
constexpr size_t WS_TOPE  = WS_X2 + (size_t)NTOK * 1024 * 4;
constexpr size_t WS_TOPP  = WS_TOPE + al256((size_t)NTOK * 4 * 4);
constexpr size_t WS_GATE  = WS_TOPP + al256((size_t)NTOK * 4 * 4);
constexpr size_t WS_LIST  = WS_GATE + al256((size_t)NTOK * 4 * 4);
constexpr size_t WS_ACT   = WS_LIST + al256((size_t)32 * NTOK * 4);
constexpr size_t WS_YB    = WS_ACT + (size_t)(NTOK * 4 + 256) * 1024 * 2;
constexpr size_t WS_END   = WS_YB + (size_t)(NTOK * 4) * 1024 * 2;

constexpr int LDS_BYTES = 160 * 1024;
extern __shared__ __attribute__((aligned(16))) char smem[];

struct Params {
    const float *x, *c, *ctx, *c_ctx, *ada_w, *ada_b, *norm_g, *router_w, *router_b, *moe_w1, *moe_b1, *moe_w2, *moe_b2;
    const float *ab_in_w, *gla_wa_f, *gla_ba_f, *gla_wa_b, *gla_ba_b, *gla_onorm, *mla_qnorm, *mla_wuq, *mla_kvnorm, *mla_wukv;
    const float *ab_out_w, *na_qkv_w, *na_rpb, *na_out_w;
    float* out; char* ws;
    int pad0, pad1;
};
typedef const __attribute__((address_space(4))) Params& PRef;
typedef const __attribute__((address_space(4))) Params* KPtr;
__device__ __forceinline__ KPtr kparams() { KPtr k = (KPtr)__builtin_amdgcn_kernarg_segment_ptr(); asm volatile("" : "+s"(k)); return k; }

__device__ __forceinline__ float bf2f(bf16_t h) { return __uint_as_float(((unsigned)h) << 16); }
__device__ __forceinline__ bf16_t f2bf(float f) { unsigned u = __float_as_uint(f); u += 0x7FFFu + ((u >> 16) & 1u); return (bf16_t)(u >> 16); }
__device__ __forceinline__ unsigned cvtpk(float lo, float hi) { unsigned r; asm volatile("v_cvt_pk_bf16_f32 %0, %1, %2" : "=v"(r) : "v"(lo), "v"(hi)); return r; }
__device__ __forceinline__ float wave_sum(float v) {
#pragma unroll
    for (int o = 32; o >= 1; o >>= 1) v += __shfl_xor(v, o);
    return v;
}
__device__ __forceinline__ int crow(int r, int hi) { return (r & 3) + 8 * (r >> 2) + 4 * hi; }
__device__ __forceinline__ float silu_f(float x) { return x / (1.f + __expf(-x)); }
#define SBAR() __builtin_amdgcn_sched_barrier(0)
__device__ __forceinline__ unsigned pk4_fp8(float a, float b, float c, float d) {
    a = __builtin_amdgcn_fmed3f(a, -448.f, 448.f); b = __builtin_amdgcn_fmed3f(b, -448.f, 448.f); c = __builtin_amdgcn_fmed3f(c, -448.f, 448.f); d = __builtin_amdgcn_fmed3f(d, -448.f, 448.f);
    int r = __builtin_amdgcn_cvt_pk_fp8_f32(a, b, 0, false); r = __builtin_amdgcn_cvt_pk_fp8_f32(c, d, r, true); return (unsigned)r; }
__device__ __forceinline__ int tid_opaque() { int t = threadIdx.x; asm volatile("" : "+v"(t)); return t; }

struct ConvJob { const float* src; bf16_t* dst; const float* gain; int K, Nsrc, kt, nt, mode, f8; };
constexpr int CONV8_RS = 264;
constexpr float W8_SCALE = 64.f;
__device__ __forceinline__ void conv_load(const ConvJob& jb, float4 (&v)[16]) {
    const int tid = threadIdx.x, n4 = tid & 63, kr = tid >> 6, n = jb.nt * 256 + n4 * 4;
    const float* q = jb.src + (size_t)(jb.kt * 128 + kr) * jb.Nsrc + n;
#pragma unroll
    for (int i = 0; i < 16; ++i) { if (n < jb.Nsrc) { const f32x4 t = __builtin_nontemporal_load((const f32x4*)(q + (size_t)(8 * i) * jb.Nsrc)); v[i] = make_float4(t[0], t[1], t[2], t[3]); } else v[i] = make_float4(0.f, 0.f, 0.f, 0.f); }
}
__device__ __forceinline__ void conv_to_lds(const ConvJob& jb, const float4 (&v)[16]) {
    bf16_t* T = (bf16_t*)smem;
    const int tid = threadIdx.x, n4 = tid & 63, kr = tid >> 6;
#pragma unroll
    for (int i = 0; i < 16; ++i) {
        const int k = kr + 8 * i;
        float4 w = v[i];
        if (jb.mode == 1) { const float g = jb.gain[jb.kt * 128 + k]; w.x *= g; w.y *= g; w.z *= g; w.w *= g; }
        if (jb.f8) { *(unsigned*)((char*)smem + k * CONV8_RS + n4 * 4) = pk4_fp8(w.x * W8_SCALE, w.y * W8_SCALE, w.z * W8_SCALE, w.w * W8_SCALE); continue; }
        u32x2 pk; pk.x = cvtpk(w.x, w.y); pk.y = cvtpk(w.z, w.w);
        *(u32x2*)(T + k * 260 + n4 * 4) = pk;
    }
}
__device__ __forceinline__ void conv_readout(const ConvJob& jb) {
    const bf16_t* T = (const bf16_t*)smem;
    const int tid = threadIdx.x, k0 = jb.kt * 128;
    if (jb.f8) {
        const unsigned char* T8 = (const unsigned char*)smem;
#pragma unroll
        for (int i = 0; i < 4; ++i) {
            const int cc = tid + 512 * i, nn = cc >> 3, kc = cc & 7;
            const int col = (jb.mode == 2) ? (2 * (nn & 127) + (nn >> 7)) : nn;
            unsigned e[16];
#pragma unroll
            for (int j = 0; j < 16; ++j) e[j] = T8[(kc * 16 + j) * CONV8_RS + col];
            u32x4 o;
#pragma unroll
            for (int q = 0; q < 4; ++q) o[q] = e[4 * q] | (e[4 * q + 1] << 8) | (e[4 * q + 2] << 16) | (e[4 * q + 3] << 24);
            __builtin_nontemporal_store(o, (u32x4*)((char*)jb.dst + (size_t)(jb.nt * 256 + nn) * jb.K + k0 + kc * 16));
        }
        return;
    }
#pragma unroll
    for (int i = 0; i < 8; ++i) {
        const int cc = tid + 512 * i, nn = cc >> 4, kc = cc & 15;
        const int col = (jb.mode == 2) ? (2 * (nn & 127) + (nn >> 7)) : nn;
        unsigned short e[8];
#pragma unroll
        for (int j = 0; j < 8; ++j) e[j] = T[(kc * 8 + j) * 260 + col];
        u32x4 o; o.x = e[0] | ((unsigned)e[1] << 16); o.y = e[2] | ((unsigned)e[3] << 16); o.z = e[4] | ((unsigned)e[5] << 16); o.w = e[6] | ((unsigned)e[7] << 16);
        __builtin_nontemporal_store(o, (u32x4*)(jb.dst + (size_t)(jb.nt * 256 + nn) * jb.K + k0 + kc * 8));
    }
}

__device__ __forceinline__ void adaln_job(PRef p, int job) {
    const int l = job / 24, cb = (job % 24) * 256, tid = threadIdx.x;
    float* sv = (float*)smem;
    for (int i = tid; i < 2048; i += NTH) { const int k = i & 1023; const float xx = (i < 1024) ? p.c[k] : p.c_ctx[k]; sv[i] = silu_f(xx); }
    __syncthreads();
    const int col4 = tid & 63, kq = tid >> 6;
    float4 a0 = make_float4(0, 0, 0, 0), a1 = make_float4(0, 0, 0, 0);
    const float* w = p.ada_w + ((size_t)l * 1024 + kq * 128) * 6144 + cb + col4 * 4;
#pragma unroll 8
    for (int k = 0; k < 128; ++k) {
        const float4 wv = *(const float4*)(w + (size_t)k * 6144);
        const float s0 = sv[kq * 128 + k], s1 = sv[1024 + kq * 128 + k];
        a0.x += s0 * wv.x; a0.y += s0 * wv.y; a0.z += s0 * wv.z; a0.w += s0 * wv.w;
        a1.x += s1 * wv.x; a1.y += s1 * wv.y; a1.z += s1 * wv.z; a1.w += s1 * wv.w;
    }
    float* red = sv + 2048;
    *(float4*)(red + (kq * 2 + 0) * 256 + col4 * 4) = a0;
    *(float4*)(red + (kq * 2 + 1) * 256 + col4 * 4) = a1;
    __syncthreads();
    {
        const int s = tid >> 8, col = tid & 255;
        float acc = p.ada_b[l * 6144 + cb + col];
#pragma unroll
        for (int q = 0; q < 8; ++q) acc += red[(q * 2 + s) * 256 + col];
        ((float*)(p.ws + WS_MOD))[(l * 2 + s) * 6144 + cb + col] = acc;
    }
    __syncthreads();
}

__device__ __forceinline__ void tables_job(PRef p) {
    float* rope = (float*)(p.ws + WS_ROPE);
    const int tid = threadIdx.x;
    for (int i = tid; i < (256 + 64) * 16; i += NTH) {
        const bool isrow = i < 256 * 16;
        const int idx = isrow ? i : i - 256 * 16, pos = idx >> 4, j = idx & 15;
        const float inv = exp2f(-(float)j * (13.287712379549449f / 16.f));
        const float ang = (float)pos * inv;
        float rev = ang * 0.15915494309189535f; rev -= rintf(rev);
        const float cs = __builtin_amdgcn_cosf(rev), sn = __builtin_amdgcn_sinf(rev);
        if (isrow) { rope[idx] = cs; rope[256 * 16 + idx] = sn; }
        else { rope[512 * 16 + idx] = cs; rope[512 * 16 + 64 * 16 + idx] = sn; }
    }
    if (tid < 64) ((int*)(p.ws + WS_CNT))[tid] = 0;
}
__device__ __forceinline__ void rwt_job(PRef p, int l) {
    float* dst = (float*)(p.ws + WS_RWT) + (size_t)l * 32 * 1024;
    const float* src = p.router_w + (size_t)l * 1024 * 32;
    for (int i = threadIdx.x; i < 32 * 1024; i += NTH) { const int cch = i >> 5, e = i & 31; dst[e * 1024 + cch] = src[i]; }
}

constexpr int J_IN = 8 * 8, J_UQ = 2 * 3, J_UKV = 1 * 4, J_OUT0 = 32, J_QKV = 8 * 12, J_NAO = 32, J_W1 = 64 * 64, J_W2 = 64 * 32;
constexpr int J_TOTAL = J_IN + J_UQ + J_UKV + J_OUT0 + J_QKV + J_NAO + J_W1 + J_W2;
__device__ __forceinline__ ConvJob conv_decode(PRef p, int j) {
    ConvJob jb; jb.gain = nullptr; jb.mode = 0; jb.f8 = 0;
    int t = j;
    if (t < J_W1) { const int m = t >> 6, q = t & 63; jb.src = p.moe_w1 + (size_t)m * 1024 * 2048; jb.dst = (bf16_t*)(p.ws + WS_W1T + (size_t)m * 2048 * 1024); jb.K = 1024; jb.Nsrc = 2048; jb.kt = q >> 3; jb.nt = q & 7; jb.mode = 2; jb.f8 = 1; return jb; } t -= J_W1;
    if (t < J_W2) { const int m = t >> 5, q = t & 31; jb.src = p.moe_w2 + (size_t)m * 1024 * 1024; jb.dst = (bf16_t*)(p.ws + WS_W2T + (size_t)m * 1024 * 1024); jb.K = 1024; jb.Nsrc = 1024; jb.kt = q >> 2; jb.nt = q & 3; jb.f8 = 1; return jb; } t -= J_W2;
    if (t < J_IN) { jb.src = p.ab_in_w; jb.dst = (bf16_t*)(p.ws + WS_WIN); jb.K = 1024; jb.Nsrc = 2016; jb.kt = t / 8; jb.nt = t % 8; return jb; } t -= J_IN;
    if (t < J_UQ) { jb.src = p.mla_wuq; jb.dst = (bf16_t*)(p.ws + WS_WUQ); jb.K = 256; jb.Nsrc = 768; jb.kt = t / 3; jb.nt = t % 3; jb.mode = 1; jb.gain = p.mla_qnorm; return jb; } t -= J_UQ;
    if (t < J_UKV) { jb.src = p.mla_wukv; jb.dst = (bf16_t*)(p.ws + WS_WUKV); jb.K = 128; jb.Nsrc = 1024; jb.kt = 0; jb.nt = t; jb.mode = 1; jb.gain = p.mla_kvnorm; return jb; } t -= J_UKV;
    if (t < J_OUT0) { jb.src = p.ab_out_w; jb.dst = (bf16_t*)(p.ws + WS_WOUT0); jb.K = 1024; jb.Nsrc = 1024; jb.kt = t / 4; jb.nt = t % 4; return jb; } t -= J_OUT0;
    if (t < J_QKV) { jb.src = p.na_qkv_w; jb.dst = (bf16_t*)(p.ws + WS_WQKV); jb.K = 1024; jb.Nsrc = 3072; jb.kt = t / 12; jb.nt = t % 12; return jb; } t -= J_QKV;
    jb.src = p.na_out_w; jb.dst = (bf16_t*)(p.ws + WS_WNAO); jb.K = 1024; jb.Nsrc = 1024; jb.kt = t / 4; jb.nt = t % 4; return jb;
}

__device__ __forceinline__ void phase_prologue(PRef p) {
    const int G = gridDim.x, b = blockIdx.x;
    for (int j = b; j < 51; j += G) {
        if (j < 48) adaln_job(p, j);
        else if (j == 48) tables_job(p);
        else rwt_job(p, j - 49);
    }
    __syncthreads();
    int j = b;
    if (j >= J_TOTAL) return;
    ConvJob cur = conv_decode(p, j);
    float4 v[16];
    conv_load(cur, v);
    for (;;) {
        conv_to_lds(cur, v);
        __syncthreads();
        const int jn = j + G;
        ConvJob nxt = cur;
        if (jn < J_TOTAL) { nxt = conv_decode(p, jn); conv_load(nxt, v); }
        conv_readout(cur);
        __syncthreads();
        if (jn >= J_TOTAL) break;
        cur = nxt; j = jn;
    }
}

namespace gm {
constexpr int BK = 64, HT = 128 * 64;
__device__ __forceinline__ int lds_byte(int r, int c) { const int st = (r >> 4) * 2 + (c >> 5), rr = r & 15, cc = c & 31, ob = rr * 64 + cc * 2; return st * 1024 + (ob ^ (((ob >> 9) & 1) << 5)); }
__device__ __forceinline__ void stage_rc(int b, int& R, int& C) { const int st = b / 1024, sb = b % 1024, swz = sb ^ (((sb >> 9) & 1) << 5); R = (st >> 1) * 16 + swz / 64; C = (st & 1) * 32 + (swz % 64) / 2; }

template <class Epi>
__device__ __forceinline__ void gemm_tile(const bf16_t* __restrict__ A, const int (&aoff)[2][2], const bf16_t* __restrict__ Bt, const int (&boff)[2], int nk, Epi& epi) {
    bf16_t* shm = (bf16_t*)smem;
    const int tid = tid_opaque(), wid = tid >> 6, lane = tid & 63, wr = wid >> 1, wc = wid & 1, fr = lane & 15, fq = lane >> 4;
    f32x4 acc[4][4];
#pragma unroll
    for (int m = 0; m < 4; ++m)
#pragma unroll
        for (int n = 0; n < 4; ++n) acc[m][n] = (f32x4){0.f, 0.f, 0.f, 0.f};
#define GM_STAGE(buf, kt) do { \
        _Pragma("unroll") for (int _i = 0; _i < 2; ++_i) { \
            __builtin_amdgcn_global_load_lds((const unsigned*)(A + aoff[0][_i] + (kt) * BK), (unsigned*)((char*)(shm + ((buf) * 3 + 0) * HT) + tid * 16 + _i * 8192), 16, 0, 0); \
            __builtin_amdgcn_global_load_lds((const unsigned*)(A + aoff[1][_i] + (kt) * BK), (unsigned*)((char*)(shm + ((buf) * 3 + 1) * HT) + tid * 16 + _i * 8192), 16, 0, 0); \
            __builtin_amdgcn_global_load_lds((const unsigned*)(Bt + boff[_i] + (kt) * BK), (unsigned*)((char*)(shm + ((buf) * 3 + 2) * HT) + tid * 16 + _i * 8192), 16, 0, 0); } } while (0)
    GM_STAGE(0, 0);
    for (int kt = 0; kt < nk; ++kt) {
        __syncthreads();
        const int buf = kt & 1;
        if (kt + 1 < nk) GM_STAGE(buf ^ 1, kt + 1);
        const char* Ab = (const char*)(shm + (buf * 3 + (wr >> 1)) * HT);
        const char* Bb = (const char*)(shm + (buf * 3 + 2) * HT);
#pragma unroll
        for (int k = 0; k < 2; ++k) {
            bf16x8 Bf[4], Af[4];
#pragma unroll
            for (int n = 0; n < 4; ++n) Bf[n] = *(const bf16x8*)(Bb + lds_byte(wc * 64 + n * 16 + fr, k * 32 + fq * 8));
#pragma unroll
            for (int m = 0; m < 4; ++m) Af[m] = *(const bf16x8*)(Ab + lds_byte((wr & 1) * 64 + m * 16 + fr, k * 32 + fq * 8));
#pragma unroll
            for (int m = 0; m < 4; ++m)
#pragma unroll
                for (int n = 0; n < 4; ++n) acc[m][n] = __builtin_amdgcn_mfma_f32_16x16x32_bf16(Af[m], Bf[n], acc[m][n], 0, 0, 0);
        }
    }
#undef GM_STAGE
    float* stg = (float*)smem;
    __syncthreads();
    {
        float* wb = stg + (wr * 64 + fq * 4) * 132 + wc * 64 + fr;
#pragma unroll
        for (int m = 0; m < 4; ++m)
#pragma unroll
            for (int n = 0; n < 4; ++n)
#pragma unroll
                for (int j = 0; j < 4; ++j) wb[(m * 16 + j) * 132 + n * 16] = acc[m][n][j];
    }
    __syncthreads();
    if (Epi::MOE1) {
        const int fch = tid & 7, rg = tid >> 3;
        for (int ps = 0; ps < 4; ++ps) {
            const int row = ps * 64 + rg;
            const float* q = stg + row * 132 + (fch >> 1) * 32 + (fch & 1) * 8;
            float g[8], l[8];
            *(f32x4*)&g[0] = *(const f32x4*)q; *(f32x4*)&g[4] = *(const f32x4*)(q + 4);
            *(f32x4*)&l[0] = *(const f32x4*)(q + 16); *(f32x4*)&l[4] = *(const f32x4*)(q + 20);
            epi.pair(row, fch * 8, g, l);
        }
    } else {
        const int ch = tid & 15, rg = tid >> 4;
        for (int ps = 0; ps < 8; ++ps) {
            const int row = ps * 32 + rg;
            const float* q = stg + row * 132 + ch * 8;
            float v[8];
            *(f32x4*)&v[0] = *(const f32x4*)q; *(f32x4*)&v[4] = *(const f32x4*)(q + 4);
            epi.row8(row, ch * 8, v);
        }
    }
    __syncthreads();
}
__device__ __forceinline__ void make_off(int (&off)[2][2], int row0, int ld) {
#pragma unroll
    for (int h = 0; h < 2; ++h)
#pragma unroll
        for (int i = 0; i < 2; ++i) { int R, C; stage_rc(tid_opaque() * 16 + i * 8192, R, C); off[h][i] = (row0 + h * 128 + R) * ld + C; }
}
__device__ __forceinline__ void make_off1(int (&off)[2], int row0, int ld) {
#pragma unroll
    for (int i = 0; i < 2; ++i) { int R, C; stage_rc(tid_opaque() * 16 + i * 8192, R, C); off[i] = (row0 + R) * ld + C; }
}
}

namespace pg8 {
#define PG8_LAS __attribute__((address_space(3)))
constexpr int BM = 256, BK = 64, HALF = 128, HTB = HALF * BK * 2, STAGE_BYTES = 8 * HTB, NXCD = 8, WGM = 8;
__device__ __forceinline__ int lds_byte(int r, int c) { const int st = (r >> 4) * 2 + (c >> 5), rr = r & 15, cc = c & 31, ob = rr * 64 + cc * 2; return st * 1024 + (ob ^ (((ob >> 9) & 1) << 5)); }
__device__ __forceinline__ void stage_rc(int b, int& R, int& C) { const int st = b / 1024, sb = b % 1024, swz = sb ^ (((sb >> 9) & 1) << 5); R = (st >> 1) * 16 + swz / 64; C = (st & 1) * 32 + (swz % 64) / 2; }
__device__ __forceinline__ int perm32(int rho) { const int n = rho >> 4, i = rho & 15; return 8 * (i >> 2) + 4 * n + (i & 3); }
struct Unit { int pm, pn, e, nvalid, slot0; };

template <class Epi, class Sched, bool GATHER, bool F8 = false>
__device__ __forceinline__ void gemm_phase(PG8_LAS unsigned char* lds, const Sched& S, const Epi& E, int K, int lda, int ldb, int scA = 0x7F7F7F7F, int scB = 0x7F7F7F7F) {
    const int tid = tid_opaque(), wid = __builtin_amdgcn_readfirstlane(tid >> 6), lane = tid & 63, wr = wid >> 2, wc = wid & 3, fr = lane & 15, fq = lane >> 4;
    const int nt = K / BK;
    unsigned voffA[2], voffB[2]; int gR[2], gC[2];
#pragma unroll
    for (int i = 0; i < 2; ++i) { int R, C; stage_rc(tid * 16 + i * 8192, R, C); const int Rb = Epi::PERM ? ((R & ~31) + perm32(R & 31)) : R;
        voffA[i] = (unsigned)(R * lda + C) * 2u; voffB[i] = (unsigned)(Rb * ldb + C) * 2u; gR[i] = R; gC[i] = C * 2; }
    const size_t kstep = (size_t)(BK * 2);
    const size_t hstepA = (size_t)HALF * lda * 2, hstepB = (size_t)HALF * ldb * 2;
    const unsigned ldsw = (unsigned)wid * 1024u;
    const int aoff = lds_byte(wr * 64 + fr, fq * 8), boff = lds_byte(wc * 32 + fr, fq * 8);
    unsigned gA[2][2] = {{0u, 0u}, {0u, 0u}};
#define PG8_SA(b, h) (((b) * 2 + (h)) * HTB)
#define PG8_SB(b, h) ((4 + (b) * 2 + (h)) * HTB)
#define PG8_STAGE(bufoff, gbase, voff) do { _Pragma("unroll") for (int _i = 0; _i < 2; ++_i) \
        __builtin_amdgcn_global_load_lds((const unsigned*)((const char*)(gbase) + (voff)[_i]), (PG8_LAS unsigned*)(lds + (bufoff) + ldsw + _i * 8192), 16, 0, 0); } while (0)
#define PG8_STAGE_A(bufoff, base, h) do { if constexpr (GATHER) PG8_STAGE(bufoff, base, gA[h]); else PG8_STAGE(bufoff, (base) + (h) * hstepA, voffA); } while (0)
#define PG8_LDA(dst, b, h) do { _Pragma("unroll") for (int m = 0; m < 4; ++m) _Pragma("unroll") for (int k = 0; k < 2; ++k) dst[m][k] = *(const PG8_LAS bf16x8*)(lds + PG8_SA(b, h) + aoff + m * 2048 + k * 1024); } while (0)
#define PG8_LDB(dst, b, h) do { _Pragma("unroll") for (int n = 0; n < 2; ++n) _Pragma("unroll") for (int k = 0; k < 2; ++k) dst[n][k] = *(const PG8_LAS bf16x8*)(lds + PG8_SB(b, h) + boff + n * 2048 + k * 1024); } while (0)
#define PG8_MMA(ai, bj, At, Bt) do { __builtin_amdgcn_s_setprio(1); _Pragma("unroll") for (int m = 0; m < 4; ++m) _Pragma("unroll") for (int n = 0; n < 2; ++n) { \
        if constexpr (F8) { const i32x4 _b0 = __builtin_bit_cast(i32x4, Bt[n][0]), _b1 = __builtin_bit_cast(i32x4, Bt[n][1]), _a0 = __builtin_bit_cast(i32x4, At[m][0]), _a1 = __builtin_bit_cast(i32x4, At[m][1]); \
            acc[ai][bj][m][n] = __builtin_amdgcn_mfma_scale_f32_16x16x128_f8f6f4(__builtin_shufflevector(_b0, _b1, 0, 1, 2, 3, 4, 5, 6, 7), __builtin_shufflevector(_a0, _a1, 0, 1, 2, 3, 4, 5, 6, 7), acc[ai][bj][m][n], 0, 0, 0, scB, 0, scA); } \
        else { _Pragma("unroll") for (int k = 0; k < 2; ++k) acc[ai][bj][m][n] = __builtin_amdgcn_mfma_f32_16x16x32_bf16(Bt[n][k], At[m][k], acc[ai][bj][m][n], 0, 0, 0); } } __builtin_amdgcn_s_setprio(0); } while (0)
#define PG8_WAIT_V(n) asm volatile("s_waitcnt vmcnt(" #n ")" ::: "memory")
#define PG8_WAIT_L(n) asm volatile("s_waitcnt lgkmcnt(" #n ")" ::: "memory")
#define PG8_BAR __builtin_amdgcn_s_barrier()
#define PG8_SCHED __builtin_amdgcn_sched_barrier(0)
#define PG8_GLOAD(ui_) do { const PG8_LAS int* _gl = S.glist(ui_); _Pragma("unroll") for (int _h = 0; _h < 2; ++_h) _Pragma("unroll") for (int _i = 0; _i < 2; ++_i) \
        gA[_h][_i] = ((unsigned)_gl[_h * 128 + gR[_i]] << (F8 ? 10 : 11)) + (unsigned)gC[_i]; } while (0)
    Unit cur, nxt; int ui = 0;
    if (!S.next(0, cur)) return;
    f32x4 acc[2][2][4][2];
#pragma unroll
    for (int a = 0; a < 2; ++a)
#pragma unroll
        for (int b = 0; b < 2; ++b)
#pragma unroll
            for (int m = 0; m < 4; ++m)
#pragma unroll
                for (int n = 0; n < 2; ++n) acc[a][b][m][n] = (f32x4){0.f, 0.f, 0.f, 0.f};
    bf16x8 At[4][2], B0[2][2], B1[2][2];
    const char* cA = S.a_base(cur); const char* cB = S.b_base(cur);
    if constexpr (GATHER) PG8_GLOAD(0);
    PG8_STAGE(PG8_SB(0, 0), cB, voffB); PG8_STAGE_A(PG8_SA(0, 0), cA, 0); PG8_STAGE(PG8_SB(0, 1), cB + hstepB, voffB); PG8_STAGE_A(PG8_SA(0, 1), cA, 1);
    if (wr == 1) PG8_BAR;
    PG8_WAIT_V(4); PG8_BAR;
    PG8_STAGE(PG8_SB(1, 0), cB + kstep, voffB); PG8_STAGE_A(PG8_SA(1, 0), cA + kstep, 0); PG8_STAGE(PG8_SB(1, 1), cB + hstepB + kstep, voffB);
    PG8_WAIT_V(6); PG8_BAR;
    for (;;) {
        const bool has_next = S.next(ui + 1, nxt);
        const char* nA = has_next ? S.a_base(nxt) : cA; const char* nB = has_next ? S.b_base(nxt) : cB;
#pragma unroll 1
        for (int t = 0; t < nt; t += 2) {
            const bool last = (t == nt - 2);
            const char* a1 = cA + (size_t)(t + 1) * kstep;
            const char* a2 = last ? nA : cA + (size_t)(t + 2) * kstep; const char* b2 = last ? nB : cB + (size_t)(t + 2) * kstep;
            const char* a3 = a2 + kstep; const char* b3 = b2 + kstep;
            PG8_LDB(B0, 0, 0); PG8_SCHED; PG8_LDA(At, 0, 0); PG8_STAGE_A(PG8_SA(1, 1), a1, 1);
            PG8_WAIT_L(8); PG8_BAR; PG8_WAIT_L(0); PG8_MMA(0, 0, At, B0); PG8_BAR; PG8_SCHED;
            if constexpr (GATHER) { if (last && has_next) PG8_GLOAD(ui + 1); }
            PG8_LDB(B1, 0, 1); PG8_STAGE(PG8_SB(0, 0), b2, voffB);
            PG8_BAR; PG8_WAIT_L(0); PG8_MMA(0, 1, At, B1); PG8_BAR;
            PG8_LDA(At, 0, 1); PG8_STAGE_A(PG8_SA(0, 0), a2, 0);
            PG8_BAR; PG8_WAIT_L(0); PG8_MMA(1, 0, At, B0); PG8_BAR; PG8_SCHED;
            PG8_STAGE(PG8_SB(0, 1), b2 + hstepB, voffB);
            PG8_WAIT_V(6); PG8_BAR; PG8_MMA(1, 1, At, B1); PG8_BAR;
            PG8_LDB(B0, 1, 0); PG8_SCHED; PG8_LDA(At, 1, 0); PG8_STAGE_A(PG8_SA(0, 1), a2, 1);
            PG8_WAIT_L(8); PG8_BAR; PG8_WAIT_L(0); PG8_MMA(0, 0, At, B0); PG8_BAR; PG8_SCHED;
            PG8_LDB(B1, 1, 1); PG8_STAGE(PG8_SB(1, 0), b3, voffB);
            PG8_BAR; PG8_WAIT_L(0); PG8_MMA(0, 1, At, B1); PG8_BAR;
            PG8_LDA(At, 1, 1); PG8_STAGE_A(PG8_SA(1, 0), a3, 0);
            PG8_BAR; PG8_WAIT_L(0); PG8_MMA(1, 0, At, B0); PG8_BAR; PG8_SCHED;
            PG8_STAGE(PG8_SB(1, 1), b3 + hstepB, voffB);
            PG8_WAIT_V(6); PG8_BAR; PG8_MMA(1, 1, At, B1); PG8_BAR;
        }
        { int fr_e = fr, fq_e = fq; asm volatile("" : "+v"(fr_e), "+v"(fq_e));
          E(acc, cur, wr, wc, fr_e, fq_e); }
        if (!has_next) break;
#pragma unroll
        for (int a = 0; a < 2; ++a)
#pragma unroll
            for (int b = 0; b < 2; ++b)
#pragma unroll
                for (int m = 0; m < 4; ++m)
#pragma unroll
                    for (int n = 0; n < 2; ++n) acc[a][b][m][n] = (f32x4){0.f, 0.f, 0.f, 0.f};
        cur = nxt; cA = nA; cB = nB; ++ui;
    }
    PG8_WAIT_V(0);
    if (wr == 0) PG8_BAR;
    PG8_BAR;
#undef PG8_SA
#undef PG8_SB
#undef PG8_STAGE
#undef PG8_STAGE_A
#undef PG8_LDA
#undef PG8_LDB
#undef PG8_MMA
#undef PG8_WAIT_V
#undef PG8_WAIT_L
#undef PG8_BAR
#undef PG8_SCHED
#undef PG8_GLOAD
}

struct PlainOrder {
    const char* A; const char* Bt; int lda, ldb, nM, nN, nwg, G, c;
    __device__ void init(const bf16_t* A_, int lda_, const bf16_t* Bt_, int ldb_, int nM_, int nN_) { A = (const char*)A_; Bt = (const char*)Bt_; lda = lda_; ldb = ldb_; nM = nM_; nN = nN_; nwg = nM * nN; G = gridDim.x; c = blockIdx.x; }
    __device__ __forceinline__ bool next(int i, Unit& u) const {
        const long L = (long)i * G + c; if (L >= nwg) return false;
        int wgid = (int)L; { const int q = nwg / NXCD, r = nwg % NXCD, xcd = wgid % NXCD, off = wgid / NXCD; wgid = (xcd < r ? xcd * (q + 1) : r * (q + 1) + (xcd - r) * q) + off; }
        const int nig = WGM * nN, gid = wgid / nig, fm = gid * WGM, gsz = (nM - fm) < WGM ? (nM - fm) : WGM;
        u.pm = fm + ((wgid % nig) % gsz); u.pn = (wgid % nig) / gsz; u.e = 0; u.nvalid = 256; u.slot0 = 0; return true;
    }
    __device__ __forceinline__ const char* a_base(const Unit& u) const { return A + (size_t)u.pm * 256 * lda * 2; }
    __device__ __forceinline__ const char* b_base(const Unit& u) const { return Bt + (size_t)u.pn * 256 * ldb * 2; }
    __device__ __forceinline__ const PG8_LAS int* glist(int) const { return nullptr; }
};
struct MoeOrder {
    const char* A; const char* W; const PG8_LAS int* tab; const PG8_LAS int* gl; int wrows, nunits;
    __device__ __forceinline__ bool next(int i, Unit& u) const {
        if (i >= nunits) return false;
        const PG8_LAS int* t = tab + i * 8;
        u.pm = t[0]; u.pn = t[1]; u.e = t[2]; u.nvalid = t[3]; u.slot0 = t[4]; return true;
    }
    __device__ __forceinline__ const char* a_base(const Unit& u) const { return A + (size_t)u.slot0 * 1024; }
    __device__ __forceinline__ const char* b_base(const Unit& u) const { return W + ((size_t)u.e * wrows + (size_t)u.pn * 256) * 1024; }
    __device__ __forceinline__ const PG8_LAS int* glist(int i) const { return gl + i * 256; }
};
constexpr int MOE_UNITS_MAX = 16;
__device__ __forceinline__ int moe_build_units(PG8_LAS int* tab, const int* cnt, const int* off, const int* toff, int nN) {
    const int G = gridDim.x, c = blockIdx.x, x = c & 7, j = c >> 3, per = (G >> 3) / nN, nMt = toff[32];
    const int i = threadIdx.x;
    if (i < MOE_UNITS_MAX) {
        const int pn = j % nN, mt = (i * 8 + x) * per + j / nN;
        int e = 0, valid = (mt < nMt && j < per * nN) ? 1 : 0;
        if (valid) { while (toff[e + 1] <= mt) ++e; }
        const int m = mt - toff[e];
        tab[i * 8 + 0] = mt; tab[i * 8 + 1] = pn; tab[i * 8 + 2] = e; tab[i * 8 + 3] = cnt[e] - m * 256; tab[i * 8 + 4] = off[e] + m * 256; tab[i * 8 + 5] = valid;
    }
    __syncthreads();
    int n = 0;
    while (n < MOE_UNITS_MAX && tab[n * 8 + 5]) ++n;
    return n;
}
struct MoeOrderG : MoeOrder { __device__ __forceinline__ const char* a_base(const Unit&) const { return A; } };

__device__ __forceinline__ u32x4 pk8(const f32x4& a, const f32x4& b) { return (u32x4){cvtpk(a[0], a[1]), cvtpk(a[2], a[3]), cvtpk(b[0], b[1]), cvtpk(b[2], b[3])}; }
struct EpiStore {
    static constexpr bool PERM = true;
    bf16_t* C; int ldc; const float* rs;
    __device__ __forceinline__ void operator()(const f32x4 (&acc)[2][2][4][2], const Unit& u, int wr, int wc, int fr, int fq) const {
        bf16_t* base = C + ((size_t)u.pm * 256 + wr * 64 + fr) * ldc + u.pn * 256 + wc * 32 + 8 * fq;
#pragma unroll
        for (int ai = 0; ai < 2; ++ai)
#pragma unroll
            for (int m = 0; m < 4; ++m) { bf16_t* rowp = base + (size_t)(ai * HALF + m * 16) * ldc; const float s = rs ? rs[ai * HALF + wr * 64 + m * 16 + fr] : 1.f;
#pragma unroll
                for (int bj = 0; bj < 2; ++bj) *(u32x4*)(rowp + bj * HALF) = pk8(acc[ai][bj][m][0] * s, acc[ai][bj][m][1] * s); }
    }
};
constexpr float ACT8_SCALE = 4.f;
struct EpiAct {
    static constexpr bool PERM = true;
    unsigned char* Act; const float* b1all;
    __device__ __forceinline__ void operator()(const f32x4 (&acc)[2][2][4][2], const Unit& u, int wr, int wc, int fr, int fq) const {
        const int f0 = u.pn * 128 + wc * 32 + 8 * fq;
        const float* bb = b1all + (size_t)u.e * 2048 + 2 * f0;
        f32x4 bv[4];
#pragma unroll
        for (int q = 0; q < 4; ++q) bv[q] = *(const f32x4*)(bb + 4 * q);
        unsigned char* base = Act + ((size_t)u.slot0 + wr * 64 + fr) * 1024 + f0;
#pragma unroll
        for (int ai = 0; ai < 2; ++ai)
#pragma unroll
            for (int m = 0; m < 4; ++m) {
                const int r = ai * HALF + wr * 64 + m * 16 + fr;
                float a[8];
#pragma unroll
                for (int n = 0; n < 2; ++n)
#pragma unroll
                    for (int j = 0; j < 4; ++j) { const int f = 4 * n + j;
                        float glu = acc[ai][0][m][n][j] + bv[f >> 1][(f & 1) * 2], lin = acc[ai][1][m][n][j] + bv[f >> 1][(f & 1) * 2 + 1];
                        glu = fminf(glu, 7.f); lin = fminf(fmaxf(lin, -7.f), 7.f);
                        a[f] = glu * __builtin_amdgcn_rcpf(1.f + __builtin_amdgcn_exp2f(-1.702f * LOG2E * glu)) * (lin * ACT8_SCALE + ACT8_SCALE); }
                if (r < u.nvalid) *(u32x2*)(base + (size_t)(ai * HALF + m * 16) * 1024) = (u32x2){pk4_fp8(a[0], a[1], a[2], a[3]), pk4_fp8(a[4], a[5], a[6], a[7])};
            }
    }
};
struct EpiBias {
    static constexpr bool PERM = true;
    bf16_t* Y; const float* b2all;
    __device__ __forceinline__ void operator()(const f32x4 (&acc)[2][2][4][2], const Unit& u, int wr, int wc, int fr, int fq) const {
        const int c0 = u.pn * 256 + wc * 32 + 8 * fq;
        const float* bb = b2all + (size_t)u.e * 1024 + c0;
        f32x4 bv[2][2];
#pragma unroll
        for (int bj = 0; bj < 2; ++bj)
#pragma unroll
            for (int n = 0; n < 2; ++n) bv[bj][n] = *(const f32x4*)(bb + bj * HALF + 4 * n);
        bf16_t* base = Y + ((size_t)u.slot0 + wr * 64 + fr) * 1024 + c0;
#pragma unroll
        for (int ai = 0; ai < 2; ++ai)
#pragma unroll
            for (int m = 0; m < 4; ++m) { const int r = ai * HALF + wr * 64 + m * 16 + fr;
                if (r < u.nvalid) {
#pragma unroll
                    for (int bj = 0; bj < 2; ++bj) *(u32x4*)(base + (size_t)(ai * HALF + m * 16) * 1024 + bj * HALF) = pk8(acc[ai][bj][m][0] + bv[bj][0], acc[ai][bj][m][1] + bv[bj][1]); } }
    }
};
}

__device__ __forceinline__ u32x4 pack8(const float (&v)[8]) { return (u32x4){cvtpk(v[0], v[1]), cvtpk(v[2], v[3]), cvtpk(v[4], v[5]), cvtpk(v[6], v[7])}; }
struct EpiPlain {
    static constexpr bool MOE1 = false;
    bf16_t* C; int ldc;
    __device__ __forceinline__ void row8(int r, int c, const float (&v)[8]) const { *(u32x4*)(C + (size_t)r * ldc + c) = pack8(v); }
    __device__ __forceinline__ void pair(int, int, const float (&)[8], const float (&)[8]) const {}
};
struct EpiRowScale {
    static constexpr bool MOE1 = false;
    bf16_t* C; int ldc; const float* rs;
    __device__ __forceinline__ void row8(int r, int c, const float (&v)[8]) const { const float s = rs[r]; float w[8];
#pragma unroll
        for (int i = 0; i < 8; ++i) w[i] = v[i] * s;
        *(u32x4*)(C + (size_t)r * ldc + c) = pack8(w); }
    __device__ __forceinline__ void pair(int, int, const float (&)[8], const float (&)[8]) const {}
};
__device__ __forceinline__ void phase_gemm_plain(const bf16_t* A, int lda, const bf16_t* Bt, int K, bf16_t* C, int ldc, int nM, int nN) {
    const int G = gridDim.x;
    for (int u = blockIdx.x; u < nM * nN; u += G) {
        const int pm = u / nN, pn = u % nN;
        int aoff[2][2], boff[2];
        gm::make_off(aoff, pm * 256, lda); gm::make_off1(boff, pn * 128, K);
        EpiPlain epi{C + (size_t)pm * 256 * ldc + pn * 128, ldc};
        gm::gemm_tile(A, aoff, Bt, boff, K / 64, epi);
    }
}

struct Row16 { float4 v[4]; };
__device__ __forceinline__ Row16 ld_row_f32(const float* p, int lane) { Row16 r;
#pragma unroll
    for (int i = 0; i < 4; ++i) r.v[i] = *(const float4*)(p + lane * 4 + 256 * i);
    return r; }
__device__ __forceinline__ Row16 ld_row_bf16(const bf16_t* p, int lane) { Row16 r;
#pragma unroll
    for (int i = 0; i < 4; ++i) { const u32x2 w = *(const u32x2*)(p + lane * 4 + 256 * i);
        r.v[i] = make_float4(__uint_as_float(w.x << 16), __uint_as_float(w.x & 0xFFFF0000u), __uint_as_float(w.y << 16), __uint_as_float(w.y & 0xFFFF0000u)); }
    return r; }
__device__ __forceinline__ void st_row_f32(float* p, int lane, const Row16& r) {
#pragma unroll
    for (int i = 0; i < 4; ++i) *(float4*)(p + lane * 4 + 256 * i) = r.v[i]; }
__device__ __forceinline__ void st_row_bf16(bf16_t* p, int lane, const Row16& r) {
#pragma unroll
    for (int i = 0; i < 4; ++i) { u32x2 w; w.x = cvtpk(r.v[i].x, r.v[i].y); w.y = cvtpk(r.v[i].z, r.v[i].w); *(u32x2*)(p + lane * 4 + 256 * i) = w; } }
__device__ __forceinline__ void st_row_fp8(unsigned char* p, int lane, const Row16& r) {
#pragma unroll
    for (int i = 0; i < 4; ++i) *(unsigned*)(p + lane * 4 + 256 * i) = pk4_fp8(r.v[i].x, r.v[i].y, r.v[i].z, r.v[i].w); }
__device__ __forceinline__ float row_rstd(const Row16& r) {
    float s = 0.f;
#pragma unroll
    for (int i = 0; i < 4; ++i) s += r.v[i].x * r.v[i].x + r.v[i].y * r.v[i].y + r.v[i].z * r.v[i].z + r.v[i].w * r.v[i].w;
    s = wave_sum(s);
    return rsqrtf(s * (1.f / 1024.f) + EPSN);
}
__device__ __forceinline__ Row16 norm_mod(const Row16& x, float rstd, const float* g, const float* sc, const float* sh, int lane) {
    Row16 h;
#pragma unroll
    for (int i = 0; i < 4; ++i) {
        const int c = lane * 4 + 256 * i;
        const float4 gv = *(const float4*)(g + c), scv = *(const float4*)(sc + c), shv = *(const float4*)(sh + c);
        h.v[i].x = x.v[i].x * rstd * gv.x * (1.f + scv.x) + shv.x; h.v[i].y = x.v[i].y * rstd * gv.y * (1.f + scv.y) + shv.y;
        h.v[i].z = x.v[i].z * rstd * gv.z * (1.f + scv.z) + shv.z; h.v[i].w = x.v[i].w * rstd * gv.w * (1.f + scv.w) + shv.w;
    }
    return h;
}
__device__ __forceinline__ Row16 resid_add(const Row16& x, const Row16& y, float rstd, const float* g, const float* gate, int lane) {
    Row16 o;
#pragma unroll
    for (int i = 0; i < 4; ++i) {
        const int c = lane * 4 + 256 * i;
        const float4 gv = *(const float4*)(g + c), ga = *(const float4*)(gate + c);
        o.v[i].x = x.v[i].x + y.v[i].x * rstd * gv.x * ga.x; o.v[i].y = x.v[i].y + y.v[i].y * rstd * gv.y * ga.y;
        o.v[i].z = x.v[i].z + y.v[i].z * rstd * gv.z * ga.z; o.v[i].w = x.v[i].w + y.v[i].w * rstd * gv.w * ga.w;
    }
    return o;
}
__device__ __forceinline__ const float* mod_ptr(PRef p, int l, int r) { return (const float*)(p.ws + WS_MOD) + (size_t)(l * 2 + (r < CTXN ? 1 : 0)) * 6144; }
__device__ __forceinline__ const float* src_row(PRef p, int r) { return r < CTXN ? p.ctx + (size_t)r * 1024 : p.x + (size_t)(r - CTXN) * 1024; }

struct ModAB { float4 a[4], b[4]; };
struct ModG { float4 g[4]; };
__device__ __forceinline__ ModAB load_ab(const float* g, const float* sc, const float* sh, int lane) { ModAB m;
#pragma unroll
    for (int i = 0; i < 4; ++i) { const int c = lane * 4 + 256 * i; const float4 gv = *(const float4*)(g + c), sv = *(const float4*)(sc + c); m.b[i] = *(const float4*)(sh + c);
        m.a[i] = make_float4(gv.x * (1.f + sv.x), gv.y * (1.f + sv.y), gv.z * (1.f + sv.z), gv.w * (1.f + sv.w)); }
    return m; }
__device__ __forceinline__ ModG load_g(const float* g, const float* gate, int lane) { ModG m;
#pragma unroll
    for (int i = 0; i < 4; ++i) { const int c = lane * 4 + 256 * i; const float4 gv = *(const float4*)(g + c), ga = *(const float4*)(gate + c); m.g[i] = make_float4(gv.x * ga.x, gv.y * ga.y, gv.z * ga.z, gv.w * ga.w); }
    return m; }
__device__ __forceinline__ Row16 apply_ab(const Row16& x, float rstd, const ModAB& m) { Row16 h;
#pragma unroll
    for (int i = 0; i < 4; ++i) h.v[i] = make_float4(x.v[i].x * rstd * m.a[i].x + m.b[i].x, x.v[i].y * rstd * m.a[i].y + m.b[i].y, x.v[i].z * rstd * m.a[i].z + m.b[i].z, x.v[i].w * rstd * m.a[i].w + m.b[i].w);
    return h; }
__device__ __forceinline__ Row16 apply_g(const Row16& x, const Row16& y, float rstd, const ModG& m) { Row16 o;
#pragma unroll
    for (int i = 0; i < 4; ++i) o.v[i] = make_float4(x.v[i].x + y.v[i].x * rstd * m.g[i].x, x.v[i].y + y.v[i].y * rstd * m.g[i].y, x.v[i].z + y.v[i].z * rstd * m.g[i].z, x.v[i].w + y.v[i].w * rstd * m.g[i].w);
    return o; }
struct RowB8 { u32x2 v[4]; };
__device__ __forceinline__ RowB8 ld_rowb(const bf16_t* p, int lane) { RowB8 r;
#pragma unroll
    for (int i = 0; i < 4; ++i) r.v[i] = *(const u32x2*)(p + lane * 4 + 256 * i);
    return r; }
__device__ __forceinline__ Row16 cvt_rowb(const RowB8& b) { Row16 r;
#pragma unroll
    for (int i = 0; i < 4; ++i) r.v[i] = make_float4(__uint_as_float(b.v[i].x << 16), __uint_as_float(b.v[i].x & 0xFFFF0000u), __uint_as_float(b.v[i].y << 16), __uint_as_float(b.v[i].y & 0xFFFF0000u));
    return r; }

__device__ __forceinline__ void phase_norm1_l0(PRef p) {
    const int lane = threadIdx.x & 63, wave = threadIdx.x >> 6, G = gridDim.x, step = G * 8;
    bf16_t* HB = (bf16_t*)(p.ws + WS_HB);
    int r = blockIdx.x * 8 + wave;
    if (r >= NTOK) return;
    int cur_s = (r < CTXN) ? 1 : 0;
    const float* mod = mod_ptr(p, 0, r);
    ModAB m = load_ab(p.norm_g, mod + 1024, mod, lane);
    Row16 x = ld_row_f32(src_row(p, r), lane);
    for (; r < NTOK; r += step) {
        const int rn = r + step;
        Row16 xn = x;
        if (rn < NTOK) xn = ld_row_f32(src_row(p, rn), lane);
        const int s_ = (r < CTXN) ? 1 : 0;
        if (s_ != cur_s) { cur_s = s_; const float* md = mod_ptr(p, 0, r); m = load_ab(p.norm_g, md + 1024, md, lane); }
        const float rstd = row_rstd(x);
        st_row_bf16(HB + (size_t)r * 1024, lane, apply_ab(x, rstd, m));
        x = xn;
    }
}

__device__ __forceinline__ void phase_mid(PRef p, int l) {
    const int tid = tid_opaque(), lane = tid & 63, wave = tid >> 6, G = gridDim.x;
    float* wT = (float*)smem;
    int* lcnt = (int*)(smem + 139264);
    int* lbase = lcnt + 32;
    int* sel = lbase + 32;
    {
        const float4* src = (const float4*)((const float*)(p.ws + WS_RWT) + (size_t)l * 32 * 1024);
        for (int i = tid; i < 32 * 1024 / 4; i += NTH) ((float4*)wT)[i] = src[i];
        if (tid < 32) lcnt[tid] = 0;
    }
    __syncthreads();
    const int r_begin = (l == 0) ? 0 : CTXN;
    bf16_t* HB = (bf16_t*)(p.ws + WS_HB); const bf16_t* OB = (const bf16_t*)(p.ws + WS_OB);
    float* X1 = (float*)(p.ws + WS_X1); const float* X2 = (const float*)(p.ws + WS_X2);
    const float* ng = p.norm_g + (size_t)l * 4 * 1024;
    const float* rb = p.router_b + l * 32;
    float* GATE = (float*)(p.ws + WS_GATE);
    int it = 0;
    int r = r_begin + blockIdx.x * 8 + wave;
    const int step = G * 8;
    int cur_s = -1; ModG mg; ModAB mab;
    Row16 xin; RowB8 ob;
    if (r < NTOK) { xin = (l == 0) ? ld_row_f32(src_row(p, r), lane) : ld_row_f32(X2 + (size_t)r * 1024, lane); ob = ld_rowb(OB + (size_t)r * 1024, lane); }
    for (; r < NTOK; r += step, ++it) {
        const int rn = r + step;
        Row16 xin_n = xin; RowB8 ob_n = ob;
        if (rn < NTOK) { xin_n = (l == 0) ? ld_row_f32(src_row(p, rn), lane) : ld_row_f32(X2 + (size_t)rn * 1024, lane); ob_n = ld_rowb(OB + (size_t)rn * 1024, lane); }
        const int s_ = (r < CTXN) ? 1 : 0;
        if (s_ != cur_s) { cur_s = s_; const float* mod = mod_ptr(p, l, r); mg = load_g(ng + 1024, mod + 2048, lane); mab = load_ab(ng + 2048, mod + 4096, mod + 3072, lane); }
        const Row16 o = cvt_rowb(ob);
        const float rso = row_rstd(o);
        const Row16 x1 = apply_g(xin, o, rso, mg);
        st_row_f32(X1 + (size_t)r * 1024, lane, x1);
        const float rs1 = row_rstd(x1);
        const Row16 h = apply_ab(x1, rs1, mab);
        xin = xin_n; ob = ob_n;
        float part[32];
        {
            const float* wl = wT + lane * 4;
            float4 wa[4], wb[4];
#pragma unroll
            for (int i = 0; i < 4; ++i) wa[i] = *(const float4*)(wl + 256 * i);
#pragma unroll
            for (int e = 0; e < 32; e += 2) {
#pragma unroll
                for (int i = 0; i < 4; ++i) wb[i] = *(const float4*)(wl + (e + 1) * 1024 + 256 * i);
                { float a = 0.f;
#pragma unroll
                  for (int i = 0; i < 4; ++i) a += h.v[i].x * wa[i].x + h.v[i].y * wa[i].y + h.v[i].z * wa[i].z + h.v[i].w * wa[i].w;
                  part[e] = a; }
                if (e + 2 < 32) {
#pragma unroll
                    for (int i = 0; i < 4; ++i) wa[i] = *(const float4*)(wl + (e + 2) * 1024 + 256 * i);
                }
                { float a = 0.f;
#pragma unroll
                  for (int i = 0; i < 4; ++i) a += h.v[i].x * wb[i].x + h.v[i].y * wb[i].y + h.v[i].z * wb[i].z + h.v[i].w * wb[i].w;
                  part[e + 1] = a; }
            }
        }
        st_row_fp8((unsigned char*)HB + (size_t)r * 1024, lane, h);
#define TR_STEP(NV, BIT) _Pragma("unroll") for (int i = 0; i < (NV) / 2; ++i) { const float lo = part[i], hi_ = part[i + (NV) / 2]; const bool up = (lane & (BIT)) != 0; \
            const float send = up ? lo : hi_, keep = up ? hi_ : lo; part[i] = keep + __shfl_xor(send, (BIT)); }
        TR_STEP(32, 32) TR_STEP(16, 16) TR_STEP(8, 8) TR_STEP(4, 4) TR_STEP(2, 2)
#undef TR_STEP
        float logit = part[0] + __shfl_xor(part[0], 1);
        const int myexp = lane >> 1;
        logit += rb[myexp];
        float val = (lane & 1) ? -3.0e38f : logit;
        float tv[4]; int ti[4];
#pragma unroll
        for (int k = 0; k < 4; ++k) {
            float bv = val; int bi = myexp;
#pragma unroll
            for (int off = 32; off >= 1; off >>= 1) { const float ov = __shfl_xor(bv, off); const int oi = __shfl_xor(bi, off); if (ov > bv || (ov == bv && oi < bi)) { bv = ov; bi = oi; } }
            tv[k] = bv; ti[k] = bi;
            if (myexp == bi) val = -3.0e38f;
        }
        const float e1 = __expf(tv[1] - tv[0]), e2 = __expf(tv[2] - tv[0]), e3 = __expf(tv[3] - tv[0]);
        const float inv = 1.f / (1.f + e1 + e2 + e3);
        if (lane < 4) {
            const int k = lane;
            const int e = (k == 0) ? ti[0] : (k == 1) ? ti[1] : (k == 2) ? ti[2] : ti[3];
            const float gk = ((k == 0) ? 1.f : (k == 1) ? e1 : (k == 2) ? e2 : e3) * inv;
            GATE[(size_t)r * 4 + k] = gk;
            const int lp = atomicAdd(&lcnt[e], 1);
            sel[(it * 8 + wave) * 4 + k] = e | (lp << 8);
        }
    }
    __syncthreads();
    int* CNT = (int*)(p.ws + WS_CNT) + l * 32;
    if (tid < 32) lbase[tid] = atomicAdd(&CNT[tid], lcnt[tid]);
    __syncthreads();
    {
        int* TOPE = (int*)(p.ws + WS_TOPE); int* TOPP = (int*)(p.ws + WS_TOPP); int* LIST = (int*)(p.ws + WS_LIST);
        for (int q = tid; q < 80 * 4; q += NTH) {
            const int slot = q >> 2, k = q & 3, itq = slot >> 3, wv = slot & 7;
            const int r = r_begin + blockIdx.x * 8 + wv + itq * G * 8;
            if (r < NTOK) {
                const int s = sel[q], e = s & 255, lp = s >> 8, pos = lbase[e] + lp;
                TOPE[(size_t)r * 4 + k] = e; TOPP[(size_t)r * 4 + k] = pos; LIST[(size_t)e * NTOK + pos] = r;
            }
        }
    }
    __syncthreads();
}

struct MoeLds { int* cnt; int* off; int* toff; };
__device__ __forceinline__ MoeLds moe_setup(PRef p, int l, char* base) {
    MoeLds m; m.cnt = (int*)base; m.off = m.cnt + 32; m.toff = m.off + 33;
    const int tid = tid_opaque();
    if (tid < 64) {
        const int e = tid & 31;
        const int cval = ((const int*)(p.ws + WS_CNT))[l * 32 + e];
        const int tiles = (cval + 255) >> 8;
        int pc = cval, pt = tiles;
#pragma unroll
        for (int o = 1; o < 32; o <<= 1) { const int a = __shfl_up(pc, o, 32), b = __shfl_up(pt, o, 32); if (e >= o) { pc += a; pt += b; } }
        if (tid < 32) { m.cnt[e] = cval; m.off[e + 1] = pc; m.toff[e + 1] = pt; if (e == 0) { m.off[0] = 0; m.toff[0] = 0; } }
    }
    __syncthreads();
    return m;
}

__device__ __forceinline__ void phase_end(PRef p, int l) {
    const int tid = tid_opaque(), lane = tid & 63, wave = tid >> 6, G = gridDim.x;
    MoeLds ml = moe_setup(p, l, smem);
    const int r_begin = (l == 0) ? 0 : CTXN;
    const bf16_t* YB = (const bf16_t*)(p.ws + WS_YB);
    const float* X1 = (const float*)(p.ws + WS_X1); float* X2 = (float*)(p.ws + WS_X2);
    bf16_t* HB = (bf16_t*)(p.ws + WS_HB);
    const int* TOPE = (const int*)(p.ws + WS_TOPE); const int* TOPP = (const int*)(p.ws + WS_TOPP); const float* GATE = (const float*)(p.ws + WS_GATE);
    const float* ng = p.norm_g + (size_t)l * 4 * 1024;
    int cur_s = -1; ModG mg; ModAB mab;
    int r = r_begin + blockIdx.x * 8 + wave;
    int4 en = make_int4(0, 0, 0, 0), pn = make_int4(0, 0, 0, 0); float4 gn = make_float4(0.f, 0.f, 0.f, 0.f);
    const int step = G * 8;
    if (r < NTOK) { en = *(const int4*)(TOPE + (size_t)r * 4); pn = *(const int4*)(TOPP + (size_t)r * 4); gn = *(const float4*)(GATE + (size_t)r * 4); }
    RowB8 t4n[4]; Row16 x1n; float4 gcur = gn;
    if (r < NTOK) {
        t4n[0] = ld_rowb(YB + (size_t)(ml.off[en.x] + pn.x) * 1024, lane); t4n[1] = ld_rowb(YB + (size_t)(ml.off[en.y] + pn.y) * 1024, lane);
        t4n[2] = ld_rowb(YB + (size_t)(ml.off[en.z] + pn.z) * 1024, lane); t4n[3] = ld_rowb(YB + (size_t)(ml.off[en.w] + pn.w) * 1024, lane);
        x1n = ld_row_f32(X1 + (size_t)r * 1024, lane);
        if (r + step < NTOK) { en = *(const int4*)(TOPE + (size_t)(r + step) * 4); pn = *(const int4*)(TOPP + (size_t)(r + step) * 4); gn = *(const float4*)(GATE + (size_t)(r + step) * 4); }
    }
    for (; r < NTOK; r += step) {
        RowB8 t4[4]; t4[0] = t4n[0]; t4[1] = t4n[1]; t4[2] = t4n[2]; t4[3] = t4n[3];
        const Row16 x1 = x1n;
        const float g4[4] = {gcur.x, gcur.y, gcur.z, gcur.w};
        const int rn = r + step;
        if (rn < NTOK) {
            t4n[0] = ld_rowb(YB + (size_t)(ml.off[en.x] + pn.x) * 1024, lane); t4n[1] = ld_rowb(YB + (size_t)(ml.off[en.y] + pn.y) * 1024, lane);
            t4n[2] = ld_rowb(YB + (size_t)(ml.off[en.z] + pn.z) * 1024, lane); t4n[3] = ld_rowb(YB + (size_t)(ml.off[en.w] + pn.w) * 1024, lane);
            x1n = ld_row_f32(X1 + (size_t)rn * 1024, lane);
            gcur = gn;
            if (rn + step < NTOK) { en = *(const int4*)(TOPE + (size_t)(rn + step) * 4); pn = *(const int4*)(TOPP + (size_t)(rn + step) * 4); gn = *(const float4*)(GATE + (size_t)(rn + step) * 4); }
        }
        const int s_ = (r < CTXN) ? 1 : 0;
        if (s_ != cur_s) { cur_s = s_; const float* mod = mod_ptr(p, l, r); mg = load_g(ng + 3072, mod + 5120, lane);
            if (l == 0) { const float* mod1 = mod_ptr(p, 1, r); mab = load_ab(p.norm_g + (size_t)4 * 1024, mod1 + 1024, mod1, lane); } }
        Row16 y;
#pragma unroll
        for (int i = 0; i < 4; ++i) y.v[i] = make_float4(0.f, 0.f, 0.f, 0.f);
#pragma unroll
        for (int k = 0; k < 4; ++k) { const Row16 t = cvt_rowb(t4[k]); const float gk = g4[k];
#pragma unroll
            for (int i = 0; i < 4; ++i) { y.v[i].x += gk * t.v[i].x; y.v[i].y += gk * t.v[i].y; y.v[i].z += gk * t.v[i].z; y.v[i].w += gk * t.v[i].w; } }
        const float rsy = row_rstd(y);
        const Row16 x2 = apply_g(x1, y, rsy, mg);
        if (l == 0) {
            st_row_f32(X2 + (size_t)r * 1024, lane, x2);
            const float rs2 = row_rstd(x2);
            st_row_bf16(HB + (size_t)r * 1024, lane, apply_ab(x2, rs2, mab));
        } else {
            st_row_f32(p.out + (size_t)(r - CTXN) * 1024, lane, x2);
        }
    }
    __syncthreads();
}

__device__ __forceinline__ void phase_gemm_pg8(const bf16_t* A, int lda, const bf16_t* Bt, int K, bf16_t* C, int ldc, int nM, int nN) {
    pg8::PlainOrder S; S.init(A, lda, Bt, K, nM, nN);
    pg8::EpiStore E{C, ldc, nullptr};
    pg8::gemm_phase<pg8::EpiStore, pg8::PlainOrder, false>((PG8_LAS unsigned char*)smem, S, E, K, lda, K);
    __syncthreads();
}
constexpr int MOE_GL_OFF = 131072, MOE_ML_OFF = 143360, MOE_TAB_OFF = 143872, MOE_GL_MAX = 12;
__device__ __forceinline__ void phase_moe1(PRef p, int l) {
    MoeLds ml = moe_setup(p, l, smem + MOE_ML_OFF);
    const int tid = tid_opaque();
    PG8_LAS int* gl = (PG8_LAS int*)(smem + MOE_GL_OFF);
    PG8_LAS int* tab = (PG8_LAS int*)(smem + MOE_TAB_OFF);
    pg8::MoeOrderG S;
    S.A = (const char*)(p.ws + WS_HB); S.W = (const char*)(p.ws + WS_W1T) + (size_t)l * 32 * 2048 * 1024;
    S.tab = tab; S.gl = gl; S.wrows = 2048;
    S.nunits = pg8::moe_build_units(tab, ml.cnt, ml.off, ml.toff, 8);
    if (S.nunits > MOE_GL_MAX) S.nunits = MOE_GL_MAX;
    const int* LIST = (const int*)(p.ws + WS_LIST);
    for (int i = 0; i < S.nunits; ++i) {
        const int e = tab[i * 8 + 2], mt = tab[i * 8 + 0], nvalid = tab[i * 8 + 3], m = mt - ml.toff[e];
        if (tid < 256) gl[i * 256 + tid] = (tid < nvalid) ? LIST[(size_t)e * NTOK + m * 256 + tid] : 0;
    }
    __syncthreads();
    pg8::EpiAct E{(unsigned char*)(p.ws + WS_ACT), p.moe_b1 + (size_t)l * 32 * 2048};
    pg8::gemm_phase<pg8::EpiAct, pg8::MoeOrderG, true, true>((PG8_LAS unsigned char*)smem, S, E, 512, 512, 512, 0x7F7F7F7F, 0x79797979);
    __syncthreads();
}
__device__ __forceinline__ void phase_moe2(PRef p, int l) {
    MoeLds ml = moe_setup(p, l, smem + MOE_ML_OFF);
    PG8_LAS int* tab = (PG8_LAS int*)(smem + MOE_TAB_OFF);
    PG8_LAS int* gl = (PG8_LAS int*)(smem + MOE_GL_OFF);
    pg8::MoeOrderG S;
    S.A = (const char*)(p.ws + WS_ACT); S.W = (const char*)(p.ws + WS_W2T) + (size_t)l * 32 * 1024 * 1024;
    S.tab = tab; S.gl = gl; S.wrows = 1024;
    S.nunits = pg8::moe_build_units(tab, ml.cnt, ml.off, ml.toff, 4);
    if (S.nunits > MOE_GL_MAX) S.nunits = MOE_GL_MAX;
    { const int tid = tid_opaque();
      for (int i = 0; i < S.nunits; ++i) if (tid < 256) gl[i * 256 + tid] = tab[i * 8 + 4] + tid;
      __syncthreads(); }
    pg8::EpiBias E{(bf16_t*)(p.ws + WS_YB), p.moe_b2 + (size_t)l * 32 * 1024};
    pg8::gemm_phase<pg8::EpiBias, pg8::MoeOrderG, true, true>((PG8_LAS unsigned char*)smem, S, E, 512, 512, 512, 0x7D7D7D7D, 0x79797979);
    __syncthreads();
}

__device__ __forceinline__ void gla_local_units(PRef p);
__device__ __forceinline__ void rope8(const float* rope, int t, int j0, const u32x4& a, const u32x4& b, u32x4& oa, u32x4& ob);
__device__ __forceinline__ void rowstat(const bf16_t* A, int lda, int K, float* rs) {
    const int tid = tid_opaque(), r = tid >> 1, hf = tid & 1, half = K / 2;
    const bf16_t* q = A + (size_t)r * lda + hf * half;
    float s = 0.f;
    for (int i = 0; i < half; i += 8) { const u32x4 w = *(const u32x4*)(q + i);
#pragma unroll
        for (int j = 0; j < 4; ++j) { const float a = __uint_as_float(w[j] << 16), b = __uint_as_float(w[j] & 0xFFFF0000u); s += a * a + b * b; } }
    s += __shfl_xor(s, 1);
    if (hf == 0) rs[r] = rsqrtf(s / (float)K + EPSN);
    __syncthreads();
}
__device__ __forceinline__ void phase_mla_up(PRef p) {
    const int G = gridDim.x, tid = threadIdx.x;
    const bf16_t* P = (const bf16_t*)(p.ws + WS_P);
    float* rs = (float*)(smem + 139264);
    const int nM = NTOK / 256;
    {
        pg8::PlainOrder S; S.init(P + PC_CQ, PW, (const bf16_t*)(p.ws + WS_WUQ), 256, nM, 3);
        pg8::Unit u;
        if (S.next(0, u)) rowstat(P + (size_t)u.pm * 256 * PW + PC_CQ, PW, 256, rs);
        pg8::EpiStore E{(bf16_t*)(p.ws + WS_QM), 768, rs};
        pg8::gemm_phase<pg8::EpiStore, pg8::PlainOrder, false>((PG8_LAS unsigned char*)smem, S, E, 256, PW, 256);
        __syncthreads();
    }
    for (int v = (blockIdx.x + G - 195) % G; v < nM * 8; v += G) {
        int aoff[2][2], boff[2];
        const int pm = v >> 3, pn = v & 7, h = pn >> 1;
        rowstat(P + (size_t)pm * 256 * PW + PC_CKV, PW, 128, rs);
        gm::make_off(aoff, pm * 256, PW); gm::make_off1(boff, pn * 128, 128);
        bf16_t* dst = (pn & 1) ? (bf16_t*)(p.ws + WS_VM) + (size_t)pm * 256 * 512 + h * 128 : (bf16_t*)(p.ws + WS_KM) + (size_t)pm * 256 * 768 + h * 192;
        EpiRowScale epi{dst, (pn & 1) ? 512 : 768, rs};
        gm::gemm_tile(P + PC_CKV, aoff, (const bf16_t*)(p.ws + WS_WUKV), boff, 2, epi);
    }
    const float* rope = (const float*)(p.ws + WS_ROPE);
    bf16_t* KM = (bf16_t*)(p.ws + WS_KM);
    for (int i = blockIdx.x * NTH + tid; i < NTOK * 4; i += G * NTH) {
        const int r = i >> 2, j0 = (i & 3) * 8;
        const u32x4 a = *(const u32x4*)(P + (size_t)r * PW + PC_KR + j0), b = *(const u32x4*)(P + (size_t)r * PW + PC_KR + 32 + j0);
        u32x4 oa = a, ob = b;
        if (r >= CTXN) rope8(rope, r - CTXN, j0, a, b, oa, ob);
#pragma unroll
        for (int h = 0; h < 4; ++h) { *(u32x4*)(KM + (size_t)r * 768 + h * 192 + 128 + j0) = oa; *(u32x4*)(KM + (size_t)r * 768 + h * 192 + 160 + j0) = ob; }
    }
    __syncthreads();
    gla_local_units(p);
}

struct GlaB { float b[16]; float total; };
__device__ __forceinline__ GlaB gla_decay(PRef p, int gc, int h, float* scr  ) {
    const int tid = threadIdx.x, lane = tid & 63, wave = tid >> 6, dir = wave & 1, tq = wave >> 1;
    const bf16_t* P = (const bf16_t*)(p.ws + WS_P);
    float* af = scr;
    float* wa = scr + 2048;
    float* ba = scr + 4096;
    float* tot = scr + 4224;
#pragma unroll
    for (int i = 0; i < 4; ++i) {
        const int idx = tid + 512 * i, dd = idx >> 10, t = (idx >> 4) & 63, j = idx & 15;
        af[idx] = bf2f(P[(size_t)(gc * 64 + t) * PW + PC_AF + dd * 16 + j]);
        const int jj = (idx >> 6) & 15, d = idx & 63;
        wa[idx] = (dd == 0 ? p.gla_wa_f : p.gla_wa_b)[jj * 256 + h * 64 + d];
    }
    if (tid < 128) ba[tid] = ((tid >> 6) == 0 ? p.gla_ba_f : p.gla_ba_b)[h * 64 + (tid & 63)];
    __syncthreads();
    float w[16];
#pragma unroll
    for (int j = 0; j < 16; ++j) w[j] = wa[(dir * 16 + j) * 64 + lane];
    const float bias = ba[dir * 64 + lane];
    GlaB r;
#pragma unroll
    for (int i = 0; i < 16; ++i) {
        const int t = tq * 16 + i;
        float z = bias;
#pragma unroll
        for (int j = 0; j < 16; ++j) z += af[(dir * 64 + t) * 16 + j] * w[j];
        const float g = (fminf(z, 0.f) - __logf(1.f + __expf(-fabsf(z)))) * (1.f / 16.f);
        r.b[i] = g;
    }
    if (dir == 0) {
#pragma unroll
        for (int i = 1; i < 16; ++i) r.b[i] += r.b[i - 1];
        tot[(dir * 4 + tq) * 64 + lane] = r.b[15];
    } else {
#pragma unroll
        for (int i = 14; i >= 0; --i) r.b[i] += r.b[i + 1];
        tot[(dir * 4 + tq) * 64 + lane] = r.b[0];
    }
    __syncthreads();
    float offs = 0.f, total = 0.f;
#pragma unroll
    for (int q = 0; q < 4; ++q) { const float tv = tot[(dir * 4 + q) * 64 + lane]; total += tv; if (dir == 0 ? (q < tq) : (q > tq)) offs += tv; }
#pragma unroll
    for (int i = 0; i < 16; ++i) r.b[i] += offs;
    r.total = total;
    return r;
}

__device__ __forceinline__ void gla_stage_vt(const bf16_t* P, int gc, int h, bf16_t* VT) {
    const int tid = threadIdx.x, v = tid & 127, sq = tid >> 7;
    unsigned pk[8];
#pragma unroll
    for (int i = 0; i < 8; ++i) {
        const bf16_t a = P[(size_t)(gc * 64 + sq * 16 + 2 * i) * PW + PC_V + h * 128 + v], b = P[(size_t)(gc * 64 + sq * 16 + 2 * i + 1) * PW + PC_V + h * 128 + v];
        pk[i] = a | ((unsigned)b << 16);
    }
    *(u32x4*)(VT + v * 72 + sq * 16) = (u32x4){pk[0], pk[1], pk[2], pk[3]};
    *(u32x4*)(VT + v * 72 + sq * 16 + 8) = (u32x4){pk[4], pk[5], pk[6], pk[7]};
}

struct GlaPreL { u32x4 kc, vc[2], ac; float4 wac; float bac; };
__device__ __forceinline__ void gla_prefetch_local(PRef p, int gc, int h, GlaPreL& g) {
    const int tid = threadIdx.x;
    const bf16_t* P = (const bf16_t*)(p.ws + WS_P);
    g.kc = *(const u32x4*)(P + (size_t)(gc * 64 + (tid >> 3)) * PW + PC_K + h * 64 + (tid & 7) * 8);
#pragma unroll
    for (int i = 0; i < 2; ++i) { const int idx = tid + 512 * i; g.vc[i] = *(const u32x4*)(P + (size_t)(gc * 64 + (idx >> 4)) * PW + PC_V + h * 128 + (idx & 15) * 8); }
    g.ac = *(const u32x4*)(P + (size_t)(gc * 64 + ((tid & 255) >> 2)) * PW + PC_AF + (tid & 3) * 8);
    { const int dd = tid >> 8, jj = (tid >> 4) & 15, d4 = tid & 15; g.wac = *(const float4*)((dd == 0 ? p.gla_wa_f : p.gla_wa_b) + jj * 256 + h * 64 + d4 * 4); }
    g.bac = ((tid >> 6) & 1 ? p.gla_ba_b : p.gla_ba_f)[h * 64 + (tid & 63)];
}
template <int OFF> __device__ __forceinline__ s16x4 glal_tr(int vb) { s16x4 r; asm volatile("ds_read_b64_tr_b16 %0, %1 offset:%2" : "=&v"(r) : "v"(vb), "i"(OFF) : "memory"); return r; }
__device__ __forceinline__ void gla_local_units(PRef p) {
    const int tid = threadIdx.x, lane = tid & 63, wave = tid >> 6, r32 = lane & 31, hi = lane >> 5, G = gridDim.x;
    bf16_t* kdT = (bf16_t*)smem;
    bf16_t* Kraw = kdT + 2 * 64 * 72;
    char* Vraw = smem + 27648;
    float* af = (float*)(smem + 49152);
    float* wa = af + 2048; float* ba = wa + 2048; float* tot = ba + 128;
    bf16_t* U = (bf16_t*)(p.ws + WS_U); float* DEC = (float*)(p.ws + WS_DEC);
    int u = blockIdx.x;
    if (u >= NCH * 4) return;
    GlaPreL g;
    gla_prefetch_local(p, u >> 2, u & 3, g);
    const int dir = wave & 1, tq = wave >> 1;
    for (; u < NCH * 4; u += G) {
        const int gc = u >> 2, h = u & 3;
        *(u32x4*)(Kraw + (tid >> 3) * 72 + (tid & 7) * 8) = g.kc;
#pragma unroll
        for (int i = 0; i < 2; ++i) { const int idx = tid + 512 * i; *(u32x4*)(Vraw + (idx >> 4) * 320 + (idx & 15) * 16) = g.vc[i]; }
        if (tid < 256) { const int t = tid >> 2, ch = tid & 3, dd = ch >> 1, j0 = (ch & 1) * 8; float* q = af + dd * 1024 + t * 16 + j0;
#pragma unroll
            for (int e = 0; e < 4; ++e) { q[2 * e] = __uint_as_float(g.ac[e] << 16); q[2 * e + 1] = __uint_as_float(g.ac[e] & 0xFFFF0000u); } }
        { const int dd = tid >> 8, jj = (tid >> 4) & 15, d4 = tid & 15; *(float4*)(wa + (dd * 16 + jj) * 64 + d4 * 4) = g.wac; }
        if (tid < 128) ba[tid] = g.bac;
        __syncthreads();
        const int un = u + G;
        if (un < NCH * 4) gla_prefetch_local(p, un >> 2, un & 3, g);
        float bb[16]; float total = 0.f;
        {
            float w[16];
#pragma unroll
            for (int j = 0; j < 16; ++j) w[j] = wa[(dir * 16 + j) * 64 + lane];
            const float bias = ba[dir * 64 + lane];
#pragma unroll
            for (int i = 0; i < 16; ++i) {
                const int t = tq * 16 + i;
                float z = bias;
#pragma unroll
                for (int j = 0; j < 16; ++j) z += af[(dir * 64 + t) * 16 + j] * w[j];
                bb[i] = (fminf(z, 0.f) - __logf(1.f + __expf(-fabsf(z)))) * (1.f / 16.f);
            }
            if (dir == 0) {
#pragma unroll
                for (int i = 1; i < 16; ++i) bb[i] += bb[i - 1];
                tot[(dir * 4 + tq) * 64 + lane] = bb[15];
            } else {
#pragma unroll
                for (int i = 14; i >= 0; --i) bb[i] += bb[i + 1];
                tot[(dir * 4 + tq) * 64 + lane] = bb[0];
            }
        }
        __syncthreads();
        {
            float offs = 0.f;
#pragma unroll
            for (int q = 0; q < 4; ++q) { const float tv = tot[(dir * 4 + q) * 64 + lane]; total += tv; if (dir == 0 ? (q < tq) : (q > tq)) offs += tv; }
#pragma unroll
            for (int i = 0; i < 16; ++i) bb[i] += offs;
        }
        {
            unsigned pk[8];
#pragma unroll
            for (int i = 0; i < 8; ++i) {
                const int s0 = tq * 16 + 2 * i;
                const float k0 = bf2f(Kraw[s0 * 72 + lane]), k1 = bf2f(Kraw[(s0 + 1) * 72 + lane]);
                pk[i] = cvtpk(k0 * __expf(total - bb[2 * i]), k1 * __expf(total - bb[2 * i + 1]));
            }
            *(u32x4*)(kdT + (dir * 64 + lane) * 72 + tq * 16) = (u32x4){pk[0], pk[1], pk[2], pk[3]};
            *(u32x4*)(kdT + (dir * 64 + lane) * 72 + tq * 16 + 8) = (u32x4){pk[4], pk[5], pk[6], pk[7]};
            if (tq == 0) DEC[((size_t)(dir * NCH + gc) * 4 + h) * 64 + lane] = __expf(total);
        }
        __syncthreads();
        {
            const int mdir = wave >> 2, vbk = wave & 3;
            const int vb = (int)(uintptr_t)Vraw + (8 * hi + ((lane & 15) >> 2)) * 320 + (vbk * 32 + 16 * ((lane >> 4) & 1) + 4 * (lane & 3)) * 2;
            f32x16 a0 = {}, a1 = {};
#define GLAL_STEP(KS) do { const s16x4 l_ = glal_tr<(KS) * 5120>(vb), h_ = glal_tr<(KS) * 5120 + 1280>(vb); \
            const bf16x8 b0 = *(const bf16x8*)(kdT + (mdir * 64 + r32) * 72 + (KS) * 16 + hi * 8); \
            const bf16x8 b1 = *(const bf16x8*)(kdT + (mdir * 64 + 32 + r32) * 72 + (KS) * 16 + hi * 8); \
            asm volatile("s_waitcnt lgkmcnt(0)" ::: "memory"); SBAR(); \
            const bf16x8 a_ = (bf16x8){l_[0], l_[1], l_[2], l_[3], h_[0], h_[1], h_[2], h_[3]}; \
            a0 = __builtin_amdgcn_mfma_f32_32x32x16_bf16(a_, b0, a0, 0, 0, 0); a1 = __builtin_amdgcn_mfma_f32_32x32x16_bf16(a_, b1, a1, 0, 0, 0); } while (0)
            GLAL_STEP(0); GLAL_STEP(1); GLAL_STEP(2); GLAL_STEP(3);
#undef GLAL_STEP
            bf16_t* Uo = U + ((size_t)(mdir * NCH + gc) * 4 + h) * 8192;
#pragma unroll
            for (int r = 0; r < 16; ++r) { const int v = vbk * 32 + crow(r, hi); Uo[v * 64 + r32] = f2bf(a0[r]); Uo[v * 64 + 32 + r32] = f2bf(a1[r]); }
        }
        __syncthreads();
    }
}
__device__ __forceinline__ void rope8(const float* rope, int t, int j0, const u32x4& a, const u32x4& b, u32x4& oa, u32x4& ob) {
    const int row = t >> 6, col = t & 63;
    const float* cs = (j0 < 16) ? rope + row * 16 + j0 : rope + 512 * 16 + col * 16 + (j0 - 16);
    const float* sn = (j0 < 16) ? rope + 256 * 16 + row * 16 + j0 : rope + 512 * 16 + 64 * 16 + col * 16 + (j0 - 16);
    const f32x4 c0 = *(const f32x4*)cs, c1 = *(const f32x4*)(cs + 4), s0 = *(const f32x4*)sn, s1 = *(const f32x4*)(sn + 4);
#pragma unroll
    for (int e = 0; e < 4; ++e) {
        const float x1l = __uint_as_float(a[e] << 16), x1h = __uint_as_float(a[e] & 0xFFFF0000u), x2l = __uint_as_float(b[e] << 16), x2h = __uint_as_float(b[e] & 0xFFFF0000u);
        const float cl = (e < 2) ? c0[2 * e] : c1[2 * e - 4], ch = (e < 2) ? c0[2 * e + 1] : c1[2 * e - 3], sl = (e < 2) ? s0[2 * e] : s1[2 * e - 4], sh = (e < 2) ? s0[2 * e + 1] : s1[2 * e - 3];
        oa[e] = cvtpk(x1l * cl - x2l * sl, x1h * ch - x2h * sh);
        ob[e] = cvtpk(x1l * sl + x2l * cl, x1h * sh + x2h * ch);
    }
}
__device__ __forceinline__ u32x4 cvt16_fp8(const u32x4& a, const u32x4& b) {
    u32x4 o;
#pragma unroll
    for (int j = 0; j < 2; ++j) {
        o[j] = pk4_fp8(__uint_as_float(a[2 * j] << 16), __uint_as_float(a[2 * j] & 0xFFFF0000u), __uint_as_float(a[2 * j + 1] << 16), __uint_as_float(a[2 * j + 1] & 0xFFFF0000u));
        o[2 + j] = pk4_fp8(__uint_as_float(b[2 * j] << 16), __uint_as_float(b[2 * j] & 0xFFFF0000u), __uint_as_float(b[2 * j + 1] << 16), __uint_as_float(b[2 * j + 1] & 0xFFFF0000u));
    }
    return o;
}
__device__ __forceinline__ u32x2 cvt8_fp8(const u32x4& a) { return (u32x2){pk4_fp8(__uint_as_float(a[0] << 16), __uint_as_float(a[0] & 0xFFFF0000u), __uint_as_float(a[1] << 16), __uint_as_float(a[1] & 0xFFFF0000u)),
                                                                       pk4_fp8(__uint_as_float(a[2] << 16), __uint_as_float(a[2] & 0xFFFF0000u), __uint_as_float(a[3] << 16), __uint_as_float(a[3] & 0xFFFF0000u))}; }
__device__ __forceinline__ void mla_pack_pass(PRef p, int b0, int nb) {
    const int tid = threadIdx.x, gt = (blockIdx.x - b0) * NTH + tid, gn = nb * NTH;
    const float* rope = (const float*)(p.ws + WS_ROPE);
    const bf16_t* QM = (const bf16_t*)(p.ws + WS_QM); const bf16_t* KM = (const bf16_t*)(p.ws + WS_KM); const bf16_t* VM = (const bf16_t*)(p.ws + WS_VM);
    unsigned char* Q8 = (unsigned char*)(p.ws + WS_Q8); unsigned char* K8 = (unsigned char*)(p.ws + WS_K8); unsigned char* VT8 = (unsigned char*)(p.ws + WS_VT8);
    for (int i = gt; i < NTOK * 48; i += gn) {
        const int r = i / 48, q = i % 48, hh = q / 12, c = q % 12;
        const bf16_t* qs = QM + (size_t)r * 768 + hh * 192; const bf16_t* ks = KM + (size_t)r * 768 + hh * 192;
        unsigned char* qd = Q8 + (size_t)r * 768 + hh * 192; unsigned char* kd = K8 + ((size_t)hh * NTOK + r) * 192;
        if (c < 8) {
            *(u32x4*)(qd + c * 16) = cvt16_fp8(*(const u32x4*)(qs + c * 16), *(const u32x4*)(qs + c * 16 + 8));
            *(u32x4*)(kd + c * 16) = cvt16_fp8(*(const u32x4*)(ks + c * 16), *(const u32x4*)(ks + c * 16 + 8));
        } else {
            const int j0 = (c - 8) * 8;
            const u32x4 a = *(const u32x4*)(qs + 128 + j0), b = *(const u32x4*)(qs + 160 + j0);
            u32x4 oa = a, ob = b;
            if (r >= CTXN) rope8(rope, r - CTXN, j0, a, b, oa, ob);
            *(u32x2*)(qd + 128 + j0) = cvt8_fp8(oa); *(u32x2*)(qd + 160 + j0) = cvt8_fp8(ob);
            *(u32x2*)(kd + 128 + j0) = cvt8_fp8(*(const u32x4*)(ks + 128 + j0)); *(u32x2*)(kd + 160 + j0) = cvt8_fp8(*(const u32x4*)(ks + 160 + j0));
        }
    }
    {
        const int lane = tid & 63, g = lane >> 4, dq = lane & 15;
        for (int u = gt >> 6; u < 4 * NCH; u += gn >> 6) {
            const int hh = u / NCH, t = u % NCH;
            const bf16_t* vs = VM + (size_t)(t * 64 + 16 * g) * 512 + hh * 128 + dq * 8;
            u32x4 w[16];
#pragma unroll
            for (int i = 0; i < 16; ++i) w[i] = *(const u32x4*)(vs + (size_t)i * 512);
            unsigned char* dst = VT8 + ((size_t)u * 128 + dq * 8) * 64 + 8 * g;
#pragma unroll
            for (int d = 0; d < 8; ++d) {
                float f[16];
#pragma unroll
                for (int i = 0; i < 16; ++i) f[i] = (d & 1) ? __uint_as_float(w[i][d >> 1] & 0xFFFF0000u) : __uint_as_float(w[i][d >> 1] << 16);
                *(u32x2*)(dst + d * 64) = (u32x2){pk4_fp8(f[0], f[1], f[2], f[3]), pk4_fp8(f[8], f[9], f[10], f[11])};
                *(u32x2*)(dst + d * 64 + 32) = (u32x2){pk4_fp8(f[4], f[5], f[6], f[7]), pk4_fp8(f[12], f[13], f[14], f[15])};
            }
        }
    }
}

__device__ __forceinline__ int gla_order(int dir, int step) { return dir == 0 ? step : (step < 4 ? 3 - step : NCH - 1 - (step - 4)); }
__device__ __forceinline__ void phase_gla_scan(PRef p) {
    const int gid = blockIdx.x * NTH + threadIdx.x;
    if (gid >= 2 * 4 * 8192) { mla_pack_pass(p, 128, (int)gridDim.x - 128); return; }
    const int dir = gid >> 15, h = (gid >> 13) & 3, e = gid & 8191, d = e & 63;
    const bf16_t* U = (const bf16_t*)(p.ws + WS_U); bf16_t* S = (bf16_t*)(p.ws + WS_SIN); const float* DEC = (const float*)(p.ws + WS_DEC);
    float s = 0.f;
#pragma unroll 1
    for (int s0 = 0; s0 < NCH; s0 += 52) {
        float uu[52], dc[52];
#pragma unroll
        for (int i = 0; i < 52; ++i) { const size_t o = ((size_t)(dir * NCH + gla_order(dir, s0 + i)) * 4 + h); uu[i] = bf2f(U[o * 8192 + e]); dc[i] = DEC[o * 64 + d]; }
#pragma unroll
        for (int i = 0; i < 52; ++i) { const size_t o = ((size_t)(dir * NCH + gla_order(dir, s0 + i)) * 4 + h); S[o * 8192 + e] = f2bf(s); s = dc[i] * s + uu[i]; }
    }
}

__device__ __forceinline__ void gla_out_unit(PRef p, int gc, int h) {
    const int tid = threadIdx.x, lane = tid & 63, wave = tid >> 6, r32 = lane & 31, hi = lane >> 5;
    const bf16_t* P = (const bf16_t*)(p.ws + WS_P);
    bf16_t* qe = (bf16_t*)smem;
    bf16_t* ke = qe + 2 * 64 * 72;
    bf16_t* Am = ke + 2 * 64 * 72;
    bf16_t* VT = Am + 2 * 64 * 72;
    bf16_t* ST = VT + 128 * 72;
    float* scr = (float*)(smem + 110592);
    float* ob = (float*)(ke);
    const GlaB gb = gla_decay(p, gc, h, scr);
    {
        const int dir = wave & 1, tq = wave >> 1;
#pragma unroll
        for (int i = 0; i < 16; ++i) {
            const int t = tq * 16 + i;
            const float qv = bf2f(P[(size_t)(gc * 64 + t) * PW + PC_Q + h * 64 + lane]) * 0.125f, kv = bf2f(P[(size_t)(gc * 64 + t) * PW + PC_K + h * 64 + lane]);
            qe[(dir * 64 + t) * 72 + lane] = f2bf(qv * __expf(gb.b[i]));
            ke[(dir * 64 + t) * 72 + lane] = f2bf(kv * __expf(-gb.b[i]));
        }
    }
    gla_stage_vt(P, gc, h, VT);
    {
        const bf16_t* S = (const bf16_t*)(p.ws + WS_SIN);
#pragma unroll
        for (int i = 0; i < 4; ++i) {
            const int cc = tid + 512 * i, dir = cc >> 10, v = (cc >> 3) & 127, ch = cc & 7;
            *(u32x4*)(ST + (dir * 128 + v) * 72 + ch * 8) = *(const u32x4*)(S + ((size_t)(dir * NCH + gc) * 4 + h) * 8192 + v * 64 + ch * 8);
        }
    }
    __syncthreads();
    {
        const int dir = wave >> 2, tb = (wave >> 1) & 1, sb = wave & 1;
        f32x16 acc = {};
#pragma unroll
        for (int ks = 0; ks < 4; ++ks) {
            const bf16x8 a = *(const bf16x8*)(qe + (dir * 64 + tb * 32 + r32) * 72 + ks * 16 + hi * 8);
            const bf16x8 b = *(const bf16x8*)(ke + (dir * 64 + sb * 32 + r32) * 72 + ks * 16 + hi * 8);
            acc = __builtin_amdgcn_mfma_f32_32x32x16_bf16(a, b, acc, 0, 0, 0);
        }
        const int s = sb * 32 + r32;
#pragma unroll
        for (int r = 0; r < 16; ++r) { const int t = tb * 32 + crow(r, hi); const bool keep = (dir == 0) ? (s <= t) : (s >= t); Am[(dir * 64 + t) * 72 + s] = f2bf(keep ? acc[r] : 0.f); }
    }
    __syncthreads();
    f32x16 o = {};
    const int tb = wave >> 2, vb = wave & 3;
#pragma unroll
    for (int dir = 0; dir < 2; ++dir)
#pragma unroll
        for (int ks = 0; ks < 4; ++ks) {
            const bf16x8 a1 = *(const bf16x8*)(Am + (dir * 64 + tb * 32 + r32) * 72 + ks * 16 + hi * 8);
            const bf16x8 b1 = *(const bf16x8*)(VT + (vb * 32 + r32) * 72 + ks * 16 + hi * 8);
            o = __builtin_amdgcn_mfma_f32_32x32x16_bf16(a1, b1, o, 0, 0, 0);
            const bf16x8 a2 = *(const bf16x8*)(qe + (dir * 64 + tb * 32 + r32) * 72 + ks * 16 + hi * 8);
            const bf16x8 b2 = *(const bf16x8*)(ST + (dir * 128 + vb * 32 + r32) * 72 + ks * 16 + hi * 8);
            o = __builtin_amdgcn_mfma_f32_32x32x16_bf16(a2, b2, o, 0, 0, 0);
        }
    __syncthreads();
#pragma unroll
    for (int r = 0; r < 16; ++r) ob[(tb * 32 + crow(r, hi)) * 132 + vb * 32 + r32] = o[r];
    __syncthreads();
    {
        const int t = tid >> 3, v0 = (tid & 7) * 16;
        float vals[16]; float ss = 0.f;
#pragma unroll
        for (int i = 0; i < 16; ++i) { vals[i] = ob[t * 132 + v0 + i]; ss += vals[i] * vals[i]; }
        ss += __shfl_xor(ss, 1); ss += __shfl_xor(ss, 2); ss += __shfl_xor(ss, 4);
        const float rstd = rsqrtf(ss * (1.f / 128.f) + EPSN);
        const size_t row = (size_t)gc * 64 + t;
        unsigned pk[8];
#pragma unroll
        for (int i = 0; i < 8; ++i) {
            const float r0 = bf2f(P[row * PW + PC_R + h * 128 + v0 + 2 * i]), r1 = bf2f(P[row * PW + PC_R + h * 128 + v0 + 2 * i + 1]);
            pk[i] = cvtpk(vals[2 * i] * rstd * p.gla_onorm[v0 + 2 * i] * silu_f(r0), vals[2 * i + 1] * rstd * p.gla_onorm[v0 + 2 * i + 1] * silu_f(r1));
        }
        bf16_t* M = (bf16_t*)(p.ws + WS_MIX) + row * 1024 + h * 128 + v0;
        *(u32x4*)M = (u32x4){pk[0], pk[1], pk[2], pk[3]}; *(u32x4*)(M + 8) = (u32x4){pk[4], pk[5], pk[6], pk[7]};
    }
    __syncthreads();
}


struct GlaPre { u32x4 qc, kc, vc[2], ac, sc[4]; float4 wac; float bac; };
__device__ __forceinline__ void gla_prefetch(PRef p, int gc, int h, GlaPre& g, u32x4 (&rc)[2]) {
    const int tid = threadIdx.x;
    const bf16_t* P = (const bf16_t*)(p.ws + WS_P);
    const bf16_t* rowp = P + (size_t)(gc * 64 + (tid >> 3)) * PW;
    g.qc = *(const u32x4*)(rowp + PC_Q + h * 64 + (tid & 7) * 8);
    g.kc = *(const u32x4*)(rowp + PC_K + h * 64 + (tid & 7) * 8);
#pragma unroll
    for (int i = 0; i < 2; ++i) { const int idx = tid + 512 * i; g.vc[i] = *(const u32x4*)(P + (size_t)(gc * 64 + (idx >> 4)) * PW + PC_V + h * 128 + (idx & 15) * 8); }
#pragma unroll
    for (int i = 0; i < 2; ++i) rc[i] = *(const u32x4*)(rowp + PC_R + h * 128 + (tid & 7) * 16 + 8 * i);
    g.ac = *(const u32x4*)(P + (size_t)(gc * 64 + ((tid & 255) >> 2)) * PW + PC_AF + (tid & 3) * 8);
    const bf16_t* S = (const bf16_t*)(p.ws + WS_SIN);
#pragma unroll
    for (int i = 0; i < 4; ++i) { const int cc = tid + 512 * i, dir = cc >> 10; g.sc[i] = *(const u32x4*)(S + ((size_t)(dir * NCH + gc) * 4 + h) * 8192 + (cc & 1023) * 8); }
    { const int dd = tid >> 8, jj = (tid >> 4) & 15, d4 = tid & 15; g.wac = *(const float4*)((dd == 0 ? p.gla_wa_f : p.gla_wa_b) + jj * 256 + h * 64 + d4 * 4); }
    g.bac = ((tid >> 6) & 1 ? p.gla_ba_b : p.gla_ba_f)[h * 64 + (tid & 63)];
}
template <int OFF> __device__ __forceinline__ s16x4 gla_tr(int vb) { s16x4 r; asm volatile("ds_read_b64_tr_b16 %0, %1 offset:%2" : "=&v"(r) : "v"(vb), "i"(OFF) : "memory"); return r; }
__device__ __forceinline__ void phase_gla_out(PRef p) {
    const int tid = threadIdx.x, lane = tid & 63, wave = tid >> 6, r32 = lane & 31, hi = lane >> 5, G = gridDim.x;
    bf16_t* qe = (bf16_t*)smem;
    bf16_t* ke = qe + 2 * 64 * 72;
    bf16_t* Am = ke + 2 * 64 * 72;
    bf16_t* Qraw = Am; bf16_t* Kraw = Am + 64 * 72;
    char* Vraw = smem + 55296;
    bf16_t* ST = (bf16_t*)(smem + 75776);
    float* af = (float*)(smem + 112640);
    float* wa = af + 2048;
    float* ba = wa + 2048;
    float* tot = ba + 128;
    float* ob = (float*)ke;
    int u = blockIdx.x;
    if (u >= NCH * 4) return;
    const int nt_t = tid >> 3, nt_v0 = (tid & 7) * 16;
    float on[16];
#pragma unroll
    for (int i = 0; i < 16; ++i) on[i] = p.gla_onorm[nt_v0 + i];
    GlaPre g; u32x4 rc[2], rcn[2];
    gla_prefetch(p, u >> 2, u & 3, g, rc);
    const int dir = wave & 1, tq = wave >> 1;
    for (; u < NCH * 4; u += G) {
        const int gc = u >> 2, h = u & 3;
        *(u32x4*)(Qraw + (tid >> 3) * 72 + (tid & 7) * 8) = g.qc;
        *(u32x4*)(Kraw + (tid >> 3) * 72 + (tid & 7) * 8) = g.kc;
#pragma unroll
        for (int i = 0; i < 2; ++i) { const int idx = tid + 512 * i; *(u32x4*)(Vraw + (idx >> 4) * 320 + (idx & 15) * 16) = g.vc[i]; }
#pragma unroll
        for (int i = 0; i < 4; ++i) { const int cc = tid + 512 * i; *(u32x4*)(ST + ((cc >> 10) * 128 + ((cc >> 3) & 127)) * 72 + (cc & 7) * 8) = g.sc[i]; }
        if (tid < 256) { const int t = tid >> 2, ch = tid & 3, dd = ch >> 1, j0 = (ch & 1) * 8; float* q = af + dd * 1024 + t * 16 + j0;
#pragma unroll
            for (int e = 0; e < 4; ++e) { q[2 * e] = __uint_as_float(g.ac[e] << 16); q[2 * e + 1] = __uint_as_float(g.ac[e] & 0xFFFF0000u); } }
        { const int dd = tid >> 8, jj = (tid >> 4) & 15, d4 = tid & 15; *(float4*)(wa + (dd * 16 + jj) * 64 + d4 * 4) = g.wac; }
        if (tid < 128) ba[tid] = g.bac;
        __syncthreads();
        const int un = u + G;
        if (un < NCH * 4) gla_prefetch(p, un >> 2, un & 3, g, rcn);
        float bb[16]; float total;
        {
            float w[16];
#pragma unroll
            for (int j = 0; j < 16; ++j) w[j] = wa[(dir * 16 + j) * 64 + lane];
            const float bias = ba[dir * 64 + lane];
#pragma unroll
            for (int i = 0; i < 16; ++i) {
                const int t = tq * 16 + i;
                float z = bias;
#pragma unroll
                for (int j = 0; j < 16; ++j) z += af[(dir * 64 + t) * 16 + j] * w[j];
                bb[i] = (fminf(z, 0.f) - __logf(1.f + __expf(-fabsf(z)))) * (1.f / 16.f);
            }
            if (dir == 0) {
#pragma unroll
                for (int i = 1; i < 16; ++i) bb[i] += bb[i - 1];
                tot[(dir * 4 + tq) * 64 + lane] = bb[15];
            } else {
#pragma unroll
                for (int i = 14; i >= 0; --i) bb[i] += bb[i + 1];
                tot[(dir * 4 + tq) * 64 + lane] = bb[0];
            }
        }
        __syncthreads();
        {
            float offs = 0.f; total = 0.f;
#pragma unroll
            for (int q = 0; q < 4; ++q) { const float tv = tot[(dir * 4 + q) * 64 + lane]; total += tv; if (dir == 0 ? (q < tq) : (q > tq)) offs += tv; }
#pragma unroll
            for (int i = 0; i < 16; ++i) bb[i] += offs;
        }
#pragma unroll
        for (int i = 0; i < 16; ++i) {
            const int t = tq * 16 + i;
            const float qv = bf2f(Qraw[t * 72 + lane]) * 0.125f, kv = bf2f(Kraw[t * 72 + lane]);
            qe[(dir * 64 + t) * 72 + lane] = f2bf(qv * __expf(bb[i]));
            ke[(dir * 64 + t) * 72 + lane] = f2bf(kv * __expf(-bb[i]));
        }
        __syncthreads();
        {
            const int mdir = wave >> 2, tb = (wave >> 1) & 1, sb = wave & 1;
            f32x16 acc = {};
#pragma unroll
            for (int ks = 0; ks < 4; ++ks) {
                const bf16x8 a = *(const bf16x8*)(qe + (mdir * 64 + tb * 32 + r32) * 72 + ks * 16 + hi * 8);
                const bf16x8 b = *(const bf16x8*)(ke + (mdir * 64 + sb * 32 + r32) * 72 + ks * 16 + hi * 8);
                acc = __builtin_amdgcn_mfma_f32_32x32x16_bf16(a, b, acc, 0, 0, 0);
            }
            const int sI = sb * 32 + r32;
#pragma unroll
            for (int r = 0; r < 16; ++r) { const int t = tb * 32 + crow(r, hi); const bool keep = (mdir == 0) ? (sI <= t) : (sI >= t); Am[(mdir * 64 + t) * 72 + sI] = f2bf(keep ? acc[r] : 0.f); }
        }
        __syncthreads();
        f32x16 o = {};
        const int tb = wave >> 2, vbk = wave & 3;
        {
            const int vb = (int)(uintptr_t)Vraw + (8 * hi + ((lane & 15) >> 2)) * 320 + (vbk * 32 + 16 * ((lane >> 4) & 1) + 4 * (lane & 3)) * 2;
#define GLA_PV(KS, DIRN) do { const s16x4 l_ = gla_tr<(KS) * 5120>(vb), h_ = gla_tr<(KS) * 5120 + 1280>(vb); \
            const bf16x8 a1 = *(const bf16x8*)(Am + ((DIRN) * 64 + tb * 32 + r32) * 72 + (KS) * 16 + hi * 8); \
            const bf16x8 a2 = *(const bf16x8*)(qe + ((DIRN) * 64 + tb * 32 + r32) * 72 + (KS) * 16 + hi * 8); \
            const bf16x8 b2 = *(const bf16x8*)(ST + ((DIRN) * 128 + vbk * 32 + r32) * 72 + (KS) * 16 + hi * 8); \
            asm volatile("s_waitcnt lgkmcnt(0)" ::: "memory"); SBAR(); \
            o = __builtin_amdgcn_mfma_f32_32x32x16_bf16(a1, (bf16x8){l_[0], l_[1], l_[2], l_[3], h_[0], h_[1], h_[2], h_[3]}, o, 0, 0, 0); \
            o = __builtin_amdgcn_mfma_f32_32x32x16_bf16(a2, b2, o, 0, 0, 0); } while (0)
            GLA_PV(0, 0); GLA_PV(1, 0); GLA_PV(2, 0); GLA_PV(3, 0); GLA_PV(0, 1); GLA_PV(1, 1); GLA_PV(2, 1); GLA_PV(3, 1);
#undef GLA_PV
        }
        __syncthreads();
#pragma unroll
        for (int r = 0; r < 16; ++r) ob[(tb * 32 + crow(r, hi)) * 132 + vbk * 32 + r32] = o[r];
        __syncthreads();
        {
            float vals[16]; float ss = 0.f;
#pragma unroll
            for (int i = 0; i < 4; ++i) { const f32x4 x = *(const f32x4*)(ob + nt_t * 132 + nt_v0 + 4 * i); vals[4 * i] = x[0]; vals[4 * i + 1] = x[1]; vals[4 * i + 2] = x[2]; vals[4 * i + 3] = x[3]; }
#pragma unroll
            for (int i = 0; i < 16; ++i) ss += vals[i] * vals[i];
            ss += __shfl_xor(ss, 1); ss += __shfl_xor(ss, 2); ss += __shfl_xor(ss, 4);
            const float rstd = rsqrtf(ss * (1.f / 128.f) + EPSN);
            unsigned pk[8];
#pragma unroll
            for (int i = 0; i < 8; ++i) {
                const unsigned w = rc[i >> 2][i & 3];
                const float r0 = __uint_as_float(w << 16), r1 = __uint_as_float(w & 0xFFFF0000u);
                const float s0 = r0 * __builtin_amdgcn_rcpf(1.f + __expf(-r0)), s1 = r1 * __builtin_amdgcn_rcpf(1.f + __expf(-r1));
                pk[i] = cvtpk(vals[2 * i] * rstd * on[2 * i] * s0, vals[2 * i + 1] * rstd * on[2 * i + 1] * s1);
            }
            bf16_t* M = (bf16_t*)(p.ws + WS_MIX) + ((size_t)gc * 64 + nt_t) * 1024 + h * 128 + nt_v0;
            *(u32x4*)M = (u32x4){pk[0], pk[1], pk[2], pk[3]}; *(u32x4*)(M + 8) = (u32x4){pk[4], pk[5], pk[6], pk[7]};
        }
        rc[0] = rcn[0]; rc[1] = rcn[1];
        __syncthreads();
    }
}

namespace mla {
constexpr int KVBLK = 64, QBLK = 32;
#ifndef MLA_QREG
#define MLA_QREG 12
#endif
constexpr int QREG = MLA_QREG;
constexpr float SCALE = 0.07216878364870322f;
constexpr float THR = 8.f;
constexpr int LDQ = 768, LDK = 768, LDV = 512, LDO = 1024;
constexpr int SHM_V = KVBLK * 128 * 2, SHM_K = KVBLK * 400;
#define MKSWZ(row, colB) ((row) * 400 + (colB))
__device__ __forceinline__ void partialSM(f32x16& p0, f32x16& p1, float& m_reg, float& mn, float& alpha) {
    constexpr float C = SCALE * LOG2E;
    float pmax = p0[0];
#pragma unroll
    for (int r = 1; r < 16; ++r) pmax = fmaxf(pmax, p0[r]);
#pragma unroll
    for (int r = 0; r < 16; ++r) pmax = fmaxf(pmax, p1[r]);
    { auto rr = __builtin_amdgcn_permlane32_swap(__float_as_uint(pmax), __float_as_uint(pmax), false, false);
      pmax = fmaxf(__uint_as_float(rr[0]), __uint_as_float(rr[1])); }
    if (__builtin_expect(__all(pmax - m_reg <= THR / SCALE), 1)) { mn = m_reg; alpha = 1.f; }
    else { mn = fmaxf(m_reg, pmax); alpha = __builtin_amdgcn_exp2f((m_reg - mn) * C); m_reg = mn; }
    const float mnC = -mn * C;
#pragma unroll
    for (int r = 0; r < 16; ++r) p0[r] = fmaf(p0[r], C, mnC);
#pragma unroll
    for (int r = 0; r < 16; ++r) p1[r] = fmaf(p1[r], C, mnC);
#pragma unroll
    for (int r = 0; r < 16; ++r) p0[r] = __builtin_amdgcn_exp2f(p0[r]);
}
__device__ __forceinline__ void finishSM(f32x16& p0, f32x16& p1, float alpha, float& l_reg, bf16x8& pa0, bf16x8& pa1, bf16x8& pa2, bf16x8& pa3) {
#pragma unroll
    for (int r = 0; r < 16; ++r) p1[r] = __builtin_amdgcn_exp2f(p1[r]);
    float ps = 0;
#pragma unroll
    for (int r = 0; r < 16; ++r) ps += p0[r];
#pragma unroll
    for (int r = 0; r < 16; ++r) ps += p1[r];
    { auto rr = __builtin_amdgcn_permlane32_swap(__float_as_uint(ps), __float_as_uint(ps), false, false);
      ps = __uint_as_float(rr[0]) + __uint_as_float(rr[1]); }
    l_reg = l_reg * alpha + ps;
#define PK4(P, BASE, OUT) do { unsigned a0 = cvtpk(P[BASE + 0], P[BASE + 1]), a1 = cvtpk(P[BASE + 2], P[BASE + 3]);   \
    unsigned b0 = cvtpk(P[BASE + 4], P[BASE + 5]), b1 = cvtpk(P[BASE + 6], P[BASE + 7]);                              \
    auto r0 = __builtin_amdgcn_permlane32_swap(a0, b0, false, false); auto r1 = __builtin_amdgcn_permlane32_swap(a1, b1, false, false); \
    u32x4 w = {r0[0], r1[0], r0[1], r1[1]}; OUT = *reinterpret_cast<bf16x8*>(&w); } while (0)
    PK4(p0, 0, pa0); PK4(p0, 8, pa1); PK4(p1, 0, pa2); PK4(p1, 8, pa3);
}
__device__ __forceinline__ void qkt(f32x16& p0, f32x16& p1, const char* Ks, const bf16x8* qr, const char* qlds, int r32, int hi) {
    p0 = f32x16{}; p1 = f32x16{};
#pragma unroll
    for (int d0 = 0; d0 < 12; ++d0) { const int cb = (d0 * 16 + hi * 8) * 2;
        const bf16x8 b0 = *reinterpret_cast<const bf16x8*>(Ks + MKSWZ(r32, cb));
        const bf16x8 b1 = *reinterpret_cast<const bf16x8*>(Ks + MKSWZ(32 + r32, cb));
        const bf16x8 qv = (d0 < QREG) ? qr[d0 < QREG ? d0 : 0] : *reinterpret_cast<const bf16x8*>(qlds + (d0 - QREG) * 1024);
        p0 = __builtin_amdgcn_mfma_f32_32x32x16_bf16(b0, qv, p0, 0, 0, 0);
        p1 = __builtin_amdgcn_mfma_f32_32x32x16_bf16(b1, qv, p1, 0, 0, 0); }
}
__device__ __forceinline__ int v_st(int k, int c) { const int kk = (k & ~0xC) | ((k & 4) << 1) | ((k & 8) >> 1); return ((kk >> 3) * 4 + (c >> 5)) * 512 + ((kk & 7) * 32 + (c & 31)) * 2; }
__device__ __forceinline__ int v_rd_base(int lane) { return ((lane & 3) << 3) | (((lane >> 2) & 3) << 6) | (((lane >> 4) & 1) << 5) | (((lane >> 5) & 1) << 8); }
constexpr int v_rd_off(int d0, int ks, int half) { return d0 * 512 + ks * 4096 + half * 2048; }
template <int OFF> __device__ __forceinline__ s16x4 tr_read(int vb) {
    s16x4 r; asm volatile("ds_read_b64_tr_b16 %0, %1 offset:%2" : "=&v"(r) : "v"(vb), "i"(OFF) : "memory"); return r;
}
template <int D0> __device__ __forceinline__ void pv_one(f32x16& od, int vb, bf16x8 pa0, bf16x8 pa1, bf16x8 pa2, bf16x8 pa3) {
#define PKV(L, H) (bf16x8){L[0], L[1], L[2], L[3], H[0], H[1], H[2], H[3]}
    {
    const s16x4 l0 = tr_read<v_rd_off(D0, 0, 0)>(vb), h0 = tr_read<v_rd_off(D0, 0, 1)>(vb), l1 = tr_read<v_rd_off(D0, 1, 0)>(vb), h1 = tr_read<v_rd_off(D0, 1, 1)>(vb);
    asm volatile("s_waitcnt lgkmcnt(0)" ::: "memory"); SBAR();
    od = __builtin_amdgcn_mfma_f32_32x32x16_bf16(pa0, PKV(l0, h0), od, 0, 0, 0);
    od = __builtin_amdgcn_mfma_f32_32x32x16_bf16(pa1, PKV(l1, h1), od, 0, 0, 0);
    }
    {
    const s16x4 l2 = tr_read<v_rd_off(D0, 2, 0)>(vb), h2 = tr_read<v_rd_off(D0, 2, 1)>(vb), l3 = tr_read<v_rd_off(D0, 3, 0)>(vb), h3 = tr_read<v_rd_off(D0, 3, 1)>(vb);
    asm volatile("s_waitcnt lgkmcnt(0)" ::: "memory"); SBAR();
    od = __builtin_amdgcn_mfma_f32_32x32x16_bf16(pa2, PKV(l2, h2), od, 0, 0, 0);
    od = __builtin_amdgcn_mfma_f32_32x32x16_bf16(pa3, PKV(l3, h3), od, 0, 0, 0);
    }
#undef PKV
}
__device__ __forceinline__ void pv_d0(f32x16* o, int vb, bf16x8 pa0, bf16x8 pa1, bf16x8 pa2, bf16x8 pa3) {
    pv_one<0>(o[0], vb, pa0, pa1, pa2, pa3); pv_one<1>(o[1], vb, pa0, pa1, pa2, pa3); pv_one<2>(o[2], vb, pa0, pa1, pa2, pa3); pv_one<3>(o[3], vb, pa0, pa1, pa2, pa3);
}
__device__ __forceinline__ void attn_body(const bf16_t* __restrict__ Qb, const bf16_t* __restrict__ Kh, const bf16_t* __restrict__ Vh, bf16_t* __restrict__ Ob, int seq) {
    char* lds = smem;
    const int tid = threadIdx.x, wid = tid >> 6, lane = tid & 63, r32 = lane & 31, hi = lane >> 5;
    char* V_lds = lds; char* K_lds = lds + 2 * SHM_V;
    float* ws = (float*)(lds + 2 * SHM_V + 2 * SHM_K) + wid * 64; float* li_l = ws; float* al_l = ws + 32;
    float m_reg = -1e30f, l_reg = 0; f32x16 o[4] = {}; bf16x8 qr[QREG];
    const bf16_t* Qw = Qb + (long)(wid * QBLK + r32) * LDQ + hi * 8;
#pragma unroll
    for (int d0 = 0; d0 < QREG; ++d0) qr[d0] = *reinterpret_cast<const bf16x8*>(Qw + d0 * 16);
    char* qlds = lds + 2 * SHM_V + 2 * SHM_K + 2048 + wid * ((12 - QREG) * 1024) + lane * 16;
#pragma unroll
    for (int d0 = 0; d0 < 12 - QREG; ++d0) *reinterpret_cast<bf16x8*>(qlds + d0 * 1024) = *reinterpret_cast<const bf16x8*>(Qw + (QREG + d0) * 16);
    const int sr = tid >> 4, sc = (tid & 15) * 8, vst0 = v_st(sr, sc), vst1 = v_st(32 + sr, sc);
    int kgo[3], kso[3];
#pragma unroll
    for (int i = 0; i < 3; ++i) { const int id = tid + 512 * i, kr_ = id / 24, kc_ = (id % 24) * 8; kgo[i] = kr_ * LDK + kc_; kso[i] = MKSWZ(kr_, kc_ * 2); }
    const int vb0 = (int)(uintptr_t)V_lds + v_rd_base(lane);
    struct { bf16x8 vs0, vs1, ks0, ks1, ks2; } st_;
#define SLOAD(k0) do { st_.vs0 = *(const bf16x8*)(&Vh[(long)((k0) + sr) * LDV + sc]); st_.vs1 = *(const bf16x8*)(&Vh[(long)((k0) + 32 + sr) * LDV + sc]); \
    st_.ks0 = *(const bf16x8*)(&Kh[(long)(k0) * LDK + kgo[0]]); st_.ks1 = *(const bf16x8*)(&Kh[(long)(k0) * LDK + kgo[1]]); \
    st_.ks2 = *(const bf16x8*)(&Kh[(long)(k0) * LDK + kgo[2]]); } while (0)
#define SWRITE(b) do { *(bf16x8*)(V_lds + (b) * SHM_V + vst0) = st_.vs0; *(bf16x8*)(V_lds + (b) * SHM_V + vst1) = st_.vs1; \
    *(bf16x8*)(K_lds + (b) * SHM_K + kso[0]) = st_.ks0; *(bf16x8*)(K_lds + (b) * SHM_K + kso[1]) = st_.ks1; \
    *(bf16x8*)(K_lds + (b) * SHM_K + kso[2]) = st_.ks2; } while (0)
#define RESC(a) do { if (__any((a) < 1.f)) { if (hi == 0) al_l[r32] = (a); asm volatile("s_waitcnt lgkmcnt(0)" ::: "memory"); \
    _Pragma("unroll") for (int d = 0; d < 4; ++d) _Pragma("unroll") for (int r = 0; r < 16; ++r) o[d][r] *= al_l[crow(r, hi)]; } } while (0)
    f32x16 pA0, pA1, pB0, pB1; float mnA, mnB, alA, alB; bf16x8 pa0, pa1, pa2, pa3; const int NT = seq / KVBLK;
    SLOAD(0); SWRITE(0); __syncthreads();
    qkt(pA0, pA1, K_lds, qr, qlds, r32, hi); partialSM(pA0, pA1, m_reg, mnA, alA);
    SLOAD(KVBLK); SWRITE(1); __syncthreads();
    for (int j = 1; j + 1 < NT; j += 2) {
        SBAR(); qkt(pB0, pB1, K_lds + SHM_K, qr, qlds, r32, hi);
        finishSM(pA0, pA1, alA, l_reg, pa0, pa1, pa2, pa3); SBAR();
        SLOAD((j + 1) * KVBLK); SBAR();
        pv_d0(o, vb0, pa0, pa1, pa2, pa3); partialSM(pB0, pB1, m_reg, mnB, alB);
        __syncthreads(); SWRITE(0);
        RESC(alB); __syncthreads();
        SBAR(); qkt(pA0, pA1, K_lds, qr, qlds, r32, hi);
        finishSM(pB0, pB1, alB, l_reg, pa0, pa1, pa2, pa3); SBAR();
        SLOAD((j + 2) * KVBLK); SBAR();
        pv_d0(o, vb0 + SHM_V, pa0, pa1, pa2, pa3); partialSM(pA0, pA1, m_reg, mnA, alA);
        __syncthreads(); SWRITE(1);
        RESC(alA); __syncthreads();
    }
    SBAR(); qkt(pB0, pB1, K_lds + SHM_K, qr, qlds, r32, hi);
    finishSM(pA0, pA1, alA, l_reg, pa0, pa1, pa2, pa3); SBAR();
    pv_d0(o, vb0, pa0, pa1, pa2, pa3); partialSM(pB0, pB1, m_reg, mnB, alB);
    __syncthreads(); RESC(alB);
    finishSM(pB0, pB1, alB, l_reg, pa0, pa1, pa2, pa3); SBAR();
    pv_d0(o, vb0 + SHM_V, pa0, pa1, pa2, pa3);
    if (hi == 0) li_l[r32] = l_reg; asm volatile("s_waitcnt lgkmcnt(0)" ::: "memory");
    float rli[16];
#pragma unroll
    for (int r = 0; r < 16; ++r) rli[r] = __builtin_amdgcn_rcpf(li_l[crow(r, hi)]);
    bf16_t* Ow = Ob + (long)(wid * QBLK) * LDO;
#pragma unroll
    for (int r = 0; r < 16; ++r) { const int orow = crow(r, hi);
#pragma unroll
        for (int d0 = 0; d0 < 4; ++d0) Ow[(long)orow * LDO + d0 * 32 + r32] = f2bf(o[d0][r] * rli[r]); }
    __syncthreads();
#undef SLOAD
#undef SWRITE
#undef RESC
}
}

namespace mla8 {
typedef int i32x8 __attribute__((ext_vector_type(8)));
constexpr int KVBLK = 64;
constexpr float SCALE = 0.07216878364870322f;
constexpr float THR = 3.f;
constexpr float PBIAS = 4.f;
constexpr int KROW = 208, VROW = 80;
constexpr int SHM_K = KVBLK * KROW, SHM_V = 128 * VROW;
constexpr int ONE = 0x7F7F7F7F;
__device__ __forceinline__ i32x8 ld32(const char* a) { const i32x4 lo = *(const i32x4*)a, hi_ = *(const i32x4*)(a + 16); return __builtin_shufflevector(lo, hi_, 0, 1, 2, 3, 4, 5, 6, 7); }
__device__ __forceinline__ void qkt(f32x16& p0, f32x16& p1, const char* Kw, const i32x8 (&q)[3]) {
    p0 = f32x16{}; p1 = f32x16{};
#pragma unroll
    for (int s_ = 0; s_ < 3; ++s_) {
        const i32x8 a0 = ld32(Kw + s_ * 64), a1 = ld32(Kw + 32 * KROW + s_ * 64);
        p0 = __builtin_amdgcn_mfma_scale_f32_32x32x64_f8f6f4(a0, q[s_], p0, 0, 0, 0, ONE, 0, ONE);
        p1 = __builtin_amdgcn_mfma_scale_f32_32x32x64_f8f6f4(a1, q[s_], p1, 0, 0, 0, ONE, 0, ONE);
    }
}
__device__ __forceinline__ void partialSM(f32x16& p0, f32x16& p1, float& m_reg, float& alpha) {
    constexpr float C = SCALE * LOG2E;
    float pmax = p0[0];
#pragma unroll
    for (int r = 1; r < 16; ++r) pmax = fmaxf(pmax, p0[r]);
#pragma unroll
    for (int r = 0; r < 16; ++r) pmax = fmaxf(pmax, p1[r]);
    { auto rr = __builtin_amdgcn_permlane32_swap(__float_as_uint(pmax), __float_as_uint(pmax), false, false);
      pmax = fmaxf(__uint_as_float(rr[0]), __uint_as_float(rr[1])); }
    float mn;
    if (__builtin_expect(__all(pmax - m_reg <= THR / SCALE), 1)) { mn = m_reg; alpha = 1.f; }
    else { mn = fmaxf(m_reg, pmax); alpha = __builtin_amdgcn_exp2f((m_reg - mn) * C); m_reg = mn; }
    const float mnC = PBIAS - mn * C;
#pragma unroll
    for (int r = 0; r < 16; ++r) p0[r] = fmaf(p0[r], C, mnC);
#pragma unroll
    for (int r = 0; r < 16; ++r) p1[r] = fmaf(p1[r], C, mnC);
#pragma unroll
    for (int r = 0; r < 16; ++r) p0[r] = __builtin_amdgcn_exp2f(p0[r]);
}
__device__ __forceinline__ void finishSM(f32x16& p0, f32x16& p1, float alpha, float& l_reg, i32x8& P8) {
#pragma unroll
    for (int r = 0; r < 16; ++r) p1[r] = __builtin_amdgcn_exp2f(p1[r]);
    float ps = 0;
#pragma unroll
    for (int r = 0; r < 16; ++r) ps += p0[r];
#pragma unroll
    for (int r = 0; r < 16; ++r) ps += p1[r];
    { auto rr = __builtin_amdgcn_permlane32_swap(__float_as_uint(ps), __float_as_uint(ps), false, false);
      ps = __uint_as_float(rr[0]) + __uint_as_float(rr[1]); }
    l_reg = l_reg * alpha + ps;
#pragma unroll
    for (int w = 0; w < 4; ++w) {
        int a = __builtin_amdgcn_cvt_pk_fp8_f32(p0[4 * w], p0[4 * w + 1], 0, false); a = __builtin_amdgcn_cvt_pk_fp8_f32(p0[4 * w + 2], p0[4 * w + 3], a, true); P8[w] = a;
        int b = __builtin_amdgcn_cvt_pk_fp8_f32(p1[4 * w], p1[4 * w + 1], 0, false); b = __builtin_amdgcn_cvt_pk_fp8_f32(p1[4 * w + 2], p1[4 * w + 3], b, true); P8[4 + w] = b;
    }
}
__device__ __forceinline__ void pv(f32x16 (&o)[4], const char* Vw, const i32x8& P8) {
#pragma unroll
    for (int d0 = 0; d0 < 4; ++d0) { const i32x8 av = ld32(Vw + d0 * 32 * VROW); o[d0] = __builtin_amdgcn_mfma_scale_f32_32x32x64_f8f6f4(av, P8, o[d0], 0, 0, 0, ONE, 0, ONE); }
}
__device__ __forceinline__ void attn_body(const unsigned char* __restrict__ Q8w, const unsigned char* __restrict__ K8h, const unsigned char* __restrict__ V8h, bf16_t* __restrict__ Ob, int seq) {
    char* lds = smem;
    const int tid = tid_opaque(), wid = tid >> 6, lane = tid & 63, r32 = lane & 31, hi = lane >> 5;
    char* K_lds = lds; char* V_lds = lds + 2 * SHM_K;
    float m_reg = -1e30f, l_reg = 0; f32x16 o[4] = {};
    i32x8 q[3];
    { const unsigned char* qp = Q8w + (size_t)(wid * 32 + r32) * 768 + hi * 32;
#pragma unroll
      for (int s_ = 0; s_ < 3; ++s_) { const i32x4 lo = *(const i32x4*)(qp + s_ * 64), hi_ = *(const i32x4*)(qp + s_ * 64 + 16); q[s_] = __builtin_shufflevector(lo, hi_, 0, 1, 2, 3, 4, 5, 6, 7); } }
    const int kc0 = tid, kc1 = 512 + (tid & 255);
    const int kso0 = (kc0 / 12) * KROW + (kc0 % 12) * 16, kso1 = (kc1 / 12) * KROW + (kc1 % 12) * 16, vso = (tid >> 2) * VROW + (tid & 3) * 16;
    const bool two = tid < 256;
    const char* Kw = K_lds + r32 * KROW + hi * 32; const char* Vw = V_lds + r32 * VROW + hi * 32;
    struct { u32x4 k0, k1, v; } st_;
#define SLOAD(t_) do { const unsigned char* kt_ = K8h + (size_t)(t_) * (KVBLK * 192); st_.k0 = *(const u32x4*)(kt_ + kc0 * 16); if (two) st_.k1 = *(const u32x4*)(kt_ + kc1 * 16); \
    st_.v = *(const u32x4*)(V8h + (size_t)(t_) * 8192 + tid * 16); } while (0)
#define SWRITE(b) do { *(u32x4*)(K_lds + (b) * SHM_K + kso0) = st_.k0; if (two) *(u32x4*)(K_lds + (b) * SHM_K + kso1) = st_.k1; *(u32x4*)(V_lds + (b) * SHM_V + vso) = st_.v; } while (0)
#define RESC(a) do { if (__any((a) < 1.f)) { _Pragma("unroll") for (int d = 0; d < 4; ++d) _Pragma("unroll") for (int r = 0; r < 16; ++r) o[d][r] *= (a); } } while (0)
    f32x16 pA0, pA1, pB0, pB1; float alA, alB; i32x8 P8; const int NT = seq / KVBLK;
    SLOAD(0); SWRITE(0); __syncthreads();
    qkt(pA0, pA1, Kw, q); partialSM(pA0, pA1, m_reg, alA);
    SLOAD(1); SWRITE(1); __syncthreads();
    for (int j = 1; j + 1 < NT; j += 2) {
        SBAR(); qkt(pB0, pB1, Kw + SHM_K, q);
        finishSM(pA0, pA1, alA, l_reg, P8); SBAR();
        SLOAD(j + 1); SBAR();
        pv(o, Vw, P8); partialSM(pB0, pB1, m_reg, alB);
        __syncthreads(); SWRITE(0);
        RESC(alB); __syncthreads();
        SBAR(); qkt(pA0, pA1, Kw, q);
        finishSM(pB0, pB1, alB, l_reg, P8); SBAR();
        SLOAD(j + 2); SBAR();
        pv(o, Vw + SHM_V, P8); partialSM(pA0, pA1, m_reg, alA);
        __syncthreads(); SWRITE(1);
        RESC(alA); __syncthreads();
    }
    SBAR(); qkt(pB0, pB1, Kw + SHM_K, q);
    finishSM(pA0, pA1, alA, l_reg, P8); SBAR();
    pv(o, Vw, P8); partialSM(pB0, pB1, m_reg, alB);
    RESC(alB);
    finishSM(pB0, pB1, alB, l_reg, P8); SBAR();
    pv(o, Vw + SHM_V, P8);
    const float rl = __builtin_amdgcn_rcpf(l_reg);
    bf16_t* Ow = Ob + (size_t)(wid * 32 + r32) * 1024 + 4 * hi;
#pragma unroll
    for (int d0 = 0; d0 < 4; ++d0)
#pragma unroll
        for (int g = 0; g < 4; ++g)
            *(u32x2*)(Ow + d0 * 32 + 8 * g) = (u32x2){cvtpk(o[d0][4 * g] * rl, o[d0][4 * g + 1] * rl), cvtpk(o[d0][4 * g + 2] * rl, o[d0][4 * g + 3] * rl)};
    __syncthreads();
#undef SLOAD
#undef SWRITE
#undef RESC
}
typedef float f32x2 __attribute__((ext_vector_type(2)));
#define M8_PAIR(P, i) ((f32x2){P[2 * (i)], P[2 * (i) + 1]})
#define M8_EXP(P, i) P[i] = __builtin_amdgcn_exp2f(P[i])
#define M8_MFMA(A, B, C) __builtin_amdgcn_mfma_scale_f32_32x32x64_f8f6f4(A, B, C, 0, 0, 0, ONE, 0, ONE)
constexpr int NEXP_B = 8;
#define M8_F1(P0, P1) do { M8_EXP(P0, 8); M8_EXP(P0, 9); M8_EXP(P0, 10); M8_EXP(P0, 11); M8_EXP(P0, 12); M8_EXP(P0, 13); } while (0)
#define M8_F2(P0, P1) do { M8_EXP(P0, 14); M8_EXP(P0, 15); M8_EXP(P1, 0); M8_EXP(P1, 1); M8_EXP(P1, 2); M8_EXP(P1, 3); } while (0)
#define M8_F3(P0, P1) do { M8_EXP(P1, 4); M8_EXP(P1, 5); M8_EXP(P1, 6); M8_EXP(P1, 7); M8_EXP(P1, 8); M8_EXP(P1, 9); } while (0)
#define M8_F4(P0, P1) do { M8_EXP(P1, 10); M8_EXP(P1, 11); M8_EXP(P1, 12); M8_EXP(P1, 13); M8_EXP(P1, 14); M8_EXP(P1, 15); } while (0)
#define M8_F5(P0, P1) do { f32x2 t0_ = M8_PAIR(P0, 0) + M8_PAIR(P0, 1), t1_ = M8_PAIR(P0, 2) + M8_PAIR(P0, 3), t2_ = M8_PAIR(P0, 4) + M8_PAIR(P0, 5), t3_ = M8_PAIR(P0, 6) + M8_PAIR(P0, 7); \
    f32x2 t4_ = M8_PAIR(P1, 0) + M8_PAIR(P1, 1), t5_ = M8_PAIR(P1, 2) + M8_PAIR(P1, 3), t6_ = M8_PAIR(P1, 4) + M8_PAIR(P1, 5), t7_ = M8_PAIR(P1, 6) + M8_PAIR(P1, 7); \
    t0_ += t1_; t2_ += t3_; t4_ += t5_; t6_ += t7_; t0_ += t2_; t4_ += t6_; t0_ += t4_; psum = t0_[0] + t0_[1]; \
    _Pragma("unroll") for (int w_ = 0; w_ < 4; ++w_) { int a_ = __builtin_amdgcn_cvt_pk_fp8_f32(P0[4 * w_], P0[4 * w_ + 1], 0, false); P8[w_] = __builtin_amdgcn_cvt_pk_fp8_f32(P0[4 * w_ + 2], P0[4 * w_ + 3], a_, true); } } while (0)
#define M8_F6(P0, P1, AL) do { { auto rr_ = __builtin_amdgcn_permlane32_swap(__float_as_uint(psum), __float_as_uint(psum), false, false); psum = __uint_as_float(rr_[0]) + __uint_as_float(rr_[1]); } \
    l_reg = fmaf(l_reg, AL, psum); \
    _Pragma("unroll") for (int w_ = 0; w_ < 4; ++w_) { int b_ = __builtin_amdgcn_cvt_pk_fp8_f32(P1[4 * w_], P1[4 * w_ + 1], 0, false); P8[4 + w_] = __builtin_amdgcn_cvt_pk_fp8_f32(P1[4 * w_ + 2], P1[4 * w_ + 3], b_, true); } } while (0)
#define M8_P1(P0, P1) do { float x_ = fmaxf(P0[0], P0[1]); _Pragma("unroll") for (int r_ = 2; r_ < 16; r_ += 2) x_ = fmaxf(fmaxf(x_, P0[r_]), P0[r_ + 1]); \
    _Pragma("unroll") for (int r_ = 0; r_ < 16; r_ += 2) x_ = fmaxf(fmaxf(x_, P1[r_]), P1[r_ + 1]); \
    { auto rr_ = __builtin_amdgcn_permlane32_swap(__float_as_uint(x_), __float_as_uint(x_), false, false); pmax = fmaxf(__uint_as_float(rr_[0]), __uint_as_float(rr_[1])); } } while (0)
#define M8_P2(P0, P1, AL) do { const bool keep_ = __all(pmax - m_reg <= THR / SCALE); const float mn_ = keep_ ? m_reg : fmaxf(m_reg, pmax); \
    AL = keep_ ? 1.f : __builtin_amdgcn_exp2f((m_reg - mn_) * (SCALE * LOG2E)); m_reg = mn_; const float mc_ = PBIAS - mn_ * (SCALE * LOG2E); mnC2 = (f32x2){mc_, mc_}; \
    _Pragma("unroll") for (int i_ = 0; i_ < 8; ++i_) { const f32x2 t_ = M8_PAIR(P0, i_) * C2 + mnC2; P0[2 * i_] = t_[0]; P0[2 * i_ + 1] = t_[1]; } } while (0)
#define M8_P3(P0, P1) do { _Pragma("unroll") for (int i_ = 0; i_ < 8; ++i_) { const f32x2 t_ = M8_PAIR(P1, i_) * C2 + mnC2; P1[2 * i_] = t_[0]; P1[2 * i_ + 1] = t_[1]; } \
    M8_EXP(P0, 0); M8_EXP(P0, 1); M8_EXP(P0, 2); M8_EXP(P0, 3); } while (0)
#define M8_P4(P0, P1) do { M8_EXP(P0, 4); M8_EXP(P0, 5); M8_EXP(P0, 6); M8_EXP(P0, 7); } while (0)
__device__ __forceinline__ void attn_body2(const unsigned char* __restrict__ Q8w, const unsigned char* __restrict__ K8h, const unsigned char* __restrict__ V8h, bf16_t* __restrict__ Ob, int seq) {
    char* lds = smem;
    const int tid = tid_opaque(), wid = tid >> 6, lane = tid & 63, r32 = lane & 31, hi = lane >> 5;
    constexpr int BUF = SHM_K + SHM_V;
    float m_reg = -1e30f, l_reg = 0; f32x16 o[4] = {};
    i32x8 q[3];
    { const unsigned char* qp = Q8w + (size_t)(wid * 32 + r32) * 768 + hi * 32;
#pragma unroll
      for (int s_ = 0; s_ < 3; ++s_) { const i32x4 lo = *(const i32x4*)(qp + s_ * 64), hi_ = *(const i32x4*)(qp + s_ * 64 + 16); q[s_] = __builtin_shufflevector(lo, hi_, 0, 1, 2, 3, 4, 5, 6, 7); } }
    const int kc0 = tid, kc1 = 512 + (tid & 255);
    const int kso0 = (kc0 / 12) * KROW + (kc0 % 12) * 16, kso1 = (kc1 / 12) * KROW + (kc1 % 12) * 16, vso = SHM_K + (tid >> 2) * VROW + (tid & 3) * 16;
    const bool two = tid < 256;
    const char* Kw = lds + r32 * KROW + hi * 32; const char* Vw = lds + SHM_K + r32 * VROW + hi * 32;
    struct { u32x4 k0, k1, v; } st_;
#define SLOAD(t_) do { const unsigned char* kt_ = K8h + (size_t)(t_) * (KVBLK * 192); st_.k0 = *(const u32x4*)(kt_ + kc0 * 16); if (two) st_.k1 = *(const u32x4*)(kt_ + kc1 * 16); \
    st_.v = *(const u32x4*)(V8h + (size_t)(t_) * 8192 + tid * 16); } while (0)
#define SWRITE(bo) do { *(u32x4*)(lds + (bo) + kso0) = st_.k0; if (two) *(u32x4*)(lds + (bo) + kso1) = st_.k1; *(u32x4*)(lds + (bo) + vso) = st_.v; } while (0)
#define RESC(a) do { if (__any((a) < 1.f)) { _Pragma("unroll") for (int d = 0; d < 4; ++d) _Pragma("unroll") for (int r = 0; r < 16; ++r) o[d][r] *= (a); } } while (0)
    f32x16 pA0, pA1, pB0, pB1; float alA = 1.f, alB = 1.f, pmax, psum; i32x8 P8; f32x2 mnC2; const f32x2 C2 = {SCALE * LOG2E, SCALE * LOG2E};
    const int NT = seq / KVBLK;
#define TIE3(a, b, c) asm volatile("" : "+v"(a), "+v"(b), "+v"(c))
#define TIE4(a, b, c, d) asm volatile("" : "+v"(a), "+v"(b), "+v"(c), "+v"(d))
#define TIE5(a, b, c, d, e) asm volatile("" : "+v"(a), "+v"(b), "+v"(c), "+v"(d), "+v"(e))
#define TIE6(a, b, c, d, e, f) asm volatile("" : "+v"(a), "+v"(b), "+v"(c), "+v"(d), "+v"(e), "+v"(f))
#define M8_STEP(PC0, PC1, ALC, PN0, PN1, ALN, kb, vb, DO_QK) do { \
    i32x8 k00, k10, k01, k11, k02, k12, v0, v1, v2, v3; \
    int ko_ = (kb), vo_ = (vb);        \
    if (DO_QK) { k00 = ld32(Kw + ko_); k10 = ld32(Kw + ko_ + 32 * KROW); k01 = ld32(Kw + ko_ + 64); k11 = ld32(Kw + ko_ + 32 * KROW + 64); \
        PN0 = M8_MFMA(k00, q[0], (f32x16){}); TIE4(PN0, PC0, PC1, ko_); } \
    M8_F1(PC0, PC1); \
    if (DO_QK) { k02 = ld32(Kw + ko_ + 128); k12 = ld32(Kw + ko_ + 32 * KROW + 128); TIE3(PC0, PC1, k10); PN1 = M8_MFMA(k10, q[0], (f32x16){}); TIE3(PN1, PC0, PC1); } \
    M8_F2(PC0, PC1); \
    if (DO_QK) { TIE3(PC0, PC1, k01); PN0 = M8_MFMA(k01, q[1], PN0); TIE4(PN0, PC0, PC1, vo_); } \
    M8_F3(PC0, PC1); \
    v0 = ld32(Vw + vo_); v1 = ld32(Vw + vo_ + 32 * VROW); \
    if (DO_QK) { TIE3(PC0, PC1, k11); PN1 = M8_MFMA(k11, q[1], PN1); TIE3(PN1, PC0, PC1); } \
    M8_F4(PC0, PC1); \
    if (DO_QK) { TIE3(PC0, PC1, k02); PN0 = M8_MFMA(k02, q[2], PN0); TIE4(PN0, PC0, PC1, vo_); } \
    M8_F5(PC0, PC1); \
    v2 = ld32(Vw + vo_ + 64 * VROW); v3 = ld32(Vw + vo_ + 96 * VROW); \
    if (DO_QK) { TIE5(PC0, PC1, P8, psum, k12); PN1 = M8_MFMA(k12, q[2], PN1); TIE5(PN1, PC0, PC1, P8, psum); } \
    M8_F6(PC0, PC1, ALC); \
    TIE3(P8, l_reg, v0); o[0] = M8_MFMA(v0, P8, o[0]); \
    if (DO_QK) { TIE3(o[0], PN0, PN1); M8_P1(PN0, PN1); TIE4(PN0, PN1, pmax, v1); } \
    o[1] = M8_MFMA(v1, P8, o[1]); \
    if (DO_QK) { TIE4(o[1], PN0, PN1, pmax); M8_P2(PN0, PN1, ALN); TIE6(PN0, PN1, mnC2, ALN, m_reg, v2); } \
    o[2] = M8_MFMA(v2, P8, o[2]); \
    if (DO_QK) { TIE4(o[2], PN0, PN1, mnC2); M8_P3(PN0, PN1); TIE3(PN0, PN1, v3); } \
    o[3] = M8_MFMA(v3, P8, o[3]); \
    if (DO_QK) { TIE3(o[3], PN0, PN1); M8_P4(PN0, PN1); TIE3(PN0, PN1, ALN); RESC(ALN); } } while (0)
    SLOAD(0); SWRITE(0); SLOAD(1); SWRITE(BUF); __syncthreads();
    SLOAD(2);
    qkt(pA0, pA1, Kw, q);
    M8_P1(pA0, pA1); M8_P2(pA0, pA1, alA); M8_P3(pA0, pA1); M8_P4(pA0, pA1);
    int b0 = 0, b1 = BUF, b2 = 2 * BUF;
    for (int j = 0; j + 2 < NT; j += 2) {
        __syncthreads(); SWRITE(b2); if (j + 3 < NT) SLOAD(j + 3);
        M8_STEP(pA0, pA1, alA, pB0, pB1, alB, b1, b0, true);
        __syncthreads(); SWRITE(b0); if (j + 4 < NT) SLOAD(j + 4);
        M8_STEP(pB0, pB1, alB, pA0, pA1, alA, b2, b1, true);
        { const int t_ = b0; b0 = b2; b2 = b1; b1 = t_; }
    }
    __syncthreads();
    M8_STEP(pA0, pA1, alA, pB0, pB1, alB, b1, b0, true);
    M8_STEP(pB0, pB1, alB, pA0, pA1, alA, 0, b1, false);
    const float rl = __builtin_amdgcn_rcpf(l_reg);
    bf16_t* Ow = Ob + (size_t)(wid * 32 + r32) * 1024 + 4 * hi;
#pragma unroll
    for (int d0 = 0; d0 < 4; ++d0)
#pragma unroll
        for (int g = 0; g < 4; ++g)
            *(u32x2*)(Ow + d0 * 32 + 8 * g) = (u32x2){cvtpk(o[d0][4 * g] * rl, o[d0][4 * g + 1] * rl), cvtpk(o[d0][4 * g + 2] * rl, o[d0][4 * g + 3] * rl)};
    __syncthreads();
#undef SLOAD
#undef SWRITE
#undef RESC
#undef M8_STEP
}
}

__device__ __forceinline__ void phase_mix0(PRef p) {
    const int G = gridDim.x;
    phase_gla_out(p);
    __syncthreads();
    const unsigned char* Q8 = (const unsigned char*)(p.ws + WS_Q8); const unsigned char* K8 = (const unsigned char*)(p.ws + WS_K8); const unsigned char* VT8 = (const unsigned char*)(p.ws + WS_VT8);
    bf16_t* MIX = (bf16_t*)(p.ws + WS_MIX);
    for (int u = blockIdx.x; u < 260; u += G) {
        const bool lat = u < 256;
        const int h = lat ? (u & 3) : (u - 256);
        const size_t q0 = lat ? (size_t)CTXN + (size_t)(u >> 2) * 256 : 0;
        mla8::attn_body2(Q8 + q0 * 768 + h * 192, K8 + (size_t)h * NTOK * 192, VT8 + (size_t)h * NCH * 8192, MIX + q0 * 1024 + 512 + h * 128, lat ? NTOK : CTXN);
    }
}

template <int OFF> __device__ __forceinline__ s16x4 na_tr(int vb) { s16x4 r; asm volatile("ds_read_b64_tr_b16 %0, %1 offset:%2" : "=&v"(r) : "v"(vb), "i"(OFF) : "memory"); return r; }
template <int KS> __device__ __forceinline__ void na_pv(f32x16& o0, f32x16& o1, int vb, bf16x8 pa) {
    const s16x4 a0 = na_tr<KS * 5120>(vb), a1 = na_tr<KS * 5120 + 1280>(vb), b0 = na_tr<KS * 5120 + 64>(vb), b1 = na_tr<KS * 5120 + 1280 + 64>(vb);
    asm volatile("s_waitcnt lgkmcnt(0)" ::: "memory"); SBAR();
    o0 = __builtin_amdgcn_mfma_f32_32x32x16_bf16(pa, (bf16x8){a0[0], a0[1], a0[2], a0[3], a1[0], a1[1], a1[2], a1[3]}, o0, 0, 0, 0);
    o1 = __builtin_amdgcn_mfma_f32_32x32x16_bf16(pa, (bf16x8){b0[0], b0[1], b0[2], b0[3], b1[0], b1[1], b1[2], b1[3]}, o1, 0, 0, 0);
}
template <int MODE> __device__ __forceinline__ void na_softmax(f32x16& p0, f32x16& p1, float& m_reg, float& l_reg, float& alpha, const float* brow, int c0, int hi) {
    constexpr float C = 0.125f * LOG2E;
#define NA_L0(q) (MODE != 2 || (q) >= 12)
#define NA_L1(q) (MODE != 1 || (q) < 4)
    if (MODE == 0) {
#pragma unroll
        for (int q = 0; q < 16; ++q) { p0[q] *= C; p1[q] *= C; }
    } else {
        float bv0[16], bv1[16];
#pragma unroll
        for (int q = 0; q < 16; ++q) { const int kc0 = crow(q, hi); if (NA_L0(q)) bv0[q] = brow[kc0]; if (NA_L1(q)) bv1[q] = brow[32 + kc0]; }
#pragma unroll
        for (int q = 0; q < 16; ++q) { if (NA_L0(q)) asm volatile("" : "+v"(bv0[q])); if (NA_L1(q)) asm volatile("" : "+v"(bv1[q])); }
#pragma unroll
        for (int q = 0; q < 16; ++q) {
            const int kc0 = crow(q, hi), kc1 = 32 + kc0;
            if (NA_L0(q)) { const float t = fmaf(p0[q], C, bv0[q]); p0[q] = ((unsigned)(kc0 - c0) < 16u) ? t : -1e30f; }
            if (NA_L1(q)) { const float t = fmaf(p1[q], C, bv1[q]); p1[q] = ((unsigned)(kc1 - c0) < 16u) ? t : -1e30f; }
        }
    }
    float pmax = -1e30f;
#pragma unroll
    for (int q = 0; q < 16; ++q) { if (NA_L0(q)) pmax = fmaxf(pmax, p0[q]); if (NA_L1(q)) pmax = fmaxf(pmax, p1[q]); }
    { auto rr = __builtin_amdgcn_permlane32_swap(__float_as_uint(pmax), __float_as_uint(pmax), false, false);
      pmax = fmaxf(__uint_as_float(rr[0]), __uint_as_float(rr[1])); }
    const float mn = fmaxf(m_reg, pmax);
    alpha = __builtin_amdgcn_exp2f(m_reg - mn);
    m_reg = mn;
    float ps = 0.f;
#pragma unroll
    for (int q = 0; q < 16; ++q) {
        if (NA_L0(q)) { p0[q] = __builtin_amdgcn_exp2f(p0[q] - mn); ps += p0[q]; } else p0[q] = 0.f;
        if (NA_L1(q)) { p1[q] = __builtin_amdgcn_exp2f(p1[q] - mn); ps += p1[q]; } else p1[q] = 0.f;
    }
    { auto rr = __builtin_amdgcn_permlane32_swap(__float_as_uint(ps), __float_as_uint(ps), false, false);
      ps = __uint_as_float(rr[0]) + __uint_as_float(rr[1]); }
    l_reg = l_reg * alpha + ps;
#undef NA_L0
#undef NA_L1
}
__device__ __forceinline__ void phase_na(PRef p) {
    const int tid = threadIdx.x, lane = tid & 63, wave = tid >> 6, r32 = lane & 31, hi = lane >> 5, G = gridDim.x;
    const bf16_t* QKV = (const bf16_t*)(p.ws + WS_P);
    bf16_t* MIX = (bf16_t*)(p.ws + WS_MIX);
    constexpr int KB = 64 * 72 * 2, VB = 64 * 160 * 2;
    char* Kl = smem;
    char* Vl = smem + 2 * KB;
    float* xch = (float*)(smem + 2 * KB + 2 * VB) + wave * 64;
    float* rpbL = (float*)(smem + 2 * KB + 2 * VB + 8 * 64 * 4);
    constexpr float C = 0.125f * LOG2E;
    const int skey = tid >> 3, sch = tid & 7;
    const int vb0 = (int)(uintptr_t)Vl + (8 * hi + ((lane & 15) >> 2)) * 320 + (16 * ((lane >> 4) & 1) + 4 * (lane & 3)) * 2;
    for (int u = blockIdx.x; u < 64 * 16; u += G) {
        const int rg = u >> 4, h = u & 15;
        const int r = rg * 4 + (wave >> 1), qb = wave & 1;
        const int r0w = min(max(r - 4, 0), 248);
        const int kr_lo = min(max(rg * 4 - 4, 0), 248), kr_hi = min(max(rg * 4 + 3 - 4, 0), 248) + 7, nwin = kr_hi - kr_lo + 1, ntile = nwin + 4;
        for (int i = tid; i < 15 * 31; i += NTH) rpbL[i] = p.na_rpb[(size_t)h * 15 * 31 + i] * LOG2E;
        const int c = qb * 32 + r32, c0 = min(max(c - 8, 0), 48);
        const size_t qrow = (size_t)CTXN + (size_t)r * 64 + c;
        bf16x8 qr[4];
#pragma unroll
        for (int ks = 0; ks < 4; ++ks) qr[ks] = *(const bf16x8*)(QKV + qrow * 3072 + h * 64 + ks * 16 + hi * 8);
        float m_reg = -1e30f, l_reg = 0.f; f32x16 o0 = {}, o1 = {};
        u32x4 skA, svA, skB, svB;
#define NA_LOAD(ti_, SK, SV) do { const size_t key0_ = ((ti_) >= nwin) ? (size_t)((ti_) - nwin) * 64 : (size_t)CTXN + (size_t)(kr_lo + (ti_)) * 64; \
            const bf16_t* src_ = QKV + (key0_ + skey) * 3072 + h * 64 + sch * 8; SK = *(const u32x4*)(src_ + 1024); SV = *(const u32x4*)(src_ + 2048); } while (0)
#define NA_WRITE(b_, SK, SV) do { *(u32x4*)(Kl + (b_) * KB + skey * 144 + sch * 16) = SK; *(u32x4*)(Vl + (b_) * VB + skey * 320 + sch * 16) = SV; } while (0)
        NA_LOAD(0, skA, svA); NA_WRITE(0, skA, svA);
        NA_LOAD(1, skA, svA);
        __syncthreads();
        for (int ti = 0; ti < ntile; ++ti) {
            const int b = ti & 1;
            if (ti + 2 < ntile) { if (b == 0) NA_LOAD(ti + 2, skB, svB); else NA_LOAD(ti + 2, skA, svA); }
            const bool isctx = ti >= nwin;
            const int kr = kr_lo + ti;
            const bool need = isctx || (kr >= r0w && kr <= r0w + 7);
            if (need) {
                const bf16_t* Ks = (const bf16_t*)(Kl + b * KB);
                f32x16 p0 = {}, p1 = {};
#pragma unroll
                for (int ks = 0; ks < 4; ++ks) {
                    const bf16x8 a0 = *(const bf16x8*)(Ks + r32 * 72 + ks * 16 + hi * 8), a1 = *(const bf16x8*)(Ks + (32 + r32) * 72 + ks * 16 + hi * 8);
                    p0 = __builtin_amdgcn_mfma_f32_32x32x16_bf16(a0, qr[ks], p0, 0, 0, 0);
                    p1 = __builtin_amdgcn_mfma_f32_32x32x16_bf16(a1, qr[ks], p1, 0, 0, 0);
                }
                float alpha;
                const float* brow = rpbL + (kr - r + 7) * 31 + 15 - c;
                if (isctx) na_softmax<0>(p0, p1, m_reg, l_reg, alpha, brow, c0, hi);
                else if (qb == 0) na_softmax<1>(p0, p1, m_reg, l_reg, alpha, brow, c0, hi);
                else na_softmax<2>(p0, p1, m_reg, l_reg, alpha, brow, c0, hi);
                bf16x8 pa0, pa1, pa2, pa3;
                PK4(p0, 0, pa0); PK4(p0, 8, pa1); PK4(p1, 0, pa2); PK4(p1, 8, pa3);
                if (__any(alpha < 1.f)) {
                    if (hi == 0) xch[r32] = alpha;
                    asm volatile("s_waitcnt lgkmcnt(0)" ::: "memory");
#pragma unroll
                    for (int q = 0; q < 16; ++q) { const float a = xch[crow(q, hi)]; o0[q] *= a; o1[q] *= a; }
                }
                const int vb = vb0 + b * VB;
                na_pv<0>(o0, o1, vb, pa0); na_pv<1>(o0, o1, vb, pa1); na_pv<2>(o0, o1, vb, pa2); na_pv<3>(o0, o1, vb, pa3);
            }
            if (ti + 1 < ntile) { if (b == 0) NA_WRITE(1, skA, svA); else NA_WRITE(0, skB, svB); }
            __syncthreads();
        }
#undef NA_LOAD
#undef NA_WRITE
        if (hi == 0) xch[32 + r32] = l_reg;
        asm volatile("s_waitcnt lgkmcnt(0)" ::: "memory");
        const size_t orow0 = (size_t)CTXN + (size_t)r * 64 + qb * 32;
#pragma unroll
        for (int q = 0; q < 16; ++q) {
            const int qi = crow(q, hi); const float il = __builtin_amdgcn_rcpf(xch[32 + qi]);
            bf16_t* dst = MIX + (orow0 + qi) * 1024 + h * 64;
            dst[r32] = f2bf(o0[q] * il); dst[32 + r32] = f2bf(o1[q] * il);
        }
        __syncthreads();
    }
}
#undef PK4

#define XB_TMO      128
#define XB_XCNT(j)  (256  + 64 * (j))
#define XB_XSUB(j)  (1280 + 64 * (j))
#define XB_XGEN(j)  (2304 + 64 * (j))
#define XB_TOP      3328
#define XB_TOPGEN   3392
#define XCD_BAR_WORDS 3456
#define XB_SPIN_CAP (1u << 22)
#define LAS __attribute__((address_space(3)))
__device__ __forceinline__ unsigned xb_ld(unsigned* p)              { return __hip_atomic_load(p, __ATOMIC_RELAXED, __HIP_MEMORY_SCOPE_AGENT); }
__device__ __forceinline__ unsigned xb_add(unsigned* p, unsigned v) { return __hip_atomic_fetch_add(p, v, __ATOMIC_RELAXED, __HIP_MEMORY_SCOPE_AGENT); }
__device__ __forceinline__ unsigned xb_xcc_id() { return (unsigned)__builtin_amdgcn_s_getreg((3 << 11) | 20) & 0xFu; }
#define XB_SPIN(cond, bar) do { unsigned _sp = 0; while (cond) { __builtin_amdgcn_s_sleep(1); \
    if ((++_sp & 255u) == 0u) { if (xb_ld(&(bar)[XB_TMO])) break; if (_sp > XB_SPIN_CAP) { atomicAdd(&(bar)[XB_TMO], 1u); break; } } } } while (0)
struct XcdBarrier { unsigned* bar; unsigned x; volatile LAS unsigned* st; };
__device__ __forceinline__ XcdBarrier xcd_barrier_post(unsigned* bar, volatile LAS unsigned* st) {
    XcdBarrier b; b.bar = bar; b.x = xb_xcc_id(); b.st = st;
    if (threadIdx.x == 0) (void)xb_add(&bar[XB_XCNT(b.x)], 1u);
    return b;
}
__device__ __forceinline__ void xcd_barrier_complete(unsigned* bar, unsigned x, unsigned& nloc, unsigned& nx) {
    const unsigned G = gridDim.x * gridDim.y * gridDim.z;
    unsigned sum, cnt, mine, sp = 0u;
    for (;;) {
        sum = 0u; cnt = 0u; mine = 0u;
#pragma unroll
        for (unsigned j = 0; j < 16; ++j) { const unsigned c = xb_ld(&bar[XB_XCNT(j)]); sum += c; cnt += (c > 0u) ? 1u : 0u; mine = (j == x) ? c : mine; }
        if (sum == G) break;
        __builtin_amdgcn_s_sleep(1);
        if ((++sp & 255u) == 0u) { if (xb_ld(&bar[XB_TMO])) break; if (sp > XB_SPIN_CAP) { atomicAdd(&bar[XB_TMO], 1u); break; } }
    }
    nloc = mine > 0u ? mine : 1u; nx = cnt > 0u ? cnt : 1u;
}
__device__ __forceinline__ void xcd_barrier(const XcdBarrier& b) {
    asm volatile("s_waitcnt vmcnt(0)" ::: "memory");
    __syncthreads();
    if (threadIdx.x == 0) {
        unsigned* bar = b.bar;
        __builtin_amdgcn_s_waitcnt(0);
        unsigned nloc = b.st[0], nx = b.st[1];
        if (nloc == 0u) { xcd_barrier_complete(bar, b.x, nloc, nx); b.st[0] = nloc; b.st[1] = nx; }
        const unsigned old = xb_add(&bar[XB_XSUB(b.x)], 1u);
        const unsigned gen = old / nloc;
        if (old + 1u == (gen + 1u) * nloc) {
            __builtin_amdgcn_fence(__ATOMIC_RELEASE, "agent");
            asm volatile("s_waitcnt vmcnt(0)" ::: "memory");
            const unsigned og = xb_add(&bar[XB_TOP], 1u);
            const unsigned tg = og / nx;
            if (og + 1u == (tg + 1u) * nx) xb_add(&bar[XB_TOPGEN], 1u);
            else XB_SPIN(xb_ld(&bar[XB_TOPGEN]) == tg, bar);
            __builtin_amdgcn_fence(__ATOMIC_ACQUIRE, "agent");
            xb_add(&bar[XB_XGEN(b.x)], 1u);
            asm volatile("s_waitcnt vmcnt(0)" ::: "memory");
        } else {
            XB_SPIN(xb_ld(&bar[XB_XGEN(b.x)]) == gen, bar);
            __builtin_amdgcn_fence(__ATOMIC_ACQUIRE, "agent");
            asm volatile("s_waitcnt vmcnt(0)" ::: "memory");
        }
    }
    __syncthreads();
}

__device__ __forceinline__ void run_phase(PRef p, int ph) {
#ifdef ONLY_PHASE
    if (ph != ONLY_PHASE) return;
    ph = ONLY_PHASE;
#endif
    const bf16_t* HB = (const bf16_t*)(p.ws + WS_HB);
    switch (ph) {
    case 0: phase_prologue(p); break;
    case 1: phase_norm1_l0(p); break;
    case 2: phase_gemm_pg8(HB, 1024, (const bf16_t*)(p.ws + WS_WIN), 1024, (bf16_t*)(p.ws + WS_P), PW, NTOK / 256, 8); break;
    case 3: phase_mla_up(p); break;
    case 4: break;
    case 5: phase_gla_scan(p); break;
    case 6: phase_mix0(p); break;
    case 7: phase_gemm_pg8((const bf16_t*)(p.ws + WS_MIX), 1024, (const bf16_t*)(p.ws + WS_WOUT0), 1024, (bf16_t*)(p.ws + WS_OB), 1024, NTOK / 256, 4); break;
    case 8: phase_mid(p, 0); break;
    case 9: phase_moe1(p, 0); break;
    case 10: phase_moe2(p, 0); break;
    case 11: phase_end(p, 0); break;
    case 12: phase_gemm_pg8(HB, 1024, (const bf16_t*)(p.ws + WS_WQKV), 1024, (bf16_t*)(p.ws + WS_P), 3072, NTOK / 256, 12); break;
    case 13: phase_na(p); break;
    case 14: phase_gemm_pg8((const bf16_t*)(p.ws + WS_MIX) + (size_t)CTXN * 1024, 1024, (const bf16_t*)(p.ws + WS_WNAO), 1024, (bf16_t*)(p.ws + WS_OB) + (size_t)CTXN * 1024, 1024, SEQ / 256, 4); break;
    case 15: phase_mid(p, 1); break;
    case 16: phase_moe1(p, 1); break;
    case 17: phase_moe2(p, 1); break;
    case 18: phase_end(p, 1); break;
    default: break;
    }
}
constexpr int N_PHASES = 19;

#if MK_LAUNCHES == 1
__global__ void __launch_bounds__(512) mega_kernel(Params p) {
    cg::grid_group grid = cg::this_grid();
    volatile LAS unsigned* xst = (volatile LAS unsigned*)(smem + LDS_BYTES - 16);
    if (threadIdx.x == 0) { xst[0] = 0u; xst[1] = 0u; xst[2] = 0u; xst[3] = 0u; }
    __syncthreads();
    XcdBarrier xb = xcd_barrier_post((unsigned*)(kparams()->ws + WS_BAR), xst);
    run_phase(*kparams(), 0); xcd_barrier(xb);
    if (kparams()->pad0 == 0x7fffffff) grid.sync();
    if (PROBE_REPEAT == 100) { run_phase(*kparams(), 0); xcd_barrier(xb); }
    if (PROBE_REPEAT == 61) { phase_gla_out(*kparams()); xcd_barrier(xb); }
#define PH_(n) run_phase(*kparams(), n); xcd_barrier(xb); if ((n) == PROBE_REPEAT) { run_phase(*kparams(), n); xcd_barrier(xb); }
    PH_(1) PH_(2) PH_(3) PH_(5) PH_(6) PH_(7) PH_(8) PH_(9) PH_(10) PH_(11) PH_(12) PH_(13) PH_(14) PH_(15) PH_(16) PH_(17)
    run_phase(*kparams(), 18);
#undef PH_
}
#else
template <int PH> __global__ void __launch_bounds__(512) phase_kernel(Params p) { run_phase(*kparams(), PH); }
typedef void (*phase_fn)(Params);
template <int PH> static bool launch_phase(const Params& p, int grid, hipStream_t stream, bool setattr) {
    if (setattr && hipFuncSetAttribute((const void*)phase_kernel<PH>, hipFuncAttributeMaxDynamicSharedMemorySize, LDS_BYTES) != hipSuccess) return false;
    hipLaunchKernelGGL(phase_kernel<PH>, dim3(grid), dim3(NTH), LDS_BYTES, stream, p);
    return true;
}
#endif

extern "C" void kernel_launch(void* const* d_in, const int* in_sizes, int n_in, void* d_out, int out_size, void* d_ws, size_t ws_size, hipStream_t stream) {
    static int grid_blocks = 0;
    bool first = false;
    if (!grid_blocks) {
        if (ws_size < WS_END) { fprintf(stderr, "kernel_launch: workspace too small: %zu < %zu\n", ws_size, (size_t)WS_END); return; }
        int dev = 0, cus = 0;
        (void)hipGetDevice(&dev);
        (void)hipDeviceGetAttribute(&cus, hipDeviceAttributeMultiprocessorCount, dev);
#if MK_LAUNCHES == 1
        if (hipFuncSetAttribute((const void*)mega_kernel, hipFuncAttributeMaxDynamicSharedMemorySize, LDS_BYTES) != hipSuccess) { fprintf(stderr, "kernel_launch: LDS attribute failed\n"); return; }
        int per_cu = 0;
        (void)hipOccupancyMaxActiveBlocksPerMultiprocessor(&per_cu, (const void*)mega_kernel, NTH, LDS_BYTES);
        if (per_cu < 1) { fprintf(stderr, "kernel_launch: occupancy query returned %d\n", per_cu); return; }
#endif
        grid_blocks = cus;
        first = true;
    }
    Params p{};
    const float* const* in = (const float* const*)d_in;
    p.x = in[0]; p.c = in[1]; p.ctx = in[2]; p.c_ctx = in[3]; p.ada_w = in[4]; p.ada_b = in[5]; p.norm_g = in[6]; p.router_w = in[7]; p.router_b = in[8];
    p.moe_w1 = in[9]; p.moe_b1 = in[10]; p.moe_w2 = in[11]; p.moe_b2 = in[12]; p.ab_in_w = in[13]; p.gla_wa_f = in[14]; p.gla_ba_f = in[15]; p.gla_wa_b = in[16]; p.gla_ba_b = in[17];
    p.gla_onorm = in[18]; p.mla_qnorm = in[19]; p.mla_wuq = in[20]; p.mla_kvnorm = in[21]; p.mla_wukv = in[22]; p.ab_out_w = in[23]; p.na_qkv_w = in[24]; p.na_rpb = in[25]; p.na_out_w = in[26];
    p.out = (float*)d_out; p.ws = (char*)d_ws;
#if MK_LAUNCHES == 1
    (void)hipMemsetAsync((char*)d_ws + WS_BAR, 0, 16384, stream);
    void* args[] = {&p};
    hipError_t e = hipLaunchCooperativeKernel((const void*)mega_kernel, dim3(grid_blocks), dim3(NTH), args, LDS_BYTES, stream);
    if (e != hipSuccess) fprintf(stderr, "cooperative launch failed: %s (grid %d)\n", hipGetErrorString(e), grid_blocks);
#else
    const int g = grid_blocks;
    launch_phase<0>(p, g, stream, first); launch_phase<1>(p, g, stream, first); launch_phase<2>(p, g, stream, first); launch_phase<3>(p, g, stream, first);
    launch_phase<4>(p, g, stream, first); launch_phase<5>(p, g, stream, first); launch_phase<6>(p, g, stream, first); launch_phase<7>(p, g, stream, first);
    launch_phase<8>(p, g, stream, first); launch_phase<9>(p, g, stream, first); launch_phase<10>(p, g, stream, first); launch_phase<11>(p, g, stream, first);
    launch_phase<12>(p, g, stream, first); launch_phase<13>(p, g, stream, first); launch_phase<14>(p, g, stream, first); launch_phase<15>(p, g, stream, first);
    launch_phase<16>(p, g, stream, first); launch_phase<17>(p, g, stream, first); launch_phase<18>(p, g, stream, first);
#endif
}
```

```cpp
#include <hip/hip_runtime.h>
#include <hip/hip_cooperative_groups.h>
#include <cstdio>
#include <cstdint>
namespace cg = cooperative_groups;

#ifndef PROBE_REPEAT
#define PROBE_REPEAT -1
#endif
#ifndef MK_LAUNCHES
#define MK_LAUNCHES 1
#endif

typedef unsigned short bf16_t;
typedef short bf16x8 __attribute__((ext_vector_type(8)));
typedef short s16x4 __attribute__((ext_vector_type(4)));
typedef float f32x4 __attribute__((ext_vector_type(4)));
typedef float f32x16 __attribute__((ext_vector_type(16)));
typedef unsigned u32x4 __attribute__((ext_vector_type(4)));
typedef int i32x4 __attribute__((ext_vector_type(4)));
typedef unsigned u32x2 __attribute__((ext_vector_type(2)));

constexpr int SEQ = 16384, CTXN = 256, NTOK = SEQ + CTXN, DM = 1024;
constexpr int NEXP = 32, FF = 1024;
constexpr int PW = 2048;
constexpr int PC_Q = 0, PC_K = 256, PC_V = 512, PC_R = 1024, PC_AF = 1536, PC_AB = 1552, PC_CQ = 1568, PC_CKV = 1824, PC_KR = 1952;
constexpr int NCH = NTOK / 64;
constexpr int NTH = 512;
constexpr float EPSN = 1e-6f;
constexpr float LOG2E = 1.4426950408889634f;

constexpr size_t al256(size_t x) { return (x + 255) / 256 * 256; }
constexpr size_t WS_BAR   = 0;
constexpr size_t WS_CNT   = WS_BAR + 16384;
constexpr size_t WS_MOD   = WS_CNT + 1024;
constexpr size_t WS_ROPE  = WS_MOD + al256((size_t)2 * 2 * 6144 * 4);
constexpr size_t WS_RWT   = WS_ROPE + al256((size_t)(256 + 256 + 64 + 64) * 16 * 4);
constexpr size_t WS_WIN   = WS_RWT + al256((size_t)2 * 32 * 1024 * 4);
constexpr size_t WS_WUQ   = WS_WIN + (size_t)2048 * 1024 * 2;
constexpr size_t WS_WUKV  = WS_WUQ + (size_t)768 * 256 * 2;
constexpr size_t WS_WOUT0 = WS_WUKV + (size_t)1024 * 128 * 2;
constexpr size_t WS_WQKV  = WS_WOUT0 + (size_t)1024 * 1024 * 2;
constexpr size_t WS_WNAO  = WS_WQKV + (size_t)3072 * 1024 * 2;
constexpr size_t WS_W1T   = WS_WNAO + (size_t)1024 * 1024 * 2;
constexpr size_t WS_W2T   = WS_W1T + (size_t)2 * 32 * 2048 * 1024 * 2;
constexpr size_t WS_Q8    = WS_W1T + (size_t)2 * 32 * 2048 * 1024;
constexpr size_t WS_K8    = WS_Q8 + (size_t)NTOK * 768;
constexpr size_t WS_VT8   = WS_K8 + (size_t)NTOK * 768;
static_assert(WS_VT8 + (size_t)NTOK * 512 <= WS_W2T, "fp8 MLA operands overflow the W1T region");
constexpr size_t WS_HB    = WS_W2T + (size_t)2 * 32 * 1024 * 1024 * 2;
constexpr size_t WS_P     = WS_HB + (size_t)NTOK * 1024 * 2;
constexpr size_t WS_QM    = WS_P + (size_t)NTOK * 3072 * 2;
constexpr size_t WS_KM    = WS_QM + (size_t)NTOK * 768 * 2;
constexpr size_t WS_VM    = WS_KM + (size_t)NTOK * 768 * 2;
constexpr size_t WS_U     = WS_VM + (size_t)NTOK * 512 * 2;
constexpr size_t WS_SIN   = WS_U + (size_t)2 * NCH * 4 * 128 * 64 * 2;
constexpr size_t WS_DEC   = WS_SIN + (size_t)2 * NCH * 4 * 128 * 64 * 2;
constexpr size_t WS_MIX   = WS_DEC + al256((size_t)2 * NCH * 4 * 64 * 4);
constexpr size_t WS_OB    = WS_MIX + (size_t)NTOK * 1024 * 2;
constexpr size_t WS_X1    = WS_OB + (size_t)NTOK * 1024 * 2;
constexpr size_t WS_X2    = WS_X1 + (size_t)NTOK * 1024 * 4;
constexpr size_t WS_TOPE  = WS_X2 + (size_t)NTOK * 1024 * 4;
constexpr size_t WS_TOPP  = WS_TOPE + al256((size_t)NTOK * 4 * 4);
constexpr size_t WS_GATE  = WS_TOPP + al256((size_t)NTOK * 4 * 4);
constexpr size_t WS_LIST  = WS_GATE + al256((size_t)NTOK * 4 * 4);
constexpr size_t WS_ACT   = WS_LIST + al256((size_t)32 * NTOK * 4);
constexpr size_t WS_YB    = WS_ACT + (size_t)(NTOK * 4 + 256) * 1024 * 2;
constexpr size_t WS_END   = WS_YB + (size_t)(NTOK * 4) * 1024 * 2;

constexpr int LDS_BYTES = 160 * 1024;
extern __shared__ __attribute__((aligned(16))) char smem[];

struct Params {
    const float *x, *c, *ctx, *c_ctx, *ada_w, *ada_b, *norm_g, *router_w, *router_b, *moe_w1, *moe_b1, *moe_w2, *moe_b2;
    const float *ab_in_w, *gla_wa_f, *gla_ba_f, *gla_wa_b, *gla_ba_b, *gla_onorm, *mla_qnorm, *mla_wuq, *mla_kvnorm, *mla_wukv;
    const float *ab_out_w, *na_qkv_w, *na_rpb, *na_out_w;
    float* out; char* ws;
    int pad0, pad1;
};
typedef const __attribute__((address_space(4))) Params& PRef;
typedef const __attribute__((address_space(4))) Params* KPtr;
__device__ __forceinline__ KPtr kparams() { KPtr k = (KPtr)__builtin_amdgcn_kernarg_segment_ptr(); asm volatile("" : "+s"(k)); return k; }

__device__ __forceinline__ float bf2f(bf16_t h) { return __uint_as_float(((unsigned)h) << 16); }
__device__ __forceinline__ bf16_t f2bf(float f) { unsigned u = __float_as_uint(f); u += 0x7FFFu + ((u >> 16) & 1u); return (bf16_t)(u >> 16); }
__device__ __forceinline__ unsigned cvtpk(float lo, float hi) { unsigned r; asm volatile("v_cvt_pk_bf16_f32 %0, %1, %2" : "=v"(r) : "v"(lo), "v"(hi)); return r; }
__device__ __forceinline__ float wave_sum(float v) {
#pragma unroll
    for (int o = 32; o >= 1; o >>= 1) v += __shfl_xor(v, o);
    return v;
}
__device__ __forceinline__ int crow(int r, int hi) { return (r & 3) + 8 * (r >> 2) + 4 * hi; }
__device__ __forceinline__ float silu_f(float x) { return x / (1.f + __expf(-x)); }
#define SBAR() __builtin_amdgcn_sched_barrier(0)
__device__ __forceinline__ unsigned pk4_fp8(float a, float b, float c, float d) {
    a = __builtin_amdgcn_fmed3f(a, -448.f, 448.f); b = __builtin_amdgcn_fmed3f(b, -448.f, 448.f); c = __builtin_amdgcn_fmed3f(c, -448.f, 448.f); d = __builtin_amdgcn_fmed3f(d, -448.f, 448.f);
    int r = __builtin_amdgcn_cvt_pk_fp8_f32(a, b, 0, false); r = __builtin_amdgcn_cvt_pk_fp8_f32(c, d, r, true); return (unsigned)r; }
__device__ __forceinline__ int tid_opaque() { int t = threadIdx.x; asm volatile("" : "+v"(t)); return t; }

struct ConvJob { const float* src; bf16_t* dst; const float* gain; int K, Nsrc, kt, nt, mode, f8; };
constexpr int CONV8_RS = 264;
constexpr float W8_SCALE = 64.f;
__device__ __forceinline__ void conv_load(const ConvJob& jb, float4 (&v)[16]) {
    const int tid = threadIdx.x, n4 = tid & 63, kr = tid >> 6, n = jb.nt * 256 + n4 * 4;
    const float* q = jb.src + (size_t)(jb.kt * 128 + kr) * jb.Nsrc + n;
#pragma unroll
    for (int i = 0; i < 16; ++i) { if (n < jb.Nsrc) { const f32x4 t = __builtin_nontemporal_load((const f32x4*)(q + (size_t)(8 * i) * jb.Nsrc)); v[i] = make_float4(t[0], t[1], t[2], t[3]); } else v[i] = make_float4(0.f, 0.f, 0.f, 0.f); }
}
__device__ __forceinline__ void conv_to_lds(const ConvJob& jb, const float4 (&v)[16]) {
    bf16_t* T = (bf16_t*)smem;
    const int tid = threadIdx.x, n4 = tid & 63, kr = tid >> 6;
#pragma unroll
    for (int i = 0; i < 16; ++i) {
        const int k = kr + 8 * i;
        float4 w = v[i];
        if (jb.mode == 1) { const float g = jb.gain[jb.kt * 128 + k]; w.x *= g; w.y *= g; w.z *= g; w.w *= g; }
        if (jb.f8) { *(unsigned*)((char*)smem + k * CONV8_RS + n4 * 4) = pk4_fp8(w.x * W8_SCALE, w.y * W8_SCALE, w.z * W8_SCALE, w.w * W8_SCALE); continue; }
        u32x2 pk; pk.x = cvtpk(w.x, w.y); pk.y = cvtpk(w.z, w.w);
        *(u32x2*)(T + k * 260 + n4 * 4) = pk;
    }
}
__device__ __forceinline__ void conv_readout(const ConvJob& jb) {
    const bf16_t* T = (const bf16_t*)smem;
    const int tid = threadIdx.x, k0 = jb.kt * 128;
    if (jb.f8) {
        const unsigned char* T8 = (const unsigned char*)smem;
#pragma unroll
        for (int i = 0; i < 4; ++i) {
            const int cc = tid + 512 * i, nn = cc >> 3, kc = cc & 7;
            const int col = (jb.mode == 2) ? (2 * (nn & 127) + (nn >> 7)) : nn;
            unsigned e[16];
#pragma unroll
            for (int j = 0; j < 16; ++j) e[j] = T8[(kc * 16 + j) * CONV8_RS + col];
            u32x4 o;
#pragma unroll
            for (int q = 0; q < 4; ++q) o[q] = e[4 * q] | (e[4 * q + 1] << 8) | (e[4 * q + 2] << 16) | (e[4 * q + 3] << 24);
            __builtin_nontemporal_store(o, (u32x4*)((char*)jb.dst + (size_t)(jb.nt * 256 + nn) * jb.K + k0 + kc * 16));
        }
        return;
    }
#pragma unroll
    for (int i = 0; i < 8; ++i) {
        const int cc = tid + 512 * i, nn = cc >> 4, kc = cc & 15;
        const int col = (jb.mode == 2) ? (2 * (nn & 127) + (nn >> 7)) : nn;
        unsigned short e[8];
#pragma unroll
        for (int j = 0; j < 8; ++j) e[j] = T[(kc * 8 + j) * 260 + col];
        u32x4 o; o.x = e[0] | ((unsigned)e[1] << 16); o.y = e[2] | ((unsigned)e[3] << 16); o.z = e[4] | ((unsigned)e[5] << 16); o.w = e[6] | ((unsigned)e[7] << 16);
        __builtin_nontemporal_store(o, (u32x4*)(jb.dst + (size_t)(jb.nt * 256 + nn) * jb.K + k0 + kc * 8));
    }
}

__device__ __forceinline__ void adaln_job(PRef p, int job) {
    const int l = job / 24, cb = (job % 24) * 256, tid = threadIdx.x;
    float* sv = (float*)smem;
    for (int i = tid; i < 2048; i += NTH) { const int k = i & 1023; const float xx = (i < 1024) ? p.c[k] : p.c_ctx[k]; sv[i] = silu_f(xx); }
    __syncthreads();
    const int col4 = tid & 63, kq = tid >> 6;
    float4 a0 = make_float4(0, 0, 0, 0), a1 = make_float4(0, 0, 0, 0);
    const float* w = p.ada_w + ((size_t)l * 1024 + kq * 128) * 6144 + cb + col4 * 4;
#pragma unroll 8
    for (int k = 0; k < 128; ++k) {
        const float4 wv = *(const float4*)(w + (size_t)k * 6144);
        const float s0 = sv[kq * 128 + k], s1 = sv[1024 + kq * 128 + k];
        a0.x += s0 * wv.x; a0.y += s0 * wv.y; a0.z += s0 * wv.z; a0.w += s0 * wv.w;
        a1.x += s1 * wv.x; a1.y += s1 * wv.y; a1.z += s1 * wv.z; a1.w += s1 * wv.w;
    }
    float* red = sv + 2048;
    *(float4*)(red + (kq * 2 + 0) * 256 + col4 * 4) = a0;
    *(float4*)(red + (kq * 2 + 1) * 256 + col4 * 4) = a1;
    __syncthreads();
    {
        const int s = tid >> 8, col = tid & 255;
        float acc = p.ada_b[l * 6144 + cb + col];
#pragma unroll
        for (int q = 0; q < 8; ++q) acc += red[(q * 2 + s) * 256 + col];
        ((float*)(p.ws + WS_MOD))[(l * 2 + s) * 6144 + cb + col] = acc;
    }
    __syncthreads();
}

__device__ __forceinline__ void tables_job(PRef p) {
    float* rope = (float*)(p.ws + WS_ROPE);
    const int tid = threadIdx.x;
    for (int i = tid; i < (256 + 64) * 16; i += NTH) {
        const bool isrow = i < 256 * 16;
        const int idx = isrow ? i : i - 256 * 16, pos = idx >> 4, j = idx & 15;
        const float inv = exp2f(-(float)j * (13.287712379549449f / 16.f));
        const float ang = (float)pos * inv;
        float rev = ang * 0.15915494309189535f; rev -= rintf(rev);
        const float cs = __builtin_amdgcn_cosf(rev), sn = __builtin_amdgcn_sinf(rev);
        if (isrow) { rope[idx] = cs; rope[256 * 16 + idx] = sn; }
        else { rope[512 * 16 + idx] = cs; rope[512 * 16 + 64 * 16 + idx] = sn; }
    }
    if (tid < 64) ((int*)(p.ws + WS_CNT))[tid] = 0;
}
__device__ __forceinline__ void rwt_job(PRef p, int l) {
    float* dst = (float*)(p.ws + WS_RWT) + (size_t)l * 32 * 1024;
    const float* src = p.router_w + (size_t)l * 1024 * 32;
    for (int i = threadIdx.x; i < 32 * 1024; i += NTH) { const int cch = i >> 5, e = i & 31; dst[e * 1024 + cch] = src[i]; }
}

constexpr int J_IN = 8 * 8, J_UQ = 2 * 3, J_UKV = 1 * 4, J_OUT0 = 32, J_QKV = 8 * 12, J_NAO = 32, J_W1 = 64 * 64, J_W2 = 64 * 32;
constexpr int J_TOTAL = J_IN + J_UQ + J_UKV + J_OUT0 + J_QKV + J_NAO + J_W1 + J_W2;
__device__ __forceinline__ ConvJob conv_decode(PRef p, int j) {
    ConvJob jb; jb.gain = nullptr; jb.mode = 0; jb.f8 = 0;
    int t = j;
    if (t < J_W1) { const int m = t >> 6, q = t & 63; jb.src = p.moe_w1 + (size_t)m * 1024 * 2048; jb.dst = (bf16_t*)(p.ws + WS_W1T + (size_t)m * 2048 * 1024); jb.K = 1024; jb.Nsrc = 2048; jb.kt = q >> 3; jb.nt = q & 7; jb.mode = 2; jb.f8 = 1; return jb; } t -= J_W1;
    if (t < J_W2) { const int m = t >> 5, q = t & 31; jb.src = p.moe_w2 + (size_t)m * 1024 * 1024; jb.dst = (bf16_t*)(p.ws + WS_W2T + (size_t)m * 1024 * 1024); jb.K = 1024; jb.Nsrc = 1024; jb.kt = q >> 2; jb.nt = q & 3; jb.f8 = 1; return jb; } t -= J_W2;
    if (t < J_IN) { jb.src = p.ab_in_w; jb.dst = (bf16_t*)(p.ws + WS_WIN); jb.K = 1024; jb.Nsrc = 2016; jb.kt = t / 8; jb.nt = t % 8; return jb; } t -= J_IN;
    if (t < J_UQ) { jb.src = p.mla_wuq; jb.dst = (bf16_t*)(p.ws + WS_WUQ); jb.K = 256; jb.Nsrc = 768; jb.kt = t / 3; jb.nt = t % 3; jb.mode = 1; jb.gain = p.mla_qnorm; return jb; } t -= J_UQ;
    if (t < J_UKV) { jb.src = p.mla_wukv; jb.dst = (bf16_t*)(p.ws + WS_WUKV); jb.K = 128; jb.Nsrc = 1024; jb.kt = 0; jb.nt = t; jb.mode = 1; jb.gain = p.mla_kvnorm; return jb; } t -= J_UKV;
    if (t < J_OUT0) { jb.src = p.ab_out_w; jb.dst = (bf16_t*)(p.ws + WS_WOUT0); jb.K = 1024; jb.Nsrc = 1024; jb.kt = t / 4; jb.nt = t % 4; return jb; } t -= J_OUT0;
    if (t < J_QKV) { jb.src = p.na_qkv_w; jb.dst = (bf16_t*)(p.ws + WS_WQKV); jb.K = 1024; jb.Nsrc = 3072; jb.kt = t / 12; jb.nt = t % 12; return jb; } t -= J_QKV;
    jb.src = p.na_out_w; jb.dst = (bf16_t*)(p.ws + WS_WNAO); jb.K = 1024; jb.Nsrc = 1024; jb.kt = t / 4; jb.nt = t % 4; return jb;
}

__device__ __forceinline__ void phase_prologue(PRef p) {
    const int G = gridDim.x, b = blockIdx.x;
    for (int j = b; j < 51; j += G) {
        if (j < 48) adaln_job(p, j);
        else if (j == 48) tables_job(p);
        else rwt_job(p, j - 49);
    }
    __syncthreads();
    int j = b;
    if (j >= J_TOTAL) return;
    ConvJob cur = conv_decode(p, j);
    float4 v[16];
    conv_load(cur, v);
    for (;;) {
        conv_to_lds(cur, v);
        __syncthreads();
        const int jn = j + G;
        ConvJob nxt = cur;
        if (jn < J_TOTAL) { nxt = conv_decode(p, jn); conv_load(nxt, v); }
        conv_readout(cur);
        __syncthreads();
        if (jn >= J_TOTAL) break;
        cur = nxt; j = jn;
    }
}

namespace gm {
constexpr int BK = 64, HT = 128 * 64;
__device__ __forceinline__ int lds_byte(int r, int c) { const int st = (r >> 4) * 2 + (c >> 5), rr = r & 15, cc = c & 31, ob = rr * 64 + cc * 2; return st * 1024 + (ob ^ (((ob >> 9) & 1) << 5)); }
__device__ __forceinline__ void stage_rc(int b, int& R, int& C) { const int st = b / 1024, sb = b % 1024, swz = sb ^ (((sb >> 9) & 1) << 5); R = (st >> 1) * 16 + swz / 64; C = (st & 1) * 32 + (swz % 64) / 2; }

template <class Epi>
__device__ __forceinline__ void gemm_tile(const bf16_t* __restrict__ A, const int (&aoff)[2][2], const bf16_t* __restrict__ Bt, const int (&boff)[2], int nk, Epi& epi) {
    bf16_t* shm = (bf16_t*)smem;
    const int tid = tid_opaque(), wid = tid >> 6, lane = tid & 63, wr = wid >> 1, wc = wid & 1, fr = lane & 15, fq = lane >> 4;
    f32x4 acc[4][4];
#pragma unroll
    for (int m = 0; m < 4; ++m)
#pragma unroll
        for (int n = 0; n < 4; ++n) acc[m][n] = (f32x4){0.f, 0.f, 0.f, 0.f};
#define GM_STAGE(buf, kt) do { \
        _Pragma("unroll") for (int _i = 0; _i < 2; ++_i) { \
            __builtin_amdgcn_global_load_lds((const unsigned*)(A + aoff[0][_i] + (kt) * BK), (unsigned*)((char*)(shm + ((buf) * 3 + 0) * HT) + tid * 16 + _i * 8192), 16, 0, 0); \
            __builtin_amdgcn_global_load_lds((const unsigned*)(A + aoff[1][_i] + (kt) * BK), (unsigned*)((char*)(shm + ((buf) * 3 + 1) * HT) + tid * 16 + _i * 8192), 16, 0, 0); \
            __builtin_amdgcn_global_load_lds((const unsigned*)(Bt + boff[_i] + (kt) * BK), (unsigned*)((char*)(shm + ((buf) * 3 + 2) * HT) + tid * 16 + _i * 8192), 16, 0, 0); } } while (0)
    GM_STAGE(0, 0);
    for (int kt = 0; kt < nk; ++kt) {
        __syncthreads();
        const int buf = kt & 1;
        if (kt + 1 < nk) GM_STAGE(buf ^ 1, kt + 1);
        const char* Ab = (const char*)(shm + (buf * 3 + (wr >> 1)) * HT);
        const char* Bb = (const char*)(shm + (buf * 3 + 2) * HT);
#pragma unroll
        for (int k = 0; k < 2; ++k) {
            bf16x8 Bf[4], Af[4];
#pragma unroll
            for (int n = 0; n < 4; ++n) Bf[n] = *(const bf16x8*)(Bb + lds_byte(wc * 64 + n * 16 + fr, k * 32 + fq * 8));
#pragma unroll
            for (int m = 0; m < 4; ++m) Af[m] = *(const bf16x8*)(Ab + lds_byte((wr & 1) * 64 + m * 16 + fr, k * 32 + fq * 8));
#pragma unroll
            for (int m = 0; m < 4; ++m)
#pragma unroll
                for (int n = 0; n < 4; ++n) acc[m][n] = __builtin_amdgcn_mfma_f32_16x16x32_bf16(Af[m], Bf[n], acc[m][n], 0, 0, 0);
        }
    }
#undef GM_STAGE
    float* stg = (float*)smem;
    __syncthreads();
    {
        float* wb = stg + (wr * 64 + fq * 4) * 132 + wc * 64 + fr;
#pragma unroll
        for (int m = 0; m < 4; ++m)
#pragma unroll
            for (int n = 0; n < 4; ++n)
#pragma unroll
                for (int j = 0; j < 4; ++j) wb[(m * 16 + j) * 132 + n * 16] = acc[m][n][j];
    }
    __syncthreads();
    if (Epi::MOE1) {
        const int fch = tid & 7, rg = tid >> 3;
        for (int ps = 0; ps < 4; ++ps) {
            const int row = ps * 64 + rg;
            const float* q = stg + row * 132 + (fch >> 1) * 32 + (fch & 1) * 8;
            float g[8], l[8];
            *(f32x4*)&g[0] = *(const f32x4*)q; *(f32x4*)&g[4] = *(const f32x4*)(q + 4);
            *(f32x4*)&l[0] = *(const f32x4*)(q + 16); *(f32x4*)&l[4] = *(const f32x4*)(q + 20);
            epi.pair(row, fch * 8, g, l);
        }
    } else {
        const int ch = tid & 15, rg = tid >> 4;
        for (int ps = 0; ps < 8; ++ps) {
            const int row = ps * 32 + rg;
            const float* q = stg + row * 132 + ch * 8;
            float v[8];
            *(f32x4*)&v[0] = *(const f32x4*)q; *(f32x4*)&v[4] = *(const f32x4*)(q + 4);
            epi.row8(row, ch * 8, v);
        }
    }
    __syncthreads();
}
__device__ __forceinline__ void make_off(int (&off)[2][2], int row0, int ld) {
#pragma unroll
    for (int h = 0; h < 2; ++h)
#pragma unroll
        for (int i = 0; i < 2; ++i) { int R, C; stage_rc(tid_opaque() * 16 + i * 8192, R, C); off[h][i] = (row0 + h * 128 + R) * ld + C; }
}
__device__ __forceinline__ void make_off1(int (&off)[2], int row0, int ld) {
#pragma unroll
    for (int i = 0; i < 2; ++i) { int R, C; stage_rc(tid_opaque() * 16 + i * 8192, R, C); off[i] = (row0 + R) * ld + C; }
}
}

namespace pg8 {
#define PG8_LAS __attribute__((address_space(3)))
constexpr int BM = 256, BK = 64, HALF = 128, HTB = HALF * BK * 2, STAGE_BYTES = 8 * HTB, NXCD = 8, WGM = 8;
__device__ __forceinline__ int lds_byte(int r, int c) { const int st = (r >> 4) * 2 + (c >> 5), rr = r & 15, cc = c & 31, ob = rr * 64 + cc * 2; return st * 1024 + (ob ^ (((ob >> 9) & 1) << 5)); }
__device__ __forceinline__ void stage_rc(int b, int& R, int& C) { const int st = b / 1024, sb = b % 1024, swz = sb ^ (((sb >> 9) & 1) << 5); R = (st >> 1) * 16 + swz / 64; C = (st & 1) * 32 + (swz % 64) / 2; }
__device__ __forceinline__ int perm32(int rho) { const int n = rho >> 4, i = rho & 15; return 8 * (i >> 2) + 4 * n + (i & 3); }
struct Unit { int pm, pn, e, nvalid, slot0; };

template <class Epi, class Sched, bool GATHER, bool F8 = false>
__device__ __forceinline__ void gemm_phase(PG8_LAS unsigned char* lds, const Sched& S, const Epi& E, int K, int lda, int ldb, int scA = 0x7F7F7F7F, int scB = 0x7F7F7F7F) {
    const int tid = tid_opaque(), wid = __builtin_amdgcn_readfirstlane(tid >> 6), lane = tid & 63, wr = wid >> 2, wc = wid & 3, fr = lane & 15, fq = lane >> 4;
    const int nt = K / BK;
    unsigned voffA[2], voffB[2]; int gR[2], gC[2];
#pragma unroll
    for (int i = 0; i < 2; ++i) { int R, C; stage_rc(tid * 16 + i * 8192, R, C); const int Rb = Epi::PERM ? ((R & ~31) + perm32(R & 31)) : R;
        voffA[i] = (unsigned)(R * lda + C) * 2u; voffB[i] = (unsigned)(Rb * ldb + C) * 2u; gR[i] = R; gC[i] = C * 2; }
    const size_t kstep = (size_t)(BK * 2);
    const size_t hstepA = (size_t)HALF * lda * 2, hstepB = (size_t)HALF * ldb * 2;
    const unsigned ldsw = (unsigned)wid * 1024u;
    const int aoff = lds_byte(wr * 64 + fr, fq * 8), boff = lds_byte(wc * 32 + fr, fq * 8);
    unsigned gA[2][2] = {{0u, 0u}, {0u, 0u}};
#define PG8_SA(b, h) (((b) * 2 + (h)) * HTB)
#define PG8_SB(b, h) ((4 + (b) * 2 + (h)) * HTB)
#define PG8_STAGE(bufoff, gbase, voff) do { _Pragma("unroll") for (int _i = 0; _i < 2; ++_i) \
        __builtin_amdgcn_global_load_lds((const unsigned*)((const char*)(gbase) + (voff)[_i]), (PG8_LAS unsigned*)(lds + (bufoff) + ldsw + _i * 8192), 16, 0, 0); } while (0)
#define PG8_STAGE_A(bufoff, base, h) do { if constexpr (GATHER) PG8_STAGE(bufoff, base, gA[h]); else PG8_STAGE(bufoff, (base) + (h) * hstepA, voffA); } while (0)
#define PG8_LDA(dst, b, h) do { _Pragma("unroll") for (int m = 0; m < 4; ++m) _Pragma("unroll") for (int k = 0; k < 2; ++k) dst[m][k] = *(const PG8_LAS bf16x8*)(lds + PG8_SA(b, h) + aoff + m * 2048 + k * 1024); } while (0)
#define PG8_LDB(dst, b, h) do { _Pragma("unroll") for (int n = 0; n < 2; ++n) _Pragma("unroll") for (int k = 0; k < 2; ++k) dst[n][k] = *(const PG8_LAS bf16x8*)(lds + PG8_SB(b, h) + boff + n * 2048 + k * 1024); } while (0)
#define PG8_MMA(ai, bj, At, Bt) do { __builtin_amdgcn_s_setprio(1); _Pragma("unroll") for (int m = 0; m < 4; ++m) _Pragma("unroll") for (int n = 0; n < 2; ++n) { \
        if constexpr (F8) { const i32x4 _b0 = __builtin_bit_cast(i32x4, Bt[n][0]), _b1 = __builtin_bit_cast(i32x4, Bt[n][1]), _a0 = __builtin_bit_cast(i32x4, At[m][0]), _a1 = __builtin_bit_cast(i32x4, At[m][1]); \
            acc[ai][bj][m][n] = __builtin_amdgcn_mfma_scale_f32_16x16x128_f8f6f4(__builtin_shufflevector(_b0, _b1, 0, 1, 2, 3, 4, 5, 6, 7), __builtin_shufflevector(_a0, _a1, 0, 1, 2, 3, 4, 5, 6, 7), acc[ai][bj][m][n], 0, 0, 0, scB, 0, scA); } \
        else { _Pragma("unroll") for (int k = 0; k < 2; ++k) acc[ai][bj][m][n] = __builtin_amdgcn_mfma_f32_16x16x32_bf16(Bt[n][k], At[m][k], acc[ai][bj][m][n], 0, 0, 0); } } __builtin_amdgcn_s_setprio(0); } while (0)
#define PG8_WAIT_V(n) asm volatile("s_waitcnt vmcnt(" #n ")" ::: "memory")
#define PG8_WAIT_L(n) asm volatile("s_waitcnt lgkmcnt(" #n ")" ::: "memory")
#define PG8_BAR __builtin_amdgcn_s_barrier()
#define PG8_SCHED __builtin_amdgcn_sched_barrier(0)
#define PG8_GLOAD(ui_) do { const PG8_LAS int* _gl = S.glist(ui_); _Pragma("unroll") for (int _h = 0; _h < 2; ++_h) _Pragma("unroll") for (int _i = 0; _i < 2; ++_i) \
        gA[_h][_i] = ((unsigned)_gl[_h * 128 + gR[_i]] << (F8 ? 10 : 11)) + (unsigned)gC[_i]; } while (0)
    Unit cur, nxt; int ui = 0;
    if (!S.next(0, cur)) return;
    f32x4 acc[2][2][4][2];
#pragma unroll
    for (int a = 0; a < 2; ++a)
#pragma unroll
        for (int b = 0; b < 2; ++b)
#pragma unroll
            for (int m = 0; m < 4; ++m)
#pragma unroll
                for (int n = 0; n < 2; ++n) acc[a][b][m][n] = (f32x4){0.f, 0.f, 0.f, 0.f};
    bf16x8 At[4][2], B0[2][2], B1[2][2];
    const char* cA = S.a_base(cur); const char* cB = S.b_base(cur);
    if constexpr (GATHER) PG8_GLOAD(0);
    PG8_STAGE(PG8_SB(0, 0), cB, voffB); PG8_STAGE_A(PG8_SA(0, 0), cA, 0); PG8_STAGE(PG8_SB(0, 1), cB + hstepB, voffB); PG8_STAGE_A(PG8_SA(0, 1), cA, 1);
    if (wr == 1) PG8_BAR;
    PG8_WAIT_V(4); PG8_BAR;
    PG8_STAGE(PG8_SB(1, 0), cB + kstep, voffB); PG8_STAGE_A(PG8_SA(1, 0), cA + kstep, 0); PG8_STAGE(PG8_SB(1, 1), cB + hstepB + kstep, voffB);
    PG8_WAIT_V(6); PG8_BAR;
    for (;;) {
        const bool has_next = S.next(ui + 1, nxt);
        const char* nA = has_next ? S.a_base(nxt) : cA; const char* nB = has_next ? S.b_base(nxt) : cB;
#pragma unroll 1
        for (int t = 0; t < nt; t += 2) {
            const bool last = (t == nt - 2);
            const char* a1 = cA + (size_t)(t + 1) * kstep;
            const char* a2 = last ? nA : cA + (size_t)(t + 2) * kstep; const char* b2 = last ? nB : cB + (size_t)(t + 2) * kstep;
            const char* a3 = a2 + kstep; const char* b3 = b2 + kstep;
            PG8_LDB(B0, 0, 0); PG8_SCHED; PG8_LDA(At, 0, 0); PG8_STAGE_A(PG8_SA(1, 1), a1, 1);
            PG8_WAIT_L(8); PG8_BAR; PG8_WAIT_L(0); PG8_MMA(0, 0, At, B0); PG8_BAR; PG8_SCHED;
            if constexpr (GATHER) { if (last && has_next) PG8_GLOAD(ui + 1); }
            PG8_LDB(B1, 0, 1); PG8_STAGE(PG8_SB(0, 0), b2, voffB);
            PG8_BAR; PG8_WAIT_L(0); PG8_MMA(0, 1, At, B1); PG8_BAR;
            PG8_LDA(At, 0, 1); PG8_STAGE_A(PG8_SA(0, 0), a2, 0);
            PG8_BAR; PG8_WAIT_L(0); PG8_MMA(1, 0, At, B0); PG8_BAR; PG8_SCHED;
            PG8_STAGE(PG8_SB(0, 1), b2 + hstepB, voffB);
            PG8_WAIT_V(6); PG8_BAR; PG8_MMA(1, 1, At, B1); PG8_BAR;
            PG8_LDB(B0, 1, 0); PG8_SCHED; PG8_LDA(At, 1, 0); PG8_STAGE_A(PG8_SA(0, 1), a2, 1);
            PG8_WAIT_L(8); PG8_BAR; PG8_WAIT_L(0); PG8_MMA(0, 0, At, B0); PG8_BAR; PG8_SCHED;
            PG8_LDB(B1, 1, 1); PG8_STAGE(PG8_SB(1, 0), b3, voffB);
            PG8_BAR; PG8_WAIT_L(0); PG8_MMA(0, 1, At, B1); PG8_BAR;
            PG8_LDA(At, 1, 1); PG8_STAGE_A(PG8_SA(1, 0), a3, 0);
            PG8_BAR; PG8_WAIT_L(0); PG8_MMA(1, 0, At, B0); PG8_BAR; PG8_SCHED;
            PG8_STAGE(PG8_SB(1, 1), b3 + hstepB, voffB);
            PG8_WAIT_V(6); PG8_BAR; PG8_MMA(1, 1, At, B1); PG8_BAR;
        }
        { int fr_e = fr, fq_e = fq; asm volatile("" : "+v"(fr_e), "+v"(fq_e));
          E(acc, cur, wr, wc, fr_e, fq_e); }
        if (!has_next) break;
#pragma unroll
        for (int a = 0; a < 2; ++a)
#pragma unroll
            for (int b = 0; b < 2; ++b)
#pragma unroll
                for (int m = 0; m < 4; ++m)
#pragma unroll
                    for (int n = 0; n < 2; ++n) acc[a][b][m][n] = (f32x4){0.f, 0.f, 0.f, 0.f};
        cur = nxt; cA = nA; cB = nB; ++ui;
    }
    PG8_WAIT_V(0);
    if (wr == 0) PG8_BAR;
    PG8_BAR;
#undef PG8_SA
#undef PG8_SB
#undef PG8_STAGE
#undef PG8_STAGE_A
#undef PG8_LDA
#undef PG8_LDB
#undef PG8_MMA
#undef PG8_WAIT_V
#undef PG8_WAIT_L
#undef PG8_BAR
#undef PG8_SCHED
#undef PG8_GLOAD
}

struct PlainOrder {
    const char* A; const char* Bt; int lda, ldb, nM, nN, nwg, G, c;
    __device__ void init(const bf16_t* A_, int lda_, const bf16_t* Bt_, int ldb_, int nM_, int nN_) { A = (const char*)A_; Bt = (const char*)Bt_; lda = lda_; ldb = ldb_; nM = nM_; nN = nN_; nwg = nM * nN; G = gridDim.x; c = blockIdx.x; }
    __device__ __forceinline__ bool next(int i, Unit& u) const {
        const long L = (long)i * G + c; if (L >= nwg) return false;
        int wgid = (int)L; { const int q = nwg / NXCD, r = nwg % NXCD, xcd = wgid % NXCD, off = wgid / NXCD; wgid = (xcd < r ? xcd * (q + 1) : r * (q + 1) + (xcd - r) * q) + off; }
        const int nig = WGM * nN, gid = wgid / nig, fm = gid * WGM, gsz = (nM - fm) < WGM ? (nM - fm) : WGM;
        u.pm = fm + ((wgid % nig) % gsz); u.pn = (wgid % nig) / gsz; u.e = 0; u.nvalid = 256; u.slot0 = 0; return true;
    }
    __device__ __forceinline__ const char* a_base(const Unit& u) const { return A + (size_t)u.pm * 256 * lda * 2; }
    __device__ __forceinline__ const char* b_base(const Unit& u) const { return Bt + (size_t)u.pn * 256 * ldb * 2; }
    __device__ __forceinline__ const PG8_LAS int* glist(int) const { return nullptr; }
};
struct MoeOrder {
    const char* A; const char* W; const PG8_LAS int* tab; const PG8_LAS int* gl; int wrows, nunits;
    __device__ __forceinline__ bool next(int i, Unit& u) const {
        if (i >= nunits) return false;
        const PG8_LAS int* t = tab + i * 8;
        u.pm = t[0]; u.pn = t[1]; u.e = t[2]; u.nvalid = t[3]; u.slot0 = t[4]; return true;
    }
    __device__ __forceinline__ const char* a_base(const Unit& u) const { return A + (size_t)u.slot0 * 1024; }
    __device__ __forceinline__ const char* b_base(const Unit& u) const { return W + ((size_t)u.e * wrows + (size_t)u.pn * 256) * 1024; }
    __device__ __forceinline__ const PG8_LAS int* glist(int i) const { return gl + i * 256; }
};
constexpr int MOE_UNITS_MAX = 16;
__device__ __forceinline__ int moe_build_units(PG8_LAS int* tab, const int* cnt, const int* off, const int* toff, int nN) {
    const int G = gridDim.x, c = blockIdx.x, x = c & 7, j = c >> 3, per = (G >> 3) / nN, nMt = toff[32];
    const int i = threadIdx.x;
    if (i < MOE_UNITS_MAX) {
        const int pn = j % nN, mt = (i * 8 + x) * per + j / nN;
        int e = 0, valid = (mt < nMt && j < per * nN) ? 1 : 0;
        if (valid) { while (toff[e + 1] <= mt) ++e; }
        const int m = mt - toff[e];
        tab[i * 8 + 0] = mt; tab[i * 8 + 1] = pn; tab[i * 8 + 2] = e; tab[i * 8 + 3] = cnt[e] - m * 256; tab[i * 8 + 4] = off[e] + m * 256; tab[i * 8 + 5] = valid;
    }
    __syncthreads();
    int n = 0;
    while (n < MOE_UNITS_MAX && tab[n * 8 + 5]) ++n;
    return n;
}
struct MoeOrderG : MoeOrder { __device__ __forceinline__ const char* a_base(const Unit&) const { return A; } };

__device__ __forceinline__ u32x4 pk8(const f32x4& a, const f32x4& b) { return (u32x4){cvtpk(a[0], a[1]), cvtpk(a[2], a[3]), cvtpk(b[0], b[1]), cvtpk(b[2], b[3])}; }
struct EpiStore {
    static constexpr bool PERM = true;
    bf16_t* C; int ldc; const float* rs;
    __device__ __forceinline__ void operator()(const f32x4 (&acc)[2][2][4][2], const Unit& u, int wr, int wc, int fr, int fq) const {
        bf16_t* base = C + ((size_t)u.pm * 256 + wr * 64 + fr) * ldc + u.pn * 256 + wc * 32 + 8 * fq;
#pragma unroll
        for (int ai = 0; ai < 2; ++ai)
#pragma unroll
            for (int m = 0; m < 4; ++m) { bf16_t* rowp = base + (size_t)(ai * HALF + m * 16) * ldc; const float s = rs ? rs[ai * HALF + wr * 64 + m * 16 + fr] : 1.f;
#pragma unroll
                for (int bj = 0; bj < 2; ++bj) *(u32x4*)(rowp + bj * HALF) = pk8(acc[ai][bj][m][0] * s, acc[ai][bj][m][1] * s); }
    }
};
constexpr float ACT8_SCALE = 4.f;
struct EpiAct {
    static constexpr bool PERM = true;
    unsigned char* Act; const float* b1all;
    __device__ __forceinline__ void operator()(const f32x4 (&acc)[2][2][4][2], const Unit& u, int wr, int wc, int fr, int fq) const {
        const int f0 = u.pn * 128 + wc * 32 + 8 * fq;
        const float* bb = b1all + (size_t)u.e * 2048 + 2 * f0;
        f32x4 bv[4];
#pragma unroll
        for (int q = 0; q < 4; ++q) bv[q] = *(const f32x4*)(bb + 4 * q);
        unsigned char* base = Act + ((size_t)u.slot0 + wr * 64 + fr) * 1024 + f0;
#pragma unroll
        for (int ai = 0; ai < 2; ++ai)
#pragma unroll
            for (int m = 0; m < 4; ++m) {
                const int r = ai * HALF + wr * 64 + m * 16 + fr;
                float a[8];
#pragma unroll
                for (int n = 0; n < 2; ++n)
#pragma unroll
                    for (int j = 0; j < 4; ++j) { const int f = 4 * n + j;
                        float glu = acc[ai][0][m][n][j] + bv[f >> 1][(f & 1) * 2], lin = acc[ai][1][m][n][j] + bv[f >> 1][(f & 1) * 2 + 1];
                        glu = fminf(glu, 7.f); lin = fminf(fmaxf(lin, -7.f), 7.f);
                        a[f] = glu * __builtin_amdgcn_rcpf(1.f + __builtin_amdgcn_exp2f(-1.702f * LOG2E * glu)) * (lin * ACT8_SCALE + ACT8_SCALE); }
                if (r < u.nvalid) *(u32x2*)(base + (size_t)(ai * HALF + m * 16) * 1024) = (u32x2){pk4_fp8(a[0], a[1], a[2], a[3]), pk4_fp8(a[4], a[5], a[6], a[7])};
            }
    }
};
struct EpiBias {
    static constexpr bool PERM = true;
    bf16_t* Y; const float* b2all;
    __device__ __forceinline__ void operator()(const f32x4 (&acc)[2][2][4][2], const Unit& u, int wr, int wc, int fr, int fq) const {
        const int c0 = u.pn * 256 + wc * 32 + 8 * fq;
        const float* bb = b2all + (size_t)u.e * 1024 + c0;
        f32x4 bv[2][2];
#pragma unroll
        for (int bj = 0; bj < 2; ++bj)
#pragma unroll
            for (int n = 0; n < 2; ++n) bv[bj][n] = *(const f32x4*)(bb + bj * HALF + 4 * n);
        bf16_t* base = Y + ((size_t)u.slot0 + wr * 64 + fr) * 1024 + c0;
#pragma unroll
        for (int ai = 0; ai < 2; ++ai)
#pragma unroll
            for (int m = 0; m < 4; ++m) { const int r = ai * HALF + wr * 64 + m * 16 + fr;
                if (r < u.nvalid) {
#pragma unroll
                    for (int bj = 0; bj < 2; ++bj) *(u32x4*)(base + (size_t)(ai * HALF + m * 16) * 1024 + bj * HALF) = pk8(acc[ai][bj][m][0] + bv[bj][0], acc[ai][bj][m][1] + bv[bj][1]); } }
    }
};
}

__device__ __forceinline__ u32x4 pack8(const float (&v)[8]) { return (u32x4){cvtpk(v[0], v[1]), cvtpk(v[2], v[3]), cvtpk(v[4], v[5]), cvtpk(v[6], v[7])}; }
struct EpiPlain {
    static constexpr bool MOE1 = false;
    bf16_t* C; int ldc;
    __device__ __forceinline__ void row8(int r, int c, const float (&v)[8]) const { *(u32x4*)(C + (size_t)r * ldc + c) = pack8(v); }
    __device__ __forceinline__ void pair(int, int, const float (&)[8], const float (&)[8]) const {}
};
struct EpiRowScale {
    static constexpr bool MOE1 = false;
    bf16_t* C; int ldc; const float* rs;
    __device__ __forceinline__ void row8(int r, int c, const float (&v)[8]) const { const float s = rs[r]; float w[8];
#pragma unroll
        for (int i = 0; i < 8; ++i) w[i] = v[i] * s;
        *(u32x4*)(C + (size_t)r * ldc + c) = pack8(w); }
    __device__ __forceinline__ void pair(int, int, const float (&)[8], const float (&)[8]) const {}
};
__device__ __forceinline__ void phase_gemm_plain(const bf16_t* A, int lda, const bf16_t* Bt, int K, bf16_t* C, int ldc, int nM, int nN) {
    const int G = gridDim.x;
    for (int u = blockIdx.x; u < nM * nN; u += G) {
        const int pm = u / nN, pn = u % nN;
        int aoff[2][2], boff[2];
        gm::make_off(aoff, pm * 256, lda); gm::make_off1(boff, pn * 128, K);
        EpiPlain epi{C + (size_t)pm * 256 * ldc + pn * 128, ldc};
        gm::gemm_tile(A, aoff, Bt, boff, K / 64, epi);
    }
}

struct Row16 { float4 v[4]; };
__device__ __forceinline__ Row16 ld_row_f32(const float* p, int lane) { Row16 r;
#pragma unroll
    for (int i = 0; i < 4; ++i) r.v[i] = *(const float4*)(p + lane * 4 + 256 * i);
    return r; }
__device__ __forceinline__ Row16 ld_row_bf16(const bf16_t* p, int lane) { Row16 r;
#pragma unroll
    for (int i = 0; i < 4; ++i) { const u32x2 w = *(const u32x2*)(p + lane * 4 + 256 * i);
        r.v[i] = make_float4(__uint_as_float(w.x << 16), __uint_as_float(w.x & 0xFFFF0000u), __uint_as_float(w.y << 16), __uint_as_float(w.y & 0xFFFF0000u)); }
    return r; }
__device__ __forceinline__ void st_row_f32(float* p, int lane, const Row16& r) {
#pragma unroll
    for (int i = 0; i < 4; ++i) *(float4*)(p + lane * 4 + 256 * i) = r.v[i]; }
__device__ __forceinline__ void st_row_bf16(bf16_t* p, int lane, const Row16& r) {
#pragma unroll
    for (int i = 0; i < 4; ++i) { u32x2 w; w.x = cvtpk(r.v[i].x, r.v[i].y); w.y = cvtpk(r.v[i].z, r.v[i].w); *(u32x2*)(p + lane * 4 + 256 * i) = w; } }
__device__ __forceinline__ void st_row_fp8(unsigned char* p, int lane, const Row16& r) {
#pragma unroll
    for (int i = 0; i < 4; ++i) *(unsigned*)(p + lane * 4 + 256 * i) = pk4_fp8(r.v[i].x, r.v[i].y, r.v[i].z, r.v[i].w); }
__device__ __forceinline__ float row_rstd(const Row16& r) {
    float s = 0.f;
#pragma unroll
    for (int i = 0; i < 4; ++i) s += r.v[i].x * r.v[i].x + r.v[i].y * r.v[i].y + r.v[i].z * r.v[i].z + r.v[i].w * r.v[i].w;
    s = wave_sum(s);
    return rsqrtf(s * (1.f / 1024.f) + EPSN);
}
__device__ __forceinline__ Row16 norm_mod(const Row16& x, float rstd, const float* g, const float* sc, const float* sh, int lane) {
    Row16 h;
#pragma unroll
    for (int i = 0; i < 4; ++i) {
        const int c = lane * 4 + 256 * i;
        const float4 gv = *(const float4*)(g + c), scv = *(const float4*)(sc + c), shv = *(const float4*)(sh + c);
        h.v[i].x = x.v[i].x * rstd * gv.x * (1.f + scv.x) + shv.x; h.v[i].y = x.v[i].y * rstd * gv.y * (1.f + scv.y) + shv.y;
        h.v[i].z = x.v[i].z * rstd * gv.z * (1.f + scv.z) + shv.z; h.v[i].w = x.v[i].w * rstd * gv.w * (1.f + scv.w) + shv.w;
    }
    return h;
}
__device__ __forceinline__ Row16 resid_add(const Row16& x, const Row16& y, float rstd, const float* g, const float* gate, int lane) {
    Row16 o;
#pragma unroll
    for (int i = 0; i < 4; ++i) {
        const int c = lane * 4 + 256 * i;
        const float4 gv = *(const float4*)(g + c), ga = *(const float4*)(gate + c);
        o.v[i].x = x.v[i].x + y.v[i].x * rstd * gv.x * ga.x; o.v[i].y = x.v[i].y + y.v[i].y * rstd * gv.y * ga.y;
        o.v[i].z = x.v[i].z + y.v[i].z * rstd * gv.z * ga.z; o.v[i].w = x.v[i].w + y.v[i].w * rstd * gv.w * ga.w;
    }
    return o;
}
__device__ __forceinline__ const float* mod_ptr(PRef p, int l, int r) { return (const float*)(p.ws + WS_MOD) + (size_t)(l * 2 + (r < CTXN ? 1 : 0)) * 6144; }
__device__ __forceinline__ const float* src_row(PRef p, int r) { return r < CTXN ? p.ctx + (size_t)r * 1024 : p.x + (size_t)(r - CTXN) * 1024; }

struct ModAB { float4 a[4], b[4]; };
struct ModG { float4 g[4]; };
__device__ __forceinline__ ModAB load_ab(const float* g, const float* sc, const float* sh, int lane) { ModAB m;
#pragma unroll
    for (int i = 0; i < 4; ++i) { const int c = lane * 4 + 256 * i; const float4 gv = *(const float4*)(g + c), sv = *(const float4*)(sc + c); m.b[i] = *(const float4*)(sh + c);
        m.a[i] = make_float4(gv.x * (1.f + sv.x), gv.y * (1.f + sv.y), gv.z * (1.f + sv.z), gv.w * (1.f + sv.w)); }
    return m; }
__device__ __forceinline__ ModG load_g(const float* g, const float* gate, int lane) { ModG m;
#pragma unroll
    for (int i = 0; i < 4; ++i) { const int c = lane * 4 + 256 * i; const float4 gv = *(const float4*)(g + c), ga = *(const float4*)(gate + c); m.g[i] = make_float4(gv.x * ga.x, gv.y * ga.y, gv.z * ga.z, gv.w * ga.w); }
    return m; }
__device__ __forceinline__ Row16 apply_ab(const Row16& x, float rstd, const ModAB& m) { Row16 h;
#pragma unroll
    for (int i = 0; i < 4; ++i) h.v[i] = make_float4(x.v[i].x * rstd * m.a[i].x + m.b[i].x, x.v[i].y * rstd * m.a[i].y + m.b[i].y, x.v[i].z * rstd * m.a[i].z + m.b[i].z, x.v[i].w * rstd * m.a[i].w + m.b[i].w);
    return h; }
__device__ __forceinline__ Row16 apply_g(const Row16& x, const Row16& y, float rstd, const ModG& m) { Row16 o;
#pragma unroll
    for (int i = 0; i < 4; ++i) o.v[i] = make_float4(x.v[i].x + y.v[i].x * rstd * m.g[i].x, x.v[i].y + y.v[i].y * rstd * m.g[i].y, x.v[i].z + y.v[i].z * rstd * m.g[i].z, x.v[i].w + y.v[i].w * rstd * m.g[i].w);
    return o; }
struct RowB8 { u32x2 v[4]; };
__device__ __forceinline__ RowB8 ld_rowb(const bf16_t* p, int lane) { RowB8 r;
#pragma unroll
    for (int i = 0; i < 4; ++i) r.v[i] = *(const u32x2*)(p + lane * 4 + 256 * i);
    return r; }
__device__ __forceinline__ Row16 cvt_rowb(const RowB8& b) { Row16 r;
#pragma unroll
    for (int i = 0; i < 4; ++i) r.v[i] = make_float4(__uint_as_float(b.v[i].x << 16), __uint_as_float(b.v[i].x & 0xFFFF0000u), __uint_as_float(b.v[i].y << 16), __uint_as_float(b.v[i].y & 0xFFFF0000u));
    return r; }

__device__ __forceinline__ void phase_norm1_l0(PRef p) {
    const int lane = threadIdx.x & 63, wave = threadIdx.x >> 6, G = gridDim.x, step = G * 8;
    bf16_t* HB = (bf16_t*)(p.ws + WS_HB);
    int r = blockIdx.x * 8 + wave;
    if (r >= NTOK) return;
    int cur_s = (r < CTXN) ? 1 : 0;
    const float* mod = mod_ptr(p, 0, r);
    ModAB m = load_ab(p.norm_g, mod + 1024, mod, lane);
    Row16 x = ld_row_f32(src_row(p, r), lane);
    for (; r < NTOK; r += step) {
        const int rn = r + step;
        Row16 xn = x;
        if (rn < NTOK) xn = ld_row_f32(src_row(p, rn), lane);
        const int s_ = (r < CTXN) ? 1 : 0;
        if (s_ != cur_s) { cur_s = s_; const float* md = mod_ptr(p, 0, r); m = load_ab(p.norm_g, md + 1024, md, lane); }
        const float rstd = row_rstd(x);
        st_row_bf16(HB + (size_t)r * 1024, lane, apply_ab(x, rstd, m));
        x = xn;
    }
}

__device__ __forceinline__ void phase_mid(PRef p, int l) {
    const int tid = tid_opaque(), lane = tid & 63, wave = tid >> 6, G = gridDim.x;
    float* wT = (float*)smem;
    int* lcnt = (int*)(smem + 139264);
    int* lbase = lcnt + 32;
    int* sel = lbase + 32;
    {
        const float4* src = (const float4*)((const float*)(p.ws + WS_RWT) + (size_t)l * 32 * 1024);
        for (int i = tid; i < 32 * 1024 / 4; i += NTH) ((float4*)wT)[i] = src[i];
        if (tid < 32) lcnt[tid] = 0;
    }
    __syncthreads();
    const int r_begin = (l == 0) ? 0 : CTXN;
    bf16_t* HB = (bf16_t*)(p.ws + WS_HB); const bf16_t* OB = (const bf16_t*)(p.ws + WS_OB);
    float* X1 = (float*)(p.ws + WS_X1); const float* X2 = (const float*)(p.ws + WS_X2);
    const float* ng = p.norm_g + (size_t)l * 4 * 1024;
    const float* rb = p.router_b + l * 32;
    float* GATE = (float*)(p.ws + WS_GATE);
    int it = 0;
    int r = r_begin + blockIdx.x * 8 + wave;
    const int step = G * 8;
    int cur_s = -1; ModG mg; ModAB mab;
    Row16 xin; RowB8 ob;
    if (r < NTOK) { xin = (l == 0) ? ld_row_f32(src_row(p, r), lane) : ld_row_f32(X2 + (size_t)r * 1024, lane); ob = ld_rowb(OB + (size_t)r * 1024, lane); }
    for (; r < NTOK; r += step, ++it) {
        const int rn = r + step;
        Row16 xin_n = xin; RowB8 ob_n = ob;
        if (rn < NTOK) { xin_n = (l == 0) ? ld_row_f32(src_row(p, rn), lane) : ld_row_f32(X2 + (size_t)rn * 1024, lane); ob_n = ld_rowb(OB + (size_t)rn * 1024, lane); }
        const int s_ = (r < CTXN) ? 1 : 0;
        if (s_ != cur_s) { cur_s = s_; const float* mod = mod_ptr(p, l, r); mg = load_g(ng + 1024, mod + 2048, lane); mab = load_ab(ng + 2048, mod + 4096, mod + 3072, lane); }
        const Row16 o = cvt_rowb(ob);
        const float rso = row_rstd(o);
        const Row16 x1 = apply_g(xin, o, rso, mg);
        st_row_f32(X1 + (size_t)r * 1024, lane, x1);
        const float rs1 = row_rstd(x1);
        const Row16 h = apply_ab(x1, rs1, mab);
        xin = xin_n; ob = ob_n;
        float part[32];
        {
            const float* wl = wT + lane * 4;
            float4 wa[4], wb[4];
#pragma unroll
            for (int i = 0; i < 4; ++i) wa[i] = *(const float4*)(wl + 256 * i);
#pragma unroll
            for (int e = 0; e < 32; e += 2) {
#pragma unroll
                for (int i = 0; i < 4; ++i) wb[i] = *(const float4*)(wl + (e + 1) * 1024 + 256 * i);
                { float a = 0.f;
#pragma unroll
                  for (int i = 0; i < 4; ++i) a += h.v[i].x * wa[i].x + h.v[i].y * wa[i].y + h.v[i].z * wa[i].z + h.v[i].w * wa[i].w;
                  part[e] = a; }
                if (e + 2 < 32) {
#pragma unroll
                    for (int i = 0; i < 4; ++i) wa[i] = *(const float4*)(wl + (e + 2) * 1024 + 256 * i);
                }
                { float a = 0.f;
#pragma unroll
                  for (int i = 0; i < 4; ++i) a += h.v[i].x * wb[i].x + h.v[i].y * wb[i].y + h.v[i].z * wb[i].z + h.v[i].w * wb[i].w;
                  part[e + 1] = a; }
            }
        }
        st_row_fp8((unsigned char*)HB + (size_t)r * 1024, lane, h);
#define TR_STEP(NV, BIT) _Pragma("unroll") for (int i = 0; i < (NV) / 2; ++i) { const float lo = part[i], hi_ = part[i + (NV) / 2]; const bool up = (lane & (BIT)) != 0; \
            const float send = up ? lo : hi_, keep = up ? hi_ : lo; part[i] = keep + __shfl_xor(send, (BIT)); }
        TR_STEP(32, 32) TR_STEP(16, 16) TR_STEP(8, 8) TR_STEP(4, 4) TR_STEP(2, 2)
#undef TR_STEP
        float logit = part[0] + __shfl_xor(part[0], 1);
        const int myexp = lane >> 1;
        logit += rb[myexp];
        float val = (lane & 1) ? -3.0e38f : logit;
        float tv[4]; int ti[4];
#pragma unroll
        for (int k = 0; k < 4; ++k) {
            float bv = val; int bi = myexp;
#pragma unroll
            for (int off = 32; off >= 1; off >>= 1) { const float ov = __shfl_xor(bv, off); const int oi = __shfl_xor(bi, off); if (ov > bv || (ov == bv && oi < bi)) { bv = ov; bi = oi; } }
            tv[k] = bv; ti[k] = bi;
            if (myexp == bi) val = -3.0e38f;
        }
        const float e1 = __expf(tv[1] - tv[0]), e2 = __expf(tv[2] - tv[0]), e3 = __expf(tv[3] - tv[0]);
        const float inv = 1.f / (1.f + e1 + e2 + e3);
        if (lane < 4) {
            const int k = lane;
            const int e = (k == 0) ? ti[0] : (k == 1) ? ti[1] : (k == 2) ? ti[2] : ti[3];
            const float gk = ((k == 0) ? 1.f : (k == 1) ? e1 : (k == 2) ? e2 : e3) * inv;
            GATE[(size_t)r * 4 + k] = gk;
            const int lp = atomicAdd(&lcnt[e], 1);
            sel[(it * 8 + wave) * 4 + k] = e | (lp << 8);
        }
    }
    __syncthreads();
    int* CNT = (int*)(p.ws + WS_CNT) + l * 32;
    if (tid < 32) lbase[tid] = atomicAdd(&CNT[tid], lcnt[tid]);
    __syncthreads();
    {
        int* TOPE = (int*)(p.ws + WS_TOPE); int* TOPP = (int*)(p.ws + WS_TOPP); int* LIST = (int*)(p.ws + WS_LIST);
        for (int q = tid; q < 80 * 4; q += NTH) {
            const int slot = q >> 2, k = q & 3, itq = slot >> 3, wv = slot & 7;
            const int r = r_begin + blockIdx.x * 8 + wv + itq * G * 8;
            if (r < NTOK) {
                const int s = sel[q], e = s & 255, lp = s >> 8, pos = lbase[e] + lp;
                TOPE[(size_t)r * 4 + k] = e; TOPP[(size_t)r * 4 + k] = pos; LIST[(size_t)e * NTOK + pos] = r;
            }
        }
    }
    __syncthreads();
}

struct MoeLds { int* cnt; int* off; int* toff; };
__device__ __forceinline__ MoeLds moe_setup(PRef p, int l, char* base) {
    MoeLds m; m.cnt = (int*)base; m.off = m.cnt + 32; m.toff = m.off + 33;
    const int tid = tid_opaque();
    if (tid < 64) {
        const int e = tid & 31;
        const int cval = ((const int*)(p.ws + WS_CNT))[l * 32 + e];
        const int tiles = (cval + 255) >> 8;
        int pc = cval, pt = tiles;
#pragma unroll
        for (int o = 1; o < 32; o <<= 1) { const int a = __shfl_up(pc, o, 32), b = __shfl_up(pt, o, 32); if (e >= o) { pc += a; pt += b; } }
        if (tid < 32) { m.cnt[e] = cval; m.off[e + 1] = pc; m.toff[e + 1] = pt; if (e == 0) { m.off[0] = 0; m.toff[0] = 0; } }
    }
    __syncthreads();
    return m;
}

__device__ __forceinline__ void phase_end(PRef p, int l) {
    const int tid = tid_opaque(), lane = tid & 63, wave = tid >> 6, G = gridDim.x;
    MoeLds ml = moe_setup(p, l, smem);
    const int r_begin = (l == 0) ? 0 : CTXN;
    const bf16_t* YB = (const bf16_t*)(p.ws + WS_YB);
    const float* X1 = (const float*)(p.ws + WS_X1); float* X2 = (float*)(p.ws + WS_X2);
    bf16_t* HB = (bf16_t*)(p.ws + WS_HB);
    const int* TOPE = (const int*)(p.ws + WS_TOPE); const int* TOPP = (const int*)(p.ws + WS_TOPP); const float* GATE = (const float*)(p.ws + WS_GATE);
    const float* ng = p.norm_g + (size_t)l * 4 * 1024;
    int cur_s = -1; ModG mg; ModAB mab;
    int r = r_begin + blockIdx.x * 8 + wave;
    int4 en = make_int4(0, 0, 0, 0), pn = make_int4(0, 0, 0, 0); float4 gn = make_float4(0.f, 0.f, 0.f, 0.f);
    const int step = G * 8;
    if (r < NTOK) { en = *(const int4*)(TOPE + (size_t)r * 4); pn = *(const int4*)(TOPP + (size_t)r * 4); gn = *(const float4*)(GATE + (size_t)r * 4); }
    RowB8 t4n[4]; Row16 x1n; float4 gcur = gn;
    if (r < NTOK) {
        t4n[0] = ld_rowb(YB + (size_t)(ml.off[en.x] + pn.x) * 1024, lane); t4n[1] = ld_rowb(YB + (size_t)(ml.off[en.y] + pn.y) * 1024, lane);
        t4n[2] = ld_rowb(YB + (size_t)(ml.off[en.z] + pn.z) * 1024, lane); t4n[3] = ld_rowb(YB + (size_t)(ml.off[en.w] + pn.w) * 1024, lane);
        x1n = ld_row_f32(X1 + (size_t)r * 1024, lane);
        if (r + step < NTOK) { en = *(const int4*)(TOPE + (size_t)(r + step) * 4); pn = *(const int4*)(TOPP + (size_t)(r + step) * 4); gn = *(const float4*)(GATE + (size_t)(r + step) * 4); }
    }
    for (; r < NTOK; r += step) {
        RowB8 t4[4]; t4[0] = t4n[0]; t4[1] = t4n[1]; t4[2] = t4n[2]; t4[3] = t4n[3];
        const Row16 x1 = x1n;
        const float g4[4] = {gcur.x, gcur.y, gcur.z, gcur.w};
        const int rn = r + step;
        if (rn < NTOK) {
            t4n[0] = ld_rowb(YB + (size_t)(ml.off[en.x] + pn.x) * 1024, lane); t4n[1] = ld_rowb(YB + (size_t)(ml.off[en.y] + pn.y) * 1024, lane);
            t4n[2] = ld_rowb(YB + (size_t)(ml.off[en.z] + pn.z) * 1024, lane); t4n[3] = ld_rowb(YB + (size_t)(ml.off[en.w] + pn.w) * 1024, lane);
            x1n = ld_row_f32(X1 + (size_t)rn * 1024, lane);
            gcur = gn;
            if (rn + step < NTOK) { en = *(const int4*)(TOPE + (size_t)(rn + step) * 4); pn = *(const int4*)(TOPP + (size_t)(rn + step) * 4); gn = *(const float4*)(GATE + (size_t)(rn + step) * 4); }
        }
        const int s_ = (r < CTXN) ? 1 : 0;
        if (s_ != cur_s) { cur_s = s_; const float* mod = mod_ptr(p, l, r); mg = load_g(ng + 3072, mod + 5120, lane);
            if (l == 0) { const float* mod1 = mod_ptr(p, 1, r); mab = load_ab(p.norm_g + (size_t)4 * 1024, mod1 + 1024, mod1, lane); } }
        Row16 y;
#pragma unroll
        for (int i = 0; i < 4; ++i) y.v[i] = make_float4(0.f, 0.f, 0.f, 0.f);
#pragma unroll
        for (int k = 0; k < 4; ++k) { const Row16 t = cvt_rowb(t4[k]); const float gk = g4[k];
#pragma unroll
            for (int i = 0; i < 4; ++i) { y.v[i].x += gk * t.v[i].x; y.v[i].y += gk * t.v[i].y; y.v[i].z += gk * t.v[i].z; y.v[i].w += gk * t.v[i].w; } }
        const float rsy = row_rstd(y);
        const Row16 x2 = apply_g(x1, y, rsy, mg);
        if (l == 0) {
            st_row_f32(X2 + (size_t)r * 1024, lane, x2);
            const float rs2 = row_rstd(x2);
            st_row_bf16(HB + (size_t)r * 1024, lane, apply_ab(x2, rs2, mab));
        } else {
            st_row_f32(p.out + (size_t)(r - CTXN) * 1024, lane, x2);
        }
    }
    __syncthreads();
}

__device__ __forceinline__ void phase_gemm_pg8(const bf16_t* A, int lda, const bf16_t* Bt, int K, bf16_t* C, int ldc, int nM, int nN) {
    pg8::PlainOrder S; S.init(A, lda, Bt, K, nM, nN);
    pg8::EpiStore E{C, ldc, nullptr};
    pg8::gemm_phase<pg8::EpiStore, pg8::PlainOrder, false>((PG8_LAS unsigned char*)smem, S, E, K, lda, K);
    __syncthreads();
}
constexpr int MOE_GL_OFF = 131072, MOE_ML_OFF = 143360, MOE_TAB_OFF = 143872, MOE_GL_MAX = 12;
__device__ __forceinline__ void phase_moe1(PRef p, int l) {
    MoeLds ml = moe_setup(p, l, smem + MOE_ML_OFF);
    const int tid = tid_opaque();
    PG8_LAS int* gl = (PG8_LAS int*)(smem + MOE_GL_OFF);
    PG8_LAS int* tab = (PG8_LAS int*)(smem + MOE_TAB_OFF);
    pg8::MoeOrderG S;
    S.A = (const char*)(p.ws + WS_HB); S.W = (const char*)(p.ws + WS_W1T) + (size_t)l * 32 * 2048 * 1024;
    S.tab = tab; S.gl = gl; S.wrows = 2048;
    S.nunits = pg8::moe_build_units(tab, ml.cnt, ml.off, ml.toff, 8);
    if (S.nunits > MOE_GL_MAX) S.nunits = MOE_GL_MAX;
    const int* LIST = (const int*)(p.ws + WS_LIST);
    for (int i = 0; i < S.nunits; ++i) {
        const int e = tab[i * 8 + 2], mt = tab[i * 8 + 0], nvalid = tab[i * 8 + 3], m = mt - ml.toff[e];
        if (tid < 256) gl[i * 256 + tid] = (tid < nvalid) ? LIST[(size_t)e * NTOK + m * 256 + tid] : 0;
    }
    __syncthreads();
    pg8::EpiAct E{(unsigned char*)(p.ws + WS_ACT), p.moe_b1 + (size_t)l * 32 * 2048};
    pg8::gemm_phase<pg8::EpiAct, pg8::MoeOrderG, true, true>((PG8_LAS unsigned char*)smem, S, E, 512, 512, 512, 0x7F7F7F7F, 0x79797979);
    __syncthreads();
}
__device__ __forceinline__ void phase_moe2(PRef p, int l) {
    MoeLds ml = moe_setup(p, l, smem + MOE_ML_OFF);
    PG8_LAS int* tab = (PG8_LAS int*)(smem + MOE_TAB_OFF);
    PG8_LAS int* gl = (PG8_LAS int*)(smem + MOE_GL_OFF);
    pg8::MoeOrderG S;
    S.A = (const char*)(p.ws + WS_ACT); S.W = (const char*)(p.ws + WS_W2T) + (size_t)l * 32 * 1024 * 1024;
    S.tab = tab; S.gl = gl; S.wrows = 1024;
    S.nunits = pg8::moe_build_units(tab, ml.cnt, ml.off, ml.toff, 4);
    if (S.nunits > MOE_GL_MAX) S.nunits = MOE_GL_MAX;
    { const int tid = tid_opaque();
      for (int i = 0; i < S.nunits; ++i) if (tid < 256) gl[i * 256 + tid] = tab[i * 8 + 4] + tid;
      __syncthreads(); }
    pg8::EpiBias E{(bf16_t*)(p.ws + WS_YB), p.moe_b2 + (size_t)l * 32 * 1024};
    pg8::gemm_phase<pg8::EpiBias, pg8::MoeOrderG, true, true>((PG8_LAS unsigned char*)smem, S, E, 512, 512, 512, 0x7D7D7D7D, 0x79797979);
    __syncthreads();
}

__device__ __forceinline__ void gla_local_units(PRef p);
__device__ __forceinline__ void rope8(const float* rope, int t, int j0, const u32x4& a, const u32x4& b, u32x4& oa, u32x4& ob);
__device__ __forceinline__ void rowstat(const bf16_t* A, int lda, int K, float* rs) {
    const int tid = tid_opaque(), r = tid >> 1, hf = tid & 1, half = K / 2;
    const bf16_t* q = A + (size_t)r * lda + hf * half;
    float s = 0.f;
    for (int i = 0; i < half; i += 8) { const u32x4 w = *(const u32x4*)(q + i);
#pragma unroll
        for (int j = 0; j < 4; ++j) { const float a = __uint_as_float(w[j] << 16), b = __uint_as_float(w[j] & 0xFFFF0000u); s += a * a + b * b; } }
    s += __shfl_xor(s, 1);
    if (hf == 0) rs[r] = rsqrtf(s / (float)K + EPSN);
    __syncthreads();
}
__device__ __forceinline__ void phase_mla_up(PRef p) {
    const int G = gridDim.x, tid = threadIdx.x;
    const bf16_t* P = (const bf16_t*)(p.ws + WS_P);
    float* rs = (float*)(smem + 139264);
    const int nM = NTOK / 256;
    {
        pg8::PlainOrder S; S.init(P + PC_CQ, PW, (const bf16_t*)(p.ws + WS_WUQ), 256, nM, 3);
        pg8::Unit u;
        if (S.next(0, u)) rowstat(P + (size_t)u.pm * 256 * PW + PC_CQ, PW, 256, rs);
        pg8::EpiStore E{(bf16_t*)(p.ws + WS_QM), 768, rs};
        pg8::gemm_phase<pg8::EpiStore, pg8::PlainOrder, false>((PG8_LAS unsigned char*)smem, S, E, 256, PW, 256);
        __syncthreads();
    }
    for (int v = (blockIdx.x + G - 195) % G; v < nM * 8; v += G) {
        int aoff[2][2], boff[2];
        const int pm = v >> 3, pn = v & 7, h = pn >> 1;
        rowstat(P + (size_t)pm * 256 * PW + PC_CKV, PW, 128, rs);
        gm::make_off(aoff, pm * 256, PW); gm::make_off1(boff, pn * 128, 128);
        bf16_t* dst = (pn & 1) ? (bf16_t*)(p.ws + WS_VM) + (size_t)pm * 256 * 512 + h * 128 : (bf16_t*)(p.ws + WS_KM) + (size_t)pm * 256 * 768 + h * 192;
        EpiRowScale epi{dst, (pn & 1) ? 512 : 768, rs};
        gm::gemm_tile(P + PC_CKV, aoff, (const bf16_t*)(p.ws + WS_WUKV), boff, 2, epi);
    }
    const float* rope = (const float*)(p.ws + WS_ROPE);
    bf16_t* KM = (bf16_t*)(p.ws + WS_KM);
    for (int i = blockIdx.x * NTH + tid; i < NTOK * 4; i += G * NTH) {
        const int r = i >> 2, j0 = (i & 3) * 8;
        const u32x4 a = *(const u32x4*)(P + (size_t)r * PW + PC_KR + j0), b = *(const u32x4*)(P + (size_t)r * PW + PC_KR + 32 + j0);
        u32x4 oa = a, ob = b;
        if (r >= CTXN) rope8(rope, r - CTXN, j0, a, b, oa, ob);
#pragma unroll
        for (int h = 0; h < 4; ++h) { *(u32x4*)(KM + (size_t)r * 768 + h * 192 + 128 + j0) = oa; *(u32x4*)(KM + (size_t)r * 768 + h * 192 + 160 + j0) = ob; }
    }
    __syncthreads();
    gla_local_units(p);
}

struct GlaB { float b[16]; float total; };
__device__ __forceinline__ GlaB gla_decay(PRef p, int gc, int h, float* scr  ) {
    const int tid = threadIdx.x, lane = tid & 63, wave = tid >> 6, dir = wave & 1, tq = wave >> 1;
    const bf16_t* P = (const bf16_t*)(p.ws + WS_P);
    float* af = scr;
    float* wa = scr + 2048;
    float* ba = scr + 4096;
    float* tot = scr + 4224;
#pragma unroll
    for (int i = 0; i < 4; ++i) {
        const int idx = tid + 512 * i, dd = idx >> 10, t = (idx >> 4) & 63, j = idx & 15;
        af[idx] = bf2f(P[(size_t)(gc * 64 + t) * PW + PC_AF + dd * 16 + j]);
        const int jj = (idx >> 6) & 15, d = idx & 63;
        wa[idx] = (dd == 0 ? p.gla_wa_f : p.gla_wa_b)[jj * 256 + h * 64 + d];
    }
    if (tid < 128) ba[tid] = ((tid >> 6) == 0 ? p.gla_ba_f : p.gla_ba_b)[h * 64 + (tid & 63)];
    __syncthreads();
    float w[16];
#pragma unroll
    for (int j = 0; j < 16; ++j) w[j] = wa[(dir * 16 + j) * 64 + lane];
    const float bias = ba[dir * 64 + lane];
    GlaB r;
#pragma unroll
    for (int i = 0; i < 16; ++i) {
        const int t = tq * 16 + i;
        float z = bias;
#pragma unroll
        for (int j = 0; j < 16; ++j) z += af[(dir * 64 + t) * 16 + j] * w[j];
        const float g = (fminf(z, 0.f) - __logf(1.f + __expf(-fabsf(z)))) * (1.f / 16.f);
        r.b[i] = g;
    }
    if (dir == 0) {
#pragma unroll
        for (int i = 1; i < 16; ++i) r.b[i] += r.b[i - 1];
        tot[(dir * 4 + tq) * 64 + lane] = r.b[15];
    } else {
#pragma unroll
        for (int i = 14; i >= 0; --i) r.b[i] += r.b[i + 1];
        tot[(dir * 4 + tq) * 64 + lane] = r.b[0];
    }
    __syncthreads();
    float offs = 0.f, total = 0.f;
#pragma unroll
    for (int q = 0; q < 4; ++q) { const float tv = tot[(dir * 4 + q) * 64 + lane]; total += tv; if (dir == 0 ? (q < tq) : (q > tq)) offs += tv; }
#pragma unroll
    for (int i = 0; i < 16; ++i) r.b[i] += offs;
    r.total = total;
    return r;
}

__device__ __forceinline__ void gla_stage_vt(const bf16_t* P, int gc, int h, bf16_t* VT) {
    const int tid = threadIdx.x, v = tid & 127, sq = tid >> 7;
    unsigned pk[8];
#pragma unroll
    for (int i = 0; i < 8; ++i) {
        const bf16_t a = P[(size_t)(gc * 64 + sq * 16 + 2 * i) * PW + PC_V + h * 128 + v], b = P[(size_t)(gc * 64 + sq * 16 + 2 * i + 1) * PW + PC_V + h * 128 + v];
        pk[i] = a | ((unsigned)b << 16);
    }
    *(u32x4*)(VT + v * 72 + sq * 16) = (u32x4){pk[0], pk[1], pk[2], pk[3]};
    *(u32x4*)(VT + v * 72 + sq * 16 + 8) = (u32x4){pk[4], pk[5], pk[6], pk[7]};
}

struct GlaPreL { u32x4 kc, vc[2], ac; float4 wac; float bac; };
__device__ __forceinline__ void gla_prefetch_local(PRef p, int gc, int h, GlaPreL& g) {
    const int tid = threadIdx.x;
    const bf16_t* P = (const bf16_t*)(p.ws + WS_P);
    g.kc = *(const u32x4*)(P + (size_t)(gc * 64 + (tid >> 3)) * PW + PC_K + h * 64 + (tid & 7) * 8);
#pragma unroll
    for (int i = 0; i < 2; ++i) { const int idx = tid + 512 * i; g.vc[i] = *(const u32x4*)(P + (size_t)(gc * 64 + (idx >> 4)) * PW + PC_V + h * 128 + (idx & 15) * 8); }
    g.ac = *(const u32x4*)(P + (size_t)(gc * 64 + ((tid & 255) >> 2)) * PW + PC_AF + (tid & 3) * 8);
    { const int dd = tid >> 8, jj = (tid >> 4) & 15, d4 = tid & 15; g.wac = *(const float4*)((dd == 0 ? p.gla_wa_f : p.gla_wa_b) + jj * 256 + h * 64 + d4 * 4); }
    g.bac = ((tid >> 6) & 1 ? p.gla_ba_b : p.gla_ba_f)[h * 64 + (tid & 63)];
}
template <int OFF> __device__ __forceinline__ s16x4 glal_tr(int vb) { s16x4 r; asm volatile("ds_read_b64_tr_b16 %0, %1 offset:%2" : "=&v"(r) : "v"(vb), "i"(OFF) : "memory"); return r; }
__device__ __forceinline__ void gla_local_units(PRef p) {
    const int tid = threadIdx.x, lane = tid & 63, wave = tid >> 6, r32 = lane & 31, hi = lane >> 5, G = gridDim.x;
    bf16_t* kdT = (bf16_t*)smem;
    bf16_t* Kraw = kdT + 2 * 64 * 72;
    char* Vraw = smem + 27648;
    float* af = (float*)(smem + 49152);
    float* wa = af + 2048; float* ba = wa + 2048; float* tot = ba + 128;
    bf16_t* U = (bf16_t*)(p.ws + WS_U); float* DEC = (float*)(p.ws + WS_DEC);
    int u = blockIdx.x;
    if (u >= NCH * 4) return;
    GlaPreL g;
    gla_prefetch_local(p, u >> 2, u & 3, g);
    const int dir = wave & 1, tq = wave >> 1;
    for (; u < NCH * 4; u += G) {
        const int gc = u >> 2, h = u & 3;
        *(u32x4*)(Kraw + (tid >> 3) * 72 + (tid & 7) * 8) = g.kc;
#pragma unroll
        for (int i = 0; i < 2; ++i) { const int idx = tid + 512 * i; *(u32x4*)(Vraw + (idx >> 4) * 320 + (idx & 15) * 16) = g.vc[i]; }
        if (tid < 256) { const int t = tid >> 2, ch = tid & 3, dd = ch >> 1, j0 = (ch & 1) * 8; float* q = af + dd * 1024 + t * 16 + j0;
#pragma unroll
            for (int e = 0; e < 4; ++e) { q[2 * e] = __uint_as_float(g.ac[e] << 16); q[2 * e + 1] = __uint_as_float(g.ac[e] & 0xFFFF0000u); } }
        { const int dd = tid >> 8, jj = (tid >> 4) & 15, d4 = tid & 15; *(float4*)(wa + (dd * 16 + jj) * 64 + d4 * 4) = g.wac; }
        if (tid < 128) ba[tid] = g.bac;
        __syncthreads();
        const int un = u + G;
        if (un < NCH * 4) gla_prefetch_local(p, un >> 2, un & 3, g);
        float bb[16]; float total = 0.f;
        {
            float w[16];
#pragma unroll
            for (int j = 0; j < 16; ++j) w[j] = wa[(dir * 16 + j) * 64 + lane];
            const float bias = ba[dir * 64 + lane];
#pragma unroll
            for (int i = 0; i < 16; ++i) {
                const int t = tq * 16 + i;
                float z = bias;
#pragma unroll
                for (int j = 0; j < 16; ++j) z += af[(dir * 64 + t) * 16 + j] * w[j];
                bb[i] = (fminf(z, 0.f) - __logf(1.f + __expf(-fabsf(z)))) * (1.f / 16.f);
            }
            if (dir == 0) {
#pragma unroll
                for (int i = 1; i < 16; ++i) bb[i] += bb[i - 1];
                tot[(dir * 4 + tq) * 64 + lane] = bb[15];
            } else {
#pragma unroll
                for (int i = 14; i >= 0; --i) bb[i] += bb[i + 1];
                tot[(dir * 4 + tq) * 64 + lane] = bb[0];
            }
        }
        __syncthreads();
        {
            float offs = 0.f;
#pragma unroll
            for (int q = 0; q < 4; ++q) { const float tv = tot[(dir * 4 + q) * 64 + lane]; total += tv; if (dir == 0 ? (q < tq) : (q > tq)) offs += tv; }
#pragma unroll
            for (int i = 0; i < 16; ++i) bb[i] += offs;
        }
        {
            unsigned pk[8];
#pragma unroll
            for (int i = 0; i < 8; ++i) {
                const int s0 = tq * 16 + 2 * i;
                const float k0 = bf2f(Kraw[s0 * 72 + lane]), k1 = bf2f(Kraw[(s0 + 1) * 72 + lane]);
                pk[i] = cvtpk(k0 * __expf(total - bb[2 * i]), k1 * __expf(total - bb[2 * i + 1]));
            }
            *(u32x4*)(kdT + (dir * 64 + lane) * 72 + tq * 16) = (u32x4){pk[0], pk[1], pk[2], pk[3]};
            *(u32x4*)(kdT + (dir * 64 + lane) * 72 + tq * 16 + 8) = (u32x4){pk[4], pk[5], pk[6], pk[7]};
            if (tq == 0) DEC[((size_t)(dir * NCH + gc) * 4 + h) * 64 + lane] = __expf(total);
        }
        __syncthreads();
        {
            const int mdir = wave >> 2, vbk = wave & 3;
            const int vb = (int)(uintptr_t)Vraw + (8 * hi + ((lane & 15) >> 2)) * 320 + (vbk * 32 + 16 * ((lane >> 4) & 1) + 4 * (lane & 3)) * 2;
            f32x16 a0 = {}, a1 = {};
#define GLAL_STEP(KS) do { const s16x4 l_ = glal_tr<(KS) * 5120>(vb), h_ = glal_tr<(KS) * 5120 + 1280>(vb); \
            const bf16x8 b0 = *(const bf16x8*)(kdT + (mdir * 64 + r32) * 72 + (KS) * 16 + hi * 8); \
            const bf16x8 b1 = *(const bf16x8*)(kdT + (mdir * 64 + 32 + r32) * 72 + (KS) * 16 + hi * 8); \
            asm volatile("s_waitcnt lgkmcnt(0)" ::: "memory"); SBAR(); \
            const bf16x8 a_ = (bf16x8){l_[0], l_[1], l_[2], l_[3], h_[0], h_[1], h_[2], h_[3]}; \
            a0 = __builtin_amdgcn_mfma_f32_32x32x16_bf16(a_, b0, a0, 0, 0, 0); a1 = __builtin_amdgcn_mfma_f32_32x32x16_bf16(a_, b1, a1, 0, 0, 0); } while (0)
            GLAL_STEP(0); GLAL_STEP(1); GLAL_STEP(2); GLAL_STEP(3);
#undef GLAL_STEP
            bf16_t* Uo = U + ((size_t)(mdir * NCH + gc) * 4 + h) * 8192;
#pragma unroll
            for (int r = 0; r < 16; ++r) { const int v = vbk * 32 + crow(r, hi); Uo[v * 64 + r32] = f2bf(a0[r]); Uo[v * 64 + 32 + r32] = f2bf(a1[r]); }
        }
        __syncthreads();
    }
}
__device__ __forceinline__ void rope8(const float* rope, int t, int j0, const u32x4& a, const u32x4& b, u32x4& oa, u32x4& ob) {
    const int row = t >> 6, col = t & 63;
    const float* cs = (j0 < 16) ? rope + row * 16 + j0 : rope + 512 * 16 + col * 16 + (j0 - 16);
    const float* sn = (j0 < 16) ? rope + 256 * 16 + row * 16 + j0 : rope + 512 * 16 + 64 * 16 + col * 16 + (j0 - 16);
    const f32x4 c0 = *(const f32x4*)cs, c1 = *(const f32x4*)(cs + 4), s0 = *(const f32x4*)sn, s1 = *(const f32x4*)(sn + 4);
#pragma unroll
    for (int e = 0; e < 4; ++e) {
        const float x1l = __uint_as_float(a[e] << 16), x1h = __uint_as_float(a[e] & 0xFFFF0000u), x2l = __uint_as_float(b[e] << 16), x2h = __uint_as_float(b[e] & 0xFFFF0000u);
        const float cl = (e < 2) ? c0[2 * e] : c1[2 * e - 4], ch = (e < 2) ? c0[2 * e + 1] : c1[2 * e - 3], sl = (e < 2) ? s0[2 * e] : s1[2 * e - 4], sh = (e < 2) ? s0[2 * e + 1] : s1[2 * e - 3];
        oa[e] = cvtpk(x1l * cl - x2l * sl, x1h * ch - x2h * sh);
        ob[e] = cvtpk(x1l * sl + x2l * cl, x1h * sh + x2h * ch);
    }
}
__device__ __forceinline__ u32x4 cvt16_fp8(const u32x4& a, const u32x4& b) {
    u32x4 o;
#pragma unroll
    for (int j = 0; j < 2; ++j) {
        o[j] = pk4_fp8(__uint_as_float(a[2 * j] << 16), __uint_as_float(a[2 * j] & 0xFFFF0000u), __uint_as_float(a[2 * j + 1] << 16), __uint_as_float(a[2 * j + 1] & 0xFFFF0000u));
        o[2 + j] = pk4_fp8(__uint_as_float(b[2 * j] << 16), __uint_as_float(b[2 * j] & 0xFFFF0000u), __uint_as_float(b[2 * j + 1] << 16), __uint_as_float(b[2 * j + 1] & 0xFFFF0000u));
    }
    return o;
}
constexpr float MLA_QS = 8.f * 0.07216878364870322f * 1.4426950408889634f;
__device__ __forceinline__ u32x4 cvt16_fp8s(const u32x4& a, const u32x4& b, float sc) {
    u32x4 o;
#pragma unroll
    for (int j = 0; j < 2; ++j) {
        o[j] = pk4_fp8(__uint_as_float(a[2 * j] << 16) * sc, __uint_as_float(a[2 * j] & 0xFFFF0000u) * sc, __uint_as_float(a[2 * j + 1] << 16) * sc, __uint_as_float(a[2 * j + 1] & 0xFFFF0000u) * sc);
        o[2 + j] = pk4_fp8(__uint_as_float(b[2 * j] << 16) * sc, __uint_as_float(b[2 * j] & 0xFFFF0000u) * sc, __uint_as_float(b[2 * j + 1] << 16) * sc, __uint_as_float(b[2 * j + 1] & 0xFFFF0000u) * sc);
    }
    return o;
}
__device__ __forceinline__ u32x2 cvt8_fp8s(const u32x4& a, float sc) { return (u32x2){pk4_fp8(__uint_as_float(a[0] << 16) * sc, __uint_as_float(a[0] & 0xFFFF0000u) * sc, __uint_as_float(a[1] << 16) * sc, __uint_as_float(a[1] & 0xFFFF0000u) * sc),
                                                                                 pk4_fp8(__uint_as_float(a[2] << 16) * sc, __uint_as_float(a[2] & 0xFFFF0000u) * sc, __uint_as_float(a[3] << 16) * sc, __uint_as_float(a[3] & 0xFFFF0000u) * sc)}; }
__device__ __forceinline__ u32x2 cvt8_fp8(const u32x4& a) { return (u32x2){pk4_fp8(__uint_as_float(a[0] << 16), __uint_as_float(a[0] & 0xFFFF0000u), __uint_as_float(a[1] << 16), __uint_as_float(a[1] & 0xFFFF0000u)),
                                                                       pk4_fp8(__uint_as_float(a[2] << 16), __uint_as_float(a[2] & 0xFFFF0000u), __uint_as_float(a[3] << 16), __uint_as_float(a[3] & 0xFFFF0000u))}; }
__device__ __forceinline__ void mla_pack_pass(PRef p, int b0, int nb) {
    const int tid = threadIdx.x, gt = (blockIdx.x - b0) * NTH + tid, gn = nb * NTH;
    const float* rope = (const float*)(p.ws + WS_ROPE);
    const bf16_t* QM = (const bf16_t*)(p.ws + WS_QM); const bf16_t* KM = (const bf16_t*)(p.ws + WS_KM); const bf16_t* VM = (const bf16_t*)(p.ws + WS_VM);
    unsigned char* Q8 = (unsigned char*)(p.ws + WS_Q8); unsigned char* K8 = (unsigned char*)(p.ws + WS_K8); unsigned char* VT8 = (unsigned char*)(p.ws + WS_VT8);
    for (int i = gt; i < NTOK * 48; i += gn) {
        const int r = i / 48, q = i % 48, hh = q / 12, c = q % 12;
        const bf16_t* qs = QM + (size_t)r * 768 + hh * 192; const bf16_t* ks = KM + (size_t)r * 768 + hh * 192;
        unsigned char* qd = Q8 + (size_t)r * 768 + hh * 192; unsigned char* kd = K8 + ((size_t)hh * NTOK + r) * 192;
        if (c < 8) {
            *(u32x4*)(qd + c * 16) = cvt16_fp8s(*(const u32x4*)(qs + c * 16), *(const u32x4*)(qs + c * 16 + 8), MLA_QS);
            *(u32x4*)(kd + c * 16) = cvt16_fp8(*(const u32x4*)(ks + c * 16), *(const u32x4*)(ks + c * 16 + 8));
        } else {
            const int j0 = (c - 8) * 8;
            const u32x4 a = *(const u32x4*)(qs + 128 + j0), b = *(const u32x4*)(qs + 160 + j0);
            u32x4 oa = a, ob = b;
            if (r >= CTXN) rope8(rope, r - CTXN, j0, a, b, oa, ob);
            *(u32x2*)(qd + 128 + j0) = cvt8_fp8s(oa, MLA_QS); *(u32x2*)(qd + 160 + j0) = cvt8_fp8s(ob, MLA_QS);
            *(u32x2*)(kd + 128 + j0) = cvt8_fp8(*(const u32x4*)(ks + 128 + j0)); *(u32x2*)(kd + 160 + j0) = cvt8_fp8(*(const u32x4*)(ks + 160 + j0));
        }
    }
    {
        const int lane = tid & 63, g = lane >> 4, dq = lane & 15;
        for (int u = gt >> 6; u < 4 * NCH; u += gn >> 6) {
            const int hh = u / NCH, t = u % NCH;
            const bf16_t* vs = VM + (size_t)(t * 64 + 16 * g) * 512 + hh * 128 + dq * 8;
            u32x4 w[16];
#pragma unroll
            for (int i = 0; i < 16; ++i) w[i] = *(const u32x4*)(vs + (size_t)i * 512);
            unsigned char* dst = VT8 + ((size_t)u * 128 + dq * 8) * 64 + 8 * g;
#pragma unroll
            for (int d = 0; d < 8; ++d) {
                float f[16];
#pragma unroll
                for (int i = 0; i < 16; ++i) f[i] = (d & 1) ? __uint_as_float(w[i][d >> 1] & 0xFFFF0000u) : __uint_as_float(w[i][d >> 1] << 16);
                *(u32x2*)(dst + d * 64) = (u32x2){pk4_fp8(f[0], f[1], f[2], f[3]), pk4_fp8(f[8], f[9], f[10], f[11])};
                *(u32x2*)(dst + d * 64 + 32) = (u32x2){pk4_fp8(f[4], f[5], f[6], f[7]), pk4_fp8(f[12], f[13], f[14], f[15])};
            }
        }
    }
}

__device__ __forceinline__ int gla_order(int dir, int step) { return dir == 0 ? step : (step < 4 ? 3 - step : NCH - 1 - (step - 4)); }
__device__ __forceinline__ void phase_gla_scan(PRef p) {
    const int gid = blockIdx.x * NTH + threadIdx.x;
    if (gid >= 2 * 4 * 8192) { mla_pack_pass(p, 128, (int)gridDim.x - 128); return; }
    const int dir = gid >> 15, h = (gid >> 13) & 3, e = gid & 8191, d = e & 63;
    const bf16_t* U = (const bf16_t*)(p.ws + WS_U); bf16_t* S = (bf16_t*)(p.ws + WS_SIN); const float* DEC = (const float*)(p.ws + WS_DEC);
    float s = 0.f;
#pragma unroll 1
    for (int s0 = 0; s0 < NCH; s0 += 52) {
        float uu[52], dc[52];
#pragma unroll
        for (int i = 0; i < 52; ++i) { const size_t o = ((size_t)(dir * NCH + gla_order(dir, s0 + i)) * 4 + h); uu[i] = bf2f(U[o * 8192 + e]); dc[i] = DEC[o * 64 + d]; }
#pragma unroll
        for (int i = 0; i < 52; ++i) { const size_t o = ((size_t)(dir * NCH + gla_order(dir, s0 + i)) * 4 + h); S[o * 8192 + e] = f2bf(s); s = dc[i] * s + uu[i]; }
    }
}

__device__ __forceinline__ void gla_out_unit(PRef p, int gc, int h) {
    const int tid = threadIdx.x, lane = tid & 63, wave = tid >> 6, r32 = lane & 31, hi = lane >> 5;
    const bf16_t* P = (const bf16_t*)(p.ws + WS_P);
    bf16_t* qe = (bf16_t*)smem;
    bf16_t* ke = qe + 2 * 64 * 72;
    bf16_t* Am = ke + 2 * 64 * 72;
    bf16_t* VT = Am + 2 * 64 * 72;
    bf16_t* ST = VT + 128 * 72;
    float* scr = (float*)(smem + 110592);
    float* ob = (float*)(ke);
    const GlaB gb = gla_decay(p, gc, h, scr);
    {
        const int dir = wave & 1, tq = wave >> 1;
#pragma unroll
        for (int i = 0; i < 16; ++i) {
            const int t = tq * 16 + i;
            const float qv = bf2f(P[(size_t)(gc * 64 + t) * PW + PC_Q + h * 64 + lane]) * 0.125f, kv = bf2f(P[(size_t)(gc * 64 + t) * PW + PC_K + h * 64 + lane]);
            qe[(dir * 64 + t) * 72 + lane] = f2bf(qv * __expf(gb.b[i]));
            ke[(dir * 64 + t) * 72 + lane] = f2bf(kv * __expf(-gb.b[i]));
        }
    }
    gla_stage_vt(P, gc, h, VT);
    {
        const bf16_t* S = (const bf16_t*)(p.ws + WS_SIN);
#pragma unroll
        for (int i = 0; i < 4; ++i) {
            const int cc = tid + 512 * i, dir = cc >> 10, v = (cc >> 3) & 127, ch = cc & 7;
            *(u32x4*)(ST + (dir * 128 + v) * 72 + ch * 8) = *(const u32x4*)(S + ((size_t)(dir * NCH + gc) * 4 + h) * 8192 + v * 64 + ch * 8);
        }
    }
    __syncthreads();
    {
        const int dir = wave >> 2, tb = (wave >> 1) & 1, sb = wave & 1;
        f32x16 acc = {};
#pragma unroll
        for (int ks = 0; ks < 4; ++ks) {
            const bf16x8 a = *(const bf16x8*)(qe + (dir * 64 + tb * 32 + r32) * 72 + ks * 16 + hi * 8);
            const bf16x8 b = *(const bf16x8*)(ke + (dir * 64 + sb * 32 + r32) * 72 + ks * 16 + hi * 8);
            acc = __builtin_amdgcn_mfma_f32_32x32x16_bf16(a, b, acc, 0, 0, 0);
        }
        const int s = sb * 32 + r32;
#pragma unroll
        for (int r = 0; r < 16; ++r) { const int t = tb * 32 + crow(r, hi); const bool keep = (dir == 0) ? (s <= t) : (s >= t); Am[(dir * 64 + t) * 72 + s] = f2bf(keep ? acc[r] : 0.f); }
    }
    __syncthreads();
    f32x16 o = {};
    const int tb = wave >> 2, vb = wave & 3;
#pragma unroll
    for (int dir = 0; dir < 2; ++dir)
#pragma unroll
        for (int ks = 0; ks < 4; ++ks) {
            const bf16x8 a1 = *(const bf16x8*)(Am + (dir * 64 + tb * 32 + r32) * 72 + ks * 16 + hi * 8);
            const bf16x8 b1 = *(const bf16x8*)(VT + (vb * 32 + r32) * 72 + ks * 16 + hi * 8);
            o = __builtin_amdgcn_mfma_f32_32x32x16_bf16(a1, b1, o, 0, 0, 0);
            const bf16x8 a2 = *(const bf16x8*)(qe + (dir * 64 + tb * 32 + r32) * 72 + ks * 16 + hi * 8);
            const bf16x8 b2 = *(const bf16x8*)(ST + (dir * 128 + vb * 32 + r32) * 72 + ks * 16 + hi * 8);
            o = __builtin_amdgcn_mfma_f32_32x32x16_bf16(a2, b2, o, 0, 0, 0);
        }
    __syncthreads();
#pragma unroll
    for (int r = 0; r < 16; ++r) ob[(tb * 32 + crow(r, hi)) * 132 + vb * 32 + r32] = o[r];
    __syncthreads();
    {
        const int t = tid >> 3, v0 = (tid & 7) * 16;
        float vals[16]; float ss = 0.f;
#pragma unroll
        for (int i = 0; i < 16; ++i) { vals[i] = ob[t * 132 + v0 + i]; ss += vals[i] * vals[i]; }
        ss += __shfl_xor(ss, 1); ss += __shfl_xor(ss, 2); ss += __shfl_xor(ss, 4);
        const float rstd = rsqrtf(ss * (1.f / 128.f) + EPSN);
        const size_t row = (size_t)gc * 64 + t;
        unsigned pk[8];
#pragma unroll
        for (int i = 0; i < 8; ++i) {
            const float r0 = bf2f(P[row * PW + PC_R + h * 128 + v0 + 2 * i]), r1 = bf2f(P[row * PW + PC_R + h * 128 + v0 + 2 * i + 1]);
            pk[i] = cvtpk(vals[2 * i] * rstd * p.gla_onorm[v0 + 2 * i] * silu_f(r0), vals[2 * i + 1] * rstd * p.gla_onorm[v0 + 2 * i + 1] * silu_f(r1));
        }
        bf16_t* M = (bf16_t*)(p.ws + WS_MIX) + row * 1024 + h * 128 + v0;
        *(u32x4*)M = (u32x4){pk[0], pk[1], pk[2], pk[3]}; *(u32x4*)(M + 8) = (u32x4){pk[4], pk[5], pk[6], pk[7]};
    }
    __syncthreads();
}


struct GlaPre { u32x4 qc, kc, vc[2], ac, sc[4]; float4 wac; float bac; };
__device__ __forceinline__ void gla_prefetch(PRef p, int gc, int h, GlaPre& g, u32x4 (&rc)[2]) {
    const int tid = threadIdx.x;
    const bf16_t* P = (const bf16_t*)(p.ws + WS_P);
    const bf16_t* rowp = P + (size_t)(gc * 64 + (tid >> 3)) * PW;
    g.qc = *(const u32x4*)(rowp + PC_Q + h * 64 + (tid & 7) * 8);
    g.kc = *(const u32x4*)(rowp + PC_K + h * 64 + (tid & 7) * 8);
#pragma unroll
    for (int i = 0; i < 2; ++i) { const int idx = tid + 512 * i; g.vc[i] = *(const u32x4*)(P + (size_t)(gc * 64 + (idx >> 4)) * PW + PC_V + h * 128 + (idx & 15) * 8); }
#pragma unroll
    for (int i = 0; i < 2; ++i) rc[i] = *(const u32x4*)(rowp + PC_R + h * 128 + (tid & 7) * 16 + 8 * i);
    g.ac = *(const u32x4*)(P + (size_t)(gc * 64 + ((tid & 255) >> 2)) * PW + PC_AF + (tid & 3) * 8);
    const bf16_t* S = (const bf16_t*)(p.ws + WS_SIN);
#pragma unroll
    for (int i = 0; i < 4; ++i) { const int cc = tid + 512 * i, dir = cc >> 10; g.sc[i] = *(const u32x4*)(S + ((size_t)(dir * NCH + gc) * 4 + h) * 8192 + (cc & 1023) * 8); }
    { const int dd = tid >> 8, jj = (tid >> 4) & 15, d4 = tid & 15; g.wac = *(const float4*)((dd == 0 ? p.gla_wa_f : p.gla_wa_b) + jj * 256 + h * 64 + d4 * 4); }
    g.bac = ((tid >> 6) & 1 ? p.gla_ba_b : p.gla_ba_f)[h * 64 + (tid & 63)];
}
template <int OFF> __device__ __forceinline__ s16x4 gla_tr(int vb) { s16x4 r; asm volatile("ds_read_b64_tr_b16 %0, %1 offset:%2" : "=&v"(r) : "v"(vb), "i"(OFF) : "memory"); return r; }
__device__ __forceinline__ void phase_gla_out(PRef p) {
    const int tid = threadIdx.x, lane = tid & 63, wave = tid >> 6, r32 = lane & 31, hi = lane >> 5, G = gridDim.x;
    bf16_t* qe = (bf16_t*)smem;
    bf16_t* ke = qe + 2 * 64 * 72;
    bf16_t* Am = ke + 2 * 64 * 72;
    bf16_t* Qraw = Am; bf16_t* Kraw = Am + 64 * 72;
    char* Vraw = smem + 55296;
    bf16_t* ST = (bf16_t*)(smem + 75776);
    float* af = (float*)(smem + 112640);
    float* wa = af + 2048;
    float* ba = wa + 2048;
    float* tot = ba + 128;
    float* ob = (float*)ke;
    int u = blockIdx.x;
    if (u >= NCH * 4) return;
    const int nt_t = tid >> 3, nt_v0 = (tid & 7) * 16;
    float on[16];
#pragma unroll
    for (int i = 0; i < 16; ++i) on[i] = p.gla_onorm[nt_v0 + i];
    GlaPre g; u32x4 rc[2], rcn[2];
    gla_prefetch(p, u >> 2, u & 3, g, rc);
    const int dir = wave & 1, tq = wave >> 1;
    for (; u < NCH * 4; u += G) {
        const int gc = u >> 2, h = u & 3;
        *(u32x4*)(Qraw + (tid >> 3) * 72 + (tid & 7) * 8) = g.qc;
        *(u32x4*)(Kraw + (tid >> 3) * 72 + (tid & 7) * 8) = g.kc;
#pragma unroll
        for (int i = 0; i < 2; ++i) { const int idx = tid + 512 * i; *(u32x4*)(Vraw + (idx >> 4) * 320 + (idx & 15) * 16) = g.vc[i]; }
#pragma unroll
        for (int i = 0; i < 4; ++i) { const int cc = tid + 512 * i; *(u32x4*)(ST + ((cc >> 10) * 128 + ((cc >> 3) & 127)) * 72 + (cc & 7) * 8) = g.sc[i]; }
        if (tid < 256) { const int t = tid >> 2, ch = tid & 3, dd = ch >> 1, j0 = (ch & 1) * 8; float* q = af + dd * 1024 + t * 16 + j0;
#pragma unroll
            for (int e = 0; e < 4; ++e) { q[2 * e] = __uint_as_float(g.ac[e] << 16); q[2 * e + 1] = __uint_as_float(g.ac[e] & 0xFFFF0000u); } }
        { const int dd = tid >> 8, jj = (tid >> 4) & 15, d4 = tid & 15; *(float4*)(wa + (dd * 16 + jj) * 64 + d4 * 4) = g.wac; }
        if (tid < 128) ba[tid] = g.bac;
        __syncthreads();
        const int un = u + G;
        if (un < NCH * 4) gla_prefetch(p, un >> 2, un & 3, g, rcn);
        float bb[16]; float total;
        {
            float w[16];
#pragma unroll
            for (int j = 0; j < 16; ++j) w[j] = wa[(dir * 16 + j) * 64 + lane];
            const float bias = ba[dir * 64 + lane];
#pragma unroll
            for (int i = 0; i < 16; ++i) {
                const int t = tq * 16 + i;
                float z = bias;
#pragma unroll
                for (int j = 0; j < 16; ++j) z += af[(dir * 64 + t) * 16 + j] * w[j];
                bb[i] = (fminf(z, 0.f) - __logf(1.f + __expf(-fabsf(z)))) * (1.f / 16.f);
            }
            if (dir == 0) {
#pragma unroll
                for (int i = 1; i < 16; ++i) bb[i] += bb[i - 1];
                tot[(dir * 4 + tq) * 64 + lane] = bb[15];
            } else {
#pragma unroll
                for (int i = 14; i >= 0; --i) bb[i] += bb[i + 1];
                tot[(dir * 4 + tq) * 64 + lane] = bb[0];
            }
        }
        __syncthreads();
        {
            float offs = 0.f; total = 0.f;
#pragma unroll
            for (int q = 0; q < 4; ++q) { const float tv = tot[(dir * 4 + q) * 64 + lane]; total += tv; if (dir == 0 ? (q < tq) : (q > tq)) offs += tv; }
#pragma unroll
            for (int i = 0; i < 16; ++i) bb[i] += offs;
        }
#pragma unroll
        for (int i = 0; i < 16; ++i) {
            const int t = tq * 16 + i;
            const float qv = bf2f(Qraw[t * 72 + lane]) * 0.125f, kv = bf2f(Kraw[t * 72 + lane]);
            qe[(dir * 64 + t) * 72 + lane] = f2bf(qv * __expf(bb[i]));
            ke[(dir * 64 + t) * 72 + lane] = f2bf(kv * __expf(-bb[i]));
        }
        __syncthreads();
        {
            const int mdir = wave >> 2, tb = (wave >> 1) & 1, sb = wave & 1;
            f32x16 acc = {};
#pragma unroll
            for (int ks = 0; ks < 4; ++ks) {
                const bf16x8 a = *(const bf16x8*)(qe + (mdir * 64 + tb * 32 + r32) * 72 + ks * 16 + hi * 8);
                const bf16x8 b = *(const bf16x8*)(ke + (mdir * 64 + sb * 32 + r32) * 72 + ks * 16 + hi * 8);
                acc = __builtin_amdgcn_mfma_f32_32x32x16_bf16(a, b, acc, 0, 0, 0);
            }
            const int sI = sb * 32 + r32;
#pragma unroll
            for (int r = 0; r < 16; ++r) { const int t = tb * 32 + crow(r, hi); const bool keep = (mdir == 0) ? (sI <= t) : (sI >= t); Am[(mdir * 64 + t) * 72 + sI] = f2bf(keep ? acc[r] : 0.f); }
        }
        __syncthreads();
        f32x16 o = {};
        const int tb = wave >> 2, vbk = wave & 3;
        {
            const int vb = (int)(uintptr_t)Vraw + (8 * hi + ((lane & 15) >> 2)) * 320 + (vbk * 32 + 16 * ((lane >> 4) & 1) + 4 * (lane & 3)) * 2;
#define GLA_PV(KS, DIRN) do { const s16x4 l_ = gla_tr<(KS) * 5120>(vb), h_ = gla_tr<(KS) * 5120 + 1280>(vb); \
            const bf16x8 a1 = *(const bf16x8*)(Am + ((DIRN) * 64 + tb * 32 + r32) * 72 + (KS) * 16 + hi * 8); \
            const bf16x8 a2 = *(const bf16x8*)(qe + ((DIRN) * 64 + tb * 32 + r32) * 72 + (KS) * 16 + hi * 8); \
            const bf16x8 b2 = *(const bf16x8*)(ST + ((DIRN) * 128 + vbk * 32 + r32) * 72 + (KS) * 16 + hi * 8); \
            asm volatile("s_waitcnt lgkmcnt(0)" ::: "memory"); SBAR(); \
            o = __builtin_amdgcn_mfma_f32_32x32x16_bf16(a1, (bf16x8){l_[0], l_[1], l_[2], l_[3], h_[0], h_[1], h_[2], h_[3]}, o, 0, 0, 0); \
            o = __builtin_amdgcn_mfma_f32_32x32x16_bf16(a2, b2, o, 0, 0, 0); } while (0)
            GLA_PV(0, 0); GLA_PV(1, 0); GLA_PV(2, 0); GLA_PV(3, 0); GLA_PV(0, 1); GLA_PV(1, 1); GLA_PV(2, 1); GLA_PV(3, 1);
#undef GLA_PV
        }
        __syncthreads();
#pragma unroll
        for (int r = 0; r < 16; ++r) ob[(tb * 32 + crow(r, hi)) * 132 + vbk * 32 + r32] = o[r];
        __syncthreads();
        {
            float vals[16]; float ss = 0.f;
#pragma unroll
            for (int i = 0; i < 4; ++i) { const f32x4 x = *(const f32x4*)(ob + nt_t * 132 + nt_v0 + 4 * i); vals[4 * i] = x[0]; vals[4 * i + 1] = x[1]; vals[4 * i + 2] = x[2]; vals[4 * i + 3] = x[3]; }
#pragma unroll
            for (int i = 0; i < 16; ++i) ss += vals[i] * vals[i];
            ss += __shfl_xor(ss, 1); ss += __shfl_xor(ss, 2); ss += __shfl_xor(ss, 4);
            const float rstd = rsqrtf(ss * (1.f / 128.f) + EPSN);
            unsigned pk[8];
#pragma unroll
            for (int i = 0; i < 8; ++i) {
                const unsigned w = rc[i >> 2][i & 3];
                const float r0 = __uint_as_float(w << 16), r1 = __uint_as_float(w & 0xFFFF0000u);
                const float s0 = r0 * __builtin_amdgcn_rcpf(1.f + __expf(-r0)), s1 = r1 * __builtin_amdgcn_rcpf(1.f + __expf(-r1));
                pk[i] = cvtpk(vals[2 * i] * rstd * on[2 * i] * s0, vals[2 * i + 1] * rstd * on[2 * i + 1] * s1);
            }
            bf16_t* M = (bf16_t*)(p.ws + WS_MIX) + ((size_t)gc * 64 + nt_t) * 1024 + h * 128 + nt_v0;
            *(u32x4*)M = (u32x4){pk[0], pk[1], pk[2], pk[3]}; *(u32x4*)(M + 8) = (u32x4){pk[4], pk[5], pk[6], pk[7]};
        }
        rc[0] = rcn[0]; rc[1] = rcn[1];
        __syncthreads();
    }
}

namespace mla8 {
typedef int i32x8 __attribute__((ext_vector_type(8)));
constexpr int KVBLK = 64;
constexpr float SCALE = 0.07216878364870322f;
constexpr float THR = 3.f;
constexpr float PBIAS = 4.f;
constexpr int KROW = 208, VROW = 80;
constexpr int SHM_K = KVBLK * KROW, SHM_V = 128 * VROW;
constexpr int ONE = 0x7F7F7F7F, QSC = 0x7C7C7C7C;
__device__ __forceinline__ i32x8 ld32(const char* a) { const i32x4 lo = *(const i32x4*)a, hi_ = *(const i32x4*)(a + 16); return __builtin_shufflevector(lo, hi_, 0, 1, 2, 3, 4, 5, 6, 7); }
__device__ __forceinline__ void qkt(f32x16& p0, f32x16& p1, const char* Kw, const i32x8 (&q)[3]) {
    p0 = f32x16{}; p1 = f32x16{};
#pragma unroll
    for (int s_ = 0; s_ < 3; ++s_) {
        const i32x8 a0 = ld32(Kw + s_ * 64), a1 = ld32(Kw + 32 * KROW + s_ * 64);
        p0 = __builtin_amdgcn_mfma_scale_f32_32x32x64_f8f6f4(a0, q[s_], p0, 0, 0, 0, ONE, 0, QSC);
        p1 = __builtin_amdgcn_mfma_scale_f32_32x32x64_f8f6f4(a1, q[s_], p1, 0, 0, 0, ONE, 0, QSC);
    }
}
typedef float f32x2 __attribute__((ext_vector_type(2)));
#define M8_PAIR(P, i) ((f32x2){P[2 * (i)], P[2 * (i) + 1]})
#define M8_EXP(P, i) P[i] = __builtin_amdgcn_exp2f(P[i])
__device__ __forceinline__ float fma1(float a, float b, float c) { float d; asm("v_fma_f32 %0, %1, %2, %3" : "=v"(d) : "v"(a), "v"(b), "v"(c)); return d; }
__device__ __forceinline__ float mul1(float a, float b) { float d; asm("v_mul_f32 %0, %1, %2" : "=v"(d) : "v"(a), "v"(b)); return d; }
__device__ __forceinline__ float add1(float a, float b) { float d; asm("v_add_f32 %0, %1, %2" : "=v"(d) : "v"(a), "v"(b)); return d; }
#define M8_MFMA(A, B, C) __builtin_amdgcn_mfma_scale_f32_32x32x64_f8f6f4(A, B, C, 0, 0, 0, ONE, 0, ONE)
#define M8_MFMAQ(A, B, C) __builtin_amdgcn_mfma_scale_f32_32x32x64_f8f6f4(A, B, C, 0, 0, 0, ONE, 0, QSC)
constexpr int NEXP_B = 8;
#define M8_F1(P0, P1) do { M8_EXP(P0, 8); M8_EXP(P0, 9); M8_EXP(P0, 10); M8_EXP(P0, 11); M8_EXP(P0, 12); M8_EXP(P0, 13); } while (0)
#define M8_F2(P0, P1) do { M8_EXP(P0, 14); M8_EXP(P0, 15); M8_EXP(P1, 0); M8_EXP(P1, 1); M8_EXP(P1, 2); M8_EXP(P1, 3); } while (0)
#define M8_F3(P0, P1) do { M8_EXP(P1, 4); M8_EXP(P1, 5); M8_EXP(P1, 6); M8_EXP(P1, 7); M8_EXP(P1, 8); M8_EXP(P1, 9); } while (0)
#define M8_F4(P0, P1) do { M8_EXP(P1, 10); M8_EXP(P1, 11); M8_EXP(P1, 12); M8_EXP(P1, 13); M8_EXP(P1, 14); M8_EXP(P1, 15); } while (0)
#define M8_F5(P0, P1) do { float t0_ = add1(P0[0], P0[1]), t1_ = add1(P0[2], P0[3]), t2_ = add1(P0[4], P0[5]), t3_ = add1(P0[6], P0[7]); \
    _Pragma("unroll") for (int i_ = 8; i_ < 16; i_ += 4) { t0_ = add1(t0_, P0[i_]); t1_ = add1(t1_, P0[i_ + 1]); t2_ = add1(t2_, P0[i_ + 2]); t3_ = add1(t3_, P0[i_ + 3]); } \
    _Pragma("unroll") for (int i_ = 0; i_ < 16; i_ += 4) { t0_ = add1(t0_, P1[i_]); t1_ = add1(t1_, P1[i_ + 1]); t2_ = add1(t2_, P1[i_ + 2]); t3_ = add1(t3_, P1[i_ + 3]); } \
    psum = add1(add1(t0_, t1_), add1(t2_, t3_)); \
    _Pragma("unroll") for (int w_ = 0; w_ < 4; ++w_) { int a_ = __builtin_amdgcn_cvt_pk_fp8_f32(P0[4 * w_], P0[4 * w_ + 1], 0, false); P8[w_] = __builtin_amdgcn_cvt_pk_fp8_f32(P0[4 * w_ + 2], P0[4 * w_ + 3], a_, true); } } while (0)
#define M8_F6A(P0, P1) do { _Pragma("unroll") for (int w_ = 0; w_ < 4; ++w_) { int b_ = __builtin_amdgcn_cvt_pk_fp8_f32(P1[4 * w_], P1[4 * w_ + 1], 0, false); P8[4 + w_] = __builtin_amdgcn_cvt_pk_fp8_f32(P1[4 * w_ + 2], P1[4 * w_ + 3], b_, true); } } while (0)
#define M8_F6B(AL) do { { auto rr_ = __builtin_amdgcn_permlane32_swap(__float_as_uint(psum), __float_as_uint(psum), false, false); psum = __uint_as_float(rr_[0]) + __uint_as_float(rr_[1]); } \
    l_reg = fmaf(l_reg, AL, psum); } while (0)
#define M8_F6(P0, P1, AL) do { M8_F6A(P0, P1); M8_F6B(AL); } while (0)
#define M8_P1(P0, P1) do { float x_ = fmaxf(P0[0], P0[1]); _Pragma("unroll") for (int r_ = 2; r_ < 16; r_ += 2) x_ = fmaxf(fmaxf(x_, P0[r_]), P0[r_ + 1]); \
    _Pragma("unroll") for (int r_ = 0; r_ < 16; r_ += 2) x_ = fmaxf(fmaxf(x_, P1[r_]), P1[r_ + 1]); \
    { auto rr_ = __builtin_amdgcn_permlane32_swap(__float_as_uint(x_), __float_as_uint(x_), false, false); pmax = fmaxf(__uint_as_float(rr_[0]), __uint_as_float(rr_[1])); } } while (0)
#define M8_P2(P0, P1, AL) do { AL = 1.f; if (!__all(pmax <= PBIAS + THR * LOG2E)) { const float d_ = fmaxf(pmax - PBIAS, 0.f); AL = __builtin_amdgcn_exp2f(-d_); \
    _Pragma("unroll") for (int i_ = 0; i_ < 16; ++i_) { P0[i_] -= d_; P1[i_] -= d_; minit[i_] -= d_; } } } while (0)
#define M8_P3(P0, P1) do { M8_EXP(P0, 0); M8_EXP(P0, 1); M8_EXP(P0, 2); M8_EXP(P0, 3); } while (0)
#define M8_P4(P0, P1) do { M8_EXP(P0, 4); M8_EXP(P0, 5); M8_EXP(P0, 6); M8_EXP(P0, 7); } while (0)
__device__ __forceinline__ void attn_body2(const unsigned char* __restrict__ Q8w, const unsigned char* __restrict__ K8h, const unsigned char* __restrict__ V8h, bf16_t* __restrict__ Ob, int seq) {
    char* lds = smem;
    const int tid = tid_opaque(), wid = tid >> 6, lane = tid & 63, r32 = lane & 31, hi = lane >> 5;
    constexpr int BUF = SHM_K + SHM_V;
    float l_reg = 0; f32x16 o[4] = {}; f32x16 minit;
    i32x8 q[3];
    { const unsigned char* qp = Q8w + (size_t)(wid * 32 + r32) * 768 + hi * 32;
#pragma unroll
      for (int s_ = 0; s_ < 3; ++s_) { const i32x4 lo = *(const i32x4*)(qp + s_ * 64), hi_ = *(const i32x4*)(qp + s_ * 64 + 16); q[s_] = __builtin_shufflevector(lo, hi_, 0, 1, 2, 3, 4, 5, 6, 7); } }
    const int kc0 = tid, kc1 = 512 + (tid & 255);
    const int kso0 = (kc0 / 12) * KROW + (kc0 % 12) * 16, kso1 = (kc1 / 12) * KROW + (kc1 % 12) * 16, vso = SHM_K + (tid >> 2) * VROW + (tid & 3) * 16;
    const bool two = tid < 256;
    const char* Kw = lds + r32 * KROW + hi * 32; const char* Vw = lds + SHM_K + r32 * VROW + hi * 32;
    struct { u32x4 k0, k1, v; } st_;
#define SLOAD(t_) do { const unsigned char* kt_ = K8h + (size_t)(t_) * (KVBLK * 192); st_.k0 = *(const u32x4*)(kt_ + kc0 * 16); if (two) st_.k1 = *(const u32x4*)(kt_ + kc1 * 16); \
    st_.v = *(const u32x4*)(V8h + (size_t)(t_) * 8192 + tid * 16); } while (0)
#define SWRITE(bo) do { *(u32x4*)(lds + (bo) + kso0) = st_.k0; if (two) *(u32x4*)(lds + (bo) + kso1) = st_.k1; *(u32x4*)(lds + (bo) + vso) = st_.v; } while (0)
#define RESC(a) do { if (__any((a) < 1.f)) { asm volatile("s_nop 15\n\ts_nop 15\n\ts_nop 15\n\ts_nop 15\n\ts_nop 15\n\ts_nop 15" ::: "memory");     \
    _Pragma("unroll") for (int d = 0; d < 4; ++d) _Pragma("unroll") for (int r = 0; r < 16; ++r) o[d][r] = mul1(o[d][r], (a)); } } while (0)
    f32x16 pA0, pA1, pB0, pB1; float alA = 1.f, alB = 1.f, pmax, psum; i32x8 P8;
    const int NT = seq / KVBLK;
#define TIE3(a, b, c) asm volatile("" : "+v"(a), "+v"(b), "+v"(c))
#define TIE4(a, b, c, d) asm volatile("" : "+v"(a), "+v"(b), "+v"(c), "+v"(d))
#define TIE5(a, b, c, d, e) asm volatile("" : "+v"(a), "+v"(b), "+v"(c), "+v"(d), "+v"(e))
#define TIE6(a, b, c, d, e, f) asm volatile("" : "+v"(a), "+v"(b), "+v"(c), "+v"(d), "+v"(e), "+v"(f))
#define M8_STEP(PC0, PC1, ALC, PN0, PN1, ALN, kb, vb, DO_QK) do { \
    i32x8 k00, k10, k01, k11, k02, k12, v0, v1, v2, v3; \
    int ko_ = (kb), vo_ = (vb);        \
    if (DO_QK) { k00 = ld32(Kw + ko_); k10 = ld32(Kw + ko_ + 32 * KROW); k01 = ld32(Kw + ko_ + 64); \
        PN0 = M8_MFMAQ(k00, q[0], minit); TIE4(PN0, PC0, PC1, ko_); } \
    M8_F1(PC0, PC1); \
    if (DO_QK) { k11 = ld32(Kw + ko_ + 32 * KROW + 64); TIE3(PC0, PC1, k10); PN1 = M8_MFMAQ(k10, q[0], minit); TIE4(PN1, PC0, PC1, ko_); } \
    M8_F2(PC0, PC1); \
    if (DO_QK) { k02 = ld32(Kw + ko_ + 128); TIE3(PC0, PC1, k01); PN0 = M8_MFMAQ(k01, q[1], PN0); TIE4(PN0, PC0, PC1, ko_); } \
    M8_F3(PC0, PC1); \
    if (DO_QK) { k12 = ld32(Kw + ko_ + 32 * KROW + 128); TIE3(PC0, PC1, k11); PN1 = M8_MFMAQ(k11, q[1], PN1); TIE4(PN1, PC0, PC1, vo_); } \
    M8_F4(PC0, PC1); \
    v0 = ld32(Vw + vo_); \
    if (DO_QK) { TIE3(PC0, PC1, k02); PN0 = M8_MFMAQ(k02, q[2], PN0); TIE4(PN0, PC0, PC1, vo_); } \
    M8_F5(PC0, PC1); \
    v1 = ld32(Vw + vo_ + 32 * VROW); \
    if (DO_QK) { TIE5(PC0, PC1, P8, psum, k12); PN1 = M8_MFMAQ(k12, q[2], PN1); TIE6(PN1, PC0, PC1, P8, psum, vo_); } \
    M8_F6A(PC0, PC1); \
    v2 = ld32(Vw + vo_ + 64 * VROW); \
    TIE3(P8, psum, v0); o[0] = M8_MFMA(v0, P8, o[0]); \
    TIE3(o[0], psum, vo_); M8_F6B(ALC); v3 = ld32(Vw + vo_ + 96 * VROW); TIE3(l_reg, psum, v1); \
    o[1] = M8_MFMA(v1, P8, o[1]); \
      \
    if (DO_QK) { TIE4(o[1], PN0, PN1, vo_); M8_P1(PN0, PN1); TIE4(PN0, PN1, pmax, v2); } \
    o[2] = M8_MFMA(v2, P8, o[2]); \
    if (DO_QK) { TIE4(o[2], PN0, PN1, pmax); M8_P2(PN0, PN1, ALN); M8_P3(PN0, PN1); TIE5(PN0, PN1, minit, ALN, v3); } \
    o[3] = M8_MFMA(v3, P8, o[3]); \
    if (DO_QK) { TIE3(o[3], PN0, PN1); M8_P4(PN0, PN1); TIE3(PN0, PN1, ALN); RESC(ALN); } } while (0)
    SLOAD(0); SWRITE(0); SLOAD(1); SWRITE(BUF); __syncthreads();
    SLOAD(2);
    qkt(pA0, pA1, Kw, q);
    M8_P1(pA0, pA1);
    { const float mc_ = PBIAS - pmax;
#pragma unroll
      for (int i_ = 0; i_ < 16; ++i_) { pA0[i_] += mc_; pA1[i_] += mc_; minit[i_] = mc_; } }
    M8_P3(pA0, pA1); M8_P4(pA0, pA1);
    int b0 = 0, b1 = BUF, b2 = 2 * BUF;
    for (int j = 0; j + 2 < NT; j += 2) {
        __syncthreads(); SWRITE(b2); if (j + 3 < NT) SLOAD(j + 3);
        M8_STEP(pA0, pA1, alA, pB0, pB1, alB, b1, b0, true);
        __syncthreads(); SWRITE(b0); if (j + 4 < NT) SLOAD(j + 4);
        M8_STEP(pB0, pB1, alB, pA0, pA1, alA, b2, b1, true);
        { const int t_ = b0; b0 = b2; b2 = b1; b1 = t_; }
    }
    __syncthreads();
    M8_STEP(pA0, pA1, alA, pB0, pB1, alB, b1, b0, true);
    M8_STEP(pB0, pB1, alB, pA0, pA1, alA, 0, b1, false);
    const float rl = __builtin_amdgcn_rcpf(l_reg);
    bf16_t* Ow = Ob + (size_t)(wid * 32 + r32) * 1024 + 4 * hi;
#pragma unroll
    for (int d0 = 0; d0 < 4; ++d0)
#pragma unroll
        for (int g = 0; g < 4; ++g)
            *(u32x2*)(Ow + d0 * 32 + 8 * g) = (u32x2){cvtpk(o[d0][4 * g] * rl, o[d0][4 * g + 1] * rl), cvtpk(o[d0][4 * g + 2] * rl, o[d0][4 * g + 3] * rl)};
    __syncthreads();
#undef SLOAD
#undef SWRITE
#undef RESC
#undef M8_STEP
}
}

__device__ __forceinline__ void phase_mix0(PRef p) {
    const int G = gridDim.x;
    phase_gla_out(p);
    __syncthreads();
    const unsigned char* Q8 = (const unsigned char*)(p.ws + WS_Q8); const unsigned char* K8 = (const unsigned char*)(p.ws + WS_K8); const unsigned char* VT8 = (const unsigned char*)(p.ws + WS_VT8);
    bf16_t* MIX = (bf16_t*)(p.ws + WS_MIX);
    for (int u = blockIdx.x; u < 260; u += G) {
        const bool lat = u < 256;
        const int h = lat ? (u & 3) : (u - 256);
        const size_t q0 = lat ? (size_t)CTXN + (size_t)(u >> 2) * 256 : 0;
        mla8::attn_body2(Q8 + q0 * 768 + h * 192, K8 + (size_t)h * NTOK * 192, VT8 + (size_t)h * NCH * 8192, MIX + q0 * 1024 + 512 + h * 128, lat ? NTOK : CTXN);
    }
}

#define PK4(P, BASE, OUT) do { unsigned a0 = cvtpk(P[BASE + 0], P[BASE + 1]), a1 = cvtpk(P[BASE + 2], P[BASE + 3]);   \
    unsigned b0 = cvtpk(P[BASE + 4], P[BASE + 5]), b1 = cvtpk(P[BASE + 6], P[BASE + 7]);                              \
    auto r0 = __builtin_amdgcn_permlane32_swap(a0, b0, false, false); auto r1 = __builtin_amdgcn_permlane32_swap(a1, b1, false, false); \
    u32x4 w = {r0[0], r1[0], r0[1], r1[1]}; OUT = *reinterpret_cast<bf16x8*>(&w); } while (0)
template <int OFF> __device__ __forceinline__ s16x4 na_tr(int vb) { s16x4 r; asm volatile("ds_read_b64_tr_b16 %0, %1 offset:%2" : "=&v"(r) : "v"(vb), "i"(OFF) : "memory"); return r; }
template <int KS> __device__ __forceinline__ void na_pv(f32x16& o0, f32x16& o1, int vb, bf16x8 pa) {
    const s16x4 a0 = na_tr<KS * 5120>(vb), a1 = na_tr<KS * 5120 + 1280>(vb), b0 = na_tr<KS * 5120 + 64>(vb), b1 = na_tr<KS * 5120 + 1280 + 64>(vb);
    asm volatile("s_waitcnt lgkmcnt(0)" ::: "memory"); SBAR();
    o0 = __builtin_amdgcn_mfma_f32_32x32x16_bf16(pa, (bf16x8){a0[0], a0[1], a0[2], a0[3], a1[0], a1[1], a1[2], a1[3]}, o0, 0, 0, 0);
    o1 = __builtin_amdgcn_mfma_f32_32x32x16_bf16(pa, (bf16x8){b0[0], b0[1], b0[2], b0[3], b1[0], b1[1], b1[2], b1[3]}, o1, 0, 0, 0);
}
template <int MODE> __device__ __forceinline__ void na_softmax(f32x16& p0, f32x16& p1, float& m_reg, float& l_reg, float& alpha, const float* brow, int c0, int hi) {
    constexpr float C = 0.125f * LOG2E;
#define NA_L0(q) (MODE != 2 || (q) >= 12)
#define NA_L1(q) (MODE != 1 || (q) < 4)
    if (MODE == 0) {
#pragma unroll
        for (int q = 0; q < 16; ++q) { p0[q] *= C; p1[q] *= C; }
    } else {
        float bv0[16], bv1[16];
#pragma unroll
        for (int q = 0; q < 16; ++q) { const int kc0 = crow(q, hi); if (NA_L0(q)) bv0[q] = brow[kc0]; if (NA_L1(q)) bv1[q] = brow[32 + kc0]; }
#pragma unroll
        for (int q = 0; q < 16; ++q) { if (NA_L0(q)) asm volatile("" : "+v"(bv0[q])); if (NA_L1(q)) asm volatile("" : "+v"(bv1[q])); }
#pragma unroll
        for (int q = 0; q < 16; ++q) {
            const int kc0 = crow(q, hi), kc1 = 32 + kc0;
            if (NA_L0(q)) { const float t = fmaf(p0[q], C, bv0[q]); p0[q] = ((unsigned)(kc0 - c0) < 16u) ? t : -1e30f; }
            if (NA_L1(q)) { const float t = fmaf(p1[q], C, bv1[q]); p1[q] = ((unsigned)(kc1 - c0) < 16u) ? t : -1e30f; }
        }
    }
    float pmax = -1e30f;
#pragma unroll
    for (int q = 0; q < 16; ++q) { if (NA_L0(q)) pmax = fmaxf(pmax, p0[q]); if (NA_L1(q)) pmax = fmaxf(pmax, p1[q]); }
    { auto rr = __builtin_amdgcn_permlane32_swap(__float_as_uint(pmax), __float_as_uint(pmax), false, false);
      pmax = fmaxf(__uint_as_float(rr[0]), __uint_as_float(rr[1])); }
    const float mn = fmaxf(m_reg, pmax);
    alpha = __builtin_amdgcn_exp2f(m_reg - mn);
    m_reg = mn;
    float ps = 0.f;
#pragma unroll
    for (int q = 0; q < 16; ++q) {
        if (NA_L0(q)) { p0[q] = __builtin_amdgcn_exp2f(p0[q] - mn); ps += p0[q]; } else p0[q] = 0.f;
        if (NA_L1(q)) { p1[q] = __builtin_amdgcn_exp2f(p1[q] - mn); ps += p1[q]; } else p1[q] = 0.f;
    }
    { auto rr = __builtin_amdgcn_permlane32_swap(__float_as_uint(ps), __float_as_uint(ps), false, false);
      ps = __uint_as_float(rr[0]) + __uint_as_float(rr[1]); }
    l_reg = l_reg * alpha + ps;
#undef NA_L0
#undef NA_L1
}
__device__ __forceinline__ void phase_na(PRef p) {
    const int tid = threadIdx.x, lane = tid & 63, wave = tid >> 6, r32 = lane & 31, hi = lane >> 5, G = gridDim.x;
    const bf16_t* QKV = (const bf16_t*)(p.ws + WS_P);
    bf16_t* MIX = (bf16_t*)(p.ws + WS_MIX);
    constexpr int KB = 64 * 72 * 2, VB = 64 * 160 * 2;
    char* Kl = smem;
    char* Vl = smem + 2 * KB;
    float* xch = (float*)(smem + 2 * KB + 2 * VB) + wave * 64;
    float* rpbL = (float*)(smem + 2 * KB + 2 * VB + 8 * 64 * 4);
    constexpr float C = 0.125f * LOG2E;
    const int skey = tid >> 3, sch = tid & 7;
    const int vb0 = (int)(uintptr_t)Vl + (8 * hi + ((lane & 15) >> 2)) * 320 + (16 * ((lane >> 4) & 1) + 4 * (lane & 3)) * 2;
    for (int u = blockIdx.x; u < 64 * 16; u += G) {
        const int rg = u >> 4, h = u & 15;
        const int r = rg * 4 + (wave >> 1), qb = wave & 1;
        const int r0w = min(max(r - 4, 0), 248);
        const int kr_lo = min(max(rg * 4 - 4, 0), 248), kr_hi = min(max(rg * 4 + 3 - 4, 0), 248) + 7, nwin = kr_hi - kr_lo + 1, ntile = nwin + 4;
        for (int i = tid; i < 15 * 31; i += NTH) rpbL[i] = p.na_rpb[(size_t)h * 15 * 31 + i] * LOG2E;
        const int c = qb * 32 + r32, c0 = min(max(c - 8, 0), 48);
        const size_t qrow = (size_t)CTXN + (size_t)r * 64 + c;
        bf16x8 qr[4];
#pragma unroll
        for (int ks = 0; ks < 4; ++ks) qr[ks] = *(const bf16x8*)(QKV + qrow * 3072 + h * 64 + ks * 16 + hi * 8);
        float m_reg = -1e30f, l_reg = 0.f; f32x16 o0 = {}, o1 = {};
        u32x4 skA, svA, skB, svB;
#define NA_LOAD(ti_, SK, SV) do { const size_t key0_ = ((ti_) >= nwin) ? (size_t)((ti_) - nwin) * 64 : (size_t)CTXN + (size_t)(kr_lo + (ti_)) * 64; \
            const bf16_t* src_ = QKV + (key0_ + skey) * 3072 + h * 64 + sch * 8; SK = *(const u32x4*)(src_ + 1024); SV = *(const u32x4*)(src_ + 2048); } while (0)
#define NA_WRITE(b_, SK, SV) do { *(u32x4*)(Kl + (b_) * KB + skey * 144 + sch * 16) = SK; *(u32x4*)(Vl + (b_) * VB + skey * 320 + sch * 16) = SV; } while (0)
        NA_LOAD(0, skA, svA); NA_WRITE(0, skA, svA);
        NA_LOAD(1, skA, svA);
        __syncthreads();
        for (int ti = 0; ti < ntile; ++ti) {
            const int b = ti & 1;
            if (ti + 2 < ntile) { if (b == 0) NA_LOAD(ti + 2, skB, svB); else NA_LOAD(ti + 2, skA, svA); }
            const bool isctx = ti >= nwin;
            const int kr = kr_lo + ti;
            const bool need = isctx || (kr >= r0w && kr <= r0w + 7);
            if (need) {
                const bf16_t* Ks = (const bf16_t*)(Kl + b * KB);
                f32x16 p0 = {}, p1 = {};
#pragma unroll
                for (int ks = 0; ks < 4; ++ks) {
                    const bf16x8 a0 = *(const bf16x8*)(Ks + r32 * 72 + ks * 16 + hi * 8), a1 = *(const bf16x8*)(Ks + (32 + r32) * 72 + ks * 16 + hi * 8);
                    p0 = __builtin_amdgcn_mfma_f32_32x32x16_bf16(a0, qr[ks], p0, 0, 0, 0);
                    p1 = __builtin_amdgcn_mfma_f32_32x32x16_bf16(a1, qr[ks], p1, 0, 0, 0);
                }
                float alpha;
                const float* brow = rpbL + (kr - r + 7) * 31 + 15 - c;
                if (isctx) na_softmax<0>(p0, p1, m_reg, l_reg, alpha, brow, c0, hi);
                else if (qb == 0) na_softmax<1>(p0, p1, m_reg, l_reg, alpha, brow, c0, hi);
                else na_softmax<2>(p0, p1, m_reg, l_reg, alpha, brow, c0, hi);
                bf16x8 pa0, pa1, pa2, pa3;
                PK4(p0, 0, pa0); PK4(p0, 8, pa1); PK4(p1, 0, pa2); PK4(p1, 8, pa3);
                if (__any(alpha < 1.f)) {
                    if (hi == 0) xch[r32] = alpha;
                    asm volatile("s_waitcnt lgkmcnt(0)" ::: "memory");
#pragma unroll
                    for (int q = 0; q < 16; ++q) { const float a = xch[crow(q, hi)]; o0[q] *= a; o1[q] *= a; }
                }
                const int vb = vb0 + b * VB;
                na_pv<0>(o0, o1, vb, pa0); na_pv<1>(o0, o1, vb, pa1); na_pv<2>(o0, o1, vb, pa2); na_pv<3>(o0, o1, vb, pa3);
            }
            if (ti + 1 < ntile) { if (b == 0) NA_WRITE(1, skA, svA); else NA_WRITE(0, skB, svB); }
            __syncthreads();
        }
#undef NA_LOAD
#undef NA_WRITE
        if (hi == 0) xch[32 + r32] = l_reg;
        asm volatile("s_waitcnt lgkmcnt(0)" ::: "memory");
        const size_t orow0 = (size_t)CTXN + (size_t)r * 64 + qb * 32;
#pragma unroll
        for (int q = 0; q < 16; ++q) {
            const int qi = crow(q, hi); const float il = __builtin_amdgcn_rcpf(xch[32 + qi]);
            bf16_t* dst = MIX + (orow0 + qi) * 1024 + h * 64;
            dst[r32] = f2bf(o0[q] * il); dst[32 + r32] = f2bf(o1[q] * il);
        }
        __syncthreads();
    }
}
#undef PK4

#define XB_TMO      128
#define XB_XCNT(j)  (256  + 64 * (j))
#define XB_XSUB(j)  (1280 + 64 * (j))
#define XB_XGEN(j)  (2304 + 64 * (j))
#define XB_TOP      3328
#define XB_TOPGEN   3392
#define XCD_BAR_WORDS 3456
#define XB_SPIN_CAP (1u << 22)
#define LAS __attribute__((address_space(3)))
__device__ __forceinline__ unsigned xb_ld(unsigned* p)              { return __hip_atomic_load(p, __ATOMIC_RELAXED, __HIP_MEMORY_SCOPE_AGENT); }
__device__ __forceinline__ unsigned xb_add(unsigned* p, unsigned v) { return __hip_atomic_fetch_add(p, v, __ATOMIC_RELAXED, __HIP_MEMORY_SCOPE_AGENT); }
__device__ __forceinline__ unsigned xb_xcc_id() { return (unsigned)__builtin_amdgcn_s_getreg((3 << 11) | 20) & 0xFu; }
#define XB_SPIN(cond, bar) do { unsigned _sp = 0; while (cond) { __builtin_amdgcn_s_sleep(1); \
    if ((++_sp & 255u) == 0u) { if (xb_ld(&(bar)[XB_TMO])) break; if (_sp > XB_SPIN_CAP) { atomicAdd(&(bar)[XB_TMO], 1u); break; } } } } while (0)
struct XcdBarrier { unsigned* bar; unsigned x; volatile LAS unsigned* st; };
__device__ __forceinline__ XcdBarrier xcd_barrier_post(unsigned* bar, volatile LAS unsigned* st) {
    XcdBarrier b; b.bar = bar; b.x = xb_xcc_id(); b.st = st;
    if (threadIdx.x == 0) (void)xb_add(&bar[XB_XCNT(b.x)], 1u);
    return b;
}
__device__ __forceinline__ void xcd_barrier_complete(unsigned* bar, unsigned x, unsigned& nloc, unsigned& nx) {
    const unsigned G = gridDim.x * gridDim.y * gridDim.z;
    unsigned sum, cnt, mine, sp = 0u;
    for (;;) {
        sum = 0u; cnt = 0u; mine = 0u;
#pragma unroll
        for (unsigned j = 0; j < 16; ++j) { const unsigned c = xb_ld(&bar[XB_XCNT(j)]); sum += c; cnt += (c > 0u) ? 1u : 0u; mine = (j == x) ? c : mine; }
        if (sum == G) break;
        __builtin_amdgcn_s_sleep(1);
        if ((++sp & 255u) == 0u) { if (xb_ld(&bar[XB_TMO])) break; if (sp > XB_SPIN_CAP) { atomicAdd(&bar[XB_TMO], 1u); break; } }
    }
    nloc = mine > 0u ? mine : 1u; nx = cnt > 0u ? cnt : 1u;
}
__device__ __forceinline__ void xcd_barrier(const XcdBarrier& b) {
    asm volatile("s_waitcnt vmcnt(0)" ::: "memory");
    __syncthreads();
    if (threadIdx.x == 0) {
        unsigned* bar = b.bar;
        __builtin_amdgcn_s_waitcnt(0);
        unsigned nloc = b.st[0], nx = b.st[1];
        if (nloc == 0u) { xcd_barrier_complete(bar, b.x, nloc, nx); b.st[0] = nloc; b.st[1] = nx; }
        const unsigned old = xb_add(&bar[XB_XSUB(b.x)], 1u);
        const unsigned gen = old / nloc;
        if (old + 1u == (gen + 1u) * nloc) {
            __builtin_amdgcn_fence(__ATOMIC_RELEASE, "agent");
            asm volatile("s_waitcnt vmcnt(0)" ::: "memory");
            const unsigned og = xb_add(&bar[XB_TOP], 1u);
            const unsigned tg = og / nx;
            if (og + 1u == (tg + 1u) * nx) xb_add(&bar[XB_TOPGEN], 1u);
            else XB_SPIN(xb_ld(&bar[XB_TOPGEN]) == tg, bar);
            __builtin_amdgcn_fence(__ATOMIC_ACQUIRE, "agent");
            xb_add(&bar[XB_XGEN(b.x)], 1u);
            asm volatile("s_waitcnt vmcnt(0)" ::: "memory");
        } else {
            XB_SPIN(xb_ld(&bar[XB_XGEN(b.x)]) == gen, bar);
            __builtin_amdgcn_fence(__ATOMIC_ACQUIRE, "agent");
            asm volatile("s_waitcnt vmcnt(0)" ::: "memory");
        }
    }
    __syncthreads();
}

__device__ __forceinline__ void run_phase(PRef p, int ph) {
#ifdef ONLY_PHASE
    if (ph != ONLY_PHASE) return;
    ph = ONLY_PHASE;
#endif
    const bf16_t* HB = (const bf16_t*)(p.ws + WS_HB);
    switch (ph) {
    case 0: phase_prologue(p); break;
    case 1: phase_norm1_l0(p); break;
    case 2: phase_gemm_pg8(HB, 1024, (const bf16_t*)(p.ws + WS_WIN), 1024, (bf16_t*)(p.ws + WS_P), PW, NTOK / 256, 8); break;
    case 3: phase_mla_up(p); break;
    case 4: break;
    case 5: phase_gla_scan(p); break;
    case 6: phase_mix0(p); break;
    case 7: phase_gemm_pg8((const bf16_t*)(p.ws + WS_MIX), 1024, (const bf16_t*)(p.ws + WS_WOUT0), 1024, (bf16_t*)(p.ws + WS_OB), 1024, NTOK / 256, 4); break;
    case 8: phase_mid(p, 0); break;
    case 9: phase_moe1(p, 0); break;
    case 10: phase_moe2(p, 0); break;
    case 11: phase_end(p, 0); break;
    case 12: phase_gemm_pg8(HB, 1024, (const bf16_t*)(p.ws + WS_WQKV), 1024, (bf16_t*)(p.ws + WS_P), 3072, NTOK / 256, 12); break;
    case 13: phase_na(p); break;
    case 14: phase_gemm_pg8((const bf16_t*)(p.ws + WS_MIX) + (size_t)CTXN * 1024, 1024, (const bf16_t*)(p.ws + WS_WNAO), 1024, (bf16_t*)(p.ws + WS_OB) + (size_t)CTXN * 1024, 1024, SEQ / 256, 4); break;
    case 15: phase_mid(p, 1); break;
    case 16: phase_moe1(p, 1); break;
    case 17: phase_moe2(p, 1); break;
    case 18: phase_end(p, 1); break;
    default: break;
    }
}
constexpr int N_PHASES = 19;

#if MK_LAUNCHES == 1
__global__ void __launch_bounds__(512) mega_kernel(Params p) {
    cg::grid_group grid = cg::this_grid();
    volatile LAS unsigned* xst = (volatile LAS unsigned*)(smem + LDS_BYTES - 16);
    if (threadIdx.x == 0) { xst[0] = 0u; xst[1] = 0u; xst[2] = 0u; xst[3] = 0u; }
    __syncthreads();
    XcdBarrier xb = xcd_barrier_post((unsigned*)(kparams()->ws + WS_BAR), xst);
    run_phase(*kparams(), 0); xcd_barrier(xb);
    if (kparams()->pad0 == 0x7fffffff) grid.sync();
    if (PROBE_REPEAT == 100) { run_phase(*kparams(), 0); xcd_barrier(xb); }
    if (PROBE_REPEAT == 61) { phase_gla_out(*kparams()); xcd_barrier(xb); }
#define PH_(n) run_phase(*kparams(), n); xcd_barrier(xb); if ((n) == PROBE_REPEAT) { run_phase(*kparams(), n); xcd_barrier(xb); }
    PH_(1) PH_(2) PH_(3) PH_(5) PH_(6) PH_(7) PH_(8) PH_(9) PH_(10) PH_(11) PH_(12) PH_(13) PH_(14) PH_(15) PH_(16) PH_(17)
    run_phase(*kparams(), 18);
#undef PH_
}
#else
template <int PH> __global__ void __launch_bounds__(512) phase_kernel(Params p) { run_phase(*kparams(), PH); }
typedef void (*phase_fn)(Params);
template <int PH> static bool launch_phase(const Params& p, int grid, hipStream_t stream, bool setattr) {
    if (setattr && hipFuncSetAttribute((const void*)phase_kernel<PH>, hipFuncAttributeMaxDynamicSharedMemorySize, LDS_BYTES) != hipSuccess) return false;
    hipLaunchKernelGGL(phase_kernel<PH>, dim3(grid), dim3(NTH), LDS_BYTES, stream, p);
    return true;
}
#endif

extern "C" void kernel_launch(void* const* d_in, const int* in_sizes, int n_in, void* d_out, int out_size, void* d_ws, size_t ws_size, hipStream_t stream) {
    static int grid_blocks = 0;
    bool first = false;
    if (!grid_blocks) {
        if (ws_size < WS_END) { fprintf(stderr, "kernel_launch: workspace too small: %zu < %zu\n", ws_size, (size_t)WS_END); return; }
        int dev = 0, cus = 0;
        (void)hipGetDevice(&dev);
        (void)hipDeviceGetAttribute(&cus, hipDeviceAttributeMultiprocessorCount, dev);
#if MK_LAUNCHES == 1
        if (hipFuncSetAttribute((const void*)mega_kernel, hipFuncAttributeMaxDynamicSharedMemorySize, LDS_BYTES) != hipSuccess) { fprintf(stderr, "kernel_launch: LDS attribute failed\n"); return; }
        int per_cu = 0;
        (void)hipOccupancyMaxActiveBlocksPerMultiprocessor(&per_cu, (const void*)mega_kernel, NTH, LDS_BYTES);
        if (per_cu < 1) { fprintf(stderr, "kernel_launch: occupancy query returned %d\n", per_cu); return; }
#endif
        grid_blocks = cus;
        first = true;
    }
    Params p{};
    const float* const* in = (const float* const*)d_in;
    p.x = in[0]; p.c = in[1]; p.ctx = in[2]; p.c_ctx = in[3]; p.ada_w = in[4]; p.ada_b = in[5]; p.norm_g = in[6]; p.router_w = in[7]; p.router_b = in[8];
    p.moe_w1 = in[9]; p.moe_b1 = in[10]; p.moe_w2 = in[11]; p.moe_b2 = in[12]; p.ab_in_w = in[13]; p.gla_wa_f = in[14]; p.gla_ba_f = in[15]; p.gla_wa_b = in[16]; p.gla_ba_b = in[17];
    p.gla_onorm = in[18]; p.mla_qnorm = in[19]; p.mla_wuq = in[20]; p.mla_kvnorm = in[21]; p.mla_wukv = in[22]; p.ab_out_w = in[23]; p.na_qkv_w = in[24]; p.na_rpb = in[25]; p.na_out_w = in[26];
    p.out = (float*)d_out; p.ws = (char*)d_ws;
#if MK_LAUNCHES == 1
    (void)hipMemsetAsync((char*)d_ws + WS_BAR, 0, 16384, stream);
    void* args[] = {&p};
    hipError_t e = hipLaunchCooperativeKernel((const void*)mega_kernel, dim3(grid_blocks), dim3(NTH), args, LDS_BYTES, stream);
    if (e != hipSuccess) fprintf(stderr, "cooperative launch failed: %s (grid %d)\n", hipGetErrorString(e), grid_blocks);
#else
    const int g = grid_blocks;
    launch_phase<0>(p, g, stream, first); launch_phase<1>(p, g, stream, first); launch_phase<2>(p, g, stream, first); launch_phase<3>(p, g, stream, first);
    launch_phase<4>(p, g, stream, first); launch_phase<5>(p, g, stream, first); launch_phase<6>(p, g, stream, first); launch_phase<7>(p, g, stream, first);
    launch_phase<8>(p, g, stream, first); launch_phase<9>(p, g, stream, first); launch_phase<10>(p, g, stream, first); launch_phase<11>(p, g, stream, first);
    launch_phase<12>(p, g, stream, first); launch_phase<13>(p, g, stream, first); launch_phase<14>(p, g, stream, first); launch_phase<15>(p, g, stream, first);
    launch_phase<16>(p, g, stream, first); launch_phase<17>(p, g, stream, first); launch_phase<18>(p, g, stream, first);
#endif
}
```

```cpp
#include <hip/hip_runtime.h>
#include <hip/hip_cooperative_groups.h>
#include <cstdio>
#include <cstdint>
namespace cg = cooperative_groups;

#ifndef PROBE_REPEAT
#define PROBE_REPEAT -1
#endif
#ifndef MK_LAUNCHES
#define MK_LAUNCHES 1
#endif

typedef unsigned short bf16_t;
typedef short bf16x8 __attribute__((ext_vector_type(8)));
typedef short s16x4 __attribute__((ext_vector_type(4)));
typedef float f32x4 __attribute__((ext_vector_type(4)));
typedef float f32x16 __attribute__((ext_vector_type(16)));
typedef unsigned u32x4 __attribute__((ext_vector_type(4)));
typedef int i32x4 __attribute__((ext_vector_type(4)));
typedef unsigned u32x2 __attribute__((ext_vector_type(2)));

constexpr int SEQ = 16384, CTXN = 256, NTOK = SEQ + CTXN, DM = 1024;
constexpr int NEXP = 32, FF = 1024;
constexpr int PW = 2048;
constexpr int PC_Q = 0, PC_K = 256, PC_V = 512, PC_R = 1024, PC_AF = 1536, PC_AB = 1552, PC_CQ = 1568, PC_CKV = 1824, PC_KR = 1952;
constexpr int NCH = NTOK / 64;
constexpr int NTH = 512;
constexpr float EPSN = 1e-6f;
constexpr float LOG2E = 1.4426950408889634f;

constexpr size_t al256(size_t x) { return (x + 255) / 256 * 256; }
constexpr size_t WS_BAR   = 0;
constexpr size_t WS_CNT   = WS_BAR + 16384;
constexpr size_t WS_MOD   = WS_CNT + 1024;
constexpr size_t WS_ROPE  = WS_MOD + al256((size_t)2 * 2 * 6144 * 4);
constexpr size_t WS_RWT   = WS_ROPE + al256((size_t)(256 + 256 + 64 + 64) * 16 * 4);
constexpr size_t WS_WIN   = WS_RWT + al256((size_t)2 * 32 * 1024 * 4);
constexpr size_t WS_WUQ   = WS_WIN + (size_t)2048 * 1024 * 2;
constexpr size_t WS_WUKV  = WS_WUQ + (size_t)768 * 256 * 2;
constexpr size_t WS_WOUT0 = WS_WUKV + (size_t)1024 * 128 * 2;
constexpr size_t WS_WQKV  = WS_WOUT0 + (size_t)1024 * 1024 * 2;
constexpr size_t WS_WNAO  = WS_WQKV + (size_t)3072 * 1024 * 2;
constexpr size_t WS_W1T   = WS_WNAO + (size_t)1024 * 1024 * 2;
constexpr size_t WS_W2T   = WS_W1T + (size_t)2 * 32 * 2048 * 1024 * 2;
constexpr size_t WS_Q8    = WS_W1T + (size_t)2 * 32 * 2048 * 1024;
constexpr size_t WS_K8    = WS_Q8 + (size_t)NTOK * 768;
constexpr size_t WS_VT8   = WS_K8 + (size_t)NTOK * 768;
constexpr size_t WS_DUMMY = WS_VT8 + (size_t)NTOK * 512;
static_assert(WS_DUMMY + (size_t)256 * 2048 <= WS_W2T, "fp8 MLA operands overflow the W1T region");
constexpr size_t WS_HB    = WS_W2T + (size_t)2 * 32 * 1024 * 1024 * 2;
constexpr size_t WS_P     = WS_HB + (size_t)NTOK * 1024 * 2;
constexpr size_t WS_QM    = WS_P + (size_t)NTOK * 3072 * 2;
constexpr size_t WS_KM    = WS_QM + (size_t)NTOK * 768 * 2;
constexpr size_t WS_VM    = WS_KM + (size_t)NTOK * 768 * 2;
constexpr size_t WS_U     = WS_VM + (size_t)NTOK * 512 * 2;
constexpr size_t WS_SIN   = WS_U + (size_t)2 * NCH * 4 * 128 * 64 * 2;
constexpr size_t WS_DEC   = WS_SIN + (size_t)2 * NCH * 4 * 128 * 64 * 2;
constexpr size_t WS_MIX   = WS_DEC + al256((size_t)2 * NCH * 4 * 64 * 4);
constexpr size_t WS_OB    = WS_MIX + (size_t)NTOK * 1024 * 2;
constexpr size_t WS_X1    = WS_OB + (size_t)NTOK * 1024 * 2;
constexpr size_t WS_X2    = WS_X1 + (size_t)NTOK * 1024 * 4;
constexpr size_t WS_TOPE  = WS_X2 + (size_t)NTOK * 1024 * 4;
constexpr size_t WS_TOPP  = WS_TOPE + al256((size_t)NTOK * 4 * 4);
constexpr size_t WS_GATE  = WS_TOPP + al256((size_t)NTOK * 4 * 4);
constexpr size_t WS_LIST  = WS_GATE + al256((size_t)NTOK * 4 * 4);
constexpr size_t WS_ACT   = WS_LIST + al256((size_t)32 * NTOK * 4);
constexpr size_t WS_YB    = WS_ACT + (size_t)(NTOK * 4 + 256) * 1024 * 2;
constexpr size_t WS_END   = WS_YB + (size_t)(NTOK * 4) * 1024 * 2;

constexpr int LDS_BYTES = 160 * 1024;
extern __shared__ __attribute__((aligned(16))) char smem[];

struct Params {
    const float *x, *c, *ctx, *c_ctx, *ada_w, *ada_b, *norm_g, *router_w, *router_b, *moe_w1, *moe_b1, *moe_w2, *moe_b2;
    const float *ab_in_w, *gla_wa_f, *gla_ba_f, *gla_wa_b, *gla_ba_b, *gla_onorm, *mla_qnorm, *mla_wuq, *mla_kvnorm, *mla_wukv;
    const float *ab_out_w, *na_qkv_w, *na_rpb, *na_out_w;
    float* out; char* ws;
    int pad0, pad1;
};
typedef const __attribute__((address_space(4))) Params& PRef;
typedef const __attribute__((address_space(4))) Params* KPtr;
__device__ __forceinline__ KPtr kparams() { KPtr k = (KPtr)__builtin_amdgcn_kernarg_segment_ptr(); asm volatile("" : "+s"(k)); return k; }

__device__ __forceinline__ float bf2f(bf16_t h) { return __uint_as_float(((unsigned)h) << 16); }
__device__ __forceinline__ bf16_t f2bf(float f) { unsigned u = __float_as_uint(f); u += 0x7FFFu + ((u >> 16) & 1u); return (bf16_t)(u >> 16); }
__device__ __forceinline__ unsigned cvtpk(float lo, float hi) { unsigned r; asm volatile("v_cvt_pk_bf16_f32 %0, %1, %2" : "=v"(r) : "v"(lo), "v"(hi)); return r; }
__device__ __forceinline__ float wave_sum(float v) {
#pragma unroll
    for (int o = 32; o >= 1; o >>= 1) v += __shfl_xor(v, o);
    return v;
}
__device__ __forceinline__ int crow(int r, int hi) { return (r & 3) + 8 * (r >> 2) + 4 * hi; }
__device__ __forceinline__ float silu_f(float x) { return x / (1.f + __expf(-x)); }
#define SBAR() __builtin_amdgcn_sched_barrier(0)
__device__ __forceinline__ unsigned pk4_fp8(float a, float b, float c, float d) {
    a = __builtin_amdgcn_fmed3f(a, -448.f, 448.f); b = __builtin_amdgcn_fmed3f(b, -448.f, 448.f); c = __builtin_amdgcn_fmed3f(c, -448.f, 448.f); d = __builtin_amdgcn_fmed3f(d, -448.f, 448.f);
    int r = __builtin_amdgcn_cvt_pk_fp8_f32(a, b, 0, false); r = __builtin_amdgcn_cvt_pk_fp8_f32(c, d, r, true); return (unsigned)r; }
__device__ __forceinline__ int tid_opaque() { int t = threadIdx.x; asm volatile("" : "+v"(t)); return t; }

struct ConvJob { const float* src; bf16_t* dst; const float* gain; int K, Nsrc, kt, nt, mode, f8; };
constexpr int CONV8_RS = 264;
constexpr float W8_SCALE = 64.f;
__device__ __forceinline__ void conv_load(const ConvJob& jb, float4 (&v)[16]) {
    const int tid = threadIdx.x, n4 = tid & 63, kr = tid >> 6, n = jb.nt * 256 + n4 * 4;
    const float* q = jb.src + (size_t)(jb.kt * 128 + kr) * jb.Nsrc + n;
#pragma unroll
    for (int i = 0; i < 16; ++i) { if (n < jb.Nsrc) { const f32x4 t = __builtin_nontemporal_load((const f32x4*)(q + (size_t)(8 * i) * jb.Nsrc)); v[i] = make_float4(t[0], t[1], t[2], t[3]); } else v[i] = make_float4(0.f, 0.f, 0.f, 0.f); }
}
__device__ __forceinline__ void conv_to_lds(const ConvJob& jb, const float4 (&v)[16]) {
    bf16_t* T = (bf16_t*)smem;
    const int tid = threadIdx.x, n4 = tid & 63, kr = tid >> 6;
#pragma unroll
    for (int i = 0; i < 16; ++i) {
        const int k = kr + 8 * i;
        float4 w = v[i];
        if (jb.mode == 1) { const float g = jb.gain[jb.kt * 128 + k]; w.x *= g; w.y *= g; w.z *= g; w.w *= g; }
        if (jb.f8) { *(unsigned*)((char*)smem + k * CONV8_RS + n4 * 4) = pk4_fp8(w.x * W8_SCALE, w.y * W8_SCALE, w.z * W8_SCALE, w.w * W8_SCALE); continue; }
        u32x2 pk; pk.x = cvtpk(w.x, w.y); pk.y = cvtpk(w.z, w.w);
        *(u32x2*)(T + k * 260 + n4 * 4) = pk;
    }
}
__device__ __forceinline__ void conv_readout(const ConvJob& jb) {
    const bf16_t* T = (const bf16_t*)smem;
    const int tid = threadIdx.x, k0 = jb.kt * 128;
    if (jb.f8) {
        const unsigned char* T8 = (const unsigned char*)smem;
#pragma unroll
        for (int i = 0; i < 4; ++i) {
            const int cc = tid + 512 * i, nn = cc >> 3, kc = cc & 7;
            const int col = (jb.mode == 2) ? (2 * (nn & 127) + (nn >> 7)) : nn;
            unsigned e[16];
#pragma unroll
            for (int j = 0; j < 16; ++j) e[j] = T8[(kc * 16 + j) * CONV8_RS + col];
            u32x4 o;
#pragma unroll
            for (int q = 0; q < 4; ++q) o[q] = e[4 * q] | (e[4 * q + 1] << 8) | (e[4 * q + 2] << 16) | (e[4 * q + 3] << 24);
            __builtin_nontemporal_store(o, (u32x4*)((char*)jb.dst + (size_t)(jb.nt * 256 + nn) * jb.K + k0 + kc * 16));
        }
        return;
    }
#pragma unroll
    for (int i = 0; i < 8; ++i) {
        const int cc = tid + 512 * i, nn = cc >> 4, kc = cc & 15;
        const int col = (jb.mode == 2) ? (2 * (nn & 127) + (nn >> 7)) : nn;
        unsigned short e[8];
#pragma unroll
        for (int j = 0; j < 8; ++j) e[j] = T[(kc * 8 + j) * 260 + col];
        u32x4 o; o.x = e[0] | ((unsigned)e[1] << 16); o.y = e[2] | ((unsigned)e[3] << 16); o.z = e[4] | ((unsigned)e[5] << 16); o.w = e[6] | ((unsigned)e[7] << 16);
        __builtin_nontemporal_store(o, (u32x4*)(jb.dst + (size_t)(jb.nt * 256 + nn) * jb.K + k0 + kc * 8));
    }
}

__device__ __forceinline__ void adaln_job(PRef p, int job) {
    const int l = job / 24, cb = (job % 24) * 256, tid = threadIdx.x;
    float* sv = (float*)smem;
    for (int i = tid; i < 2048; i += NTH) { const int k = i & 1023; const float xx = (i < 1024) ? p.c[k] : p.c_ctx[k]; sv[i] = silu_f(xx); }
    __syncthreads();
    const int col4 = tid & 63, kq = tid >> 6;
    float4 a0 = make_float4(0, 0, 0, 0), a1 = make_float4(0, 0, 0, 0);
    const float* w = p.ada_w + ((size_t)l * 1024 + kq * 128) * 6144 + cb + col4 * 4;
#pragma unroll 8
    for (int k = 0; k < 128; ++k) {
        const float4 wv = *(const float4*)(w + (size_t)k * 6144);
        const float s0 = sv[kq * 128 + k], s1 = sv[1024 + kq * 128 + k];
        a0.x += s0 * wv.x; a0.y += s0 * wv.y; a0.z += s0 * wv.z; a0.w += s0 * wv.w;
        a1.x += s1 * wv.x; a1.y += s1 * wv.y; a1.z += s1 * wv.z; a1.w += s1 * wv.w;
    }
    float* red = sv + 2048;
    *(float4*)(red + (kq * 2 + 0) * 256 + col4 * 4) = a0;
    *(float4*)(red + (kq * 2 + 1) * 256 + col4 * 4) = a1;
    __syncthreads();
    {
        const int s = tid >> 8, col = tid & 255;
        float acc = p.ada_b[l * 6144 + cb + col];
#pragma unroll
        for (int q = 0; q < 8; ++q) acc += red[(q * 2 + s) * 256 + col];
        ((float*)(p.ws + WS_MOD))[(l * 2 + s) * 6144 + cb + col] = acc;
    }
    __syncthreads();
}

__device__ __forceinline__ void tables_job(PRef p) {
    float* rope = (float*)(p.ws + WS_ROPE);
    const int tid = threadIdx.x;
    for (int i = tid; i < (256 + 64) * 16; i += NTH) {
        const bool isrow = i < 256 * 16;
        const int idx = isrow ? i : i - 256 * 16, pos = idx >> 4, j = idx & 15;
        const float inv = exp2f(-(float)j * (13.287712379549449f / 16.f));
        const float ang = (float)pos * inv;
        float rev = ang * 0.15915494309189535f; rev -= rintf(rev);
        const float cs = __builtin_amdgcn_cosf(rev), sn = __builtin_amdgcn_sinf(rev);
        if (isrow) { rope[idx] = cs; rope[256 * 16 + idx] = sn; }
        else { rope[512 * 16 + idx] = cs; rope[512 * 16 + 64 * 16 + idx] = sn; }
    }
    if (tid < 64) ((int*)(p.ws + WS_CNT))[tid] = 0;
}
__device__ __forceinline__ void rwt_job(PRef p, int l) {
    float* dst = (float*)(p.ws + WS_RWT) + (size_t)l * 32 * 1024;
    const float* src = p.router_w + (size_t)l * 1024 * 32;
    for (int i = threadIdx.x; i < 32 * 1024; i += NTH) { const int cch = i >> 5, e = i & 31; dst[e * 1024 + cch] = src[i]; }
}

constexpr int J_IN = 8 * 8, J_UQ = 2 * 3, J_UKV = 1 * 4, J_OUT0 = 32, J_QKV = 8 * 12, J_NAO = 32, J_W1 = 64 * 64, J_W2 = 64 * 32;
constexpr int J_TOTAL = J_IN + J_UQ + J_UKV + J_OUT0 + J_QKV + J_NAO + J_W1 + J_W2;
__device__ __forceinline__ ConvJob conv_decode(PRef p, int j) {
    ConvJob jb; jb.gain = nullptr; jb.mode = 0; jb.f8 = 0;
    int t = j;
    if (t < J_W1) { const int m = t >> 6, q = t & 63; jb.src = p.moe_w1 + (size_t)m * 1024 * 2048; jb.dst = (bf16_t*)(p.ws + WS_W1T + (size_t)m * 2048 * 1024); jb.K = 1024; jb.Nsrc = 2048; jb.kt = q >> 3; jb.nt = q & 7; jb.mode = 2; jb.f8 = 1; return jb; } t -= J_W1;
    if (t < J_W2) { const int m = t >> 5, q = t & 31; jb.src = p.moe_w2 + (size_t)m * 1024 * 1024; jb.dst = (bf16_t*)(p.ws + WS_W2T + (size_t)m * 1024 * 1024); jb.K = 1024; jb.Nsrc = 1024; jb.kt = q >> 2; jb.nt = q & 3; jb.f8 = 1; return jb; } t -= J_W2;
    if (t < J_IN) { jb.src = p.ab_in_w; jb.dst = (bf16_t*)(p.ws + WS_WIN); jb.K = 1024; jb.Nsrc = 2016; jb.kt = t / 8; jb.nt = t % 8; return jb; } t -= J_IN;
    if (t < J_UQ) { jb.src = p.mla_wuq; jb.dst = (bf16_t*)(p.ws + WS_WUQ); jb.K = 256; jb.Nsrc = 768; jb.kt = t / 3; jb.nt = t % 3; jb.mode = 1; jb.gain = p.mla_qnorm; return jb; } t -= J_UQ;
    if (t < J_UKV) { jb.src = p.mla_wukv; jb.dst = (bf16_t*)(p.ws + WS_WUKV); jb.K = 128; jb.Nsrc = 1024; jb.kt = 0; jb.nt = t; jb.mode = 1; jb.gain = p.mla_kvnorm; return jb; } t -= J_UKV;
    if (t < J_OUT0) { jb.src = p.ab_out_w; jb.dst = (bf16_t*)(p.ws + WS_WOUT0); jb.K = 1024; jb.Nsrc = 1024; jb.kt = t / 4; jb.nt = t % 4; return jb; } t -= J_OUT0;
    if (t < J_QKV) { jb.src = p.na_qkv_w; jb.dst = (bf16_t*)(p.ws + WS_WQKV); jb.K = 1024; jb.Nsrc = 3072; jb.kt = t / 12; jb.nt = t % 12; return jb; } t -= J_QKV;
    jb.src = p.na_out_w; jb.dst = (bf16_t*)(p.ws + WS_WNAO); jb.K = 1024; jb.Nsrc = 1024; jb.kt = t / 4; jb.nt = t % 4; return jb;
}

__device__ __forceinline__ void phase_prologue(PRef p) {
    const int G = gridDim.x, b = blockIdx.x;
    for (int j = b; j < 51; j += G) {
        if (j < 48) adaln_job(p, j);
        else if (j == 48) tables_job(p);
        else rwt_job(p, j - 49);
    }
    __syncthreads();
    int j = b;
    if (j >= J_TOTAL) return;
    ConvJob cur = conv_decode(p, j);
    float4 v[16];
    conv_load(cur, v);
    for (;;) {
        conv_to_lds(cur, v);
        __syncthreads();
        const int jn = j + G;
        ConvJob nxt = cur;
        if (jn < J_TOTAL) { nxt = conv_decode(p, jn); conv_load(nxt, v); }
        conv_readout(cur);
        __syncthreads();
        if (jn >= J_TOTAL) break;
        cur = nxt; j = jn;
    }
}

namespace gm {
constexpr int BK = 64, HT = 128 * 64;
__device__ __forceinline__ int lds_byte(int r, int c) { const int st = (r >> 4) * 2 + (c >> 5), rr = r & 15, cc = c & 31, ob = rr * 64 + cc * 2; return st * 1024 + (ob ^ (((ob >> 9) & 1) << 5)); }
__device__ __forceinline__ void stage_rc(int b, int& R, int& C) { const int st = b / 1024, sb = b % 1024, swz = sb ^ (((sb >> 9) & 1) << 5); R = (st >> 1) * 16 + swz / 64; C = (st & 1) * 32 + (swz % 64) / 2; }

template <class Epi>
__device__ __forceinline__ void gemm_tile(const bf16_t* __restrict__ A, const int (&aoff)[2][2], const bf16_t* __restrict__ Bt, const int (&boff)[2], int nk, Epi& epi) {
    bf16_t* shm = (bf16_t*)smem;
    const int tid = tid_opaque(), wid = tid >> 6, lane = tid & 63, wr = wid >> 1, wc = wid & 1, fr = lane & 15, fq = lane >> 4;
    f32x4 acc[4][4];
#pragma unroll
    for (int m = 0; m < 4; ++m)
#pragma unroll
        for (int n = 0; n < 4; ++n) acc[m][n] = (f32x4){0.f, 0.f, 0.f, 0.f};
#define GM_STAGE(buf, kt) do { \
        _Pragma("unroll") for (int _i = 0; _i < 2; ++_i) { \
            __builtin_amdgcn_global_load_lds((const unsigned*)(A + aoff[0][_i] + (kt) * BK), (unsigned*)((char*)(shm + ((buf) * 3 + 0) * HT) + tid * 16 + _i * 8192), 16, 0, 0); \
            __builtin_amdgcn_global_load_lds((const unsigned*)(A + aoff[1][_i] + (kt) * BK), (unsigned*)((char*)(shm + ((buf) * 3 + 1) * HT) + tid * 16 + _i * 8192), 16, 0, 0); \
            __builtin_amdgcn_global_load_lds((const unsigned*)(Bt + boff[_i] + (kt) * BK), (unsigned*)((char*)(shm + ((buf) * 3 + 2) * HT) + tid * 16 + _i * 8192), 16, 0, 0); } } while (0)
    GM_STAGE(0, 0);
    for (int kt = 0; kt < nk; ++kt) {
        __syncthreads();
        const int buf = kt & 1;
        if (kt + 1 < nk) GM_STAGE(buf ^ 1, kt + 1);
        const char* Ab = (const char*)(shm + (buf * 3 + (wr >> 1)) * HT);
        const char* Bb = (const char*)(shm + (buf * 3 + 2) * HT);
#pragma unroll
        for (int k = 0; k < 2; ++k) {
            bf16x8 Bf[4], Af[4];
#pragma unroll
            for (int n = 0; n < 4; ++n) Bf[n] = *(const bf16x8*)(Bb + lds_byte(wc * 64 + n * 16 + fr, k * 32 + fq * 8));
#pragma unroll
            for (int m = 0; m < 4; ++m) Af[m] = *(const bf16x8*)(Ab + lds_byte((wr & 1) * 64 + m * 16 + fr, k * 32 + fq * 8));
#pragma unroll
            for (int m = 0; m < 4; ++m)
#pragma unroll
                for (int n = 0; n < 4; ++n) acc[m][n] = __builtin_amdgcn_mfma_f32_16x16x32_bf16(Af[m], Bf[n], acc[m][n], 0, 0, 0);
        }
    }
#undef GM_STAGE
    float* stg = (float*)smem;
    __syncthreads();
    {
        float* wb = stg + (wr * 64 + fq * 4) * 132 + wc * 64 + fr;
#pragma unroll
        for (int m = 0; m < 4; ++m)
#pragma unroll
            for (int n = 0; n < 4; ++n)
#pragma unroll
                for (int j = 0; j < 4; ++j) wb[(m * 16 + j) * 132 + n * 16] = acc[m][n][j];
    }
    __syncthreads();
    if (Epi::MOE1) {
        const int fch = tid & 7, rg = tid >> 3;
        for (int ps = 0; ps < 4; ++ps) {
            const int row = ps * 64 + rg;
            const float* q = stg + row * 132 + (fch >> 1) * 32 + (fch & 1) * 8;
            float g[8], l[8];
            *(f32x4*)&g[0] = *(const f32x4*)q; *(f32x4*)&g[4] = *(const f32x4*)(q + 4);
            *(f32x4*)&l[0] = *(const f32x4*)(q + 16); *(f32x4*)&l[4] = *(const f32x4*)(q + 20);
            epi.pair(row, fch * 8, g, l);
        }
    } else {
        const int ch = tid & 15, rg = tid >> 4;
        for (int ps = 0; ps < 8; ++ps) {
            const int row = ps * 32 + rg;
            const float* q = stg + row * 132 + ch * 8;
            float v[8];
            *(f32x4*)&v[0] = *(const f32x4*)q; *(f32x4*)&v[4] = *(const f32x4*)(q + 4);
            epi.row8(row, ch * 8, v);
        }
    }
    __syncthreads();
}
__device__ __forceinline__ void make_off(int (&off)[2][2], int row0, int ld) {
#pragma unroll
    for (int h = 0; h < 2; ++h)
#pragma unroll
        for (int i = 0; i < 2; ++i) { int R, C; stage_rc(tid_opaque() * 16 + i * 8192, R, C); off[h][i] = (row0 + h * 128 + R) * ld + C; }
}
__device__ __forceinline__ void make_off1(int (&off)[2], int row0, int ld) {
#pragma unroll
    for (int i = 0; i < 2; ++i) { int R, C; stage_rc(tid_opaque() * 16 + i * 8192, R, C); off[i] = (row0 + R) * ld + C; }
}
}

namespace pg8 {
#define PG8_LAS __attribute__((address_space(3)))
constexpr int BM = 256, BK = 64, HALF = 128, HTB = HALF * BK * 2, STAGE_BYTES = 8 * HTB, NXCD = 8, WGM = 8;
__device__ __forceinline__ int lds_byte(int r, int c) { const int st = (r >> 4) * 2 + (c >> 5), rr = r & 15, cc = c & 31, ob = rr * 64 + cc * 2; return st * 1024 + (ob ^ (((ob >> 9) & 1) << 5)); }
__device__ __forceinline__ void stage_rc(int b, int& R, int& C) { const int st = b / 1024, sb = b % 1024, swz = sb ^ (((sb >> 9) & 1) << 5); R = (st >> 1) * 16 + swz / 64; C = (st & 1) * 32 + (swz % 64) / 2; }
__device__ __forceinline__ int perm32(int rho) { const int n = rho >> 4, i = rho & 15; return 8 * (i >> 2) + 4 * n + (i & 3); }
struct Unit { int pm, pn, e, nvalid, slot0, lbase; };

template <class Epi, class Sched, bool GATHER, bool F8 = false>
__device__ __forceinline__ void gemm_phase(PG8_LAS unsigned char* lds, const Sched& S, const Epi& E, int K, int lda, int ldb, int scA = 0x7F7F7F7F, int scB = 0x7F7F7F7F) {
    const int tid = tid_opaque(), wid = __builtin_amdgcn_readfirstlane(tid >> 6), lane = tid & 63, wr = wid >> 2, wc = wid & 3, fr = lane & 15, fq = lane >> 4;
    const int nt = K / BK;
    unsigned voffA[2], voffB[2]; int gR[2], gC[2];
#pragma unroll
    for (int i = 0; i < 2; ++i) { int R, C; stage_rc(tid * 16 + i * 8192, R, C); const int Rb = Epi::PERM ? ((R & ~31) + perm32(R & 31)) : R;
        voffA[i] = (unsigned)(R * lda + C) * 2u; voffB[i] = (unsigned)(Rb * ldb + C) * 2u; gR[i] = R; gC[i] = C * 2; }
    const size_t kstep = (size_t)(BK * 2);
    const size_t hstepA = (size_t)HALF * lda * 2, hstepB = (size_t)HALF * ldb * 2;
    const unsigned ldsw = (unsigned)wid * 1024u;
    const int aoff = lds_byte(wr * 64 + fr, fq * 8), boff = lds_byte(wc * 32 + fr, fq * 8);
    unsigned gA[2][2] = {{0u, 0u}, {0u, 0u}};
#define PG8_SA(b, h) (((b) * 2 + (h)) * HTB)
#define PG8_SB(b, h) ((4 + (b) * 2 + (h)) * HTB)
#define PG8_STAGE(bufoff, gbase, voff) do { _Pragma("unroll") for (int _i = 0; _i < 2; ++_i) \
        __builtin_amdgcn_global_load_lds((const unsigned*)((const char*)(gbase) + (voff)[_i]), (PG8_LAS unsigned*)(lds + (bufoff) + ldsw + _i * 8192), 16, 0, 0); } while (0)
#define PG8_STAGE_A(bufoff, base, h) do { if constexpr (GATHER) PG8_STAGE(bufoff, base, gA[h]); else PG8_STAGE(bufoff, (base) + (h) * hstepA, voffA); } while (0)
#define PG8_LDA(dst, b, h) do { _Pragma("unroll") for (int m = 0; m < 4; ++m) _Pragma("unroll") for (int k = 0; k < 2; ++k) dst[m][k] = *(const PG8_LAS bf16x8*)(lds + PG8_SA(b, h) + aoff + m * 2048 + k * 1024); } while (0)
#define PG8_LDB(dst, b, h) do { _Pragma("unroll") for (int n = 0; n < 2; ++n) _Pragma("unroll") for (int k = 0; k < 2; ++k) dst[n][k] = *(const PG8_LAS bf16x8*)(lds + PG8_SB(b, h) + boff + n * 2048 + k * 1024); } while (0)
#define PG8_MMA(ai, bj, At, Bt) do { __builtin_amdgcn_s_setprio(1); _Pragma("unroll") for (int m = 0; m < 4; ++m) _Pragma("unroll") for (int n = 0; n < 2; ++n) { \
        if constexpr (F8) { const i32x4 _b0 = __builtin_bit_cast(i32x4, Bt[n][0]), _b1 = __builtin_bit_cast(i32x4, Bt[n][1]), _a0 = __builtin_bit_cast(i32x4, At[m][0]), _a1 = __builtin_bit_cast(i32x4, At[m][1]); \
            acc[ai][bj][m][n] = __builtin_amdgcn_mfma_scale_f32_16x16x128_f8f6f4(__builtin_shufflevector(_b0, _b1, 0, 1, 2, 3, 4, 5, 6, 7), __builtin_shufflevector(_a0, _a1, 0, 1, 2, 3, 4, 5, 6, 7), acc[ai][bj][m][n], 0, 0, 0, scB, 0, scA); } \
        else { _Pragma("unroll") for (int k = 0; k < 2; ++k) acc[ai][bj][m][n] = __builtin_amdgcn_mfma_f32_16x16x32_bf16(Bt[n][k], At[m][k], acc[ai][bj][m][n], 0, 0, 0); } } __builtin_amdgcn_s_setprio(0); } while (0)
#define PG8_WAIT_V(n) asm volatile("s_waitcnt vmcnt(" #n ")" ::: "memory")
#define PG8_WAIT_L(n) asm volatile("s_waitcnt lgkmcnt(" #n ")" ::: "memory")
#define PG8_BAR __builtin_amdgcn_s_barrier()
#define PG8_SCHED __builtin_amdgcn_sched_barrier(0)
#define PG8_GLOAD(U_) do { _Pragma("unroll") for (int _h = 0; _h < 2; ++_h) _Pragma("unroll") for (int _i = 0; _i < 2; ++_i) \
        gA[_h][_i] = ((unsigned)S.grow(U_, _h * 128 + gR[_i]) << (F8 ? 10 : 11)) + (unsigned)gC[_i]; } while (0)
    unsigned gN[2][2] = {{0u, 0u}, {0u, 0u}};
#define PG8_GLOADN(U_) do { _Pragma("unroll") for (int _h = 0; _h < 2; ++_h) _Pragma("unroll") for (int _i = 0; _i < 2; ++_i) gN[_h][_i] = (unsigned)S.grow(U_, _h * 128 + gR[_i]); } while (0)
#define PG8_GSWITCH() do { _Pragma("unroll") for (int _h = 0; _h < 2; ++_h) _Pragma("unroll") for (int _i = 0; _i < 2; ++_i) gA[_h][_i] = (gN[_h][_i] << (F8 ? 10 : 11)) + (unsigned)gC[_i]; } while (0)
    Unit cur, nxt; int ui = 0;
    if (!S.next(0, cur)) return;
    f32x4 acc[2][2][4][2];
#pragma unroll
    for (int a = 0; a < 2; ++a)
#pragma unroll
        for (int b = 0; b < 2; ++b)
#pragma unroll
            for (int m = 0; m < 4; ++m)
#pragma unroll
                for (int n = 0; n < 2; ++n) acc[a][b][m][n] = (f32x4){0.f, 0.f, 0.f, 0.f};
    bf16x8 At[4][2], B0[2][2], B1[2][2];
    const char* cA = S.a_base(cur); const char* cB = S.b_base(cur);
    if constexpr (GATHER) PG8_GLOAD(cur);
    PG8_STAGE(PG8_SB(0, 0), cB, voffB); PG8_STAGE_A(PG8_SA(0, 0), cA, 0); PG8_STAGE(PG8_SB(0, 1), cB + hstepB, voffB); PG8_STAGE_A(PG8_SA(0, 1), cA, 1);
    if (wr == 1) PG8_BAR;
    PG8_WAIT_V(4); PG8_BAR;
    PG8_STAGE(PG8_SB(1, 0), cB + kstep, voffB); PG8_STAGE_A(PG8_SA(1, 0), cA + kstep, 0); PG8_STAGE(PG8_SB(1, 1), cB + hstepB + kstep, voffB);
    PG8_WAIT_V(6); PG8_BAR;
    for (;;) {
        const bool has_next = S.next(ui + 1, nxt);
        const char* nA = has_next ? S.a_base(nxt) : cA; const char* nB = has_next ? S.b_base(nxt) : cB;
#pragma unroll 1
        for (int t = 0; t < nt; t += 2) {
            const bool last = (t == nt - 2);
            if constexpr (GATHER) { if (t == 0 && has_next) PG8_GLOADN(nxt); }
            const char* a1 = cA + (size_t)(t + 1) * kstep;
            const char* a2 = last ? nA : cA + (size_t)(t + 2) * kstep; const char* b2 = last ? nB : cB + (size_t)(t + 2) * kstep;
            const char* a3 = a2 + kstep; const char* b3 = b2 + kstep;
            PG8_LDB(B0, 0, 0); PG8_SCHED; PG8_LDA(At, 0, 0); PG8_STAGE_A(PG8_SA(1, 1), a1, 1);
            PG8_WAIT_L(8); PG8_BAR; PG8_WAIT_L(0); PG8_MMA(0, 0, At, B0); PG8_BAR; PG8_SCHED;
            if constexpr (GATHER) { if (last && has_next) PG8_GSWITCH(); }
            PG8_LDB(B1, 0, 1); PG8_STAGE(PG8_SB(0, 0), b2, voffB);
            PG8_BAR; PG8_WAIT_L(0); PG8_MMA(0, 1, At, B1); PG8_BAR;
            PG8_LDA(At, 0, 1); PG8_STAGE_A(PG8_SA(0, 0), a2, 0);
            PG8_BAR; PG8_WAIT_L(0); PG8_MMA(1, 0, At, B0); PG8_BAR; PG8_SCHED;
            PG8_STAGE(PG8_SB(0, 1), b2 + hstepB, voffB);
            PG8_WAIT_V(6); PG8_BAR; PG8_MMA(1, 1, At, B1); PG8_BAR;
            PG8_LDB(B0, 1, 0); PG8_SCHED; PG8_LDA(At, 1, 0); PG8_STAGE_A(PG8_SA(0, 1), a2, 1);
            PG8_WAIT_L(8); PG8_BAR; PG8_WAIT_L(0); PG8_MMA(0, 0, At, B0); PG8_BAR; PG8_SCHED;
            PG8_LDB(B1, 1, 1); PG8_STAGE(PG8_SB(1, 0), b3, voffB);
            PG8_BAR; PG8_WAIT_L(0); PG8_MMA(0, 1, At, B1); PG8_BAR;
            PG8_LDA(At, 1, 1); PG8_STAGE_A(PG8_SA(1, 0), a3, 0);
            PG8_BAR; PG8_WAIT_L(0); PG8_MMA(1, 0, At, B0); PG8_BAR; PG8_SCHED;
            PG8_STAGE(PG8_SB(1, 1), b3 + hstepB, voffB);
            PG8_WAIT_V(6); PG8_BAR; PG8_MMA(1, 1, At, B1); PG8_BAR;
        }
        { int fr_e = fr, fq_e = fq; asm volatile("" : "+v"(fr_e), "+v"(fq_e));
          E(acc, cur, wr, wc, fr_e, fq_e); }
        if (!has_next) break;
#pragma unroll
        for (int a = 0; a < 2; ++a)
#pragma unroll
            for (int b = 0; b < 2; ++b)
#pragma unroll
                for (int m = 0; m < 4; ++m)
#pragma unroll
                    for (int n = 0; n < 2; ++n) acc[a][b][m][n] = (f32x4){0.f, 0.f, 0.f, 0.f};
        cur = nxt; cA = nA; cB = nB; ++ui;
    }
    PG8_WAIT_V(0);
    if (wr == 0) PG8_BAR;
    PG8_BAR;
#undef PG8_SA
#undef PG8_SB
#undef PG8_STAGE
#undef PG8_STAGE_A
#undef PG8_LDA
#undef PG8_LDB
#undef PG8_MMA
#undef PG8_WAIT_V
#undef PG8_WAIT_L
#undef PG8_BAR
#undef PG8_SCHED
#undef PG8_GLOAD
#undef PG8_GLOADN
#undef PG8_GSWITCH
}

struct PlainOrder {
    const char* A; const char* Bt; int lda, ldb, nM, nN, nwg, G, c;
    __device__ void init(const bf16_t* A_, int lda_, const bf16_t* Bt_, int ldb_, int nM_, int nN_) { A = (const char*)A_; Bt = (const char*)Bt_; lda = lda_; ldb = ldb_; nM = nM_; nN = nN_; nwg = nM * nN; G = gridDim.x; c = blockIdx.x; }
    __device__ __forceinline__ bool next(int i, Unit& u) const {
        const long L = (long)i * G + c; if (L >= nwg) return false;
        int wgid = (int)L; { const int q = nwg / NXCD, r = nwg % NXCD, xcd = wgid % NXCD, off = wgid / NXCD; wgid = (xcd < r ? xcd * (q + 1) : r * (q + 1) + (xcd - r) * q) + off; }
        const int nig = WGM * nN, gid = wgid / nig, fm = gid * WGM, gsz = (nM - fm) < WGM ? (nM - fm) : WGM;
        u.pm = fm + ((wgid % nig) % gsz); u.pn = (wgid % nig) / gsz; u.e = 0; u.nvalid = 256; u.slot0 = 0; return true;
    }
    __device__ __forceinline__ const char* a_base(const Unit& u) const { return A + (size_t)u.pm * 256 * lda * 2; }
    __device__ __forceinline__ const char* b_base(const Unit& u) const { return Bt + (size_t)u.pn * 256 * ldb * 2; }
    __device__ __forceinline__ int grow(const Unit&, int) const { return 0; }
};
struct MoeOrder {
    const char* A; const char* W; const PG8_LAS int* tab; const PG8_LAS int* gl; int wrows, nunits;
    __device__ __forceinline__ bool next(int i, Unit& u) const {
        if (i >= nunits) return false;
        const PG8_LAS int* t = tab + i * 8;
        u.pm = t[0]; u.pn = t[1]; u.e = t[2]; u.nvalid = t[3]; u.slot0 = t[4]; u.lbase = t[6]; return true;
    }
    __device__ __forceinline__ const char* a_base(const Unit& u) const { return A + (size_t)u.slot0 * 1024; }
    __device__ __forceinline__ const char* b_base(const Unit& u) const { return W + ((size_t)u.e * wrows + (size_t)u.pn * 256) * 1024; }
    __device__ __forceinline__ int grow(const Unit& u, int r) const { return u.slot0 + r; }
};
constexpr int MOE_UNITS_MAX = 16;
__device__ __forceinline__ int moe_build_units(PG8_LAS int* tab, const int* cnt, const int* off, const int* toff, int nN) {
    const int G = gridDim.x, c = blockIdx.x, x = c & 7, j = c >> 3, per = (G >> 3) / nN, nMt = toff[32];
    const int i = threadIdx.x;
    if (i < MOE_UNITS_MAX) {
        const int pn = j % nN, mt = (i * 8 + x) * per + j / nN;
        int e = 0, valid = (mt < nMt && j < per * nN) ? 1 : 0;
        if (valid) { while (toff[e + 1] <= mt) ++e; }
        const int m = mt - toff[e];
        tab[i * 8 + 0] = mt; tab[i * 8 + 1] = pn; tab[i * 8 + 2] = e; tab[i * 8 + 3] = cnt[e] - m * 256; tab[i * 8 + 4] = off[e] + m * 256; tab[i * 8 + 5] = valid; tab[i * 8 + 6] = e * NTOK + m * 256;
    }
    __syncthreads();
    int n = 0;
    while (n < MOE_UNITS_MAX && tab[n * 8 + 5]) ++n;
    return n;
}
struct MoeOrderG : MoeOrder { const int* list;
    __device__ __forceinline__ const char* a_base(const Unit&) const { return A; }
    __device__ __forceinline__ int grow(const Unit& u, int r) const { const int rc = r < u.nvalid ? r : u.nvalid - 1; return list[u.lbase + rc]; } };
struct MoeOrderI : MoeOrder { __device__ __forceinline__ const char* a_base(const Unit&) const { return A; } };

__device__ __forceinline__ u32x4 pk8(const f32x4& a, const f32x4& b) { return (u32x4){cvtpk(a[0], a[1]), cvtpk(a[2], a[3]), cvtpk(b[0], b[1]), cvtpk(b[2], b[3])}; }
struct EpiStore {
    static constexpr bool PERM = true;
    bf16_t* C; int ldc; const float* rs;
    __device__ __forceinline__ void operator()(const f32x4 (&acc)[2][2][4][2], const Unit& u, int wr, int wc, int fr, int fq) const {
        bf16_t* base = C + ((size_t)u.pm * 256 + wr * 64 + fr) * ldc + u.pn * 256 + wc * 32 + 8 * fq;
#pragma unroll
        for (int ai = 0; ai < 2; ++ai)
#pragma unroll
            for (int m = 0; m < 4; ++m) { bf16_t* rowp = base + (size_t)(ai * HALF + m * 16) * ldc; const float s = rs ? rs[ai * HALF + wr * 64 + m * 16 + fr] : 1.f;
#pragma unroll
                for (int bj = 0; bj < 2; ++bj) *(u32x4*)(rowp + bj * HALF) = pk8(acc[ai][bj][m][0] * s, acc[ai][bj][m][1] * s); }
    }
};
constexpr float ACT8_SCALE = 4.f;
struct EpiAct {
    static constexpr bool PERM = true;
    unsigned char* Act; const float* b1all; unsigned char* dummy;
    __device__ __forceinline__ void operator()(const f32x4 (&acc)[2][2][4][2], const Unit& u, int wr, int wc, int fr, int fq) const {
        const int f0 = u.pn * 128 + wc * 32 + 8 * fq;
        const float* bb = b1all + (size_t)u.e * 2048 + 2 * f0;
        f32x4 bv[4];
#pragma unroll
        for (int q = 0; q < 4; ++q) bv[q] = *(const f32x4*)(bb + 4 * q);
        unsigned char* base = Act + ((size_t)u.slot0 + wr * 64 + fr) * 1024 + f0;
#pragma unroll
        for (int ai = 0; ai < 2; ++ai)
#pragma unroll
            for (int m = 0; m < 4; ++m) {
                const int r = ai * HALF + wr * 64 + m * 16 + fr;
                float a[8];
#pragma unroll
                for (int n = 0; n < 2; ++n)
#pragma unroll
                    for (int j = 0; j < 4; ++j) { const int f = 4 * n + j;
                        float glu = acc[ai][0][m][n][j] + bv[f >> 1][(f & 1) * 2], lin = acc[ai][1][m][n][j] + bv[f >> 1][(f & 1) * 2 + 1];
                        glu = fminf(glu, 7.f); lin = fminf(fmaxf(lin, -7.f), 7.f);
                        a[f] = glu * __builtin_amdgcn_rcpf(1.f + __builtin_amdgcn_exp2f(-1.702f * LOG2E * glu)) * (lin * ACT8_SCALE + ACT8_SCALE); }
                unsigned char* dst = (r < u.nvalid) ? base + (size_t)(ai * HALF + m * 16) * 1024 : dummy + (size_t)r * 1024 + f0;
                *(u32x2*)dst = (u32x2){pk4_fp8(a[0], a[1], a[2], a[3]), pk4_fp8(a[4], a[5], a[6], a[7])};
            }
    }
};
struct EpiBias {
    static constexpr bool PERM = true;
    bf16_t* Y; const float* b2all; bf16_t* dummy;
    __device__ __forceinline__ void operator()(const f32x4 (&acc)[2][2][4][2], const Unit& u, int wr, int wc, int fr, int fq) const {
        const int c0 = u.pn * 256 + wc * 32 + 8 * fq;
        const float* bb = b2all + (size_t)u.e * 1024 + c0;
        f32x4 bv[2][2];
#pragma unroll
        for (int bj = 0; bj < 2; ++bj)
#pragma unroll
            for (int n = 0; n < 2; ++n) bv[bj][n] = *(const f32x4*)(bb + bj * HALF + 4 * n);
        bf16_t* base = Y + ((size_t)u.slot0 + wr * 64 + fr) * 1024 + c0;
#pragma unroll
        for (int ai = 0; ai < 2; ++ai)
#pragma unroll
            for (int m = 0; m < 4; ++m) { const int r = ai * HALF + wr * 64 + m * 16 + fr;
                bf16_t* dst = (r < u.nvalid) ? base + (size_t)(ai * HALF + m * 16) * 1024 : dummy + (size_t)r * 1024 + c0;
#pragma unroll
                for (int bj = 0; bj < 2; ++bj) *(u32x4*)(dst + bj * HALF) = pk8(acc[ai][bj][m][0] + bv[bj][0], acc[ai][bj][m][1] + bv[bj][1]); }
    }
};
}

__device__ __forceinline__ u32x4 pack8(const float (&v)[8]) { return (u32x4){cvtpk(v[0], v[1]), cvtpk(v[2], v[3]), cvtpk(v[4], v[5]), cvtpk(v[6], v[7])}; }
struct EpiPlain {
    static constexpr bool MOE1 = false;
    bf16_t* C; int ldc;
    __device__ __forceinline__ void row8(int r, int c, const float (&v)[8]) const { *(u32x4*)(C + (size_t)r * ldc + c) = pack8(v); }
    __device__ __forceinline__ void pair(int, int, const float (&)[8], const float (&)[8]) const {}
};
struct EpiRowScale {
    static constexpr bool MOE1 = false;
    bf16_t* C; int ldc; const float* rs;
    __device__ __forceinline__ void row8(int r, int c, const float (&v)[8]) const { const float s = rs[r]; float w[8];
#pragma unroll
        for (int i = 0; i < 8; ++i) w[i] = v[i] * s;
        *(u32x4*)(C + (size_t)r * ldc + c) = pack8(w); }
    __device__ __forceinline__ void pair(int, int, const float (&)[8], const float (&)[8]) const {}
};
__device__ __forceinline__ void phase_gemm_plain(const bf16_t* A, int lda, const bf16_t* Bt, int K, bf16_t* C, int ldc, int nM, int nN) {
    const int G = gridDim.x;
    for (int u = blockIdx.x; u < nM * nN; u += G) {
        const int pm = u / nN, pn = u % nN;
        int aoff[2][2], boff[2];
        gm::make_off(aoff, pm * 256, lda); gm::make_off1(boff, pn * 128, K);
        EpiPlain epi{C + (size_t)pm * 256 * ldc + pn * 128, ldc};
        gm::gemm_tile(A, aoff, Bt, boff, K / 64, epi);
    }
}

struct Row16 { float4 v[4]; };
__device__ __forceinline__ Row16 ld_row_f32(const float* p, int lane) { Row16 r;
#pragma unroll
    for (int i = 0; i < 4; ++i) r.v[i] = *(const float4*)(p + lane * 4 + 256 * i);
    return r; }
__device__ __forceinline__ Row16 ld_row_bf16(const bf16_t* p, int lane) { Row16 r;
#pragma unroll
    for (int i = 0; i < 4; ++i) { const u32x2 w = *(const u32x2*)(p + lane * 4 + 256 * i);
        r.v[i] = make_float4(__uint_as_float(w.x << 16), __uint_as_float(w.x & 0xFFFF0000u), __uint_as_float(w.y << 16), __uint_as_float(w.y & 0xFFFF0000u)); }
    return r; }
__device__ __forceinline__ void st_row_f32(float* p, int lane, const Row16& r) {
#pragma unroll
    for (int i = 0; i < 4; ++i) *(float4*)(p + lane * 4 + 256 * i) = r.v[i]; }
__device__ __forceinline__ void st_row_bf16(bf16_t* p, int lane, const Row16& r) {
#pragma unroll
    for (int i = 0; i < 4; ++i) { u32x2 w; w.x = cvtpk(r.v[i].x, r.v[i].y); w.y = cvtpk(r.v[i].z, r.v[i].w); *(u32x2*)(p + lane * 4 + 256 * i) = w; } }
__device__ __forceinline__ void st_row_fp8(unsigned char* p, int lane, const Row16& r) {
#pragma unroll
    for (int i = 0; i < 4; ++i) *(unsigned*)(p + lane * 4 + 256 * i) = pk4_fp8(r.v[i].x, r.v[i].y, r.v[i].z, r.v[i].w); }
__device__ __forceinline__ float row_rstd(const Row16& r) {
    float s = 0.f;
#pragma unroll
    for (int i = 0; i < 4; ++i) s += r.v[i].x * r.v[i].x + r.v[i].y * r.v[i].y + r.v[i].z * r.v[i].z + r.v[i].w * r.v[i].w;
    s = wave_sum(s);
    return rsqrtf(s * (1.f / 1024.f) + EPSN);
}
__device__ __forceinline__ Row16 norm_mod(const Row16& x, float rstd, const float* g, const float* sc, const float* sh, int lane) {
    Row16 h;
#pragma unroll
    for (int i = 0; i < 4; ++i) {
        const int c = lane * 4 + 256 * i;
        const float4 gv = *(const float4*)(g + c), scv = *(const float4*)(sc + c), shv = *(const float4*)(sh + c);
        h.v[i].x = x.v[i].x * rstd * gv.x * (1.f + scv.x) + shv.x; h.v[i].y = x.v[i].y * rstd * gv.y * (1.f + scv.y) + shv.y;
        h.v[i].z = x.v[i].z * rstd * gv.z * (1.f + scv.z) + shv.z; h.v[i].w = x.v[i].w * rstd * gv.w * (1.f + scv.w) + shv.w;
    }
    return h;
}
__device__ __forceinline__ Row16 resid_add(const Row16& x, const Row16& y, float rstd, const float* g, const float* gate, int lane) {
    Row16 o;
#pragma unroll
    for (int i = 0; i < 4; ++i) {
        const int c = lane * 4 + 256 * i;
        const float4 gv = *(const float4*)(g + c), ga = *(const float4*)(gate + c);
        o.v[i].x = x.v[i].x + y.v[i].x * rstd * gv.x * ga.x; o.v[i].y = x.v[i].y + y.v[i].y * rstd * gv.y * ga.y;
        o.v[i].z = x.v[i].z + y.v[i].z * rstd * gv.z * ga.z; o.v[i].w = x.v[i].w + y.v[i].w * rstd * gv.w * ga.w;
    }
    return o;
}
__device__ __forceinline__ const float* mod_ptr(PRef p, int l, int r) { return (const float*)(p.ws + WS_MOD) + (size_t)(l * 2 + (r < CTXN ? 1 : 0)) * 6144; }
__device__ __forceinline__ const float* src_row(PRef p, int r) { return r < CTXN ? p.ctx + (size_t)r * 1024 : p.x + (size_t)(r - CTXN) * 1024; }

struct ModAB { float4 a[4], b[4]; };
struct ModG { float4 g[4]; };
__device__ __forceinline__ ModAB load_ab(const float* g, const float* sc, const float* sh, int lane) { ModAB m;
#pragma unroll
    for (int i = 0; i < 4; ++i) { const int c = lane * 4 + 256 * i; const float4 gv = *(const float4*)(g + c), sv = *(const float4*)(sc + c); m.b[i] = *(const float4*)(sh + c);
        m.a[i] = make_float4(gv.x * (1.f + sv.x), gv.y * (1.f + sv.y), gv.z * (1.f + sv.z), gv.w * (1.f + sv.w)); }
    return m; }
__device__ __forceinline__ ModG load_g(const float* g, const float* gate, int lane) { ModG m;
#pragma unroll
    for (int i = 0; i < 4; ++i) { const int c = lane * 4 + 256 * i; const float4 gv = *(const float4*)(g + c), ga = *(const float4*)(gate + c); m.g[i] = make_float4(gv.x * ga.x, gv.y * ga.y, gv.z * ga.z, gv.w * ga.w); }
    return m; }
__device__ __forceinline__ Row16 apply_ab(const Row16& x, float rstd, const ModAB& m) { Row16 h;
#pragma unroll
    for (int i = 0; i < 4; ++i) h.v[i] = make_float4(x.v[i].x * rstd * m.a[i].x + m.b[i].x, x.v[i].y * rstd * m.a[i].y + m.b[i].y, x.v[i].z * rstd * m.a[i].z + m.b[i].z, x.v[i].w * rstd * m.a[i].w + m.b[i].w);
    return h; }
__device__ __forceinline__ Row16 apply_g(const Row16& x, const Row16& y, float rstd, const ModG& m) { Row16 o;
#pragma unroll
    for (int i = 0; i < 4; ++i) o.v[i] = make_float4(x.v[i].x + y.v[i].x * rstd * m.g[i].x, x.v[i].y + y.v[i].y * rstd * m.g[i].y, x.v[i].z + y.v[i].z * rstd * m.g[i].z, x.v[i].w + y.v[i].w * rstd * m.g[i].w);
    return o; }
struct RowB8 { u32x2 v[4]; };
__device__ __forceinline__ RowB8 ld_rowb(const bf16_t* p, int lane) { RowB8 r;
#pragma unroll
    for (int i = 0; i < 4; ++i) r.v[i] = *(const u32x2*)(p + lane * 4 + 256 * i);
    return r; }
__device__ __forceinline__ Row16 cvt_rowb(const RowB8& b) { Row16 r;
#pragma unroll
    for (int i = 0; i < 4; ++i) r.v[i] = make_float4(__uint_as_float(b.v[i].x << 16), __uint_as_float(b.v[i].x & 0xFFFF0000u), __uint_as_float(b.v[i].y << 16), __uint_as_float(b.v[i].y & 0xFFFF0000u));
    return r; }

__device__ __forceinline__ void phase_norm1_l0(PRef p) {
    const int lane = threadIdx.x & 63, wave = threadIdx.x >> 6, G = gridDim.x, step = G * 8;
    bf16_t* HB = (bf16_t*)(p.ws + WS_HB);
    int r = blockIdx.x * 8 + wave;
    if (r >= NTOK) return;
    int cur_s = (r < CTXN) ? 1 : 0;
    const float* mod = mod_ptr(p, 0, r);
    ModAB m = load_ab(p.norm_g, mod + 1024, mod, lane);
    Row16 x = ld_row_f32(src_row(p, r), lane);
    for (; r < NTOK; r += step) {
        const int rn = r + step;
        Row16 xn = x;
        if (rn < NTOK) xn = ld_row_f32(src_row(p, rn), lane);
        const int s_ = (r < CTXN) ? 1 : 0;
        if (s_ != cur_s) { cur_s = s_; const float* md = mod_ptr(p, 0, r); m = load_ab(p.norm_g, md + 1024, md, lane); }
        const float rstd = row_rstd(x);
        st_row_bf16(HB + (size_t)r * 1024, lane, apply_ab(x, rstd, m));
        x = xn;
    }
}

__device__ __forceinline__ void phase_mid(PRef p, int l) {
    const int tid = tid_opaque(), lane = tid & 63, wave = tid >> 6, G = gridDim.x;
    float* wT = (float*)smem;
    int* lcnt = (int*)(smem + 139264);
    int* lbase = lcnt + 32;
    int* sel = lbase + 32;
    {
        const float4* src = (const float4*)((const float*)(p.ws + WS_RWT) + (size_t)l * 32 * 1024);
        for (int i = tid; i < 32 * 1024 / 4; i += NTH) ((float4*)wT)[i] = src[i];
        if (tid < 32) lcnt[tid] = 0;
    }
    __syncthreads();
    const int r_begin = (l == 0) ? 0 : CTXN;
    bf16_t* HB = (bf16_t*)(p.ws + WS_HB); const bf16_t* OB = (const bf16_t*)(p.ws + WS_OB);
    float* X1 = (float*)(p.ws + WS_X1); const float* X2 = (const float*)(p.ws + WS_X2);
    const float* ng = p.norm_g + (size_t)l * 4 * 1024;
    const float* rb = p.router_b + l * 32;
    float* GATE = (float*)(p.ws + WS_GATE);
    int it = 0;
    int r = r_begin + blockIdx.x * 8 + wave;
    const int step = G * 8;
    int cur_s = -1; ModG mg; ModAB mab;
    Row16 xin; RowB8 ob;
    if (r < NTOK) { xin = (l == 0) ? ld_row_f32(src_row(p, r), lane) : ld_row_f32(X2 + (size_t)r * 1024, lane); ob = ld_rowb(OB + (size_t)r * 1024, lane); }
    for (; r < NTOK; r += step, ++it) {
        const int rn = r + step;
        Row16 xin_n = xin; RowB8 ob_n = ob;
        if (rn < NTOK) { xin_n = (l == 0) ? ld_row_f32(src_row(p, rn), lane) : ld_row_f32(X2 + (size_t)rn * 1024, lane); ob_n = ld_rowb(OB + (size_t)rn * 1024, lane); }
        const int s_ = (r < CTXN) ? 1 : 0;
        if (s_ != cur_s) { cur_s = s_; const float* mod = mod_ptr(p, l, r); mg = load_g(ng + 1024, mod + 2048, lane); mab = load_ab(ng + 2048, mod + 4096, mod + 3072, lane); }
        const Row16 o = cvt_rowb(ob);
        const float rso = row_rstd(o);
        const Row16 x1 = apply_g(xin, o, rso, mg);
        st_row_f32(X1 + (size_t)r * 1024, lane, x1);
        const float rs1 = row_rstd(x1);
        const Row16 h = apply_ab(x1, rs1, mab);
        xin = xin_n; ob = ob_n;
        float part[32];
        {
            const float* wl = wT + lane * 4;
            float4 wa[4], wb[4];
#pragma unroll
            for (int i = 0; i < 4; ++i) wa[i] = *(const float4*)(wl + 256 * i);
#pragma unroll
            for (int e = 0; e < 32; e += 2) {
#pragma unroll
                for (int i = 0; i < 4; ++i) wb[i] = *(const float4*)(wl + (e + 1) * 1024 + 256 * i);
                { float a = 0.f;
#pragma unroll
                  for (int i = 0; i < 4; ++i) a += h.v[i].x * wa[i].x + h.v[i].y * wa[i].y + h.v[i].z * wa[i].z + h.v[i].w * wa[i].w;
                  part[e] = a; }
                if (e + 2 < 32) {
#pragma unroll
                    for (int i = 0; i < 4; ++i) wa[i] = *(const float4*)(wl + (e + 2) * 1024 + 256 * i);
                }
                { float a = 0.f;
#pragma unroll
                  for (int i = 0; i < 4; ++i) a += h.v[i].x * wb[i].x + h.v[i].y * wb[i].y + h.v[i].z * wb[i].z + h.v[i].w * wb[i].w;
                  part[e + 1] = a; }
            }
        }
        st_row_fp8((unsigned char*)HB + (size_t)r * 1024, lane, h);
#define TR_STEP(NV, BIT) _Pragma("unroll") for (int i = 0; i < (NV) / 2; ++i) { const float lo = part[i], hi_ = part[i + (NV) / 2]; const bool up = (lane & (BIT)) != 0; \
            const float send = up ? lo : hi_, keep = up ? hi_ : lo; part[i] = keep + __shfl_xor(send, (BIT)); }
        TR_STEP(32, 32) TR_STEP(16, 16) TR_STEP(8, 8) TR_STEP(4, 4) TR_STEP(2, 2)
#undef TR_STEP
        float logit = part[0] + __shfl_xor(part[0], 1);
        const int myexp = lane >> 1;
        logit += rb[myexp];
        float val = (lane & 1) ? -3.0e38f : logit;
        float tv[4]; int ti[4];
#pragma unroll
        for (int k = 0; k < 4; ++k) {
            float bv = val; int bi = myexp;
#pragma unroll
            for (int off = 32; off >= 1; off >>= 1) { const float ov = __shfl_xor(bv, off); const int oi = __shfl_xor(bi, off); if (ov > bv || (ov == bv && oi < bi)) { bv = ov; bi = oi; } }
            tv[k] = bv; ti[k] = bi;
            if (myexp == bi) val = -3.0e38f;
        }
        const float e1 = __expf(tv[1] - tv[0]), e2 = __expf(tv[2] - tv[0]), e3 = __expf(tv[3] - tv[0]);
        const float inv = 1.f / (1.f + e1 + e2 + e3);
        if (lane < 4) {
            const int k = lane;
            const int e = (k == 0) ? ti[0] : (k == 1) ? ti[1] : (k == 2) ? ti[2] : ti[3];
            const float gk = ((k == 0) ? 1.f : (k == 1) ? e1 : (k == 2) ? e2 : e3) * inv;
            GATE[(size_t)r * 4 + k] = gk;
            const int lp = atomicAdd(&lcnt[e], 1);
            sel[(it * 8 + wave) * 4 + k] = e | (lp << 8);
        }
    }
    __syncthreads();
    int* CNT = (int*)(p.ws + WS_CNT) + l * 32;
    if (tid < 32) lbase[tid] = atomicAdd(&CNT[tid], lcnt[tid]);
    __syncthreads();
    {
        int* TOPE = (int*)(p.ws + WS_TOPE); int* TOPP = (int*)(p.ws + WS_TOPP); int* LIST = (int*)(p.ws + WS_LIST);
        for (int q = tid; q < 80 * 4; q += NTH) {
            const int slot = q >> 2, k = q & 3, itq = slot >> 3, wv = slot & 7;
            const int r = r_begin + blockIdx.x * 8 + wv + itq * G * 8;
            if (r < NTOK) {
                const int s = sel[q], e = s & 255, lp = s >> 8, pos = lbase[e] + lp;
                TOPE[(size_t)r * 4 + k] = e; TOPP[(size_t)r * 4 + k] = pos; LIST[(size_t)e * NTOK + pos] = r;
            }
        }
    }
    __syncthreads();
}

struct MoeLds { int* cnt; int* off; int* toff; };
__device__ __forceinline__ MoeLds moe_setup(PRef p, int l, char* base) {
    MoeLds m; m.cnt = (int*)base; m.off = m.cnt + 32; m.toff = m.off + 33;
    const int tid = tid_opaque();
    if (tid < 64) {
        const int e = tid & 31;
        const int cval = ((const int*)(p.ws + WS_CNT))[l * 32 + e];
        const int tiles = (cval + 255) >> 8;
        int pc = cval, pt = tiles;
#pragma unroll
        for (int o = 1; o < 32; o <<= 1) { const int a = __shfl_up(pc, o, 32), b = __shfl_up(pt, o, 32); if (e >= o) { pc += a; pt += b; } }
        if (tid < 32) { m.cnt[e] = cval; m.off[e + 1] = pc; m.toff[e + 1] = pt; if (e == 0) { m.off[0] = 0; m.toff[0] = 0; } }
    }
    __syncthreads();
    return m;
}

__device__ __forceinline__ void phase_end(PRef p, int l) {
    const int tid = tid_opaque(), lane = tid & 63, wave = tid >> 6, G = gridDim.x;
    MoeLds ml = moe_setup(p, l, smem);
    const int r_begin = (l == 0) ? 0 : CTXN;
    const bf16_t* YB = (const bf16_t*)(p.ws + WS_YB);
    const float* X1 = (const float*)(p.ws + WS_X1); float* X2 = (float*)(p.ws + WS_X2);
    bf16_t* HB = (bf16_t*)(p.ws + WS_HB);
    const int* TOPE = (const int*)(p.ws + WS_TOPE); const int* TOPP = (const int*)(p.ws + WS_TOPP); const float* GATE = (const float*)(p.ws + WS_GATE);
    const float* ng = p.norm_g + (size_t)l * 4 * 1024;
    int cur_s = -1; ModG mg; ModAB mab;
    int r = r_begin + blockIdx.x * 8 + wave;
    int4 en = make_int4(0, 0, 0, 0), pn = make_int4(0, 0, 0, 0); float4 gn = make_float4(0.f, 0.f, 0.f, 0.f);
    const int step = G * 8;
    if (r < NTOK) { en = *(const int4*)(TOPE + (size_t)r * 4); pn = *(const int4*)(TOPP + (size_t)r * 4); gn = *(const float4*)(GATE + (size_t)r * 4); }
    RowB8 t4n[4]; Row16 x1n; float4 gcur = gn;
    if (r < NTOK) {
        t4n[0] = ld_rowb(YB + (size_t)(ml.off[en.x] + pn.x) * 1024, lane); t4n[1] = ld_rowb(YB + (size_t)(ml.off[en.y] + pn.y) * 1024, lane);
        t4n[2] = ld_rowb(YB + (size_t)(ml.off[en.z] + pn.z) * 1024, lane); t4n[3] = ld_rowb(YB + (size_t)(ml.off[en.w] + pn.w) * 1024, lane);
        x1n = ld_row_f32(X1 + (size_t)r * 1024, lane);
        if (r + step < NTOK) { en = *(const int4*)(TOPE + (size_t)(r + step) * 4); pn = *(const int4*)(TOPP + (size_t)(r + step) * 4); gn = *(const float4*)(GATE + (size_t)(r + step) * 4); }
    }
    for (; r < NTOK; r += step) {
        RowB8 t4[4]; t4[0] = t4n[0]; t4[1] = t4n[1]; t4[2] = t4n[2]; t4[3] = t4n[3];
        const Row16 x1 = x1n;
        const float g4[4] = {gcur.x, gcur.y, gcur.z, gcur.w};
        const int rn = r + step;
        if (rn < NTOK) {
            t4n[0] = ld_rowb(YB + (size_t)(ml.off[en.x] + pn.x) * 1024, lane); t4n[1] = ld_rowb(YB + (size_t)(ml.off[en.y] + pn.y) * 1024, lane);
            t4n[2] = ld_rowb(YB + (size_t)(ml.off[en.z] + pn.z) * 1024, lane); t4n[3] = ld_rowb(YB + (size_t)(ml.off[en.w] + pn.w) * 1024, lane);
            x1n = ld_row_f32(X1 + (size_t)rn * 1024, lane);
            gcur = gn;
            if (rn + step < NTOK) { en = *(const int4*)(TOPE + (size_t)(rn + step) * 4); pn = *(const int4*)(TOPP + (size_t)(rn + step) * 4); gn = *(const float4*)(GATE + (size_t)(rn + step) * 4); }
        }
        const int s_ = (r < CTXN) ? 1 : 0;
        if (s_ != cur_s) { cur_s = s_; const float* mod = mod_ptr(p, l, r); mg = load_g(ng + 3072, mod + 5120, lane);
            if (l == 0) { const float* mod1 = mod_ptr(p, 1, r); mab = load_ab(p.norm_g + (size_t)4 * 1024, mod1 + 1024, mod1, lane); } }
        Row16 y;
#pragma unroll
        for (int i = 0; i < 4; ++i) y.v[i] = make_float4(0.f, 0.f, 0.f, 0.f);
#pragma unroll
        for (int k = 0; k < 4; ++k) { const Row16 t = cvt_rowb(t4[k]); const float gk = g4[k];
#pragma unroll
            for (int i = 0; i < 4; ++i) { y.v[i].x += gk * t.v[i].x; y.v[i].y += gk * t.v[i].y; y.v[i].z += gk * t.v[i].z; y.v[i].w += gk * t.v[i].w; } }
        const float rsy = row_rstd(y);
        const Row16 x2 = apply_g(x1, y, rsy, mg);
        if (l == 0) {
            st_row_f32(X2 + (size_t)r * 1024, lane, x2);
            const float rs2 = row_rstd(x2);
            st_row_bf16(HB + (size_t)r * 1024, lane, apply_ab(x2, rs2, mab));
        } else {
            st_row_f32(p.out + (size_t)(r - CTXN) * 1024, lane, x2);
        }
    }
    __syncthreads();
}

__device__ __forceinline__ void phase_gemm_pg8(const bf16_t* A, int lda, const bf16_t* Bt, int K, bf16_t* C, int ldc, int nM, int nN) {
    pg8::PlainOrder S; S.init(A, lda, Bt, K, nM, nN);
    pg8::EpiStore E{C, ldc, nullptr};
    pg8::gemm_phase<pg8::EpiStore, pg8::PlainOrder, false>((PG8_LAS unsigned char*)smem, S, E, K, lda, K);
    __syncthreads();
}
constexpr int MOE_GL_OFF = 131072, MOE_ML_OFF = 143360, MOE_TAB_OFF = 143872, MOE_GL_MAX = 12;
__device__ __forceinline__ void phase_moe1(PRef p, int l) {
    MoeLds ml = moe_setup(p, l, smem + MOE_ML_OFF);
    const int tid = tid_opaque();
    PG8_LAS int* gl = (PG8_LAS int*)(smem + MOE_GL_OFF);
    PG8_LAS int* tab = (PG8_LAS int*)(smem + MOE_TAB_OFF);
    pg8::MoeOrderG S;
    S.A = (const char*)(p.ws + WS_HB); S.W = (const char*)(p.ws + WS_W1T) + (size_t)l * 32 * 2048 * 1024;
    S.tab = tab; S.gl = gl; S.wrows = 2048; S.list = (const int*)(p.ws + WS_LIST);
    S.nunits = pg8::moe_build_units(tab, ml.cnt, ml.off, ml.toff, 8);
    pg8::EpiAct E{(unsigned char*)(p.ws + WS_ACT), p.moe_b1 + (size_t)l * 32 * 2048, (unsigned char*)(p.ws + WS_DUMMY)};
    pg8::gemm_phase<pg8::EpiAct, pg8::MoeOrderG, true, true>((PG8_LAS unsigned char*)smem, S, E, 512, 512, 512, 0x7F7F7F7F, 0x79797979);
    __syncthreads();
}
__device__ __forceinline__ void phase_moe2(PRef p, int l) {
    MoeLds ml = moe_setup(p, l, smem + MOE_ML_OFF);
    PG8_LAS int* tab = (PG8_LAS int*)(smem + MOE_TAB_OFF);
    pg8::MoeOrderI S;
    S.A = (const char*)(p.ws + WS_ACT); S.W = (const char*)(p.ws + WS_W2T) + (size_t)l * 32 * 1024 * 1024;
    S.tab = tab; S.gl = nullptr; S.wrows = 1024;
    S.nunits = pg8::moe_build_units(tab, ml.cnt, ml.off, ml.toff, 4);
    pg8::EpiBias E{(bf16_t*)(p.ws + WS_YB), p.moe_b2 + (size_t)l * 32 * 1024, (bf16_t*)(p.ws + WS_DUMMY)};
    pg8::gemm_phase<pg8::EpiBias, pg8::MoeOrderI, true, true>((PG8_LAS unsigned char*)smem, S, E, 512, 512, 512, 0x7D7D7D7D, 0x79797979);
    __syncthreads();
}

__device__ __forceinline__ void gla_local_units(PRef p);
__device__ __forceinline__ void rope8(const float* rope, int t, int j0, const u32x4& a, const u32x4& b, u32x4& oa, u32x4& ob);
__device__ __forceinline__ void rowstat(const bf16_t* A, int lda, int K, float* rs) {
    const int tid = tid_opaque(), r = tid >> 1, hf = tid & 1, half = K / 2;
    const bf16_t* q = A + (size_t)r * lda + hf * half;
    float s = 0.f;
    for (int i = 0; i < half; i += 8) { const u32x4 w = *(const u32x4*)(q + i);
#pragma unroll
        for (int j = 0; j < 4; ++j) { const float a = __uint_as_float(w[j] << 16), b = __uint_as_float(w[j] & 0xFFFF0000u); s += a * a + b * b; } }
    s += __shfl_xor(s, 1);
    if (hf == 0) rs[r] = rsqrtf(s / (float)K + EPSN);
    __syncthreads();
}
__device__ __forceinline__ void phase_mla_up(PRef p) {
    const int G = gridDim.x, tid = threadIdx.x;
    const bf16_t* P = (const bf16_t*)(p.ws + WS_P);
    float* rs = (float*)(smem + 139264);
    const int nM = NTOK / 256;
    {
        pg8::PlainOrder S; S.init(P + PC_CQ, PW, (const bf16_t*)(p.ws + WS_WUQ), 256, nM, 3);
        pg8::Unit u;
        if (S.next(0, u)) rowstat(P + (size_t)u.pm * 256 * PW + PC_CQ, PW, 256, rs);
        pg8::EpiStore E{(bf16_t*)(p.ws + WS_QM), 768, rs};
        pg8::gemm_phase<pg8::EpiStore, pg8::PlainOrder, false>((PG8_LAS unsigned char*)smem, S, E, 256, PW, 256);
        __syncthreads();
    }
    for (int v = (blockIdx.x + G - 195) % G; v < nM * 8; v += G) {
        int aoff[2][2], boff[2];
        const int pm = v >> 3, pn = v & 7, h = pn >> 1;
        rowstat(P + (size_t)pm * 256 * PW + PC_CKV, PW, 128, rs);
        gm::make_off(aoff, pm * 256, PW); gm::make_off1(boff, pn * 128, 128);
        bf16_t* dst = (pn & 1) ? (bf16_t*)(p.ws + WS_VM) + (size_t)pm * 256 * 512 + h * 128 : (bf16_t*)(p.ws + WS_KM) + (size_t)pm * 256 * 768 + h * 192;
        EpiRowScale epi{dst, (pn & 1) ? 512 : 768, rs};
        gm::gemm_tile(P + PC_CKV, aoff, (const bf16_t*)(p.ws + WS_WUKV), boff, 2, epi);
    }
    const float* rope = (const float*)(p.ws + WS_ROPE);
    bf16_t* KM = (bf16_t*)(p.ws + WS_KM);
    for (int i = blockIdx.x * NTH + tid; i < NTOK * 4; i += G * NTH) {
        const int r = i >> 2, j0 = (i & 3) * 8;
        const u32x4 a = *(const u32x4*)(P + (size_t)r * PW + PC_KR + j0), b = *(const u32x4*)(P + (size_t)r * PW + PC_KR + 32 + j0);
        u32x4 oa = a, ob = b;
        if (r >= CTXN) rope8(rope, r - CTXN, j0, a, b, oa, ob);
#pragma unroll
        for (int h = 0; h < 4; ++h) { *(u32x4*)(KM + (size_t)r * 768 + h * 192 + 128 + j0) = oa; *(u32x4*)(KM + (size_t)r * 768 + h * 192 + 160 + j0) = ob; }
    }
    __syncthreads();
    gla_local_units(p);
}

struct GlaB { float b[16]; float total; };
__device__ __forceinline__ GlaB gla_decay(PRef p, int gc, int h, float* scr  ) {
    const int tid = threadIdx.x, lane = tid & 63, wave = tid >> 6, dir = wave & 1, tq = wave >> 1;
    const bf16_t* P = (const bf16_t*)(p.ws + WS_P);
    float* af = scr;
    float* wa = scr + 2048;
    float* ba = scr + 4096;
    float* tot = scr + 4224;
#pragma unroll
    for (int i = 0; i < 4; ++i) {
        const int idx = tid + 512 * i, dd = idx >> 10, t = (idx >> 4) & 63, j = idx & 15;
        af[idx] = bf2f(P[(size_t)(gc * 64 + t) * PW + PC_AF + dd * 16 + j]);
        const int jj = (idx >> 6) & 15, d = idx & 63;
        wa[idx] = (dd == 0 ? p.gla_wa_f : p.gla_wa_b)[jj * 256 + h * 64 + d];
    }
    if (tid < 128) ba[tid] = ((tid >> 6) == 0 ? p.gla_ba_f : p.gla_ba_b)[h * 64 + (tid & 63)];
    __syncthreads();
    float w[16];
#pragma unroll
    for (int j = 0; j < 16; ++j) w[j] = wa[(dir * 16 + j) * 64 + lane];
    const float bias = ba[dir * 64 + lane];
    GlaB r;
#pragma unroll
    for (int i = 0; i < 16; ++i) {
        const int t = tq * 16 + i;
        float z = bias;
#pragma unroll
        for (int j = 0; j < 16; ++j) z += af[(dir * 64 + t) * 16 + j] * w[j];
        const float g = (fminf(z, 0.f) - __logf(1.f + __expf(-fabsf(z)))) * (1.f / 16.f);
        r.b[i] = g;
    }
    if (dir == 0) {
#pragma unroll
        for (int i = 1; i < 16; ++i) r.b[i] += r.b[i - 1];
        tot[(dir * 4 + tq) * 64 + lane] = r.b[15];
    } else {
#pragma unroll
        for (int i = 14; i >= 0; --i) r.b[i] += r.b[i + 1];
        tot[(dir * 4 + tq) * 64 + lane] = r.b[0];
    }
    __syncthreads();
    float offs = 0.f, total = 0.f;
#pragma unroll
    for (int q = 0; q < 4; ++q) { const float tv = tot[(dir * 4 + q) * 64 + lane]; total += tv; if (dir == 0 ? (q < tq) : (q > tq)) offs += tv; }
#pragma unroll
    for (int i = 0; i < 16; ++i) r.b[i] += offs;
    r.total = total;
    return r;
}

__device__ __forceinline__ void gla_stage_vt(const bf16_t* P, int gc, int h, bf16_t* VT) {
    const int tid = threadIdx.x, v = tid & 127, sq = tid >> 7;
    unsigned pk[8];
#pragma unroll
    for (int i = 0; i < 8; ++i) {
        const bf16_t a = P[(size_t)(gc * 64 + sq * 16 + 2 * i) * PW + PC_V + h * 128 + v], b = P[(size_t)(gc * 64 + sq * 16 + 2 * i + 1) * PW + PC_V + h * 128 + v];
        pk[i] = a | ((unsigned)b << 16);
    }
    *(u32x4*)(VT + v * 72 + sq * 16) = (u32x4){pk[0], pk[1], pk[2], pk[3]};
    *(u32x4*)(VT + v * 72 + sq * 16 + 8) = (u32x4){pk[4], pk[5], pk[6], pk[7]};
}

struct GlaPreL { u32x4 kc, vc[2], ac; float4 wac; float bac; };
__device__ __forceinline__ void gla_prefetch_local(PRef p, int gc, int h, GlaPreL& g) {
    const int tid = threadIdx.x;
    const bf16_t* P = (const bf16_t*)(p.ws + WS_P);
    g.kc = *(const u32x4*)(P + (size_t)(gc * 64 + (tid >> 3)) * PW + PC_K + h * 64 + (tid & 7) * 8);
#pragma unroll
    for (int i = 0; i < 2; ++i) { const int idx = tid + 512 * i; g.vc[i] = *(const u32x4*)(P + (size_t)(gc * 64 + (idx >> 4)) * PW + PC_V + h * 128 + (idx & 15) * 8); }
    g.ac = *(const u32x4*)(P + (size_t)(gc * 64 + ((tid & 255) >> 2)) * PW + PC_AF + (tid & 3) * 8);
    { const int dd = tid >> 8, jj = (tid >> 4) & 15, d4 = tid & 15; g.wac = *(const float4*)((dd == 0 ? p.gla_wa_f : p.gla_wa_b) + jj * 256 + h * 64 + d4 * 4); }
    g.bac = ((tid >> 6) & 1 ? p.gla_ba_b : p.gla_ba_f)[h * 64 + (tid & 63)];
}
template <int OFF> __device__ __forceinline__ s16x4 glal_tr(int vb) { s16x4 r; asm volatile("ds_read_b64_tr_b16 %0, %1 offset:%2" : "=&v"(r) : "v"(vb), "i"(OFF) : "memory"); return r; }
__device__ __forceinline__ void gla_local_units(PRef p) {
    const int tid = threadIdx.x, lane = tid & 63, wave = tid >> 6, r32 = lane & 31, hi = lane >> 5, G = gridDim.x;
    bf16_t* kdT = (bf16_t*)smem;
    bf16_t* Kraw = kdT + 2 * 64 * 72;
    char* Vraw = smem + 27648;
    float* af = (float*)(smem + 49152);
    float* wa = af + 2048; float* ba = wa + 2048; float* tot = ba + 128;
    bf16_t* U = (bf16_t*)(p.ws + WS_U); float* DEC = (float*)(p.ws + WS_DEC);
    int u = blockIdx.x;
    if (u >= NCH * 4) return;
    GlaPreL g;
    gla_prefetch_local(p, u >> 2, u & 3, g);
    const int dir = wave & 1, tq = wave >> 1;
    for (; u < NCH * 4; u += G) {
        const int gc = u >> 2, h = u & 3;
        *(u32x4*)(Kraw + (tid >> 3) * 72 + (tid & 7) * 8) = g.kc;
#pragma unroll
        for (int i = 0; i < 2; ++i) { const int idx = tid + 512 * i; *(u32x4*)(Vraw + (idx >> 4) * 320 + (idx & 15) * 16) = g.vc[i]; }
        if (tid < 256) { const int t = tid >> 2, ch = tid & 3, dd = ch >> 1, j0 = (ch & 1) * 8; float* q = af + dd * 1024 + t * 16 + j0;
#pragma unroll
            for (int e = 0; e < 4; ++e) { q[2 * e] = __uint_as_float(g.ac[e] << 16); q[2 * e + 1] = __uint_as_float(g.ac[e] & 0xFFFF0000u); } }
        { const int dd = tid >> 8, jj = (tid >> 4) & 15, d4 = tid & 15; *(float4*)(wa + (dd * 16 + jj) * 64 + d4 * 4) = g.wac; }
        if (tid < 128) ba[tid] = g.bac;
        __syncthreads();
        const int un = u + G;
        if (un < NCH * 4) gla_prefetch_local(p, un >> 2, un & 3, g);
        float bb[16]; float total = 0.f;
        {
            float w[16];
#pragma unroll
            for (int j = 0; j < 16; ++j) w[j] = wa[(dir * 16 + j) * 64 + lane];
            const float bias = ba[dir * 64 + lane];
#pragma unroll
            for (int i = 0; i < 16; ++i) {
                const int t = tq * 16 + i;
                float z = bias;
#pragma unroll
                for (int j = 0; j < 16; ++j) z += af[(dir * 64 + t) * 16 + j] * w[j];
                bb[i] = (fminf(z, 0.f) - __logf(1.f + __expf(-fabsf(z)))) * (1.f / 16.f);
            }
            if (dir == 0) {
#pragma unroll
                for (int i = 1; i < 16; ++i) bb[i] += bb[i - 1];
                tot[(dir * 4 + tq) * 64 + lane] = bb[15];
            } else {
#pragma unroll
                for (int i = 14; i >= 0; --i) bb[i] += bb[i + 1];
                tot[(dir * 4 + tq) * 64 + lane] = bb[0];
            }
        }
        __syncthreads();
        {
            float offs = 0.f;
#pragma unroll
            for (int q = 0; q < 4; ++q) { const float tv = tot[(dir * 4 + q) * 64 + lane]; total += tv; if (dir == 0 ? (q < tq) : (q > tq)) offs += tv; }
#pragma unroll
            for (int i = 0; i < 16; ++i) bb[i] += offs;
        }
        {
            unsigned pk[8];
#pragma unroll
            for (int i = 0; i < 8; ++i) {
                const int s0 = tq * 16 + 2 * i;
                const float k0 = bf2f(Kraw[s0 * 72 + lane]), k1 = bf2f(Kraw[(s0 + 1) * 72 + lane]);
                pk[i] = cvtpk(k0 * __expf(total - bb[2 * i]), k1 * __expf(total - bb[2 * i + 1]));
            }
            *(u32x4*)(kdT + (dir * 64 + lane) * 72 + tq * 16) = (u32x4){pk[0], pk[1], pk[2], pk[3]};
            *(u32x4*)(kdT + (dir * 64 + lane) * 72 + tq * 16 + 8) = (u32x4){pk[4], pk[5], pk[6], pk[7]};
            if (tq == 0) DEC[((size_t)(dir * NCH + gc) * 4 + h) * 64 + lane] = __expf(total);
        }
        __syncthreads();
        {
            const int mdir = wave >> 2, vbk = wave & 3;
            const int vb = (int)(uintptr_t)Vraw + (8 * hi + ((lane & 15) >> 2)) * 320 + (vbk * 32 + 16 * ((lane >> 4) & 1) + 4 * (lane & 3)) * 2;
            f32x16 a0 = {}, a1 = {};
#define GLAL_STEP(KS) do { const s16x4 l_ = glal_tr<(KS) * 5120>(vb), h_ = glal_tr<(KS) * 5120 + 1280>(vb); \
            const bf16x8 b0 = *(const bf16x8*)(kdT + (mdir * 64 + r32) * 72 + (KS) * 16 + hi * 8); \
            const bf16x8 b1 = *(const bf16x8*)(kdT + (mdir * 64 + 32 + r32) * 72 + (KS) * 16 + hi * 8); \
            asm volatile("s_waitcnt lgkmcnt(0)" ::: "memory"); SBAR(); \
            const bf16x8 a_ = (bf16x8){l_[0], l_[1], l_[2], l_[3], h_[0], h_[1], h_[2], h_[3]}; \
            a0 = __builtin_amdgcn_mfma_f32_32x32x16_bf16(a_, b0, a0, 0, 0, 0); a1 = __builtin_amdgcn_mfma_f32_32x32x16_bf16(a_, b1, a1, 0, 0, 0); } while (0)
            GLAL_STEP(0); GLAL_STEP(1); GLAL_STEP(2); GLAL_STEP(3);
#undef GLAL_STEP
            bf16_t* Uo = U + ((size_t)(mdir * NCH + gc) * 4 + h) * 8192;
#pragma unroll
            for (int r = 0; r < 16; ++r) { const int v = vbk * 32 + crow(r, hi); Uo[v * 64 + r32] = f2bf(a0[r]); Uo[v * 64 + 32 + r32] = f2bf(a1[r]); }
        }
        __syncthreads();
    }
}
__device__ __forceinline__ void rope8(const float* rope, int t, int j0, const u32x4& a, const u32x4& b, u32x4& oa, u32x4& ob) {
    const int row = t >> 6, col = t & 63;
    const float* cs = (j0 < 16) ? rope + row * 16 + j0 : rope + 512 * 16 + col * 16 + (j0 - 16);
    const float* sn = (j0 < 16) ? rope + 256 * 16 + row * 16 + j0 : rope + 512 * 16 + 64 * 16 + col * 16 + (j0 - 16);
    const f32x4 c0 = *(const f32x4*)cs, c1 = *(const f32x4*)(cs + 4), s0 = *(const f32x4*)sn, s1 = *(const f32x4*)(sn + 4);
#pragma unroll
    for (int e = 0; e < 4; ++e) {
        const float x1l = __uint_as_float(a[e] << 16), x1h = __uint_as_float(a[e] & 0xFFFF0000u), x2l = __uint_as_float(b[e] << 16), x2h = __uint_as_float(b[e] & 0xFFFF0000u);
        const float cl = (e < 2) ? c0[2 * e] : c1[2 * e - 4], ch = (e < 2) ? c0[2 * e + 1] : c1[2 * e - 3], sl = (e < 2) ? s0[2 * e] : s1[2 * e - 4], sh = (e < 2) ? s0[2 * e + 1] : s1[2 * e - 3];
        oa[e] = cvtpk(x1l * cl - x2l * sl, x1h * ch - x2h * sh);
        ob[e] = cvtpk(x1l * sl + x2l * cl, x1h * sh + x2h * ch);
    }
}
__device__ __forceinline__ u32x4 cvt16_fp8(const u32x4& a, const u32x4& b) {
    u32x4 o;
#pragma unroll
    for (int j = 0; j < 2; ++j) {
        o[j] = pk4_fp8(__uint_as_float(a[2 * j] << 16), __uint_as_float(a[2 * j] & 0xFFFF0000u), __uint_as_float(a[2 * j + 1] << 16), __uint_as_float(a[2 * j + 1] & 0xFFFF0000u));
        o[2 + j] = pk4_fp8(__uint_as_float(b[2 * j] << 16), __uint_as_float(b[2 * j] & 0xFFFF0000u), __uint_as_float(b[2 * j + 1] << 16), __uint_as_float(b[2 * j + 1] & 0xFFFF0000u));
    }
    return o;
}
constexpr float MLA_QS = 8.f * 0.07216878364870322f * 1.4426950408889634f;
__device__ __forceinline__ u32x4 cvt16_fp8s(const u32x4& a, const u32x4& b, float sc) {
    u32x4 o;
#pragma unroll
    for (int j = 0; j < 2; ++j) {
        o[j] = pk4_fp8(__uint_as_float(a[2 * j] << 16) * sc, __uint_as_float(a[2 * j] & 0xFFFF0000u) * sc, __uint_as_float(a[2 * j + 1] << 16) * sc, __uint_as_float(a[2 * j + 1] & 0xFFFF0000u) * sc);
        o[2 + j] = pk4_fp8(__uint_as_float(b[2 * j] << 16) * sc, __uint_as_float(b[2 * j] & 0xFFFF0000u) * sc, __uint_as_float(b[2 * j + 1] << 16) * sc, __uint_as_float(b[2 * j + 1] & 0xFFFF0000u) * sc);
    }
    return o;
}
__device__ __forceinline__ u32x2 cvt8_fp8s(const u32x4& a, float sc) { return (u32x2){pk4_fp8(__uint_as_float(a[0] << 16) * sc, __uint_as_float(a[0] & 0xFFFF0000u) * sc, __uint_as_float(a[1] << 16) * sc, __uint_as_float(a[1] & 0xFFFF0000u) * sc),
                                                                                 pk4_fp8(__uint_as_float(a[2] << 16) * sc, __uint_as_float(a[2] & 0xFFFF0000u) * sc, __uint_as_float(a[3] << 16) * sc, __uint_as_float(a[3] & 0xFFFF0000u) * sc)}; }
__device__ __forceinline__ u32x2 cvt8_fp8(const u32x4& a) { return (u32x2){pk4_fp8(__uint_as_float(a[0] << 16), __uint_as_float(a[0] & 0xFFFF0000u), __uint_as_float(a[1] << 16), __uint_as_float(a[1] & 0xFFFF0000u)),
                                                                       pk4_fp8(__uint_as_float(a[2] << 16), __uint_as_float(a[2] & 0xFFFF0000u), __uint_as_float(a[3] << 16), __uint_as_float(a[3] & 0xFFFF0000u))}; }
__device__ __forceinline__ void mla_pack_pass(PRef p, int b0, int nb) {
    const int tid = threadIdx.x, gt = (blockIdx.x - b0) * NTH + tid, gn = nb * NTH;
    const float* rope = (const float*)(p.ws + WS_ROPE);
    const bf16_t* QM = (const bf16_t*)(p.ws + WS_QM); const bf16_t* KM = (const bf16_t*)(p.ws + WS_KM); const bf16_t* VM = (const bf16_t*)(p.ws + WS_VM);
    unsigned char* Q8 = (unsigned char*)(p.ws + WS_Q8); unsigned char* K8 = (unsigned char*)(p.ws + WS_K8); unsigned char* VT8 = (unsigned char*)(p.ws + WS_VT8);
    for (int i = gt; i < NTOK * 48; i += gn) {
        const int r = i / 48, q = i % 48, hh = q / 12, c = q % 12;
        const bf16_t* qs = QM + (size_t)r * 768 + hh * 192; const bf16_t* ks = KM + (size_t)r * 768 + hh * 192;
        unsigned char* qd = Q8 + (size_t)r * 768 + hh * 192; unsigned char* kd = K8 + ((size_t)hh * NTOK + r) * 192;
        if (c < 8) {
            *(u32x4*)(qd + c * 16) = cvt16_fp8s(*(const u32x4*)(qs + c * 16), *(const u32x4*)(qs + c * 16 + 8), MLA_QS);
            *(u32x4*)(kd + c * 16) = cvt16_fp8(*(const u32x4*)(ks + c * 16), *(const u32x4*)(ks + c * 16 + 8));
        } else {
            const int j0 = (c - 8) * 8;
            const u32x4 a = *(const u32x4*)(qs + 128 + j0), b = *(const u32x4*)(qs + 160 + j0);
            u32x4 oa = a, ob = b;
            if (r >= CTXN) rope8(rope, r - CTXN, j0, a, b, oa, ob);
            *(u32x2*)(qd + 128 + j0) = cvt8_fp8s(oa, MLA_QS); *(u32x2*)(qd + 160 + j0) = cvt8_fp8s(ob, MLA_QS);
            *(u32x2*)(kd + 128 + j0) = cvt8_fp8(*(const u32x4*)(ks + 128 + j0)); *(u32x2*)(kd + 160 + j0) = cvt8_fp8(*(const u32x4*)(ks + 160 + j0));
        }
    }
    {
        const int lane = tid & 63, g = lane >> 4, dq = lane & 15;
        for (int u = gt >> 6; u < 4 * NCH; u += gn >> 6) {
            const int hh = u / NCH, t = u % NCH;
            const bf16_t* vs = VM + (size_t)(t * 64 + 16 * g) * 512 + hh * 128 + dq * 8;
            u32x4 w[16];
#pragma unroll
            for (int i = 0; i < 16; ++i) w[i] = *(const u32x4*)(vs + (size_t)i * 512);
            unsigned char* dst = VT8 + ((size_t)u * 128 + dq * 8) * 64 + 8 * g;
#pragma unroll
            for (int d = 0; d < 8; ++d) {
                float f[16];
#pragma unroll
                for (int i = 0; i < 16; ++i) f[i] = (d & 1) ? __uint_as_float(w[i][d >> 1] & 0xFFFF0000u) : __uint_as_float(w[i][d >> 1] << 16);
                *(u32x2*)(dst + d * 64) = (u32x2){pk4_fp8(f[0], f[1], f[2], f[3]), pk4_fp8(f[8], f[9], f[10], f[11])};
                *(u32x2*)(dst + d * 64 + 32) = (u32x2){pk4_fp8(f[4], f[5], f[6], f[7]), pk4_fp8(f[12], f[13], f[14], f[15])};
            }
        }
    }
}

__device__ __forceinline__ int gla_order(int dir, int step) { return dir == 0 ? step : (step < 4 ? 3 - step : NCH - 1 - (step - 4)); }
__device__ __forceinline__ void phase_gla_scan(PRef p) {
    const int gid = blockIdx.x * NTH + threadIdx.x;
    if (gid >= 2 * 4 * 8192) { mla_pack_pass(p, 128, (int)gridDim.x - 128); return; }
    const int dir = gid >> 15, h = (gid >> 13) & 3, e = gid & 8191, d = e & 63;
    const bf16_t* U = (const bf16_t*)(p.ws + WS_U); bf16_t* S = (bf16_t*)(p.ws + WS_SIN); const float* DEC = (const float*)(p.ws + WS_DEC);
    float s = 0.f;
#pragma unroll 1
    for (int s0 = 0; s0 < NCH; s0 += 52) {
        float uu[52], dc[52];
#pragma unroll
        for (int i = 0; i < 52; ++i) { const size_t o = ((size_t)(dir * NCH + gla_order(dir, s0 + i)) * 4 + h); uu[i] = bf2f(U[o * 8192 + e]); dc[i] = DEC[o * 64 + d]; }
#pragma unroll
        for (int i = 0; i < 52; ++i) { const size_t o = ((size_t)(dir * NCH + gla_order(dir, s0 + i)) * 4 + h); S[o * 8192 + e] = f2bf(s); s = dc[i] * s + uu[i]; }
    }
}

__device__ __forceinline__ void gla_out_unit(PRef p, int gc, int h) {
    const int tid = threadIdx.x, lane = tid & 63, wave = tid >> 6, r32 = lane & 31, hi = lane >> 5;
    const bf16_t* P = (const bf16_t*)(p.ws + WS_P);
    bf16_t* qe = (bf16_t*)smem;
    bf16_t* ke = qe + 2 * 64 * 72;
    bf16_t* Am = ke + 2 * 64 * 72;
    bf16_t* VT = Am + 2 * 64 * 72;
    bf16_t* ST = VT + 128 * 72;
    float* scr = (float*)(smem + 110592);
    float* ob = (float*)(ke);
    const GlaB gb = gla_decay(p, gc, h, scr);
    {
        const int dir = wave & 1, tq = wave >> 1;
#pragma unroll
        for (int i = 0; i < 16; ++i) {
            const int t = tq * 16 + i;
            const float qv = bf2f(P[(size_t)(gc * 64 + t) * PW + PC_Q + h * 64 + lane]) * 0.125f, kv = bf2f(P[(size_t)(gc * 64 + t) * PW + PC_K + h * 64 + lane]);
            qe[(dir * 64 + t) * 72 + lane] = f2bf(qv * __expf(gb.b[i]));
            ke[(dir * 64 + t) * 72 + lane] = f2bf(kv * __expf(-gb.b[i]));
        }
    }
    gla_stage_vt(P, gc, h, VT);
    {
        const bf16_t* S = (const bf16_t*)(p.ws + WS_SIN);
#pragma unroll
        for (int i = 0; i < 4; ++i) {
            const int cc = tid + 512 * i, dir = cc >> 10, v = (cc >> 3) & 127, ch = cc & 7;
            *(u32x4*)(ST + (dir * 128 + v) * 72 + ch * 8) = *(const u32x4*)(S + ((size_t)(dir * NCH + gc) * 4 + h) * 8192 + v * 64 + ch * 8);
        }
    }
    __syncthreads();
    {
        const int dir = wave >> 2, tb = (wave >> 1) & 1, sb = wave & 1;
        f32x16 acc = {};
#pragma unroll
        for (int ks = 0; ks < 4; ++ks) {
            const bf16x8 a = *(const bf16x8*)(qe + (dir * 64 + tb * 32 + r32) * 72 + ks * 16 + hi * 8);
            const bf16x8 b = *(const bf16x8*)(ke + (dir * 64 + sb * 32 + r32) * 72 + ks * 16 + hi * 8);
            acc = __builtin_amdgcn_mfma_f32_32x32x16_bf16(a, b, acc, 0, 0, 0);
        }
        const int s = sb * 32 + r32;
#pragma unroll
        for (int r = 0; r < 16; ++r) { const int t = tb * 32 + crow(r, hi); const bool keep = (dir == 0) ? (s <= t) : (s >= t); Am[(dir * 64 + t) * 72 + s] = f2bf(keep ? acc[r] : 0.f); }
    }
    __syncthreads();
    f32x16 o = {};
    const int tb = wave >> 2, vb = wave & 3;
#pragma unroll
    for (int dir = 0; dir < 2; ++dir)
#pragma unroll
        for (int ks = 0; ks < 4; ++ks) {
            const bf16x8 a1 = *(const bf16x8*)(Am + (dir * 64 + tb * 32 + r32) * 72 + ks * 16 + hi * 8);
            const bf16x8 b1 = *(const bf16x8*)(VT + (vb * 32 + r32) * 72 + ks * 16 + hi * 8);
            o = __builtin_amdgcn_mfma_f32_32x32x16_bf16(a1, b1, o, 0, 0, 0);
            const bf16x8 a2 = *(const bf16x8*)(qe + (dir * 64 + tb * 32 + r32) * 72 + ks * 16 + hi * 8);
            const bf16x8 b2 = *(const bf16x8*)(ST + (dir * 128 + vb * 32 + r32) * 72 + ks * 16 + hi * 8);
            o = __builtin_amdgcn_mfma_f32_32x32x16_bf16(a2, b2, o, 0, 0, 0);
        }
    __syncthreads();
#pragma unroll
    for (int r = 0; r < 16; ++r) ob[(tb * 32 + crow(r, hi)) * 132 + vb * 32 + r32] = o[r];
    __syncthreads();
    {
        const int t = tid >> 3, v0 = (tid & 7) * 16;
        float vals[16]; float ss = 0.f;
#pragma unroll
        for (int i = 0; i < 16; ++i) { vals[i] = ob[t * 132 + v0 + i]; ss += vals[i] * vals[i]; }
        ss += __shfl_xor(ss, 1); ss += __shfl_xor(ss, 2); ss += __shfl_xor(ss, 4);
        const float rstd = rsqrtf(ss * (1.f / 128.f) + EPSN);
        const size_t row = (size_t)gc * 64 + t;
        unsigned pk[8];
#pragma unroll
        for (int i = 0; i < 8; ++i) {
            const float r0 = bf2f(P[row * PW + PC_R + h * 128 + v0 + 2 * i]), r1 = bf2f(P[row * PW + PC_R + h * 128 + v0 + 2 * i + 1]);
            pk[i] = cvtpk(vals[2 * i] * rstd * p.gla_onorm[v0 + 2 * i] * silu_f(r0), vals[2 * i + 1] * rstd * p.gla_onorm[v0 + 2 * i + 1] * silu_f(r1));
        }
        bf16_t* M = (bf16_t*)(p.ws + WS_MIX) + row * 1024 + h * 128 + v0;
        *(u32x4*)M = (u32x4){pk[0], pk[1], pk[2], pk[3]}; *(u32x4*)(M + 8) = (u32x4){pk[4], pk[5], pk[6], pk[7]};
    }
    __syncthreads();
}


struct GlaPre { u32x4 qc, kc, vc[2], ac, sc[4]; float4 wac; float bac; };
__device__ __forceinline__ void gla_prefetch(PRef p, int gc, int h, GlaPre& g, u32x4 (&rc)[2]) {
    const int tid = threadIdx.x;
    const bf16_t* P = (const bf16_t*)(p.ws + WS_P);
    const bf16_t* rowp = P + (size_t)(gc * 64 + (tid >> 3)) * PW;
    g.qc = *(const u32x4*)(rowp + PC_Q + h * 64 + (tid & 7) * 8);
    g.kc = *(const u32x4*)(rowp + PC_K + h * 64 + (tid & 7) * 8);
#pragma unroll
    for (int i = 0; i < 2; ++i) { const int idx = tid + 512 * i; g.vc[i] = *(const u32x4*)(P + (size_t)(gc * 64 + (idx >> 4)) * PW + PC_V + h * 128 + (idx & 15) * 8); }
#pragma unroll
    for (int i = 0; i < 2; ++i) rc[i] = *(const u32x4*)(rowp + PC_R + h * 128 + (tid & 7) * 16 + 8 * i);
    g.ac = *(const u32x4*)(P + (size_t)(gc * 64 + ((tid & 255) >> 2)) * PW + PC_AF + (tid & 3) * 8);
    const bf16_t* S = (const bf16_t*)(p.ws + WS_SIN);
#pragma unroll
    for (int i = 0; i < 4; ++i) { const int cc = tid + 512 * i, dir = cc >> 10; g.sc[i] = *(const u32x4*)(S + ((size_t)(dir * NCH + gc) * 4 + h) * 8192 + (cc & 1023) * 8); }
    { const int dd = tid >> 8, jj = (tid >> 4) & 15, d4 = tid & 15; g.wac = *(const float4*)((dd == 0 ? p.gla_wa_f : p.gla_wa_b) + jj * 256 + h * 64 + d4 * 4); }
    g.bac = ((tid >> 6) & 1 ? p.gla_ba_b : p.gla_ba_f)[h * 64 + (tid & 63)];
}
template <int OFF> __device__ __forceinline__ s16x4 gla_tr(int vb) { s16x4 r; asm volatile("ds_read_b64_tr_b16 %0, %1 offset:%2" : "=&v"(r) : "v"(vb), "i"(OFF) : "memory"); return r; }
__device__ __forceinline__ void phase_gla_out(PRef p) {
    const int tid = threadIdx.x, lane = tid & 63, wave = tid >> 6, r32 = lane & 31, hi = lane >> 5, G = gridDim.x;
    bf16_t* qe = (bf16_t*)smem;
    bf16_t* ke = qe + 2 * 64 * 72;
    bf16_t* Am = ke + 2 * 64 * 72;
    bf16_t* Qraw = Am; bf16_t* Kraw = Am + 64 * 72;
    char* Vraw = smem + 55296;
    bf16_t* ST = (bf16_t*)(smem + 75776);
    float* af = (float*)(smem + 112640);
    float* wa = af + 2048;
    float* ba = wa + 2048;
    float* tot = ba + 128;
    float* ob = (float*)ke;
    int u = blockIdx.x;
    if (u >= NCH * 4) return;
    const int nt_t = tid >> 3, nt_v0 = (tid & 7) * 16;
    float on[16];
#pragma unroll
    for (int i = 0; i < 16; ++i) on[i] = p.gla_onorm[nt_v0 + i];
    GlaPre g; u32x4 rc[2], rcn[2];
    gla_prefetch(p, u >> 2, u & 3, g, rc);
    const int dir = wave & 1, tq = wave >> 1;
    for (; u < NCH * 4; u += G) {
        const int gc = u >> 2, h = u & 3;
        *(u32x4*)(Qraw + (tid >> 3) * 72 + (tid & 7) * 8) = g.qc;
        *(u32x4*)(Kraw + (tid >> 3) * 72 + (tid & 7) * 8) = g.kc;
#pragma unroll
        for (int i = 0; i < 2; ++i) { const int idx = tid + 512 * i; *(u32x4*)(Vraw + (idx >> 4) * 320 + (idx & 15) * 16) = g.vc[i]; }
#pragma unroll
        for (int i = 0; i < 4; ++i) { const int cc = tid + 512 * i; *(u32x4*)(ST + ((cc >> 10) * 128 + ((cc >> 3) & 127)) * 72 + (cc & 7) * 8) = g.sc[i]; }
        if (tid < 256) { const int t = tid >> 2, ch = tid & 3, dd = ch >> 1, j0 = (ch & 1) * 8; float* q = af + dd * 1024 + t * 16 + j0;
#pragma unroll
            for (int e = 0; e < 4; ++e) { q[2 * e] = __uint_as_float(g.ac[e] << 16); q[2 * e + 1] = __uint_as_float(g.ac[e] & 0xFFFF0000u); } }
        { const int dd = tid >> 8, jj = (tid >> 4) & 15, d4 = tid & 15; *(float4*)(wa + (dd * 16 + jj) * 64 + d4 * 4) = g.wac; }
        if (tid < 128) ba[tid] = g.bac;
        __syncthreads();
        const int un = u + G;
        if (un < NCH * 4) gla_prefetch(p, un >> 2, un & 3, g, rcn);
        float bb[16]; float total;
        {
            float w[16];
#pragma unroll
            for (int j = 0; j < 16; ++j) w[j] = wa[(dir * 16 + j) * 64 + lane];
            const float bias = ba[dir * 64 + lane];
#pragma unroll
            for (int i = 0; i < 16; ++i) {
                const int t = tq * 16 + i;
                float z = bias;
#pragma unroll
                for (int j = 0; j < 16; ++j) z += af[(dir * 64 + t) * 16 + j] * w[j];
                bb[i] = (fminf(z, 0.f) - __logf(1.f + __expf(-fabsf(z)))) * (1.f / 16.f);
            }
            if (dir == 0) {
#pragma unroll
                for (int i = 1; i < 16; ++i) bb[i] += bb[i - 1];
                tot[(dir * 4 + tq) * 64 + lane] = bb[15];
            } else {
#pragma unroll
                for (int i = 14; i >= 0; --i) bb[i] += bb[i + 1];
                tot[(dir * 4 + tq) * 64 + lane] = bb[0];
            }
        }
        __syncthreads();
        {
            float offs = 0.f; total = 0.f;
#pragma unroll
            for (int q = 0; q < 4; ++q) { const float tv = tot[(dir * 4 + q) * 64 + lane]; total += tv; if (dir == 0 ? (q < tq) : (q > tq)) offs += tv; }
#pragma unroll
            for (int i = 0; i < 16; ++i) bb[i] += offs;
        }
#pragma unroll
        for (int i = 0; i < 16; ++i) {
            const int t = tq * 16 + i;
            const float qv = bf2f(Qraw[t * 72 + lane]) * 0.125f, kv = bf2f(Kraw[t * 72 + lane]);
            qe[(dir * 64 + t) * 72 + lane] = f2bf(qv * __expf(bb[i]));
            ke[(dir * 64 + t) * 72 + lane] = f2bf(kv * __expf(-bb[i]));
        }
        __syncthreads();
        {
            const int mdir = wave >> 2, tb = (wave >> 1) & 1, sb = wave & 1;
            f32x16 acc = {};
#pragma unroll
            for (int ks = 0; ks < 4; ++ks) {
                const bf16x8 a = *(const bf16x8*)(qe + (mdir * 64 + tb * 32 + r32) * 72 + ks * 16 + hi * 8);
                const bf16x8 b = *(const bf16x8*)(ke + (mdir * 64 + sb * 32 + r32) * 72 + ks * 16 + hi * 8);
                acc = __builtin_amdgcn_mfma_f32_32x32x16_bf16(a, b, acc, 0, 0, 0);
            }
            const int sI = sb * 32 + r32;
#pragma unroll
            for (int r = 0; r < 16; ++r) { const int t = tb * 32 + crow(r, hi); const bool keep = (mdir == 0) ? (sI <= t) : (sI >= t); Am[(mdir * 64 + t) * 72 + sI] = f2bf(keep ? acc[r] : 0.f); }
        }
        __syncthreads();
        f32x16 o = {};
        const int tb = wave >> 2, vbk = wave & 3;
        {
            const int vb = (int)(uintptr_t)Vraw + (8 * hi + ((lane & 15) >> 2)) * 320 + (vbk * 32 + 16 * ((lane >> 4) & 1) + 4 * (lane & 3)) * 2;
#define GLA_PV(KS, DIRN) do { const s16x4 l_ = gla_tr<(KS) * 5120>(vb), h_ = gla_tr<(KS) * 5120 + 1280>(vb); \
            const bf16x8 a1 = *(const bf16x8*)(Am + ((DIRN) * 64 + tb * 32 + r32) * 72 + (KS) * 16 + hi * 8); \
            const bf16x8 a2 = *(const bf16x8*)(qe + ((DIRN) * 64 + tb * 32 + r32) * 72 + (KS) * 16 + hi * 8); \
            const bf16x8 b2 = *(const bf16x8*)(ST + ((DIRN) * 128 + vbk * 32 + r32) * 72 + (KS) * 16 + hi * 8); \
            asm volatile("s_waitcnt lgkmcnt(0)" ::: "memory"); SBAR(); \
            o = __builtin_amdgcn_mfma_f32_32x32x16_bf16(a1, (bf16x8){l_[0], l_[1], l_[2], l_[3], h_[0], h_[1], h_[2], h_[3]}, o, 0, 0, 0); \
            o = __builtin_amdgcn_mfma_f32_32x32x16_bf16(a2, b2, o, 0, 0, 0); } while (0)
            GLA_PV(0, 0); GLA_PV(1, 0); GLA_PV(2, 0); GLA_PV(3, 0); GLA_PV(0, 1); GLA_PV(1, 1); GLA_PV(2, 1); GLA_PV(3, 1);
#undef GLA_PV
        }
        __syncthreads();
#pragma unroll
        for (int r = 0; r < 16; ++r) ob[(tb * 32 + crow(r, hi)) * 132 + vbk * 32 + r32] = o[r];
        __syncthreads();
        {
            float vals[16]; float ss = 0.f;
#pragma unroll
            for (int i = 0; i < 4; ++i) { const f32x4 x = *(const f32x4*)(ob + nt_t * 132 + nt_v0 + 4 * i); vals[4 * i] = x[0]; vals[4 * i + 1] = x[1]; vals[4 * i + 2] = x[2]; vals[4 * i + 3] = x[3]; }
#pragma unroll
            for (int i = 0; i < 16; ++i) ss += vals[i] * vals[i];
            ss += __shfl_xor(ss, 1); ss += __shfl_xor(ss, 2); ss += __shfl_xor(ss, 4);
            const float rstd = rsqrtf(ss * (1.f / 128.f) + EPSN);
            unsigned pk[8];
#pragma unroll
            for (int i = 0; i < 8; ++i) {
                const unsigned w = rc[i >> 2][i & 3];
                const float r0 = __uint_as_float(w << 16), r1 = __uint_as_float(w & 0xFFFF0000u);
                const float s0 = r0 * __builtin_amdgcn_rcpf(1.f + __expf(-r0)), s1 = r1 * __builtin_amdgcn_rcpf(1.f + __expf(-r1));
                pk[i] = cvtpk(vals[2 * i] * rstd * on[2 * i] * s0, vals[2 * i + 1] * rstd * on[2 * i + 1] * s1);
            }
            bf16_t* M = (bf16_t*)(p.ws + WS_MIX) + ((size_t)gc * 64 + nt_t) * 1024 + h * 128 + nt_v0;
            *(u32x4*)M = (u32x4){pk[0], pk[1], pk[2], pk[3]}; *(u32x4*)(M + 8) = (u32x4){pk[4], pk[5], pk[6], pk[7]};
        }
        rc[0] = rcn[0]; rc[1] = rcn[1];
        __syncthreads();
    }
}

namespace mla8 {
typedef int i32x8 __attribute__((ext_vector_type(8)));
constexpr int KVBLK = 64;
constexpr float SCALE = 0.07216878364870322f;
constexpr float THR = 3.f;
constexpr float PBIAS = 4.f;
constexpr int KROW = 208, VROW = 80;
constexpr int SHM_K = KVBLK * KROW, SHM_V = 128 * VROW;
constexpr int ONE = 0x7F7F7F7F, QSC = 0x7C7C7C7C;
__device__ __forceinline__ i32x8 ld32(const char* a) { const i32x4 lo = *(const i32x4*)a, hi_ = *(const i32x4*)(a + 16); return __builtin_shufflevector(lo, hi_, 0, 1, 2, 3, 4, 5, 6, 7); }
__device__ __forceinline__ void qkt(f32x16& p0, f32x16& p1, const char* Kw, const i32x8 (&q)[3]) {
    p0 = f32x16{}; p1 = f32x16{};
#pragma unroll
    for (int s_ = 0; s_ < 3; ++s_) {
        const i32x8 a0 = ld32(Kw + s_ * 64), a1 = ld32(Kw + 32 * KROW + s_ * 64);
        p0 = __builtin_amdgcn_mfma_scale_f32_32x32x64_f8f6f4(a0, q[s_], p0, 0, 0, 0, ONE, 0, QSC);
        p1 = __builtin_amdgcn_mfma_scale_f32_32x32x64_f8f6f4(a1, q[s_], p1, 0, 0, 0, ONE, 0, QSC);
    }
}
typedef float f32x2 __attribute__((ext_vector_type(2)));
#define M8_PAIR(P, i) ((f32x2){P[2 * (i)], P[2 * (i) + 1]})
#define M8_EXP(P, i) P[i] = __builtin_amdgcn_exp2f(P[i])
__device__ __forceinline__ float fma1(float a, float b, float c) { float d; asm("v_fma_f32 %0, %1, %2, %3" : "=v"(d) : "v"(a), "v"(b), "v"(c)); return d; }
__device__ __forceinline__ float mul1(float a, float b) { float d; asm("v_mul_f32 %0, %1, %2" : "=v"(d) : "v"(a), "v"(b)); return d; }
__device__ __forceinline__ float add1(float a, float b) { float d; asm("v_add_f32 %0, %1, %2" : "=v"(d) : "v"(a), "v"(b)); return d; }
#define M8_MFMA(A, B, C) __builtin_amdgcn_mfma_scale_f32_32x32x64_f8f6f4(A, B, C, 0, 0, 0, ONE, 0, ONE)
#define M8_MFMAQ(A, B, C) __builtin_amdgcn_mfma_scale_f32_32x32x64_f8f6f4(A, B, C, 0, 0, 0, ONE, 0, QSC)
constexpr int NEXP_B = 8;
#define M8_F1(P0, P1) do { M8_EXP(P0, 8); M8_EXP(P0, 9); M8_EXP(P0, 10); M8_EXP(P0, 11); M8_EXP(P0, 12); M8_EXP(P0, 13); } while (0)
#define M8_F2(P0, P1) do { M8_EXP(P0, 14); M8_EXP(P0, 15); M8_EXP(P1, 0); M8_EXP(P1, 1); M8_EXP(P1, 2); M8_EXP(P1, 3); } while (0)
#define M8_F3(P0, P1) do { M8_EXP(P1, 4); M8_EXP(P1, 5); M8_EXP(P1, 6); M8_EXP(P1, 7); M8_EXP(P1, 8); M8_EXP(P1, 9); } while (0)
#define M8_F4(P0, P1) do { M8_EXP(P1, 10); M8_EXP(P1, 11); M8_EXP(P1, 12); M8_EXP(P1, 13); M8_EXP(P1, 14); M8_EXP(P1, 15); } while (0)
#define M8_F5(P0, P1) do { float t0_ = add1(P0[0], P0[1]), t1_ = add1(P0[2], P0[3]), t2_ = add1(P0[4], P0[5]), t3_ = add1(P0[6], P0[7]); \
    _Pragma("unroll") for (int i_ = 8; i_ < 16; i_ += 4) { t0_ = add1(t0_, P0[i_]); t1_ = add1(t1_, P0[i_ + 1]); t2_ = add1(t2_, P0[i_ + 2]); t3_ = add1(t3_, P0[i_ + 3]); } \
    _Pragma("unroll") for (int i_ = 0; i_ < 16; i_ += 4) { t0_ = add1(t0_, P1[i_]); t1_ = add1(t1_, P1[i_ + 1]); t2_ = add1(t2_, P1[i_ + 2]); t3_ = add1(t3_, P1[i_ + 3]); } \
    psum = add1(add1(t0_, t1_), add1(t2_, t3_)); \
    _Pragma("unroll") for (int w_ = 0; w_ < 4; ++w_) { int a_ = __builtin_amdgcn_cvt_pk_fp8_f32(P0[4 * w_], P0[4 * w_ + 1], 0, false); P8[w_] = __builtin_amdgcn_cvt_pk_fp8_f32(P0[4 * w_ + 2], P0[4 * w_ + 3], a_, true); } } while (0)
#define M8_F6A(P0, P1) do { _Pragma("unroll") for (int w_ = 0; w_ < 4; ++w_) { int b_ = __builtin_amdgcn_cvt_pk_fp8_f32(P1[4 * w_], P1[4 * w_ + 1], 0, false); P8[4 + w_] = __builtin_amdgcn_cvt_pk_fp8_f32(P1[4 * w_ + 2], P1[4 * w_ + 3], b_, true); } } while (0)
#define M8_F6B(AL) do { { auto rr_ = __builtin_amdgcn_permlane32_swap(__float_as_uint(psum), __float_as_uint(psum), false, false); psum = __uint_as_float(rr_[0]) + __uint_as_float(rr_[1]); } \
    l_reg = fmaf(l_reg, AL, psum); } while (0)
#define M8_F6(P0, P1, AL) do { M8_F6A(P0, P1); M8_F6B(AL); } while (0)
#define M8_P1(P0, P1) do { float x_ = fmaxf(P0[0], P0[1]); _Pragma("unroll") for (int r_ = 2; r_ < 16; r_ += 2) x_ = fmaxf(fmaxf(x_, P0[r_]), P0[r_ + 1]); \
    _Pragma("unroll") for (int r_ = 0; r_ < 16; r_ += 2) x_ = fmaxf(fmaxf(x_, P1[r_]), P1[r_ + 1]); \
    { auto rr_ = __builtin_amdgcn_permlane32_swap(__float_as_uint(x_), __float_as_uint(x_), false, false); pmax = fmaxf(__uint_as_float(rr_[0]), __uint_as_float(rr_[1])); } } while (0)
#define M8_P2(P0, P1, AL) do { AL = 1.f; if (!__all(pmax <= PBIAS + THR * LOG2E)) { const float d_ = fmaxf(pmax - PBIAS, 0.f); AL = __builtin_amdgcn_exp2f(-d_); \
    _Pragma("unroll") for (int i_ = 0; i_ < 16; ++i_) { P0[i_] -= d_; P1[i_] -= d_; minit[i_] -= d_; } } } while (0)
#define M8_P3(P0, P1) do { M8_EXP(P0, 0); M8_EXP(P0, 1); M8_EXP(P0, 2); M8_EXP(P0, 3); } while (0)
#define M8_P4(P0, P1) do { M8_EXP(P0, 4); M8_EXP(P0, 5); M8_EXP(P0, 6); M8_EXP(P0, 7); } while (0)
__device__ __forceinline__ void attn_body2(const unsigned char* __restrict__ Q8w, const unsigned char* __restrict__ K8h, const unsigned char* __restrict__ V8h, bf16_t* __restrict__ Ob, int seq) {
    char* lds = smem;
    const int tid = tid_opaque(), wid = tid >> 6, lane = tid & 63, r32 = lane & 31, hi = lane >> 5;
    constexpr int BUF = SHM_K + SHM_V;
    float l_reg = 0; f32x16 o[4] = {}; f32x16 minit;
    i32x8 q[3];
    { const unsigned char* qp = Q8w + (size_t)(wid * 32 + r32) * 768 + hi * 32;
#pragma unroll
      for (int s_ = 0; s_ < 3; ++s_) { const i32x4 lo = *(const i32x4*)(qp + s_ * 64), hi_ = *(const i32x4*)(qp + s_ * 64 + 16); q[s_] = __builtin_shufflevector(lo, hi_, 0, 1, 2, 3, 4, 5, 6, 7); } }
    const int kc0 = tid, kc1 = 512 + (tid & 255);
    const int kso0 = (kc0 / 12) * KROW + (kc0 % 12) * 16, kso1 = (kc1 / 12) * KROW + (kc1 % 12) * 16, vso = SHM_K + (tid >> 2) * VROW + (tid & 3) * 16;
    const bool two = tid < 256;
    const char* Kw = lds + r32 * KROW + hi * 32; const char* Vw = lds + SHM_K + r32 * VROW + hi * 32;
    struct { u32x4 k0, k1, v; } st_;
#define SLOAD(t_) do { const unsigned char* kt_ = K8h + (size_t)(t_) * (KVBLK * 192); st_.k0 = *(const u32x4*)(kt_ + kc0 * 16); if (two) st_.k1 = *(const u32x4*)(kt_ + kc1 * 16); \
    st_.v = *(const u32x4*)(V8h + (size_t)(t_) * 8192 + tid * 16); } while (0)
#define SWRITE(bo) do { *(u32x4*)(lds + (bo) + kso0) = st_.k0; if (two) *(u32x4*)(lds + (bo) + kso1) = st_.k1; *(u32x4*)(lds + (bo) + vso) = st_.v; } while (0)
#define RESC(a) do { if (__any((a) < 1.f)) { asm volatile("s_nop 15\n\ts_nop 15\n\ts_nop 15\n\ts_nop 15\n\ts_nop 15\n\ts_nop 15" ::: "memory");     \
    _Pragma("unroll") for (int d = 0; d < 4; ++d) _Pragma("unroll") for (int r = 0; r < 16; ++r) o[d][r] = mul1(o[d][r], (a)); } } while (0)
    f32x16 pA0, pA1, pB0, pB1; float alA = 1.f, alB = 1.f, pmax, psum; i32x8 P8;
    const int NT = seq / KVBLK;
#define TIE3(a, b, c) asm volatile("" : "+v"(a), "+v"(b), "+v"(c))
#define TIE4(a, b, c, d) asm volatile("" : "+v"(a), "+v"(b), "+v"(c), "+v"(d))
#define TIE5(a, b, c, d, e) asm volatile("" : "+v"(a), "+v"(b), "+v"(c), "+v"(d), "+v"(e))
#define TIE6(a, b, c, d, e, f) asm volatile("" : "+v"(a), "+v"(b), "+v"(c), "+v"(d), "+v"(e), "+v"(f))
#define M8_STEP(PC0, PC1, ALC, PN0, PN1, ALN, kb, vb, DO_QK) do { \
    i32x8 k00, k10, k01, k11, k02, k12, v0, v1, v2, v3; \
    int ko_ = (kb), vo_ = (vb);        \
    if (DO_QK) { k00 = ld32(Kw + ko_); k10 = ld32(Kw + ko_ + 32 * KROW); k01 = ld32(Kw + ko_ + 64); \
        PN0 = M8_MFMAQ(k00, q[0], minit); TIE4(PN0, PC0, PC1, ko_); } \
    M8_F1(PC0, PC1); \
    if (DO_QK) { k11 = ld32(Kw + ko_ + 32 * KROW + 64); TIE3(PC0, PC1, k10); PN1 = M8_MFMAQ(k10, q[0], minit); TIE4(PN1, PC0, PC1, ko_); } \
    M8_F2(PC0, PC1); \
    if (DO_QK) { k02 = ld32(Kw + ko_ + 128); TIE3(PC0, PC1, k01); PN0 = M8_MFMAQ(k01, q[1], PN0); TIE4(PN0, PC0, PC1, ko_); } \
    M8_F3(PC0, PC1); \
    if (DO_QK) { k12 = ld32(Kw + ko_ + 32 * KROW + 128); TIE3(PC0, PC1, k11); PN1 = M8_MFMAQ(k11, q[1], PN1); TIE4(PN1, PC0, PC1, vo_); } \
    M8_F4(PC0, PC1); \
    v0 = ld32(Vw + vo_); \
    if (DO_QK) { TIE3(PC0, PC1, k02); PN0 = M8_MFMAQ(k02, q[2], PN0); TIE4(PN0, PC0, PC1, vo_); } \
    M8_F5(PC0, PC1); \
    v1 = ld32(Vw + vo_ + 32 * VROW); \
    if (DO_QK) { TIE5(PC0, PC1, P8, psum, k12); PN1 = M8_MFMAQ(k12, q[2], PN1); TIE6(PN1, PC0, PC1, P8, psum, vo_); } \
    M8_F6A(PC0, PC1); \
    v2 = ld32(Vw + vo_ + 64 * VROW); \
    TIE3(P8, psum, v0); o[0] = M8_MFMA(v0, P8, o[0]); \
    TIE3(o[0], psum, vo_); M8_F6B(ALC); v3 = ld32(Vw + vo_ + 96 * VROW); TIE3(l_reg, psum, v1); \
    o[1] = M8_MFMA(v1, P8, o[1]); \
      \
    if (DO_QK) { TIE4(o[1], PN0, PN1, vo_); M8_P1(PN0, PN1); TIE4(PN0, PN1, pmax, v2); } \
    o[2] = M8_MFMA(v2, P8, o[2]); \
    if (DO_QK) { TIE4(o[2], PN0, PN1, pmax); M8_P2(PN0, PN1, ALN); M8_P3(PN0, PN1); TIE5(PN0, PN1, minit, ALN, v3); } \
    o[3] = M8_MFMA(v3, P8, o[3]); \
    if (DO_QK) { TIE3(o[3], PN0, PN1); M8_P4(PN0, PN1); TIE3(PN0, PN1, ALN); RESC(ALN); } } while (0)
    SLOAD(0); SWRITE(0); SLOAD(1); SWRITE(BUF); __syncthreads();
    SLOAD(2);
    qkt(pA0, pA1, Kw, q);
    M8_P1(pA0, pA1);
    { const float mc_ = PBIAS - pmax;
#pragma unroll
      for (int i_ = 0; i_ < 16; ++i_) { pA0[i_] += mc_; pA1[i_] += mc_; minit[i_] = mc_; } }
    M8_P3(pA0, pA1); M8_P4(pA0, pA1);
    int b0 = 0, b1 = BUF, b2 = 2 * BUF;
    for (int j = 0; j + 2 < NT; j += 2) {
        __syncthreads(); SWRITE(b2); if (j + 3 < NT) SLOAD(j + 3);
        M8_STEP(pA0, pA1, alA, pB0, pB1, alB, b1, b0, true);
        __syncthreads(); SWRITE(b0); if (j + 4 < NT) SLOAD(j + 4);
        M8_STEP(pB0, pB1, alB, pA0, pA1, alA, b2, b1, true);
        { const int t_ = b0; b0 = b2; b2 = b1; b1 = t_; }
    }
    __syncthreads();
    M8_STEP(pA0, pA1, alA, pB0, pB1, alB, b1, b0, true);
    M8_STEP(pB0, pB1, alB, pA0, pA1, alA, 0, b1, false);
    const float rl = __builtin_amdgcn_rcpf(l_reg);
    bf16_t* Ow = Ob + (size_t)(wid * 32 + r32) * 1024 + 4 * hi;
#pragma unroll
    for (int d0 = 0; d0 < 4; ++d0)
#pragma unroll
        for (int g = 0; g < 4; ++g)
            *(u32x2*)(Ow + d0 * 32 + 8 * g) = (u32x2){cvtpk(o[d0][4 * g] * rl, o[d0][4 * g + 1] * rl), cvtpk(o[d0][4 * g + 2] * rl, o[d0][4 * g + 3] * rl)};
    __syncthreads();
#undef SLOAD
#undef SWRITE
#undef RESC
#undef M8_STEP
}
}

__device__ __forceinline__ void phase_mix0(PRef p) {
    const int G = gridDim.x;
    phase_gla_out(p);
    __syncthreads();
    const unsigned char* Q8 = (const unsigned char*)(p.ws + WS_Q8); const unsigned char* K8 = (const unsigned char*)(p.ws + WS_K8); const unsigned char* VT8 = (const unsigned char*)(p.ws + WS_VT8);
    bf16_t* MIX = (bf16_t*)(p.ws + WS_MIX);
    for (int u = blockIdx.x; u < 260; u += G) {
        const bool lat = u < 256;
        const int h = lat ? (u & 3) : (u - 256);
        const size_t q0 = lat ? (size_t)CTXN + (size_t)(u >> 2) * 256 : 0;
        mla8::attn_body2(Q8 + q0 * 768 + h * 192, K8 + (size_t)h * NTOK * 192, VT8 + (size_t)h * NCH * 8192, MIX + q0 * 1024 + 512 + h * 128, lat ? NTOK : CTXN);
    }
}

#define PK4(P, BASE, OUT) do { unsigned a0 = cvtpk(P[BASE + 0], P[BASE + 1]), a1 = cvtpk(P[BASE + 2], P[BASE + 3]);   \
    unsigned b0 = cvtpk(P[BASE + 4], P[BASE + 5]), b1 = cvtpk(P[BASE + 6], P[BASE + 7]);                              \
    auto r0 = __builtin_amdgcn_permlane32_swap(a0, b0, false, false); auto r1 = __builtin_amdgcn_permlane32_swap(a1, b1, false, false); \
    u32x4 w = {r0[0], r1[0], r0[1], r1[1]}; OUT = *reinterpret_cast<bf16x8*>(&w); } while (0)
template <int OFF> __device__ __forceinline__ s16x4 na_tr(int vb) { s16x4 r; asm volatile("ds_read_b64_tr_b16 %0, %1 offset:%2" : "=&v"(r) : "v"(vb), "i"(OFF) : "memory"); return r; }
template <int KS> __device__ __forceinline__ void na_pv(f32x16& o0, f32x16& o1, int vb, bf16x8 pa) {
    const s16x4 a0 = na_tr<KS * 5120>(vb), a1 = na_tr<KS * 5120 + 1280>(vb), b0 = na_tr<KS * 5120 + 64>(vb), b1 = na_tr<KS * 5120 + 1280 + 64>(vb);
    asm volatile("s_waitcnt lgkmcnt(0)" ::: "memory"); SBAR();
    o0 = __builtin_amdgcn_mfma_f32_32x32x16_bf16(pa, (bf16x8){a0[0], a0[1], a0[2], a0[3], a1[0], a1[1], a1[2], a1[3]}, o0, 0, 0, 0);
    o1 = __builtin_amdgcn_mfma_f32_32x32x16_bf16(pa, (bf16x8){b0[0], b0[1], b0[2], b0[3], b1[0], b1[1], b1[2], b1[3]}, o1, 0, 0, 0);
}
template <int MODE> __device__ __forceinline__ void na_softmax(f32x16& p0, f32x16& p1, float& m_reg, float& l_reg, float& alpha, const float* brow, int c0, int hi) {
    constexpr float C = 0.125f * LOG2E;
#define NA_L0(q) (MODE != 2 || (q) >= 12)
#define NA_L1(q) (MODE != 1 || (q) < 4)
    if (MODE == 0) {
#pragma unroll
        for (int q = 0; q < 16; ++q) { p0[q] *= C; p1[q] *= C; }
    } else {
        float bv0[16], bv1[16];
#pragma unroll
        for (int q = 0; q < 16; ++q) { const int kc0 = crow(q, hi); if (NA_L0(q)) bv0[q] = brow[kc0]; if (NA_L1(q)) bv1[q] = brow[32 + kc0]; }
#pragma unroll
        for (int q = 0; q < 16; ++q) { if (NA_L0(q)) asm volatile("" : "+v"(bv0[q])); if (NA_L1(q)) asm volatile("" : "+v"(bv1[q])); }
#pragma unroll
        for (int q = 0; q < 16; ++q) {
            const int kc0 = crow(q, hi), kc1 = 32 + kc0;
            if (NA_L0(q)) { const float t = fmaf(p0[q], C, bv0[q]); p0[q] = ((unsigned)(kc0 - c0) < 16u) ? t : -1e30f; }
            if (NA_L1(q)) { const float t = fmaf(p1[q], C, bv1[q]); p1[q] = ((unsigned)(kc1 - c0) < 16u) ? t : -1e30f; }
        }
    }
    float pmax = -1e30f;
#pragma unroll
    for (int q = 0; q < 16; ++q) { if (NA_L0(q)) pmax = fmaxf(pmax, p0[q]); if (NA_L1(q)) pmax = fmaxf(pmax, p1[q]); }
    { auto rr = __builtin_amdgcn_permlane32_swap(__float_as_uint(pmax), __float_as_uint(pmax), false, false);
      pmax = fmaxf(__uint_as_float(rr[0]), __uint_as_float(rr[1])); }
    const float mn = fmaxf(m_reg, pmax);
    alpha = __builtin_amdgcn_exp2f(m_reg - mn);
    m_reg = mn;
    float ps = 0.f;
#pragma unroll
    for (int q = 0; q < 16; ++q) {
        if (NA_L0(q)) { p0[q] = __builtin_amdgcn_exp2f(p0[q] - mn); ps += p0[q]; } else p0[q] = 0.f;
        if (NA_L1(q)) { p1[q] = __builtin_amdgcn_exp2f(p1[q] - mn); ps += p1[q]; } else p1[q] = 0.f;
    }
    { auto rr = __builtin_amdgcn_permlane32_swap(__float_as_uint(ps), __float_as_uint(ps), false, false);
      ps = __uint_as_float(rr[0]) + __uint_as_float(rr[1]); }
    l_reg = l_reg * alpha + ps;
#undef NA_L0
#undef NA_L1
}
__device__ __forceinline__ void phase_na(PRef p) {
    const int tid = threadIdx.x, lane = tid & 63, wave = tid >> 6, r32 = lane & 31, hi = lane >> 5, G = gridDim.x;
    const bf16_t* QKV = (const bf16_t*)(p.ws + WS_P);
    bf16_t* MIX = (bf16_t*)(p.ws + WS_MIX);
    constexpr int KB = 64 * 72 * 2, VB = 64 * 160 * 2;
    char* Kl = smem;
    char* Vl = smem + 2 * KB;
    float* xch = (float*)(smem + 2 * KB + 2 * VB) + wave * 64;
    float* rpbL = (float*)(smem + 2 * KB + 2 * VB + 8 * 64 * 4);
    constexpr float C = 0.125f * LOG2E;
    const int skey = tid >> 3, sch = tid & 7;
    const int vb0 = (int)(uintptr_t)Vl + (8 * hi + ((lane & 15) >> 2)) * 320 + (16 * ((lane >> 4) & 1) + 4 * (lane & 3)) * 2;
    for (int u = blockIdx.x; u < 64 * 16; u += G) {
        const int rg = u >> 4, h = u & 15;
        const int r = rg * 4 + (wave >> 1), qb = wave & 1;
        const int r0w = min(max(r - 4, 0), 248);
        const int kr_lo = min(max(rg * 4 - 4, 0), 248), kr_hi = min(max(rg * 4 + 3 - 4, 0), 248) + 7, nwin = kr_hi - kr_lo + 1, ntile = nwin + 4;
        for (int i = tid; i < 15 * 31; i += NTH) rpbL[i] = p.na_rpb[(size_t)h * 15 * 31 + i] * LOG2E;
        const int c = qb * 32 + r32, c0 = min(max(c - 8, 0), 48);
        const size_t qrow = (size_t)CTXN + (size_t)r * 64 + c;
        bf16x8 qr[4];
#pragma unroll
        for (int ks = 0; ks < 4; ++ks) qr[ks] = *(const bf16x8*)(QKV + qrow * 3072 + h * 64 + ks * 16 + hi * 8);
        float m_reg = -1e30f, l_reg = 0.f; f32x16 o0 = {}, o1 = {};
        u32x4 skA, svA, skB, svB;
#define NA_LOAD(ti_, SK, SV) do { const size_t key0_ = ((ti_) >= nwin) ? (size_t)((ti_) - nwin) * 64 : (size_t)CTXN + (size_t)(kr_lo + (ti_)) * 64; \
            const bf16_t* src_ = QKV + (key0_ + skey) * 3072 + h * 64 + sch * 8; SK = *(const u32x4*)(src_ + 1024); SV = *(const u32x4*)(src_ + 2048); } while (0)
#define NA_WRITE(b_, SK, SV) do { *(u32x4*)(Kl + (b_) * KB + skey * 144 + sch * 16) = SK; *(u32x4*)(Vl + (b_) * VB + skey * 320 + sch * 16) = SV; } while (0)
        NA_LOAD(0, skA, svA); NA_WRITE(0, skA, svA);
        NA_LOAD(1, skA, svA);
        __syncthreads();
        for (int ti = 0; ti < ntile; ++ti) {
            const int b = ti & 1;
            if (ti + 2 < ntile) { if (b == 0) NA_LOAD(ti + 2, skB, svB); else NA_LOAD(ti + 2, skA, svA); }
            const bool isctx = ti >= nwin;
            const int kr = kr_lo + ti;
            const bool need = isctx || (kr >= r0w && kr <= r0w + 7);
            if (need) {
                const bf16_t* Ks = (const bf16_t*)(Kl + b * KB);
                f32x16 p0 = {}, p1 = {};
#pragma unroll
                for (int ks = 0; ks < 4; ++ks) {
                    const bf16x8 a0 = *(const bf16x8*)(Ks + r32 * 72 + ks * 16 + hi * 8), a1 = *(const bf16x8*)(Ks + (32 + r32) * 72 + ks * 16 + hi * 8);
                    p0 = __builtin_amdgcn_mfma_f32_32x32x16_bf16(a0, qr[ks], p0, 0, 0, 0);
                    p1 = __builtin_amdgcn_mfma_f32_32x32x16_bf16(a1, qr[ks], p1, 0, 0, 0);
                }
                float alpha;
                const float* brow = rpbL + (kr - r + 7) * 31 + 15 - c;
                if (isctx) na_softmax<0>(p0, p1, m_reg, l_reg, alpha, brow, c0, hi);
                else if (qb == 0) na_softmax<1>(p0, p1, m_reg, l_reg, alpha, brow, c0, hi);
                else na_softmax<2>(p0, p1, m_reg, l_reg, alpha, brow, c0, hi);
                bf16x8 pa0, pa1, pa2, pa3;
                PK4(p0, 0, pa0); PK4(p0, 8, pa1); PK4(p1, 0, pa2); PK4(p1, 8, pa3);
                if (__any(alpha < 1.f)) {
                    if (hi == 0) xch[r32] = alpha;
                    asm volatile("s_waitcnt lgkmcnt(0)" ::: "memory");
#pragma unroll
                    for (int q = 0; q < 16; ++q) { const float a = xch[crow(q, hi)]; o0[q] *= a; o1[q] *= a; }
                }
                const int vb = vb0 + b * VB;
                na_pv<0>(o0, o1, vb, pa0); na_pv<1>(o0, o1, vb, pa1); na_pv<2>(o0, o1, vb, pa2); na_pv<3>(o0, o1, vb, pa3);
            }
            if (ti + 1 < ntile) { if (b == 0) NA_WRITE(1, skA, svA); else NA_WRITE(0, skB, svB); }
            __syncthreads();
        }
#undef NA_LOAD
#undef NA_WRITE
        if (hi == 0) xch[32 + r32] = l_reg;
        asm volatile("s_waitcnt lgkmcnt(0)" ::: "memory");
        const size_t orow0 = (size_t)CTXN + (size_t)r * 64 + qb * 32;
#pragma unroll
        for (int q = 0; q < 16; ++q) {
            const int qi = crow(q, hi); const float il = __builtin_amdgcn_rcpf(xch[32 + qi]);
            bf16_t* dst = MIX + (orow0 + qi) * 1024 + h * 64;
            dst[r32] = f2bf(o0[q] * il); dst[32 + r32] = f2bf(o1[q] * il);
        }
        __syncthreads();
    }
}
#undef PK4

#define XB_TMO      128
#define XB_XCNT(j)  (256  + 64 * (j))
#define XB_XSUB(j)  (1280 + 64 * (j))
#define XB_XGEN(j)  (2304 + 64 * (j))
#define XB_TOP      3328
#define XB_TOPGEN   3392
#define XCD_BAR_WORDS 3456
#define XB_SPIN_CAP (1u << 22)
#define LAS __attribute__((address_space(3)))
__device__ __forceinline__ unsigned xb_ld(unsigned* p)              { return __hip_atomic_load(p, __ATOMIC_RELAXED, __HIP_MEMORY_SCOPE_AGENT); }
__device__ __forceinline__ unsigned xb_add(unsigned* p, unsigned v) { return __hip_atomic_fetch_add(p, v, __ATOMIC_RELAXED, __HIP_MEMORY_SCOPE_AGENT); }
__device__ __forceinline__ unsigned xb_xcc_id() { return (unsigned)__builtin_amdgcn_s_getreg((3 << 11) | 20) & 0xFu; }
#define XB_SPIN(cond, bar) do { unsigned _sp = 0; while (cond) { __builtin_amdgcn_s_sleep(1); \
    if ((++_sp & 255u) == 0u) { if (xb_ld(&(bar)[XB_TMO])) break; if (_sp > XB_SPIN_CAP) { atomicAdd(&(bar)[XB_TMO], 1u); break; } } } } while (0)
struct XcdBarrier { unsigned* bar; unsigned x; volatile LAS unsigned* st; };
__device__ __forceinline__ XcdBarrier xcd_barrier_post(unsigned* bar, volatile LAS unsigned* st) {
    XcdBarrier b; b.bar = bar; b.x = xb_xcc_id(); b.st = st;
    if (threadIdx.x == 0) (void)xb_add(&bar[XB_XCNT(b.x)], 1u);
    return b;
}
__device__ __forceinline__ void xcd_barrier_complete(unsigned* bar, unsigned x, unsigned& nloc, unsigned& nx) {
    const unsigned G = gridDim.x * gridDim.y * gridDim.z;
    unsigned sum, cnt, mine, sp = 0u;
    for (;;) {
        sum = 0u; cnt = 0u; mine = 0u;
#pragma unroll
        for (unsigned j = 0; j < 16; ++j) { const unsigned c = xb_ld(&bar[XB_XCNT(j)]); sum += c; cnt += (c > 0u) ? 1u : 0u; mine = (j == x) ? c : mine; }
        if (sum == G) break;
        __builtin_amdgcn_s_sleep(1);
        if ((++sp & 255u) == 0u) { if (xb_ld(&bar[XB_TMO])) break; if (sp > XB_SPIN_CAP) { atomicAdd(&bar[XB_TMO], 1u); break; } }
    }
    nloc = mine > 0u ? mine : 1u; nx = cnt > 0u ? cnt : 1u;
}
__device__ __forceinline__ void xcd_barrier(const XcdBarrier& b) {
    asm volatile("s_waitcnt vmcnt(0)" ::: "memory");
    __syncthreads();
    if (threadIdx.x == 0) {
        unsigned* bar = b.bar;
        __builtin_amdgcn_s_waitcnt(0);
        unsigned nloc = b.st[0], nx = b.st[1];
        if (nloc == 0u) { xcd_barrier_complete(bar, b.x, nloc, nx); b.st[0] = nloc; b.st[1] = nx; }
        const unsigned old = xb_add(&bar[XB_XSUB(b.x)], 1u);
        const unsigned gen = old / nloc;
        if (old + 1u == (gen + 1u) * nloc) {
            __builtin_amdgcn_fence(__ATOMIC_RELEASE, "agent");
            asm volatile("s_waitcnt vmcnt(0)" ::: "memory");
            const unsigned og = xb_add(&bar[XB_TOP], 1u);
            const unsigned tg = og / nx;
            if (og + 1u == (tg + 1u) * nx) xb_add(&bar[XB_TOPGEN], 1u);
            else XB_SPIN(xb_ld(&bar[XB_TOPGEN]) == tg, bar);
            __builtin_amdgcn_fence(__ATOMIC_ACQUIRE, "agent");
            xb_add(&bar[XB_XGEN(b.x)], 1u);
            asm volatile("s_waitcnt vmcnt(0)" ::: "memory");
        } else {
            XB_SPIN(xb_ld(&bar[XB_XGEN(b.x)]) == gen, bar);
            __builtin_amdgcn_fence(__ATOMIC_ACQUIRE, "agent");
            asm volatile("s_waitcnt vmcnt(0)" ::: "memory");
        }
    }
    __syncthreads();
}

__device__ __forceinline__ void run_phase(PRef p, int ph) {
#ifdef ONLY_PHASE
    if (ph != ONLY_PHASE) return;
    ph = ONLY_PHASE;
#endif
    const bf16_t* HB = (const bf16_t*)(p.ws + WS_HB);
    switch (ph) {
    case 0: phase_prologue(p); break;
    case 1: phase_norm1_l0(p); break;
    case 2: phase_gemm_pg8(HB, 1024, (const bf16_t*)(p.ws + WS_WIN), 1024, (bf16_t*)(p.ws + WS_P), PW, NTOK / 256, 8); break;
    case 3: phase_mla_up(p); break;
    case 4: break;
    case 5: phase_gla_scan(p); break;
    case 6: phase_mix0(p); break;
    case 7: phase_gemm_pg8((const bf16_t*)(p.ws + WS_MIX), 1024, (const bf16_t*)(p.ws + WS_WOUT0), 1024, (bf16_t*)(p.ws + WS_OB), 1024, NTOK / 256, 4); break;
    case 8: phase_mid(p, 0); break;
    case 9: phase_moe1(p, 0); break;
    case 10: phase_moe2(p, 0); break;
    case 11: phase_end(p, 0); break;
    case 12: phase_gemm_pg8(HB, 1024, (const bf16_t*)(p.ws + WS_WQKV), 1024, (bf16_t*)(p.ws + WS_P), 3072, NTOK / 256, 12); break;
    case 13: phase_na(p); break;
    case 14: phase_gemm_pg8((const bf16_t*)(p.ws + WS_MIX) + (size_t)CTXN * 1024, 1024, (const bf16_t*)(p.ws + WS_WNAO), 1024, (bf16_t*)(p.ws + WS_OB) + (size_t)CTXN * 1024, 1024, SEQ / 256, 4); break;
    case 15: phase_mid(p, 1); break;
    case 16: phase_moe1(p, 1); break;
    case 17: phase_moe2(p, 1); break;
    case 18: phase_end(p, 1); break;
    default: break;
    }
}
constexpr int N_PHASES = 19;

#if MK_LAUNCHES == 1
__global__ void __launch_bounds__(512) mega_kernel(Params p) {
    cg::grid_group grid = cg::this_grid();
    volatile LAS unsigned* xst = (volatile LAS unsigned*)(smem + LDS_BYTES - 16);
    if (threadIdx.x == 0) { xst[0] = 0u; xst[1] = 0u; xst[2] = 0u; xst[3] = 0u; }
    __syncthreads();
    XcdBarrier xb = xcd_barrier_post((unsigned*)(kparams()->ws + WS_BAR), xst);
    run_phase(*kparams(), 0); xcd_barrier(xb);
    if (kparams()->pad0 == 0x7fffffff) grid.sync();
    if (PROBE_REPEAT == 100) { run_phase(*kparams(), 0); xcd_barrier(xb); }
    if (PROBE_REPEAT == 61) { phase_gla_out(*kparams()); xcd_barrier(xb); }
#define PH_(n) run_phase(*kparams(), n); xcd_barrier(xb); if ((n) == PROBE_REPEAT) { run_phase(*kparams(), n); xcd_barrier(xb); }
    PH_(1) PH_(2) PH_(3) PH_(5) PH_(6) PH_(7) PH_(8) PH_(9) PH_(10) PH_(11) PH_(12) PH_(13) PH_(14) PH_(15) PH_(16) PH_(17)
    run_phase(*kparams(), 18);
#undef PH_
}
#else
template <int PH> __global__ void __launch_bounds__(512) phase_kernel(Params p) { run_phase(*kparams(), PH); }
typedef void (*phase_fn)(Params);
template <int PH> static bool launch_phase(const Params& p, int grid, hipStream_t stream, bool setattr) {
    if (setattr && hipFuncSetAttribute((const void*)phase_kernel<PH>, hipFuncAttributeMaxDynamicSharedMemorySize, LDS_BYTES) != hipSuccess) return false;
    hipLaunchKernelGGL(phase_kernel<PH>, dim3(grid), dim3(NTH), LDS_BYTES, stream, p);
    return true;
}
#endif

extern "C" void kernel_launch(void* const* d_in, const int* in_sizes, int n_in, void* d_out, int out_size, void* d_ws, size_t ws_size, hipStream_t stream) {
    static int grid_blocks = 0;
    bool first = false;
    if (!grid_blocks) {
        if (ws_size < WS_END) { fprintf(stderr, "kernel_launch: workspace too small: %zu < %zu\n", ws_size, (size_t)WS_END); return; }
        int dev = 0, cus = 0;
        (void)hipGetDevice(&dev);
        (void)hipDeviceGetAttribute(&cus, hipDeviceAttributeMultiprocessorCount, dev);
#if MK_LAUNCHES == 1
        if (hipFuncSetAttribute((const void*)mega_kernel, hipFuncAttributeMaxDynamicSharedMemorySize, LDS_BYTES) != hipSuccess) { fprintf(stderr, "kernel_launch: LDS attribute failed\n"); return; }
        int per_cu = 0;
        (void)hipOccupancyMaxActiveBlocksPerMultiprocessor(&per_cu, (const void*)mega_kernel, NTH, LDS_BYTES);
        if (per_cu < 1) { fprintf(stderr, "kernel_launch: occupancy query returned %d\n", per_cu); return; }
#endif
        grid_blocks = cus;
        first = true;
    }
    Params p{};
    const float* const* in = (const float* const*)d_in;
    p.x = in[0]; p.c = in[1]; p.ctx = in[2]; p.c_ctx = in[3]; p.ada_w = in[4]; p.ada_b = in[5]; p.norm_g = in[6]; p.router_w = in[7]; p.router_b = in[8];
    p.moe_w1 = in[9]; p.moe_b1 = in[10]; p.moe_w2 = in[11]; p.moe_b2 = in[12]; p.ab_in_w = in[13]; p.gla_wa_f = in[14]; p.gla_ba_f = in[15]; p.gla_wa_b = in[16]; p.gla_ba_b = in[17];
    p.gla_onorm = in[18]; p.mla_qnorm = in[19]; p.mla_wuq = in[20]; p.mla_kvnorm = in[21]; p.mla_wukv = in[22]; p.ab_out_w = in[23]; p.na_qkv_w = in[24]; p.na_rpb = in[25]; p.na_out_w = in[26];
    p.out = (float*)d_out; p.ws = (char*)d_ws;
#if MK_LAUNCHES == 1
    (void)hipMemsetAsync((char*)d_ws + WS_BAR, 0, 16384, stream);
    void* args[] = {&p};
    hipError_t e = hipLaunchCooperativeKernel((const void*)mega_kernel, dim3(grid_blocks), dim3(NTH), args, LDS_BYTES, stream);
    if (e != hipSuccess) fprintf(stderr, "cooperative launch failed: %s (grid %d)\n", hipGetErrorString(e), grid_blocks);
#else
    const int g = grid_blocks;
    launch_phase<0>(p, g, stream, first); launch_phase<1>(p, g, stream, first); launch_phase<2>(p, g, stream, first); launch_phase<3>(p, g, stream, first);
    launch_phase<4>(p, g, stream, first); launch_phase<5>(p, g, stream, first); launch_phase<6>(p, g, stream, first); launch_phase<7>(p, g, stream, first);
    launch_phase<8>(p, g, stream, first); launch_phase<9>(p, g, stream, first); launch_phase<10>(p, g, stream, first); launch_phase<11>(p, g, stream, first);
    launch_phase<12>(p, g, stream, first); launch_phase<13>(p, g, stream, first); launch_phase<14>(p, g, stream, first); launch_phase<15>(p, g, stream, first);
    launch_phase<16>(p, g, stream, first); launch_phase<17>(p, g, stream, first); launch_phase<18>(p, g, stream, first);
#endif
}
```

```cpp
#include <hip/hip_runtime.h>
#include <hip/hip_cooperative_groups.h>
#include <cstdio>
#include <cstdint>
namespace cg = cooperative_groups;

#ifndef PROBE_REPEAT
#define PROBE_REPEAT -1
#endif
#ifndef MK_LAUNCHES
#define MK_LAUNCHES 1
#endif

typedef unsigned short bf16_t;
typedef short bf16x8 __attribute__((ext_vector_type(8)));
typedef short s16x4 __attribute__((ext_vector_type(4)));
typedef float f32x4 __attribute__((ext_vector_type(4)));
typedef float f32x16 __attribute__((ext_vector_type(16)));
typedef unsigned u32x4 __attribute__((ext_vector_type(4)));
typedef int i32x4 __attribute__((ext_vector_type(4)));
typedef unsigned u32x2 __attribute__((ext_vector_type(2)));

constexpr int SEQ = 16384, CTXN = 256, NTOK = SEQ + CTXN, DM = 1024;
constexpr int NEXP = 32, FF = 1024;
constexpr int PW = 2048;
constexpr int PC_Q = 0, PC_K = 256, PC_V = 512, PC_R = 1024, PC_AF = 1536, PC_AB = 1552, PC_CQ = 1568, PC_CKV = 1824, PC_KR = 1952;
constexpr int NCH = NTOK / 64;
constexpr int NTH = 512;
constexpr float EPSN = 1e-6f;
constexpr float LOG2E = 1.4426950408889634f;

constexpr size_t al256(size_t x) { return (x + 255) / 256 * 256; }
constexpr size_t WS_BAR   = 0;
constexpr size_t WS_CNT   = WS_BAR + 16384;
constexpr size_t WS_MOD   = WS_CNT + 1024;
constexpr size_t WS_ROPE  = WS_MOD + al256((size_t)2 * 2 * 6144 * 4);
constexpr size_t WS_RWT   = WS_ROPE + al256((size_t)(256 + 256 + 64 + 64) * 16 * 4);
constexpr size_t WS_WIN   = WS_RWT + al256((size_t)2 * 32 * 1024 * 4);
constexpr size_t WS_WUQ   = WS_WIN + (size_t)2048 * 1024 * 2;
constexpr size_t WS_WUKV  = WS_WUQ + (size_t)768 * 256 * 2;
constexpr size_t WS_WOUT0 = WS_WUKV + (size_t)1024 * 128 * 2;
constexpr size_t WS_WQKV  = WS_WOUT0 + (size_t)1024 * 1024 * 2;
constexpr size_t WS_WNAO  = WS_WQKV + (size_t)3072 * 1024 * 2;
constexpr size_t WS_W1T   = WS_WNAO + (size_t)1024 * 1024 * 2;
constexpr size_t WS_W2T   = WS_W1T + (size_t)2 * 32 * 2048 * 1024 * 2;
constexpr size_t WS_Q8    = WS_W1T + (size_t)2 * 32 * 2048 * 1024;
constexpr size_t WS_K8    = WS_Q8 + (size_t)NTOK * 768;
constexpr size_t WS_VT8   = WS_K8 + (size_t)NTOK * 768;
constexpr size_t WS_DUMMY = WS_VT8 + (size_t)NTOK * 512;
static_assert(WS_DUMMY + (size_t)256 * 2048 <= WS_W2T, "fp8 MLA operands overflow the W1T region");
constexpr size_t WS_HB    = WS_W2T + (size_t)2 * 32 * 1024 * 1024 * 2;
constexpr size_t WS_P     = WS_HB + (size_t)NTOK * 1024 * 2;
constexpr size_t WS_QM    = WS_P + (size_t)NTOK * 3072 * 2;
constexpr size_t WS_KM    = WS_QM + (size_t)NTOK * 768 * 2;
constexpr size_t WS_VM    = WS_KM + (size_t)NTOK * 768 * 2;
constexpr size_t WS_U     = WS_VM + (size_t)NTOK * 512 * 2;
constexpr size_t WS_SIN   = WS_U + (size_t)2 * NCH * 4 * 128 * 64 * 2;
constexpr size_t WS_DEC   = WS_SIN + (size_t)2 * NCH * 4 * 128 * 64 * 2;
constexpr size_t WS_MIX   = WS_DEC + al256((size_t)2 * NCH * 4 * 64 * 4);
constexpr size_t WS_OB    = WS_MIX + (size_t)NTOK * 1024 * 2;
constexpr size_t WS_X1    = WS_OB + (size_t)NTOK * 1024 * 2;
constexpr size_t WS_X2    = WS_X1 + (size_t)NTOK * 1024 * 4;
constexpr size_t WS_TOPE  = WS_X2 + (size_t)NTOK * 1024 * 4;
constexpr size_t WS_TOPP  = WS_TOPE + al256((size_t)NTOK * 4 * 4);
constexpr size_t WS_GATE  = WS_TOPP + al256((size_t)NTOK * 4 * 4);
constexpr size_t WS_LIST  = WS_GATE + al256((size_t)NTOK * 4 * 4);
constexpr size_t WS_ACT   = WS_LIST + al256((size_t)32 * NTOK * 4);
constexpr size_t WS_YB    = WS_ACT + (size_t)(NTOK * 4 + 256) * 1024 * 2;
constexpr size_t WS_END   = WS_YB + (size_t)(NTOK * 4) * 1024 * 2;

constexpr int LDS_BYTES = 160 * 1024;
extern __shared__ __attribute__((aligned(16))) char smem[];

struct Params {
    const float *x, *c, *ctx, *c_ctx, *ada_w, *ada_b, *norm_g, *router_w, *router_b, *moe_w1, *moe_b1, *moe_w2, *moe_b2;
    const float *ab_in_w, *gla_wa_f, *gla_ba_f, *gla_wa_b, *gla_ba_b, *gla_onorm, *mla_qnorm, *mla_wuq, *mla_kvnorm, *mla_wukv;
    const float *ab_out_w, *na_qkv_w, *na_rpb, *na_out_w;
    float* out; char* ws;
    int pad0, pad1;
};
typedef const __attribute__((address_space(4))) Params& PRef;
typedef const __attribute__((address_space(4))) Params* KPtr;
__device__ __forceinline__ KPtr kparams() { KPtr k = (KPtr)__builtin_amdgcn_kernarg_segment_ptr(); asm volatile("" : "+s"(k)); return k; }

__device__ __forceinline__ float bf2f(bf16_t h) { return __uint_as_float(((unsigned)h) << 16); }
__device__ __forceinline__ bf16_t f2bf(float f) { unsigned u = __float_as_uint(f); u += 0x7FFFu + ((u >> 16) & 1u); return (bf16_t)(u >> 16); }
__device__ __forceinline__ unsigned cvtpk(float lo, float hi) { unsigned r; asm volatile("v_cvt_pk_bf16_f32 %0, %1, %2" : "=v"(r) : "v"(lo), "v"(hi)); return r; }
__device__ __forceinline__ float wave_sum(float v) {
#pragma unroll
    for (int o = 32; o >= 1; o >>= 1) v += __shfl_xor(v, o);
    return v;
}
__device__ __forceinline__ int crow(int r, int hi) { return (r & 3) + 8 * (r >> 2) + 4 * hi; }
__device__ __forceinline__ float silu_f(float x) { return x / (1.f + __expf(-x)); }
#define SBAR() __builtin_amdgcn_sched_barrier(0)
__device__ __forceinline__ unsigned pk4_fp8(float a, float b, float c, float d) {
    a = __builtin_amdgcn_fmed3f(a, -448.f, 448.f); b = __builtin_amdgcn_fmed3f(b, -448.f, 448.f); c = __builtin_amdgcn_fmed3f(c, -448.f, 448.f); d = __builtin_amdgcn_fmed3f(d, -448.f, 448.f);
    int r = __builtin_amdgcn_cvt_pk_fp8_f32(a, b, 0, false); r = __builtin_amdgcn_cvt_pk_fp8_f32(c, d, r, true); return (unsigned)r; }
__device__ __forceinline__ int tid_opaque() { int t = threadIdx.x; asm volatile("" : "+v"(t)); return t; }

struct ConvJob { const float* src; bf16_t* dst; const float* gain; int K, Nsrc, kt, nt, mode, f8; };
constexpr int CONV8_RS = 264;
constexpr float W8_SCALE = 64.f;
__device__ __forceinline__ void conv_load(const ConvJob& jb, float4 (&v)[16]) {
    const int tid = threadIdx.x, n4 = tid & 63, kr = tid >> 6, n = jb.nt * 256 + n4 * 4;
    const float* q = jb.src + (size_t)(jb.kt * 128 + kr) * jb.Nsrc + n;
#pragma unroll
    for (int i = 0; i < 16; ++i) { if (n < jb.Nsrc) { const f32x4 t = __builtin_nontemporal_load((const f32x4*)(q + (size_t)(8 * i) * jb.Nsrc)); v[i] = make_float4(t[0], t[1], t[2], t[3]); } else v[i] = make_float4(0.f, 0.f, 0.f, 0.f); }
}
__device__ __forceinline__ void conv_to_lds(const ConvJob& jb, const float4 (&v)[16]) {
    bf16_t* T = (bf16_t*)smem;
    const int tid = threadIdx.x, n4 = tid & 63, kr = tid >> 6;
#pragma unroll
    for (int i = 0; i < 16; ++i) {
        const int k = kr + 8 * i;
        float4 w = v[i];
        if (jb.mode == 1) { const float g = jb.gain[jb.kt * 128 + k]; w.x *= g; w.y *= g; w.z *= g; w.w *= g; }
        if (jb.f8) { *(unsigned*)((char*)smem + k * CONV8_RS + n4 * 4) = pk4_fp8(w.x * W8_SCALE, w.y * W8_SCALE, w.z * W8_SCALE, w.w * W8_SCALE); continue; }
        u32x2 pk; pk.x = cvtpk(w.x, w.y); pk.y = cvtpk(w.z, w.w);
        *(u32x2*)(T + k * 260 + n4 * 4) = pk;
    }
}
__device__ __forceinline__ void conv_readout(const ConvJob& jb) {
    const bf16_t* T = (const bf16_t*)smem;
    const int tid = threadIdx.x, k0 = jb.kt * 128;
    if (jb.f8) {
        const unsigned char* T8 = (const unsigned char*)smem;
#pragma unroll
        for (int i = 0; i < 4; ++i) {
            const int cc = tid + 512 * i, nn = cc >> 3, kc = cc & 7;
            const int col = (jb.mode == 2) ? (2 * (nn & 127) + (nn >> 7)) : nn;
            unsigned e[16];
#pragma unroll
            for (int j = 0; j < 16; ++j) e[j] = T8[(kc * 16 + j) * CONV8_RS + col];
            u32x4 o;
#pragma unroll
            for (int q = 0; q < 4; ++q) o[q] = e[4 * q] | (e[4 * q + 1] << 8) | (e[4 * q + 2] << 16) | (e[4 * q + 3] << 24);
            __builtin_nontemporal_store(o, (u32x4*)((char*)jb.dst + (size_t)(jb.nt * 256 + nn) * jb.K + k0 + kc * 16));
        }
        return;
    }
#pragma unroll
    for (int i = 0; i < 8; ++i) {
        const int cc = tid + 512 * i, nn = cc >> 4, kc = cc & 15;
        const int col = (jb.mode == 2) ? (2 * (nn & 127) + (nn >> 7)) : nn;
        unsigned short e[8];
#pragma unroll
        for (int j = 0; j < 8; ++j) e[j] = T[(kc * 8 + j) * 260 + col];
        u32x4 o; o.x = e[0] | ((unsigned)e[1] << 16); o.y = e[2] | ((unsigned)e[3] << 16); o.z = e[4] | ((unsigned)e[5] << 16); o.w = e[6] | ((unsigned)e[7] << 16);
        __builtin_nontemporal_store(o, (u32x4*)(jb.dst + (size_t)(jb.nt * 256 + nn) * jb.K + k0 + kc * 8));
    }
}

__device__ __forceinline__ void adaln_job(PRef p, int job) {
    const int l = job / 24, cb = (job % 24) * 256, tid = threadIdx.x;
    float* sv = (float*)smem;
    for (int i = tid; i < 2048; i += NTH) { const int k = i & 1023; const float xx = (i < 1024) ? p.c[k] : p.c_ctx[k]; sv[i] = silu_f(xx); }
    __syncthreads();
    const int col4 = tid & 63, kq = tid >> 6;
    float4 a0 = make_float4(0, 0, 0, 0), a1 = make_float4(0, 0, 0, 0);
    const float* w = p.ada_w + ((size_t)l * 1024 + kq * 128) * 6144 + cb + col4 * 4;
#pragma unroll 8
    for (int k = 0; k < 128; ++k) {
        const float4 wv = *(const float4*)(w + (size_t)k * 6144);
        const float s0 = sv[kq * 128 + k], s1 = sv[1024 + kq * 128 + k];
        a0.x += s0 * wv.x; a0.y += s0 * wv.y; a0.z += s0 * wv.z; a0.w += s0 * wv.w;
        a1.x += s1 * wv.x; a1.y += s1 * wv.y; a1.z += s1 * wv.z; a1.w += s1 * wv.w;
    }
    float* red = sv + 2048;
    *(float4*)(red + (kq * 2 + 0) * 256 + col4 * 4) = a0;
    *(float4*)(red + (kq * 2 + 1) * 256 + col4 * 4) = a1;
    __syncthreads();
    {
        const int s = tid >> 8, col = tid & 255;
        float acc = p.ada_b[l * 6144 + cb + col];
#pragma unroll
        for (int q = 0; q < 8; ++q) acc += red[(q * 2 + s) * 256 + col];
        ((float*)(p.ws + WS_MOD))[(l * 2 + s) * 6144 + cb + col] = acc;
    }
    __syncthreads();
}

__device__ __forceinline__ void tables_job(PRef p) {
    float* rope = (float*)(p.ws + WS_ROPE);
    const int tid = threadIdx.x;
    for (int i = tid; i < (256 + 64) * 16; i += NTH) {
        const bool isrow = i < 256 * 16;
        const int idx = isrow ? i : i - 256 * 16, pos = idx >> 4, j = idx & 15;
        const float inv = exp2f(-(float)j * (13.287712379549449f / 16.f));
        const float ang = (float)pos * inv;
        float rev = ang * 0.15915494309189535f; rev -= rintf(rev);
        const float cs = __builtin_amdgcn_cosf(rev), sn = __builtin_amdgcn_sinf(rev);
        if (isrow) { rope[idx] = cs; rope[256 * 16 + idx] = sn; }
        else { rope[512 * 16 + idx] = cs; rope[512 * 16 + 64 * 16 + idx] = sn; }
    }
    if (tid < 64) ((int*)(p.ws + WS_CNT))[tid] = 0;
}
__device__ __forceinline__ void rwt_job(PRef p, int l) {
    float* dst = (float*)(p.ws + WS_RWT) + (size_t)l * 32 * 1024;
    const float* src = p.router_w + (size_t)l * 1024 * 32;
    for (int i = threadIdx.x; i < 32 * 1024; i += NTH) { const int cch = i >> 5, e = i & 31; dst[e * 1024 + cch] = src[i]; }
}

constexpr int J_IN = 8 * 8, J_UQ = 2 * 3, J_UKV = 1 * 4, J_OUT0 = 32, J_QKV = 8 * 12, J_NAO = 32, J_W1 = 64 * 64, J_W2 = 64 * 32;
constexpr int J_TOTAL = J_IN + J_UQ + J_UKV + J_OUT0 + J_QKV + J_NAO + J_W1 + J_W2;
__device__ __forceinline__ ConvJob conv_decode(PRef p, int j) {
    ConvJob jb; jb.gain = nullptr; jb.mode = 0; jb.f8 = 0;
    int t = j;
    if (t < J_W1) { const int m = t >> 6, q = t & 63; jb.src = p.moe_w1 + (size_t)m * 1024 * 2048; jb.dst = (bf16_t*)(p.ws + WS_W1T + (size_t)m * 2048 * 1024); jb.K = 1024; jb.Nsrc = 2048; jb.kt = q >> 3; jb.nt = q & 7; jb.mode = 2; jb.f8 = 1; return jb; } t -= J_W1;
    if (t < J_W2) { const int m = t >> 5, q = t & 31; jb.src = p.moe_w2 + (size_t)m * 1024 * 1024; jb.dst = (bf16_t*)(p.ws + WS_W2T + (size_t)m * 1024 * 1024); jb.K = 1024; jb.Nsrc = 1024; jb.kt = q >> 2; jb.nt = q & 3; jb.f8 = 1; return jb; } t -= J_W2;
    if (t < J_IN) { jb.src = p.ab_in_w; jb.dst = (bf16_t*)(p.ws + WS_WIN); jb.K = 1024; jb.Nsrc = 2016; jb.kt = t / 8; jb.nt = t % 8; return jb; } t -= J_IN;
    if (t < J_UQ) { jb.src = p.mla_wuq; jb.dst = (bf16_t*)(p.ws + WS_WUQ); jb.K = 256; jb.Nsrc = 768; jb.kt = t / 3; jb.nt = t % 3; jb.mode = 1; jb.gain = p.mla_qnorm; return jb; } t -= J_UQ;
    if (t < J_UKV) { jb.src = p.mla_wukv; jb.dst = (bf16_t*)(p.ws + WS_WUKV); jb.K = 128; jb.Nsrc = 1024; jb.kt = 0; jb.nt = t; jb.mode = 1; jb.gain = p.mla_kvnorm; return jb; } t -= J_UKV;
    if (t < J_OUT0) { jb.src = p.ab_out_w; jb.dst = (bf16_t*)(p.ws + WS_WOUT0); jb.K = 1024; jb.Nsrc = 1024; jb.kt = t / 4; jb.nt = t % 4; return jb; } t -= J_OUT0;
    if (t < J_QKV) { jb.src = p.na_qkv_w; jb.dst = (bf16_t*)(p.ws + WS_WQKV); jb.K = 1024; jb.Nsrc = 3072; jb.kt = t / 12; jb.nt = t % 12; return jb; } t -= J_QKV;
    jb.src = p.na_out_w; jb.dst = (bf16_t*)(p.ws + WS_WNAO); jb.K = 1024; jb.Nsrc = 1024; jb.kt = t / 4; jb.nt = t % 4; return jb;
}

__device__ __forceinline__ void phase_prologue(PRef p) {
    const int G = gridDim.x, b = blockIdx.x;
    for (int j = b; j < 51; j += G) {
        if (j < 48) adaln_job(p, j);
        else if (j == 48) tables_job(p);
        else rwt_job(p, j - 49);
    }
    __syncthreads();
    int j = b;
    if (j >= J_TOTAL) return;
    ConvJob cur = conv_decode(p, j);
    float4 v[16];
    conv_load(cur, v);
    for (;;) {
        conv_to_lds(cur, v);
        __syncthreads();
        const int jn = j + G;
        ConvJob nxt = cur;
        if (jn < J_TOTAL) { nxt = conv_decode(p, jn); conv_load(nxt, v); }
        conv_readout(cur);
        __syncthreads();
        if (jn >= J_TOTAL) break;
        cur = nxt; j = jn;
    }
}

namespace gm {
constexpr int BK = 64, HT = 128 * 64;
__device__ __forceinline__ int lds_byte(int r, int c) { const int st = (r >> 4) * 2 + (c >> 5), rr = r & 15, cc = c & 31, ob = rr * 64 + cc * 2; return st * 1024 + (ob ^ (((ob >> 9) & 1) << 5)); }
__device__ __forceinline__ void stage_rc(int b, int& R, int& C) { const int st = b / 1024, sb = b % 1024, swz = sb ^ (((sb >> 9) & 1) << 5); R = (st >> 1) * 16 + swz / 64; C = (st & 1) * 32 + (swz % 64) / 2; }

template <class Epi>
__device__ __forceinline__ void gemm_tile(const bf16_t* __restrict__ A, const int (&aoff)[2][2], const bf16_t* __restrict__ Bt, const int (&boff)[2], int nk, Epi& epi) {
    bf16_t* shm = (bf16_t*)smem;
    const int tid = tid_opaque(), wid = tid >> 6, lane = tid & 63, wr = wid >> 1, wc = wid & 1, fr = lane & 15, fq = lane >> 4;
    f32x4 acc[4][4];
#pragma unroll
    for (int m = 0; m < 4; ++m)
#pragma unroll
        for (int n = 0; n < 4; ++n) acc[m][n] = (f32x4){0.f, 0.f, 0.f, 0.f};
#define GM_STAGE(buf, kt) do { \
        _Pragma("unroll") for (int _i = 0; _i < 2; ++_i) { \
            __builtin_amdgcn_global_load_lds((const unsigned*)(A + aoff[0][_i] + (kt) * BK), (unsigned*)((char*)(shm + ((buf) * 3 + 0) * HT) + tid * 16 + _i * 8192), 16, 0, 0); \
            __builtin_amdgcn_global_load_lds((const unsigned*)(A + aoff[1][_i] + (kt) * BK), (unsigned*)((char*)(shm + ((buf) * 3 + 1) * HT) + tid * 16 + _i * 8192), 16, 0, 0); \
            __builtin_amdgcn_global_load_lds((const unsigned*)(Bt + boff[_i] + (kt) * BK), (unsigned*)((char*)(shm + ((buf) * 3 + 2) * HT) + tid * 16 + _i * 8192), 16, 0, 0); } } while (0)
    GM_STAGE(0, 0);
    for (int kt = 0; kt < nk; ++kt) {
        __syncthreads();
        const int buf = kt & 1;
        if (kt + 1 < nk) GM_STAGE(buf ^ 1, kt + 1);
        const char* Ab = (const char*)(shm + (buf * 3 + (wr >> 1)) * HT);
        const char* Bb = (const char*)(shm + (buf * 3 + 2) * HT);
#pragma unroll
        for (int k = 0; k < 2; ++k) {
            bf16x8 Bf[4], Af[4];
#pragma unroll
            for (int n = 0; n < 4; ++n) Bf[n] = *(const bf16x8*)(Bb + lds_byte(wc * 64 + n * 16 + fr, k * 32 + fq * 8));
#pragma unroll
            for (int m = 0; m < 4; ++m) Af[m] = *(const bf16x8*)(Ab + lds_byte((wr & 1) * 64 + m * 16 + fr, k * 32 + fq * 8));
#pragma unroll
            for (int m = 0; m < 4; ++m)
#pragma unroll
                for (int n = 0; n < 4; ++n) acc[m][n] = __builtin_amdgcn_mfma_f32_16x16x32_bf16(Af[m], Bf[n], acc[m][n], 0, 0, 0);
        }
    }
#undef GM_STAGE
    float* stg = (float*)smem;
    __syncthreads();
    {
        float* wb = stg + (wr * 64 + fq * 4) * 132 + wc * 64 + fr;
#pragma unroll
        for (int m = 0; m < 4; ++m)
#pragma unroll
            for (int n = 0; n < 4; ++n)
#pragma unroll
                for (int j = 0; j < 4; ++j) wb[(m * 16 + j) * 132 + n * 16] = acc[m][n][j];
    }
    __syncthreads();
    if (Epi::MOE1) {
        const int fch = tid & 7, rg = tid >> 3;
        for (int ps = 0; ps < 4; ++ps) {
            const int row = ps * 64 + rg;
            const float* q = stg + row * 132 + (fch >> 1) * 32 + (fch & 1) * 8;
            float g[8], l[8];
            *(f32x4*)&g[0] = *(const f32x4*)q; *(f32x4*)&g[4] = *(const f32x4*)(q + 4);
            *(f32x4*)&l[0] = *(const f32x4*)(q + 16); *(f32x4*)&l[4] = *(const f32x4*)(q + 20);
            epi.pair(row, fch * 8, g, l);
        }
    } else {
        const int ch = tid & 15, rg = tid >> 4;
        for (int ps = 0; ps < 8; ++ps) {
            const int row = ps * 32 + rg;
            const float* q = stg + row * 132 + ch * 8;
            float v[8];
            *(f32x4*)&v[0] = *(const f32x4*)q; *(f32x4*)&v[4] = *(const f32x4*)(q + 4);
            epi.row8(row, ch * 8, v);
        }
    }
    __syncthreads();
}
__device__ __forceinline__ void make_off(int (&off)[2][2], int row0, int ld) {
#pragma unroll
    for (int h = 0; h < 2; ++h)
#pragma unroll
        for (int i = 0; i < 2; ++i) { int R, C; stage_rc(tid_opaque() * 16 + i * 8192, R, C); off[h][i] = (row0 + h * 128 + R) * ld + C; }
}
__device__ __forceinline__ void make_off1(int (&off)[2], int row0, int ld) {
#pragma unroll
    for (int i = 0; i < 2; ++i) { int R, C; stage_rc(tid_opaque() * 16 + i * 8192, R, C); off[i] = (row0 + R) * ld + C; }
}
}

namespace pg8 {
#define PG8_LAS __attribute__((address_space(3)))
constexpr int BM = 256, BK = 64, HALF = 128, HTB = HALF * BK * 2, STAGE_BYTES = 8 * HTB, NXCD = 8, WGM = 8;
__device__ __forceinline__ int lds_byte(int r, int c) { const int st = (r >> 4) * 2 + (c >> 5), rr = r & 15, cc = c & 31, ob = rr * 64 + cc * 2; return st * 1024 + (ob ^ (((ob >> 9) & 1) << 5)); }
__device__ __forceinline__ void stage_rc(int b, int& R, int& C) { const int st = b / 1024, sb = b % 1024, swz = sb ^ (((sb >> 9) & 1) << 5); R = (st >> 1) * 16 + swz / 64; C = (st & 1) * 32 + (swz % 64) / 2; }
__device__ __forceinline__ int perm32(int rho) { const int n = rho >> 4, i = rho & 15; return 8 * (i >> 2) + 4 * n + (i & 3); }
struct Unit { int pm, pn, e, nvalid, slot0, lbase; };

template <class Epi, class Sched, bool GATHER, bool F8 = false>
__device__ __forceinline__ void gemm_phase(PG8_LAS unsigned char* lds, const Sched& S, const Epi& E, int K, int lda, int ldb, int scA = 0x7F7F7F7F, int scB = 0x7F7F7F7F) {
    const int tid = tid_opaque(), wid = __builtin_amdgcn_readfirstlane(tid >> 6), lane = tid & 63, wr = wid >> 2, wc = wid & 3, fr = lane & 15, fq = lane >> 4;
    const int nt = K / BK;
    unsigned voffA[2], voffB[2]; int gR[2], gC[2];
#pragma unroll
    for (int i = 0; i < 2; ++i) { int R, C; stage_rc(tid * 16 + i * 8192, R, C); const int Rb = Epi::PERM ? ((R & ~31) + perm32(R & 31)) : R;
        voffA[i] = (unsigned)(R * lda + C) * 2u; voffB[i] = (unsigned)(Rb * ldb + C) * 2u; gR[i] = R; gC[i] = C * 2; }
    const size_t kstep = (size_t)(BK * 2);
    const size_t hstepA = (size_t)HALF * lda * 2, hstepB = (size_t)HALF * ldb * 2;
    const unsigned ldsw = (unsigned)wid * 1024u;
    const int aoff = lds_byte(wr * 64 + fr, fq * 8), boff = lds_byte(wc * 32 + fr, fq * 8);
    unsigned gA[2][2] = {{0u, 0u}, {0u, 0u}};
#define PG8_SA(b, h) (((b) * 2 + (h)) * HTB)
#define PG8_SB(b, h) ((4 + (b) * 2 + (h)) * HTB)
#define PG8_STAGE(bufoff, gbase, voff) do { _Pragma("unroll") for (int _i = 0; _i < 2; ++_i) \
        __builtin_amdgcn_global_load_lds((const unsigned*)((const char*)(gbase) + (voff)[_i]), (PG8_LAS unsigned*)(lds + (bufoff) + ldsw + _i * 8192), 16, 0, 0); } while (0)
#define PG8_STAGE_A(bufoff, base, h) do { if constexpr (GATHER) PG8_STAGE(bufoff, base, gA[h]); else PG8_STAGE(bufoff, (base) + (h) * hstepA, voffA); } while (0)
#define PG8_LDA(dst, b, h) do { _Pragma("unroll") for (int m = 0; m < 4; ++m) _Pragma("unroll") for (int k = 0; k < 2; ++k) dst[m][k] = *(const PG8_LAS bf16x8*)(lds + PG8_SA(b, h) + aoff + m * 2048 + k * 1024); } while (0)
#define PG8_LDB(dst, b, h) do { _Pragma("unroll") for (int n = 0; n < 2; ++n) _Pragma("unroll") for (int k = 0; k < 2; ++k) dst[n][k] = *(const PG8_LAS bf16x8*)(lds + PG8_SB(b, h) + boff + n * 2048 + k * 1024); } while (0)
#define PG8_MMA(ai, bj, At, Bt) do { __builtin_amdgcn_s_setprio(1); _Pragma("unroll") for (int m = 0; m < 4; ++m) _Pragma("unroll") for (int n = 0; n < 2; ++n) { \
        if constexpr (F8) { const i32x4 _b0 = __builtin_bit_cast(i32x4, Bt[n][0]), _b1 = __builtin_bit_cast(i32x4, Bt[n][1]), _a0 = __builtin_bit_cast(i32x4, At[m][0]), _a1 = __builtin_bit_cast(i32x4, At[m][1]); \
            acc[ai][bj][m][n] = __builtin_amdgcn_mfma_scale_f32_16x16x128_f8f6f4(__builtin_shufflevector(_b0, _b1, 0, 1, 2, 3, 4, 5, 6, 7), __builtin_shufflevector(_a0, _a1, 0, 1, 2, 3, 4, 5, 6, 7), acc[ai][bj][m][n], 0, 0, 0, scB, 0, scA); } \
        else { _Pragma("unroll") for (int k = 0; k < 2; ++k) acc[ai][bj][m][n] = __builtin_amdgcn_mfma_f32_16x16x32_bf16(Bt[n][k], At[m][k], acc[ai][bj][m][n], 0, 0, 0); } } __builtin_amdgcn_s_setprio(0); } while (0)
#define PG8_WAIT_V(n) asm volatile("s_waitcnt vmcnt(" #n ")" ::: "memory")
#define PG8_WAIT_L(n) asm volatile("s_waitcnt lgkmcnt(" #n ")" ::: "memory")
#define PG8_BAR __builtin_amdgcn_s_barrier()
#define PG8_SCHED __builtin_amdgcn_sched_barrier(0)
#define PG8_GLOAD(U_) do { _Pragma("unroll") for (int _h = 0; _h < 2; ++_h) _Pragma("unroll") for (int _i = 0; _i < 2; ++_i) \
        gA[_h][_i] = ((unsigned)S.grow(U_, _h * 128 + gR[_i]) << (F8 ? 10 : 11)) + (unsigned)gC[_i]; } while (0)
    unsigned gN[2][2] = {{0u, 0u}, {0u, 0u}};
#define PG8_GLOADN(U_) do { _Pragma("unroll") for (int _h = 0; _h < 2; ++_h) _Pragma("unroll") for (int _i = 0; _i < 2; ++_i) gN[_h][_i] = (unsigned)S.grow(U_, _h * 128 + gR[_i]); } while (0)
#define PG8_GSWITCH() do { _Pragma("unroll") for (int _h = 0; _h < 2; ++_h) _Pragma("unroll") for (int _i = 0; _i < 2; ++_i) gA[_h][_i] = (gN[_h][_i] << (F8 ? 10 : 11)) + (unsigned)gC[_i]; } while (0)
    Unit cur, nxt; int ui = 0;
    if (!S.next(0, cur)) return;
    f32x4 acc[2][2][4][2];
#pragma unroll
    for (int a = 0; a < 2; ++a)
#pragma unroll
        for (int b = 0; b < 2; ++b)
#pragma unroll
            for (int m = 0; m < 4; ++m)
#pragma unroll
                for (int n = 0; n < 2; ++n) acc[a][b][m][n] = (f32x4){0.f, 0.f, 0.f, 0.f};
    bf16x8 At[4][2], B0[2][2], B1[2][2];
    const char* cA = S.a_base(cur); const char* cB = S.b_base(cur);
    if constexpr (GATHER) PG8_GLOAD(cur);
    PG8_STAGE(PG8_SB(0, 0), cB, voffB); PG8_STAGE_A(PG8_SA(0, 0), cA, 0); PG8_STAGE(PG8_SB(0, 1), cB + hstepB, voffB); PG8_STAGE_A(PG8_SA(0, 1), cA, 1);
    if (wr == 1) PG8_BAR;
    PG8_WAIT_V(4); PG8_BAR;
    PG8_STAGE(PG8_SB(1, 0), cB + kstep, voffB); PG8_STAGE_A(PG8_SA(1, 0), cA + kstep, 0); PG8_STAGE(PG8_SB(1, 1), cB + hstepB + kstep, voffB);
    PG8_WAIT_V(6); PG8_BAR;
    for (;;) {
        const bool has_next = S.next(ui + 1, nxt);
        const char* nA = has_next ? S.a_base(nxt) : cA; const char* nB = has_next ? S.b_base(nxt) : cB;
#pragma unroll 1
        for (int t = 0; t < nt; t += 2) {
            const bool last = (t == nt - 2);
            if constexpr (GATHER) { if (t == 0 && has_next) PG8_GLOADN(nxt); }
            const char* a1 = cA + (size_t)(t + 1) * kstep;
            const char* a2 = last ? nA : cA + (size_t)(t + 2) * kstep; const char* b2 = last ? nB : cB + (size_t)(t + 2) * kstep;
            const char* a3 = a2 + kstep; const char* b3 = b2 + kstep;
            PG8_LDB(B0, 0, 0); PG8_SCHED; PG8_LDA(At, 0, 0); PG8_STAGE_A(PG8_SA(1, 1), a1, 1);
            PG8_WAIT_L(8); PG8_BAR; PG8_WAIT_L(0); PG8_MMA(0, 0, At, B0); PG8_BAR; PG8_SCHED;
            if constexpr (GATHER) { if (last && has_next) PG8_GSWITCH(); }
            PG8_LDB(B1, 0, 1); PG8_STAGE(PG8_SB(0, 0), b2, voffB);
            PG8_BAR; PG8_WAIT_L(0); PG8_MMA(0, 1, At, B1); PG8_BAR;
            PG8_LDA(At, 0, 1); PG8_STAGE_A(PG8_SA(0, 0), a2, 0);
            PG8_BAR; PG8_WAIT_L(0); PG8_MMA(1, 0, At, B0); PG8_BAR; PG8_SCHED;
            PG8_STAGE(PG8_SB(0, 1), b2 + hstepB, voffB);
            PG8_WAIT_V(6); PG8_BAR; PG8_MMA(1, 1, At, B1); PG8_BAR;
            PG8_LDB(B0, 1, 0); PG8_SCHED; PG8_LDA(At, 1, 0); PG8_STAGE_A(PG8_SA(0, 1), a2, 1);
            PG8_WAIT_L(8); PG8_BAR; PG8_WAIT_L(0); PG8_MMA(0, 0, At, B0); PG8_BAR; PG8_SCHED;
            PG8_LDB(B1, 1, 1); PG8_STAGE(PG8_SB(1, 0), b3, voffB);
            PG8_BAR; PG8_WAIT_L(0); PG8_MMA(0, 1, At, B1); PG8_BAR;
            PG8_LDA(At, 1, 1); PG8_STAGE_A(PG8_SA(1, 0), a3, 0);
            PG8_BAR; PG8_WAIT_L(0); PG8_MMA(1, 0, At, B0); PG8_BAR; PG8_SCHED;
            PG8_STAGE(PG8_SB(1, 1), b3 + hstepB, voffB);
            PG8_WAIT_V(6); PG8_BAR; PG8_MMA(1, 1, At, B1); PG8_BAR;
        }
        { int fr_e = fr, fq_e = fq; asm volatile("" : "+v"(fr_e), "+v"(fq_e));
          E(acc, cur, wr, wc, fr_e, fq_e); }
        if (!has_next) break;
#pragma unroll
        for (int a = 0; a < 2; ++a)
#pragma unroll
            for (int b = 0; b < 2; ++b)
#pragma unroll
                for (int m = 0; m < 4; ++m)
#pragma unroll
                    for (int n = 0; n < 2; ++n) acc[a][b][m][n] = (f32x4){0.f, 0.f, 0.f, 0.f};
        cur = nxt; cA = nA; cB = nB; ++ui;
    }
    PG8_WAIT_V(0);
    if (wr == 0) PG8_BAR;
    PG8_BAR;
#undef PG8_SA
#undef PG8_SB
#undef PG8_STAGE
#undef PG8_STAGE_A
#undef PG8_LDA
#undef PG8_LDB
#undef PG8_MMA
#undef PG8_WAIT_V
#undef PG8_WAIT_L
#undef PG8_BAR
#undef PG8_SCHED
#undef PG8_GLOAD
#undef PG8_GLOADN
#undef PG8_GSWITCH
}

struct PlainOrder {
    const char* A; const char* Bt; int lda, ldb, nM, nN, nwg, G, c;
    __device__ void init(const bf16_t* A_, int lda_, const bf16_t* Bt_, int ldb_, int nM_, int nN_) { A = (const char*)A_; Bt = (const char*)Bt_; lda = lda_; ldb = ldb_; nM = nM_; nN = nN_; nwg = nM * nN; G = gridDim.x; c = blockIdx.x; }
    __device__ __forceinline__ bool next(int i, Unit& u) const {
        const long L = (long)i * G + c; if (L >= nwg) return false;
        int wgid = (int)L; { const int q = nwg / NXCD, r = nwg % NXCD, xcd = wgid % NXCD, off = wgid / NXCD; wgid = (xcd < r ? xcd * (q + 1) : r * (q + 1) + (xcd - r) * q) + off; }
        const int nig = WGM * nN, gid = wgid / nig, fm = gid * WGM, gsz = (nM - fm) < WGM ? (nM - fm) : WGM;
        u.pm = fm + ((wgid % nig) % gsz); u.pn = (wgid % nig) / gsz; u.e = 0; u.nvalid = 256; u.slot0 = 0; return true;
    }
    __device__ __forceinline__ const char* a_base(const Unit& u) const { return A + (size_t)u.pm * 256 * lda * 2; }
    __device__ __forceinline__ const char* b_base(const Unit& u) const { return Bt + (size_t)u.pn * 256 * ldb * 2; }
    __device__ __forceinline__ int grow(const Unit&, int) const { return 0; }
};
struct MoeOrder {
    const char* A; const char* W; const PG8_LAS int* tab; const PG8_LAS int* gl; int wrows, nunits;
    __device__ __forceinline__ bool next(int i, Unit& u) const {
        if (i >= nunits) return false;
        const PG8_LAS int* t = tab + i * 8;
        u.pm = t[0]; u.pn = t[1]; u.e = t[2]; u.nvalid = t[3]; u.slot0 = t[4]; u.lbase = t[6]; return true;
    }
    __device__ __forceinline__ const char* a_base(const Unit& u) const { return A + (size_t)u.slot0 * 1024; }
    __device__ __forceinline__ const char* b_base(const Unit& u) const { return W + ((size_t)u.e * wrows + (size_t)u.pn * 256) * 1024; }
    __device__ __forceinline__ int grow(const Unit& u, int r) const { return u.slot0 + r; }
};
constexpr int MOE_UNITS_MAX = 16;
__device__ __forceinline__ int moe_build_units(PG8_LAS int* tab, const int* cnt, const int* off, const int* toff, int nN) {
    const int G = gridDim.x, c = blockIdx.x, x = c & 7, j = c >> 3, per = (G >> 3) / nN, nMt = toff[32];
    const int i = threadIdx.x;
    if (i < MOE_UNITS_MAX) {
        const int pn = j % nN, mt = (i * 8 + x) * per + j / nN;
        int e = 0, valid = (mt < nMt && j < per * nN) ? 1 : 0;
        if (valid) { while (toff[e + 1] <= mt) ++e; }
        const int m = mt - toff[e];
        tab[i * 8 + 0] = mt; tab[i * 8 + 1] = pn; tab[i * 8 + 2] = e; tab[i * 8 + 3] = cnt[e] - m * 256; tab[i * 8 + 4] = off[e] + m * 256; tab[i * 8 + 5] = valid; tab[i * 8 + 6] = e * NTOK + m * 256;
    }
    __syncthreads();
    int n = 0;
    while (n < MOE_UNITS_MAX && tab[n * 8 + 5]) ++n;
    return n;
}
struct MoeOrderG : MoeOrder { const int* list;
    __device__ __forceinline__ const char* a_base(const Unit&) const { return A; }
    __device__ __forceinline__ int grow(const Unit& u, int r) const { const int rc = r < u.nvalid ? r : u.nvalid - 1; return list[u.lbase + rc]; } };
struct MoeOrderI : MoeOrder { __device__ __forceinline__ const char* a_base(const Unit&) const { return A; } };

__device__ __forceinline__ u32x4 pk8(const f32x4& a, const f32x4& b) { return (u32x4){cvtpk(a[0], a[1]), cvtpk(a[2], a[3]), cvtpk(b[0], b[1]), cvtpk(b[2], b[3])}; }
struct EpiStore {
    static constexpr bool PERM = true;
    bf16_t* C; int ldc; const float* rs;
    __device__ __forceinline__ void operator()(const f32x4 (&acc)[2][2][4][2], const Unit& u, int wr, int wc, int fr, int fq) const {
        bf16_t* base = C + ((size_t)u.pm * 256 + wr * 64 + fr) * ldc + u.pn * 256 + wc * 32 + 8 * fq;
#pragma unroll
        for (int ai = 0; ai < 2; ++ai)
#pragma unroll
            for (int m = 0; m < 4; ++m) { bf16_t* rowp = base + (size_t)(ai * HALF + m * 16) * ldc; const float s = rs ? rs[ai * HALF + wr * 64 + m * 16 + fr] : 1.f;
#pragma unroll
                for (int bj = 0; bj < 2; ++bj) *(u32x4*)(rowp + bj * HALF) = pk8(acc[ai][bj][m][0] * s, acc[ai][bj][m][1] * s); }
    }
};
constexpr float ACT8_SCALE = 4.f;
struct EpiAct {
    static constexpr bool PERM = true;
    unsigned char* Act; const float* b1all; unsigned char* dummy;
    __device__ __forceinline__ void operator()(const f32x4 (&acc)[2][2][4][2], const Unit& u, int wr, int wc, int fr, int fq) const {
        const int f0 = u.pn * 128 + wc * 32 + 8 * fq;
        const float* bb = b1all + (size_t)u.e * 2048 + 2 * f0;
        f32x4 bv[4];
#pragma unroll
        for (int q = 0; q < 4; ++q) bv[q] = *(const f32x4*)(bb + 4 * q);
        unsigned char* base = Act + ((size_t)u.slot0 + wr * 64 + fr) * 1024 + f0;
#pragma unroll
        for (int ai = 0; ai < 2; ++ai)
#pragma unroll
            for (int m = 0; m < 4; ++m) {
                const int r = ai * HALF + wr * 64 + m * 16 + fr;
                float a[8];
#pragma unroll
                for (int n = 0; n < 2; ++n)
#pragma unroll
                    for (int j = 0; j < 4; ++j) { const int f = 4 * n + j;
                        float glu = acc[ai][0][m][n][j] + bv[f >> 1][(f & 1) * 2], lin = acc[ai][1][m][n][j] + bv[f >> 1][(f & 1) * 2 + 1];
                        glu = fminf(glu, 7.f); lin = fminf(fmaxf(lin, -7.f), 7.f);
                        a[f] = glu * __builtin_amdgcn_rcpf(1.f + __builtin_amdgcn_exp2f(-1.702f * LOG2E * glu)) * (lin * ACT8_SCALE + ACT8_SCALE); }
                unsigned char* dst = (r < u.nvalid) ? base + (size_t)(ai * HALF + m * 16) * 1024 : dummy + (size_t)r * 1024 + f0;
                *(u32x2*)dst = (u32x2){pk4_fp8(a[0], a[1], a[2], a[3]), pk4_fp8(a[4], a[5], a[6], a[7])};
            }
    }
};
struct EpiBias {
    static constexpr bool PERM = true;
    bf16_t* Y; const float* b2all; bf16_t* dummy;
    __device__ __forceinline__ void operator()(const f32x4 (&acc)[2][2][4][2], const Unit& u, int wr, int wc, int fr, int fq) const {
        const int c0 = u.pn * 256 + wc * 32 + 8 * fq;
        const float* bb = b2all + (size_t)u.e * 1024 + c0;
        f32x4 bv[2][2];
#pragma unroll
        for (int bj = 0; bj < 2; ++bj)
#pragma unroll
            for (int n = 0; n < 2; ++n) bv[bj][n] = *(const f32x4*)(bb + bj * HALF + 4 * n);
        bf16_t* base = Y + ((size_t)u.slot0 + wr * 64 + fr) * 1024 + c0;
#pragma unroll
        for (int ai = 0; ai < 2; ++ai)
#pragma unroll
            for (int m = 0; m < 4; ++m) { const int r = ai * HALF + wr * 64 + m * 16 + fr;
                bf16_t* dst = (r < u.nvalid) ? base + (size_t)(ai * HALF + m * 16) * 1024 : dummy + (size_t)r * 1024 + c0;
#pragma unroll
                for (int bj = 0; bj < 2; ++bj) *(u32x4*)(dst + bj * HALF) = pk8(acc[ai][bj][m][0] + bv[bj][0], acc[ai][bj][m][1] + bv[bj][1]); }
    }
};
}

__device__ __forceinline__ u32x4 pack8(const float (&v)[8]) { return (u32x4){cvtpk(v[0], v[1]), cvtpk(v[2], v[3]), cvtpk(v[4], v[5]), cvtpk(v[6], v[7])}; }
struct EpiPlain {
    static constexpr bool MOE1 = false;
    bf16_t* C; int ldc;
    __device__ __forceinline__ void row8(int r, int c, const float (&v)[8]) const { *(u32x4*)(C + (size_t)r * ldc + c) = pack8(v); }
    __device__ __forceinline__ void pair(int, int, const float (&)[8], const float (&)[8]) const {}
};
struct EpiRowScale {
    static constexpr bool MOE1 = false;
    bf16_t* C; int ldc; const float* rs;
    __device__ __forceinline__ void row8(int r, int c, const float (&v)[8]) const { const float s = rs[r]; float w[8];
#pragma unroll
        for (int i = 0; i < 8; ++i) w[i] = v[i] * s;
        *(u32x4*)(C + (size_t)r * ldc + c) = pack8(w); }
    __device__ __forceinline__ void pair(int, int, const float (&)[8], const float (&)[8]) const {}
};
__device__ __forceinline__ void phase_gemm_plain(const bf16_t* A, int lda, const bf16_t* Bt, int K, bf16_t* C, int ldc, int nM, int nN) {
    const int G = gridDim.x;
    for (int u = blockIdx.x; u < nM * nN; u += G) {
        const int pm = u / nN, pn = u % nN;
        int aoff[2][2], boff[2];
        gm::make_off(aoff, pm * 256, lda); gm::make_off1(boff, pn * 128, K);
        EpiPlain epi{C + (size_t)pm * 256 * ldc + pn * 128, ldc};
        gm::gemm_tile(A, aoff, Bt, boff, K / 64, epi);
    }
}

struct Row16 { float4 v[4]; };
__device__ __forceinline__ Row16 ld_row_f32(const float* p, int lane) { Row16 r;
#pragma unroll
    for (int i = 0; i < 4; ++i) r.v[i] = *(const float4*)(p + lane * 4 + 256 * i);
    return r; }
__device__ __forceinline__ Row16 ld_row_bf16(const bf16_t* p, int lane) { Row16 r;
#pragma unroll
    for (int i = 0; i < 4; ++i) { const u32x2 w = *(const u32x2*)(p + lane * 4 + 256 * i);
        r.v[i] = make_float4(__uint_as_float(w.x << 16), __uint_as_float(w.x & 0xFFFF0000u), __uint_as_float(w.y << 16), __uint_as_float(w.y & 0xFFFF0000u)); }
    return r; }
__device__ __forceinline__ void st_row_f32(float* p, int lane, const Row16& r) {
#pragma unroll
    for (int i = 0; i < 4; ++i) *(float4*)(p + lane * 4 + 256 * i) = r.v[i]; }
__device__ __forceinline__ void st_row_bf16(bf16_t* p, int lane, const Row16& r) {
#pragma unroll
    for (int i = 0; i < 4; ++i) { u32x2 w; w.x = cvtpk(r.v[i].x, r.v[i].y); w.y = cvtpk(r.v[i].z, r.v[i].w); *(u32x2*)(p + lane * 4 + 256 * i) = w; } }
__device__ __forceinline__ void st_row_fp8(unsigned char* p, int lane, const Row16& r) {
#pragma unroll
    for (int i = 0; i < 4; ++i) *(unsigned*)(p + lane * 4 + 256 * i) = pk4_fp8(r.v[i].x, r.v[i].y, r.v[i].z, r.v[i].w); }
__device__ __forceinline__ float row_rstd(const Row16& r) {
    float s = 0.f;
#pragma unroll
    for (int i = 0; i < 4; ++i) s += r.v[i].x * r.v[i].x + r.v[i].y * r.v[i].y + r.v[i].z * r.v[i].z + r.v[i].w * r.v[i].w;
    s = wave_sum(s);
    return rsqrtf(s * (1.f / 1024.f) + EPSN);
}
__device__ __forceinline__ Row16 norm_mod(const Row16& x, float rstd, const float* g, const float* sc, const float* sh, int lane) {
    Row16 h;
#pragma unroll
    for (int i = 0; i < 4; ++i) {
        const int c = lane * 4 + 256 * i;
        const float4 gv = *(const float4*)(g + c), scv = *(const float4*)(sc + c), shv = *(const float4*)(sh + c);
        h.v[i].x = x.v[i].x * rstd * gv.x * (1.f + scv.x) + shv.x; h.v[i].y = x.v[i].y * rstd * gv.y * (1.f + scv.y) + shv.y;
        h.v[i].z = x.v[i].z * rstd * gv.z * (1.f + scv.z) + shv.z; h.v[i].w = x.v[i].w * rstd * gv.w * (1.f + scv.w) + shv.w;
    }
    return h;
}
__device__ __forceinline__ Row16 resid_add(const Row16& x, const Row16& y, float rstd, const float* g, const float* gate, int lane) {
    Row16 o;
#pragma unroll
    for (int i = 0; i < 4; ++i) {
        const int c = lane * 4 + 256 * i;
        const float4 gv = *(const float4*)(g + c), ga = *(const float4*)(gate + c);
        o.v[i].x = x.v[i].x + y.v[i].x * rstd * gv.x * ga.x; o.v[i].y = x.v[i].y + y.v[i].y * rstd * gv.y * ga.y;
        o.v[i].z = x.v[i].z + y.v[i].z * rstd * gv.z * ga.z; o.v[i].w = x.v[i].w + y.v[i].w * rstd * gv.w * ga.w;
    }
    return o;
}
__device__ __forceinline__ const float* mod_ptr(PRef p, int l, int r) { return (const float*)(p.ws + WS_MOD) + (size_t)(l * 2 + (r < CTXN ? 1 : 0)) * 6144; }
__device__ __forceinline__ const float* src_row(PRef p, int r) { return r < CTXN ? p.ctx + (size_t)r * 1024 : p.x + (size_t)(r - CTXN) * 1024; }

struct ModAB { float4 a[4], b[4]; };
struct ModG { float4 g[4]; };
__device__ __forceinline__ ModAB load_ab(const float* g, const float* sc, const float* sh, int lane) { ModAB m;
#pragma unroll
    for (int i = 0; i < 4; ++i) { const int c = lane * 4 + 256 * i; const float4 gv = *(const float4*)(g + c), sv = *(const float4*)(sc + c); m.b[i] = *(const float4*)(sh + c);
        m.a[i] = make_float4(gv.x * (1.f + sv.x), gv.y * (1.f + sv.y), gv.z * (1.f + sv.z), gv.w * (1.f + sv.w)); }
    return m; }
__device__ __forceinline__ ModG load_g(const float* g, const float* gate, int lane) { ModG m;
#pragma unroll
    for (int i = 0; i < 4; ++i) { const int c = lane * 4 + 256 * i; const float4 gv = *(const float4*)(g + c), ga = *(const float4*)(gate + c); m.g[i] = make_float4(gv.x * ga.x, gv.y * ga.y, gv.z * ga.z, gv.w * ga.w); }
    return m; }
__device__ __forceinline__ Row16 apply_ab(const Row16& x, float rstd, const ModAB& m) { Row16 h;
#pragma unroll
    for (int i = 0; i < 4; ++i) h.v[i] = make_float4(x.v[i].x * rstd * m.a[i].x + m.b[i].x, x.v[i].y * rstd * m.a[i].y + m.b[i].y, x.v[i].z * rstd * m.a[i].z + m.b[i].z, x.v[i].w * rstd * m.a[i].w + m.b[i].w);
    return h; }
__device__ __forceinline__ Row16 apply_g(const Row16& x, const Row16& y, float rstd, const ModG& m) { Row16 o;
#pragma unroll
    for (int i = 0; i < 4; ++i) o.v[i] = make_float4(x.v[i].x + y.v[i].x * rstd * m.g[i].x, x.v[i].y + y.v[i].y * rstd * m.g[i].y, x.v[i].z + y.v[i].z * rstd * m.g[i].z, x.v[i].w + y.v[i].w * rstd * m.g[i].w);
    return o; }
struct RowB8 { u32x2 v[4]; };
__device__ __forceinline__ RowB8 ld_rowb(const bf16_t* p, int lane) { RowB8 r;
#pragma unroll
    for (int i = 0; i < 4; ++i) r.v[i] = *(const u32x2*)(p + lane * 4 + 256 * i);
    return r; }
__device__ __forceinline__ Row16 cvt_rowb(const RowB8& b) { Row16 r;
#pragma unroll
    for (int i = 0; i < 4; ++i) r.v[i] = make_float4(__uint_as_float(b.v[i].x << 16), __uint_as_float(b.v[i].x & 0xFFFF0000u), __uint_as_float(b.v[i].y << 16), __uint_as_float(b.v[i].y & 0xFFFF0000u));
    return r; }

__device__ __forceinline__ void phase_norm1_l0(PRef p) {
    const int lane = threadIdx.x & 63, wave = threadIdx.x >> 6, G = gridDim.x, step = G * 8;
    bf16_t* HB = (bf16_t*)(p.ws + WS_HB);
    int r = blockIdx.x * 8 + wave;
    if (r >= NTOK) return;
    int cur_s = (r < CTXN) ? 1 : 0;
    const float* mod = mod_ptr(p, 0, r);
    ModAB m = load_ab(p.norm_g, mod + 1024, mod, lane);
    Row16 x = ld_row_f32(src_row(p, r), lane);
    for (; r < NTOK; r += step) {
        const int rn = r + step;
        Row16 xn = x;
        if (rn < NTOK) xn = ld_row_f32(src_row(p, rn), lane);
        const int s_ = (r < CTXN) ? 1 : 0;
        if (s_ != cur_s) { cur_s = s_; const float* md = mod_ptr(p, 0, r); m = load_ab(p.norm_g, md + 1024, md, lane); }
        const float rstd = row_rstd(x);
        st_row_bf16(HB + (size_t)r * 1024, lane, apply_ab(x, rstd, m));
        x = xn;
    }
}

__device__ __forceinline__ void phase_mid(PRef p, int l) {
    const int tid = tid_opaque(), lane = tid & 63, wave = tid >> 6, G = gridDim.x;
    float* wT = (float*)smem;
    int* lcnt = (int*)(smem + 139264);
    int* lbase = lcnt + 32;
    int* sel = lbase + 32;
    {
        const float4* src = (const float4*)((const float*)(p.ws + WS_RWT) + (size_t)l * 32 * 1024);
        for (int i = tid; i < 32 * 1024 / 4; i += NTH) ((float4*)wT)[i] = src[i];
        if (tid < 32) lcnt[tid] = 0;
    }
    __syncthreads();
    const int r_begin = (l == 0) ? 0 : CTXN;
    bf16_t* HB = (bf16_t*)(p.ws + WS_HB); const bf16_t* OB = (const bf16_t*)(p.ws + WS_OB);
    float* X1 = (float*)(p.ws + WS_X1); const float* X2 = (const float*)(p.ws + WS_X2);
    const float* ng = p.norm_g + (size_t)l * 4 * 1024;
    const float* rb = p.router_b + l * 32;
    float* GATE = (float*)(p.ws + WS_GATE);
    int it = 0;
    int r = r_begin + blockIdx.x * 8 + wave;
    const int step = G * 8;
    int cur_s = -1; ModG mg; ModAB mab;
    Row16 xin; RowB8 ob;
    if (r < NTOK) { xin = (l == 0) ? ld_row_f32(src_row(p, r), lane) : ld_row_f32(X2 + (size_t)r * 1024, lane); ob = ld_rowb(OB + (size_t)r * 1024, lane); }
    for (; r < NTOK; r += step, ++it) {
        const int rn = r + step;
        Row16 xin_n = xin; RowB8 ob_n = ob;
        if (rn < NTOK) { xin_n = (l == 0) ? ld_row_f32(src_row(p, rn), lane) : ld_row_f32(X2 + (size_t)rn * 1024, lane); ob_n = ld_rowb(OB + (size_t)rn * 1024, lane); }
        const int s_ = (r < CTXN) ? 1 : 0;
        if (s_ != cur_s) { cur_s = s_; const float* mod = mod_ptr(p, l, r); mg = load_g(ng + 1024, mod + 2048, lane); mab = load_ab(ng + 2048, mod + 4096, mod + 3072, lane); }
        const Row16 o = cvt_rowb(ob);
        const float rso = row_rstd(o);
        const Row16 x1 = apply_g(xin, o, rso, mg);
        st_row_f32(X1 + (size_t)r * 1024, lane, x1);
        const float rs1 = row_rstd(x1);
        const Row16 h = apply_ab(x1, rs1, mab);
        xin = xin_n; ob = ob_n;
        float part[32];
        {
            const float* wl = wT + lane * 4;
            float4 wa[4], wb[4];
#pragma unroll
            for (int i = 0; i < 4; ++i) wa[i] = *(const float4*)(wl + 256 * i);
#pragma unroll
            for (int e = 0; e < 32; e += 2) {
#pragma unroll
                for (int i = 0; i < 4; ++i) wb[i] = *(const float4*)(wl + (e + 1) * 1024 + 256 * i);
                { float a = 0.f;
#pragma unroll
                  for (int i = 0; i < 4; ++i) a += h.v[i].x * wa[i].x + h.v[i].y * wa[i].y + h.v[i].z * wa[i].z + h.v[i].w * wa[i].w;
                  part[e] = a; }
                if (e + 2 < 32) {
#pragma unroll
                    for (int i = 0; i < 4; ++i) wa[i] = *(const float4*)(wl + (e + 2) * 1024 + 256 * i);
                }
                { float a = 0.f;
#pragma unroll
                  for (int i = 0; i < 4; ++i) a += h.v[i].x * wb[i].x + h.v[i].y * wb[i].y + h.v[i].z * wb[i].z + h.v[i].w * wb[i].w;
                  part[e + 1] = a; }
            }
        }
        st_row_fp8((unsigned char*)HB + (size_t)r * 1024, lane, h);
#define TR_STEP(NV, BIT) _Pragma("unroll") for (int i = 0; i < (NV) / 2; ++i) { const float lo = part[i], hi_ = part[i + (NV) / 2]; const bool up = (lane & (BIT)) != 0; \
            const float send = up ? lo : hi_, keep = up ? hi_ : lo; part[i] = keep + __shfl_xor(send, (BIT)); }
        TR_STEP(32, 32) TR_STEP(16, 16) TR_STEP(8, 8) TR_STEP(4, 4) TR_STEP(2, 2)
#undef TR_STEP
        float logit = part[0] + __shfl_xor(part[0], 1);
        const int myexp = lane >> 1;
        logit += rb[myexp];
        float val = (lane & 1) ? -3.0e38f : logit;
        float tv[4]; int ti[4];
#pragma unroll
        for (int k = 0; k < 4; ++k) {
            float bv = val; int bi = myexp;
#pragma unroll
            for (int off = 32; off >= 1; off >>= 1) { const float ov = __shfl_xor(bv, off); const int oi = __shfl_xor(bi, off); const bool take = (ov > bv) | ((ov == bv) & (oi < bi)); bv = take ? ov : bv; bi = take ? oi : bi; }
            tv[k] = bv; ti[k] = bi;
            if (myexp == bi) val = -3.0e38f;
        }
        const float e1 = __expf(tv[1] - tv[0]), e2 = __expf(tv[2] - tv[0]), e3 = __expf(tv[3] - tv[0]);
        const float inv = 1.f / (1.f + e1 + e2 + e3);
        if (lane < 4) {
            const int k = lane;
            const int e = (k == 0) ? ti[0] : (k == 1) ? ti[1] : (k == 2) ? ti[2] : ti[3];
            const float gk = ((k == 0) ? 1.f : (k == 1) ? e1 : (k == 2) ? e2 : e3) * inv;
            GATE[(size_t)r * 4 + k] = gk;
            const int lp = atomicAdd(&lcnt[e], 1);
            sel[(it * 8 + wave) * 4 + k] = e | (lp << 8);
        }
    }
    __syncthreads();
    int* CNT = (int*)(p.ws + WS_CNT) + l * 32;
    if (tid < 32) lbase[tid] = atomicAdd(&CNT[tid], lcnt[tid]);
    __syncthreads();
    {
        int* TOPE = (int*)(p.ws + WS_TOPE); int* TOPP = (int*)(p.ws + WS_TOPP); int* LIST = (int*)(p.ws + WS_LIST);
        for (int q = tid; q < 80 * 4; q += NTH) {
            const int slot = q >> 2, k = q & 3, itq = slot >> 3, wv = slot & 7;
            const int r = r_begin + blockIdx.x * 8 + wv + itq * G * 8;
            if (r < NTOK) {
                const int s = sel[q], e = s & 255, lp = s >> 8, pos = lbase[e] + lp;
                TOPE[(size_t)r * 4 + k] = e; TOPP[(size_t)r * 4 + k] = pos; LIST[(size_t)e * NTOK + pos] = r;
            }
        }
    }
    __syncthreads();
}

struct MoeLds { int* cnt; int* off; int* toff; };
__device__ __forceinline__ MoeLds moe_setup(PRef p, int l, char* base) {
    MoeLds m; m.cnt = (int*)base; m.off = m.cnt + 32; m.toff = m.off + 33;
    const int tid = tid_opaque();
    if (tid < 64) {
        const int e = tid & 31;
        const int cval = ((const int*)(p.ws + WS_CNT))[l * 32 + e];
        const int tiles = (cval + 255) >> 8;
        int pc = cval, pt = tiles;
#pragma unroll
        for (int o = 1; o < 32; o <<= 1) { const int a = __shfl_up(pc, o, 32), b = __shfl_up(pt, o, 32); if (e >= o) { pc += a; pt += b; } }
        if (tid < 32) { m.cnt[e] = cval; m.off[e + 1] = pc; m.toff[e + 1] = pt; if (e == 0) { m.off[0] = 0; m.toff[0] = 0; } }
    }
    __syncthreads();
    return m;
}

__device__ __forceinline__ void phase_end(PRef p, int l) {
    const int tid = tid_opaque(), lane = tid & 63, wave = tid >> 6, G = gridDim.x;
    MoeLds ml = moe_setup(p, l, smem);
    const int r_begin = (l == 0) ? 0 : CTXN;
    const bf16_t* YB = (const bf16_t*)(p.ws + WS_YB);
    const float* X1 = (const float*)(p.ws + WS_X1); float* X2 = (float*)(p.ws + WS_X2);
    bf16_t* HB = (bf16_t*)(p.ws + WS_HB);
    const int* TOPE = (const int*)(p.ws + WS_TOPE); const int* TOPP = (const int*)(p.ws + WS_TOPP); const float* GATE = (const float*)(p.ws + WS_GATE);
    const float* ng = p.norm_g + (size_t)l * 4 * 1024;
    int cur_s = -1; ModG mg; ModAB mab;
    int r = r_begin + blockIdx.x * 8 + wave;
    int4 en = make_int4(0, 0, 0, 0), pn = make_int4(0, 0, 0, 0); float4 gn = make_float4(0.f, 0.f, 0.f, 0.f);
    const int step = G * 8;
    if (r < NTOK) { en = *(const int4*)(TOPE + (size_t)r * 4); pn = *(const int4*)(TOPP + (size_t)r * 4); gn = *(const float4*)(GATE + (size_t)r * 4); }
    RowB8 t4n[4]; Row16 x1n; float4 gcur = gn;
    if (r < NTOK) {
        t4n[0] = ld_rowb(YB + (size_t)(ml.off[en.x] + pn.x) * 1024, lane); t4n[1] = ld_rowb(YB + (size_t)(ml.off[en.y] + pn.y) * 1024, lane);
        t4n[2] = ld_rowb(YB + (size_t)(ml.off[en.z] + pn.z) * 1024, lane); t4n[3] = ld_rowb(YB + (size_t)(ml.off[en.w] + pn.w) * 1024, lane);
        x1n = ld_row_f32(X1 + (size_t)r * 1024, lane);
        if (r + step < NTOK) { en = *(const int4*)(TOPE + (size_t)(r + step) * 4); pn = *(const int4*)(TOPP + (size_t)(r + step) * 4); gn = *(const float4*)(GATE + (size_t)(r + step) * 4); }
    }
    for (; r < NTOK; r += step) {
        RowB8 t4[4]; t4[0] = t4n[0]; t4[1] = t4n[1]; t4[2] = t4n[2]; t4[3] = t4n[3];
        const Row16 x1 = x1n;
        const float g4[4] = {gcur.x, gcur.y, gcur.z, gcur.w};
        const int rn = r + step;
        if (rn < NTOK) {
            t4n[0] = ld_rowb(YB + (size_t)(ml.off[en.x] + pn.x) * 1024, lane); t4n[1] = ld_rowb(YB + (size_t)(ml.off[en.y] + pn.y) * 1024, lane);
            t4n[2] = ld_rowb(YB + (size_t)(ml.off[en.z] + pn.z) * 1024, lane); t4n[3] = ld_rowb(YB + (size_t)(ml.off[en.w] + pn.w) * 1024, lane);
            x1n = ld_row_f32(X1 + (size_t)rn * 1024, lane);
            gcur = gn;
            if (rn + step < NTOK) { en = *(const int4*)(TOPE + (size_t)(rn + step) * 4); pn = *(const int4*)(TOPP + (size_t)(rn + step) * 4); gn = *(const float4*)(GATE + (size_t)(rn + step) * 4); }
        }
        const int s_ = (r < CTXN) ? 1 : 0;
        if (s_ != cur_s) { cur_s = s_; const float* mod = mod_ptr(p, l, r); mg = load_g(ng + 3072, mod + 5120, lane);
            if (l == 0) { const float* mod1 = mod_ptr(p, 1, r); mab = load_ab(p.norm_g + (size_t)4 * 1024, mod1 + 1024, mod1, lane); } }
        Row16 y;
#pragma unroll
        for (int i = 0; i < 4; ++i) y.v[i] = make_float4(0.f, 0.f, 0.f, 0.f);
#pragma unroll
        for (int k = 0; k < 4; ++k) { const Row16 t = cvt_rowb(t4[k]); const float gk = g4[k];
#pragma unroll
            for (int i = 0; i < 4; ++i) { y.v[i].x += gk * t.v[i].x; y.v[i].y += gk * t.v[i].y; y.v[i].z += gk * t.v[i].z; y.v[i].w += gk * t.v[i].w; } }
        const float rsy = row_rstd(y);
        const Row16 x2 = apply_g(x1, y, rsy, mg);
        if (l == 0) {
            st_row_f32(X2 + (size_t)r * 1024, lane, x2);
            const float rs2 = row_rstd(x2);
            st_row_bf16(HB + (size_t)r * 1024, lane, apply_ab(x2, rs2, mab));
        } else {
            st_row_f32(p.out + (size_t)(r - CTXN) * 1024, lane, x2);
        }
    }
    __syncthreads();
}

__device__ __forceinline__ void phase_gemm_pg8(const bf16_t* A, int lda, const bf16_t* Bt, int K, bf16_t* C, int ldc, int nM, int nN) {
    pg8::PlainOrder S; S.init(A, lda, Bt, K, nM, nN);
    pg8::EpiStore E{C, ldc, nullptr};
    pg8::gemm_phase<pg8::EpiStore, pg8::PlainOrder, false>((PG8_LAS unsigned char*)smem, S, E, K, lda, K);
    __syncthreads();
}
constexpr int MOE_GL_OFF = 131072, MOE_ML_OFF = 143360, MOE_TAB_OFF = 143872, MOE_GL_MAX = 12;
__device__ __forceinline__ void phase_moe1(PRef p, int l) {
    MoeLds ml = moe_setup(p, l, smem + MOE_ML_OFF);
    const int tid = tid_opaque();
    PG8_LAS int* gl = (PG8_LAS int*)(smem + MOE_GL_OFF);
    PG8_LAS int* tab = (PG8_LAS int*)(smem + MOE_TAB_OFF);
    pg8::MoeOrderG S;
    S.A = (const char*)(p.ws + WS_HB); S.W = (const char*)(p.ws + WS_W1T) + (size_t)l * 32 * 2048 * 1024;
    S.tab = tab; S.gl = gl; S.wrows = 2048; S.list = (const int*)(p.ws + WS_LIST);
    S.nunits = pg8::moe_build_units(tab, ml.cnt, ml.off, ml.toff, 8);
    pg8::EpiAct E{(unsigned char*)(p.ws + WS_ACT), p.moe_b1 + (size_t)l * 32 * 2048, (unsigned char*)(p.ws + WS_DUMMY)};
    pg8::gemm_phase<pg8::EpiAct, pg8::MoeOrderG, true, true>((PG8_LAS unsigned char*)smem, S, E, 512, 512, 512, 0x7F7F7F7F, 0x79797979);
    __syncthreads();
}
__device__ __forceinline__ void phase_moe2(PRef p, int l) {
    MoeLds ml = moe_setup(p, l, smem + MOE_ML_OFF);
    PG8_LAS int* tab = (PG8_LAS int*)(smem + MOE_TAB_OFF);
    pg8::MoeOrderI S;
    S.A = (const char*)(p.ws + WS_ACT); S.W = (const char*)(p.ws + WS_W2T) + (size_t)l * 32 * 1024 * 1024;
    S.tab = tab; S.gl = nullptr; S.wrows = 1024;
    S.nunits = pg8::moe_build_units(tab, ml.cnt, ml.off, ml.toff, 4);
    pg8::EpiBias E{(bf16_t*)(p.ws + WS_YB), p.moe_b2 + (size_t)l * 32 * 1024, (bf16_t*)(p.ws + WS_DUMMY)};
    pg8::gemm_phase<pg8::EpiBias, pg8::MoeOrderI, true, true>((PG8_LAS unsigned char*)smem, S, E, 512, 512, 512, 0x7D7D7D7D, 0x79797979);
    __syncthreads();
}

__device__ __forceinline__ void gla_local_units(PRef p);
__device__ __forceinline__ void rope8(const float* rope, int t, int j0, const u32x4& a, const u32x4& b, u32x4& oa, u32x4& ob);
__device__ __forceinline__ void rowstat(const bf16_t* A, int lda, int K, float* rs) {
    const int tid = tid_opaque(), r = tid >> 1, hf = tid & 1, half = K / 2;
    const bf16_t* q = A + (size_t)r * lda + hf * half;
    float s = 0.f;
    for (int i = 0; i < half; i += 8) { const u32x4 w = *(const u32x4*)(q + i);
#pragma unroll
        for (int j = 0; j < 4; ++j) { const float a = __uint_as_float(w[j] << 16), b = __uint_as_float(w[j] & 0xFFFF0000u); s += a * a + b * b; } }
    s += __shfl_xor(s, 1);
    if (hf == 0) rs[r] = rsqrtf(s / (float)K + EPSN);
    __syncthreads();
}
__device__ __forceinline__ void phase_mla_up(PRef p) {
    const int G = gridDim.x, tid = threadIdx.x;
    const bf16_t* P = (const bf16_t*)(p.ws + WS_P);
    float* rs = (float*)(smem + 139264);
    const int nM = NTOK / 256;
    {
        pg8::PlainOrder S; S.init(P + PC_CQ, PW, (const bf16_t*)(p.ws + WS_WUQ), 256, nM, 3);
        pg8::Unit u;
        if (S.next(0, u)) rowstat(P + (size_t)u.pm * 256 * PW + PC_CQ, PW, 256, rs);
        pg8::EpiStore E{(bf16_t*)(p.ws + WS_QM), 768, rs};
        pg8::gemm_phase<pg8::EpiStore, pg8::PlainOrder, false>((PG8_LAS unsigned char*)smem, S, E, 256, PW, 256);
        __syncthreads();
    }
    for (int v = (blockIdx.x + G - 195) % G; v < nM * 8; v += G) {
        int aoff[2][2], boff[2];
        const int pm = v >> 3, pn = v & 7, h = pn >> 1;
        rowstat(P + (size_t)pm * 256 * PW + PC_CKV, PW, 128, rs);
        gm::make_off(aoff, pm * 256, PW); gm::make_off1(boff, pn * 128, 128);
        bf16_t* dst = (pn & 1) ? (bf16_t*)(p.ws + WS_VM) + (size_t)pm * 256 * 512 + h * 128 : (bf16_t*)(p.ws + WS_KM) + (size_t)pm * 256 * 768 + h * 192;
        EpiRowScale epi{dst, (pn & 1) ? 512 : 768, rs};
        gm::gemm_tile(P + PC_CKV, aoff, (const bf16_t*)(p.ws + WS_WUKV), boff, 2, epi);
    }
    const float* rope = (const float*)(p.ws + WS_ROPE);
    bf16_t* KM = (bf16_t*)(p.ws + WS_KM);
    for (int i = blockIdx.x * NTH + tid; i < NTOK * 4; i += G * NTH) {
        const int r = i >> 2, j0 = (i & 3) * 8;
        const u32x4 a = *(const u32x4*)(P + (size_t)r * PW + PC_KR + j0), b = *(const u32x4*)(P + (size_t)r * PW + PC_KR + 32 + j0);
        u32x4 oa = a, ob = b;
        if (r >= CTXN) rope8(rope, r - CTXN, j0, a, b, oa, ob);
#pragma unroll
        for (int h = 0; h < 4; ++h) { *(u32x4*)(KM + (size_t)r * 768 + h * 192 + 128 + j0) = oa; *(u32x4*)(KM + (size_t)r * 768 + h * 192 + 160 + j0) = ob; }
    }
    __syncthreads();
    gla_local_units(p);
}

struct GlaB { float b[16]; float total; };
__device__ __forceinline__ GlaB gla_decay(PRef p, int gc, int h, float* scr  ) {
    const int tid = threadIdx.x, lane = tid & 63, wave = tid >> 6, dir = wave & 1, tq = wave >> 1;
    const bf16_t* P = (const bf16_t*)(p.ws + WS_P);
    float* af = scr;
    float* wa = scr + 2048;
    float* ba = scr + 4096;
    float* tot = scr + 4224;
#pragma unroll
    for (int i = 0; i < 4; ++i) {
        const int idx = tid + 512 * i, dd = idx >> 10, t = (idx >> 4) & 63, j = idx & 15;
        af[idx] = bf2f(P[(size_t)(gc * 64 + t) * PW + PC_AF + dd * 16 + j]);
        const int jj = (idx >> 6) & 15, d = idx & 63;
        wa[idx] = (dd == 0 ? p.gla_wa_f : p.gla_wa_b)[jj * 256 + h * 64 + d];
    }
    if (tid < 128) ba[tid] = ((tid >> 6) == 0 ? p.gla_ba_f : p.gla_ba_b)[h * 64 + (tid & 63)];
    __syncthreads();
    float w[16];
#pragma unroll
    for (int j = 0; j < 16; ++j) w[j] = wa[(dir * 16 + j) * 64 + lane];
    const float bias = ba[dir * 64 + lane];
    GlaB r;
#pragma unroll
    for (int i = 0; i < 16; ++i) {
        const int t = tq * 16 + i;
        float z = bias;
#pragma unroll
        for (int j = 0; j < 16; ++j) z += af[(dir * 64 + t) * 16 + j] * w[j];
        const float g = (fminf(z, 0.f) - __logf(1.f + __expf(-fabsf(z)))) * (1.f / 16.f);
        r.b[i] = g;
    }
    if (dir == 0) {
#pragma unroll
        for (int i = 1; i < 16; ++i) r.b[i] += r.b[i - 1];
        tot[(dir * 4 + tq) * 64 + lane] = r.b[15];
    } else {
#pragma unroll
        for (int i = 14; i >= 0; --i) r.b[i] += r.b[i + 1];
        tot[(dir * 4 + tq) * 64 + lane] = r.b[0];
    }
    __syncthreads();
    float offs = 0.f, total = 0.f;
#pragma unroll
    for (int q = 0; q < 4; ++q) { const float tv = tot[(dir * 4 + q) * 64 + lane]; total += tv; if (dir == 0 ? (q < tq) : (q > tq)) offs += tv; }
#pragma unroll
    for (int i = 0; i < 16; ++i) r.b[i] += offs;
    r.total = total;
    return r;
}

__device__ __forceinline__ void gla_stage_vt(const bf16_t* P, int gc, int h, bf16_t* VT) {
    const int tid = threadIdx.x, v = tid & 127, sq = tid >> 7;
    unsigned pk[8];
#pragma unroll
    for (int i = 0; i < 8; ++i) {
        const bf16_t a = P[(size_t)(gc * 64 + sq * 16 + 2 * i) * PW + PC_V + h * 128 + v], b = P[(size_t)(gc * 64 + sq * 16 + 2 * i + 1) * PW + PC_V + h * 128 + v];
        pk[i] = a | ((unsigned)b << 16);
    }
    *(u32x4*)(VT + v * 72 + sq * 16) = (u32x4){pk[0], pk[1], pk[2], pk[3]};
    *(u32x4*)(VT + v * 72 + sq * 16 + 8) = (u32x4){pk[4], pk[5], pk[6], pk[7]};
}

struct GlaPreL { u32x4 kc, vc[2], ac; float4 wac; float bac; };
__device__ __forceinline__ void gla_prefetch_local(PRef p, int gc, int h, GlaPreL& g) {
    const int tid = threadIdx.x;
    const bf16_t* P = (const bf16_t*)(p.ws + WS_P);
    g.kc = *(const u32x4*)(P + (size_t)(gc * 64 + (tid >> 3)) * PW + PC_K + h * 64 + (tid & 7) * 8);
#pragma unroll
    for (int i = 0; i < 2; ++i) { const int idx = tid + 512 * i; g.vc[i] = *(const u32x4*)(P + (size_t)(gc * 64 + (idx >> 4)) * PW + PC_V + h * 128 + (idx & 15) * 8); }
    g.ac = *(const u32x4*)(P + (size_t)(gc * 64 + ((tid & 255) >> 2)) * PW + PC_AF + (tid & 3) * 8);
    { const int dd = tid >> 8, jj = (tid >> 4) & 15, d4 = tid & 15; g.wac = *(const float4*)((dd == 0 ? p.gla_wa_f : p.gla_wa_b) + jj * 256 + h * 64 + d4 * 4); }
    g.bac = ((tid >> 6) & 1 ? p.gla_ba_b : p.gla_ba_f)[h * 64 + (tid & 63)];
}
template <int OFF> __device__ __forceinline__ s16x4 glal_tr(int vb) { s16x4 r; asm volatile("ds_read_b64_tr_b16 %0, %1 offset:%2" : "=&v"(r) : "v"(vb), "i"(OFF) : "memory"); return r; }
__device__ __forceinline__ void gla_local_units(PRef p) {
    const int tid = threadIdx.x, lane = tid & 63, wave = tid >> 6, r32 = lane & 31, hi = lane >> 5, G = gridDim.x;
    bf16_t* kdT = (bf16_t*)smem;
    bf16_t* Kraw = kdT + 2 * 64 * 72;
    char* Vraw = smem + 27648;
    float* af = (float*)(smem + 49152);
    float* wa = af + 2048; float* ba = wa + 2048; float* tot = ba + 128;
    bf16_t* U = (bf16_t*)(p.ws + WS_U); float* DEC = (float*)(p.ws + WS_DEC);
    int u = blockIdx.x;
    if (u >= NCH * 4) return;
    GlaPreL g;
    gla_prefetch_local(p, u >> 2, u & 3, g);
    const int dir = wave & 1, tq = wave >> 1;
    for (; u < NCH * 4; u += G) {
        const int gc = u >> 2, h = u & 3;
        *(u32x4*)(Kraw + (tid >> 3) * 72 + (tid & 7) * 8) = g.kc;
#pragma unroll
        for (int i = 0; i < 2; ++i) { const int idx = tid + 512 * i; *(u32x4*)(Vraw + (idx >> 4) * 320 + (idx & 15) * 16) = g.vc[i]; }
        if (tid < 256) { const int t = tid >> 2, ch = tid & 3, dd = ch >> 1, j0 = (ch & 1) * 8; float* q = af + dd * 1024 + t * 16 + j0;
#pragma unroll
            for (int e = 0; e < 4; ++e) { q[2 * e] = __uint_as_float(g.ac[e] << 16); q[2 * e + 1] = __uint_as_float(g.ac[e] & 0xFFFF0000u); } }
        { const int dd = tid >> 8, jj = (tid >> 4) & 15, d4 = tid & 15; *(float4*)(wa + (dd * 16 + jj) * 64 + d4 * 4) = g.wac; }
        if (tid < 128) ba[tid] = g.bac;
        __syncthreads();
        const int un = u + G;
        if (un < NCH * 4) gla_prefetch_local(p, un >> 2, un & 3, g);
        float bb[16]; float total = 0.f;
        {
            float w[16];
#pragma unroll
            for (int j = 0; j < 16; ++j) w[j] = wa[(dir * 16 + j) * 64 + lane];
            const float bias = ba[dir * 64 + lane];
#pragma unroll
            for (int i = 0; i < 16; ++i) {
                const int t = tq * 16 + i;
                float z = bias;
#pragma unroll
                for (int j = 0; j < 16; ++j) z += af[(dir * 64 + t) * 16 + j] * w[j];
                bb[i] = (fminf(z, 0.f) - __logf(1.f + __expf(-fabsf(z)))) * (1.f / 16.f);
            }
            if (dir == 0) {
#pragma unroll
                for (int i = 1; i < 16; ++i) bb[i] += bb[i - 1];
                tot[(dir * 4 + tq) * 64 + lane] = bb[15];
            } else {
#pragma unroll
                for (int i = 14; i >= 0; --i) bb[i] += bb[i + 1];
                tot[(dir * 4 + tq) * 64 + lane] = bb[0];
            }
        }
        __syncthreads();
        {
            float offs = 0.f;
#pragma unroll
            for (int q = 0; q < 4; ++q) { const float tv = tot[(dir * 4 + q) * 64 + lane]; total += tv; if (dir == 0 ? (q < tq) : (q > tq)) offs += tv; }
#pragma unroll
            for (int i = 0; i < 16; ++i) bb[i] += offs;
        }
        {
            unsigned pk[8];
#pragma unroll
            for (int i = 0; i < 8; ++i) {
                const int s0 = tq * 16 + 2 * i;
                const float k0 = bf2f(Kraw[s0 * 72 + lane]), k1 = bf2f(Kraw[(s0 + 1) * 72 + lane]);
                pk[i] = cvtpk(k0 * __expf(total - bb[2 * i]), k1 * __expf(total - bb[2 * i + 1]));
            }
            *(u32x4*)(kdT + (dir * 64 + lane) * 72 + tq * 16) = (u32x4){pk[0], pk[1], pk[2], pk[3]};
            *(u32x4*)(kdT + (dir * 64 + lane) * 72 + tq * 16 + 8) = (u32x4){pk[4], pk[5], pk[6], pk[7]};
            if (tq == 0) DEC[((size_t)(dir * NCH + gc) * 4 + h) * 64 + lane] = __expf(total);
        }
        __syncthreads();
        {
            const int mdir = wave >> 2, vbk = wave & 3;
            const int vb = (int)(uintptr_t)Vraw + (8 * hi + ((lane & 15) >> 2)) * 320 + (vbk * 32 + 16 * ((lane >> 4) & 1) + 4 * (lane & 3)) * 2;
            f32x16 a0 = {}, a1 = {};
#define GLAL_STEP(KS) do { const s16x4 l_ = glal_tr<(KS) * 5120>(vb), h_ = glal_tr<(KS) * 5120 + 1280>(vb); \
            const bf16x8 b0 = *(const bf16x8*)(kdT + (mdir * 64 + r32) * 72 + (KS) * 16 + hi * 8); \
            const bf16x8 b1 = *(const bf16x8*)(kdT + (mdir * 64 + 32 + r32) * 72 + (KS) * 16 + hi * 8); \
            asm volatile("s_waitcnt lgkmcnt(0)" ::: "memory"); SBAR(); \
            const bf16x8 a_ = (bf16x8){l_[0], l_[1], l_[2], l_[3], h_[0], h_[1], h_[2], h_[3]}; \
            a0 = __builtin_amdgcn_mfma_f32_32x32x16_bf16(a_, b0, a0, 0, 0, 0); a1 = __builtin_amdgcn_mfma_f32_32x32x16_bf16(a_, b1, a1, 0, 0, 0); } while (0)
            GLAL_STEP(0); GLAL_STEP(1); GLAL_STEP(2); GLAL_STEP(3);
#undef GLAL_STEP
            bf16_t* Uo = U + ((size_t)(mdir * NCH + gc) * 4 + h) * 8192;
#pragma unroll
            for (int r = 0; r < 16; ++r) { const int v = vbk * 32 + crow(r, hi); Uo[v * 64 + r32] = f2bf(a0[r]); Uo[v * 64 + 32 + r32] = f2bf(a1[r]); }
        }
        __syncthreads();
    }
}
__device__ __forceinline__ void rope8(const float* rope, int t, int j0, const u32x4& a, const u32x4& b, u32x4& oa, u32x4& ob) {
    const int row = t >> 6, col = t & 63;
    const float* cs = (j0 < 16) ? rope + row * 16 + j0 : rope + 512 * 16 + col * 16 + (j0 - 16);
    const float* sn = (j0 < 16) ? rope + 256 * 16 + row * 16 + j0 : rope + 512 * 16 + 64 * 16 + col * 16 + (j0 - 16);
    const f32x4 c0 = *(const f32x4*)cs, c1 = *(const f32x4*)(cs + 4), s0 = *(const f32x4*)sn, s1 = *(const f32x4*)(sn + 4);
#pragma unroll
    for (int e = 0; e < 4; ++e) {
        const float x1l = __uint_as_float(a[e] << 16), x1h = __uint_as_float(a[e] & 0xFFFF0000u), x2l = __uint_as_float(b[e] << 16), x2h = __uint_as_float(b[e] & 0xFFFF0000u);
        const float cl = (e < 2) ? c0[2 * e] : c1[2 * e - 4], ch = (e < 2) ? c0[2 * e + 1] : c1[2 * e - 3], sl = (e < 2) ? s0[2 * e] : s1[2 * e - 4], sh = (e < 2) ? s0[2 * e + 1] : s1[2 * e - 3];
        oa[e] = cvtpk(x1l * cl - x2l * sl, x1h * ch - x2h * sh);
        ob[e] = cvtpk(x1l * sl + x2l * cl, x1h * sh + x2h * ch);
    }
}
__device__ __forceinline__ u32x4 cvt16_fp8(const u32x4& a, const u32x4& b) {
    u32x4 o;
#pragma unroll
    for (int j = 0; j < 2; ++j) {
        o[j] = pk4_fp8(__uint_as_float(a[2 * j] << 16), __uint_as_float(a[2 * j] & 0xFFFF0000u), __uint_as_float(a[2 * j + 1] << 16), __uint_as_float(a[2 * j + 1] & 0xFFFF0000u));
        o[2 + j] = pk4_fp8(__uint_as_float(b[2 * j] << 16), __uint_as_float(b[2 * j] & 0xFFFF0000u), __uint_as_float(b[2 * j + 1] << 16), __uint_as_float(b[2 * j + 1] & 0xFFFF0000u));
    }
    return o;
}
constexpr float MLA_QS = 8.f * 0.07216878364870322f * 1.4426950408889634f;
__device__ __forceinline__ u32x4 cvt16_fp8s(const u32x4& a, const u32x4& b, float sc) {
    u32x4 o;
#pragma unroll
    for (int j = 0; j < 2; ++j) {
        o[j] = pk4_fp8(__uint_as_float(a[2 * j] << 16) * sc, __uint_as_float(a[2 * j] & 0xFFFF0000u) * sc, __uint_as_float(a[2 * j + 1] << 16) * sc, __uint_as_float(a[2 * j + 1] & 0xFFFF0000u) * sc);
        o[2 + j] = pk4_fp8(__uint_as_float(b[2 * j] << 16) * sc, __uint_as_float(b[2 * j] & 0xFFFF0000u) * sc, __uint_as_float(b[2 * j + 1] << 16) * sc, __uint_as_float(b[2 * j + 1] & 0xFFFF0000u) * sc);
    }
    return o;
}
__device__ __forceinline__ u32x2 cvt8_fp8s(const u32x4& a, float sc) { return (u32x2){pk4_fp8(__uint_as_float(a[0] << 16) * sc, __uint_as_float(a[0] & 0xFFFF0000u) * sc, __uint_as_float(a[1] << 16) * sc, __uint_as_float(a[1] & 0xFFFF0000u) * sc),
                                                                                 pk4_fp8(__uint_as_float(a[2] << 16) * sc, __uint_as_float(a[2] & 0xFFFF0000u) * sc, __uint_as_float(a[3] << 16) * sc, __uint_as_float(a[3] & 0xFFFF0000u) * sc)}; }
__device__ __forceinline__ u32x2 cvt8_fp8(const u32x4& a) { return (u32x2){pk4_fp8(__uint_as_float(a[0] << 16), __uint_as_float(a[0] & 0xFFFF0000u), __uint_as_float(a[1] << 16), __uint_as_float(a[1] & 0xFFFF0000u)),
                                                                       pk4_fp8(__uint_as_float(a[2] << 16), __uint_as_float(a[2] & 0xFFFF0000u), __uint_as_float(a[3] << 16), __uint_as_float(a[3] & 0xFFFF0000u))}; }
__device__ __forceinline__ void mla_pack_pass(PRef p, int b0, int nb) {
    const int tid = threadIdx.x, gt = (blockIdx.x - b0) * NTH + tid, gn = nb * NTH;
    const float* rope = (const float*)(p.ws + WS_ROPE);
    const bf16_t* QM = (const bf16_t*)(p.ws + WS_QM); const bf16_t* KM = (const bf16_t*)(p.ws + WS_KM); const bf16_t* VM = (const bf16_t*)(p.ws + WS_VM);
    unsigned char* Q8 = (unsigned char*)(p.ws + WS_Q8); unsigned char* K8 = (unsigned char*)(p.ws + WS_K8); unsigned char* VT8 = (unsigned char*)(p.ws + WS_VT8);
    for (int i = gt; i < NTOK * 48; i += gn) {
        const int r = i / 48, q = i % 48, hh = q / 12, c = q % 12;
        const bf16_t* qs = QM + (size_t)r * 768 + hh * 192; const bf16_t* ks = KM + (size_t)r * 768 + hh * 192;
        unsigned char* qd = Q8 + (size_t)r * 768 + hh * 192; unsigned char* kd = K8 + ((size_t)hh * NTOK + r) * 192;
        if (c < 8) {
            *(u32x4*)(qd + c * 16) = cvt16_fp8s(*(const u32x4*)(qs + c * 16), *(const u32x4*)(qs + c * 16 + 8), MLA_QS);
            *(u32x4*)(kd + c * 16) = cvt16_fp8(*(const u32x4*)(ks + c * 16), *(const u32x4*)(ks + c * 16 + 8));
        } else {
            const int j0 = (c - 8) * 8;
            const u32x4 a = *(const u32x4*)(qs + 128 + j0), b = *(const u32x4*)(qs + 160 + j0);
            u32x4 oa = a, ob = b;
            if (r >= CTXN) rope8(rope, r - CTXN, j0, a, b, oa, ob);
            *(u32x2*)(qd + 128 + j0) = cvt8_fp8s(oa, MLA_QS); *(u32x2*)(qd + 160 + j0) = cvt8_fp8s(ob, MLA_QS);
            *(u32x2*)(kd + 128 + j0) = cvt8_fp8(*(const u32x4*)(ks + 128 + j0)); *(u32x2*)(kd + 160 + j0) = cvt8_fp8(*(const u32x4*)(ks + 160 + j0));
        }
    }
    {
        const int lane = tid & 63, g = lane >> 4, dq = lane & 15;
        for (int u = gt >> 6; u < 4 * NCH; u += gn >> 6) {
            const int hh = u / NCH, t = u % NCH;
            const bf16_t* vs = VM + (size_t)(t * 64 + 16 * g) * 512 + hh * 128 + dq * 8;
            u32x4 w[16];
#pragma unroll
            for (int i = 0; i < 16; ++i) w[i] = *(const u32x4*)(vs + (size_t)i * 512);
            unsigned char* dst = VT8 + ((size_t)u * 128 + dq * 8) * 64 + 8 * g;
#pragma unroll
            for (int d = 0; d < 8; ++d) {
                float f[16];
#pragma unroll
                for (int i = 0; i < 16; ++i) f[i] = (d & 1) ? __uint_as_float(w[i][d >> 1] & 0xFFFF0000u) : __uint_as_float(w[i][d >> 1] << 16);
                *(u32x2*)(dst + d * 64) = (u32x2){pk4_fp8(f[0], f[1], f[2], f[3]), pk4_fp8(f[8], f[9], f[10], f[11])};
                *(u32x2*)(dst + d * 64 + 32) = (u32x2){pk4_fp8(f[4], f[5], f[6], f[7]), pk4_fp8(f[12], f[13], f[14], f[15])};
            }
        }
    }
}

__device__ __forceinline__ int gla_order(int dir, int step) { return dir == 0 ? step : (step < 4 ? 3 - step : NCH - 1 - (step - 4)); }
__device__ __forceinline__ void phase_gla_scan(PRef p) {
    const int gid = blockIdx.x * NTH + threadIdx.x;
    if (gid >= 2 * 4 * 8192) { mla_pack_pass(p, 128, (int)gridDim.x - 128); return; }
    const int dir = gid >> 15, h = (gid >> 13) & 3, e = gid & 8191, d = e & 63;
    const bf16_t* U = (const bf16_t*)(p.ws + WS_U); bf16_t* S = (bf16_t*)(p.ws + WS_SIN); const float* DEC = (const float*)(p.ws + WS_DEC);
    float s = 0.f;
#pragma unroll 1
    for (int s0 = 0; s0 < NCH; s0 += 52) {
        float uu[52], dc[52];
#pragma unroll
        for (int i = 0; i < 52; ++i) { const size_t o = ((size_t)(dir * NCH + gla_order(dir, s0 + i)) * 4 + h); uu[i] = bf2f(U[o * 8192 + e]); dc[i] = DEC[o * 64 + d]; }
#pragma unroll
        for (int i = 0; i < 52; ++i) { const size_t o = ((size_t)(dir * NCH + gla_order(dir, s0 + i)) * 4 + h); S[o * 8192 + e] = f2bf(s); s = dc[i] * s + uu[i]; }
    }
}

__device__ __forceinline__ void gla_out_unit(PRef p, int gc, int h) {
    const int tid = threadIdx.x, lane = tid & 63, wave = tid >> 6, r32 = lane & 31, hi = lane >> 5;
    const bf16_t* P = (const bf16_t*)(p.ws + WS_P);
    bf16_t* qe = (bf16_t*)smem;
    bf16_t* ke = qe + 2 * 64 * 72;
    bf16_t* Am = ke + 2 * 64 * 72;
    bf16_t* VT = Am + 2 * 64 * 72;
    bf16_t* ST = VT + 128 * 72;
    float* scr = (float*)(smem + 110592);
    float* ob = (float*)(ke);
    const GlaB gb = gla_decay(p, gc, h, scr);
    {
        const int dir = wave & 1, tq = wave >> 1;
#pragma unroll
        for (int i = 0; i < 16; ++i) {
            const int t = tq * 16 + i;
            const float qv = bf2f(P[(size_t)(gc * 64 + t) * PW + PC_Q + h * 64 + lane]) * 0.125f, kv = bf2f(P[(size_t)(gc * 64 + t) * PW + PC_K + h * 64 + lane]);
            qe[(dir * 64 + t) * 72 + lane] = f2bf(qv * __expf(gb.b[i]));
            ke[(dir * 64 + t) * 72 + lane] = f2bf(kv * __expf(-gb.b[i]));
        }
    }
    gla_stage_vt(P, gc, h, VT);
    {
        const bf16_t* S = (const bf16_t*)(p.ws + WS_SIN);
#pragma unroll
        for (int i = 0; i < 4; ++i) {
            const int cc = tid + 512 * i, dir = cc >> 10, v = (cc >> 3) & 127, ch = cc & 7;
            *(u32x4*)(ST + (dir * 128 + v) * 72 + ch * 8) = *(const u32x4*)(S + ((size_t)(dir * NCH + gc) * 4 + h) * 8192 + v * 64 + ch * 8);
        }
    }
    __syncthreads();
    {
        const int dir = wave >> 2, tb = (wave >> 1) & 1, sb = wave & 1;
        f32x16 acc = {};
#pragma unroll
        for (int ks = 0; ks < 4; ++ks) {
            const bf16x8 a = *(const bf16x8*)(qe + (dir * 64 + tb * 32 + r32) * 72 + ks * 16 + hi * 8);
            const bf16x8 b = *(const bf16x8*)(ke + (dir * 64 + sb * 32 + r32) * 72 + ks * 16 + hi * 8);
            acc = __builtin_amdgcn_mfma_f32_32x32x16_bf16(a, b, acc, 0, 0, 0);
        }
        const int s = sb * 32 + r32;
#pragma unroll
        for (int r = 0; r < 16; ++r) { const int t = tb * 32 + crow(r, hi); const bool keep = (dir == 0) ? (s <= t) : (s >= t); Am[(dir * 64 + t) * 72 + s] = f2bf(keep ? acc[r] : 0.f); }
    }
    __syncthreads();
    f32x16 o = {};
    const int tb = wave >> 2, vb = wave & 3;
#pragma unroll
    for (int dir = 0; dir < 2; ++dir)
#pragma unroll
        for (int ks = 0; ks < 4; ++ks) {
            const bf16x8 a1 = *(const bf16x8*)(Am + (dir * 64 + tb * 32 + r32) * 72 + ks * 16 + hi * 8);
            const bf16x8 b1 = *(const bf16x8*)(VT + (vb * 32 + r32) * 72 + ks * 16 + hi * 8);
            o = __builtin_amdgcn_mfma_f32_32x32x16_bf16(a1, b1, o, 0, 0, 0);
            const bf16x8 a2 = *(const bf16x8*)(qe + (dir * 64 + tb * 32 + r32) * 72 + ks * 16 + hi * 8);
            const bf16x8 b2 = *(const bf16x8*)(ST + (dir * 128 + vb * 32 + r32) * 72 + ks * 16 + hi * 8);
            o = __builtin_amdgcn_mfma_f32_32x32x16_bf16(a2, b2, o, 0, 0, 0);
        }
    __syncthreads();
#pragma unroll
    for (int r = 0; r < 16; ++r) ob[(tb * 32 + crow(r, hi)) * 132 + vb * 32 + r32] = o[r];
    __syncthreads();
    {
        const int t = tid >> 3, v0 = (tid & 7) * 16;
        float vals[16]; float ss = 0.f;
#pragma unroll
        for (int i = 0; i < 16; ++i) { vals[i] = ob[t * 132 + v0 + i]; ss += vals[i] * vals[i]; }
        ss += __shfl_xor(ss, 1); ss += __shfl_xor(ss, 2); ss += __shfl_xor(ss, 4);
        const float rstd = rsqrtf(ss * (1.f / 128.f) + EPSN);
        const size_t row = (size_t)gc * 64 + t;
        unsigned pk[8];
#pragma unroll
        for (int i = 0; i < 8; ++i) {
            const float r0 = bf2f(P[row * PW + PC_R + h * 128 + v0 + 2 * i]), r1 = bf2f(P[row * PW + PC_R + h * 128 + v0 + 2 * i + 1]);
            pk[i] = cvtpk(vals[2 * i] * rstd * p.gla_onorm[v0 + 2 * i] * silu_f(r0), vals[2 * i + 1] * rstd * p.gla_onorm[v0 + 2 * i + 1] * silu_f(r1));
        }
        bf16_t* M = (bf16_t*)(p.ws + WS_MIX) + row * 1024 + h * 128 + v0;
        *(u32x4*)M = (u32x4){pk[0], pk[1], pk[2], pk[3]}; *(u32x4*)(M + 8) = (u32x4){pk[4], pk[5], pk[6], pk[7]};
    }
    __syncthreads();
}


struct GlaPre { u32x4 qc, kc, vc[2], ac, sc[4]; float4 wac; float bac; };
__device__ __forceinline__ void gla_prefetch(PRef p, int gc, int h, GlaPre& g, u32x4 (&rc)[2]) {
    const int tid = threadIdx.x;
    const bf16_t* P = (const bf16_t*)(p.ws + WS_P);
    const bf16_t* rowp = P + (size_t)(gc * 64 + (tid >> 3)) * PW;
    g.qc = *(const u32x4*)(rowp + PC_Q + h * 64 + (tid & 7) * 8);
    g.kc = *(const u32x4*)(rowp + PC_K + h * 64 + (tid & 7) * 8);
#pragma unroll
    for (int i = 0; i < 2; ++i) { const int idx = tid + 512 * i; g.vc[i] = *(const u32x4*)(P + (size_t)(gc * 64 + (idx >> 4)) * PW + PC_V + h * 128 + (idx & 15) * 8); }
#pragma unroll
    for (int i = 0; i < 2; ++i) rc[i] = *(const u32x4*)(rowp + PC_R + h * 128 + (tid & 7) * 16 + 8 * i);
    g.ac = *(const u32x4*)(P + (size_t)(gc * 64 + ((tid & 255) >> 2)) * PW + PC_AF + (tid & 3) * 8);
    const bf16_t* S = (const bf16_t*)(p.ws + WS_SIN);
#pragma unroll
    for (int i = 0; i < 4; ++i) { const int cc = tid + 512 * i, dir = cc >> 10; g.sc[i] = *(const u32x4*)(S + ((size_t)(dir * NCH + gc) * 4 + h) * 8192 + (cc & 1023) * 8); }
    { const int dd = tid >> 8, jj = (tid >> 4) & 15, d4 = tid & 15; g.wac = *(const float4*)((dd == 0 ? p.gla_wa_f : p.gla_wa_b) + jj * 256 + h * 64 + d4 * 4); }
    g.bac = ((tid >> 6) & 1 ? p.gla_ba_b : p.gla_ba_f)[h * 64 + (tid & 63)];
}
template <int OFF> __device__ __forceinline__ s16x4 gla_tr(int vb) { s16x4 r; asm volatile("ds_read_b64_tr_b16 %0, %1 offset:%2" : "=&v"(r) : "v"(vb), "i"(OFF) : "memory"); return r; }
__device__ __forceinline__ void phase_gla_out(PRef p) {
    const int tid = threadIdx.x, lane = tid & 63, wave = tid >> 6, r32 = lane & 31, hi = lane >> 5, G = gridDim.x;
    bf16_t* qe = (bf16_t*)smem;
    bf16_t* ke = qe + 2 * 64 * 72;
    bf16_t* Am = ke + 2 * 64 * 72;
    bf16_t* Qraw = Am; bf16_t* Kraw = Am + 64 * 72;
    char* Vraw = smem + 55296;
    bf16_t* ST = (bf16_t*)(smem + 75776);
    float* af = (float*)(smem + 112640);
    float* wa = af + 2048;
    float* ba = wa + 2048;
    float* tot = ba + 128;
    float* ob = (float*)ke;
    int u = blockIdx.x;
    if (u >= NCH * 4) return;
    const int nt_t = tid >> 3, nt_v0 = (tid & 7) * 16;
    float on[16];
#pragma unroll
    for (int i = 0; i < 16; ++i) on[i] = p.gla_onorm[nt_v0 + i];
    GlaPre g; u32x4 rc[2], rcn[2];
    gla_prefetch(p, u >> 2, u & 3, g, rc);
    const int dir = wave & 1, tq = wave >> 1;
    for (; u < NCH * 4; u += G) {
        const int gc = u >> 2, h = u & 3;
        *(u32x4*)(Qraw + (tid >> 3) * 72 + (tid & 7) * 8) = g.qc;
        *(u32x4*)(Kraw + (tid >> 3) * 72 + (tid & 7) * 8) = g.kc;
#pragma unroll
        for (int i = 0; i < 2; ++i) { const int idx = tid + 512 * i; *(u32x4*)(Vraw + (idx >> 4) * 320 + (idx & 15) * 16) = g.vc[i]; }
#pragma unroll
        for (int i = 0; i < 4; ++i) { const int cc = tid + 512 * i; *(u32x4*)(ST + ((cc >> 10) * 128 + ((cc >> 3) & 127)) * 72 + (cc & 7) * 8) = g.sc[i]; }
        if (tid < 256) { const int t = tid >> 2, ch = tid & 3, dd = ch >> 1, j0 = (ch & 1) * 8; float* q = af + dd * 1024 + t * 16 + j0;
#pragma unroll
            for (int e = 0; e < 4; ++e) { q[2 * e] = __uint_as_float(g.ac[e] << 16); q[2 * e + 1] = __uint_as_float(g.ac[e] & 0xFFFF0000u); } }
        { const int dd = tid >> 8, jj = (tid >> 4) & 15, d4 = tid & 15; *(float4*)(wa + (dd * 16 + jj) * 64 + d4 * 4) = g.wac; }
        if (tid < 128) ba[tid] = g.bac;
        __syncthreads();
        const int un = u + G;
        if (un < NCH * 4) gla_prefetch(p, un >> 2, un & 3, g, rcn);
        float bb[16]; float total;
        {
            float w[16];
#pragma unroll
            for (int j = 0; j < 16; ++j) w[j] = wa[(dir * 16 + j) * 64 + lane];
            const float bias = ba[dir * 64 + lane];
#pragma unroll
            for (int i = 0; i < 16; ++i) {
                const int t = tq * 16 + i;
                float z = bias;
#pragma unroll
                for (int j = 0; j < 16; ++j) z += af[(dir * 64 + t) * 16 + j] * w[j];
                bb[i] = (fminf(z, 0.f) - __logf(1.f + __expf(-fabsf(z)))) * (1.f / 16.f);
            }
            if (dir == 0) {
#pragma unroll
                for (int i = 1; i < 16; ++i) bb[i] += bb[i - 1];
                tot[(dir * 4 + tq) * 64 + lane] = bb[15];
            } else {
#pragma unroll
                for (int i = 14; i >= 0; --i) bb[i] += bb[i + 1];
                tot[(dir * 4 + tq) * 64 + lane] = bb[0];
            }
        }
        __syncthreads();
        {
            float offs = 0.f; total = 0.f;
#pragma unroll
            for (int q = 0; q < 4; ++q) { const float tv = tot[(dir * 4 + q) * 64 + lane]; total += tv; if (dir == 0 ? (q < tq) : (q > tq)) offs += tv; }
#pragma unroll
            for (int i = 0; i < 16; ++i) bb[i] += offs;
        }
#pragma unroll
        for (int i = 0; i < 16; ++i) {
            const int t = tq * 16 + i;
            const float qv = bf2f(Qraw[t * 72 + lane]) * 0.125f, kv = bf2f(Kraw[t * 72 + lane]);
            qe[(dir * 64 + t) * 72 + lane] = f2bf(qv * __expf(bb[i]));
            ke[(dir * 64 + t) * 72 + lane] = f2bf(kv * __expf(-bb[i]));
        }
        __syncthreads();
        {
            const int mdir = wave >> 2, tb = (wave >> 1) & 1, sb = wave & 1;
            f32x16 acc = {};
#pragma unroll
            for (int ks = 0; ks < 4; ++ks) {
                const bf16x8 a = *(const bf16x8*)(qe + (mdir * 64 + tb * 32 + r32) * 72 + ks * 16 + hi * 8);
                const bf16x8 b = *(const bf16x8*)(ke + (mdir * 64 + sb * 32 + r32) * 72 + ks * 16 + hi * 8);
                acc = __builtin_amdgcn_mfma_f32_32x32x16_bf16(a, b, acc, 0, 0, 0);
            }
            const int sI = sb * 32 + r32;
#pragma unroll
            for (int r = 0; r < 16; ++r) { const int t = tb * 32 + crow(r, hi); const bool keep = (mdir == 0) ? (sI <= t) : (sI >= t); Am[(mdir * 64 + t) * 72 + sI] = f2bf(keep ? acc[r] : 0.f); }
        }
        __syncthreads();
        f32x16 o = {};
        const int tb = wave >> 2, vbk = wave & 3;
        {
            const int vb = (int)(uintptr_t)Vraw + (8 * hi + ((lane & 15) >> 2)) * 320 + (vbk * 32 + 16 * ((lane >> 4) & 1) + 4 * (lane & 3)) * 2;
#define GLA_PV(KS, DIRN) do { const s16x4 l_ = gla_tr<(KS) * 5120>(vb), h_ = gla_tr<(KS) * 5120 + 1280>(vb); \
            const bf16x8 a1 = *(const bf16x8*)(Am + ((DIRN) * 64 + tb * 32 + r32) * 72 + (KS) * 16 + hi * 8); \
            const bf16x8 a2 = *(const bf16x8*)(qe + ((DIRN) * 64 + tb * 32 + r32) * 72 + (KS) * 16 + hi * 8); \
            const bf16x8 b2 = *(const bf16x8*)(ST + ((DIRN) * 128 + vbk * 32 + r32) * 72 + (KS) * 16 + hi * 8); \
            asm volatile("s_waitcnt lgkmcnt(0)" ::: "memory"); SBAR(); \
            o = __builtin_amdgcn_mfma_f32_32x32x16_bf16(a1, (bf16x8){l_[0], l_[1], l_[2], l_[3], h_[0], h_[1], h_[2], h_[3]}, o, 0, 0, 0); \
            o = __builtin_amdgcn_mfma_f32_32x32x16_bf16(a2, b2, o, 0, 0, 0); } while (0)
            GLA_PV(0, 0); GLA_PV(1, 0); GLA_PV(2, 0); GLA_PV(3, 0); GLA_PV(0, 1); GLA_PV(1, 1); GLA_PV(2, 1); GLA_PV(3, 1);
#undef GLA_PV
        }
        __syncthreads();
#pragma unroll
        for (int r = 0; r < 16; ++r) ob[(tb * 32 + crow(r, hi)) * 132 + vbk * 32 + r32] = o[r];
        __syncthreads();
        {
            float vals[16]; float ss = 0.f;
#pragma unroll
            for (int i = 0; i < 4; ++i) { const f32x4 x = *(const f32x4*)(ob + nt_t * 132 + nt_v0 + 4 * i); vals[4 * i] = x[0]; vals[4 * i + 1] = x[1]; vals[4 * i + 2] = x[2]; vals[4 * i + 3] = x[3]; }
#pragma unroll
            for (int i = 0; i < 16; ++i) ss += vals[i] * vals[i];
            ss += __shfl_xor(ss, 1); ss += __shfl_xor(ss, 2); ss += __shfl_xor(ss, 4);
            const float rstd = rsqrtf(ss * (1.f / 128.f) + EPSN);
            unsigned pk[8];
#pragma unroll
            for (int i = 0; i < 8; ++i) {
                const unsigned w = rc[i >> 2][i & 3];
                const float r0 = __uint_as_float(w << 16), r1 = __uint_as_float(w & 0xFFFF0000u);
                const float s0 = r0 * __builtin_amdgcn_rcpf(1.f + __expf(-r0)), s1 = r1 * __builtin_amdgcn_rcpf(1.f + __expf(-r1));
                pk[i] = cvtpk(vals[2 * i] * rstd * on[2 * i] * s0, vals[2 * i + 1] * rstd * on[2 * i + 1] * s1);
            }
            bf16_t* M = (bf16_t*)(p.ws + WS_MIX) + ((size_t)gc * 64 + nt_t) * 1024 + h * 128 + nt_v0;
            *(u32x4*)M = (u32x4){pk[0], pk[1], pk[2], pk[3]}; *(u32x4*)(M + 8) = (u32x4){pk[4], pk[5], pk[6], pk[7]};
        }
        rc[0] = rcn[0]; rc[1] = rcn[1];
        __syncthreads();
    }
}

namespace mla8 {
typedef int i32x8 __attribute__((ext_vector_type(8)));
constexpr int KVBLK = 64;
constexpr float SCALE = 0.07216878364870322f;
constexpr float THR = 3.f;
constexpr float PBIAS = 4.f;
constexpr int KROW = 208, VROW = 80;
constexpr int SHM_K = KVBLK * KROW, SHM_V = 128 * VROW;
constexpr int ONE = 0x7F7F7F7F, QSC = 0x7C7C7C7C;
__device__ __forceinline__ i32x8 ld32(const char* a) { const i32x4 lo = *(const i32x4*)a, hi_ = *(const i32x4*)(a + 16); return __builtin_shufflevector(lo, hi_, 0, 1, 2, 3, 4, 5, 6, 7); }
__device__ __forceinline__ void qkt(f32x16& p0, f32x16& p1, const char* Kw, const i32x8 (&q)[3]) {
    p0 = f32x16{}; p1 = f32x16{};
#pragma unroll
    for (int s_ = 0; s_ < 3; ++s_) {
        const i32x8 a0 = ld32(Kw + s_ * 64), a1 = ld32(Kw + 32 * KROW + s_ * 64);
        p0 = __builtin_amdgcn_mfma_scale_f32_32x32x64_f8f6f4(a0, q[s_], p0, 0, 0, 0, ONE, 0, QSC);
        p1 = __builtin_amdgcn_mfma_scale_f32_32x32x64_f8f6f4(a1, q[s_], p1, 0, 0, 0, ONE, 0, QSC);
    }
}
typedef float f32x2 __attribute__((ext_vector_type(2)));
#define M8_PAIR(P, i) ((f32x2){P[2 * (i)], P[2 * (i) + 1]})
#define M8_EXP(P, i) P[i] = __builtin_amdgcn_exp2f(P[i])
__device__ __forceinline__ float fma1(float a, float b, float c) { float d; asm("v_fma_f32 %0, %1, %2, %3" : "=v"(d) : "v"(a), "v"(b), "v"(c)); return d; }
__device__ __forceinline__ float mul1(float a, float b) { float d; asm("v_mul_f32 %0, %1, %2" : "=v"(d) : "v"(a), "v"(b)); return d; }
__device__ __forceinline__ float add1(float a, float b) { float d; asm("v_add_f32 %0, %1, %2" : "=v"(d) : "v"(a), "v"(b)); return d; }
#define M8_MFMA(A, B, C) __builtin_amdgcn_mfma_scale_f32_32x32x64_f8f6f4(A, B, C, 0, 0, 0, ONE, 0, ONE)
#define M8_MFMAQ(A, B, C) __builtin_amdgcn_mfma_scale_f32_32x32x64_f8f6f4(A, B, C, 0, 0, 0, ONE, 0, QSC)
constexpr int NEXP_B = 8;
#define M8_F1(P0, P1) do { M8_EXP(P0, 8); M8_EXP(P0, 9); M8_EXP(P0, 10); M8_EXP(P0, 11); M8_EXP(P0, 12); M8_EXP(P0, 13); } while (0)
#define M8_F2(P0, P1) do { M8_EXP(P0, 14); M8_EXP(P0, 15); M8_EXP(P1, 0); M8_EXP(P1, 1); M8_EXP(P1, 2); M8_EXP(P1, 3); } while (0)
#define M8_F3(P0, P1) do { M8_EXP(P1, 4); M8_EXP(P1, 5); M8_EXP(P1, 6); M8_EXP(P1, 7); M8_EXP(P1, 8); M8_EXP(P1, 9); } while (0)
#define M8_F4(P0, P1) do { M8_EXP(P1, 10); M8_EXP(P1, 11); M8_EXP(P1, 12); M8_EXP(P1, 13); M8_EXP(P1, 14); M8_EXP(P1, 15); } while (0)
#define M8_F5(P0, P1) do { float t0_ = add1(P0[0], P0[1]), t1_ = add1(P0[2], P0[3]), t2_ = add1(P0[4], P0[5]), t3_ = add1(P0[6], P0[7]); \
    _Pragma("unroll") for (int i_ = 8; i_ < 16; i_ += 4) { t0_ = add1(t0_, P0[i_]); t1_ = add1(t1_, P0[i_ + 1]); t2_ = add1(t2_, P0[i_ + 2]); t3_ = add1(t3_, P0[i_ + 3]); } \
    _Pragma("unroll") for (int i_ = 0; i_ < 16; i_ += 4) { t0_ = add1(t0_, P1[i_]); t1_ = add1(t1_, P1[i_ + 1]); t2_ = add1(t2_, P1[i_ + 2]); t3_ = add1(t3_, P1[i_ + 3]); } \
    psum = add1(add1(t0_, t1_), add1(t2_, t3_)); \
    _Pragma("unroll") for (int w_ = 0; w_ < 4; ++w_) { int a_ = __builtin_amdgcn_cvt_pk_fp8_f32(P0[4 * w_], P0[4 * w_ + 1], 0, false); P8[w_] = __builtin_amdgcn_cvt_pk_fp8_f32(P0[4 * w_ + 2], P0[4 * w_ + 3], a_, true); } } while (0)
#define M8_F6A(P0, P1) do { _Pragma("unroll") for (int w_ = 0; w_ < 4; ++w_) { int b_ = __builtin_amdgcn_cvt_pk_fp8_f32(P1[4 * w_], P1[4 * w_ + 1], 0, false); P8[4 + w_] = __builtin_amdgcn_cvt_pk_fp8_f32(P1[4 * w_ + 2], P1[4 * w_ + 3], b_, true); } } while (0)
#define M8_F6B(AL) do { { auto rr_ = __builtin_amdgcn_permlane32_swap(__float_as_uint(psum), __float_as_uint(psum), false, false); psum = __uint_as_float(rr_[0]) + __uint_as_float(rr_[1]); } \
    l_reg = fmaf(l_reg, AL, psum); } while (0)
#define M8_F6(P0, P1, AL) do { M8_F6A(P0, P1); M8_F6B(AL); } while (0)
#define M8_P1(P0, P1) do { float x_ = fmaxf(P0[0], P0[1]); _Pragma("unroll") for (int r_ = 2; r_ < 16; r_ += 2) x_ = fmaxf(fmaxf(x_, P0[r_]), P0[r_ + 1]); \
    _Pragma("unroll") for (int r_ = 0; r_ < 16; r_ += 2) x_ = fmaxf(fmaxf(x_, P1[r_]), P1[r_ + 1]); \
    { auto rr_ = __builtin_amdgcn_permlane32_swap(__float_as_uint(x_), __float_as_uint(x_), false, false); pmax = fmaxf(__uint_as_float(rr_[0]), __uint_as_float(rr_[1])); } } while (0)
#define M8_P2(P0, P1, AL) do { AL = 1.f; if (!__all(pmax <= PBIAS + THR * LOG2E)) { const float d_ = fmaxf(pmax - PBIAS, 0.f); AL = __builtin_amdgcn_exp2f(-d_); \
    _Pragma("unroll") for (int i_ = 0; i_ < 16; ++i_) { P0[i_] -= d_; P1[i_] -= d_; minit[i_] -= d_; } } } while (0)
#define M8_P3(P0, P1) do { M8_EXP(P0, 0); M8_EXP(P0, 1); M8_EXP(P0, 2); M8_EXP(P0, 3); } while (0)
#define M8_P4(P0, P1) do { M8_EXP(P0, 4); M8_EXP(P0, 5); M8_EXP(P0, 6); M8_EXP(P0, 7); } while (0)
__device__ __forceinline__ void attn_body2(const unsigned char* __restrict__ Q8w, const unsigned char* __restrict__ K8h, const unsigned char* __restrict__ V8h, bf16_t* __restrict__ Ob, int seq) {
    char* lds = smem;
    const int tid = tid_opaque(), wid = tid >> 6, lane = tid & 63, r32 = lane & 31, hi = lane >> 5;
    constexpr int BUF = SHM_K + SHM_V;
    float l_reg = 0; f32x16 o[4] = {}; f32x16 minit;
    i32x8 q[3];
    { const unsigned char* qp = Q8w + (size_t)(wid * 32 + r32) * 768 + hi * 32;
#pragma unroll
      for (int s_ = 0; s_ < 3; ++s_) { const i32x4 lo = *(const i32x4*)(qp + s_ * 64), hi_ = *(const i32x4*)(qp + s_ * 64 + 16); q[s_] = __builtin_shufflevector(lo, hi_, 0, 1, 2, 3, 4, 5, 6, 7); } }
    const int kc0 = tid, kc1 = 512 + (tid & 255);
    const int kso0 = (kc0 / 12) * KROW + (kc0 % 12) * 16, kso1 = (kc1 / 12) * KROW + (kc1 % 12) * 16, vso = SHM_K + (tid >> 2) * VROW + (tid & 3) * 16;
    const bool two = tid < 256;
    const char* Kw = lds + r32 * KROW + hi * 32; const char* Vw = lds + SHM_K + r32 * VROW + hi * 32;
    struct { u32x4 k0, k1, v; } st_;
#define SLOAD(t_) do { const unsigned char* kt_ = K8h + (size_t)(t_) * (KVBLK * 192); st_.k0 = *(const u32x4*)(kt_ + kc0 * 16); if (two) st_.k1 = *(const u32x4*)(kt_ + kc1 * 16); \
    st_.v = *(const u32x4*)(V8h + (size_t)(t_) * 8192 + tid * 16); } while (0)
#define SWRITE(bo) do { *(u32x4*)(lds + (bo) + kso0) = st_.k0; if (two) *(u32x4*)(lds + (bo) + kso1) = st_.k1; *(u32x4*)(lds + (bo) + vso) = st_.v; } while (0)
#define RESC(a) do { if (__any((a) < 1.f)) { asm volatile("s_nop 15\n\ts_nop 15\n\ts_nop 15\n\ts_nop 15\n\ts_nop 15\n\ts_nop 15" ::: "memory");     \
    _Pragma("unroll") for (int d = 0; d < 4; ++d) _Pragma("unroll") for (int r = 0; r < 16; ++r) o[d][r] = mul1(o[d][r], (a)); } } while (0)
    f32x16 pA0, pA1, pB0, pB1; float alA = 1.f, alB = 1.f, pmax, psum; i32x8 P8;
    const int NT = seq / KVBLK;
#define TIE3(a, b, c) asm volatile("" : "+v"(a), "+v"(b), "+v"(c))
#define TIE4(a, b, c, d) asm volatile("" : "+v"(a), "+v"(b), "+v"(c), "+v"(d))
#define TIE5(a, b, c, d, e) asm volatile("" : "+v"(a), "+v"(b), "+v"(c), "+v"(d), "+v"(e))
#define TIE6(a, b, c, d, e, f) asm volatile("" : "+v"(a), "+v"(b), "+v"(c), "+v"(d), "+v"(e), "+v"(f))
#define M8_STEP(PC0, PC1, ALC, PN0, PN1, ALN, kb, vb, DO_QK) do { \
    i32x8 k00, k10, k01, k11, k02, k12, v0, v1, v2, v3; \
    int ko_ = (kb), vo_ = (vb);        \
    if (DO_QK) { k00 = ld32(Kw + ko_); k10 = ld32(Kw + ko_ + 32 * KROW); k01 = ld32(Kw + ko_ + 64); \
        PN0 = M8_MFMAQ(k00, q[0], minit); TIE4(PN0, PC0, PC1, ko_); } \
    M8_F1(PC0, PC1); \
    if (DO_QK) { k11 = ld32(Kw + ko_ + 32 * KROW + 64); TIE3(PC0, PC1, k10); PN1 = M8_MFMAQ(k10, q[0], minit); TIE4(PN1, PC0, PC1, ko_); } \
    M8_F2(PC0, PC1); \
    if (DO_QK) { k02 = ld32(Kw + ko_ + 128); TIE3(PC0, PC1, k01); PN0 = M8_MFMAQ(k01, q[1], PN0); TIE4(PN0, PC0, PC1, ko_); } \
    M8_F3(PC0, PC1); \
    if (DO_QK) { k12 = ld32(Kw + ko_ + 32 * KROW + 128); TIE3(PC0, PC1, k11); PN1 = M8_MFMAQ(k11, q[1], PN1); TIE4(PN1, PC0, PC1, vo_); } \
    M8_F4(PC0, PC1); \
    v0 = ld32(Vw + vo_); \
    if (DO_QK) { TIE3(PC0, PC1, k02); PN0 = M8_MFMAQ(k02, q[2], PN0); TIE4(PN0, PC0, PC1, vo_); } \
    M8_F5(PC0, PC1); \
    v1 = ld32(Vw + vo_ + 32 * VROW); \
    if (DO_QK) { TIE5(PC0, PC1, P8, psum, k12); PN1 = M8_MFMAQ(k12, q[2], PN1); TIE6(PN1, PC0, PC1, P8, psum, vo_); } \
    M8_F6A(PC0, PC1); \
    v2 = ld32(Vw + vo_ + 64 * VROW); \
    TIE3(P8, psum, v0); o[0] = M8_MFMA(v0, P8, o[0]); \
    TIE3(o[0], psum, vo_); M8_F6B(ALC); v3 = ld32(Vw + vo_ + 96 * VROW); TIE3(l_reg, psum, v1); \
    o[1] = M8_MFMA(v1, P8, o[1]); \
      \
    if (DO_QK) { TIE4(o[1], PN0, PN1, vo_); M8_P1(PN0, PN1); TIE4(PN0, PN1, pmax, v2); } \
    o[2] = M8_MFMA(v2, P8, o[2]); \
    if (DO_QK) { TIE4(o[2], PN0, PN1, pmax); M8_P2(PN0, PN1, ALN); M8_P3(PN0, PN1); TIE5(PN0, PN1, minit, ALN, v3); } \
    o[3] = M8_MFMA(v3, P8, o[3]); \
    if (DO_QK) { TIE3(o[3], PN0, PN1); M8_P4(PN0, PN1); TIE3(PN0, PN1, ALN); RESC(ALN); } } while (0)
    SLOAD(0); SWRITE(0); SLOAD(1); SWRITE(BUF); __syncthreads();
    SLOAD(2);
    qkt(pA0, pA1, Kw, q);
    M8_P1(pA0, pA1);
    { const float mc_ = PBIAS - pmax;
#pragma unroll
      for (int i_ = 0; i_ < 16; ++i_) { pA0[i_] += mc_; pA1[i_] += mc_; minit[i_] = mc_; } }
    M8_P3(pA0, pA1); M8_P4(pA0, pA1);
    int b0 = 0, b1 = BUF, b2 = 2 * BUF;
    for (int j = 0; j + 2 < NT; j += 2) {
        __syncthreads(); SWRITE(b2); if (j + 3 < NT) SLOAD(j + 3);
        M8_STEP(pA0, pA1, alA, pB0, pB1, alB, b1, b0, true);
        __syncthreads(); SWRITE(b0); if (j + 4 < NT) SLOAD(j + 4);
        M8_STEP(pB0, pB1, alB, pA0, pA1, alA, b2, b1, true);
        { const int t_ = b0; b0 = b2; b2 = b1; b1 = t_; }
    }
    __syncthreads();
    M8_STEP(pA0, pA1, alA, pB0, pB1, alB, b1, b0, true);
    M8_STEP(pB0, pB1, alB, pA0, pA1, alA, 0, b1, false);
    const float rl = __builtin_amdgcn_rcpf(l_reg);
    bf16_t* Ow = Ob + (size_t)(wid * 32 + r32) * 1024 + 4 * hi;
#pragma unroll
    for (int d0 = 0; d0 < 4; ++d0)
#pragma unroll
        for (int g = 0; g < 4; ++g)
            *(u32x2*)(Ow + d0 * 32 + 8 * g) = (u32x2){cvtpk(o[d0][4 * g] * rl, o[d0][4 * g + 1] * rl), cvtpk(o[d0][4 * g + 2] * rl, o[d0][4 * g + 3] * rl)};
    __syncthreads();
#undef SLOAD
#undef SWRITE
#undef RESC
#undef M8_STEP
}
}

__device__ __forceinline__ void phase_mix0(PRef p) {
    const int G = gridDim.x;
    phase_gla_out(p);
    __syncthreads();
    const unsigned char* Q8 = (const unsigned char*)(p.ws + WS_Q8); const unsigned char* K8 = (const unsigned char*)(p.ws + WS_K8); const unsigned char* VT8 = (const unsigned char*)(p.ws + WS_VT8);
    bf16_t* MIX = (bf16_t*)(p.ws + WS_MIX);
    for (int u = blockIdx.x; u < 260; u += G) {
        const bool lat = u < 256;
        const int h = lat ? (u & 3) : (u - 256);
        const size_t q0 = lat ? (size_t)CTXN + (size_t)(u >> 2) * 256 : 0;
        mla8::attn_body2(Q8 + q0 * 768 + h * 192, K8 + (size_t)h * NTOK * 192, VT8 + (size_t)h * NCH * 8192, MIX + q0 * 1024 + 512 + h * 128, lat ? NTOK : CTXN);
    }
}

#define PK4(P, BASE, OUT) do { unsigned a0 = cvtpk(P[BASE + 0], P[BASE + 1]), a1 = cvtpk(P[BASE + 2], P[BASE + 3]);   \
    unsigned b0 = cvtpk(P[BASE + 4], P[BASE + 5]), b1 = cvtpk(P[BASE + 6], P[BASE + 7]);                              \
    auto r0 = __builtin_amdgcn_permlane32_swap(a0, b0, false, false); auto r1 = __builtin_amdgcn_permlane32_swap(a1, b1, false, false); \
    u32x4 w = {r0[0], r1[0], r0[1], r1[1]}; OUT = *reinterpret_cast<bf16x8*>(&w); } while (0)
template <int OFF> __device__ __forceinline__ s16x4 na_tr(int vb) { s16x4 r; asm volatile("ds_read_b64_tr_b16 %0, %1 offset:%2" : "=&v"(r) : "v"(vb), "i"(OFF) : "memory"); return r; }
template <int KS> __device__ __forceinline__ void na_pv(f32x16& o0, f32x16& o1, int vb, bf16x8 pa) {
    const s16x4 a0 = na_tr<KS * 5120>(vb), a1 = na_tr<KS * 5120 + 1280>(vb), b0 = na_tr<KS * 5120 + 64>(vb), b1 = na_tr<KS * 5120 + 1280 + 64>(vb);
    asm volatile("s_waitcnt lgkmcnt(0)" ::: "memory"); SBAR();
    o0 = __builtin_amdgcn_mfma_f32_32x32x16_bf16(pa, (bf16x8){a0[0], a0[1], a0[2], a0[3], a1[0], a1[1], a1[2], a1[3]}, o0, 0, 0, 0);
    o1 = __builtin_amdgcn_mfma_f32_32x32x16_bf16(pa, (bf16x8){b0[0], b0[1], b0[2], b0[3], b1[0], b1[1], b1[2], b1[3]}, o1, 0, 0, 0);
}
template <int MODE> __device__ __forceinline__ void na_softmax(f32x16& p0, f32x16& p1, float& m_reg, float& l_reg, float& alpha, const float* brow, int c0, int hi) {
    constexpr float C = 0.125f * LOG2E;
#define NA_L0(q) (MODE != 2 || (q) >= 12)
#define NA_L1(q) (MODE != 1 || (q) < 4)
    if (MODE == 0) {
#pragma unroll
        for (int q = 0; q < 16; ++q) { p0[q] *= C; p1[q] *= C; }
    } else {
        float bv0[16], bv1[16];
#pragma unroll
        for (int q = 0; q < 16; ++q) { const int kc0 = crow(q, hi); if (NA_L0(q)) bv0[q] = brow[kc0]; if (NA_L1(q)) bv1[q] = brow[32 + kc0]; }
#pragma unroll
        for (int q = 0; q < 16; ++q) { if (NA_L0(q)) asm volatile("" : "+v"(bv0[q])); if (NA_L1(q)) asm volatile("" : "+v"(bv1[q])); }
#pragma unroll
        for (int q = 0; q < 16; ++q) {
            const int kc0 = crow(q, hi), kc1 = 32 + kc0;
            if (NA_L0(q)) { const float t = fmaf(p0[q], C, bv0[q]); p0[q] = ((unsigned)(kc0 - c0) < 16u) ? t : -1e30f; }
            if (NA_L1(q)) { const float t = fmaf(p1[q], C, bv1[q]); p1[q] = ((unsigned)(kc1 - c0) < 16u) ? t : -1e30f; }
        }
    }
    float pmax = -1e30f;
#pragma unroll
    for (int q = 0; q < 16; ++q) { if (NA_L0(q)) pmax = fmaxf(pmax, p0[q]); if (NA_L1(q)) pmax = fmaxf(pmax, p1[q]); }
    { auto rr = __builtin_amdgcn_permlane32_swap(__float_as_uint(pmax), __float_as_uint(pmax), false, false);
      pmax = fmaxf(__uint_as_float(rr[0]), __uint_as_float(rr[1])); }
    const float mn = fmaxf(m_reg, pmax);
    alpha = __builtin_amdgcn_exp2f(m_reg - mn);
    m_reg = mn;
    float ps = 0.f;
#pragma unroll
    for (int q = 0; q < 16; ++q) {
        if (NA_L0(q)) { p0[q] = __builtin_amdgcn_exp2f(p0[q] - mn); ps += p0[q]; } else p0[q] = 0.f;
        if (NA_L1(q)) { p1[q] = __builtin_amdgcn_exp2f(p1[q] - mn); ps += p1[q]; } else p1[q] = 0.f;
    }
    { auto rr = __builtin_amdgcn_permlane32_swap(__float_as_uint(ps), __float_as_uint(ps), false, false);
      ps = __uint_as_float(rr[0]) + __uint_as_float(rr[1]); }
    l_reg = l_reg * alpha + ps;
#undef NA_L0
#undef NA_L1
}
__device__ __forceinline__ void phase_na(PRef p) {
    const int tid = threadIdx.x, lane = tid & 63, wave = tid >> 6, r32 = lane & 31, hi = lane >> 5, G = gridDim.x;
    const bf16_t* QKV = (const bf16_t*)(p.ws + WS_P);
    bf16_t* MIX = (bf16_t*)(p.ws + WS_MIX);
    constexpr int KB = 64 * 72 * 2, VB = 64 * 160 * 2;
    char* Kl = smem;
    char* Vl = smem + 2 * KB;
    float* xch = (float*)(smem + 2 * KB + 2 * VB) + wave * 64;
    float* rpbL = (float*)(smem + 2 * KB + 2 * VB + 8 * 64 * 4);
    constexpr float C = 0.125f * LOG2E;
    const int skey = tid >> 3, sch = tid & 7;
    const int vb0 = (int)(uintptr_t)Vl + (8 * hi + ((lane & 15) >> 2)) * 320 + (16 * ((lane >> 4) & 1) + 4 * (lane & 3)) * 2;
    for (int u = blockIdx.x; u < 64 * 16; u += G) {
        const int rg = u >> 4, h = u & 15;
        const int r = rg * 4 + (wave >> 1), qb = wave & 1;
        const int r0w = min(max(r - 4, 0), 248);
        const int kr_lo = min(max(rg * 4 - 4, 0), 248), kr_hi = min(max(rg * 4 + 3 - 4, 0), 248) + 7, nwin = kr_hi - kr_lo + 1, ntile = nwin + 4;
        for (int i = tid; i < 15 * 31; i += NTH) rpbL[i] = p.na_rpb[(size_t)h * 15 * 31 + i] * LOG2E;
        const int c = qb * 32 + r32, c0 = min(max(c - 8, 0), 48);
        const size_t qrow = (size_t)CTXN + (size_t)r * 64 + c;
        bf16x8 qr[4];
#pragma unroll
        for (int ks = 0; ks < 4; ++ks) qr[ks] = *(const bf16x8*)(QKV + qrow * 3072 + h * 64 + ks * 16 + hi * 8);
        float m_reg = -1e30f, l_reg = 0.f; f32x16 o0 = {}, o1 = {};
        u32x4 skA, svA, skB, svB;
#define NA_LOAD(ti_, SK, SV) do { const size_t key0_ = ((ti_) >= nwin) ? (size_t)((ti_) - nwin) * 64 : (size_t)CTXN + (size_t)(kr_lo + (ti_)) * 64; \
            const bf16_t* src_ = QKV + (key0_ + skey) * 3072 + h * 64 + sch * 8; SK = *(const u32x4*)(src_ + 1024); SV = *(const u32x4*)(src_ + 2048); } while (0)
#define NA_WRITE(b_, SK, SV) do { *(u32x4*)(Kl + (b_) * KB + skey * 144 + sch * 16) = SK; *(u32x4*)(Vl + (b_) * VB + skey * 320 + sch * 16) = SV; } while (0)
        NA_LOAD(0, skA, svA); NA_WRITE(0, skA, svA);
        NA_LOAD(1, skA, svA);
        __syncthreads();
        for (int ti = 0; ti < ntile; ++ti) {
            const int b = ti & 1;
            if (ti + 2 < ntile) { if (b == 0) NA_LOAD(ti + 2, skB, svB); else NA_LOAD(ti + 2, skA, svA); }
            const bool isctx = ti >= nwin;
            const int kr = kr_lo + ti;
            const bool need = isctx || (kr >= r0w && kr <= r0w + 7);
            if (need) {
                const bf16_t* Ks = (const bf16_t*)(Kl + b * KB);
                f32x16 p0 = {}, p1 = {};
#pragma unroll
                for (int ks = 0; ks < 4; ++ks) {
                    const bf16x8 a0 = *(const bf16x8*)(Ks + r32 * 72 + ks * 16 + hi * 8), a1 = *(const bf16x8*)(Ks + (32 + r32) * 72 + ks * 16 + hi * 8);
                    p0 = __builtin_amdgcn_mfma_f32_32x32x16_bf16(a0, qr[ks], p0, 0, 0, 0);
                    p1 = __builtin_amdgcn_mfma_f32_32x32x16_bf16(a1, qr[ks], p1, 0, 0, 0);
                }
                float alpha;
                const float* brow = rpbL + (kr - r + 7) * 31 + 15 - c;
                if (isctx) na_softmax<0>(p0, p1, m_reg, l_reg, alpha, brow, c0, hi);
                else if (qb == 0) na_softmax<1>(p0, p1, m_reg, l_reg, alpha, brow, c0, hi);
                else na_softmax<2>(p0, p1, m_reg, l_reg, alpha, brow, c0, hi);
                bf16x8 pa0, pa1, pa2, pa3;
                PK4(p0, 0, pa0); PK4(p0, 8, pa1); PK4(p1, 0, pa2); PK4(p1, 8, pa3);
                if (__any(alpha < 1.f)) {
                    if (hi == 0) xch[r32] = alpha;
                    asm volatile("s_waitcnt lgkmcnt(0)" ::: "memory");
#pragma unroll
                    for (int q = 0; q < 16; ++q) { const float a = xch[crow(q, hi)]; o0[q] *= a; o1[q] *= a; }
                }
                const int vb = vb0 + b * VB;
                na_pv<0>(o0, o1, vb, pa0); na_pv<1>(o0, o1, vb, pa1); na_pv<2>(o0, o1, vb, pa2); na_pv<3>(o0, o1, vb, pa3);
            }
            if (ti + 1 < ntile) { if (b == 0) NA_WRITE(1, skA, svA); else NA_WRITE(0, skB, svB); }
            __syncthreads();
        }
#undef NA_LOAD
#undef NA_WRITE
        if (hi == 0) xch[32 + r32] = l_reg;
        asm volatile("s_waitcnt lgkmcnt(0)" ::: "memory");
        const size_t orow0 = (size_t)CTXN + (size_t)r * 64 + qb * 32;
#pragma unroll
        for (int q = 0; q < 16; ++q) {
            const int qi = crow(q, hi); const float il = __builtin_amdgcn_rcpf(xch[32 + qi]);
            bf16_t* dst = MIX + (orow0 + qi) * 1024 + h * 64;
            dst[r32] = f2bf(o0[q] * il); dst[32 + r32] = f2bf(o1[q] * il);
        }
        __syncthreads();
    }
}
#undef PK4

#define XB_TMO      128
#define XB_XCNT(j)  (256  + 64 * (j))
#define XB_XSUB(j)  (1280 + 64 * (j))
#define XB_XGEN(j)  (2304 + 64 * (j))
#define XB_TOP      3328
#define XB_TOPGEN   3392
#define XCD_BAR_WORDS 3456
#define XB_SPIN_CAP (1u << 22)
#define LAS __attribute__((address_space(3)))
__device__ __forceinline__ unsigned xb_ld(unsigned* p)              { return __hip_atomic_load(p, __ATOMIC_RELAXED, __HIP_MEMORY_SCOPE_AGENT); }
__device__ __forceinline__ unsigned xb_add(unsigned* p, unsigned v) { return __hip_atomic_fetch_add(p, v, __ATOMIC_RELAXED, __HIP_MEMORY_SCOPE_AGENT); }
__device__ __forceinline__ unsigned xb_xcc_id() { return (unsigned)__builtin_amdgcn_s_getreg((3 << 11) | 20) & 0xFu; }
#define XB_SPIN(cond, bar) do { unsigned _sp = 0; while (cond) { __builtin_amdgcn_s_sleep(1); \
    if ((++_sp & 255u) == 0u) { if (xb_ld(&(bar)[XB_TMO])) break; if (_sp > XB_SPIN_CAP) { atomicAdd(&(bar)[XB_TMO], 1u); break; } } } } while (0)
struct XcdBarrier { unsigned* bar; unsigned x; volatile LAS unsigned* st; };
__device__ __forceinline__ XcdBarrier xcd_barrier_post(unsigned* bar, volatile LAS unsigned* st) {
    XcdBarrier b; b.bar = bar; b.x = xb_xcc_id(); b.st = st;
    if (threadIdx.x == 0) (void)xb_add(&bar[XB_XCNT(b.x)], 1u);
    return b;
}
__device__ __forceinline__ void xcd_barrier_complete(unsigned* bar, unsigned x, unsigned& nloc, unsigned& nx) {
    const unsigned G = gridDim.x * gridDim.y * gridDim.z;
    unsigned sum, cnt, mine, sp = 0u;
    for (;;) {
        sum = 0u; cnt = 0u; mine = 0u;
#pragma unroll
        for (unsigned j = 0; j < 16; ++j) { const unsigned c = xb_ld(&bar[XB_XCNT(j)]); sum += c; cnt += (c > 0u) ? 1u : 0u; mine = (j == x) ? c : mine; }
        if (sum == G) break;
        __builtin_amdgcn_s_sleep(1);
        if ((++sp & 255u) == 0u) { if (xb_ld(&bar[XB_TMO])) break; if (sp > XB_SPIN_CAP) { atomicAdd(&bar[XB_TMO], 1u); break; } }
    }
    nloc = mine > 0u ? mine : 1u; nx = cnt > 0u ? cnt : 1u;
}
__device__ __forceinline__ void xcd_barrier(const XcdBarrier& b) {
    asm volatile("s_waitcnt vmcnt(0)" ::: "memory");
    __syncthreads();
    if (threadIdx.x == 0) {
        unsigned* bar = b.bar;
        __builtin_amdgcn_s_waitcnt(0);
        unsigned nloc = b.st[0], nx = b.st[1];
        if (nloc == 0u) { xcd_barrier_complete(bar, b.x, nloc, nx); b.st[0] = nloc; b.st[1] = nx; }
        const unsigned old = xb_add(&bar[XB_XSUB(b.x)], 1u);
        const unsigned gen = old / nloc;
        if (old + 1u == (gen + 1u) * nloc) {
            __builtin_amdgcn_fence(__ATOMIC_RELEASE, "agent");
            asm volatile("s_waitcnt vmcnt(0)" ::: "memory");
            const unsigned og = xb_add(&bar[XB_TOP], 1u);
            const unsigned tg = og / nx;
            if (og + 1u == (tg + 1u) * nx) xb_add(&bar[XB_TOPGEN], 1u);
            else XB_SPIN(xb_ld(&bar[XB_TOPGEN]) == tg, bar);
            __builtin_amdgcn_fence(__ATOMIC_ACQUIRE, "agent");
            xb_add(&bar[XB_XGEN(b.x)], 1u);
            asm volatile("s_waitcnt vmcnt(0)" ::: "memory");
        } else {
            XB_SPIN(xb_ld(&bar[XB_XGEN(b.x)]) == gen, bar);
            __builtin_amdgcn_fence(__ATOMIC_ACQUIRE, "agent");
            asm volatile("s_waitcnt vmcnt(0)" ::: "memory");
        }
    }
    __syncthreads();
}

__device__ __forceinline__ void run_phase(PRef p, int ph) {
#ifdef ONLY_PHASE
    if (ph != ONLY_PHASE) return;
    ph = ONLY_PHASE;
#endif
    const bf16_t* HB = (const bf16_t*)(p.ws + WS_HB);
    switch (ph) {
    case 0: phase_prologue(p); break;
    case 1: phase_norm1_l0(p); break;
    case 2: phase_gemm_pg8(HB, 1024, (const bf16_t*)(p.ws + WS_WIN), 1024, (bf16_t*)(p.ws + WS_P), PW, NTOK / 256, 8); break;
    case 3: phase_mla_up(p); break;
    case 4: break;
    case 5: phase_gla_scan(p); break;
    case 6: phase_mix0(p); break;
    case 7: phase_gemm_pg8((const bf16_t*)(p.ws + WS_MIX), 1024, (const bf16_t*)(p.ws + WS_WOUT0), 1024, (bf16_t*)(p.ws + WS_OB), 1024, NTOK / 256, 4); break;
    case 8: phase_mid(p, 0); break;
    case 9: phase_moe1(p, 0); break;
    case 10: phase_moe2(p, 0); break;
    case 11: phase_end(p, 0); break;
    case 12: phase_gemm_pg8(HB, 1024, (const bf16_t*)(p.ws + WS_WQKV), 1024, (bf16_t*)(p.ws + WS_P), 3072, NTOK / 256, 12); break;
    case 13: phase_na(p); break;
    case 14: phase_gemm_pg8((const bf16_t*)(p.ws + WS_MIX) + (size_t)CTXN * 1024, 1024, (const bf16_t*)(p.ws + WS_WNAO), 1024, (bf16_t*)(p.ws + WS_OB) + (size_t)CTXN * 1024, 1024, SEQ / 256, 4); break;
    case 15: phase_mid(p, 1); break;
    case 16: phase_moe1(p, 1); break;
    case 17: phase_moe2(p, 1); break;
    case 18: phase_end(p, 1); break;
    default: break;
    }
}
constexpr int N_PHASES = 19;

#if MK_LAUNCHES == 1
__global__ void __launch_bounds__(512) mega_kernel(Params p) {
    cg::grid_group grid = cg::this_grid();
    volatile LAS unsigned* xst = (volatile LAS unsigned*)(smem + LDS_BYTES - 16);
    if (threadIdx.x == 0) { xst[0] = 0u; xst[1] = 0u; xst[2] = 0u; xst[3] = 0u; }
    __syncthreads();
    XcdBarrier xb = xcd_barrier_post((unsigned*)(kparams()->ws + WS_BAR), xst);
    run_phase(*kparams(), 0); xcd_barrier(xb);
    if (kparams()->pad0 == 0x7fffffff) grid.sync();
    if (PROBE_REPEAT == 100) { run_phase(*kparams(), 0); xcd_barrier(xb); }
    if (PROBE_REPEAT == 61) { phase_gla_out(*kparams()); xcd_barrier(xb); }
#define PH_(n) run_phase(*kparams(), n); xcd_barrier(xb); if ((n) == PROBE_REPEAT) { run_phase(*kparams(), n); xcd_barrier(xb); }
    PH_(1) PH_(2) PH_(3) PH_(5) PH_(6) PH_(7) PH_(8) PH_(9) PH_(10) PH_(11) PH_(12) PH_(13) PH_(14) PH_(15) PH_(16) PH_(17)
    run_phase(*kparams(), 18);
#undef PH_
}
#else
template <int PH> __global__ void __launch_bounds__(512) phase_kernel(Params p) { run_phase(*kparams(), PH); }
typedef void (*phase_fn)(Params);
template <int PH> static bool launch_phase(const Params& p, int grid, hipStream_t stream, bool setattr) {
    if (setattr && hipFuncSetAttribute((const void*)phase_kernel<PH>, hipFuncAttributeMaxDynamicSharedMemorySize, LDS_BYTES) != hipSuccess) return false;
    hipLaunchKernelGGL(phase_kernel<PH>, dim3(grid), dim3(NTH), LDS_BYTES, stream, p);
    return true;
}
#endif

extern "C" void kernel_launch(void* const* d_in, const int* in_sizes, int n_in, void* d_out, int out_size, void* d_ws, size_t ws_size, hipStream_t stream) {
    static int grid_blocks = 0;
    bool first = false;
    if (!grid_blocks) {
        if (ws_size < WS_END) { fprintf(stderr, "kernel_launch: workspace too small: %zu < %zu\n", ws_size, (size_t)WS_END); return; }
        int dev = 0, cus = 0;
        (void)hipGetDevice(&dev);
        (void)hipDeviceGetAttribute(&cus, hipDeviceAttributeMultiprocessorCount, dev);
#if MK_LAUNCHES == 1
        if (hipFuncSetAttribute((const void*)mega_kernel, hipFuncAttributeMaxDynamicSharedMemorySize, LDS_BYTES) != hipSuccess) { fprintf(stderr, "kernel_launch: LDS attribute failed\n"); return; }
        int per_cu = 0;
        (void)hipOccupancyMaxActiveBlocksPerMultiprocessor(&per_cu, (const void*)mega_kernel, NTH, LDS_BYTES);
        if (per_cu < 1) { fprintf(stderr, "kernel_launch: occupancy query returned %d\n", per_cu); return; }
#endif
        grid_blocks = cus;
        first = true;
    }
    Params p{};
    const float* const* in = (const float* const*)d_in;
    p.x = in[0]; p.c = in[1]; p.ctx = in[2]; p.c_ctx = in[3]; p.ada_w = in[4]; p.ada_b = in[5]; p.norm_g = in[6]; p.router_w = in[7]; p.router_b = in[8];
    p.moe_w1 = in[9]; p.moe_b1 = in[10]; p.moe_w2 = in[11]; p.moe_b2 = in[12]; p.ab_in_w = in[13]; p.gla_wa_f = in[14]; p.gla_ba_f = in[15]; p.gla_wa_b = in[16]; p.gla_ba_b = in[17];
    p.gla_onorm = in[18]; p.mla_qnorm = in[19]; p.mla_wuq = in[20]; p.mla_kvnorm = in[21]; p.mla_wukv = in[22]; p.ab_out_w = in[23]; p.na_qkv_w = in[24]; p.na_rpb = in[25]; p.na_out_w = in[26];
    p.out = (float*)d_out; p.ws = (char*)d_ws;
#if MK_LAUNCHES == 1
    (void)hipMemsetAsync((char*)d_ws + WS_BAR, 0, 16384, stream);
    void* args[] = {&p};
    hipError_t e = hipLaunchCooperativeKernel((const void*)mega_kernel, dim3(grid_blocks), dim3(NTH), args, LDS_BYTES, stream);
    if (e != hipSuccess) fprintf(stderr, "cooperative launch failed: %s (grid %d)\n", hipGetErrorString(e), grid_blocks);
#else
    const int g = grid_blocks;
    launch_phase<0>(p, g, stream, first); launch_phase<1>(p, g, stream, first); launch_phase<2>(p, g, stream, first); launch_phase<3>(p, g, stream, first);
    launch_phase<4>(p, g, stream, first); launch_phase<5>(p, g, stream, first); launch_phase<6>(p, g, stream, first); launch_phase<7>(p, g, stream, first);
    launch_phase<8>(p, g, stream, first); launch_phase<9>(p, g, stream, first); launch_phase<10>(p, g, stream, first); launch_phase<11>(p, g, stream, first);
    launch_phase<12>(p, g, stream, first); launch_phase<13>(p, g, stream, first); launch_phase<14>(p, g, stream, first); launch_phase<15>(p, g, stream, first);
    launch_phase<16>(p, g, stream, first); launch_phase<17>(p, g, stream, first); launch_phase<18>(p, g, stream, first);
#endif
}
```

```cpp
#include <hip/hip_runtime.h>
#include <hip/hip_cooperative_groups.h>
#include <cstdio>
#include <cstdint>
namespace cg = cooperative_groups;

#ifndef PROBE_REPEAT
#define PROBE_REPEAT -1
#endif
#ifndef MK_LAUNCHES
#define MK_LAUNCHES 1
#endif

typedef unsigned short bf16_t;
typedef short bf16x8 __attribute__((ext_vector_type(8)));
typedef short s16x4 __attribute__((ext_vector_type(4)));
typedef float f32x4 __attribute__((ext_vector_type(4)));
typedef float f32x16 __attribute__((ext_vector_type(16)));
typedef unsigned u32x4 __attribute__((ext_vector_type(4)));
typedef int i32x4 __attribute__((ext_vector_type(4)));
typedef unsigned u32x2 __attribute__((ext_vector_type(2)));

constexpr int SEQ = 16384, CTXN = 256, NTOK = SEQ + CTXN, DM = 1024;
constexpr int NEXP = 32, FF = 1024;
constexpr int PW = 2048;
constexpr int PC_Q = 0, PC_K = 256, PC_V = 512, PC_R = 1024, PC_AF = 1536, PC_AB = 1552, PC_CQ = 1568, PC_CKV = 1824, PC_KR = 1952;
constexpr int NCH = NTOK / 64;
constexpr int NTH = 512;
constexpr float EPSN = 1e-6f;
constexpr float LOG2E = 1.4426950408889634f;

constexpr size_t al256(size_t x) { return (x + 255) / 256 * 256; }
constexpr size_t WS_BAR   = 0;
constexpr size_t WS_CNT   = WS_BAR + 16384;
constexpr size_t WS_MOD   = WS_CNT + 1024;
constexpr size_t WS_ROPE  = WS_MOD + al256((size_t)2 * 2 * 6144 * 4);
constexpr size_t WS_RWT   = WS_ROPE + al256((size_t)(256 + 256 + 64 + 64) * 16 * 4);
constexpr size_t WS_WIN   = WS_RWT + al256((size_t)2 * 32 * 1024 * 4);
constexpr size_t WS_WUQ   = WS_WIN + (size_t)2048 * 1024 * 2;
constexpr size_t WS_WUKV  = WS_WUQ + (size_t)768 * 256 * 2;
constexpr size_t WS_WOUT0 = WS_WUKV + (size_t)1024 * 128 * 2;
constexpr size_t WS_WQKV  = WS_WOUT0 + (size_t)1024 * 1024 * 2;
constexpr size_t WS_WNAO  = WS_WQKV + (size_t)3072 * 1024 * 2;
constexpr size_t WS_W1T   = WS_WNAO + (size_t)1024 * 1024 * 2;
constexpr size_t WS_W2T   = WS_W1T + (size_t)2 * 32 * 2048 * 1024 * 2;
constexpr size_t WS_Q8    = WS_W1T + (size_t)2 * 32 * 2048 * 1024;
constexpr size_t WS_K8    = WS_Q8 + (size_t)NTOK * 768;
constexpr size_t WS_VT8   = WS_K8 + (size_t)NTOK * 768;
constexpr size_t WS_DUMMY = WS_VT8 + (size_t)NTOK * 512;
static_assert(WS_DUMMY + (size_t)256 * 2048 <= WS_W2T, "fp8 MLA operands overflow the W1T region");
constexpr size_t WS_HB    = WS_W2T + (size_t)2 * 32 * 1024 * 1024 * 2;
constexpr size_t WS_P     = WS_HB + (size_t)NTOK * 1024 * 2;
constexpr size_t WS_QM    = WS_P + (size_t)NTOK * 3072 * 2;
constexpr size_t WS_KM    = WS_QM + (size_t)NTOK * 768 * 2;
constexpr size_t WS_VM    = WS_KM + (size_t)NTOK * 768 * 2;
constexpr size_t WS_U     = WS_VM + (size_t)NTOK * 512 * 2;
constexpr size_t WS_SIN   = WS_U + (size_t)2 * NCH * 4 * 128 * 64 * 2;
constexpr size_t WS_DEC   = WS_SIN + (size_t)2 * NCH * 4 * 128 * 64 * 2;
constexpr size_t WS_MIX   = WS_DEC + al256((size_t)2 * NCH * 4 * 64 * 4);
constexpr size_t WS_OB    = WS_MIX + (size_t)NTOK * 1024 * 2;
constexpr size_t WS_X1    = WS_OB + (size_t)NTOK * 1024 * 2;
constexpr size_t WS_X2    = WS_X1 + (size_t)NTOK * 1024 * 4;
constexpr size_t WS_TOPE  = WS_X2 + (size_t)NTOK * 1024 * 4;
constexpr size_t WS_TOPP  = WS_TOPE + al256((size_t)NTOK * 4 * 4);
constexpr size_t WS_GATE  = WS_TOPP + al256((size_t)NTOK * 4 * 4);
constexpr size_t WS_LIST  = WS_GATE + al256((size_t)NTOK * 4 * 4);
constexpr size_t WS_ACT   = WS_LIST + al256((size_t)32 * NTOK * 4);
constexpr size_t WS_YB    = WS_ACT + (size_t)(NTOK * 4 + 256) * 1024 * 2;
constexpr size_t WS_END   = WS_YB + (size_t)(NTOK * 4) * 1024 * 2;

constexpr int LDS_BYTES = 160 * 1024;
extern __shared__ __attribute__((aligned(16))) char smem[];

struct Params {
    const float *x, *c, *ctx, *c_ctx, *ada_w, *ada_b, *norm_g, *router_w, *router_b, *moe_w1, *moe_b1, *moe_w2, *moe_b2;
    const float *ab_in_w, *gla_wa_f, *gla_ba_f, *gla_wa_b, *gla_ba_b, *gla_onorm, *mla_qnorm, *mla_wuq, *mla_kvnorm, *mla_wukv;
    const float *ab_out_w, *na_qkv_w, *na_rpb, *na_out_w;
    float* out; char* ws;
    int pad0, pad1;
};
typedef const __attribute__((address_space(4))) Params& PRef;
typedef const __attribute__((address_space(4))) Params* KPtr;
__device__ __forceinline__ KPtr kparams() { KPtr k = (KPtr)__builtin_amdgcn_kernarg_segment_ptr(); asm volatile("" : "+s"(k)); return k; }

__device__ __forceinline__ float bf2f(bf16_t h) { return __uint_as_float(((unsigned)h) << 16); }
__device__ __forceinline__ bf16_t f2bf(float f) { unsigned u = __float_as_uint(f); u += 0x7FFFu + ((u >> 16) & 1u); return (bf16_t)(u >> 16); }
__device__ __forceinline__ unsigned cvtpk(float lo, float hi) { unsigned r; asm volatile("v_cvt_pk_bf16_f32 %0, %1, %2" : "=v"(r) : "v"(lo), "v"(hi)); return r; }
__device__ __forceinline__ float wave_sum(float v) {
#pragma unroll
    for (int o = 32; o >= 1; o >>= 1) v += __shfl_xor(v, o);
    return v;
}
__device__ __forceinline__ int crow(int r, int hi) { return (r & 3) + 8 * (r >> 2) + 4 * hi; }
__device__ __forceinline__ float silu_f(float x) { return x / (1.f + __expf(-x)); }
#define SBAR() __builtin_amdgcn_sched_barrier(0)
__device__ __forceinline__ unsigned pk4_fp8_nc(float a, float b, float c, float d) { int r = __builtin_amdgcn_cvt_pk_fp8_f32(a, b, 0, false); r = __builtin_amdgcn_cvt_pk_fp8_f32(c, d, r, true); return (unsigned)r; }
__device__ __forceinline__ unsigned pk4_fp8(float a, float b, float c, float d) {
    a = __builtin_amdgcn_fmed3f(a, -448.f, 448.f); b = __builtin_amdgcn_fmed3f(b, -448.f, 448.f); c = __builtin_amdgcn_fmed3f(c, -448.f, 448.f); d = __builtin_amdgcn_fmed3f(d, -448.f, 448.f);
    int r = __builtin_amdgcn_cvt_pk_fp8_f32(a, b, 0, false); r = __builtin_amdgcn_cvt_pk_fp8_f32(c, d, r, true); return (unsigned)r; }
constexpr float MIX8_SCALE = 8.f;
__device__ __forceinline__ unsigned pk2_fp8(float a, float b) { a = __builtin_amdgcn_fmed3f(a, -448.f, 448.f); b = __builtin_amdgcn_fmed3f(b, -448.f, 448.f); return (unsigned)__builtin_amdgcn_cvt_pk_fp8_f32(a, b, 0, false); }
__device__ __forceinline__ int tid_opaque() { int t = threadIdx.x; asm volatile("" : "+v"(t)); return t; }

struct ConvJob { const float* src; bf16_t* dst; const float* gain; int K, Nsrc, kt, nt, mode, f8; };
constexpr int CONV8_RS = 264;
constexpr float W8_SCALE = 64.f;
__device__ __forceinline__ void conv_load(const ConvJob& jb, float4 (&v)[16]) {
    const int tid = threadIdx.x, n4 = tid & 63, kr = tid >> 6, n = jb.nt * 256 + n4 * 4;
    const float* q = jb.src + (size_t)(jb.kt * 128 + kr) * jb.Nsrc + n;
#pragma unroll
    for (int i = 0; i < 16; ++i) { if (n < jb.Nsrc) { const f32x4 t = __builtin_nontemporal_load((const f32x4*)(q + (size_t)(8 * i) * jb.Nsrc)); v[i] = make_float4(t[0], t[1], t[2], t[3]); } else v[i] = make_float4(0.f, 0.f, 0.f, 0.f); }
}
__device__ __forceinline__ void conv_to_lds(const ConvJob& jb, const float4 (&v)[16]) {
    bf16_t* T = (bf16_t*)smem;
    const int tid = threadIdx.x, n4 = tid & 63, kr = tid >> 6;
#pragma unroll
    for (int i = 0; i < 16; ++i) {
        const int k = kr + 8 * i;
        float4 w = v[i];
        if (jb.mode == 1) { const float g = jb.gain[jb.kt * 128 + k]; w.x *= g; w.y *= g; w.z *= g; w.w *= g; }
        if (jb.f8) { *(unsigned*)((char*)smem + k * CONV8_RS + n4 * 4) = pk4_fp8(w.x * W8_SCALE, w.y * W8_SCALE, w.z * W8_SCALE, w.w * W8_SCALE); continue; }
        u32x2 pk; pk.x = cvtpk(w.x, w.y); pk.y = cvtpk(w.z, w.w);
        *(u32x2*)(T + k * 260 + n4 * 4) = pk;
    }
}
__device__ __forceinline__ void conv_readout(const ConvJob& jb) {
    const bf16_t* T = (const bf16_t*)smem;
    const int tid = threadIdx.x, k0 = jb.kt * 128;
    if (jb.f8) {
        const unsigned char* T8 = (const unsigned char*)smem;
#pragma unroll
        for (int i = 0; i < 4; ++i) {
            const int cc = tid + 512 * i, nn = cc >> 3, kc = cc & 7;
            const int col = (jb.mode == 2) ? (2 * (nn & 127) + (nn >> 7)) : nn;
            unsigned e[16];
#pragma unroll
            for (int j = 0; j < 16; ++j) e[j] = T8[(kc * 16 + j) * CONV8_RS + col];
            u32x4 o;
#pragma unroll
            for (int q = 0; q < 4; ++q) o[q] = e[4 * q] | (e[4 * q + 1] << 8) | (e[4 * q + 2] << 16) | (e[4 * q + 3] << 24);
            __builtin_nontemporal_store(o, (u32x4*)((char*)jb.dst + (size_t)(jb.nt * 256 + nn) * jb.K + k0 + kc * 16));
        }
        return;
    }
#pragma unroll
    for (int i = 0; i < 8; ++i) {
        const int cc = tid + 512 * i, nn = cc >> 4, kc = cc & 15;
        const int col = (jb.mode == 2) ? (2 * (nn & 127) + (nn >> 7)) : nn;
        unsigned short e[8];
#pragma unroll
        for (int j = 0; j < 8; ++j) e[j] = T[(kc * 8 + j) * 260 + col];
        u32x4 o; o.x = e[0] | ((unsigned)e[1] << 16); o.y = e[2] | ((unsigned)e[3] << 16); o.z = e[4] | ((unsigned)e[5] << 16); o.w = e[6] | ((unsigned)e[7] << 16);
        __builtin_nontemporal_store(o, (u32x4*)(jb.dst + (size_t)(jb.nt * 256 + nn) * jb.K + k0 + kc * 8));
    }
}

__device__ __forceinline__ void adaln_job(PRef p, int job) {
    const int l = job / 24, cb = (job % 24) * 256, tid = threadIdx.x;
    float* sv = (float*)smem;
    for (int i = tid; i < 2048; i += NTH) { const int k = i & 1023; const float xx = (i < 1024) ? p.c[k] : p.c_ctx[k]; sv[i] = silu_f(xx); }
    __syncthreads();
    const int col4 = tid & 63, kq = tid >> 6;
    float4 a0 = make_float4(0, 0, 0, 0), a1 = make_float4(0, 0, 0, 0);
    const float* w = p.ada_w + ((size_t)l * 1024 + kq * 128) * 6144 + cb + col4 * 4;
#pragma unroll 8
    for (int k = 0; k < 128; ++k) {
        const float4 wv = *(const float4*)(w + (size_t)k * 6144);
        const float s0 = sv[kq * 128 + k], s1 = sv[1024 + kq * 128 + k];
        a0.x += s0 * wv.x; a0.y += s0 * wv.y; a0.z += s0 * wv.z; a0.w += s0 * wv.w;
        a1.x += s1 * wv.x; a1.y += s1 * wv.y; a1.z += s1 * wv.z; a1.w += s1 * wv.w;
    }
    float* red = sv + 2048;
    *(float4*)(red + (kq * 2 + 0) * 256 + col4 * 4) = a0;
    *(float4*)(red + (kq * 2 + 1) * 256 + col4 * 4) = a1;
    __syncthreads();
    {
        const int s = tid >> 8, col = tid & 255;
        float acc = p.ada_b[l * 6144 + cb + col];
#pragma unroll
        for (int q = 0; q < 8; ++q) acc += red[(q * 2 + s) * 256 + col];
        ((float*)(p.ws + WS_MOD))[(l * 2 + s) * 6144 + cb + col] = acc;
    }
    __syncthreads();
}

__device__ __forceinline__ void tables_job(PRef p) {
    float* rope = (float*)(p.ws + WS_ROPE);
    const int tid = threadIdx.x;
    for (int i = tid; i < (256 + 64) * 16; i += NTH) {
        const bool isrow = i < 256 * 16;
        const int idx = isrow ? i : i - 256 * 16, pos = idx >> 4, j = idx & 15;
        const float inv = exp2f(-(float)j * (13.287712379549449f / 16.f));
        const float ang = (float)pos * inv;
        float rev = ang * 0.15915494309189535f; rev -= rintf(rev);
        const float cs = __builtin_amdgcn_cosf(rev), sn = __builtin_amdgcn_sinf(rev);
        if (isrow) { rope[idx] = cs; rope[256 * 16 + idx] = sn; }
        else { rope[512 * 16 + idx] = cs; rope[512 * 16 + 64 * 16 + idx] = sn; }
    }
    if (tid < 64) ((int*)(p.ws + WS_CNT))[tid] = 0;
}
__device__ __forceinline__ void rwt_job(PRef p, int l) {
    float* dst = (float*)(p.ws + WS_RWT) + (size_t)l * 32 * 1024;
    const float* src = p.router_w + (size_t)l * 1024 * 32;
    for (int i = threadIdx.x; i < 32 * 1024; i += NTH) { const int cch = i >> 5, e = i & 31; dst[e * 1024 + cch] = src[i]; }
}

constexpr int J_IN = 8 * 8, J_UQ = 2 * 3, J_UKV = 1 * 4, J_OUT0 = 32, J_QKV = 8 * 12, J_NAO = 32, J_W1 = 64 * 64, J_W2 = 64 * 32;
constexpr int J_TOTAL = J_IN + J_UQ + J_UKV + J_OUT0 + J_QKV + J_NAO + J_W1 + J_W2;
__device__ __forceinline__ ConvJob conv_decode(PRef p, int j) {
    ConvJob jb; jb.gain = nullptr; jb.mode = 0; jb.f8 = 0;
    int t = j;
    if (t < J_W1) { const int m = t >> 6, q = t & 63; jb.src = p.moe_w1 + (size_t)m * 1024 * 2048; jb.dst = (bf16_t*)(p.ws + WS_W1T + (size_t)m * 2048 * 1024); jb.K = 1024; jb.Nsrc = 2048; jb.kt = q >> 3; jb.nt = q & 7; jb.mode = 2; jb.f8 = 1; return jb; } t -= J_W1;
    if (t < J_W2) { const int m = t >> 5, q = t & 31; jb.src = p.moe_w2 + (size_t)m * 1024 * 1024; jb.dst = (bf16_t*)(p.ws + WS_W2T + (size_t)m * 1024 * 1024); jb.K = 1024; jb.Nsrc = 1024; jb.kt = q >> 2; jb.nt = q & 3; jb.f8 = 1; return jb; } t -= J_W2;
    if (t < J_IN) { jb.src = p.ab_in_w; jb.dst = (bf16_t*)(p.ws + WS_WIN); jb.K = 1024; jb.Nsrc = 2016; jb.kt = t / 8; jb.nt = t % 8; return jb; } t -= J_IN;
    if (t < J_UQ) { jb.src = p.mla_wuq; jb.dst = (bf16_t*)(p.ws + WS_WUQ); jb.K = 256; jb.Nsrc = 768; jb.kt = t / 3; jb.nt = t % 3; jb.mode = 1; jb.gain = p.mla_qnorm; return jb; } t -= J_UQ;
    if (t < J_UKV) { jb.src = p.mla_wukv; jb.dst = (bf16_t*)(p.ws + WS_WUKV); jb.K = 128; jb.Nsrc = 1024; jb.kt = 0; jb.nt = t; jb.mode = 1; jb.gain = p.mla_kvnorm; return jb; } t -= J_UKV;
    if (t < J_OUT0) { jb.src = p.ab_out_w; jb.dst = (bf16_t*)(p.ws + WS_WOUT0); jb.K = 1024; jb.Nsrc = 1024; jb.kt = t / 4; jb.nt = t % 4; jb.f8 = 1; return jb; } t -= J_OUT0;
    if (t < J_QKV) { jb.src = p.na_qkv_w; jb.dst = (bf16_t*)(p.ws + WS_WQKV); jb.K = 1024; jb.Nsrc = 3072; jb.kt = t / 12; jb.nt = t % 12; jb.f8 = 1; return jb; } t -= J_QKV;
    jb.src = p.na_out_w; jb.dst = (bf16_t*)(p.ws + WS_WNAO); jb.K = 1024; jb.Nsrc = 1024; jb.kt = t / 4; jb.nt = t % 4; jb.f8 = 1; return jb;
}

__device__ __forceinline__ void phase_prologue(PRef p) {
    const int G = gridDim.x, b = blockIdx.x;
    for (int j = b; j < 51; j += G) {
        if (j < 48) adaln_job(p, j);
        else if (j == 48) tables_job(p);
        else rwt_job(p, j - 49);
    }
    __syncthreads();
    int j = b;
    if (j >= J_TOTAL) return;
    ConvJob cur = conv_decode(p, j);
    float4 v[16];
    conv_load(cur, v);
    for (;;) {
        conv_to_lds(cur, v);
        __syncthreads();
        const int jn = j + G;
        ConvJob nxt = cur;
        if (jn < J_TOTAL) { nxt = conv_decode(p, jn); conv_load(nxt, v); }
        conv_readout(cur);
        __syncthreads();
        if (jn >= J_TOTAL) break;
        cur = nxt; j = jn;
    }
}

namespace gm {
constexpr int BK = 64, HT = 128 * 64;
__device__ __forceinline__ int lds_byte(int r, int c) { const int st = (r >> 4) * 2 + (c >> 5), rr = r & 15, cc = c & 31, ob = rr * 64 + cc * 2; return st * 1024 + (ob ^ (((ob >> 9) & 1) << 5)); }
__device__ __forceinline__ void stage_rc(int b, int& R, int& C) { const int st = b / 1024, sb = b % 1024, swz = sb ^ (((sb >> 9) & 1) << 5); R = (st >> 1) * 16 + swz / 64; C = (st & 1) * 32 + (swz % 64) / 2; }

template <class Epi>
__device__ __forceinline__ void gemm_tile(const bf16_t* __restrict__ A, const int (&aoff)[2][2], const bf16_t* __restrict__ Bt, const int (&boff)[2], int nk, Epi& epi) {
    bf16_t* shm = (bf16_t*)smem;
    const int tid = tid_opaque(), wid = tid >> 6, lane = tid & 63, wr = wid >> 1, wc = wid & 1, fr = lane & 15, fq = lane >> 4;
    f32x4 acc[4][4];
#pragma unroll
    for (int m = 0; m < 4; ++m)
#pragma unroll
        for (int n = 0; n < 4; ++n) acc[m][n] = (f32x4){0.f, 0.f, 0.f, 0.f};
#define GM_STAGE(buf, kt) do { \
        _Pragma("unroll") for (int _i = 0; _i < 2; ++_i) { \
            __builtin_amdgcn_global_load_lds((const unsigned*)(A + aoff[0][_i] + (kt) * BK), (unsigned*)((char*)(shm + ((buf) * 3 + 0) * HT) + tid * 16 + _i * 8192), 16, 0, 0); \
            __builtin_amdgcn_global_load_lds((const unsigned*)(A + aoff[1][_i] + (kt) * BK), (unsigned*)((char*)(shm + ((buf) * 3 + 1) * HT) + tid * 16 + _i * 8192), 16, 0, 0); \
            __builtin_amdgcn_global_load_lds((const unsigned*)(Bt + boff[_i] + (kt) * BK), (unsigned*)((char*)(shm + ((buf) * 3 + 2) * HT) + tid * 16 + _i * 8192), 16, 0, 0); } } while (0)
    GM_STAGE(0, 0);
    for (int kt = 0; kt < nk; ++kt) {
        __syncthreads();
        const int buf = kt & 1;
        if (kt + 1 < nk) GM_STAGE(buf ^ 1, kt + 1);
        const char* Ab = (const char*)(shm + (buf * 3 + (wr >> 1)) * HT);
        const char* Bb = (const char*)(shm + (buf * 3 + 2) * HT);
#pragma unroll
        for (int k = 0; k < 2; ++k) {
            bf16x8 Bf[4], Af[4];
#pragma unroll
            for (int n = 0; n < 4; ++n) Bf[n] = *(const bf16x8*)(Bb + lds_byte(wc * 64 + n * 16 + fr, k * 32 + fq * 8));
#pragma unroll
            for (int m = 0; m < 4; ++m) Af[m] = *(const bf16x8*)(Ab + lds_byte((wr & 1) * 64 + m * 16 + fr, k * 32 + fq * 8));
#pragma unroll
            for (int m = 0; m < 4; ++m)
#pragma unroll
                for (int n = 0; n < 4; ++n) acc[m][n] = __builtin_amdgcn_mfma_f32_16x16x32_bf16(Af[m], Bf[n], acc[m][n], 0, 0, 0);
        }
    }
#undef GM_STAGE
    float* stg = (float*)smem;
    __syncthreads();
    {
        float* wb = stg + (wr * 64 + fq * 4) * 132 + wc * 64 + fr;
#pragma unroll
        for (int m = 0; m < 4; ++m)
#pragma unroll
            for (int n = 0; n < 4; ++n)
#pragma unroll
                for (int j = 0; j < 4; ++j) wb[(m * 16 + j) * 132 + n * 16] = acc[m][n][j];
    }
    __syncthreads();
    if (Epi::MOE1) {
        const int fch = tid & 7, rg = tid >> 3;
        for (int ps = 0; ps < 4; ++ps) {
            const int row = ps * 64 + rg;
            const float* q = stg + row * 132 + (fch >> 1) * 32 + (fch & 1) * 8;
            float g[8], l[8];
            *(f32x4*)&g[0] = *(const f32x4*)q; *(f32x4*)&g[4] = *(const f32x4*)(q + 4);
            *(f32x4*)&l[0] = *(const f32x4*)(q + 16); *(f32x4*)&l[4] = *(const f32x4*)(q + 20);
            epi.pair(row, fch * 8, g, l);
        }
    } else {
        const int ch = tid & 15, rg = tid >> 4;
        for (int ps = 0; ps < 8; ++ps) {
            const int row = ps * 32 + rg;
            const float* q = stg + row * 132 + ch * 8;
            float v[8];
            *(f32x4*)&v[0] = *(const f32x4*)q; *(f32x4*)&v[4] = *(const f32x4*)(q + 4);
            epi.row8(row, ch * 8, v);
        }
    }
    __syncthreads();
}
__device__ __forceinline__ void make_off(int (&off)[2][2], int row0, int ld) {
#pragma unroll
    for (int h = 0; h < 2; ++h)
#pragma unroll
        for (int i = 0; i < 2; ++i) { int R, C; stage_rc(tid_opaque() * 16 + i * 8192, R, C); off[h][i] = (row0 + h * 128 + R) * ld + C; }
}
__device__ __forceinline__ void make_off1(int (&off)[2], int row0, int ld) {
#pragma unroll
    for (int i = 0; i < 2; ++i) { int R, C; stage_rc(tid_opaque() * 16 + i * 8192, R, C); off[i] = (row0 + R) * ld + C; }
}
}

namespace pg8 {
#define PG8_LAS __attribute__((address_space(3)))
constexpr int BM = 256, BK = 64, HALF = 128, HTB = HALF * BK * 2, STAGE_BYTES = 8 * HTB, NXCD = 8, WGM = 8;
__device__ __forceinline__ int lds_byte(int r, int c) { const int st = (r >> 4) * 2 + (c >> 5), rr = r & 15, cc = c & 31, ob = rr * 64 + cc * 2; return st * 1024 + (ob ^ (((ob >> 9) & 1) << 5)); }
__device__ __forceinline__ void stage_rc(int b, int& R, int& C) { const int st = b / 1024, sb = b % 1024, swz = sb ^ (((sb >> 9) & 1) << 5); R = (st >> 1) * 16 + swz / 64; C = (st & 1) * 32 + (swz % 64) / 2; }
__device__ __forceinline__ int perm32(int rho) { const int n = rho >> 4, i = rho & 15; return 8 * (i >> 2) + 4 * n + (i & 3); }
struct Unit { int pm, pn, e, nvalid, slot0, lbase; };

template <class Epi, class Sched, bool GATHER, bool F8 = false>
__device__ __forceinline__ void gemm_phase(PG8_LAS unsigned char* lds, const Sched& S, const Epi& E, int K, int lda, int ldb, int scA = 0x7F7F7F7F, int scB = 0x7F7F7F7F) {
    const int tid = tid_opaque(), wid = __builtin_amdgcn_readfirstlane(tid >> 6), lane = tid & 63, wr = wid >> 2, wc = wid & 3, fr = lane & 15, fq = lane >> 4;
    const int nt = K / BK;
    unsigned voffA[2], voffB[2]; int gR[2], gC[2];
#pragma unroll
    for (int i = 0; i < 2; ++i) { int R, C; stage_rc(tid * 16 + i * 8192, R, C); const int Rb = Epi::PERM ? ((R & ~31) + perm32(R & 31)) : R;
        voffA[i] = (unsigned)(R * lda + C) * 2u; voffB[i] = (unsigned)(Rb * ldb + C) * 2u; gR[i] = R; gC[i] = C * 2; }
    const size_t kstep = (size_t)(BK * 2);
    const size_t hstepA = (size_t)HALF * lda * 2, hstepB = (size_t)HALF * ldb * 2;
    const unsigned ldsw = (unsigned)wid * 1024u;
    const int aoff = lds_byte(wr * 64 + fr, fq * 8), boff = lds_byte(wc * 32 + fr, fq * 8);
    unsigned gA[2][2] = {{0u, 0u}, {0u, 0u}};
#define PG8_SA(b, h) (((b) * 2 + (h)) * HTB)
#define PG8_SB(b, h) ((4 + (b) * 2 + (h)) * HTB)
#define PG8_STAGE(bufoff, gbase, voff) do { _Pragma("unroll") for (int _i = 0; _i < 2; ++_i) \
        __builtin_amdgcn_global_load_lds((const unsigned*)((const char*)(gbase) + (voff)[_i]), (PG8_LAS unsigned*)(lds + (bufoff) + ldsw + _i * 8192), 16, 0, 0); } while (0)
#define PG8_STAGE_A(bufoff, base, h) do { if constexpr (GATHER) PG8_STAGE(bufoff, base, gA[h]); else PG8_STAGE(bufoff, (base) + (h) * hstepA, voffA); } while (0)
#define PG8_LDA(dst, b, h) do { _Pragma("unroll") for (int m = 0; m < 4; ++m) _Pragma("unroll") for (int k = 0; k < 2; ++k) dst[m][k] = *(const PG8_LAS bf16x8*)(lds + PG8_SA(b, h) + aoff + m * 2048 + k * 1024); } while (0)
#define PG8_LDB(dst, b, h) do { _Pragma("unroll") for (int n = 0; n < 2; ++n) _Pragma("unroll") for (int k = 0; k < 2; ++k) dst[n][k] = *(const PG8_LAS bf16x8*)(lds + PG8_SB(b, h) + boff + n * 2048 + k * 1024); } while (0)
#define PG8_MMA(ai, bj, At, Bt) do { __builtin_amdgcn_s_setprio(1); _Pragma("unroll") for (int m = 0; m < 4; ++m) _Pragma("unroll") for (int n = 0; n < 2; ++n) { \
        if constexpr (F8) { const i32x4 _b0 = __builtin_bit_cast(i32x4, Bt[n][0]), _b1 = __builtin_bit_cast(i32x4, Bt[n][1]), _a0 = __builtin_bit_cast(i32x4, At[m][0]), _a1 = __builtin_bit_cast(i32x4, At[m][1]); \
            acc[ai][bj][m][n] = __builtin_amdgcn_mfma_scale_f32_16x16x128_f8f6f4(__builtin_shufflevector(_b0, _b1, 0, 1, 2, 3, 4, 5, 6, 7), __builtin_shufflevector(_a0, _a1, 0, 1, 2, 3, 4, 5, 6, 7), acc[ai][bj][m][n], 0, 0, 0, scB, 0, scA); } \
        else { _Pragma("unroll") for (int k = 0; k < 2; ++k) acc[ai][bj][m][n] = __builtin_amdgcn_mfma_f32_16x16x32_bf16(Bt[n][k], At[m][k], acc[ai][bj][m][n], 0, 0, 0); } } __builtin_amdgcn_s_setprio(0); } while (0)
#define PG8_WAIT_V(n) asm volatile("s_waitcnt vmcnt(" #n ")" ::: "memory")
#define PG8_WAIT_L(n) asm volatile("s_waitcnt lgkmcnt(" #n ")" ::: "memory")
#define PG8_BAR __builtin_amdgcn_s_barrier()
#define PG8_SCHED __builtin_amdgcn_sched_barrier(0)
#define PG8_GLOAD(U_) do { _Pragma("unroll") for (int _h = 0; _h < 2; ++_h) _Pragma("unroll") for (int _i = 0; _i < 2; ++_i) \
        gA[_h][_i] = ((unsigned)S.grow(U_, _h * 128 + gR[_i]) << (F8 ? 10 : 11)) + (unsigned)gC[_i]; } while (0)
    unsigned gN[2][2] = {{0u, 0u}, {0u, 0u}};
#define PG8_GLOADN(U_) do { _Pragma("unroll") for (int _h = 0; _h < 2; ++_h) _Pragma("unroll") for (int _i = 0; _i < 2; ++_i) gN[_h][_i] = (unsigned)S.grow(U_, _h * 128 + gR[_i]); } while (0)
#define PG8_GSWITCH() do { _Pragma("unroll") for (int _h = 0; _h < 2; ++_h) _Pragma("unroll") for (int _i = 0; _i < 2; ++_i) gA[_h][_i] = (gN[_h][_i] << (F8 ? 10 : 11)) + (unsigned)gC[_i]; } while (0)
    Unit cur, nxt; int ui = 0;
    if (!S.next(0, cur)) return;
    f32x4 acc[2][2][4][2];
#pragma unroll
    for (int a = 0; a < 2; ++a)
#pragma unroll
        for (int b = 0; b < 2; ++b)
#pragma unroll
            for (int m = 0; m < 4; ++m)
#pragma unroll
                for (int n = 0; n < 2; ++n) acc[a][b][m][n] = (f32x4){0.f, 0.f, 0.f, 0.f};
    bf16x8 At[4][2], B0[2][2], B1[2][2];
    const char* cA = S.a_base(cur); const char* cB = S.b_base(cur);
    if constexpr (GATHER) PG8_GLOAD(cur);
    PG8_STAGE(PG8_SB(0, 0), cB, voffB); PG8_STAGE_A(PG8_SA(0, 0), cA, 0); PG8_STAGE(PG8_SB(0, 1), cB + hstepB, voffB); PG8_STAGE_A(PG8_SA(0, 1), cA, 1);
    if (wr == 1) PG8_BAR;
    PG8_WAIT_V(4); PG8_BAR;
    PG8_STAGE(PG8_SB(1, 0), cB + kstep, voffB); PG8_STAGE_A(PG8_SA(1, 0), cA + kstep, 0); PG8_STAGE(PG8_SB(1, 1), cB + hstepB + kstep, voffB);
    PG8_WAIT_V(6); PG8_BAR;
    for (;;) {
        const bool has_next = S.next(ui + 1, nxt);
        const char* nA = has_next ? S.a_base(nxt) : cA; const char* nB = has_next ? S.b_base(nxt) : cB;
#pragma unroll 1
        for (int t = 0; t < nt; t += 2) {
            const bool last = (t == nt - 2);
            if constexpr (GATHER) { if (t == 0 && has_next) PG8_GLOADN(nxt); }
            const char* a1 = cA + (size_t)(t + 1) * kstep;
            const char* a2 = last ? nA : cA + (size_t)(t + 2) * kstep; const char* b2 = last ? nB : cB + (size_t)(t + 2) * kstep;
            const char* a3 = a2 + kstep; const char* b3 = b2 + kstep;
            PG8_LDB(B0, 0, 0); PG8_SCHED; PG8_LDA(At, 0, 0); PG8_STAGE_A(PG8_SA(1, 1), a1, 1);
            PG8_WAIT_L(8); PG8_BAR; PG8_WAIT_L(0); PG8_MMA(0, 0, At, B0); PG8_BAR; PG8_SCHED;
            if constexpr (GATHER) { if (last && has_next) PG8_GSWITCH(); }
            PG8_LDB(B1, 0, 1); PG8_STAGE(PG8_SB(0, 0), b2, voffB);
            PG8_BAR; PG8_WAIT_L(0); PG8_MMA(0, 1, At, B1); PG8_BAR;
            PG8_LDA(At, 0, 1); PG8_STAGE_A(PG8_SA(0, 0), a2, 0);
            PG8_BAR; PG8_WAIT_L(0); PG8_MMA(1, 0, At, B0); PG8_BAR; PG8_SCHED;
            PG8_STAGE(PG8_SB(0, 1), b2 + hstepB, voffB);
            PG8_WAIT_V(6); PG8_BAR; PG8_MMA(1, 1, At, B1); PG8_BAR;
            PG8_LDB(B0, 1, 0); PG8_SCHED; PG8_LDA(At, 1, 0); PG8_STAGE_A(PG8_SA(0, 1), a2, 1);
            PG8_WAIT_L(8); PG8_BAR; PG8_WAIT_L(0); PG8_MMA(0, 0, At, B0); PG8_BAR; PG8_SCHED;
            PG8_LDB(B1, 1, 1); PG8_STAGE(PG8_SB(1, 0), b3, voffB);
            PG8_BAR; PG8_WAIT_L(0); PG8_MMA(0, 1, At, B1); PG8_BAR;
            PG8_LDA(At, 1, 1); PG8_STAGE_A(PG8_SA(1, 0), a3, 0);
            PG8_BAR; PG8_WAIT_L(0); PG8_MMA(1, 0, At, B0); PG8_BAR; PG8_SCHED;
            PG8_STAGE(PG8_SB(1, 1), b3 + hstepB, voffB);
            PG8_WAIT_V(6); PG8_BAR; PG8_MMA(1, 1, At, B1); PG8_BAR;
        }
        { int fr_e = fr, fq_e = fq; asm volatile("" : "+v"(fr_e), "+v"(fq_e));
          E(acc, cur, wr, wc, fr_e, fq_e); }
        if (!has_next) break;
#pragma unroll
        for (int a = 0; a < 2; ++a)
#pragma unroll
            for (int b = 0; b < 2; ++b)
#pragma unroll
                for (int m = 0; m < 4; ++m)
#pragma unroll
                    for (int n = 0; n < 2; ++n) acc[a][b][m][n] = (f32x4){0.f, 0.f, 0.f, 0.f};
        cur = nxt; cA = nA; cB = nB; ++ui;
    }
    PG8_WAIT_V(0);
    if (wr == 0) PG8_BAR;
    PG8_BAR;
#undef PG8_SA
#undef PG8_SB
#undef PG8_STAGE
#undef PG8_STAGE_A
#undef PG8_LDA
#undef PG8_LDB
#undef PG8_MMA
#undef PG8_WAIT_V
#undef PG8_WAIT_L
#undef PG8_BAR
#undef PG8_SCHED
#undef PG8_GLOAD
#undef PG8_GLOADN
#undef PG8_GSWITCH
}

struct PlainOrder {
    const char* A; const char* Bt; int lda, ldb, nM, nN, nwg, G, c;
    __device__ void init(const bf16_t* A_, int lda_, const bf16_t* Bt_, int ldb_, int nM_, int nN_) { A = (const char*)A_; Bt = (const char*)Bt_; lda = lda_; ldb = ldb_; nM = nM_; nN = nN_; nwg = nM * nN; G = gridDim.x; c = blockIdx.x; }
    __device__ __forceinline__ bool next(int i, Unit& u) const {
        const long L = (long)i * G + c; if (L >= nwg) return false;
        int wgid = (int)L; { const int q = nwg / NXCD, r = nwg % NXCD, xcd = wgid % NXCD, off = wgid / NXCD; wgid = (xcd < r ? xcd * (q + 1) : r * (q + 1) + (xcd - r) * q) + off; }
        const int nig = WGM * nN, gid = wgid / nig, fm = gid * WGM, gsz = (nM - fm) < WGM ? (nM - fm) : WGM;
        u.pm = fm + ((wgid % nig) % gsz); u.pn = (wgid % nig) / gsz; u.e = 0; u.nvalid = 256; u.slot0 = 0; return true;
    }
    __device__ __forceinline__ const char* a_base(const Unit& u) const { return A + (size_t)u.pm * 256 * lda * 2; }
    __device__ __forceinline__ const char* b_base(const Unit& u) const { return Bt + (size_t)u.pn * 256 * ldb * 2; }
    __device__ __forceinline__ int grow(const Unit&, int) const { return 0; }
};
struct PlainOrderI : PlainOrder {
    __device__ __forceinline__ const char* a_base(const Unit&) const { return A; }
    __device__ __forceinline__ int grow(const Unit& u, int r) const { return u.pm * 256 + r; }
};
struct MoeOrder {
    const char* A; const char* W; const PG8_LAS int* tab; const PG8_LAS int* gl; int wrows, nunits;
    __device__ __forceinline__ bool next(int i, Unit& u) const {
        if (i >= nunits) return false;
        const PG8_LAS int* t = tab + i * 8;
        u.pm = t[0]; u.pn = t[1]; u.e = t[2]; u.nvalid = t[3]; u.slot0 = t[4]; u.lbase = t[6]; return true;
    }
    __device__ __forceinline__ const char* a_base(const Unit& u) const { return A + (size_t)u.slot0 * 1024; }
    __device__ __forceinline__ const char* b_base(const Unit& u) const { return W + ((size_t)u.e * wrows + (size_t)u.pn * 256) * 1024; }
    __device__ __forceinline__ int grow(const Unit& u, int r) const { return u.slot0 + r; }
};
constexpr int MOE_UNITS_MAX = 16;
__device__ __forceinline__ int moe_build_units(PG8_LAS int* tab, const int* cnt, const int* off, const int* toff, int nN) {
    const int G = gridDim.x, c = blockIdx.x, x = c & 7, j = c >> 3, per = (G >> 3) / nN, nMt = toff[32];
    const int i = threadIdx.x;
    if (i < MOE_UNITS_MAX) {
        const int pn = j % nN, mt = (i * 8 + x) * per + j / nN;
        int e = 0, valid = (mt < nMt && j < per * nN) ? 1 : 0;
        if (valid) { while (toff[e + 1] <= mt) ++e; }
        const int m = mt - toff[e];
        tab[i * 8 + 0] = mt; tab[i * 8 + 1] = pn; tab[i * 8 + 2] = e; tab[i * 8 + 3] = cnt[e] - m * 256; tab[i * 8 + 4] = off[e] + m * 256; tab[i * 8 + 5] = valid; tab[i * 8 + 6] = e * NTOK + m * 256;
    }
    __syncthreads();
    int n = 0;
    while (n < MOE_UNITS_MAX && tab[n * 8 + 5]) ++n;
    return n;
}
struct MoeOrderG : MoeOrder { const int* list;
    __device__ __forceinline__ const char* a_base(const Unit&) const { return A; }
    __device__ __forceinline__ int grow(const Unit& u, int r) const { const int rc = r < u.nvalid ? r : u.nvalid - 1; return list[u.lbase + rc]; } };
struct MoeOrderI : MoeOrder { __device__ __forceinline__ const char* a_base(const Unit&) const { return A; } };

__device__ __forceinline__ u32x4 pk8(const f32x4& a, const f32x4& b) { return (u32x4){cvtpk(a[0], a[1]), cvtpk(a[2], a[3]), cvtpk(b[0], b[1]), cvtpk(b[2], b[3])}; }
struct EpiStore {
    static constexpr bool PERM = true;
    bf16_t* C; int ldc; const float* rs;
    __device__ __forceinline__ void operator()(const f32x4 (&acc)[2][2][4][2], const Unit& u, int wr, int wc, int fr, int fq) const {
        bf16_t* base = C + ((size_t)u.pm * 256 + wr * 64 + fr) * ldc + u.pn * 256 + wc * 32 + 8 * fq;
#pragma unroll
        for (int ai = 0; ai < 2; ++ai)
#pragma unroll
            for (int m = 0; m < 4; ++m) { bf16_t* rowp = base + (size_t)(ai * HALF + m * 16) * ldc; const float s = rs ? rs[ai * HALF + wr * 64 + m * 16 + fr] : 1.f;
#pragma unroll
                for (int bj = 0; bj < 2; ++bj) *(u32x4*)(rowp + bj * HALF) = pk8(acc[ai][bj][m][0] * s, acc[ai][bj][m][1] * s); }
    }
};
constexpr float ACT8_SCALE = 4.f;
struct EpiAct {
    static constexpr bool PERM = true;
    unsigned char* Act; const float* b1all; unsigned char* dummy;
    __device__ __forceinline__ void operator()(const f32x4 (&acc)[2][2][4][2], const Unit& u, int wr, int wc, int fr, int fq) const {
        const int f0 = u.pn * 128 + wc * 32 + 8 * fq;
        const float* bb = b1all + (size_t)u.e * 2048 + 2 * f0;
        f32x4 bv[4];
#pragma unroll
        for (int q = 0; q < 4; ++q) bv[q] = *(const f32x4*)(bb + 4 * q);
        unsigned char* base = Act + ((size_t)u.slot0 + wr * 64 + fr) * 1024 + f0;
#pragma unroll
        for (int ai = 0; ai < 2; ++ai)
#pragma unroll
            for (int m = 0; m < 4; ++m) {
                const int r = ai * HALF + wr * 64 + m * 16 + fr;
                float a[8];
#pragma unroll
                for (int n = 0; n < 2; ++n)
#pragma unroll
                    for (int j = 0; j < 4; ++j) { const int f = 4 * n + j;
                        float glu = acc[ai][0][m][n][j] + bv[f >> 1][(f & 1) * 2], lin = acc[ai][1][m][n][j] + bv[f >> 1][(f & 1) * 2 + 1];
                        glu = fminf(glu, 7.f); lin = fminf(fmaxf(lin, -7.f), 7.f);
                        a[f] = glu * __builtin_amdgcn_rcpf(1.f + __builtin_amdgcn_exp2f(-1.702f * LOG2E * glu)) * (lin * ACT8_SCALE + ACT8_SCALE); }
                unsigned char* dst = (r < u.nvalid) ? base + (size_t)(ai * HALF + m * 16) * 1024 : dummy + (size_t)r * 1024 + f0;
                *(u32x2*)dst = (u32x2){pk4_fp8_nc(a[0], a[1], a[2], a[3]), pk4_fp8_nc(a[4], a[5], a[6], a[7])};
            }
    }
};
constexpr float YB8_SCALE = 16.f;
struct EpiBias {
    static constexpr bool PERM = true;
    unsigned char* Y; const float* b2all; unsigned char* dummy;
    __device__ __forceinline__ void operator()(const f32x4 (&acc)[2][2][4][2], const Unit& u, int wr, int wc, int fr, int fq) const {
        const int c0 = u.pn * 256 + wc * 32 + 8 * fq;
        const float* bb = b2all + (size_t)u.e * 1024 + c0;
        f32x4 bv[2][2];
#pragma unroll
        for (int bj = 0; bj < 2; ++bj)
#pragma unroll
            for (int n = 0; n < 2; ++n) bv[bj][n] = *(const f32x4*)(bb + bj * HALF + 4 * n);
        unsigned char* base = Y + ((size_t)u.slot0 + wr * 64 + fr) * 1024 + c0;
#pragma unroll
        for (int ai = 0; ai < 2; ++ai)
#pragma unroll
            for (int m = 0; m < 4; ++m) { const int r = ai * HALF + wr * 64 + m * 16 + fr;
                unsigned char* dst = (r < u.nvalid) ? base + (size_t)(ai * HALF + m * 16) * 1024 : dummy + (size_t)r * 1024 + c0;
#pragma unroll
                for (int bj = 0; bj < 2; ++bj) { const f32x4 y0 = (acc[ai][bj][m][0] + bv[bj][0]) * YB8_SCALE, y1 = (acc[ai][bj][m][1] + bv[bj][1]) * YB8_SCALE;
                    *(u32x2*)(dst + bj * HALF) = (u32x2){pk4_fp8(y0[0], y0[1], y0[2], y0[3]), pk4_fp8(y1[0], y1[1], y1[2], y1[3])}; } }
    }
};
}

__device__ __forceinline__ u32x4 pack8(const float (&v)[8]) { return (u32x4){cvtpk(v[0], v[1]), cvtpk(v[2], v[3]), cvtpk(v[4], v[5]), cvtpk(v[6], v[7])}; }
struct EpiPlain {
    static constexpr bool MOE1 = false;
    bf16_t* C; int ldc;
    __device__ __forceinline__ void row8(int r, int c, const float (&v)[8]) const { *(u32x4*)(C + (size_t)r * ldc + c) = pack8(v); }
    __device__ __forceinline__ void pair(int, int, const float (&)[8], const float (&)[8]) const {}
};
struct EpiRowScale {
    static constexpr bool MOE1 = false;
    bf16_t* C; int ldc; const float* rs;
    __device__ __forceinline__ void row8(int r, int c, const float (&v)[8]) const { const float s = rs[r]; float w[8];
#pragma unroll
        for (int i = 0; i < 8; ++i) w[i] = v[i] * s;
        *(u32x4*)(C + (size_t)r * ldc + c) = pack8(w); }
    __device__ __forceinline__ void pair(int, int, const float (&)[8], const float (&)[8]) const {}
};
__device__ __forceinline__ void phase_gemm_plain(const bf16_t* A, int lda, const bf16_t* Bt, int K, bf16_t* C, int ldc, int nM, int nN) {
    const int G = gridDim.x;
    for (int u = blockIdx.x; u < nM * nN; u += G) {
        const int pm = u / nN, pn = u % nN;
        int aoff[2][2], boff[2];
        gm::make_off(aoff, pm * 256, lda); gm::make_off1(boff, pn * 128, K);
        EpiPlain epi{C + (size_t)pm * 256 * ldc + pn * 128, ldc};
        gm::gemm_tile(A, aoff, Bt, boff, K / 64, epi);
    }
}

struct Row16 { float4 v[4]; };
__device__ __forceinline__ Row16 ld_row_f32(const float* p, int lane) { Row16 r;
#pragma unroll
    for (int i = 0; i < 4; ++i) r.v[i] = *(const float4*)(p + lane * 4 + 256 * i);
    return r; }
__device__ __forceinline__ Row16 ld_row_bf16(const bf16_t* p, int lane) { Row16 r;
#pragma unroll
    for (int i = 0; i < 4; ++i) { const u32x2 w = *(const u32x2*)(p + lane * 4 + 256 * i);
        r.v[i] = make_float4(__uint_as_float(w.x << 16), __uint_as_float(w.x & 0xFFFF0000u), __uint_as_float(w.y << 16), __uint_as_float(w.y & 0xFFFF0000u)); }
    return r; }
__device__ __forceinline__ void st_row_f32(float* p, int lane, const Row16& r) {
#pragma unroll
    for (int i = 0; i < 4; ++i) *(float4*)(p + lane * 4 + 256 * i) = r.v[i]; }
__device__ __forceinline__ void st_row_bf16(bf16_t* p, int lane, const Row16& r) {
#pragma unroll
    for (int i = 0; i < 4; ++i) { u32x2 w; w.x = cvtpk(r.v[i].x, r.v[i].y); w.y = cvtpk(r.v[i].z, r.v[i].w); *(u32x2*)(p + lane * 4 + 256 * i) = w; } }
__device__ __forceinline__ void st_row_fp8(unsigned char* p, int lane, const Row16& r) {
#pragma unroll
    for (int i = 0; i < 4; ++i) *(unsigned*)(p + lane * 4 + 256 * i) = pk4_fp8(r.v[i].x, r.v[i].y, r.v[i].z, r.v[i].w); }
__device__ __forceinline__ float row_rstd(const Row16& r) {
    float s = 0.f;
#pragma unroll
    for (int i = 0; i < 4; ++i) s += r.v[i].x * r.v[i].x + r.v[i].y * r.v[i].y + r.v[i].z * r.v[i].z + r.v[i].w * r.v[i].w;
    s = wave_sum(s);
    return rsqrtf(s * (1.f / 1024.f) + EPSN);
}
__device__ __forceinline__ Row16 norm_mod(const Row16& x, float rstd, const float* g, const float* sc, const float* sh, int lane) {
    Row16 h;
#pragma unroll
    for (int i = 0; i < 4; ++i) {
        const int c = lane * 4 + 256 * i;
        const float4 gv = *(const float4*)(g + c), scv = *(const float4*)(sc + c), shv = *(const float4*)(sh + c);
        h.v[i].x = x.v[i].x * rstd * gv.x * (1.f + scv.x) + shv.x; h.v[i].y = x.v[i].y * rstd * gv.y * (1.f + scv.y) + shv.y;
        h.v[i].z = x.v[i].z * rstd * gv.z * (1.f + scv.z) + shv.z; h.v[i].w = x.v[i].w * rstd * gv.w * (1.f + scv.w) + shv.w;
    }
    return h;
}
__device__ __forceinline__ Row16 resid_add(const Row16& x, const Row16& y, float rstd, const float* g, const float* gate, int lane) {
    Row16 o;
#pragma unroll
    for (int i = 0; i < 4; ++i) {
        const int c = lane * 4 + 256 * i;
        const float4 gv = *(const float4*)(g + c), ga = *(const float4*)(gate + c);
        o.v[i].x = x.v[i].x + y.v[i].x * rstd * gv.x * ga.x; o.v[i].y = x.v[i].y + y.v[i].y * rstd * gv.y * ga.y;
        o.v[i].z = x.v[i].z + y.v[i].z * rstd * gv.z * ga.z; o.v[i].w = x.v[i].w + y.v[i].w * rstd * gv.w * ga.w;
    }
    return o;
}
__device__ __forceinline__ const float* mod_ptr(PRef p, int l, int r) { return (const float*)(p.ws + WS_MOD) + (size_t)(l * 2 + (r < CTXN ? 1 : 0)) * 6144; }
__device__ __forceinline__ const float* src_row(PRef p, int r) { return r < CTXN ? p.ctx + (size_t)r * 1024 : p.x + (size_t)(r - CTXN) * 1024; }

struct ModAB { float4 a[4], b[4]; };
struct ModG { float4 g[4]; };
__device__ __forceinline__ ModAB load_ab(const float* g, const float* sc, const float* sh, int lane) { ModAB m;
#pragma unroll
    for (int i = 0; i < 4; ++i) { const int c = lane * 4 + 256 * i; const float4 gv = *(const float4*)(g + c), sv = *(const float4*)(sc + c); m.b[i] = *(const float4*)(sh + c);
        m.a[i] = make_float4(gv.x * (1.f + sv.x), gv.y * (1.f + sv.y), gv.z * (1.f + sv.z), gv.w * (1.f + sv.w)); }
    return m; }
__device__ __forceinline__ ModG load_g(const float* g, const float* gate, int lane) { ModG m;
#pragma unroll
    for (int i = 0; i < 4; ++i) { const int c = lane * 4 + 256 * i; const float4 gv = *(const float4*)(g + c), ga = *(const float4*)(gate + c); m.g[i] = make_float4(gv.x * ga.x, gv.y * ga.y, gv.z * ga.z, gv.w * ga.w); }
    return m; }
__device__ __forceinline__ Row16 apply_ab(const Row16& x, float rstd, const ModAB& m) { Row16 h;
#pragma unroll
    for (int i = 0; i < 4; ++i) h.v[i] = make_float4(x.v[i].x * rstd * m.a[i].x + m.b[i].x, x.v[i].y * rstd * m.a[i].y + m.b[i].y, x.v[i].z * rstd * m.a[i].z + m.b[i].z, x.v[i].w * rstd * m.a[i].w + m.b[i].w);
    return h; }
__device__ __forceinline__ Row16 apply_g(const Row16& x, const Row16& y, float rstd, const ModG& m) { Row16 o;
#pragma unroll
    for (int i = 0; i < 4; ++i) o.v[i] = make_float4(x.v[i].x + y.v[i].x * rstd * m.g[i].x, x.v[i].y + y.v[i].y * rstd * m.g[i].y, x.v[i].z + y.v[i].z * rstd * m.g[i].z, x.v[i].w + y.v[i].w * rstd * m.g[i].w);
    return o; }
struct RowB8 { u32x2 v[4]; };
struct RowF8 { unsigned v[4]; };
__device__ __forceinline__ RowF8 ld_rowf8(const unsigned char* p, int lane) { RowF8 r;
#pragma unroll
    for (int i = 0; i < 4; ++i) r.v[i] = *(const unsigned*)(p + lane * 4 + 256 * i);
    return r; }
__device__ __forceinline__ Row16 cvt_rowf8(const RowF8& b) { Row16 r;
#pragma unroll
    for (int i = 0; i < 4; ++i) r.v[i] = make_float4(__builtin_amdgcn_cvt_f32_fp8((int)b.v[i], 0), __builtin_amdgcn_cvt_f32_fp8((int)b.v[i], 1), __builtin_amdgcn_cvt_f32_fp8((int)b.v[i], 2), __builtin_amdgcn_cvt_f32_fp8((int)b.v[i], 3));
    return r; }
__device__ __forceinline__ RowB8 ld_rowb(const bf16_t* p, int lane) { RowB8 r;
#pragma unroll
    for (int i = 0; i < 4; ++i) r.v[i] = *(const u32x2*)(p + lane * 4 + 256 * i);
    return r; }
__device__ __forceinline__ Row16 cvt_rowb(const RowB8& b) { Row16 r;
#pragma unroll
    for (int i = 0; i < 4; ++i) r.v[i] = make_float4(__uint_as_float(b.v[i].x << 16), __uint_as_float(b.v[i].x & 0xFFFF0000u), __uint_as_float(b.v[i].y << 16), __uint_as_float(b.v[i].y & 0xFFFF0000u));
    return r; }

__device__ __forceinline__ void phase_norm1_l0(PRef p) {
    const int lane = threadIdx.x & 63, wave = threadIdx.x >> 6, G = gridDim.x, step = G * 8;
    bf16_t* HB = (bf16_t*)(p.ws + WS_HB);
    int r = blockIdx.x * 8 + wave;
    if (r >= NTOK) return;
    int cur_s = (r < CTXN) ? 1 : 0;
    const float* mod = mod_ptr(p, 0, r);
    ModAB m = load_ab(p.norm_g, mod + 1024, mod, lane);
    Row16 x = ld_row_f32(src_row(p, r), lane);
    for (; r < NTOK; r += step) {
        const int rn = r + step;
        Row16 xn = x;
        if (rn < NTOK) xn = ld_row_f32(src_row(p, rn), lane);
        const int s_ = (r < CTXN) ? 1 : 0;
        if (s_ != cur_s) { cur_s = s_; const float* md = mod_ptr(p, 0, r); m = load_ab(p.norm_g, md + 1024, md, lane); }
        const float rstd = row_rstd(x);
        st_row_bf16(HB + (size_t)r * 1024, lane, apply_ab(x, rstd, m));
        x = xn;
    }
}

__device__ __forceinline__ void phase_mid(PRef p, int l) {
    const int tid = tid_opaque(), lane = tid & 63, wave = tid >> 6, G = gridDim.x;
    float* wT = (float*)smem;
    int* lcnt = (int*)(smem + 139264);
    int* lbase = lcnt + 32;
    int* sel = lbase + 32;
    {
        const float4* src = (const float4*)((const float*)(p.ws + WS_RWT) + (size_t)l * 32 * 1024);
        for (int i = tid; i < 32 * 1024 / 4; i += NTH) ((float4*)wT)[i] = src[i];
        if (tid < 32) lcnt[tid] = 0;
    }
    __syncthreads();
    const int r_begin = (l == 0) ? 0 : CTXN;
    bf16_t* HB = (bf16_t*)(p.ws + WS_HB); const bf16_t* OB = (const bf16_t*)(p.ws + WS_OB);
    bf16_t* X1 = (bf16_t*)(p.ws + WS_X1); const bf16_t* X2 = (const bf16_t*)(p.ws + WS_X2);
    const float* ng = p.norm_g + (size_t)l * 4 * 1024;
    const float* rb = p.router_b + l * 32;
    float* GATE = (float*)(p.ws + WS_GATE);
    int it = 0;
    int r = r_begin + blockIdx.x * 8 + wave;
    const int step = G * 8;
    int cur_s = -1; ModG mg; ModAB mab;
    Row16 xin; RowB8 ob;
    if (r < NTOK) { xin = (l == 0) ? ld_row_f32(src_row(p, r), lane) : ld_row_bf16(X2 + (size_t)r * 1024, lane); ob = ld_rowb(OB + (size_t)r * 1024, lane); }
    for (; r < NTOK; r += step, ++it) {
        const int rn = r + step;
        Row16 xin_n = xin; RowB8 ob_n = ob;
        if (rn < NTOK) { xin_n = (l == 0) ? ld_row_f32(src_row(p, rn), lane) : ld_row_bf16(X2 + (size_t)rn * 1024, lane); ob_n = ld_rowb(OB + (size_t)rn * 1024, lane); }
        const int s_ = (r < CTXN) ? 1 : 0;
        if (s_ != cur_s) { cur_s = s_; const float* mod = mod_ptr(p, l, r); mg = load_g(ng + 1024, mod + 2048, lane); mab = load_ab(ng + 2048, mod + 4096, mod + 3072, lane); }
        const Row16 o = cvt_rowb(ob);
        const float rso = row_rstd(o);
        const Row16 x1 = apply_g(xin, o, rso, mg);
        st_row_bf16(X1 + (size_t)r * 1024, lane, x1);
        const float rs1 = row_rstd(x1);
        const Row16 h = apply_ab(x1, rs1, mab);
        xin = xin_n; ob = ob_n;
        float part[32];
        {
            const float* wl = wT + lane * 4;
            float4 wa[4], wb[4];
#pragma unroll
            for (int i = 0; i < 4; ++i) wa[i] = *(const float4*)(wl + 256 * i);
#pragma unroll
            for (int e = 0; e < 32; e += 2) {
#pragma unroll
                for (int i = 0; i < 4; ++i) wb[i] = *(const float4*)(wl + (e + 1) * 1024 + 256 * i);
                { float a = 0.f;
#pragma unroll
                  for (int i = 0; i < 4; ++i) a += h.v[i].x * wa[i].x + h.v[i].y * wa[i].y + h.v[i].z * wa[i].z + h.v[i].w * wa[i].w;
                  part[e] = a; }
                if (e + 2 < 32) {
#pragma unroll
                    for (int i = 0; i < 4; ++i) wa[i] = *(const float4*)(wl + (e + 2) * 1024 + 256 * i);
                }
                { float a = 0.f;
#pragma unroll
                  for (int i = 0; i < 4; ++i) a += h.v[i].x * wb[i].x + h.v[i].y * wb[i].y + h.v[i].z * wb[i].z + h.v[i].w * wb[i].w;
                  part[e + 1] = a; }
            }
        }
        st_row_fp8((unsigned char*)HB + (size_t)r * 1024, lane, h);
#define TR_STEP(NV, BIT) _Pragma("unroll") for (int i = 0; i < (NV) / 2; ++i) { const float lo = part[i], hi_ = part[i + (NV) / 2]; const bool up = (lane & (BIT)) != 0; \
            const float send = up ? lo : hi_, keep = up ? hi_ : lo; part[i] = keep + __shfl_xor(send, (BIT)); }
        TR_STEP(32, 32) TR_STEP(16, 16) TR_STEP(8, 8) TR_STEP(4, 4) TR_STEP(2, 2)
#undef TR_STEP
        float logit = part[0] + __shfl_xor(part[0], 1);
        const int myexp = lane >> 1;
        logit += rb[myexp];
        float val = (lane & 1) ? -3.0e38f : logit;
        float tv[4]; int ti[4];
#pragma unroll
        for (int k = 0; k < 4; ++k) {
            float bv = val; int bi = myexp;
#pragma unroll
            for (int off = 32; off >= 1; off >>= 1) { const float ov = __shfl_xor(bv, off); const int oi = __shfl_xor(bi, off); const bool take = (ov > bv) | ((ov == bv) & (oi < bi)); bv = take ? ov : bv; bi = take ? oi : bi; }
            tv[k] = bv; ti[k] = bi;
            if (myexp == bi) val = -3.0e38f;
        }
        const float e1 = __expf(tv[1] - tv[0]), e2 = __expf(tv[2] - tv[0]), e3 = __expf(tv[3] - tv[0]);
        const float inv = 1.f / (1.f + e1 + e2 + e3);
        if (lane < 4) {
            const int k = lane;
            const int e = (k == 0) ? ti[0] : (k == 1) ? ti[1] : (k == 2) ? ti[2] : ti[3];
            const float gk = ((k == 0) ? 1.f : (k == 1) ? e1 : (k == 2) ? e2 : e3) * inv;
            GATE[(size_t)r * 4 + k] = gk;
            const int lp = atomicAdd(&lcnt[e], 1);
            sel[(it * 8 + wave) * 4 + k] = e | (lp << 8);
        }
    }
    __syncthreads();
    int* CNT = (int*)(p.ws + WS_CNT) + l * 32;
    if (tid < 32) lbase[tid] = atomicAdd(&CNT[tid], lcnt[tid]);
    __syncthreads();
    {
        int* TOPE = (int*)(p.ws + WS_TOPE); int* TOPP = (int*)(p.ws + WS_TOPP); int* LIST = (int*)(p.ws + WS_LIST);
        for (int q = tid; q < 80 * 4; q += NTH) {
            const int slot = q >> 2, k = q & 3, itq = slot >> 3, wv = slot & 7;
            const int r = r_begin + blockIdx.x * 8 + wv + itq * G * 8;
            if (r < NTOK) {
                const int s = sel[q], e = s & 255, lp = s >> 8, pos = lbase[e] + lp;
                TOPE[(size_t)r * 4 + k] = e; TOPP[(size_t)r * 4 + k] = pos; LIST[(size_t)e * NTOK + pos] = r;
            }
        }
    }
    __syncthreads();
}

struct MoeLds { int* cnt; int* off; int* toff; };
__device__ __forceinline__ MoeLds moe_setup(PRef p, int l, char* base) {
    MoeLds m; m.cnt = (int*)base; m.off = m.cnt + 32; m.toff = m.off + 33;
    const int tid = tid_opaque();
    if (tid < 64) {
        const int e = tid & 31;
        const int cval = ((const int*)(p.ws + WS_CNT))[l * 32 + e];
        const int tiles = (cval + 255) >> 8;
        int pc = cval, pt = tiles;
#pragma unroll
        for (int o = 1; o < 32; o <<= 1) { const int a = __shfl_up(pc, o, 32), b = __shfl_up(pt, o, 32); if (e >= o) { pc += a; pt += b; } }
        if (tid < 32) { m.cnt[e] = cval; m.off[e + 1] = pc; m.toff[e + 1] = pt; if (e == 0) { m.off[0] = 0; m.toff[0] = 0; } }
    }
    __syncthreads();
    return m;
}

__device__ __forceinline__ void phase_end(PRef p, int l) {
    const int tid = tid_opaque(), lane = tid & 63, wave = tid >> 6, G = gridDim.x;
    MoeLds ml = moe_setup(p, l, smem);
    const int r_begin = (l == 0) ? 0 : CTXN;
    const unsigned char* YB = (const unsigned char*)(p.ws + WS_YB);
    const bf16_t* X1 = (const bf16_t*)(p.ws + WS_X1); bf16_t* X2 = (bf16_t*)(p.ws + WS_X2);
    bf16_t* HB = (bf16_t*)(p.ws + WS_HB);
    const int* TOPE = (const int*)(p.ws + WS_TOPE); const int* TOPP = (const int*)(p.ws + WS_TOPP); const float* GATE = (const float*)(p.ws + WS_GATE);
    const float* ng = p.norm_g + (size_t)l * 4 * 1024;
    int cur_s = -1; ModG mg; ModAB mab;
    int r = r_begin + blockIdx.x * 8 + wave;
    int4 en = make_int4(0, 0, 0, 0), pn = make_int4(0, 0, 0, 0); float4 gn = make_float4(0.f, 0.f, 0.f, 0.f);
    const int step = G * 8;
    if (r < NTOK) { en = *(const int4*)(TOPE + (size_t)r * 4); pn = *(const int4*)(TOPP + (size_t)r * 4); gn = *(const float4*)(GATE + (size_t)r * 4); }
    RowF8 t4n[4]; Row16 x1n; float4 gcur = gn;
    if (r < NTOK) {
        t4n[0] = ld_rowf8(YB + (size_t)(ml.off[en.x] + pn.x) * 1024, lane); t4n[1] = ld_rowf8(YB + (size_t)(ml.off[en.y] + pn.y) * 1024, lane);
        t4n[2] = ld_rowf8(YB + (size_t)(ml.off[en.z] + pn.z) * 1024, lane); t4n[3] = ld_rowf8(YB + (size_t)(ml.off[en.w] + pn.w) * 1024, lane);
        x1n = ld_row_bf16(X1 + (size_t)r * 1024, lane);
        if (r + step < NTOK) { en = *(const int4*)(TOPE + (size_t)(r + step) * 4); pn = *(const int4*)(TOPP + (size_t)(r + step) * 4); gn = *(const float4*)(GATE + (size_t)(r + step) * 4); }
    }
    for (; r < NTOK; r += step) {
        RowF8 t4[4]; t4[0] = t4n[0]; t4[1] = t4n[1]; t4[2] = t4n[2]; t4[3] = t4n[3];
        const Row16 x1 = x1n;
        const float g4[4] = {gcur.x, gcur.y, gcur.z, gcur.w};
        const int rn = r + step;
        if (rn < NTOK) {
            t4n[0] = ld_rowf8(YB + (size_t)(ml.off[en.x] + pn.x) * 1024, lane); t4n[1] = ld_rowf8(YB + (size_t)(ml.off[en.y] + pn.y) * 1024, lane);
            t4n[2] = ld_rowf8(YB + (size_t)(ml.off[en.z] + pn.z) * 1024, lane); t4n[3] = ld_rowf8(YB + (size_t)(ml.off[en.w] + pn.w) * 1024, lane);
            x1n = ld_row_bf16(X1 + (size_t)rn * 1024, lane);
            gcur = gn;
            if (rn + step < NTOK) { en = *(const int4*)(TOPE + (size_t)(rn + step) * 4); pn = *(const int4*)(TOPP + (size_t)(rn + step) * 4); gn = *(const float4*)(GATE + (size_t)(rn + step) * 4); }
        }
        const int s_ = (r < CTXN) ? 1 : 0;
        if (s_ != cur_s) { cur_s = s_; const float* mod = mod_ptr(p, l, r); mg = load_g(ng + 3072, mod + 5120, lane);
            if (l == 0) { const float* mod1 = mod_ptr(p, 1, r); mab = load_ab(p.norm_g + (size_t)4 * 1024, mod1 + 1024, mod1, lane); } }
        Row16 y;
#pragma unroll
        for (int i = 0; i < 4; ++i) y.v[i] = make_float4(0.f, 0.f, 0.f, 0.f);
#pragma unroll
        for (int k = 0; k < 4; ++k) { const Row16 t = cvt_rowf8(t4[k]); const float gk = g4[k] * (1.f / pg8::YB8_SCALE);
#pragma unroll
            for (int i = 0; i < 4; ++i) { y.v[i].x += gk * t.v[i].x; y.v[i].y += gk * t.v[i].y; y.v[i].z += gk * t.v[i].z; y.v[i].w += gk * t.v[i].w; } }
        const float rsy = row_rstd(y);
        const Row16 x2 = apply_g(x1, y, rsy, mg);
        if (l == 0) {
            st_row_bf16(X2 + (size_t)r * 1024, lane, x2);
            const float rs2 = row_rstd(x2);
            st_row_fp8((unsigned char*)HB + (size_t)r * 1024, lane, apply_ab(x2, rs2, mab));
        } else {
            st_row_f32(p.out + (size_t)(r - CTXN) * 1024, lane, x2);
        }
    }
    __syncthreads();
}

__device__ __forceinline__ void phase_gemm_pg8(const bf16_t* A, int lda, const bf16_t* Bt, int K, bf16_t* C, int ldc, int nM, int nN) {
    pg8::PlainOrder S; S.init(A, lda, Bt, K, nM, nN);
    pg8::EpiStore E{C, ldc, nullptr};
    pg8::gemm_phase<pg8::EpiStore, pg8::PlainOrder, false>((PG8_LAS unsigned char*)smem, S, E, K, lda, K);
    __syncthreads();
}
constexpr float NA_O8_SCALE = 8.f;
__device__ __forceinline__ void phase_gemm_pg8_f8(const unsigned char* A8, const unsigned char* W8, bf16_t* C, int ldc, int nM, int nN, int scA = 0x7F7F7F7F) {
    pg8::PlainOrderI S; S.init((const bf16_t*)A8, 512, (const bf16_t*)W8, 512, nM, nN);
    pg8::EpiStore E{C, ldc, nullptr};
    pg8::gemm_phase<pg8::EpiStore, pg8::PlainOrderI, true, true>((PG8_LAS unsigned char*)smem, S, E, 512, 512, 512, scA, 0x79797979);
    __syncthreads();
}
constexpr int MOE_GL_OFF = 131072, MOE_ML_OFF = 143360, MOE_TAB_OFF = 143872, MOE_GL_MAX = 12;
__device__ __forceinline__ void phase_moe1(PRef p, int l) {
    MoeLds ml = moe_setup(p, l, smem + MOE_ML_OFF);
    const int tid = tid_opaque();
    PG8_LAS int* gl = (PG8_LAS int*)(smem + MOE_GL_OFF);
    PG8_LAS int* tab = (PG8_LAS int*)(smem + MOE_TAB_OFF);
    pg8::MoeOrderG S;
    S.A = (const char*)(p.ws + WS_HB); S.W = (const char*)(p.ws + WS_W1T) + (size_t)l * 32 * 2048 * 1024;
    S.tab = tab; S.gl = gl; S.wrows = 2048; S.list = (const int*)(p.ws + WS_LIST);
    S.nunits = pg8::moe_build_units(tab, ml.cnt, ml.off, ml.toff, 8);
    pg8::EpiAct E{(unsigned char*)(p.ws + WS_ACT), p.moe_b1 + (size_t)l * 32 * 2048, (unsigned char*)(p.ws + WS_DUMMY)};
    pg8::gemm_phase<pg8::EpiAct, pg8::MoeOrderG, true, true>((PG8_LAS unsigned char*)smem, S, E, 512, 512, 512, 0x7F7F7F7F, 0x79797979);
    __syncthreads();
}
__device__ __forceinline__ void phase_moe2(PRef p, int l) {
    MoeLds ml = moe_setup(p, l, smem + MOE_ML_OFF);
    PG8_LAS int* tab = (PG8_LAS int*)(smem + MOE_TAB_OFF);
    pg8::MoeOrderI S;
    S.A = (const char*)(p.ws + WS_ACT); S.W = (const char*)(p.ws + WS_W2T) + (size_t)l * 32 * 1024 * 1024;
    S.tab = tab; S.gl = nullptr; S.wrows = 1024;
    S.nunits = pg8::moe_build_units(tab, ml.cnt, ml.off, ml.toff, 4);
    pg8::EpiBias E{(unsigned char*)(p.ws + WS_YB), p.moe_b2 + (size_t)l * 32 * 1024, (unsigned char*)(p.ws + WS_DUMMY)};
    pg8::gemm_phase<pg8::EpiBias, pg8::MoeOrderI, true, true>((PG8_LAS unsigned char*)smem, S, E, 512, 512, 512, 0x7D7D7D7D, 0x79797979);
    __syncthreads();
}

__device__ __forceinline__ void gla_local_units(PRef p);
__device__ __forceinline__ void rope8(const float* rope, int t, int j0, const u32x4& a, const u32x4& b, u32x4& oa, u32x4& ob);
__device__ __forceinline__ void rowstat(const bf16_t* A, int lda, int K, float* rs) {
    const int tid = tid_opaque(), r = tid >> 1, hf = tid & 1, half = K / 2;
    const bf16_t* q = A + (size_t)r * lda + hf * half;
    float s = 0.f;
    for (int i = 0; i < half; i += 8) { const u32x4 w = *(const u32x4*)(q + i);
#pragma unroll
        for (int j = 0; j < 4; ++j) { const float a = __uint_as_float(w[j] << 16), b = __uint_as_float(w[j] & 0xFFFF0000u); s += a * a + b * b; } }
    s += __shfl_xor(s, 1);
    if (hf == 0) rs[r] = rsqrtf(s / (float)K + EPSN);
    __syncthreads();
}
__device__ __forceinline__ void phase_mla_up(PRef p) {
    const int G = gridDim.x, tid = threadIdx.x;
    const bf16_t* P = (const bf16_t*)(p.ws + WS_P);
    float* rs = (float*)(smem + 139264);
    const int nM = NTOK / 256;
    {
        pg8::PlainOrder S; S.init(P + PC_CQ, PW, (const bf16_t*)(p.ws + WS_WUQ), 256, nM, 3);
        pg8::Unit u;
        if (S.next(0, u)) rowstat(P + (size_t)u.pm * 256 * PW + PC_CQ, PW, 256, rs);
        pg8::EpiStore E{(bf16_t*)(p.ws + WS_QM), 768, rs};
        pg8::gemm_phase<pg8::EpiStore, pg8::PlainOrder, false>((PG8_LAS unsigned char*)smem, S, E, 256, PW, 256);
        __syncthreads();
    }
    for (int v = (blockIdx.x + G - 195) % G; v < nM * 8; v += G) {
        int aoff[2][2], boff[2];
        const int pm = v >> 3, pn = v & 7, h = pn >> 1;
        rowstat(P + (size_t)pm * 256 * PW + PC_CKV, PW, 128, rs);
        gm::make_off(aoff, pm * 256, PW); gm::make_off1(boff, pn * 128, 128);
        bf16_t* dst = (pn & 1) ? (bf16_t*)(p.ws + WS_VM) + (size_t)pm * 256 * 512 + h * 128 : (bf16_t*)(p.ws + WS_KM) + (size_t)pm * 256 * 768 + h * 192;
        EpiRowScale epi{dst, (pn & 1) ? 512 : 768, rs};
        gm::gemm_tile(P + PC_CKV, aoff, (const bf16_t*)(p.ws + WS_WUKV), boff, 2, epi);
    }
    const float* rope = (const float*)(p.ws + WS_ROPE);
    bf16_t* KM = (bf16_t*)(p.ws + WS_KM);
    for (int i = blockIdx.x * NTH + tid; i < NTOK * 4; i += G * NTH) {
        const int r = i >> 2, j0 = (i & 3) * 8;
        const u32x4 a = *(const u32x4*)(P + (size_t)r * PW + PC_KR + j0), b = *(const u32x4*)(P + (size_t)r * PW + PC_KR + 32 + j0);
        u32x4 oa = a, ob = b;
        if (r >= CTXN) rope8(rope, r - CTXN, j0, a, b, oa, ob);
#pragma unroll
        for (int h = 0; h < 4; ++h) { *(u32x4*)(KM + (size_t)r * 768 + h * 192 + 128 + j0) = oa; *(u32x4*)(KM + (size_t)r * 768 + h * 192 + 160 + j0) = ob; }
    }
    __syncthreads();
    gla_local_units(p);
}

struct GlaB { float b[16]; float total; };
__device__ __forceinline__ GlaB gla_decay(PRef p, int gc, int h, float* scr  ) {
    const int tid = threadIdx.x, lane = tid & 63, wave = tid >> 6, dir = wave & 1, tq = wave >> 1;
    const bf16_t* P = (const bf16_t*)(p.ws + WS_P);
    float* af = scr;
    float* wa = scr + 2048;
    float* ba = scr + 4096;
    float* tot = scr + 4224;
#pragma unroll
    for (int i = 0; i < 4; ++i) {
        const int idx = tid + 512 * i, dd = idx >> 10, t = (idx >> 4) & 63, j = idx & 15;
        af[idx] = bf2f(P[(size_t)(gc * 64 + t) * PW + PC_AF + dd * 16 + j]);
        const int jj = (idx >> 6) & 15, d = idx & 63;
        wa[idx] = (dd == 0 ? p.gla_wa_f : p.gla_wa_b)[jj * 256 + h * 64 + d];
    }
    if (tid < 128) ba[tid] = ((tid >> 6) == 0 ? p.gla_ba_f : p.gla_ba_b)[h * 64 + (tid & 63)];
    __syncthreads();
    float w[16];
#pragma unroll
    for (int j = 0; j < 16; ++j) w[j] = wa[(dir * 16 + j) * 64 + lane];
    const float bias = ba[dir * 64 + lane];
    GlaB r;
#pragma unroll
    for (int i = 0; i < 16; ++i) {
        const int t = tq * 16 + i;
        float z = bias;
#pragma unroll
        for (int j = 0; j < 16; ++j) z += af[(dir * 64 + t) * 16 + j] * w[j];
        const float g = (fminf(z, 0.f) - __logf(1.f + __expf(-fabsf(z)))) * (1.f / 16.f);
        r.b[i] = g;
    }
    if (dir == 0) {
#pragma unroll
        for (int i = 1; i < 16; ++i) r.b[i] += r.b[i - 1];
        tot[(dir * 4 + tq) * 64 + lane] = r.b[15];
    } else {
#pragma unroll
        for (int i = 14; i >= 0; --i) r.b[i] += r.b[i + 1];
        tot[(dir * 4 + tq) * 64 + lane] = r.b[0];
    }
    __syncthreads();
    float offs = 0.f, total = 0.f;
#pragma unroll
    for (int q = 0; q < 4; ++q) { const float tv = tot[(dir * 4 + q) * 64 + lane]; total += tv; if (dir == 0 ? (q < tq) : (q > tq)) offs += tv; }
#pragma unroll
    for (int i = 0; i < 16; ++i) r.b[i] += offs;
    r.total = total;
    return r;
}

__device__ __forceinline__ void gla_stage_vt(const bf16_t* P, int gc, int h, bf16_t* VT) {
    const int tid = threadIdx.x, v = tid & 127, sq = tid >> 7;
    unsigned pk[8];
#pragma unroll
    for (int i = 0; i < 8; ++i) {
        const bf16_t a = P[(size_t)(gc * 64 + sq * 16 + 2 * i) * PW + PC_V + h * 128 + v], b = P[(size_t)(gc * 64 + sq * 16 + 2 * i + 1) * PW + PC_V + h * 128 + v];
        pk[i] = a | ((unsigned)b << 16);
    }
    *(u32x4*)(VT + v * 72 + sq * 16) = (u32x4){pk[0], pk[1], pk[2], pk[3]};
    *(u32x4*)(VT + v * 72 + sq * 16 + 8) = (u32x4){pk[4], pk[5], pk[6], pk[7]};
}

struct GlaPreL { u32x4 kc, vc[2], ac; float4 wac; float bac; };
__device__ __forceinline__ void gla_prefetch_local(PRef p, int gc, int h, GlaPreL& g) {
    const int tid = threadIdx.x;
    const bf16_t* P = (const bf16_t*)(p.ws + WS_P);
    g.kc = *(const u32x4*)(P + (size_t)(gc * 64 + (tid >> 3)) * PW + PC_K + h * 64 + (tid & 7) * 8);
#pragma unroll
    for (int i = 0; i < 2; ++i) { const int idx = tid + 512 * i; g.vc[i] = *(const u32x4*)(P + (size_t)(gc * 64 + (idx >> 4)) * PW + PC_V + h * 128 + (idx & 15) * 8); }
    g.ac = *(const u32x4*)(P + (size_t)(gc * 64 + ((tid & 255) >> 2)) * PW + PC_AF + (tid & 3) * 8);
    { const int dd = tid >> 8, jj = (tid >> 4) & 15, d4 = tid & 15; g.wac = *(const float4*)((dd == 0 ? p.gla_wa_f : p.gla_wa_b) + jj * 256 + h * 64 + d4 * 4); }
    g.bac = ((tid >> 6) & 1 ? p.gla_ba_b : p.gla_ba_f)[h * 64 + (tid & 63)];
}
template <int OFF> __device__ __forceinline__ s16x4 glal_tr(int vb) { typedef __attribute__((address_space(3))) s16x4 lds_s16x4_t; return __builtin_amdgcn_ds_read_tr16_b64_v4i16((lds_s16x4_t*)(uintptr_t)(unsigned)(vb + OFF)); }
__device__ __forceinline__ void gla_local_units(PRef p) {
    const int tid = threadIdx.x, lane = tid & 63, wave = tid >> 6, r32 = lane & 31, hi = lane >> 5, G = gridDim.x;
    bf16_t* kdT = (bf16_t*)smem;
    bf16_t* Kraw = kdT + 2 * 64 * 72;
    char* Vraw = smem + 27648;
    float* af = (float*)(smem + 49152);
    float* wa = af + 2048; float* ba = wa + 2048; float* tot = ba + 128;
    bf16_t* U = (bf16_t*)(p.ws + WS_U); float* DEC = (float*)(p.ws + WS_DEC);
    int u = blockIdx.x;
    if (u >= NCH * 4) return;
    GlaPreL g;
    gla_prefetch_local(p, u >> 2, u & 3, g);
    const int dir = wave & 1, tq = wave >> 1;
    for (; u < NCH * 4; u += G) {
        const int gc = u >> 2, h = u & 3;
        *(u32x4*)(Kraw + (tid >> 3) * 72 + (tid & 7) * 8) = g.kc;
#pragma unroll
        for (int i = 0; i < 2; ++i) { const int idx = tid + 512 * i; *(u32x4*)(Vraw + (idx >> 4) * 320 + (idx & 15) * 16) = g.vc[i]; }
        if (tid < 256) { const int t = tid >> 2, ch = tid & 3, dd = ch >> 1, j0 = (ch & 1) * 8; float* q = af + dd * 1024 + t * 16 + j0;
#pragma unroll
            for (int e = 0; e < 4; ++e) { q[2 * e] = __uint_as_float(g.ac[e] << 16); q[2 * e + 1] = __uint_as_float(g.ac[e] & 0xFFFF0000u); } }
        { const int dd = tid >> 8, jj = (tid >> 4) & 15, d4 = tid & 15; *(float4*)(wa + (dd * 16 + jj) * 64 + d4 * 4) = g.wac; }
        if (tid < 128) ba[tid] = g.bac;
        __syncthreads();
        const int un = u + G;
        if (un < NCH * 4) gla_prefetch_local(p, un >> 2, un & 3, g);
        float bb[16]; float total = 0.f;
        {
            float w[16];
#pragma unroll
            for (int j = 0; j < 16; ++j) w[j] = wa[(dir * 16 + j) * 64 + lane];
            const float bias = ba[dir * 64 + lane];
#pragma unroll
            for (int i = 0; i < 16; ++i) {
                const int t = tq * 16 + i;
                float z = bias;
#pragma unroll
                for (int j = 0; j < 16; ++j) z += af[(dir * 64 + t) * 16 + j] * w[j];
                bb[i] = (fminf(z, 0.f) - __logf(1.f + __expf(-fabsf(z)))) * (1.f / 16.f);
            }
            if (dir == 0) {
#pragma unroll
                for (int i = 1; i < 16; ++i) bb[i] += bb[i - 1];
                tot[(dir * 4 + tq) * 64 + lane] = bb[15];
            } else {
#pragma unroll
                for (int i = 14; i >= 0; --i) bb[i] += bb[i + 1];
                tot[(dir * 4 + tq) * 64 + lane] = bb[0];
            }
        }
        __syncthreads();
        {
            float offs = 0.f;
#pragma unroll
            for (int q = 0; q < 4; ++q) { const float tv = tot[(dir * 4 + q) * 64 + lane]; total += tv; if (dir == 0 ? (q < tq) : (q > tq)) offs += tv; }
#pragma unroll
            for (int i = 0; i < 16; ++i) bb[i] += offs;
        }
        {
            unsigned pk[8];
#pragma unroll
            for (int i = 0; i < 8; ++i) {
                const int s0 = tq * 16 + 2 * i;
                const float k0 = bf2f(Kraw[s0 * 72 + lane]), k1 = bf2f(Kraw[(s0 + 1) * 72 + lane]);
                pk[i] = cvtpk(k0 * __expf(total - bb[2 * i]), k1 * __expf(total - bb[2 * i + 1]));
            }
            *(u32x4*)(kdT + (dir * 64 + lane) * 72 + tq * 16) = (u32x4){pk[0], pk[1], pk[2], pk[3]};
            *(u32x4*)(kdT + (dir * 64 + lane) * 72 + tq * 16 + 8) = (u32x4){pk[4], pk[5], pk[6], pk[7]};
            if (tq == 0) DEC[((size_t)(dir * NCH + gc) * 4 + h) * 64 + lane] = __expf(total);
        }
        __syncthreads();
        {
            const int mdir = wave >> 2, vbk = wave & 3;
            const int vb = (int)(uintptr_t)Vraw + (8 * hi + ((lane & 15) >> 2)) * 320 + (vbk * 32 + 16 * ((lane >> 4) & 1) + 4 * (lane & 3)) * 2;
            f32x16 a0 = {}, a1 = {};
#define GLAL_STEP(KS) do { const s16x4 l_ = glal_tr<(KS) * 5120>(vb), h_ = glal_tr<(KS) * 5120 + 1280>(vb); \
            const bf16x8 b0 = *(const bf16x8*)(kdT + (mdir * 64 + r32) * 72 + (KS) * 16 + hi * 8); \
            const bf16x8 b1 = *(const bf16x8*)(kdT + (mdir * 64 + 32 + r32) * 72 + (KS) * 16 + hi * 8); \
            asm volatile("s_waitcnt lgkmcnt(0)" ::: "memory"); SBAR(); \
            const bf16x8 a_ = (bf16x8){l_[0], l_[1], l_[2], l_[3], h_[0], h_[1], h_[2], h_[3]}; \
            a0 = __builtin_amdgcn_mfma_f32_32x32x16_bf16(a_, b0, a0, 0, 0, 0); a1 = __builtin_amdgcn_mfma_f32_32x32x16_bf16(a_, b1, a1, 0, 0, 0); } while (0)
            GLAL_STEP(0); GLAL_STEP(1); GLAL_STEP(2); GLAL_STEP(3);
#undef GLAL_STEP
            bf16_t* Uo = U + ((size_t)(mdir * NCH + gc) * 4 + h) * 8192;
#pragma unroll
            for (int r = 0; r < 16; ++r) { const int v = vbk * 32 + crow(r, hi); Uo[v * 64 + r32] = f2bf(a0[r]); Uo[v * 64 + 32 + r32] = f2bf(a1[r]); }
        }
        __syncthreads();
    }
}
__device__ __forceinline__ void rope8(const float* rope, int t, int j0, const u32x4& a, const u32x4& b, u32x4& oa, u32x4& ob) {
    const int row = t >> 6, col = t & 63;
    const float* cs = (j0 < 16) ? rope + row * 16 + j0 : rope + 512 * 16 + col * 16 + (j0 - 16);
    const float* sn = (j0 < 16) ? rope + 256 * 16 + row * 16 + j0 : rope + 512 * 16 + 64 * 16 + col * 16 + (j0 - 16);
    const f32x4 c0 = *(const f32x4*)cs, c1 = *(const f32x4*)(cs + 4), s0 = *(const f32x4*)sn, s1 = *(const f32x4*)(sn + 4);
#pragma unroll
    for (int e = 0; e < 4; ++e) {
        const float x1l = __uint_as_float(a[e] << 16), x1h = __uint_as_float(a[e] & 0xFFFF0000u), x2l = __uint_as_float(b[e] << 16), x2h = __uint_as_float(b[e] & 0xFFFF0000u);
        const float cl = (e < 2) ? c0[2 * e] : c1[2 * e - 4], ch = (e < 2) ? c0[2 * e + 1] : c1[2 * e - 3], sl = (e < 2) ? s0[2 * e] : s1[2 * e - 4], sh = (e < 2) ? s0[2 * e + 1] : s1[2 * e - 3];
        oa[e] = cvtpk(x1l * cl - x2l * sl, x1h * ch - x2h * sh);
        ob[e] = cvtpk(x1l * sl + x2l * cl, x1h * sh + x2h * ch);
    }
}
__device__ __forceinline__ u32x4 cvt16_fp8(const u32x4& a, const u32x4& b) {
    u32x4 o;
#pragma unroll
    for (int j = 0; j < 2; ++j) {
        o[j] = pk4_fp8(__uint_as_float(a[2 * j] << 16), __uint_as_float(a[2 * j] & 0xFFFF0000u), __uint_as_float(a[2 * j + 1] << 16), __uint_as_float(a[2 * j + 1] & 0xFFFF0000u));
        o[2 + j] = pk4_fp8(__uint_as_float(b[2 * j] << 16), __uint_as_float(b[2 * j] & 0xFFFF0000u), __uint_as_float(b[2 * j + 1] << 16), __uint_as_float(b[2 * j + 1] & 0xFFFF0000u));
    }
    return o;
}
constexpr float MLA_QS = 8.f * 0.07216878364870322f * 1.4426950408889634f;
__device__ __forceinline__ u32x4 cvt16_fp8s(const u32x4& a, const u32x4& b, float sc) {
    u32x4 o;
#pragma unroll
    for (int j = 0; j < 2; ++j) {
        o[j] = pk4_fp8(__uint_as_float(a[2 * j] << 16) * sc, __uint_as_float(a[2 * j] & 0xFFFF0000u) * sc, __uint_as_float(a[2 * j + 1] << 16) * sc, __uint_as_float(a[2 * j + 1] & 0xFFFF0000u) * sc);
        o[2 + j] = pk4_fp8(__uint_as_float(b[2 * j] << 16) * sc, __uint_as_float(b[2 * j] & 0xFFFF0000u) * sc, __uint_as_float(b[2 * j + 1] << 16) * sc, __uint_as_float(b[2 * j + 1] & 0xFFFF0000u) * sc);
    }
    return o;
}
__device__ __forceinline__ u32x2 cvt8_fp8s(const u32x4& a, float sc) { return (u32x2){pk4_fp8(__uint_as_float(a[0] << 16) * sc, __uint_as_float(a[0] & 0xFFFF0000u) * sc, __uint_as_float(a[1] << 16) * sc, __uint_as_float(a[1] & 0xFFFF0000u) * sc),
                                                                                 pk4_fp8(__uint_as_float(a[2] << 16) * sc, __uint_as_float(a[2] & 0xFFFF0000u) * sc, __uint_as_float(a[3] << 16) * sc, __uint_as_float(a[3] & 0xFFFF0000u) * sc)}; }
__device__ __forceinline__ u32x2 cvt8_fp8(const u32x4& a) { return (u32x2){pk4_fp8(__uint_as_float(a[0] << 16), __uint_as_float(a[0] & 0xFFFF0000u), __uint_as_float(a[1] << 16), __uint_as_float(a[1] & 0xFFFF0000u)),
                                                                       pk4_fp8(__uint_as_float(a[2] << 16), __uint_as_float(a[2] & 0xFFFF0000u), __uint_as_float(a[3] << 16), __uint_as_float(a[3] & 0xFFFF0000u))}; }
__device__ __forceinline__ void mla_pack_pass(PRef p, int b0, int nb) {
    const int tid = threadIdx.x, gt = (blockIdx.x - b0) * NTH + tid, gn = nb * NTH;
    const float* rope = (const float*)(p.ws + WS_ROPE);
    const bf16_t* QM = (const bf16_t*)(p.ws + WS_QM); const bf16_t* KM = (const bf16_t*)(p.ws + WS_KM); const bf16_t* VM = (const bf16_t*)(p.ws + WS_VM);
    unsigned char* Q8 = (unsigned char*)(p.ws + WS_Q8); unsigned char* K8 = (unsigned char*)(p.ws + WS_K8); unsigned char* VT8 = (unsigned char*)(p.ws + WS_VT8);
    for (int i = gt; i < NTOK * 48; i += gn) {
        const int r = i / 48, q = i % 48, hh = q / 12, c = q % 12;
        const bf16_t* qs = QM + (size_t)r * 768 + hh * 192; const bf16_t* ks = KM + (size_t)r * 768 + hh * 192;
        unsigned char* qd = Q8 + (size_t)r * 768 + hh * 192; unsigned char* kd = K8 + ((size_t)hh * NTOK + r) * 192;
        if (c < 8) {
            *(u32x4*)(qd + c * 16) = cvt16_fp8s(*(const u32x4*)(qs + c * 16), *(const u32x4*)(qs + c * 16 + 8), MLA_QS);
            *(u32x4*)(kd + c * 16) = cvt16_fp8(*(const u32x4*)(ks + c * 16), *(const u32x4*)(ks + c * 16 + 8));
        } else {
            const int j0 = (c - 8) * 8;
            const u32x4 a = *(const u32x4*)(qs + 128 + j0), b = *(const u32x4*)(qs + 160 + j0);
            u32x4 oa = a, ob = b;
            if (r >= CTXN) rope8(rope, r - CTXN, j0, a, b, oa, ob);
            *(u32x2*)(qd + 128 + j0) = cvt8_fp8s(oa, MLA_QS); *(u32x2*)(qd + 160 + j0) = cvt8_fp8s(ob, MLA_QS);
            *(u32x2*)(kd + 128 + j0) = cvt8_fp8(*(const u32x4*)(ks + 128 + j0)); *(u32x2*)(kd + 160 + j0) = cvt8_fp8(*(const u32x4*)(ks + 160 + j0));
        }
    }
    {
        const int lane = tid & 63, g = lane >> 4, dq = lane & 15;
        for (int u = gt >> 6; u < 4 * NCH; u += gn >> 6) {
            const int hh = u / NCH, t = u % NCH;
            const bf16_t* vs = VM + (size_t)(t * 64 + 16 * g) * 512 + hh * 128 + dq * 8;
            u32x4 w[16];
#pragma unroll
            for (int i = 0; i < 16; ++i) w[i] = *(const u32x4*)(vs + (size_t)i * 512);
            unsigned char* dst = VT8 + ((size_t)u * 128 + dq * 8) * 64 + 8 * g;
#pragma unroll
            for (int d = 0; d < 8; ++d) {
                float f[16];
#pragma unroll
                for (int i = 0; i < 16; ++i) f[i] = (d & 1) ? __uint_as_float(w[i][d >> 1] & 0xFFFF0000u) : __uint_as_float(w[i][d >> 1] << 16);
                *(u32x2*)(dst + d * 64) = (u32x2){pk4_fp8(f[0], f[1], f[2], f[3]), pk4_fp8(f[8], f[9], f[10], f[11])};
                *(u32x2*)(dst + d * 64 + 32) = (u32x2){pk4_fp8(f[4], f[5], f[6], f[7]), pk4_fp8(f[12], f[13], f[14], f[15])};
            }
        }
    }
}

__device__ __forceinline__ int gla_order(int dir, int step) { return dir == 0 ? step : (step < 4 ? 3 - step : NCH - 1 - (step - 4)); }
__device__ __forceinline__ void phase_gla_scan(PRef p) {
    const int gid = blockIdx.x * NTH + threadIdx.x;
    if (gid >= 2 * 4 * 8192) { mla_pack_pass(p, 128, (int)gridDim.x - 128); return; }
    const int dir = gid >> 15, h = (gid >> 13) & 3, e = gid & 8191, d = e & 63;
    const bf16_t* U = (const bf16_t*)(p.ws + WS_U); bf16_t* S = (bf16_t*)(p.ws + WS_SIN); const float* DEC = (const float*)(p.ws + WS_DEC);
    float s = 0.f;
#pragma unroll 1
    for (int s0 = 0; s0 < NCH; s0 += 52) {
        float uu[52], dc[52];
#pragma unroll
        for (int i = 0; i < 52; ++i) { const size_t o = ((size_t)(dir * NCH + gla_order(dir, s0 + i)) * 4 + h); uu[i] = bf2f(U[o * 8192 + e]); dc[i] = DEC[o * 64 + d]; }
#pragma unroll
        for (int i = 0; i < 52; ++i) { const size_t o = ((size_t)(dir * NCH + gla_order(dir, s0 + i)) * 4 + h); S[o * 8192 + e] = f2bf(s); s = dc[i] * s + uu[i]; }
    }
}

__device__ __forceinline__ void gla_out_unit(PRef p, int gc, int h) {
    const int tid = threadIdx.x, lane = tid & 63, wave = tid >> 6, r32 = lane & 31, hi = lane >> 5;
    const bf16_t* P = (const bf16_t*)(p.ws + WS_P);
    bf16_t* qe = (bf16_t*)smem;
    bf16_t* ke = qe + 2 * 64 * 72;
    bf16_t* Am = ke + 2 * 64 * 72;
    bf16_t* VT = Am + 2 * 64 * 72;
    bf16_t* ST = VT + 128 * 72;
    float* scr = (float*)(smem + 110592);
    float* ob = (float*)(ke);
    const GlaB gb = gla_decay(p, gc, h, scr);
    {
        const int dir = wave & 1, tq = wave >> 1;
#pragma unroll
        for (int i = 0; i < 16; ++i) {
            const int t = tq * 16 + i;
            const float qv = bf2f(P[(size_t)(gc * 64 + t) * PW + PC_Q + h * 64 + lane]) * 0.125f, kv = bf2f(P[(size_t)(gc * 64 + t) * PW + PC_K + h * 64 + lane]);
            qe[(dir * 64 + t) * 72 + lane] = f2bf(qv * __expf(gb.b[i]));
            ke[(dir * 64 + t) * 72 + lane] = f2bf(kv * __expf(-gb.b[i]));
        }
    }
    gla_stage_vt(P, gc, h, VT);
    {
        const bf16_t* S = (const bf16_t*)(p.ws + WS_SIN);
#pragma unroll
        for (int i = 0; i < 4; ++i) {
            const int cc = tid + 512 * i, dir = cc >> 10, v = (cc >> 3) & 127, ch = cc & 7;
            *(u32x4*)(ST + (dir * 128 + v) * 72 + ch * 8) = *(const u32x4*)(S + ((size_t)(dir * NCH + gc) * 4 + h) * 8192 + v * 64 + ch * 8);
        }
    }
    __syncthreads();
    {
        const int dir = wave >> 2, tb = (wave >> 1) & 1, sb = wave & 1;
        f32x16 acc = {};
#pragma unroll
        for (int ks = 0; ks < 4; ++ks) {
            const bf16x8 a = *(const bf16x8*)(qe + (dir * 64 + tb * 32 + r32) * 72 + ks * 16 + hi * 8);
            const bf16x8 b = *(const bf16x8*)(ke + (dir * 64 + sb * 32 + r32) * 72 + ks * 16 + hi * 8);
            acc = __builtin_amdgcn_mfma_f32_32x32x16_bf16(a, b, acc, 0, 0, 0);
        }
        const int s = sb * 32 + r32;
#pragma unroll
        for (int r = 0; r < 16; ++r) { const int t = tb * 32 + crow(r, hi); const bool keep = (dir == 0) ? (s <= t) : (s >= t); Am[(dir * 64 + t) * 72 + s] = f2bf(keep ? acc[r] : 0.f); }
    }
    __syncthreads();
    f32x16 o = {};
    const int tb = wave >> 2, vb = wave & 3;
#pragma unroll
    for (int dir = 0; dir < 2; ++dir)
#pragma unroll
        for (int ks = 0; ks < 4; ++ks) {
            const bf16x8 a1 = *(const bf16x8*)(Am + (dir * 64 + tb * 32 + r32) * 72 + ks * 16 + hi * 8);
            const bf16x8 b1 = *(const bf16x8*)(VT + (vb * 32 + r32) * 72 + ks * 16 + hi * 8);
            o = __builtin_amdgcn_mfma_f32_32x32x16_bf16(a1, b1, o, 0, 0, 0);
            const bf16x8 a2 = *(const bf16x8*)(qe + (dir * 64 + tb * 32 + r32) * 72 + ks * 16 + hi * 8);
            const bf16x8 b2 = *(const bf16x8*)(ST + (dir * 128 + vb * 32 + r32) * 72 + ks * 16 + hi * 8);
            o = __builtin_amdgcn_mfma_f32_32x32x16_bf16(a2, b2, o, 0, 0, 0);
        }
    __syncthreads();
#pragma unroll
    for (int r = 0; r < 16; ++r) ob[(tb * 32 + crow(r, hi)) * 132 + vb * 32 + r32] = o[r];
    __syncthreads();
    {
        const int t = tid >> 3, v0 = (tid & 7) * 16;
        float vals[16]; float ss = 0.f;
#pragma unroll
        for (int i = 0; i < 16; ++i) { vals[i] = ob[t * 132 + v0 + i]; ss += vals[i] * vals[i]; }
        ss += __shfl_xor(ss, 1); ss += __shfl_xor(ss, 2); ss += __shfl_xor(ss, 4);
        const float rstd = rsqrtf(ss * (1.f / 128.f) + EPSN);
        const size_t row = (size_t)gc * 64 + t;
        unsigned pk[8];
#pragma unroll
        for (int i = 0; i < 8; ++i) {
            const float r0 = bf2f(P[row * PW + PC_R + h * 128 + v0 + 2 * i]), r1 = bf2f(P[row * PW + PC_R + h * 128 + v0 + 2 * i + 1]);
            pk[i] = pk2_fp8(vals[2 * i] * rstd * p.gla_onorm[v0 + 2 * i] * silu_f(r0) * MIX8_SCALE, vals[2 * i + 1] * rstd * p.gla_onorm[v0 + 2 * i + 1] * silu_f(r1) * MIX8_SCALE);
        }
        unsigned char* M = (unsigned char*)(p.ws + WS_MIX) + row * 1024 + h * 128 + v0;
        *(u32x4*)M = (u32x4){pk[0] | (pk[1] << 16), pk[2] | (pk[3] << 16), pk[4] | (pk[5] << 16), pk[6] | (pk[7] << 16)};
    }
    __syncthreads();
}


struct GlaPre { u32x4 qc, kc, vc[2], ac, sc[4]; float4 wac; float bac; };
__device__ __forceinline__ void gla_prefetch(PRef p, int gc, int h, GlaPre& g, u32x4 (&rc)[2]) {
    const int tid = threadIdx.x;
    const bf16_t* P = (const bf16_t*)(p.ws + WS_P);
    const bf16_t* rowp = P + (size_t)(gc * 64 + (tid >> 3)) * PW;
    g.qc = *(const u32x4*)(rowp + PC_Q + h * 64 + (tid & 7) * 8);
    g.kc = *(const u32x4*)(rowp + PC_K + h * 64 + (tid & 7) * 8);
#pragma unroll
    for (int i = 0; i < 2; ++i) { const int idx = tid + 512 * i; g.vc[i] = *(const u32x4*)(P + (size_t)(gc * 64 + (idx >> 4)) * PW + PC_V + h * 128 + (idx & 15) * 8); }
#pragma unroll
    for (int i = 0; i < 2; ++i) rc[i] = *(const u32x4*)(rowp + PC_R + h * 128 + (tid & 7) * 16 + 8 * i);
    g.ac = *(const u32x4*)(P + (size_t)(gc * 64 + ((tid & 255) >> 2)) * PW + PC_AF + (tid & 3) * 8);
    const bf16_t* S = (const bf16_t*)(p.ws + WS_SIN);
#pragma unroll
    for (int i = 0; i < 4; ++i) { const int cc = tid + 512 * i, dir = cc >> 10; g.sc[i] = *(const u32x4*)(S + ((size_t)(dir * NCH + gc) * 4 + h) * 8192 + (cc & 1023) * 8); }
    { const int dd = tid >> 8, jj = (tid >> 4) & 15, d4 = tid & 15; g.wac = *(const float4*)((dd == 0 ? p.gla_wa_f : p.gla_wa_b) + jj * 256 + h * 64 + d4 * 4); }
    g.bac = ((tid >> 6) & 1 ? p.gla_ba_b : p.gla_ba_f)[h * 64 + (tid & 63)];
}
template <int OFF> __device__ __forceinline__ s16x4 gla_tr(int vb) { typedef __attribute__((address_space(3))) s16x4 lds_s16x4_t; return __builtin_amdgcn_ds_read_tr16_b64_v4i16((lds_s16x4_t*)(uintptr_t)(unsigned)(vb + OFF)); }
__device__ __forceinline__ void phase_gla_out(PRef p) {
    const int tid = threadIdx.x, lane = tid & 63, wave = tid >> 6, r32 = lane & 31, hi = lane >> 5, G = gridDim.x;
    bf16_t* qe = (bf16_t*)smem;
    bf16_t* ke = qe + 2 * 64 * 72;
    bf16_t* Am = ke + 2 * 64 * 72;
    bf16_t* Qraw = Am; bf16_t* Kraw = Am + 64 * 72;
    char* Vraw = smem + 55296;
    bf16_t* ST = (bf16_t*)(smem + 75776);
    float* af = (float*)(smem + 112640);
    float* wa = af + 2048;
    float* ba = wa + 2048;
    float* tot = ba + 128;
    float* ob = (float*)ke;
    int u = blockIdx.x;
    if (u >= NCH * 4) return;
    const int nt_t = tid >> 3, nt_v0 = (tid & 7) * 16;
    float on[16];
#pragma unroll
    for (int i = 0; i < 16; ++i) on[i] = p.gla_onorm[nt_v0 + i];
    GlaPre g; u32x4 rc[2], rcn[2];
    gla_prefetch(p, u >> 2, u & 3, g, rc);
    const int dir = wave & 1, tq = wave >> 1;
    for (; u < NCH * 4; u += G) {
        const int gc = u >> 2, h = u & 3;
        *(u32x4*)(Qraw + (tid >> 3) * 72 + (tid & 7) * 8) = g.qc;
        *(u32x4*)(Kraw + (tid >> 3) * 72 + (tid & 7) * 8) = g.kc;
#pragma unroll
        for (int i = 0; i < 2; ++i) { const int idx = tid + 512 * i; *(u32x4*)(Vraw + (idx >> 4) * 320 + (idx & 15) * 16) = g.vc[i]; }
#pragma unroll
        for (int i = 0; i < 4; ++i) { const int cc = tid + 512 * i; *(u32x4*)(ST + ((cc >> 10) * 128 + ((cc >> 3) & 127)) * 72 + (cc & 7) * 8) = g.sc[i]; }
        if (tid < 256) { const int t = tid >> 2, ch = tid & 3, dd = ch >> 1, j0 = (ch & 1) * 8; float* q = af + dd * 1024 + t * 16 + j0;
#pragma unroll
            for (int e = 0; e < 4; ++e) { q[2 * e] = __uint_as_float(g.ac[e] << 16); q[2 * e + 1] = __uint_as_float(g.ac[e] & 0xFFFF0000u); } }
        { const int dd = tid >> 8, jj = (tid >> 4) & 15, d4 = tid & 15; *(float4*)(wa + (dd * 16 + jj) * 64 + d4 * 4) = g.wac; }
        if (tid < 128) ba[tid] = g.bac;
        __syncthreads();
        const int un = u + G;
        if (un < NCH * 4) gla_prefetch(p, un >> 2, un & 3, g, rcn);
        float bb[16]; float total;
        {
            float w[16];
#pragma unroll
            for (int j = 0; j < 16; ++j) w[j] = wa[(dir * 16 + j) * 64 + lane];
            const float bias = ba[dir * 64 + lane];
#pragma unroll
            for (int i = 0; i < 16; ++i) {
                const int t = tq * 16 + i;
                float z = bias;
#pragma unroll
                for (int j = 0; j < 16; ++j) z += af[(dir * 64 + t) * 16 + j] * w[j];
                bb[i] = (fminf(z, 0.f) - __logf(1.f + __expf(-fabsf(z)))) * (1.f / 16.f);
            }
            if (dir == 0) {
#pragma unroll
                for (int i = 1; i < 16; ++i) bb[i] += bb[i - 1];
                tot[(dir * 4 + tq) * 64 + lane] = bb[15];
            } else {
#pragma unroll
                for (int i = 14; i >= 0; --i) bb[i] += bb[i + 1];
                tot[(dir * 4 + tq) * 64 + lane] = bb[0];
            }
        }
        __syncthreads();
        {
            float offs = 0.f; total = 0.f;
#pragma unroll
            for (int q = 0; q < 4; ++q) { const float tv = tot[(dir * 4 + q) * 64 + lane]; total += tv; if (dir == 0 ? (q < tq) : (q > tq)) offs += tv; }
#pragma unroll
            for (int i = 0; i < 16; ++i) bb[i] += offs;
        }
#pragma unroll
        for (int i = 0; i < 16; ++i) {
            const int t = tq * 16 + i;
            const float qv = bf2f(Qraw[t * 72 + lane]) * 0.125f, kv = bf2f(Kraw[t * 72 + lane]);
            qe[(dir * 64 + t) * 72 + lane] = f2bf(qv * __expf(bb[i]));
            ke[(dir * 64 + t) * 72 + lane] = f2bf(kv * __expf(-bb[i]));
        }
        __syncthreads();
        {
            const int mdir = wave >> 2, tb = (wave >> 1) & 1, sb = wave & 1;
            f32x16 acc = {};
#pragma unroll
            for (int ks = 0; ks < 4; ++ks) {
                const bf16x8 a = *(const bf16x8*)(qe + (mdir * 64 + tb * 32 + r32) * 72 + ks * 16 + hi * 8);
                const bf16x8 b = *(const bf16x8*)(ke + (mdir * 64 + sb * 32 + r32) * 72 + ks * 16 + hi * 8);
                acc = __builtin_amdgcn_mfma_f32_32x32x16_bf16(a, b, acc, 0, 0, 0);
            }
            const int sI = sb * 32 + r32;
#pragma unroll
            for (int r = 0; r < 16; ++r) { const int t = tb * 32 + crow(r, hi); const bool keep = (mdir == 0) ? (sI <= t) : (sI >= t); Am[(mdir * 64 + t) * 72 + sI] = f2bf(keep ? acc[r] : 0.f); }
        }
        __syncthreads();
        f32x16 o = {};
        const int tb = wave >> 2, vbk = wave & 3;
        {
            const int vb = (int)(uintptr_t)Vraw + (8 * hi + ((lane & 15) >> 2)) * 320 + (vbk * 32 + 16 * ((lane >> 4) & 1) + 4 * (lane & 3)) * 2;
#define GLA_PV(KS, DIRN) do { const s16x4 l_ = gla_tr<(KS) * 5120>(vb), h_ = gla_tr<(KS) * 5120 + 1280>(vb); \
            const bf16x8 a1 = *(const bf16x8*)(Am + ((DIRN) * 64 + tb * 32 + r32) * 72 + (KS) * 16 + hi * 8); \
            const bf16x8 a2 = *(const bf16x8*)(qe + ((DIRN) * 64 + tb * 32 + r32) * 72 + (KS) * 16 + hi * 8); \
            const bf16x8 b2 = *(const bf16x8*)(ST + ((DIRN) * 128 + vbk * 32 + r32) * 72 + (KS) * 16 + hi * 8); \
            asm volatile("s_waitcnt lgkmcnt(0)" ::: "memory"); SBAR(); \
            o = __builtin_amdgcn_mfma_f32_32x32x16_bf16(a1, (bf16x8){l_[0], l_[1], l_[2], l_[3], h_[0], h_[1], h_[2], h_[3]}, o, 0, 0, 0); \
            o = __builtin_amdgcn_mfma_f32_32x32x16_bf16(a2, b2, o, 0, 0, 0); } while (0)
            GLA_PV(0, 0); GLA_PV(1, 0); GLA_PV(2, 0); GLA_PV(3, 0); GLA_PV(0, 1); GLA_PV(1, 1); GLA_PV(2, 1); GLA_PV(3, 1);
#undef GLA_PV
        }
        __syncthreads();
#pragma unroll
        for (int r = 0; r < 16; ++r) ob[(tb * 32 + crow(r, hi)) * 132 + vbk * 32 + r32] = o[r];
        __syncthreads();
        {
            float vals[16]; float ss = 0.f;
#pragma unroll
            for (int i = 0; i < 4; ++i) { const f32x4 x = *(const f32x4*)(ob + nt_t * 132 + nt_v0 + 4 * i); vals[4 * i] = x[0]; vals[4 * i + 1] = x[1]; vals[4 * i + 2] = x[2]; vals[4 * i + 3] = x[3]; }
#pragma unroll
            for (int i = 0; i < 16; ++i) ss += vals[i] * vals[i];
            ss += __shfl_xor(ss, 1); ss += __shfl_xor(ss, 2); ss += __shfl_xor(ss, 4);
            const float rstd = rsqrtf(ss * (1.f / 128.f) + EPSN);
            unsigned pk[8];
#pragma unroll
            for (int i = 0; i < 8; ++i) {
                const unsigned w = rc[i >> 2][i & 3];
                const float r0 = __uint_as_float(w << 16), r1 = __uint_as_float(w & 0xFFFF0000u);
                const float s0 = r0 * __builtin_amdgcn_rcpf(1.f + __expf(-r0)), s1 = r1 * __builtin_amdgcn_rcpf(1.f + __expf(-r1));
                pk[i] = pk2_fp8(vals[2 * i] * rstd * on[2 * i] * s0 * MIX8_SCALE, vals[2 * i + 1] * rstd * on[2 * i + 1] * s1 * MIX8_SCALE);
            }
            unsigned char* M = (unsigned char*)(p.ws + WS_MIX) + ((size_t)gc * 64 + nt_t) * 1024 + h * 128 + nt_v0;
            *(u32x4*)M = (u32x4){pk[0] | (pk[1] << 16), pk[2] | (pk[3] << 16), pk[4] | (pk[5] << 16), pk[6] | (pk[7] << 16)};
        }
        rc[0] = rcn[0]; rc[1] = rcn[1];
        __syncthreads();
    }
}

namespace mla8 {
typedef int i32x8 __attribute__((ext_vector_type(8)));
constexpr int KVBLK = 64;
constexpr float SCALE = 0.07216878364870322f;
constexpr float THR = 3.f;
constexpr float PBIAS = 4.f;
constexpr int KROW = 208, VROW = 80;
constexpr int SHM_K = KVBLK * KROW, SHM_V = 128 * VROW;
constexpr int ONE = 0x7F7F7F7F, QSC = 0x7C7C7C7C;
__device__ __forceinline__ i32x8 ld32(const char* a) { const i32x4 lo = *(const i32x4*)a, hi_ = *(const i32x4*)(a + 16); return __builtin_shufflevector(lo, hi_, 0, 1, 2, 3, 4, 5, 6, 7); }
__device__ __forceinline__ void qkt(f32x16& p0, f32x16& p1, const char* Kw, const i32x8 (&q)[3]) {
    p0 = f32x16{}; p1 = f32x16{};
#pragma unroll
    for (int s_ = 0; s_ < 3; ++s_) {
        const i32x8 a0 = ld32(Kw + s_ * 64), a1 = ld32(Kw + 32 * KROW + s_ * 64);
        p0 = __builtin_amdgcn_mfma_scale_f32_32x32x64_f8f6f4(a0, q[s_], p0, 0, 0, 0, ONE, 0, QSC);
        p1 = __builtin_amdgcn_mfma_scale_f32_32x32x64_f8f6f4(a1, q[s_], p1, 0, 0, 0, ONE, 0, QSC);
    }
}
typedef float f32x2 __attribute__((ext_vector_type(2)));
#define M8_PAIR(P, i) ((f32x2){P[2 * (i)], P[2 * (i) + 1]})
#define M8_EXP(P, i) P[i] = __builtin_amdgcn_exp2f(P[i])
__device__ __forceinline__ float fma1(float a, float b, float c) { float d; asm("v_fma_f32 %0, %1, %2, %3" : "=v"(d) : "v"(a), "v"(b), "v"(c)); return d; }
__device__ __forceinline__ float mul1(float a, float b) { float d; asm("v_mul_f32 %0, %1, %2" : "=v"(d) : "v"(a), "v"(b)); return d; }
__device__ __forceinline__ float add1(float a, float b) { float d; asm("v_add_f32 %0, %1, %2" : "=v"(d) : "v"(a), "v"(b)); return d; }
__device__ __forceinline__ float add1n(float a, float b) { float d; asm("s_nop 0\n\tv_add_f32 %0, %1, %2" : "=v"(d) : "v"(a), "v"(b)); return d; }
#define M8_MFMA(A, B, C) __builtin_amdgcn_mfma_scale_f32_32x32x64_f8f6f4(A, B, C, 0, 0, 0, ONE, 0, ONE)
#define M8_MFMAQ(A, B, C) __builtin_amdgcn_mfma_scale_f32_32x32x64_f8f6f4(A, B, C, 0, 0, 0, ONE, 0, QSC)
constexpr int NEXP_B = 8;
#define M8_F1(P0, P1) do { M8_EXP(P0, 8); M8_EXP(P0, 9); M8_EXP(P0, 10); M8_EXP(P0, 11); M8_EXP(P0, 12); M8_EXP(P0, 13); } while (0)
#define M8_F2(P0, P1) do { M8_EXP(P0, 14); M8_EXP(P0, 15); M8_EXP(P1, 0); M8_EXP(P1, 1); M8_EXP(P1, 2); M8_EXP(P1, 3); } while (0)
#define M8_F3(P0, P1) do { M8_EXP(P1, 4); M8_EXP(P1, 5); M8_EXP(P1, 6); M8_EXP(P1, 7); M8_EXP(P1, 8); M8_EXP(P1, 9); } while (0)
#define M8_F4(P0, P1) do { M8_EXP(P1, 10); M8_EXP(P1, 11); M8_EXP(P1, 12); M8_EXP(P1, 13); M8_EXP(P1, 14); M8_EXP(P1, 15); } while (0)
#define M8_F5(P0, P1) do { float t0_ = add1(P0[0], P0[1]), t1_ = add1(P0[2], P0[3]), t2_ = add1(P0[4], P0[5]), t3_ = add1(P0[6], P0[7]); \
    _Pragma("unroll") for (int i_ = 8; i_ < 16; i_ += 4) { t0_ = add1(t0_, P0[i_]); t1_ = add1(t1_, P0[i_ + 1]); t2_ = add1(t2_, P0[i_ + 2]); t3_ = add1(t3_, P0[i_ + 3]); } \
    _Pragma("unroll") for (int i_ = 0; i_ < 8; i_ += 4) { t0_ = add1(t0_, P1[i_]); t1_ = add1(t1_, P1[i_ + 1]); t2_ = add1(t2_, P1[i_ + 2]); t3_ = add1(t3_, P1[i_ + 3]); } \
    _Pragma("unroll") for (int i_ = 8; i_ < 16; i_ += 4) { t0_ = add1n(t0_, P1[i_]); t1_ = add1n(t1_, P1[i_ + 1]); t2_ = add1n(t2_, P1[i_ + 2]); t3_ = add1n(t3_, P1[i_ + 3]); }        \
    psum = add1(add1(t0_, t1_), add1(t2_, t3_)); \
    _Pragma("unroll") for (int w_ = 0; w_ < 4; ++w_) { int a_ = __builtin_amdgcn_cvt_pk_fp8_f32(P0[4 * w_], P0[4 * w_ + 1], 0, false); P8[w_] = __builtin_amdgcn_cvt_pk_fp8_f32(P0[4 * w_ + 2], P0[4 * w_ + 3], a_, true); } } while (0)
#define M8_F6A(P0, P1) do { _Pragma("unroll") for (int w_ = 0; w_ < 4; ++w_) { int b_ = __builtin_amdgcn_cvt_pk_fp8_f32(P1[4 * w_], P1[4 * w_ + 1], 0, false); P8[4 + w_] = __builtin_amdgcn_cvt_pk_fp8_f32(P1[4 * w_ + 2], P1[4 * w_ + 3], b_, true); } } while (0)
#define M8_F6B(AL) do { { auto rr_ = __builtin_amdgcn_permlane32_swap(__float_as_uint(psum), __float_as_uint(psum), false, false); psum = __uint_as_float(rr_[0]) + __uint_as_float(rr_[1]); } \
    l_reg = fmaf(l_reg, AL, psum); } while (0)
#define M8_F6(P0, P1, AL) do { M8_F6A(P0, P1); M8_F6B(AL); } while (0)
#define M8_P1(P0, P1) do { float x_ = fmaxf(P0[0], P0[1]); _Pragma("unroll") for (int r_ = 2; r_ < 16; r_ += 2) x_ = fmaxf(fmaxf(x_, P0[r_]), P0[r_ + 1]); \
    _Pragma("unroll") for (int r_ = 0; r_ < 16; r_ += 2) x_ = fmaxf(fmaxf(x_, P1[r_]), P1[r_ + 1]); \
    { auto rr_ = __builtin_amdgcn_permlane32_swap(__float_as_uint(x_), __float_as_uint(x_), false, false); pmax = fmaxf(__uint_as_float(rr_[0]), __uint_as_float(rr_[1])); } } while (0)
#define M8_P2(P0, P1, AL) do { AL = 1.f; if (!__all(pmax <= PBIAS + THR * LOG2E)) { const float d_ = fmaxf(pmax - PBIAS, 0.f); AL = __builtin_amdgcn_exp2f(-d_); \
    _Pragma("unroll") for (int i_ = 0; i_ < 16; ++i_) { P0[i_] -= d_; P1[i_] -= d_; minit[i_] -= d_; } } } while (0)
#define M8_P3(P0, P1) do { M8_EXP(P0, 0); M8_EXP(P0, 1); M8_EXP(P0, 2); M8_EXP(P0, 3); } while (0)
#define M8_P4(P0, P1) do { M8_EXP(P0, 4); M8_EXP(P0, 5); M8_EXP(P0, 6); M8_EXP(P0, 7); } while (0)
__device__ __forceinline__ void attn_body2(const unsigned char* __restrict__ Q8w, const unsigned char* __restrict__ K8h, const unsigned char* __restrict__ V8h, unsigned char* __restrict__ Ob, int seq) {
    char* lds = smem;
    const int tid = tid_opaque(), wid = tid >> 6, lane = tid & 63, r32 = lane & 31, hi = lane >> 5;
    constexpr int BUF = SHM_K + SHM_V;
    float l_reg = 0; f32x16 o[4] = {}; f32x16 minit;
    i32x8 q[3];
    { const unsigned char* qp = Q8w + (size_t)(wid * 32 + r32) * 768 + hi * 32;
#pragma unroll
      for (int s_ = 0; s_ < 3; ++s_) { const i32x4 lo = *(const i32x4*)(qp + s_ * 64), hi_ = *(const i32x4*)(qp + s_ * 64 + 16); q[s_] = __builtin_shufflevector(lo, hi_, 0, 1, 2, 3, 4, 5, 6, 7); } }
    const int kc0 = tid, kc1 = 512 + (tid & 255);
    const int kso0 = (kc0 / 12) * KROW + (kc0 % 12) * 16, kso1 = (kc1 / 12) * KROW + (kc1 % 12) * 16, vso = SHM_K + (tid >> 2) * VROW + (tid & 3) * 16;
    const bool two = tid < 256;
    const char* Kw = lds + r32 * KROW + hi * 32; const char* Vw = lds + SHM_K + r32 * VROW + hi * 32;
    struct { u32x4 k0, k1, v; } st_;
#define SLOAD(t_) do { const unsigned char* kt_ = K8h + (size_t)(t_) * (KVBLK * 192); st_.k0 = *(const u32x4*)(kt_ + kc0 * 16); if (two) st_.k1 = *(const u32x4*)(kt_ + kc1 * 16); \
    st_.v = *(const u32x4*)(V8h + (size_t)(t_) * 8192 + tid * 16); } while (0)
#define SWRITE(bo) do { *(u32x4*)(lds + (bo) + kso0) = st_.k0; if (two) *(u32x4*)(lds + (bo) + kso1) = st_.k1; *(u32x4*)(lds + (bo) + vso) = st_.v; } while (0)
#define RESC(a) do { if (__any((a) < 1.f)) { asm volatile("s_nop 15\n\ts_nop 15\n\ts_nop 15\n\ts_nop 15\n\ts_nop 15\n\ts_nop 15" ::: "memory");     \
    _Pragma("unroll") for (int d = 0; d < 4; ++d) _Pragma("unroll") for (int r = 0; r < 16; ++r) o[d][r] = mul1(o[d][r], (a)); } } while (0)
    f32x16 pA0, pA1, pB0, pB1; float alA = 1.f, alB = 1.f, pmax, psum; i32x8 P8;
    const int NT = seq / KVBLK;
#define TIE3(a, b, c) asm volatile("" : "+v"(a), "+v"(b), "+v"(c))
#define TIE4(a, b, c, d) asm volatile("" : "+v"(a), "+v"(b), "+v"(c), "+v"(d))
#define TIE5(a, b, c, d, e) asm volatile("" : "+v"(a), "+v"(b), "+v"(c), "+v"(d), "+v"(e))
#define TIE6(a, b, c, d, e, f) asm volatile("" : "+v"(a), "+v"(b), "+v"(c), "+v"(d), "+v"(e), "+v"(f))
#define M8_STEP(PC0, PC1, ALC, PN0, PN1, ALN, kb, vb, DO_QK) do { \
    i32x8 k00, k10, k01, k11, k02, k12, v0, v1, v2, v3; \
    int ko_ = (kb), vo_ = (vb);        \
    if (DO_QK) { k00 = ld32(Kw + ko_); k10 = ld32(Kw + ko_ + 32 * KROW); k01 = ld32(Kw + ko_ + 64); \
        PN0 = M8_MFMAQ(k00, q[0], minit); TIE4(PN0, PC0, PC1, ko_); } \
    M8_F1(PC0, PC1); \
    if (DO_QK) { k11 = ld32(Kw + ko_ + 32 * KROW + 64); TIE3(PC0, PC1, k10); PN1 = M8_MFMAQ(k10, q[0], minit); TIE4(PN1, PC0, PC1, ko_); } \
    M8_F2(PC0, PC1); \
    if (DO_QK) { k02 = ld32(Kw + ko_ + 128); TIE3(PC0, PC1, k01); PN0 = M8_MFMAQ(k01, q[1], PN0); TIE4(PN0, PC0, PC1, ko_); } \
    M8_F3(PC0, PC1); \
    if (DO_QK) { k12 = ld32(Kw + ko_ + 32 * KROW + 128); TIE3(PC0, PC1, k11); PN1 = M8_MFMAQ(k11, q[1], PN1); TIE4(PN1, PC0, PC1, vo_); } \
    M8_F4(PC0, PC1); \
    v0 = ld32(Vw + vo_); \
    if (DO_QK) { TIE3(PC0, PC1, k02); PN0 = M8_MFMAQ(k02, q[2], PN0); TIE4(PN0, PC0, PC1, vo_); } \
    M8_F5(PC0, PC1); \
    v1 = ld32(Vw + vo_ + 32 * VROW); \
    if (DO_QK) { TIE5(PC0, PC1, P8, psum, k12); PN1 = M8_MFMAQ(k12, q[2], PN1); TIE6(PN1, PC0, PC1, P8, psum, vo_); } \
    M8_F6A(PC0, PC1); \
    v2 = ld32(Vw + vo_ + 64 * VROW); \
    TIE3(P8, psum, v0); o[0] = M8_MFMA(v0, P8, o[0]); \
    TIE3(o[0], psum, vo_); M8_F6B(ALC); v3 = ld32(Vw + vo_ + 96 * VROW); TIE3(l_reg, psum, v1); \
    o[1] = M8_MFMA(v1, P8, o[1]); \
      \
    if (DO_QK) { TIE4(o[1], PN0, PN1, vo_); M8_P1(PN0, PN1); TIE4(PN0, PN1, pmax, v2); } \
    o[2] = M8_MFMA(v2, P8, o[2]); \
    if (DO_QK) { TIE4(o[2], PN0, PN1, pmax); M8_P2(PN0, PN1, ALN); M8_P3(PN0, PN1); TIE5(PN0, PN1, minit, ALN, v3); } \
    o[3] = M8_MFMA(v3, P8, o[3]); \
    if (DO_QK) { TIE3(o[3], PN0, PN1); M8_P4(PN0, PN1); TIE3(PN0, PN1, ALN); RESC(ALN); } } while (0)
    SLOAD(0); SWRITE(0); SLOAD(1); SWRITE(BUF); __syncthreads();
    SLOAD(2);
    qkt(pA0, pA1, Kw, q);
    M8_P1(pA0, pA1);
    { const float mc_ = PBIAS - pmax;
#pragma unroll
      for (int i_ = 0; i_ < 16; ++i_) { pA0[i_] += mc_; pA1[i_] += mc_; minit[i_] = mc_; } }
    M8_P3(pA0, pA1); M8_P4(pA0, pA1);
    int b0 = 0, b1 = BUF, b2 = 2 * BUF;
    for (int j = 0; j + 2 < NT; j += 2) {
        __syncthreads(); SWRITE(b2); if (j + 3 < NT) SLOAD(j + 3);
        M8_STEP(pA0, pA1, alA, pB0, pB1, alB, b1, b0, true);
        __syncthreads(); SWRITE(b0); if (j + 4 < NT) SLOAD(j + 4);
        M8_STEP(pB0, pB1, alB, pA0, pA1, alA, b2, b1, true);
        { const int t_ = b0; b0 = b2; b2 = b1; b1 = t_; }
    }
    __syncthreads();
    M8_STEP(pA0, pA1, alA, pB0, pB1, alB, b1, b0, true);
    M8_STEP(pB0, pB1, alB, pA0, pA1, alA, 0, b1, false);
    const float rl = __builtin_amdgcn_rcpf(l_reg) * MIX8_SCALE;
    unsigned char* Ow = Ob + (size_t)(wid * 32 + r32) * 1024 + 4 * hi;
#pragma unroll
    for (int d0 = 0; d0 < 4; ++d0)
#pragma unroll
        for (int g = 0; g < 4; ++g)
            *(unsigned*)(Ow + d0 * 32 + 8 * g) = pk4_fp8(o[d0][4 * g] * rl, o[d0][4 * g + 1] * rl, o[d0][4 * g + 2] * rl, o[d0][4 * g + 3] * rl);
    __syncthreads();
#undef SLOAD
#undef SWRITE
#undef RESC
#undef M8_STEP
}
}

__device__ __forceinline__ void phase_mix0(PRef p) {
    const int G = gridDim.x;
    phase_gla_out(p);
    __syncthreads();
    const unsigned char* Q8 = (const unsigned char*)(p.ws + WS_Q8); const unsigned char* K8 = (const unsigned char*)(p.ws + WS_K8); const unsigned char* VT8 = (const unsigned char*)(p.ws + WS_VT8);
    bf16_t* MIX = (bf16_t*)(p.ws + WS_MIX);
    for (int u = blockIdx.x; u < 256 + G; u += G) {
        const bool lat = u < 256;
        const int cu = lat ? 0 : G - 1 - (u - 256);
        if (!lat && cu >= 4) continue;
        const int h = lat ? (u & 3) : cu;
        const size_t q0 = lat ? (size_t)CTXN + (size_t)(u >> 2) * 256 : 0;
        mla8::attn_body2(Q8 + q0 * 768 + h * 192, K8 + (size_t)h * NTOK * 192, VT8 + (size_t)h * NCH * 8192, (unsigned char*)MIX + q0 * 1024 + 512 + h * 128, lat ? NTOK : CTXN);
    }
}

#define PK4(P, BASE, OUT) do { unsigned a0 = cvtpk(P[BASE + 0], P[BASE + 1]), a1 = cvtpk(P[BASE + 2], P[BASE + 3]);   \
    unsigned b0 = cvtpk(P[BASE + 4], P[BASE + 5]), b1 = cvtpk(P[BASE + 6], P[BASE + 7]);                              \
    auto r0 = __builtin_amdgcn_permlane32_swap(a0, b0, false, false); auto r1 = __builtin_amdgcn_permlane32_swap(a1, b1, false, false); \
    u32x4 w = {r0[0], r1[0], r0[1], r1[1]}; OUT = *reinterpret_cast<bf16x8*>(&w); } while (0)
template <int OFF> __device__ __forceinline__ s16x4 na_tr(int vb) { typedef __attribute__((address_space(3))) s16x4 lds_s16x4_t; return __builtin_amdgcn_ds_read_tr16_b64_v4i16((lds_s16x4_t*)(uintptr_t)(unsigned)(vb + OFF)); }
struct NaVF { s16x4 a0[4], a1[4], b0[4], b1[4]; };
__device__ __forceinline__ void na_vload(NaVF& f, int vb) {
    f.a0[0] = na_tr<0>(vb); f.a1[0] = na_tr<1280>(vb); f.b0[0] = na_tr<64>(vb); f.b1[0] = na_tr<1280 + 64>(vb);
    f.a0[1] = na_tr<5120>(vb); f.a1[1] = na_tr<5120 + 1280>(vb); f.b0[1] = na_tr<5120 + 64>(vb); f.b1[1] = na_tr<5120 + 1280 + 64>(vb);
    f.a0[2] = na_tr<10240>(vb); f.a1[2] = na_tr<10240 + 1280>(vb); f.b0[2] = na_tr<10240 + 64>(vb); f.b1[2] = na_tr<10240 + 1280 + 64>(vb);
    f.a0[3] = na_tr<15360>(vb); f.a1[3] = na_tr<15360 + 1280>(vb); f.b0[3] = na_tr<15360 + 64>(vb); f.b1[3] = na_tr<15360 + 1280 + 64>(vb);
}
__device__ __forceinline__ void na_pvall(f32x16& o0, f32x16& o1, const NaVF& f, bf16x8 pa0, bf16x8 pa1, bf16x8 pa2, bf16x8 pa3) {
#define NA_PV1(K, PA) do { o0 = __builtin_amdgcn_mfma_f32_32x32x16_bf16(PA, (bf16x8){f.a0[K][0], f.a0[K][1], f.a0[K][2], f.a0[K][3], f.a1[K][0], f.a1[K][1], f.a1[K][2], f.a1[K][3]}, o0, 0, 0, 0); \
        o1 = __builtin_amdgcn_mfma_f32_32x32x16_bf16(PA, (bf16x8){f.b0[K][0], f.b0[K][1], f.b0[K][2], f.b0[K][3], f.b1[K][0], f.b1[K][1], f.b1[K][2], f.b1[K][3]}, o1, 0, 0, 0); } while (0)
    NA_PV1(0, pa0); NA_PV1(1, pa1); NA_PV1(2, pa2); NA_PV1(3, pa3);
#undef NA_PV1
}
template <int KS> __device__ __forceinline__ void na_pv(f32x16& o0, f32x16& o1, int vb, bf16x8 pa) {
    const s16x4 a0 = na_tr<KS * 5120>(vb), a1 = na_tr<KS * 5120 + 1280>(vb), b0 = na_tr<KS * 5120 + 64>(vb), b1 = na_tr<KS * 5120 + 1280 + 64>(vb);
    asm volatile("s_waitcnt lgkmcnt(0)" ::: "memory"); SBAR();
    o0 = __builtin_amdgcn_mfma_f32_32x32x16_bf16(pa, (bf16x8){a0[0], a0[1], a0[2], a0[3], a1[0], a1[1], a1[2], a1[3]}, o0, 0, 0, 0);
    o1 = __builtin_amdgcn_mfma_f32_32x32x16_bf16(pa, (bf16x8){b0[0], b0[1], b0[2], b0[3], b1[0], b1[1], b1[2], b1[3]}, o1, 0, 0, 0);
}
template <int MODE> __device__ __forceinline__ void na_softmax(f32x16& p0, f32x16& p1, float& m_reg, float& l_reg, float& alpha, const float* brow, int c0, int hi) {
    constexpr float C = 0.125f * LOG2E;
#define NA_L0(q) (MODE != 2 || (q) >= 12)
#define NA_L1(q) (MODE != 1 || (q) < 4)
    if (MODE == 0) {
#pragma unroll
        for (int q = 0; q < 16; ++q) { p0[q] *= C; p1[q] *= C; }
    } else {
        float bv0[16], bv1[16];
#pragma unroll
        for (int q = 0; q < 16; ++q) { const int kc0 = crow(q, hi); if (NA_L0(q)) bv0[q] = brow[kc0]; if (NA_L1(q)) bv1[q] = brow[32 + kc0]; }
#pragma unroll
        for (int q = 0; q < 16; ++q) { if (NA_L0(q)) asm volatile("" : "+v"(bv0[q])); if (NA_L1(q)) asm volatile("" : "+v"(bv1[q])); }
#pragma unroll
        for (int q = 0; q < 16; ++q) {
            const int kc0 = crow(q, hi), kc1 = 32 + kc0;
            if (NA_L0(q)) { const float t = fmaf(p0[q], C, bv0[q]); p0[q] = ((unsigned)(kc0 - c0) < 16u) ? t : -1e30f; }
            if (NA_L1(q)) { const float t = fmaf(p1[q], C, bv1[q]); p1[q] = ((unsigned)(kc1 - c0) < 16u) ? t : -1e30f; }
        }
    }
    float pmax = -1e30f;
#pragma unroll
    for (int q = 0; q < 16; ++q) { if (NA_L0(q)) pmax = fmaxf(pmax, p0[q]); if (NA_L1(q)) pmax = fmaxf(pmax, p1[q]); }
    { auto rr = __builtin_amdgcn_permlane32_swap(__float_as_uint(pmax), __float_as_uint(pmax), false, false);
      pmax = fmaxf(__uint_as_float(rr[0]), __uint_as_float(rr[1])); }
    const float mn = fmaxf(m_reg, pmax);
    alpha = __builtin_amdgcn_exp2f(m_reg - mn);
    m_reg = mn;
    float ps = 0.f;
#pragma unroll
    for (int q = 0; q < 16; ++q) {
        if (NA_L0(q)) { p0[q] = __builtin_amdgcn_exp2f(p0[q] - mn); ps += p0[q]; } else p0[q] = 0.f;
        if (NA_L1(q)) { p1[q] = __builtin_amdgcn_exp2f(p1[q] - mn); ps += p1[q]; } else p1[q] = 0.f;
    }
    { auto rr = __builtin_amdgcn_permlane32_swap(__float_as_uint(ps), __float_as_uint(ps), false, false);
      ps = __uint_as_float(rr[0]) + __uint_as_float(rr[1]); }
    l_reg = l_reg * alpha + ps;
#undef NA_L0
#undef NA_L1
}
__device__ __forceinline__ void phase_na(PRef p) {
    const int tid = threadIdx.x, lane = tid & 63, wave = tid >> 6, r32 = lane & 31, hi = lane >> 5, G = gridDim.x;
    const bf16_t* QKV = (const bf16_t*)(p.ws + WS_P);
    bf16_t* MIX = (bf16_t*)(p.ws + WS_MIX);
    constexpr int KB = 64 * 72 * 2, VB = 64 * 160 * 2;
    char* Kl = smem;
    char* Vl = smem + 2 * KB;
    float* xch = (float*)(smem + 2 * KB + 2 * VB) + wave * 64;
    float* rpbL = (float*)(smem + 2 * KB + 2 * VB + 8 * 64 * 4);
    constexpr float C = 0.125f * LOG2E;
    const int skey = tid >> 3, sch = tid & 7;
    const int vb0 = (int)(uintptr_t)Vl + (8 * hi + ((lane & 15) >> 2)) * 320 + (16 * ((lane >> 4) & 1) + 4 * (lane & 3)) * 2;
    for (int u = blockIdx.x; u < 64 * 16; u += G) {
        const int rg = u >> 4, h = u & 15;
        const int r = rg * 4 + (wave >> 1), qb = wave & 1;
        const int r0w = min(max(r - 4, 0), 248);
        const int kr_lo = min(max(rg * 4 - 4, 0), 248), kr_hi = min(max(rg * 4 + 3 - 4, 0), 248) + 7, nwin = kr_hi - kr_lo + 1, ntile = nwin + 4;
        for (int i = tid; i < 15 * 31; i += NTH) rpbL[i] = p.na_rpb[(size_t)h * 15 * 31 + i] * LOG2E;
        const int c = qb * 32 + r32, c0 = min(max(c - 8, 0), 48);
        const size_t qrow = (size_t)CTXN + (size_t)r * 64 + c;
        bf16x8 qr[4];
#pragma unroll
        for (int ks = 0; ks < 4; ++ks) qr[ks] = *(const bf16x8*)(QKV + qrow * 3072 + h * 64 + ks * 16 + hi * 8);
        float m_reg = -1e30f, l_reg = 0.f; f32x16 o0 = {}, o1 = {};
        u32x4 skA, svA, skB, svB;
#define NA_LOAD(ti_, SK, SV) do { const size_t key0_ = ((ti_) >= nwin) ? (size_t)((ti_) - nwin) * 64 : (size_t)CTXN + (size_t)(kr_lo + (ti_)) * 64; \
            const bf16_t* src_ = QKV + (key0_ + skey) * 3072 + h * 64 + sch * 8; SK = *(const u32x4*)(src_ + 1024); SV = *(const u32x4*)(src_ + 2048); } while (0)
#define NA_WRITE(b_, SK, SV) do { *(u32x4*)(Kl + (b_) * KB + skey * 144 + sch * 16) = SK; *(u32x4*)(Vl + (b_) * VB + skey * 320 + sch * 16) = SV; } while (0)
#define NA_LOADC(ti_, SK, SV) do { const int tc_ = (ti_) < ntile ? (ti_) : ntile - 1; NA_LOAD(tc_, SK, SV); } while (0)
#define NA_COMPUTE(TI, B) do { \
            const bool isctx = (TI) >= nwin; \
            const int kr = kr_lo + (TI); \
            const bool need = isctx || (kr >= r0w && kr <= r0w + 7); \
            if (need) { \
                const bf16_t* Ks = (const bf16_t*)(Kl + (B) * KB); \
                f32x16 p0 = {}, p1 = {}; \
                _Pragma("unroll") for (int ks = 0; ks < 4; ++ks) { \
                    const bf16x8 a0 = *(const bf16x8*)(Ks + r32 * 72 + ks * 16 + hi * 8), a1 = *(const bf16x8*)(Ks + (32 + r32) * 72 + ks * 16 + hi * 8); \
                    p0 = __builtin_amdgcn_mfma_f32_32x32x16_bf16(a0, qr[ks], p0, 0, 0, 0); \
                    p1 = __builtin_amdgcn_mfma_f32_32x32x16_bf16(a1, qr[ks], p1, 0, 0, 0); \
                } \
                NaVF vf; na_vload(vf, vb0 + (B) * VB); SBAR();        \
                float alpha; \
                const float* brow = rpbL + (kr - r + 7) * 31 + 15 - c; \
                if (isctx) na_softmax<0>(p0, p1, m_reg, l_reg, alpha, brow, c0, hi); \
                else if (qb == 0) na_softmax<1>(p0, p1, m_reg, l_reg, alpha, brow, c0, hi); \
                else na_softmax<2>(p0, p1, m_reg, l_reg, alpha, brow, c0, hi); \
                bf16x8 pa0, pa1, pa2, pa3; \
                PK4(p0, 0, pa0); PK4(p0, 8, pa1); PK4(p1, 0, pa2); PK4(p1, 8, pa3); \
                if (__any(alpha < 1.f)) { \
                    if (hi == 0) xch[r32] = alpha; \
                    asm volatile("s_waitcnt lgkmcnt(0)" ::: "memory"); \
                    _Pragma("unroll") for (int q = 0; q < 16; ++q) { const float a = xch[crow(q, hi)]; o0[q] *= a; o1[q] *= a; } \
                } \
                na_pvall(o0, o1, vf, pa0, pa1, pa2, pa3); \
            } } while (0)
        NA_LOAD(0, skA, svA); NA_WRITE(0, skA, svA);
        NA_LOAD(1, skA, svA);
        __syncthreads();
        for (int ti = 0; ti < ntile; ti += 2) {
            NA_LOADC(ti + 2, skB, svB);
            NA_COMPUTE(ti, 0);
            NA_WRITE(1, skA, svA);
            __syncthreads();
            if (ti + 1 >= ntile) break;
            NA_LOADC(ti + 3, skA, svA);
            NA_COMPUTE(ti + 1, 1);
            NA_WRITE(0, skB, svB);
            __syncthreads();
        }
#undef NA_LOADC
#undef NA_COMPUTE
#undef NA_LOAD
#undef NA_WRITE
        if (hi == 0) xch[32 + r32] = l_reg;
        asm volatile("s_waitcnt lgkmcnt(0)" ::: "memory");
        const size_t orow0 = (size_t)CTXN + (size_t)r * 64 + qb * 32;
#pragma unroll
        for (int q = 0; q < 16; ++q) {
            const int qi = crow(q, hi); const float il = __builtin_amdgcn_rcpf(xch[32 + qi]);
            unsigned char* dst = (unsigned char*)MIX + (orow0 + qi) * 1024 + h * 64;
            const unsigned w8 = pk4_fp8(o0[q] * il * NA_O8_SCALE, o1[q] * il * NA_O8_SCALE, 0.f, 0.f);
            dst[r32] = (unsigned char)(w8 & 255u); dst[32 + r32] = (unsigned char)((w8 >> 8) & 255u);
        }
        __syncthreads();
    }
}
#undef PK4

#define XB_TMO      128
#define XB_XCNT(j)  (256  + 64 * (j))
#define XB_XSUB(j)  (1280 + 64 * (j))
#define XB_XGEN(j)  (2304 + 64 * (j))
#define XB_TOP      3328
#define XB_TOPGEN   3392
#define XCD_BAR_WORDS 3456
#define XB_SPIN_CAP (1u << 22)
#define LAS __attribute__((address_space(3)))
__device__ __forceinline__ unsigned xb_ld(unsigned* p)              { return __hip_atomic_load(p, __ATOMIC_RELAXED, __HIP_MEMORY_SCOPE_AGENT); }
__device__ __forceinline__ unsigned xb_add(unsigned* p, unsigned v) { return __hip_atomic_fetch_add(p, v, __ATOMIC_RELAXED, __HIP_MEMORY_SCOPE_AGENT); }
__device__ __forceinline__ unsigned xb_xcc_id() { return (unsigned)__builtin_amdgcn_s_getreg((3 << 11) | 20) & 0xFu; }
#define XB_SPIN(cond, bar) do { unsigned _sp = 0; while (cond) { __builtin_amdgcn_s_sleep(1); \
    if ((++_sp & 255u) == 0u) { if (xb_ld(&(bar)[XB_TMO])) break; if (_sp > XB_SPIN_CAP) { atomicAdd(&(bar)[XB_TMO], 1u); break; } } } } while (0)
struct XcdBarrier { unsigned* bar; unsigned x; volatile LAS unsigned* st; };
__device__ __forceinline__ XcdBarrier xcd_barrier_post(unsigned* bar, volatile LAS unsigned* st) {
    XcdBarrier b; b.bar = bar; b.x = xb_xcc_id(); b.st = st;
    if (threadIdx.x == 0) (void)xb_add(&bar[XB_XCNT(b.x)], 1u);
    return b;
}
__device__ __forceinline__ void xcd_barrier_complete(unsigned* bar, unsigned x, unsigned& nloc, unsigned& nx) {
    const unsigned G = gridDim.x * gridDim.y * gridDim.z;
    unsigned sum, cnt, mine, sp = 0u;
    for (;;) {
        sum = 0u; cnt = 0u; mine = 0u;
#pragma unroll
        for (unsigned j = 0; j < 16; ++j) { const unsigned c = xb_ld(&bar[XB_XCNT(j)]); sum += c; cnt += (c > 0u) ? 1u : 0u; mine = (j == x) ? c : mine; }
        if (sum == G) break;
        __builtin_amdgcn_s_sleep(1);
        if ((++sp & 255u) == 0u) { if (xb_ld(&bar[XB_TMO])) break; if (sp > XB_SPIN_CAP) { atomicAdd(&bar[XB_TMO], 1u); break; } }
    }
    nloc = mine > 0u ? mine : 1u; nx = cnt > 0u ? cnt : 1u;
}
__device__ __forceinline__ void xcd_barrier(const XcdBarrier& b) {
    asm volatile("s_waitcnt vmcnt(0)" ::: "memory");
    __syncthreads();
    if (threadIdx.x == 0) {
        unsigned* bar = b.bar;
        __builtin_amdgcn_s_waitcnt(0);
        unsigned nloc = b.st[0], nx = b.st[1];
        if (nloc == 0u) { xcd_barrier_complete(bar, b.x, nloc, nx); b.st[0] = nloc; b.st[1] = nx; }
        const unsigned old = xb_add(&bar[XB_XSUB(b.x)], 1u);
        const unsigned gen = old / nloc;
        if (old + 1u == (gen + 1u) * nloc) {
            __builtin_amdgcn_fence(__ATOMIC_RELEASE, "agent");
            asm volatile("s_waitcnt vmcnt(0)" ::: "memory");
            const unsigned og = xb_add(&bar[XB_TOP], 1u);
            const unsigned tg = og / nx;
            if (og + 1u == (tg + 1u) * nx) xb_add(&bar[XB_TOPGEN], 1u);
            else XB_SPIN(xb_ld(&bar[XB_TOPGEN]) == tg, bar);
            __builtin_amdgcn_fence(__ATOMIC_ACQUIRE, "agent");
            xb_add(&bar[XB_XGEN(b.x)], 1u);
            asm volatile("s_waitcnt vmcnt(0)" ::: "memory");
        } else {
            XB_SPIN(xb_ld(&bar[XB_XGEN(b.x)]) == gen, bar);
            __builtin_amdgcn_fence(__ATOMIC_ACQUIRE, "agent");
            asm volatile("s_waitcnt vmcnt(0)" ::: "memory");
        }
    }
    __syncthreads();
}

__device__ __forceinline__ void run_phase(PRef p, int ph) {
#ifdef ONLY_PHASE
    if (ph != ONLY_PHASE) return;
    ph = ONLY_PHASE;
#endif
    const bf16_t* HB = (const bf16_t*)(p.ws + WS_HB);
    switch (ph) {
    case 0: phase_prologue(p); break;
    case 1: phase_norm1_l0(p); break;
    case 2: phase_gemm_pg8(HB, 1024, (const bf16_t*)(p.ws + WS_WIN), 1024, (bf16_t*)(p.ws + WS_P), PW, NTOK / 256, 8); break;
    case 3: phase_mla_up(p); break;
    case 4: break;
    case 5: phase_gla_scan(p); break;
    case 6: phase_mix0(p); break;
    case 7: phase_gemm_pg8_f8((const unsigned char*)(p.ws + WS_MIX), (const unsigned char*)(p.ws + WS_WOUT0), (bf16_t*)(p.ws + WS_OB), 1024, NTOK / 256, 4, 0x7C7C7C7C); break;
    case 8: phase_mid(p, 0); break;
    case 9: phase_moe1(p, 0); break;
    case 10: phase_moe2(p, 0); break;
    case 11: phase_end(p, 0); break;
    case 12: phase_gemm_pg8_f8((const unsigned char*)HB, (const unsigned char*)(p.ws + WS_WQKV), (bf16_t*)(p.ws + WS_P), 3072, NTOK / 256, 12); break;
    case 13: phase_na(p); break;
    case 14: phase_gemm_pg8_f8((const unsigned char*)(p.ws + WS_MIX) + (size_t)CTXN * 1024, (const unsigned char*)(p.ws + WS_WNAO), (bf16_t*)(p.ws + WS_OB) + (size_t)CTXN * 1024, 1024, SEQ / 256, 4, 0x7C7C7C7C); break;
    case 15: phase_mid(p, 1); break;
    case 16: phase_moe1(p, 1); break;
    case 17: phase_moe2(p, 1); break;
    case 18: phase_end(p, 1); break;
    default: break;
    }
}
constexpr int N_PHASES = 19;

#if MK_LAUNCHES == 1
__global__ void __launch_bounds__(512) mega_kernel(Params p) {
    cg::grid_group grid = cg::this_grid();
    volatile LAS unsigned* xst = (volatile LAS unsigned*)(smem + LDS_BYTES - 16);
    if (threadIdx.x == 0) { xst[0] = 0u; xst[1] = 0u; xst[2] = 0u; xst[3] = 0u; }
    __syncthreads();
    XcdBarrier xb = xcd_barrier_post((unsigned*)(kparams()->ws + WS_BAR), xst);
    run_phase(*kparams(), 0); xcd_barrier(xb);
    if (kparams()->pad0 == 0x7fffffff) grid.sync();
    if (PROBE_REPEAT == 100) { run_phase(*kparams(), 0); xcd_barrier(xb); }
    if (PROBE_REPEAT == 61) { phase_gla_out(*kparams()); xcd_barrier(xb); }
#define PH_(n) run_phase(*kparams(), n); xcd_barrier(xb); if ((n) == PROBE_REPEAT) { run_phase(*kparams(), n); xcd_barrier(xb); }
    PH_(1) PH_(2) PH_(3) PH_(5) PH_(6) PH_(7) PH_(8) PH_(9) PH_(10) PH_(11) PH_(12) PH_(13) PH_(14) PH_(15) PH_(16) PH_(17)
    run_phase(*kparams(), 18);
#undef PH_
}
#else
template <int PH> __global__ void __launch_bounds__(512) phase_kernel(Params p) { run_phase(*kparams(), PH); }
typedef void (*phase_fn)(Params);
template <int PH> static bool launch_phase(const Params& p, int grid, hipStream_t stream, bool setattr) {
    if (setattr && hipFuncSetAttribute((const void*)phase_kernel<PH>, hipFuncAttributeMaxDynamicSharedMemorySize, LDS_BYTES) != hipSuccess) return false;
    hipLaunchKernelGGL(phase_kernel<PH>, dim3(grid), dim3(NTH), LDS_BYTES, stream, p);
    return true;
}
#endif

extern "C" void kernel_launch(void* const* d_in, const int* in_sizes, int n_in, void* d_out, int out_size, void* d_ws, size_t ws_size, hipStream_t stream) {
    static int grid_blocks = 0;
    bool first = false;
    if (!grid_blocks) {
        if (ws_size < WS_END) { fprintf(stderr, "kernel_launch: workspace too small: %zu < %zu\n", ws_size, (size_t)WS_END); return; }
        int dev = 0, cus = 0;
        (void)hipGetDevice(&dev);
        (void)hipDeviceGetAttribute(&cus, hipDeviceAttributeMultiprocessorCount, dev);
#if MK_LAUNCHES == 1
        if (hipFuncSetAttribute((const void*)mega_kernel, hipFuncAttributeMaxDynamicSharedMemorySize, LDS_BYTES) != hipSuccess) { fprintf(stderr, "kernel_launch: LDS attribute failed\n"); return; }
        int per_cu = 0;
        (void)hipOccupancyMaxActiveBlocksPerMultiprocessor(&per_cu, (const void*)mega_kernel, NTH, LDS_BYTES);
        if (per_cu < 1) { fprintf(stderr, "kernel_launch: occupancy query returned %d\n", per_cu); return; }
#endif
        grid_blocks = cus;
        first = true;
    }
    Params p{};
    const float* const* in = (const float* const*)d_in;
    p.x = in[0]; p.c = in[1]; p.ctx = in[2]; p.c_ctx = in[3]; p.ada_w = in[4]; p.ada_b = in[5]; p.norm_g = in[6]; p.router_w = in[7]; p.router_b = in[8];
    p.moe_w1 = in[9]; p.moe_b1 = in[10]; p.moe_w2 = in[11]; p.moe_b2 = in[12]; p.ab_in_w = in[13]; p.gla_wa_f = in[14]; p.gla_ba_f = in[15]; p.gla_wa_b = in[16]; p.gla_ba_b = in[17];
    p.gla_onorm = in[18]; p.mla_qnorm = in[19]; p.mla_wuq = in[20]; p.mla_kvnorm = in[21]; p.mla_wukv = in[22]; p.ab_out_w = in[23]; p.na_qkv_w = in[24]; p.na_rpb = in[25]; p.na_out_w = in[26];
    p.out = (float*)d_out; p.ws = (char*)d_ws;
#if MK_LAUNCHES == 1
    (void)hipMemsetAsync((char*)d_ws + WS_BAR, 0, 16384, stream);
    void* args[] = {&p};
    hipError_t e = hipLaunchCooperativeKernel((const void*)mega_kernel, dim3(grid_blocks), dim3(NTH), args, LDS_BYTES, stream);
    if (e != hipSuccess) fprintf(stderr, "cooperative launch failed: %s (grid %d)\n", hipGetErrorString(e), grid_blocks);
#else
    const int g = grid_blocks;
    launch_phase<0>(p, g, stream, first); launch_phase<1>(p, g, stream, first); launch_phase<2>(p, g, stream, first); launch_phase<3>(p, g, stream, first);
    launch_phase<4>(p, g, stream, first); launch_phase<5>(p, g, stream, first); launch_phase<6>(p, g, stream, first); launch_phase<7>(p, g, stream, first);
    launch_phase<8>(p, g, stream, first); launch_phase<9>(p, g, stream, first); launch_phase<10>(p, g, stream, first); launch_phase<11>(p, g, stream, first);
    launch_phase<12>(p, g, stream, first); launch_phase<13>(p, g, stream, first); launch_phase<14>(p, g, stream, first); launch_phase<15>(p, g, stream, first);
    launch_phase<16>(p, g, stream, first); launch_phase<17>(p, g, stream, first); launch_phase<18>(p, g, stream, first);
#endif
}
```
